# Optimizing an MI355X kernel written in HIP

```python
import math
import jax
import jax.numpy as jnp
from jax import lax
import numpy as np

D_MODEL = 1024
BATCH = 8
SEQ = 2048
DEPTH = 4

CTX_LEN = 256
GRID_W = 64
D_A = 512
H_A = 8
HD_A = D_A // H_A
H_B = 4
DK_B = 128
DV_B = 128
D_B = H_B * DV_B
H_C = 4
DK_C = 128
DV_C = 128
D_C = H_C * DV_C
D_MIX = D_A + D_B + D_C
CONV_W = 4
CONV_PAD = 2
CHUNK_B = 64
CHUNK_C = 16
RG_C = 8.0
EPS = 1e-6
SPLIT_SIZES = (D_A, D_A, 2 * H_B * DK_B + D_B, 2 * H_B, 2 * H_B, D_B,
               H_C * DK_C, 2 * H_C * DK_C, H_C * DV_C, D_C)
N_IN = sum(SPLIT_SIZES)

kernel_name = 'hybrid_rglru_gdn_hgrn2_prefix_dit'


def rms_norm(x, w):
    xf = x.astype(jnp.float32)
    y = xf * lax.rsqrt(jnp.mean(xf * xf, axis=-1, keepdims=True) + EPS)
    return (y * w.astype(jnp.float32)).astype(x.dtype)


def l2norm(x):
    xf = x.astype(jnp.float32)
    return xf * lax.rsqrt(jnp.sum(xf * xf, axis=-1, keepdims=True) + EPS)


def _rev(a):
    return jnp.flip(a, axis=1)


def dw_conv(x, w):
    return lax.conv_general_dilated(
        x, w[:, None, :].astype(x.dtype), window_strides=(1,),
        padding=[(CONV_PAD, CONV_W - 1 - CONV_PAD)],
        dimension_numbers=('NWC', 'WIO', 'NWC'), feature_group_count=x.shape[-1])


def _to_chunks(x, chunk):
    bsz, t_len = x.shape[:2]
    x = x.reshape((bsz, t_len // chunk, chunk) + x.shape[2:])
    return jnp.moveaxis(x, 3, 2)


def _from_chunks(x):
    x = jnp.moveaxis(x, 2, 3)
    return x.reshape((x.shape[0], x.shape[1] * x.shape[2]) + x.shape[3:])


def to_col_major(u, rows):
    bsz, t_len, d = u.shape
    return u.reshape(bsz, rows, GRID_W, d).transpose(0, 2, 1, 3).reshape(bsz, t_len, d)


def from_col_major(u, rows):
    bsz, t_len, d = u.shape
    return u.reshape(bsz, GRID_W, rows, d).transpose(0, 2, 1, 3).reshape(bsz, t_len, d)


def rglru(x, w_r, b_r, w_i, b_i, lam, h0):
    bsz, t_len, _ = x.shape
    xf = x.astype(jnp.float32)
    xh = xf.reshape(bsz, t_len, H_A, HD_A)
    r = jax.nn.sigmoid(jnp.einsum('bthi,hij->bthj', xh, w_r.astype(jnp.float32)).reshape(bsz, t_len, D_A) + b_r)
    i = jax.nn.sigmoid(jnp.einsum('bthi,hij->bthj', xh, w_i.astype(jnp.float32)).reshape(bsz, t_len, D_A) + b_i)
    log_a = -RG_C * r * jax.nn.softplus(-lam.astype(jnp.float32))
    a = jnp.exp(log_a)
    u = jnp.sqrt(-jnp.expm1(2.0 * log_a)) * (i * xf)

    def combine(lhs, rhs):
        a1, u1 = lhs
        a2, u2 = rhs
        return a1 * a2, a2 * u1 + u2

    a_cum, h = lax.associative_scan(combine, (a, u), axis=1)
    h = h + a_cum * h0[:, None, :]
    return h, h[:, -1]


def gated_delta_chunked(q, k, v, g, beta, s0):
    f32 = jnp.float32
    q = _to_chunks(q.astype(f32) * DK_B ** -0.5, CHUNK_B)
    k = _to_chunks(k.astype(f32), CHUNK_B)
    v = _to_chunks(v.astype(f32), CHUNK_B)
    g = jnp.cumsum(_to_chunks(g.astype(f32), CHUNK_B), axis=-1)
    beta = _to_chunks(beta.astype(f32), CHUNK_B)
    idx = jnp.arange(CHUNK_B)
    causal = idx[:, None] >= idx[None, :]
    strict = idx[:, None] > idx[None, :]
    decay = jnp.exp(jnp.where(causal, g[..., :, None] - g[..., None, :], -jnp.inf))
    kb = k * beta[..., None]
    a_int = jnp.where(strict, jnp.einsum('bnhcd,bnhsd->bnhcs', kb, k) * decay, 0.0)
    eye = jnp.eye(CHUNK_B, dtype=f32)
    t_inv = lax.linalg.triangular_solve(eye + a_int, jnp.broadcast_to(eye, a_int.shape),
                                        left_side=True, lower=True, unit_diagonal=True)
    u = jnp.einsum('bnhcs,bnhse->bnhce', t_inv, v * beta[..., None])
    w = jnp.einsum('bnhcs,bnhsd->bnhcd', t_inv, kb * jnp.exp(g)[..., None])
    qk = jnp.einsum('bnhcd,bnhsd->bnhcs', q, k) * decay
    q_dec = q * jnp.exp(g)[..., None]
    g_last = g[..., -1]
    k_dec = k * jnp.exp(g_last[..., None] - g)[..., None]

    def step(s, inp):
        qk_n, u_n, w_n, q_n, k_n, gl_n = inp
        v_new = u_n - jnp.einsum('bhcd,bhde->bhce', w_n, s)
        o = jnp.einsum('bhcd,bhde->bhce', q_n, s) + jnp.einsum('bhcs,bhse->bhce', qk_n, v_new)
        s = s * jnp.exp(gl_n)[..., None, None] + jnp.einsum('bhcd,bhce->bhde', k_n, v_new)
        return s, o

    xs = tuple(jnp.moveaxis(t, 1, 0) for t in (qk, u, w, q_dec, k_dec, g_last))
    s_fin, o = lax.scan(step, s0, xs)
    return _from_chunks(jnp.moveaxis(o, 0, 1)), s_fin


def gla_chunked(q, k, v, log_f, s0):
    f32 = jnp.float32
    q = _to_chunks(q.astype(f32), CHUNK_C)
    k = _to_chunks(k.astype(f32), CHUNK_C)
    v = _to_chunks(v.astype(f32), CHUNK_C)
    b = jnp.cumsum(_to_chunks(log_f.astype(f32), CHUNK_C), axis=-2)
    idx = jnp.arange(CHUNK_C)
    causal = idx[:, None] >= idx[None, :]
    dec = jnp.exp(jnp.where(causal[:, :, None], b[..., :, None, :] - b[..., None, :, :], -jnp.inf))
    scores = jnp.einsum('bnhcd,bnhsd,bnhcsd->bnhcs', q, k, dec)
    o_intra = jnp.einsum('bnhcs,bnhse->bnhce', scores, v)
    b_last = b[..., -1, :]
    q_dec = q * jnp.exp(b)
    k_dec = k * jnp.exp(b_last[..., None, :] - b)
    upd = jnp.einsum('bnhcd,bnhce->bnhde', k_dec, v)

    def step(s, inp):
        dec_n, upd_n = inp
        return s * dec_n[..., None] + upd_n, s

    s_fin, s_start = lax.scan(step, s0, (jnp.moveaxis(jnp.exp(b_last), 1, 0), jnp.moveaxis(upd, 1, 0)))
    o_inter = jnp.einsum('bnhcd,nbhde->bnhce', q_dec, s_start)
    return _from_chunks(o_intra + o_inter), s_fin


def mixer_core(u, w_in_l, conv_a_w_l, conv_a_b_l, rg_w_r_l, rg_b_r_l, rg_w_i_l, rg_b_i_l, rg_lam_l,
               conv_b_w_l, a_log_l, dt_bias_l, lb_l, init):
    bsz, t_len, _ = u.shape
    f32 = jnp.float32
    z = jnp.einsum('btd,dn->btn', u, w_in_l)
    xa, ga, qkv, a_lg, b_lg, gb, qc, fc, ic, gc = jnp.split(z, np.cumsum(SPLIT_SIZES)[:-1].tolist(), axis=-1)
    a_f0, a_b0, b_f0, b_b0, c_f0, c_b0 = init
    xa = dw_conv(xa, conv_a_w_l) + conv_a_b_l
    ha_f, a_f1 = rglru(xa, rg_w_r_l[0], rg_b_r_l[0], rg_w_i_l[0], rg_b_i_l[0], rg_lam_l[0], a_f0)
    ha_b, a_b1 = rglru(_rev(xa), rg_w_r_l[1], rg_b_r_l[1], rg_w_i_l[1], rg_b_i_l[1], rg_lam_l[1], a_b0)
    ya = ha_f + _rev(ha_b)
    qkv = jax.nn.silu(dw_conv(qkv, conv_b_w_l))
    qb, kb, vb = jnp.split(qkv, [H_B * DK_B, 2 * H_B * DK_B], axis=-1)
    qb = l2norm(qb.reshape(bsz, t_len, H_B, DK_B))
    kb = l2norm(kb.reshape(bsz, t_len, H_B, DK_B))
    vb = vb.reshape(bsz, t_len, H_B, DV_B)
    g = -jnp.exp(a_log_l) * jax.nn.softplus(a_lg.reshape(bsz, t_len, 2, H_B).astype(f32) + dt_bias_l)
    beta = jax.nn.sigmoid(b_lg.reshape(bsz, t_len, 2, H_B).astype(f32))
    ob_f, b_f1 = gated_delta_chunked(qb, kb, vb, g[:, :, 0], beta[:, :, 0], b_f0)
    ob_b, b_b1 = gated_delta_chunked(_rev(qb), _rev(kb), _rev(vb), _rev(g[:, :, 1]), _rev(beta[:, :, 1]), b_b0)
    ob = ob_f + _rev(ob_b)
    qc = jax.nn.silu(qc).reshape(bsz, t_len, H_C, DK_C)
    ic = ic.reshape(bsz, t_len, H_C, DV_C)
    fg = lb_l + (1.0 - lb_l) * jax.nn.sigmoid(fc.reshape(bsz, t_len, 2, H_C * DK_C).astype(f32))
    kc = (1.0 - fg).reshape(bsz, t_len, 2, H_C, DK_C)
    log_f = jnp.log(fg).reshape(bsz, t_len, 2, H_C, DK_C)
    oc_f, c_f1 = gla_chunked(qc, kc[:, :, 0], ic, log_f[:, :, 0], c_f0)
    oc_b, c_b1 = gla_chunked(_rev(qc), _rev(kc[:, :, 1]), _rev(ic), _rev(log_f[:, :, 1]), c_b0)
    oc = oc_f + _rev(oc_b)
    dt = u.dtype
    core = (ya.astype(dt), ga, ob.astype(dt), gb, oc.astype(dt), gc)
    states = (a_f1, a_b1, b_f1, b_b1, c_f1, c_b1)
    return core, states


def merge(core, gdn_norm_l, hg_norm_l):
    ya, ga, ob, gb, oc, gc = core
    bsz, t_len = ya.shape[:2]
    yb = rms_norm(ob, gdn_norm_l).reshape(bsz, t_len, D_B)
    yc = rms_norm(oc, hg_norm_l).reshape(bsz, t_len, D_C)
    return jnp.concatenate([ya * jax.nn.silu(ga), yb * jax.nn.silu(gb), yc * jax.nn.silu(gc)], axis=-1)


def setup_inputs(seed: int = 0) -> dict:
    key = jax.random.key(seed)
    ks = jax.random.split(key, 24)
    f32 = jnp.float32

    def nrm(k, shape, s):
        return jax.random.normal(k, shape, f32) * s

    a8 = jax.random.uniform(ks[11], (DEPTH, 2, D_A), f32, 0.9, 0.999)
    sig = a8 ** (1.0 / RG_C)
    rg_lam = jnp.log(sig) - jnp.log1p(-sig)
    a_log = jnp.log(jax.random.uniform(ks[13], (DEPTH, 2, H_B), f32, 1.0, 16.0))
    dt = jnp.exp(jax.random.uniform(ks[14], (DEPTH, 2, H_B), f32, math.log(1e-3), math.log(1e-1)))
    dt_bias = dt + jnp.log(-jnp.expm1(-dt))
    return {
        'x': nrm(ks[0], (BATCH, SEQ, D_MODEL), 1.0),
        'c': nrm(ks[1], (BATCH, D_MODEL), 1.0),
        'ctx': nrm(ks[2], (BATCH, CTX_LEN, D_MODEL), 1.0),
        'c_ctx': nrm(ks[3], (D_MODEL,), 1.0),
        'w_ada': nrm(ks[4], (DEPTH, D_MODEL, 3 * D_MODEL), 0.5 * D_MODEL ** -0.5),
        'b_ada': nrm(ks[5], (DEPTH, 3 * D_MODEL), 0.02),
        'norm_pre': 1.0 + nrm(ks[6], (DEPTH, D_MODEL), 0.02),
        'norm_post': 1.0 + nrm(ks[7], (DEPTH, D_MODEL), 0.02),
        'w_in': nrm(ks[8], (DEPTH, D_MODEL, N_IN), D_MODEL ** -0.5),
        'conv_a_w': nrm(ks[9], (DEPTH, CONV_W, D_A), CONV_W ** -0.5),
        'conv_a_b': nrm(ks[10], (DEPTH, D_A), 0.02),
        'rg_w_r': nrm(ks[12], (DEPTH, 2, H_A, HD_A, HD_A), HD_A ** -0.5),
        'rg_b_r': nrm(ks[15], (DEPTH, 2, D_A), 0.1),
        'rg_w_i': nrm(ks[16], (DEPTH, 2, H_A, HD_A, HD_A), HD_A ** -0.5),
        'rg_b_i': nrm(ks[17], (DEPTH, 2, D_A), 0.1),
        'rg_lam': rg_lam,
        'conv_b_w': nrm(ks[18], (DEPTH, CONV_W, 2 * H_B * DK_B + D_B), CONV_W ** -0.5),
        'gdn_a_log': a_log,
        'gdn_dt_bias': dt_bias,
        'gdn_norm': 1.0 + nrm(ks[19], (DEPTH, DV_B), 0.02),
        'hg_lb': nrm(ks[20], (DEPTH, 2, H_C * DK_C), 0.1),
        'hg_norm': 1.0 + nrm(ks[21], (DEPTH, DV_C), 0.02),
        'w_out': nrm(ks[22], (DEPTH, D_MIX, D_MODEL), D_MIX ** -0.5),
    }


def reference(x, c, ctx, c_ctx, w_ada, b_ada, norm_pre, norm_post, w_in, conv_a_w, conv_a_b,
              rg_w_r, rg_b_r, rg_w_i, rg_b_i, rg_lam, conv_b_w, gdn_a_log, gdn_dt_bias, gdn_norm,
              hg_lb, hg_norm, w_out):
    f32 = jnp.float32
    bsz, t_len, _ = x.shape
    rows = t_len // GRID_W
    lb_w = jax.nn.softmax(hg_lb.astype(f32), axis=0)
    lbs = jnp.cumsum(lb_w, axis=0) - lb_w[0]
    zero_states = (jnp.zeros((bsz, D_A), f32), jnp.zeros((bsz, D_A), f32),
                   jnp.zeros((bsz, H_B, DK_B, DV_B), f32), jnp.zeros((bsz, H_B, DK_B, DV_B), f32),
                   jnp.zeros((bsz, H_C, DK_C, DV_C), f32), jnp.zeros((bsz, H_C, DK_C, DV_C), f32))
    sc = jax.nn.silu(c)
    scc = jax.nn.silu(c_ctx)
    h, hc = x, ctx
    for l in range(DEPTH):
        shift_x, scale_x, gate_x = jnp.split(jnp.einsum('bd,de->be', sc, w_ada[l]) + b_ada[l], 3, axis=-1)
        shift_c, scale_c, gate_c = jnp.split(jnp.einsum('d,de->e', scc, w_ada[l]) + b_ada[l], 3, axis=-1)
        layer_w = (w_in[l], conv_a_w[l], conv_a_b[l], rg_w_r[l], rg_b_r[l], rg_w_i[l], rg_b_i[l], rg_lam[l],
                   conv_b_w[l], gdn_a_log[l], gdn_dt_bias[l], lbs[l])
        uc = rms_norm(hc, norm_pre[l]) * (1.0 + scale_c) + shift_c
        core_c, ctx_states = mixer_core(uc, *layer_w, zero_states)
        ux = rms_norm(h, norm_pre[l]) * (1.0 + scale_x[:, None]) + shift_x[:, None]
        transposed = (l % 2 == 1)
        if transposed:
            ux = to_col_major(ux, rows)
        core_x, _ = mixer_core(ux, *layer_w, ctx_states)
        yx = merge(core_x, gdn_norm[l], hg_norm[l])
        if transposed:
            yx = from_col_major(yx, rows)
        h = h + gate_x[:, None] * rms_norm(jnp.einsum('btm,md->btd', yx, w_out[l]), norm_post[l])
        if l < DEPTH - 1:
            yc = merge(core_c, gdn_norm[l], hg_norm[l])
            hc = hc + gate_c * rms_norm(jnp.einsum('btm,md->btd', yc, w_out[l]), norm_post[l])
    return h
```

```cpp
#include <hip/hip_runtime.h>
#include <hip/hip_cooperative_groups.h>
#include <cstdio>
namespace cg = cooperative_groups;

typedef __attribute__((ext_vector_type(8))) short bf16x8;
typedef __attribute__((ext_vector_type(4))) float f32x4;
typedef unsigned short u16;
#define DEV __device__ __forceinline__

constexpr int DM = 1024, TL = 2048, TCX = 256, TS = 2304, GB = 4, GR = GB * TS, NG = 2;
constexpr int NZ = 5760, DEPTH = 4;
constexpr int C_XA = 0, C_Q = 512, C_K = 1024, C_V = 1536, C_QC = 2048, C_F0 = 2560, C_IC = 3584,
              C_GA = 4096, C_GB = 4608, C_GC = 5120, C_AB = 5632;
constexpr int NCH = GR / 64;
constexpr float EPS = 1e-6f;
constexpr int WPB = 2;

constexpr size_t al256(size_t x) { return (x + 255) & ~(size_t)255; }
constexpr size_t O_WTIN = 0;
constexpr size_t O_WTOUT = O_WTIN + al256((size_t)DEPTH * NZ * 1024 * 2);
constexpr size_t O_WGT = O_WTOUT + al256((size_t)DEPTH * 1024 * 1536 * 2);
constexpr size_t O_MOD = O_WGT + al256((size_t)DEPTH * 2 * 2 * 8 * 4096 * 2);
constexpr size_t O_LBS = O_MOD + al256((size_t)DEPTH * 9 * 3072 * 4);
constexpr size_t O_HC = O_LBS + al256((size_t)DEPTH * 1024 * 4);
constexpr size_t O_Z = O_HC + al256((size_t)GB * TCX * 1024 * 4);
constexpr size_t O_ZT = O_Z + al256((size_t)GR * NZ * 2);
constexpr size_t O_AB = O_ZT + al256((size_t)512 * GR * 2);
constexpr size_t O_BSH = O_AB + al256((size_t)GR * 16 * 4);
constexpr size_t BSH_ONE = (size_t)GR * 512 * 2;
constexpr size_t O_BIT = O_BSH + al256(4 * BSH_ONE);
constexpr size_t BIT_SZ = 17408;
constexpr size_t O_CREC = O_BIT + al256((size_t)NCH * 4 * 2 * BIT_SZ);
constexpr size_t CREC_SZ = 33280;
constexpr size_t O_OB = O_CREC + al256((size_t)NCH * 4 * 2 * CREC_SZ);
constexpr size_t O_OC = O_OB + al256((size_t)2 * GR * 512 * 2);
constexpr size_t O_AP = O_OC + al256((size_t)2 * GR * 512 * 2);
constexpr size_t O_AH = O_AP + al256((size_t)NCH * 2 * 512 * 4);
constexpr size_t O_ACAR = O_AH + al256((size_t)NCH * 2 * 512 * 4);
constexpr size_t WS_TOTAL = O_ACAR + al256((size_t)NCH * 2 * 512 * 4);

constexpr int LDS_BYTES = 69632;

struct P {
  const float *x, *c, *ctx, *c_ctx, *w_ada, *b_ada, *norm_pre, *norm_post, *w_in, *conv_a_w, *conv_a_b, *rg_w_r,
      *rg_b_r, *rg_w_i, *rg_b_i, *rg_lam, *conv_b_w, *gdn_a_log, *gdn_dt_bias, *gdn_norm, *hg_lb, *hg_norm, *w_out;
  float* out;
  char* ws;
};

DEV int opq(int x) { asm volatile("" : "+v"(x)); return x; }
DEV int opqs(int x) { asm volatile("" : "+s"(x)); return x; }
DEV u16 f2bf(float f) {
  unsigned u = __float_as_uint(f);
  u += 0x7fffu + ((u >> 16) & 1u);
  return (u16)(u >> 16);
}
DEV float bf2f(u16 h) { return __uint_as_float(((unsigned)h) << 16); }
DEV unsigned pk2(float a, float b) { return (unsigned)f2bf(a) | ((unsigned)f2bf(b) << 16); }
DEV float sigm(float x) { return 1.f / (1.f + __expf(-x)); }
DEV float silu(float x) { return x / (1.f + __expf(-x)); }
DEV float softplus(float x) { return x > 20.f ? x : log1pf(__expf(x)); }
DEV f32x4 mfma(bf16x8 a, bf16x8 b, f32x4 c) { return __builtin_amdgcn_mfma_f32_16x16x32_bf16(a, b, c, 0, 0, 0); }
DEV bf16x8 ld8(const u16* p) { return *reinterpret_cast<const bf16x8*>(p); }
DEV int lat_map(int l, int t) { return (l & 1) ? ((t & 63) * 32 + (t >> 6)) : t; }
DEV int orig_col(int n) {
  if (n < 512) return n;
  if (n < 2048) return n + 512;
  if (n < 4096) return n + 1040;
  if (n < 4608) return n - 4096 + 512;
  if (n < 5120) return n - 4608 + 2576;
  if (n < 5632) return n + 16;
  if (n < 5648) return n - 5632 + 2560;
  return -1;
}
DEV float zval(const u16* z, int rb, int cp, int n, int col) {
  if (cp < 0 && (n == 0 || n == 4)) return 0.f;
  if (cp > 63 && (n == 3 || n == 35)) return 0.f;
  return bf2f(z[(size_t)(rb + cp) * NZ + col]);
}

DEV void ph0_ada(const P& p, int item, char* smem) {
  float* sc = (float*)smem;
  for (int i = threadIdx.x; i < 9 * 1024; i += 256) {
    int v = i >> 10, d = i & 1023;
    float cv = (v < 8) ? p.c[v * 1024 + d] : p.c_ctx[d];
    sc[i] = silu(cv);
  }
  __syncthreads();
  int col = item * 256 + threadIdx.x;
  int l = col / 3072, e = col % 3072;
  const float* w = p.w_ada + (size_t)l * 1024 * 3072 + e;
  float acc[9];
#pragma unroll
  for (int i = 0; i < 9; ++i) acc[i] = 0.f;
  for (int d = 0; d < 1024; d += 4) {
    float w0 = w[(size_t)d * 3072], w1 = w[(size_t)(d + 1) * 3072], w2 = w[(size_t)(d + 2) * 3072],
          w3 = w[(size_t)(d + 3) * 3072];
#pragma unroll
    for (int i = 0; i < 9; ++i)
      acc[i] += sc[i * 1024 + d] * w0 + sc[i * 1024 + d + 1] * w1 + sc[i * 1024 + d + 2] * w2 +
                sc[i * 1024 + d + 3] * w3;
  }
  float* mod = (float*)(p.ws + O_MOD);
  float bb = p.b_ada[l * 3072 + e];
#pragma unroll
  for (int i = 0; i < 9; ++i) mod[((size_t)l * 9 + i) * 3072 + e] = acc[i] + bb;
  __syncthreads();
}
DEV void tconv_tile(const float* src, int lds_, u16* dst, int ldd, int k0, int n0, bool mapcol, char* smem) {
  float* t = (float*)smem;
  for (int i = threadIdx.x; i < 4096; i += 256) {
    int kk = i >> 6, nn = i & 63;
    int n = n0 + nn;
    int sn = mapcol ? orig_col(n) : n;
    t[kk * 65 + nn] = (sn >= 0) ? src[(size_t)(k0 + kk) * lds_ + sn] : 0.f;
  }
  __syncthreads();
  for (int i = threadIdx.x; i < 4096; i += 256) {
    int nn = i >> 6, kk = i & 63;
    dst[(size_t)(n0 + nn) * ldd + k0 + kk] = f2bf(t[kk * 65 + nn]);
  }
  __syncthreads();
}
DEV void phase0(const P& p, char* smem) {
  const int n_ada = 48, n_in = DEPTH * 16 * 90, n_out = DEPTH * 24 * 16, n_g = 128, n_lb = 4;
  const int total = n_ada + n_in + n_out + n_g + n_lb;
  for (int it = blockIdx.x; it < total; it += gridDim.x) {
    int i = it;
    if (i < n_ada) { ph0_ada(p, i, smem); continue; }
    i -= n_ada;
    if (i < n_in) {
      int l = i / 1440, r = i % 1440, kt = r / 90, nt = r % 90;
      tconv_tile(p.w_in + (size_t)l * 1024 * 5648, 5648, (u16*)(p.ws + O_WTIN) + (size_t)l * NZ * 1024, 1024, kt * 64,
                 nt * 64, true, smem);
      continue;
    }
    i -= n_in;
    if (i < n_out) {
      int l = i / 384, r = i % 384, kt = r / 16, nt = r % 16;
      tconv_tile(p.w_out + (size_t)l * 1536 * 1024, 1024, (u16*)(p.ws + O_WTOUT) + (size_t)l * 1024 * 1536, 1536,
                 kt * 64, nt * 64, false, smem);
      continue;
    }
    i -= n_out;
    if (i < n_g) {
      int h = i & 7, gate = (i >> 3) & 1, dir = (i >> 4) & 1, l = i >> 5;
      const float* src = (gate ? p.rg_w_i : p.rg_w_r) + ((size_t)(l * 2 + dir) * 8 + h) * 4096;
      tconv_tile(src, 64, (u16*)(p.ws + O_WGT) + (size_t)i * 4096, 64, 0, 0, false, smem);
      continue;
    }
    i -= n_g;
    {
      int j = i * 256 + threadIdx.x;
      float v[4], mx = -1e30f;
      for (int l = 0; l < 4; ++l) { v[l] = p.hg_lb[l * 1024 + j]; mx = fmaxf(mx, v[l]); }
      float s = 0.f;
      for (int l = 0; l < 4; ++l) { v[l] = __expf(v[l] - mx); s += v[l]; }
      float* lbs = (float*)(p.ws + O_LBS);
      float cum = 0.f;
      for (int l = 0; l < 4; ++l) {
        if (l > 0) cum += v[l] / s;
        lbs[l * 1024 + j] = cum;
      }
    }
  }
}

DEV void phaseR(const P& p, int g, int l) {
  const int tid_ = opq(threadIdx.x); const int lane = tid_ & 63, w = tid_ >> 6;
  const float* mod = (const float*)(p.ws + O_MOD);
  float* hc = (float*)(p.ws + O_HC);
  const float* o = (const float*)(p.ws + O_BSH);
  u16* u = (u16*)(p.ws + O_BIT);
  for (int it = blockIdx.x; it < GR / 4; it += gridDim.x) {
    int lr = it * 4 + w;
    int lb = lr / TS, s = lr % TS;
    bool isctx = s < TCX;
    if (l == DEPTH && isctx) continue;
    int b = g * GB + lb, t = s - TCX;
    int mi = isctx ? 8 : b;
    float* hp = isctx ? hc + ((size_t)lb * TCX + s) * 1024 : p.out + ((size_t)b * TL + t) * 1024;
    float hv[16];
    if (l == 0) {
      const float* src = isctx ? p.ctx + ((size_t)b * TCX + s) * 1024 : p.x + ((size_t)b * TL + t) * 1024;
#pragma unroll
      for (int k = 0; k < 4; ++k) {
        float4 v = *(const float4*)(src + k * 256 + lane * 4);
        hv[k * 4] = v.x; hv[k * 4 + 1] = v.y; hv[k * 4 + 2] = v.z; hv[k * 4 + 3] = v.w;
      }
    } else {
      int orow = lb * TS + (isctx ? s : TCX + lat_map(l - 1, t));
      const float* op = o + (size_t)orow * 1024;
      float ov[16], ss = 0.f;
#pragma unroll
      for (int k = 0; k < 4; ++k) {
        float4 v = *(const float4*)(op + k * 256 + lane * 4);
        ov[k * 4] = v.x; ov[k * 4 + 1] = v.y; ov[k * 4 + 2] = v.z; ov[k * 4 + 3] = v.w;
        ss += v.x * v.x + v.y * v.y + v.z * v.z + v.w * v.w;
      }
#pragma unroll
      for (int off = 32; off; off >>= 1) ss += __shfl_xor(ss, off);
      float rinv = rsqrtf(ss * (1.f / 1024.f) + EPS);
      const float* gate = mod + ((size_t)(l - 1) * 9 + mi) * 3072 + 2048;
      const float* wp = p.norm_post + (l - 1) * 1024;
#pragma unroll
      for (int k = 0; k < 4; ++k) {
        float4 hh = *(const float4*)(hp + k * 256 + lane * 4);
        float4 gg = *(const float4*)(gate + k * 256 + lane * 4);
        float4 ww = *(const float4*)(wp + k * 256 + lane * 4);
        hv[k * 4] = hh.x + gg.x * (ov[k * 4] * rinv * ww.x);
        hv[k * 4 + 1] = hh.y + gg.y * (ov[k * 4 + 1] * rinv * ww.y);
        hv[k * 4 + 2] = hh.z + gg.z * (ov[k * 4 + 2] * rinv * ww.z);
        hv[k * 4 + 3] = hh.w + gg.w * (ov[k * 4 + 3] * rinv * ww.w);
      }
    }
#pragma unroll
    for (int k = 0; k < 4; ++k)
      *(float4*)(hp + k * 256 + lane * 4) = make_float4(hv[k * 4], hv[k * 4 + 1], hv[k * 4 + 2], hv[k * 4 + 3]);
    if (l < DEPTH) {
      float ss = 0.f;
#pragma unroll
      for (int k = 0; k < 16; ++k) ss += hv[k] * hv[k];
#pragma unroll
      for (int off = 32; off; off >>= 1) ss += __shfl_xor(ss, off);
      float rinv = rsqrtf(ss * (1.f / 1024.f) + EPS);
      const float* sh = mod + ((size_t)l * 9 + mi) * 3072;
      const float* wp = p.norm_pre + l * 1024;
      int urow = lb * TS + (isctx ? s : TCX + lat_map(l, t));
      u16* up = u + (size_t)urow * 1024;
#pragma unroll
      for (int k = 0; k < 4; ++k) {
        float4 ww = *(const float4*)(wp + k * 256 + lane * 4);
        float4 s0 = *(const float4*)(sh + k * 256 + lane * 4);
        float4 s1 = *(const float4*)(sh + 1024 + k * 256 + lane * 4);
        float a0 = hv[k * 4] * rinv * ww.x * (1.f + s1.x) + s0.x;
        float a1 = hv[k * 4 + 1] * rinv * ww.y * (1.f + s1.y) + s0.y;
        float a2 = hv[k * 4 + 2] * rinv * ww.z * (1.f + s1.z) + s0.z;
        float a3 = hv[k * 4 + 3] * rinv * ww.w * (1.f + s1.w) + s0.w;
        uint2 pk; pk.x = pk2(a0, a1); pk.y = pk2(a2, a3);
        *(uint2*)(up + k * 256 + lane * 4) = pk;
      }
    }
  }
}

template <int MODE>
DEV void gemm_tile(const u16* __restrict__ A, int lda, const u16* __restrict__ Bt, int K, int rt, int ct, u16* z,
                   u16* zT, float* ab, float* o, char* smem) {
  u16* As = (u16*)smem;
  u16* Bs = As + 128 * 72;
  const int tid = opq(threadIdx.x), lane = tid & 63, w = tid >> 6, wr = w >> 1, wc = w & 1, fr = lane & 15, fq = lane >> 4;
  const int lrow = tid >> 3, lseg = tid & 7;
  const u16* Ag = A + (size_t)(rt * 128 + lrow) * lda + lseg * 8;
  const u16* Bg = Bt + (size_t)(ct * 128 + lrow) * K + lseg * 8;
  uint4 ra0, ra1, ra2, ra3, rb0, rb1, rb2, rb3;
  f32x4 acc[4][4];
#pragma unroll
  for (int i = 0; i < 4; ++i)
#pragma unroll
    for (int j = 0; j < 4; ++j) acc[i][j] = (f32x4){0.f, 0.f, 0.f, 0.f};
#define GLOAD()                                             \
  ra0 = *(const uint4*)(Ag);                                \
  ra1 = *(const uint4*)(Ag + (size_t)32 * lda);             \
  ra2 = *(const uint4*)(Ag + (size_t)64 * lda);             \
  ra3 = *(const uint4*)(Ag + (size_t)96 * lda);             \
  rb0 = *(const uint4*)(Bg);                                \
  rb1 = *(const uint4*)(Bg + (size_t)32 * K);               \
  rb2 = *(const uint4*)(Bg + (size_t)64 * K);               \
  rb3 = *(const uint4*)(Bg + (size_t)96 * K);
  GLOAD();
  const int nk = K / 64;
  for (int kt = 0; kt < nk; ++kt) {
    __syncthreads();
    *(uint4*)(As + (lrow)*72 + lseg * 8) = ra0;
    *(uint4*)(As + (lrow + 32) * 72 + lseg * 8) = ra1;
    *(uint4*)(As + (lrow + 64) * 72 + lseg * 8) = ra2;
    *(uint4*)(As + (lrow + 96) * 72 + lseg * 8) = ra3;
    *(uint4*)(Bs + (lrow)*72 + lseg * 8) = rb0;
    *(uint4*)(Bs + (lrow + 32) * 72 + lseg * 8) = rb1;
    *(uint4*)(Bs + (lrow + 64) * 72 + lseg * 8) = rb2;
    *(uint4*)(Bs + (lrow + 96) * 72 + lseg * 8) = rb3;
    __syncthreads();
    if (kt + 1 < nk) {
      Ag += 64; Bg += 64;
      GLOAD();
    }
#pragma unroll
    for (int ks = 0; ks < 2; ++ks) {
      bf16x8 af[4], bfr[4];
#pragma unroll
      for (int mi = 0; mi < 4; ++mi) af[mi] = ld8(As + (wr * 64 + mi * 16 + fr) * 72 + ks * 32 + fq * 8);
#pragma unroll
      for (int ni = 0; ni < 4; ++ni) bfr[ni] = ld8(Bs + (wc * 64 + ni * 16 + fr) * 72 + ks * 32 + fq * 8);
#pragma unroll
      for (int mi = 0; mi < 4; ++mi)
#pragma unroll
        for (int ni = 0; ni < 4; ++ni) acc[mi][ni] = mfma(af[mi], bfr[ni], acc[mi][ni]);
    }
  }
#pragma unroll
  for (int mi = 0; mi < 4; ++mi)
#pragma unroll
    for (int ni = 0; ni < 4; ++ni) {
      int row0 = rt * 128 + wr * 64 + mi * 16 + fq * 4;
      int col = ct * 128 + wc * 64 + ni * 16 + fr;
      f32x4 v = acc[mi][ni];
      if (MODE == 1) {
#pragma unroll
        for (int r = 0; r < 4; ++r) o[(size_t)(row0 + r) * 1024 + col] = v[r];
      } else {
        if (ct >= 28 && ct < 32) {
          uint2 pk; pk.x = pk2(v[0], v[1]); pk.y = pk2(v[2], v[3]);
          *(uint2*)(zT + (size_t)(col - C_IC) * GR + row0) = pk;
        } else if (ct == 44) {
          if (col - C_AB < 16) {
#pragma unroll
            for (int r = 0; r < 4; ++r) ab[(size_t)(row0 + r) * 16 + (col - C_AB)] = v[r];
          }
        } else {
#pragma unroll
          for (int r = 0; r < 4; ++r) z[(size_t)(row0 + r) * NZ + col] = f2bf(v[r]);
        }
      }
    }
}

DEV void a_item(const P& p, int l, int item, int mode, char* smem) {
  float* xc = (float*)smem;
  u16* xcb = (u16*)(smem + 16384);
  float* av = (float*)(smem + 16384 + 9216);
  float* uv = av + 4096;
  float* segP = uv + 4096;
  float* segH = segP + 256;
  const int tid = opq(threadIdx.x), lane = tid & 63, w = tid >> 6, fr = lane & 15, fq = lane >> 4;
  const int cgk = item >> 3, hA = item & 7, n = cgk % 36, rb = cgk * 64;
  u16* z = (u16*)(p.ws + O_Z);
  for (int idx = tid; idx < 4096; idx += 256) {
    int c = idx >> 6, j = idx & 63, ch = hA * 64 + j;
    float val = p.conv_a_b[l * 512 + ch];
#pragma unroll
    for (int tap = 0; tap < 4; ++tap) val += p.conv_a_w[(l * 4 + tap) * 512 + ch] * zval(z, rb, c + tap - 2, n, C_XA + ch);
    xc[idx] = val;
    xcb[c * 72 + j] = f2bf(val);
  }
  __syncthreads();
  float yacc[16];
#pragma unroll
  for (int k = 0; k < 16; ++k) yacc[k] = 0.f;
  const int seg = tid >> 6, sj = tid & 63, sch = hA * 64 + sj;
  for (int dir = 0; dir < 2; ++dir) {
    {
      const u16* wg = (const u16*)(p.ws + O_WGT);
      const u16* wr_ = wg + (size_t)((((l * 2 + dir) * 2 + 0) * 8 + hA)) * 4096;
      const u16* wi_ = wg + (size_t)((((l * 2 + dir) * 2 + 1) * 8 + hA)) * 4096;
      bf16x8 a0 = ld8(xcb + (16 * w + fr) * 72 + fq * 8), a1 = ld8(xcb + (16 * w + fr) * 72 + 32 + fq * 8);
#pragma unroll
      for (int nt = 0; nt < 4; ++nt) {
        f32x4 ar = {0.f, 0.f, 0.f, 0.f}, ai = {0.f, 0.f, 0.f, 0.f};
        const u16* br = wr_ + (nt * 16 + fr) * 64 + fq * 8;
        const u16* bi = wi_ + (nt * 16 + fr) * 64 + fq * 8;
        ar = mfma(a0, ld8(br), ar); ar = mfma(a1, ld8(br + 32), ar);
        ai = mfma(a0, ld8(bi), ai); ai = mfma(a1, ld8(bi + 32), ai);
        int j = nt * 16 + fr, ch = hA * 64 + j;
        float brv = p.rg_b_r[(l * 2 + dir) * 512 + ch], biv = p.rg_b_i[(l * 2 + dir) * 512 + ch];
        float sp = softplus(-p.rg_lam[(l * 2 + dir) * 512 + ch]);
#pragma unroll
        for (int r = 0; r < 4; ++r) {
          int c = 16 * w + 4 * fq + r;
          float rg = sigm(ar[r] + brv), ig = sigm(ai[r] + biv);
          float la = -8.f * rg * sp;
          float a = __expf(la);
          float uu = sqrtf(fmaxf(-expm1f(2.f * la), 0.f)) * (ig * xc[c * 64 + j]);
          av[c * 64 + j] = a;
          uv[c * 64 + j] = uu;
        }
      }
    }
    __syncthreads();
    {
      float Pp = 1.f, H = 0.f;
#pragma unroll
      for (int k = 0; k < 16; ++k) {
        int c = dir ? (16 * seg + 15 - k) : (16 * seg + k);
        float a = av[c * 64 + sj];
        H = a * H + uv[c * 64 + sj];
        Pp *= a;
      }
      segP[seg * 64 + sj] = Pp;
      segH[seg * 64 + sj] = H;
    }
    __syncthreads();
    if (mode == 0) {
      if (seg == 0) {
        float Pc = 1.f, Hc = 0.f;
        for (int q = 0; q < 4; ++q) {
          int sg = dir ? 3 - q : q;
          Hc = segP[sg * 64 + sj] * Hc + segH[sg * 64 + sj];
          Pc *= segP[sg * 64 + sj];
        }
        size_t idx = ((size_t)cgk * 2 + dir) * 512 + sch;
        ((float*)(p.ws + O_AP))[idx] = Pc;
        ((float*)(p.ws + O_AH))[idx] = Hc;
      }
    } else {
      float st = ((const float*)(p.ws + O_ACAR))[((size_t)cgk * 2 + dir) * 512 + sch];
      int nbefore = dir ? 3 - seg : seg;
      for (int q = 0; q < nbefore; ++q) {
        int sg = dir ? 3 - q : q;
        st = segP[sg * 64 + sj] * st + segH[sg * 64 + sj];
      }
      if (dir == 0) {
#pragma unroll
        for (int k = 0; k < 16; ++k) {
          int c = 16 * seg + k;
          st = av[c * 64 + sj] * st + uv[c * 64 + sj];
          yacc[k] += st;
        }
      } else {
#pragma unroll
        for (int k = 15; k >= 0; --k) {
          int c = 16 * seg + k;
          st = av[c * 64 + sj] * st + uv[c * 64 + sj];
          yacc[k] += st;
        }
      }
    }
    __syncthreads();
  }
  if (mode == 1) {
#pragma unroll
    for (int k = 0; k < 16; ++k) {
      size_t zi = (size_t)(rb + 16 * seg + k) * NZ + C_GA + sch;
      float gate = bf2f(z[zi]);
      z[zi] = f2bf(yacc[k] * silu(gate));
    }
  }
}

DEV void a_carry(const P& p, int item) {
  int t = item * 256 + threadIdx.x;
  int ch = t & 511, dir = (t >> 9) & 1, lb = t >> 10;
  const float* AP = (const float*)(p.ws + O_AP);
  const float* AH = (const float*)(p.ws + O_AH);
  float* AC = (float*)(p.ws + O_ACAR);
  float st = 0.f;
  for (int j = 0; j < 36; ++j) {
    int n = dir ? (j < 4 ? 3 - j : 39 - j) : j;
    size_t idx = ((size_t)(lb * 36 + n) * 2 + dir) * 512 + ch;
    AC[idx] = st;
    st = AP[idx] * st + AH[idx];
  }
}

DEV void b_local(const P& p, int l, int item, char* smem) {
  u16* qs = (u16*)smem;
  u16* ks = qs + 64 * 136;
  float* Am = (float*)(smem + 34816);
  float* gc = (float*)(smem + 34816 + 32768);
  float* bt = gc + 128;
  const int tid = opq(threadIdx.x), lane = tid & 63, w = tid >> 6, fr = lane & 15, fq = lane >> 4;
  const int cgk = item >> 2, h = item & 3, n = cgk % 36, rb = cgk * 64;
  const u16* z = (const u16*)(p.ws + O_Z);
  u16* qn = (u16*)(p.ws + O_BSH);
  u16* kn = qn + (size_t)GR * 512;
  u16* vb = kn + (size_t)GR * 512;
  u16* knT = vb + (size_t)GR * 512;
  const float* ab = (const float*)(p.ws + O_AB);
  for (int c = w; c < 64; c += 4) {
    float qv[2], kv[2], vv[2];
#pragma unroll
    for (int hh = 0; hh < 2; ++hh) {
      int d = lane + 64 * hh, chn = h * 128 + d;
      float a0 = 0.f, a1 = 0.f, a2 = 0.f;
#pragma unroll
      for (int tap = 0; tap < 4; ++tap) {
        const float* cw = p.conv_b_w + (size_t)(l * 4 + tap) * 1536;
        a0 += cw[chn] * zval(z, rb, c + tap - 2, n, C_Q + chn);
        a1 += cw[512 + chn] * zval(z, rb, c + tap - 2, n, C_K + chn);
        a2 += cw[1024 + chn] * zval(z, rb, c + tap - 2, n, C_V + chn);
      }
      qv[hh] = silu(a0); kv[hh] = silu(a1); vv[hh] = silu(a2);
    }
    float sq = qv[0] * qv[0] + qv[1] * qv[1], sk = kv[0] * kv[0] + kv[1] * kv[1];
#pragma unroll
    for (int off = 32; off; off >>= 1) { sq += __shfl_xor(sq, off); sk += __shfl_xor(sk, off); }
    float rq = rsqrtf(sq + EPS) * 0.08838834764831845f, rk = rsqrtf(sk + EPS);
#pragma unroll
    for (int hh = 0; hh < 2; ++hh) {
      int d = lane + 64 * hh;
      u16 qb = f2bf(qv[hh] * rq), kb = f2bf(kv[hh] * rk);
      qs[c * 136 + d] = qb; ks[c * 136 + d] = kb;
      size_t gi = (size_t)(rb + c) * 512 + h * 128 + d;
      qn[gi] = qb; kn[gi] = kb; vb[gi] = f2bf(vv[hh]);
    }
  }
  if (w < 2) {
    int dir = w, i = lane, c = dir ? 63 - i : i;
    float al = ab[(size_t)(rb + c) * 16 + dir * 4 + h], bl = ab[(size_t)(rb + c) * 16 + 8 + dir * 4 + h];
    float g = -__expf(p.gdn_a_log[(l * 2 + dir) * 4 + h]) * softplus(al + p.gdn_dt_bias[(l * 2 + dir) * 4 + h]);
#pragma unroll
    for (int off = 1; off < 64; off <<= 1) {
      float v = __shfl_up(g, off);
      if (lane >= off) g += v;
    }
    gc[dir * 64 + i] = g;
    bt[dir * 64 + i] = sigm(bl);
  }
  __syncthreads();
  for (int idx = tid; idx < 1024; idx += 256) {
    int d = idx >> 3, c8 = idx & 7;
    uint4 pk;
    pk.x = (unsigned)ks[(c8 * 8 + 0) * 136 + d] | ((unsigned)ks[(c8 * 8 + 1) * 136 + d] << 16);
    pk.y = (unsigned)ks[(c8 * 8 + 2) * 136 + d] | ((unsigned)ks[(c8 * 8 + 3) * 136 + d] << 16);
    pk.z = (unsigned)ks[(c8 * 8 + 4) * 136 + d] | ((unsigned)ks[(c8 * 8 + 5) * 136 + d] << 16);
    pk.w = (unsigned)ks[(c8 * 8 + 6) * 136 + d] | ((unsigned)ks[(c8 * 8 + 7) * 136 + d] << 16);
    *(uint4*)(knT + ((size_t)(cgk * 4 + h) * 128 + d) * 64 + c8 * 8) = pk;
  }
  for (int dir = 0; dir < 2; ++dir) {
    char* rec = p.ws + O_BIT + ((size_t)(cgk * 4 + h) * 2 + dir) * BIT_SZ;
    u16* QKm = (u16*)rec + 4096;
    float* scal = (float*)(rec + 16384);
    int irow = 16 * w + fr, ci = dir ? 63 - irow : irow;
    bf16x8 ak[4], aq[4];
#pragma unroll
    for (int s = 0; s < 4; ++s) { ak[s] = ld8(ks + ci * 136 + 32 * s + 8 * fq); aq[s] = ld8(qs + ci * 136 + 32 * s + 8 * fq); }
#pragma unroll
    for (int nt = 0; nt < 4; ++nt) {
      int jcol = 16 * nt + fr, cj = dir ? 63 - jcol : jcol;
      f32x4 kk = {0.f, 0.f, 0.f, 0.f}, qk = {0.f, 0.f, 0.f, 0.f};
#pragma unroll
      for (int s = 0; s < 4; ++s) {
        bf16x8 b = ld8(ks + cj * 136 + 32 * s + 8 * fq);
        kk = mfma(ak[s], b, kk);
        qk = mfma(aq[s], b, qk);
      }
      float gj = gc[dir * 64 + jcol];
#pragma unroll
      for (int r = 0; r < 4; ++r) {
        int i = 16 * w + 4 * fq + r;
        float dec = (jcol <= i) ? __expf(gc[dir * 64 + i] - gj) : 0.f;
        Am[(dir * 64 + i) * 64 + jcol] = (jcol < i) ? bt[dir * 64 + i] * kk[r] * dec : 0.f;
        QKm[i * 64 + jcol] = f2bf(qk[r] * dec);
      }
    }
    if (tid < 64) {
      float gl = gc[dir * 64 + 63], gi = gc[dir * 64 + tid];
      scal[tid] = __expf(gi);
      scal[64 + tid] = bt[dir * 64 + tid];
      scal[128 + tid] = __expf(gl - gi);
      if (tid == 0) scal[192] = __expf(gl);
    }
  }
  __syncthreads();
  if (w < 2) {
    int dir = w, col = lane;
    u16* Tinv = (u16*)(p.ws + O_BIT + ((size_t)(cgk * 4 + h) * 2 + dir) * BIT_SZ);
    const float* Ad = Am + dir * 4096;
    float T[64];
#pragma unroll
    for (int i = 0; i < 64; ++i) {
      float s = (i == col) ? 1.f : 0.f;
#pragma unroll
      for (int j = 0; j < i; ++j) s -= Ad[i * 64 + j] * T[j];
      T[i] = s;
      Tinv[i * 64 + col] = f2bf(s);
      __builtin_amdgcn_sched_barrier(0);
    }
  }
  __syncthreads();
}

DEV void b_seq(const P& p, int bitem, char* smem) {
  const int tid = opq(threadIdx.x), lane = tid & 63, w = tid >> 6, fr = lane & 15, fq = lane >> 4;
  const bool active = w < WPB;
  const int item = bitem * WPB + (active ? w : 0);
  const int slice = item & 7, dir = (item >> 3) & 1, h = (item >> 4) & 3, lb = item >> 6, e0 = slice * 16;
  u16* Ss = (u16*)(smem + w * 11264);
  u16* Rs = Ss + 16 * 136;
  u16* Vsc = Rs + 16 * 72;
  u16* Vor = Vsc + 16 * 72;
  const u16* qn = (const u16*)(p.ws + O_BSH);
  const u16* kn = qn + (size_t)GR * 512;
  const u16* vb = kn + (size_t)GR * 512;
  const u16* knT = vb + (size_t)GR * 512;
  u16* OB = (u16*)(p.ws + O_OB);
  f32x4 S[8];
#pragma unroll
  for (int m = 0; m < 8; ++m) S[m] = (f32x4){0.f, 0.f, 0.f, 0.f};
  for (int j = 0; j < 36; ++j) {
    const int n = dir ? (j < 4 ? 3 - j : 39 - j) : j;
    const int cgk = lb * 36 + n, rb = cgk * 64;
    const char* rec = p.ws + O_BIT + ((size_t)(cgk * 4 + h) * 2 + dir) * BIT_SZ;
    const u16* Tinv = (const u16*)rec;
    const u16* QKm = Tinv + 4096;
    const float* scal = (const float*)(rec + 16384);
    if (active) {
#pragma unroll
      for (int m = 0; m < 8; ++m) {
        uint2 pk; pk.x = pk2(S[m][0], S[m][1]); pk.y = pk2(S[m][2], S[m][3]);
        *(uint2*)(Ss + fr * 136 + 16 * m + 4 * fq) = pk;
      }
    }
    __syncthreads();
    bf16x8 Sf[4];
    if (active) {
#pragma unroll
      for (int s = 0; s < 4; ++s) Sf[s] = ld8(Ss + fr * 136 + 32 * s + 8 * fq);
#pragma unroll
      for (int m = 0; m < 4; ++m) {
        int i = 16 * m + fr, rowi = rb + (dir ? 63 - i : i);
        f32x4 X = {0.f, 0.f, 0.f, 0.f};
#pragma unroll
        for (int s = 0; s < 4; ++s) X = mfma(ld8(kn + (size_t)rowi * 512 + h * 128 + 32 * s + 8 * fq), Sf[s], X);
        float rv[4];
#pragma unroll
        for (int r = 0; r < 4; ++r) {
          int ii = 16 * m + 4 * fq + r, rowr = rb + (dir ? 63 - ii : ii);
          float v = bf2f(vb[(size_t)rowr * 512 + h * 128 + e0 + fr]);
          rv[r] = scal[64 + ii] * (v - scal[ii] * X[r]);
        }
        uint2 pk; pk.x = pk2(rv[0], rv[1]); pk.y = pk2(rv[2], rv[3]);
        *(uint2*)(Rs + fr * 72 + 16 * m + 4 * fq) = pk;
      }
    }
    __syncthreads();
    if (active) {
      bf16x8 Rf0 = ld8(Rs + fr * 72 + 8 * fq), Rf1 = ld8(Rs + fr * 72 + 32 + 8 * fq);
#pragma unroll
      for (int m = 0; m < 4; ++m) {
        f32x4 VN = {0.f, 0.f, 0.f, 0.f};
        VN = mfma(ld8(Tinv + (16 * m + fr) * 64 + 8 * fq), Rf0, VN);
        VN = mfma(ld8(Tinv + (16 * m + fr) * 64 + 32 + 8 * fq), Rf1, VN);
        uint2 pk; pk.x = pk2(VN[0], VN[1]); pk.y = pk2(VN[2], VN[3]);
        *(uint2*)(Vsc + fr * 72 + 16 * m + 4 * fq) = pk;
        int ib = 16 * m + 4 * fq;
        float s0 = VN[0] * scal[128 + ib], s1 = VN[1] * scal[128 + ib + 1], s2 = VN[2] * scal[128 + ib + 2],
              s3 = VN[3] * scal[128 + ib + 3];
        if (dir) {
          pk.x = pk2(s3, s2); pk.y = pk2(s1, s0);
          *(uint2*)(Vor + fr * 72 + (60 - ib)) = pk;
        } else {
          pk.x = pk2(s0, s1); pk.y = pk2(s2, s3);
          *(uint2*)(Vor + fr * 72 + ib) = pk;
        }
      }
    }
    __syncthreads();
    if (active) {
      bf16x8 Vs0 = ld8(Vsc + fr * 72 + 8 * fq), Vs1 = ld8(Vsc + fr * 72 + 32 + 8 * fq);
      bf16x8 Vo0 = ld8(Vor + fr * 72 + 8 * fq), Vo1 = ld8(Vor + fr * 72 + 32 + 8 * fq);
#pragma unroll
      for (int m = 0; m < 4; ++m) {
        int i = 16 * m + fr, rowi = rb + (dir ? 63 - i : i);
        f32x4 O = {0.f, 0.f, 0.f, 0.f};
#pragma unroll
        for (int s = 0; s < 4; ++s) O = mfma(ld8(qn + (size_t)rowi * 512 + h * 128 + 32 * s + 8 * fq), Sf[s], O);
#pragma unroll
        for (int r = 0; r < 4; ++r) O[r] *= scal[16 * m + 4 * fq + r];
        O = mfma(ld8(QKm + (16 * m + fr) * 64 + 8 * fq), Vs0, O);
        O = mfma(ld8(QKm + (16 * m + fr) * 64 + 32 + 8 * fq), Vs1, O);
#pragma unroll
        for (int r = 0; r < 4; ++r) {
          int ii = 16 * m + 4 * fq + r, rowr = rb + (dir ? 63 - ii : ii);
          OB[((size_t)dir * GR + rowr) * 512 + h * 128 + e0 + fr] = f2bf(O[r]);
        }
      }
      float egl = scal[192];
#pragma unroll
      for (int m = 0; m < 8; ++m) {
        const u16* kt = knT + ((size_t)(cgk * 4 + h) * 128 + 16 * m + fr) * 64;
        f32x4 t = S[m];
#pragma unroll
        for (int r = 0; r < 4; ++r) t[r] *= egl;
        t = mfma(ld8(kt + 8 * fq), Vo0, t);
        t = mfma(ld8(kt + 32 + 8 * fq), Vo1, t);
        S[m] = t;
      }
    }
  }
  __syncthreads();
}

DEV void c_local(const P& p, int l, int item, char* smem) {
  float* bsm = (float*)smem;
  u16* Ps = (u16*)(smem + 33024);
  u16* kdt = (u16*)(smem + 33024 + 9216);
  const int tid = opq(threadIdx.x), lane = tid & 63, w = tid >> 6, fr = lane & 15, fq = lane >> 4;
  const int cgk = item >> 2, h = item & 3, rb = cgk * 64;
  const u16* z = (const u16*)(p.ws + O_Z);
  const u16* zT = (const u16*)(p.ws + O_ZT);
  u16* OC = (u16*)(p.ws + O_OC);
  const float* lbs = (const float*)(p.ws + O_LBS);
  for (int dir = 0; dir < 2; ++dir) {
    char* rec = p.ws + O_CREC + ((size_t)(cgk * 4 + h) * 2 + dir) * CREC_SZ;
    u16* QD = (u16*)rec;
    u16* KDT = QD + 8192;
    float* decv = (float*)(rec + 32768);
    const float* lbp = lbs + l * 1024 + dir * 512 + h * 128;
    const int fcol = C_F0 + dir * 512 + h * 128;
    {
      int d = tid & 127, half = tid >> 7;
      float lb_ = lbp[d], run = 0.f;
      for (int k = 0; k < 32; ++k) {
        int i = 32 * half + k, c = dir ? 63 - i : i;
        float f = bf2f(z[(size_t)(rb + c) * NZ + fcol + d]);
        float fg = lb_ + (1.f - lb_) * sigm(f);
        run += __logf(fg);
        bsm[i * 129 + d] = run;
      }
    }
    __syncthreads();
    {
      int d = tid & 127, half = tid >> 7;
      if (half) {
        float add = bsm[31 * 129 + d];
        for (int k = 0; k < 32; ++k) bsm[(32 + k) * 129 + d] += add;
      }
    }
    __syncthreads();
    for (int idx = tid; idx < 8192; idx += 256) {
      int i = idx >> 7, d = idx & 127, c = dir ? 63 - i : i;
      float b = bsm[i * 129 + d];
      float q = silu(bf2f(z[(size_t)(rb + c) * NZ + C_QC + h * 128 + d]));
      QD[i * 128 + d] = f2bf(q * __expf(b));
      float f = bf2f(z[(size_t)(rb + c) * NZ + fcol + d]);
      float k = (1.f - lbp[d]) * sigm(-f);
      kdt[d * 72 + c] = f2bf(k * __expf(bsm[63 * 129 + d] - b));
    }
    if (tid < 128) decv[tid] = __expf(bsm[63 * 129 + tid]);
    __syncthreads();
    for (int idx = tid; idx < 1024; idx += 256) {
      int d = idx >> 3, c8 = idx & 7;
      *(uint4*)(KDT + d * 64 + c8 * 8) = *(const uint4*)(kdt + d * 72 + c8 * 8);
    }
    {
      const int sj = w;
      for (int si = 0; si < 4; ++si) {
        f32x4 acc = {0.f, 0.f, 0.f, 0.f};
        if (si >= sj) {
          int it = 16 * si + fr, jt = 16 * sj + fr;
          int ci = dir ? 63 - it : it, cj = dir ? 63 - jt : jt;
#pragma unroll
          for (int s = 0; s < 4; ++s) {
            int d0 = 32 * s + 8 * fq;
            bf16x8 qv = ld8(z + (size_t)(rb + ci) * NZ + C_QC + h * 128 + d0);
            bf16x8 fv = ld8(z + (size_t)(rb + cj) * NZ + fcol + d0);
            bf16x8 af, bf;
#pragma unroll
            for (int e = 0; e < 8; ++e) {
              int d = d0 + e;
              float Bs_ = si ? bsm[(16 * si - 1) * 129 + d] : 0.f;
              float qq = silu(bf2f((u16)qv[e])) * __expf(bsm[it * 129 + d] - Bs_);
              float kk = (1.f - lbp[d]) * sigm(-bf2f((u16)fv[e])) * __expf(Bs_ - bsm[jt * 129 + d]);
              af[e] = (short)f2bf(qq);
              bf[e] = (short)f2bf(kk);
            }
            acc = mfma(af, bf, acc);
          }
        }
#pragma unroll
        for (int r = 0; r < 4; ++r) {
          int i = 16 * si + 4 * fq + r, jj = 16 * sj + fr;
          float v = (si >= sj && jj <= i) ? acc[r] : 0.f;
          Ps[i * 72 + (dir ? 63 - jj : jj)] = f2bf(v);
        }
      }
    }
    __syncthreads();
#pragma unroll
    for (int nt2 = 0; nt2 < 2; ++nt2) {
      int e = h * 128 + (2 * w + nt2) * 16 + fr;
      bf16x8 v0 = ld8(zT + (size_t)e * GR + rb + 8 * fq), v1 = ld8(zT + (size_t)e * GR + rb + 32 + 8 * fq);
#pragma unroll
      for (int m = 0; m < 4; ++m) {
        f32x4 O = {0.f, 0.f, 0.f, 0.f};
        O = mfma(ld8(Ps + (16 * m + fr) * 72 + 8 * fq), v0, O);
        O = mfma(ld8(Ps + (16 * m + fr) * 72 + 32 + 8 * fq), v1, O);
#pragma unroll
        for (int r = 0; r < 4; ++r) {
          int ii = 16 * m + 4 * fq + r, rowr = rb + (dir ? 63 - ii : ii);
          OC[((size_t)dir * GR + rowr) * 512 + e] = f2bf(O[r]);
        }
      }
    }
    __syncthreads();
  }
}

DEV void c_seq(const P& p, int bitem, char* smem) {
  const int tid = opq(threadIdx.x), lane = tid & 63, w = tid >> 6, fr = lane & 15, fq = lane >> 4;
  const bool active = w < WPB;
  const int item = bitem * WPB + (active ? w : 0);
  const int slice = item & 7, dir = (item >> 3) & 1, h = (item >> 4) & 3, lb = item >> 6, e0 = slice * 16;
  u16* Ss = (u16*)(smem + w * 4352);
  const u16* zT = (const u16*)(p.ws + O_ZT);
  u16* OC = (u16*)(p.ws + O_OC);
  f32x4 S[8];
#pragma unroll
  for (int m = 0; m < 8; ++m) S[m] = (f32x4){0.f, 0.f, 0.f, 0.f};
  for (int j = 0; j < 36; ++j) {
    const int n = dir ? (j < 4 ? 3 - j : 39 - j) : j;
    const int cgk = lb * 36 + n, rb = cgk * 64;
    const char* rec = p.ws + O_CREC + ((size_t)(cgk * 4 + h) * 2 + dir) * CREC_SZ;
    const u16* QD = (const u16*)rec;
    const u16* KDT = QD + 8192;
    const float* decv = (const float*)(rec + 32768);
    if (active) {
#pragma unroll
      for (int m = 0; m < 8; ++m) {
        uint2 pk; pk.x = pk2(S[m][0], S[m][1]); pk.y = pk2(S[m][2], S[m][3]);
        *(uint2*)(Ss + fr * 136 + 16 * m + 4 * fq) = pk;
      }
    }
    __syncthreads();
    if (active) {
      bf16x8 Sf[4];
#pragma unroll
      for (int s = 0; s < 4; ++s) Sf[s] = ld8(Ss + fr * 136 + 32 * s + 8 * fq);
#pragma unroll
      for (int m = 0; m < 4; ++m) {
        f32x4 O = {0.f, 0.f, 0.f, 0.f};
#pragma unroll
        for (int s = 0; s < 4; ++s) O = mfma(ld8(QD + (16 * m + fr) * 128 + 32 * s + 8 * fq), Sf[s], O);
#pragma unroll
        for (int r = 0; r < 4; ++r) {
          int ii = 16 * m + 4 * fq + r, rowr = rb + (dir ? 63 - ii : ii);
          size_t oi = ((size_t)dir * GR + rowr) * 512 + h * 128 + e0 + fr;
          OC[oi] = f2bf(bf2f(OC[oi]) + O[r]);
        }
      }
      const u16* vp = zT + (size_t)(h * 128 + e0 + fr) * GR + rb;
      bf16x8 V0 = ld8(vp + 8 * fq), V1 = ld8(vp + 32 + 8 * fq);
#pragma unroll
      for (int m = 0; m < 8; ++m) {
        f32x4 t = S[m];
#pragma unroll
        for (int r = 0; r < 4; ++r) t[r] *= decv[16 * m + 4 * fq + r];
        t = mfma(ld8(KDT + (16 * m + fr) * 64 + 8 * fq), V0, t);
        t = mfma(ld8(KDT + (16 * m + fr) * 64 + 32 + 8 * fq), V1, t);
        S[m] = t;
      }
    }
    __syncthreads();
  }
}

DEV void bc_merge(const P& p, int l, int it) {
  const int tid_ = opq(threadIdx.x); const int lane = tid_ & 63, w = tid_ >> 6;
  int lr = it * 4 + w;
  int mix = lane >> 5, cm = (lane * 16) & 511;
  const u16* O = (const u16*)(p.ws + (mix ? O_OC : O_OB));
  u16* z = (u16*)(p.ws + O_Z);
  float ov[16], ss = 0.f;
#pragma unroll
  for (int k2 = 0; k2 < 2; ++k2) {
    uint4 a = *(const uint4*)(O + (size_t)lr * 512 + cm + 8 * k2);
    uint4 b = *(const uint4*)(O + ((size_t)GR + lr) * 512 + cm + 8 * k2);
    unsigned aa[4] = {a.x, a.y, a.z, a.w}, bb[4] = {b.x, b.y, b.z, b.w};
#pragma unroll
    for (int q = 0; q < 4; ++q) {
      float v0 = bf2f((u16)(aa[q] & 0xffff)) + bf2f((u16)(bb[q] & 0xffff));
      float v1 = bf2f((u16)(aa[q] >> 16)) + bf2f((u16)(bb[q] >> 16));
      ov[k2 * 8 + q * 2] = v0; ov[k2 * 8 + q * 2 + 1] = v1;
      ss += v0 * v0 + v1 * v1;
    }
  }
  ss += __shfl_xor(ss, 1); ss += __shfl_xor(ss, 2); ss += __shfl_xor(ss, 4);
  float rinv = rsqrtf(ss * (1.f / 128.f) + EPS);
  const float* nw = (mix ? p.hg_norm : p.gdn_norm) + l * 128 + (cm & 127);
  u16* gp = z + (size_t)lr * NZ + (mix ? C_GC : C_GB) + cm;
#pragma unroll
  for (int k2 = 0; k2 < 2; ++k2) {
    uint4 gv = *(const uint4*)(gp + 8 * k2);
    unsigned gg[4] = {gv.x, gv.y, gv.z, gv.w}, oo[4];
#pragma unroll
    for (int q = 0; q < 4; ++q) {
      int e = k2 * 8 + q * 2;
      float y0 = ov[e] * rinv * nw[e] * silu(bf2f((u16)(gg[q] & 0xffff)));
      float y1 = ov[e + 1] * rinv * nw[e + 1] * silu(bf2f((u16)(gg[q] >> 16)));
      oo[q] = pk2(y0, y1);
    }
    *(uint4*)(gp + 8 * k2) = make_uint4(oo[0], oo[1], oo[2], oo[3]);
  }
}

#ifdef NO_G0
#define XG0(x)
#else
#define XG0(x) x
#endif
#ifdef NO_G1
#define XG1(x)
#else
#define XG1(x) x
#endif
#ifdef NO_BC
#define XBC(x)
#else
#define XBC(x) x
#endif
#ifdef NO_AC
#define XAC(x)
#else
#define XAC(x) x
#endif
#ifdef NO_P0
#define XP0(x)
#else
#define XP0(x) x
#endif
#ifdef NO_R
#define XR(x)
#else
#define XR(x) x
#endif
#ifdef NO_BL
#define XBL(x)
#else
#define XBL(x) x
#endif
#ifdef NO_CL
#define XCL(x)
#else
#define XCL(x) x
#endif
#ifdef NO_A0
#define XA0(x)
#else
#define XA0(x) x
#endif
#ifdef NO_A1
#define XA1(x)
#else
#define XA1(x) x
#endif
#ifdef NO_BS
#define XBS(x)
#else
#define XBS(x) x
#endif
#ifdef NO_CS
#define XCS(x)
#else
#define XCS(x) x
#endif
__global__ void __launch_bounds__(256, 2) fwd_mega(P p) {
  extern __shared__ __attribute__((aligned(16))) char smem[];
  cg::grid_group grid = cg::this_grid();
  const int G = gridDim.x;
  XP0(phase0(p, smem));
  grid.sync();
  u16* z = (u16*)(p.ws + O_Z);
  u16* zT = (u16*)(p.ws + O_ZT);
  float* ab = (float*)(p.ws + O_AB);
  float* o = (float*)(p.ws + O_BSH);
  const u16* u = (const u16*)(p.ws + O_BIT);
  for (int g = 0; g < NG; ++g) {
    XR(phaseR(p, g, 0));
    grid.sync();
    for (int l = 0; l < DEPTH; ++l) {
      {
        const u16* Bt = (const u16*)(p.ws + O_WTIN) + (size_t)l * NZ * 1024;
        for (int t = blockIdx.x; t < 72 * 45; t += G) { XG0(gemm_tile<0>(u, 1024, Bt, 1024, t % 72, t / 72, z, zT, ab, o, smem)); }
      }
      grid.sync();
      {
        const int nb = NCH * 4, nc = NCH * 4, na = NCH * 8;
        for (int t = blockIdx.x; t < nb + nc + na; t += G) {
          if (t < nb) { XBL(b_local(p, l, t, smem)); }
          else if (t < nb + nc) { XCL(c_local(p, l, t - nb, smem)); }
          else { XA0(a_item(p, l, t - nb - nc, 0, smem)); }
        }
      }
      grid.sync();
      {
        const int nb = 256 / WPB, nc = 256 / WPB, na = 16;
        for (int t = blockIdx.x; t < nb + nc + na; t += G) {
          if (t < nb) { XBS(b_seq(p, t, smem)); }
          else if (t < nb + nc) { XCS(c_seq(p, t - nb, smem)); }
          else { XAC(a_carry(p, t - nb - nc)); }
        }
      }
      grid.sync();
      {
        const int na = NCH * 8, nm = GR / 4;
        for (int t = blockIdx.x; t < na + nm; t += G) {
          if (t < na) { XA1(a_item(p, l, t, 1, smem)); }
          else { XBC(bc_merge(p, l, t - na)); }
        }
      }
      grid.sync();
      {
        const u16* Bt = (const u16*)(p.ws + O_WTOUT) + (size_t)l * 1024 * 1536;
        for (int t = blockIdx.x; t < 72 * 8; t += G) { XG1(gemm_tile<1>(z + C_GA, NZ, Bt, 1536, t % 72, t / 72, z, zT, ab, o, smem)); }
      }
      grid.sync();
      XR(phaseR(p, g, l + 1));
      grid.sync();
    }
  }
}

extern "C" void kernel_launch(void* const* d_in, const int* in_sizes, int n_in, void* d_out, int out_size, void* d_ws,
                              size_t ws_size, hipStream_t stream) {
  static int grid_blocks = 0;
  if (!grid_blocks) {
    int dev = 0, cus = 0, per_cu = 0;
    hipGetDevice(&dev);
    hipDeviceGetAttribute(&cus, hipDeviceAttributeMultiprocessorCount, dev);
    hipFuncSetAttribute((const void*)fwd_mega, hipFuncAttributeMaxDynamicSharedMemorySize, LDS_BYTES);
    hipOccupancyMaxActiveBlocksPerMultiprocessor(&per_cu, fwd_mega, 256, LDS_BYTES);
    if (per_cu > 2) per_cu = 2;
    if (per_cu < 1) per_cu = 1;
    grid_blocks = cus * per_cu;
  }
  if (ws_size < WS_TOTAL) {
    fprintf(stderr, "workspace too small: %zu < %zu\n", ws_size, (size_t)WS_TOTAL);
    return;
  }
  P p{};
  const float** f = (const float**)&p;
  for (int i = 0; i < 23; ++i) f[i] = (const float*)d_in[i];
  p.out = (float*)d_out;
  p.ws = (char*)d_ws;
  void* args[] = {&p};
  hipError_t e = hipLaunchCooperativeKernel((void*)fwd_mega, dim3(grid_blocks), dim3(256), args, LDS_BYTES, stream);
  if (e != hipSuccess) fprintf(stderr, "cooperative launch failed: %s (grid %d)\n", hipGetErrorString(e), grid_blocks);
}
```

```cpp
#include <hip/hip_runtime.h>
#include <hip/hip_cooperative_groups.h>
#include <cstdio>
namespace cg = cooperative_groups;

typedef __attribute__((ext_vector_type(8))) short bf16x8;
typedef __attribute__((ext_vector_type(4))) float f32x4;
typedef unsigned short u16;
#define DEV __device__ __forceinline__

constexpr int DM = 1024, TL = 2048, TCX = 256, TS = 2304, GB = 4, GR = GB * TS, NG = 2;
constexpr int NZ = 5760, DEPTH = 4;
constexpr int C_XA = 0, C_Q = 512, C_K = 1024, C_V = 1536, C_QC = 2048, C_F0 = 2560, C_IC = 3584,
              C_GA = 4096, C_GB = 4608, C_GC = 5120, C_AB = 5632;
constexpr int NCH = GR / 64;
constexpr float EPS = 1e-6f;
constexpr int WPB = 2;

constexpr size_t al256(size_t x) { return (x + 255) & ~(size_t)255; }
constexpr size_t O_WTIN = 0;
constexpr size_t O_WTOUT = O_WTIN + al256((size_t)DEPTH * NZ * 1024 * 2);
constexpr size_t O_WGT = O_WTOUT + al256((size_t)DEPTH * 1024 * 1536 * 2);
constexpr size_t O_MOD = O_WGT + al256((size_t)DEPTH * 2 * 2 * 8 * 4096 * 2);
constexpr size_t O_LBS = O_MOD + al256((size_t)DEPTH * 9 * 3072 * 4);
constexpr size_t O_HC = O_LBS + al256((size_t)DEPTH * 1024 * 4);
constexpr size_t O_Z = O_HC + al256((size_t)GB * TCX * 1024 * 4);
constexpr size_t O_ZT = O_Z + al256((size_t)GR * NZ * 2);
constexpr size_t O_AB = O_ZT + al256((size_t)512 * GR * 2);
constexpr size_t O_BSH = O_AB + al256((size_t)GR * 16 * 4);
constexpr size_t BSH_ONE = (size_t)GR * 512 * 2;
constexpr size_t O_BIT = O_BSH + al256(4 * BSH_ONE);
constexpr size_t BIT_SZ = 17408;
constexpr size_t O_CREC = O_BIT + al256((size_t)NCH * 4 * 2 * BIT_SZ);
constexpr size_t CREC_SZ = 33280;
constexpr size_t O_OB = O_CREC + al256((size_t)NCH * 4 * 2 * CREC_SZ);
constexpr size_t O_OC = O_OB + al256((size_t)2 * GR * 512 * 2);
constexpr size_t O_AP = O_OC + al256((size_t)2 * GR * 512 * 2);
constexpr size_t O_AH = O_AP + al256((size_t)NCH * 2 * 512 * 4);
constexpr size_t O_ACAR = O_AH + al256((size_t)NCH * 2 * 512 * 4);
constexpr size_t WS_TOTAL = O_ACAR + al256((size_t)NCH * 2 * 512 * 4);

constexpr int LDS_BYTES = 69632;
#ifndef REP_A
#define REP_A 1
#endif
#ifndef REP_G
#define REP_G 1
#endif
#ifndef REP_M
#define REP_M 1
#endif

struct P {
  const float *x, *c, *ctx, *c_ctx, *w_ada, *b_ada, *norm_pre, *norm_post, *w_in, *conv_a_w, *conv_a_b, *rg_w_r,
      *rg_b_r, *rg_w_i, *rg_b_i, *rg_lam, *conv_b_w, *gdn_a_log, *gdn_dt_bias, *gdn_norm, *hg_lb, *hg_norm, *w_out;
  float* out;
  char* ws;
};

DEV int opq(int x) { asm volatile("" : "+v"(x)); return x; }
DEV int opqs(int x) { asm volatile("" : "+s"(x)); return x; }
DEV u16 f2bf(float f) {
  unsigned u = __float_as_uint(f);
  u += 0x7fffu + ((u >> 16) & 1u);
  return (u16)(u >> 16);
}
DEV float bf2f(u16 h) { return __uint_as_float(((unsigned)h) << 16); }
DEV unsigned pk2(float a, float b) { return (unsigned)f2bf(a) | ((unsigned)f2bf(b) << 16); }
DEV float sigm(float x) { return 1.f / (1.f + __expf(-x)); }
DEV float silu(float x) { return x / (1.f + __expf(-x)); }
DEV float softplus(float x) { return x > 20.f ? x : log1pf(__expf(x)); }
DEV f32x4 mfma(bf16x8 a, bf16x8 b, f32x4 c) { return __builtin_amdgcn_mfma_f32_16x16x32_bf16(a, b, c, 0, 0, 0); }
DEV bf16x8 ld8(const u16* p) { return *reinterpret_cast<const bf16x8*>(p); }
DEV int lat_map(int l, int t) { return (l & 1) ? ((t & 63) * 32 + (t >> 6)) : t; }
DEV int orig_col(int n) {
  if (n < 512) return n;
  if (n < 2048) return n + 512;
  if (n < 4096) return n + 1040;
  if (n < 4608) return n - 4096 + 512;
  if (n < 5120) return n - 4608 + 2576;
  if (n < 5632) return n + 16;
  if (n < 5648) return n - 5632 + 2560;
  return -1;
}
DEV float zval(const u16* z, int rb, int cp, int n, int col) {
  if (cp < 0 && (n == 0 || n == 4)) return 0.f;
  if (cp > 63 && (n == 3 || n == 35)) return 0.f;
  return bf2f(z[(size_t)(rb + cp) * NZ + col]);
}

DEV void ph0_ada(const P& p, int item, char* smem) {
  float* sc = (float*)smem;
  for (int i = threadIdx.x; i < 9 * 1024; i += 256) {
    int v = i >> 10, d = i & 1023;
    float cv = (v < 8) ? p.c[v * 1024 + d] : p.c_ctx[d];
    sc[i] = silu(cv);
  }
  __syncthreads();
  int col = item * 256 + threadIdx.x;
  int l = col / 3072, e = col % 3072;
  const float* w = p.w_ada + (size_t)l * 1024 * 3072 + e;
  float acc[9];
#pragma unroll
  for (int i = 0; i < 9; ++i) acc[i] = 0.f;
  for (int d = 0; d < 1024; d += 4) {
    float w0 = w[(size_t)d * 3072], w1 = w[(size_t)(d + 1) * 3072], w2 = w[(size_t)(d + 2) * 3072],
          w3 = w[(size_t)(d + 3) * 3072];
#pragma unroll
    for (int i = 0; i < 9; ++i)
      acc[i] += sc[i * 1024 + d] * w0 + sc[i * 1024 + d + 1] * w1 + sc[i * 1024 + d + 2] * w2 +
                sc[i * 1024 + d + 3] * w3;
  }
  float* mod = (float*)(p.ws + O_MOD);
  float bb = p.b_ada[l * 3072 + e];
#pragma unroll
  for (int i = 0; i < 9; ++i) mod[((size_t)l * 9 + i) * 3072 + e] = acc[i] + bb;
  __syncthreads();
}
DEV void tconv_tile(const float* src, int lds_, u16* dst, int ldd, int k0, int n0, bool mapcol, char* smem) {
  float* t = (float*)smem;
  for (int i = threadIdx.x; i < 4096; i += 256) {
    int kk = i >> 6, nn = i & 63;
    int n = n0 + nn;
    int sn = mapcol ? orig_col(n) : n;
    t[kk * 65 + nn] = (sn >= 0) ? src[(size_t)(k0 + kk) * lds_ + sn] : 0.f;
  }
  __syncthreads();
  for (int i = threadIdx.x; i < 4096; i += 256) {
    int nn = i >> 6, kk = i & 63;
    dst[(size_t)(n0 + nn) * ldd + k0 + kk] = f2bf(t[kk * 65 + nn]);
  }
  __syncthreads();
}
DEV void phase0(const P& p, char* smem) {
  const int n_ada = 48, n_in = DEPTH * 16 * 90, n_out = DEPTH * 24 * 16, n_g = 128, n_lb = 4;
  const int total = n_ada + n_in + n_out + n_g + n_lb;
  for (int it = blockIdx.x; it < total; it += gridDim.x) {
    int i = it;
    if (i < n_ada) { ph0_ada(p, i, smem); continue; }
    i -= n_ada;
    if (i < n_in) {
      int l = i / 1440, r = i % 1440, kt = r / 90, nt = r % 90;
      tconv_tile(p.w_in + (size_t)l * 1024 * 5648, 5648, (u16*)(p.ws + O_WTIN) + (size_t)l * NZ * 1024, 1024, kt * 64,
                 nt * 64, true, smem);
      continue;
    }
    i -= n_in;
    if (i < n_out) {
      int l = i / 384, r = i % 384, kt = r / 16, nt = r % 16;
      tconv_tile(p.w_out + (size_t)l * 1536 * 1024, 1024, (u16*)(p.ws + O_WTOUT) + (size_t)l * 1024 * 1536, 1536,
                 kt * 64, nt * 64, false, smem);
      continue;
    }
    i -= n_out;
    if (i < n_g) {
      int h = i & 7, gate = (i >> 3) & 1, dir = (i >> 4) & 1, l = i >> 5;
      const float* src = (gate ? p.rg_w_i : p.rg_w_r) + ((size_t)(l * 2 + dir) * 8 + h) * 4096;
      tconv_tile(src, 64, (u16*)(p.ws + O_WGT) + (size_t)i * 4096, 64, 0, 0, false, smem);
      continue;
    }
    i -= n_g;
    {
      int j = i * 256 + threadIdx.x;
      float v[4], mx = -1e30f;
      for (int l = 0; l < 4; ++l) { v[l] = p.hg_lb[l * 1024 + j]; mx = fmaxf(mx, v[l]); }
      float s = 0.f;
      for (int l = 0; l < 4; ++l) { v[l] = __expf(v[l] - mx); s += v[l]; }
      float* lbs = (float*)(p.ws + O_LBS);
      float cum = 0.f;
      for (int l = 0; l < 4; ++l) {
        if (l > 0) cum += v[l] / s;
        lbs[l * 1024 + j] = cum;
      }
    }
  }
}

DEV void phaseR(const P& p, int g, int l) {
  const int tid_ = opq(threadIdx.x); const int lane = tid_ & 63, w = tid_ >> 6;
  const float* mod = (const float*)(p.ws + O_MOD);
  float* hc = (float*)(p.ws + O_HC);
  const float* o = (const float*)(p.ws + O_BSH);
  u16* u = (u16*)(p.ws + O_BIT);
  for (int it = blockIdx.x; it < GR / 4; it += gridDim.x) {
    int lr = it * 4 + w;
    int lb = lr / TS, s = lr % TS;
    bool isctx = s < TCX;
    if (l == DEPTH && isctx) continue;
    int b = g * GB + lb, t = s - TCX;
    int mi = isctx ? 8 : b;
    float* hp = isctx ? hc + ((size_t)lb * TCX + s) * 1024 : p.out + ((size_t)b * TL + t) * 1024;
    float hv[16];
    if (l == 0) {
      const float* src = isctx ? p.ctx + ((size_t)b * TCX + s) * 1024 : p.x + ((size_t)b * TL + t) * 1024;
#pragma unroll
      for (int k = 0; k < 4; ++k) {
        float4 v = *(const float4*)(src + k * 256 + lane * 4);
        hv[k * 4] = v.x; hv[k * 4 + 1] = v.y; hv[k * 4 + 2] = v.z; hv[k * 4 + 3] = v.w;
      }
    } else {
      int orow = lb * TS + (isctx ? s : TCX + lat_map(l - 1, t));
      const float* op = o + (size_t)orow * 1024;
      float ov[16], ss = 0.f;
#pragma unroll
      for (int k = 0; k < 4; ++k) {
        float4 v = *(const float4*)(op + k * 256 + lane * 4);
        ov[k * 4] = v.x; ov[k * 4 + 1] = v.y; ov[k * 4 + 2] = v.z; ov[k * 4 + 3] = v.w;
        ss += v.x * v.x + v.y * v.y + v.z * v.z + v.w * v.w;
      }
#pragma unroll
      for (int off = 32; off; off >>= 1) ss += __shfl_xor(ss, off);
      float rinv = rsqrtf(ss * (1.f / 1024.f) + EPS);
      const float* gate = mod + ((size_t)(l - 1) * 9 + mi) * 3072 + 2048;
      const float* wp = p.norm_post + (l - 1) * 1024;
#pragma unroll
      for (int k = 0; k < 4; ++k) {
        float4 hh = *(const float4*)(hp + k * 256 + lane * 4);
        float4 gg = *(const float4*)(gate + k * 256 + lane * 4);
        float4 ww = *(const float4*)(wp + k * 256 + lane * 4);
        hv[k * 4] = hh.x + gg.x * (ov[k * 4] * rinv * ww.x);
        hv[k * 4 + 1] = hh.y + gg.y * (ov[k * 4 + 1] * rinv * ww.y);
        hv[k * 4 + 2] = hh.z + gg.z * (ov[k * 4 + 2] * rinv * ww.z);
        hv[k * 4 + 3] = hh.w + gg.w * (ov[k * 4 + 3] * rinv * ww.w);
      }
    }
#pragma unroll
    for (int k = 0; k < 4; ++k)
      *(float4*)(hp + k * 256 + lane * 4) = make_float4(hv[k * 4], hv[k * 4 + 1], hv[k * 4 + 2], hv[k * 4 + 3]);
    if (l < DEPTH) {
      float ss = 0.f;
#pragma unroll
      for (int k = 0; k < 16; ++k) ss += hv[k] * hv[k];
#pragma unroll
      for (int off = 32; off; off >>= 1) ss += __shfl_xor(ss, off);
      float rinv = rsqrtf(ss * (1.f / 1024.f) + EPS);
      const float* sh = mod + ((size_t)l * 9 + mi) * 3072;
      const float* wp = p.norm_pre + l * 1024;
      int urow = lb * TS + (isctx ? s : TCX + lat_map(l, t));
      u16* up = u + (size_t)urow * 1024;
#pragma unroll
      for (int k = 0; k < 4; ++k) {
        float4 ww = *(const float4*)(wp + k * 256 + lane * 4);
        float4 s0 = *(const float4*)(sh + k * 256 + lane * 4);
        float4 s1 = *(const float4*)(sh + 1024 + k * 256 + lane * 4);
        float a0 = hv[k * 4] * rinv * ww.x * (1.f + s1.x) + s0.x;
        float a1 = hv[k * 4 + 1] * rinv * ww.y * (1.f + s1.y) + s0.y;
        float a2 = hv[k * 4 + 2] * rinv * ww.z * (1.f + s1.z) + s0.z;
        float a3 = hv[k * 4 + 3] * rinv * ww.w * (1.f + s1.w) + s0.w;
        uint2 pk; pk.x = pk2(a0, a1); pk.y = pk2(a2, a3);
        *(uint2*)(up + k * 256 + lane * 4) = pk;
      }
    }
  }
}

template <int MODE>
DEV void gemm_tile(const u16* __restrict__ A, int lda, const u16* __restrict__ Bt, int K, int rt, int ct, u16* z,
                   u16* zT, float* ab, float* o, char* smem) {
  u16* As = (u16*)smem;
  u16* Bs = As + 128 * 72;
  const int tid = opq(threadIdx.x), lane = tid & 63, w = tid >> 6, wr = w >> 1, wc = w & 1, fr = lane & 15, fq = lane >> 4;
  const int lrow = tid >> 3, lseg = tid & 7;
  const u16* Ag = A + (size_t)(rt * 128 + lrow) * lda + lseg * 8;
  const u16* Bg = Bt + (size_t)(ct * 128 + lrow) * K + lseg * 8;
  uint4 ra0, ra1, ra2, ra3, rb0, rb1, rb2, rb3;
  f32x4 acc[4][4];
#pragma unroll
  for (int i = 0; i < 4; ++i)
#pragma unroll
    for (int j = 0; j < 4; ++j) acc[i][j] = (f32x4){0.f, 0.f, 0.f, 0.f};
#define GLOAD()                                             \
  ra0 = *(const uint4*)(Ag);                                \
  ra1 = *(const uint4*)(Ag + (size_t)32 * lda);             \
  ra2 = *(const uint4*)(Ag + (size_t)64 * lda);             \
  ra3 = *(const uint4*)(Ag + (size_t)96 * lda);             \
  rb0 = *(const uint4*)(Bg);                                \
  rb1 = *(const uint4*)(Bg + (size_t)32 * K);               \
  rb2 = *(const uint4*)(Bg + (size_t)64 * K);               \
  rb3 = *(const uint4*)(Bg + (size_t)96 * K);
  GLOAD();
  const int nk = K / 64;
  for (int kt = 0; kt < nk; ++kt) {
    __syncthreads();
    *(uint4*)(As + (lrow)*72 + lseg * 8) = ra0;
    *(uint4*)(As + (lrow + 32) * 72 + lseg * 8) = ra1;
    *(uint4*)(As + (lrow + 64) * 72 + lseg * 8) = ra2;
    *(uint4*)(As + (lrow + 96) * 72 + lseg * 8) = ra3;
    *(uint4*)(Bs + (lrow)*72 + lseg * 8) = rb0;
    *(uint4*)(Bs + (lrow + 32) * 72 + lseg * 8) = rb1;
    *(uint4*)(Bs + (lrow + 64) * 72 + lseg * 8) = rb2;
    *(uint4*)(Bs + (lrow + 96) * 72 + lseg * 8) = rb3;
    __syncthreads();
    if (kt + 1 < nk) {
      Ag += 64; Bg += 64;
      GLOAD();
    }
#pragma unroll
    for (int ks = 0; ks < 2; ++ks) {
      bf16x8 af[4], bfr[4];
#pragma unroll
      for (int mi = 0; mi < 4; ++mi) af[mi] = ld8(As + (wr * 64 + mi * 16 + fr) * 72 + ks * 32 + fq * 8);
#pragma unroll
      for (int ni = 0; ni < 4; ++ni) bfr[ni] = ld8(Bs + (wc * 64 + ni * 16 + fr) * 72 + ks * 32 + fq * 8);
#pragma unroll
      for (int mi = 0; mi < 4; ++mi)
#pragma unroll
        for (int ni = 0; ni < 4; ++ni) acc[mi][ni] = mfma(af[mi], bfr[ni], acc[mi][ni]);
    }
  }
#pragma unroll
  for (int mi = 0; mi < 4; ++mi)
#pragma unroll
    for (int ni = 0; ni < 4; ++ni) {
      int row0 = rt * 128 + wr * 64 + mi * 16 + fq * 4;
      int col = ct * 128 + wc * 64 + ni * 16 + fr;
      f32x4 v = acc[mi][ni];
      if (MODE == 1) {
#pragma unroll
        for (int r = 0; r < 4; ++r) o[(size_t)(row0 + r) * 1024 + col] = v[r];
      } else {
        if (ct >= 28 && ct < 32) {
          uint2 pk; pk.x = pk2(v[0], v[1]); pk.y = pk2(v[2], v[3]);
          *(uint2*)(zT + (size_t)(col - C_IC) * GR + row0) = pk;
        } else if (ct == 44) {
          if (col - C_AB < 16) {
#pragma unroll
            for (int r = 0; r < 4; ++r) ab[(size_t)(row0 + r) * 16 + (col - C_AB)] = v[r];
          }
        } else {
#pragma unroll
          for (int r = 0; r < 4; ++r) z[(size_t)(row0 + r) * NZ + col] = f2bf(v[r]);
        }
      }
    }
}

DEV void a_item(const P& p, int l, int item, int mode, char* smem) {
  float* xc = (float*)smem;
  u16* xcb = (u16*)(smem + 16384);
  float* av = (float*)(smem + 16384 + 9216);
  float* uv = av + 4096;
  float* segP = uv + 4096;
  float* segH = segP + 256;
  const int tid = opq(threadIdx.x), lane = tid & 63, w = tid >> 6, fr = lane & 15, fq = lane >> 4;
  const int cgk = item >> 3, hA = item & 7, n = cgk % 36, rb = cgk * 64;
  u16* z = (u16*)(p.ws + O_Z);
  for (int idx = tid; idx < 4096; idx += 256) {
    int c = idx >> 6, j = idx & 63, ch = hA * 64 + j;
    float val = p.conv_a_b[l * 512 + ch];
#pragma unroll
    for (int tap = 0; tap < 4; ++tap) val += p.conv_a_w[(l * 4 + tap) * 512 + ch] * zval(z, rb, c + tap - 2, n, C_XA + ch);
    xc[idx] = val;
    xcb[c * 72 + j] = f2bf(val);
  }
  __syncthreads();
  float yacc[16];
#pragma unroll
  for (int k = 0; k < 16; ++k) yacc[k] = 0.f;
  const int seg = tid >> 6, sj = tid & 63, sch = hA * 64 + sj;
  for (int dir = 0; dir < 2; ++dir) {
    {
      const u16* wg = (const u16*)(p.ws + O_WGT);
      const u16* wr_ = wg + (size_t)((((l * 2 + dir) * 2 + 0) * 8 + hA)) * 4096;
      const u16* wi_ = wg + (size_t)((((l * 2 + dir) * 2 + 1) * 8 + hA)) * 4096;
      bf16x8 a0 = ld8(xcb + (16 * w + fr) * 72 + fq * 8), a1 = ld8(xcb + (16 * w + fr) * 72 + 32 + fq * 8);
#pragma unroll
      for (int nt = 0; nt < 4; ++nt) {
        f32x4 ar = {0.f, 0.f, 0.f, 0.f}, ai = {0.f, 0.f, 0.f, 0.f};
        const u16* br = wr_ + (nt * 16 + fr) * 64 + fq * 8;
        const u16* bi = wi_ + (nt * 16 + fr) * 64 + fq * 8;
        ar = mfma(a0, ld8(br), ar); ar = mfma(a1, ld8(br + 32), ar);
        ai = mfma(a0, ld8(bi), ai); ai = mfma(a1, ld8(bi + 32), ai);
        int j = nt * 16 + fr, ch = hA * 64 + j;
        float brv = p.rg_b_r[(l * 2 + dir) * 512 + ch], biv = p.rg_b_i[(l * 2 + dir) * 512 + ch];
        float sp = softplus(-p.rg_lam[(l * 2 + dir) * 512 + ch]);
#pragma unroll
        for (int r = 0; r < 4; ++r) {
          int c = 16 * w + 4 * fq + r;
          float rg = sigm(ar[r] + brv), ig = sigm(ai[r] + biv);
          float la = -8.f * rg * sp;
          float a = __expf(la);
          float uu = sqrtf(fmaxf(-expm1f(2.f * la), 0.f)) * (ig * xc[c * 64 + j]);
          av[c * 64 + j] = a;
          uv[c * 64 + j] = uu;
        }
      }
    }
    __syncthreads();
    {
      float Pp = 1.f, H = 0.f;
#pragma unroll
      for (int k = 0; k < 16; ++k) {
        int c = dir ? (16 * seg + 15 - k) : (16 * seg + k);
        float a = av[c * 64 + sj];
        H = a * H + uv[c * 64 + sj];
        Pp *= a;
      }
      segP[seg * 64 + sj] = Pp;
      segH[seg * 64 + sj] = H;
    }
    __syncthreads();
    if (mode == 0) {
      if (seg == 0) {
        float Pc = 1.f, Hc = 0.f;
        for (int q = 0; q < 4; ++q) {
          int sg = dir ? 3 - q : q;
          Hc = segP[sg * 64 + sj] * Hc + segH[sg * 64 + sj];
          Pc *= segP[sg * 64 + sj];
        }
        size_t idx = ((size_t)cgk * 2 + dir) * 512 + sch;
        ((float*)(p.ws + O_AP))[idx] = Pc;
        ((float*)(p.ws + O_AH))[idx] = Hc;
      }
    } else {
      float st = ((const float*)(p.ws + O_ACAR))[((size_t)cgk * 2 + dir) * 512 + sch];
      int nbefore = dir ? 3 - seg : seg;
      for (int q = 0; q < nbefore; ++q) {
        int sg = dir ? 3 - q : q;
        st = segP[sg * 64 + sj] * st + segH[sg * 64 + sj];
      }
      if (dir == 0) {
#pragma unroll
        for (int k = 0; k < 16; ++k) {
          int c = 16 * seg + k;
          st = av[c * 64 + sj] * st + uv[c * 64 + sj];
          yacc[k] += st;
        }
      } else {
#pragma unroll
        for (int k = 15; k >= 0; --k) {
          int c = 16 * seg + k;
          st = av[c * 64 + sj] * st + uv[c * 64 + sj];
          yacc[k] += st;
        }
      }
    }
    __syncthreads();
  }
  if (mode == 1) {
#pragma unroll
    for (int k = 0; k < 16; ++k) {
      size_t zi = (size_t)(rb + 16 * seg + k) * NZ + C_GA + sch;
      float gate = bf2f(z[zi]);
      z[zi] = f2bf(yacc[k] * silu(gate));
    }
  }
}

DEV void a_carry(const P& p, int item) {
  int t = item * 256 + threadIdx.x;
  int ch = t & 511, dir = (t >> 9) & 1, lb = t >> 10;
  const float* AP = (const float*)(p.ws + O_AP);
  const float* AH = (const float*)(p.ws + O_AH);
  float* AC = (float*)(p.ws + O_ACAR);
  float st = 0.f;
  for (int j = 0; j < 36; ++j) {
    int n = dir ? (j < 4 ? 3 - j : 39 - j) : j;
    size_t idx = ((size_t)(lb * 36 + n) * 2 + dir) * 512 + ch;
    AC[idx] = st;
    st = AP[idx] * st + AH[idx];
  }
}

DEV void b_local(const P& p, int l, int item, char* smem) {
  u16* qs = (u16*)smem;
  u16* ks = qs + 64 * 136;
  float* Am = (float*)(smem + 34816);
  float* gc = (float*)(smem + 34816 + 32768);
  float* bt = gc + 128;
  const int tid = opq(threadIdx.x), lane = tid & 63, w = tid >> 6, fr = lane & 15, fq = lane >> 4;
  const int cgk = item >> 2, h = item & 3, n = cgk % 36, rb = cgk * 64;
  const u16* z = (const u16*)(p.ws + O_Z);
  u16* qn = (u16*)(p.ws + O_BSH);
  u16* kn = qn + (size_t)GR * 512;
  u16* vb = kn + (size_t)GR * 512;
  u16* knT = vb + (size_t)GR * 512;
  const float* ab = (const float*)(p.ws + O_AB);
  for (int c = w; c < 64; c += 4) {
    float qv[2], kv[2], vv[2];
#pragma unroll
    for (int hh = 0; hh < 2; ++hh) {
      int d = lane + 64 * hh, chn = h * 128 + d;
      float a0 = 0.f, a1 = 0.f, a2 = 0.f;
#pragma unroll
      for (int tap = 0; tap < 4; ++tap) {
        const float* cw = p.conv_b_w + (size_t)(l * 4 + tap) * 1536;
        a0 += cw[chn] * zval(z, rb, c + tap - 2, n, C_Q + chn);
        a1 += cw[512 + chn] * zval(z, rb, c + tap - 2, n, C_K + chn);
        a2 += cw[1024 + chn] * zval(z, rb, c + tap - 2, n, C_V + chn);
      }
      qv[hh] = silu(a0); kv[hh] = silu(a1); vv[hh] = silu(a2);
    }
    float sq = qv[0] * qv[0] + qv[1] * qv[1], sk = kv[0] * kv[0] + kv[1] * kv[1];
#pragma unroll
    for (int off = 32; off; off >>= 1) { sq += __shfl_xor(sq, off); sk += __shfl_xor(sk, off); }
    float rq = rsqrtf(sq + EPS) * 0.08838834764831845f, rk = rsqrtf(sk + EPS);
#pragma unroll
    for (int hh = 0; hh < 2; ++hh) {
      int d = lane + 64 * hh;
      u16 qb = f2bf(qv[hh] * rq), kb = f2bf(kv[hh] * rk);
      qs[c * 136 + d] = qb; ks[c * 136 + d] = kb;
      size_t gi = (size_t)(rb + c) * 512 + h * 128 + d;
      qn[gi] = qb; kn[gi] = kb; vb[gi] = f2bf(vv[hh]);
    }
  }
  if (w < 2) {
    int dir = w, i = lane, c = dir ? 63 - i : i;
    float al = ab[(size_t)(rb + c) * 16 + dir * 4 + h], bl = ab[(size_t)(rb + c) * 16 + 8 + dir * 4 + h];
    float g = -__expf(p.gdn_a_log[(l * 2 + dir) * 4 + h]) * softplus(al + p.gdn_dt_bias[(l * 2 + dir) * 4 + h]);
#pragma unroll
    for (int off = 1; off < 64; off <<= 1) {
      float v = __shfl_up(g, off);
      if (lane >= off) g += v;
    }
    gc[dir * 64 + i] = g;
    bt[dir * 64 + i] = sigm(bl);
  }
  __syncthreads();
  for (int idx = tid; idx < 1024; idx += 256) {
    int d = idx >> 3, c8 = idx & 7;
    uint4 pk;
    pk.x = (unsigned)ks[(c8 * 8 + 0) * 136 + d] | ((unsigned)ks[(c8 * 8 + 1) * 136 + d] << 16);
    pk.y = (unsigned)ks[(c8 * 8 + 2) * 136 + d] | ((unsigned)ks[(c8 * 8 + 3) * 136 + d] << 16);
    pk.z = (unsigned)ks[(c8 * 8 + 4) * 136 + d] | ((unsigned)ks[(c8 * 8 + 5) * 136 + d] << 16);
    pk.w = (unsigned)ks[(c8 * 8 + 6) * 136 + d] | ((unsigned)ks[(c8 * 8 + 7) * 136 + d] << 16);
    *(uint4*)(knT + ((size_t)(cgk * 4 + h) * 128 + d) * 64 + c8 * 8) = pk;
  }
  for (int dir = 0; dir < 2; ++dir) {
    char* rec = p.ws + O_BIT + ((size_t)(cgk * 4 + h) * 2 + dir) * BIT_SZ;
    u16* QKm = (u16*)rec + 4096;
    float* scal = (float*)(rec + 16384);
    int irow = 16 * w + fr, ci = dir ? 63 - irow : irow;
    bf16x8 ak[4], aq[4];
#pragma unroll
    for (int s = 0; s < 4; ++s) { ak[s] = ld8(ks + ci * 136 + 32 * s + 8 * fq); aq[s] = ld8(qs + ci * 136 + 32 * s + 8 * fq); }
#pragma unroll
    for (int nt = 0; nt < 4; ++nt) {
      int jcol = 16 * nt + fr, cj = dir ? 63 - jcol : jcol;
      f32x4 kk = {0.f, 0.f, 0.f, 0.f}, qk = {0.f, 0.f, 0.f, 0.f};
#pragma unroll
      for (int s = 0; s < 4; ++s) {
        bf16x8 b = ld8(ks + cj * 136 + 32 * s + 8 * fq);
        kk = mfma(ak[s], b, kk);
        qk = mfma(aq[s], b, qk);
      }
      float gj = gc[dir * 64 + jcol];
#pragma unroll
      for (int r = 0; r < 4; ++r) {
        int i = 16 * w + 4 * fq + r;
        float dec = (jcol <= i) ? __expf(gc[dir * 64 + i] - gj) : 0.f;
        Am[(dir * 64 + i) * 64 + jcol] = (jcol < i) ? bt[dir * 64 + i] * kk[r] * dec : 0.f;
        QKm[i * 64 + jcol] = f2bf(qk[r] * dec);
      }
    }
    if (tid < 64) {
      float gl = gc[dir * 64 + 63], gi = gc[dir * 64 + tid];
      scal[tid] = __expf(gi);
      scal[64 + tid] = bt[dir * 64 + tid];
      scal[128 + tid] = __expf(gl - gi);
      if (tid == 0) scal[192] = __expf(gl);
    }
  }
  __syncthreads();
  if (w < 2) {
    int dir = w, col = lane;
    u16* Tinv = (u16*)(p.ws + O_BIT + ((size_t)(cgk * 4 + h) * 2 + dir) * BIT_SZ);
    const float* Ad = Am + dir * 4096;
    float T[64];
#pragma unroll
    for (int i = 0; i < 64; ++i) {
      float s = (i == col) ? 1.f : 0.f;
#pragma unroll
      for (int j = 0; j < i; ++j) s -= Ad[i * 64 + j] * T[j];
      T[i] = s;
      Tinv[i * 64 + col] = f2bf(s);
      __builtin_amdgcn_sched_barrier(0);
    }
  }
  __syncthreads();
}

DEV void b_seq(const P& p, int bitem, char* smem) {
  const int tid = opq(threadIdx.x), lane = tid & 63, w = tid >> 6, fr = lane & 15, fq = lane >> 4;
  const bool active = w < WPB;
  const int item = bitem * WPB + (active ? w : 0);
  const int slice = item & 7, dir = (item >> 3) & 1, h = (item >> 4) & 3, lb = item >> 6, e0 = slice * 16;
  u16* Ss = (u16*)(smem + w * 11264);
  u16* Rs = Ss + 16 * 136;
  u16* Vsc = Rs + 16 * 72;
  u16* Vor = Vsc + 16 * 72;
  const u16* qn = (const u16*)(p.ws + O_BSH);
  const u16* kn = qn + (size_t)GR * 512;
  const u16* vb = kn + (size_t)GR * 512;
  const u16* knT = vb + (size_t)GR * 512;
  u16* OB = (u16*)(p.ws + O_OB);
  f32x4 S[8];
#pragma unroll
  for (int m = 0; m < 8; ++m) S[m] = (f32x4){0.f, 0.f, 0.f, 0.f};
  for (int j = 0; j < 36; ++j) {
    const int n = dir ? (j < 4 ? 3 - j : 39 - j) : j;
    const int cgk = lb * 36 + n, rb = cgk * 64;
    const char* rec = p.ws + O_BIT + ((size_t)(cgk * 4 + h) * 2 + dir) * BIT_SZ;
    const u16* Tinv = (const u16*)rec;
    const u16* QKm = Tinv + 4096;
    const float* scal = (const float*)(rec + 16384);
    if (active) {
#pragma unroll
      for (int m = 0; m < 8; ++m) {
        uint2 pk; pk.x = pk2(S[m][0], S[m][1]); pk.y = pk2(S[m][2], S[m][3]);
        *(uint2*)(Ss + fr * 136 + 16 * m + 4 * fq) = pk;
      }
    }
    __syncthreads();
    bf16x8 Sf[4];
    if (active) {
#pragma unroll
      for (int s = 0; s < 4; ++s) Sf[s] = ld8(Ss + fr * 136 + 32 * s + 8 * fq);
#pragma unroll
      for (int m = 0; m < 4; ++m) {
        int i = 16 * m + fr, rowi = rb + (dir ? 63 - i : i);
        f32x4 X = {0.f, 0.f, 0.f, 0.f};
#pragma unroll
        for (int s = 0; s < 4; ++s) X = mfma(ld8(kn + (size_t)rowi * 512 + h * 128 + 32 * s + 8 * fq), Sf[s], X);
        float rv[4];
#pragma unroll
        for (int r = 0; r < 4; ++r) {
          int ii = 16 * m + 4 * fq + r, rowr = rb + (dir ? 63 - ii : ii);
          float v = bf2f(vb[(size_t)rowr * 512 + h * 128 + e0 + fr]);
          rv[r] = scal[64 + ii] * (v - scal[ii] * X[r]);
        }
        uint2 pk; pk.x = pk2(rv[0], rv[1]); pk.y = pk2(rv[2], rv[3]);
        *(uint2*)(Rs + fr * 72 + 16 * m + 4 * fq) = pk;
      }
    }
    __syncthreads();
    if (active) {
      bf16x8 Rf0 = ld8(Rs + fr * 72 + 8 * fq), Rf1 = ld8(Rs + fr * 72 + 32 + 8 * fq);
#pragma unroll
      for (int m = 0; m < 4; ++m) {
        f32x4 VN = {0.f, 0.f, 0.f, 0.f};
        VN = mfma(ld8(Tinv + (16 * m + fr) * 64 + 8 * fq), Rf0, VN);
        VN = mfma(ld8(Tinv + (16 * m + fr) * 64 + 32 + 8 * fq), Rf1, VN);
        uint2 pk; pk.x = pk2(VN[0], VN[1]); pk.y = pk2(VN[2], VN[3]);
        *(uint2*)(Vsc + fr * 72 + 16 * m + 4 * fq) = pk;
        int ib = 16 * m + 4 * fq;
        float s0 = VN[0] * scal[128 + ib], s1 = VN[1] * scal[128 + ib + 1], s2 = VN[2] * scal[128 + ib + 2],
              s3 = VN[3] * scal[128 + ib + 3];
        if (dir) {
          pk.x = pk2(s3, s2); pk.y = pk2(s1, s0);
          *(uint2*)(Vor + fr * 72 + (60 - ib)) = pk;
        } else {
          pk.x = pk2(s0, s1); pk.y = pk2(s2, s3);
          *(uint2*)(Vor + fr * 72 + ib) = pk;
        }
      }
    }
    __syncthreads();
    if (active) {
      bf16x8 Vs0 = ld8(Vsc + fr * 72 + 8 * fq), Vs1 = ld8(Vsc + fr * 72 + 32 + 8 * fq);
      bf16x8 Vo0 = ld8(Vor + fr * 72 + 8 * fq), Vo1 = ld8(Vor + fr * 72 + 32 + 8 * fq);
#pragma unroll
      for (int m = 0; m < 4; ++m) {
        int i = 16 * m + fr, rowi = rb + (dir ? 63 - i : i);
        f32x4 O = {0.f, 0.f, 0.f, 0.f};
#pragma unroll
        for (int s = 0; s < 4; ++s) O = mfma(ld8(qn + (size_t)rowi * 512 + h * 128 + 32 * s + 8 * fq), Sf[s], O);
#pragma unroll
        for (int r = 0; r < 4; ++r) O[r] *= scal[16 * m + 4 * fq + r];
        O = mfma(ld8(QKm + (16 * m + fr) * 64 + 8 * fq), Vs0, O);
        O = mfma(ld8(QKm + (16 * m + fr) * 64 + 32 + 8 * fq), Vs1, O);
#pragma unroll
        for (int r = 0; r < 4; ++r) {
          int ii = 16 * m + 4 * fq + r, rowr = rb + (dir ? 63 - ii : ii);
          OB[((size_t)dir * GR + rowr) * 512 + h * 128 + e0 + fr] = f2bf(O[r]);
        }
      }
      float egl = scal[192];
#pragma unroll
      for (int m = 0; m < 8; ++m) {
        const u16* kt = knT + ((size_t)(cgk * 4 + h) * 128 + 16 * m + fr) * 64;
        f32x4 t = S[m];
#pragma unroll
        for (int r = 0; r < 4; ++r) t[r] *= egl;
        t = mfma(ld8(kt + 8 * fq), Vo0, t);
        t = mfma(ld8(kt + 32 + 8 * fq), Vo1, t);
        S[m] = t;
      }
    }
  }
  __syncthreads();
}

DEV void c_local(const P& p, int l, int item, char* smem) {
  float* bsm = (float*)smem;
  u16* Ps = (u16*)(smem + 33024);
  u16* kdt = (u16*)(smem + 33024 + 9216);
  const int tid = opq(threadIdx.x), lane = tid & 63, w = tid >> 6, fr = lane & 15, fq = lane >> 4;
  const int cgk = item >> 2, h = item & 3, rb = cgk * 64;
  const u16* z = (const u16*)(p.ws + O_Z);
  const u16* zT = (const u16*)(p.ws + O_ZT);
  u16* OC = (u16*)(p.ws + O_OC);
  const float* lbs = (const float*)(p.ws + O_LBS);
  for (int dir = 0; dir < 2; ++dir) {
    char* rec = p.ws + O_CREC + ((size_t)(cgk * 4 + h) * 2 + dir) * CREC_SZ;
    u16* QD = (u16*)rec;
    u16* KDT = QD + 8192;
    float* decv = (float*)(rec + 32768);
    const float* lbp = lbs + l * 1024 + dir * 512 + h * 128;
    const int fcol = C_F0 + dir * 512 + h * 128;
    {
      int d = tid & 127, half = tid >> 7;
      float lb_ = lbp[d], run = 0.f;
      for (int k = 0; k < 32; ++k) {
        int i = 32 * half + k, c = dir ? 63 - i : i;
        float f = bf2f(z[(size_t)(rb + c) * NZ + fcol + d]);
        float fg = lb_ + (1.f - lb_) * sigm(f);
        run += __logf(fg);
        bsm[i * 129 + d] = run;
      }
    }
    __syncthreads();
    {
      int d = tid & 127, half = tid >> 7;
      if (half) {
        float add = bsm[31 * 129 + d];
        for (int k = 0; k < 32; ++k) bsm[(32 + k) * 129 + d] += add;
      }
    }
    __syncthreads();
    for (int idx = tid; idx < 8192; idx += 256) {
      int i = idx >> 7, d = idx & 127, c = dir ? 63 - i : i;
      float b = bsm[i * 129 + d];
      float q = silu(bf2f(z[(size_t)(rb + c) * NZ + C_QC + h * 128 + d]));
      QD[i * 128 + d] = f2bf(q * __expf(b));
      float f = bf2f(z[(size_t)(rb + c) * NZ + fcol + d]);
      float k = (1.f - lbp[d]) * sigm(-f);
      kdt[d * 72 + c] = f2bf(k * __expf(bsm[63 * 129 + d] - b));
    }
    if (tid < 128) decv[tid] = __expf(bsm[63 * 129 + tid]);
    __syncthreads();
    for (int idx = tid; idx < 1024; idx += 256) {
      int d = idx >> 3, c8 = idx & 7;
      *(uint4*)(KDT + d * 64 + c8 * 8) = *(const uint4*)(kdt + d * 72 + c8 * 8);
    }
    {
      const int sj = w;
      for (int si = 0; si < 4; ++si) {
        f32x4 acc = {0.f, 0.f, 0.f, 0.f};
        if (si >= sj) {
          int it = 16 * si + fr, jt = 16 * sj + fr;
          int ci = dir ? 63 - it : it, cj = dir ? 63 - jt : jt;
#pragma unroll
          for (int s = 0; s < 4; ++s) {
            int d0 = 32 * s + 8 * fq;
            bf16x8 qv = ld8(z + (size_t)(rb + ci) * NZ + C_QC + h * 128 + d0);
            bf16x8 fv = ld8(z + (size_t)(rb + cj) * NZ + fcol + d0);
            bf16x8 af, bf;
#pragma unroll
            for (int e = 0; e < 8; ++e) {
              int d = d0 + e;
              float Bs_ = si ? bsm[(16 * si - 1) * 129 + d] : 0.f;
              float qq = silu(bf2f((u16)qv[e])) * __expf(bsm[it * 129 + d] - Bs_);
              float kk = (1.f - lbp[d]) * sigm(-bf2f((u16)fv[e])) * __expf(Bs_ - bsm[jt * 129 + d]);
              af[e] = (short)f2bf(qq);
              bf[e] = (short)f2bf(kk);
            }
            acc = mfma(af, bf, acc);
          }
        }
#pragma unroll
        for (int r = 0; r < 4; ++r) {
          int i = 16 * si + 4 * fq + r, jj = 16 * sj + fr;
          float v = (si >= sj && jj <= i) ? acc[r] : 0.f;
          Ps[i * 72 + (dir ? 63 - jj : jj)] = f2bf(v);
        }
      }
    }
    __syncthreads();
#pragma unroll
    for (int nt2 = 0; nt2 < 2; ++nt2) {
      int e = h * 128 + (2 * w + nt2) * 16 + fr;
      bf16x8 v0 = ld8(zT + (size_t)e * GR + rb + 8 * fq), v1 = ld8(zT + (size_t)e * GR + rb + 32 + 8 * fq);
#pragma unroll
      for (int m = 0; m < 4; ++m) {
        f32x4 O = {0.f, 0.f, 0.f, 0.f};
        O = mfma(ld8(Ps + (16 * m + fr) * 72 + 8 * fq), v0, O);
        O = mfma(ld8(Ps + (16 * m + fr) * 72 + 32 + 8 * fq), v1, O);
#pragma unroll
        for (int r = 0; r < 4; ++r) {
          int ii = 16 * m + 4 * fq + r, rowr = rb + (dir ? 63 - ii : ii);
          OC[((size_t)dir * GR + rowr) * 512 + e] = f2bf(O[r]);
        }
      }
    }
    __syncthreads();
  }
}

DEV void c_seq(const P& p, int bitem, char* smem) {
  const int tid = opq(threadIdx.x), lane = tid & 63, w = tid >> 6, fr = lane & 15, fq = lane >> 4;
  const bool active = w < WPB;
  const int item = bitem * WPB + (active ? w : 0);
  const int slice = item & 7, dir = (item >> 3) & 1, h = (item >> 4) & 3, lb = item >> 6, e0 = slice * 16;
  u16* Ss = (u16*)(smem + w * 4352);
  const u16* zT = (const u16*)(p.ws + O_ZT);
  u16* OC = (u16*)(p.ws + O_OC);
  f32x4 S[8];
#pragma unroll
  for (int m = 0; m < 8; ++m) S[m] = (f32x4){0.f, 0.f, 0.f, 0.f};
  for (int j = 0; j < 36; ++j) {
    const int n = dir ? (j < 4 ? 3 - j : 39 - j) : j;
    const int cgk = lb * 36 + n, rb = cgk * 64;
    const char* rec = p.ws + O_CREC + ((size_t)(cgk * 4 + h) * 2 + dir) * CREC_SZ;
    const u16* QD = (const u16*)rec;
    const u16* KDT = QD + 8192;
    const float* decv = (const float*)(rec + 32768);
    if (active) {
#pragma unroll
      for (int m = 0; m < 8; ++m) {
        uint2 pk; pk.x = pk2(S[m][0], S[m][1]); pk.y = pk2(S[m][2], S[m][3]);
        *(uint2*)(Ss + fr * 136 + 16 * m + 4 * fq) = pk;
      }
    }
    __syncthreads();
    if (active) {
      bf16x8 Sf[4];
#pragma unroll
      for (int s = 0; s < 4; ++s) Sf[s] = ld8(Ss + fr * 136 + 32 * s + 8 * fq);
#pragma unroll
      for (int m = 0; m < 4; ++m) {
        f32x4 O = {0.f, 0.f, 0.f, 0.f};
#pragma unroll
        for (int s = 0; s < 4; ++s) O = mfma(ld8(QD + (16 * m + fr) * 128 + 32 * s + 8 * fq), Sf[s], O);
#pragma unroll
        for (int r = 0; r < 4; ++r) {
          int ii = 16 * m + 4 * fq + r, rowr = rb + (dir ? 63 - ii : ii);
          size_t oi = ((size_t)dir * GR + rowr) * 512 + h * 128 + e0 + fr;
          OC[oi] = f2bf(bf2f(OC[oi]) + O[r]);
        }
      }
      const u16* vp = zT + (size_t)(h * 128 + e0 + fr) * GR + rb;
      bf16x8 V0 = ld8(vp + 8 * fq), V1 = ld8(vp + 32 + 8 * fq);
#pragma unroll
      for (int m = 0; m < 8; ++m) {
        f32x4 t = S[m];
#pragma unroll
        for (int r = 0; r < 4; ++r) t[r] *= decv[16 * m + 4 * fq + r];
        t = mfma(ld8(KDT + (16 * m + fr) * 64 + 8 * fq), V0, t);
        t = mfma(ld8(KDT + (16 * m + fr) * 64 + 32 + 8 * fq), V1, t);
        S[m] = t;
      }
    }
    __syncthreads();
  }
}

#define LBAR()                                              \
  do {                                                      \
    asm volatile("s_waitcnt lgkmcnt(0)" ::: "memory");      \
    __builtin_amdgcn_s_barrier();                           \
    asm volatile("" ::: "memory");                          \
  } while (0)
#define CBAR() asm volatile("" ::: "memory")

DEV void b_seq2(const P& p, int bitem, char* smem) {
  const int tid = opq(threadIdx.x), lane = tid & 63, w = tid >> 6, fr = lane & 15, fq = lane >> 4;
  const int es = bitem & 3, dir = (bitem >> 2) & 1, h = (bitem >> 3) & 3, lb = bitem >> 5, e0 = es * 32;
  u16* Ss = (u16*)smem;
  u16* Rs = Ss + 32 * 136;
  u16* Vsc = Rs + 32 * 72;
  u16* Vor = Vsc + 32 * 72;
  const u16* qn = (const u16*)(p.ws + O_BSH);
  const u16* kn = qn + (size_t)GR * 512;
  const u16* vb = kn + (size_t)GR * 512;
  const u16* knT = vb + (size_t)GR * 512;
  u16* OB = (u16*)(p.ws + O_OB);
  const int mrow = 16 * w + fr, crow0 = 16 * w + 4 * fq;
  f32x4 S[2][2];
#pragma unroll
  for (int a = 0; a < 2; ++a)
#pragma unroll
    for (int b = 0; b < 2; ++b) S[a][b] = (f32x4){0.f, 0.f, 0.f, 0.f};
  bf16x8 Akn[4], Aqn[4], At[2], Aqk[2], AkT[2][2];
  u16 vbv[2][4];
  float4 eg4, be4, ek4;
  float egl;
#define BS_CHUNK(jj) (dir ? ((jj) < 4 ? 3 - (jj) : 39 - (jj)) : (jj))
#define BS_LOAD1(jj)                                                                         \
  {                                                                                          \
    const int cg_ = lb * 36 + BS_CHUNK(jj), rb_ = cg_ * 64;                                  \
    const size_t ra_ = (size_t)(rb_ + (dir ? 63 - mrow : mrow)) * 512 + h * 128 + 8 * fq;    \
    _Pragma("unroll") for (int s = 0; s < 4; ++s) {                                          \
      Akn[s] = ld8(kn + ra_ + 32 * s);                                                       \
      Aqn[s] = ld8(qn + ra_ + 32 * s);                                                       \
    }                                                                                        \
    _Pragma("unroll") for (int r = 0; r < 4; ++r) {                                          \
      const size_t rr_ = (size_t)(rb_ + (dir ? 63 - (crow0 + r) : (crow0 + r))) * 512 + h * 128 + e0 + fr; \
      vbv[0][r] = vb[rr_];                                                                   \
      vbv[1][r] = vb[rr_ + 16];                                                              \
    }                                                                                        \
    const float* sc_ = (const float*)(p.ws + O_BIT + ((size_t)(cg_ * 4 + h) * 2 + dir) * BIT_SZ + 16384); \
    eg4 = *(const float4*)(sc_ + crow0);                                                     \
    be4 = *(const float4*)(sc_ + 64 + crow0);                                                \
  }
#define BS_LOAD2(jj)                                                                         \
  {                                                                                          \
    const int cg_ = lb * 36 + BS_CHUNK(jj);                                                  \
    const char* rec_ = p.ws + O_BIT + ((size_t)(cg_ * 4 + h) * 2 + dir) * BIT_SZ;            \
    const u16* T_ = (const u16*)rec_ + mrow * 64 + 8 * fq;                                   \
    At[0] = ld8(T_); At[1] = ld8(T_ + 32);                                                   \
    ek4 = *(const float4*)((const float*)(rec_ + 16384) + 128 + crow0);                      \
  }
#define BS_LOAD3(jj)                                                                         \
  {                                                                                          \
    const int cg_ = lb * 36 + BS_CHUNK(jj);                                                  \
    const char* rec_ = p.ws + O_BIT + ((size_t)(cg_ * 4 + h) * 2 + dir) * BIT_SZ;            \
    const u16* Q_ = (const u16*)rec_ + 4096 + mrow * 64 + 8 * fq;                            \
    Aqk[0] = ld8(Q_); Aqk[1] = ld8(Q_ + 32);                                                 \
    egl = ((const float*)(rec_ + 16384))[192];                                               \
    _Pragma("unroll") for (int mm = 0; mm < 2; ++mm) {                                       \
      const u16* k_ = knT + ((size_t)(cg_ * 4 + h) * 128 + 32 * w + 16 * mm + fr) * 64 + 8 * fq; \
      AkT[mm][0] = ld8(k_); AkT[mm][1] = ld8(k_ + 32);                                       \
    }                                                                                        \
  }
  BS_LOAD1(0) BS_LOAD2(0) BS_LOAD3(0)
  for (int j = 0; j < 36; ++j) {
    const int cgk = lb * 36 + BS_CHUNK(j), rb = cgk * 64;
    const int jn = (j + 1 < 36) ? j + 1 : j;
#pragma unroll
    for (int mm = 0; mm < 2; ++mm)
#pragma unroll
      for (int nt = 0; nt < 2; ++nt) {
        uint2 pk; pk.x = pk2(S[mm][nt][0], S[mm][nt][1]); pk.y = pk2(S[mm][nt][2], S[mm][nt][3]);
        *(uint2*)(Ss + (16 * nt + fr) * 136 + 32 * w + 16 * mm + 4 * fq) = pk;
      }
    LBAR();
    f32x4 QS[2];
    {
      bf16x8 Sf[2][4];
#pragma unroll
      for (int nt = 0; nt < 2; ++nt)
#pragma unroll
        for (int s = 0; s < 4; ++s) Sf[nt][s] = ld8(Ss + (16 * nt + fr) * 136 + 32 * s + 8 * fq);
#pragma unroll
      for (int nt = 0; nt < 2; ++nt) {
        f32x4 X = {0.f, 0.f, 0.f, 0.f}, Q = {0.f, 0.f, 0.f, 0.f};
#pragma unroll
        for (int s = 0; s < 4; ++s) { X = mfma(Akn[s], Sf[nt][s], X); Q = mfma(Aqn[s], Sf[nt][s], Q); }
        float r0 = be4.x * (bf2f(vbv[nt][0]) - eg4.x * X[0]);
        float r1 = be4.y * (bf2f(vbv[nt][1]) - eg4.y * X[1]);
        float r2 = be4.z * (bf2f(vbv[nt][2]) - eg4.z * X[2]);
        float r3 = be4.w * (bf2f(vbv[nt][3]) - eg4.w * X[3]);
        uint2 pk; pk.x = pk2(r0, r1); pk.y = pk2(r2, r3);
        *(uint2*)(Rs + (16 * nt + fr) * 72 + crow0) = pk;
        Q[0] *= eg4.x; Q[1] *= eg4.y; Q[2] *= eg4.z; Q[3] *= eg4.w;
        QS[nt] = Q;
      }
    }
    CBAR();
    BS_LOAD1(jn)
    LBAR();
    {
#pragma unroll
      for (int nt = 0; nt < 2; ++nt) {
        bf16x8 Rf0 = ld8(Rs + (16 * nt + fr) * 72 + 8 * fq), Rf1 = ld8(Rs + (16 * nt + fr) * 72 + 32 + 8 * fq);
        f32x4 VN = {0.f, 0.f, 0.f, 0.f};
        VN = mfma(At[0], Rf0, VN);
        VN = mfma(At[1], Rf1, VN);
        uint2 pk; pk.x = pk2(VN[0], VN[1]); pk.y = pk2(VN[2], VN[3]);
        *(uint2*)(Vsc + (16 * nt + fr) * 72 + crow0) = pk;
        float s0 = VN[0] * ek4.x, s1 = VN[1] * ek4.y, s2 = VN[2] * ek4.z, s3 = VN[3] * ek4.w;
        if (dir) {
          pk.x = pk2(s3, s2); pk.y = pk2(s1, s0);
          *(uint2*)(Vor + (16 * nt + fr) * 72 + (60 - crow0)) = pk;
        } else {
          pk.x = pk2(s0, s1); pk.y = pk2(s2, s3);
          *(uint2*)(Vor + (16 * nt + fr) * 72 + crow0) = pk;
        }
      }
    }
    CBAR();
    BS_LOAD2(jn)
    LBAR();
    {
#pragma unroll
      for (int nt = 0; nt < 2; ++nt) {
        bf16x8 Vs0 = ld8(Vsc + (16 * nt + fr) * 72 + 8 * fq), Vs1 = ld8(Vsc + (16 * nt + fr) * 72 + 32 + 8 * fq);
        bf16x8 Vo0 = ld8(Vor + (16 * nt + fr) * 72 + 8 * fq), Vo1 = ld8(Vor + (16 * nt + fr) * 72 + 32 + 8 * fq);
        f32x4 O = QS[nt];
        O = mfma(Aqk[0], Vs0, O);
        O = mfma(Aqk[1], Vs1, O);
#pragma unroll
        for (int r = 0; r < 4; ++r) {
          int ii = crow0 + r, rowr = rb + (dir ? 63 - ii : ii);
          OB[((size_t)dir * GR + rowr) * 512 + h * 128 + e0 + 16 * nt + fr] = f2bf(O[r]);
        }
#pragma unroll
        for (int mm = 0; mm < 2; ++mm) {
          f32x4 t = S[mm][nt];
#pragma unroll
          for (int r = 0; r < 4; ++r) t[r] *= egl;
          t = mfma(AkT[mm][0], Vo0, t);
          t = mfma(AkT[mm][1], Vo1, t);
          S[mm][nt] = t;
        }
      }
    }
    CBAR();
    BS_LOAD3(jn)
  }
  LBAR();
}

DEV void c_seq2(const P& p, int bitem, char* smem) {
  const int tid = opq(threadIdx.x), lane = tid & 63, w = tid >> 6, fr = lane & 15, fq = lane >> 4;
  const int es = bitem & 3, dir = (bitem >> 2) & 1, h = (bitem >> 3) & 3, lb = bitem >> 5, e0 = es * 32;
  u16* Ssb = (u16*)smem;
  const u16* zT = (const u16*)(p.ws + O_ZT);
  u16* OC = (u16*)(p.ws + O_OC);
  const int mrow = 16 * w + fr, crow0 = 16 * w + 4 * fq;
  f32x4 S[2][2];
#pragma unroll
  for (int a = 0; a < 2; ++a)
#pragma unroll
    for (int b = 0; b < 2; ++b) S[a][b] = (f32x4){0.f, 0.f, 0.f, 0.f};
  bf16x8 Aqd[4], Akd[2][2], Vf[2][2];
  u16 oi[2][4];
  float4 dec4[2];
#define CS_LOAD(jj)                                                                          \
  {                                                                                          \
    const int cg_ = lb * 36 + BS_CHUNK(jj), rb_ = cg_ * 64;                                  \
    const char* rec_ = p.ws + O_CREC + ((size_t)(cg_ * 4 + h) * 2 + dir) * CREC_SZ;          \
    const u16* QD_ = (const u16*)rec_ + mrow * 128 + 8 * fq;                                 \
    _Pragma("unroll") for (int s = 0; s < 4; ++s) Aqd[s] = ld8(QD_ + 32 * s);                \
    _Pragma("unroll") for (int mm = 0; mm < 2; ++mm) {                                       \
      const u16* K_ = (const u16*)rec_ + 8192 + (32 * w + 16 * mm + fr) * 64 + 8 * fq;       \
      Akd[mm][0] = ld8(K_); Akd[mm][1] = ld8(K_ + 32);                                       \
      dec4[mm] = *(const float4*)((const float*)(rec_ + 32768) + 32 * w + 16 * mm + 4 * fq); \
    }                                                                                        \
    _Pragma("unroll") for (int nt = 0; nt < 2; ++nt) {                                       \
      const u16* v_ = zT + (size_t)(h * 128 + e0 + 16 * nt + fr) * GR + rb_ + 8 * fq;        \
      Vf[nt][0] = ld8(v_); Vf[nt][1] = ld8(v_ + 32);                                         \
      _Pragma("unroll") for (int r = 0; r < 4; ++r) {                                        \
        int ii_ = crow0 + r, rowr_ = rb_ + (dir ? 63 - ii_ : ii_);                           \
        oi[nt][r] = OC[((size_t)dir * GR + rowr_) * 512 + h * 128 + e0 + 16 * nt + fr];      \
      }                                                                                      \
    }                                                                                        \
  }
  CS_LOAD(0)
  for (int j = 0; j < 36; ++j) {
    const int cgk = lb * 36 + BS_CHUNK(j), rb = cgk * 64;
    const int jn = (j + 1 < 36) ? j + 1 : j;
    u16* Ss = Ssb + (j & 1) * (32 * 136);
#pragma unroll
    for (int mm = 0; mm < 2; ++mm)
#pragma unroll
      for (int nt = 0; nt < 2; ++nt) {
        uint2 pk; pk.x = pk2(S[mm][nt][0], S[mm][nt][1]); pk.y = pk2(S[mm][nt][2], S[mm][nt][3]);
        *(uint2*)(Ss + (16 * nt + fr) * 136 + 32 * w + 16 * mm + 4 * fq) = pk;
      }
    LBAR();
#pragma unroll
    for (int nt = 0; nt < 2; ++nt) {
      f32x4 O = {0.f, 0.f, 0.f, 0.f};
#pragma unroll
      for (int s = 0; s < 4; ++s) O = mfma(Aqd[s], ld8(Ss + (16 * nt + fr) * 136 + 32 * s + 8 * fq), O);
#pragma unroll
      for (int r = 0; r < 4; ++r) {
        int ii = crow0 + r, rowr = rb + (dir ? 63 - ii : ii);
        OC[((size_t)dir * GR + rowr) * 512 + h * 128 + e0 + 16 * nt + fr] = f2bf(bf2f(oi[nt][r]) + O[r]);
      }
#pragma unroll
      for (int mm = 0; mm < 2; ++mm) {
        f32x4 t = S[mm][nt];
        t[0] *= dec4[mm].x; t[1] *= dec4[mm].y; t[2] *= dec4[mm].z; t[3] *= dec4[mm].w;
        t = mfma(Akd[mm][0], Vf[nt][0], t);
        t = mfma(Akd[mm][1], Vf[nt][1], t);
        S[mm][nt] = t;
      }
    }
    CBAR();
    CS_LOAD(jn)
  }
  LBAR();
}

DEV void bc_merge(const P& p, int l, int it) {
  const int tid_ = opq(threadIdx.x); const int lane = tid_ & 63, w = tid_ >> 6;
  int lr = it * 4 + w;
  int mix = lane >> 5, cm = (lane * 16) & 511;
  const u16* O = (const u16*)(p.ws + (mix ? O_OC : O_OB));
  u16* z = (u16*)(p.ws + O_Z);
  float ov[16], ss = 0.f;
#pragma unroll
  for (int k2 = 0; k2 < 2; ++k2) {
    uint4 a = *(const uint4*)(O + (size_t)lr * 512 + cm + 8 * k2);
    uint4 b = *(const uint4*)(O + ((size_t)GR + lr) * 512 + cm + 8 * k2);
    unsigned aa[4] = {a.x, a.y, a.z, a.w}, bb[4] = {b.x, b.y, b.z, b.w};
#pragma unroll
    for (int q = 0; q < 4; ++q) {
      float v0 = bf2f((u16)(aa[q] & 0xffff)) + bf2f((u16)(bb[q] & 0xffff));
      float v1 = bf2f((u16)(aa[q] >> 16)) + bf2f((u16)(bb[q] >> 16));
      ov[k2 * 8 + q * 2] = v0; ov[k2 * 8 + q * 2 + 1] = v1;
      ss += v0 * v0 + v1 * v1;
    }
  }
  ss += __shfl_xor(ss, 1); ss += __shfl_xor(ss, 2); ss += __shfl_xor(ss, 4);
  float rinv = rsqrtf(ss * (1.f / 128.f) + EPS);
  const float* nw = (mix ? p.hg_norm : p.gdn_norm) + l * 128 + (cm & 127);
  u16* gp = z + (size_t)lr * NZ + (mix ? C_GC : C_GB) + cm;
#pragma unroll
  for (int k2 = 0; k2 < 2; ++k2) {
    uint4 gv = *(const uint4*)(gp + 8 * k2);
    unsigned gg[4] = {gv.x, gv.y, gv.z, gv.w}, oo[4];
#pragma unroll
    for (int q = 0; q < 4; ++q) {
      int e = k2 * 8 + q * 2;
      float y0 = ov[e] * rinv * nw[e] * silu(bf2f((u16)(gg[q] & 0xffff)));
      float y1 = ov[e + 1] * rinv * nw[e + 1] * silu(bf2f((u16)(gg[q] >> 16)));
      oo[q] = pk2(y0, y1);
    }
    *(uint4*)(gp + 8 * k2) = make_uint4(oo[0], oo[1], oo[2], oo[3]);
  }
}

#ifdef NO_G0
#define XG0(x)
#else
#define XG0(x) x
#endif
#ifdef NO_G1
#define XG1(x)
#else
#define XG1(x) x
#endif
#ifdef NO_BC
#define XBC(x)
#else
#define XBC(x) x
#endif
#ifdef NO_AC
#define XAC(x)
#else
#define XAC(x) x
#endif
#ifdef NO_P0
#define XP0(x)
#else
#define XP0(x) x
#endif
#ifdef NO_R
#define XR(x)
#else
#define XR(x) x
#endif
#ifdef NO_BL
#define XBL(x)
#else
#define XBL(x) x
#endif
#ifdef NO_CL
#define XCL(x)
#else
#define XCL(x) x
#endif
#ifdef NO_A0
#define XA0(x)
#else
#define XA0(x) x
#endif
#ifdef NO_A1
#define XA1(x)
#else
#define XA1(x) x
#endif
#ifdef NO_BS
#define XBS(x)
#else
#define XBS(x) x
#endif
#ifdef NO_CS
#define XCS(x)
#else
#define XCS(x) x
#endif
__global__ void __launch_bounds__(256, 2) fwd_mega(P p) {
  extern __shared__ __attribute__((aligned(16))) char smem[];
  cg::grid_group grid = cg::this_grid();
  const int G = gridDim.x;
  XP0(phase0(p, smem));
  grid.sync();
  u16* z = (u16*)(p.ws + O_Z);
  u16* zT = (u16*)(p.ws + O_ZT);
  float* ab = (float*)(p.ws + O_AB);
  float* o = (float*)(p.ws + O_BSH);
  const u16* u = (const u16*)(p.ws + O_BIT);
  for (int g = 0; g < NG; ++g) {
    XR(phaseR(p, g, 0));
    grid.sync();
    for (int l = 0; l < DEPTH; ++l) {
      for (int rep = 0; rep < REP_G; ++rep) {
        const u16* Bt = (const u16*)(p.ws + O_WTIN) + (size_t)l * NZ * 1024;
        for (int t = blockIdx.x; t < 72 * 45; t += G) { XG0(gemm_tile<0>(u, 1024, Bt, 1024, t % 72, t / 72, z, zT, ab, o, smem)); }
      }
      grid.sync();
      for (int rep2 = 0; rep2 < REP_M; ++rep2) {
      for (int rep3 = 0; rep3 < REP_A; ++rep3) {
        if (rep3) grid.sync();
        const int nb = NCH * 4, nc = NCH * 4, na = NCH * 8;
        for (int t = blockIdx.x; t < nb + nc + na; t += G) {
          if (t < nb) { XBL(b_local(p, l, t, smem)); }
          else if (t < nb + nc) { XCL(c_local(p, l, t - nb, smem)); }
          else { XA0(a_item(p, l, t - nb - nc, 0, smem)); }
        }
      }
      grid.sync();
      {
        const int nb = 128, nc = 128, na = 16;
        for (int t = blockIdx.x; t < nb + nc + na; t += G) {
          if (t < nb) { XBS(b_seq2(p, t, smem)); }
          else if (t < nb + nc) { XCS(c_seq2(p, t - nb, smem)); }
          else { XAC(a_carry(p, t - nb - nc)); }
        }
      }
      grid.sync();
      }
      {
        const int na = NCH * 8, nm = GR / 4;
        for (int t = blockIdx.x; t < na + nm; t += G) {
          if (t < na) { XA1(a_item(p, l, t, 1, smem)); }
          else { XBC(bc_merge(p, l, t - na)); }
        }
      }
      grid.sync();
      for (int rep = 0; rep < REP_G; ++rep) {
        const u16* Bt = (const u16*)(p.ws + O_WTOUT) + (size_t)l * 1024 * 1536;
        for (int t = blockIdx.x; t < 72 * 8; t += G) { XG1(gemm_tile<1>(z + C_GA, NZ, Bt, 1536, t % 72, t / 72, z, zT, ab, o, smem)); }
      }
      grid.sync();
      XR(phaseR(p, g, l + 1));
      grid.sync();
    }
  }
}

extern "C" void kernel_launch(void* const* d_in, const int* in_sizes, int n_in, void* d_out, int out_size, void* d_ws,
                              size_t ws_size, hipStream_t stream) {
  static int grid_blocks = 0;
  if (!grid_blocks) {
    int dev = 0, cus = 0, per_cu = 0;
    hipGetDevice(&dev);
    hipDeviceGetAttribute(&cus, hipDeviceAttributeMultiprocessorCount, dev);
    hipFuncSetAttribute((const void*)fwd_mega, hipFuncAttributeMaxDynamicSharedMemorySize, LDS_BYTES);
    hipOccupancyMaxActiveBlocksPerMultiprocessor(&per_cu, fwd_mega, 256, LDS_BYTES);
    if (per_cu > 2) per_cu = 2;
    if (per_cu < 1) per_cu = 1;
    grid_blocks = cus * per_cu;
  }
  if (ws_size < WS_TOTAL) {
    fprintf(stderr, "workspace too small: %zu < %zu\n", ws_size, (size_t)WS_TOTAL);
    return;
  }
  P p{};
  const float** f = (const float**)&p;
  for (int i = 0; i < 23; ++i) f[i] = (const float*)d_in[i];
  p.out = (float*)d_out;
  p.ws = (char*)d_ws;
  void* args[] = {&p};
  hipError_t e = hipLaunchCooperativeKernel((void*)fwd_mega, dim3(grid_blocks), dim3(256), args, LDS_BYTES, stream);
  if (e != hipSuccess) fprintf(stderr, "cooperative launch failed: %s (grid %d)\n", hipGetErrorString(e), grid_blocks);
}
```

```cpp
#include <hip/hip_runtime.h>
#include <hip/hip_cooperative_groups.h>
#include <cstdio>
namespace cg = cooperative_groups;

typedef __attribute__((ext_vector_type(8))) short bf16x8;
typedef __attribute__((ext_vector_type(4))) float f32x4;
typedef unsigned short u16;
#define DEV __device__ __forceinline__

constexpr int DM = 1024, TL = 2048, TCX = 256, TS = 2304, GB = 4, GR = GB * TS, NG = 2;
constexpr int NZ = 5760, DEPTH = 4;
constexpr int C_XA = 0, C_Q = 512, C_K = 1024, C_V = 1536, C_QC = 2048, C_F0 = 2560, C_IC = 3584,
              C_GA = 4096, C_GB = 4608, C_GC = 5120, C_AB = 5632;
constexpr int NCH = GR / 64;
constexpr float EPS = 1e-6f;
constexpr int WPB = 2;

constexpr size_t al256(size_t x) { return (x + 255) & ~(size_t)255; }
constexpr size_t O_WTIN = 0;
constexpr size_t O_WTOUT = O_WTIN + al256((size_t)DEPTH * NZ * 1024 * 2);
constexpr size_t O_WGT = O_WTOUT + al256((size_t)DEPTH * 1024 * 1536 * 2);
constexpr size_t O_MOD = O_WGT + al256((size_t)DEPTH * 2 * 2 * 8 * 4096 * 2);
constexpr size_t O_LBS = O_MOD + al256((size_t)DEPTH * 9 * 3072 * 4);
constexpr size_t O_HC = O_LBS + al256((size_t)DEPTH * 1024 * 4);
constexpr size_t O_Z = O_HC + al256((size_t)GB * TCX * 1024 * 4);
constexpr size_t O_ZT = O_Z + al256((size_t)GR * NZ * 2);
constexpr size_t O_AB = O_ZT + al256((size_t)512 * GR * 2);
constexpr size_t O_BSH = O_AB + al256((size_t)GR * 16 * 4);
constexpr size_t BSH_ONE = (size_t)GR * 512 * 2;
constexpr size_t O_BIT = O_BSH + al256(4 * BSH_ONE);
constexpr size_t BIT_SZ = 17408;
constexpr size_t O_CREC = O_BIT + al256((size_t)NCH * 4 * 2 * BIT_SZ);
constexpr size_t CREC_SZ = 33280;
constexpr size_t O_OB = O_CREC + al256((size_t)NCH * 4 * 2 * CREC_SZ);
constexpr size_t O_OC = O_OB + al256((size_t)2 * GR * 512 * 2);
constexpr size_t O_AP = O_OC + al256((size_t)2 * GR * 512 * 2);
constexpr size_t O_AH = O_AP + al256((size_t)NCH * 2 * 512 * 4);
constexpr size_t O_ACAR = O_AH + al256((size_t)NCH * 2 * 512 * 4);
constexpr size_t O_BAR = O_ACAR + al256((size_t)NCH * 2 * 512 * 4);
constexpr size_t WS_TOTAL = O_BAR + al256(3456 * 4);

constexpr int LDS_BYTES = 69632;
#ifndef REP_A
#define REP_A 1
#endif
#ifndef REP_G
#define REP_G 1
#endif
#ifndef REP_M
#define REP_M 1
#endif

struct P {
  const float *x, *c, *ctx, *c_ctx, *w_ada, *b_ada, *norm_pre, *norm_post, *w_in, *conv_a_w, *conv_a_b, *rg_w_r,
      *rg_b_r, *rg_w_i, *rg_b_i, *rg_lam, *conv_b_w, *gdn_a_log, *gdn_dt_bias, *gdn_norm, *hg_lb, *hg_norm, *w_out;
  float* out;
  char* ws;
};

DEV int opq(int x) { asm volatile("" : "+v"(x)); return x; }
DEV int opqs(int x) { asm volatile("" : "+s"(x)); return x; }
DEV u16 f2bf(float f) {
  unsigned u = __float_as_uint(f);
  u += 0x7fffu + ((u >> 16) & 1u);
  return (u16)(u >> 16);
}
DEV float bf2f(u16 h) { return __uint_as_float(((unsigned)h) << 16); }
DEV unsigned pk2(float a, float b) { return (unsigned)f2bf(a) | ((unsigned)f2bf(b) << 16); }
DEV float sigm(float x) { return 1.f / (1.f + __expf(-x)); }
DEV float silu(float x) { return x / (1.f + __expf(-x)); }
DEV float softplus(float x) { return x > 20.f ? x : log1pf(__expf(x)); }
DEV f32x4 mfma(bf16x8 a, bf16x8 b, f32x4 c) { return __builtin_amdgcn_mfma_f32_16x16x32_bf16(a, b, c, 0, 0, 0); }
DEV bf16x8 ld8(const u16* p) { return *reinterpret_cast<const bf16x8*>(p); }
DEV int lat_map(int l, int t) { return (l & 1) ? ((t & 63) * 32 + (t >> 6)) : t; }
DEV int orig_col(int n) {
  if (n < 512) return n;
  if (n < 2048) return n + 512;
  if (n < 4096) return n + 1040;
  if (n < 4608) return n - 4096 + 512;
  if (n < 5120) return n - 4608 + 2576;
  if (n < 5632) return n + 16;
  if (n < 5648) return n - 5632 + 2560;
  return -1;
}
DEV float zval(const u16* z, int rb, int cp, int n, int col) {
  if (cp < 0 && (n == 0 || n == 4)) return 0.f;
  if (cp > 63 && (n == 3 || n == 35)) return 0.f;
  return bf2f(z[(size_t)(rb + cp) * NZ + col]);
}

DEV void ph0_ada(const P& p, int item, char* smem) {
  float* sc = (float*)smem;
  for (int i = threadIdx.x; i < 9 * 1024; i += 256) {
    int v = i >> 10, d = i & 1023;
    float cv = (v < 8) ? p.c[v * 1024 + d] : p.c_ctx[d];
    sc[i] = silu(cv);
  }
  __syncthreads();
  int col = item * 256 + threadIdx.x;
  int l = col / 3072, e = col % 3072;
  const float* w = p.w_ada + (size_t)l * 1024 * 3072 + e;
  float acc[9];
#pragma unroll
  for (int i = 0; i < 9; ++i) acc[i] = 0.f;
  for (int d = 0; d < 1024; d += 4) {
    float w0 = w[(size_t)d * 3072], w1 = w[(size_t)(d + 1) * 3072], w2 = w[(size_t)(d + 2) * 3072],
          w3 = w[(size_t)(d + 3) * 3072];
#pragma unroll
    for (int i = 0; i < 9; ++i)
      acc[i] += sc[i * 1024 + d] * w0 + sc[i * 1024 + d + 1] * w1 + sc[i * 1024 + d + 2] * w2 +
                sc[i * 1024 + d + 3] * w3;
  }
  float* mod = (float*)(p.ws + O_MOD);
  float bb = p.b_ada[l * 3072 + e];
#pragma unroll
  for (int i = 0; i < 9; ++i) mod[((size_t)l * 9 + i) * 3072 + e] = acc[i] + bb;
  __syncthreads();
}
DEV void tconv_tile(const float* src, int lds_, u16* dst, int ldd, int k0, int n0, bool mapcol, char* smem) {
  float* t = (float*)smem;
  for (int i = threadIdx.x; i < 4096; i += 256) {
    int kk = i >> 6, nn = i & 63;
    int n = n0 + nn;
    int sn = mapcol ? orig_col(n) : n;
    t[kk * 65 + nn] = (sn >= 0) ? src[(size_t)(k0 + kk) * lds_ + sn] : 0.f;
  }
  __syncthreads();
  for (int i = threadIdx.x; i < 4096; i += 256) {
    int nn = i >> 6, kk = i & 63;
    dst[(size_t)(n0 + nn) * ldd + k0 + kk] = f2bf(t[kk * 65 + nn]);
  }
  __syncthreads();
}
DEV void phase0(const P& p, char* smem) {
  const int n_ada = 48, n_in = DEPTH * 16 * 90, n_out = DEPTH * 24 * 16, n_g = 128, n_lb = 4;
  const int total = n_ada + n_in + n_out + n_g + n_lb;
  for (int it = blockIdx.x; it < total; it += gridDim.x) {
    int i = it;
    if (i < n_ada) { ph0_ada(p, i, smem); continue; }
    i -= n_ada;
    if (i < n_in) {
      int l = i / 1440, r = i % 1440, kt = r / 90, nt = r % 90;
      tconv_tile(p.w_in + (size_t)l * 1024 * 5648, 5648, (u16*)(p.ws + O_WTIN) + (size_t)l * NZ * 1024, 1024, kt * 64,
                 nt * 64, true, smem);
      continue;
    }
    i -= n_in;
    if (i < n_out) {
      int l = i / 384, r = i % 384, kt = r / 16, nt = r % 16;
      tconv_tile(p.w_out + (size_t)l * 1536 * 1024, 1024, (u16*)(p.ws + O_WTOUT) + (size_t)l * 1024 * 1536, 1536,
                 kt * 64, nt * 64, false, smem);
      continue;
    }
    i -= n_out;
    if (i < n_g) {
      int h = i & 7, gate = (i >> 3) & 1, dir = (i >> 4) & 1, l = i >> 5;
      const float* src = (gate ? p.rg_w_i : p.rg_w_r) + ((size_t)(l * 2 + dir) * 8 + h) * 4096;
      tconv_tile(src, 64, (u16*)(p.ws + O_WGT) + (size_t)i * 4096, 64, 0, 0, false, smem);
      continue;
    }
    i -= n_g;
    {
      int j = i * 256 + threadIdx.x;
      float v[4], mx = -1e30f;
      for (int l = 0; l < 4; ++l) { v[l] = p.hg_lb[l * 1024 + j]; mx = fmaxf(mx, v[l]); }
      float s = 0.f;
      for (int l = 0; l < 4; ++l) { v[l] = __expf(v[l] - mx); s += v[l]; }
      float* lbs = (float*)(p.ws + O_LBS);
      float cum = 0.f;
      for (int l = 0; l < 4; ++l) {
        if (l > 0) cum += v[l] / s;
        lbs[l * 1024 + j] = cum;
      }
    }
  }
}

DEV void phaseR(const P& p, int g, int l) {
  const int tid_ = opq(threadIdx.x); const int lane = tid_ & 63, w = tid_ >> 6;
  const float* mod = (const float*)(p.ws + O_MOD);
  float* hc = (float*)(p.ws + O_HC);
  const float* o = (const float*)(p.ws + O_BSH);
  u16* u = (u16*)(p.ws + O_BIT);
  for (int it = blockIdx.x; it < GR / 4; it += gridDim.x) {
    int lr = it * 4 + w;
    int lb = lr / TS, s = lr % TS;
    bool isctx = s < TCX;
    if (l == DEPTH && isctx) continue;
    int b = g * GB + lb, t = s - TCX;
    int mi = isctx ? 8 : b;
    float* hp = isctx ? hc + ((size_t)lb * TCX + s) * 1024 : p.out + ((size_t)b * TL + t) * 1024;
    float hv[16];
    if (l == 0) {
      const float* src = isctx ? p.ctx + ((size_t)b * TCX + s) * 1024 : p.x + ((size_t)b * TL + t) * 1024;
#pragma unroll
      for (int k = 0; k < 4; ++k) {
        float4 v = *(const float4*)(src + k * 256 + lane * 4);
        hv[k * 4] = v.x; hv[k * 4 + 1] = v.y; hv[k * 4 + 2] = v.z; hv[k * 4 + 3] = v.w;
      }
    } else {
      int orow = lb * TS + (isctx ? s : TCX + lat_map(l - 1, t));
      const float* op = o + (size_t)orow * 1024;
      float ov[16], ss = 0.f;
#pragma unroll
      for (int k = 0; k < 4; ++k) {
        float4 v = *(const float4*)(op + k * 256 + lane * 4);
        ov[k * 4] = v.x; ov[k * 4 + 1] = v.y; ov[k * 4 + 2] = v.z; ov[k * 4 + 3] = v.w;
        ss += v.x * v.x + v.y * v.y + v.z * v.z + v.w * v.w;
      }
#pragma unroll
      for (int off = 32; off; off >>= 1) ss += __shfl_xor(ss, off);
      float rinv = rsqrtf(ss * (1.f / 1024.f) + EPS);
      const float* gate = mod + ((size_t)(l - 1) * 9 + mi) * 3072 + 2048;
      const float* wp = p.norm_post + (l - 1) * 1024;
#pragma unroll
      for (int k = 0; k < 4; ++k) {
        float4 hh = *(const float4*)(hp + k * 256 + lane * 4);
        float4 gg = *(const float4*)(gate + k * 256 + lane * 4);
        float4 ww = *(const float4*)(wp + k * 256 + lane * 4);
        hv[k * 4] = hh.x + gg.x * (ov[k * 4] * rinv * ww.x);
        hv[k * 4 + 1] = hh.y + gg.y * (ov[k * 4 + 1] * rinv * ww.y);
        hv[k * 4 + 2] = hh.z + gg.z * (ov[k * 4 + 2] * rinv * ww.z);
        hv[k * 4 + 3] = hh.w + gg.w * (ov[k * 4 + 3] * rinv * ww.w);
      }
    }
#pragma unroll
    for (int k = 0; k < 4; ++k)
      *(float4*)(hp + k * 256 + lane * 4) = make_float4(hv[k * 4], hv[k * 4 + 1], hv[k * 4 + 2], hv[k * 4 + 3]);
    if (l < DEPTH) {
      float ss = 0.f;
#pragma unroll
      for (int k = 0; k < 16; ++k) ss += hv[k] * hv[k];
#pragma unroll
      for (int off = 32; off; off >>= 1) ss += __shfl_xor(ss, off);
      float rinv = rsqrtf(ss * (1.f / 1024.f) + EPS);
      const float* sh = mod + ((size_t)l * 9 + mi) * 3072;
      const float* wp = p.norm_pre + l * 1024;
      int urow = lb * TS + (isctx ? s : TCX + lat_map(l, t));
      u16* up = u + (size_t)urow * 1024;
#pragma unroll
      for (int k = 0; k < 4; ++k) {
        float4 ww = *(const float4*)(wp + k * 256 + lane * 4);
        float4 s0 = *(const float4*)(sh + k * 256 + lane * 4);
        float4 s1 = *(const float4*)(sh + 1024 + k * 256 + lane * 4);
        float a0 = hv[k * 4] * rinv * ww.x * (1.f + s1.x) + s0.x;
        float a1 = hv[k * 4 + 1] * rinv * ww.y * (1.f + s1.y) + s0.y;
        float a2 = hv[k * 4 + 2] * rinv * ww.z * (1.f + s1.z) + s0.z;
        float a3 = hv[k * 4 + 3] * rinv * ww.w * (1.f + s1.w) + s0.w;
        uint2 pk; pk.x = pk2(a0, a1); pk.y = pk2(a2, a3);
        *(uint2*)(up + k * 256 + lane * 4) = pk;
      }
    }
  }
}

template <int MODE>
DEV void gemm_tile(const u16* __restrict__ A, int lda, const u16* __restrict__ Bt, int K, int rt, int ct, u16* z,
                   u16* zT, float* ab, float* o, char* smem) {
  u16* As = (u16*)smem;
  u16* Bs = As + 128 * 72;
  const int tid = opq(threadIdx.x), lane = tid & 63, w = tid >> 6, wr = w >> 1, wc = w & 1, fr = lane & 15, fq = lane >> 4;
  const int lrow = tid >> 3, lseg = tid & 7;
  const u16* Ag = A + (size_t)(rt * 128 + lrow) * lda + lseg * 8;
  const u16* Bg = Bt + (size_t)(ct * 128 + lrow) * K + lseg * 8;
  uint4 ra0, ra1, ra2, ra3, rb0, rb1, rb2, rb3;
  f32x4 acc[4][4];
#pragma unroll
  for (int i = 0; i < 4; ++i)
#pragma unroll
    for (int j = 0; j < 4; ++j) acc[i][j] = (f32x4){0.f, 0.f, 0.f, 0.f};
#define GLOAD()                                             \
  ra0 = *(const uint4*)(Ag);                                \
  ra1 = *(const uint4*)(Ag + (size_t)32 * lda);             \
  ra2 = *(const uint4*)(Ag + (size_t)64 * lda);             \
  ra3 = *(const uint4*)(Ag + (size_t)96 * lda);             \
  rb0 = *(const uint4*)(Bg);                                \
  rb1 = *(const uint4*)(Bg + (size_t)32 * K);               \
  rb2 = *(const uint4*)(Bg + (size_t)64 * K);               \
  rb3 = *(const uint4*)(Bg + (size_t)96 * K);
  GLOAD();
  const int nk = K / 64;
  for (int kt = 0; kt < nk; ++kt) {
    __syncthreads();
    *(uint4*)(As + (lrow)*72 + lseg * 8) = ra0;
    *(uint4*)(As + (lrow + 32) * 72 + lseg * 8) = ra1;
    *(uint4*)(As + (lrow + 64) * 72 + lseg * 8) = ra2;
    *(uint4*)(As + (lrow + 96) * 72 + lseg * 8) = ra3;
    *(uint4*)(Bs + (lrow)*72 + lseg * 8) = rb0;
    *(uint4*)(Bs + (lrow + 32) * 72 + lseg * 8) = rb1;
    *(uint4*)(Bs + (lrow + 64) * 72 + lseg * 8) = rb2;
    *(uint4*)(Bs + (lrow + 96) * 72 + lseg * 8) = rb3;
    __syncthreads();
    if (kt + 1 < nk) {
      Ag += 64; Bg += 64;
      GLOAD();
    }
#pragma unroll
    for (int ks = 0; ks < 2; ++ks) {
      bf16x8 af[4], bfr[4];
#pragma unroll
      for (int mi = 0; mi < 4; ++mi) af[mi] = ld8(As + (wr * 64 + mi * 16 + fr) * 72 + ks * 32 + fq * 8);
#pragma unroll
      for (int ni = 0; ni < 4; ++ni) bfr[ni] = ld8(Bs + (wc * 64 + ni * 16 + fr) * 72 + ks * 32 + fq * 8);
#pragma unroll
      for (int mi = 0; mi < 4; ++mi)
#pragma unroll
        for (int ni = 0; ni < 4; ++ni) acc[mi][ni] = mfma(af[mi], bfr[ni], acc[mi][ni]);
    }
  }
#pragma unroll
  for (int mi = 0; mi < 4; ++mi)
#pragma unroll
    for (int ni = 0; ni < 4; ++ni) {
      int row0 = rt * 128 + wr * 64 + mi * 16 + fq * 4;
      int col = ct * 128 + wc * 64 + ni * 16 + fr;
      f32x4 v = acc[mi][ni];
      if (MODE == 1) {
#pragma unroll
        for (int r = 0; r < 4; ++r) o[(size_t)(row0 + r) * 1024 + col] = v[r];
      } else {
        if (ct >= 28 && ct < 32) {
          uint2 pk; pk.x = pk2(v[0], v[1]); pk.y = pk2(v[2], v[3]);
          *(uint2*)(zT + (size_t)(col - C_IC) * GR + row0) = pk;
        } else if (ct == 44) {
          if (col - C_AB < 16) {
#pragma unroll
            for (int r = 0; r < 4; ++r) ab[(size_t)(row0 + r) * 16 + (col - C_AB)] = v[r];
          }
        } else {
#pragma unroll
          for (int r = 0; r < 4; ++r) z[(size_t)(row0 + r) * NZ + col] = f2bf(v[r]);
        }
      }
    }
}

DEV void a_item(const P& p, int l, int item, int mode, char* smem) {
  float* xc = (float*)smem;
  u16* xcb = (u16*)(smem + 16384);
  float* av = (float*)(smem + 16384 + 9216);
  float* uv = av + 4096;
  float* segP = uv + 4096;
  float* segH = segP + 256;
  const int tid = opq(threadIdx.x), lane = tid & 63, w = tid >> 6, fr = lane & 15, fq = lane >> 4;
  const int cgk = item >> 3, hA = item & 7, n = cgk % 36, rb = cgk * 64;
  u16* z = (u16*)(p.ws + O_Z);
  for (int idx = tid; idx < 4096; idx += 256) {
    int c = idx >> 6, j = idx & 63, ch = hA * 64 + j;
    float val = p.conv_a_b[l * 512 + ch];
#pragma unroll
    for (int tap = 0; tap < 4; ++tap) val += p.conv_a_w[(l * 4 + tap) * 512 + ch] * zval(z, rb, c + tap - 2, n, C_XA + ch);
    xc[idx] = val;
    xcb[c * 72 + j] = f2bf(val);
  }
  __syncthreads();
  float yacc[16];
#pragma unroll
  for (int k = 0; k < 16; ++k) yacc[k] = 0.f;
  const int seg = tid >> 6, sj = tid & 63, sch = hA * 64 + sj;
  for (int dir = 0; dir < 2; ++dir) {
    {
      const u16* wg = (const u16*)(p.ws + O_WGT);
      const u16* wr_ = wg + (size_t)((((l * 2 + dir) * 2 + 0) * 8 + hA)) * 4096;
      const u16* wi_ = wg + (size_t)((((l * 2 + dir) * 2 + 1) * 8 + hA)) * 4096;
      bf16x8 a0 = ld8(xcb + (16 * w + fr) * 72 + fq * 8), a1 = ld8(xcb + (16 * w + fr) * 72 + 32 + fq * 8);
#pragma unroll
      for (int nt = 0; nt < 4; ++nt) {
        f32x4 ar = {0.f, 0.f, 0.f, 0.f}, ai = {0.f, 0.f, 0.f, 0.f};
        const u16* br = wr_ + (nt * 16 + fr) * 64 + fq * 8;
        const u16* bi = wi_ + (nt * 16 + fr) * 64 + fq * 8;
        ar = mfma(a0, ld8(br), ar); ar = mfma(a1, ld8(br + 32), ar);
        ai = mfma(a0, ld8(bi), ai); ai = mfma(a1, ld8(bi + 32), ai);
        int j = nt * 16 + fr, ch = hA * 64 + j;
        float brv = p.rg_b_r[(l * 2 + dir) * 512 + ch], biv = p.rg_b_i[(l * 2 + dir) * 512 + ch];
        float sp = softplus(-p.rg_lam[(l * 2 + dir) * 512 + ch]);
#pragma unroll
        for (int r = 0; r < 4; ++r) {
          int c = 16 * w + 4 * fq + r;
          float rg = sigm(ar[r] + brv), ig = sigm(ai[r] + biv);
          float la = -8.f * rg * sp;
          float a = __expf(la);
          float uu = sqrtf(fmaxf(-expm1f(2.f * la), 0.f)) * (ig * xc[c * 64 + j]);
          av[c * 64 + j] = a;
          uv[c * 64 + j] = uu;
        }
      }
    }
    __syncthreads();
    {
      float Pp = 1.f, H = 0.f;
#pragma unroll
      for (int k = 0; k < 16; ++k) {
        int c = dir ? (16 * seg + 15 - k) : (16 * seg + k);
        float a = av[c * 64 + sj];
        H = a * H + uv[c * 64 + sj];
        Pp *= a;
      }
      segP[seg * 64 + sj] = Pp;
      segH[seg * 64 + sj] = H;
    }
    __syncthreads();
    if (mode == 0) {
      if (seg == 0) {
        float Pc = 1.f, Hc = 0.f;
        for (int q = 0; q < 4; ++q) {
          int sg = dir ? 3 - q : q;
          Hc = segP[sg * 64 + sj] * Hc + segH[sg * 64 + sj];
          Pc *= segP[sg * 64 + sj];
        }
        size_t idx = ((size_t)cgk * 2 + dir) * 512 + sch;
        ((float*)(p.ws + O_AP))[idx] = Pc;
        ((float*)(p.ws + O_AH))[idx] = Hc;
      }
    } else {
      float st = ((const float*)(p.ws + O_ACAR))[((size_t)cgk * 2 + dir) * 512 + sch];
      int nbefore = dir ? 3 - seg : seg;
      for (int q = 0; q < nbefore; ++q) {
        int sg = dir ? 3 - q : q;
        st = segP[sg * 64 + sj] * st + segH[sg * 64 + sj];
      }
      if (dir == 0) {
#pragma unroll
        for (int k = 0; k < 16; ++k) {
          int c = 16 * seg + k;
          st = av[c * 64 + sj] * st + uv[c * 64 + sj];
          yacc[k] += st;
        }
      } else {
#pragma unroll
        for (int k = 15; k >= 0; --k) {
          int c = 16 * seg + k;
          st = av[c * 64 + sj] * st + uv[c * 64 + sj];
          yacc[k] += st;
        }
      }
    }
    __syncthreads();
  }
  if (mode == 1) {
#pragma unroll
    for (int k = 0; k < 16; ++k) {
      size_t zi = (size_t)(rb + 16 * seg + k) * NZ + C_GA + sch;
      float gate = bf2f(z[zi]);
      z[zi] = f2bf(yacc[k] * silu(gate));
    }
  }
}

DEV void a_carry(const P& p, int item) {
  int t = item * 256 + threadIdx.x;
  int ch = t & 511, dir = (t >> 9) & 1, lb = t >> 10;
  const float* AP = (const float*)(p.ws + O_AP);
  const float* AH = (const float*)(p.ws + O_AH);
  float* AC = (float*)(p.ws + O_ACAR);
  float st = 0.f;
  for (int j = 0; j < 36; ++j) {
    int n = dir ? (j < 4 ? 3 - j : 39 - j) : j;
    size_t idx = ((size_t)(lb * 36 + n) * 2 + dir) * 512 + ch;
    AC[idx] = st;
    st = AP[idx] * st + AH[idx];
  }
}

DEV void b_local(const P& p, int l, int item, char* smem) {
  u16* qs = (u16*)smem;
  u16* ks = qs + 64 * 136;
  float* Am = (float*)(smem + 34816);
  float* gc = (float*)(smem + 34816 + 32768);
  float* bt = gc + 128;
  const int tid = opq(threadIdx.x), lane = tid & 63, w = tid >> 6, fr = lane & 15, fq = lane >> 4;
  const int cgk = item >> 2, h = item & 3, n = cgk % 36, rb = cgk * 64;
  const u16* z = (const u16*)(p.ws + O_Z);
  u16* qn = (u16*)(p.ws + O_BSH);
  u16* kn = qn + (size_t)GR * 512;
  u16* vb = kn + (size_t)GR * 512;
  u16* knT = vb + (size_t)GR * 512;
  const float* ab = (const float*)(p.ws + O_AB);
  for (int c = w; c < 64; c += 4) {
    float qv[2], kv[2], vv[2];
#pragma unroll
    for (int hh = 0; hh < 2; ++hh) {
      int d = lane + 64 * hh, chn = h * 128 + d;
      float a0 = 0.f, a1 = 0.f, a2 = 0.f;
#pragma unroll
      for (int tap = 0; tap < 4; ++tap) {
        const float* cw = p.conv_b_w + (size_t)(l * 4 + tap) * 1536;
        a0 += cw[chn] * zval(z, rb, c + tap - 2, n, C_Q + chn);
        a1 += cw[512 + chn] * zval(z, rb, c + tap - 2, n, C_K + chn);
        a2 += cw[1024 + chn] * zval(z, rb, c + tap - 2, n, C_V + chn);
      }
      qv[hh] = silu(a0); kv[hh] = silu(a1); vv[hh] = silu(a2);
    }
    float sq = qv[0] * qv[0] + qv[1] * qv[1], sk = kv[0] * kv[0] + kv[1] * kv[1];
#pragma unroll
    for (int off = 32; off; off >>= 1) { sq += __shfl_xor(sq, off); sk += __shfl_xor(sk, off); }
    float rq = rsqrtf(sq + EPS) * 0.08838834764831845f, rk = rsqrtf(sk + EPS);
#pragma unroll
    for (int hh = 0; hh < 2; ++hh) {
      int d = lane + 64 * hh;
      u16 qb = f2bf(qv[hh] * rq), kb = f2bf(kv[hh] * rk);
      qs[c * 136 + d] = qb; ks[c * 136 + d] = kb;
      size_t gi = (size_t)(rb + c) * 512 + h * 128 + d;
      qn[gi] = qb; kn[gi] = kb; vb[gi] = f2bf(vv[hh]);
    }
  }
  if (w < 2) {
    int dir = w, i = lane, c = dir ? 63 - i : i;
    float al = ab[(size_t)(rb + c) * 16 + dir * 4 + h], bl = ab[(size_t)(rb + c) * 16 + 8 + dir * 4 + h];
    float g = -__expf(p.gdn_a_log[(l * 2 + dir) * 4 + h]) * softplus(al + p.gdn_dt_bias[(l * 2 + dir) * 4 + h]);
#pragma unroll
    for (int off = 1; off < 64; off <<= 1) {
      float v = __shfl_up(g, off);
      if (lane >= off) g += v;
    }
    gc[dir * 64 + i] = g;
    bt[dir * 64 + i] = sigm(bl);
  }
  __syncthreads();
  for (int idx = tid; idx < 1024; idx += 256) {
    int d = idx >> 3, c8 = idx & 7;
    uint4 pk;
    pk.x = (unsigned)ks[(c8 * 8 + 0) * 136 + d] | ((unsigned)ks[(c8 * 8 + 1) * 136 + d] << 16);
    pk.y = (unsigned)ks[(c8 * 8 + 2) * 136 + d] | ((unsigned)ks[(c8 * 8 + 3) * 136 + d] << 16);
    pk.z = (unsigned)ks[(c8 * 8 + 4) * 136 + d] | ((unsigned)ks[(c8 * 8 + 5) * 136 + d] << 16);
    pk.w = (unsigned)ks[(c8 * 8 + 6) * 136 + d] | ((unsigned)ks[(c8 * 8 + 7) * 136 + d] << 16);
    *(uint4*)(knT + ((size_t)(cgk * 4 + h) * 128 + d) * 64 + c8 * 8) = pk;
  }
  for (int dir = 0; dir < 2; ++dir) {
    char* rec = p.ws + O_BIT + ((size_t)(cgk * 4 + h) * 2 + dir) * BIT_SZ;
    u16* QKm = (u16*)rec + 4096;
    float* scal = (float*)(rec + 16384);
    int irow = 16 * w + fr, ci = dir ? 63 - irow : irow;
    bf16x8 ak[4], aq[4];
#pragma unroll
    for (int s = 0; s < 4; ++s) { ak[s] = ld8(ks + ci * 136 + 32 * s + 8 * fq); aq[s] = ld8(qs + ci * 136 + 32 * s + 8 * fq); }
#pragma unroll
    for (int nt = 0; nt < 4; ++nt) {
      int jcol = 16 * nt + fr, cj = dir ? 63 - jcol : jcol;
      f32x4 kk = {0.f, 0.f, 0.f, 0.f}, qk = {0.f, 0.f, 0.f, 0.f};
#pragma unroll
      for (int s = 0; s < 4; ++s) {
        bf16x8 b = ld8(ks + cj * 136 + 32 * s + 8 * fq);
        kk = mfma(ak[s], b, kk);
        qk = mfma(aq[s], b, qk);
      }
      float gj = gc[dir * 64 + jcol];
#pragma unroll
      for (int r = 0; r < 4; ++r) {
        int i = 16 * w + 4 * fq + r;
        float dec = (jcol <= i) ? __expf(gc[dir * 64 + i] - gj) : 0.f;
        Am[(dir * 64 + i) * 64 + jcol] = (jcol < i) ? bt[dir * 64 + i] * kk[r] * dec : 0.f;
        QKm[i * 64 + jcol] = f2bf(qk[r] * dec);
      }
    }
    if (tid < 64) {
      float gl = gc[dir * 64 + 63], gi = gc[dir * 64 + tid];
      scal[tid] = __expf(gi);
      scal[64 + tid] = bt[dir * 64 + tid];
      scal[128 + tid] = __expf(gl - gi);
      if (tid == 0) scal[192] = __expf(gl);
    }
  }
  __syncthreads();
  if (w < 2) {
    int dir = w, col = lane;
    u16* Tinv = (u16*)(p.ws + O_BIT + ((size_t)(cgk * 4 + h) * 2 + dir) * BIT_SZ);
    const float* Ad = Am + dir * 4096;
    float T[64];
#pragma unroll
    for (int i = 0; i < 64; ++i) {
      float s = (i == col) ? 1.f : 0.f;
#pragma unroll
      for (int j = 0; j < i; ++j) s -= Ad[i * 64 + j] * T[j];
      T[i] = s;
      Tinv[i * 64 + col] = f2bf(s);
      __builtin_amdgcn_sched_barrier(0);
    }
  }
  __syncthreads();
}

DEV void b_seq(const P& p, int bitem, char* smem) {
  const int tid = opq(threadIdx.x), lane = tid & 63, w = tid >> 6, fr = lane & 15, fq = lane >> 4;
  const bool active = w < WPB;
  const int item = bitem * WPB + (active ? w : 0);
  const int slice = item & 7, dir = (item >> 3) & 1, h = (item >> 4) & 3, lb = item >> 6, e0 = slice * 16;
  u16* Ss = (u16*)(smem + w * 11264);
  u16* Rs = Ss + 16 * 136;
  u16* Vsc = Rs + 16 * 72;
  u16* Vor = Vsc + 16 * 72;
  const u16* qn = (const u16*)(p.ws + O_BSH);
  const u16* kn = qn + (size_t)GR * 512;
  const u16* vb = kn + (size_t)GR * 512;
  const u16* knT = vb + (size_t)GR * 512;
  u16* OB = (u16*)(p.ws + O_OB);
  f32x4 S[8];
#pragma unroll
  for (int m = 0; m < 8; ++m) S[m] = (f32x4){0.f, 0.f, 0.f, 0.f};
  for (int j = 0; j < 36; ++j) {
    const int n = dir ? (j < 4 ? 3 - j : 39 - j) : j;
    const int cgk = lb * 36 + n, rb = cgk * 64;
    const char* rec = p.ws + O_BIT + ((size_t)(cgk * 4 + h) * 2 + dir) * BIT_SZ;
    const u16* Tinv = (const u16*)rec;
    const u16* QKm = Tinv + 4096;
    const float* scal = (const float*)(rec + 16384);
    if (active) {
#pragma unroll
      for (int m = 0; m < 8; ++m) {
        uint2 pk; pk.x = pk2(S[m][0], S[m][1]); pk.y = pk2(S[m][2], S[m][3]);
        *(uint2*)(Ss + fr * 136 + 16 * m + 4 * fq) = pk;
      }
    }
    __syncthreads();
    bf16x8 Sf[4];
    if (active) {
#pragma unroll
      for (int s = 0; s < 4; ++s) Sf[s] = ld8(Ss + fr * 136 + 32 * s + 8 * fq);
#pragma unroll
      for (int m = 0; m < 4; ++m) {
        int i = 16 * m + fr, rowi = rb + (dir ? 63 - i : i);
        f32x4 X = {0.f, 0.f, 0.f, 0.f};
#pragma unroll
        for (int s = 0; s < 4; ++s) X = mfma(ld8(kn + (size_t)rowi * 512 + h * 128 + 32 * s + 8 * fq), Sf[s], X);
        float rv[4];
#pragma unroll
        for (int r = 0; r < 4; ++r) {
          int ii = 16 * m + 4 * fq + r, rowr = rb + (dir ? 63 - ii : ii);
          float v = bf2f(vb[(size_t)rowr * 512 + h * 128 + e0 + fr]);
          rv[r] = scal[64 + ii] * (v - scal[ii] * X[r]);
        }
        uint2 pk; pk.x = pk2(rv[0], rv[1]); pk.y = pk2(rv[2], rv[3]);
        *(uint2*)(Rs + fr * 72 + 16 * m + 4 * fq) = pk;
      }
    }
    __syncthreads();
    if (active) {
      bf16x8 Rf0 = ld8(Rs + fr * 72 + 8 * fq), Rf1 = ld8(Rs + fr * 72 + 32 + 8 * fq);
#pragma unroll
      for (int m = 0; m < 4; ++m) {
        f32x4 VN = {0.f, 0.f, 0.f, 0.f};
        VN = mfma(ld8(Tinv + (16 * m + fr) * 64 + 8 * fq), Rf0, VN);
        VN = mfma(ld8(Tinv + (16 * m + fr) * 64 + 32 + 8 * fq), Rf1, VN);
        uint2 pk; pk.x = pk2(VN[0], VN[1]); pk.y = pk2(VN[2], VN[3]);
        *(uint2*)(Vsc + fr * 72 + 16 * m + 4 * fq) = pk;
        int ib = 16 * m + 4 * fq;
        float s0 = VN[0] * scal[128 + ib], s1 = VN[1] * scal[128 + ib + 1], s2 = VN[2] * scal[128 + ib + 2],
              s3 = VN[3] * scal[128 + ib + 3];
        if (dir) {
          pk.x = pk2(s3, s2); pk.y = pk2(s1, s0);
          *(uint2*)(Vor + fr * 72 + (60 - ib)) = pk;
        } else {
          pk.x = pk2(s0, s1); pk.y = pk2(s2, s3);
          *(uint2*)(Vor + fr * 72 + ib) = pk;
        }
      }
    }
    __syncthreads();
    if (active) {
      bf16x8 Vs0 = ld8(Vsc + fr * 72 + 8 * fq), Vs1 = ld8(Vsc + fr * 72 + 32 + 8 * fq);
      bf16x8 Vo0 = ld8(Vor + fr * 72 + 8 * fq), Vo1 = ld8(Vor + fr * 72 + 32 + 8 * fq);
#pragma unroll
      for (int m = 0; m < 4; ++m) {
        int i = 16 * m + fr, rowi = rb + (dir ? 63 - i : i);
        f32x4 O = {0.f, 0.f, 0.f, 0.f};
#pragma unroll
        for (int s = 0; s < 4; ++s) O = mfma(ld8(qn + (size_t)rowi * 512 + h * 128 + 32 * s + 8 * fq), Sf[s], O);
#pragma unroll
        for (int r = 0; r < 4; ++r) O[r] *= scal[16 * m + 4 * fq + r];
        O = mfma(ld8(QKm + (16 * m + fr) * 64 + 8 * fq), Vs0, O);
        O = mfma(ld8(QKm + (16 * m + fr) * 64 + 32 + 8 * fq), Vs1, O);
#pragma unroll
        for (int r = 0; r < 4; ++r) {
          int ii = 16 * m + 4 * fq + r, rowr = rb + (dir ? 63 - ii : ii);
          OB[((size_t)dir * GR + rowr) * 512 + h * 128 + e0 + fr] = f2bf(O[r]);
        }
      }
      float egl = scal[192];
#pragma unroll
      for (int m = 0; m < 8; ++m) {
        const u16* kt = knT + ((size_t)(cgk * 4 + h) * 128 + 16 * m + fr) * 64;
        f32x4 t = S[m];
#pragma unroll
        for (int r = 0; r < 4; ++r) t[r] *= egl;
        t = mfma(ld8(kt + 8 * fq), Vo0, t);
        t = mfma(ld8(kt + 32 + 8 * fq), Vo1, t);
        S[m] = t;
      }
    }
  }
  __syncthreads();
}

DEV void c_local(const P& p, int l, int item, char* smem) {
  float* bsm = (float*)smem;
  u16* Ps = (u16*)(smem + 33024);
  u16* kdt = (u16*)(smem + 33024 + 9216);
  const int tid = opq(threadIdx.x), lane = tid & 63, w = tid >> 6, fr = lane & 15, fq = lane >> 4;
  const int cgk = item >> 2, h = item & 3, rb = cgk * 64;
  const u16* z = (const u16*)(p.ws + O_Z);
  const u16* zT = (const u16*)(p.ws + O_ZT);
  u16* OC = (u16*)(p.ws + O_OC);
  const float* lbs = (const float*)(p.ws + O_LBS);
  for (int dir = 0; dir < 2; ++dir) {
    char* rec = p.ws + O_CREC + ((size_t)(cgk * 4 + h) * 2 + dir) * CREC_SZ;
    u16* QD = (u16*)rec;
    u16* KDT = QD + 8192;
    float* decv = (float*)(rec + 32768);
    const float* lbp = lbs + l * 1024 + dir * 512 + h * 128;
    const int fcol = C_F0 + dir * 512 + h * 128;
    {
      int d = tid & 127, half = tid >> 7;
      float lb_ = lbp[d], run = 0.f;
      for (int k = 0; k < 32; ++k) {
        int i = 32 * half + k, c = dir ? 63 - i : i;
        float f = bf2f(z[(size_t)(rb + c) * NZ + fcol + d]);
        float fg = lb_ + (1.f - lb_) * sigm(f);
        run += __logf(fg);
        bsm[i * 129 + d] = run;
      }
    }
    __syncthreads();
    {
      int d = tid & 127, half = tid >> 7;
      if (half) {
        float add = bsm[31 * 129 + d];
        for (int k = 0; k < 32; ++k) bsm[(32 + k) * 129 + d] += add;
      }
    }
    __syncthreads();
    for (int idx = tid; idx < 8192; idx += 256) {
      int i = idx >> 7, d = idx & 127, c = dir ? 63 - i : i;
      float b = bsm[i * 129 + d];
      float q = silu(bf2f(z[(size_t)(rb + c) * NZ + C_QC + h * 128 + d]));
      QD[i * 128 + d] = f2bf(q * __expf(b));
      float f = bf2f(z[(size_t)(rb + c) * NZ + fcol + d]);
      float k = (1.f - lbp[d]) * sigm(-f);
      kdt[d * 72 + c] = f2bf(k * __expf(bsm[63 * 129 + d] - b));
    }
    if (tid < 128) decv[tid] = __expf(bsm[63 * 129 + tid]);
    __syncthreads();
    for (int idx = tid; idx < 1024; idx += 256) {
      int d = idx >> 3, c8 = idx & 7;
      *(uint4*)(KDT + d * 64 + c8 * 8) = *(const uint4*)(kdt + d * 72 + c8 * 8);
    }
    {
      const int sj = w;
      for (int si = 0; si < 4; ++si) {
        f32x4 acc = {0.f, 0.f, 0.f, 0.f};
        if (si >= sj) {
          int it = 16 * si + fr, jt = 16 * sj + fr;
          int ci = dir ? 63 - it : it, cj = dir ? 63 - jt : jt;
#pragma unroll
          for (int s = 0; s < 4; ++s) {
            int d0 = 32 * s + 8 * fq;
            bf16x8 qv = ld8(z + (size_t)(rb + ci) * NZ + C_QC + h * 128 + d0);
            bf16x8 fv = ld8(z + (size_t)(rb + cj) * NZ + fcol + d0);
            bf16x8 af, bf;
#pragma unroll
            for (int e = 0; e < 8; ++e) {
              int d = d0 + e;
              float Bs_ = si ? bsm[(16 * si - 1) * 129 + d] : 0.f;
              float qq = silu(bf2f((u16)qv[e])) * __expf(bsm[it * 129 + d] - Bs_);
              float kk = (1.f - lbp[d]) * sigm(-bf2f((u16)fv[e])) * __expf(Bs_ - bsm[jt * 129 + d]);
              af[e] = (short)f2bf(qq);
              bf[e] = (short)f2bf(kk);
            }
            acc = mfma(af, bf, acc);
          }
        }
#pragma unroll
        for (int r = 0; r < 4; ++r) {
          int i = 16 * si + 4 * fq + r, jj = 16 * sj + fr;
          float v = (si >= sj && jj <= i) ? acc[r] : 0.f;
          Ps[i * 72 + (dir ? 63 - jj : jj)] = f2bf(v);
        }
      }
    }
    __syncthreads();
#pragma unroll
    for (int nt2 = 0; nt2 < 2; ++nt2) {
      int e = h * 128 + (2 * w + nt2) * 16 + fr;
      bf16x8 v0 = ld8(zT + (size_t)e * GR + rb + 8 * fq), v1 = ld8(zT + (size_t)e * GR + rb + 32 + 8 * fq);
#pragma unroll
      for (int m = 0; m < 4; ++m) {
        f32x4 O = {0.f, 0.f, 0.f, 0.f};
        O = mfma(ld8(Ps + (16 * m + fr) * 72 + 8 * fq), v0, O);
        O = mfma(ld8(Ps + (16 * m + fr) * 72 + 32 + 8 * fq), v1, O);
#pragma unroll
        for (int r = 0; r < 4; ++r) {
          int ii = 16 * m + 4 * fq + r, rowr = rb + (dir ? 63 - ii : ii);
          OC[((size_t)dir * GR + rowr) * 512 + e] = f2bf(O[r]);
        }
      }
    }
    __syncthreads();
  }
}

DEV void c_seq(const P& p, int bitem, char* smem) {
  const int tid = opq(threadIdx.x), lane = tid & 63, w = tid >> 6, fr = lane & 15, fq = lane >> 4;
  const bool active = w < WPB;
  const int item = bitem * WPB + (active ? w : 0);
  const int slice = item & 7, dir = (item >> 3) & 1, h = (item >> 4) & 3, lb = item >> 6, e0 = slice * 16;
  u16* Ss = (u16*)(smem + w * 4352);
  const u16* zT = (const u16*)(p.ws + O_ZT);
  u16* OC = (u16*)(p.ws + O_OC);
  f32x4 S[8];
#pragma unroll
  for (int m = 0; m < 8; ++m) S[m] = (f32x4){0.f, 0.f, 0.f, 0.f};
  for (int j = 0; j < 36; ++j) {
    const int n = dir ? (j < 4 ? 3 - j : 39 - j) : j;
    const int cgk = lb * 36 + n, rb = cgk * 64;
    const char* rec = p.ws + O_CREC + ((size_t)(cgk * 4 + h) * 2 + dir) * CREC_SZ;
    const u16* QD = (const u16*)rec;
    const u16* KDT = QD + 8192;
    const float* decv = (const float*)(rec + 32768);
    if (active) {
#pragma unroll
      for (int m = 0; m < 8; ++m) {
        uint2 pk; pk.x = pk2(S[m][0], S[m][1]); pk.y = pk2(S[m][2], S[m][3]);
        *(uint2*)(Ss + fr * 136 + 16 * m + 4 * fq) = pk;
      }
    }
    __syncthreads();
    if (active) {
      bf16x8 Sf[4];
#pragma unroll
      for (int s = 0; s < 4; ++s) Sf[s] = ld8(Ss + fr * 136 + 32 * s + 8 * fq);
#pragma unroll
      for (int m = 0; m < 4; ++m) {
        f32x4 O = {0.f, 0.f, 0.f, 0.f};
#pragma unroll
        for (int s = 0; s < 4; ++s) O = mfma(ld8(QD + (16 * m + fr) * 128 + 32 * s + 8 * fq), Sf[s], O);
#pragma unroll
        for (int r = 0; r < 4; ++r) {
          int ii = 16 * m + 4 * fq + r, rowr = rb + (dir ? 63 - ii : ii);
          size_t oi = ((size_t)dir * GR + rowr) * 512 + h * 128 + e0 + fr;
          OC[oi] = f2bf(bf2f(OC[oi]) + O[r]);
        }
      }
      const u16* vp = zT + (size_t)(h * 128 + e0 + fr) * GR + rb;
      bf16x8 V0 = ld8(vp + 8 * fq), V1 = ld8(vp + 32 + 8 * fq);
#pragma unroll
      for (int m = 0; m < 8; ++m) {
        f32x4 t = S[m];
#pragma unroll
        for (int r = 0; r < 4; ++r) t[r] *= decv[16 * m + 4 * fq + r];
        t = mfma(ld8(KDT + (16 * m + fr) * 64 + 8 * fq), V0, t);
        t = mfma(ld8(KDT + (16 * m + fr) * 64 + 32 + 8 * fq), V1, t);
        S[m] = t;
      }
    }
    __syncthreads();
  }
}

#define LBAR()                                              \
  do {                                                      \
    asm volatile("s_waitcnt lgkmcnt(0)" ::: "memory");      \
    __builtin_amdgcn_s_barrier();                           \
    asm volatile("" ::: "memory");                          \
  } while (0)
#define CBAR() asm volatile("" ::: "memory")

DEV void b_seq2(const P& p, int bitem, char* smem) {
  const int tid = opq(threadIdx.x), lane = tid & 63, w = tid >> 6, fr = lane & 15, fq = lane >> 4;
  const int es = bitem & 3, dir = (bitem >> 2) & 1, h = (bitem >> 3) & 3, lb = bitem >> 5, e0 = es * 32;
  u16* Ss = (u16*)smem;
  u16* Rs = Ss + 32 * 136;
  u16* Vsc = Rs + 32 * 72;
  u16* Vor = Vsc + 32 * 72;
  const u16* qn = (const u16*)(p.ws + O_BSH);
  const u16* kn = qn + (size_t)GR * 512;
  const u16* vb = kn + (size_t)GR * 512;
  const u16* knT = vb + (size_t)GR * 512;
  u16* OB = (u16*)(p.ws + O_OB);
  const int mrow = 16 * w + fr, crow0 = 16 * w + 4 * fq;
  f32x4 S[2][2];
#pragma unroll
  for (int a = 0; a < 2; ++a)
#pragma unroll
    for (int b = 0; b < 2; ++b) S[a][b] = (f32x4){0.f, 0.f, 0.f, 0.f};
  bf16x8 Akn[4], Aqn[4], At[2], Aqk[2], AkT[2][2];
  u16 vbv[2][4];
  float4 eg4, be4, ek4;
  float egl;
#define BS_CHUNK(jj) (dir ? ((jj) < 4 ? 3 - (jj) : 39 - (jj)) : (jj))
#define BS_LOAD1(jj)                                                                         \
  {                                                                                          \
    const int cg_ = lb * 36 + BS_CHUNK(jj), rb_ = cg_ * 64;                                  \
    const size_t ra_ = (size_t)(rb_ + (dir ? 63 - mrow : mrow)) * 512 + h * 128 + 8 * fq;    \
    _Pragma("unroll") for (int s = 0; s < 4; ++s) {                                          \
      Akn[s] = ld8(kn + ra_ + 32 * s);                                                       \
      Aqn[s] = ld8(qn + ra_ + 32 * s);                                                       \
    }                                                                                        \
    _Pragma("unroll") for (int r = 0; r < 4; ++r) {                                          \
      const size_t rr_ = (size_t)(rb_ + (dir ? 63 - (crow0 + r) : (crow0 + r))) * 512 + h * 128 + e0 + fr; \
      vbv[0][r] = vb[rr_];                                                                   \
      vbv[1][r] = vb[rr_ + 16];                                                              \
    }                                                                                        \
    const float* sc_ = (const float*)(p.ws + O_BIT + ((size_t)(cg_ * 4 + h) * 2 + dir) * BIT_SZ + 16384); \
    eg4 = *(const float4*)(sc_ + crow0);                                                     \
    be4 = *(const float4*)(sc_ + 64 + crow0);                                                \
  }
#define BS_LOAD2(jj)                                                                         \
  {                                                                                          \
    const int cg_ = lb * 36 + BS_CHUNK(jj);                                                  \
    const char* rec_ = p.ws + O_BIT + ((size_t)(cg_ * 4 + h) * 2 + dir) * BIT_SZ;            \
    const u16* T_ = (const u16*)rec_ + mrow * 64 + 8 * fq;                                   \
    At[0] = ld8(T_); At[1] = ld8(T_ + 32);                                                   \
    ek4 = *(const float4*)((const float*)(rec_ + 16384) + 128 + crow0);                      \
  }
#define BS_LOAD3(jj)                                                                         \
  {                                                                                          \
    const int cg_ = lb * 36 + BS_CHUNK(jj);                                                  \
    const char* rec_ = p.ws + O_BIT + ((size_t)(cg_ * 4 + h) * 2 + dir) * BIT_SZ;            \
    const u16* Q_ = (const u16*)rec_ + 4096 + mrow * 64 + 8 * fq;                            \
    Aqk[0] = ld8(Q_); Aqk[1] = ld8(Q_ + 32);                                                 \
    egl = ((const float*)(rec_ + 16384))[192];                                               \
    _Pragma("unroll") for (int mm = 0; mm < 2; ++mm) {                                       \
      const u16* k_ = knT + ((size_t)(cg_ * 4 + h) * 128 + 32 * w + 16 * mm + fr) * 64 + 8 * fq; \
      AkT[mm][0] = ld8(k_); AkT[mm][1] = ld8(k_ + 32);                                       \
    }                                                                                        \
  }
  BS_LOAD1(0) BS_LOAD2(0) BS_LOAD3(0)
  for (int j = 0; j < 36; ++j) {
    const int cgk = lb * 36 + BS_CHUNK(j), rb = cgk * 64;
    const int jn = (j + 1 < 36) ? j + 1 : j;
#pragma unroll
    for (int mm = 0; mm < 2; ++mm)
#pragma unroll
      for (int nt = 0; nt < 2; ++nt) {
        uint2 pk; pk.x = pk2(S[mm][nt][0], S[mm][nt][1]); pk.y = pk2(S[mm][nt][2], S[mm][nt][3]);
        *(uint2*)(Ss + (16 * nt + fr) * 136 + 32 * w + 16 * mm + 4 * fq) = pk;
      }
    LBAR();
    f32x4 QS[2];
    {
      bf16x8 Sf[2][4];
#pragma unroll
      for (int nt = 0; nt < 2; ++nt)
#pragma unroll
        for (int s = 0; s < 4; ++s) Sf[nt][s] = ld8(Ss + (16 * nt + fr) * 136 + 32 * s + 8 * fq);
#pragma unroll
      for (int nt = 0; nt < 2; ++nt) {
        f32x4 X = {0.f, 0.f, 0.f, 0.f}, Q = {0.f, 0.f, 0.f, 0.f};
#pragma unroll
        for (int s = 0; s < 4; ++s) { X = mfma(Akn[s], Sf[nt][s], X); Q = mfma(Aqn[s], Sf[nt][s], Q); }
        float r0 = be4.x * (bf2f(vbv[nt][0]) - eg4.x * X[0]);
        float r1 = be4.y * (bf2f(vbv[nt][1]) - eg4.y * X[1]);
        float r2 = be4.z * (bf2f(vbv[nt][2]) - eg4.z * X[2]);
        float r3 = be4.w * (bf2f(vbv[nt][3]) - eg4.w * X[3]);
        uint2 pk; pk.x = pk2(r0, r1); pk.y = pk2(r2, r3);
        *(uint2*)(Rs + (16 * nt + fr) * 72 + crow0) = pk;
        Q[0] *= eg4.x; Q[1] *= eg4.y; Q[2] *= eg4.z; Q[3] *= eg4.w;
        QS[nt] = Q;
      }
    }
    CBAR();
    BS_LOAD1(jn)
    LBAR();
    {
#pragma unroll
      for (int nt = 0; nt < 2; ++nt) {
        bf16x8 Rf0 = ld8(Rs + (16 * nt + fr) * 72 + 8 * fq), Rf1 = ld8(Rs + (16 * nt + fr) * 72 + 32 + 8 * fq);
        f32x4 VN = {0.f, 0.f, 0.f, 0.f};
        VN = mfma(At[0], Rf0, VN);
        VN = mfma(At[1], Rf1, VN);
        uint2 pk; pk.x = pk2(VN[0], VN[1]); pk.y = pk2(VN[2], VN[3]);
        *(uint2*)(Vsc + (16 * nt + fr) * 72 + crow0) = pk;
        float s0 = VN[0] * ek4.x, s1 = VN[1] * ek4.y, s2 = VN[2] * ek4.z, s3 = VN[3] * ek4.w;
        if (dir) {
          pk.x = pk2(s3, s2); pk.y = pk2(s1, s0);
          *(uint2*)(Vor + (16 * nt + fr) * 72 + (60 - crow0)) = pk;
        } else {
          pk.x = pk2(s0, s1); pk.y = pk2(s2, s3);
          *(uint2*)(Vor + (16 * nt + fr) * 72 + crow0) = pk;
        }
      }
    }
    CBAR();
    BS_LOAD2(jn)
    LBAR();
    {
#pragma unroll
      for (int nt = 0; nt < 2; ++nt) {
        bf16x8 Vs0 = ld8(Vsc + (16 * nt + fr) * 72 + 8 * fq), Vs1 = ld8(Vsc + (16 * nt + fr) * 72 + 32 + 8 * fq);
        bf16x8 Vo0 = ld8(Vor + (16 * nt + fr) * 72 + 8 * fq), Vo1 = ld8(Vor + (16 * nt + fr) * 72 + 32 + 8 * fq);
        f32x4 O = QS[nt];
        O = mfma(Aqk[0], Vs0, O);
        O = mfma(Aqk[1], Vs1, O);
#pragma unroll
        for (int r = 0; r < 4; ++r) {
          int ii = crow0 + r, rowr = rb + (dir ? 63 - ii : ii);
          OB[((size_t)dir * GR + rowr) * 512 + h * 128 + e0 + 16 * nt + fr] = f2bf(O[r]);
        }
#pragma unroll
        for (int mm = 0; mm < 2; ++mm) {
          f32x4 t = S[mm][nt];
#pragma unroll
          for (int r = 0; r < 4; ++r) t[r] *= egl;
          t = mfma(AkT[mm][0], Vo0, t);
          t = mfma(AkT[mm][1], Vo1, t);
          S[mm][nt] = t;
        }
      }
    }
    CBAR();
    BS_LOAD3(jn)
  }
  LBAR();
}

DEV void c_seq2(const P& p, int bitem, char* smem) {
  const int tid = opq(threadIdx.x), lane = tid & 63, w = tid >> 6, fr = lane & 15, fq = lane >> 4;
  const int es = bitem & 3, dir = (bitem >> 2) & 1, h = (bitem >> 3) & 3, lb = bitem >> 5, e0 = es * 32;
  u16* Ssb = (u16*)smem;
  const u16* zT = (const u16*)(p.ws + O_ZT);
  u16* OC = (u16*)(p.ws + O_OC);
  const int mrow = 16 * w + fr, crow0 = 16 * w + 4 * fq;
  f32x4 S[2][2];
#pragma unroll
  for (int a = 0; a < 2; ++a)
#pragma unroll
    for (int b = 0; b < 2; ++b) S[a][b] = (f32x4){0.f, 0.f, 0.f, 0.f};
  bf16x8 Aqd[4], Akd[2][2], Vf[2][2];
  u16 oi[2][4];
  float4 dec4[2];
#define CS_LOAD(jj)                                                                          \
  {                                                                                          \
    const int cg_ = lb * 36 + BS_CHUNK(jj), rb_ = cg_ * 64;                                  \
    const char* rec_ = p.ws + O_CREC + ((size_t)(cg_ * 4 + h) * 2 + dir) * CREC_SZ;          \
    const u16* QD_ = (const u16*)rec_ + mrow * 128 + 8 * fq;                                 \
    _Pragma("unroll") for (int s = 0; s < 4; ++s) Aqd[s] = ld8(QD_ + 32 * s);                \
    _Pragma("unroll") for (int mm = 0; mm < 2; ++mm) {                                       \
      const u16* K_ = (const u16*)rec_ + 8192 + (32 * w + 16 * mm + fr) * 64 + 8 * fq;       \
      Akd[mm][0] = ld8(K_); Akd[mm][1] = ld8(K_ + 32);                                       \
      dec4[mm] = *(const float4*)((const float*)(rec_ + 32768) + 32 * w + 16 * mm + 4 * fq); \
    }                                                                                        \
    _Pragma("unroll") for (int nt = 0; nt < 2; ++nt) {                                       \
      const u16* v_ = zT + (size_t)(h * 128 + e0 + 16 * nt + fr) * GR + rb_ + 8 * fq;        \
      Vf[nt][0] = ld8(v_); Vf[nt][1] = ld8(v_ + 32);                                         \
      _Pragma("unroll") for (int r = 0; r < 4; ++r) {                                        \
        int ii_ = crow0 + r, rowr_ = rb_ + (dir ? 63 - ii_ : ii_);                           \
        oi[nt][r] = OC[((size_t)dir * GR + rowr_) * 512 + h * 128 + e0 + 16 * nt + fr];      \
      }                                                                                      \
    }                                                                                        \
  }
  CS_LOAD(0)
  for (int j = 0; j < 36; ++j) {
    const int cgk = lb * 36 + BS_CHUNK(j), rb = cgk * 64;
    const int jn = (j + 1 < 36) ? j + 1 : j;
    u16* Ss = Ssb + (j & 1) * (32 * 136);
#pragma unroll
    for (int mm = 0; mm < 2; ++mm)
#pragma unroll
      for (int nt = 0; nt < 2; ++nt) {
        uint2 pk; pk.x = pk2(S[mm][nt][0], S[mm][nt][1]); pk.y = pk2(S[mm][nt][2], S[mm][nt][3]);
        *(uint2*)(Ss + (16 * nt + fr) * 136 + 32 * w + 16 * mm + 4 * fq) = pk;
      }
    LBAR();
#pragma unroll
    for (int nt = 0; nt < 2; ++nt) {
      f32x4 O = {0.f, 0.f, 0.f, 0.f};
#pragma unroll
      for (int s = 0; s < 4; ++s) O = mfma(Aqd[s], ld8(Ss + (16 * nt + fr) * 136 + 32 * s + 8 * fq), O);
#pragma unroll
      for (int r = 0; r < 4; ++r) {
        int ii = crow0 + r, rowr = rb + (dir ? 63 - ii : ii);
        OC[((size_t)dir * GR + rowr) * 512 + h * 128 + e0 + 16 * nt + fr] = f2bf(bf2f(oi[nt][r]) + O[r]);
      }
#pragma unroll
      for (int mm = 0; mm < 2; ++mm) {
        f32x4 t = S[mm][nt];
        t[0] *= dec4[mm].x; t[1] *= dec4[mm].y; t[2] *= dec4[mm].z; t[3] *= dec4[mm].w;
        t = mfma(Akd[mm][0], Vf[nt][0], t);
        t = mfma(Akd[mm][1], Vf[nt][1], t);
        S[mm][nt] = t;
      }
    }
    CBAR();
    CS_LOAD(jn)
  }
  LBAR();
}

DEV void bc_merge(const P& p, int l, int it) {
  const int tid_ = opq(threadIdx.x); const int lane = tid_ & 63, w = tid_ >> 6;
  int lr = it * 4 + w;
  int mix = lane >> 5, cm = (lane * 16) & 511;
  const u16* O = (const u16*)(p.ws + (mix ? O_OC : O_OB));
  u16* z = (u16*)(p.ws + O_Z);
  float ov[16], ss = 0.f;
#pragma unroll
  for (int k2 = 0; k2 < 2; ++k2) {
    uint4 a = *(const uint4*)(O + (size_t)lr * 512 + cm + 8 * k2);
    uint4 b = *(const uint4*)(O + ((size_t)GR + lr) * 512 + cm + 8 * k2);
    unsigned aa[4] = {a.x, a.y, a.z, a.w}, bb[4] = {b.x, b.y, b.z, b.w};
#pragma unroll
    for (int q = 0; q < 4; ++q) {
      float v0 = bf2f((u16)(aa[q] & 0xffff)) + bf2f((u16)(bb[q] & 0xffff));
      float v1 = bf2f((u16)(aa[q] >> 16)) + bf2f((u16)(bb[q] >> 16));
      ov[k2 * 8 + q * 2] = v0; ov[k2 * 8 + q * 2 + 1] = v1;
      ss += v0 * v0 + v1 * v1;
    }
  }
  ss += __shfl_xor(ss, 1); ss += __shfl_xor(ss, 2); ss += __shfl_xor(ss, 4);
  float rinv = rsqrtf(ss * (1.f / 128.f) + EPS);
  const float* nw = (mix ? p.hg_norm : p.gdn_norm) + l * 128 + (cm & 127);
  u16* gp = z + (size_t)lr * NZ + (mix ? C_GC : C_GB) + cm;
#pragma unroll
  for (int k2 = 0; k2 < 2; ++k2) {
    uint4 gv = *(const uint4*)(gp + 8 * k2);
    unsigned gg[4] = {gv.x, gv.y, gv.z, gv.w}, oo[4];
#pragma unroll
    for (int q = 0; q < 4; ++q) {
      int e = k2 * 8 + q * 2;
      float y0 = ov[e] * rinv * nw[e] * silu(bf2f((u16)(gg[q] & 0xffff)));
      float y1 = ov[e + 1] * rinv * nw[e + 1] * silu(bf2f((u16)(gg[q] >> 16)));
      oo[q] = pk2(y0, y1);
    }
    *(uint4*)(gp + 8 * k2) = make_uint4(oo[0], oo[1], oo[2], oo[3]);
  }
}

#define XB_TMO      128
#define XB_XCNT(j)  (256  + 64 * (j))
#define XB_XSUB(j)  (1280 + 64 * (j))
#define XB_XGEN(j)  (2304 + 64 * (j))
#define XB_TOP      3328
#define XB_TOPGEN   3392
#define XCD_BAR_WORDS 3456
#define XB_SPIN_CAP (1u << 18)
#define LAS __attribute__((address_space(3)))

__device__ __forceinline__ unsigned xb_ld(unsigned* p)              { return __hip_atomic_load(p, __ATOMIC_RELAXED, __HIP_MEMORY_SCOPE_AGENT); }
__device__ __forceinline__ unsigned xb_add(unsigned* p, unsigned v) { return __hip_atomic_fetch_add(p, v, __ATOMIC_RELAXED, __HIP_MEMORY_SCOPE_AGENT); }
__device__ __forceinline__ unsigned xb_xcc_id() { return (unsigned)__builtin_amdgcn_s_getreg((3 << 11) | 20) & 0xFu; }
#define XB_SPIN(cond, bar) do { unsigned _sp = 0; while (cond) { __builtin_amdgcn_s_sleep(1); \
    if ((++_sp & 255u) == 0u) { if (xb_ld(&(bar)[XB_TMO])) break; if (_sp > XB_SPIN_CAP) { atomicAdd(&(bar)[XB_TMO], 1u); break; } } } } while (0)

struct XcdBarrier {
    unsigned* bar; unsigned x;
    volatile LAS unsigned* st;
};

__device__ __forceinline__ XcdBarrier xcd_barrier_post(unsigned* bar, volatile LAS unsigned* st) {
    XcdBarrier b; b.bar = bar; b.x = xb_xcc_id(); b.st = st;
    if (threadIdx.x == 0) (void)xb_add(&bar[XB_XCNT(b.x)], 1u);
    return b;
}
__device__ __forceinline__ void xcd_barrier_complete(unsigned* bar, unsigned x, unsigned& nloc, unsigned& nx) {
    const unsigned G = gridDim.x * gridDim.y * gridDim.z;
    unsigned sum, cnt, mine, sp = 0u;
    for (;;) {
        sum = 0u; cnt = 0u; mine = 0u;
#pragma unroll
        for (unsigned j = 0; j < 16; ++j) { const unsigned c = xb_ld(&bar[XB_XCNT(j)]); sum += c; cnt += (c > 0u) ? 1u : 0u; mine = (j == x) ? c : mine; }
        if (sum == G) break;
        __builtin_amdgcn_s_sleep(1);
        if ((++sp & 255u) == 0u) { if (xb_ld(&bar[XB_TMO])) break; if (sp > XB_SPIN_CAP) { atomicAdd(&bar[XB_TMO], 1u); break; } }
    }
    nloc = mine > 0u ? mine : 1u; nx = cnt > 0u ? cnt : 1u;
}

__device__ __forceinline__ void xcd_barrier(const XcdBarrier& b) {
    asm volatile("s_waitcnt vmcnt(0)" ::: "memory");
    __syncthreads();
    if (threadIdx.x == 0) {
        unsigned* bar = b.bar;
        __builtin_amdgcn_s_waitcnt(0);
        unsigned nloc = b.st[0], nx = b.st[1];
        if (nloc == 0u) { xcd_barrier_complete(bar, b.x, nloc, nx); b.st[0] = nloc; b.st[1] = nx; }
        const unsigned old = xb_add(&bar[XB_XSUB(b.x)], 1u);
        const unsigned gen = old / nloc;
        if (old + 1u == (gen + 1u) * nloc) {
            __builtin_amdgcn_fence(__ATOMIC_RELEASE, "agent");
            asm volatile("s_waitcnt vmcnt(0)" ::: "memory");
            const unsigned og = xb_add(&bar[XB_TOP], 1u);
            const unsigned tg = og / nx;
            if (og + 1u == (tg + 1u) * nx) xb_add(&bar[XB_TOPGEN], 1u);
            else XB_SPIN(xb_ld(&bar[XB_TOPGEN]) == tg, bar);
            __builtin_amdgcn_fence(__ATOMIC_ACQUIRE, "agent");
            xb_add(&bar[XB_XGEN(b.x)], 1u);
            asm volatile("s_waitcnt vmcnt(0)" ::: "memory");
        } else {
            XB_SPIN(xb_ld(&bar[XB_XGEN(b.x)]) == gen, bar);
            __builtin_amdgcn_fence(__ATOMIC_ACQUIRE, "agent");
            asm volatile("s_waitcnt vmcnt(0)" ::: "memory");
        }
    }
    __syncthreads();
}


#ifdef NO_G0
#define XG0(x)
#else
#define XG0(x) x
#endif
#ifdef NO_G1
#define XG1(x)
#else
#define XG1(x) x
#endif
#ifdef NO_BC
#define XBC(x)
#else
#define XBC(x) x
#endif
#ifdef NO_AC
#define XAC(x)
#else
#define XAC(x) x
#endif
#ifdef NO_P0
#define XP0(x)
#else
#define XP0(x) x
#endif
#ifdef NO_R
#define XR(x)
#else
#define XR(x) x
#endif
#ifdef NO_BL
#define XBL(x)
#else
#define XBL(x) x
#endif
#ifdef NO_CL
#define XCL(x)
#else
#define XCL(x) x
#endif
#ifdef NO_A0
#define XA0(x)
#else
#define XA0(x) x
#endif
#ifdef NO_A1
#define XA1(x)
#else
#define XA1(x) x
#endif
#ifdef NO_BS
#define XBS(x)
#else
#define XBS(x) x
#endif
#ifdef NO_CS
#define XCS(x)
#else
#define XCS(x) x
#endif
__global__ void __launch_bounds__(256, 2) fwd_mega(P p) {
  extern __shared__ __attribute__((aligned(16))) char smem[];
  cg::grid_group grid = cg::this_grid();
  const int G = gridDim.x;
  __shared__ uint4 xb_words;
  if (threadIdx.x == 0) xb_words = make_uint4(0u, 0u, 0u, 0u);
  __syncthreads();
  XcdBarrier xb = xcd_barrier_post((unsigned*)(p.ws + O_BAR), (volatile LAS unsigned*)&xb_words);
  XP0(phase0(p, smem));
  grid.sync();
  u16* z = (u16*)(p.ws + O_Z);
  u16* zT = (u16*)(p.ws + O_ZT);
  float* ab = (float*)(p.ws + O_AB);
  float* o = (float*)(p.ws + O_BSH);
  const u16* u = (const u16*)(p.ws + O_BIT);
  for (int g = 0; g < NG; ++g) {
    XR(phaseR(p, g, 0));
    xcd_barrier(xb);
    for (int l = 0; l < DEPTH; ++l) {
      for (int rep = 0; rep < REP_G; ++rep) {
        const u16* Bt = (const u16*)(p.ws + O_WTIN) + (size_t)l * NZ * 1024;
        for (int t = blockIdx.x; t < 72 * 45; t += G) { XG0(gemm_tile<0>(u, 1024, Bt, 1024, t % 72, t / 72, z, zT, ab, o, smem)); }
      }
      xcd_barrier(xb);
      for (int rep2 = 0; rep2 < REP_M; ++rep2) {
      for (int rep3 = 0; rep3 < REP_A; ++rep3) {
        if (rep3) xcd_barrier(xb);
        const int nb = NCH * 4, nc = NCH * 4, na = NCH * 8;
        for (int t = blockIdx.x; t < nb + nc + na; t += G) {
          if (t < nb) { XBL(b_local(p, l, t, smem)); }
          else if (t < nb + nc) { XCL(c_local(p, l, t - nb, smem)); }
          else { XA0(a_item(p, l, t - nb - nc, 0, smem)); }
        }
      }
      xcd_barrier(xb);
      {
        const int nb = 128, nc = 128, na = 16;
        for (int t = blockIdx.x; t < nb + nc + na; t += G) {
          if (t < nb) { XBS(b_seq2(p, t, smem)); }
          else if (t < nb + nc) { XCS(c_seq2(p, t - nb, smem)); }
          else { XAC(a_carry(p, t - nb - nc)); }
        }
      }
      xcd_barrier(xb);
      }
      {
        const int na = NCH * 8, nm = GR / 4;
        for (int t = blockIdx.x; t < na + nm; t += G) {
          if (t < na) { XA1(a_item(p, l, t, 1, smem)); }
          else { XBC(bc_merge(p, l, t - na)); }
        }
      }
      xcd_barrier(xb);
      for (int rep = 0; rep < REP_G; ++rep) {
        const u16* Bt = (const u16*)(p.ws + O_WTOUT) + (size_t)l * 1024 * 1536;
        for (int t = blockIdx.x; t < 72 * 8; t += G) { XG1(gemm_tile<1>(z + C_GA, NZ, Bt, 1536, t % 72, t / 72, z, zT, ab, o, smem)); }
      }
      xcd_barrier(xb);
      XR(phaseR(p, g, l + 1));
      xcd_barrier(xb);
    }
  }
}

extern "C" void kernel_launch(void* const* d_in, const int* in_sizes, int n_in, void* d_out, int out_size, void* d_ws,
                              size_t ws_size, hipStream_t stream) {
  static int grid_blocks = 0;
  if (!grid_blocks) {
    int dev = 0, cus = 0, per_cu = 0;
    hipGetDevice(&dev);
    hipDeviceGetAttribute(&cus, hipDeviceAttributeMultiprocessorCount, dev);
    hipFuncSetAttribute((const void*)fwd_mega, hipFuncAttributeMaxDynamicSharedMemorySize, LDS_BYTES);
    hipOccupancyMaxActiveBlocksPerMultiprocessor(&per_cu, fwd_mega, 256, LDS_BYTES);
    if (per_cu > 2) per_cu = 2;
    if (per_cu < 1) per_cu = 1;
    grid_blocks = cus * per_cu;
  }
  if (ws_size < WS_TOTAL) {
    fprintf(stderr, "workspace too small: %zu < %zu\n", ws_size, (size_t)WS_TOTAL);
    return;
  }
  P p{};
  const float** f = (const float**)&p;
  for (int i = 0; i < 23; ++i) f[i] = (const float*)d_in[i];
  p.out = (float*)d_out;
  p.ws = (char*)d_ws;
  hipMemsetAsync((char*)d_ws + O_BAR, 0, XCD_BAR_WORDS * 4, stream);
  void* args[] = {&p};
  hipError_t e = hipLaunchCooperativeKernel((void*)fwd_mega, dim3(grid_blocks), dim3(256), args, LDS_BYTES, stream);
  if (e != hipSuccess) fprintf(stderr, "cooperative launch failed: %s (grid %d)\n", hipGetErrorString(e), grid_blocks);
}
```

```cpp
#include <hip/hip_runtime.h>
#include <hip/hip_cooperative_groups.h>
#include <cstdio>
namespace cg = cooperative_groups;

typedef __attribute__((ext_vector_type(8))) short bf16x8;
typedef __attribute__((ext_vector_type(4))) float f32x4;
typedef unsigned short u16;
#define DEV __device__ __forceinline__

constexpr int DM = 1024, TL = 2048, TCX = 256, TS = 2304, GB = 4, GR = GB * TS, NG = 2;
constexpr int NZ = 5760, DEPTH = 4;
constexpr int C_XA = 0, C_Q = 512, C_K = 1024, C_V = 1536, C_QC = 2048, C_F0 = 2560, C_IC = 3584,
              C_GA = 4096, C_GB = 4608, C_GC = 5120, C_AB = 5632;
constexpr int NCH = GR / 64;
constexpr float EPS = 1e-6f;
constexpr int WPB = 2;

constexpr size_t al256(size_t x) { return (x + 255) & ~(size_t)255; }
constexpr size_t O_WTIN = 0;
constexpr size_t O_WTOUT = O_WTIN + al256((size_t)DEPTH * NZ * 1024 * 2);
constexpr size_t O_WGT = O_WTOUT + al256((size_t)DEPTH * 1024 * 1536 * 2);
constexpr size_t O_MOD = O_WGT + al256((size_t)DEPTH * 2 * 2 * 8 * 4096 * 2);
constexpr size_t O_LBS = O_MOD + al256((size_t)DEPTH * 9 * 3072 * 4);
constexpr size_t O_HC = O_LBS + al256((size_t)DEPTH * 1024 * 4);
constexpr size_t O_Z = O_HC + al256((size_t)GB * TCX * 1024 * 4);
constexpr size_t O_ZT = O_Z + al256((size_t)GR * NZ * 2);
constexpr size_t O_AB = O_ZT + al256((size_t)512 * GR * 2);
constexpr size_t O_BSH = O_AB + al256((size_t)GR * 16 * 4);
constexpr size_t BSH_ONE = (size_t)GR * 512 * 2;
constexpr size_t O_BIT = O_BSH + al256(4 * BSH_ONE);
constexpr size_t BIT_SZ = 17408;
constexpr size_t O_CREC = O_BIT + al256((size_t)NCH * 4 * 2 * BIT_SZ);
constexpr size_t CREC_SZ = 33280;
constexpr size_t O_OB = O_CREC + al256((size_t)NCH * 4 * 2 * CREC_SZ);
constexpr size_t O_OC = O_OB + al256((size_t)2 * GR * 512 * 2);
constexpr size_t O_AP = O_OC + al256((size_t)2 * GR * 512 * 2);
constexpr size_t O_AH = O_AP + al256((size_t)NCH * 2 * 512 * 4);
constexpr size_t O_ACAR = O_AH + al256((size_t)NCH * 2 * 512 * 4);
constexpr size_t O_BAR = O_ACAR + al256((size_t)NCH * 2 * 512 * 4);
constexpr size_t WS_TOTAL = O_BAR + al256(3456 * 4);

constexpr int LDS_BYTES = 69632;
#ifndef REP_A
#define REP_A 1
#endif
#ifndef REP_G
#define REP_G 1
#endif
#ifndef REP_M
#define REP_M 1
#endif

struct P {
  const float *x, *c, *ctx, *c_ctx, *w_ada, *b_ada, *norm_pre, *norm_post, *w_in, *conv_a_w, *conv_a_b, *rg_w_r,
      *rg_b_r, *rg_w_i, *rg_b_i, *rg_lam, *conv_b_w, *gdn_a_log, *gdn_dt_bias, *gdn_norm, *hg_lb, *hg_norm, *w_out;
  float* out;
  char* ws;
};

DEV int opq(int x) { asm volatile("" : "+v"(x)); return x; }
DEV int opqs(int x) { asm volatile("" : "+s"(x)); return x; }
DEV u16 f2bf(float f) {
  unsigned u = __float_as_uint(f);
  u += 0x7fffu + ((u >> 16) & 1u);
  return (u16)(u >> 16);
}
DEV float bf2f(u16 h) { return __uint_as_float(((unsigned)h) << 16); }
DEV unsigned pk2(float a, float b) { return (unsigned)f2bf(a) | ((unsigned)f2bf(b) << 16); }
DEV float sigm(float x) { return 1.f / (1.f + __expf(-x)); }
DEV float silu(float x) { return x / (1.f + __expf(-x)); }
DEV float softplus(float x) { return x > 20.f ? x : log1pf(__expf(x)); }
DEV f32x4 mfma(bf16x8 a, bf16x8 b, f32x4 c) { return __builtin_amdgcn_mfma_f32_16x16x32_bf16(a, b, c, 0, 0, 0); }
DEV bf16x8 ld8(const u16* p) { return *reinterpret_cast<const bf16x8*>(p); }
DEV int lat_map(int l, int t) { return (l & 1) ? ((t & 63) * 32 + (t >> 6)) : t; }
DEV int orig_col(int n) {
  if (n < 512) return n;
  if (n < 2048) return n + 512;
  if (n < 4096) return n + 1040;
  if (n < 4608) return n - 4096 + 512;
  if (n < 5120) return n - 4608 + 2576;
  if (n < 5632) return n + 16;
  if (n < 5648) return n - 5632 + 2560;
  return -1;
}
DEV float zval(const u16* z, int rb, int cp, int n, int col) {
  if (cp < 0 && (n == 0 || n == 4)) return 0.f;
  if (cp > 63 && (n == 3 || n == 35)) return 0.f;
  return bf2f(z[(size_t)(rb + cp) * NZ + col]);
}

DEV void ph0_ada(const P& p, int item, char* smem) {
  float* sc = (float*)smem;
  for (int i = threadIdx.x; i < 9 * 1024; i += 256) {
    int v = i >> 10, d = i & 1023;
    float cv = (v < 8) ? p.c[v * 1024 + d] : p.c_ctx[d];
    sc[i] = silu(cv);
  }
  __syncthreads();
  int col = item * 256 + threadIdx.x;
  int l = col / 3072, e = col % 3072;
  const float* w = p.w_ada + (size_t)l * 1024 * 3072 + e;
  float acc[9];
#pragma unroll
  for (int i = 0; i < 9; ++i) acc[i] = 0.f;
  for (int d = 0; d < 1024; d += 4) {
    float w0 = w[(size_t)d * 3072], w1 = w[(size_t)(d + 1) * 3072], w2 = w[(size_t)(d + 2) * 3072],
          w3 = w[(size_t)(d + 3) * 3072];
#pragma unroll
    for (int i = 0; i < 9; ++i)
      acc[i] += sc[i * 1024 + d] * w0 + sc[i * 1024 + d + 1] * w1 + sc[i * 1024 + d + 2] * w2 +
                sc[i * 1024 + d + 3] * w3;
  }
  float* mod = (float*)(p.ws + O_MOD);
  float bb = p.b_ada[l * 3072 + e];
#pragma unroll
  for (int i = 0; i < 9; ++i) mod[((size_t)l * 9 + i) * 3072 + e] = acc[i] + bb;
  __syncthreads();
}
DEV void tconv_tile(const float* src, int lds_, u16* dst, int ldd, int k0, int n0, bool mapcol, char* smem) {
  float* t = (float*)smem;
  for (int i = threadIdx.x; i < 4096; i += 256) {
    int kk = i >> 6, nn = i & 63;
    int n = n0 + nn;
    int sn = mapcol ? orig_col(n) : n;
    t[kk * 65 + nn] = (sn >= 0) ? src[(size_t)(k0 + kk) * lds_ + sn] : 0.f;
  }
  __syncthreads();
  for (int i = threadIdx.x; i < 4096; i += 256) {
    int nn = i >> 6, kk = i & 63;
    dst[(size_t)(n0 + nn) * ldd + k0 + kk] = f2bf(t[kk * 65 + nn]);
  }
  __syncthreads();
}
DEV void phase0(const P& p, char* smem) {
  const int n_ada = 48, n_in = DEPTH * 16 * 90, n_out = DEPTH * 24 * 16, n_g = 128, n_lb = 4;
  const int total = n_ada + n_in + n_out + n_g + n_lb;
  for (int it = blockIdx.x; it < total; it += gridDim.x) {
    int i = it;
    if (i < n_ada) { ph0_ada(p, i, smem); continue; }
    i -= n_ada;
    if (i < n_in) {
      int l = i / 1440, r = i % 1440, kt = r / 90, nt = r % 90;
      tconv_tile(p.w_in + (size_t)l * 1024 * 5648, 5648, (u16*)(p.ws + O_WTIN) + (size_t)l * NZ * 1024, 1024, kt * 64,
                 nt * 64, true, smem);
      continue;
    }
    i -= n_in;
    if (i < n_out) {
      int l = i / 384, r = i % 384, kt = r / 16, nt = r % 16;
      tconv_tile(p.w_out + (size_t)l * 1536 * 1024, 1024, (u16*)(p.ws + O_WTOUT) + (size_t)l * 1024 * 1536, 1536,
                 kt * 64, nt * 64, false, smem);
      continue;
    }
    i -= n_out;
    if (i < n_g) {
      int h = i & 7, gate = (i >> 3) & 1, dir = (i >> 4) & 1, l = i >> 5;
      const float* src = (gate ? p.rg_w_i : p.rg_w_r) + ((size_t)(l * 2 + dir) * 8 + h) * 4096;
      tconv_tile(src, 64, (u16*)(p.ws + O_WGT) + (size_t)i * 4096, 64, 0, 0, false, smem);
      continue;
    }
    i -= n_g;
    {
      int j = i * 256 + threadIdx.x;
      float v[4], mx = -1e30f;
      for (int l = 0; l < 4; ++l) { v[l] = p.hg_lb[l * 1024 + j]; mx = fmaxf(mx, v[l]); }
      float s = 0.f;
      for (int l = 0; l < 4; ++l) { v[l] = __expf(v[l] - mx); s += v[l]; }
      float* lbs = (float*)(p.ws + O_LBS);
      float cum = 0.f;
      for (int l = 0; l < 4; ++l) {
        if (l > 0) cum += v[l] / s;
        lbs[l * 1024 + j] = cum;
      }
    }
  }
}

DEV void phaseR(const P& p, int g, int l) {
  const int tid_ = opq(threadIdx.x); const int lane = tid_ & 63, w = tid_ >> 6;
  const float* mod = (const float*)(p.ws + O_MOD);
  float* hc = (float*)(p.ws + O_HC);
  const float* o = (const float*)(p.ws + O_BSH);
  u16* u = (u16*)(p.ws + O_BIT);
  for (int it = blockIdx.x; it < GR / 4; it += gridDim.x) {
    int lr = it * 4 + w;
    int lb = lr / TS, s = lr % TS;
    bool isctx = s < TCX;
    if (l == DEPTH && isctx) continue;
    int b = g * GB + lb, t = s - TCX;
    int mi = isctx ? 8 : b;
    float* hp = isctx ? hc + ((size_t)lb * TCX + s) * 1024 : p.out + ((size_t)b * TL + t) * 1024;
    float hv[16];
    if (l == 0) {
      const float* src = isctx ? p.ctx + ((size_t)b * TCX + s) * 1024 : p.x + ((size_t)b * TL + t) * 1024;
#pragma unroll
      for (int k = 0; k < 4; ++k) {
        float4 v = *(const float4*)(src + k * 256 + lane * 4);
        hv[k * 4] = v.x; hv[k * 4 + 1] = v.y; hv[k * 4 + 2] = v.z; hv[k * 4 + 3] = v.w;
      }
    } else {
      int orow = lb * TS + (isctx ? s : TCX + lat_map(l - 1, t));
      const float* op = o + (size_t)orow * 1024;
      float ov[16], ss = 0.f;
#pragma unroll
      for (int k = 0; k < 4; ++k) {
        float4 v = *(const float4*)(op + k * 256 + lane * 4);
        ov[k * 4] = v.x; ov[k * 4 + 1] = v.y; ov[k * 4 + 2] = v.z; ov[k * 4 + 3] = v.w;
        ss += v.x * v.x + v.y * v.y + v.z * v.z + v.w * v.w;
      }
#pragma unroll
      for (int off = 32; off; off >>= 1) ss += __shfl_xor(ss, off);
      float rinv = rsqrtf(ss * (1.f / 1024.f) + EPS);
      const float* gate = mod + ((size_t)(l - 1) * 9 + mi) * 3072 + 2048;
      const float* wp = p.norm_post + (l - 1) * 1024;
#pragma unroll
      for (int k = 0; k < 4; ++k) {
        float4 hh = *(const float4*)(hp + k * 256 + lane * 4);
        float4 gg = *(const float4*)(gate + k * 256 + lane * 4);
        float4 ww = *(const float4*)(wp + k * 256 + lane * 4);
        hv[k * 4] = hh.x + gg.x * (ov[k * 4] * rinv * ww.x);
        hv[k * 4 + 1] = hh.y + gg.y * (ov[k * 4 + 1] * rinv * ww.y);
        hv[k * 4 + 2] = hh.z + gg.z * (ov[k * 4 + 2] * rinv * ww.z);
        hv[k * 4 + 3] = hh.w + gg.w * (ov[k * 4 + 3] * rinv * ww.w);
      }
    }
#pragma unroll
    for (int k = 0; k < 4; ++k)
      *(float4*)(hp + k * 256 + lane * 4) = make_float4(hv[k * 4], hv[k * 4 + 1], hv[k * 4 + 2], hv[k * 4 + 3]);
    if (l < DEPTH) {
      float ss = 0.f;
#pragma unroll
      for (int k = 0; k < 16; ++k) ss += hv[k] * hv[k];
#pragma unroll
      for (int off = 32; off; off >>= 1) ss += __shfl_xor(ss, off);
      float rinv = rsqrtf(ss * (1.f / 1024.f) + EPS);
      const float* sh = mod + ((size_t)l * 9 + mi) * 3072;
      const float* wp = p.norm_pre + l * 1024;
      int urow = lb * TS + (isctx ? s : TCX + lat_map(l, t));
      u16* up = u + (size_t)urow * 1024;
#pragma unroll
      for (int k = 0; k < 4; ++k) {
        float4 ww = *(const float4*)(wp + k * 256 + lane * 4);
        float4 s0 = *(const float4*)(sh + k * 256 + lane * 4);
        float4 s1 = *(const float4*)(sh + 1024 + k * 256 + lane * 4);
        float a0 = hv[k * 4] * rinv * ww.x * (1.f + s1.x) + s0.x;
        float a1 = hv[k * 4 + 1] * rinv * ww.y * (1.f + s1.y) + s0.y;
        float a2 = hv[k * 4 + 2] * rinv * ww.z * (1.f + s1.z) + s0.z;
        float a3 = hv[k * 4 + 3] * rinv * ww.w * (1.f + s1.w) + s0.w;
        uint2 pk; pk.x = pk2(a0, a1); pk.y = pk2(a2, a3);
        *(uint2*)(up + k * 256 + lane * 4) = pk;
      }
    }
  }
}

template <int MODE>
DEV void gemm_tile(const u16* __restrict__ A, int lda, const u16* __restrict__ Bt, int K, int rt, int ct, u16* z,
                   u16* zT, float* ab, float* o, char* smem) {
  u16* As = (u16*)smem;
  u16* Bs = As + 128 * 72;
  const int tid = opq(threadIdx.x), lane = tid & 63, w = tid >> 6, wr = w >> 1, wc = w & 1, fr = lane & 15, fq = lane >> 4;
  const int lrow = tid >> 3, lseg = tid & 7;
  const u16* Ag = A + (size_t)(rt * 128 + lrow) * lda + lseg * 8;
  const u16* Bg = Bt + (size_t)(ct * 128 + lrow) * K + lseg * 8;
  uint4 ra0, ra1, ra2, ra3, rb0, rb1, rb2, rb3;
  f32x4 acc[4][4];
#pragma unroll
  for (int i = 0; i < 4; ++i)
#pragma unroll
    for (int j = 0; j < 4; ++j) acc[i][j] = (f32x4){0.f, 0.f, 0.f, 0.f};
#define GLOAD()                                             \
  ra0 = *(const uint4*)(Ag);                                \
  ra1 = *(const uint4*)(Ag + (size_t)32 * lda);             \
  ra2 = *(const uint4*)(Ag + (size_t)64 * lda);             \
  ra3 = *(const uint4*)(Ag + (size_t)96 * lda);             \
  rb0 = *(const uint4*)(Bg);                                \
  rb1 = *(const uint4*)(Bg + (size_t)32 * K);               \
  rb2 = *(const uint4*)(Bg + (size_t)64 * K);               \
  rb3 = *(const uint4*)(Bg + (size_t)96 * K);
  GLOAD();
  const int nk = K / 64;
  for (int kt = 0; kt < nk; ++kt) {
    __syncthreads();
    *(uint4*)(As + (lrow)*72 + lseg * 8) = ra0;
    *(uint4*)(As + (lrow + 32) * 72 + lseg * 8) = ra1;
    *(uint4*)(As + (lrow + 64) * 72 + lseg * 8) = ra2;
    *(uint4*)(As + (lrow + 96) * 72 + lseg * 8) = ra3;
    *(uint4*)(Bs + (lrow)*72 + lseg * 8) = rb0;
    *(uint4*)(Bs + (lrow + 32) * 72 + lseg * 8) = rb1;
    *(uint4*)(Bs + (lrow + 64) * 72 + lseg * 8) = rb2;
    *(uint4*)(Bs + (lrow + 96) * 72 + lseg * 8) = rb3;
    __syncthreads();
    if (kt + 1 < nk) {
      Ag += 64; Bg += 64;
      GLOAD();
    }
#pragma unroll
    for (int ks = 0; ks < 2; ++ks) {
      bf16x8 af[4], bfr[4];
#pragma unroll
      for (int mi = 0; mi < 4; ++mi) af[mi] = ld8(As + (wr * 64 + mi * 16 + fr) * 72 + ks * 32 + fq * 8);
#pragma unroll
      for (int ni = 0; ni < 4; ++ni) bfr[ni] = ld8(Bs + (wc * 64 + ni * 16 + fr) * 72 + ks * 32 + fq * 8);
#pragma unroll
      for (int mi = 0; mi < 4; ++mi)
#pragma unroll
        for (int ni = 0; ni < 4; ++ni) acc[mi][ni] = mfma(af[mi], bfr[ni], acc[mi][ni]);
    }
  }
#pragma unroll
  for (int mi = 0; mi < 4; ++mi)
#pragma unroll
    for (int ni = 0; ni < 4; ++ni) {
      int row0 = rt * 128 + wr * 64 + mi * 16 + fq * 4;
      int col = ct * 128 + wc * 64 + ni * 16 + fr;
      f32x4 v = acc[mi][ni];
      if (MODE == 1) {
#pragma unroll
        for (int r = 0; r < 4; ++r) o[(size_t)(row0 + r) * 1024 + col] = v[r];
      } else {
        if (ct >= 28 && ct < 32) {
          uint2 pk; pk.x = pk2(v[0], v[1]); pk.y = pk2(v[2], v[3]);
          *(uint2*)(zT + (size_t)(col - C_IC) * GR + row0) = pk;
        } else if (ct == 44) {
          if (col - C_AB < 16) {
#pragma unroll
            for (int r = 0; r < 4; ++r) ab[(size_t)(row0 + r) * 16 + (col - C_AB)] = v[r];
          }
        } else {
#pragma unroll
          for (int r = 0; r < 4; ++r) z[(size_t)(row0 + r) * NZ + col] = f2bf(v[r]);
        }
      }
    }
}

DEV void a_item(const P& p, int l, int item, int mode, char* smem) {
  float* xc = (float*)smem;
  u16* xcb = (u16*)(smem + 16384);
  float* av = (float*)(smem + 16384 + 9216);
  float* uv = av + 4096;
  float* segP = uv + 4096;
  float* segH = segP + 256;
  const int tid = opq(threadIdx.x), lane = tid & 63, w = tid >> 6, fr = lane & 15, fq = lane >> 4;
  const int cgk = item >> 3, hA = item & 7, n = cgk % 36, rb = cgk * 64;
  u16* z = (u16*)(p.ws + O_Z);
  for (int idx = tid; idx < 4096; idx += 256) {
    int c = idx >> 6, j = idx & 63, ch = hA * 64 + j;
    float val = p.conv_a_b[l * 512 + ch];
#pragma unroll
    for (int tap = 0; tap < 4; ++tap) val += p.conv_a_w[(l * 4 + tap) * 512 + ch] * zval(z, rb, c + tap - 2, n, C_XA + ch);
    xc[idx] = val;
    xcb[c * 72 + j] = f2bf(val);
  }
  __syncthreads();
  float yacc[16];
#pragma unroll
  for (int k = 0; k < 16; ++k) yacc[k] = 0.f;
  const int seg = tid >> 6, sj = tid & 63, sch = hA * 64 + sj;
  for (int dir = 0; dir < 2; ++dir) {
    {
      const u16* wg = (const u16*)(p.ws + O_WGT);
      const u16* wr_ = wg + (size_t)((((l * 2 + dir) * 2 + 0) * 8 + hA)) * 4096;
      const u16* wi_ = wg + (size_t)((((l * 2 + dir) * 2 + 1) * 8 + hA)) * 4096;
      bf16x8 a0 = ld8(xcb + (16 * w + fr) * 72 + fq * 8), a1 = ld8(xcb + (16 * w + fr) * 72 + 32 + fq * 8);
#pragma unroll
      for (int nt = 0; nt < 4; ++nt) {
        f32x4 ar = {0.f, 0.f, 0.f, 0.f}, ai = {0.f, 0.f, 0.f, 0.f};
        const u16* br = wr_ + (nt * 16 + fr) * 64 + fq * 8;
        const u16* bi = wi_ + (nt * 16 + fr) * 64 + fq * 8;
        ar = mfma(a0, ld8(br), ar); ar = mfma(a1, ld8(br + 32), ar);
        ai = mfma(a0, ld8(bi), ai); ai = mfma(a1, ld8(bi + 32), ai);
        int j = nt * 16 + fr, ch = hA * 64 + j;
        float brv = p.rg_b_r[(l * 2 + dir) * 512 + ch], biv = p.rg_b_i[(l * 2 + dir) * 512 + ch];
        float sp = softplus(-p.rg_lam[(l * 2 + dir) * 512 + ch]);
#pragma unroll
        for (int r = 0; r < 4; ++r) {
          int c = 16 * w + 4 * fq + r;
          float rg = sigm(ar[r] + brv), ig = sigm(ai[r] + biv);
          float la = -8.f * rg * sp;
          float a = __expf(la);
          float uu = sqrtf(fmaxf(-expm1f(2.f * la), 0.f)) * (ig * xc[c * 64 + j]);
          av[c * 64 + j] = a;
          uv[c * 64 + j] = uu;
        }
      }
    }
    __syncthreads();
    {
      float Pp = 1.f, H = 0.f;
#pragma unroll
      for (int k = 0; k < 16; ++k) {
        int c = dir ? (16 * seg + 15 - k) : (16 * seg + k);
        float a = av[c * 64 + sj];
        H = a * H + uv[c * 64 + sj];
        Pp *= a;
      }
      segP[seg * 64 + sj] = Pp;
      segH[seg * 64 + sj] = H;
    }
    __syncthreads();
    if (mode == 0) {
      if (seg == 0) {
        float Pc = 1.f, Hc = 0.f;
        for (int q = 0; q < 4; ++q) {
          int sg = dir ? 3 - q : q;
          Hc = segP[sg * 64 + sj] * Hc + segH[sg * 64 + sj];
          Pc *= segP[sg * 64 + sj];
        }
        size_t idx = ((size_t)cgk * 2 + dir) * 512 + sch;
        ((float*)(p.ws + O_AP))[idx] = Pc;
        ((float*)(p.ws + O_AH))[idx] = Hc;
      }
    } else {
      float st = ((const float*)(p.ws + O_ACAR))[((size_t)cgk * 2 + dir) * 512 + sch];
      int nbefore = dir ? 3 - seg : seg;
      for (int q = 0; q < nbefore; ++q) {
        int sg = dir ? 3 - q : q;
        st = segP[sg * 64 + sj] * st + segH[sg * 64 + sj];
      }
      if (dir == 0) {
#pragma unroll
        for (int k = 0; k < 16; ++k) {
          int c = 16 * seg + k;
          st = av[c * 64 + sj] * st + uv[c * 64 + sj];
          yacc[k] += st;
        }
      } else {
#pragma unroll
        for (int k = 15; k >= 0; --k) {
          int c = 16 * seg + k;
          st = av[c * 64 + sj] * st + uv[c * 64 + sj];
          yacc[k] += st;
        }
      }
    }
    __syncthreads();
  }
  if (mode == 1) {
#pragma unroll
    for (int k = 0; k < 16; ++k) {
      size_t zi = (size_t)(rb + 16 * seg + k) * NZ + C_GA + sch;
      float gate = bf2f(z[zi]);
      z[zi] = f2bf(yacc[k] * silu(gate));
    }
  }
}

DEV void a_carry(const P& p, int item) {
  int t = item * 256 + threadIdx.x;
  int ch = t & 511, dir = (t >> 9) & 1, lb = t >> 10;
  const float* AP = (const float*)(p.ws + O_AP);
  const float* AH = (const float*)(p.ws + O_AH);
  float* AC = (float*)(p.ws + O_ACAR);
  float st = 0.f;
  for (int j = 0; j < 36; ++j) {
    int n = dir ? (j < 4 ? 3 - j : 39 - j) : j;
    size_t idx = ((size_t)(lb * 36 + n) * 2 + dir) * 512 + ch;
    AC[idx] = st;
    st = AP[idx] * st + AH[idx];
  }
}

DEV void b_local(const P& p, int l, int item, char* smem) {
  u16* qs = (u16*)smem;
  u16* ks = qs + 64 * 136;
  float* Am = (float*)(smem + 34816);
  float* gc = (float*)(smem + 34816 + 32768);
  float* bt = gc + 128;
  const int tid = opq(threadIdx.x), lane = tid & 63, w = tid >> 6, fr = lane & 15, fq = lane >> 4;
  const int cgk = item >> 2, h = item & 3, n = cgk % 36, rb = cgk * 64;
  const u16* z = (const u16*)(p.ws + O_Z);
  u16* qn = (u16*)(p.ws + O_BSH);
  u16* kn = qn + (size_t)GR * 512;
  u16* vb = kn + (size_t)GR * 512;
  u16* knT = vb + (size_t)GR * 512;
  const float* ab = (const float*)(p.ws + O_AB);
  {
    u16* Tt = (u16*)Am;
    uint4 st[5];
#define BL_TLOAD(which)                                                                                  \
  _Pragma("unroll") for (int k = 0; k < 5; ++k) {                                                        \
    int idx = tid + 256 * k, row = idx >> 4, seg = idx & 15, cp = row - 2;                               \
    bool ok = (idx < 1072) && !((cp < 0 && (n == 0 || n == 4)) || (cp > 63 && (n == 3 || n == 35)));    \
    st[k] = make_uint4(0u, 0u, 0u, 0u);                                                                  \
    if (ok) st[k] = *(const uint4*)(z + (size_t)(rb + cp) * NZ + C_Q + (which)*512 + h * 128 + seg * 8); \
  }
    BL_TLOAD(0)
#pragma unroll
    for (int which = 0; which < 3; ++which) {
#pragma unroll
      for (int k = 0; k < 5; ++k) {
        int idx = tid + 256 * k, row = idx >> 4, seg = idx & 15;
        if (idx < 1072) *(uint4*)(Tt + row * 136 + seg * 8) = st[k];
      }
      __syncthreads();
      if (which < 2) { BL_TLOAD(which + 1) }
      float cw[2][4];
#pragma unroll
      for (int hh = 0; hh < 2; ++hh)
#pragma unroll
        for (int tap = 0; tap < 4; ++tap)
          cw[hh][tap] = p.conv_b_w[(size_t)(l * 4 + tap) * 1536 + which * 512 + h * 128 + lane + 64 * hh];
      for (int c = w; c < 64; c += 4) {
        float v[2];
#pragma unroll
        for (int hh = 0; hh < 2; ++hh) {
          int d = lane + 64 * hh;
          float a = 0.f;
#pragma unroll
          for (int tap = 0; tap < 4; ++tap) a += cw[hh][tap] * bf2f(Tt[(c + tap) * 136 + d]);
          v[hh] = silu(a);
        }
        float rs = 1.f;
        if (which < 2) {
          float sq = v[0] * v[0] + v[1] * v[1];
#pragma unroll
          for (int off = 32; off; off >>= 1) sq += __shfl_xor(sq, off);
          rs = rsqrtf(sq + EPS) * (which == 0 ? 0.08838834764831845f : 1.f);
        }
#pragma unroll
        for (int hh = 0; hh < 2; ++hh) {
          int d = lane + 64 * hh;
          u16 ob = f2bf(v[hh] * rs);
          size_t gi = (size_t)(rb + c) * 512 + h * 128 + d;
          if (which == 0) { qs[c * 136 + d] = ob; qn[gi] = ob; }
          else if (which == 1) { ks[c * 136 + d] = ob; kn[gi] = ob; }
          else vb[gi] = ob;
        }
      }
      __syncthreads();
    }
  }
  if (w < 2) {
    int dir = w, i = lane, c = dir ? 63 - i : i;
    float al = ab[(size_t)(rb + c) * 16 + dir * 4 + h], bl = ab[(size_t)(rb + c) * 16 + 8 + dir * 4 + h];
    float g = -__expf(p.gdn_a_log[(l * 2 + dir) * 4 + h]) * softplus(al + p.gdn_dt_bias[(l * 2 + dir) * 4 + h]);
#pragma unroll
    for (int off = 1; off < 64; off <<= 1) {
      float v = __shfl_up(g, off);
      if (lane >= off) g += v;
    }
    gc[dir * 64 + i] = g;
    bt[dir * 64 + i] = sigm(bl);
  }
  __syncthreads();
  for (int idx = tid; idx < 1024; idx += 256) {
    int d = idx >> 3, c8 = idx & 7;
    uint4 pk;
    pk.x = (unsigned)ks[(c8 * 8 + 0) * 136 + d] | ((unsigned)ks[(c8 * 8 + 1) * 136 + d] << 16);
    pk.y = (unsigned)ks[(c8 * 8 + 2) * 136 + d] | ((unsigned)ks[(c8 * 8 + 3) * 136 + d] << 16);
    pk.z = (unsigned)ks[(c8 * 8 + 4) * 136 + d] | ((unsigned)ks[(c8 * 8 + 5) * 136 + d] << 16);
    pk.w = (unsigned)ks[(c8 * 8 + 6) * 136 + d] | ((unsigned)ks[(c8 * 8 + 7) * 136 + d] << 16);
    *(uint4*)(knT + ((size_t)(cgk * 4 + h) * 128 + d) * 64 + c8 * 8) = pk;
  }
  for (int dir = 0; dir < 2; ++dir) {
    char* rec = p.ws + O_BIT + ((size_t)(cgk * 4 + h) * 2 + dir) * BIT_SZ;
    u16* QKm = (u16*)rec + 4096;
    float* scal = (float*)(rec + 16384);
    int irow = 16 * w + fr, ci = dir ? 63 - irow : irow;
    bf16x8 ak[4], aq[4];
#pragma unroll
    for (int s = 0; s < 4; ++s) { ak[s] = ld8(ks + ci * 136 + 32 * s + 8 * fq); aq[s] = ld8(qs + ci * 136 + 32 * s + 8 * fq); }
#pragma unroll
    for (int nt = 0; nt < 4; ++nt) {
      int jcol = 16 * nt + fr, cj = dir ? 63 - jcol : jcol;
      f32x4 kk = {0.f, 0.f, 0.f, 0.f}, qk = {0.f, 0.f, 0.f, 0.f};
#pragma unroll
      for (int s = 0; s < 4; ++s) {
        bf16x8 b = ld8(ks + cj * 136 + 32 * s + 8 * fq);
        kk = mfma(ak[s], b, kk);
        qk = mfma(aq[s], b, qk);
      }
      float gj = gc[dir * 64 + jcol];
#pragma unroll
      for (int r = 0; r < 4; ++r) {
        int i = 16 * w + 4 * fq + r;
        float dec = (jcol <= i) ? __expf(gc[dir * 64 + i] - gj) : 0.f;
        Am[(dir * 64 + i) * 64 + jcol] = (jcol < i) ? bt[dir * 64 + i] * kk[r] * dec : 0.f;
        QKm[i * 64 + jcol] = f2bf(qk[r] * dec);
      }
    }
    if (tid < 64) {
      float gl = gc[dir * 64 + 63], gi = gc[dir * 64 + tid];
      scal[tid] = __expf(gi);
      scal[64 + tid] = bt[dir * 64 + tid];
      scal[128 + tid] = __expf(gl - gi);
      if (tid == 0) scal[192] = __expf(gl);
    }
  }
  __syncthreads();
  if (w < 2) {
    int dir = w, col = lane;
    u16* Tinv = (u16*)(p.ws + O_BIT + ((size_t)(cgk * 4 + h) * 2 + dir) * BIT_SZ);
    const float* Ad = Am + dir * 4096;
    float T[64];
#pragma unroll
    for (int i = 0; i < 64; ++i) {
      float s = (i == col) ? 1.f : 0.f;
#pragma unroll
      for (int j = 0; j < i; ++j) s -= Ad[i * 64 + j] * T[j];
      T[i] = s;
      Tinv[i * 64 + col] = f2bf(s);
      __builtin_amdgcn_sched_barrier(0);
    }
  }
  __syncthreads();
}

DEV void b_seq(const P& p, int bitem, char* smem) {
  const int tid = opq(threadIdx.x), lane = tid & 63, w = tid >> 6, fr = lane & 15, fq = lane >> 4;
  const bool active = w < WPB;
  const int item = bitem * WPB + (active ? w : 0);
  const int slice = item & 7, dir = (item >> 3) & 1, h = (item >> 4) & 3, lb = item >> 6, e0 = slice * 16;
  u16* Ss = (u16*)(smem + w * 11264);
  u16* Rs = Ss + 16 * 136;
  u16* Vsc = Rs + 16 * 72;
  u16* Vor = Vsc + 16 * 72;
  const u16* qn = (const u16*)(p.ws + O_BSH);
  const u16* kn = qn + (size_t)GR * 512;
  const u16* vb = kn + (size_t)GR * 512;
  const u16* knT = vb + (size_t)GR * 512;
  u16* OB = (u16*)(p.ws + O_OB);
  f32x4 S[8];
#pragma unroll
  for (int m = 0; m < 8; ++m) S[m] = (f32x4){0.f, 0.f, 0.f, 0.f};
  for (int j = 0; j < 36; ++j) {
    const int n = dir ? (j < 4 ? 3 - j : 39 - j) : j;
    const int cgk = lb * 36 + n, rb = cgk * 64;
    const char* rec = p.ws + O_BIT + ((size_t)(cgk * 4 + h) * 2 + dir) * BIT_SZ;
    const u16* Tinv = (const u16*)rec;
    const u16* QKm = Tinv + 4096;
    const float* scal = (const float*)(rec + 16384);
    if (active) {
#pragma unroll
      for (int m = 0; m < 8; ++m) {
        uint2 pk; pk.x = pk2(S[m][0], S[m][1]); pk.y = pk2(S[m][2], S[m][3]);
        *(uint2*)(Ss + fr * 136 + 16 * m + 4 * fq) = pk;
      }
    }
    __syncthreads();
    bf16x8 Sf[4];
    if (active) {
#pragma unroll
      for (int s = 0; s < 4; ++s) Sf[s] = ld8(Ss + fr * 136 + 32 * s + 8 * fq);
#pragma unroll
      for (int m = 0; m < 4; ++m) {
        int i = 16 * m + fr, rowi = rb + (dir ? 63 - i : i);
        f32x4 X = {0.f, 0.f, 0.f, 0.f};
#pragma unroll
        for (int s = 0; s < 4; ++s) X = mfma(ld8(kn + (size_t)rowi * 512 + h * 128 + 32 * s + 8 * fq), Sf[s], X);
        float rv[4];
#pragma unroll
        for (int r = 0; r < 4; ++r) {
          int ii = 16 * m + 4 * fq + r, rowr = rb + (dir ? 63 - ii : ii);
          float v = bf2f(vb[(size_t)rowr * 512 + h * 128 + e0 + fr]);
          rv[r] = scal[64 + ii] * (v - scal[ii] * X[r]);
        }
        uint2 pk; pk.x = pk2(rv[0], rv[1]); pk.y = pk2(rv[2], rv[3]);
        *(uint2*)(Rs + fr * 72 + 16 * m + 4 * fq) = pk;
      }
    }
    __syncthreads();
    if (active) {
      bf16x8 Rf0 = ld8(Rs + fr * 72 + 8 * fq), Rf1 = ld8(Rs + fr * 72 + 32 + 8 * fq);
#pragma unroll
      for (int m = 0; m < 4; ++m) {
        f32x4 VN = {0.f, 0.f, 0.f, 0.f};
        VN = mfma(ld8(Tinv + (16 * m + fr) * 64 + 8 * fq), Rf0, VN);
        VN = mfma(ld8(Tinv + (16 * m + fr) * 64 + 32 + 8 * fq), Rf1, VN);
        uint2 pk; pk.x = pk2(VN[0], VN[1]); pk.y = pk2(VN[2], VN[3]);
        *(uint2*)(Vsc + fr * 72 + 16 * m + 4 * fq) = pk;
        int ib = 16 * m + 4 * fq;
        float s0 = VN[0] * scal[128 + ib], s1 = VN[1] * scal[128 + ib + 1], s2 = VN[2] * scal[128 + ib + 2],
              s3 = VN[3] * scal[128 + ib + 3];
        if (dir) {
          pk.x = pk2(s3, s2); pk.y = pk2(s1, s0);
          *(uint2*)(Vor + fr * 72 + (60 - ib)) = pk;
        } else {
          pk.x = pk2(s0, s1); pk.y = pk2(s2, s3);
          *(uint2*)(Vor + fr * 72 + ib) = pk;
        }
      }
    }
    __syncthreads();
    if (active) {
      bf16x8 Vs0 = ld8(Vsc + fr * 72 + 8 * fq), Vs1 = ld8(Vsc + fr * 72 + 32 + 8 * fq);
      bf16x8 Vo0 = ld8(Vor + fr * 72 + 8 * fq), Vo1 = ld8(Vor + fr * 72 + 32 + 8 * fq);
#pragma unroll
      for (int m = 0; m < 4; ++m) {
        int i = 16 * m + fr, rowi = rb + (dir ? 63 - i : i);
        f32x4 O = {0.f, 0.f, 0.f, 0.f};
#pragma unroll
        for (int s = 0; s < 4; ++s) O = mfma(ld8(qn + (size_t)rowi * 512 + h * 128 + 32 * s + 8 * fq), Sf[s], O);
#pragma unroll
        for (int r = 0; r < 4; ++r) O[r] *= scal[16 * m + 4 * fq + r];
        O = mfma(ld8(QKm + (16 * m + fr) * 64 + 8 * fq), Vs0, O);
        O = mfma(ld8(QKm + (16 * m + fr) * 64 + 32 + 8 * fq), Vs1, O);
#pragma unroll
        for (int r = 0; r < 4; ++r) {
          int ii = 16 * m + 4 * fq + r, rowr = rb + (dir ? 63 - ii : ii);
          OB[((size_t)dir * GR + rowr) * 512 + h * 128 + e0 + fr] = f2bf(O[r]);
        }
      }
      float egl = scal[192];
#pragma unroll
      for (int m = 0; m < 8; ++m) {
        const u16* kt = knT + ((size_t)(cgk * 4 + h) * 128 + 16 * m + fr) * 64;
        f32x4 t = S[m];
#pragma unroll
        for (int r = 0; r < 4; ++r) t[r] *= egl;
        t = mfma(ld8(kt + 8 * fq), Vo0, t);
        t = mfma(ld8(kt + 32 + 8 * fq), Vo1, t);
        S[m] = t;
      }
    }
  }
  __syncthreads();
}

DEV void c_local(const P& p, int l, int item, char* smem) {
  float* bsm = (float*)smem;
  u16* Ps = (u16*)(smem + 33024);
  u16* kdt = (u16*)(smem + 33024 + 9216);
  const int tid = opq(threadIdx.x), lane = tid & 63, w = tid >> 6, fr = lane & 15, fq = lane >> 4;
  const int cgk = item >> 2, h = item & 3, rb = cgk * 64;
  const u16* z = (const u16*)(p.ws + O_Z);
  const u16* zT = (const u16*)(p.ws + O_ZT);
  u16* OC = (u16*)(p.ws + O_OC);
  const float* lbs = (const float*)(p.ws + O_LBS);
  for (int dir = 0; dir < 2; ++dir) {
    char* rec = p.ws + O_CREC + ((size_t)(cgk * 4 + h) * 2 + dir) * CREC_SZ;
    u16* QD = (u16*)rec;
    u16* KDT = QD + 8192;
    float* decv = (float*)(rec + 32768);
    const float* lbp = lbs + l * 1024 + dir * 512 + h * 128;
    const int fcol = C_F0 + dir * 512 + h * 128;
    {
      int d = tid & 127, half = tid >> 7;
      float lb_ = lbp[d], run = 0.f;
      for (int k = 0; k < 32; ++k) {
        int i = 32 * half + k, c = dir ? 63 - i : i;
        float f = bf2f(z[(size_t)(rb + c) * NZ + fcol + d]);
        float fg = lb_ + (1.f - lb_) * sigm(f);
        run += __logf(fg);
        bsm[i * 129 + d] = run;
      }
    }
    __syncthreads();
    {
      int d = tid & 127, half = tid >> 7;
      if (half) {
        float add = bsm[31 * 129 + d];
        for (int k = 0; k < 32; ++k) bsm[(32 + k) * 129 + d] += add;
      }
    }
    __syncthreads();
    for (int idx = tid; idx < 8192; idx += 256) {
      int i = idx >> 7, d = idx & 127, c = dir ? 63 - i : i;
      float b = bsm[i * 129 + d];
      float q = silu(bf2f(z[(size_t)(rb + c) * NZ + C_QC + h * 128 + d]));
      QD[i * 128 + d] = f2bf(q * __expf(b));
      float f = bf2f(z[(size_t)(rb + c) * NZ + fcol + d]);
      float k = (1.f - lbp[d]) * sigm(-f);
      kdt[d * 72 + c] = f2bf(k * __expf(bsm[63 * 129 + d] - b));
    }
    if (tid < 128) decv[tid] = __expf(bsm[63 * 129 + tid]);
    __syncthreads();
    for (int idx = tid; idx < 1024; idx += 256) {
      int d = idx >> 3, c8 = idx & 7;
      *(uint4*)(KDT + d * 64 + c8 * 8) = *(const uint4*)(kdt + d * 72 + c8 * 8);
    }
    {
      const int sj = w;
      for (int si = 0; si < 4; ++si) {
        f32x4 acc = {0.f, 0.f, 0.f, 0.f};
        if (si >= sj) {
          int it = 16 * si + fr, jt = 16 * sj + fr;
          int ci = dir ? 63 - it : it, cj = dir ? 63 - jt : jt;
#pragma unroll
          for (int s = 0; s < 4; ++s) {
            int d0 = 32 * s + 8 * fq;
            bf16x8 qv = ld8(z + (size_t)(rb + ci) * NZ + C_QC + h * 128 + d0);
            bf16x8 fv = ld8(z + (size_t)(rb + cj) * NZ + fcol + d0);
            bf16x8 af, bf;
#pragma unroll
            for (int e = 0; e < 8; ++e) {
              int d = d0 + e;
              float Bs_ = si ? bsm[(16 * si - 1) * 129 + d] : 0.f;
              float qq = silu(bf2f((u16)qv[e])) * __expf(bsm[it * 129 + d] - Bs_);
              float kk = (1.f - lbp[d]) * sigm(-bf2f((u16)fv[e])) * __expf(Bs_ - bsm[jt * 129 + d]);
              af[e] = (short)f2bf(qq);
              bf[e] = (short)f2bf(kk);
            }
            acc = mfma(af, bf, acc);
          }
        }
#pragma unroll
        for (int r = 0; r < 4; ++r) {
          int i = 16 * si + 4 * fq + r, jj = 16 * sj + fr;
          float v = (si >= sj && jj <= i) ? acc[r] : 0.f;
          Ps[i * 72 + (dir ? 63 - jj : jj)] = f2bf(v);
        }
        __builtin_amdgcn_sched_barrier(0);
      }
    }
    __syncthreads();
#pragma unroll
    for (int nt2 = 0; nt2 < 2; ++nt2) {
      int e = h * 128 + (2 * w + nt2) * 16 + fr;
      bf16x8 v0 = ld8(zT + (size_t)e * GR + rb + 8 * fq), v1 = ld8(zT + (size_t)e * GR + rb + 32 + 8 * fq);
#pragma unroll
      for (int m = 0; m < 4; ++m) {
        f32x4 O = {0.f, 0.f, 0.f, 0.f};
        O = mfma(ld8(Ps + (16 * m + fr) * 72 + 8 * fq), v0, O);
        O = mfma(ld8(Ps + (16 * m + fr) * 72 + 32 + 8 * fq), v1, O);
#pragma unroll
        for (int r = 0; r < 4; ++r) {
          int ii = 16 * m + 4 * fq + r, rowr = rb + (dir ? 63 - ii : ii);
          OC[((size_t)dir * GR + rowr) * 512 + e] = f2bf(O[r]);
        }
      }
    }
    __syncthreads();
  }
}

DEV void c_seq(const P& p, int bitem, char* smem) {
  const int tid = opq(threadIdx.x), lane = tid & 63, w = tid >> 6, fr = lane & 15, fq = lane >> 4;
  const bool active = w < WPB;
  const int item = bitem * WPB + (active ? w : 0);
  const int slice = item & 7, dir = (item >> 3) & 1, h = (item >> 4) & 3, lb = item >> 6, e0 = slice * 16;
  u16* Ss = (u16*)(smem + w * 4352);
  const u16* zT = (const u16*)(p.ws + O_ZT);
  u16* OC = (u16*)(p.ws + O_OC);
  f32x4 S[8];
#pragma unroll
  for (int m = 0; m < 8; ++m) S[m] = (f32x4){0.f, 0.f, 0.f, 0.f};
  for (int j = 0; j < 36; ++j) {
    const int n = dir ? (j < 4 ? 3 - j : 39 - j) : j;
    const int cgk = lb * 36 + n, rb = cgk * 64;
    const char* rec = p.ws + O_CREC + ((size_t)(cgk * 4 + h) * 2 + dir) * CREC_SZ;
    const u16* QD = (const u16*)rec;
    const u16* KDT = QD + 8192;
    const float* decv = (const float*)(rec + 32768);
    if (active) {
#pragma unroll
      for (int m = 0; m < 8; ++m) {
        uint2 pk; pk.x = pk2(S[m][0], S[m][1]); pk.y = pk2(S[m][2], S[m][3]);
        *(uint2*)(Ss + fr * 136 + 16 * m + 4 * fq) = pk;
      }
    }
    __syncthreads();
    if (active) {
      bf16x8 Sf[4];
#pragma unroll
      for (int s = 0; s < 4; ++s) Sf[s] = ld8(Ss + fr * 136 + 32 * s + 8 * fq);
#pragma unroll
      for (int m = 0; m < 4; ++m) {
        f32x4 O = {0.f, 0.f, 0.f, 0.f};
#pragma unroll
        for (int s = 0; s < 4; ++s) O = mfma(ld8(QD + (16 * m + fr) * 128 + 32 * s + 8 * fq), Sf[s], O);
#pragma unroll
        for (int r = 0; r < 4; ++r) {
          int ii = 16 * m + 4 * fq + r, rowr = rb + (dir ? 63 - ii : ii);
          size_t oi = ((size_t)dir * GR + rowr) * 512 + h * 128 + e0 + fr;
          OC[oi] = f2bf(bf2f(OC[oi]) + O[r]);
        }
      }
      const u16* vp = zT + (size_t)(h * 128 + e0 + fr) * GR + rb;
      bf16x8 V0 = ld8(vp + 8 * fq), V1 = ld8(vp + 32 + 8 * fq);
#pragma unroll
      for (int m = 0; m < 8; ++m) {
        f32x4 t = S[m];
#pragma unroll
        for (int r = 0; r < 4; ++r) t[r] *= decv[16 * m + 4 * fq + r];
        t = mfma(ld8(KDT + (16 * m + fr) * 64 + 8 * fq), V0, t);
        t = mfma(ld8(KDT + (16 * m + fr) * 64 + 32 + 8 * fq), V1, t);
        S[m] = t;
      }
    }
    __syncthreads();
  }
}

#define LBAR()                                              \
  do {                                                      \
    asm volatile("s_waitcnt lgkmcnt(0)" ::: "memory");      \
    __builtin_amdgcn_s_barrier();                           \
    asm volatile("" ::: "memory");                          \
  } while (0)
#define CBAR() asm volatile("" ::: "memory")

DEV void c_local2(const P& p, int l, int item, char* smem) {
  float* bsm = (float*)smem;
  u16* Fq = (u16*)(smem + 33024);
  u16* kdt = (u16*)(smem + 50432);
  u16* Ps = kdt;
  const int tid = opq(threadIdx.x), lane = tid & 63, w = tid >> 6, fr = lane & 15, fq = lane >> 4;
  const int cgk = item >> 2, h = item & 3, rb = cgk * 64;
  const u16* z = (const u16*)(p.ws + O_Z);
  const u16* zT = (const u16*)(p.ws + O_ZT);
  u16* OC = (u16*)(p.ws + O_OC);
  const float* lbs = (const float*)(p.ws + O_LBS);
  for (int dir = 0; dir < 2; ++dir) {
    char* rec = p.ws + O_CREC + ((size_t)(cgk * 4 + h) * 2 + dir) * CREC_SZ;
    u16* QD = (u16*)rec;
    u16* KDT = QD + 8192;
    float* decv = (float*)(rec + 32768);
    const float* lbp = lbs + l * 1024 + dir * 512 + h * 128;
    const int fcol = C_F0 + dir * 512 + h * 128;
    {
      uint4 t4[4];
#pragma unroll
      for (int k = 0; k < 4; ++k) {
        int idx = tid + 256 * k, c = idx >> 4, seg = idx & 15;
        t4[k] = *(const uint4*)(z + (size_t)(rb + c) * NZ + fcol + seg * 8);
      }
#pragma unroll
      for (int k = 0; k < 4; ++k) {
        int idx = tid + 256 * k, c = idx >> 4, seg = idx & 15;
        *(uint4*)(Fq + c * 136 + seg * 8) = t4[k];
      }
    }
    __syncthreads();
    {
      int d = tid & 127, half = tid >> 7;
      float lb_ = lbp[d], run = 0.f;
#pragma unroll 8
      for (int k = 0; k < 32; ++k) {
        int i = 32 * half + k, c = dir ? 63 - i : i;
        float f = bf2f(Fq[c * 136 + d]);
        float fg = lb_ + (1.f - lb_) * sigm(f);
        run += __logf(fg);
        bsm[i * 129 + d] = run;
      }
    }
    __syncthreads();
    {
      int d = tid & 127, half = tid >> 7;
      if (half) {
        float add = bsm[31 * 129 + d];
#pragma unroll 8
        for (int k = 0; k < 32; ++k) bsm[(32 + k) * 129 + d] += add;
      }
    }
    __syncthreads();
    {
      const int d = tid & 127, ih = tid >> 7;
      const float oml = 1.f - lbp[d], bl = bsm[63 * 129 + d];
#pragma unroll 8
      for (int k = 0; k < 32; ++k) {
        int i = 2 * k + ih, c = dir ? 63 - i : i;
        float b = bsm[i * 129 + d];
        float q = silu(bf2f(z[(size_t)(rb + c) * NZ + C_QC + h * 128 + d]));
        QD[i * 128 + d] = f2bf(q * __expf(b));
        float f = bf2f(Fq[c * 136 + d]);
        kdt[d * 72 + c] = f2bf(oml * sigm(-f) * __expf(bl - b));
      }
      if (tid < 128) decv[tid] = __expf(bl);
    }
    __syncthreads();
    for (int idx = tid; idx < 1024; idx += 256) {
      int d = idx >> 3, c8 = idx & 7;
      *(uint4*)(KDT + d * 64 + c8 * 8) = *(const uint4*)(kdt + d * 72 + c8 * 8);
    }
    bf16x8 qf[2][4];
#define CL_QLOAD(si_)                                                                                    \
  {                                                                                                      \
    int it_ = 16 * (si_) + fr, ci_ = dir ? 63 - it_ : it_;                                               \
    _Pragma("unroll") for (int s = 0; s < 4; ++s) qf[(si_)&1][s] =                                       \
        ld8(z + (size_t)(rb + ci_) * NZ + C_QC + h * 128 + 32 * s + 8 * fq);                             \
  }
    CL_QLOAD(0)
    __syncthreads();
    {
      const int sj = w;
      const int jt = 16 * sj + fr, cj = dir ? 63 - jt : jt;
#pragma unroll
      for (int si = 0; si < 4; ++si) {
        f32x4 acc = {0.f, 0.f, 0.f, 0.f};
        if (si < 3) { CL_QLOAD(si + 1) }
        if (si >= sj) {
          int it = 16 * si + fr;
#pragma unroll
          for (int s = 0; s < 4; ++s) {
            int d0 = 32 * s + 8 * fq;
            bf16x8 fv = ld8(Fq + cj * 136 + d0);
            bf16x8 af, bf;
#pragma unroll
            for (int e = 0; e < 8; ++e) {
              int d = d0 + e;
              float Bs_ = si ? bsm[(16 * si - 1) * 129 + d] : 0.f;
              float qq = silu(bf2f((u16)qf[si & 1][s][e])) * __expf(bsm[it * 129 + d] - Bs_);
              float kk = (1.f - lbp[d]) * sigm(-bf2f((u16)fv[e])) * __expf(Bs_ - bsm[jt * 129 + d]);
              af[e] = (short)f2bf(qq);
              bf[e] = (short)f2bf(kk);
            }
            acc = mfma(af, bf, acc);
            __builtin_amdgcn_sched_barrier(0);
          }
        }
#pragma unroll
        for (int r = 0; r < 4; ++r) {
          int i = 16 * si + 4 * fq + r, jj = 16 * sj + fr;
          float v = (si >= sj && jj <= i) ? acc[r] : 0.f;
          Ps[i * 72 + (dir ? 63 - jj : jj)] = f2bf(v);
        }
      }
    }
    __syncthreads();
#pragma unroll
    for (int nt2 = 0; nt2 < 2; ++nt2) {
      int e = h * 128 + (2 * w + nt2) * 16 + fr;
      bf16x8 v0 = ld8(zT + (size_t)e * GR + rb + 8 * fq), v1 = ld8(zT + (size_t)e * GR + rb + 32 + 8 * fq);
#pragma unroll
      for (int m = 0; m < 4; ++m) {
        f32x4 O = {0.f, 0.f, 0.f, 0.f};
        O = mfma(ld8(Ps + (16 * m + fr) * 72 + 8 * fq), v0, O);
        O = mfma(ld8(Ps + (16 * m + fr) * 72 + 32 + 8 * fq), v1, O);
#pragma unroll
        for (int r = 0; r < 4; ++r) {
          int ii = 16 * m + 4 * fq + r, rowr = rb + (dir ? 63 - ii : ii);
          OC[((size_t)dir * GR + rowr) * 512 + e] = f2bf(O[r]);
        }
      }
    }
    __syncthreads();
  }
}

DEV void b_seq2(const P& p, int bitem, char* smem) {
  const int tid = opq(threadIdx.x), lane = tid & 63, w = tid >> 6, fr = lane & 15, fq = lane >> 4;
  const int es = bitem & 3, dir = (bitem >> 2) & 1, h = (bitem >> 3) & 3, lb = bitem >> 5, e0 = es * 32;
  u16* Ss = (u16*)smem;
  u16* Rs = Ss + 32 * 136;
  u16* Vsc = Rs + 32 * 72;
  u16* Vor = Vsc + 32 * 72;
  const u16* qn = (const u16*)(p.ws + O_BSH);
  const u16* kn = qn + (size_t)GR * 512;
  const u16* vb = kn + (size_t)GR * 512;
  const u16* knT = vb + (size_t)GR * 512;
  u16* OB = (u16*)(p.ws + O_OB);
  const int mrow = 16 * w + fr, crow0 = 16 * w + 4 * fq;
  f32x4 S[2][2];
#pragma unroll
  for (int a = 0; a < 2; ++a)
#pragma unroll
    for (int b = 0; b < 2; ++b) S[a][b] = (f32x4){0.f, 0.f, 0.f, 0.f};
  bf16x8 Akn[4], Aqn[4], At[2], Aqk[2], AkT[2][2];
  u16 vbv[2][4];
  float4 eg4, be4, ek4;
  float egl;
#define BS_CHUNK(jj) (dir ? ((jj) < 4 ? 3 - (jj) : 39 - (jj)) : (jj))
#define BS_LOAD1(jj)                                                                         \
  {                                                                                          \
    const int cg_ = lb * 36 + BS_CHUNK(jj), rb_ = cg_ * 64;                                  \
    const size_t ra_ = (size_t)(rb_ + (dir ? 63 - mrow : mrow)) * 512 + h * 128 + 8 * fq;    \
    _Pragma("unroll") for (int s = 0; s < 4; ++s) {                                          \
      Akn[s] = ld8(kn + ra_ + 32 * s);                                                       \
      Aqn[s] = ld8(qn + ra_ + 32 * s);                                                       \
    }                                                                                        \
    _Pragma("unroll") for (int r = 0; r < 4; ++r) {                                          \
      const size_t rr_ = (size_t)(rb_ + (dir ? 63 - (crow0 + r) : (crow0 + r))) * 512 + h * 128 + e0 + fr; \
      vbv[0][r] = vb[rr_];                                                                   \
      vbv[1][r] = vb[rr_ + 16];                                                              \
    }                                                                                        \
    const float* sc_ = (const float*)(p.ws + O_BIT + ((size_t)(cg_ * 4 + h) * 2 + dir) * BIT_SZ + 16384); \
    eg4 = *(const float4*)(sc_ + crow0);                                                     \
    be4 = *(const float4*)(sc_ + 64 + crow0);                                                \
  }
#define BS_LOAD2(jj)                                                                         \
  {                                                                                          \
    const int cg_ = lb * 36 + BS_CHUNK(jj);                                                  \
    const char* rec_ = p.ws + O_BIT + ((size_t)(cg_ * 4 + h) * 2 + dir) * BIT_SZ;            \
    const u16* T_ = (const u16*)rec_ + mrow * 64 + 8 * fq;                                   \
    At[0] = ld8(T_); At[1] = ld8(T_ + 32);                                                   \
    ek4 = *(const float4*)((const float*)(rec_ + 16384) + 128 + crow0);                      \
  }
#define BS_LOAD3(jj)                                                                         \
  {                                                                                          \
    const int cg_ = lb * 36 + BS_CHUNK(jj);                                                  \
    const char* rec_ = p.ws + O_BIT + ((size_t)(cg_ * 4 + h) * 2 + dir) * BIT_SZ;            \
    const u16* Q_ = (const u16*)rec_ + 4096 + mrow * 64 + 8 * fq;                            \
    Aqk[0] = ld8(Q_); Aqk[1] = ld8(Q_ + 32);                                                 \
    egl = ((const float*)(rec_ + 16384))[192];                                               \
    _Pragma("unroll") for (int mm = 0; mm < 2; ++mm) {                                       \
      const u16* k_ = knT + ((size_t)(cg_ * 4 + h) * 128 + 32 * w + 16 * mm + fr) * 64 + 8 * fq; \
      AkT[mm][0] = ld8(k_); AkT[mm][1] = ld8(k_ + 32);                                       \
    }                                                                                        \
  }
  BS_LOAD1(0) BS_LOAD2(0) BS_LOAD3(0)
  for (int j = 0; j < 36; ++j) {
    const int cgk = lb * 36 + BS_CHUNK(j), rb = cgk * 64;
    const int jn = (j + 1 < 36) ? j + 1 : j;
#pragma unroll
    for (int mm = 0; mm < 2; ++mm)
#pragma unroll
      for (int nt = 0; nt < 2; ++nt) {
        uint2 pk; pk.x = pk2(S[mm][nt][0], S[mm][nt][1]); pk.y = pk2(S[mm][nt][2], S[mm][nt][3]);
        *(uint2*)(Ss + (16 * nt + fr) * 136 + 32 * w + 16 * mm + 4 * fq) = pk;
      }
    LBAR();
    f32x4 QS[2];
    {
      bf16x8 Sf[2][4];
#pragma unroll
      for (int nt = 0; nt < 2; ++nt)
#pragma unroll
        for (int s = 0; s < 4; ++s) Sf[nt][s] = ld8(Ss + (16 * nt + fr) * 136 + 32 * s + 8 * fq);
#pragma unroll
      for (int nt = 0; nt < 2; ++nt) {
        f32x4 X = {0.f, 0.f, 0.f, 0.f}, Q = {0.f, 0.f, 0.f, 0.f};
#pragma unroll
        for (int s = 0; s < 4; ++s) { X = mfma(Akn[s], Sf[nt][s], X); Q = mfma(Aqn[s], Sf[nt][s], Q); }
        float r0 = be4.x * (bf2f(vbv[nt][0]) - eg4.x * X[0]);
        float r1 = be4.y * (bf2f(vbv[nt][1]) - eg4.y * X[1]);
        float r2 = be4.z * (bf2f(vbv[nt][2]) - eg4.z * X[2]);
        float r3 = be4.w * (bf2f(vbv[nt][3]) - eg4.w * X[3]);
        uint2 pk; pk.x = pk2(r0, r1); pk.y = pk2(r2, r3);
        *(uint2*)(Rs + (16 * nt + fr) * 72 + crow0) = pk;
        Q[0] *= eg4.x; Q[1] *= eg4.y; Q[2] *= eg4.z; Q[3] *= eg4.w;
        QS[nt] = Q;
      }
    }
    CBAR();
    BS_LOAD1(jn)
    LBAR();
    {
#pragma unroll
      for (int nt = 0; nt < 2; ++nt) {
        bf16x8 Rf0 = ld8(Rs + (16 * nt + fr) * 72 + 8 * fq), Rf1 = ld8(Rs + (16 * nt + fr) * 72 + 32 + 8 * fq);
        f32x4 VN = {0.f, 0.f, 0.f, 0.f};
        VN = mfma(At[0], Rf0, VN);
        VN = mfma(At[1], Rf1, VN);
        uint2 pk; pk.x = pk2(VN[0], VN[1]); pk.y = pk2(VN[2], VN[3]);
        *(uint2*)(Vsc + (16 * nt + fr) * 72 + crow0) = pk;
        float s0 = VN[0] * ek4.x, s1 = VN[1] * ek4.y, s2 = VN[2] * ek4.z, s3 = VN[3] * ek4.w;
        if (dir) {
          pk.x = pk2(s3, s2); pk.y = pk2(s1, s0);
          *(uint2*)(Vor + (16 * nt + fr) * 72 + (60 - crow0)) = pk;
        } else {
          pk.x = pk2(s0, s1); pk.y = pk2(s2, s3);
          *(uint2*)(Vor + (16 * nt + fr) * 72 + crow0) = pk;
        }
      }
    }
    CBAR();
    BS_LOAD2(jn)
    LBAR();
    {
#pragma unroll
      for (int nt = 0; nt < 2; ++nt) {
        bf16x8 Vs0 = ld8(Vsc + (16 * nt + fr) * 72 + 8 * fq), Vs1 = ld8(Vsc + (16 * nt + fr) * 72 + 32 + 8 * fq);
        bf16x8 Vo0 = ld8(Vor + (16 * nt + fr) * 72 + 8 * fq), Vo1 = ld8(Vor + (16 * nt + fr) * 72 + 32 + 8 * fq);
        f32x4 O = QS[nt];
        O = mfma(Aqk[0], Vs0, O);
        O = mfma(Aqk[1], Vs1, O);
#pragma unroll
        for (int r = 0; r < 4; ++r) {
          int ii = crow0 + r, rowr = rb + (dir ? 63 - ii : ii);
          OB[((size_t)dir * GR + rowr) * 512 + h * 128 + e0 + 16 * nt + fr] = f2bf(O[r]);
        }
#pragma unroll
        for (int mm = 0; mm < 2; ++mm) {
          f32x4 t = S[mm][nt];
#pragma unroll
          for (int r = 0; r < 4; ++r) t[r] *= egl;
          t = mfma(AkT[mm][0], Vo0, t);
          t = mfma(AkT[mm][1], Vo1, t);
          S[mm][nt] = t;
        }
      }
    }
    CBAR();
    BS_LOAD3(jn)
  }
  LBAR();
}

DEV void c_seq2(const P& p, int bitem, char* smem) {
  const int tid = opq(threadIdx.x), lane = tid & 63, w = tid >> 6, fr = lane & 15, fq = lane >> 4;
  const int es = bitem & 3, dir = (bitem >> 2) & 1, h = (bitem >> 3) & 3, lb = bitem >> 5, e0 = es * 32;
  u16* Ssb = (u16*)smem;
  const u16* zT = (const u16*)(p.ws + O_ZT);
  u16* OC = (u16*)(p.ws + O_OC);
  const int mrow = 16 * w + fr, crow0 = 16 * w + 4 * fq;
  f32x4 S[2][2];
#pragma unroll
  for (int a = 0; a < 2; ++a)
#pragma unroll
    for (int b = 0; b < 2; ++b) S[a][b] = (f32x4){0.f, 0.f, 0.f, 0.f};
  bf16x8 Aqd[4], Akd[2][2], Vf[2][2];
  u16 oi[2][4];
  float4 dec4[2];
#define CS_LOAD(jj)                                                                          \
  {                                                                                          \
    const int cg_ = lb * 36 + BS_CHUNK(jj), rb_ = cg_ * 64;                                  \
    const char* rec_ = p.ws + O_CREC + ((size_t)(cg_ * 4 + h) * 2 + dir) * CREC_SZ;          \
    const u16* QD_ = (const u16*)rec_ + mrow * 128 + 8 * fq;                                 \
    _Pragma("unroll") for (int s = 0; s < 4; ++s) Aqd[s] = ld8(QD_ + 32 * s);                \
    _Pragma("unroll") for (int mm = 0; mm < 2; ++mm) {                                       \
      const u16* K_ = (const u16*)rec_ + 8192 + (32 * w + 16 * mm + fr) * 64 + 8 * fq;       \
      Akd[mm][0] = ld8(K_); Akd[mm][1] = ld8(K_ + 32);                                       \
      dec4[mm] = *(const float4*)((const float*)(rec_ + 32768) + 32 * w + 16 * mm + 4 * fq); \
    }                                                                                        \
    _Pragma("unroll") for (int nt = 0; nt < 2; ++nt) {                                       \
      const u16* v_ = zT + (size_t)(h * 128 + e0 + 16 * nt + fr) * GR + rb_ + 8 * fq;        \
      Vf[nt][0] = ld8(v_); Vf[nt][1] = ld8(v_ + 32);                                         \
      _Pragma("unroll") for (int r = 0; r < 4; ++r) {                                        \
        int ii_ = crow0 + r, rowr_ = rb_ + (dir ? 63 - ii_ : ii_);                           \
        oi[nt][r] = OC[((size_t)dir * GR + rowr_) * 512 + h * 128 + e0 + 16 * nt + fr];      \
      }                                                                                      \
    }                                                                                        \
  }
  CS_LOAD(0)
  for (int j = 0; j < 36; ++j) {
    const int cgk = lb * 36 + BS_CHUNK(j), rb = cgk * 64;
    const int jn = (j + 1 < 36) ? j + 1 : j;
    u16* Ss = Ssb + (j & 1) * (32 * 136);
#pragma unroll
    for (int mm = 0; mm < 2; ++mm)
#pragma unroll
      for (int nt = 0; nt < 2; ++nt) {
        uint2 pk; pk.x = pk2(S[mm][nt][0], S[mm][nt][1]); pk.y = pk2(S[mm][nt][2], S[mm][nt][3]);
        *(uint2*)(Ss + (16 * nt + fr) * 136 + 32 * w + 16 * mm + 4 * fq) = pk;
      }
    LBAR();
#pragma unroll
    for (int nt = 0; nt < 2; ++nt) {
      f32x4 O = {0.f, 0.f, 0.f, 0.f};
#pragma unroll
      for (int s = 0; s < 4; ++s) O = mfma(Aqd[s], ld8(Ss + (16 * nt + fr) * 136 + 32 * s + 8 * fq), O);
#pragma unroll
      for (int r = 0; r < 4; ++r) {
        int ii = crow0 + r, rowr = rb + (dir ? 63 - ii : ii);
        OC[((size_t)dir * GR + rowr) * 512 + h * 128 + e0 + 16 * nt + fr] = f2bf(bf2f(oi[nt][r]) + O[r]);
      }
#pragma unroll
      for (int mm = 0; mm < 2; ++mm) {
        f32x4 t = S[mm][nt];
        t[0] *= dec4[mm].x; t[1] *= dec4[mm].y; t[2] *= dec4[mm].z; t[3] *= dec4[mm].w;
        t = mfma(Akd[mm][0], Vf[nt][0], t);
        t = mfma(Akd[mm][1], Vf[nt][1], t);
        S[mm][nt] = t;
      }
    }
    CBAR();
    CS_LOAD(jn)
  }
  LBAR();
}

DEV void bc_merge(const P& p, int l, int it) {
  const int tid_ = opq(threadIdx.x); const int lane = tid_ & 63, w = tid_ >> 6;
  int lr = it * 4 + w;
  int mix = lane >> 5, cm = (lane * 16) & 511;
  const u16* O = (const u16*)(p.ws + (mix ? O_OC : O_OB));
  u16* z = (u16*)(p.ws + O_Z);
  float ov[16], ss = 0.f;
#pragma unroll
  for (int k2 = 0; k2 < 2; ++k2) {
    uint4 a = *(const uint4*)(O + (size_t)lr * 512 + cm + 8 * k2);
    uint4 b = *(const uint4*)(O + ((size_t)GR + lr) * 512 + cm + 8 * k2);
    unsigned aa[4] = {a.x, a.y, a.z, a.w}, bb[4] = {b.x, b.y, b.z, b.w};
#pragma unroll
    for (int q = 0; q < 4; ++q) {
      float v0 = bf2f((u16)(aa[q] & 0xffff)) + bf2f((u16)(bb[q] & 0xffff));
      float v1 = bf2f((u16)(aa[q] >> 16)) + bf2f((u16)(bb[q] >> 16));
      ov[k2 * 8 + q * 2] = v0; ov[k2 * 8 + q * 2 + 1] = v1;
      ss += v0 * v0 + v1 * v1;
    }
  }
  ss += __shfl_xor(ss, 1); ss += __shfl_xor(ss, 2); ss += __shfl_xor(ss, 4);
  float rinv = rsqrtf(ss * (1.f / 128.f) + EPS);
  const float* nw = (mix ? p.hg_norm : p.gdn_norm) + l * 128 + (cm & 127);
  u16* gp = z + (size_t)lr * NZ + (mix ? C_GC : C_GB) + cm;
#pragma unroll
  for (int k2 = 0; k2 < 2; ++k2) {
    uint4 gv = *(const uint4*)(gp + 8 * k2);
    unsigned gg[4] = {gv.x, gv.y, gv.z, gv.w}, oo[4];
#pragma unroll
    for (int q = 0; q < 4; ++q) {
      int e = k2 * 8 + q * 2;
      float y0 = ov[e] * rinv * nw[e] * silu(bf2f((u16)(gg[q] & 0xffff)));
      float y1 = ov[e + 1] * rinv * nw[e + 1] * silu(bf2f((u16)(gg[q] >> 16)));
      oo[q] = pk2(y0, y1);
    }
    *(uint4*)(gp + 8 * k2) = make_uint4(oo[0], oo[1], oo[2], oo[3]);
  }
}

#define XB_TMO      128
#define XB_XCNT(j)  (256  + 64 * (j))
#define XB_XSUB(j)  (1280 + 64 * (j))
#define XB_XGEN(j)  (2304 + 64 * (j))
#define XB_TOP      3328
#define XB_TOPGEN   3392
#define XCD_BAR_WORDS 3456
#define XB_SPIN_CAP (1u << 18)
#define LAS __attribute__((address_space(3)))

__device__ __forceinline__ unsigned xb_ld(unsigned* p)              { return __hip_atomic_load(p, __ATOMIC_RELAXED, __HIP_MEMORY_SCOPE_AGENT); }
__device__ __forceinline__ unsigned xb_add(unsigned* p, unsigned v) { return __hip_atomic_fetch_add(p, v, __ATOMIC_RELAXED, __HIP_MEMORY_SCOPE_AGENT); }
__device__ __forceinline__ unsigned xb_xcc_id() { return (unsigned)__builtin_amdgcn_s_getreg((3 << 11) | 20) & 0xFu; }
#define XB_SPIN(cond, bar) do { unsigned _sp = 0; while (cond) { __builtin_amdgcn_s_sleep(1); \
    if ((++_sp & 255u) == 0u) { if (xb_ld(&(bar)[XB_TMO])) break; if (_sp > XB_SPIN_CAP) { atomicAdd(&(bar)[XB_TMO], 1u); break; } } } } while (0)

struct XcdBarrier {
    unsigned* bar; unsigned x;
    volatile LAS unsigned* st;
};

__device__ __forceinline__ XcdBarrier xcd_barrier_post(unsigned* bar, volatile LAS unsigned* st) {
    XcdBarrier b; b.bar = bar; b.x = xb_xcc_id(); b.st = st;
    if (threadIdx.x == 0) (void)xb_add(&bar[XB_XCNT(b.x)], 1u);
    return b;
}
__device__ __forceinline__ void xcd_barrier_complete(unsigned* bar, unsigned x, unsigned& nloc, unsigned& nx) {
    const unsigned G = gridDim.x * gridDim.y * gridDim.z;
    unsigned sum, cnt, mine, sp = 0u;
    for (;;) {
        sum = 0u; cnt = 0u; mine = 0u;
#pragma unroll
        for (unsigned j = 0; j < 16; ++j) { const unsigned c = xb_ld(&bar[XB_XCNT(j)]); sum += c; cnt += (c > 0u) ? 1u : 0u; mine = (j == x) ? c : mine; }
        if (sum == G) break;
        __builtin_amdgcn_s_sleep(1);
        if ((++sp & 255u) == 0u) { if (xb_ld(&bar[XB_TMO])) break; if (sp > XB_SPIN_CAP) { atomicAdd(&bar[XB_TMO], 1u); break; } }
    }
    nloc = mine > 0u ? mine : 1u; nx = cnt > 0u ? cnt : 1u;
}

__device__ __forceinline__ void xcd_barrier(const XcdBarrier& b) {
    asm volatile("s_waitcnt vmcnt(0)" ::: "memory");
    __syncthreads();
    if (threadIdx.x == 0) {
        unsigned* bar = b.bar;
        __builtin_amdgcn_s_waitcnt(0);
        unsigned nloc = b.st[0], nx = b.st[1];
        if (nloc == 0u) { xcd_barrier_complete(bar, b.x, nloc, nx); b.st[0] = nloc; b.st[1] = nx; }
        const unsigned old = xb_add(&bar[XB_XSUB(b.x)], 1u);
        const unsigned gen = old / nloc;
        if (old + 1u == (gen + 1u) * nloc) {
            __builtin_amdgcn_fence(__ATOMIC_RELEASE, "agent");
            asm volatile("s_waitcnt vmcnt(0)" ::: "memory");
            const unsigned og = xb_add(&bar[XB_TOP], 1u);
            const unsigned tg = og / nx;
            if (og + 1u == (tg + 1u) * nx) xb_add(&bar[XB_TOPGEN], 1u);
            else XB_SPIN(xb_ld(&bar[XB_TOPGEN]) == tg, bar);
            __builtin_amdgcn_fence(__ATOMIC_ACQUIRE, "agent");
            xb_add(&bar[XB_XGEN(b.x)], 1u);
            asm volatile("s_waitcnt vmcnt(0)" ::: "memory");
        } else {
            XB_SPIN(xb_ld(&bar[XB_XGEN(b.x)]) == gen, bar);
            __builtin_amdgcn_fence(__ATOMIC_ACQUIRE, "agent");
            asm volatile("s_waitcnt vmcnt(0)" ::: "memory");
        }
    }
    __syncthreads();
}


#ifdef NO_G0
#define XG0(x)
#else
#define XG0(x) x
#endif
#ifdef NO_G1
#define XG1(x)
#else
#define XG1(x) x
#endif
#ifdef NO_BC
#define XBC(x)
#else
#define XBC(x) x
#endif
#ifdef NO_AC
#define XAC(x)
#else
#define XAC(x) x
#endif
#ifdef NO_P0
#define XP0(x)
#else
#define XP0(x) x
#endif
#ifdef NO_R
#define XR(x)
#else
#define XR(x) x
#endif
#ifdef NO_BL
#define XBL(x)
#else
#define XBL(x) x
#endif
#ifdef NO_CL
#define XCL(x)
#else
#define XCL(x) x
#endif
#ifdef NO_A0
#define XA0(x)
#else
#define XA0(x) x
#endif
#ifdef NO_A1
#define XA1(x)
#else
#define XA1(x) x
#endif
#ifdef NO_BS
#define XBS(x)
#else
#define XBS(x) x
#endif
#ifdef NO_CS
#define XCS(x)
#else
#define XCS(x) x
#endif
__global__ void __launch_bounds__(256, 2) fwd_mega(P p) {
  extern __shared__ __attribute__((aligned(16))) char smem[];
  cg::grid_group grid = cg::this_grid();
  const int G = gridDim.x;
  __shared__ uint4 xb_words;
  if (threadIdx.x == 0) xb_words = make_uint4(0u, 0u, 0u, 0u);
  __syncthreads();
  XcdBarrier xb = xcd_barrier_post((unsigned*)(p.ws + O_BAR), (volatile LAS unsigned*)&xb_words);
  XP0(phase0(p, smem));
  grid.sync();
  u16* z = (u16*)(p.ws + O_Z);
  u16* zT = (u16*)(p.ws + O_ZT);
  float* ab = (float*)(p.ws + O_AB);
  float* o = (float*)(p.ws + O_BSH);
  const u16* u = (const u16*)(p.ws + O_BIT);
  for (int g = 0; g < NG; ++g) {
    XR(phaseR(p, g, 0));
    xcd_barrier(xb);
    for (int l = 0; l < DEPTH; ++l) {
      for (int rep = 0; rep < REP_G; ++rep) {
        const u16* Bt = (const u16*)(p.ws + O_WTIN) + (size_t)l * NZ * 1024;
        for (int t = blockIdx.x; t < 72 * 45; t += G) { XG0(gemm_tile<0>(u, 1024, Bt, 1024, t % 72, t / 72, z, zT, ab, o, smem)); }
      }
      xcd_barrier(xb);
      for (int rep2 = 0; rep2 < REP_M; ++rep2) {
      for (int rep3 = 0; rep3 < REP_A; ++rep3) {
        if (rep3) xcd_barrier(xb);
        const int nb = NCH * 4, nc = NCH * 4, na = NCH * 8;
        for (int t = blockIdx.x; t < nb + nc + na; t += G) {
          if (t < nb) { XBL(b_local(p, l, t, smem)); }
          else if (t < nb + nc) { XCL(c_local2(p, l, t - nb, smem)); }
          else { XA0(a_item(p, l, t - nb - nc, 0, smem)); }
        }
      }
      xcd_barrier(xb);
      {
        const int nb = 128, nc = 128, na = 16;
        for (int t = blockIdx.x; t < nb + nc + na; t += G) {
          if (t < nb) { XBS(b_seq2(p, t, smem)); }
          else if (t < nb + nc) { XCS(c_seq2(p, t - nb, smem)); }
          else { XAC(a_carry(p, t - nb - nc)); }
        }
      }
      xcd_barrier(xb);
      }
      {
        const int na = NCH * 8, nm = GR / 4;
        for (int t = blockIdx.x; t < na + nm; t += G) {
          if (t < na) { XA1(a_item(p, l, t, 1, smem)); }
          else { XBC(bc_merge(p, l, t - na)); }
        }
      }
      xcd_barrier(xb);
      for (int rep = 0; rep < REP_G; ++rep) {
        const u16* Bt = (const u16*)(p.ws + O_WTOUT) + (size_t)l * 1024 * 1536;
        for (int t = blockIdx.x; t < 72 * 8; t += G) { XG1(gemm_tile<1>(z + C_GA, NZ, Bt, 1536, t % 72, t / 72, z, zT, ab, o, smem)); }
      }
      xcd_barrier(xb);
      XR(phaseR(p, g, l + 1));
      xcd_barrier(xb);
    }
  }
}

extern "C" void kernel_launch(void* const* d_in, const int* in_sizes, int n_in, void* d_out, int out_size, void* d_ws,
                              size_t ws_size, hipStream_t stream) {
  static int grid_blocks = 0;
  if (!grid_blocks) {
    int dev = 0, cus = 0, per_cu = 0;
    hipGetDevice(&dev);
    hipDeviceGetAttribute(&cus, hipDeviceAttributeMultiprocessorCount, dev);
    hipFuncSetAttribute((const void*)fwd_mega, hipFuncAttributeMaxDynamicSharedMemorySize, LDS_BYTES);
    hipOccupancyMaxActiveBlocksPerMultiprocessor(&per_cu, fwd_mega, 256, LDS_BYTES);
    if (per_cu > 2) per_cu = 2;
    if (per_cu < 1) per_cu = 1;
    grid_blocks = cus * per_cu;
  }
  if (ws_size < WS_TOTAL) {
    fprintf(stderr, "workspace too small: %zu < %zu\n", ws_size, (size_t)WS_TOTAL);
    return;
  }
  P p{};
  const float** f = (const float**)&p;
  for (int i = 0; i < 23; ++i) f[i] = (const float*)d_in[i];
  p.out = (float*)d_out;
  p.ws = (char*)d_ws;
  hipMemsetAsync((char*)d_ws + O_BAR, 0, XCD_BAR_WORDS * 4, stream);
  void* args[] = {&p};
  hipError_t e = hipLaunchCooperativeKernel((void*)fwd_mega, dim3(grid_blocks), dim3(256), args, LDS_BYTES, stream);
  if (e != hipSuccess) fprintf(stderr, "cooperative launch failed: %s (grid %d)\n", hipGetErrorString(e), grid_blocks);
}
```

```cpp
#include <hip/hip_runtime.h>
#include <hip/hip_cooperative_groups.h>
#include <cstdio>
namespace cg = cooperative_groups;

typedef __attribute__((ext_vector_type(8))) short bf16x8;
typedef __attribute__((ext_vector_type(4))) float f32x4;
typedef unsigned short u16;
#define DEV __device__ __forceinline__

constexpr int DM = 1024, TL = 2048, TCX = 256, TS = 2304, GB = 4, GR = GB * TS, NG = 2;
constexpr int NZ = 5760, DEPTH = 4;
constexpr int C_XA = 0, C_Q = 512, C_K = 1024, C_V = 1536, C_QC = 2048, C_F0 = 2560, C_IC = 3584,
              C_GA = 4096, C_GB = 4608, C_GC = 5120, C_AB = 5632;
constexpr int NCH = GR / 64;
constexpr float EPS = 1e-6f;
constexpr int WPB = 2;

constexpr size_t al256(size_t x) { return (x + 255) & ~(size_t)255; }
constexpr size_t O_WTIN = 0;
constexpr size_t O_WTOUT = O_WTIN + al256((size_t)DEPTH * NZ * 1024 * 2);
constexpr size_t O_WGT = O_WTOUT + al256((size_t)DEPTH * 1024 * 1536 * 2);
constexpr size_t O_MOD = O_WGT + al256((size_t)DEPTH * 2 * 2 * 8 * 4096 * 2);
constexpr size_t O_LBS = O_MOD + al256((size_t)DEPTH * 9 * 3072 * 4);
constexpr size_t O_HC = O_LBS + al256((size_t)DEPTH * 1024 * 4);
constexpr size_t O_Z = O_HC + al256((size_t)GB * TCX * 1024 * 4);
constexpr size_t O_ZT = O_Z + al256((size_t)GR * NZ * 2);
constexpr size_t O_AB = O_ZT + al256((size_t)512 * GR * 2);
constexpr size_t O_BSH = O_AB + al256((size_t)GR * 16 * 4);
constexpr size_t BSH_ONE = (size_t)GR * 512 * 2;
constexpr size_t O_BIT = O_BSH + al256(4 * BSH_ONE);
constexpr size_t BIT_SZ = 17408;
constexpr size_t O_CREC = O_BIT + al256((size_t)NCH * 4 * 2 * BIT_SZ);
constexpr size_t CREC_SZ = 33280;
constexpr size_t O_OB = O_CREC + al256((size_t)NCH * 4 * 2 * CREC_SZ);
constexpr size_t O_OC = O_OB + al256((size_t)2 * GR * 512 * 2);
constexpr size_t O_AP = O_OC + al256((size_t)2 * GR * 512 * 2);
constexpr size_t O_AH = O_AP + al256((size_t)NCH * 2 * 512 * 4);
constexpr size_t O_ACAR = O_AH + al256((size_t)NCH * 2 * 512 * 4);
constexpr size_t O_BAR = O_ACAR + al256((size_t)NCH * 2 * 512 * 4);
constexpr size_t WS_TOTAL = O_BAR + al256(3456 * 4);

constexpr int LDS_BYTES = 69632;
#ifndef REP_A
#define REP_A 1
#endif
#ifndef REP_G
#define REP_G 1
#endif
#ifndef REP_M
#define REP_M 1
#endif

struct P {
  const float *x, *c, *ctx, *c_ctx, *w_ada, *b_ada, *norm_pre, *norm_post, *w_in, *conv_a_w, *conv_a_b, *rg_w_r,
      *rg_b_r, *rg_w_i, *rg_b_i, *rg_lam, *conv_b_w, *gdn_a_log, *gdn_dt_bias, *gdn_norm, *hg_lb, *hg_norm, *w_out;
  float* out;
  char* ws;
};

DEV int opq(int x) { asm volatile("" : "+v"(x)); return x; }
DEV int opqs(int x) { asm volatile("" : "+s"(x)); return x; }
typedef __attribute__((ext_vector_type(2))) __bf16 bf16x2_t;
typedef __attribute__((ext_vector_type(2))) float f32x2_t;
DEV u16 f2bf(float f) { __bf16 r = (__bf16)f; return __builtin_bit_cast(u16, r); }
DEV float bf2f(u16 h) { return __uint_as_float(((unsigned)h) << 16); }
DEV unsigned pk2(float a, float b) { f32x2_t v = {a, b}; bf16x2_t r = __builtin_convertvector(v, bf16x2_t); return __builtin_bit_cast(unsigned, r); }
DEV float sigm(float x) { return __builtin_amdgcn_rcpf(1.f + __expf(-x)); }
DEV float silu(float x) { return x * __builtin_amdgcn_rcpf(1.f + __expf(-x)); }
DEV float softplus(float x) { return x > 20.f ? x : log1pf(__expf(x)); }
DEV f32x4 mfma(bf16x8 a, bf16x8 b, f32x4 c) { return __builtin_amdgcn_mfma_f32_16x16x32_bf16(a, b, c, 0, 0, 0); }
DEV bf16x8 ld8(const u16* p) { return *reinterpret_cast<const bf16x8*>(p); }
DEV int lat_map(int l, int t) { return (l & 1) ? ((t & 63) * 32 + (t >> 6)) : t; }
DEV int orig_col(int n) {
  if (n < 512) return n;
  if (n < 2048) return n + 512;
  if (n < 4096) return n + 1040;
  if (n < 4608) return n - 4096 + 512;
  if (n < 5120) return n - 4608 + 2576;
  if (n < 5632) return n + 16;
  if (n < 5648) return n - 5632 + 2560;
  return -1;
}
DEV float zval(const u16* z, int rb, int cp, int n, int col) {
  if (cp < 0 && (n == 0 || n == 4)) return 0.f;
  if (cp > 63 && (n == 3 || n == 35)) return 0.f;
  return bf2f(z[(size_t)(rb + cp) * NZ + col]);
}

DEV void ph0_ada(const P& p, int item, char* smem) {
  float* sc = (float*)smem;
  for (int i = threadIdx.x; i < 9 * 1024; i += 256) {
    int v = i >> 10, d = i & 1023;
    float cv = (v < 8) ? p.c[v * 1024 + d] : p.c_ctx[d];
    sc[i] = silu(cv);
  }
  __syncthreads();
  int col = item * 256 + threadIdx.x;
  int l = col / 3072, e = col % 3072;
  const float* w = p.w_ada + (size_t)l * 1024 * 3072 + e;
  float acc[9];
#pragma unroll
  for (int i = 0; i < 9; ++i) acc[i] = 0.f;
  for (int d = 0; d < 1024; d += 4) {
    float w0 = w[(size_t)d * 3072], w1 = w[(size_t)(d + 1) * 3072], w2 = w[(size_t)(d + 2) * 3072],
          w3 = w[(size_t)(d + 3) * 3072];
#pragma unroll
    for (int i = 0; i < 9; ++i)
      acc[i] += sc[i * 1024 + d] * w0 + sc[i * 1024 + d + 1] * w1 + sc[i * 1024 + d + 2] * w2 +
                sc[i * 1024 + d + 3] * w3;
  }
  float* mod = (float*)(p.ws + O_MOD);
  float bb = p.b_ada[l * 3072 + e];
#pragma unroll
  for (int i = 0; i < 9; ++i) mod[((size_t)l * 9 + i) * 3072 + e] = acc[i] + bb;
  __syncthreads();
}
DEV void tconv_tile(const float* src, int lds_, u16* dst, int ldd, int k0, int n0, bool mapcol, char* smem) {
  float* t = (float*)smem;
  for (int i = threadIdx.x; i < 4096; i += 256) {
    int kk = i >> 6, nn = i & 63;
    int n = n0 + nn;
    int sn = mapcol ? orig_col(n) : n;
    t[kk * 65 + nn] = (sn >= 0) ? src[(size_t)(k0 + kk) * lds_ + sn] : 0.f;
  }
  __syncthreads();
  for (int i = threadIdx.x; i < 4096; i += 256) {
    int nn = i >> 6, kk = i & 63;
    dst[(size_t)(n0 + nn) * ldd + k0 + kk] = f2bf(t[kk * 65 + nn]);
  }
  __syncthreads();
}
DEV void phase0(const P& p, char* smem) {
  const int n_ada = 48, n_in = DEPTH * 16 * 90, n_out = DEPTH * 24 * 16, n_g = 128, n_lb = 4;
  const int total = n_ada + n_in + n_out + n_g + n_lb;
  for (int it = blockIdx.x; it < total; it += gridDim.x) {
    int i = it;
    if (i < n_ada) { ph0_ada(p, i, smem); continue; }
    i -= n_ada;
    if (i < n_in) {
      int l = i / 1440, r = i % 1440, kt = r / 90, nt = r % 90;
      tconv_tile(p.w_in + (size_t)l * 1024 * 5648, 5648, (u16*)(p.ws + O_WTIN) + (size_t)l * NZ * 1024, 1024, kt * 64,
                 nt * 64, true, smem);
      continue;
    }
    i -= n_in;
    if (i < n_out) {
      int l = i / 384, r = i % 384, kt = r / 16, nt = r % 16;
      tconv_tile(p.w_out + (size_t)l * 1536 * 1024, 1024, (u16*)(p.ws + O_WTOUT) + (size_t)l * 1024 * 1536, 1536,
                 kt * 64, nt * 64, false, smem);
      continue;
    }
    i -= n_out;
    if (i < n_g) {
      int h = i & 7, gate = (i >> 3) & 1, dir = (i >> 4) & 1, l = i >> 5;
      const float* src = (gate ? p.rg_w_i : p.rg_w_r) + ((size_t)(l * 2 + dir) * 8 + h) * 4096;
      tconv_tile(src, 64, (u16*)(p.ws + O_WGT) + (size_t)i * 4096, 64, 0, 0, false, smem);
      continue;
    }
    i -= n_g;
    {
      int j = i * 256 + threadIdx.x;
      float v[4], mx = -1e30f;
      for (int l = 0; l < 4; ++l) { v[l] = p.hg_lb[l * 1024 + j]; mx = fmaxf(mx, v[l]); }
      float s = 0.f;
      for (int l = 0; l < 4; ++l) { v[l] = __expf(v[l] - mx); s += v[l]; }
      float* lbs = (float*)(p.ws + O_LBS);
      float cum = 0.f;
      for (int l = 0; l < 4; ++l) {
        if (l > 0) cum += v[l] / s;
        lbs[l * 1024 + j] = cum;
      }
    }
  }
}

DEV void phaseR(const P& p, int g, int l) {
  const int tid_ = opq(threadIdx.x); const int lane = tid_ & 63, w = tid_ >> 6;
  const float* mod = (const float*)(p.ws + O_MOD);
  float* hc = (float*)(p.ws + O_HC);
  const float* o = (const float*)(p.ws + O_BSH);
  u16* u = (u16*)(p.ws + O_BIT);
  for (int it = blockIdx.x; it < GR / 4; it += gridDim.x) {
    int lr = it * 4 + w;
    int lb = lr / TS, s = lr % TS;
    bool isctx = s < TCX;
    if (l == DEPTH && isctx) continue;
    int b = g * GB + lb, t = s - TCX;
    int mi = isctx ? 8 : b;
    float* hp = isctx ? hc + ((size_t)lb * TCX + s) * 1024 : p.out + ((size_t)b * TL + t) * 1024;
    float hv[16];
    if (l == 0) {
      const float* src = isctx ? p.ctx + ((size_t)b * TCX + s) * 1024 : p.x + ((size_t)b * TL + t) * 1024;
#pragma unroll
      for (int k = 0; k < 4; ++k) {
        float4 v = *(const float4*)(src + k * 256 + lane * 4);
        hv[k * 4] = v.x; hv[k * 4 + 1] = v.y; hv[k * 4 + 2] = v.z; hv[k * 4 + 3] = v.w;
      }
    } else {
      int orow = lb * TS + (isctx ? s : TCX + lat_map(l - 1, t));
      const float* op = o + (size_t)orow * 1024;
      float ov[16], ss = 0.f;
#pragma unroll
      for (int k = 0; k < 4; ++k) {
        float4 v = *(const float4*)(op + k * 256 + lane * 4);
        ov[k * 4] = v.x; ov[k * 4 + 1] = v.y; ov[k * 4 + 2] = v.z; ov[k * 4 + 3] = v.w;
        ss += v.x * v.x + v.y * v.y + v.z * v.z + v.w * v.w;
      }
#pragma unroll
      for (int off = 32; off; off >>= 1) ss += __shfl_xor(ss, off);
      float rinv = rsqrtf(ss * (1.f / 1024.f) + EPS);
      const float* gate = mod + ((size_t)(l - 1) * 9 + mi) * 3072 + 2048;
      const float* wp = p.norm_post + (l - 1) * 1024;
#pragma unroll
      for (int k = 0; k < 4; ++k) {
        float4 hh = *(const float4*)(hp + k * 256 + lane * 4);
        float4 gg = *(const float4*)(gate + k * 256 + lane * 4);
        float4 ww = *(const float4*)(wp + k * 256 + lane * 4);
        hv[k * 4] = hh.x + gg.x * (ov[k * 4] * rinv * ww.x);
        hv[k * 4 + 1] = hh.y + gg.y * (ov[k * 4 + 1] * rinv * ww.y);
        hv[k * 4 + 2] = hh.z + gg.z * (ov[k * 4 + 2] * rinv * ww.z);
        hv[k * 4 + 3] = hh.w + gg.w * (ov[k * 4 + 3] * rinv * ww.w);
      }
    }
#pragma unroll
    for (int k = 0; k < 4; ++k)
      *(float4*)(hp + k * 256 + lane * 4) = make_float4(hv[k * 4], hv[k * 4 + 1], hv[k * 4 + 2], hv[k * 4 + 3]);
    if (l < DEPTH) {
      float ss = 0.f;
#pragma unroll
      for (int k = 0; k < 16; ++k) ss += hv[k] * hv[k];
#pragma unroll
      for (int off = 32; off; off >>= 1) ss += __shfl_xor(ss, off);
      float rinv = rsqrtf(ss * (1.f / 1024.f) + EPS);
      const float* sh = mod + ((size_t)l * 9 + mi) * 3072;
      const float* wp = p.norm_pre + l * 1024;
      int urow = lb * TS + (isctx ? s : TCX + lat_map(l, t));
      u16* up = u + (size_t)urow * 1024;
#pragma unroll
      for (int k = 0; k < 4; ++k) {
        float4 ww = *(const float4*)(wp + k * 256 + lane * 4);
        float4 s0 = *(const float4*)(sh + k * 256 + lane * 4);
        float4 s1 = *(const float4*)(sh + 1024 + k * 256 + lane * 4);
        float a0 = hv[k * 4] * rinv * ww.x * (1.f + s1.x) + s0.x;
        float a1 = hv[k * 4 + 1] * rinv * ww.y * (1.f + s1.y) + s0.y;
        float a2 = hv[k * 4 + 2] * rinv * ww.z * (1.f + s1.z) + s0.z;
        float a3 = hv[k * 4 + 3] * rinv * ww.w * (1.f + s1.w) + s0.w;
        uint2 pk; pk.x = pk2(a0, a1); pk.y = pk2(a2, a3);
        *(uint2*)(up + k * 256 + lane * 4) = pk;
      }
    }
  }
}

template <int MODE>
DEV void gemm_tile(const u16* __restrict__ A, int lda, const u16* __restrict__ Bt, int K, int rt, int ct, u16* z,
                   u16* zT, float* ab, float* o, char* smem) {
  u16* As = (u16*)smem;
  u16* Bs = As + 128 * 72;
  const int tid = opq(threadIdx.x), lane = tid & 63, w = tid >> 6, wr = w >> 1, wc = w & 1, fr = lane & 15, fq = lane >> 4;
  const int lrow = tid >> 3, lseg = tid & 7;
  const u16* Ag = A + (size_t)(rt * 128 + lrow) * lda + lseg * 8;
  const u16* Bg = Bt + (size_t)(ct * 128 + lrow) * K + lseg * 8;
  uint4 ra0, ra1, ra2, ra3, rb0, rb1, rb2, rb3;
  f32x4 acc[4][4];
#pragma unroll
  for (int i = 0; i < 4; ++i)
#pragma unroll
    for (int j = 0; j < 4; ++j) acc[i][j] = (f32x4){0.f, 0.f, 0.f, 0.f};
#define GLOAD()                                             \
  ra0 = *(const uint4*)(Ag);                                \
  ra1 = *(const uint4*)(Ag + (size_t)32 * lda);             \
  ra2 = *(const uint4*)(Ag + (size_t)64 * lda);             \
  ra3 = *(const uint4*)(Ag + (size_t)96 * lda);             \
  rb0 = *(const uint4*)(Bg);                                \
  rb1 = *(const uint4*)(Bg + (size_t)32 * K);               \
  rb2 = *(const uint4*)(Bg + (size_t)64 * K);               \
  rb3 = *(const uint4*)(Bg + (size_t)96 * K);
  GLOAD();
  const int nk = K / 64;
  for (int kt = 0; kt < nk; ++kt) {
    __syncthreads();
    *(uint4*)(As + (lrow)*72 + lseg * 8) = ra0;
    *(uint4*)(As + (lrow + 32) * 72 + lseg * 8) = ra1;
    *(uint4*)(As + (lrow + 64) * 72 + lseg * 8) = ra2;
    *(uint4*)(As + (lrow + 96) * 72 + lseg * 8) = ra3;
    *(uint4*)(Bs + (lrow)*72 + lseg * 8) = rb0;
    *(uint4*)(Bs + (lrow + 32) * 72 + lseg * 8) = rb1;
    *(uint4*)(Bs + (lrow + 64) * 72 + lseg * 8) = rb2;
    *(uint4*)(Bs + (lrow + 96) * 72 + lseg * 8) = rb3;
    __syncthreads();
    if (kt + 1 < nk) {
      Ag += 64; Bg += 64;
      GLOAD();
    }
#pragma unroll
    for (int ks = 0; ks < 2; ++ks) {
      bf16x8 af[4], bfr[4];
#pragma unroll
      for (int mi = 0; mi < 4; ++mi) af[mi] = ld8(As + (wr * 64 + mi * 16 + fr) * 72 + ks * 32 + fq * 8);
#pragma unroll
      for (int ni = 0; ni < 4; ++ni) bfr[ni] = ld8(Bs + (wc * 64 + ni * 16 + fr) * 72 + ks * 32 + fq * 8);
#pragma unroll
      for (int mi = 0; mi < 4; ++mi)
#pragma unroll
        for (int ni = 0; ni < 4; ++ni) acc[mi][ni] = mfma(af[mi], bfr[ni], acc[mi][ni]);
    }
  }
#pragma unroll
  for (int mi = 0; mi < 4; ++mi)
#pragma unroll
    for (int ni = 0; ni < 4; ++ni) {
      int row0 = rt * 128 + wr * 64 + mi * 16 + fq * 4;
      int col = ct * 128 + wc * 64 + ni * 16 + fr;
      f32x4 v = acc[mi][ni];
      if (MODE == 1) {
#pragma unroll
        for (int r = 0; r < 4; ++r) o[(size_t)(row0 + r) * 1024 + col] = v[r];
      } else {
        if (ct >= 28 && ct < 32) {
          uint2 pk; pk.x = pk2(v[0], v[1]); pk.y = pk2(v[2], v[3]);
          *(uint2*)(zT + (size_t)(col - C_IC) * GR + row0) = pk;
        } else if (ct == 44) {
          if (col - C_AB < 16) {
#pragma unroll
            for (int r = 0; r < 4; ++r) ab[(size_t)(row0 + r) * 16 + (col - C_AB)] = v[r];
          }
        } else {
#pragma unroll
          for (int r = 0; r < 4; ++r) z[(size_t)(row0 + r) * NZ + col] = f2bf(v[r]);
        }
      }
    }
}

DEV void a_item(const P& p, int l, int item, int mode, char* smem) {
  float* xc = (float*)smem;
  u16* xcb = (u16*)(smem + 16384);
  float* av = (float*)(smem + 16384 + 9216);
  float* uv = av + 4096;
  float* segP = uv + 4096;
  float* segH = segP + 256;
  const int tid = opq(threadIdx.x), lane = tid & 63, w = tid >> 6, fr = lane & 15, fq = lane >> 4;
  const int cgk = item >> 3, hA = item & 7, n = cgk % 36, rb = cgk * 64;
  u16* z = (u16*)(p.ws + O_Z);
  for (int idx = tid; idx < 4096; idx += 256) {
    int c = idx >> 6, j = idx & 63, ch = hA * 64 + j;
    float val = p.conv_a_b[l * 512 + ch];
#pragma unroll
    for (int tap = 0; tap < 4; ++tap) val += p.conv_a_w[(l * 4 + tap) * 512 + ch] * zval(z, rb, c + tap - 2, n, C_XA + ch);
    xc[idx] = val;
    xcb[c * 72 + j] = f2bf(val);
  }
  __syncthreads();
  float yacc[16];
#pragma unroll
  for (int k = 0; k < 16; ++k) yacc[k] = 0.f;
  const int seg = tid >> 6, sj = tid & 63, sch = hA * 64 + sj;
  for (int dir = 0; dir < 2; ++dir) {
    {
      const u16* wg = (const u16*)(p.ws + O_WGT);
      const u16* wr_ = wg + (size_t)((((l * 2 + dir) * 2 + 0) * 8 + hA)) * 4096;
      const u16* wi_ = wg + (size_t)((((l * 2 + dir) * 2 + 1) * 8 + hA)) * 4096;
      bf16x8 a0 = ld8(xcb + (16 * w + fr) * 72 + fq * 8), a1 = ld8(xcb + (16 * w + fr) * 72 + 32 + fq * 8);
#pragma unroll
      for (int nt = 0; nt < 4; ++nt) {
        f32x4 ar = {0.f, 0.f, 0.f, 0.f}, ai = {0.f, 0.f, 0.f, 0.f};
        const u16* br = wr_ + (nt * 16 + fr) * 64 + fq * 8;
        const u16* bi = wi_ + (nt * 16 + fr) * 64 + fq * 8;
        ar = mfma(a0, ld8(br), ar); ar = mfma(a1, ld8(br + 32), ar);
        ai = mfma(a0, ld8(bi), ai); ai = mfma(a1, ld8(bi + 32), ai);
        int j = nt * 16 + fr, ch = hA * 64 + j;
        float brv = p.rg_b_r[(l * 2 + dir) * 512 + ch], biv = p.rg_b_i[(l * 2 + dir) * 512 + ch];
        float sp = softplus(-p.rg_lam[(l * 2 + dir) * 512 + ch]);
#pragma unroll
        for (int r = 0; r < 4; ++r) {
          int c = 16 * w + 4 * fq + r;
          float rg = sigm(ar[r] + brv), ig = sigm(ai[r] + biv);
          float la = -8.f * rg * sp;
          float a = __expf(la);
          float uu = sqrtf(fmaxf(-expm1f(2.f * la), 0.f)) * (ig * xc[c * 64 + j]);
          av[c * 64 + j] = a;
          uv[c * 64 + j] = uu;
        }
      }
    }
    __syncthreads();
    {
      float Pp = 1.f, H = 0.f;
#pragma unroll
      for (int k = 0; k < 16; ++k) {
        int c = dir ? (16 * seg + 15 - k) : (16 * seg + k);
        float a = av[c * 64 + sj];
        H = a * H + uv[c * 64 + sj];
        Pp *= a;
      }
      segP[seg * 64 + sj] = Pp;
      segH[seg * 64 + sj] = H;
    }
    __syncthreads();
    if (mode == 0) {
      if (seg == 0) {
        float Pc = 1.f, Hc = 0.f;
        for (int q = 0; q < 4; ++q) {
          int sg = dir ? 3 - q : q;
          Hc = segP[sg * 64 + sj] * Hc + segH[sg * 64 + sj];
          Pc *= segP[sg * 64 + sj];
        }
        size_t idx = ((size_t)cgk * 2 + dir) * 512 + sch;
        ((float*)(p.ws + O_AP))[idx] = Pc;
        ((float*)(p.ws + O_AH))[idx] = Hc;
      }
    } else {
      float st = ((const float*)(p.ws + O_ACAR))[((size_t)cgk * 2 + dir) * 512 + sch];
      int nbefore = dir ? 3 - seg : seg;
      for (int q = 0; q < nbefore; ++q) {
        int sg = dir ? 3 - q : q;
        st = segP[sg * 64 + sj] * st + segH[sg * 64 + sj];
      }
      if (dir == 0) {
#pragma unroll
        for (int k = 0; k < 16; ++k) {
          int c = 16 * seg + k;
          st = av[c * 64 + sj] * st + uv[c * 64 + sj];
          yacc[k] += st;
        }
      } else {
#pragma unroll
        for (int k = 15; k >= 0; --k) {
          int c = 16 * seg + k;
          st = av[c * 64 + sj] * st + uv[c * 64 + sj];
          yacc[k] += st;
        }
      }
    }
    __syncthreads();
  }
  if (mode == 1) {
#pragma unroll
    for (int k = 0; k < 16; ++k) {
      size_t zi = (size_t)(rb + 16 * seg + k) * NZ + C_GA + sch;
      float gate = bf2f(z[zi]);
      z[zi] = f2bf(yacc[k] * silu(gate));
    }
  }
}

DEV void a_carry(const P& p, int item) {
  int t = item * 256 + threadIdx.x;
  int ch = t & 511, dir = (t >> 9) & 1, lb = t >> 10;
  const float* AP = (const float*)(p.ws + O_AP);
  const float* AH = (const float*)(p.ws + O_AH);
  float* AC = (float*)(p.ws + O_ACAR);
  float st = 0.f;
  for (int j = 0; j < 36; ++j) {
    int n = dir ? (j < 4 ? 3 - j : 39 - j) : j;
    size_t idx = ((size_t)(lb * 36 + n) * 2 + dir) * 512 + ch;
    AC[idx] = st;
    st = AP[idx] * st + AH[idx];
  }
}

DEV void b_local(const P& p, int l, int item, char* smem) {
  u16* qs = (u16*)smem;
  u16* ks = qs + 64 * 136;
  float* Am = (float*)(smem + 34816);
  float* gc = (float*)(smem + 34816 + 32768);
  float* bt = gc + 128;
  const int tid = opq(threadIdx.x), lane = tid & 63, w = tid >> 6, fr = lane & 15, fq = lane >> 4;
  const int cgk = item >> 2, h = item & 3, n = cgk % 36, rb = cgk * 64;
  const u16* z = (const u16*)(p.ws + O_Z);
  u16* qn = (u16*)(p.ws + O_BSH);
  u16* kn = qn + (size_t)GR * 512;
  u16* vb = kn + (size_t)GR * 512;
  u16* knT = vb + (size_t)GR * 512;
  const float* ab = (const float*)(p.ws + O_AB);
  {
    u16* Tt = (u16*)Am;
    uint4 st[5];
#define BL_TLOAD(which)                                                                                  \
  _Pragma("unroll") for (int k = 0; k < 5; ++k) {                                                        \
    int idx = tid + 256 * k, row = idx >> 4, seg = idx & 15, cp = row - 2;                               \
    bool ok = (idx < 1072) && !((cp < 0 && (n == 0 || n == 4)) || (cp > 63 && (n == 3 || n == 35)));    \
    st[k] = make_uint4(0u, 0u, 0u, 0u);                                                                  \
    if (ok) st[k] = *(const uint4*)(z + (size_t)(rb + cp) * NZ + C_Q + (which)*512 + h * 128 + seg * 8); \
  }
    BL_TLOAD(0)
#pragma unroll
    for (int which = 0; which < 3; ++which) {
#pragma unroll
      for (int k = 0; k < 5; ++k) {
        int idx = tid + 256 * k, row = idx >> 4, seg = idx & 15;
        if (idx < 1072) *(uint4*)(Tt + row * 136 + seg * 8) = st[k];
      }
      __syncthreads();
      if (which < 2) { BL_TLOAD(which + 1) }
      float cw[2][4];
#pragma unroll
      for (int hh = 0; hh < 2; ++hh)
#pragma unroll
        for (int tap = 0; tap < 4; ++tap)
          cw[hh][tap] = p.conv_b_w[(size_t)(l * 4 + tap) * 1536 + which * 512 + h * 128 + lane + 64 * hh];
      for (int c = w; c < 64; c += 4) {
        float v[2];
#pragma unroll
        for (int hh = 0; hh < 2; ++hh) {
          int d = lane + 64 * hh;
          float a = 0.f;
#pragma unroll
          for (int tap = 0; tap < 4; ++tap) a += cw[hh][tap] * bf2f(Tt[(c + tap) * 136 + d]);
          v[hh] = silu(a);
        }
        float rs = 1.f;
        if (which < 2) {
          float sq = v[0] * v[0] + v[1] * v[1];
#pragma unroll
          for (int off = 32; off; off >>= 1) sq += __shfl_xor(sq, off);
          rs = rsqrtf(sq + EPS) * (which == 0 ? 0.08838834764831845f : 1.f);
        }
#pragma unroll
        for (int hh = 0; hh < 2; ++hh) {
          int d = lane + 64 * hh;
          u16 ob = f2bf(v[hh] * rs);
          size_t gi = (size_t)(rb + c) * 512 + h * 128 + d;
          if (which == 0) { qs[c * 136 + d] = ob; qn[gi] = ob; }
          else if (which == 1) { ks[c * 136 + d] = ob; kn[gi] = ob; }
          else vb[gi] = ob;
        }
      }
      __syncthreads();
    }
  }
  if (w < 2) {
    int dir = w, i = lane, c = dir ? 63 - i : i;
    float al = ab[(size_t)(rb + c) * 16 + dir * 4 + h], bl = ab[(size_t)(rb + c) * 16 + 8 + dir * 4 + h];
    float g = -__expf(p.gdn_a_log[(l * 2 + dir) * 4 + h]) * softplus(al + p.gdn_dt_bias[(l * 2 + dir) * 4 + h]);
#pragma unroll
    for (int off = 1; off < 64; off <<= 1) {
      float v = __shfl_up(g, off);
      if (lane >= off) g += v;
    }
    gc[dir * 64 + i] = g;
    bt[dir * 64 + i] = sigm(bl);
  }
  __syncthreads();
  for (int idx = tid; idx < 1024; idx += 256) {
    int d = idx >> 3, c8 = idx & 7;
    uint4 pk;
    pk.x = (unsigned)ks[(c8 * 8 + 0) * 136 + d] | ((unsigned)ks[(c8 * 8 + 1) * 136 + d] << 16);
    pk.y = (unsigned)ks[(c8 * 8 + 2) * 136 + d] | ((unsigned)ks[(c8 * 8 + 3) * 136 + d] << 16);
    pk.z = (unsigned)ks[(c8 * 8 + 4) * 136 + d] | ((unsigned)ks[(c8 * 8 + 5) * 136 + d] << 16);
    pk.w = (unsigned)ks[(c8 * 8 + 6) * 136 + d] | ((unsigned)ks[(c8 * 8 + 7) * 136 + d] << 16);
    *(uint4*)(knT + ((size_t)(cgk * 4 + h) * 128 + d) * 64 + c8 * 8) = pk;
  }
  for (int dir = 0; dir < 2; ++dir) {
    char* rec = p.ws + O_BIT + ((size_t)(cgk * 4 + h) * 2 + dir) * BIT_SZ;
    u16* QKm = (u16*)rec + 4096;
    float* scal = (float*)(rec + 16384);
    int irow = 16 * w + fr, ci = dir ? 63 - irow : irow;
    bf16x8 ak[4], aq[4];
#pragma unroll
    for (int s = 0; s < 4; ++s) { ak[s] = ld8(ks + ci * 136 + 32 * s + 8 * fq); aq[s] = ld8(qs + ci * 136 + 32 * s + 8 * fq); }
#pragma unroll
    for (int nt = 0; nt < 4; ++nt) {
      int jcol = 16 * nt + fr, cj = dir ? 63 - jcol : jcol;
      f32x4 kk = {0.f, 0.f, 0.f, 0.f}, qk = {0.f, 0.f, 0.f, 0.f};
#pragma unroll
      for (int s = 0; s < 4; ++s) {
        bf16x8 b = ld8(ks + cj * 136 + 32 * s + 8 * fq);
        kk = mfma(ak[s], b, kk);
        qk = mfma(aq[s], b, qk);
      }
      float gj = gc[dir * 64 + jcol];
#pragma unroll
      for (int r = 0; r < 4; ++r) {
        int i = 16 * w + 4 * fq + r;
        float dec = (jcol <= i) ? __expf(gc[dir * 64 + i] - gj) : 0.f;
        Am[(dir * 64 + i) * 64 + jcol] = (jcol < i) ? bt[dir * 64 + i] * kk[r] * dec : 0.f;
        QKm[i * 64 + jcol] = f2bf(qk[r] * dec);
      }
    }
    if (tid < 64) {
      float gl = gc[dir * 64 + 63], gi = gc[dir * 64 + tid];
      scal[tid] = __expf(gi);
      scal[64 + tid] = bt[dir * 64 + tid];
      scal[128 + tid] = __expf(gl - gi);
      if (tid == 0) scal[192] = __expf(gl);
    }
  }
  __syncthreads();
  if (w < 2) {
    int dir = w, col = lane;
    u16* Tinv = (u16*)(p.ws + O_BIT + ((size_t)(cgk * 4 + h) * 2 + dir) * BIT_SZ);
    const float* Ad = Am + dir * 4096;
    float T[64];
#pragma unroll
    for (int i = 0; i < 64; ++i) {
      float s = (i == col) ? 1.f : 0.f;
#pragma unroll
      for (int j = 0; j < i; ++j) s -= Ad[i * 64 + j] * T[j];
      T[i] = s;
      Tinv[i * 64 + col] = f2bf(s);
      __builtin_amdgcn_sched_barrier(0);
    }
  }
  __syncthreads();
}

DEV void b_seq(const P& p, int bitem, char* smem) {
  const int tid = opq(threadIdx.x), lane = tid & 63, w = tid >> 6, fr = lane & 15, fq = lane >> 4;
  const bool active = w < WPB;
  const int item = bitem * WPB + (active ? w : 0);
  const int slice = item & 7, dir = (item >> 3) & 1, h = (item >> 4) & 3, lb = item >> 6, e0 = slice * 16;
  u16* Ss = (u16*)(smem + w * 11264);
  u16* Rs = Ss + 16 * 136;
  u16* Vsc = Rs + 16 * 72;
  u16* Vor = Vsc + 16 * 72;
  const u16* qn = (const u16*)(p.ws + O_BSH);
  const u16* kn = qn + (size_t)GR * 512;
  const u16* vb = kn + (size_t)GR * 512;
  const u16* knT = vb + (size_t)GR * 512;
  u16* OB = (u16*)(p.ws + O_OB);
  f32x4 S[8];
#pragma unroll
  for (int m = 0; m < 8; ++m) S[m] = (f32x4){0.f, 0.f, 0.f, 0.f};
  for (int j = 0; j < 36; ++j) {
    const int n = dir ? (j < 4 ? 3 - j : 39 - j) : j;
    const int cgk = lb * 36 + n, rb = cgk * 64;
    const char* rec = p.ws + O_BIT + ((size_t)(cgk * 4 + h) * 2 + dir) * BIT_SZ;
    const u16* Tinv = (const u16*)rec;
    const u16* QKm = Tinv + 4096;
    const float* scal = (const float*)(rec + 16384);
    if (active) {
#pragma unroll
      for (int m = 0; m < 8; ++m) {
        uint2 pk; pk.x = pk2(S[m][0], S[m][1]); pk.y = pk2(S[m][2], S[m][3]);
        *(uint2*)(Ss + fr * 136 + 16 * m + 4 * fq) = pk;
      }
    }
    __syncthreads();
    bf16x8 Sf[4];
    if (active) {
#pragma unroll
      for (int s = 0; s < 4; ++s) Sf[s] = ld8(Ss + fr * 136 + 32 * s + 8 * fq);
#pragma unroll
      for (int m = 0; m < 4; ++m) {
        int i = 16 * m + fr, rowi = rb + (dir ? 63 - i : i);
        f32x4 X = {0.f, 0.f, 0.f, 0.f};
#pragma unroll
        for (int s = 0; s < 4; ++s) X = mfma(ld8(kn + (size_t)rowi * 512 + h * 128 + 32 * s + 8 * fq), Sf[s], X);
        float rv[4];
#pragma unroll
        for (int r = 0; r < 4; ++r) {
          int ii = 16 * m + 4 * fq + r, rowr = rb + (dir ? 63 - ii : ii);
          float v = bf2f(vb[(size_t)rowr * 512 + h * 128 + e0 + fr]);
          rv[r] = scal[64 + ii] * (v - scal[ii] * X[r]);
        }
        uint2 pk; pk.x = pk2(rv[0], rv[1]); pk.y = pk2(rv[2], rv[3]);
        *(uint2*)(Rs + fr * 72 + 16 * m + 4 * fq) = pk;
      }
    }
    __syncthreads();
    if (active) {
      bf16x8 Rf0 = ld8(Rs + fr * 72 + 8 * fq), Rf1 = ld8(Rs + fr * 72 + 32 + 8 * fq);
#pragma unroll
      for (int m = 0; m < 4; ++m) {
        f32x4 VN = {0.f, 0.f, 0.f, 0.f};
        VN = mfma(ld8(Tinv + (16 * m + fr) * 64 + 8 * fq), Rf0, VN);
        VN = mfma(ld8(Tinv + (16 * m + fr) * 64 + 32 + 8 * fq), Rf1, VN);
        uint2 pk; pk.x = pk2(VN[0], VN[1]); pk.y = pk2(VN[2], VN[3]);
        *(uint2*)(Vsc + fr * 72 + 16 * m + 4 * fq) = pk;
        int ib = 16 * m + 4 * fq;
        float s0 = VN[0] * scal[128 + ib], s1 = VN[1] * scal[128 + ib + 1], s2 = VN[2] * scal[128 + ib + 2],
              s3 = VN[3] * scal[128 + ib + 3];
        if (dir) {
          pk.x = pk2(s3, s2); pk.y = pk2(s1, s0);
          *(uint2*)(Vor + fr * 72 + (60 - ib)) = pk;
        } else {
          pk.x = pk2(s0, s1); pk.y = pk2(s2, s3);
          *(uint2*)(Vor + fr * 72 + ib) = pk;
        }
      }
    }
    __syncthreads();
    if (active) {
      bf16x8 Vs0 = ld8(Vsc + fr * 72 + 8 * fq), Vs1 = ld8(Vsc + fr * 72 + 32 + 8 * fq);
      bf16x8 Vo0 = ld8(Vor + fr * 72 + 8 * fq), Vo1 = ld8(Vor + fr * 72 + 32 + 8 * fq);
#pragma unroll
      for (int m = 0; m < 4; ++m) {
        int i = 16 * m + fr, rowi = rb + (dir ? 63 - i : i);
        f32x4 O = {0.f, 0.f, 0.f, 0.f};
#pragma unroll
        for (int s = 0; s < 4; ++s) O = mfma(ld8(qn + (size_t)rowi * 512 + h * 128 + 32 * s + 8 * fq), Sf[s], O);
#pragma unroll
        for (int r = 0; r < 4; ++r) O[r] *= scal[16 * m + 4 * fq + r];
        O = mfma(ld8(QKm + (16 * m + fr) * 64 + 8 * fq), Vs0, O);
        O = mfma(ld8(QKm + (16 * m + fr) * 64 + 32 + 8 * fq), Vs1, O);
#pragma unroll
        for (int r = 0; r < 4; ++r) {
          int ii = 16 * m + 4 * fq + r, rowr = rb + (dir ? 63 - ii : ii);
          OB[((size_t)dir * GR + rowr) * 512 + h * 128 + e0 + fr] = f2bf(O[r]);
        }
      }
      float egl = scal[192];
#pragma unroll
      for (int m = 0; m < 8; ++m) {
        const u16* kt = knT + ((size_t)(cgk * 4 + h) * 128 + 16 * m + fr) * 64;
        f32x4 t = S[m];
#pragma unroll
        for (int r = 0; r < 4; ++r) t[r] *= egl;
        t = mfma(ld8(kt + 8 * fq), Vo0, t);
        t = mfma(ld8(kt + 32 + 8 * fq), Vo1, t);
        S[m] = t;
      }
    }
  }
  __syncthreads();
}

DEV void c_local(const P& p, int l, int item, char* smem) {
  float* bsm = (float*)smem;
  u16* Ps = (u16*)(smem + 33024);
  u16* kdt = (u16*)(smem + 33024 + 9216);
  const int tid = opq(threadIdx.x), lane = tid & 63, w = tid >> 6, fr = lane & 15, fq = lane >> 4;
  const int cgk = item >> 2, h = item & 3, rb = cgk * 64;
  const u16* z = (const u16*)(p.ws + O_Z);
  const u16* zT = (const u16*)(p.ws + O_ZT);
  u16* OC = (u16*)(p.ws + O_OC);
  const float* lbs = (const float*)(p.ws + O_LBS);
  for (int dir = 0; dir < 2; ++dir) {
    char* rec = p.ws + O_CREC + ((size_t)(cgk * 4 + h) * 2 + dir) * CREC_SZ;
    u16* QD = (u16*)rec;
    u16* KDT = QD + 8192;
    float* decv = (float*)(rec + 32768);
    const float* lbp = lbs + l * 1024 + dir * 512 + h * 128;
    const int fcol = C_F0 + dir * 512 + h * 128;
    {
      int d = tid & 127, half = tid >> 7;
      float lb_ = lbp[d], run = 0.f;
      for (int k = 0; k < 32; ++k) {
        int i = 32 * half + k, c = dir ? 63 - i : i;
        float f = bf2f(z[(size_t)(rb + c) * NZ + fcol + d]);
        float fg = lb_ + (1.f - lb_) * sigm(f);
        run += __logf(fg);
        bsm[i * 129 + d] = run;
      }
    }
    __syncthreads();
    {
      int d = tid & 127, half = tid >> 7;
      if (half) {
        float add = bsm[31 * 129 + d];
        for (int k = 0; k < 32; ++k) bsm[(32 + k) * 129 + d] += add;
      }
    }
    __syncthreads();
    for (int idx = tid; idx < 8192; idx += 256) {
      int i = idx >> 7, d = idx & 127, c = dir ? 63 - i : i;
      float b = bsm[i * 129 + d];
      float q = silu(bf2f(z[(size_t)(rb + c) * NZ + C_QC + h * 128 + d]));
      QD[i * 128 + d] = f2bf(q * __expf(b));
      float f = bf2f(z[(size_t)(rb + c) * NZ + fcol + d]);
      float k = (1.f - lbp[d]) * sigm(-f);
      kdt[d * 72 + c] = f2bf(k * __expf(bsm[63 * 129 + d] - b));
    }
    if (tid < 128) decv[tid] = __expf(bsm[63 * 129 + tid]);
    __syncthreads();
    for (int idx = tid; idx < 1024; idx += 256) {
      int d = idx >> 3, c8 = idx & 7;
      *(uint4*)(KDT + d * 64 + c8 * 8) = *(const uint4*)(kdt + d * 72 + c8 * 8);
    }
    {
      const int sj = w;
      for (int si = 0; si < 4; ++si) {
        f32x4 acc = {0.f, 0.f, 0.f, 0.f};
        if (si >= sj) {
          int it = 16 * si + fr, jt = 16 * sj + fr;
          int ci = dir ? 63 - it : it, cj = dir ? 63 - jt : jt;
#pragma unroll
          for (int s = 0; s < 4; ++s) {
            int d0 = 32 * s + 8 * fq;
            bf16x8 qv = ld8(z + (size_t)(rb + ci) * NZ + C_QC + h * 128 + d0);
            bf16x8 fv = ld8(z + (size_t)(rb + cj) * NZ + fcol + d0);
            bf16x8 af, bf;
#pragma unroll
            for (int e = 0; e < 8; ++e) {
              int d = d0 + e;
              float Bs_ = si ? bsm[(16 * si - 1) * 129 + d] : 0.f;
              float qq = silu(bf2f((u16)qv[e])) * __expf(bsm[it * 129 + d] - Bs_);
              float kk = (1.f - lbp[d]) * sigm(-bf2f((u16)fv[e])) * __expf(Bs_ - bsm[jt * 129 + d]);
              af[e] = (short)f2bf(qq);
              bf[e] = (short)f2bf(kk);
            }
            acc = mfma(af, bf, acc);
          }
        }
#pragma unroll
        for (int r = 0; r < 4; ++r) {
          int i = 16 * si + 4 * fq + r, jj = 16 * sj + fr;
          float v = (si >= sj && jj <= i) ? acc[r] : 0.f;
          Ps[i * 72 + (dir ? 63 - jj : jj)] = f2bf(v);
        }
        __builtin_amdgcn_sched_barrier(0);
      }
    }
    __syncthreads();
#pragma unroll
    for (int nt2 = 0; nt2 < 2; ++nt2) {
      int e = h * 128 + (2 * w + nt2) * 16 + fr;
      bf16x8 v0 = ld8(zT + (size_t)e * GR + rb + 8 * fq), v1 = ld8(zT + (size_t)e * GR + rb + 32 + 8 * fq);
#pragma unroll
      for (int m = 0; m < 4; ++m) {
        f32x4 O = {0.f, 0.f, 0.f, 0.f};
        O = mfma(ld8(Ps + (16 * m + fr) * 72 + 8 * fq), v0, O);
        O = mfma(ld8(Ps + (16 * m + fr) * 72 + 32 + 8 * fq), v1, O);
#pragma unroll
        for (int r = 0; r < 4; ++r) {
          int ii = 16 * m + 4 * fq + r, rowr = rb + (dir ? 63 - ii : ii);
          OC[((size_t)dir * GR + rowr) * 512 + e] = f2bf(O[r]);
        }
      }
    }
    __syncthreads();
  }
}

DEV void c_seq(const P& p, int bitem, char* smem) {
  const int tid = opq(threadIdx.x), lane = tid & 63, w = tid >> 6, fr = lane & 15, fq = lane >> 4;
  const bool active = w < WPB;
  const int item = bitem * WPB + (active ? w : 0);
  const int slice = item & 7, dir = (item >> 3) & 1, h = (item >> 4) & 3, lb = item >> 6, e0 = slice * 16;
  u16* Ss = (u16*)(smem + w * 4352);
  const u16* zT = (const u16*)(p.ws + O_ZT);
  u16* OC = (u16*)(p.ws + O_OC);
  f32x4 S[8];
#pragma unroll
  for (int m = 0; m < 8; ++m) S[m] = (f32x4){0.f, 0.f, 0.f, 0.f};
  for (int j = 0; j < 36; ++j) {
    const int n = dir ? (j < 4 ? 3 - j : 39 - j) : j;
    const int cgk = lb * 36 + n, rb = cgk * 64;
    const char* rec = p.ws + O_CREC + ((size_t)(cgk * 4 + h) * 2 + dir) * CREC_SZ;
    const u16* QD = (const u16*)rec;
    const u16* KDT = QD + 8192;
    const float* decv = (const float*)(rec + 32768);
    if (active) {
#pragma unroll
      for (int m = 0; m < 8; ++m) {
        uint2 pk; pk.x = pk2(S[m][0], S[m][1]); pk.y = pk2(S[m][2], S[m][3]);
        *(uint2*)(Ss + fr * 136 + 16 * m + 4 * fq) = pk;
      }
    }
    __syncthreads();
    if (active) {
      bf16x8 Sf[4];
#pragma unroll
      for (int s = 0; s < 4; ++s) Sf[s] = ld8(Ss + fr * 136 + 32 * s + 8 * fq);
#pragma unroll
      for (int m = 0; m < 4; ++m) {
        f32x4 O = {0.f, 0.f, 0.f, 0.f};
#pragma unroll
        for (int s = 0; s < 4; ++s) O = mfma(ld8(QD + (16 * m + fr) * 128 + 32 * s + 8 * fq), Sf[s], O);
#pragma unroll
        for (int r = 0; r < 4; ++r) {
          int ii = 16 * m + 4 * fq + r, rowr = rb + (dir ? 63 - ii : ii);
          size_t oi = ((size_t)dir * GR + rowr) * 512 + h * 128 + e0 + fr;
          OC[oi] = f2bf(bf2f(OC[oi]) + O[r]);
        }
      }
      const u16* vp = zT + (size_t)(h * 128 + e0 + fr) * GR + rb;
      bf16x8 V0 = ld8(vp + 8 * fq), V1 = ld8(vp + 32 + 8 * fq);
#pragma unroll
      for (int m = 0; m < 8; ++m) {
        f32x4 t = S[m];
#pragma unroll
        for (int r = 0; r < 4; ++r) t[r] *= decv[16 * m + 4 * fq + r];
        t = mfma(ld8(KDT + (16 * m + fr) * 64 + 8 * fq), V0, t);
        t = mfma(ld8(KDT + (16 * m + fr) * 64 + 32 + 8 * fq), V1, t);
        S[m] = t;
      }
    }
    __syncthreads();
  }
}

#define LBAR()                                              \
  do {                                                      \
    asm volatile("s_waitcnt lgkmcnt(0)" ::: "memory");      \
    __builtin_amdgcn_s_barrier();                           \
    asm volatile("" ::: "memory");                          \
  } while (0)
#define CBAR() asm volatile("" ::: "memory")

DEV void c_local2(const P& p, int l, int item, char* smem) {
  float* bsm = (float*)smem;
  u16* Fq = (u16*)(smem + 33024);
  u16* kdt = (u16*)(smem + 50432);
  u16* Ps = kdt;
  const int tid = opq(threadIdx.x), lane = tid & 63, w = tid >> 6, fr = lane & 15, fq = lane >> 4;
  const int cgk = item >> 2, h = item & 3, rb = cgk * 64;
  const u16* z = (const u16*)(p.ws + O_Z);
  const u16* zT = (const u16*)(p.ws + O_ZT);
  u16* OC = (u16*)(p.ws + O_OC);
  const float* lbs = (const float*)(p.ws + O_LBS);
  for (int dir = 0; dir < 2; ++dir) {
    char* rec = p.ws + O_CREC + ((size_t)(cgk * 4 + h) * 2 + dir) * CREC_SZ;
    u16* QD = (u16*)rec;
    u16* KDT = QD + 8192;
    float* decv = (float*)(rec + 32768);
    const float* lbp = lbs + l * 1024 + dir * 512 + h * 128;
    const int fcol = C_F0 + dir * 512 + h * 128;
    {
      uint4 t4[4];
#pragma unroll
      for (int k = 0; k < 4; ++k) {
        int idx = tid + 256 * k, c = idx >> 4, seg = idx & 15;
        t4[k] = *(const uint4*)(z + (size_t)(rb + c) * NZ + fcol + seg * 8);
      }
#pragma unroll
      for (int k = 0; k < 4; ++k) {
        int idx = tid + 256 * k, c = idx >> 4, seg = idx & 15;
        *(uint4*)(Fq + c * 136 + seg * 8) = t4[k];
      }
    }
    __syncthreads();
    {
      int d = tid & 127, half = tid >> 7;
      float lb_ = lbp[d], run = 0.f;
#pragma unroll 8
      for (int k = 0; k < 32; ++k) {
        int i = 32 * half + k, c = dir ? 63 - i : i;
        float f = bf2f(Fq[c * 136 + d]);
        float fg = lb_ + (1.f - lb_) * sigm(f);
        run += __logf(fg);
        bsm[i * 129 + d] = run;
      }
    }
    __syncthreads();
    {
      int d = tid & 127, half = tid >> 7;
      if (half) {
        float add = bsm[31 * 129 + d];
#pragma unroll 8
        for (int k = 0; k < 32; ++k) bsm[(32 + k) * 129 + d] += add;
      }
    }
    __syncthreads();
    {
      const int d = tid & 127, ih = tid >> 7;
      const float oml = 1.f - lbp[d], bl = bsm[63 * 129 + d];
#pragma unroll 8
      for (int k = 0; k < 32; ++k) {
        int i = 2 * k + ih, c = dir ? 63 - i : i;
        float b = bsm[i * 129 + d];
        float q = silu(bf2f(z[(size_t)(rb + c) * NZ + C_QC + h * 128 + d]));
        QD[i * 128 + d] = f2bf(q * __expf(b));
        float f = bf2f(Fq[c * 136 + d]);
        kdt[d * 72 + c] = f2bf(oml * sigm(-f) * __expf(bl - b));
      }
      if (tid < 128) decv[tid] = __expf(bl);
    }
    __syncthreads();
    for (int idx = tid; idx < 1024; idx += 256) {
      int d = idx >> 3, c8 = idx & 7;
      *(uint4*)(KDT + d * 64 + c8 * 8) = *(const uint4*)(kdt + d * 72 + c8 * 8);
    }
    bf16x8 qf[3][4];
#pragma unroll
    for (int t = 0; t < 3; ++t) {
      int k = w + 4 * t;
      int si = k < 4 ? 3 : (k < 7 ? 2 : (k < 9 ? 1 : 0));
      int it_ = 16 * si + fr, ci_ = dir ? 63 - it_ : it_;
#pragma unroll
      for (int s = 0; s < 4; ++s) qf[t][s] = ld8(z + (size_t)(rb + ci_) * NZ + C_QC + h * 128 + 32 * s + 8 * fq);
    }
    __syncthreads();
    for (int idx = tid; idx < 1536; idx += 256) {
      int tl = idx >> 8, e = idx & 255, r16 = e >> 4, c16 = e & 15;
      int si = tl < 3 ? 0 : (tl < 5 ? 1 : 2);
      int sj = tl < 3 ? tl + 1 : (tl < 5 ? tl - 1 : 3);
      int jj = 16 * sj + c16;
      Ps[(16 * si + r16) * 72 + (dir ? 63 - jj : jj)] = 0;
    }
#pragma unroll
    for (int t = 0; t < 3; ++t) {
      const int k = w + 4 * t;
      if (k < 10) {
        const int si = k < 4 ? 3 : (k < 7 ? 2 : (k < 9 ? 1 : 0));
        const int sj = k - (k < 4 ? 0 : (k < 7 ? 4 : (k < 9 ? 7 : 9)));
        const int it = 16 * si + fr, jt = 16 * sj + fr, cj = dir ? 63 - jt : jt;
        const int brow = si ? (16 * si - 1) : 0;
        const float bmul = si ? 1.f : 0.f;
        f32x4 acc = {0.f, 0.f, 0.f, 0.f};
#pragma unroll
        for (int s = 0; s < 4; ++s) {
          int d0 = 32 * s + 8 * fq;
          bf16x8 fv = ld8(Fq + cj * 136 + d0);
          bf16x8 af, bf;
#pragma unroll
          for (int e = 0; e < 8; ++e) {
            int d = d0 + e;
            float Bs_ = bmul * bsm[brow * 129 + d];
            float qq = silu(bf2f((u16)qf[t][s][e])) * __expf(bsm[it * 129 + d] - Bs_);
            float kk = (1.f - lbp[d]) * sigm(-bf2f((u16)fv[e])) * __expf(Bs_ - bsm[jt * 129 + d]);
            af[e] = (short)f2bf(qq);
            bf[e] = (short)f2bf(kk);
          }
          acc = mfma(af, bf, acc);
          __builtin_amdgcn_sched_barrier(0);
        }
#pragma unroll
        for (int r = 0; r < 4; ++r) {
          int i = 16 * si + 4 * fq + r, jj = 16 * sj + fr;
          float v = (jj <= i) ? acc[r] : 0.f;
          Ps[i * 72 + (dir ? 63 - jj : jj)] = f2bf(v);
        }
      }
    }
    __syncthreads();
#pragma unroll
    for (int nt2 = 0; nt2 < 2; ++nt2) {
      int e = h * 128 + (2 * w + nt2) * 16 + fr;
      bf16x8 v0 = ld8(zT + (size_t)e * GR + rb + 8 * fq), v1 = ld8(zT + (size_t)e * GR + rb + 32 + 8 * fq);
#pragma unroll
      for (int m = 0; m < 4; ++m) {
        f32x4 O = {0.f, 0.f, 0.f, 0.f};
        O = mfma(ld8(Ps + (16 * m + fr) * 72 + 8 * fq), v0, O);
        O = mfma(ld8(Ps + (16 * m + fr) * 72 + 32 + 8 * fq), v1, O);
#pragma unroll
        for (int r = 0; r < 4; ++r) {
          int ii = 16 * m + 4 * fq + r, rowr = rb + (dir ? 63 - ii : ii);
          OC[((size_t)dir * GR + rowr) * 512 + e] = f2bf(O[r]);
        }
      }
    }
    __syncthreads();
  }
}

DEV void b_seq2(const P& p, int bitem, char* smem) {
  const int tid = opq(threadIdx.x), lane = tid & 63, w = tid >> 6, fr = lane & 15, fq = lane >> 4;
  const int es = bitem & 3, dir = (bitem >> 2) & 1, h = (bitem >> 3) & 3, lb = bitem >> 5, e0 = es * 32;
  u16* Ss = (u16*)smem;
  u16* Rs = Ss + 32 * 136;
  u16* Vsc = Rs + 32 * 72;
  u16* Vor = Vsc + 32 * 72;
  const u16* qn = (const u16*)(p.ws + O_BSH);
  const u16* kn = qn + (size_t)GR * 512;
  const u16* vb = kn + (size_t)GR * 512;
  const u16* knT = vb + (size_t)GR * 512;
  u16* OB = (u16*)(p.ws + O_OB);
  const int mrow = 16 * w + fr, crow0 = 16 * w + 4 * fq;
  f32x4 S[2][2];
#pragma unroll
  for (int a = 0; a < 2; ++a)
#pragma unroll
    for (int b = 0; b < 2; ++b) S[a][b] = (f32x4){0.f, 0.f, 0.f, 0.f};
  bf16x8 Akn[4], Aqn[4], At[2], Aqk[2], AkT[2][2];
  u16 vbv[2][4];
  float4 eg4, be4, ek4;
  float egl;
#define BS_CHUNK(jj) (dir ? ((jj) < 4 ? 3 - (jj) : 39 - (jj)) : (jj))
#define BS_LOAD1(jj)                                                                         \
  {                                                                                          \
    const int cg_ = lb * 36 + BS_CHUNK(jj), rb_ = cg_ * 64;                                  \
    const size_t ra_ = (size_t)(rb_ + (dir ? 63 - mrow : mrow)) * 512 + h * 128 + 8 * fq;    \
    _Pragma("unroll") for (int s = 0; s < 4; ++s) {                                          \
      Akn[s] = ld8(kn + ra_ + 32 * s);                                                       \
      Aqn[s] = ld8(qn + ra_ + 32 * s);                                                       \
    }                                                                                        \
    _Pragma("unroll") for (int r = 0; r < 4; ++r) {                                          \
      const size_t rr_ = (size_t)(rb_ + (dir ? 63 - (crow0 + r) : (crow0 + r))) * 512 + h * 128 + e0 + fr; \
      vbv[0][r] = vb[rr_];                                                                   \
      vbv[1][r] = vb[rr_ + 16];                                                              \
    }                                                                                        \
    const float* sc_ = (const float*)(p.ws + O_BIT + ((size_t)(cg_ * 4 + h) * 2 + dir) * BIT_SZ + 16384); \
    eg4 = *(const float4*)(sc_ + crow0);                                                     \
    be4 = *(const float4*)(sc_ + 64 + crow0);                                                \
  }
#define BS_LOAD2(jj)                                                                         \
  {                                                                                          \
    const int cg_ = lb * 36 + BS_CHUNK(jj);                                                  \
    const char* rec_ = p.ws + O_BIT + ((size_t)(cg_ * 4 + h) * 2 + dir) * BIT_SZ;            \
    const u16* T_ = (const u16*)rec_ + mrow * 64 + 8 * fq;                                   \
    At[0] = ld8(T_); At[1] = ld8(T_ + 32);                                                   \
    ek4 = *(const float4*)((const float*)(rec_ + 16384) + 128 + crow0);                      \
  }
#define BS_LOAD3(jj)                                                                         \
  {                                                                                          \
    const int cg_ = lb * 36 + BS_CHUNK(jj);                                                  \
    const char* rec_ = p.ws + O_BIT + ((size_t)(cg_ * 4 + h) * 2 + dir) * BIT_SZ;            \
    const u16* Q_ = (const u16*)rec_ + 4096 + mrow * 64 + 8 * fq;                            \
    Aqk[0] = ld8(Q_); Aqk[1] = ld8(Q_ + 32);                                                 \
    egl = ((const float*)(rec_ + 16384))[192];                                               \
    _Pragma("unroll") for (int mm = 0; mm < 2; ++mm) {                                       \
      const u16* k_ = knT + ((size_t)(cg_ * 4 + h) * 128 + 32 * w + 16 * mm + fr) * 64 + 8 * fq; \
      AkT[mm][0] = ld8(k_); AkT[mm][1] = ld8(k_ + 32);                                       \
    }                                                                                        \
  }
  BS_LOAD1(0) BS_LOAD2(0) BS_LOAD3(0)
  for (int j = 0; j < 36; ++j) {
    const int cgk = lb * 36 + BS_CHUNK(j), rb = cgk * 64;
    const int jn = (j + 1 < 36) ? j + 1 : j;
#pragma unroll
    for (int mm = 0; mm < 2; ++mm)
#pragma unroll
      for (int nt = 0; nt < 2; ++nt) {
        uint2 pk; pk.x = pk2(S[mm][nt][0], S[mm][nt][1]); pk.y = pk2(S[mm][nt][2], S[mm][nt][3]);
        *(uint2*)(Ss + (16 * nt + fr) * 136 + 32 * w + 16 * mm + 4 * fq) = pk;
      }
    LBAR();
    f32x4 QS[2];
    {
      bf16x8 Sf[2][4];
#pragma unroll
      for (int nt = 0; nt < 2; ++nt)
#pragma unroll
        for (int s = 0; s < 4; ++s) Sf[nt][s] = ld8(Ss + (16 * nt + fr) * 136 + 32 * s + 8 * fq);
#pragma unroll
      for (int nt = 0; nt < 2; ++nt) {
        f32x4 X = {0.f, 0.f, 0.f, 0.f}, Q = {0.f, 0.f, 0.f, 0.f};
#pragma unroll
        for (int s = 0; s < 4; ++s) { X = mfma(Akn[s], Sf[nt][s], X); Q = mfma(Aqn[s], Sf[nt][s], Q); }
        float r0 = be4.x * (bf2f(vbv[nt][0]) - eg4.x * X[0]);
        float r1 = be4.y * (bf2f(vbv[nt][1]) - eg4.y * X[1]);
        float r2 = be4.z * (bf2f(vbv[nt][2]) - eg4.z * X[2]);
        float r3 = be4.w * (bf2f(vbv[nt][3]) - eg4.w * X[3]);
        uint2 pk; pk.x = pk2(r0, r1); pk.y = pk2(r2, r3);
        *(uint2*)(Rs + (16 * nt + fr) * 72 + crow0) = pk;
        Q[0] *= eg4.x; Q[1] *= eg4.y; Q[2] *= eg4.z; Q[3] *= eg4.w;
        QS[nt] = Q;
      }
    }
    CBAR();
    BS_LOAD1(jn)
    LBAR();
    {
#pragma unroll
      for (int nt = 0; nt < 2; ++nt) {
        bf16x8 Rf0 = ld8(Rs + (16 * nt + fr) * 72 + 8 * fq), Rf1 = ld8(Rs + (16 * nt + fr) * 72 + 32 + 8 * fq);
        f32x4 VN = {0.f, 0.f, 0.f, 0.f};
        VN = mfma(At[0], Rf0, VN);
        VN = mfma(At[1], Rf1, VN);
        uint2 pk; pk.x = pk2(VN[0], VN[1]); pk.y = pk2(VN[2], VN[3]);
        *(uint2*)(Vsc + (16 * nt + fr) * 72 + crow0) = pk;
        float s0 = VN[0] * ek4.x, s1 = VN[1] * ek4.y, s2 = VN[2] * ek4.z, s3 = VN[3] * ek4.w;
        if (dir) {
          pk.x = pk2(s3, s2); pk.y = pk2(s1, s0);
          *(uint2*)(Vor + (16 * nt + fr) * 72 + (60 - crow0)) = pk;
        } else {
          pk.x = pk2(s0, s1); pk.y = pk2(s2, s3);
          *(uint2*)(Vor + (16 * nt + fr) * 72 + crow0) = pk;
        }
      }
    }
    CBAR();
    BS_LOAD2(jn)
    LBAR();
    {
#pragma unroll
      for (int nt = 0; nt < 2; ++nt) {
        bf16x8 Vs0 = ld8(Vsc + (16 * nt + fr) * 72 + 8 * fq), Vs1 = ld8(Vsc + (16 * nt + fr) * 72 + 32 + 8 * fq);
        bf16x8 Vo0 = ld8(Vor + (16 * nt + fr) * 72 + 8 * fq), Vo1 = ld8(Vor + (16 * nt + fr) * 72 + 32 + 8 * fq);
        f32x4 O = QS[nt];
        O = mfma(Aqk[0], Vs0, O);
        O = mfma(Aqk[1], Vs1, O);
#pragma unroll
        for (int r = 0; r < 4; ++r) {
          int ii = crow0 + r, rowr = rb + (dir ? 63 - ii : ii);
          OB[((size_t)dir * GR + rowr) * 512 + h * 128 + e0 + 16 * nt + fr] = f2bf(O[r]);
        }
#pragma unroll
        for (int mm = 0; mm < 2; ++mm) {
          f32x4 t = S[mm][nt];
#pragma unroll
          for (int r = 0; r < 4; ++r) t[r] *= egl;
          t = mfma(AkT[mm][0], Vo0, t);
          t = mfma(AkT[mm][1], Vo1, t);
          S[mm][nt] = t;
        }
      }
    }
    CBAR();
    BS_LOAD3(jn)
  }
  LBAR();
}

DEV void c_seq2(const P& p, int bitem, char* smem) {
  const int tid = opq(threadIdx.x), lane = tid & 63, w = tid >> 6, fr = lane & 15, fq = lane >> 4;
  const int es = bitem & 3, dir = (bitem >> 2) & 1, h = (bitem >> 3) & 3, lb = bitem >> 5, e0 = es * 32;
  u16* Ssb = (u16*)smem;
  const u16* zT = (const u16*)(p.ws + O_ZT);
  u16* OC = (u16*)(p.ws + O_OC);
  const int mrow = 16 * w + fr, crow0 = 16 * w + 4 * fq;
  f32x4 S[2][2];
#pragma unroll
  for (int a = 0; a < 2; ++a)
#pragma unroll
    for (int b = 0; b < 2; ++b) S[a][b] = (f32x4){0.f, 0.f, 0.f, 0.f};
  bf16x8 Aqd[4], Akd[2][2], Vf[2][2];
  u16 oi[2][4];
  float4 dec4[2];
#define CS_LOAD(jj)                                                                          \
  {                                                                                          \
    const int cg_ = lb * 36 + BS_CHUNK(jj), rb_ = cg_ * 64;                                  \
    const char* rec_ = p.ws + O_CREC + ((size_t)(cg_ * 4 + h) * 2 + dir) * CREC_SZ;          \
    const u16* QD_ = (const u16*)rec_ + mrow * 128 + 8 * fq;                                 \
    _Pragma("unroll") for (int s = 0; s < 4; ++s) Aqd[s] = ld8(QD_ + 32 * s);                \
    _Pragma("unroll") for (int mm = 0; mm < 2; ++mm) {                                       \
      const u16* K_ = (const u16*)rec_ + 8192 + (32 * w + 16 * mm + fr) * 64 + 8 * fq;       \
      Akd[mm][0] = ld8(K_); Akd[mm][1] = ld8(K_ + 32);                                       \
      dec4[mm] = *(const float4*)((const float*)(rec_ + 32768) + 32 * w + 16 * mm + 4 * fq); \
    }                                                                                        \
    _Pragma("unroll") for (int nt = 0; nt < 2; ++nt) {                                       \
      const u16* v_ = zT + (size_t)(h * 128 + e0 + 16 * nt + fr) * GR + rb_ + 8 * fq;        \
      Vf[nt][0] = ld8(v_); Vf[nt][1] = ld8(v_ + 32);                                         \
      _Pragma("unroll") for (int r = 0; r < 4; ++r) {                                        \
        int ii_ = crow0 + r, rowr_ = rb_ + (dir ? 63 - ii_ : ii_);                           \
        oi[nt][r] = OC[((size_t)dir * GR + rowr_) * 512 + h * 128 + e0 + 16 * nt + fr];      \
      }                                                                                      \
    }                                                                                        \
  }
  CS_LOAD(0)
  for (int j = 0; j < 36; ++j) {
    const int cgk = lb * 36 + BS_CHUNK(j), rb = cgk * 64;
    const int jn = (j + 1 < 36) ? j + 1 : j;
    u16* Ss = Ssb + (j & 1) * (32 * 136);
#pragma unroll
    for (int mm = 0; mm < 2; ++mm)
#pragma unroll
      for (int nt = 0; nt < 2; ++nt) {
        uint2 pk; pk.x = pk2(S[mm][nt][0], S[mm][nt][1]); pk.y = pk2(S[mm][nt][2], S[mm][nt][3]);
        *(uint2*)(Ss + (16 * nt + fr) * 136 + 32 * w + 16 * mm + 4 * fq) = pk;
      }
    LBAR();
#pragma unroll
    for (int nt = 0; nt < 2; ++nt) {
      f32x4 O = {0.f, 0.f, 0.f, 0.f};
#pragma unroll
      for (int s = 0; s < 4; ++s) O = mfma(Aqd[s], ld8(Ss + (16 * nt + fr) * 136 + 32 * s + 8 * fq), O);
#pragma unroll
      for (int r = 0; r < 4; ++r) {
        int ii = crow0 + r, rowr = rb + (dir ? 63 - ii : ii);
        OC[((size_t)dir * GR + rowr) * 512 + h * 128 + e0 + 16 * nt + fr] = f2bf(bf2f(oi[nt][r]) + O[r]);
      }
#pragma unroll
      for (int mm = 0; mm < 2; ++mm) {
        f32x4 t = S[mm][nt];
        t[0] *= dec4[mm].x; t[1] *= dec4[mm].y; t[2] *= dec4[mm].z; t[3] *= dec4[mm].w;
        t = mfma(Akd[mm][0], Vf[nt][0], t);
        t = mfma(Akd[mm][1], Vf[nt][1], t);
        S[mm][nt] = t;
      }
    }
    CBAR();
    CS_LOAD(jn)
  }
  LBAR();
}

DEV void bc_merge(const P& p, int l, int it) {
  const int tid_ = opq(threadIdx.x); const int lane = tid_ & 63, w = tid_ >> 6;
  int lr = it * 4 + w;
  int mix = lane >> 5, cm = (lane * 16) & 511;
  const u16* O = (const u16*)(p.ws + (mix ? O_OC : O_OB));
  u16* z = (u16*)(p.ws + O_Z);
  float ov[16], ss = 0.f;
#pragma unroll
  for (int k2 = 0; k2 < 2; ++k2) {
    uint4 a = *(const uint4*)(O + (size_t)lr * 512 + cm + 8 * k2);
    uint4 b = *(const uint4*)(O + ((size_t)GR + lr) * 512 + cm + 8 * k2);
    unsigned aa[4] = {a.x, a.y, a.z, a.w}, bb[4] = {b.x, b.y, b.z, b.w};
#pragma unroll
    for (int q = 0; q < 4; ++q) {
      float v0 = bf2f((u16)(aa[q] & 0xffff)) + bf2f((u16)(bb[q] & 0xffff));
      float v1 = bf2f((u16)(aa[q] >> 16)) + bf2f((u16)(bb[q] >> 16));
      ov[k2 * 8 + q * 2] = v0; ov[k2 * 8 + q * 2 + 1] = v1;
      ss += v0 * v0 + v1 * v1;
    }
  }
  ss += __shfl_xor(ss, 1); ss += __shfl_xor(ss, 2); ss += __shfl_xor(ss, 4);
  float rinv = rsqrtf(ss * (1.f / 128.f) + EPS);
  const float* nw = (mix ? p.hg_norm : p.gdn_norm) + l * 128 + (cm & 127);
  u16* gp = z + (size_t)lr * NZ + (mix ? C_GC : C_GB) + cm;
#pragma unroll
  for (int k2 = 0; k2 < 2; ++k2) {
    uint4 gv = *(const uint4*)(gp + 8 * k2);
    unsigned gg[4] = {gv.x, gv.y, gv.z, gv.w}, oo[4];
#pragma unroll
    for (int q = 0; q < 4; ++q) {
      int e = k2 * 8 + q * 2;
      float y0 = ov[e] * rinv * nw[e] * silu(bf2f((u16)(gg[q] & 0xffff)));
      float y1 = ov[e + 1] * rinv * nw[e + 1] * silu(bf2f((u16)(gg[q] >> 16)));
      oo[q] = pk2(y0, y1);
    }
    *(uint4*)(gp + 8 * k2) = make_uint4(oo[0], oo[1], oo[2], oo[3]);
  }
}

#define XB_TMO      128
#define XB_XCNT(j)  (256  + 64 * (j))
#define XB_XSUB(j)  (1280 + 64 * (j))
#define XB_XGEN(j)  (2304 + 64 * (j))
#define XB_TOP      3328
#define XB_TOPGEN   3392
#define XCD_BAR_WORDS 3456
#define XB_SPIN_CAP (1u << 18)
#define LAS __attribute__((address_space(3)))

__device__ __forceinline__ unsigned xb_ld(unsigned* p)              { return __hip_atomic_load(p, __ATOMIC_RELAXED, __HIP_MEMORY_SCOPE_AGENT); }
__device__ __forceinline__ unsigned xb_add(unsigned* p, unsigned v) { return __hip_atomic_fetch_add(p, v, __ATOMIC_RELAXED, __HIP_MEMORY_SCOPE_AGENT); }
__device__ __forceinline__ unsigned xb_xcc_id() { return (unsigned)__builtin_amdgcn_s_getreg((3 << 11) | 20) & 0xFu; }
#define XB_SPIN(cond, bar) do { unsigned _sp = 0; while (cond) { __builtin_amdgcn_s_sleep(1); \
    if ((++_sp & 255u) == 0u) { if (xb_ld(&(bar)[XB_TMO])) break; if (_sp > XB_SPIN_CAP) { atomicAdd(&(bar)[XB_TMO], 1u); break; } } } } while (0)

struct XcdBarrier {
    unsigned* bar; unsigned x;
    volatile LAS unsigned* st;
};

__device__ __forceinline__ XcdBarrier xcd_barrier_post(unsigned* bar, volatile LAS unsigned* st) {
    XcdBarrier b; b.bar = bar; b.x = xb_xcc_id(); b.st = st;
    if (threadIdx.x == 0) (void)xb_add(&bar[XB_XCNT(b.x)], 1u);
    return b;
}
__device__ __forceinline__ void xcd_barrier_complete(unsigned* bar, unsigned x, unsigned& nloc, unsigned& nx) {
    const unsigned G = gridDim.x * gridDim.y * gridDim.z;
    unsigned sum, cnt, mine, sp = 0u;
    for (;;) {
        sum = 0u; cnt = 0u; mine = 0u;
#pragma unroll
        for (unsigned j = 0; j < 16; ++j) { const unsigned c = xb_ld(&bar[XB_XCNT(j)]); sum += c; cnt += (c > 0u) ? 1u : 0u; mine = (j == x) ? c : mine; }
        if (sum == G) break;
        __builtin_amdgcn_s_sleep(1);
        if ((++sp & 255u) == 0u) { if (xb_ld(&bar[XB_TMO])) break; if (sp > XB_SPIN_CAP) { atomicAdd(&bar[XB_TMO], 1u); break; } }
    }
    nloc = mine > 0u ? mine : 1u; nx = cnt > 0u ? cnt : 1u;
}

__device__ __forceinline__ void xcd_barrier(const XcdBarrier& b) {
    asm volatile("s_waitcnt vmcnt(0)" ::: "memory");
    __syncthreads();
    if (threadIdx.x == 0) {
        unsigned* bar = b.bar;
        __builtin_amdgcn_s_waitcnt(0);
        unsigned nloc = b.st[0], nx = b.st[1];
        if (nloc == 0u) { xcd_barrier_complete(bar, b.x, nloc, nx); b.st[0] = nloc; b.st[1] = nx; }
        const unsigned old = xb_add(&bar[XB_XSUB(b.x)], 1u);
        const unsigned gen = old / nloc;
        if (old + 1u == (gen + 1u) * nloc) {
            __builtin_amdgcn_fence(__ATOMIC_RELEASE, "agent");
            asm volatile("s_waitcnt vmcnt(0)" ::: "memory");
            const unsigned og = xb_add(&bar[XB_TOP], 1u);
            const unsigned tg = og / nx;
            if (og + 1u == (tg + 1u) * nx) xb_add(&bar[XB_TOPGEN], 1u);
            else XB_SPIN(xb_ld(&bar[XB_TOPGEN]) == tg, bar);
            __builtin_amdgcn_fence(__ATOMIC_ACQUIRE, "agent");
            xb_add(&bar[XB_XGEN(b.x)], 1u);
            asm volatile("s_waitcnt vmcnt(0)" ::: "memory");
        } else {
            XB_SPIN(xb_ld(&bar[XB_XGEN(b.x)]) == gen, bar);
            __builtin_amdgcn_fence(__ATOMIC_ACQUIRE, "agent");
            asm volatile("s_waitcnt vmcnt(0)" ::: "memory");
        }
    }
    __syncthreads();
}


#ifdef NO_G0
#define XG0(x)
#else
#define XG0(x) x
#endif
#ifdef NO_G1
#define XG1(x)
#else
#define XG1(x) x
#endif
#ifdef NO_BC
#define XBC(x)
#else
#define XBC(x) x
#endif
#ifdef NO_AC
#define XAC(x)
#else
#define XAC(x) x
#endif
#ifdef NO_P0
#define XP0(x)
#else
#define XP0(x) x
#endif
#ifdef NO_R
#define XR(x)
#else
#define XR(x) x
#endif
#ifdef NO_BL
#define XBL(x)
#else
#define XBL(x) x
#endif
#ifdef NO_CL
#define XCL(x)
#else
#define XCL(x) x
#endif
#ifdef NO_A0
#define XA0(x)
#else
#define XA0(x) x
#endif
#ifdef NO_A1
#define XA1(x)
#else
#define XA1(x) x
#endif
#ifdef NO_BS
#define XBS(x)
#else
#define XBS(x) x
#endif
#ifdef NO_CS
#define XCS(x)
#else
#define XCS(x) x
#endif
__global__ void __launch_bounds__(256, 2) fwd_mega(P p) {
  extern __shared__ __attribute__((aligned(16))) char smem[];
  cg::grid_group grid = cg::this_grid();
  const int G = gridDim.x;
  __shared__ uint4 xb_words;
  if (threadIdx.x == 0) xb_words = make_uint4(0u, 0u, 0u, 0u);
  __syncthreads();
  XcdBarrier xb = xcd_barrier_post((unsigned*)(p.ws + O_BAR), (volatile LAS unsigned*)&xb_words);
  XP0(phase0(p, smem));
  grid.sync();
  u16* z = (u16*)(p.ws + O_Z);
  u16* zT = (u16*)(p.ws + O_ZT);
  float* ab = (float*)(p.ws + O_AB);
  float* o = (float*)(p.ws + O_BSH);
  const u16* u = (const u16*)(p.ws + O_BIT);
  for (int g = 0; g < NG; ++g) {
    XR(phaseR(p, g, 0));
    xcd_barrier(xb);
    for (int l = 0; l < DEPTH; ++l) {
      for (int rep = 0; rep < REP_G; ++rep) {
        const u16* Bt = (const u16*)(p.ws + O_WTIN) + (size_t)l * NZ * 1024;
        for (int t = blockIdx.x; t < 72 * 45; t += G) { XG0(gemm_tile<0>(u, 1024, Bt, 1024, t % 72, t / 72, z, zT, ab, o, smem)); }
      }
      xcd_barrier(xb);
      for (int rep2 = 0; rep2 < REP_M; ++rep2) {
      for (int rep3 = 0; rep3 < REP_A; ++rep3) {
        if (rep3) xcd_barrier(xb);
        const int nb = NCH * 4, nc = NCH * 4, na = NCH * 8;
        for (int t = blockIdx.x; t < nb + nc + na; t += G) {
          if (t < nc) { XCL(c_local2(p, l, t, smem)); }
          else if (t < nb + nc) { XBL(b_local(p, l, t - nc, smem)); }
          else { XA0(a_item(p, l, t - nb - nc, 0, smem)); }
        }
      }
      xcd_barrier(xb);
      {
        const int nb = 128, nc = 128, na = 16;
        for (int t = blockIdx.x; t < nb + nc + na; t += G) {
          if (t < nb) { XBS(b_seq2(p, t, smem)); }
          else if (t < nb + nc) { XCS(c_seq2(p, t - nb, smem)); }
          else { XAC(a_carry(p, t - nb - nc)); }
        }
      }
      xcd_barrier(xb);
      }
      {
        const int na = NCH * 8, nm = GR / 4;
        for (int t = blockIdx.x; t < na + nm; t += G) {
          if (t < na) { XA1(a_item(p, l, t, 1, smem)); }
          else { XBC(bc_merge(p, l, t - na)); }
        }
      }
      xcd_barrier(xb);
      for (int rep = 0; rep < REP_G; ++rep) {
        const u16* Bt = (const u16*)(p.ws + O_WTOUT) + (size_t)l * 1024 * 1536;
        for (int t = blockIdx.x; t < 72 * 8; t += G) { XG1(gemm_tile<1>(z + C_GA, NZ, Bt, 1536, t % 72, t / 72, z, zT, ab, o, smem)); }
      }
      xcd_barrier(xb);
      XR(phaseR(p, g, l + 1));
      xcd_barrier(xb);
    }
  }
}

extern "C" void kernel_launch(void* const* d_in, const int* in_sizes, int n_in, void* d_out, int out_size, void* d_ws,
                              size_t ws_size, hipStream_t stream) {
  static int grid_blocks = 0;
  if (!grid_blocks) {
    int dev = 0, cus = 0, per_cu = 0;
    hipGetDevice(&dev);
    hipDeviceGetAttribute(&cus, hipDeviceAttributeMultiprocessorCount, dev);
    hipFuncSetAttribute((const void*)fwd_mega, hipFuncAttributeMaxDynamicSharedMemorySize, LDS_BYTES);
    hipOccupancyMaxActiveBlocksPerMultiprocessor(&per_cu, fwd_mega, 256, LDS_BYTES);
    if (per_cu > 2) per_cu = 2;
    if (per_cu < 1) per_cu = 1;
    grid_blocks = cus * per_cu;
  }
  if (ws_size < WS_TOTAL) {
    fprintf(stderr, "workspace too small: %zu < %zu\n", ws_size, (size_t)WS_TOTAL);
    return;
  }
  P p{};
  const float** f = (const float**)&p;
  for (int i = 0; i < 23; ++i) f[i] = (const float*)d_in[i];
  p.out = (float*)d_out;
  p.ws = (char*)d_ws;
  hipMemsetAsync((char*)d_ws + O_BAR, 0, XCD_BAR_WORDS * 4, stream);
  void* args[] = {&p};
  hipError_t e = hipLaunchCooperativeKernel((void*)fwd_mega, dim3(grid_blocks), dim3(256), args, LDS_BYTES, stream);
  if (e != hipSuccess) fprintf(stderr, "cooperative launch failed: %s (grid %d)\n", hipGetErrorString(e), grid_blocks);
}
```

```cpp
#include <hip/hip_runtime.h>
#include <hip/hip_cooperative_groups.h>
#include <cstdio>
namespace cg = cooperative_groups;

typedef __attribute__((ext_vector_type(8))) short bf16x8;
typedef __attribute__((ext_vector_type(4))) float f32x4;
typedef unsigned short u16;
#define DEV __device__ __forceinline__

constexpr int DM = 1024, TL = 2048, TCX = 256, TS = 2304, GB = 4, GR = GB * TS, NG = 2;
constexpr int NZ = 5760, DEPTH = 4;
constexpr int C_XA = 0, C_Q = 512, C_K = 1024, C_V = 1536, C_QC = 2048, C_F0 = 2560, C_IC = 3584,
              C_GA = 4096, C_GB = 4608, C_GC = 5120, C_AB = 5632;
constexpr int NCH = GR / 64;
constexpr float EPS = 1e-6f;
constexpr int WPB = 2;

constexpr size_t al256(size_t x) { return (x + 255) & ~(size_t)255; }
constexpr size_t O_WTIN = 0;
constexpr size_t O_WTOUT = O_WTIN + al256((size_t)DEPTH * NZ * 1024 * 2);
constexpr size_t O_WGT = O_WTOUT + al256((size_t)DEPTH * 1024 * 1536 * 2);
constexpr size_t O_MOD = O_WGT + al256((size_t)DEPTH * 2 * 2 * 8 * 4096 * 2);
constexpr size_t O_LBS = O_MOD + al256((size_t)DEPTH * 9 * 3072 * 4);
constexpr size_t O_HC = O_LBS + al256((size_t)DEPTH * 1024 * 4);
constexpr size_t O_Z = O_HC + al256((size_t)GB * TCX * 1024 * 4);
constexpr size_t O_ZT = O_Z + al256((size_t)GR * NZ * 2);
constexpr size_t O_AB = O_ZT + al256((size_t)512 * GR * 2);
constexpr size_t O_BSH = O_AB + al256((size_t)GR * 16 * 4);
constexpr size_t BSH_ONE = (size_t)GR * 512 * 2;
constexpr size_t O_BIT = O_BSH + al256(4 * BSH_ONE);
constexpr size_t BIT_SZ = 17408;
constexpr size_t O_CREC = O_BIT + al256((size_t)NCH * 4 * 2 * BIT_SZ);
constexpr size_t CREC_SZ = 33280;
constexpr size_t O_OB = O_CREC + al256((size_t)NCH * 4 * 2 * CREC_SZ);
constexpr size_t O_OC = O_OB + al256((size_t)2 * GR * 512 * 2);
constexpr size_t O_AP = O_OC + al256((size_t)2 * GR * 512 * 2);
constexpr size_t O_AH = O_AP + al256((size_t)NCH * 2 * 512 * 4);
constexpr size_t O_ACAR = O_AH + al256((size_t)NCH * 2 * 512 * 4);
constexpr size_t O_BAR = O_ACAR + al256((size_t)NCH * 2 * 512 * 4);
constexpr size_t WS_TOTAL = O_BAR + al256(3456 * 4);

constexpr int LDS_BYTES = 69632;
#ifndef REP_A
#define REP_A 1
#endif
#ifndef REP_G
#define REP_G 1
#endif
#ifndef REP_M
#define REP_M 1
#endif

struct P {
  const float *x, *c, *ctx, *c_ctx, *w_ada, *b_ada, *norm_pre, *norm_post, *w_in, *conv_a_w, *conv_a_b, *rg_w_r,
      *rg_b_r, *rg_w_i, *rg_b_i, *rg_lam, *conv_b_w, *gdn_a_log, *gdn_dt_bias, *gdn_norm, *hg_lb, *hg_norm, *w_out;
  float* out;
  char* ws;
};

DEV int opq(int x) { asm volatile("" : "+v"(x)); return x; }
DEV int opqs(int x) { asm volatile("" : "+s"(x)); return x; }
typedef __attribute__((ext_vector_type(2))) __bf16 bf16x2_t;
typedef __attribute__((ext_vector_type(2))) float f32x2_t;
DEV u16 f2bf(float f) { __bf16 r = (__bf16)f; return __builtin_bit_cast(u16, r); }
DEV float bf2f(u16 h) { return __uint_as_float(((unsigned)h) << 16); }
DEV unsigned pk2(float a, float b) { f32x2_t v = {a, b}; bf16x2_t r = __builtin_convertvector(v, bf16x2_t); return __builtin_bit_cast(unsigned, r); }
DEV float sigm(float x) { return __builtin_amdgcn_rcpf(1.f + __expf(-x)); }
DEV float silu(float x) { return x * __builtin_amdgcn_rcpf(1.f + __expf(-x)); }
DEV float softplus(float x) { return x > 20.f ? x : log1pf(__expf(x)); }
DEV f32x4 mfma(bf16x8 a, bf16x8 b, f32x4 c) { return __builtin_amdgcn_mfma_f32_16x16x32_bf16(a, b, c, 0, 0, 0); }
DEV bf16x8 ld8(const u16* p) { return *reinterpret_cast<const bf16x8*>(p); }
DEV int lat_map(int l, int t) { return (l & 1) ? ((t & 63) * 32 + (t >> 6)) : t; }
DEV int orig_col(int n) {
  if (n < 512) return n;
  if (n < 2048) return n + 512;
  if (n < 4096) return n + 1040;
  if (n < 4608) return n - 4096 + 512;
  if (n < 5120) return n - 4608 + 2576;
  if (n < 5632) return n + 16;
  if (n < 5648) return n - 5632 + 2560;
  return -1;
}
DEV float zval(const u16* z, int rb, int cp, int n, int col) {
  if (cp < 0 && (n == 0 || n == 4)) return 0.f;
  if (cp > 63 && (n == 3 || n == 35)) return 0.f;
  return bf2f(z[(size_t)(rb + cp) * NZ + col]);
}

DEV void ph0_ada(const P& p, int item, char* smem) {
  float* sc = (float*)smem;
  for (int i = threadIdx.x; i < 9 * 1024; i += 256) {
    int v = i >> 10, d = i & 1023;
    float cv = (v < 8) ? p.c[v * 1024 + d] : p.c_ctx[d];
    sc[i] = silu(cv);
  }
  __syncthreads();
  int col = item * 256 + threadIdx.x;
  int l = col / 3072, e = col % 3072;
  const float* w = p.w_ada + (size_t)l * 1024 * 3072 + e;
  float acc[9];
#pragma unroll
  for (int i = 0; i < 9; ++i) acc[i] = 0.f;
  for (int d = 0; d < 1024; d += 4) {
    float w0 = w[(size_t)d * 3072], w1 = w[(size_t)(d + 1) * 3072], w2 = w[(size_t)(d + 2) * 3072],
          w3 = w[(size_t)(d + 3) * 3072];
#pragma unroll
    for (int i = 0; i < 9; ++i)
      acc[i] += sc[i * 1024 + d] * w0 + sc[i * 1024 + d + 1] * w1 + sc[i * 1024 + d + 2] * w2 +
                sc[i * 1024 + d + 3] * w3;
  }
  float* mod = (float*)(p.ws + O_MOD);
  float bb = p.b_ada[l * 3072 + e];
#pragma unroll
  for (int i = 0; i < 9; ++i) mod[((size_t)l * 9 + i) * 3072 + e] = acc[i] + bb;
  __syncthreads();
}
DEV void tconv_tile(const float* src, int lds_, u16* dst, int ldd, int k0, int n0, bool mapcol, char* smem) {
  float* t = (float*)smem;
  for (int i = threadIdx.x; i < 4096; i += 256) {
    int kk = i >> 6, nn = i & 63;
    int n = n0 + nn;
    int sn = mapcol ? orig_col(n) : n;
    t[kk * 65 + nn] = (sn >= 0) ? src[(size_t)(k0 + kk) * lds_ + sn] : 0.f;
  }
  __syncthreads();
  for (int i = threadIdx.x; i < 4096; i += 256) {
    int nn = i >> 6, kk = i & 63;
    dst[(size_t)(n0 + nn) * ldd + k0 + kk] = f2bf(t[kk * 65 + nn]);
  }
  __syncthreads();
}
DEV void phase0(const P& p, char* smem) {
  const int n_ada = 48, n_in = DEPTH * 16 * 90, n_out = DEPTH * 24 * 16, n_g = 128, n_lb = 4;
  const int total = n_ada + n_in + n_out + n_g + n_lb;
  for (int it = blockIdx.x; it < total; it += gridDim.x) {
    int i = it;
    if (i < n_ada) { ph0_ada(p, i, smem); continue; }
    i -= n_ada;
    if (i < n_in) {
      int l = i / 1440, r = i % 1440, kt = r / 90, nt = r % 90;
      tconv_tile(p.w_in + (size_t)l * 1024 * 5648, 5648, (u16*)(p.ws + O_WTIN) + (size_t)l * NZ * 1024, 1024, kt * 64,
                 nt * 64, true, smem);
      continue;
    }
    i -= n_in;
    if (i < n_out) {
      int l = i / 384, r = i % 384, kt = r / 16, nt = r % 16;
      tconv_tile(p.w_out + (size_t)l * 1536 * 1024, 1024, (u16*)(p.ws + O_WTOUT) + (size_t)l * 1024 * 1536, 1536,
                 kt * 64, nt * 64, false, smem);
      continue;
    }
    i -= n_out;
    if (i < n_g) {
      int h = i & 7, gate = (i >> 3) & 1, dir = (i >> 4) & 1, l = i >> 5;
      const float* src = (gate ? p.rg_w_i : p.rg_w_r) + ((size_t)(l * 2 + dir) * 8 + h) * 4096;
      tconv_tile(src, 64, (u16*)(p.ws + O_WGT) + (size_t)i * 4096, 64, 0, 0, false, smem);
      continue;
    }
    i -= n_g;
    {
      int j = i * 256 + threadIdx.x;
      float v[4], mx = -1e30f;
      for (int l = 0; l < 4; ++l) { v[l] = p.hg_lb[l * 1024 + j]; mx = fmaxf(mx, v[l]); }
      float s = 0.f;
      for (int l = 0; l < 4; ++l) { v[l] = __expf(v[l] - mx); s += v[l]; }
      float* lbs = (float*)(p.ws + O_LBS);
      float cum = 0.f;
      for (int l = 0; l < 4; ++l) {
        if (l > 0) cum += v[l] / s;
        lbs[l * 1024 + j] = cum;
      }
    }
  }
}

DEV void phaseR(const P& p, int g, int l) {
  const int tid_ = opq(threadIdx.x); const int lane = tid_ & 63, w = tid_ >> 6;
  const float* mod = (const float*)(p.ws + O_MOD);
  float* hc = (float*)(p.ws + O_HC);
  const float* o = (const float*)(p.ws + O_BSH);
  u16* u = (u16*)(p.ws + O_BIT);
  for (int it = blockIdx.x; it < GR / 4; it += gridDim.x) {
    int lr = it * 4 + w;
    int lb = lr / TS, s = lr % TS;
    bool isctx = s < TCX;
    if (l == DEPTH && isctx) continue;
    int b = g * GB + lb, t = s - TCX;
    int mi = isctx ? 8 : b;
    float* hp = isctx ? hc + ((size_t)lb * TCX + s) * 1024 : p.out + ((size_t)b * TL + t) * 1024;
    float hv[16];
    if (l == 0) {
      const float* src = isctx ? p.ctx + ((size_t)b * TCX + s) * 1024 : p.x + ((size_t)b * TL + t) * 1024;
#pragma unroll
      for (int k = 0; k < 4; ++k) {
        float4 v = *(const float4*)(src + k * 256 + lane * 4);
        hv[k * 4] = v.x; hv[k * 4 + 1] = v.y; hv[k * 4 + 2] = v.z; hv[k * 4 + 3] = v.w;
      }
    } else {
      int orow = lb * TS + (isctx ? s : TCX + lat_map(l - 1, t));
      const float* op = o + (size_t)orow * 1024;
      float ov[16], ss = 0.f;
#pragma unroll
      for (int k = 0; k < 4; ++k) {
        float4 v = *(const float4*)(op + k * 256 + lane * 4);
        ov[k * 4] = v.x; ov[k * 4 + 1] = v.y; ov[k * 4 + 2] = v.z; ov[k * 4 + 3] = v.w;
        ss += v.x * v.x + v.y * v.y + v.z * v.z + v.w * v.w;
      }
#pragma unroll
      for (int off = 32; off; off >>= 1) ss += __shfl_xor(ss, off);
      float rinv = rsqrtf(ss * (1.f / 1024.f) + EPS);
      const float* gate = mod + ((size_t)(l - 1) * 9 + mi) * 3072 + 2048;
      const float* wp = p.norm_post + (l - 1) * 1024;
#pragma unroll
      for (int k = 0; k < 4; ++k) {
        float4 hh = *(const float4*)(hp + k * 256 + lane * 4);
        float4 gg = *(const float4*)(gate + k * 256 + lane * 4);
        float4 ww = *(const float4*)(wp + k * 256 + lane * 4);
        hv[k * 4] = hh.x + gg.x * (ov[k * 4] * rinv * ww.x);
        hv[k * 4 + 1] = hh.y + gg.y * (ov[k * 4 + 1] * rinv * ww.y);
        hv[k * 4 + 2] = hh.z + gg.z * (ov[k * 4 + 2] * rinv * ww.z);
        hv[k * 4 + 3] = hh.w + gg.w * (ov[k * 4 + 3] * rinv * ww.w);
      }
    }
#pragma unroll
    for (int k = 0; k < 4; ++k)
      *(float4*)(hp + k * 256 + lane * 4) = make_float4(hv[k * 4], hv[k * 4 + 1], hv[k * 4 + 2], hv[k * 4 + 3]);
    if (l < DEPTH) {
      float ss = 0.f;
#pragma unroll
      for (int k = 0; k < 16; ++k) ss += hv[k] * hv[k];
#pragma unroll
      for (int off = 32; off; off >>= 1) ss += __shfl_xor(ss, off);
      float rinv = rsqrtf(ss * (1.f / 1024.f) + EPS);
      const float* sh = mod + ((size_t)l * 9 + mi) * 3072;
      const float* wp = p.norm_pre + l * 1024;
      int urow = lb * TS + (isctx ? s : TCX + lat_map(l, t));
      u16* up = u + (size_t)urow * 1024;
#pragma unroll
      for (int k = 0; k < 4; ++k) {
        float4 ww = *(const float4*)(wp + k * 256 + lane * 4);
        float4 s0 = *(const float4*)(sh + k * 256 + lane * 4);
        float4 s1 = *(const float4*)(sh + 1024 + k * 256 + lane * 4);
        float a0 = hv[k * 4] * rinv * ww.x * (1.f + s1.x) + s0.x;
        float a1 = hv[k * 4 + 1] * rinv * ww.y * (1.f + s1.y) + s0.y;
        float a2 = hv[k * 4 + 2] * rinv * ww.z * (1.f + s1.z) + s0.z;
        float a3 = hv[k * 4 + 3] * rinv * ww.w * (1.f + s1.w) + s0.w;
        uint2 pk; pk.x = pk2(a0, a1); pk.y = pk2(a2, a3);
        *(uint2*)(up + k * 256 + lane * 4) = pk;
      }
    }
  }
}

template <int MODE>
DEV void gemm_tile(const u16* __restrict__ A, int lda, const u16* __restrict__ Bt, int K, int rt, int ct, u16* z,
                   u16* zT, float* ab, float* o, char* smem) {
  u16* As = (u16*)smem;
  u16* Bs = As + 128 * 72;
  const int tid = opq(threadIdx.x), lane = tid & 63, w = tid >> 6, wr = w >> 1, wc = w & 1, fr = lane & 15, fq = lane >> 4;
  const int lrow = tid >> 3, lseg = tid & 7;
  const u16* Ag = A + (size_t)(rt * 128 + lrow) * lda + lseg * 8;
  const u16* Bg = Bt + (size_t)(ct * 128 + lrow) * K + lseg * 8;
  uint4 ra0, ra1, ra2, ra3, rb0, rb1, rb2, rb3;
  f32x4 acc[4][4];
#pragma unroll
  for (int i = 0; i < 4; ++i)
#pragma unroll
    for (int j = 0; j < 4; ++j) acc[i][j] = (f32x4){0.f, 0.f, 0.f, 0.f};
#define GLOAD()                                             \
  ra0 = *(const uint4*)(Ag);                                \
  ra1 = *(const uint4*)(Ag + (size_t)32 * lda);             \
  ra2 = *(const uint4*)(Ag + (size_t)64 * lda);             \
  ra3 = *(const uint4*)(Ag + (size_t)96 * lda);             \
  rb0 = *(const uint4*)(Bg);                                \
  rb1 = *(const uint4*)(Bg + (size_t)32 * K);               \
  rb2 = *(const uint4*)(Bg + (size_t)64 * K);               \
  rb3 = *(const uint4*)(Bg + (size_t)96 * K);
  GLOAD();
  const int nk = K / 64;
  for (int kt = 0; kt < nk; ++kt) {
    __syncthreads();
    *(uint4*)(As + (lrow)*72 + lseg * 8) = ra0;
    *(uint4*)(As + (lrow + 32) * 72 + lseg * 8) = ra1;
    *(uint4*)(As + (lrow + 64) * 72 + lseg * 8) = ra2;
    *(uint4*)(As + (lrow + 96) * 72 + lseg * 8) = ra3;
    *(uint4*)(Bs + (lrow)*72 + lseg * 8) = rb0;
    *(uint4*)(Bs + (lrow + 32) * 72 + lseg * 8) = rb1;
    *(uint4*)(Bs + (lrow + 64) * 72 + lseg * 8) = rb2;
    *(uint4*)(Bs + (lrow + 96) * 72 + lseg * 8) = rb3;
    __syncthreads();
    if (kt + 1 < nk) {
      Ag += 64; Bg += 64;
      GLOAD();
    }
#pragma unroll
    for (int ks = 0; ks < 2; ++ks) {
      bf16x8 af[4], bfr[4];
#pragma unroll
      for (int mi = 0; mi < 4; ++mi) af[mi] = ld8(As + (wr * 64 + mi * 16 + fr) * 72 + ks * 32 + fq * 8);
#pragma unroll
      for (int ni = 0; ni < 4; ++ni) bfr[ni] = ld8(Bs + (wc * 64 + ni * 16 + fr) * 72 + ks * 32 + fq * 8);
#pragma unroll
      for (int mi = 0; mi < 4; ++mi)
#pragma unroll
        for (int ni = 0; ni < 4; ++ni) acc[mi][ni] = mfma(af[mi], bfr[ni], acc[mi][ni]);
    }
  }
#pragma unroll
  for (int mi = 0; mi < 4; ++mi)
#pragma unroll
    for (int ni = 0; ni < 4; ++ni) {
      int row0 = rt * 128 + wr * 64 + mi * 16 + fq * 4;
      int col = ct * 128 + wc * 64 + ni * 16 + fr;
      f32x4 v = acc[mi][ni];
      if (MODE == 1) {
#pragma unroll
        for (int r = 0; r < 4; ++r) o[(size_t)(row0 + r) * 1024 + col] = v[r];
      } else {
        if (ct >= 28 && ct < 32) {
          uint2 pk; pk.x = pk2(v[0], v[1]); pk.y = pk2(v[2], v[3]);
          *(uint2*)(zT + (size_t)(col - C_IC) * GR + row0) = pk;
        } else if (ct == 44) {
          if (col - C_AB < 16) {
#pragma unroll
            for (int r = 0; r < 4; ++r) ab[(size_t)(row0 + r) * 16 + (col - C_AB)] = v[r];
          }
        } else {
#pragma unroll
          for (int r = 0; r < 4; ++r) z[(size_t)(row0 + r) * NZ + col] = f2bf(v[r]);
        }
      }
    }
}

DEV void a_item(const P& p, int l, int item, int mode, char* smem) {
  float* xc = (float*)smem;
  u16* xcb = (u16*)(smem + 16384);
  float* av = (float*)(smem + 16384 + 9216);
  float* uv = av + 4096;
  float* segP = uv + 4096;
  float* segH = segP + 256;
  const int tid = opq(threadIdx.x), lane = tid & 63, w = tid >> 6, fr = lane & 15, fq = lane >> 4;
  const int cgk = item >> 3, hA = item & 7, n = cgk % 36, rb = cgk * 64;
  u16* z = (u16*)(p.ws + O_Z);
  for (int idx = tid; idx < 4096; idx += 256) {
    int c = idx >> 6, j = idx & 63, ch = hA * 64 + j;
    float val = p.conv_a_b[l * 512 + ch];
#pragma unroll
    for (int tap = 0; tap < 4; ++tap) val += p.conv_a_w[(l * 4 + tap) * 512 + ch] * zval(z, rb, c + tap - 2, n, C_XA + ch);
    xc[idx] = val;
    xcb[c * 72 + j] = f2bf(val);
  }
  __syncthreads();
  float yacc[16];
#pragma unroll
  for (int k = 0; k < 16; ++k) yacc[k] = 0.f;
  const int seg = tid >> 6, sj = tid & 63, sch = hA * 64 + sj;
  for (int dir = 0; dir < 2; ++dir) {
    {
      const u16* wg = (const u16*)(p.ws + O_WGT);
      const u16* wr_ = wg + (size_t)((((l * 2 + dir) * 2 + 0) * 8 + hA)) * 4096;
      const u16* wi_ = wg + (size_t)((((l * 2 + dir) * 2 + 1) * 8 + hA)) * 4096;
      bf16x8 a0 = ld8(xcb + (16 * w + fr) * 72 + fq * 8), a1 = ld8(xcb + (16 * w + fr) * 72 + 32 + fq * 8);
#pragma unroll
      for (int nt = 0; nt < 4; ++nt) {
        f32x4 ar = {0.f, 0.f, 0.f, 0.f}, ai = {0.f, 0.f, 0.f, 0.f};
        const u16* br = wr_ + (nt * 16 + fr) * 64 + fq * 8;
        const u16* bi = wi_ + (nt * 16 + fr) * 64 + fq * 8;
        ar = mfma(a0, ld8(br), ar); ar = mfma(a1, ld8(br + 32), ar);
        ai = mfma(a0, ld8(bi), ai); ai = mfma(a1, ld8(bi + 32), ai);
        int j = nt * 16 + fr, ch = hA * 64 + j;
        float brv = p.rg_b_r[(l * 2 + dir) * 512 + ch], biv = p.rg_b_i[(l * 2 + dir) * 512 + ch];
        float sp = softplus(-p.rg_lam[(l * 2 + dir) * 512 + ch]);
#pragma unroll
        for (int r = 0; r < 4; ++r) {
          int c = 16 * w + 4 * fq + r;
          float rg = sigm(ar[r] + brv), ig = sigm(ai[r] + biv);
          float la = -8.f * rg * sp;
          float a = __expf(la);
          float uu = sqrtf(fmaxf(-expm1f(2.f * la), 0.f)) * (ig * xc[c * 64 + j]);
          av[c * 64 + j] = a;
          uv[c * 64 + j] = uu;
        }
      }
    }
    __syncthreads();
    {
      float Pp = 1.f, H = 0.f;
#pragma unroll
      for (int k = 0; k < 16; ++k) {
        int c = dir ? (16 * seg + 15 - k) : (16 * seg + k);
        float a = av[c * 64 + sj];
        H = a * H + uv[c * 64 + sj];
        Pp *= a;
      }
      segP[seg * 64 + sj] = Pp;
      segH[seg * 64 + sj] = H;
    }
    __syncthreads();
    if (mode == 0) {
      if (seg == 0) {
        float Pc = 1.f, Hc = 0.f;
        for (int q = 0; q < 4; ++q) {
          int sg = dir ? 3 - q : q;
          Hc = segP[sg * 64 + sj] * Hc + segH[sg * 64 + sj];
          Pc *= segP[sg * 64 + sj];
        }
        size_t idx = ((size_t)cgk * 2 + dir) * 512 + sch;
        ((float*)(p.ws + O_AP))[idx] = Pc;
        ((float*)(p.ws + O_AH))[idx] = Hc;
      }
    } else {
      float st = ((const float*)(p.ws + O_ACAR))[((size_t)cgk * 2 + dir) * 512 + sch];
      int nbefore = dir ? 3 - seg : seg;
      for (int q = 0; q < nbefore; ++q) {
        int sg = dir ? 3 - q : q;
        st = segP[sg * 64 + sj] * st + segH[sg * 64 + sj];
      }
      if (dir == 0) {
#pragma unroll
        for (int k = 0; k < 16; ++k) {
          int c = 16 * seg + k;
          st = av[c * 64 + sj] * st + uv[c * 64 + sj];
          yacc[k] += st;
        }
      } else {
#pragma unroll
        for (int k = 15; k >= 0; --k) {
          int c = 16 * seg + k;
          st = av[c * 64 + sj] * st + uv[c * 64 + sj];
          yacc[k] += st;
        }
      }
    }
    __syncthreads();
  }
  if (mode == 1) {
#pragma unroll
    for (int k = 0; k < 16; ++k) {
      size_t zi = (size_t)(rb + 16 * seg + k) * NZ + C_GA + sch;
      float gate = bf2f(z[zi]);
      z[zi] = f2bf(yacc[k] * silu(gate));
    }
  }
}

DEV void a_carry(const P& p, int item) {
  int t = item * 256 + threadIdx.x;
  int ch = t & 511, dir = (t >> 9) & 1, lb = t >> 10;
  const float* AP = (const float*)(p.ws + O_AP);
  const float* AH = (const float*)(p.ws + O_AH);
  float* AC = (float*)(p.ws + O_ACAR);
  float st = 0.f;
  for (int j = 0; j < 36; ++j) {
    int n = dir ? (j < 4 ? 3 - j : 39 - j) : j;
    size_t idx = ((size_t)(lb * 36 + n) * 2 + dir) * 512 + ch;
    AC[idx] = st;
    st = AP[idx] * st + AH[idx];
  }
}

DEV void b_local(const P& p, int l, int item, char* smem) {
  u16* qs = (u16*)smem;
  u16* ks = qs + 64 * 136;
  float* Am = (float*)(smem + 34816);
  float* gc = (float*)(smem + 34816 + 32768);
  float* bt = gc + 128;
  const int tid = opq(threadIdx.x), lane = tid & 63, w = tid >> 6, fr = lane & 15, fq = lane >> 4;
  const int cgk = item >> 2, h = item & 3, n = cgk % 36, rb = cgk * 64;
  const u16* z = (const u16*)(p.ws + O_Z);
  u16* qn = (u16*)(p.ws + O_BSH);
  u16* kn = qn + (size_t)GR * 512;
  u16* vb = kn + (size_t)GR * 512;
  u16* knT = vb + (size_t)GR * 512;
  const float* ab = (const float*)(p.ws + O_AB);
  {
    u16* Tt = (u16*)Am;
    uint4 st[5];
#define BL_TLOAD(which)                                                                                  \
  _Pragma("unroll") for (int k = 0; k < 5; ++k) {                                                        \
    int idx = tid + 256 * k, row = idx >> 4, seg = idx & 15, cp = row - 2;                               \
    bool ok = (idx < 1072) && !((cp < 0 && (n == 0 || n == 4)) || (cp > 63 && (n == 3 || n == 35)));    \
    st[k] = make_uint4(0u, 0u, 0u, 0u);                                                                  \
    if (ok) st[k] = *(const uint4*)(z + (size_t)(rb + cp) * NZ + C_Q + (which)*512 + h * 128 + seg * 8); \
  }
    BL_TLOAD(0)
#pragma unroll
    for (int which = 0; which < 3; ++which) {
#pragma unroll
      for (int k = 0; k < 5; ++k) {
        int idx = tid + 256 * k, row = idx >> 4, seg = idx & 15;
        if (idx < 1072) *(uint4*)(Tt + row * 136 + seg * 8) = st[k];
      }
      __syncthreads();
      if (which < 2) { BL_TLOAD(which + 1) }
      float cw[2][4];
#pragma unroll
      for (int hh = 0; hh < 2; ++hh)
#pragma unroll
        for (int tap = 0; tap < 4; ++tap)
          cw[hh][tap] = p.conv_b_w[(size_t)(l * 4 + tap) * 1536 + which * 512 + h * 128 + lane + 64 * hh];
      for (int c = w; c < 64; c += 4) {
        float v[2];
#pragma unroll
        for (int hh = 0; hh < 2; ++hh) {
          int d = lane + 64 * hh;
          float a = 0.f;
#pragma unroll
          for (int tap = 0; tap < 4; ++tap) a += cw[hh][tap] * bf2f(Tt[(c + tap) * 136 + d]);
          v[hh] = silu(a);
        }
        float rs = 1.f;
        if (which < 2) {
          float sq = v[0] * v[0] + v[1] * v[1];
#pragma unroll
          for (int off = 32; off; off >>= 1) sq += __shfl_xor(sq, off);
          rs = rsqrtf(sq + EPS) * (which == 0 ? 0.08838834764831845f : 1.f);
        }
#pragma unroll
        for (int hh = 0; hh < 2; ++hh) {
          int d = lane + 64 * hh;
          u16 ob = f2bf(v[hh] * rs);
          size_t gi = (size_t)(rb + c) * 512 + h * 128 + d;
          if (which == 0) { qs[c * 136 + d] = ob; qn[gi] = ob; }
          else if (which == 1) { ks[c * 136 + d] = ob; kn[gi] = ob; }
          else vb[gi] = ob;
        }
      }
      __syncthreads();
    }
  }
  if (w < 2) {
    int dir = w, i = lane, c = dir ? 63 - i : i;
    float al = ab[(size_t)(rb + c) * 16 + dir * 4 + h], bl = ab[(size_t)(rb + c) * 16 + 8 + dir * 4 + h];
    float g = -__expf(p.gdn_a_log[(l * 2 + dir) * 4 + h]) * softplus(al + p.gdn_dt_bias[(l * 2 + dir) * 4 + h]);
#pragma unroll
    for (int off = 1; off < 64; off <<= 1) {
      float v = __shfl_up(g, off);
      if (lane >= off) g += v;
    }
    gc[dir * 64 + i] = g;
    bt[dir * 64 + i] = sigm(bl);
  }
  __syncthreads();
  for (int idx = tid; idx < 1024; idx += 256) {
    int d = idx >> 3, c8 = idx & 7;
    uint4 pk;
    pk.x = (unsigned)ks[(c8 * 8 + 0) * 136 + d] | ((unsigned)ks[(c8 * 8 + 1) * 136 + d] << 16);
    pk.y = (unsigned)ks[(c8 * 8 + 2) * 136 + d] | ((unsigned)ks[(c8 * 8 + 3) * 136 + d] << 16);
    pk.z = (unsigned)ks[(c8 * 8 + 4) * 136 + d] | ((unsigned)ks[(c8 * 8 + 5) * 136 + d] << 16);
    pk.w = (unsigned)ks[(c8 * 8 + 6) * 136 + d] | ((unsigned)ks[(c8 * 8 + 7) * 136 + d] << 16);
    *(uint4*)(knT + ((size_t)(cgk * 4 + h) * 128 + d) * 64 + c8 * 8) = pk;
  }
  for (int dir = 0; dir < 2; ++dir) {
    char* rec = p.ws + O_BIT + ((size_t)(cgk * 4 + h) * 2 + dir) * BIT_SZ;
    u16* QKm = (u16*)rec + 4096;
    float* scal = (float*)(rec + 16384);
    int irow = 16 * w + fr, ci = dir ? 63 - irow : irow;
    bf16x8 ak[4], aq[4];
#pragma unroll
    for (int s = 0; s < 4; ++s) { ak[s] = ld8(ks + ci * 136 + 32 * s + 8 * fq); aq[s] = ld8(qs + ci * 136 + 32 * s + 8 * fq); }
#pragma unroll
    for (int nt = 0; nt < 4; ++nt) {
      int jcol = 16 * nt + fr, cj = dir ? 63 - jcol : jcol;
      f32x4 kk = {0.f, 0.f, 0.f, 0.f}, qk = {0.f, 0.f, 0.f, 0.f};
#pragma unroll
      for (int s = 0; s < 4; ++s) {
        bf16x8 b = ld8(ks + cj * 136 + 32 * s + 8 * fq);
        kk = mfma(ak[s], b, kk);
        qk = mfma(aq[s], b, qk);
      }
      float gj = gc[dir * 64 + jcol];
#pragma unroll
      for (int r = 0; r < 4; ++r) {
        int i = 16 * w + 4 * fq + r;
        float dec = (jcol <= i) ? __expf(gc[dir * 64 + i] - gj) : 0.f;
        Am[(dir * 64 + i) * 64 + jcol] = (jcol < i) ? bt[dir * 64 + i] * kk[r] * dec : 0.f;
        QKm[i * 64 + jcol] = f2bf(qk[r] * dec);
      }
    }
    if (tid < 64) {
      float gl = gc[dir * 64 + 63], gi = gc[dir * 64 + tid];
      scal[tid] = __expf(gi);
      scal[64 + tid] = bt[dir * 64 + tid];
      scal[128 + tid] = __expf(gl - gi);
      if (tid == 0) scal[192] = __expf(gl);
    }
  }
  __syncthreads();
  if (w < 2) {
    int dir = w, col = lane;
    u16* Tinv = (u16*)(p.ws + O_BIT + ((size_t)(cgk * 4 + h) * 2 + dir) * BIT_SZ);
    const float* Ad = Am + dir * 4096;
    float T[64];
#pragma unroll
    for (int i = 0; i < 64; ++i) {
      float s = (i == col) ? 1.f : 0.f;
#pragma unroll
      for (int j = 0; j < i; ++j) s -= Ad[i * 64 + j] * T[j];
      T[i] = s;
      Tinv[i * 64 + col] = f2bf(s);
      __builtin_amdgcn_sched_barrier(0);
    }
  }
  __syncthreads();
}

DEV void b_seq(const P& p, int bitem, char* smem) {
  const int tid = opq(threadIdx.x), lane = tid & 63, w = tid >> 6, fr = lane & 15, fq = lane >> 4;
  const bool active = w < WPB;
  const int item = bitem * WPB + (active ? w : 0);
  const int slice = item & 7, dir = (item >> 3) & 1, h = (item >> 4) & 3, lb = item >> 6, e0 = slice * 16;
  u16* Ss = (u16*)(smem + w * 11264);
  u16* Rs = Ss + 16 * 136;
  u16* Vsc = Rs + 16 * 72;
  u16* Vor = Vsc + 16 * 72;
  const u16* qn = (const u16*)(p.ws + O_BSH);
  const u16* kn = qn + (size_t)GR * 512;
  const u16* vb = kn + (size_t)GR * 512;
  const u16* knT = vb + (size_t)GR * 512;
  u16* OB = (u16*)(p.ws + O_OB);
  f32x4 S[8];
#pragma unroll
  for (int m = 0; m < 8; ++m) S[m] = (f32x4){0.f, 0.f, 0.f, 0.f};
  for (int j = 0; j < 36; ++j) {
    const int n = dir ? (j < 4 ? 3 - j : 39 - j) : j;
    const int cgk = lb * 36 + n, rb = cgk * 64;
    const char* rec = p.ws + O_BIT + ((size_t)(cgk * 4 + h) * 2 + dir) * BIT_SZ;
    const u16* Tinv = (const u16*)rec;
    const u16* QKm = Tinv + 4096;
    const float* scal = (const float*)(rec + 16384);
    if (active) {
#pragma unroll
      for (int m = 0; m < 8; ++m) {
        uint2 pk; pk.x = pk2(S[m][0], S[m][1]); pk.y = pk2(S[m][2], S[m][3]);
        *(uint2*)(Ss + fr * 136 + 16 * m + 4 * fq) = pk;
      }
    }
    __syncthreads();
    bf16x8 Sf[4];
    if (active) {
#pragma unroll
      for (int s = 0; s < 4; ++s) Sf[s] = ld8(Ss + fr * 136 + 32 * s + 8 * fq);
#pragma unroll
      for (int m = 0; m < 4; ++m) {
        int i = 16 * m + fr, rowi = rb + (dir ? 63 - i : i);
        f32x4 X = {0.f, 0.f, 0.f, 0.f};
#pragma unroll
        for (int s = 0; s < 4; ++s) X = mfma(ld8(kn + (size_t)rowi * 512 + h * 128 + 32 * s + 8 * fq), Sf[s], X);
        float rv[4];
#pragma unroll
        for (int r = 0; r < 4; ++r) {
          int ii = 16 * m + 4 * fq + r, rowr = rb + (dir ? 63 - ii : ii);
          float v = bf2f(vb[(size_t)rowr * 512 + h * 128 + e0 + fr]);
          rv[r] = scal[64 + ii] * (v - scal[ii] * X[r]);
        }
        uint2 pk; pk.x = pk2(rv[0], rv[1]); pk.y = pk2(rv[2], rv[3]);
        *(uint2*)(Rs + fr * 72 + 16 * m + 4 * fq) = pk;
      }
    }
    __syncthreads();
    if (active) {
      bf16x8 Rf0 = ld8(Rs + fr * 72 + 8 * fq), Rf1 = ld8(Rs + fr * 72 + 32 + 8 * fq);
#pragma unroll
      for (int m = 0; m < 4; ++m) {
        f32x4 VN = {0.f, 0.f, 0.f, 0.f};
        VN = mfma(ld8(Tinv + (16 * m + fr) * 64 + 8 * fq), Rf0, VN);
        VN = mfma(ld8(Tinv + (16 * m + fr) * 64 + 32 + 8 * fq), Rf1, VN);
        uint2 pk; pk.x = pk2(VN[0], VN[1]); pk.y = pk2(VN[2], VN[3]);
        *(uint2*)(Vsc + fr * 72 + 16 * m + 4 * fq) = pk;
        int ib = 16 * m + 4 * fq;
        float s0 = VN[0] * scal[128 + ib], s1 = VN[1] * scal[128 + ib + 1], s2 = VN[2] * scal[128 + ib + 2],
              s3 = VN[3] * scal[128 + ib + 3];
        if (dir) {
          pk.x = pk2(s3, s2); pk.y = pk2(s1, s0);
          *(uint2*)(Vor + fr * 72 + (60 - ib)) = pk;
        } else {
          pk.x = pk2(s0, s1); pk.y = pk2(s2, s3);
          *(uint2*)(Vor + fr * 72 + ib) = pk;
        }
      }
    }
    __syncthreads();
    if (active) {
      bf16x8 Vs0 = ld8(Vsc + fr * 72 + 8 * fq), Vs1 = ld8(Vsc + fr * 72 + 32 + 8 * fq);
      bf16x8 Vo0 = ld8(Vor + fr * 72 + 8 * fq), Vo1 = ld8(Vor + fr * 72 + 32 + 8 * fq);
#pragma unroll
      for (int m = 0; m < 4; ++m) {
        int i = 16 * m + fr, rowi = rb + (dir ? 63 - i : i);
        f32x4 O = {0.f, 0.f, 0.f, 0.f};
#pragma unroll
        for (int s = 0; s < 4; ++s) O = mfma(ld8(qn + (size_t)rowi * 512 + h * 128 + 32 * s + 8 * fq), Sf[s], O);
#pragma unroll
        for (int r = 0; r < 4; ++r) O[r] *= scal[16 * m + 4 * fq + r];
        O = mfma(ld8(QKm + (16 * m + fr) * 64 + 8 * fq), Vs0, O);
        O = mfma(ld8(QKm + (16 * m + fr) * 64 + 32 + 8 * fq), Vs1, O);
#pragma unroll
        for (int r = 0; r < 4; ++r) {
          int ii = 16 * m + 4 * fq + r, rowr = rb + (dir ? 63 - ii : ii);
          OB[((size_t)dir * GR + rowr) * 512 + h * 128 + e0 + fr] = f2bf(O[r]);
        }
      }
      float egl = scal[192];
#pragma unroll
      for (int m = 0; m < 8; ++m) {
        const u16* kt = knT + ((size_t)(cgk * 4 + h) * 128 + 16 * m + fr) * 64;
        f32x4 t = S[m];
#pragma unroll
        for (int r = 0; r < 4; ++r) t[r] *= egl;
        t = mfma(ld8(kt + 8 * fq), Vo0, t);
        t = mfma(ld8(kt + 32 + 8 * fq), Vo1, t);
        S[m] = t;
      }
    }
  }
  __syncthreads();
}

DEV void c_local(const P& p, int l, int item, char* smem) {
  float* bsm = (float*)smem;
  u16* Ps = (u16*)(smem + 33024);
  u16* kdt = (u16*)(smem + 33024 + 9216);
  const int tid = opq(threadIdx.x), lane = tid & 63, w = tid >> 6, fr = lane & 15, fq = lane >> 4;
  const int cgk = item >> 2, h = item & 3, rb = cgk * 64;
  const u16* z = (const u16*)(p.ws + O_Z);
  const u16* zT = (const u16*)(p.ws + O_ZT);
  u16* OC = (u16*)(p.ws + O_OC);
  const float* lbs = (const float*)(p.ws + O_LBS);
  for (int dir = 0; dir < 2; ++dir) {
    char* rec = p.ws + O_CREC + ((size_t)(cgk * 4 + h) * 2 + dir) * CREC_SZ;
    u16* QD = (u16*)rec;
    u16* KDT = QD + 8192;
    float* decv = (float*)(rec + 32768);
    const float* lbp = lbs + l * 1024 + dir * 512 + h * 128;
    const int fcol = C_F0 + dir * 512 + h * 128;
    {
      int d = tid & 127, half = tid >> 7;
      float lb_ = lbp[d], run = 0.f;
      for (int k = 0; k < 32; ++k) {
        int i = 32 * half + k, c = dir ? 63 - i : i;
        float f = bf2f(z[(size_t)(rb + c) * NZ + fcol + d]);
        float fg = lb_ + (1.f - lb_) * sigm(f);
        run += __logf(fg);
        bsm[i * 129 + d] = run;
      }
    }
    __syncthreads();
    {
      int d = tid & 127, half = tid >> 7;
      if (half) {
        float add = bsm[31 * 129 + d];
        for (int k = 0; k < 32; ++k) bsm[(32 + k) * 129 + d] += add;
      }
    }
    __syncthreads();
    for (int idx = tid; idx < 8192; idx += 256) {
      int i = idx >> 7, d = idx & 127, c = dir ? 63 - i : i;
      float b = bsm[i * 129 + d];
      float q = silu(bf2f(z[(size_t)(rb + c) * NZ + C_QC + h * 128 + d]));
      QD[i * 128 + d] = f2bf(q * __expf(b));
      float f = bf2f(z[(size_t)(rb + c) * NZ + fcol + d]);
      float k = (1.f - lbp[d]) * sigm(-f);
      kdt[d * 72 + c] = f2bf(k * __expf(bsm[63 * 129 + d] - b));
    }
    if (tid < 128) decv[tid] = __expf(bsm[63 * 129 + tid]);
    __syncthreads();
    for (int idx = tid; idx < 1024; idx += 256) {
      int d = idx >> 3, c8 = idx & 7;
      *(uint4*)(KDT + d * 64 + c8 * 8) = *(const uint4*)(kdt + d * 72 + c8 * 8);
    }
    {
      const int sj = w;
      for (int si = 0; si < 4; ++si) {
        f32x4 acc = {0.f, 0.f, 0.f, 0.f};
        if (si >= sj) {
          int it = 16 * si + fr, jt = 16 * sj + fr;
          int ci = dir ? 63 - it : it, cj = dir ? 63 - jt : jt;
#pragma unroll
          for (int s = 0; s < 4; ++s) {
            int d0 = 32 * s + 8 * fq;
            bf16x8 qv = ld8(z + (size_t)(rb + ci) * NZ + C_QC + h * 128 + d0);
            bf16x8 fv = ld8(z + (size_t)(rb + cj) * NZ + fcol + d0);
            bf16x8 af, bf;
#pragma unroll
            for (int e = 0; e < 8; ++e) {
              int d = d0 + e;
              float Bs_ = si ? bsm[(16 * si - 1) * 129 + d] : 0.f;
              float qq = silu(bf2f((u16)qv[e])) * __expf(bsm[it * 129 + d] - Bs_);
              float kk = (1.f - lbp[d]) * sigm(-bf2f((u16)fv[e])) * __expf(Bs_ - bsm[jt * 129 + d]);
              af[e] = (short)f2bf(qq);
              bf[e] = (short)f2bf(kk);
            }
            acc = mfma(af, bf, acc);
          }
        }
#pragma unroll
        for (int r = 0; r < 4; ++r) {
          int i = 16 * si + 4 * fq + r, jj = 16 * sj + fr;
          float v = (si >= sj && jj <= i) ? acc[r] : 0.f;
          Ps[i * 72 + (dir ? 63 - jj : jj)] = f2bf(v);
        }
        __builtin_amdgcn_sched_barrier(0);
      }
    }
    __syncthreads();
#pragma unroll
    for (int nt2 = 0; nt2 < 2; ++nt2) {
      int e = h * 128 + (2 * w + nt2) * 16 + fr;
      bf16x8 v0 = ld8(zT + (size_t)e * GR + rb + 8 * fq), v1 = ld8(zT + (size_t)e * GR + rb + 32 + 8 * fq);
#pragma unroll
      for (int m = 0; m < 4; ++m) {
        f32x4 O = {0.f, 0.f, 0.f, 0.f};
        O = mfma(ld8(Ps + (16 * m + fr) * 72 + 8 * fq), v0, O);
        O = mfma(ld8(Ps + (16 * m + fr) * 72 + 32 + 8 * fq), v1, O);
#pragma unroll
        for (int r = 0; r < 4; ++r) {
          int ii = 16 * m + 4 * fq + r, rowr = rb + (dir ? 63 - ii : ii);
          OC[((size_t)dir * GR + rowr) * 512 + e] = f2bf(O[r]);
        }
      }
    }
    __syncthreads();
  }
}

DEV void c_seq(const P& p, int bitem, char* smem) {
  const int tid = opq(threadIdx.x), lane = tid & 63, w = tid >> 6, fr = lane & 15, fq = lane >> 4;
  const bool active = w < WPB;
  const int item = bitem * WPB + (active ? w : 0);
  const int slice = item & 7, dir = (item >> 3) & 1, h = (item >> 4) & 3, lb = item >> 6, e0 = slice * 16;
  u16* Ss = (u16*)(smem + w * 4352);
  const u16* zT = (const u16*)(p.ws + O_ZT);
  u16* OC = (u16*)(p.ws + O_OC);
  f32x4 S[8];
#pragma unroll
  for (int m = 0; m < 8; ++m) S[m] = (f32x4){0.f, 0.f, 0.f, 0.f};
  for (int j = 0; j < 36; ++j) {
    const int n = dir ? (j < 4 ? 3 - j : 39 - j) : j;
    const int cgk = lb * 36 + n, rb = cgk * 64;
    const char* rec = p.ws + O_CREC + ((size_t)(cgk * 4 + h) * 2 + dir) * CREC_SZ;
    const u16* QD = (const u16*)rec;
    const u16* KDT = QD + 8192;
    const float* decv = (const float*)(rec + 32768);
    if (active) {
#pragma unroll
      for (int m = 0; m < 8; ++m) {
        uint2 pk; pk.x = pk2(S[m][0], S[m][1]); pk.y = pk2(S[m][2], S[m][3]);
        *(uint2*)(Ss + fr * 136 + 16 * m + 4 * fq) = pk;
      }
    }
    __syncthreads();
    if (active) {
      bf16x8 Sf[4];
#pragma unroll
      for (int s = 0; s < 4; ++s) Sf[s] = ld8(Ss + fr * 136 + 32 * s + 8 * fq);
#pragma unroll
      for (int m = 0; m < 4; ++m) {
        f32x4 O = {0.f, 0.f, 0.f, 0.f};
#pragma unroll
        for (int s = 0; s < 4; ++s) O = mfma(ld8(QD + (16 * m + fr) * 128 + 32 * s + 8 * fq), Sf[s], O);
#pragma unroll
        for (int r = 0; r < 4; ++r) {
          int ii = 16 * m + 4 * fq + r, rowr = rb + (dir ? 63 - ii : ii);
          size_t oi = ((size_t)dir * GR + rowr) * 512 + h * 128 + e0 + fr;
          OC[oi] = f2bf(bf2f(OC[oi]) + O[r]);
        }
      }
      const u16* vp = zT + (size_t)(h * 128 + e0 + fr) * GR + rb;
      bf16x8 V0 = ld8(vp + 8 * fq), V1 = ld8(vp + 32 + 8 * fq);
#pragma unroll
      for (int m = 0; m < 8; ++m) {
        f32x4 t = S[m];
#pragma unroll
        for (int r = 0; r < 4; ++r) t[r] *= decv[16 * m + 4 * fq + r];
        t = mfma(ld8(KDT + (16 * m + fr) * 64 + 8 * fq), V0, t);
        t = mfma(ld8(KDT + (16 * m + fr) * 64 + 32 + 8 * fq), V1, t);
        S[m] = t;
      }
    }
    __syncthreads();
  }
}

#define LBAR()                                              \
  do {                                                      \
    asm volatile("s_waitcnt lgkmcnt(0)" ::: "memory");      \
    __builtin_amdgcn_s_barrier();                           \
    asm volatile("" ::: "memory");                          \
  } while (0)
#define CBAR() asm volatile("" ::: "memory")

DEV void c_local2(const P& p, int l, int item, char* smem) {
  float* bsm = (float*)smem;
  u16* Fq = (u16*)(smem + 33024);
  u16* kdt = (u16*)(smem + 50432);
  u16* Ps = kdt;
  const int tid = opq(threadIdx.x), lane = tid & 63, w = tid >> 6, fr = lane & 15, fq = lane >> 4;
  const int cgk = item >> 2, h = item & 3, rb = cgk * 64;
  const u16* z = (const u16*)(p.ws + O_Z);
  const u16* zT = (const u16*)(p.ws + O_ZT);
  u16* OC = (u16*)(p.ws + O_OC);
  const float* lbs = (const float*)(p.ws + O_LBS);
  u16* zq = (u16*)(p.ws + O_Z) + (size_t)rb * NZ + C_QC + h * 128;
  {
    uint4 t4[4];
#pragma unroll
    for (int k = 0; k < 4; ++k) {
      int idx = tid + 256 * k, c = idx >> 4, seg = idx & 15;
      t4[k] = *(const uint4*)(zq + (size_t)c * NZ + seg * 8);
    }
#pragma unroll
    for (int k = 0; k < 4; ++k) {
      int idx = tid + 256 * k, c = idx >> 4, seg = idx & 15;
      unsigned wv[4] = {t4[k].x, t4[k].y, t4[k].z, t4[k].w};
#pragma unroll
      for (int q = 0; q < 4; ++q)
        wv[q] = pk2(silu(bf2f((u16)(wv[q] & 0xffff))), silu(bf2f((u16)(wv[q] >> 16))));
      *(uint4*)(zq + (size_t)c * NZ + seg * 8) = make_uint4(wv[0], wv[1], wv[2], wv[3]);
    }
  }
  __syncthreads();
  for (int dir = 0; dir < 2; ++dir) {
    char* rec = p.ws + O_CREC + ((size_t)(cgk * 4 + h) * 2 + dir) * CREC_SZ;
    u16* QD = (u16*)rec;
    u16* KDT = QD + 8192;
    float* decv = (float*)(rec + 32768);
    const float* lbp = lbs + l * 1024 + dir * 512 + h * 128;
    const int fcol = C_F0 + dir * 512 + h * 128;
    {
      uint4 t4[4];
#pragma unroll
      for (int k = 0; k < 4; ++k) {
        int idx = tid + 256 * k, c = idx >> 4, seg = idx & 15;
        t4[k] = *(const uint4*)(z + (size_t)(rb + c) * NZ + fcol + seg * 8);
      }
#pragma unroll
      for (int k = 0; k < 4; ++k) {
        int idx = tid + 256 * k, c = idx >> 4, seg = idx & 15;
        *(uint4*)(Fq + c * 136 + seg * 8) = t4[k];
      }
    }
    __syncthreads();
    {
      int d = tid & 127, half = tid >> 7;
      float lb_ = lbp[d], run = 0.f;
#pragma unroll 8
      for (int k = 0; k < 32; ++k) {
        int i = 32 * half + k, c = dir ? 63 - i : i;
        float f = bf2f(Fq[c * 136 + d]);
        float fg = lb_ + (1.f - lb_) * sigm(f);
        run += __logf(fg);
        bsm[i * 129 + d] = run;
      }
    }
    __syncthreads();
    {
      int d = tid & 127, half = tid >> 7;
      if (half) {
        float add = bsm[31 * 129 + d];
#pragma unroll 8
        for (int k = 0; k < 32; ++k) bsm[(32 + k) * 129 + d] += add;
      }
    }
    __syncthreads();
    {
      uint4 qv[4];
#pragma unroll
      for (int k = 0; k < 4; ++k) {
        int idx = tid + 256 * k, c = idx >> 4, seg = idx & 15;
        qv[k] = *(const uint4*)(zq + (size_t)c * NZ + seg * 8);
      }
#pragma unroll
      for (int k = 0; k < 4; ++k) {
        int idx = tid + 256 * k, c = idx >> 4, seg = idx & 15, i = dir ? 63 - c : c, d0 = seg * 8;
        unsigned qw[4] = {qv[k].x, qv[k].y, qv[k].z, qv[k].w};
        uint4 fv4 = *(const uint4*)(Fq + c * 136 + d0);
        unsigned fw[4] = {fv4.x, fv4.y, fv4.z, fv4.w};
        unsigned qo[4], ko[4];
#pragma unroll
        for (int q = 0; q < 4; ++q) {
          int d = d0 + 2 * q;
          float b0 = bsm[i * 129 + d], b1 = bsm[i * 129 + d + 1];
          float bl0 = bsm[63 * 129 + d], bl1 = bsm[63 * 129 + d + 1];
          float q0 = bf2f((u16)(qw[q] & 0xffff)), q1 = bf2f((u16)(qw[q] >> 16));
          qo[q] = pk2(q0 * __expf(b0), q1 * __expf(b1));
          float k0 = (1.f - lbp[d]) * sigm(-bf2f((u16)(fw[q] & 0xffff)));
          float k1 = (1.f - lbp[d + 1]) * sigm(-bf2f((u16)(fw[q] >> 16)));
          ko[q] = pk2(k0, k1);
          kdt[d * 72 + c] = f2bf(k0 * __expf(bl0 - b0));
          kdt[(d + 1) * 72 + c] = f2bf(k1 * __expf(bl1 - b1));
        }
        *(uint4*)(QD + i * 128 + d0) = make_uint4(qo[0], qo[1], qo[2], qo[3]);
        *(uint4*)(Fq + c * 136 + d0) = make_uint4(ko[0], ko[1], ko[2], ko[3]);
      }
      if (tid < 128) decv[tid] = __expf(bsm[63 * 129 + tid]);
    }
    __syncthreads();
    for (int idx = tid; idx < 1024; idx += 256) {
      int d = idx >> 3, c8 = idx & 7;
      *(uint4*)(KDT + d * 64 + c8 * 8) = *(const uint4*)(kdt + d * 72 + c8 * 8);
    }
    bf16x8 qf[3][4];
#pragma unroll
    for (int t = 0; t < 3; ++t) {
      int k = w + 4 * t;
      int si = k < 4 ? 3 : (k < 7 ? 2 : (k < 9 ? 1 : 0));
      int it_ = 16 * si + fr, ci_ = dir ? 63 - it_ : it_;
#pragma unroll
      for (int s = 0; s < 4; ++s) qf[t][s] = ld8(zq + (size_t)ci_ * NZ + 32 * s + 8 * fq);
    }
    __syncthreads();
    for (int idx = tid; idx < 1536; idx += 256) {
      int tl = idx >> 8, e = idx & 255, r16 = e >> 4, c16 = e & 15;
      int si = tl < 3 ? 0 : (tl < 5 ? 1 : 2);
      int sj = tl < 3 ? tl + 1 : (tl < 5 ? tl - 1 : 3);
      int jj = 16 * sj + c16;
      Ps[(16 * si + r16) * 72 + (dir ? 63 - jj : jj)] = 0;
    }
#pragma unroll
    for (int t = 0; t < 3; ++t) {
      const int k = w + 4 * t;
      if (k < 10) {
        const int si = k < 4 ? 3 : (k < 7 ? 2 : (k < 9 ? 1 : 0));
        const int sj = k - (k < 4 ? 0 : (k < 7 ? 4 : (k < 9 ? 7 : 9)));
        const int it = 16 * si + fr, jt = 16 * sj + fr, cj = dir ? 63 - jt : jt;
        const int brow = si ? (16 * si - 1) : 0;
        const float bmul = si ? 1.f : 0.f;
        f32x4 acc = {0.f, 0.f, 0.f, 0.f};
#pragma unroll
        for (int s = 0; s < 4; ++s) {
          int d0 = 32 * s + 8 * fq;
          bf16x8 fv = ld8(Fq + cj * 136 + d0);
          bf16x8 af, bf;
#pragma unroll
          for (int e = 0; e < 8; ++e) {
            int d = d0 + e;
            float Bs_ = bmul * bsm[brow * 129 + d];
            float qq = bf2f((u16)qf[t][s][e]) * __expf(bsm[it * 129 + d] - Bs_);
            float kk = bf2f((u16)fv[e]) * __expf(Bs_ - bsm[jt * 129 + d]);
            af[e] = (short)f2bf(qq);
            bf[e] = (short)f2bf(kk);
          }
          acc = mfma(af, bf, acc);
          __builtin_amdgcn_sched_barrier(0);
        }
#pragma unroll
        for (int r = 0; r < 4; ++r) {
          int i = 16 * si + 4 * fq + r, jj = 16 * sj + fr;
          float v = (jj <= i) ? acc[r] : 0.f;
          Ps[i * 72 + (dir ? 63 - jj : jj)] = f2bf(v);
        }
      }
    }
    __syncthreads();
#pragma unroll
    for (int nt2 = 0; nt2 < 2; ++nt2) {
      int e = h * 128 + (2 * w + nt2) * 16 + fr;
      bf16x8 v0 = ld8(zT + (size_t)e * GR + rb + 8 * fq), v1 = ld8(zT + (size_t)e * GR + rb + 32 + 8 * fq);
#pragma unroll
      for (int m = 0; m < 4; ++m) {
        f32x4 O = {0.f, 0.f, 0.f, 0.f};
        O = mfma(ld8(Ps + (16 * m + fr) * 72 + 8 * fq), v0, O);
        O = mfma(ld8(Ps + (16 * m + fr) * 72 + 32 + 8 * fq), v1, O);
#pragma unroll
        for (int r = 0; r < 4; ++r) {
          int ii = 16 * m + 4 * fq + r, rowr = rb + (dir ? 63 - ii : ii);
          OC[((size_t)dir * GR + rowr) * 512 + e] = f2bf(O[r]);
        }
      }
    }
    __syncthreads();
  }
}

#define LBAR()                                              \
  do {                                                      \
    asm volatile("s_waitcnt lgkmcnt(0)" ::: "memory");      \
    __builtin_amdgcn_s_barrier();                           \
    asm volatile("" ::: "memory");                          \
  } while (0)
#define CBAR() asm volatile("" ::: "memory")
#define BS_CHUNK(jj) (dir ? ((jj) < 4 ? 3 - (jj) : 39 - (jj)) : (jj))
DEV bf16x8 ldo8(const char* base, unsigned off) { return *reinterpret_cast<const bf16x8*>(base + off); }
DEV void b_seq2(const P& p, int bitem, char* smem) {
  const int tid = opq(threadIdx.x), lane = tid & 63, w = tid >> 6, fr = lane & 15, fq = lane >> 4;
  const int es = bitem & 3, dir = (bitem >> 2) & 1, h = (bitem >> 3) & 3, lb = bitem >> 5, e0 = es * 32;
  u16* Ss = (u16*)smem;
  u16* Rs = Ss + 32 * 136;
  u16* Vsc = Rs + 32 * 72;
  u16* Vor = Vsc + 32 * 72;
  const char* qnB = p.ws + O_BSH + (size_t)h * 256;
  const char* knB = qnB + BSH_ONE;
  const char* vbB = knB + BSH_ONE + (size_t)e0 * 2;
  const char* ktB = p.ws + O_BSH + 3 * BSH_ONE + (size_t)h * 16384;
  const char* recB = p.ws + O_BIT + ((size_t)h * 2 + dir) * BIT_SZ;
  char* obB = p.ws + O_OB + ((size_t)dir * GR * 512 + h * 128 + e0) * 2;
  const int mrow = 16 * w + fr, crow0 = 16 * w + 4 * fq;
  const unsigned offA = (unsigned)((dir ? 63 - mrow : mrow) * 1024 + 16 * fq);
  unsigned offR[4];
#pragma unroll
  for (int r = 0; r < 4; ++r) offR[r] = (unsigned)((dir ? 63 - (crow0 + r) : (crow0 + r)) * 1024 + fr * 2);
  const unsigned offT = (unsigned)(mrow * 128 + 16 * fq);
  const unsigned offK = (unsigned)((32 * w + fr) * 128 + 16 * fq);
  const unsigned offS = (unsigned)(16384 + crow0 * 4);
  f32x4 S[2][2];
#pragma unroll
  for (int a = 0; a < 2; ++a)
#pragma unroll
    for (int b = 0; b < 2; ++b) S[a][b] = (f32x4){0.f, 0.f, 0.f, 0.f};
  bf16x8 Akn[4], Aqn[4], At[2], Aqk[2], AkT[2][2];
  u16 vbv[2][4];
  float4 eg4, be4, ek4;
  float egl;
#define BS_LOAD1(cg_)                                                              \
  {                                                                                \
    const size_t ro_ = (size_t)(cg_) * 65536;                                      \
    _Pragma("unroll") for (int s = 0; s < 4; ++s) {                                \
      Akn[s] = ldo8(knB + ro_, offA + 64 * s);                                     \
      Aqn[s] = ldo8(qnB + ro_, offA + 64 * s);                                     \
    }                                                                              \
    _Pragma("unroll") for (int r = 0; r < 4; ++r) {                                \
      vbv[0][r] = *(const u16*)(vbB + ro_ + offR[r]);                              \
      vbv[1][r] = *(const u16*)(vbB + ro_ + (offR[r] + 32));                       \
    }                                                                              \
    const char* rc_ = recB + (size_t)(cg_) * (8 * BIT_SZ);                         \
    eg4 = *(const float4*)(rc_ + offS);                                            \
    be4 = *(const float4*)(rc_ + (offS + 256));                                    \
  }
#define BS_LOAD2(cg_)                                                              \
  {                                                                                \
    const char* rc_ = recB + (size_t)(cg_) * (8 * BIT_SZ);                         \
    At[0] = ldo8(rc_, offT); At[1] = ldo8(rc_, offT + 64);                         \
    ek4 = *(const float4*)(rc_ + (offS + 512));                                    \
  }
#define BS_LOAD3(cg_)                                                              \
  {                                                                                \
    const char* rc_ = recB + (size_t)(cg_) * (8 * BIT_SZ);                         \
    Aqk[0] = ldo8(rc_, offT + 8192); Aqk[1] = ldo8(rc_, offT + 8192 + 64);         \
    egl = *(const float*)(rc_ + 16384 + 768);                                      \
    const char* kt_ = ktB + (size_t)(cg_) * 65536;                                 \
    AkT[0][0] = ldo8(kt_, offK); AkT[0][1] = ldo8(kt_, offK + 64);                 \
    AkT[1][0] = ldo8(kt_, offK + 2048); AkT[1][1] = ldo8(kt_, offK + 2048 + 64);   \
  }
  {
    const int c0 = lb * 36 + BS_CHUNK(0);
    BS_LOAD1(c0) BS_LOAD2(c0) BS_LOAD3(c0)
  }
  for (int j = 0; j < 36; ++j) {
    const int cgk = lb * 36 + BS_CHUNK(j);
    const int jn = (j + 1 < 36) ? j + 1 : j;
    const int cgn = lb * 36 + BS_CHUNK(jn);
#pragma unroll
    for (int mm = 0; mm < 2; ++mm)
#pragma unroll
      for (int nt = 0; nt < 2; ++nt) {
        uint2 pk; pk.x = pk2(S[mm][nt][0], S[mm][nt][1]); pk.y = pk2(S[mm][nt][2], S[mm][nt][3]);
        *(uint2*)(Ss + (16 * nt + fr) * 136 + 32 * w + 16 * mm + 4 * fq) = pk;
      }
    LBAR();
    f32x4 QS[2];
    {
      bf16x8 Sf[2][4];
#pragma unroll
      for (int nt = 0; nt < 2; ++nt)
#pragma unroll
        for (int s = 0; s < 4; ++s) Sf[nt][s] = ld8(Ss + (16 * nt + fr) * 136 + 32 * s + 8 * fq);
#pragma unroll
      for (int nt = 0; nt < 2; ++nt) {
        f32x4 X = {0.f, 0.f, 0.f, 0.f}, Q = {0.f, 0.f, 0.f, 0.f};
#pragma unroll
        for (int s = 0; s < 4; ++s) { X = mfma(Akn[s], Sf[nt][s], X); Q = mfma(Aqn[s], Sf[nt][s], Q); }
        float r0 = be4.x * (bf2f(vbv[nt][0]) - eg4.x * X[0]);
        float r1 = be4.y * (bf2f(vbv[nt][1]) - eg4.y * X[1]);
        float r2 = be4.z * (bf2f(vbv[nt][2]) - eg4.z * X[2]);
        float r3 = be4.w * (bf2f(vbv[nt][3]) - eg4.w * X[3]);
        uint2 pk; pk.x = pk2(r0, r1); pk.y = pk2(r2, r3);
        *(uint2*)(Rs + (16 * nt + fr) * 72 + crow0) = pk;
        Q[0] *= eg4.x; Q[1] *= eg4.y; Q[2] *= eg4.z; Q[3] *= eg4.w;
        QS[nt] = Q;
      }
    }
    CBAR();
    BS_LOAD1(cgn)
    LBAR();
    {
#pragma unroll
      for (int nt = 0; nt < 2; ++nt) {
        bf16x8 Rf0 = ld8(Rs + (16 * nt + fr) * 72 + 8 * fq), Rf1 = ld8(Rs + (16 * nt + fr) * 72 + 32 + 8 * fq);
        f32x4 VN = {0.f, 0.f, 0.f, 0.f};
        VN = mfma(At[0], Rf0, VN);
        VN = mfma(At[1], Rf1, VN);
        uint2 pk; pk.x = pk2(VN[0], VN[1]); pk.y = pk2(VN[2], VN[3]);
        *(uint2*)(Vsc + (16 * nt + fr) * 72 + crow0) = pk;
        float s0 = VN[0] * ek4.x, s1 = VN[1] * ek4.y, s2 = VN[2] * ek4.z, s3 = VN[3] * ek4.w;
        if (dir) {
          pk.x = pk2(s3, s2); pk.y = pk2(s1, s0);
          *(uint2*)(Vor + (16 * nt + fr) * 72 + (60 - crow0)) = pk;
        } else {
          pk.x = pk2(s0, s1); pk.y = pk2(s2, s3);
          *(uint2*)(Vor + (16 * nt + fr) * 72 + crow0) = pk;
        }
      }
    }
    CBAR();
    BS_LOAD2(cgn)
    LBAR();
    {
      char* ob_ = obB + (size_t)cgk * 65536;
#pragma unroll
      for (int nt = 0; nt < 2; ++nt) {
        bf16x8 Vs0 = ld8(Vsc + (16 * nt + fr) * 72 + 8 * fq), Vs1 = ld8(Vsc + (16 * nt + fr) * 72 + 32 + 8 * fq);
        bf16x8 Vo0 = ld8(Vor + (16 * nt + fr) * 72 + 8 * fq), Vo1 = ld8(Vor + (16 * nt + fr) * 72 + 32 + 8 * fq);
        f32x4 O = QS[nt];
        O = mfma(Aqk[0], Vs0, O);
        O = mfma(Aqk[1], Vs1, O);
#pragma unroll
        for (int r = 0; r < 4; ++r) *(u16*)(ob_ + (offR[r] + 32 * nt)) = f2bf(O[r]);
#pragma unroll
        for (int mm = 0; mm < 2; ++mm) {
          f32x4 t = S[mm][nt];
#pragma unroll
          for (int r = 0; r < 4; ++r) t[r] *= egl;
          t = mfma(AkT[mm][0], Vo0, t);
          t = mfma(AkT[mm][1], Vo1, t);
          S[mm][nt] = t;
        }
      }
    }
    CBAR();
    BS_LOAD3(cgn)
  }
  LBAR();
}

DEV void c_seq2(const P& p, int bitem, char* smem) {
  const int tid = opq(threadIdx.x), lane = tid & 63, w = tid >> 6, fr = lane & 15, fq = lane >> 4;
  const int es = bitem & 3, dir = (bitem >> 2) & 1, h = (bitem >> 3) & 3, lb = bitem >> 5, e0 = es * 32;
  u16* Ssb = (u16*)smem;
  const char* recB = p.ws + O_CREC + ((size_t)h * 2 + dir) * CREC_SZ;
  const char* ztB = p.ws + O_ZT + (size_t)(h * 128 + e0) * GR * 2;
  char* ocB = p.ws + O_OC + ((size_t)dir * GR * 512 + h * 128 + e0) * 2;
  const int mrow = 16 * w + fr, crow0 = 16 * w + 4 * fq;
  const unsigned offQ = (unsigned)(mrow * 256 + 16 * fq);
  const unsigned offK = (unsigned)(16384 + (32 * w + fr) * 128 + 16 * fq);
  const unsigned offD = (unsigned)(32768 + (32 * w + 4 * fq) * 4);
  const unsigned offV = (unsigned)(fr * GR * 2 + 16 * fq);
  unsigned offR[4];
#pragma unroll
  for (int r = 0; r < 4; ++r) offR[r] = (unsigned)((dir ? 63 - (crow0 + r) : (crow0 + r)) * 1024 + fr * 2);
  f32x4 S[2][2];
#pragma unroll
  for (int a = 0; a < 2; ++a)
#pragma unroll
    for (int b = 0; b < 2; ++b) S[a][b] = (f32x4){0.f, 0.f, 0.f, 0.f};
  bf16x8 Aqd[4], Akd[2][2], Vf[2][2];
  u16 oi[2][4];
  float4 dec4[2];
#define CS_LOAD(cg_)                                                                    \
  {                                                                                     \
    const char* rc_ = recB + (size_t)(cg_) * (8 * CREC_SZ);                             \
    _Pragma("unroll") for (int s = 0; s < 4; ++s) Aqd[s] = ldo8(rc_, offQ + 64 * s);    \
    Akd[0][0] = ldo8(rc_, offK); Akd[0][1] = ldo8(rc_, offK + 64);                      \
    Akd[1][0] = ldo8(rc_, offK + 2048); Akd[1][1] = ldo8(rc_, offK + 2048 + 64);        \
    dec4[0] = *(const float4*)(rc_ + offD);                                             \
    dec4[1] = *(const float4*)(rc_ + (offD + 64));                                      \
    const char* zt_ = ztB + (size_t)(cg_) * 128;                                        \
    Vf[0][0] = ldo8(zt_, offV); Vf[0][1] = ldo8(zt_, offV + 64);                        \
    Vf[1][0] = ldo8(zt_, offV + 16 * GR * 2); Vf[1][1] = ldo8(zt_, offV + 16 * GR * 2 + 64); \
    const char* oc_ = ocB + (size_t)(cg_) * 65536;                                      \
    _Pragma("unroll") for (int r = 0; r < 4; ++r) {                                     \
      oi[0][r] = *(const u16*)(oc_ + offR[r]);                                          \
      oi[1][r] = *(const u16*)(oc_ + (offR[r] + 32));                                   \
    }                                                                                   \
  }
  {
    const int c0 = lb * 36 + BS_CHUNK(0);
    CS_LOAD(c0)
  }
  for (int j = 0; j < 36; ++j) {
    const int cgk = lb * 36 + BS_CHUNK(j);
    const int jn = (j + 1 < 36) ? j + 1 : j;
    const int cgn = lb * 36 + BS_CHUNK(jn);
    u16* Ss = Ssb + (j & 1) * (32 * 136);
#pragma unroll
    for (int mm = 0; mm < 2; ++mm)
#pragma unroll
      for (int nt = 0; nt < 2; ++nt) {
        uint2 pk; pk.x = pk2(S[mm][nt][0], S[mm][nt][1]); pk.y = pk2(S[mm][nt][2], S[mm][nt][3]);
        *(uint2*)(Ss + (16 * nt + fr) * 136 + 32 * w + 16 * mm + 4 * fq) = pk;
      }
    LBAR();
    char* oc_ = ocB + (size_t)cgk * 65536;
#pragma unroll
    for (int nt = 0; nt < 2; ++nt) {
      f32x4 O = {0.f, 0.f, 0.f, 0.f};
#pragma unroll
      for (int s = 0; s < 4; ++s) O = mfma(Aqd[s], ld8(Ss + (16 * nt + fr) * 136 + 32 * s + 8 * fq), O);
#pragma unroll
      for (int r = 0; r < 4; ++r) *(u16*)(oc_ + (offR[r] + 32 * nt)) = f2bf(bf2f(oi[nt][r]) + O[r]);
#pragma unroll
      for (int mm = 0; mm < 2; ++mm) {
        f32x4 t = S[mm][nt];
        t[0] *= dec4[mm].x; t[1] *= dec4[mm].y; t[2] *= dec4[mm].z; t[3] *= dec4[mm].w;
        t = mfma(Akd[mm][0], Vf[nt][0], t);
        t = mfma(Akd[mm][1], Vf[nt][1], t);
        S[mm][nt] = t;
      }
    }
    CBAR();
    CS_LOAD(cgn)
  }
  LBAR();
}

DEV void bc_merge(const P& p, int l, int it) {
  const int tid_ = opq(threadIdx.x); const int lane = tid_ & 63, w = tid_ >> 6;
  int lr = it * 4 + w;
  int mix = lane >> 5, cm = (lane * 16) & 511;
  const u16* O = (const u16*)(p.ws + (mix ? O_OC : O_OB));
  u16* z = (u16*)(p.ws + O_Z);
  float ov[16], ss = 0.f;
#pragma unroll
  for (int k2 = 0; k2 < 2; ++k2) {
    uint4 a = *(const uint4*)(O + (size_t)lr * 512 + cm + 8 * k2);
    uint4 b = *(const uint4*)(O + ((size_t)GR + lr) * 512 + cm + 8 * k2);
    unsigned aa[4] = {a.x, a.y, a.z, a.w}, bb[4] = {b.x, b.y, b.z, b.w};
#pragma unroll
    for (int q = 0; q < 4; ++q) {
      float v0 = bf2f((u16)(aa[q] & 0xffff)) + bf2f((u16)(bb[q] & 0xffff));
      float v1 = bf2f((u16)(aa[q] >> 16)) + bf2f((u16)(bb[q] >> 16));
      ov[k2 * 8 + q * 2] = v0; ov[k2 * 8 + q * 2 + 1] = v1;
      ss += v0 * v0 + v1 * v1;
    }
  }
  ss += __shfl_xor(ss, 1); ss += __shfl_xor(ss, 2); ss += __shfl_xor(ss, 4);
  float rinv = rsqrtf(ss * (1.f / 128.f) + EPS);
  const float* nw = (mix ? p.hg_norm : p.gdn_norm) + l * 128 + (cm & 127);
  u16* gp = z + (size_t)lr * NZ + (mix ? C_GC : C_GB) + cm;
#pragma unroll
  for (int k2 = 0; k2 < 2; ++k2) {
    uint4 gv = *(const uint4*)(gp + 8 * k2);
    unsigned gg[4] = {gv.x, gv.y, gv.z, gv.w}, oo[4];
#pragma unroll
    for (int q = 0; q < 4; ++q) {
      int e = k2 * 8 + q * 2;
      float y0 = ov[e] * rinv * nw[e] * silu(bf2f((u16)(gg[q] & 0xffff)));
      float y1 = ov[e + 1] * rinv * nw[e + 1] * silu(bf2f((u16)(gg[q] >> 16)));
      oo[q] = pk2(y0, y1);
    }
    *(uint4*)(gp + 8 * k2) = make_uint4(oo[0], oo[1], oo[2], oo[3]);
  }
}

#define XB_TMO      128
#define XB_XCNT(j)  (256  + 64 * (j))
#define XB_XSUB(j)  (1280 + 64 * (j))
#define XB_XGEN(j)  (2304 + 64 * (j))
#define XB_TOP      3328
#define XB_TOPGEN   3392
#define XCD_BAR_WORDS 3456
#define XB_SPIN_CAP (1u << 18)
#define LAS __attribute__((address_space(3)))

__device__ __forceinline__ unsigned xb_ld(unsigned* p)              { return __hip_atomic_load(p, __ATOMIC_RELAXED, __HIP_MEMORY_SCOPE_AGENT); }
__device__ __forceinline__ unsigned xb_add(unsigned* p, unsigned v) { return __hip_atomic_fetch_add(p, v, __ATOMIC_RELAXED, __HIP_MEMORY_SCOPE_AGENT); }
__device__ __forceinline__ unsigned xb_xcc_id() { return (unsigned)__builtin_amdgcn_s_getreg((3 << 11) | 20) & 0xFu; }
#define XB_SPIN(cond, bar) do { unsigned _sp = 0; while (cond) { __builtin_amdgcn_s_sleep(1); \
    if ((++_sp & 255u) == 0u) { if (xb_ld(&(bar)[XB_TMO])) break; if (_sp > XB_SPIN_CAP) { atomicAdd(&(bar)[XB_TMO], 1u); break; } } } } while (0)

struct XcdBarrier {
    unsigned* bar; unsigned x;
    volatile LAS unsigned* st;
};

__device__ __forceinline__ XcdBarrier xcd_barrier_post(unsigned* bar, volatile LAS unsigned* st) {
    XcdBarrier b; b.bar = bar; b.x = xb_xcc_id(); b.st = st;
    if (threadIdx.x == 0) (void)xb_add(&bar[XB_XCNT(b.x)], 1u);
    return b;
}
__device__ __forceinline__ void xcd_barrier_complete(unsigned* bar, unsigned x, unsigned& nloc, unsigned& nx) {
    const unsigned G = gridDim.x * gridDim.y * gridDim.z;
    unsigned sum, cnt, mine, sp = 0u;
    for (;;) {
        sum = 0u; cnt = 0u; mine = 0u;
#pragma unroll
        for (unsigned j = 0; j < 16; ++j) { const unsigned c = xb_ld(&bar[XB_XCNT(j)]); sum += c; cnt += (c > 0u) ? 1u : 0u; mine = (j == x) ? c : mine; }
        if (sum == G) break;
        __builtin_amdgcn_s_sleep(1);
        if ((++sp & 255u) == 0u) { if (xb_ld(&bar[XB_TMO])) break; if (sp > XB_SPIN_CAP) { atomicAdd(&bar[XB_TMO], 1u); break; } }
    }
    nloc = mine > 0u ? mine : 1u; nx = cnt > 0u ? cnt : 1u;
}

__device__ __forceinline__ void xcd_barrier(const XcdBarrier& b) {
    asm volatile("s_waitcnt vmcnt(0)" ::: "memory");
    __syncthreads();
    if (threadIdx.x == 0) {
        unsigned* bar = b.bar;
        __builtin_amdgcn_s_waitcnt(0);
        unsigned nloc = b.st[0], nx = b.st[1];
        if (nloc == 0u) { xcd_barrier_complete(bar, b.x, nloc, nx); b.st[0] = nloc; b.st[1] = nx; }
        const unsigned old = xb_add(&bar[XB_XSUB(b.x)], 1u);
        const unsigned gen = old / nloc;
        if (old + 1u == (gen + 1u) * nloc) {
            __builtin_amdgcn_fence(__ATOMIC_RELEASE, "agent");
            asm volatile("s_waitcnt vmcnt(0)" ::: "memory");
            const unsigned og = xb_add(&bar[XB_TOP], 1u);
            const unsigned tg = og / nx;
            if (og + 1u == (tg + 1u) * nx) xb_add(&bar[XB_TOPGEN], 1u);
            else XB_SPIN(xb_ld(&bar[XB_TOPGEN]) == tg, bar);
            __builtin_amdgcn_fence(__ATOMIC_ACQUIRE, "agent");
            xb_add(&bar[XB_XGEN(b.x)], 1u);
            asm volatile("s_waitcnt vmcnt(0)" ::: "memory");
        } else {
            XB_SPIN(xb_ld(&bar[XB_XGEN(b.x)]) == gen, bar);
            __builtin_amdgcn_fence(__ATOMIC_ACQUIRE, "agent");
            asm volatile("s_waitcnt vmcnt(0)" ::: "memory");
        }
    }
    __syncthreads();
}


#ifdef NO_G0
#define XG0(x)
#else
#define XG0(x) x
#endif
#ifdef NO_G1
#define XG1(x)
#else
#define XG1(x) x
#endif
#ifdef NO_BC
#define XBC(x)
#else
#define XBC(x) x
#endif
#ifdef NO_AC
#define XAC(x)
#else
#define XAC(x) x
#endif
#ifdef NO_P0
#define XP0(x)
#else
#define XP0(x) x
#endif
#ifdef NO_R
#define XR(x)
#else
#define XR(x) x
#endif
#ifdef NO_BL
#define XBL(x)
#else
#define XBL(x) x
#endif
#ifdef NO_CL
#define XCL(x)
#else
#define XCL(x) x
#endif
#ifdef NO_A0
#define XA0(x)
#else
#define XA0(x) x
#endif
#ifdef NO_A1
#define XA1(x)
#else
#define XA1(x) x
#endif
#ifdef NO_BS
#define XBS(x)
#else
#define XBS(x) x
#endif
#ifdef NO_CS
#define XCS(x)
#else
#define XCS(x) x
#endif
__global__ void __launch_bounds__(256, 2) fwd_mega(P p) {
  extern __shared__ __attribute__((aligned(16))) char smem[];
  cg::grid_group grid = cg::this_grid();
  const int G = gridDim.x;
  __shared__ uint4 xb_words;
  if (threadIdx.x == 0) xb_words = make_uint4(0u, 0u, 0u, 0u);
  __syncthreads();
  XcdBarrier xb = xcd_barrier_post((unsigned*)(p.ws + O_BAR), (volatile LAS unsigned*)&xb_words);
  XP0(phase0(p, smem));
  grid.sync();
  u16* z = (u16*)(p.ws + O_Z);
  u16* zT = (u16*)(p.ws + O_ZT);
  float* ab = (float*)(p.ws + O_AB);
  float* o = (float*)(p.ws + O_BSH);
  const u16* u = (const u16*)(p.ws + O_BIT);
  for (int g = 0; g < NG; ++g) {
    XR(phaseR(p, g, 0));
    xcd_barrier(xb);
    for (int l = 0; l < DEPTH; ++l) {
      for (int rep = 0; rep < REP_G; ++rep) {
        const u16* Bt = (const u16*)(p.ws + O_WTIN) + (size_t)l * NZ * 1024;
        for (int t = blockIdx.x; t < 72 * 45; t += G) { XG0(gemm_tile<0>(u, 1024, Bt, 1024, t % 72, t / 72, z, zT, ab, o, smem)); }
      }
      xcd_barrier(xb);
      for (int rep2 = 0; rep2 < REP_M; ++rep2) {
      for (int rep3 = 0; rep3 < REP_A; ++rep3) {
        if (rep3) xcd_barrier(xb);
        const int nb = NCH * 4, nc = NCH * 4, na = NCH * 8;
        for (int t = blockIdx.x; t < nb + nc + na; t += G) {
          if (t < nc) { XCL(c_local2(p, l, t, smem)); }
          else if (t < nb + nc) { XBL(b_local(p, l, t - nc, smem)); }
          else { XA0(a_item(p, l, t - nb - nc, 0, smem)); }
        }
      }
      xcd_barrier(xb);
      {
        for (int t = blockIdx.x; t < 256 + 16; t += G) {
          if (t < 128) { XBS(b_seq2(p, t, smem)); }
          else if (t < 256) { XCS(c_seq2(p, t - 128, smem)); }
          else { XAC(a_carry(p, t - 256)); }
        }
      }
      xcd_barrier(xb);
      }
      {
        const int na = NCH * 8, nm = GR / 4;
        for (int t = blockIdx.x; t < na + nm; t += G) {
          if (t < na) { XA1(a_item(p, l, t, 1, smem)); }
          else { XBC(bc_merge(p, l, t - na)); }
        }
      }
      xcd_barrier(xb);
      for (int rep = 0; rep < REP_G; ++rep) {
        const u16* Bt = (const u16*)(p.ws + O_WTOUT) + (size_t)l * 1024 * 1536;
        for (int t = blockIdx.x; t < 72 * 8; t += G) { XG1(gemm_tile<1>(z + C_GA, NZ, Bt, 1536, t % 72, t / 72, z, zT, ab, o, smem)); }
      }
      xcd_barrier(xb);
      XR(phaseR(p, g, l + 1));
      xcd_barrier(xb);
    }
  }
}

extern "C" void kernel_launch(void* const* d_in, const int* in_sizes, int n_in, void* d_out, int out_size, void* d_ws,
                              size_t ws_size, hipStream_t stream) {
  static int grid_blocks = 0;
  if (!grid_blocks) {
    int dev = 0, cus = 0, per_cu = 0;
    hipGetDevice(&dev);
    hipDeviceGetAttribute(&cus, hipDeviceAttributeMultiprocessorCount, dev);
    hipFuncSetAttribute((const void*)fwd_mega, hipFuncAttributeMaxDynamicSharedMemorySize, LDS_BYTES);
    hipOccupancyMaxActiveBlocksPerMultiprocessor(&per_cu, fwd_mega, 256, LDS_BYTES);
    if (per_cu > 2) per_cu = 2;
    if (per_cu < 1) per_cu = 1;
    grid_blocks = cus * per_cu;
  }
  if (ws_size < WS_TOTAL) {
    fprintf(stderr, "workspace too small: %zu < %zu\n", ws_size, (size_t)WS_TOTAL);
    return;
  }
  P p{};
  const float** f = (const float**)&p;
  for (int i = 0; i < 23; ++i) f[i] = (const float*)d_in[i];
  p.out = (float*)d_out;
  p.ws = (char*)d_ws;
  hipMemsetAsync((char*)d_ws + O_BAR, 0, XCD_BAR_WORDS * 4, stream);
  void* args[] = {&p};
  hipError_t e = hipLaunchCooperativeKernel((void*)fwd_mega, dim3(grid_blocks), dim3(256), args, LDS_BYTES, stream);
  if (e != hipSuccess) fprintf(stderr, "cooperative launch failed: %s (grid %d)\n", hipGetErrorString(e), grid_blocks);
}
```

```cpp
#include <hip/hip_runtime.h>
#include <hip/hip_cooperative_groups.h>
#include <cstdio>
namespace cg = cooperative_groups;

typedef __attribute__((ext_vector_type(8))) short bf16x8;
typedef __attribute__((ext_vector_type(4))) float f32x4;
typedef unsigned short u16;
#define DEV __device__ __forceinline__

constexpr int DM = 1024, TL = 2048, TCX = 256, TS = 2304, GB = 4, GR = GB * TS, NG = 2;
constexpr int NZ = 5760, DEPTH = 4;
constexpr int C_XA = 0, C_Q = 512, C_K = 1024, C_V = 1536, C_QC = 2048, C_F0 = 2560, C_IC = 3584,
              C_GA = 4096, C_GB = 4608, C_GC = 5120, C_AB = 5632;
constexpr int NCH = GR / 64;
constexpr float EPS = 1e-6f;
constexpr int WPB = 2;

constexpr size_t al256(size_t x) { return (x + 255) & ~(size_t)255; }
constexpr size_t O_WTIN = 0;
constexpr size_t O_WTOUT = O_WTIN + al256((size_t)DEPTH * NZ * 1024 * 2);
constexpr size_t O_WGT = O_WTOUT + al256((size_t)DEPTH * 1024 * 1536 * 2);
constexpr size_t O_MOD = O_WGT + al256((size_t)DEPTH * 2 * 2 * 8 * 4096 * 2);
constexpr size_t O_LBS = O_MOD + al256((size_t)DEPTH * 9 * 3072 * 4);
constexpr size_t O_HC = O_LBS + al256((size_t)DEPTH * 1024 * 4);
constexpr size_t O_Z = O_HC + al256((size_t)GB * TCX * 1024 * 4);
constexpr size_t O_ZT = O_Z + al256((size_t)GR * NZ * 2);
constexpr size_t O_AB = O_ZT + al256((size_t)512 * GR * 2);
constexpr size_t O_BSH = O_AB + al256((size_t)GR * 16 * 4);
constexpr size_t BSH_ONE = (size_t)GR * 512 * 2;
constexpr size_t O_BIT = O_BSH + al256(4 * BSH_ONE);
constexpr size_t BIT_SZ = 17408;
constexpr size_t O_CREC = O_BIT + al256((size_t)NCH * 4 * 2 * BIT_SZ);
constexpr size_t CREC_SZ = 33280;
constexpr size_t O_OB = O_CREC + al256((size_t)NCH * 4 * 2 * CREC_SZ);
constexpr size_t O_OC = O_OB + al256((size_t)2 * GR * 512 * 2);
constexpr size_t O_AP = O_OC + al256((size_t)2 * GR * 512 * 2);
constexpr size_t O_AH = O_AP + al256((size_t)NCH * 2 * 512 * 4);
constexpr size_t O_ACAR = O_AH + al256((size_t)NCH * 2 * 512 * 4);
constexpr size_t O_BAR = O_ACAR + al256((size_t)NCH * 2 * 512 * 4);
constexpr size_t WS_TOTAL = O_BAR + al256(3456 * 4);

constexpr int LDS_BYTES = 73728;
#ifndef REP_A
#define REP_A 1
#endif
#ifndef REP_G
#define REP_G 1
#endif
#ifndef REP_M
#define REP_M 1
#endif

struct P {
  const float *x, *c, *ctx, *c_ctx, *w_ada, *b_ada, *norm_pre, *norm_post, *w_in, *conv_a_w, *conv_a_b, *rg_w_r,
      *rg_b_r, *rg_w_i, *rg_b_i, *rg_lam, *conv_b_w, *gdn_a_log, *gdn_dt_bias, *gdn_norm, *hg_lb, *hg_norm, *w_out;
  float* out;
  char* ws;
};

DEV int opq(int x) { asm volatile("" : "+v"(x)); return x; }
DEV int opqs(int x) { asm volatile("" : "+s"(x)); return x; }
typedef __attribute__((ext_vector_type(2))) __bf16 bf16x2_t;
typedef __attribute__((ext_vector_type(2))) float f32x2_t;
DEV u16 f2bf(float f) { __bf16 r = (__bf16)f; return __builtin_bit_cast(u16, r); }
DEV float bf2f(u16 h) { return __uint_as_float(((unsigned)h) << 16); }
DEV unsigned pk2(float a, float b) { f32x2_t v = {a, b}; bf16x2_t r = __builtin_convertvector(v, bf16x2_t); return __builtin_bit_cast(unsigned, r); }
DEV float sigm(float x) { return __builtin_amdgcn_rcpf(1.f + __expf(-x)); }
DEV float silu(float x) { return x * __builtin_amdgcn_rcpf(1.f + __expf(-x)); }
DEV float softplus(float x) { return x > 20.f ? x : log1pf(__expf(x)); }
DEV f32x4 mfma(bf16x8 a, bf16x8 b, f32x4 c) { return __builtin_amdgcn_mfma_f32_16x16x32_bf16(a, b, c, 0, 0, 0); }
DEV bf16x8 ld8(const u16* p) { return *reinterpret_cast<const bf16x8*>(p); }
DEV int lat_map(int l, int t) { return (l & 1) ? ((t & 63) * 32 + (t >> 6)) : t; }
DEV int orig_col(int n) {
  if (n < 512) return n;
  if (n < 2048) return n + 512;
  if (n < 4096) return n + 1040;
  if (n < 4608) return n - 4096 + 512;
  if (n < 5120) return n - 4608 + 2576;
  if (n < 5632) return n + 16;
  if (n < 5648) return n - 5632 + 2560;
  return -1;
}
DEV float zval(const u16* z, int rb, int cp, int n, int col) {
  if (cp < 0 && (n == 0 || n == 4)) return 0.f;
  if (cp > 63 && (n == 3 || n == 35)) return 0.f;
  return bf2f(z[(size_t)(rb + cp) * NZ + col]);
}

DEV void ph0_ada(const P& p, int item, char* smem) {
  float* sc = (float*)smem;
  for (int i = threadIdx.x; i < 9 * 1024; i += 256) {
    int v = i >> 10, d = i & 1023;
    float cv = (v < 8) ? p.c[v * 1024 + d] : p.c_ctx[d];
    sc[i] = silu(cv);
  }
  __syncthreads();
  int col = item * 256 + threadIdx.x;
  int l = col / 3072, e = col % 3072;
  const float* w = p.w_ada + (size_t)l * 1024 * 3072 + e;
  float acc[9];
#pragma unroll
  for (int i = 0; i < 9; ++i) acc[i] = 0.f;
  for (int d = 0; d < 1024; d += 4) {
    float w0 = w[(size_t)d * 3072], w1 = w[(size_t)(d + 1) * 3072], w2 = w[(size_t)(d + 2) * 3072],
          w3 = w[(size_t)(d + 3) * 3072];
#pragma unroll
    for (int i = 0; i < 9; ++i)
      acc[i] += sc[i * 1024 + d] * w0 + sc[i * 1024 + d + 1] * w1 + sc[i * 1024 + d + 2] * w2 +
                sc[i * 1024 + d + 3] * w3;
  }
  float* mod = (float*)(p.ws + O_MOD);
  float bb = p.b_ada[l * 3072 + e];
#pragma unroll
  for (int i = 0; i < 9; ++i) mod[((size_t)l * 9 + i) * 3072 + e] = acc[i] + bb;
  __syncthreads();
}
DEV void tconv_tile(const float* src, int lds_, u16* dst, int ldd, int k0, int n0, bool mapcol, char* smem) {
  float* t = (float*)smem;
  for (int i = threadIdx.x; i < 4096; i += 256) {
    int kk = i >> 6, nn = i & 63;
    int n = n0 + nn;
    int sn = mapcol ? orig_col(n) : n;
    t[kk * 65 + nn] = (sn >= 0) ? src[(size_t)(k0 + kk) * lds_ + sn] : 0.f;
  }
  __syncthreads();
  for (int i = threadIdx.x; i < 4096; i += 256) {
    int nn = i >> 6, kk = i & 63;
    dst[(size_t)(n0 + nn) * ldd + k0 + kk] = f2bf(t[kk * 65 + nn]);
  }
  __syncthreads();
}
DEV void phase0(const P& p, char* smem) {
  const int n_ada = 48, n_in = DEPTH * 16 * 90, n_out = DEPTH * 24 * 16, n_g = 128, n_lb = 4;
  const int total = n_ada + n_in + n_out + n_g + n_lb;
  for (int it = blockIdx.x; it < total; it += gridDim.x) {
    int i = it;
    if (i < n_ada) { ph0_ada(p, i, smem); continue; }
    i -= n_ada;
    if (i < n_in) {
      int l = i / 1440, r = i % 1440, kt = r / 90, nt = r % 90;
      tconv_tile(p.w_in + (size_t)l * 1024 * 5648, 5648, (u16*)(p.ws + O_WTIN) + (size_t)l * NZ * 1024, 1024, kt * 64,
                 nt * 64, true, smem);
      continue;
    }
    i -= n_in;
    if (i < n_out) {
      int l = i / 384, r = i % 384, kt = r / 16, nt = r % 16;
      tconv_tile(p.w_out + (size_t)l * 1536 * 1024, 1024, (u16*)(p.ws + O_WTOUT) + (size_t)l * 1024 * 1536, 1536,
                 kt * 64, nt * 64, false, smem);
      continue;
    }
    i -= n_out;
    if (i < n_g) {
      int h = i & 7, gate = (i >> 3) & 1, dir = (i >> 4) & 1, l = i >> 5;
      const float* src = (gate ? p.rg_w_i : p.rg_w_r) + ((size_t)(l * 2 + dir) * 8 + h) * 4096;
      tconv_tile(src, 64, (u16*)(p.ws + O_WGT) + (size_t)i * 4096, 64, 0, 0, false, smem);
      continue;
    }
    i -= n_g;
    {
      int j = i * 256 + threadIdx.x;
      float v[4], mx = -1e30f;
      for (int l = 0; l < 4; ++l) { v[l] = p.hg_lb[l * 1024 + j]; mx = fmaxf(mx, v[l]); }
      float s = 0.f;
      for (int l = 0; l < 4; ++l) { v[l] = __expf(v[l] - mx); s += v[l]; }
      float* lbs = (float*)(p.ws + O_LBS);
      float cum = 0.f;
      for (int l = 0; l < 4; ++l) {
        if (l > 0) cum += v[l] / s;
        lbs[l * 1024 + j] = cum;
      }
    }
  }
}

DEV void phaseR(const P& p, int g, int l) {
  const int tid_ = opq(threadIdx.x); const int lane = tid_ & 63, w = tid_ >> 6;
  const float* mod = (const float*)(p.ws + O_MOD);
  float* hc = (float*)(p.ws + O_HC);
  const float* o = (const float*)(p.ws + O_BSH);
  u16* u = (u16*)(p.ws + O_BIT);
  for (int it = blockIdx.x; it < GR / 4; it += gridDim.x) {
    int lr = it * 4 + w;
    int lb = lr / TS, s = lr % TS;
    bool isctx = s < TCX;
    if (l == DEPTH && isctx) continue;
    int b = g * GB + lb, t = s - TCX;
    int mi = isctx ? 8 : b;
    float* hp = isctx ? hc + ((size_t)lb * TCX + s) * 1024 : p.out + ((size_t)b * TL + t) * 1024;
    float hv[16];
    if (l == 0) {
      const float* src = isctx ? p.ctx + ((size_t)b * TCX + s) * 1024 : p.x + ((size_t)b * TL + t) * 1024;
#pragma unroll
      for (int k = 0; k < 4; ++k) {
        float4 v = *(const float4*)(src + k * 256 + lane * 4);
        hv[k * 4] = v.x; hv[k * 4 + 1] = v.y; hv[k * 4 + 2] = v.z; hv[k * 4 + 3] = v.w;
      }
    } else {
      int orow = lb * TS + (isctx ? s : TCX + lat_map(l - 1, t));
      const float* op = o + (size_t)orow * 1024;
      float ov[16], ss = 0.f;
#pragma unroll
      for (int k = 0; k < 4; ++k) {
        float4 v = *(const float4*)(op + k * 256 + lane * 4);
        ov[k * 4] = v.x; ov[k * 4 + 1] = v.y; ov[k * 4 + 2] = v.z; ov[k * 4 + 3] = v.w;
        ss += v.x * v.x + v.y * v.y + v.z * v.z + v.w * v.w;
      }
#pragma unroll
      for (int off = 32; off; off >>= 1) ss += __shfl_xor(ss, off);
      float rinv = rsqrtf(ss * (1.f / 1024.f) + EPS);
      const float* gate = mod + ((size_t)(l - 1) * 9 + mi) * 3072 + 2048;
      const float* wp = p.norm_post + (l - 1) * 1024;
#pragma unroll
      for (int k = 0; k < 4; ++k) {
        float4 hh = *(const float4*)(hp + k * 256 + lane * 4);
        float4 gg = *(const float4*)(gate + k * 256 + lane * 4);
        float4 ww = *(const float4*)(wp + k * 256 + lane * 4);
        hv[k * 4] = hh.x + gg.x * (ov[k * 4] * rinv * ww.x);
        hv[k * 4 + 1] = hh.y + gg.y * (ov[k * 4 + 1] * rinv * ww.y);
        hv[k * 4 + 2] = hh.z + gg.z * (ov[k * 4 + 2] * rinv * ww.z);
        hv[k * 4 + 3] = hh.w + gg.w * (ov[k * 4 + 3] * rinv * ww.w);
      }
    }
#pragma unroll
    for (int k = 0; k < 4; ++k)
      *(float4*)(hp + k * 256 + lane * 4) = make_float4(hv[k * 4], hv[k * 4 + 1], hv[k * 4 + 2], hv[k * 4 + 3]);
    if (l < DEPTH) {
      float ss = 0.f;
#pragma unroll
      for (int k = 0; k < 16; ++k) ss += hv[k] * hv[k];
#pragma unroll
      for (int off = 32; off; off >>= 1) ss += __shfl_xor(ss, off);
      float rinv = rsqrtf(ss * (1.f / 1024.f) + EPS);
      const float* sh = mod + ((size_t)l * 9 + mi) * 3072;
      const float* wp = p.norm_pre + l * 1024;
      int urow = lb * TS + (isctx ? s : TCX + lat_map(l, t));
      u16* up = u + (size_t)urow * 1024;
#pragma unroll
      for (int k = 0; k < 4; ++k) {
        float4 ww = *(const float4*)(wp + k * 256 + lane * 4);
        float4 s0 = *(const float4*)(sh + k * 256 + lane * 4);
        float4 s1 = *(const float4*)(sh + 1024 + k * 256 + lane * 4);
        float a0 = hv[k * 4] * rinv * ww.x * (1.f + s1.x) + s0.x;
        float a1 = hv[k * 4 + 1] * rinv * ww.y * (1.f + s1.y) + s0.y;
        float a2 = hv[k * 4 + 2] * rinv * ww.z * (1.f + s1.z) + s0.z;
        float a3 = hv[k * 4 + 3] * rinv * ww.w * (1.f + s1.w) + s0.w;
        uint2 pk; pk.x = pk2(a0, a1); pk.y = pk2(a2, a3);
        *(uint2*)(up + k * 256 + lane * 4) = pk;
      }
    }
  }
}

template <int MODE>
DEV void gemm_tile(const u16* __restrict__ A, int lda, const u16* __restrict__ Bt, int K, int rt, int ct, u16* z,
                   u16* zT, float* ab, float* o, char* smem) {
  u16* As = (u16*)smem;
  u16* Bs = As + 128 * 72;
  const int tid = opq(threadIdx.x), lane = tid & 63, w = tid >> 6, wr = w >> 1, wc = w & 1, fr = lane & 15, fq = lane >> 4;
  const int lrow = tid >> 3, lseg = tid & 7;
  const u16* Ag = A + (size_t)(rt * 128 + lrow) * lda + lseg * 8;
  const u16* Bg = Bt + (size_t)(ct * 128 + lrow) * K + lseg * 8;
  uint4 ra0, ra1, ra2, ra3, rb0, rb1, rb2, rb3;
  f32x4 acc[4][4];
#pragma unroll
  for (int i = 0; i < 4; ++i)
#pragma unroll
    for (int j = 0; j < 4; ++j) acc[i][j] = (f32x4){0.f, 0.f, 0.f, 0.f};
#define GLOAD()                                             \
  ra0 = *(const uint4*)(Ag);                                \
  ra1 = *(const uint4*)(Ag + (size_t)32 * lda);             \
  ra2 = *(const uint4*)(Ag + (size_t)64 * lda);             \
  ra3 = *(const uint4*)(Ag + (size_t)96 * lda);             \
  rb0 = *(const uint4*)(Bg);                                \
  rb1 = *(const uint4*)(Bg + (size_t)32 * K);               \
  rb2 = *(const uint4*)(Bg + (size_t)64 * K);               \
  rb3 = *(const uint4*)(Bg + (size_t)96 * K);
  GLOAD();
  const int nk = K / 64;
#define GSTORE(bufo)                                                      \
  *(uint4*)(As + (bufo) + (lrow)*72 + lseg * 8) = ra0;                    \
  *(uint4*)(As + (bufo) + (lrow + 32) * 72 + lseg * 8) = ra1;             \
  *(uint4*)(As + (bufo) + (lrow + 64) * 72 + lseg * 8) = ra2;             \
  *(uint4*)(As + (bufo) + (lrow + 96) * 72 + lseg * 8) = ra3;             \
  *(uint4*)(Bs + (bufo) + (lrow)*72 + lseg * 8) = rb0;                    \
  *(uint4*)(Bs + (bufo) + (lrow + 32) * 72 + lseg * 8) = rb1;             \
  *(uint4*)(Bs + (bufo) + (lrow + 64) * 72 + lseg * 8) = rb2;             \
  *(uint4*)(Bs + (bufo) + (lrow + 96) * 72 + lseg * 8) = rb3;
  GSTORE(0)
  __syncthreads();
  for (int kt = 0; kt < nk; ++kt) {
    const int cb = (kt & 1) * (2 * 128 * 72);
    if (kt + 1 < nk) {
      Ag += 64; Bg += 64;
      GLOAD();
    }
#pragma unroll
    for (int ks = 0; ks < 2; ++ks) {
      bf16x8 af[4], bfr[4];
#pragma unroll
      for (int mi = 0; mi < 4; ++mi) af[mi] = ld8(As + cb + (wr * 64 + mi * 16 + fr) * 72 + ks * 32 + fq * 8);
#pragma unroll
      for (int ni = 0; ni < 4; ++ni) bfr[ni] = ld8(Bs + cb + (wc * 64 + ni * 16 + fr) * 72 + ks * 32 + fq * 8);
#pragma unroll
      for (int mi = 0; mi < 4; ++mi)
#pragma unroll
        for (int ni = 0; ni < 4; ++ni) acc[mi][ni] = mfma(af[mi], bfr[ni], acc[mi][ni]);
    }
    if (kt + 1 < nk) {
      const int nb_ = ((kt + 1) & 1) * (2 * 128 * 72);
      GSTORE(nb_)
    }
    __syncthreads();
  }
#pragma unroll
  for (int mi = 0; mi < 4; ++mi)
#pragma unroll
    for (int ni = 0; ni < 4; ++ni) {
      int row0 = rt * 128 + wr * 64 + mi * 16 + fq * 4;
      int col = ct * 128 + wc * 64 + ni * 16 + fr;
      f32x4 v = acc[mi][ni];
      if (MODE == 1) {
#pragma unroll
        for (int r = 0; r < 4; ++r) o[(size_t)(row0 + r) * 1024 + col] = v[r];
      } else {
        if (ct >= 28 && ct < 32) {
          uint2 pk; pk.x = pk2(v[0], v[1]); pk.y = pk2(v[2], v[3]);
          *(uint2*)(zT + (size_t)(col - C_IC) * GR + row0) = pk;
        } else if (ct == 44) {
          if (col - C_AB < 16) {
#pragma unroll
            for (int r = 0; r < 4; ++r) ab[(size_t)(row0 + r) * 16 + (col - C_AB)] = v[r];
          }
        } else {
#pragma unroll
          for (int r = 0; r < 4; ++r) z[(size_t)(row0 + r) * NZ + col] = f2bf(v[r]);
        }
      }
    }
}

DEV void a_item(const P& p, int l, int item, int mode, char* smem) {
  float* xc = (float*)smem;
  u16* xcb = (u16*)(smem + 16384);
  float* av = (float*)(smem + 16384 + 9216);
  float* uv = av + 4096;
  float* segP = uv + 4096;
  float* segH = segP + 256;
  const int tid = opq(threadIdx.x), lane = tid & 63, w = tid >> 6, fr = lane & 15, fq = lane >> 4;
  const int cgk = item >> 3, hA = item & 7, n = cgk % 36, rb = cgk * 64;
  u16* z = (u16*)(p.ws + O_Z);
  for (int idx = tid; idx < 4096; idx += 256) {
    int c = idx >> 6, j = idx & 63, ch = hA * 64 + j;
    float val = p.conv_a_b[l * 512 + ch];
#pragma unroll
    for (int tap = 0; tap < 4; ++tap) val += p.conv_a_w[(l * 4 + tap) * 512 + ch] * zval(z, rb, c + tap - 2, n, C_XA + ch);
    xc[idx] = val;
    xcb[c * 72 + j] = f2bf(val);
  }
  __syncthreads();
  float yacc[16];
#pragma unroll
  for (int k = 0; k < 16; ++k) yacc[k] = 0.f;
  const int seg = tid >> 6, sj = tid & 63, sch = hA * 64 + sj;
  for (int dir = 0; dir < 2; ++dir) {
    {
      const u16* wg = (const u16*)(p.ws + O_WGT);
      const u16* wr_ = wg + (size_t)((((l * 2 + dir) * 2 + 0) * 8 + hA)) * 4096;
      const u16* wi_ = wg + (size_t)((((l * 2 + dir) * 2 + 1) * 8 + hA)) * 4096;
      bf16x8 a0 = ld8(xcb + (16 * w + fr) * 72 + fq * 8), a1 = ld8(xcb + (16 * w + fr) * 72 + 32 + fq * 8);
#pragma unroll
      for (int nt = 0; nt < 4; ++nt) {
        f32x4 ar = {0.f, 0.f, 0.f, 0.f}, ai = {0.f, 0.f, 0.f, 0.f};
        const u16* br = wr_ + (nt * 16 + fr) * 64 + fq * 8;
        const u16* bi = wi_ + (nt * 16 + fr) * 64 + fq * 8;
        ar = mfma(a0, ld8(br), ar); ar = mfma(a1, ld8(br + 32), ar);
        ai = mfma(a0, ld8(bi), ai); ai = mfma(a1, ld8(bi + 32), ai);
        int j = nt * 16 + fr, ch = hA * 64 + j;
        float brv = p.rg_b_r[(l * 2 + dir) * 512 + ch], biv = p.rg_b_i[(l * 2 + dir) * 512 + ch];
        float sp = softplus(-p.rg_lam[(l * 2 + dir) * 512 + ch]);
#pragma unroll
        for (int r = 0; r < 4; ++r) {
          int c = 16 * w + 4 * fq + r;
          float rg = sigm(ar[r] + brv), ig = sigm(ai[r] + biv);
          float la = -8.f * rg * sp;
          float a = __expf(la);
          float uu = sqrtf(fmaxf(-expm1f(2.f * la), 0.f)) * (ig * xc[c * 64 + j]);
          av[c * 64 + j] = a;
          uv[c * 64 + j] = uu;
        }
      }
    }
    __syncthreads();
    {
      float Pp = 1.f, H = 0.f;
#pragma unroll
      for (int k = 0; k < 16; ++k) {
        int c = dir ? (16 * seg + 15 - k) : (16 * seg + k);
        float a = av[c * 64 + sj];
        H = a * H + uv[c * 64 + sj];
        Pp *= a;
      }
      segP[seg * 64 + sj] = Pp;
      segH[seg * 64 + sj] = H;
    }
    __syncthreads();
    if (mode == 0) {
      if (seg == 0) {
        float Pc = 1.f, Hc = 0.f;
        for (int q = 0; q < 4; ++q) {
          int sg = dir ? 3 - q : q;
          Hc = segP[sg * 64 + sj] * Hc + segH[sg * 64 + sj];
          Pc *= segP[sg * 64 + sj];
        }
        size_t idx = ((size_t)cgk * 2 + dir) * 512 + sch;
        ((float*)(p.ws + O_AP))[idx] = Pc;
        ((float*)(p.ws + O_AH))[idx] = Hc;
      }
    } else {
      float st = ((const float*)(p.ws + O_ACAR))[((size_t)cgk * 2 + dir) * 512 + sch];
      int nbefore = dir ? 3 - seg : seg;
      for (int q = 0; q < nbefore; ++q) {
        int sg = dir ? 3 - q : q;
        st = segP[sg * 64 + sj] * st + segH[sg * 64 + sj];
      }
      if (dir == 0) {
#pragma unroll
        for (int k = 0; k < 16; ++k) {
          int c = 16 * seg + k;
          st = av[c * 64 + sj] * st + uv[c * 64 + sj];
          yacc[k] += st;
        }
      } else {
#pragma unroll
        for (int k = 15; k >= 0; --k) {
          int c = 16 * seg + k;
          st = av[c * 64 + sj] * st + uv[c * 64 + sj];
          yacc[k] += st;
        }
      }
    }
    __syncthreads();
  }
  if (mode == 1) {
#pragma unroll
    for (int k = 0; k < 16; ++k) {
      size_t zi = (size_t)(rb + 16 * seg + k) * NZ + C_GA + sch;
      float gate = bf2f(z[zi]);
      z[zi] = f2bf(yacc[k] * silu(gate));
    }
  }
}

DEV void a_carry(const P& p, int item) {
  int t = item * 256 + threadIdx.x;
  int ch = t & 511, dir = (t >> 9) & 1, lb = t >> 10;
  const float* AP = (const float*)(p.ws + O_AP);
  const float* AH = (const float*)(p.ws + O_AH);
  float* AC = (float*)(p.ws + O_ACAR);
  float st = 0.f;
  for (int j = 0; j < 36; ++j) {
    int n = dir ? (j < 4 ? 3 - j : 39 - j) : j;
    size_t idx = ((size_t)(lb * 36 + n) * 2 + dir) * 512 + ch;
    AC[idx] = st;
    st = AP[idx] * st + AH[idx];
  }
}

DEV void b_local(const P& p, int l, int item, char* smem) {
  u16* qs = (u16*)smem;
  u16* ks = qs + 64 * 136;
  float* Am = (float*)(smem + 34816);
  float* gc = (float*)(smem + 34816 + 32768);
  float* bt = gc + 128;
  const int tid = opq(threadIdx.x), lane = tid & 63, w = tid >> 6, fr = lane & 15, fq = lane >> 4;
  const int cgk = item >> 2, h = item & 3, n = cgk % 36, rb = cgk * 64;
  const u16* z = (const u16*)(p.ws + O_Z);
  u16* qn = (u16*)(p.ws + O_BSH);
  u16* kn = qn + (size_t)GR * 512;
  u16* vb = kn + (size_t)GR * 512;
  u16* knT = vb + (size_t)GR * 512;
  const float* ab = (const float*)(p.ws + O_AB);
  {
    u16* Tt = (u16*)Am;
    uint4 st[5];
#define BL_TLOAD(which)                                                                                  \
  _Pragma("unroll") for (int k = 0; k < 5; ++k) {                                                        \
    int idx = tid + 256 * k, row = idx >> 4, seg = idx & 15, cp = row - 2;                               \
    bool ok = (idx < 1072) && !((cp < 0 && (n == 0 || n == 4)) || (cp > 63 && (n == 3 || n == 35)));    \
    st[k] = make_uint4(0u, 0u, 0u, 0u);                                                                  \
    if (ok) st[k] = *(const uint4*)(z + (size_t)(rb + cp) * NZ + C_Q + (which)*512 + h * 128 + seg * 8); \
  }
    BL_TLOAD(0)
#pragma unroll
    for (int which = 0; which < 3; ++which) {
#pragma unroll
      for (int k = 0; k < 5; ++k) {
        int idx = tid + 256 * k, row = idx >> 4, seg = idx & 15;
        if (idx < 1072) *(uint4*)(Tt + row * 136 + seg * 8) = st[k];
      }
      __syncthreads();
      if (which < 2) { BL_TLOAD(which + 1) }
      float cw[2][4];
#pragma unroll
      for (int hh = 0; hh < 2; ++hh)
#pragma unroll
        for (int tap = 0; tap < 4; ++tap)
          cw[hh][tap] = p.conv_b_w[(size_t)(l * 4 + tap) * 1536 + which * 512 + h * 128 + lane + 64 * hh];
      for (int c = w; c < 64; c += 4) {
        float v[2];
#pragma unroll
        for (int hh = 0; hh < 2; ++hh) {
          int d = lane + 64 * hh;
          float a = 0.f;
#pragma unroll
          for (int tap = 0; tap < 4; ++tap) a += cw[hh][tap] * bf2f(Tt[(c + tap) * 136 + d]);
          v[hh] = silu(a);
        }
        float rs = 1.f;
        if (which < 2) {
          float sq = v[0] * v[0] + v[1] * v[1];
#pragma unroll
          for (int off = 32; off; off >>= 1) sq += __shfl_xor(sq, off);
          rs = rsqrtf(sq + EPS) * (which == 0 ? 0.08838834764831845f : 1.f);
        }
#pragma unroll
        for (int hh = 0; hh < 2; ++hh) {
          int d = lane + 64 * hh;
          u16 ob = f2bf(v[hh] * rs);
          size_t gi = (size_t)(rb + c) * 512 + h * 128 + d;
          if (which == 0) { qs[c * 136 + d] = ob; qn[gi] = ob; }
          else if (which == 1) { ks[c * 136 + d] = ob; kn[gi] = ob; }
          else vb[gi] = ob;
        }
      }
      __syncthreads();
    }
  }
  if (w < 2) {
    int dir = w, i = lane, c = dir ? 63 - i : i;
    float al = ab[(size_t)(rb + c) * 16 + dir * 4 + h], bl = ab[(size_t)(rb + c) * 16 + 8 + dir * 4 + h];
    float g = -__expf(p.gdn_a_log[(l * 2 + dir) * 4 + h]) * softplus(al + p.gdn_dt_bias[(l * 2 + dir) * 4 + h]);
#pragma unroll
    for (int off = 1; off < 64; off <<= 1) {
      float v = __shfl_up(g, off);
      if (lane >= off) g += v;
    }
    gc[dir * 64 + i] = g;
    bt[dir * 64 + i] = sigm(bl);
  }
  __syncthreads();
  for (int idx = tid; idx < 1024; idx += 256) {
    int d = idx >> 3, c8 = idx & 7;
    uint4 pk;
    pk.x = (unsigned)ks[(c8 * 8 + 0) * 136 + d] | ((unsigned)ks[(c8 * 8 + 1) * 136 + d] << 16);
    pk.y = (unsigned)ks[(c8 * 8 + 2) * 136 + d] | ((unsigned)ks[(c8 * 8 + 3) * 136 + d] << 16);
    pk.z = (unsigned)ks[(c8 * 8 + 4) * 136 + d] | ((unsigned)ks[(c8 * 8 + 5) * 136 + d] << 16);
    pk.w = (unsigned)ks[(c8 * 8 + 6) * 136 + d] | ((unsigned)ks[(c8 * 8 + 7) * 136 + d] << 16);
    *(uint4*)(knT + ((size_t)(cgk * 4 + h) * 128 + d) * 64 + c8 * 8) = pk;
  }
  for (int dir = 0; dir < 2; ++dir) {
    char* rec = p.ws + O_BIT + ((size_t)(cgk * 4 + h) * 2 + dir) * BIT_SZ;
    u16* QKm = (u16*)rec + 4096;
    float* scal = (float*)(rec + 16384);
    int irow = 16 * w + fr, ci = dir ? 63 - irow : irow;
    bf16x8 ak[4], aq[4];
#pragma unroll
    for (int s = 0; s < 4; ++s) { ak[s] = ld8(ks + ci * 136 + 32 * s + 8 * fq); aq[s] = ld8(qs + ci * 136 + 32 * s + 8 * fq); }
#pragma unroll
    for (int nt = 0; nt < 4; ++nt) {
      int jcol = 16 * nt + fr, cj = dir ? 63 - jcol : jcol;
      f32x4 kk = {0.f, 0.f, 0.f, 0.f}, qk = {0.f, 0.f, 0.f, 0.f};
#pragma unroll
      for (int s = 0; s < 4; ++s) {
        bf16x8 b = ld8(ks + cj * 136 + 32 * s + 8 * fq);
        kk = mfma(ak[s], b, kk);
        qk = mfma(aq[s], b, qk);
      }
      float gj = gc[dir * 64 + jcol];
#pragma unroll
      for (int r = 0; r < 4; ++r) {
        int i = 16 * w + 4 * fq + r;
        float dec = (jcol <= i) ? __expf(gc[dir * 64 + i] - gj) : 0.f;
        Am[(dir * 64 + i) * 64 + jcol] = (jcol < i) ? bt[dir * 64 + i] * kk[r] * dec : 0.f;
        QKm[i * 64 + jcol] = f2bf(qk[r] * dec);
      }
    }
    if (tid < 64) {
      float gl = gc[dir * 64 + 63], gi = gc[dir * 64 + tid];
      scal[tid] = __expf(gi);
      scal[64 + tid] = bt[dir * 64 + tid];
      scal[128 + tid] = __expf(gl - gi);
      if (tid == 0) scal[192] = __expf(gl);
    }
  }
  __syncthreads();
  if (w < 2) {
    int dir = w, col = lane;
    u16* Tinv = (u16*)(p.ws + O_BIT + ((size_t)(cgk * 4 + h) * 2 + dir) * BIT_SZ);
    const float* Ad = Am + dir * 4096;
    float T[64];
#pragma unroll
    for (int i = 0; i < 64; ++i) {
      float s = (i == col) ? 1.f : 0.f;
#pragma unroll
      for (int j = 0; j < i; ++j) s -= Ad[i * 64 + j] * T[j];
      T[i] = s;
      Tinv[i * 64 + col] = f2bf(s);
      __builtin_amdgcn_sched_barrier(0);
    }
  }
  __syncthreads();
}

DEV void b_seq(const P& p, int bitem, char* smem) {
  const int tid = opq(threadIdx.x), lane = tid & 63, w = tid >> 6, fr = lane & 15, fq = lane >> 4;
  const bool active = w < WPB;
  const int item = bitem * WPB + (active ? w : 0);
  const int slice = item & 7, dir = (item >> 3) & 1, h = (item >> 4) & 3, lb = item >> 6, e0 = slice * 16;
  u16* Ss = (u16*)(smem + w * 11264);
  u16* Rs = Ss + 16 * 136;
  u16* Vsc = Rs + 16 * 72;
  u16* Vor = Vsc + 16 * 72;
  const u16* qn = (const u16*)(p.ws + O_BSH);
  const u16* kn = qn + (size_t)GR * 512;
  const u16* vb = kn + (size_t)GR * 512;
  const u16* knT = vb + (size_t)GR * 512;
  u16* OB = (u16*)(p.ws + O_OB);
  f32x4 S[8];
#pragma unroll
  for (int m = 0; m < 8; ++m) S[m] = (f32x4){0.f, 0.f, 0.f, 0.f};
  for (int j = 0; j < 36; ++j) {
    const int n = dir ? (j < 4 ? 3 - j : 39 - j) : j;
    const int cgk = lb * 36 + n, rb = cgk * 64;
    const char* rec = p.ws + O_BIT + ((size_t)(cgk * 4 + h) * 2 + dir) * BIT_SZ;
    const u16* Tinv = (const u16*)rec;
    const u16* QKm = Tinv + 4096;
    const float* scal = (const float*)(rec + 16384);
    if (active) {
#pragma unroll
      for (int m = 0; m < 8; ++m) {
        uint2 pk; pk.x = pk2(S[m][0], S[m][1]); pk.y = pk2(S[m][2], S[m][3]);
        *(uint2*)(Ss + fr * 136 + 16 * m + 4 * fq) = pk;
      }
    }
    __syncthreads();
    bf16x8 Sf[4];
    if (active) {
#pragma unroll
      for (int s = 0; s < 4; ++s) Sf[s] = ld8(Ss + fr * 136 + 32 * s + 8 * fq);
#pragma unroll
      for (int m = 0; m < 4; ++m) {
        int i = 16 * m + fr, rowi = rb + (dir ? 63 - i : i);
        f32x4 X = {0.f, 0.f, 0.f, 0.f};
#pragma unroll
        for (int s = 0; s < 4; ++s) X = mfma(ld8(kn + (size_t)rowi * 512 + h * 128 + 32 * s + 8 * fq), Sf[s], X);
        float rv[4];
#pragma unroll
        for (int r = 0; r < 4; ++r) {
          int ii = 16 * m + 4 * fq + r, rowr = rb + (dir ? 63 - ii : ii);
          float v = bf2f(vb[(size_t)rowr * 512 + h * 128 + e0 + fr]);
          rv[r] = scal[64 + ii] * (v - scal[ii] * X[r]);
        }
        uint2 pk; pk.x = pk2(rv[0], rv[1]); pk.y = pk2(rv[2], rv[3]);
        *(uint2*)(Rs + fr * 72 + 16 * m + 4 * fq) = pk;
      }
    }
    __syncthreads();
    if (active) {
      bf16x8 Rf0 = ld8(Rs + fr * 72 + 8 * fq), Rf1 = ld8(Rs + fr * 72 + 32 + 8 * fq);
#pragma unroll
      for (int m = 0; m < 4; ++m) {
        f32x4 VN = {0.f, 0.f, 0.f, 0.f};
        VN = mfma(ld8(Tinv + (16 * m + fr) * 64 + 8 * fq), Rf0, VN);
        VN = mfma(ld8(Tinv + (16 * m + fr) * 64 + 32 + 8 * fq), Rf1, VN);
        uint2 pk; pk.x = pk2(VN[0], VN[1]); pk.y = pk2(VN[2], VN[3]);
        *(uint2*)(Vsc + fr * 72 + 16 * m + 4 * fq) = pk;
        int ib = 16 * m + 4 * fq;
        float s0 = VN[0] * scal[128 + ib], s1 = VN[1] * scal[128 + ib + 1], s2 = VN[2] * scal[128 + ib + 2],
              s3 = VN[3] * scal[128 + ib + 3];
        if (dir) {
          pk.x = pk2(s3, s2); pk.y = pk2(s1, s0);
          *(uint2*)(Vor + fr * 72 + (60 - ib)) = pk;
        } else {
          pk.x = pk2(s0, s1); pk.y = pk2(s2, s3);
          *(uint2*)(Vor + fr * 72 + ib) = pk;
        }
      }
    }
    __syncthreads();
    if (active) {
      bf16x8 Vs0 = ld8(Vsc + fr * 72 + 8 * fq), Vs1 = ld8(Vsc + fr * 72 + 32 + 8 * fq);
      bf16x8 Vo0 = ld8(Vor + fr * 72 + 8 * fq), Vo1 = ld8(Vor + fr * 72 + 32 + 8 * fq);
#pragma unroll
      for (int m = 0; m < 4; ++m) {
        int i = 16 * m + fr, rowi = rb + (dir ? 63 - i : i);
        f32x4 O = {0.f, 0.f, 0.f, 0.f};
#pragma unroll
        for (int s = 0; s < 4; ++s) O = mfma(ld8(qn + (size_t)rowi * 512 + h * 128 + 32 * s + 8 * fq), Sf[s], O);
#pragma unroll
        for (int r = 0; r < 4; ++r) O[r] *= scal[16 * m + 4 * fq + r];
        O = mfma(ld8(QKm + (16 * m + fr) * 64 + 8 * fq), Vs0, O);
        O = mfma(ld8(QKm + (16 * m + fr) * 64 + 32 + 8 * fq), Vs1, O);
#pragma unroll
        for (int r = 0; r < 4; ++r) {
          int ii = 16 * m + 4 * fq + r, rowr = rb + (dir ? 63 - ii : ii);
          OB[((size_t)dir * GR + rowr) * 512 + h * 128 + e0 + fr] = f2bf(O[r]);
        }
      }
      float egl = scal[192];
#pragma unroll
      for (int m = 0; m < 8; ++m) {
        const u16* kt = knT + ((size_t)(cgk * 4 + h) * 128 + 16 * m + fr) * 64;
        f32x4 t = S[m];
#pragma unroll
        for (int r = 0; r < 4; ++r) t[r] *= egl;
        t = mfma(ld8(kt + 8 * fq), Vo0, t);
        t = mfma(ld8(kt + 32 + 8 * fq), Vo1, t);
        S[m] = t;
      }
    }
  }
  __syncthreads();
}

DEV void c_local(const P& p, int l, int item, char* smem) {
  float* bsm = (float*)smem;
  u16* Ps = (u16*)(smem + 33024);
  u16* kdt = (u16*)(smem + 33024 + 9216);
  const int tid = opq(threadIdx.x), lane = tid & 63, w = tid >> 6, fr = lane & 15, fq = lane >> 4;
  const int cgk = item >> 2, h = item & 3, rb = cgk * 64;
  const u16* z = (const u16*)(p.ws + O_Z);
  const u16* zT = (const u16*)(p.ws + O_ZT);
  u16* OC = (u16*)(p.ws + O_OC);
  const float* lbs = (const float*)(p.ws + O_LBS);
  for (int dir = 0; dir < 2; ++dir) {
    char* rec = p.ws + O_CREC + ((size_t)(cgk * 4 + h) * 2 + dir) * CREC_SZ;
    u16* QD = (u16*)rec;
    u16* KDT = QD + 8192;
    float* decv = (float*)(rec + 32768);
    const float* lbp = lbs + l * 1024 + dir * 512 + h * 128;
    const int fcol = C_F0 + dir * 512 + h * 128;
    {
      int d = tid & 127, half = tid >> 7;
      float lb_ = lbp[d], run = 0.f;
      for (int k = 0; k < 32; ++k) {
        int i = 32 * half + k, c = dir ? 63 - i : i;
        float f = bf2f(z[(size_t)(rb + c) * NZ + fcol + d]);
        float fg = lb_ + (1.f - lb_) * sigm(f);
        run += __logf(fg);
        bsm[i * 129 + d] = run;
      }
    }
    __syncthreads();
    {
      int d = tid & 127, half = tid >> 7;
      if (half) {
        float add = bsm[31 * 129 + d];
        for (int k = 0; k < 32; ++k) bsm[(32 + k) * 129 + d] += add;
      }
    }
    __syncthreads();
    for (int idx = tid; idx < 8192; idx += 256) {
      int i = idx >> 7, d = idx & 127, c = dir ? 63 - i : i;
      float b = bsm[i * 129 + d];
      float q = silu(bf2f(z[(size_t)(rb + c) * NZ + C_QC + h * 128 + d]));
      QD[i * 128 + d] = f2bf(q * __expf(b));
      float f = bf2f(z[(size_t)(rb + c) * NZ + fcol + d]);
      float k = (1.f - lbp[d]) * sigm(-f);
      kdt[d * 72 + c] = f2bf(k * __expf(bsm[63 * 129 + d] - b));
    }
    if (tid < 128) decv[tid] = __expf(bsm[63 * 129 + tid]);
    __syncthreads();
    for (int idx = tid; idx < 1024; idx += 256) {
      int d = idx >> 3, c8 = idx & 7;
      *(uint4*)(KDT + d * 64 + c8 * 8) = *(const uint4*)(kdt + d * 72 + c8 * 8);
    }
    {
      const int sj = w;
      for (int si = 0; si < 4; ++si) {
        f32x4 acc = {0.f, 0.f, 0.f, 0.f};
        if (si >= sj) {
          int it = 16 * si + fr, jt = 16 * sj + fr;
          int ci = dir ? 63 - it : it, cj = dir ? 63 - jt : jt;
#pragma unroll
          for (int s = 0; s < 4; ++s) {
            int d0 = 32 * s + 8 * fq;
            bf16x8 qv = ld8(z + (size_t)(rb + ci) * NZ + C_QC + h * 128 + d0);
            bf16x8 fv = ld8(z + (size_t)(rb + cj) * NZ + fcol + d0);
            bf16x8 af, bf;
#pragma unroll
            for (int e = 0; e < 8; ++e) {
              int d = d0 + e;
              float Bs_ = si ? bsm[(16 * si - 1) * 129 + d] : 0.f;
              float qq = silu(bf2f((u16)qv[e])) * __expf(bsm[it * 129 + d] - Bs_);
              float kk = (1.f - lbp[d]) * sigm(-bf2f((u16)fv[e])) * __expf(Bs_ - bsm[jt * 129 + d]);
              af[e] = (short)f2bf(qq);
              bf[e] = (short)f2bf(kk);
            }
            acc = mfma(af, bf, acc);
          }
        }
#pragma unroll
        for (int r = 0; r < 4; ++r) {
          int i = 16 * si + 4 * fq + r, jj = 16 * sj + fr;
          float v = (si >= sj && jj <= i) ? acc[r] : 0.f;
          Ps[i * 72 + (dir ? 63 - jj : jj)] = f2bf(v);
        }
        __builtin_amdgcn_sched_barrier(0);
      }
    }
    __syncthreads();
#pragma unroll
    for (int nt2 = 0; nt2 < 2; ++nt2) {
      int e = h * 128 + (2 * w + nt2) * 16 + fr;
      bf16x8 v0 = ld8(zT + (size_t)e * GR + rb + 8 * fq), v1 = ld8(zT + (size_t)e * GR + rb + 32 + 8 * fq);
#pragma unroll
      for (int m = 0; m < 4; ++m) {
        f32x4 O = {0.f, 0.f, 0.f, 0.f};
        O = mfma(ld8(Ps + (16 * m + fr) * 72 + 8 * fq), v0, O);
        O = mfma(ld8(Ps + (16 * m + fr) * 72 + 32 + 8 * fq), v1, O);
#pragma unroll
        for (int r = 0; r < 4; ++r) {
          int ii = 16 * m + 4 * fq + r, rowr = rb + (dir ? 63 - ii : ii);
          OC[((size_t)dir * GR + rowr) * 512 + e] = f2bf(O[r]);
        }
      }
    }
    __syncthreads();
  }
}

DEV void c_seq(const P& p, int bitem, char* smem) {
  const int tid = opq(threadIdx.x), lane = tid & 63, w = tid >> 6, fr = lane & 15, fq = lane >> 4;
  const bool active = w < WPB;
  const int item = bitem * WPB + (active ? w : 0);
  const int slice = item & 7, dir = (item >> 3) & 1, h = (item >> 4) & 3, lb = item >> 6, e0 = slice * 16;
  u16* Ss = (u16*)(smem + w * 4352);
  const u16* zT = (const u16*)(p.ws + O_ZT);
  u16* OC = (u16*)(p.ws + O_OC);
  f32x4 S[8];
#pragma unroll
  for (int m = 0; m < 8; ++m) S[m] = (f32x4){0.f, 0.f, 0.f, 0.f};
  for (int j = 0; j < 36; ++j) {
    const int n = dir ? (j < 4 ? 3 - j : 39 - j) : j;
    const int cgk = lb * 36 + n, rb = cgk * 64;
    const char* rec = p.ws + O_CREC + ((size_t)(cgk * 4 + h) * 2 + dir) * CREC_SZ;
    const u16* QD = (const u16*)rec;
    const u16* KDT = QD + 8192;
    const float* decv = (const float*)(rec + 32768);
    if (active) {
#pragma unroll
      for (int m = 0; m < 8; ++m) {
        uint2 pk; pk.x = pk2(S[m][0], S[m][1]); pk.y = pk2(S[m][2], S[m][3]);
        *(uint2*)(Ss + fr * 136 + 16 * m + 4 * fq) = pk;
      }
    }
    __syncthreads();
    if (active) {
      bf16x8 Sf[4];
#pragma unroll
      for (int s = 0; s < 4; ++s) Sf[s] = ld8(Ss + fr * 136 + 32 * s + 8 * fq);
#pragma unroll
      for (int m = 0; m < 4; ++m) {
        f32x4 O = {0.f, 0.f, 0.f, 0.f};
#pragma unroll
        for (int s = 0; s < 4; ++s) O = mfma(ld8(QD + (16 * m + fr) * 128 + 32 * s + 8 * fq), Sf[s], O);
#pragma unroll
        for (int r = 0; r < 4; ++r) {
          int ii = 16 * m + 4 * fq + r, rowr = rb + (dir ? 63 - ii : ii);
          size_t oi = ((size_t)dir * GR + rowr) * 512 + h * 128 + e0 + fr;
          OC[oi] = f2bf(bf2f(OC[oi]) + O[r]);
        }
      }
      const u16* vp = zT + (size_t)(h * 128 + e0 + fr) * GR + rb;
      bf16x8 V0 = ld8(vp + 8 * fq), V1 = ld8(vp + 32 + 8 * fq);
#pragma unroll
      for (int m = 0; m < 8; ++m) {
        f32x4 t = S[m];
#pragma unroll
        for (int r = 0; r < 4; ++r) t[r] *= decv[16 * m + 4 * fq + r];
        t = mfma(ld8(KDT + (16 * m + fr) * 64 + 8 * fq), V0, t);
        t = mfma(ld8(KDT + (16 * m + fr) * 64 + 32 + 8 * fq), V1, t);
        S[m] = t;
      }
    }
    __syncthreads();
  }
}

#define LBAR()                                              \
  do {                                                      \
    asm volatile("s_waitcnt lgkmcnt(0)" ::: "memory");      \
    __builtin_amdgcn_s_barrier();                           \
    asm volatile("" ::: "memory");                          \
  } while (0)
#define CBAR() asm volatile("" ::: "memory")

DEV void c_local2(const P& p, int l, int item, char* smem) {
  float* bsm = (float*)smem;
  u16* Fq = (u16*)(smem + 33024);
  u16* kdt = (u16*)(smem + 50432);
  u16* Ps = kdt;
  const int tid = opq(threadIdx.x), lane = tid & 63, w = tid >> 6, fr = lane & 15, fq = lane >> 4;
  const int cgk = item >> 2, h = item & 3, rb = cgk * 64;
  const u16* z = (const u16*)(p.ws + O_Z);
  const u16* zT = (const u16*)(p.ws + O_ZT);
  u16* OC = (u16*)(p.ws + O_OC);
  const float* lbs = (const float*)(p.ws + O_LBS);
  u16* zq = (u16*)(p.ws + O_Z) + (size_t)rb * NZ + C_QC + h * 128;
  {
    uint4 t4[4];
#pragma unroll
    for (int k = 0; k < 4; ++k) {
      int idx = tid + 256 * k, c = idx >> 4, seg = idx & 15;
      t4[k] = *(const uint4*)(zq + (size_t)c * NZ + seg * 8);
    }
#pragma unroll
    for (int k = 0; k < 4; ++k) {
      int idx = tid + 256 * k, c = idx >> 4, seg = idx & 15;
      unsigned wv[4] = {t4[k].x, t4[k].y, t4[k].z, t4[k].w};
#pragma unroll
      for (int q = 0; q < 4; ++q)
        wv[q] = pk2(silu(bf2f((u16)(wv[q] & 0xffff))), silu(bf2f((u16)(wv[q] >> 16))));
      *(uint4*)(zq + (size_t)c * NZ + seg * 8) = make_uint4(wv[0], wv[1], wv[2], wv[3]);
    }
  }
  __syncthreads();
  for (int dir = 0; dir < 2; ++dir) {
    char* rec = p.ws + O_CREC + ((size_t)(cgk * 4 + h) * 2 + dir) * CREC_SZ;
    u16* QD = (u16*)rec;
    u16* KDT = QD + 8192;
    float* decv = (float*)(rec + 32768);
    const float* lbp = lbs + l * 1024 + dir * 512 + h * 128;
    const int fcol = C_F0 + dir * 512 + h * 128;
    {
      uint4 t4[4];
#pragma unroll
      for (int k = 0; k < 4; ++k) {
        int idx = tid + 256 * k, c = idx >> 4, seg = idx & 15;
        t4[k] = *(const uint4*)(z + (size_t)(rb + c) * NZ + fcol + seg * 8);
      }
#pragma unroll
      for (int k = 0; k < 4; ++k) {
        int idx = tid + 256 * k, c = idx >> 4, seg = idx & 15;
        *(uint4*)(Fq + c * 136 + seg * 8) = t4[k];
      }
    }
    __syncthreads();
    {
      int d = tid & 127, half = tid >> 7;
      float lb_ = lbp[d], run = 0.f;
#pragma unroll 8
      for (int k = 0; k < 32; ++k) {
        int i = 32 * half + k, c = dir ? 63 - i : i;
        float f = bf2f(Fq[c * 136 + d]);
        float fg = lb_ + (1.f - lb_) * sigm(f);
        run += __logf(fg);
        bsm[i * 129 + d] = run;
      }
    }
    __syncthreads();
    {
      int d = tid & 127, half = tid >> 7;
      if (half) {
        float add = bsm[31 * 129 + d];
#pragma unroll 8
        for (int k = 0; k < 32; ++k) bsm[(32 + k) * 129 + d] += add;
      }
    }
    __syncthreads();
    {
      uint4 qv[4];
#pragma unroll
      for (int k = 0; k < 4; ++k) {
        int idx = tid + 256 * k, c = idx >> 4, seg = idx & 15;
        qv[k] = *(const uint4*)(zq + (size_t)c * NZ + seg * 8);
      }
#pragma unroll
      for (int k = 0; k < 4; ++k) {
        int idx = tid + 256 * k, c = idx >> 4, seg = idx & 15, i = dir ? 63 - c : c, d0 = seg * 8;
        unsigned qw[4] = {qv[k].x, qv[k].y, qv[k].z, qv[k].w};
        uint4 fv4 = *(const uint4*)(Fq + c * 136 + d0);
        unsigned fw[4] = {fv4.x, fv4.y, fv4.z, fv4.w};
        unsigned qo[4], ko[4];
#pragma unroll
        for (int q = 0; q < 4; ++q) {
          int d = d0 + 2 * q;
          float b0 = bsm[i * 129 + d], b1 = bsm[i * 129 + d + 1];
          float bl0 = bsm[63 * 129 + d], bl1 = bsm[63 * 129 + d + 1];
          float q0 = bf2f((u16)(qw[q] & 0xffff)), q1 = bf2f((u16)(qw[q] >> 16));
          qo[q] = pk2(q0 * __expf(b0), q1 * __expf(b1));
          float k0 = (1.f - lbp[d]) * sigm(-bf2f((u16)(fw[q] & 0xffff)));
          float k1 = (1.f - lbp[d + 1]) * sigm(-bf2f((u16)(fw[q] >> 16)));
          ko[q] = pk2(k0, k1);
          kdt[d * 72 + c] = f2bf(k0 * __expf(bl0 - b0));
          kdt[(d + 1) * 72 + c] = f2bf(k1 * __expf(bl1 - b1));
        }
        *(uint4*)(QD + i * 128 + d0) = make_uint4(qo[0], qo[1], qo[2], qo[3]);
        *(uint4*)(Fq + c * 136 + d0) = make_uint4(ko[0], ko[1], ko[2], ko[3]);
      }
      if (tid < 128) decv[tid] = __expf(bsm[63 * 129 + tid]);
    }
    __syncthreads();
    for (int idx = tid; idx < 1024; idx += 256) {
      int d = idx >> 3, c8 = idx & 7;
      *(uint4*)(KDT + d * 64 + c8 * 8) = *(const uint4*)(kdt + d * 72 + c8 * 8);
    }
    bf16x8 qf[3][4];
#pragma unroll
    for (int t = 0; t < 3; ++t) {
      int k = w + 4 * t;
      int si = k < 4 ? 3 : (k < 7 ? 2 : (k < 9 ? 1 : 0));
      int it_ = 16 * si + fr, ci_ = dir ? 63 - it_ : it_;
#pragma unroll
      for (int s = 0; s < 4; ++s) qf[t][s] = ld8(zq + (size_t)ci_ * NZ + 32 * s + 8 * fq);
    }
    __syncthreads();
    for (int idx = tid; idx < 1536; idx += 256) {
      int tl = idx >> 8, e = idx & 255, r16 = e >> 4, c16 = e & 15;
      int si = tl < 3 ? 0 : (tl < 5 ? 1 : 2);
      int sj = tl < 3 ? tl + 1 : (tl < 5 ? tl - 1 : 3);
      int jj = 16 * sj + c16;
      Ps[(16 * si + r16) * 72 + (dir ? 63 - jj : jj)] = 0;
    }
#pragma unroll
    for (int t = 0; t < 3; ++t) {
      const int k = w + 4 * t;
      if (k < 10) {
        const int si = k < 4 ? 3 : (k < 7 ? 2 : (k < 9 ? 1 : 0));
        const int sj = k - (k < 4 ? 0 : (k < 7 ? 4 : (k < 9 ? 7 : 9)));
        const int it = 16 * si + fr, jt = 16 * sj + fr, cj = dir ? 63 - jt : jt;
        const int brow = si ? (16 * si - 1) : 0;
        const float bmul = si ? 1.f : 0.f;
        f32x4 acc = {0.f, 0.f, 0.f, 0.f};
#pragma unroll
        for (int s = 0; s < 4; ++s) {
          int d0 = 32 * s + 8 * fq;
          bf16x8 fv = ld8(Fq + cj * 136 + d0);
          bf16x8 af, bf;
#pragma unroll
          for (int e = 0; e < 8; ++e) {
            int d = d0 + e;
            float Bs_ = bmul * bsm[brow * 129 + d];
            float qq = bf2f((u16)qf[t][s][e]) * __expf(bsm[it * 129 + d] - Bs_);
            float kk = bf2f((u16)fv[e]) * __expf(Bs_ - bsm[jt * 129 + d]);
            af[e] = (short)f2bf(qq);
            bf[e] = (short)f2bf(kk);
          }
          acc = mfma(af, bf, acc);
          __builtin_amdgcn_sched_barrier(0);
        }
#pragma unroll
        for (int r = 0; r < 4; ++r) {
          int i = 16 * si + 4 * fq + r, jj = 16 * sj + fr;
          float v = (jj <= i) ? acc[r] : 0.f;
          Ps[i * 72 + (dir ? 63 - jj : jj)] = f2bf(v);
        }
      }
    }
    __syncthreads();
#pragma unroll
    for (int nt2 = 0; nt2 < 2; ++nt2) {
      int e = h * 128 + (2 * w + nt2) * 16 + fr;
      bf16x8 v0 = ld8(zT + (size_t)e * GR + rb + 8 * fq), v1 = ld8(zT + (size_t)e * GR + rb + 32 + 8 * fq);
#pragma unroll
      for (int m = 0; m < 4; ++m) {
        f32x4 O = {0.f, 0.f, 0.f, 0.f};
        O = mfma(ld8(Ps + (16 * m + fr) * 72 + 8 * fq), v0, O);
        O = mfma(ld8(Ps + (16 * m + fr) * 72 + 32 + 8 * fq), v1, O);
#pragma unroll
        for (int r = 0; r < 4; ++r) {
          int ii = 16 * m + 4 * fq + r, rowr = rb + (dir ? 63 - ii : ii);
          OC[((size_t)dir * GR + rowr) * 512 + e] = f2bf(O[r]);
        }
      }
    }
    __syncthreads();
  }
}

#define LBAR()                                              \
  do {                                                      \
    asm volatile("s_waitcnt lgkmcnt(0)" ::: "memory");      \
    __builtin_amdgcn_s_barrier();                           \
    asm volatile("" ::: "memory");                          \
  } while (0)
#define CBAR() asm volatile("" ::: "memory")
#define BS_CHUNK(jj) (dir ? ((jj) < 4 ? 3 - (jj) : 39 - (jj)) : (jj))
DEV bf16x8 ldo8(const char* base, unsigned off) { return *reinterpret_cast<const bf16x8*>(base + off); }
DEV void b_seq2(const P& p, int bitem, char* smem) {
  const int tid = opq(threadIdx.x), lane = tid & 63, w = tid >> 6, fr = lane & 15, fq = lane >> 4;
  const int es = bitem & 3, dir = (bitem >> 2) & 1, h = (bitem >> 3) & 3, lb = bitem >> 5, e0 = es * 32;
  u16* Ss = (u16*)smem;
  u16* Rs = Ss + 32 * 136;
  u16* Vsc = Rs + 32 * 72;
  u16* Vor = Vsc + 32 * 72;
  const char* qnB = p.ws + O_BSH + (size_t)h * 256;
  const char* knB = qnB + BSH_ONE;
  const char* vbB = knB + BSH_ONE + (size_t)e0 * 2;
  const char* ktB = p.ws + O_BSH + 3 * BSH_ONE + (size_t)h * 16384;
  const char* recB = p.ws + O_BIT + ((size_t)h * 2 + dir) * BIT_SZ;
  char* obB = p.ws + O_OB + ((size_t)dir * GR * 512 + h * 128 + e0) * 2;
  const int mrow = 16 * w + fr, crow0 = 16 * w + 4 * fq;
  const unsigned offA = (unsigned)((dir ? 63 - mrow : mrow) * 1024 + 16 * fq);
  unsigned offR[4];
#pragma unroll
  for (int r = 0; r < 4; ++r) offR[r] = (unsigned)((dir ? 63 - (crow0 + r) : (crow0 + r)) * 1024 + fr * 2);
  const unsigned offT = (unsigned)(mrow * 128 + 16 * fq);
  const unsigned offK = (unsigned)((32 * w + fr) * 128 + 16 * fq);
  const unsigned offS = (unsigned)(16384 + crow0 * 4);
  f32x4 S[2][2];
#pragma unroll
  for (int a = 0; a < 2; ++a)
#pragma unroll
    for (int b = 0; b < 2; ++b) S[a][b] = (f32x4){0.f, 0.f, 0.f, 0.f};
  bf16x8 Akn[4], Aqn[4], At[2], Aqk[2], AkT[2][2];
  u16 vbv[2][4];
  float4 eg4, be4, ek4;
  float egl;
#define BS_LOAD1(cg_)                                                              \
  {                                                                                \
    const size_t ro_ = (size_t)(cg_) * 65536;                                      \
    _Pragma("unroll") for (int s = 0; s < 4; ++s) {                                \
      Akn[s] = ldo8(knB + ro_, offA + 64 * s);                                     \
      Aqn[s] = ldo8(qnB + ro_, offA + 64 * s);                                     \
    }                                                                              \
    _Pragma("unroll") for (int r = 0; r < 4; ++r) {                                \
      vbv[0][r] = *(const u16*)(vbB + ro_ + offR[r]);                              \
      vbv[1][r] = *(const u16*)(vbB + ro_ + (offR[r] + 32));                       \
    }                                                                              \
    const char* rc_ = recB + (size_t)(cg_) * (8 * BIT_SZ);                         \
    eg4 = *(const float4*)(rc_ + offS);                                            \
    be4 = *(const float4*)(rc_ + (offS + 256));                                    \
  }
#define BS_LOAD2(cg_)                                                              \
  {                                                                                \
    const char* rc_ = recB + (size_t)(cg_) * (8 * BIT_SZ);                         \
    At[0] = ldo8(rc_, offT); At[1] = ldo8(rc_, offT + 64);                         \
    ek4 = *(const float4*)(rc_ + (offS + 512));                                    \
  }
#define BS_LOAD3(cg_)                                                              \
  {                                                                                \
    const char* rc_ = recB + (size_t)(cg_) * (8 * BIT_SZ);                         \
    Aqk[0] = ldo8(rc_, offT + 8192); Aqk[1] = ldo8(rc_, offT + 8192 + 64);         \
    egl = *(const float*)(rc_ + 16384 + 768);                                      \
    const char* kt_ = ktB + (size_t)(cg_) * 65536;                                 \
    AkT[0][0] = ldo8(kt_, offK); AkT[0][1] = ldo8(kt_, offK + 64);                 \
    AkT[1][0] = ldo8(kt_, offK + 2048); AkT[1][1] = ldo8(kt_, offK + 2048 + 64);   \
  }
  {
    const int c0 = lb * 36 + BS_CHUNK(0);
    BS_LOAD1(c0) BS_LOAD2(c0) BS_LOAD3(c0)
  }
  for (int j = 0; j < 36; ++j) {
    const int cgk = lb * 36 + BS_CHUNK(j);
    const int jn = (j + 1 < 36) ? j + 1 : j;
    const int cgn = lb * 36 + BS_CHUNK(jn);
#pragma unroll
    for (int mm = 0; mm < 2; ++mm)
#pragma unroll
      for (int nt = 0; nt < 2; ++nt) {
        uint2 pk; pk.x = pk2(S[mm][nt][0], S[mm][nt][1]); pk.y = pk2(S[mm][nt][2], S[mm][nt][3]);
        *(uint2*)(Ss + (16 * nt + fr) * 136 + 32 * w + 16 * mm + 4 * fq) = pk;
      }
    LBAR();
    f32x4 QS[2];
    {
      bf16x8 Sf[2][4];
#pragma unroll
      for (int nt = 0; nt < 2; ++nt)
#pragma unroll
        for (int s = 0; s < 4; ++s) Sf[nt][s] = ld8(Ss + (16 * nt + fr) * 136 + 32 * s + 8 * fq);
#pragma unroll
      for (int nt = 0; nt < 2; ++nt) {
        f32x4 X = {0.f, 0.f, 0.f, 0.f}, Q = {0.f, 0.f, 0.f, 0.f};
#pragma unroll
        for (int s = 0; s < 4; ++s) { X = mfma(Akn[s], Sf[nt][s], X); Q = mfma(Aqn[s], Sf[nt][s], Q); }
        float r0 = be4.x * (bf2f(vbv[nt][0]) - eg4.x * X[0]);
        float r1 = be4.y * (bf2f(vbv[nt][1]) - eg4.y * X[1]);
        float r2 = be4.z * (bf2f(vbv[nt][2]) - eg4.z * X[2]);
        float r3 = be4.w * (bf2f(vbv[nt][3]) - eg4.w * X[3]);
        uint2 pk; pk.x = pk2(r0, r1); pk.y = pk2(r2, r3);
        *(uint2*)(Rs + (16 * nt + fr) * 72 + crow0) = pk;
        Q[0] *= eg4.x; Q[1] *= eg4.y; Q[2] *= eg4.z; Q[3] *= eg4.w;
        QS[nt] = Q;
      }
    }
    CBAR();
    BS_LOAD1(cgn)
    LBAR();
    {
#pragma unroll
      for (int nt = 0; nt < 2; ++nt) {
        bf16x8 Rf0 = ld8(Rs + (16 * nt + fr) * 72 + 8 * fq), Rf1 = ld8(Rs + (16 * nt + fr) * 72 + 32 + 8 * fq);
        f32x4 VN = {0.f, 0.f, 0.f, 0.f};
        VN = mfma(At[0], Rf0, VN);
        VN = mfma(At[1], Rf1, VN);
        uint2 pk; pk.x = pk2(VN[0], VN[1]); pk.y = pk2(VN[2], VN[3]);
        *(uint2*)(Vsc + (16 * nt + fr) * 72 + crow0) = pk;
        float s0 = VN[0] * ek4.x, s1 = VN[1] * ek4.y, s2 = VN[2] * ek4.z, s3 = VN[3] * ek4.w;
        if (dir) {
          pk.x = pk2(s3, s2); pk.y = pk2(s1, s0);
          *(uint2*)(Vor + (16 * nt + fr) * 72 + (60 - crow0)) = pk;
        } else {
          pk.x = pk2(s0, s1); pk.y = pk2(s2, s3);
          *(uint2*)(Vor + (16 * nt + fr) * 72 + crow0) = pk;
        }
      }
    }
    CBAR();
    BS_LOAD2(cgn)
    LBAR();
    {
      char* ob_ = obB + (size_t)cgk * 65536;
#pragma unroll
      for (int nt = 0; nt < 2; ++nt) {
        bf16x8 Vs0 = ld8(Vsc + (16 * nt + fr) * 72 + 8 * fq), Vs1 = ld8(Vsc + (16 * nt + fr) * 72 + 32 + 8 * fq);
        bf16x8 Vo0 = ld8(Vor + (16 * nt + fr) * 72 + 8 * fq), Vo1 = ld8(Vor + (16 * nt + fr) * 72 + 32 + 8 * fq);
        f32x4 O = QS[nt];
        O = mfma(Aqk[0], Vs0, O);
        O = mfma(Aqk[1], Vs1, O);
#pragma unroll
        for (int r = 0; r < 4; ++r) *(u16*)(ob_ + (offR[r] + 32 * nt)) = f2bf(O[r]);
#pragma unroll
        for (int mm = 0; mm < 2; ++mm) {
          f32x4 t = S[mm][nt];
#pragma unroll
          for (int r = 0; r < 4; ++r) t[r] *= egl;
          t = mfma(AkT[mm][0], Vo0, t);
          t = mfma(AkT[mm][1], Vo1, t);
          S[mm][nt] = t;
        }
      }
    }
    CBAR();
    BS_LOAD3(cgn)
  }
  LBAR();
}

DEV void c_seq2(const P& p, int bitem, char* smem) {
  const int tid = opq(threadIdx.x), lane = tid & 63, w = tid >> 6, fr = lane & 15, fq = lane >> 4;
  const int es = bitem & 3, dir = (bitem >> 2) & 1, h = (bitem >> 3) & 3, lb = bitem >> 5, e0 = es * 32;
  u16* Ssb = (u16*)smem;
  const char* recB = p.ws + O_CREC + ((size_t)h * 2 + dir) * CREC_SZ;
  const char* ztB = p.ws + O_ZT + (size_t)(h * 128 + e0) * GR * 2;
  char* ocB = p.ws + O_OC + ((size_t)dir * GR * 512 + h * 128 + e0) * 2;
  const int mrow = 16 * w + fr, crow0 = 16 * w + 4 * fq;
  const unsigned offQ = (unsigned)(mrow * 256 + 16 * fq);
  const unsigned offK = (unsigned)(16384 + (32 * w + fr) * 128 + 16 * fq);
  const unsigned offD = (unsigned)(32768 + (32 * w + 4 * fq) * 4);
  const unsigned offV = (unsigned)(fr * GR * 2 + 16 * fq);
  unsigned offR[4];
#pragma unroll
  for (int r = 0; r < 4; ++r) offR[r] = (unsigned)((dir ? 63 - (crow0 + r) : (crow0 + r)) * 1024 + fr * 2);
  f32x4 S[2][2];
#pragma unroll
  for (int a = 0; a < 2; ++a)
#pragma unroll
    for (int b = 0; b < 2; ++b) S[a][b] = (f32x4){0.f, 0.f, 0.f, 0.f};
  bf16x8 Aqd[4], Akd[2][2], Vf[2][2];
  u16 oi[2][4];
  float4 dec4[2];
#define CS_LOAD(cg_)                                                                    \
  {                                                                                     \
    const char* rc_ = recB + (size_t)(cg_) * (8 * CREC_SZ);                             \
    _Pragma("unroll") for (int s = 0; s < 4; ++s) Aqd[s] = ldo8(rc_, offQ + 64 * s);    \
    Akd[0][0] = ldo8(rc_, offK); Akd[0][1] = ldo8(rc_, offK + 64);                      \
    Akd[1][0] = ldo8(rc_, offK + 2048); Akd[1][1] = ldo8(rc_, offK + 2048 + 64);        \
    dec4[0] = *(const float4*)(rc_ + offD);                                             \
    dec4[1] = *(const float4*)(rc_ + (offD + 64));                                      \
    const char* zt_ = ztB + (size_t)(cg_) * 128;                                        \
    Vf[0][0] = ldo8(zt_, offV); Vf[0][1] = ldo8(zt_, offV + 64);                        \
    Vf[1][0] = ldo8(zt_, offV + 16 * GR * 2); Vf[1][1] = ldo8(zt_, offV + 16 * GR * 2 + 64); \
    const char* oc_ = ocB + (size_t)(cg_) * 65536;                                      \
    _Pragma("unroll") for (int r = 0; r < 4; ++r) {                                     \
      oi[0][r] = *(const u16*)(oc_ + offR[r]);                                          \
      oi[1][r] = *(const u16*)(oc_ + (offR[r] + 32));                                   \
    }                                                                                   \
  }
  {
    const int c0 = lb * 36 + BS_CHUNK(0);
    CS_LOAD(c0)
  }
  for (int j = 0; j < 36; ++j) {
    const int cgk = lb * 36 + BS_CHUNK(j);
    const int jn = (j + 1 < 36) ? j + 1 : j;
    const int cgn = lb * 36 + BS_CHUNK(jn);
    u16* Ss = Ssb + (j & 1) * (32 * 136);
#pragma unroll
    for (int mm = 0; mm < 2; ++mm)
#pragma unroll
      for (int nt = 0; nt < 2; ++nt) {
        uint2 pk; pk.x = pk2(S[mm][nt][0], S[mm][nt][1]); pk.y = pk2(S[mm][nt][2], S[mm][nt][3]);
        *(uint2*)(Ss + (16 * nt + fr) * 136 + 32 * w + 16 * mm + 4 * fq) = pk;
      }
    LBAR();
    char* oc_ = ocB + (size_t)cgk * 65536;
#pragma unroll
    for (int nt = 0; nt < 2; ++nt) {
      f32x4 O = {0.f, 0.f, 0.f, 0.f};
#pragma unroll
      for (int s = 0; s < 4; ++s) O = mfma(Aqd[s], ld8(Ss + (16 * nt + fr) * 136 + 32 * s + 8 * fq), O);
#pragma unroll
      for (int r = 0; r < 4; ++r) *(u16*)(oc_ + (offR[r] + 32 * nt)) = f2bf(bf2f(oi[nt][r]) + O[r]);
#pragma unroll
      for (int mm = 0; mm < 2; ++mm) {
        f32x4 t = S[mm][nt];
        t[0] *= dec4[mm].x; t[1] *= dec4[mm].y; t[2] *= dec4[mm].z; t[3] *= dec4[mm].w;
        t = mfma(Akd[mm][0], Vf[nt][0], t);
        t = mfma(Akd[mm][1], Vf[nt][1], t);
        S[mm][nt] = t;
      }
    }
    CBAR();
    CS_LOAD(cgn)
  }
  LBAR();
}

DEV void bc_merge(const P& p, int l, int it) {
  const int tid_ = opq(threadIdx.x); const int lane = tid_ & 63, w = tid_ >> 6;
  int lr = it * 4 + w;
  int mix = lane >> 5, cm = (lane * 16) & 511;
  const u16* O = (const u16*)(p.ws + (mix ? O_OC : O_OB));
  u16* z = (u16*)(p.ws + O_Z);
  float ov[16], ss = 0.f;
#pragma unroll
  for (int k2 = 0; k2 < 2; ++k2) {
    uint4 a = *(const uint4*)(O + (size_t)lr * 512 + cm + 8 * k2);
    uint4 b = *(const uint4*)(O + ((size_t)GR + lr) * 512 + cm + 8 * k2);
    unsigned aa[4] = {a.x, a.y, a.z, a.w}, bb[4] = {b.x, b.y, b.z, b.w};
#pragma unroll
    for (int q = 0; q < 4; ++q) {
      float v0 = bf2f((u16)(aa[q] & 0xffff)) + bf2f((u16)(bb[q] & 0xffff));
      float v1 = bf2f((u16)(aa[q] >> 16)) + bf2f((u16)(bb[q] >> 16));
      ov[k2 * 8 + q * 2] = v0; ov[k2 * 8 + q * 2 + 1] = v1;
      ss += v0 * v0 + v1 * v1;
    }
  }
  ss += __shfl_xor(ss, 1); ss += __shfl_xor(ss, 2); ss += __shfl_xor(ss, 4);
  float rinv = rsqrtf(ss * (1.f / 128.f) + EPS);
  const float* nw = (mix ? p.hg_norm : p.gdn_norm) + l * 128 + (cm & 127);
  u16* gp = z + (size_t)lr * NZ + (mix ? C_GC : C_GB) + cm;
#pragma unroll
  for (int k2 = 0; k2 < 2; ++k2) {
    uint4 gv = *(const uint4*)(gp + 8 * k2);
    unsigned gg[4] = {gv.x, gv.y, gv.z, gv.w}, oo[4];
#pragma unroll
    for (int q = 0; q < 4; ++q) {
      int e = k2 * 8 + q * 2;
      float y0 = ov[e] * rinv * nw[e] * silu(bf2f((u16)(gg[q] & 0xffff)));
      float y1 = ov[e + 1] * rinv * nw[e + 1] * silu(bf2f((u16)(gg[q] >> 16)));
      oo[q] = pk2(y0, y1);
    }
    *(uint4*)(gp + 8 * k2) = make_uint4(oo[0], oo[1], oo[2], oo[3]);
  }
}

#define XB_TMO      128
#define XB_XCNT(j)  (256  + 64 * (j))
#define XB_XSUB(j)  (1280 + 64 * (j))
#define XB_XGEN(j)  (2304 + 64 * (j))
#define XB_TOP      3328
#define XB_TOPGEN   3392
#define XCD_BAR_WORDS 3456
#define XB_SPIN_CAP (1u << 18)
#define LAS __attribute__((address_space(3)))

__device__ __forceinline__ unsigned xb_ld(unsigned* p)              { return __hip_atomic_load(p, __ATOMIC_RELAXED, __HIP_MEMORY_SCOPE_AGENT); }
__device__ __forceinline__ unsigned xb_add(unsigned* p, unsigned v) { return __hip_atomic_fetch_add(p, v, __ATOMIC_RELAXED, __HIP_MEMORY_SCOPE_AGENT); }
__device__ __forceinline__ unsigned xb_xcc_id() { return (unsigned)__builtin_amdgcn_s_getreg((3 << 11) | 20) & 0xFu; }
#define XB_SPIN(cond, bar) do { unsigned _sp = 0; while (cond) { __builtin_amdgcn_s_sleep(1); \
    if ((++_sp & 255u) == 0u) { if (xb_ld(&(bar)[XB_TMO])) break; if (_sp > XB_SPIN_CAP) { atomicAdd(&(bar)[XB_TMO], 1u); break; } } } } while (0)

struct XcdBarrier {
    unsigned* bar; unsigned x;
    volatile LAS unsigned* st;
};

__device__ __forceinline__ XcdBarrier xcd_barrier_post(unsigned* bar, volatile LAS unsigned* st) {
    XcdBarrier b; b.bar = bar; b.x = xb_xcc_id(); b.st = st;
    if (threadIdx.x == 0) (void)xb_add(&bar[XB_XCNT(b.x)], 1u);
    return b;
}
__device__ __forceinline__ void xcd_barrier_complete(unsigned* bar, unsigned x, unsigned& nloc, unsigned& nx) {
    const unsigned G = gridDim.x * gridDim.y * gridDim.z;
    unsigned sum, cnt, mine, sp = 0u;
    for (;;) {
        sum = 0u; cnt = 0u; mine = 0u;
#pragma unroll
        for (unsigned j = 0; j < 16; ++j) { const unsigned c = xb_ld(&bar[XB_XCNT(j)]); sum += c; cnt += (c > 0u) ? 1u : 0u; mine = (j == x) ? c : mine; }
        if (sum == G) break;
        __builtin_amdgcn_s_sleep(1);
        if ((++sp & 255u) == 0u) { if (xb_ld(&bar[XB_TMO])) break; if (sp > XB_SPIN_CAP) { atomicAdd(&bar[XB_TMO], 1u); break; } }
    }
    nloc = mine > 0u ? mine : 1u; nx = cnt > 0u ? cnt : 1u;
}

__device__ __forceinline__ void xcd_barrier(const XcdBarrier& b) {
    asm volatile("s_waitcnt vmcnt(0)" ::: "memory");
    __syncthreads();
    if (threadIdx.x == 0) {
        unsigned* bar = b.bar;
        __builtin_amdgcn_s_waitcnt(0);
        unsigned nloc = b.st[0], nx = b.st[1];
        if (nloc == 0u) { xcd_barrier_complete(bar, b.x, nloc, nx); b.st[0] = nloc; b.st[1] = nx; }
        const unsigned old = xb_add(&bar[XB_XSUB(b.x)], 1u);
        const unsigned gen = old / nloc;
        if (old + 1u == (gen + 1u) * nloc) {
            __builtin_amdgcn_fence(__ATOMIC_RELEASE, "agent");
            asm volatile("s_waitcnt vmcnt(0)" ::: "memory");
            const unsigned og = xb_add(&bar[XB_TOP], 1u);
            const unsigned tg = og / nx;
            if (og + 1u == (tg + 1u) * nx) xb_add(&bar[XB_TOPGEN], 1u);
            else XB_SPIN(xb_ld(&bar[XB_TOPGEN]) == tg, bar);
            __builtin_amdgcn_fence(__ATOMIC_ACQUIRE, "agent");
            xb_add(&bar[XB_XGEN(b.x)], 1u);
            asm volatile("s_waitcnt vmcnt(0)" ::: "memory");
        } else {
            XB_SPIN(xb_ld(&bar[XB_XGEN(b.x)]) == gen, bar);
            __builtin_amdgcn_fence(__ATOMIC_ACQUIRE, "agent");
            asm volatile("s_waitcnt vmcnt(0)" ::: "memory");
        }
    }
    __syncthreads();
}


#ifdef NO_G0
#define XG0(x)
#else
#define XG0(x) x
#endif
#ifdef NO_G1
#define XG1(x)
#else
#define XG1(x) x
#endif
#ifdef NO_BC
#define XBC(x)
#else
#define XBC(x) x
#endif
#ifdef NO_AC
#define XAC(x)
#else
#define XAC(x) x
#endif
#ifdef NO_P0
#define XP0(x)
#else
#define XP0(x) x
#endif
#ifdef NO_R
#define XR(x)
#else
#define XR(x) x
#endif
#ifdef NO_BL
#define XBL(x)
#else
#define XBL(x) x
#endif
#ifdef NO_CL
#define XCL(x)
#else
#define XCL(x) x
#endif
#ifdef NO_A0
#define XA0(x)
#else
#define XA0(x) x
#endif
#ifdef NO_A1
#define XA1(x)
#else
#define XA1(x) x
#endif
#ifdef NO_BS
#define XBS(x)
#else
#define XBS(x) x
#endif
#ifdef NO_CS
#define XCS(x)
#else
#define XCS(x) x
#endif
__global__ void __launch_bounds__(256, 2) fwd_mega(P p) {
  extern __shared__ __attribute__((aligned(16))) char smem[];
  cg::grid_group grid = cg::this_grid();
  const int G = gridDim.x;
  __shared__ uint4 xb_words;
  if (threadIdx.x == 0) xb_words = make_uint4(0u, 0u, 0u, 0u);
  __syncthreads();
  XcdBarrier xb = xcd_barrier_post((unsigned*)(p.ws + O_BAR), (volatile LAS unsigned*)&xb_words);
  XP0(phase0(p, smem));
  grid.sync();
  u16* z = (u16*)(p.ws + O_Z);
  u16* zT = (u16*)(p.ws + O_ZT);
  float* ab = (float*)(p.ws + O_AB);
  float* o = (float*)(p.ws + O_BSH);
  const u16* u = (const u16*)(p.ws + O_BIT);
  for (int g = 0; g < NG; ++g) {
    XR(phaseR(p, g, 0));
    xcd_barrier(xb);
    for (int l = 0; l < DEPTH; ++l) {
      for (int rep = 0; rep < REP_G; ++rep) {
        const u16* Bt = (const u16*)(p.ws + O_WTIN) + (size_t)l * NZ * 1024;
        if ((G & 7) == 0) {
          const int x = blockIdx.x & 7, bl = blockIdx.x >> 3, nbl = G >> 3;
          for (int q = bl; q < 9 * 45; q += nbl) { XG0(gemm_tile<0>(u, 1024, Bt, 1024, 9 * x + q % 9, q / 9, z, zT, ab, o, smem)); }
        } else {
          for (int t = blockIdx.x; t < 72 * 45; t += G) { XG0(gemm_tile<0>(u, 1024, Bt, 1024, t % 72, t / 72, z, zT, ab, o, smem)); }
        }
      }
      xcd_barrier(xb);
      for (int rep2 = 0; rep2 < REP_M; ++rep2) {
      for (int rep3 = 0; rep3 < REP_A; ++rep3) {
        if (rep3) xcd_barrier(xb);
        const int nb = NCH * 4, nc = NCH * 4, na = NCH * 8;
        for (int t = blockIdx.x; t < nb + nc + na; t += G) {
          if (t < nc) { XCL(c_local2(p, l, t, smem)); }
          else if (t < nb + nc) { XBL(b_local(p, l, t - nc, smem)); }
          else { XA0(a_item(p, l, t - nb - nc, 0, smem)); }
        }
      }
      xcd_barrier(xb);
      {
        for (int t = blockIdx.x; t < 256 + 16; t += G) {
          if (t < 128) { XBS(b_seq2(p, t, smem)); }
          else if (t < 256) { XCS(c_seq2(p, t - 128, smem)); }
          else { XAC(a_carry(p, t - 256)); }
        }
      }
      xcd_barrier(xb);
      }
      {
        const int na = NCH * 8, nm = GR / 4;
        for (int t = blockIdx.x; t < na + nm; t += G) {
          if (t < na) { XA1(a_item(p, l, t, 1, smem)); }
          else { XBC(bc_merge(p, l, t - na)); }
        }
      }
      xcd_barrier(xb);
      for (int rep = 0; rep < REP_G; ++rep) {
        const u16* Bt = (const u16*)(p.ws + O_WTOUT) + (size_t)l * 1024 * 1536;
        for (int t = blockIdx.x; t < 72 * 8; t += G) { XG1(gemm_tile<1>(z + C_GA, NZ, Bt, 1536, t % 72, t / 72, z, zT, ab, o, smem)); }
      }
      xcd_barrier(xb);
      XR(phaseR(p, g, l + 1));
      xcd_barrier(xb);
    }
  }
}

extern "C" void kernel_launch(void* const* d_in, const int* in_sizes, int n_in, void* d_out, int out_size, void* d_ws,
                              size_t ws_size, hipStream_t stream) {
  static int grid_blocks = 0;
  if (!grid_blocks) {
    int dev = 0, cus = 0, per_cu = 0;
    hipGetDevice(&dev);
    hipDeviceGetAttribute(&cus, hipDeviceAttributeMultiprocessorCount, dev);
    hipFuncSetAttribute((const void*)fwd_mega, hipFuncAttributeMaxDynamicSharedMemorySize, LDS_BYTES);
    hipOccupancyMaxActiveBlocksPerMultiprocessor(&per_cu, fwd_mega, 256, LDS_BYTES);
    if (per_cu > 2) per_cu = 2;
    if (per_cu < 1) per_cu = 1;
    grid_blocks = cus * per_cu;
  }
  if (ws_size < WS_TOTAL) {
    fprintf(stderr, "workspace too small: %zu < %zu\n", ws_size, (size_t)WS_TOTAL);
    return;
  }
  P p{};
  const float** f = (const float**)&p;
  for (int i = 0; i < 23; ++i) f[i] = (const float*)d_in[i];
  p.out = (float*)d_out;
  p.ws = (char*)d_ws;
  hipMemsetAsync((char*)d_ws + O_BAR, 0, XCD_BAR_WORDS * 4, stream);
  void* args[] = {&p};
  hipError_t e = hipLaunchCooperativeKernel((void*)fwd_mega, dim3(grid_blocks), dim3(256), args, LDS_BYTES, stream);
  if (e != hipSuccess) fprintf(stderr, "cooperative launch failed: %s (grid %d)\n", hipGetErrorString(e), grid_blocks);
}
```

```cpp
#include <hip/hip_runtime.h>
#include <hip/hip_cooperative_groups.h>
#include <cstdio>
namespace cg = cooperative_groups;

typedef __attribute__((ext_vector_type(8))) short bf16x8;
typedef __attribute__((ext_vector_type(4))) float f32x4;
typedef unsigned short u16;
#define DEV __device__ __forceinline__

constexpr int DM = 1024, TL = 2048, TCX = 256, TS = 2304, GB = 4, GR = GB * TS, NG = 2;
constexpr int NZ = 5760, DEPTH = 4;
constexpr int C_XA = 0, C_Q = 512, C_K = 1024, C_V = 1536, C_QC = 2048, C_F0 = 2560, C_IC = 3584,
              C_GA = 4096, C_GB = 4608, C_GC = 5120, C_AB = 5632;
constexpr int NCH = GR / 64;
constexpr float EPS = 1e-6f;
constexpr int WPB = 2;

constexpr size_t al256(size_t x) { return (x + 255) & ~(size_t)255; }
constexpr size_t O_WTIN = 0;
constexpr size_t O_WTOUT = O_WTIN + al256((size_t)DEPTH * NZ * 1024 * 2);
constexpr size_t O_WGT = O_WTOUT + al256((size_t)DEPTH * 1024 * 1536 * 2);
constexpr size_t O_MOD = O_WGT + al256((size_t)DEPTH * 2 * 2 * 8 * 4096 * 2);
constexpr size_t O_LBS = O_MOD + al256((size_t)DEPTH * 9 * 3072 * 4);
constexpr size_t O_HC = O_LBS + al256((size_t)DEPTH * 1024 * 4);
constexpr size_t O_Z = O_HC + al256((size_t)GB * TCX * 1024 * 4);
constexpr size_t O_ZT = O_Z + al256((size_t)GR * NZ * 2);
constexpr size_t O_AB = O_ZT + al256((size_t)512 * GR * 2);
constexpr size_t O_BSH = O_AB + al256((size_t)GR * 16 * 4);
constexpr size_t BSH_ONE = (size_t)GR * 512 * 2;
constexpr size_t O_BIT = O_BSH + al256(4 * BSH_ONE);
constexpr size_t BIT_SZ = 17408;
constexpr size_t O_CREC = O_BIT + al256((size_t)NCH * 4 * 2 * BIT_SZ);
constexpr size_t CREC_SZ = 33280;
constexpr size_t O_OB = O_CREC + al256((size_t)NCH * 4 * 2 * CREC_SZ);
constexpr size_t O_OC = O_OB + al256((size_t)2 * GR * 512 * 2);
constexpr size_t O_AP = O_OC + al256((size_t)2 * GR * 512 * 2);
constexpr size_t O_AH = O_AP + al256((size_t)NCH * 2 * 512 * 4);
constexpr size_t O_ACAR = O_AH + al256((size_t)NCH * 2 * 512 * 4);
constexpr size_t O_BAR = O_ACAR + al256((size_t)NCH * 2 * 512 * 4);
constexpr size_t WS_TOTAL = O_BAR + al256(3456 * 4);

constexpr int LDS_BYTES = 73728;
#ifndef REP_A
#define REP_A 1
#endif
#ifndef REP_G
#define REP_G 1
#endif
#ifndef REP_M
#define REP_M 1
#endif

struct P {
  const float *x, *c, *ctx, *c_ctx, *w_ada, *b_ada, *norm_pre, *norm_post, *w_in, *conv_a_w, *conv_a_b, *rg_w_r,
      *rg_b_r, *rg_w_i, *rg_b_i, *rg_lam, *conv_b_w, *gdn_a_log, *gdn_dt_bias, *gdn_norm, *hg_lb, *hg_norm, *w_out;
  float* out;
  char* ws;
};

DEV int opq(int x) { asm volatile("" : "+v"(x)); return x; }
DEV int opqs(int x) { asm volatile("" : "+s"(x)); return x; }
typedef __attribute__((ext_vector_type(2))) __bf16 bf16x2_t;
typedef __attribute__((ext_vector_type(2))) float f32x2_t;
DEV u16 f2bf(float f) { __bf16 r = (__bf16)f; return __builtin_bit_cast(u16, r); }
DEV float bf2f(u16 h) { return __uint_as_float(((unsigned)h) << 16); }
DEV unsigned pk2(float a, float b) { f32x2_t v = {a, b}; bf16x2_t r = __builtin_convertvector(v, bf16x2_t); return __builtin_bit_cast(unsigned, r); }
DEV float sigm(float x) { return __builtin_amdgcn_rcpf(1.f + __expf(-x)); }
DEV float silu(float x) { return x * __builtin_amdgcn_rcpf(1.f + __expf(-x)); }
DEV float softplus(float x) { return x > 20.f ? x : log1pf(__expf(x)); }
DEV f32x4 mfma(bf16x8 a, bf16x8 b, f32x4 c) { return __builtin_amdgcn_mfma_f32_16x16x32_bf16(a, b, c, 0, 0, 0); }
DEV bf16x8 ld8(const u16* p) { return *reinterpret_cast<const bf16x8*>(p); }
DEV int lat_map(int l, int t) { return (l & 1) ? ((t & 63) * 32 + (t >> 6)) : t; }
DEV int orig_col(int n) {
  if (n < 512) return n;
  if (n < 2048) return n + 512;
  if (n < 4096) return n + 1040;
  if (n < 4608) return n - 4096 + 512;
  if (n < 5120) return n - 4608 + 2576;
  if (n < 5632) return n + 16;
  if (n < 5648) return n - 5632 + 2560;
  return -1;
}
DEV float zval(const u16* z, int rb, int cp, int n, int col) {
  if (cp < 0 && (n == 0 || n == 4)) return 0.f;
  if (cp > 63 && (n == 3 || n == 35)) return 0.f;
  return bf2f(z[(size_t)(rb + cp) * NZ + col]);
}

DEV void ph0_ada(const P& p, int item, char* smem) {
  float* sc = (float*)smem;
  float* red = (float*)(smem + 36864);
  const int tid = threadIdx.x, lane = tid & 63, wv = tid >> 6;
  for (int i = tid; i < 9 * 1024; i += 256) {
    int v = i >> 10, d = i & 1023;
    float cv = (v < 8) ? p.c[v * 1024 + d] : p.c_ctx[d];
    sc[i] = silu(cv);
  }
  __syncthreads();
  const int col = item * 64 + lane;
  const int l = col / 3072, e = col % 3072;
  const float* w = p.w_ada + (size_t)l * 1024 * 3072 + e + (size_t)(256 * wv) * 3072;
  const float* scw = sc + 256 * wv;
  float acc[9];
#pragma unroll
  for (int i = 0; i < 9; ++i) acc[i] = 0.f;
  for (int d = 0; d < 256; d += 16) {
    float wr[16];
#pragma unroll
    for (int k = 0; k < 16; ++k) wr[k] = w[(size_t)(d + k) * 3072];
#pragma unroll
    for (int k = 0; k < 16; ++k)
#pragma unroll
      for (int i = 0; i < 9; ++i) acc[i] += scw[i * 1024 + d + k] * wr[k];
  }
#pragma unroll
  for (int i = 0; i < 9; ++i) red[(wv * 9 + i) * 64 + lane] = acc[i];
  __syncthreads();
  float* mod = (float*)(p.ws + O_MOD);
  for (int idx = tid; idx < 9 * 64; idx += 256) {
    int i = idx >> 6, ln = idx & 63;
    float sum = red[(0 * 9 + i) * 64 + ln] + red[(1 * 9 + i) * 64 + ln] + red[(2 * 9 + i) * 64 + ln] + red[(3 * 9 + i) * 64 + ln];
    int cc = item * 64 + ln, l2 = cc / 3072, e2 = cc % 3072;
    mod[((size_t)l2 * 9 + i) * 3072 + e2] = sum + p.b_ada[l2 * 3072 + e2];
  }
  __syncthreads();
}
DEV void tconv_tile(const float* src, int lds_, u16* dst, int ldd, int k0, int n0, bool mapcol, char* smem) {
  float* t = (float*)smem;
  const int tid = threadIdx.x, nn = tid & 63, kq = tid >> 6;
  const int n = n0 + nn;
  const int sn0 = mapcol ? orig_col(n) : n;
  const float msk = (sn0 >= 0) ? 1.f : 0.f;
  const int sn = sn0 >= 0 ? sn0 : 0;
  float v[16];
#pragma unroll
  for (int k = 0; k < 16; ++k) v[k] = src[(size_t)(k0 + kq + 4 * k) * lds_ + sn];
#pragma unroll
  for (int k = 0; k < 16; ++k) t[(kq + 4 * k) * 65 + nn] = v[k] * msk;
  __syncthreads();
  {
    const int kk = tid & 63, nq = tid >> 6;
#pragma unroll
    for (int k = 0; k < 16; ++k) {
      int n2 = nq + 4 * k;
      dst[(size_t)(n0 + n2) * ldd + k0 + kk] = f2bf(t[kk * 65 + n2]);
    }
  }
  __syncthreads();
}
DEV void phase0(const P& p, char* smem) {
  const int n_ada = 192, n_in = DEPTH * 16 * 90, n_out = DEPTH * 24 * 16, n_g = 128, n_lb = 4;
  const int total = n_ada + n_in + n_out + n_g + n_lb;
  for (int it = blockIdx.x; it < total; it += gridDim.x) {
    int i = it;
    if (i < n_ada) { ph0_ada(p, i, smem); continue; }
    i -= n_ada;
    if (i < n_in) {
      int l = i / 1440, r = i % 1440, kt = r / 90, nt = r % 90;
      tconv_tile(p.w_in + (size_t)l * 1024 * 5648, 5648, (u16*)(p.ws + O_WTIN) + (size_t)l * NZ * 1024, 1024, kt * 64,
                 nt * 64, true, smem);
      continue;
    }
    i -= n_in;
    if (i < n_out) {
      int l = i / 384, r = i % 384, kt = r / 16, nt = r % 16;
      tconv_tile(p.w_out + (size_t)l * 1536 * 1024, 1024, (u16*)(p.ws + O_WTOUT) + (size_t)l * 1024 * 1536, 1536,
                 kt * 64, nt * 64, false, smem);
      continue;
    }
    i -= n_out;
    if (i < n_g) {
      int h = i & 7, gate = (i >> 3) & 1, dir = (i >> 4) & 1, l = i >> 5;
      const float* src = (gate ? p.rg_w_i : p.rg_w_r) + ((size_t)(l * 2 + dir) * 8 + h) * 4096;
      tconv_tile(src, 64, (u16*)(p.ws + O_WGT) + (size_t)i * 4096, 64, 0, 0, false, smem);
      continue;
    }
    i -= n_g;
    {
      int j = i * 256 + threadIdx.x;
      float v[4], mx = -1e30f;
      for (int l = 0; l < 4; ++l) { v[l] = p.hg_lb[l * 1024 + j]; mx = fmaxf(mx, v[l]); }
      float s = 0.f;
      for (int l = 0; l < 4; ++l) { v[l] = __expf(v[l] - mx); s += v[l]; }
      float* lbs = (float*)(p.ws + O_LBS);
      float cum = 0.f;
      for (int l = 0; l < 4; ++l) {
        if (l > 0) cum += v[l] / s;
        lbs[l * 1024 + j] = cum;
      }
    }
  }
}

DEV void phaseR(const P& p, int g, int l) {
  const int tid_ = opq(threadIdx.x); const int lane = tid_ & 63, w = tid_ >> 6;
  const float* mod = (const float*)(p.ws + O_MOD);
  float* hc = (float*)(p.ws + O_HC);
  const float* o = (const float*)(p.ws + O_BSH);
  u16* u = (u16*)(p.ws + O_BIT);
  for (int it = blockIdx.x; it < GR / 4; it += gridDim.x) {
    int lr = it * 4 + w;
    int lb = lr / TS, s = lr % TS;
    bool isctx = s < TCX;
    if (l == DEPTH && isctx) continue;
    int b = g * GB + lb, t = s - TCX;
    int mi = isctx ? 8 : b;
    float* hp = isctx ? hc + ((size_t)lb * TCX + s) * 1024 : p.out + ((size_t)b * TL + t) * 1024;
    float hv[16];
    if (l == 0) {
      const float* src = isctx ? p.ctx + ((size_t)b * TCX + s) * 1024 : p.x + ((size_t)b * TL + t) * 1024;
#pragma unroll
      for (int k = 0; k < 4; ++k) {
        float4 v = *(const float4*)(src + k * 256 + lane * 4);
        hv[k * 4] = v.x; hv[k * 4 + 1] = v.y; hv[k * 4 + 2] = v.z; hv[k * 4 + 3] = v.w;
      }
    } else {
      int orow = lb * TS + (isctx ? s : TCX + lat_map(l - 1, t));
      const float* op = o + (size_t)orow * 1024;
      float ov[16], ss = 0.f;
#pragma unroll
      for (int k = 0; k < 4; ++k) {
        float4 v = *(const float4*)(op + k * 256 + lane * 4);
        ov[k * 4] = v.x; ov[k * 4 + 1] = v.y; ov[k * 4 + 2] = v.z; ov[k * 4 + 3] = v.w;
        ss += v.x * v.x + v.y * v.y + v.z * v.z + v.w * v.w;
      }
#pragma unroll
      for (int off = 32; off; off >>= 1) ss += __shfl_xor(ss, off);
      float rinv = rsqrtf(ss * (1.f / 1024.f) + EPS);
      const float* gate = mod + ((size_t)(l - 1) * 9 + mi) * 3072 + 2048;
      const float* wp = p.norm_post + (l - 1) * 1024;
#pragma unroll
      for (int k = 0; k < 4; ++k) {
        float4 hh = *(const float4*)(hp + k * 256 + lane * 4);
        float4 gg = *(const float4*)(gate + k * 256 + lane * 4);
        float4 ww = *(const float4*)(wp + k * 256 + lane * 4);
        hv[k * 4] = hh.x + gg.x * (ov[k * 4] * rinv * ww.x);
        hv[k * 4 + 1] = hh.y + gg.y * (ov[k * 4 + 1] * rinv * ww.y);
        hv[k * 4 + 2] = hh.z + gg.z * (ov[k * 4 + 2] * rinv * ww.z);
        hv[k * 4 + 3] = hh.w + gg.w * (ov[k * 4 + 3] * rinv * ww.w);
      }
    }
#pragma unroll
    for (int k = 0; k < 4; ++k)
      *(float4*)(hp + k * 256 + lane * 4) = make_float4(hv[k * 4], hv[k * 4 + 1], hv[k * 4 + 2], hv[k * 4 + 3]);
    if (l < DEPTH) {
      float ss = 0.f;
#pragma unroll
      for (int k = 0; k < 16; ++k) ss += hv[k] * hv[k];
#pragma unroll
      for (int off = 32; off; off >>= 1) ss += __shfl_xor(ss, off);
      float rinv = rsqrtf(ss * (1.f / 1024.f) + EPS);
      const float* sh = mod + ((size_t)l * 9 + mi) * 3072;
      const float* wp = p.norm_pre + l * 1024;
      int urow = lb * TS + (isctx ? s : TCX + lat_map(l, t));
      u16* up = u + (size_t)urow * 1024;
#pragma unroll
      for (int k = 0; k < 4; ++k) {
        float4 ww = *(const float4*)(wp + k * 256 + lane * 4);
        float4 s0 = *(const float4*)(sh + k * 256 + lane * 4);
        float4 s1 = *(const float4*)(sh + 1024 + k * 256 + lane * 4);
        float a0 = hv[k * 4] * rinv * ww.x * (1.f + s1.x) + s0.x;
        float a1 = hv[k * 4 + 1] * rinv * ww.y * (1.f + s1.y) + s0.y;
        float a2 = hv[k * 4 + 2] * rinv * ww.z * (1.f + s1.z) + s0.z;
        float a3 = hv[k * 4 + 3] * rinv * ww.w * (1.f + s1.w) + s0.w;
        uint2 pk; pk.x = pk2(a0, a1); pk.y = pk2(a2, a3);
        *(uint2*)(up + k * 256 + lane * 4) = pk;
      }
    }
  }
}

template <int MODE>
DEV void gemm_tile(const u16* __restrict__ A, int lda, const u16* __restrict__ Bt, int K, int rt, int ct, u16* z,
                   u16* zT, float* ab, float* o, char* smem) {
  u16* As = (u16*)smem;
  u16* Bs = As + 128 * 72;
  const int tid = opq(threadIdx.x), lane = tid & 63, w = tid >> 6, wr = w >> 1, wc = w & 1, fr = lane & 15, fq = lane >> 4;
  const int lrow = tid >> 3, lseg = tid & 7;
  const u16* Ag = A + (size_t)(rt * 128 + lrow) * lda + lseg * 8;
  const u16* Bg = Bt + (size_t)(ct * 128 + lrow) * K + lseg * 8;
  uint4 ra0, ra1, ra2, ra3, rb0, rb1, rb2, rb3;
  f32x4 acc[4][4];
#pragma unroll
  for (int i = 0; i < 4; ++i)
#pragma unroll
    for (int j = 0; j < 4; ++j) acc[i][j] = (f32x4){0.f, 0.f, 0.f, 0.f};
#define GLOAD()                                             \
  ra0 = *(const uint4*)(Ag);                                \
  ra1 = *(const uint4*)(Ag + (size_t)32 * lda);             \
  ra2 = *(const uint4*)(Ag + (size_t)64 * lda);             \
  ra3 = *(const uint4*)(Ag + (size_t)96 * lda);             \
  rb0 = *(const uint4*)(Bg);                                \
  rb1 = *(const uint4*)(Bg + (size_t)32 * K);               \
  rb2 = *(const uint4*)(Bg + (size_t)64 * K);               \
  rb3 = *(const uint4*)(Bg + (size_t)96 * K);
  GLOAD();
  const int nk = K / 64;
#define GSTORE(bufo)                                                      \
  *(uint4*)(As + (bufo) + (lrow)*72 + lseg * 8) = ra0;                    \
  *(uint4*)(As + (bufo) + (lrow + 32) * 72 + lseg * 8) = ra1;             \
  *(uint4*)(As + (bufo) + (lrow + 64) * 72 + lseg * 8) = ra2;             \
  *(uint4*)(As + (bufo) + (lrow + 96) * 72 + lseg * 8) = ra3;             \
  *(uint4*)(Bs + (bufo) + (lrow)*72 + lseg * 8) = rb0;                    \
  *(uint4*)(Bs + (bufo) + (lrow + 32) * 72 + lseg * 8) = rb1;             \
  *(uint4*)(Bs + (bufo) + (lrow + 64) * 72 + lseg * 8) = rb2;             \
  *(uint4*)(Bs + (bufo) + (lrow + 96) * 72 + lseg * 8) = rb3;
  GSTORE(0)
  __syncthreads();
  for (int kt = 0; kt < nk; ++kt) {
    const int cb = (kt & 1) * (2 * 128 * 72);
    if (kt + 1 < nk) {
      Ag += 64; Bg += 64;
      GLOAD();
    }
#pragma unroll
    for (int ks = 0; ks < 2; ++ks) {
      bf16x8 af[4], bfr[4];
#pragma unroll
      for (int mi = 0; mi < 4; ++mi) af[mi] = ld8(As + cb + (wr * 64 + mi * 16 + fr) * 72 + ks * 32 + fq * 8);
#pragma unroll
      for (int ni = 0; ni < 4; ++ni) bfr[ni] = ld8(Bs + cb + (wc * 64 + ni * 16 + fr) * 72 + ks * 32 + fq * 8);
#pragma unroll
      for (int mi = 0; mi < 4; ++mi)
#pragma unroll
        for (int ni = 0; ni < 4; ++ni) acc[mi][ni] = mfma(af[mi], bfr[ni], acc[mi][ni]);
    }
    if (kt + 1 < nk) {
      const int nb_ = ((kt + 1) & 1) * (2 * 128 * 72);
      GSTORE(nb_)
    }
    __syncthreads();
  }
#pragma unroll
  for (int mi = 0; mi < 4; ++mi)
#pragma unroll
    for (int ni = 0; ni < 4; ++ni) {
      int row0 = rt * 128 + wr * 64 + mi * 16 + fq * 4;
      int col = ct * 128 + wc * 64 + ni * 16 + fr;
      f32x4 v = acc[mi][ni];
      if (MODE == 1) {
#pragma unroll
        for (int r = 0; r < 4; ++r) o[(size_t)(row0 + r) * 1024 + col] = v[r];
      } else {
        if (ct >= 28 && ct < 32) {
          uint2 pk; pk.x = pk2(v[0], v[1]); pk.y = pk2(v[2], v[3]);
          *(uint2*)(zT + (size_t)(col - C_IC) * GR + row0) = pk;
        } else if (ct == 44) {
          if (col - C_AB < 16) {
#pragma unroll
            for (int r = 0; r < 4; ++r) ab[(size_t)(row0 + r) * 16 + (col - C_AB)] = v[r];
          }
        } else {
#pragma unroll
          for (int r = 0; r < 4; ++r) z[(size_t)(row0 + r) * NZ + col] = f2bf(v[r]);
        }
      }
    }
}

DEV void a_item(const P& p, int l, int item, int mode, char* smem) {
  float* xc = (float*)smem;
  u16* xcb = (u16*)(smem + 16384);
  float* av = (float*)(smem + 16384 + 9216);
  float* uv = av + 4096;
  float* segP = uv + 4096;
  float* segH = segP + 256;
  const int tid = opq(threadIdx.x), lane = tid & 63, w = tid >> 6, fr = lane & 15, fq = lane >> 4;
  const int cgk = item >> 3, hA = item & 7, n = cgk % 36, rb = cgk * 64;
  u16* z = (u16*)(p.ws + O_Z);
  for (int idx = tid; idx < 4096; idx += 256) {
    int c = idx >> 6, j = idx & 63, ch = hA * 64 + j;
    float val = p.conv_a_b[l * 512 + ch];
#pragma unroll
    for (int tap = 0; tap < 4; ++tap) val += p.conv_a_w[(l * 4 + tap) * 512 + ch] * zval(z, rb, c + tap - 2, n, C_XA + ch);
    xc[idx] = val;
    xcb[c * 72 + j] = f2bf(val);
  }
  __syncthreads();
  float yacc[16];
#pragma unroll
  for (int k = 0; k < 16; ++k) yacc[k] = 0.f;
  const int seg = tid >> 6, sj = tid & 63, sch = hA * 64 + sj;
  for (int dir = 0; dir < 2; ++dir) {
    {
      const u16* wg = (const u16*)(p.ws + O_WGT);
      const u16* wr_ = wg + (size_t)((((l * 2 + dir) * 2 + 0) * 8 + hA)) * 4096;
      const u16* wi_ = wg + (size_t)((((l * 2 + dir) * 2 + 1) * 8 + hA)) * 4096;
      bf16x8 a0 = ld8(xcb + (16 * w + fr) * 72 + fq * 8), a1 = ld8(xcb + (16 * w + fr) * 72 + 32 + fq * 8);
#pragma unroll
      for (int nt = 0; nt < 4; ++nt) {
        f32x4 ar = {0.f, 0.f, 0.f, 0.f}, ai = {0.f, 0.f, 0.f, 0.f};
        const u16* br = wr_ + (nt * 16 + fr) * 64 + fq * 8;
        const u16* bi = wi_ + (nt * 16 + fr) * 64 + fq * 8;
        ar = mfma(a0, ld8(br), ar); ar = mfma(a1, ld8(br + 32), ar);
        ai = mfma(a0, ld8(bi), ai); ai = mfma(a1, ld8(bi + 32), ai);
        int j = nt * 16 + fr, ch = hA * 64 + j;
        float brv = p.rg_b_r[(l * 2 + dir) * 512 + ch], biv = p.rg_b_i[(l * 2 + dir) * 512 + ch];
        float sp = softplus(-p.rg_lam[(l * 2 + dir) * 512 + ch]);
#pragma unroll
        for (int r = 0; r < 4; ++r) {
          int c = 16 * w + 4 * fq + r;
          float rg = sigm(ar[r] + brv), ig = sigm(ai[r] + biv);
          float la = -8.f * rg * sp;
          float a = __expf(la);
          float uu = sqrtf(fmaxf(-expm1f(2.f * la), 0.f)) * (ig * xc[c * 64 + j]);
          av[c * 64 + j] = a;
          uv[c * 64 + j] = uu;
        }
      }
    }
    __syncthreads();
    {
      float Pp = 1.f, H = 0.f;
#pragma unroll
      for (int k = 0; k < 16; ++k) {
        int c = dir ? (16 * seg + 15 - k) : (16 * seg + k);
        float a = av[c * 64 + sj];
        H = a * H + uv[c * 64 + sj];
        Pp *= a;
      }
      segP[seg * 64 + sj] = Pp;
      segH[seg * 64 + sj] = H;
    }
    __syncthreads();
    if (mode == 0) {
      if (seg == 0) {
        float Pc = 1.f, Hc = 0.f;
        for (int q = 0; q < 4; ++q) {
          int sg = dir ? 3 - q : q;
          Hc = segP[sg * 64 + sj] * Hc + segH[sg * 64 + sj];
          Pc *= segP[sg * 64 + sj];
        }
        size_t idx = ((size_t)cgk * 2 + dir) * 512 + sch;
        ((float*)(p.ws + O_AP))[idx] = Pc;
        ((float*)(p.ws + O_AH))[idx] = Hc;
      }
    } else {
      float st = ((const float*)(p.ws + O_ACAR))[((size_t)cgk * 2 + dir) * 512 + sch];
      int nbefore = dir ? 3 - seg : seg;
      for (int q = 0; q < nbefore; ++q) {
        int sg = dir ? 3 - q : q;
        st = segP[sg * 64 + sj] * st + segH[sg * 64 + sj];
      }
      if (dir == 0) {
#pragma unroll
        for (int k = 0; k < 16; ++k) {
          int c = 16 * seg + k;
          st = av[c * 64 + sj] * st + uv[c * 64 + sj];
          yacc[k] += st;
        }
      } else {
#pragma unroll
        for (int k = 15; k >= 0; --k) {
          int c = 16 * seg + k;
          st = av[c * 64 + sj] * st + uv[c * 64 + sj];
          yacc[k] += st;
        }
      }
    }
    __syncthreads();
  }
  if (mode == 1) {
#pragma unroll
    for (int k = 0; k < 16; ++k) {
      size_t zi = (size_t)(rb + 16 * seg + k) * NZ + C_GA + sch;
      float gate = bf2f(z[zi]);
      z[zi] = f2bf(yacc[k] * silu(gate));
    }
  }
}

DEV void a_carry(const P& p, int item) {
  int t = item * 256 + threadIdx.x;
  int ch = t & 511, dir = (t >> 9) & 1, lb = t >> 10;
  const float* AP = (const float*)(p.ws + O_AP);
  const float* AH = (const float*)(p.ws + O_AH);
  float* AC = (float*)(p.ws + O_ACAR);
  float st = 0.f;
  for (int j = 0; j < 36; ++j) {
    int n = dir ? (j < 4 ? 3 - j : 39 - j) : j;
    size_t idx = ((size_t)(lb * 36 + n) * 2 + dir) * 512 + ch;
    AC[idx] = st;
    st = AP[idx] * st + AH[idx];
  }
}

DEV void b_local(const P& p, int l, int item, char* smem) {
  u16* qs = (u16*)smem;
  u16* ks = qs + 64 * 136;
  float* Am = (float*)(smem + 34816);
  float* gc = (float*)(smem + 34816 + 32768);
  float* bt = gc + 128;
  const int tid = opq(threadIdx.x), lane = tid & 63, w = tid >> 6, fr = lane & 15, fq = lane >> 4;
  const int cgk = item >> 2, h = item & 3, n = cgk % 36, rb = cgk * 64;
  const u16* z = (const u16*)(p.ws + O_Z);
  u16* qn = (u16*)(p.ws + O_BSH);
  u16* kn = qn + (size_t)GR * 512;
  u16* vb = kn + (size_t)GR * 512;
  u16* knT = vb + (size_t)GR * 512;
  const float* ab = (const float*)(p.ws + O_AB);
  {
    u16* Tt = (u16*)Am;
    uint4 st[5];
#define BL_TLOAD(which)                                                                                  \
  _Pragma("unroll") for (int k = 0; k < 5; ++k) {                                                        \
    int idx = tid + 256 * k, row = idx >> 4, seg = idx & 15, cp = row - 2;                               \
    bool ok = (idx < 1072) && !((cp < 0 && (n == 0 || n == 4)) || (cp > 63 && (n == 3 || n == 35)));    \
    st[k] = make_uint4(0u, 0u, 0u, 0u);                                                                  \
    if (ok) st[k] = *(const uint4*)(z + (size_t)(rb + cp) * NZ + C_Q + (which)*512 + h * 128 + seg * 8); \
  }
    BL_TLOAD(0)
#pragma unroll
    for (int which = 0; which < 3; ++which) {
#pragma unroll
      for (int k = 0; k < 5; ++k) {
        int idx = tid + 256 * k, row = idx >> 4, seg = idx & 15;
        if (idx < 1072) *(uint4*)(Tt + row * 136 + seg * 8) = st[k];
      }
      __syncthreads();
      if (which < 2) { BL_TLOAD(which + 1) }
      float cw[2][4];
#pragma unroll
      for (int hh = 0; hh < 2; ++hh)
#pragma unroll
        for (int tap = 0; tap < 4; ++tap)
          cw[hh][tap] = p.conv_b_w[(size_t)(l * 4 + tap) * 1536 + which * 512 + h * 128 + lane + 64 * hh];
      for (int c = w; c < 64; c += 4) {
        float v[2];
#pragma unroll
        for (int hh = 0; hh < 2; ++hh) {
          int d = lane + 64 * hh;
          float a = 0.f;
#pragma unroll
          for (int tap = 0; tap < 4; ++tap) a += cw[hh][tap] * bf2f(Tt[(c + tap) * 136 + d]);
          v[hh] = silu(a);
        }
        float rs = 1.f;
        if (which < 2) {
          float sq = v[0] * v[0] + v[1] * v[1];
#pragma unroll
          for (int off = 32; off; off >>= 1) sq += __shfl_xor(sq, off);
          rs = rsqrtf(sq + EPS) * (which == 0 ? 0.08838834764831845f : 1.f);
        }
#pragma unroll
        for (int hh = 0; hh < 2; ++hh) {
          int d = lane + 64 * hh;
          u16 ob = f2bf(v[hh] * rs);
          size_t gi = (size_t)(rb + c) * 512 + h * 128 + d;
          if (which == 0) { qs[c * 136 + d] = ob; qn[gi] = ob; }
          else if (which == 1) { ks[c * 136 + d] = ob; kn[gi] = ob; }
          else vb[gi] = ob;
        }
      }
      __syncthreads();
    }
  }
  if (w < 2) {
    int dir = w, i = lane, c = dir ? 63 - i : i;
    float al = ab[(size_t)(rb + c) * 16 + dir * 4 + h], bl = ab[(size_t)(rb + c) * 16 + 8 + dir * 4 + h];
    float g = -__expf(p.gdn_a_log[(l * 2 + dir) * 4 + h]) * softplus(al + p.gdn_dt_bias[(l * 2 + dir) * 4 + h]);
#pragma unroll
    for (int off = 1; off < 64; off <<= 1) {
      float v = __shfl_up(g, off);
      if (lane >= off) g += v;
    }
    gc[dir * 64 + i] = g;
    bt[dir * 64 + i] = sigm(bl);
  }
  __syncthreads();
  for (int idx = tid; idx < 1024; idx += 256) {
    int d = idx >> 3, c8 = idx & 7;
    uint4 pk;
    pk.x = (unsigned)ks[(c8 * 8 + 0) * 136 + d] | ((unsigned)ks[(c8 * 8 + 1) * 136 + d] << 16);
    pk.y = (unsigned)ks[(c8 * 8 + 2) * 136 + d] | ((unsigned)ks[(c8 * 8 + 3) * 136 + d] << 16);
    pk.z = (unsigned)ks[(c8 * 8 + 4) * 136 + d] | ((unsigned)ks[(c8 * 8 + 5) * 136 + d] << 16);
    pk.w = (unsigned)ks[(c8 * 8 + 6) * 136 + d] | ((unsigned)ks[(c8 * 8 + 7) * 136 + d] << 16);
    *(uint4*)(knT + ((size_t)(cgk * 4 + h) * 128 + d) * 64 + c8 * 8) = pk;
  }
  for (int dir = 0; dir < 2; ++dir) {
    char* rec = p.ws + O_BIT + ((size_t)(cgk * 4 + h) * 2 + dir) * BIT_SZ;
    u16* QKm = (u16*)rec + 4096;
    float* scal = (float*)(rec + 16384);
    int irow = 16 * w + fr, ci = dir ? 63 - irow : irow;
    bf16x8 ak[4], aq[4];
#pragma unroll
    for (int s = 0; s < 4; ++s) { ak[s] = ld8(ks + ci * 136 + 32 * s + 8 * fq); aq[s] = ld8(qs + ci * 136 + 32 * s + 8 * fq); }
#pragma unroll
    for (int nt = 0; nt < 4; ++nt) {
      int jcol = 16 * nt + fr, cj = dir ? 63 - jcol : jcol;
      f32x4 kk = {0.f, 0.f, 0.f, 0.f}, qk = {0.f, 0.f, 0.f, 0.f};
#pragma unroll
      for (int s = 0; s < 4; ++s) {
        bf16x8 b = ld8(ks + cj * 136 + 32 * s + 8 * fq);
        kk = mfma(ak[s], b, kk);
        qk = mfma(aq[s], b, qk);
      }
      float gj = gc[dir * 64 + jcol];
#pragma unroll
      for (int r = 0; r < 4; ++r) {
        int i = 16 * w + 4 * fq + r;
        float dec = (jcol <= i) ? __expf(gc[dir * 64 + i] - gj) : 0.f;
        Am[(dir * 64 + i) * 64 + jcol] = (jcol < i) ? bt[dir * 64 + i] * kk[r] * dec : 0.f;
        QKm[i * 64 + jcol] = f2bf(qk[r] * dec);
      }
    }
    if (tid < 64) {
      float gl = gc[dir * 64 + 63], gi = gc[dir * 64 + tid];
      scal[tid] = __expf(gi);
      scal[64 + tid] = bt[dir * 64 + tid];
      scal[128 + tid] = __expf(gl - gi);
      if (tid == 0) scal[192] = __expf(gl);
    }
  }
  __syncthreads();
  if (w < 2) {
    int dir = w, col = lane;
    u16* Tinv = (u16*)(p.ws + O_BIT + ((size_t)(cgk * 4 + h) * 2 + dir) * BIT_SZ);
    const float* Ad = Am + dir * 4096;
    float T[64];
#pragma unroll
    for (int i = 0; i < 64; ++i) {
      float s = (i == col) ? 1.f : 0.f;
#pragma unroll
      for (int j = 0; j < i; ++j) s -= Ad[i * 64 + j] * T[j];
      T[i] = s;
      Tinv[i * 64 + col] = f2bf(s);
      __builtin_amdgcn_sched_barrier(0);
    }
  }
  __syncthreads();
}

DEV void b_seq(const P& p, int bitem, char* smem) {
  const int tid = opq(threadIdx.x), lane = tid & 63, w = tid >> 6, fr = lane & 15, fq = lane >> 4;
  const bool active = w < WPB;
  const int item = bitem * WPB + (active ? w : 0);
  const int slice = item & 7, dir = (item >> 3) & 1, h = (item >> 4) & 3, lb = item >> 6, e0 = slice * 16;
  u16* Ss = (u16*)(smem + w * 11264);
  u16* Rs = Ss + 16 * 136;
  u16* Vsc = Rs + 16 * 72;
  u16* Vor = Vsc + 16 * 72;
  const u16* qn = (const u16*)(p.ws + O_BSH);
  const u16* kn = qn + (size_t)GR * 512;
  const u16* vb = kn + (size_t)GR * 512;
  const u16* knT = vb + (size_t)GR * 512;
  u16* OB = (u16*)(p.ws + O_OB);
  f32x4 S[8];
#pragma unroll
  for (int m = 0; m < 8; ++m) S[m] = (f32x4){0.f, 0.f, 0.f, 0.f};
  for (int j = 0; j < 36; ++j) {
    const int n = dir ? (j < 4 ? 3 - j : 39 - j) : j;
    const int cgk = lb * 36 + n, rb = cgk * 64;
    const char* rec = p.ws + O_BIT + ((size_t)(cgk * 4 + h) * 2 + dir) * BIT_SZ;
    const u16* Tinv = (const u16*)rec;
    const u16* QKm = Tinv + 4096;
    const float* scal = (const float*)(rec + 16384);
    if (active) {
#pragma unroll
      for (int m = 0; m < 8; ++m) {
        uint2 pk; pk.x = pk2(S[m][0], S[m][1]); pk.y = pk2(S[m][2], S[m][3]);
        *(uint2*)(Ss + fr * 136 + 16 * m + 4 * fq) = pk;
      }
    }
    __syncthreads();
    bf16x8 Sf[4];
    if (active) {
#pragma unroll
      for (int s = 0; s < 4; ++s) Sf[s] = ld8(Ss + fr * 136 + 32 * s + 8 * fq);
#pragma unroll
      for (int m = 0; m < 4; ++m) {
        int i = 16 * m + fr, rowi = rb + (dir ? 63 - i : i);
        f32x4 X = {0.f, 0.f, 0.f, 0.f};
#pragma unroll
        for (int s = 0; s < 4; ++s) X = mfma(ld8(kn + (size_t)rowi * 512 + h * 128 + 32 * s + 8 * fq), Sf[s], X);
        float rv[4];
#pragma unroll
        for (int r = 0; r < 4; ++r) {
          int ii = 16 * m + 4 * fq + r, rowr = rb + (dir ? 63 - ii : ii);
          float v = bf2f(vb[(size_t)rowr * 512 + h * 128 + e0 + fr]);
          rv[r] = scal[64 + ii] * (v - scal[ii] * X[r]);
        }
        uint2 pk; pk.x = pk2(rv[0], rv[1]); pk.y = pk2(rv[2], rv[3]);
        *(uint2*)(Rs + fr * 72 + 16 * m + 4 * fq) = pk;
      }
    }
    __syncthreads();
    if (active) {
      bf16x8 Rf0 = ld8(Rs + fr * 72 + 8 * fq), Rf1 = ld8(Rs + fr * 72 + 32 + 8 * fq);
#pragma unroll
      for (int m = 0; m < 4; ++m) {
        f32x4 VN = {0.f, 0.f, 0.f, 0.f};
        VN = mfma(ld8(Tinv + (16 * m + fr) * 64 + 8 * fq), Rf0, VN);
        VN = mfma(ld8(Tinv + (16 * m + fr) * 64 + 32 + 8 * fq), Rf1, VN);
        uint2 pk; pk.x = pk2(VN[0], VN[1]); pk.y = pk2(VN[2], VN[3]);
        *(uint2*)(Vsc + fr * 72 + 16 * m + 4 * fq) = pk;
        int ib = 16 * m + 4 * fq;
        float s0 = VN[0] * scal[128 + ib], s1 = VN[1] * scal[128 + ib + 1], s2 = VN[2] * scal[128 + ib + 2],
              s3 = VN[3] * scal[128 + ib + 3];
        if (dir) {
          pk.x = pk2(s3, s2); pk.y = pk2(s1, s0);
          *(uint2*)(Vor + fr * 72 + (60 - ib)) = pk;
        } else {
          pk.x = pk2(s0, s1); pk.y = pk2(s2, s3);
          *(uint2*)(Vor + fr * 72 + ib) = pk;
        }
      }
    }
    __syncthreads();
    if (active) {
      bf16x8 Vs0 = ld8(Vsc + fr * 72 + 8 * fq), Vs1 = ld8(Vsc + fr * 72 + 32 + 8 * fq);
      bf16x8 Vo0 = ld8(Vor + fr * 72 + 8 * fq), Vo1 = ld8(Vor + fr * 72 + 32 + 8 * fq);
#pragma unroll
      for (int m = 0; m < 4; ++m) {
        int i = 16 * m + fr, rowi = rb + (dir ? 63 - i : i);
        f32x4 O = {0.f, 0.f, 0.f, 0.f};
#pragma unroll
        for (int s = 0; s < 4; ++s) O = mfma(ld8(qn + (size_t)rowi * 512 + h * 128 + 32 * s + 8 * fq), Sf[s], O);
#pragma unroll
        for (int r = 0; r < 4; ++r) O[r] *= scal[16 * m + 4 * fq + r];
        O = mfma(ld8(QKm + (16 * m + fr) * 64 + 8 * fq), Vs0, O);
        O = mfma(ld8(QKm + (16 * m + fr) * 64 + 32 + 8 * fq), Vs1, O);
#pragma unroll
        for (int r = 0; r < 4; ++r) {
          int ii = 16 * m + 4 * fq + r, rowr = rb + (dir ? 63 - ii : ii);
          OB[((size_t)dir * GR + rowr) * 512 + h * 128 + e0 + fr] = f2bf(O[r]);
        }
      }
      float egl = scal[192];
#pragma unroll
      for (int m = 0; m < 8; ++m) {
        const u16* kt = knT + ((size_t)(cgk * 4 + h) * 128 + 16 * m + fr) * 64;
        f32x4 t = S[m];
#pragma unroll
        for (int r = 0; r < 4; ++r) t[r] *= egl;
        t = mfma(ld8(kt + 8 * fq), Vo0, t);
        t = mfma(ld8(kt + 32 + 8 * fq), Vo1, t);
        S[m] = t;
      }
    }
  }
  __syncthreads();
}

DEV void c_local(const P& p, int l, int item, char* smem) {
  float* bsm = (float*)smem;
  u16* Ps = (u16*)(smem + 33024);
  u16* kdt = (u16*)(smem + 33024 + 9216);
  const int tid = opq(threadIdx.x), lane = tid & 63, w = tid >> 6, fr = lane & 15, fq = lane >> 4;
  const int cgk = item >> 2, h = item & 3, rb = cgk * 64;
  const u16* z = (const u16*)(p.ws + O_Z);
  const u16* zT = (const u16*)(p.ws + O_ZT);
  u16* OC = (u16*)(p.ws + O_OC);
  const float* lbs = (const float*)(p.ws + O_LBS);
  for (int dir = 0; dir < 2; ++dir) {
    char* rec = p.ws + O_CREC + ((size_t)(cgk * 4 + h) * 2 + dir) * CREC_SZ;
    u16* QD = (u16*)rec;
    u16* KDT = QD + 8192;
    float* decv = (float*)(rec + 32768);
    const float* lbp = lbs + l * 1024 + dir * 512 + h * 128;
    const int fcol = C_F0 + dir * 512 + h * 128;
    {
      int d = tid & 127, half = tid >> 7;
      float lb_ = lbp[d], run = 0.f;
      for (int k = 0; k < 32; ++k) {
        int i = 32 * half + k, c = dir ? 63 - i : i;
        float f = bf2f(z[(size_t)(rb + c) * NZ + fcol + d]);
        float fg = lb_ + (1.f - lb_) * sigm(f);
        run += __logf(fg);
        bsm[i * 129 + d] = run;
      }
    }
    __syncthreads();
    {
      int d = tid & 127, half = tid >> 7;
      if (half) {
        float add = bsm[31 * 129 + d];
        for (int k = 0; k < 32; ++k) bsm[(32 + k) * 129 + d] += add;
      }
    }
    __syncthreads();
    for (int idx = tid; idx < 8192; idx += 256) {
      int i = idx >> 7, d = idx & 127, c = dir ? 63 - i : i;
      float b = bsm[i * 129 + d];
      float q = silu(bf2f(z[(size_t)(rb + c) * NZ + C_QC + h * 128 + d]));
      QD[i * 128 + d] = f2bf(q * __expf(b));
      float f = bf2f(z[(size_t)(rb + c) * NZ + fcol + d]);
      float k = (1.f - lbp[d]) * sigm(-f);
      kdt[d * 72 + c] = f2bf(k * __expf(bsm[63 * 129 + d] - b));
    }
    if (tid < 128) decv[tid] = __expf(bsm[63 * 129 + tid]);
    __syncthreads();
    for (int idx = tid; idx < 1024; idx += 256) {
      int d = idx >> 3, c8 = idx & 7;
      *(uint4*)(KDT + d * 64 + c8 * 8) = *(const uint4*)(kdt + d * 72 + c8 * 8);
    }
    {
      const int sj = w;
      for (int si = 0; si < 4; ++si) {
        f32x4 acc = {0.f, 0.f, 0.f, 0.f};
        if (si >= sj) {
          int it = 16 * si + fr, jt = 16 * sj + fr;
          int ci = dir ? 63 - it : it, cj = dir ? 63 - jt : jt;
#pragma unroll
          for (int s = 0; s < 4; ++s) {
            int d0 = 32 * s + 8 * fq;
            bf16x8 qv = ld8(z + (size_t)(rb + ci) * NZ + C_QC + h * 128 + d0);
            bf16x8 fv = ld8(z + (size_t)(rb + cj) * NZ + fcol + d0);
            bf16x8 af, bf;
#pragma unroll
            for (int e = 0; e < 8; ++e) {
              int d = d0 + e;
              float Bs_ = si ? bsm[(16 * si - 1) * 129 + d] : 0.f;
              float qq = silu(bf2f((u16)qv[e])) * __expf(bsm[it * 129 + d] - Bs_);
              float kk = (1.f - lbp[d]) * sigm(-bf2f((u16)fv[e])) * __expf(Bs_ - bsm[jt * 129 + d]);
              af[e] = (short)f2bf(qq);
              bf[e] = (short)f2bf(kk);
            }
            acc = mfma(af, bf, acc);
          }
        }
#pragma unroll
        for (int r = 0; r < 4; ++r) {
          int i = 16 * si + 4 * fq + r, jj = 16 * sj + fr;
          float v = (si >= sj && jj <= i) ? acc[r] : 0.f;
          Ps[i * 72 + (dir ? 63 - jj : jj)] = f2bf(v);
        }
        __builtin_amdgcn_sched_barrier(0);
      }
    }
    __syncthreads();
#pragma unroll
    for (int nt2 = 0; nt2 < 2; ++nt2) {
      int e = h * 128 + (2 * w + nt2) * 16 + fr;
      bf16x8 v0 = ld8(zT + (size_t)e * GR + rb + 8 * fq), v1 = ld8(zT + (size_t)e * GR + rb + 32 + 8 * fq);
#pragma unroll
      for (int m = 0; m < 4; ++m) {
        f32x4 O = {0.f, 0.f, 0.f, 0.f};
        O = mfma(ld8(Ps + (16 * m + fr) * 72 + 8 * fq), v0, O);
        O = mfma(ld8(Ps + (16 * m + fr) * 72 + 32 + 8 * fq), v1, O);
#pragma unroll
        for (int r = 0; r < 4; ++r) {
          int ii = 16 * m + 4 * fq + r, rowr = rb + (dir ? 63 - ii : ii);
          OC[((size_t)dir * GR + rowr) * 512 + e] = f2bf(O[r]);
        }
      }
    }
    __syncthreads();
  }
}

DEV void c_seq(const P& p, int bitem, char* smem) {
  const int tid = opq(threadIdx.x), lane = tid & 63, w = tid >> 6, fr = lane & 15, fq = lane >> 4;
  const bool active = w < WPB;
  const int item = bitem * WPB + (active ? w : 0);
  const int slice = item & 7, dir = (item >> 3) & 1, h = (item >> 4) & 3, lb = item >> 6, e0 = slice * 16;
  u16* Ss = (u16*)(smem + w * 4352);
  const u16* zT = (const u16*)(p.ws + O_ZT);
  u16* OC = (u16*)(p.ws + O_OC);
  f32x4 S[8];
#pragma unroll
  for (int m = 0; m < 8; ++m) S[m] = (f32x4){0.f, 0.f, 0.f, 0.f};
  for (int j = 0; j < 36; ++j) {
    const int n = dir ? (j < 4 ? 3 - j : 39 - j) : j;
    const int cgk = lb * 36 + n, rb = cgk * 64;
    const char* rec = p.ws + O_CREC + ((size_t)(cgk * 4 + h) * 2 + dir) * CREC_SZ;
    const u16* QD = (const u16*)rec;
    const u16* KDT = QD + 8192;
    const float* decv = (const float*)(rec + 32768);
    if (active) {
#pragma unroll
      for (int m = 0; m < 8; ++m) {
        uint2 pk; pk.x = pk2(S[m][0], S[m][1]); pk.y = pk2(S[m][2], S[m][3]);
        *(uint2*)(Ss + fr * 136 + 16 * m + 4 * fq) = pk;
      }
    }
    __syncthreads();
    if (active) {
      bf16x8 Sf[4];
#pragma unroll
      for (int s = 0; s < 4; ++s) Sf[s] = ld8(Ss + fr * 136 + 32 * s + 8 * fq);
#pragma unroll
      for (int m = 0; m < 4; ++m) {
        f32x4 O = {0.f, 0.f, 0.f, 0.f};
#pragma unroll
        for (int s = 0; s < 4; ++s) O = mfma(ld8(QD + (16 * m + fr) * 128 + 32 * s + 8 * fq), Sf[s], O);
#pragma unroll
        for (int r = 0; r < 4; ++r) {
          int ii = 16 * m + 4 * fq + r, rowr = rb + (dir ? 63 - ii : ii);
          size_t oi = ((size_t)dir * GR + rowr) * 512 + h * 128 + e0 + fr;
          OC[oi] = f2bf(bf2f(OC[oi]) + O[r]);
        }
      }
      const u16* vp = zT + (size_t)(h * 128 + e0 + fr) * GR + rb;
      bf16x8 V0 = ld8(vp + 8 * fq), V1 = ld8(vp + 32 + 8 * fq);
#pragma unroll
      for (int m = 0; m < 8; ++m) {
        f32x4 t = S[m];
#pragma unroll
        for (int r = 0; r < 4; ++r) t[r] *= decv[16 * m + 4 * fq + r];
        t = mfma(ld8(KDT + (16 * m + fr) * 64 + 8 * fq), V0, t);
        t = mfma(ld8(KDT + (16 * m + fr) * 64 + 32 + 8 * fq), V1, t);
        S[m] = t;
      }
    }
    __syncthreads();
  }
}

#define LBAR()                                              \
  do {                                                      \
    asm volatile("s_waitcnt lgkmcnt(0)" ::: "memory");      \
    __builtin_amdgcn_s_barrier();                           \
    asm volatile("" ::: "memory");                          \
  } while (0)
#define CBAR() asm volatile("" ::: "memory")

DEV void c_local2(const P& p, int l, int item, char* smem) {
  float* bsm = (float*)smem;
  u16* Fq = (u16*)(smem + 33024);
  u16* kdt = (u16*)(smem + 50432);
  u16* Ps = kdt;
  const int tid = opq(threadIdx.x), lane = tid & 63, w = tid >> 6, fr = lane & 15, fq = lane >> 4;
  const int cgk = item >> 2, h = item & 3, rb = cgk * 64;
  const u16* z = (const u16*)(p.ws + O_Z);
  const u16* zT = (const u16*)(p.ws + O_ZT);
  u16* OC = (u16*)(p.ws + O_OC);
  const float* lbs = (const float*)(p.ws + O_LBS);
  u16* zq = (u16*)(p.ws + O_Z) + (size_t)rb * NZ + C_QC + h * 128;
  {
    uint4 t4[4];
#pragma unroll
    for (int k = 0; k < 4; ++k) {
      int idx = tid + 256 * k, c = idx >> 4, seg = idx & 15;
      t4[k] = *(const uint4*)(zq + (size_t)c * NZ + seg * 8);
    }
#pragma unroll
    for (int k = 0; k < 4; ++k) {
      int idx = tid + 256 * k, c = idx >> 4, seg = idx & 15;
      unsigned wv[4] = {t4[k].x, t4[k].y, t4[k].z, t4[k].w};
#pragma unroll
      for (int q = 0; q < 4; ++q)
        wv[q] = pk2(silu(bf2f((u16)(wv[q] & 0xffff))), silu(bf2f((u16)(wv[q] >> 16))));
      *(uint4*)(zq + (size_t)c * NZ + seg * 8) = make_uint4(wv[0], wv[1], wv[2], wv[3]);
    }
  }
  __syncthreads();
  for (int dir = 0; dir < 2; ++dir) {
    char* rec = p.ws + O_CREC + ((size_t)(cgk * 4 + h) * 2 + dir) * CREC_SZ;
    u16* QD = (u16*)rec;
    u16* KDT = QD + 8192;
    float* decv = (float*)(rec + 32768);
    const float* lbp = lbs + l * 1024 + dir * 512 + h * 128;
    const int fcol = C_F0 + dir * 512 + h * 128;
    {
      uint4 t4[4];
#pragma unroll
      for (int k = 0; k < 4; ++k) {
        int idx = tid + 256 * k, c = idx >> 4, seg = idx & 15;
        t4[k] = *(const uint4*)(z + (size_t)(rb + c) * NZ + fcol + seg * 8);
      }
#pragma unroll
      for (int k = 0; k < 4; ++k) {
        int idx = tid + 256 * k, c = idx >> 4, seg = idx & 15;
        *(uint4*)(Fq + c * 136 + seg * 8) = t4[k];
      }
    }
    __syncthreads();
    {
      int d = tid & 127, half = tid >> 7;
      float lb_ = lbp[d], run = 0.f;
#pragma unroll 8
      for (int k = 0; k < 32; ++k) {
        int i = 32 * half + k, c = dir ? 63 - i : i;
        float f = bf2f(Fq[c * 136 + d]);
        float fg = lb_ + (1.f - lb_) * sigm(f);
        run += __logf(fg);
        bsm[i * 129 + d] = run;
      }
    }
    __syncthreads();
    {
      int d = tid & 127, half = tid >> 7;
      if (half) {
        float add = bsm[31 * 129 + d];
#pragma unroll 8
        for (int k = 0; k < 32; ++k) bsm[(32 + k) * 129 + d] += add;
      }
    }
    __syncthreads();
    {
      uint4 qv[4];
#pragma unroll
      for (int k = 0; k < 4; ++k) {
        int idx = tid + 256 * k, c = idx >> 4, seg = idx & 15;
        qv[k] = *(const uint4*)(zq + (size_t)c * NZ + seg * 8);
      }
#pragma unroll
      for (int k = 0; k < 4; ++k) {
        int idx = tid + 256 * k, c = idx >> 4, seg = idx & 15, i = dir ? 63 - c : c, d0 = seg * 8;
        unsigned qw[4] = {qv[k].x, qv[k].y, qv[k].z, qv[k].w};
        uint4 fv4 = *(const uint4*)(Fq + c * 136 + d0);
        unsigned fw[4] = {fv4.x, fv4.y, fv4.z, fv4.w};
        unsigned qo[4], ko[4];
#pragma unroll
        for (int q = 0; q < 4; ++q) {
          int d = d0 + 2 * q;
          float b0 = bsm[i * 129 + d], b1 = bsm[i * 129 + d + 1];
          float bl0 = bsm[63 * 129 + d], bl1 = bsm[63 * 129 + d + 1];
          float q0 = bf2f((u16)(qw[q] & 0xffff)), q1 = bf2f((u16)(qw[q] >> 16));
          qo[q] = pk2(q0 * __expf(b0), q1 * __expf(b1));
          float k0 = (1.f - lbp[d]) * sigm(-bf2f((u16)(fw[q] & 0xffff)));
          float k1 = (1.f - lbp[d + 1]) * sigm(-bf2f((u16)(fw[q] >> 16)));
          ko[q] = pk2(k0, k1);
          kdt[d * 72 + c] = f2bf(k0 * __expf(bl0 - b0));
          kdt[(d + 1) * 72 + c] = f2bf(k1 * __expf(bl1 - b1));
        }
        *(uint4*)(QD + i * 128 + d0) = make_uint4(qo[0], qo[1], qo[2], qo[3]);
        *(uint4*)(Fq + c * 136 + d0) = make_uint4(ko[0], ko[1], ko[2], ko[3]);
      }
      if (tid < 128) decv[tid] = __expf(bsm[63 * 129 + tid]);
    }
    __syncthreads();
    for (int idx = tid; idx < 1024; idx += 256) {
      int d = idx >> 3, c8 = idx & 7;
      *(uint4*)(KDT + d * 64 + c8 * 8) = *(const uint4*)(kdt + d * 72 + c8 * 8);
    }
    bf16x8 qf[3][4];
#pragma unroll
    for (int t = 0; t < 3; ++t) {
      int k = w + 4 * t;
      int si = k < 4 ? 3 : (k < 7 ? 2 : (k < 9 ? 1 : 0));
      int it_ = 16 * si + fr, ci_ = dir ? 63 - it_ : it_;
#pragma unroll
      for (int s = 0; s < 4; ++s) qf[t][s] = ld8(zq + (size_t)ci_ * NZ + 32 * s + 8 * fq);
    }
    __syncthreads();
    for (int idx = tid; idx < 1536; idx += 256) {
      int tl = idx >> 8, e = idx & 255, r16 = e >> 4, c16 = e & 15;
      int si = tl < 3 ? 0 : (tl < 5 ? 1 : 2);
      int sj = tl < 3 ? tl + 1 : (tl < 5 ? tl - 1 : 3);
      int jj = 16 * sj + c16;
      Ps[(16 * si + r16) * 72 + (dir ? 63 - jj : jj)] = 0;
    }
#pragma unroll
    for (int t = 0; t < 3; ++t) {
      const int k = w + 4 * t;
      if (k < 10) {
        const int si = k < 4 ? 3 : (k < 7 ? 2 : (k < 9 ? 1 : 0));
        const int sj = k - (k < 4 ? 0 : (k < 7 ? 4 : (k < 9 ? 7 : 9)));
        const int it = 16 * si + fr, jt = 16 * sj + fr, cj = dir ? 63 - jt : jt;
        const int brow = si ? (16 * si - 1) : 0;
        const float bmul = si ? 1.f : 0.f;
        f32x4 acc = {0.f, 0.f, 0.f, 0.f};
#pragma unroll
        for (int s = 0; s < 4; ++s) {
          int d0 = 32 * s + 8 * fq;
          bf16x8 fv = ld8(Fq + cj * 136 + d0);
          bf16x8 af, bf;
#pragma unroll
          for (int e = 0; e < 8; ++e) {
            int d = d0 + e;
            float Bs_ = bmul * bsm[brow * 129 + d];
            float qq = bf2f((u16)qf[t][s][e]) * __expf(bsm[it * 129 + d] - Bs_);
            float kk = bf2f((u16)fv[e]) * __expf(Bs_ - bsm[jt * 129 + d]);
            af[e] = (short)f2bf(qq);
            bf[e] = (short)f2bf(kk);
          }
          acc = mfma(af, bf, acc);
          __builtin_amdgcn_sched_barrier(0);
        }
#pragma unroll
        for (int r = 0; r < 4; ++r) {
          int i = 16 * si + 4 * fq + r, jj = 16 * sj + fr;
          float v = (jj <= i) ? acc[r] : 0.f;
          Ps[i * 72 + (dir ? 63 - jj : jj)] = f2bf(v);
        }
      }
    }
    __syncthreads();
#pragma unroll
    for (int nt2 = 0; nt2 < 2; ++nt2) {
      int e = h * 128 + (2 * w + nt2) * 16 + fr;
      bf16x8 v0 = ld8(zT + (size_t)e * GR + rb + 8 * fq), v1 = ld8(zT + (size_t)e * GR + rb + 32 + 8 * fq);
#pragma unroll
      for (int m = 0; m < 4; ++m) {
        f32x4 O = {0.f, 0.f, 0.f, 0.f};
        O = mfma(ld8(Ps + (16 * m + fr) * 72 + 8 * fq), v0, O);
        O = mfma(ld8(Ps + (16 * m + fr) * 72 + 32 + 8 * fq), v1, O);
#pragma unroll
        for (int r = 0; r < 4; ++r) {
          int ii = 16 * m + 4 * fq + r, rowr = rb + (dir ? 63 - ii : ii);
          OC[((size_t)dir * GR + rowr) * 512 + e] = f2bf(O[r]);
        }
      }
    }
    __syncthreads();
  }
}

#define LBAR()                                              \
  do {                                                      \
    asm volatile("s_waitcnt lgkmcnt(0)" ::: "memory");      \
    __builtin_amdgcn_s_barrier();                           \
    asm volatile("" ::: "memory");                          \
  } while (0)
#define CBAR() asm volatile("" ::: "memory")
#define BS_CHUNK(jj) (dir ? ((jj) < 4 ? 3 - (jj) : 39 - (jj)) : (jj))
DEV bf16x8 ldo8(const char* base, unsigned off) { return *reinterpret_cast<const bf16x8*>(base + off); }
DEV void b_seq2(const P& p, int bitem, char* smem) {
  const int tid = opq(threadIdx.x), lane = tid & 63, w = tid >> 6, fr = lane & 15, fq = lane >> 4;
  const int es = bitem & 3, dir = (bitem >> 2) & 1, h = (bitem >> 3) & 3, lb = bitem >> 5, e0 = es * 32;
  u16* Ss = (u16*)smem;
  u16* Rs = Ss + 32 * 136;
  u16* Vsc = Rs + 32 * 72;
  u16* Vor = Vsc + 32 * 72;
  const char* qnB = p.ws + O_BSH + (size_t)h * 256;
  const char* knB = qnB + BSH_ONE;
  const char* vbB = knB + BSH_ONE + (size_t)e0 * 2;
  const char* ktB = p.ws + O_BSH + 3 * BSH_ONE + (size_t)h * 16384;
  const char* recB = p.ws + O_BIT + ((size_t)h * 2 + dir) * BIT_SZ;
  char* obB = p.ws + O_OB + ((size_t)dir * GR * 512 + h * 128 + e0) * 2;
  const int mrow = 16 * w + fr, crow0 = 16 * w + 4 * fq;
  const unsigned offA = (unsigned)((dir ? 63 - mrow : mrow) * 1024 + 16 * fq);
  unsigned offR[4];
#pragma unroll
  for (int r = 0; r < 4; ++r) offR[r] = (unsigned)((dir ? 63 - (crow0 + r) : (crow0 + r)) * 1024 + fr * 2);
  const unsigned offT = (unsigned)(mrow * 128 + 16 * fq);
  const unsigned offK = (unsigned)((32 * w + fr) * 128 + 16 * fq);
  const unsigned offS = (unsigned)(16384 + crow0 * 4);
  f32x4 S[2][2];
#pragma unroll
  for (int a = 0; a < 2; ++a)
#pragma unroll
    for (int b = 0; b < 2; ++b) S[a][b] = (f32x4){0.f, 0.f, 0.f, 0.f};
  bf16x8 Akn[4], Aqn[4], At[2], Aqk[2], AkT[2][2];
  u16 vbv[2][4];
  float4 eg4, be4, ek4;
  float egl;
#define BS_LOAD1(cg_)                                                              \
  {                                                                                \
    const size_t ro_ = (size_t)(cg_) * 65536;                                      \
    _Pragma("unroll") for (int s = 0; s < 4; ++s) {                                \
      Akn[s] = ldo8(knB + ro_, offA + 64 * s);                                     \
      Aqn[s] = ldo8(qnB + ro_, offA + 64 * s);                                     \
    }                                                                              \
    _Pragma("unroll") for (int r = 0; r < 4; ++r) {                                \
      vbv[0][r] = *(const u16*)(vbB + ro_ + offR[r]);                              \
      vbv[1][r] = *(const u16*)(vbB + ro_ + (offR[r] + 32));                       \
    }                                                                              \
    const char* rc_ = recB + (size_t)(cg_) * (8 * BIT_SZ);                         \
    eg4 = *(const float4*)(rc_ + offS);                                            \
    be4 = *(const float4*)(rc_ + (offS + 256));                                    \
  }
#define BS_LOAD2(cg_)                                                              \
  {                                                                                \
    const char* rc_ = recB + (size_t)(cg_) * (8 * BIT_SZ);                         \
    At[0] = ldo8(rc_, offT); At[1] = ldo8(rc_, offT + 64);                         \
    ek4 = *(const float4*)(rc_ + (offS + 512));                                    \
  }
#define BS_LOAD3(cg_)                                                              \
  {                                                                                \
    const char* rc_ = recB + (size_t)(cg_) * (8 * BIT_SZ);                         \
    Aqk[0] = ldo8(rc_, offT + 8192); Aqk[1] = ldo8(rc_, offT + 8192 + 64);         \
    egl = *(const float*)(rc_ + 16384 + 768);                                      \
    const char* kt_ = ktB + (size_t)(cg_) * 65536;                                 \
    AkT[0][0] = ldo8(kt_, offK); AkT[0][1] = ldo8(kt_, offK + 64);                 \
    AkT[1][0] = ldo8(kt_, offK + 2048); AkT[1][1] = ldo8(kt_, offK + 2048 + 64);   \
  }
  {
    const int c0 = lb * 36 + BS_CHUNK(0);
    BS_LOAD1(c0) BS_LOAD2(c0) BS_LOAD3(c0)
  }
  for (int j = 0; j < 36; ++j) {
    const int cgk = lb * 36 + BS_CHUNK(j);
    const int jn = (j + 1 < 36) ? j + 1 : j;
    const int cgn = lb * 36 + BS_CHUNK(jn);
#pragma unroll
    for (int mm = 0; mm < 2; ++mm)
#pragma unroll
      for (int nt = 0; nt < 2; ++nt) {
        uint2 pk; pk.x = pk2(S[mm][nt][0], S[mm][nt][1]); pk.y = pk2(S[mm][nt][2], S[mm][nt][3]);
        *(uint2*)(Ss + (16 * nt + fr) * 136 + 32 * w + 16 * mm + 4 * fq) = pk;
      }
    LBAR();
    f32x4 QS[2];
    {
      bf16x8 Sf[2][4];
#pragma unroll
      for (int nt = 0; nt < 2; ++nt)
#pragma unroll
        for (int s = 0; s < 4; ++s) Sf[nt][s] = ld8(Ss + (16 * nt + fr) * 136 + 32 * s + 8 * fq);
#pragma unroll
      for (int nt = 0; nt < 2; ++nt) {
        f32x4 X = {0.f, 0.f, 0.f, 0.f}, Q = {0.f, 0.f, 0.f, 0.f};
#pragma unroll
        for (int s = 0; s < 4; ++s) { X = mfma(Akn[s], Sf[nt][s], X); Q = mfma(Aqn[s], Sf[nt][s], Q); }
        float r0 = be4.x * (bf2f(vbv[nt][0]) - eg4.x * X[0]);
        float r1 = be4.y * (bf2f(vbv[nt][1]) - eg4.y * X[1]);
        float r2 = be4.z * (bf2f(vbv[nt][2]) - eg4.z * X[2]);
        float r3 = be4.w * (bf2f(vbv[nt][3]) - eg4.w * X[3]);
        uint2 pk; pk.x = pk2(r0, r1); pk.y = pk2(r2, r3);
        *(uint2*)(Rs + (16 * nt + fr) * 72 + crow0) = pk;
        Q[0] *= eg4.x; Q[1] *= eg4.y; Q[2] *= eg4.z; Q[3] *= eg4.w;
        QS[nt] = Q;
      }
    }
    CBAR();
    BS_LOAD1(cgn)
    LBAR();
    {
#pragma unroll
      for (int nt = 0; nt < 2; ++nt) {
        bf16x8 Rf0 = ld8(Rs + (16 * nt + fr) * 72 + 8 * fq), Rf1 = ld8(Rs + (16 * nt + fr) * 72 + 32 + 8 * fq);
        f32x4 VN = {0.f, 0.f, 0.f, 0.f};
        VN = mfma(At[0], Rf0, VN);
        VN = mfma(At[1], Rf1, VN);
        uint2 pk; pk.x = pk2(VN[0], VN[1]); pk.y = pk2(VN[2], VN[3]);
        *(uint2*)(Vsc + (16 * nt + fr) * 72 + crow0) = pk;
        float s0 = VN[0] * ek4.x, s1 = VN[1] * ek4.y, s2 = VN[2] * ek4.z, s3 = VN[3] * ek4.w;
        if (dir) {
          pk.x = pk2(s3, s2); pk.y = pk2(s1, s0);
          *(uint2*)(Vor + (16 * nt + fr) * 72 + (60 - crow0)) = pk;
        } else {
          pk.x = pk2(s0, s1); pk.y = pk2(s2, s3);
          *(uint2*)(Vor + (16 * nt + fr) * 72 + crow0) = pk;
        }
      }
    }
    CBAR();
    BS_LOAD2(cgn)
    LBAR();
    {
      char* ob_ = obB + (size_t)cgk * 65536;
#pragma unroll
      for (int nt = 0; nt < 2; ++nt) {
        bf16x8 Vs0 = ld8(Vsc + (16 * nt + fr) * 72 + 8 * fq), Vs1 = ld8(Vsc + (16 * nt + fr) * 72 + 32 + 8 * fq);
        bf16x8 Vo0 = ld8(Vor + (16 * nt + fr) * 72 + 8 * fq), Vo1 = ld8(Vor + (16 * nt + fr) * 72 + 32 + 8 * fq);
        f32x4 O = QS[nt];
        O = mfma(Aqk[0], Vs0, O);
        O = mfma(Aqk[1], Vs1, O);
#pragma unroll
        for (int r = 0; r < 4; ++r) *(u16*)(ob_ + (offR[r] + 32 * nt)) = f2bf(O[r]);
#pragma unroll
        for (int mm = 0; mm < 2; ++mm) {
          f32x4 t = S[mm][nt];
#pragma unroll
          for (int r = 0; r < 4; ++r) t[r] *= egl;
          t = mfma(AkT[mm][0], Vo0, t);
          t = mfma(AkT[mm][1], Vo1, t);
          S[mm][nt] = t;
        }
      }
    }
    CBAR();
    BS_LOAD3(cgn)
  }
  LBAR();
}

DEV void c_seq2(const P& p, int bitem, char* smem) {
  const int tid = opq(threadIdx.x), lane = tid & 63, w = tid >> 6, fr = lane & 15, fq = lane >> 4;
  const int es = bitem & 3, dir = (bitem >> 2) & 1, h = (bitem >> 3) & 3, lb = bitem >> 5, e0 = es * 32;
  u16* Ssb = (u16*)smem;
  const char* recB = p.ws + O_CREC + ((size_t)h * 2 + dir) * CREC_SZ;
  const char* ztB = p.ws + O_ZT + (size_t)(h * 128 + e0) * GR * 2;
  char* ocB = p.ws + O_OC + ((size_t)dir * GR * 512 + h * 128 + e0) * 2;
  const int mrow = 16 * w + fr, crow0 = 16 * w + 4 * fq;
  const unsigned offQ = (unsigned)(mrow * 256 + 16 * fq);
  const unsigned offK = (unsigned)(16384 + (32 * w + fr) * 128 + 16 * fq);
  const unsigned offD = (unsigned)(32768 + (32 * w + 4 * fq) * 4);
  const unsigned offV = (unsigned)(fr * GR * 2 + 16 * fq);
  unsigned offR[4];
#pragma unroll
  for (int r = 0; r < 4; ++r) offR[r] = (unsigned)((dir ? 63 - (crow0 + r) : (crow0 + r)) * 1024 + fr * 2);
  f32x4 S[2][2];
#pragma unroll
  for (int a = 0; a < 2; ++a)
#pragma unroll
    for (int b = 0; b < 2; ++b) S[a][b] = (f32x4){0.f, 0.f, 0.f, 0.f};
  bf16x8 Aqd[4], Akd[2][2], Vf[2][2];
  u16 oi[2][4];
  float4 dec4[2];
#define CS_LOAD(cg_)                                                                    \
  {                                                                                     \
    const char* rc_ = recB + (size_t)(cg_) * (8 * CREC_SZ);                             \
    _Pragma("unroll") for (int s = 0; s < 4; ++s) Aqd[s] = ldo8(rc_, offQ + 64 * s);    \
    Akd[0][0] = ldo8(rc_, offK); Akd[0][1] = ldo8(rc_, offK + 64);                      \
    Akd[1][0] = ldo8(rc_, offK + 2048); Akd[1][1] = ldo8(rc_, offK + 2048 + 64);        \
    dec4[0] = *(const float4*)(rc_ + offD);                                             \
    dec4[1] = *(const float4*)(rc_ + (offD + 64));                                      \
    const char* zt_ = ztB + (size_t)(cg_) * 128;                                        \
    Vf[0][0] = ldo8(zt_, offV); Vf[0][1] = ldo8(zt_, offV + 64);                        \
    Vf[1][0] = ldo8(zt_, offV + 16 * GR * 2); Vf[1][1] = ldo8(zt_, offV + 16 * GR * 2 + 64); \
    const char* oc_ = ocB + (size_t)(cg_) * 65536;                                      \
    _Pragma("unroll") for (int r = 0; r < 4; ++r) {                                     \
      oi[0][r] = *(const u16*)(oc_ + offR[r]);                                          \
      oi[1][r] = *(const u16*)(oc_ + (offR[r] + 32));                                   \
    }                                                                                   \
  }
  {
    const int c0 = lb * 36 + BS_CHUNK(0);
    CS_LOAD(c0)
  }
  for (int j = 0; j < 36; ++j) {
    const int cgk = lb * 36 + BS_CHUNK(j);
    const int jn = (j + 1 < 36) ? j + 1 : j;
    const int cgn = lb * 36 + BS_CHUNK(jn);
    u16* Ss = Ssb + (j & 1) * (32 * 136);
#pragma unroll
    for (int mm = 0; mm < 2; ++mm)
#pragma unroll
      for (int nt = 0; nt < 2; ++nt) {
        uint2 pk; pk.x = pk2(S[mm][nt][0], S[mm][nt][1]); pk.y = pk2(S[mm][nt][2], S[mm][nt][3]);
        *(uint2*)(Ss + (16 * nt + fr) * 136 + 32 * w + 16 * mm + 4 * fq) = pk;
      }
    LBAR();
    char* oc_ = ocB + (size_t)cgk * 65536;
#pragma unroll
    for (int nt = 0; nt < 2; ++nt) {
      f32x4 O = {0.f, 0.f, 0.f, 0.f};
#pragma unroll
      for (int s = 0; s < 4; ++s) O = mfma(Aqd[s], ld8(Ss + (16 * nt + fr) * 136 + 32 * s + 8 * fq), O);
#pragma unroll
      for (int r = 0; r < 4; ++r) *(u16*)(oc_ + (offR[r] + 32 * nt)) = f2bf(bf2f(oi[nt][r]) + O[r]);
#pragma unroll
      for (int mm = 0; mm < 2; ++mm) {
        f32x4 t = S[mm][nt];
        t[0] *= dec4[mm].x; t[1] *= dec4[mm].y; t[2] *= dec4[mm].z; t[3] *= dec4[mm].w;
        t = mfma(Akd[mm][0], Vf[nt][0], t);
        t = mfma(Akd[mm][1], Vf[nt][1], t);
        S[mm][nt] = t;
      }
    }
    CBAR();
    CS_LOAD(cgn)
  }
  LBAR();
}

DEV void bc_merge(const P& p, int l, int it) {
  const int tid_ = opq(threadIdx.x); const int lane = tid_ & 63, w = tid_ >> 6;
  int lr = it * 4 + w;
  int mix = lane >> 5, cm = (lane * 16) & 511;
  const u16* O = (const u16*)(p.ws + (mix ? O_OC : O_OB));
  u16* z = (u16*)(p.ws + O_Z);
  float ov[16], ss = 0.f;
#pragma unroll
  for (int k2 = 0; k2 < 2; ++k2) {
    uint4 a = *(const uint4*)(O + (size_t)lr * 512 + cm + 8 * k2);
    uint4 b = *(const uint4*)(O + ((size_t)GR + lr) * 512 + cm + 8 * k2);
    unsigned aa[4] = {a.x, a.y, a.z, a.w}, bb[4] = {b.x, b.y, b.z, b.w};
#pragma unroll
    for (int q = 0; q < 4; ++q) {
      float v0 = bf2f((u16)(aa[q] & 0xffff)) + bf2f((u16)(bb[q] & 0xffff));
      float v1 = bf2f((u16)(aa[q] >> 16)) + bf2f((u16)(bb[q] >> 16));
      ov[k2 * 8 + q * 2] = v0; ov[k2 * 8 + q * 2 + 1] = v1;
      ss += v0 * v0 + v1 * v1;
    }
  }
  ss += __shfl_xor(ss, 1); ss += __shfl_xor(ss, 2); ss += __shfl_xor(ss, 4);
  float rinv = rsqrtf(ss * (1.f / 128.f) + EPS);
  const float* nw = (mix ? p.hg_norm : p.gdn_norm) + l * 128 + (cm & 127);
  u16* gp = z + (size_t)lr * NZ + (mix ? C_GC : C_GB) + cm;
#pragma unroll
  for (int k2 = 0; k2 < 2; ++k2) {
    uint4 gv = *(const uint4*)(gp + 8 * k2);
    unsigned gg[4] = {gv.x, gv.y, gv.z, gv.w}, oo[4];
#pragma unroll
    for (int q = 0; q < 4; ++q) {
      int e = k2 * 8 + q * 2;
      float y0 = ov[e] * rinv * nw[e] * silu(bf2f((u16)(gg[q] & 0xffff)));
      float y1 = ov[e + 1] * rinv * nw[e + 1] * silu(bf2f((u16)(gg[q] >> 16)));
      oo[q] = pk2(y0, y1);
    }
    *(uint4*)(gp + 8 * k2) = make_uint4(oo[0], oo[1], oo[2], oo[3]);
  }
}

#define XB_TMO      128
#define XB_XCNT(j)  (256  + 64 * (j))
#define XB_XSUB(j)  (1280 + 64 * (j))
#define XB_XGEN(j)  (2304 + 64 * (j))
#define XB_TOP      3328
#define XB_TOPGEN   3392
#define XCD_BAR_WORDS 3456
#define XB_SPIN_CAP (1u << 18)
#define LAS __attribute__((address_space(3)))

__device__ __forceinline__ unsigned xb_ld(unsigned* p)              { return __hip_atomic_load(p, __ATOMIC_RELAXED, __HIP_MEMORY_SCOPE_AGENT); }
__device__ __forceinline__ unsigned xb_add(unsigned* p, unsigned v) { return __hip_atomic_fetch_add(p, v, __ATOMIC_RELAXED, __HIP_MEMORY_SCOPE_AGENT); }
__device__ __forceinline__ unsigned xb_xcc_id() { return (unsigned)__builtin_amdgcn_s_getreg((3 << 11) | 20) & 0xFu; }
#define XB_SPIN(cond, bar) do { unsigned _sp = 0; while (cond) { __builtin_amdgcn_s_sleep(1); \
    if ((++_sp & 255u) == 0u) { if (xb_ld(&(bar)[XB_TMO])) break; if (_sp > XB_SPIN_CAP) { atomicAdd(&(bar)[XB_TMO], 1u); break; } } } } while (0)

struct XcdBarrier {
    unsigned* bar; unsigned x;
    volatile LAS unsigned* st;
};

__device__ __forceinline__ XcdBarrier xcd_barrier_post(unsigned* bar, volatile LAS unsigned* st) {
    XcdBarrier b; b.bar = bar; b.x = xb_xcc_id(); b.st = st;
    if (threadIdx.x == 0) (void)xb_add(&bar[XB_XCNT(b.x)], 1u);
    return b;
}
__device__ __forceinline__ void xcd_barrier_complete(unsigned* bar, unsigned x, unsigned& nloc, unsigned& nx) {
    const unsigned G = gridDim.x * gridDim.y * gridDim.z;
    unsigned sum, cnt, mine, sp = 0u;
    for (;;) {
        sum = 0u; cnt = 0u; mine = 0u;
#pragma unroll
        for (unsigned j = 0; j < 16; ++j) { const unsigned c = xb_ld(&bar[XB_XCNT(j)]); sum += c; cnt += (c > 0u) ? 1u : 0u; mine = (j == x) ? c : mine; }
        if (sum == G) break;
        __builtin_amdgcn_s_sleep(1);
        if ((++sp & 255u) == 0u) { if (xb_ld(&bar[XB_TMO])) break; if (sp > XB_SPIN_CAP) { atomicAdd(&bar[XB_TMO], 1u); break; } }
    }
    nloc = mine > 0u ? mine : 1u; nx = cnt > 0u ? cnt : 1u;
}

__device__ __forceinline__ void xcd_barrier(const XcdBarrier& b) {
    asm volatile("s_waitcnt vmcnt(0)" ::: "memory");
    __syncthreads();
    if (threadIdx.x == 0) {
        unsigned* bar = b.bar;
        __builtin_amdgcn_s_waitcnt(0);
        unsigned nloc = b.st[0], nx = b.st[1];
        if (nloc == 0u) { xcd_barrier_complete(bar, b.x, nloc, nx); b.st[0] = nloc; b.st[1] = nx; }
        const unsigned old = xb_add(&bar[XB_XSUB(b.x)], 1u);
        const unsigned gen = old / nloc;
        if (old + 1u == (gen + 1u) * nloc) {
            __builtin_amdgcn_fence(__ATOMIC_RELEASE, "agent");
            asm volatile("s_waitcnt vmcnt(0)" ::: "memory");
            const unsigned og = xb_add(&bar[XB_TOP], 1u);
            const unsigned tg = og / nx;
            if (og + 1u == (tg + 1u) * nx) xb_add(&bar[XB_TOPGEN], 1u);
            else XB_SPIN(xb_ld(&bar[XB_TOPGEN]) == tg, bar);
            __builtin_amdgcn_fence(__ATOMIC_ACQUIRE, "agent");
            xb_add(&bar[XB_XGEN(b.x)], 1u);
            asm volatile("s_waitcnt vmcnt(0)" ::: "memory");
        } else {
            XB_SPIN(xb_ld(&bar[XB_XGEN(b.x)]) == gen, bar);
            __builtin_amdgcn_fence(__ATOMIC_ACQUIRE, "agent");
            asm volatile("s_waitcnt vmcnt(0)" ::: "memory");
        }
    }
    __syncthreads();
}


#ifdef NO_G0
#define XG0(x)
#else
#define XG0(x) x
#endif
#ifdef NO_G1
#define XG1(x)
#else
#define XG1(x) x
#endif
#ifdef NO_BC
#define XBC(x)
#else
#define XBC(x) x
#endif
#ifdef NO_AC
#define XAC(x)
#else
#define XAC(x) x
#endif
#ifdef NO_P0
#define XP0(x)
#else
#define XP0(x) x
#endif
#ifdef NO_R
#define XR(x)
#else
#define XR(x) x
#endif
#ifdef NO_BL
#define XBL(x)
#else
#define XBL(x) x
#endif
#ifdef NO_CL
#define XCL(x)
#else
#define XCL(x) x
#endif
#ifdef NO_A0
#define XA0(x)
#else
#define XA0(x) x
#endif
#ifdef NO_A1
#define XA1(x)
#else
#define XA1(x) x
#endif
#ifdef NO_BS
#define XBS(x)
#else
#define XBS(x) x
#endif
#ifdef NO_CS
#define XCS(x)
#else
#define XCS(x) x
#endif
__global__ void __launch_bounds__(256, 2) fwd_mega(P p) {
  extern __shared__ __attribute__((aligned(16))) char smem[];
  cg::grid_group grid = cg::this_grid();
  const int G = gridDim.x;
  __shared__ uint4 xb_words;
  if (threadIdx.x == 0) xb_words = make_uint4(0u, 0u, 0u, 0u);
  __syncthreads();
  XcdBarrier xb = xcd_barrier_post((unsigned*)(p.ws + O_BAR), (volatile LAS unsigned*)&xb_words);
  XP0(phase0(p, smem));
  grid.sync();
  u16* z = (u16*)(p.ws + O_Z);
  u16* zT = (u16*)(p.ws + O_ZT);
  float* ab = (float*)(p.ws + O_AB);
  float* o = (float*)(p.ws + O_BSH);
  const u16* u = (const u16*)(p.ws + O_BIT);
  for (int g = 0; g < NG; ++g) {
    XR(phaseR(p, g, 0));
    xcd_barrier(xb);
    for (int l = 0; l < DEPTH; ++l) {
      for (int rep = 0; rep < REP_G; ++rep) {
        const u16* Bt = (const u16*)(p.ws + O_WTIN) + (size_t)l * NZ * 1024;
        if ((G & 7) == 0) {
          const int x = blockIdx.x & 7, bl = blockIdx.x >> 3, nbl = G >> 3;
          for (int q = bl; q < 9 * 45; q += nbl) { XG0(gemm_tile<0>(u, 1024, Bt, 1024, 9 * x + q % 9, q / 9, z, zT, ab, o, smem)); }
        } else {
          for (int t = blockIdx.x; t < 72 * 45; t += G) { XG0(gemm_tile<0>(u, 1024, Bt, 1024, t % 72, t / 72, z, zT, ab, o, smem)); }
        }
      }
      xcd_barrier(xb);
      for (int rep2 = 0; rep2 < REP_M; ++rep2) {
      for (int rep3 = 0; rep3 < REP_A; ++rep3) {
        if (rep3) xcd_barrier(xb);
        const int nb = NCH * 4, nc = NCH * 4, na = NCH * 8;
        for (int t = blockIdx.x; t < nb + nc + na; t += G) {
          if (t < nc) { XCL(c_local2(p, l, t, smem)); }
          else if (t < nb + nc) { XBL(b_local(p, l, t - nc, smem)); }
          else { XA0(a_item(p, l, t - nb - nc, 0, smem)); }
        }
      }
      xcd_barrier(xb);
      {
        for (int t = blockIdx.x; t < 256 + 16; t += G) {
          if (t < 128) { XBS(b_seq2(p, t, smem)); }
          else if (t < 256) { XCS(c_seq2(p, t - 128, smem)); }
          else { XAC(a_carry(p, t - 256)); }
        }
      }
      xcd_barrier(xb);
      }
      {
        const int na = NCH * 8, nm = GR / 4;
        for (int t = blockIdx.x; t < na + nm; t += G) {
          if (t < na) { XA1(a_item(p, l, t, 1, smem)); }
          else { XBC(bc_merge(p, l, t - na)); }
        }
      }
      xcd_barrier(xb);
      for (int rep = 0; rep < REP_G; ++rep) {
        const u16* Bt = (const u16*)(p.ws + O_WTOUT) + (size_t)l * 1024 * 1536;
        for (int t = blockIdx.x; t < 72 * 8; t += G) { XG1(gemm_tile<1>(z + C_GA, NZ, Bt, 1536, t % 72, t / 72, z, zT, ab, o, smem)); }
      }
      xcd_barrier(xb);
      XR(phaseR(p, g, l + 1));
      xcd_barrier(xb);
    }
  }
}

extern "C" void kernel_launch(void* const* d_in, const int* in_sizes, int n_in, void* d_out, int out_size, void* d_ws,
                              size_t ws_size, hipStream_t stream) {
  static int grid_blocks = 0;
  if (!grid_blocks) {
    int dev = 0, cus = 0, per_cu = 0;
    hipGetDevice(&dev);
    hipDeviceGetAttribute(&cus, hipDeviceAttributeMultiprocessorCount, dev);
    hipFuncSetAttribute((const void*)fwd_mega, hipFuncAttributeMaxDynamicSharedMemorySize, LDS_BYTES);
    hipOccupancyMaxActiveBlocksPerMultiprocessor(&per_cu, fwd_mega, 256, LDS_BYTES);
    if (per_cu > 2) per_cu = 2;
    if (per_cu < 1) per_cu = 1;
    grid_blocks = cus * per_cu;
  }
  if (ws_size < WS_TOTAL) {
    fprintf(stderr, "workspace too small: %zu < %zu\n", ws_size, (size_t)WS_TOTAL);
    return;
  }
  P p{};
  const float** f = (const float**)&p;
  for (int i = 0; i < 23; ++i) f[i] = (const float*)d_in[i];
  p.out = (float*)d_out;
  p.ws = (char*)d_ws;
  hipMemsetAsync((char*)d_ws + O_BAR, 0, XCD_BAR_WORDS * 4, stream);
  void* args[] = {&p};
  hipError_t e = hipLaunchCooperativeKernel((void*)fwd_mega, dim3(grid_blocks), dim3(256), args, LDS_BYTES, stream);
  if (e != hipSuccess) fprintf(stderr, "cooperative launch failed: %s (grid %d)\n", hipGetErrorString(e), grid_blocks);
}
```

```cpp
#include <hip/hip_runtime.h>
#include <hip/hip_cooperative_groups.h>
#include <cstdio>
namespace cg = cooperative_groups;

typedef __attribute__((ext_vector_type(8))) short bf16x8;
typedef __attribute__((ext_vector_type(4))) float f32x4;
typedef unsigned short u16;
#define DEV __device__ __forceinline__

constexpr int DM = 1024, TL = 2048, TCX = 256, TS = 2304, GB = 4, GR = GB * TS, NG = 2;
constexpr int NZ = 5760, DEPTH = 4;
constexpr int C_XA = 0, C_Q = 512, C_K = 1024, C_V = 1536, C_QC = 2048, C_F0 = 2560, C_IC = 3584,
              C_GA = 4096, C_GB = 4608, C_GC = 5120, C_AB = 5632;
constexpr int NCH = GR / 64;
constexpr float EPS = 1e-6f;
constexpr int WPB = 2;

constexpr size_t al256(size_t x) { return (x + 255) & ~(size_t)255; }
constexpr size_t O_WTIN = 0;
constexpr size_t O_WTOUT = O_WTIN + al256((size_t)DEPTH * NZ * 1024 * 2);
constexpr size_t O_WGT = O_WTOUT + al256((size_t)DEPTH * 1024 * 1536 * 2);
constexpr size_t O_MOD = O_WGT + al256((size_t)DEPTH * 2 * 2 * 8 * 4096 * 2);
constexpr size_t O_LBS = O_MOD + al256((size_t)DEPTH * 9 * 3072 * 4);
constexpr size_t O_HC = O_LBS + al256((size_t)DEPTH * 1024 * 4);
constexpr size_t O_Z = O_HC + al256((size_t)GB * TCX * 1024 * 4);
constexpr size_t O_ZT = O_Z + al256((size_t)GR * NZ * 2);
constexpr size_t O_AB = O_ZT + al256((size_t)512 * GR * 2);
constexpr size_t O_BSH = O_AB + al256((size_t)GR * 16 * 4);
constexpr size_t BSH_ONE = (size_t)GR * 512 * 2;
constexpr size_t O_BIT = O_BSH + al256(4 * BSH_ONE);
constexpr size_t BIT_SZ = 17408;
constexpr size_t O_CREC = O_BIT + al256((size_t)NCH * 4 * 2 * BIT_SZ);
constexpr size_t CREC_SZ = 33280;
constexpr size_t O_OB = O_CREC + al256((size_t)NCH * 4 * 2 * CREC_SZ);
constexpr size_t O_OC = O_OB + al256((size_t)2 * GR * 512 * 2);
constexpr size_t O_AP = O_OC + al256((size_t)2 * GR * 512 * 2);
constexpr size_t O_AH = O_AP + al256((size_t)NCH * 2 * 512 * 4);
constexpr size_t O_ACAR = O_AH + al256((size_t)NCH * 2 * 512 * 4);
constexpr size_t O_BAR = O_ACAR + al256((size_t)NCH * 2 * 512 * 4);
constexpr size_t WS_TOTAL = O_BAR + al256(3456 * 4);

constexpr int LDS_BYTES = 73728;
#ifndef REP_A
#define REP_A 1
#endif
#ifndef REP_G
#define REP_G 1
#endif
#ifndef REP_M
#define REP_M 1
#endif

struct P {
  const float *x, *c, *ctx, *c_ctx, *w_ada, *b_ada, *norm_pre, *norm_post, *w_in, *conv_a_w, *conv_a_b, *rg_w_r,
      *rg_b_r, *rg_w_i, *rg_b_i, *rg_lam, *conv_b_w, *gdn_a_log, *gdn_dt_bias, *gdn_norm, *hg_lb, *hg_norm, *w_out;
  float* out;
  char* ws;
};

DEV int opq(int x) { asm volatile("" : "+v"(x)); return x; }
DEV int opqs(int x) { asm volatile("" : "+s"(x)); return x; }
typedef __attribute__((ext_vector_type(2))) __bf16 bf16x2_t;
typedef __attribute__((ext_vector_type(2))) float f32x2_t;
DEV u16 f2bf(float f) { __bf16 r = (__bf16)f; return __builtin_bit_cast(u16, r); }
DEV float bf2f(u16 h) { return __uint_as_float(((unsigned)h) << 16); }
DEV unsigned pk2(float a, float b) { f32x2_t v = {a, b}; bf16x2_t r = __builtin_convertvector(v, bf16x2_t); return __builtin_bit_cast(unsigned, r); }
DEV float sigm(float x) { return __builtin_amdgcn_rcpf(1.f + __expf(-x)); }
DEV float silu(float x) { return x * __builtin_amdgcn_rcpf(1.f + __expf(-x)); }
DEV float softplus(float x) { return x > 20.f ? x : log1pf(__expf(x)); }
DEV f32x4 mfma(bf16x8 a, bf16x8 b, f32x4 c) { return __builtin_amdgcn_mfma_f32_16x16x32_bf16(a, b, c, 0, 0, 0); }
DEV bf16x8 ld8(const u16* p) { return *reinterpret_cast<const bf16x8*>(p); }
DEV int lat_map(int l, int t) { return (l & 1) ? ((t & 63) * 32 + (t >> 6)) : t; }
DEV int orig_col(int n) {
  if (n < 512) return n;
  if (n < 2048) return n + 512;
  if (n < 4096) return n + 1040;
  if (n < 4608) return n - 4096 + 512;
  if (n < 5120) return n - 4608 + 2576;
  if (n < 5632) return n + 16;
  if (n < 5648) return n - 5632 + 2560;
  return -1;
}
DEV float zval(const u16* z, int rb, int cp, int n, int col) {
  if (cp < 0 && (n == 0 || n == 4)) return 0.f;
  if (cp > 63 && (n == 3 || n == 35)) return 0.f;
  return bf2f(z[(size_t)(rb + cp) * NZ + col]);
}

DEV void ph0_ada(const P& p, int item, char* smem) {
  float* sc = (float*)smem;
  float* red = (float*)(smem + 36864);
  const int tid = threadIdx.x, lane = tid & 63, wv = tid >> 6;
  for (int i = tid; i < 9 * 1024; i += 256) {
    int v = i >> 10, d = i & 1023;
    float cv = (v < 8) ? p.c[v * 1024 + d] : p.c_ctx[d];
    sc[i] = silu(cv);
  }
  __syncthreads();
  const int col = item * 64 + lane;
  const int l = col / 3072, e = col % 3072;
  const float* w = p.w_ada + (size_t)l * 1024 * 3072 + e + (size_t)(256 * wv) * 3072;
  const float* scw = sc + 256 * wv;
  float acc[9];
#pragma unroll
  for (int i = 0; i < 9; ++i) acc[i] = 0.f;
  for (int d = 0; d < 256; d += 16) {
    float wr[16];
#pragma unroll
    for (int k = 0; k < 16; ++k) wr[k] = w[(size_t)(d + k) * 3072];
#pragma unroll
    for (int k = 0; k < 16; ++k)
#pragma unroll
      for (int i = 0; i < 9; ++i) acc[i] += scw[i * 1024 + d + k] * wr[k];
  }
#pragma unroll
  for (int i = 0; i < 9; ++i) red[(wv * 9 + i) * 64 + lane] = acc[i];
  __syncthreads();
  float* mod = (float*)(p.ws + O_MOD);
  for (int idx = tid; idx < 9 * 64; idx += 256) {
    int i = idx >> 6, ln = idx & 63;
    float sum = red[(0 * 9 + i) * 64 + ln] + red[(1 * 9 + i) * 64 + ln] + red[(2 * 9 + i) * 64 + ln] + red[(3 * 9 + i) * 64 + ln];
    int cc = item * 64 + ln, l2 = cc / 3072, e2 = cc % 3072;
    mod[((size_t)l2 * 9 + i) * 3072 + e2] = sum + p.b_ada[l2 * 3072 + e2];
  }
  __syncthreads();
}
DEV void tconv_tile(const float* src, int lds_, u16* dst, int ldd, int k0, int n0, bool mapcol, char* smem) {
  float* t = (float*)smem;
  const int tid = threadIdx.x, nn = tid & 63, kq = tid >> 6;
  const int n = n0 + nn;
  const int sn0 = mapcol ? orig_col(n) : n;
  const float msk = (sn0 >= 0) ? 1.f : 0.f;
  const int sn = sn0 >= 0 ? sn0 : 0;
  float v[16];
#pragma unroll
  for (int k = 0; k < 16; ++k) v[k] = src[(size_t)(k0 + kq + 4 * k) * lds_ + sn];
#pragma unroll
  for (int k = 0; k < 16; ++k) t[(kq + 4 * k) * 65 + nn] = v[k] * msk;
  __syncthreads();
  {
    const int kk = tid & 63, nq = tid >> 6;
#pragma unroll
    for (int k = 0; k < 16; ++k) {
      int n2 = nq + 4 * k;
      dst[(size_t)(n0 + n2) * ldd + k0 + kk] = f2bf(t[kk * 65 + n2]);
    }
  }
  __syncthreads();
}
DEV void phase0(const P& p, char* smem) {
  const int n_ada = 192, n_in = DEPTH * 16 * 90, n_out = DEPTH * 24 * 16, n_g = 128, n_lb = 4;
  const int total = n_ada + n_in + n_out + n_g + n_lb;
  for (int it = blockIdx.x; it < total; it += gridDim.x) {
    int i = it;
    if (i < n_ada) { ph0_ada(p, i, smem); continue; }
    i -= n_ada;
    if (i < n_in) {
      int l = i / 1440, r = i % 1440, kt = r / 90, nt = r % 90;
      tconv_tile(p.w_in + (size_t)l * 1024 * 5648, 5648, (u16*)(p.ws + O_WTIN) + (size_t)l * NZ * 1024, 1024, kt * 64,
                 nt * 64, true, smem);
      continue;
    }
    i -= n_in;
    if (i < n_out) {
      int l = i / 384, r = i % 384, kt = r / 16, nt = r % 16;
      tconv_tile(p.w_out + (size_t)l * 1536 * 1024, 1024, (u16*)(p.ws + O_WTOUT) + (size_t)l * 1024 * 1536, 1536,
                 kt * 64, nt * 64, false, smem);
      continue;
    }
    i -= n_out;
    if (i < n_g) {
      int h = i & 7, gate = (i >> 3) & 1, dir = (i >> 4) & 1, l = i >> 5;
      const float* src = (gate ? p.rg_w_i : p.rg_w_r) + ((size_t)(l * 2 + dir) * 8 + h) * 4096;
      tconv_tile(src, 64, (u16*)(p.ws + O_WGT) + (size_t)i * 4096, 64, 0, 0, false, smem);
      continue;
    }
    i -= n_g;
    {
      int j = i * 256 + threadIdx.x;
      float v[4], mx = -1e30f;
      for (int l = 0; l < 4; ++l) { v[l] = p.hg_lb[l * 1024 + j]; mx = fmaxf(mx, v[l]); }
      float s = 0.f;
      for (int l = 0; l < 4; ++l) { v[l] = __expf(v[l] - mx); s += v[l]; }
      float* lbs = (float*)(p.ws + O_LBS);
      float cum = 0.f;
      for (int l = 0; l < 4; ++l) {
        if (l > 0) cum += v[l] / s;
        lbs[l * 1024 + j] = cum;
      }
    }
  }
}

DEV void phaseR(const P& p, int g, int l) {
  const int tid_ = opq(threadIdx.x); const int lane = tid_ & 63, w = tid_ >> 6;
  const float* mod = (const float*)(p.ws + O_MOD);
  float* hc = (float*)(p.ws + O_HC);
  const float* o = (const float*)(p.ws + O_BSH);
  u16* u = (u16*)(p.ws + O_BIT);
  for (int it = blockIdx.x; it < GR / 4; it += gridDim.x) {
    int lr = it * 4 + w;
    int lb = lr / TS, s = lr % TS;
    bool isctx = s < TCX;
    if (l == DEPTH && isctx) continue;
    int b = g * GB + lb, t = s - TCX;
    int mi = isctx ? 8 : b;
    float* hp = isctx ? hc + ((size_t)lb * TCX + s) * 1024 : p.out + ((size_t)b * TL + t) * 1024;
    float hv[16];
    if (l == 0) {
      const float* src = isctx ? p.ctx + ((size_t)b * TCX + s) * 1024 : p.x + ((size_t)b * TL + t) * 1024;
#pragma unroll
      for (int k = 0; k < 4; ++k) {
        float4 v = *(const float4*)(src + k * 256 + lane * 4);
        hv[k * 4] = v.x; hv[k * 4 + 1] = v.y; hv[k * 4 + 2] = v.z; hv[k * 4 + 3] = v.w;
      }
    } else {
      int orow = lb * TS + (isctx ? s : TCX + lat_map(l - 1, t));
      const float* op = o + (size_t)orow * 1024;
      float ov[16], ss = 0.f;
#pragma unroll
      for (int k = 0; k < 4; ++k) {
        float4 v = *(const float4*)(op + k * 256 + lane * 4);
        ov[k * 4] = v.x; ov[k * 4 + 1] = v.y; ov[k * 4 + 2] = v.z; ov[k * 4 + 3] = v.w;
        ss += v.x * v.x + v.y * v.y + v.z * v.z + v.w * v.w;
      }
#pragma unroll
      for (int off = 32; off; off >>= 1) ss += __shfl_xor(ss, off);
      float rinv = rsqrtf(ss * (1.f / 1024.f) + EPS);
      const float* gate = mod + ((size_t)(l - 1) * 9 + mi) * 3072 + 2048;
      const float* wp = p.norm_post + (l - 1) * 1024;
#pragma unroll
      for (int k = 0; k < 4; ++k) {
        float4 hh = *(const float4*)(hp + k * 256 + lane * 4);
        float4 gg = *(const float4*)(gate + k * 256 + lane * 4);
        float4 ww = *(const float4*)(wp + k * 256 + lane * 4);
        hv[k * 4] = hh.x + gg.x * (ov[k * 4] * rinv * ww.x);
        hv[k * 4 + 1] = hh.y + gg.y * (ov[k * 4 + 1] * rinv * ww.y);
        hv[k * 4 + 2] = hh.z + gg.z * (ov[k * 4 + 2] * rinv * ww.z);
        hv[k * 4 + 3] = hh.w + gg.w * (ov[k * 4 + 3] * rinv * ww.w);
      }
    }
#pragma unroll
    for (int k = 0; k < 4; ++k)
      *(float4*)(hp + k * 256 + lane * 4) = make_float4(hv[k * 4], hv[k * 4 + 1], hv[k * 4 + 2], hv[k * 4 + 3]);
    if (l < DEPTH) {
      float ss = 0.f;
#pragma unroll
      for (int k = 0; k < 16; ++k) ss += hv[k] * hv[k];
#pragma unroll
      for (int off = 32; off; off >>= 1) ss += __shfl_xor(ss, off);
      float rinv = rsqrtf(ss * (1.f / 1024.f) + EPS);
      const float* sh = mod + ((size_t)l * 9 + mi) * 3072;
      const float* wp = p.norm_pre + l * 1024;
      int urow = lb * TS + (isctx ? s : TCX + lat_map(l, t));
      u16* up = u + (size_t)urow * 1024;
#pragma unroll
      for (int k = 0; k < 4; ++k) {
        float4 ww = *(const float4*)(wp + k * 256 + lane * 4);
        float4 s0 = *(const float4*)(sh + k * 256 + lane * 4);
        float4 s1 = *(const float4*)(sh + 1024 + k * 256 + lane * 4);
        float a0 = hv[k * 4] * rinv * ww.x * (1.f + s1.x) + s0.x;
        float a1 = hv[k * 4 + 1] * rinv * ww.y * (1.f + s1.y) + s0.y;
        float a2 = hv[k * 4 + 2] * rinv * ww.z * (1.f + s1.z) + s0.z;
        float a3 = hv[k * 4 + 3] * rinv * ww.w * (1.f + s1.w) + s0.w;
        uint2 pk; pk.x = pk2(a0, a1); pk.y = pk2(a2, a3);
        *(uint2*)(up + k * 256 + lane * 4) = pk;
      }
    }
  }
}

template <int MODE>
DEV void gemm_tile(const u16* __restrict__ A, int lda, const u16* __restrict__ Bt, int K, int rt, int ct, u16* z,
                   u16* zT, float* ab, float* o, char* smem) {
  u16* As = (u16*)smem;
  u16* Bs = As + 128 * 72;
  const int tid = opq(threadIdx.x), lane = tid & 63, w = tid >> 6, wr = w >> 1, wc = w & 1, fr = lane & 15, fq = lane >> 4;
  const int lrow = tid >> 3, lseg = tid & 7;
  const u16* Ag = A + (size_t)(rt * 128 + lrow) * lda + lseg * 8;
  const u16* Bg = Bt + (size_t)(ct * 128 + lrow) * K + lseg * 8;
  uint4 ra0, ra1, ra2, ra3, rb0, rb1, rb2, rb3;
  f32x4 acc[4][4];
#pragma unroll
  for (int i = 0; i < 4; ++i)
#pragma unroll
    for (int j = 0; j < 4; ++j) acc[i][j] = (f32x4){0.f, 0.f, 0.f, 0.f};
#define GLOAD()                                             \
  ra0 = *(const uint4*)(Ag);                                \
  ra1 = *(const uint4*)(Ag + (size_t)32 * lda);             \
  ra2 = *(const uint4*)(Ag + (size_t)64 * lda);             \
  ra3 = *(const uint4*)(Ag + (size_t)96 * lda);             \
  rb0 = *(const uint4*)(Bg);                                \
  rb1 = *(const uint4*)(Bg + (size_t)32 * K);               \
  rb2 = *(const uint4*)(Bg + (size_t)64 * K);               \
  rb3 = *(const uint4*)(Bg + (size_t)96 * K);
  GLOAD();
  const int nk = K / 64;
#define GSTORE(bufo)                                                      \
  *(uint4*)(As + (bufo) + (lrow)*72 + lseg * 8) = ra0;                    \
  *(uint4*)(As + (bufo) + (lrow + 32) * 72 + lseg * 8) = ra1;             \
  *(uint4*)(As + (bufo) + (lrow + 64) * 72 + lseg * 8) = ra2;             \
  *(uint4*)(As + (bufo) + (lrow + 96) * 72 + lseg * 8) = ra3;             \
  *(uint4*)(Bs + (bufo) + (lrow)*72 + lseg * 8) = rb0;                    \
  *(uint4*)(Bs + (bufo) + (lrow + 32) * 72 + lseg * 8) = rb1;             \
  *(uint4*)(Bs + (bufo) + (lrow + 64) * 72 + lseg * 8) = rb2;             \
  *(uint4*)(Bs + (bufo) + (lrow + 96) * 72 + lseg * 8) = rb3;
  GSTORE(0)
  __syncthreads();
  for (int kt = 0; kt < nk; ++kt) {
    const int cb = (kt & 1) * (2 * 128 * 72);
    if (kt + 1 < nk) {
      Ag += 64; Bg += 64;
      GLOAD();
    }
#pragma unroll
    for (int ks = 0; ks < 2; ++ks) {
      bf16x8 af[4], bfr[4];
#pragma unroll
      for (int mi = 0; mi < 4; ++mi) af[mi] = ld8(As + cb + (wr * 64 + mi * 16 + fr) * 72 + ks * 32 + fq * 8);
#pragma unroll
      for (int ni = 0; ni < 4; ++ni) bfr[ni] = ld8(Bs + cb + (wc * 64 + ni * 16 + fr) * 72 + ks * 32 + fq * 8);
#pragma unroll
      for (int mi = 0; mi < 4; ++mi)
#pragma unroll
        for (int ni = 0; ni < 4; ++ni) acc[mi][ni] = mfma(af[mi], bfr[ni], acc[mi][ni]);
    }
    if (kt + 1 < nk) {
      const int nb_ = ((kt + 1) & 1) * (2 * 128 * 72);
      GSTORE(nb_)
    }
    __syncthreads();
  }
#pragma unroll
  for (int mi = 0; mi < 4; ++mi)
#pragma unroll
    for (int ni = 0; ni < 4; ++ni) {
      int row0 = rt * 128 + wr * 64 + mi * 16 + fq * 4;
      int col = ct * 128 + wc * 64 + ni * 16 + fr;
      f32x4 v = acc[mi][ni];
      if (MODE == 1) {
#pragma unroll
        for (int r = 0; r < 4; ++r) o[(size_t)(row0 + r) * 1024 + col] = v[r];
      } else {
        if (ct >= 28 && ct < 32) {
          uint2 pk; pk.x = pk2(v[0], v[1]); pk.y = pk2(v[2], v[3]);
          *(uint2*)(zT + (size_t)(col - C_IC) * GR + row0) = pk;
        } else if (ct == 44) {
          if (col - C_AB < 16) {
#pragma unroll
            for (int r = 0; r < 4; ++r) ab[(size_t)(row0 + r) * 16 + (col - C_AB)] = v[r];
          }
        } else {
#pragma unroll
          for (int r = 0; r < 4; ++r) z[(size_t)(row0 + r) * NZ + col] = f2bf(v[r]);
        }
      }
    }
}

DEV void a_item(const P& p, int l, int item, int mode, char* smem) {
  float* xc = (float*)smem;
  u16* xcb = (u16*)(smem + 16384);
  float* av = (float*)(smem + 16384 + 9216);
  float* uv = av + 4096;
  float* segP = uv + 4096;
  float* segH = segP + 256;
  const int tid = opq(threadIdx.x), lane = tid & 63, w = tid >> 6, fr = lane & 15, fq = lane >> 4;
  const int cgk = item >> 3, hA = item & 7, n = cgk % 36, rb = cgk * 64;
  u16* z = (u16*)(p.ws + O_Z);
  for (int idx = tid; idx < 4096; idx += 256) {
    int c = idx >> 6, j = idx & 63, ch = hA * 64 + j;
    float val = p.conv_a_b[l * 512 + ch];
#pragma unroll
    for (int tap = 0; tap < 4; ++tap) val += p.conv_a_w[(l * 4 + tap) * 512 + ch] * zval(z, rb, c + tap - 2, n, C_XA + ch);
    xc[idx] = val;
    xcb[c * 72 + j] = f2bf(val);
  }
  __syncthreads();
  float yacc[16];
#pragma unroll
  for (int k = 0; k < 16; ++k) yacc[k] = 0.f;
  const int seg = tid >> 6, sj = tid & 63, sch = hA * 64 + sj;
  for (int dir = 0; dir < 2; ++dir) {
    {
      const u16* wg = (const u16*)(p.ws + O_WGT);
      const u16* wr_ = wg + (size_t)((((l * 2 + dir) * 2 + 0) * 8 + hA)) * 4096;
      const u16* wi_ = wg + (size_t)((((l * 2 + dir) * 2 + 1) * 8 + hA)) * 4096;
      bf16x8 a0 = ld8(xcb + (16 * w + fr) * 72 + fq * 8), a1 = ld8(xcb + (16 * w + fr) * 72 + 32 + fq * 8);
#pragma unroll
      for (int nt = 0; nt < 4; ++nt) {
        f32x4 ar = {0.f, 0.f, 0.f, 0.f}, ai = {0.f, 0.f, 0.f, 0.f};
        const u16* br = wr_ + (nt * 16 + fr) * 64 + fq * 8;
        const u16* bi = wi_ + (nt * 16 + fr) * 64 + fq * 8;
        ar = mfma(a0, ld8(br), ar); ar = mfma(a1, ld8(br + 32), ar);
        ai = mfma(a0, ld8(bi), ai); ai = mfma(a1, ld8(bi + 32), ai);
        int j = nt * 16 + fr, ch = hA * 64 + j;
        float brv = p.rg_b_r[(l * 2 + dir) * 512 + ch], biv = p.rg_b_i[(l * 2 + dir) * 512 + ch];
        float sp = softplus(-p.rg_lam[(l * 2 + dir) * 512 + ch]);
#pragma unroll
        for (int r = 0; r < 4; ++r) {
          int c = 16 * w + 4 * fq + r;
          float rg = sigm(ar[r] + brv), ig = sigm(ai[r] + biv);
          float la = -8.f * rg * sp;
          float a = __expf(la);
          float t2 = 2.f * la;
          float om = (t2 > -0.02f) ? -t2 * (1.f + 0.5f * t2 * (1.f + t2 * (1.f / 3.f) * (1.f + 0.25f * t2))) : 1.f - a * a;
          float uu = sqrtf(fmaxf(om, 0.f)) * (ig * xc[c * 64 + j]);
          av[c * 64 + j] = a;
          uv[c * 64 + j] = uu;
        }
      }
    }
    __syncthreads();
    {
      float Pp = 1.f, H = 0.f;
#pragma unroll
      for (int k = 0; k < 16; ++k) {
        int c = dir ? (16 * seg + 15 - k) : (16 * seg + k);
        float a = av[c * 64 + sj];
        H = a * H + uv[c * 64 + sj];
        Pp *= a;
      }
      segP[seg * 64 + sj] = Pp;
      segH[seg * 64 + sj] = H;
    }
    __syncthreads();
    if (mode == 0) {
      if (seg == 0) {
        float Pc = 1.f, Hc = 0.f;
        for (int q = 0; q < 4; ++q) {
          int sg = dir ? 3 - q : q;
          Hc = segP[sg * 64 + sj] * Hc + segH[sg * 64 + sj];
          Pc *= segP[sg * 64 + sj];
        }
        size_t idx = ((size_t)cgk * 2 + dir) * 512 + sch;
        ((float*)(p.ws + O_AP))[idx] = Pc;
        ((float*)(p.ws + O_AH))[idx] = Hc;
      }
    } else {
      float st = ((const float*)(p.ws + O_ACAR))[((size_t)cgk * 2 + dir) * 512 + sch];
      int nbefore = dir ? 3 - seg : seg;
      for (int q = 0; q < nbefore; ++q) {
        int sg = dir ? 3 - q : q;
        st = segP[sg * 64 + sj] * st + segH[sg * 64 + sj];
      }
      if (dir == 0) {
#pragma unroll
        for (int k = 0; k < 16; ++k) {
          int c = 16 * seg + k;
          st = av[c * 64 + sj] * st + uv[c * 64 + sj];
          yacc[k] += st;
        }
      } else {
#pragma unroll
        for (int k = 15; k >= 0; --k) {
          int c = 16 * seg + k;
          st = av[c * 64 + sj] * st + uv[c * 64 + sj];
          yacc[k] += st;
        }
      }
    }
    __syncthreads();
  }
  if (mode == 1) {
#pragma unroll
    for (int k = 0; k < 16; ++k) {
      size_t zi = (size_t)(rb + 16 * seg + k) * NZ + C_GA + sch;
      float gate = bf2f(z[zi]);
      z[zi] = f2bf(yacc[k] * silu(gate));
    }
  }
}

DEV void a_carry(const P& p, int item) {
  int t = item * 256 + threadIdx.x;
  int ch = t & 511, dir = (t >> 9) & 1, lb = t >> 10;
  const float* AP = (const float*)(p.ws + O_AP);
  const float* AH = (const float*)(p.ws + O_AH);
  float* AC = (float*)(p.ws + O_ACAR);
  float st = 0.f;
  for (int j = 0; j < 36; ++j) {
    int n = dir ? (j < 4 ? 3 - j : 39 - j) : j;
    size_t idx = ((size_t)(lb * 36 + n) * 2 + dir) * 512 + ch;
    AC[idx] = st;
    st = AP[idx] * st + AH[idx];
  }
}

DEV void b_local(const P& p, int l, int item, char* smem) {
  u16* qs = (u16*)smem;
  u16* ks = qs + 64 * 136;
  float* Am = (float*)(smem + 34816);
  float* gc = (float*)(smem + 34816 + 32768);
  float* bt = gc + 128;
  const int tid = opq(threadIdx.x), lane = tid & 63, w = tid >> 6, fr = lane & 15, fq = lane >> 4;
  const int cgk = item >> 2, h = item & 3, n = cgk % 36, rb = cgk * 64;
  const u16* z = (const u16*)(p.ws + O_Z);
  u16* qn = (u16*)(p.ws + O_BSH);
  u16* kn = qn + (size_t)GR * 512;
  u16* vb = kn + (size_t)GR * 512;
  u16* knT = vb + (size_t)GR * 512;
  const float* ab = (const float*)(p.ws + O_AB);
  {
    u16* Tt = (u16*)Am;
    uint4 st[5];
#define BL_TLOAD(which)                                                                                  \
  _Pragma("unroll") for (int k = 0; k < 5; ++k) {                                                        \
    int idx = tid + 256 * k, row = idx >> 4, seg = idx & 15, cp = row - 2;                               \
    bool ok = (idx < 1072) && !((cp < 0 && (n == 0 || n == 4)) || (cp > 63 && (n == 3 || n == 35)));    \
    st[k] = make_uint4(0u, 0u, 0u, 0u);                                                                  \
    if (ok) st[k] = *(const uint4*)(z + (size_t)(rb + cp) * NZ + C_Q + (which)*512 + h * 128 + seg * 8); \
  }
    BL_TLOAD(0)
#pragma unroll
    for (int which = 0; which < 3; ++which) {
#pragma unroll
      for (int k = 0; k < 5; ++k) {
        int idx = tid + 256 * k, row = idx >> 4, seg = idx & 15;
        if (idx < 1072) *(uint4*)(Tt + row * 136 + seg * 8) = st[k];
      }
      __syncthreads();
      if (which < 2) { BL_TLOAD(which + 1) }
      float cw[2][4];
#pragma unroll
      for (int hh = 0; hh < 2; ++hh)
#pragma unroll
        for (int tap = 0; tap < 4; ++tap)
          cw[hh][tap] = p.conv_b_w[(size_t)(l * 4 + tap) * 1536 + which * 512 + h * 128 + lane + 64 * hh];
      for (int c = w; c < 64; c += 4) {
        float v[2];
#pragma unroll
        for (int hh = 0; hh < 2; ++hh) {
          int d = lane + 64 * hh;
          float a = 0.f;
#pragma unroll
          for (int tap = 0; tap < 4; ++tap) a += cw[hh][tap] * bf2f(Tt[(c + tap) * 136 + d]);
          v[hh] = silu(a);
        }
        float rs = 1.f;
        if (which < 2) {
          float sq = v[0] * v[0] + v[1] * v[1];
#pragma unroll
          for (int off = 32; off; off >>= 1) sq += __shfl_xor(sq, off);
          rs = rsqrtf(sq + EPS) * (which == 0 ? 0.08838834764831845f : 1.f);
        }
#pragma unroll
        for (int hh = 0; hh < 2; ++hh) {
          int d = lane + 64 * hh;
          u16 ob = f2bf(v[hh] * rs);
          size_t gi = (size_t)(rb + c) * 512 + h * 128 + d;
          if (which == 0) { qs[c * 136 + d] = ob; qn[gi] = ob; }
          else if (which == 1) { ks[c * 136 + d] = ob; kn[gi] = ob; }
          else vb[gi] = ob;
        }
      }
      __syncthreads();
    }
  }
  if (w < 2) {
    int dir = w, i = lane, c = dir ? 63 - i : i;
    float al = ab[(size_t)(rb + c) * 16 + dir * 4 + h], bl = ab[(size_t)(rb + c) * 16 + 8 + dir * 4 + h];
    float g = -__expf(p.gdn_a_log[(l * 2 + dir) * 4 + h]) * softplus(al + p.gdn_dt_bias[(l * 2 + dir) * 4 + h]);
#pragma unroll
    for (int off = 1; off < 64; off <<= 1) {
      float v = __shfl_up(g, off);
      if (lane >= off) g += v;
    }
    gc[dir * 64 + i] = g;
    bt[dir * 64 + i] = sigm(bl);
  }
  __syncthreads();
  for (int idx = tid; idx < 1024; idx += 256) {
    int d = idx >> 3, c8 = idx & 7;
    uint4 pk;
    pk.x = (unsigned)ks[(c8 * 8 + 0) * 136 + d] | ((unsigned)ks[(c8 * 8 + 1) * 136 + d] << 16);
    pk.y = (unsigned)ks[(c8 * 8 + 2) * 136 + d] | ((unsigned)ks[(c8 * 8 + 3) * 136 + d] << 16);
    pk.z = (unsigned)ks[(c8 * 8 + 4) * 136 + d] | ((unsigned)ks[(c8 * 8 + 5) * 136 + d] << 16);
    pk.w = (unsigned)ks[(c8 * 8 + 6) * 136 + d] | ((unsigned)ks[(c8 * 8 + 7) * 136 + d] << 16);
    *(uint4*)(knT + ((size_t)(cgk * 4 + h) * 128 + d) * 64 + c8 * 8) = pk;
  }
  for (int dir = 0; dir < 2; ++dir) {
    char* rec = p.ws + O_BIT + ((size_t)(cgk * 4 + h) * 2 + dir) * BIT_SZ;
    u16* QKm = (u16*)rec + 4096;
    float* scal = (float*)(rec + 16384);
    int irow = 16 * w + fr, ci = dir ? 63 - irow : irow;
    bf16x8 ak[4], aq[4];
#pragma unroll
    for (int s = 0; s < 4; ++s) { ak[s] = ld8(ks + ci * 136 + 32 * s + 8 * fq); aq[s] = ld8(qs + ci * 136 + 32 * s + 8 * fq); }
#pragma unroll
    for (int nt = 0; nt < 4; ++nt) {
      int jcol = 16 * nt + fr, cj = dir ? 63 - jcol : jcol;
      f32x4 kk = {0.f, 0.f, 0.f, 0.f}, qk = {0.f, 0.f, 0.f, 0.f};
#pragma unroll
      for (int s = 0; s < 4; ++s) {
        bf16x8 b = ld8(ks + cj * 136 + 32 * s + 8 * fq);
        kk = mfma(ak[s], b, kk);
        qk = mfma(aq[s], b, qk);
      }
      float gj = gc[dir * 64 + jcol];
#pragma unroll
      for (int r = 0; r < 4; ++r) {
        int i = 16 * w + 4 * fq + r;
        float dec = (jcol <= i) ? __expf(gc[dir * 64 + i] - gj) : 0.f;
        Am[(dir * 64 + i) * 64 + jcol] = (jcol < i) ? bt[dir * 64 + i] * kk[r] * dec : 0.f;
        QKm[i * 64 + jcol] = f2bf(qk[r] * dec);
      }
    }
    if (tid < 64) {
      float gl = gc[dir * 64 + 63], gi = gc[dir * 64 + tid];
      scal[tid] = __expf(gi);
      scal[64 + tid] = bt[dir * 64 + tid];
      scal[128 + tid] = __expf(gl - gi);
      if (tid == 0) scal[192] = __expf(gl);
    }
  }
  __syncthreads();
  if (w < 2) {
    int dir = w, col = lane;
    u16* Tinv = (u16*)(p.ws + O_BIT + ((size_t)(cgk * 4 + h) * 2 + dir) * BIT_SZ);
    const float* Ad = Am + dir * 4096;
    float T[64];
#pragma unroll
    for (int i = 0; i < 64; ++i) {
      float s = (i == col) ? 1.f : 0.f;
#pragma unroll
      for (int j = 0; j < i; ++j) s -= Ad[i * 64 + j] * T[j];
      T[i] = s;
      Tinv[i * 64 + col] = f2bf(s);
      __builtin_amdgcn_sched_barrier(0);
    }
  }
  __syncthreads();
}

DEV void b_seq(const P& p, int bitem, char* smem) {
  const int tid = opq(threadIdx.x), lane = tid & 63, w = tid >> 6, fr = lane & 15, fq = lane >> 4;
  const bool active = w < WPB;
  const int item = bitem * WPB + (active ? w : 0);
  const int slice = item & 7, dir = (item >> 3) & 1, h = (item >> 4) & 3, lb = item >> 6, e0 = slice * 16;
  u16* Ss = (u16*)(smem + w * 11264);
  u16* Rs = Ss + 16 * 136;
  u16* Vsc = Rs + 16 * 72;
  u16* Vor = Vsc + 16 * 72;
  const u16* qn = (const u16*)(p.ws + O_BSH);
  const u16* kn = qn + (size_t)GR * 512;
  const u16* vb = kn + (size_t)GR * 512;
  const u16* knT = vb + (size_t)GR * 512;
  u16* OB = (u16*)(p.ws + O_OB);
  f32x4 S[8];
#pragma unroll
  for (int m = 0; m < 8; ++m) S[m] = (f32x4){0.f, 0.f, 0.f, 0.f};
  for (int j = 0; j < 36; ++j) {
    const int n = dir ? (j < 4 ? 3 - j : 39 - j) : j;
    const int cgk = lb * 36 + n, rb = cgk * 64;
    const char* rec = p.ws + O_BIT + ((size_t)(cgk * 4 + h) * 2 + dir) * BIT_SZ;
    const u16* Tinv = (const u16*)rec;
    const u16* QKm = Tinv + 4096;
    const float* scal = (const float*)(rec + 16384);
    if (active) {
#pragma unroll
      for (int m = 0; m < 8; ++m) {
        uint2 pk; pk.x = pk2(S[m][0], S[m][1]); pk.y = pk2(S[m][2], S[m][3]);
        *(uint2*)(Ss + fr * 136 + 16 * m + 4 * fq) = pk;
      }
    }
    __syncthreads();
    bf16x8 Sf[4];
    if (active) {
#pragma unroll
      for (int s = 0; s < 4; ++s) Sf[s] = ld8(Ss + fr * 136 + 32 * s + 8 * fq);
#pragma unroll
      for (int m = 0; m < 4; ++m) {
        int i = 16 * m + fr, rowi = rb + (dir ? 63 - i : i);
        f32x4 X = {0.f, 0.f, 0.f, 0.f};
#pragma unroll
        for (int s = 0; s < 4; ++s) X = mfma(ld8(kn + (size_t)rowi * 512 + h * 128 + 32 * s + 8 * fq), Sf[s], X);
        float rv[4];
#pragma unroll
        for (int r = 0; r < 4; ++r) {
          int ii = 16 * m + 4 * fq + r, rowr = rb + (dir ? 63 - ii : ii);
          float v = bf2f(vb[(size_t)rowr * 512 + h * 128 + e0 + fr]);
          rv[r] = scal[64 + ii] * (v - scal[ii] * X[r]);
        }
        uint2 pk; pk.x = pk2(rv[0], rv[1]); pk.y = pk2(rv[2], rv[3]);
        *(uint2*)(Rs + fr * 72 + 16 * m + 4 * fq) = pk;
      }
    }
    __syncthreads();
    if (active) {
      bf16x8 Rf0 = ld8(Rs + fr * 72 + 8 * fq), Rf1 = ld8(Rs + fr * 72 + 32 + 8 * fq);
#pragma unroll
      for (int m = 0; m < 4; ++m) {
        f32x4 VN = {0.f, 0.f, 0.f, 0.f};
        VN = mfma(ld8(Tinv + (16 * m + fr) * 64 + 8 * fq), Rf0, VN);
        VN = mfma(ld8(Tinv + (16 * m + fr) * 64 + 32 + 8 * fq), Rf1, VN);
        uint2 pk; pk.x = pk2(VN[0], VN[1]); pk.y = pk2(VN[2], VN[3]);
        *(uint2*)(Vsc + fr * 72 + 16 * m + 4 * fq) = pk;
        int ib = 16 * m + 4 * fq;
        float s0 = VN[0] * scal[128 + ib], s1 = VN[1] * scal[128 + ib + 1], s2 = VN[2] * scal[128 + ib + 2],
              s3 = VN[3] * scal[128 + ib + 3];
        if (dir) {
          pk.x = pk2(s3, s2); pk.y = pk2(s1, s0);
          *(uint2*)(Vor + fr * 72 + (60 - ib)) = pk;
        } else {
          pk.x = pk2(s0, s1); pk.y = pk2(s2, s3);
          *(uint2*)(Vor + fr * 72 + ib) = pk;
        }
      }
    }
    __syncthreads();
    if (active) {
      bf16x8 Vs0 = ld8(Vsc + fr * 72 + 8 * fq), Vs1 = ld8(Vsc + fr * 72 + 32 + 8 * fq);
      bf16x8 Vo0 = ld8(Vor + fr * 72 + 8 * fq), Vo1 = ld8(Vor + fr * 72 + 32 + 8 * fq);
#pragma unroll
      for (int m = 0; m < 4; ++m) {
        int i = 16 * m + fr, rowi = rb + (dir ? 63 - i : i);
        f32x4 O = {0.f, 0.f, 0.f, 0.f};
#pragma unroll
        for (int s = 0; s < 4; ++s) O = mfma(ld8(qn + (size_t)rowi * 512 + h * 128 + 32 * s + 8 * fq), Sf[s], O);
#pragma unroll
        for (int r = 0; r < 4; ++r) O[r] *= scal[16 * m + 4 * fq + r];
        O = mfma(ld8(QKm + (16 * m + fr) * 64 + 8 * fq), Vs0, O);
        O = mfma(ld8(QKm + (16 * m + fr) * 64 + 32 + 8 * fq), Vs1, O);
#pragma unroll
        for (int r = 0; r < 4; ++r) {
          int ii = 16 * m + 4 * fq + r, rowr = rb + (dir ? 63 - ii : ii);
          OB[((size_t)dir * GR + rowr) * 512 + h * 128 + e0 + fr] = f2bf(O[r]);
        }
      }
      float egl = scal[192];
#pragma unroll
      for (int m = 0; m < 8; ++m) {
        const u16* kt = knT + ((size_t)(cgk * 4 + h) * 128 + 16 * m + fr) * 64;
        f32x4 t = S[m];
#pragma unroll
        for (int r = 0; r < 4; ++r) t[r] *= egl;
        t = mfma(ld8(kt + 8 * fq), Vo0, t);
        t = mfma(ld8(kt + 32 + 8 * fq), Vo1, t);
        S[m] = t;
      }
    }
  }
  __syncthreads();
}

DEV void c_local(const P& p, int l, int item, char* smem) {
  float* bsm = (float*)smem;
  u16* Ps = (u16*)(smem + 33024);
  u16* kdt = (u16*)(smem + 33024 + 9216);
  const int tid = opq(threadIdx.x), lane = tid & 63, w = tid >> 6, fr = lane & 15, fq = lane >> 4;
  const int cgk = item >> 2, h = item & 3, rb = cgk * 64;
  const u16* z = (const u16*)(p.ws + O_Z);
  const u16* zT = (const u16*)(p.ws + O_ZT);
  u16* OC = (u16*)(p.ws + O_OC);
  const float* lbs = (const float*)(p.ws + O_LBS);
  for (int dir = 0; dir < 2; ++dir) {
    char* rec = p.ws + O_CREC + ((size_t)(cgk * 4 + h) * 2 + dir) * CREC_SZ;
    u16* QD = (u16*)rec;
    u16* KDT = QD + 8192;
    float* decv = (float*)(rec + 32768);
    const float* lbp = lbs + l * 1024 + dir * 512 + h * 128;
    const int fcol = C_F0 + dir * 512 + h * 128;
    {
      int d = tid & 127, half = tid >> 7;
      float lb_ = lbp[d], run = 0.f;
      for (int k = 0; k < 32; ++k) {
        int i = 32 * half + k, c = dir ? 63 - i : i;
        float f = bf2f(z[(size_t)(rb + c) * NZ + fcol + d]);
        float fg = lb_ + (1.f - lb_) * sigm(f);
        run += __logf(fg);
        bsm[i * 129 + d] = run;
      }
    }
    __syncthreads();
    {
      int d = tid & 127, half = tid >> 7;
      if (half) {
        float add = bsm[31 * 129 + d];
        for (int k = 0; k < 32; ++k) bsm[(32 + k) * 129 + d] += add;
      }
    }
    __syncthreads();
    for (int idx = tid; idx < 8192; idx += 256) {
      int i = idx >> 7, d = idx & 127, c = dir ? 63 - i : i;
      float b = bsm[i * 129 + d];
      float q = silu(bf2f(z[(size_t)(rb + c) * NZ + C_QC + h * 128 + d]));
      QD[i * 128 + d] = f2bf(q * __expf(b));
      float f = bf2f(z[(size_t)(rb + c) * NZ + fcol + d]);
      float k = (1.f - lbp[d]) * sigm(-f);
      kdt[d * 72 + c] = f2bf(k * __expf(bsm[63 * 129 + d] - b));
    }
    if (tid < 128) decv[tid] = __expf(bsm[63 * 129 + tid]);
    __syncthreads();
    for (int idx = tid; idx < 1024; idx += 256) {
      int d = idx >> 3, c8 = idx & 7;
      *(uint4*)(KDT + d * 64 + c8 * 8) = *(const uint4*)(kdt + d * 72 + c8 * 8);
    }
    {
      const int sj = w;
      for (int si = 0; si < 4; ++si) {
        f32x4 acc = {0.f, 0.f, 0.f, 0.f};
        if (si >= sj) {
          int it = 16 * si + fr, jt = 16 * sj + fr;
          int ci = dir ? 63 - it : it, cj = dir ? 63 - jt : jt;
#pragma unroll
          for (int s = 0; s < 4; ++s) {
            int d0 = 32 * s + 8 * fq;
            bf16x8 qv = ld8(z + (size_t)(rb + ci) * NZ + C_QC + h * 128 + d0);
            bf16x8 fv = ld8(z + (size_t)(rb + cj) * NZ + fcol + d0);
            bf16x8 af, bf;
#pragma unroll
            for (int e = 0; e < 8; ++e) {
              int d = d0 + e;
              float Bs_ = si ? bsm[(16 * si - 1) * 129 + d] : 0.f;
              float qq = silu(bf2f((u16)qv[e])) * __expf(bsm[it * 129 + d] - Bs_);
              float kk = (1.f - lbp[d]) * sigm(-bf2f((u16)fv[e])) * __expf(Bs_ - bsm[jt * 129 + d]);
              af[e] = (short)f2bf(qq);
              bf[e] = (short)f2bf(kk);
            }
            acc = mfma(af, bf, acc);
          }
        }
#pragma unroll
        for (int r = 0; r < 4; ++r) {
          int i = 16 * si + 4 * fq + r, jj = 16 * sj + fr;
          float v = (si >= sj && jj <= i) ? acc[r] : 0.f;
          Ps[i * 72 + (dir ? 63 - jj : jj)] = f2bf(v);
        }
        __builtin_amdgcn_sched_barrier(0);
      }
    }
    __syncthreads();
#pragma unroll
    for (int nt2 = 0; nt2 < 2; ++nt2) {
      int e = h * 128 + (2 * w + nt2) * 16 + fr;
      bf16x8 v0 = ld8(zT + (size_t)e * GR + rb + 8 * fq), v1 = ld8(zT + (size_t)e * GR + rb + 32 + 8 * fq);
#pragma unroll
      for (int m = 0; m < 4; ++m) {
        f32x4 O = {0.f, 0.f, 0.f, 0.f};
        O = mfma(ld8(Ps + (16 * m + fr) * 72 + 8 * fq), v0, O);
        O = mfma(ld8(Ps + (16 * m + fr) * 72 + 32 + 8 * fq), v1, O);
#pragma unroll
        for (int r = 0; r < 4; ++r) {
          int ii = 16 * m + 4 * fq + r, rowr = rb + (dir ? 63 - ii : ii);
          OC[((size_t)dir * GR + rowr) * 512 + e] = f2bf(O[r]);
        }
      }
    }
    __syncthreads();
  }
}

DEV void c_seq(const P& p, int bitem, char* smem) {
  const int tid = opq(threadIdx.x), lane = tid & 63, w = tid >> 6, fr = lane & 15, fq = lane >> 4;
  const bool active = w < WPB;
  const int item = bitem * WPB + (active ? w : 0);
  const int slice = item & 7, dir = (item >> 3) & 1, h = (item >> 4) & 3, lb = item >> 6, e0 = slice * 16;
  u16* Ss = (u16*)(smem + w * 4352);
  const u16* zT = (const u16*)(p.ws + O_ZT);
  u16* OC = (u16*)(p.ws + O_OC);
  f32x4 S[8];
#pragma unroll
  for (int m = 0; m < 8; ++m) S[m] = (f32x4){0.f, 0.f, 0.f, 0.f};
  for (int j = 0; j < 36; ++j) {
    const int n = dir ? (j < 4 ? 3 - j : 39 - j) : j;
    const int cgk = lb * 36 + n, rb = cgk * 64;
    const char* rec = p.ws + O_CREC + ((size_t)(cgk * 4 + h) * 2 + dir) * CREC_SZ;
    const u16* QD = (const u16*)rec;
    const u16* KDT = QD + 8192;
    const float* decv = (const float*)(rec + 32768);
    if (active) {
#pragma unroll
      for (int m = 0; m < 8; ++m) {
        uint2 pk; pk.x = pk2(S[m][0], S[m][1]); pk.y = pk2(S[m][2], S[m][3]);
        *(uint2*)(Ss + fr * 136 + 16 * m + 4 * fq) = pk;
      }
    }
    __syncthreads();
    if (active) {
      bf16x8 Sf[4];
#pragma unroll
      for (int s = 0; s < 4; ++s) Sf[s] = ld8(Ss + fr * 136 + 32 * s + 8 * fq);
#pragma unroll
      for (int m = 0; m < 4; ++m) {
        f32x4 O = {0.f, 0.f, 0.f, 0.f};
#pragma unroll
        for (int s = 0; s < 4; ++s) O = mfma(ld8(QD + (16 * m + fr) * 128 + 32 * s + 8 * fq), Sf[s], O);
#pragma unroll
        for (int r = 0; r < 4; ++r) {
          int ii = 16 * m + 4 * fq + r, rowr = rb + (dir ? 63 - ii : ii);
          size_t oi = ((size_t)dir * GR + rowr) * 512 + h * 128 + e0 + fr;
          OC[oi] = f2bf(bf2f(OC[oi]) + O[r]);
        }
      }
      const u16* vp = zT + (size_t)(h * 128 + e0 + fr) * GR + rb;
      bf16x8 V0 = ld8(vp + 8 * fq), V1 = ld8(vp + 32 + 8 * fq);
#pragma unroll
      for (int m = 0; m < 8; ++m) {
        f32x4 t = S[m];
#pragma unroll
        for (int r = 0; r < 4; ++r) t[r] *= decv[16 * m + 4 * fq + r];
        t = mfma(ld8(KDT + (16 * m + fr) * 64 + 8 * fq), V0, t);
        t = mfma(ld8(KDT + (16 * m + fr) * 64 + 32 + 8 * fq), V1, t);
        S[m] = t;
      }
    }
    __syncthreads();
  }
}

#define LBAR()                                              \
  do {                                                      \
    asm volatile("s_waitcnt lgkmcnt(0)" ::: "memory");      \
    __builtin_amdgcn_s_barrier();                           \
    asm volatile("" ::: "memory");                          \
  } while (0)
#define CBAR() asm volatile("" ::: "memory")

DEV void c_local2(const P& p, int l, int item, char* smem) {
  float* bsm = (float*)smem;
  u16* Fq = (u16*)(smem + 33024);
  u16* kdt = (u16*)(smem + 50432);
  u16* Ps = kdt;
  const int tid = opq(threadIdx.x), lane = tid & 63, w = tid >> 6, fr = lane & 15, fq = lane >> 4;
  const int cgk = item >> 2, h = item & 3, rb = cgk * 64;
  const u16* z = (const u16*)(p.ws + O_Z);
  const u16* zT = (const u16*)(p.ws + O_ZT);
  u16* OC = (u16*)(p.ws + O_OC);
  const float* lbs = (const float*)(p.ws + O_LBS);
  u16* zq = (u16*)(p.ws + O_Z) + (size_t)rb * NZ + C_QC + h * 128;
  {
    uint4 t4[4];
#pragma unroll
    for (int k = 0; k < 4; ++k) {
      int idx = tid + 256 * k, c = idx >> 4, seg = idx & 15;
      t4[k] = *(const uint4*)(zq + (size_t)c * NZ + seg * 8);
    }
#pragma unroll
    for (int k = 0; k < 4; ++k) {
      int idx = tid + 256 * k, c = idx >> 4, seg = idx & 15;
      unsigned wv[4] = {t4[k].x, t4[k].y, t4[k].z, t4[k].w};
#pragma unroll
      for (int q = 0; q < 4; ++q)
        wv[q] = pk2(silu(bf2f((u16)(wv[q] & 0xffff))), silu(bf2f((u16)(wv[q] >> 16))));
      *(uint4*)(zq + (size_t)c * NZ + seg * 8) = make_uint4(wv[0], wv[1], wv[2], wv[3]);
    }
  }
  __syncthreads();
  for (int dir = 0; dir < 2; ++dir) {
    char* rec = p.ws + O_CREC + ((size_t)(cgk * 4 + h) * 2 + dir) * CREC_SZ;
    u16* QD = (u16*)rec;
    u16* KDT = QD + 8192;
    float* decv = (float*)(rec + 32768);
    const float* lbp = lbs + l * 1024 + dir * 512 + h * 128;
    const int fcol = C_F0 + dir * 512 + h * 128;
    {
      uint4 t4[4];
#pragma unroll
      for (int k = 0; k < 4; ++k) {
        int idx = tid + 256 * k, c = idx >> 4, seg = idx & 15;
        t4[k] = *(const uint4*)(z + (size_t)(rb + c) * NZ + fcol + seg * 8);
      }
#pragma unroll
      for (int k = 0; k < 4; ++k) {
        int idx = tid + 256 * k, c = idx >> 4, seg = idx & 15;
        *(uint4*)(Fq + c * 136 + seg * 8) = t4[k];
      }
    }
    __syncthreads();
    {
      int d = tid & 127, half = tid >> 7;
      float lb_ = lbp[d], run = 0.f;
#pragma unroll 8
      for (int k = 0; k < 32; ++k) {
        int i = 32 * half + k, c = dir ? 63 - i : i;
        float f = bf2f(Fq[c * 136 + d]);
        float fg = lb_ + (1.f - lb_) * sigm(f);
        run += __logf(fg);
        bsm[i * 129 + d] = run;
      }
    }
    __syncthreads();
    {
      int d = tid & 127, half = tid >> 7;
      if (half) {
        float add = bsm[31 * 129 + d];
#pragma unroll 8
        for (int k = 0; k < 32; ++k) bsm[(32 + k) * 129 + d] += add;
      }
    }
    __syncthreads();
    {
      uint4 qv[4];
#pragma unroll
      for (int k = 0; k < 4; ++k) {
        int idx = tid + 256 * k, c = idx >> 4, seg = idx & 15;
        qv[k] = *(const uint4*)(zq + (size_t)c * NZ + seg * 8);
      }
#pragma unroll
      for (int k = 0; k < 4; ++k) {
        int idx = tid + 256 * k, c = idx >> 4, seg = idx & 15, i = dir ? 63 - c : c, d0 = seg * 8;
        unsigned qw[4] = {qv[k].x, qv[k].y, qv[k].z, qv[k].w};
        uint4 fv4 = *(const uint4*)(Fq + c * 136 + d0);
        unsigned fw[4] = {fv4.x, fv4.y, fv4.z, fv4.w};
        unsigned qo[4], ko[4];
#pragma unroll
        for (int q = 0; q < 4; ++q) {
          int d = d0 + 2 * q;
          float b0 = bsm[i * 129 + d], b1 = bsm[i * 129 + d + 1];
          float bl0 = bsm[63 * 129 + d], bl1 = bsm[63 * 129 + d + 1];
          float q0 = bf2f((u16)(qw[q] & 0xffff)), q1 = bf2f((u16)(qw[q] >> 16));
          qo[q] = pk2(q0 * __expf(b0), q1 * __expf(b1));
          float k0 = (1.f - lbp[d]) * sigm(-bf2f((u16)(fw[q] & 0xffff)));
          float k1 = (1.f - lbp[d + 1]) * sigm(-bf2f((u16)(fw[q] >> 16)));
          ko[q] = pk2(k0, k1);
          kdt[d * 72 + c] = f2bf(k0 * __expf(bl0 - b0));
          kdt[(d + 1) * 72 + c] = f2bf(k1 * __expf(bl1 - b1));
        }
        *(uint4*)(QD + i * 128 + d0) = make_uint4(qo[0], qo[1], qo[2], qo[3]);
        *(uint4*)(Fq + c * 136 + d0) = make_uint4(ko[0], ko[1], ko[2], ko[3]);
      }
      if (tid < 128) decv[tid] = __expf(bsm[63 * 129 + tid]);
    }
    __syncthreads();
    for (int idx = tid; idx < 1024; idx += 256) {
      int d = idx >> 3, c8 = idx & 7;
      *(uint4*)(KDT + d * 64 + c8 * 8) = *(const uint4*)(kdt + d * 72 + c8 * 8);
    }
    bf16x8 qf[3][4];
#pragma unroll
    for (int t = 0; t < 3; ++t) {
      int k = w + 4 * t;
      int si = k < 4 ? 3 : (k < 7 ? 2 : (k < 9 ? 1 : 0));
      int it_ = 16 * si + fr, ci_ = dir ? 63 - it_ : it_;
#pragma unroll
      for (int s = 0; s < 4; ++s) qf[t][s] = ld8(zq + (size_t)ci_ * NZ + 32 * s + 8 * fq);
    }
    __syncthreads();
    for (int idx = tid; idx < 1536; idx += 256) {
      int tl = idx >> 8, e = idx & 255, r16 = e >> 4, c16 = e & 15;
      int si = tl < 3 ? 0 : (tl < 5 ? 1 : 2);
      int sj = tl < 3 ? tl + 1 : (tl < 5 ? tl - 1 : 3);
      int jj = 16 * sj + c16;
      Ps[(16 * si + r16) * 72 + (dir ? 63 - jj : jj)] = 0;
    }
#pragma unroll
    for (int t = 0; t < 3; ++t) {
      const int k = w + 4 * t;
      if (k < 10) {
        const int si = k < 4 ? 3 : (k < 7 ? 2 : (k < 9 ? 1 : 0));
        const int sj = k - (k < 4 ? 0 : (k < 7 ? 4 : (k < 9 ? 7 : 9)));
        const int it = 16 * si + fr, jt = 16 * sj + fr, cj = dir ? 63 - jt : jt;
        const int brow = si ? (16 * si - 1) : 0;
        const float bmul = si ? 1.f : 0.f;
        f32x4 acc = {0.f, 0.f, 0.f, 0.f};
#pragma unroll
        for (int s = 0; s < 4; ++s) {
          int d0 = 32 * s + 8 * fq;
          bf16x8 fv = ld8(Fq + cj * 136 + d0);
          bf16x8 af, bf;
#pragma unroll
          for (int e = 0; e < 8; ++e) {
            int d = d0 + e;
            float Bs_ = bmul * bsm[brow * 129 + d];
            float qq = bf2f((u16)qf[t][s][e]) * __expf(bsm[it * 129 + d] - Bs_);
            float kk = bf2f((u16)fv[e]) * __expf(Bs_ - bsm[jt * 129 + d]);
            af[e] = (short)f2bf(qq);
            bf[e] = (short)f2bf(kk);
          }
          acc = mfma(af, bf, acc);
          __builtin_amdgcn_sched_barrier(0);
        }
#pragma unroll
        for (int r = 0; r < 4; ++r) {
          int i = 16 * si + 4 * fq + r, jj = 16 * sj + fr;
          float v = (jj <= i) ? acc[r] : 0.f;
          Ps[i * 72 + (dir ? 63 - jj : jj)] = f2bf(v);
        }
      }
    }
    __syncthreads();
#pragma unroll
    for (int nt2 = 0; nt2 < 2; ++nt2) {
      int e = h * 128 + (2 * w + nt2) * 16 + fr;
      bf16x8 v0 = ld8(zT + (size_t)e * GR + rb + 8 * fq), v1 = ld8(zT + (size_t)e * GR + rb + 32 + 8 * fq);
#pragma unroll
      for (int m = 0; m < 4; ++m) {
        f32x4 O = {0.f, 0.f, 0.f, 0.f};
        O = mfma(ld8(Ps + (16 * m + fr) * 72 + 8 * fq), v0, O);
        O = mfma(ld8(Ps + (16 * m + fr) * 72 + 32 + 8 * fq), v1, O);
#pragma unroll
        for (int r = 0; r < 4; ++r) {
          int ii = 16 * m + 4 * fq + r, rowr = rb + (dir ? 63 - ii : ii);
          OC[((size_t)dir * GR + rowr) * 512 + e] = f2bf(O[r]);
        }
      }
    }
    __syncthreads();
  }
}

#define LBAR()                                              \
  do {                                                      \
    asm volatile("s_waitcnt lgkmcnt(0)" ::: "memory");      \
    __builtin_amdgcn_s_barrier();                           \
    asm volatile("" ::: "memory");                          \
  } while (0)
#define CBAR() asm volatile("" ::: "memory")
#define BS_CHUNK(jj) (dir ? ((jj) < 4 ? 3 - (jj) : 39 - (jj)) : (jj))
DEV bf16x8 ldo8(const char* base, unsigned off) { return *reinterpret_cast<const bf16x8*>(base + off); }
DEV void b_seq2(const P& p, int bitem, char* smem) {
  const int tid = opq(threadIdx.x), lane = tid & 63, w = tid >> 6, fr = lane & 15, fq = lane >> 4;
  const int es = bitem & 3, dir = (bitem >> 2) & 1, h = (bitem >> 3) & 3, lb = bitem >> 5, e0 = es * 32;
  u16* Ss = (u16*)smem;
  u16* Rs = Ss + 32 * 136;
  u16* Vsc = Rs + 32 * 72;
  u16* Vor = Vsc + 32 * 72;
  const char* qnB = p.ws + O_BSH + (size_t)h * 256;
  const char* knB = qnB + BSH_ONE;
  const char* vbB = knB + BSH_ONE + (size_t)e0 * 2;
  const char* ktB = p.ws + O_BSH + 3 * BSH_ONE + (size_t)h * 16384;
  const char* recB = p.ws + O_BIT + ((size_t)h * 2 + dir) * BIT_SZ;
  char* obB = p.ws + O_OB + ((size_t)dir * GR * 512 + h * 128 + e0) * 2;
  const int mrow = 16 * w + fr, crow0 = 16 * w + 4 * fq;
  const unsigned offA = (unsigned)((dir ? 63 - mrow : mrow) * 1024 + 16 * fq);
  unsigned offR[4];
#pragma unroll
  for (int r = 0; r < 4; ++r) offR[r] = (unsigned)((dir ? 63 - (crow0 + r) : (crow0 + r)) * 1024 + fr * 2);
  const unsigned offT = (unsigned)(mrow * 128 + 16 * fq);
  const unsigned offK = (unsigned)((32 * w + fr) * 128 + 16 * fq);
  const unsigned offS = (unsigned)(16384 + crow0 * 4);
  f32x4 S[2][2];
#pragma unroll
  for (int a = 0; a < 2; ++a)
#pragma unroll
    for (int b = 0; b < 2; ++b) S[a][b] = (f32x4){0.f, 0.f, 0.f, 0.f};
  bf16x8 Akn[4], Aqn[4], At[2], Aqk[2], AkT[2][2];
  u16 vbv[2][4];
  float4 eg4, be4, ek4;
  float egl;
#define BS_LOAD1(cg_)                                                              \
  {                                                                                \
    const size_t ro_ = (size_t)(cg_) * 65536;                                      \
    _Pragma("unroll") for (int s = 0; s < 4; ++s) {                                \
      Akn[s] = ldo8(knB + ro_, offA + 64 * s);                                     \
      Aqn[s] = ldo8(qnB + ro_, offA + 64 * s);                                     \
    }                                                                              \
    _Pragma("unroll") for (int r = 0; r < 4; ++r) {                                \
      vbv[0][r] = *(const u16*)(vbB + ro_ + offR[r]);                              \
      vbv[1][r] = *(const u16*)(vbB + ro_ + (offR[r] + 32));                       \
    }                                                                              \
    const char* rc_ = recB + (size_t)(cg_) * (8 * BIT_SZ);                         \
    eg4 = *(const float4*)(rc_ + offS);                                            \
    be4 = *(const float4*)(rc_ + (offS + 256));                                    \
  }
#define BS_LOAD2(cg_)                                                              \
  {                                                                                \
    const char* rc_ = recB + (size_t)(cg_) * (8 * BIT_SZ);                         \
    At[0] = ldo8(rc_, offT); At[1] = ldo8(rc_, offT + 64);                         \
    ek4 = *(const float4*)(rc_ + (offS + 512));                                    \
  }
#define BS_LOAD3(cg_)                                                              \
  {                                                                                \
    const char* rc_ = recB + (size_t)(cg_) * (8 * BIT_SZ);                         \
    Aqk[0] = ldo8(rc_, offT + 8192); Aqk[1] = ldo8(rc_, offT + 8192 + 64);         \
    egl = *(const float*)(rc_ + 16384 + 768);                                      \
    const char* kt_ = ktB + (size_t)(cg_) * 65536;                                 \
    AkT[0][0] = ldo8(kt_, offK); AkT[0][1] = ldo8(kt_, offK + 64);                 \
    AkT[1][0] = ldo8(kt_, offK + 2048); AkT[1][1] = ldo8(kt_, offK + 2048 + 64);   \
  }
  {
    const int c0 = lb * 36 + BS_CHUNK(0);
    BS_LOAD1(c0) BS_LOAD2(c0) BS_LOAD3(c0)
  }
  for (int j = 0; j < 36; ++j) {
    const int cgk = lb * 36 + BS_CHUNK(j);
    const int jn = (j + 1 < 36) ? j + 1 : j;
    const int cgn = lb * 36 + BS_CHUNK(jn);
#pragma unroll
    for (int mm = 0; mm < 2; ++mm)
#pragma unroll
      for (int nt = 0; nt < 2; ++nt) {
        uint2 pk; pk.x = pk2(S[mm][nt][0], S[mm][nt][1]); pk.y = pk2(S[mm][nt][2], S[mm][nt][3]);
        *(uint2*)(Ss + (16 * nt + fr) * 136 + 32 * w + 16 * mm + 4 * fq) = pk;
      }
    LBAR();
    f32x4 QS[2];
    {
      bf16x8 Sf[2][4];
#pragma unroll
      for (int nt = 0; nt < 2; ++nt)
#pragma unroll
        for (int s = 0; s < 4; ++s) Sf[nt][s] = ld8(Ss + (16 * nt + fr) * 136 + 32 * s + 8 * fq);
#pragma unroll
      for (int nt = 0; nt < 2; ++nt) {
        f32x4 X = {0.f, 0.f, 0.f, 0.f}, Q = {0.f, 0.f, 0.f, 0.f};
#pragma unroll
        for (int s = 0; s < 4; ++s) { X = mfma(Akn[s], Sf[nt][s], X); Q = mfma(Aqn[s], Sf[nt][s], Q); }
        float r0 = be4.x * (bf2f(vbv[nt][0]) - eg4.x * X[0]);
        float r1 = be4.y * (bf2f(vbv[nt][1]) - eg4.y * X[1]);
        float r2 = be4.z * (bf2f(vbv[nt][2]) - eg4.z * X[2]);
        float r3 = be4.w * (bf2f(vbv[nt][3]) - eg4.w * X[3]);
        uint2 pk; pk.x = pk2(r0, r1); pk.y = pk2(r2, r3);
        *(uint2*)(Rs + (16 * nt + fr) * 72 + crow0) = pk;
        Q[0] *= eg4.x; Q[1] *= eg4.y; Q[2] *= eg4.z; Q[3] *= eg4.w;
        QS[nt] = Q;
      }
    }
    CBAR();
    BS_LOAD1(cgn)
    LBAR();
    {
#pragma unroll
      for (int nt = 0; nt < 2; ++nt) {
        bf16x8 Rf0 = ld8(Rs + (16 * nt + fr) * 72 + 8 * fq), Rf1 = ld8(Rs + (16 * nt + fr) * 72 + 32 + 8 * fq);
        f32x4 VN = {0.f, 0.f, 0.f, 0.f};
        VN = mfma(At[0], Rf0, VN);
        VN = mfma(At[1], Rf1, VN);
        uint2 pk; pk.x = pk2(VN[0], VN[1]); pk.y = pk2(VN[2], VN[3]);
        *(uint2*)(Vsc + (16 * nt + fr) * 72 + crow0) = pk;
        float s0 = VN[0] * ek4.x, s1 = VN[1] * ek4.y, s2 = VN[2] * ek4.z, s3 = VN[3] * ek4.w;
        if (dir) {
          pk.x = pk2(s3, s2); pk.y = pk2(s1, s0);
          *(uint2*)(Vor + (16 * nt + fr) * 72 + (60 - crow0)) = pk;
        } else {
          pk.x = pk2(s0, s1); pk.y = pk2(s2, s3);
          *(uint2*)(Vor + (16 * nt + fr) * 72 + crow0) = pk;
        }
      }
    }
    CBAR();
    BS_LOAD2(cgn)
    LBAR();
    {
      char* ob_ = obB + (size_t)cgk * 65536;
#pragma unroll
      for (int nt = 0; nt < 2; ++nt) {
        bf16x8 Vs0 = ld8(Vsc + (16 * nt + fr) * 72 + 8 * fq), Vs1 = ld8(Vsc + (16 * nt + fr) * 72 + 32 + 8 * fq);
        bf16x8 Vo0 = ld8(Vor + (16 * nt + fr) * 72 + 8 * fq), Vo1 = ld8(Vor + (16 * nt + fr) * 72 + 32 + 8 * fq);
        f32x4 O = QS[nt];
        O = mfma(Aqk[0], Vs0, O);
        O = mfma(Aqk[1], Vs1, O);
#pragma unroll
        for (int r = 0; r < 4; ++r) *(u16*)(ob_ + (offR[r] + 32 * nt)) = f2bf(O[r]);
#pragma unroll
        for (int mm = 0; mm < 2; ++mm) {
          f32x4 t = S[mm][nt];
#pragma unroll
          for (int r = 0; r < 4; ++r) t[r] *= egl;
          t = mfma(AkT[mm][0], Vo0, t);
          t = mfma(AkT[mm][1], Vo1, t);
          S[mm][nt] = t;
        }
      }
    }
    CBAR();
    BS_LOAD3(cgn)
  }
  LBAR();
}

DEV void c_seq2(const P& p, int bitem, char* smem) {
  const int tid = opq(threadIdx.x), lane = tid & 63, w = tid >> 6, fr = lane & 15, fq = lane >> 4;
  const int es = bitem & 3, dir = (bitem >> 2) & 1, h = (bitem >> 3) & 3, lb = bitem >> 5, e0 = es * 32;
  u16* Ssb = (u16*)smem;
  const char* recB = p.ws + O_CREC + ((size_t)h * 2 + dir) * CREC_SZ;
  const char* ztB = p.ws + O_ZT + (size_t)(h * 128 + e0) * GR * 2;
  char* ocB = p.ws + O_OC + ((size_t)dir * GR * 512 + h * 128 + e0) * 2;
  const int mrow = 16 * w + fr, crow0 = 16 * w + 4 * fq;
  const unsigned offQ = (unsigned)(mrow * 256 + 16 * fq);
  const unsigned offK = (unsigned)(16384 + (32 * w + fr) * 128 + 16 * fq);
  const unsigned offD = (unsigned)(32768 + (32 * w + 4 * fq) * 4);
  const unsigned offV = (unsigned)(fr * GR * 2 + 16 * fq);
  unsigned offR[4];
#pragma unroll
  for (int r = 0; r < 4; ++r) offR[r] = (unsigned)((dir ? 63 - (crow0 + r) : (crow0 + r)) * 1024 + fr * 2);
  f32x4 S[2][2];
#pragma unroll
  for (int a = 0; a < 2; ++a)
#pragma unroll
    for (int b = 0; b < 2; ++b) S[a][b] = (f32x4){0.f, 0.f, 0.f, 0.f};
  bf16x8 Aqd[4], Akd[2][2], Vf[2][2];
  u16 oi[2][4];
  float4 dec4[2];
#define CS_LOAD(cg_)                                                                    \
  {                                                                                     \
    const char* rc_ = recB + (size_t)(cg_) * (8 * CREC_SZ);                             \
    _Pragma("unroll") for (int s = 0; s < 4; ++s) Aqd[s] = ldo8(rc_, offQ + 64 * s);    \
    Akd[0][0] = ldo8(rc_, offK); Akd[0][1] = ldo8(rc_, offK + 64);                      \
    Akd[1][0] = ldo8(rc_, offK + 2048); Akd[1][1] = ldo8(rc_, offK + 2048 + 64);        \
    dec4[0] = *(const float4*)(rc_ + offD);                                             \
    dec4[1] = *(const float4*)(rc_ + (offD + 64));                                      \
    const char* zt_ = ztB + (size_t)(cg_) * 128;                                        \
    Vf[0][0] = ldo8(zt_, offV); Vf[0][1] = ldo8(zt_, offV + 64);                        \
    Vf[1][0] = ldo8(zt_, offV + 16 * GR * 2); Vf[1][1] = ldo8(zt_, offV + 16 * GR * 2 + 64); \
    const char* oc_ = ocB + (size_t)(cg_) * 65536;                                      \
    _Pragma("unroll") for (int r = 0; r < 4; ++r) {                                     \
      oi[0][r] = *(const u16*)(oc_ + offR[r]);                                          \
      oi[1][r] = *(const u16*)(oc_ + (offR[r] + 32));                                   \
    }                                                                                   \
  }
  {
    const int c0 = lb * 36 + BS_CHUNK(0);
    CS_LOAD(c0)
  }
  for (int j = 0; j < 36; ++j) {
    const int cgk = lb * 36 + BS_CHUNK(j);
    const int jn = (j + 1 < 36) ? j + 1 : j;
    const int cgn = lb * 36 + BS_CHUNK(jn);
    u16* Ss = Ssb + (j & 1) * (32 * 136);
#pragma unroll
    for (int mm = 0; mm < 2; ++mm)
#pragma unroll
      for (int nt = 0; nt < 2; ++nt) {
        uint2 pk; pk.x = pk2(S[mm][nt][0], S[mm][nt][1]); pk.y = pk2(S[mm][nt][2], S[mm][nt][3]);
        *(uint2*)(Ss + (16 * nt + fr) * 136 + 32 * w + 16 * mm + 4 * fq) = pk;
      }
    LBAR();
    char* oc_ = ocB + (size_t)cgk * 65536;
#pragma unroll
    for (int nt = 0; nt < 2; ++nt) {
      f32x4 O = {0.f, 0.f, 0.f, 0.f};
#pragma unroll
      for (int s = 0; s < 4; ++s) O = mfma(Aqd[s], ld8(Ss + (16 * nt + fr) * 136 + 32 * s + 8 * fq), O);
#pragma unroll
      for (int r = 0; r < 4; ++r) *(u16*)(oc_ + (offR[r] + 32 * nt)) = f2bf(bf2f(oi[nt][r]) + O[r]);
#pragma unroll
      for (int mm = 0; mm < 2; ++mm) {
        f32x4 t = S[mm][nt];
        t[0] *= dec4[mm].x; t[1] *= dec4[mm].y; t[2] *= dec4[mm].z; t[3] *= dec4[mm].w;
        t = mfma(Akd[mm][0], Vf[nt][0], t);
        t = mfma(Akd[mm][1], Vf[nt][1], t);
        S[mm][nt] = t;
      }
    }
    CBAR();
    CS_LOAD(cgn)
  }
  LBAR();
}

DEV void bc_merge(const P& p, int l, int it) {
  const int tid_ = opq(threadIdx.x); const int lane = tid_ & 63, w = tid_ >> 6;
  int lr = it * 4 + w;
  int mix = lane >> 5, cm = (lane * 16) & 511;
  const u16* O = (const u16*)(p.ws + (mix ? O_OC : O_OB));
  u16* z = (u16*)(p.ws + O_Z);
  float ov[16], ss = 0.f;
#pragma unroll
  for (int k2 = 0; k2 < 2; ++k2) {
    uint4 a = *(const uint4*)(O + (size_t)lr * 512 + cm + 8 * k2);
    uint4 b = *(const uint4*)(O + ((size_t)GR + lr) * 512 + cm + 8 * k2);
    unsigned aa[4] = {a.x, a.y, a.z, a.w}, bb[4] = {b.x, b.y, b.z, b.w};
#pragma unroll
    for (int q = 0; q < 4; ++q) {
      float v0 = bf2f((u16)(aa[q] & 0xffff)) + bf2f((u16)(bb[q] & 0xffff));
      float v1 = bf2f((u16)(aa[q] >> 16)) + bf2f((u16)(bb[q] >> 16));
      ov[k2 * 8 + q * 2] = v0; ov[k2 * 8 + q * 2 + 1] = v1;
      ss += v0 * v0 + v1 * v1;
    }
  }
  ss += __shfl_xor(ss, 1); ss += __shfl_xor(ss, 2); ss += __shfl_xor(ss, 4);
  float rinv = rsqrtf(ss * (1.f / 128.f) + EPS);
  const float* nw = (mix ? p.hg_norm : p.gdn_norm) + l * 128 + (cm & 127);
  u16* gp = z + (size_t)lr * NZ + (mix ? C_GC : C_GB) + cm;
#pragma unroll
  for (int k2 = 0; k2 < 2; ++k2) {
    uint4 gv = *(const uint4*)(gp + 8 * k2);
    unsigned gg[4] = {gv.x, gv.y, gv.z, gv.w}, oo[4];
#pragma unroll
    for (int q = 0; q < 4; ++q) {
      int e = k2 * 8 + q * 2;
      float y0 = ov[e] * rinv * nw[e] * silu(bf2f((u16)(gg[q] & 0xffff)));
      float y1 = ov[e + 1] * rinv * nw[e + 1] * silu(bf2f((u16)(gg[q] >> 16)));
      oo[q] = pk2(y0, y1);
    }
    *(uint4*)(gp + 8 * k2) = make_uint4(oo[0], oo[1], oo[2], oo[3]);
  }
}

#define XB_TMO      128
#define XB_XCNT(j)  (256  + 64 * (j))
#define XB_XSUB(j)  (1280 + 64 * (j))
#define XB_XGEN(j)  (2304 + 64 * (j))
#define XB_TOP      3328
#define XB_TOPGEN   3392
#define XCD_BAR_WORDS 3456
#define XB_SPIN_CAP (1u << 18)
#define LAS __attribute__((address_space(3)))

__device__ __forceinline__ unsigned xb_ld(unsigned* p)              { return __hip_atomic_load(p, __ATOMIC_RELAXED, __HIP_MEMORY_SCOPE_AGENT); }
__device__ __forceinline__ unsigned xb_add(unsigned* p, unsigned v) { return __hip_atomic_fetch_add(p, v, __ATOMIC_RELAXED, __HIP_MEMORY_SCOPE_AGENT); }
__device__ __forceinline__ unsigned xb_xcc_id() { return (unsigned)__builtin_amdgcn_s_getreg((3 << 11) | 20) & 0xFu; }
#define XB_SPIN(cond, bar) do { unsigned _sp = 0; while (cond) { __builtin_amdgcn_s_sleep(1); \
    if ((++_sp & 255u) == 0u) { if (xb_ld(&(bar)[XB_TMO])) break; if (_sp > XB_SPIN_CAP) { atomicAdd(&(bar)[XB_TMO], 1u); break; } } } } while (0)

struct XcdBarrier {
    unsigned* bar; unsigned x;
    volatile LAS unsigned* st;
};

__device__ __forceinline__ XcdBarrier xcd_barrier_post(unsigned* bar, volatile LAS unsigned* st) {
    XcdBarrier b; b.bar = bar; b.x = xb_xcc_id(); b.st = st;
    if (threadIdx.x == 0) (void)xb_add(&bar[XB_XCNT(b.x)], 1u);
    return b;
}
__device__ __forceinline__ void xcd_barrier_complete(unsigned* bar, unsigned x, unsigned& nloc, unsigned& nx) {
    const unsigned G = gridDim.x * gridDim.y * gridDim.z;
    unsigned sum, cnt, mine, sp = 0u;
    for (;;) {
        sum = 0u; cnt = 0u; mine = 0u;
#pragma unroll
        for (unsigned j = 0; j < 16; ++j) { const unsigned c = xb_ld(&bar[XB_XCNT(j)]); sum += c; cnt += (c > 0u) ? 1u : 0u; mine = (j == x) ? c : mine; }
        if (sum == G) break;
        __builtin_amdgcn_s_sleep(1);
        if ((++sp & 255u) == 0u) { if (xb_ld(&bar[XB_TMO])) break; if (sp > XB_SPIN_CAP) { atomicAdd(&bar[XB_TMO], 1u); break; } }
    }
    nloc = mine > 0u ? mine : 1u; nx = cnt > 0u ? cnt : 1u;
}

__device__ __forceinline__ void xcd_barrier(const XcdBarrier& b) {
    asm volatile("s_waitcnt vmcnt(0)" ::: "memory");
    __syncthreads();
    if (threadIdx.x == 0) {
        unsigned* bar = b.bar;
        __builtin_amdgcn_s_waitcnt(0);
        unsigned nloc = b.st[0], nx = b.st[1];
        if (nloc == 0u) { xcd_barrier_complete(bar, b.x, nloc, nx); b.st[0] = nloc; b.st[1] = nx; }
        const unsigned old = xb_add(&bar[XB_XSUB(b.x)], 1u);
        const unsigned gen = old / nloc;
        if (old + 1u == (gen + 1u) * nloc) {
            __builtin_amdgcn_fence(__ATOMIC_RELEASE, "agent");
            asm volatile("s_waitcnt vmcnt(0)" ::: "memory");
            const unsigned og = xb_add(&bar[XB_TOP], 1u);
            const unsigned tg = og / nx;
            if (og + 1u == (tg + 1u) * nx) xb_add(&bar[XB_TOPGEN], 1u);
            else XB_SPIN(xb_ld(&bar[XB_TOPGEN]) == tg, bar);
            __builtin_amdgcn_fence(__ATOMIC_ACQUIRE, "agent");
            xb_add(&bar[XB_XGEN(b.x)], 1u);
            asm volatile("s_waitcnt vmcnt(0)" ::: "memory");
        } else {
            XB_SPIN(xb_ld(&bar[XB_XGEN(b.x)]) == gen, bar);
            __builtin_amdgcn_fence(__ATOMIC_ACQUIRE, "agent");
            asm volatile("s_waitcnt vmcnt(0)" ::: "memory");
        }
    }
    __syncthreads();
}


#ifdef NO_G0
#define XG0(x)
#else
#define XG0(x) x
#endif
#ifdef NO_G1
#define XG1(x)
#else
#define XG1(x) x
#endif
#ifdef NO_BC
#define XBC(x)
#else
#define XBC(x) x
#endif
#ifdef NO_AC
#define XAC(x)
#else
#define XAC(x) x
#endif
#ifdef NO_P0
#define XP0(x)
#else
#define XP0(x) x
#endif
#ifdef NO_R
#define XR(x)
#else
#define XR(x) x
#endif
#ifdef NO_BL
#define XBL(x)
#else
#define XBL(x) x
#endif
#ifdef NO_CL
#define XCL(x)
#else
#define XCL(x) x
#endif
#ifdef NO_A0
#define XA0(x)
#else
#define XA0(x) x
#endif
#ifdef NO_A1
#define XA1(x)
#else
#define XA1(x) x
#endif
#ifdef NO_BS
#define XBS(x)
#else
#define XBS(x) x
#endif
#ifdef NO_CS
#define XCS(x)
#else
#define XCS(x) x
#endif
__global__ void __launch_bounds__(256, 2) fwd_mega(P p) {
  extern __shared__ __attribute__((aligned(16))) char smem[];
  cg::grid_group grid = cg::this_grid();
  const int G = gridDim.x;
  __shared__ uint4 xb_words;
  if (threadIdx.x == 0) xb_words = make_uint4(0u, 0u, 0u, 0u);
  __syncthreads();
  XcdBarrier xb = xcd_barrier_post((unsigned*)(p.ws + O_BAR), (volatile LAS unsigned*)&xb_words);
  XP0(phase0(p, smem));
  grid.sync();
  u16* z = (u16*)(p.ws + O_Z);
  u16* zT = (u16*)(p.ws + O_ZT);
  float* ab = (float*)(p.ws + O_AB);
  float* o = (float*)(p.ws + O_BSH);
  const u16* u = (const u16*)(p.ws + O_BIT);
  for (int g = 0; g < NG; ++g) {
    XR(phaseR(p, g, 0));
    xcd_barrier(xb);
    for (int l = 0; l < DEPTH; ++l) {
      for (int rep = 0; rep < REP_G; ++rep) {
        const u16* Bt = (const u16*)(p.ws + O_WTIN) + (size_t)l * NZ * 1024;
        if ((G & 7) == 0) {
          const int x = blockIdx.x & 7, bl = blockIdx.x >> 3, nbl = G >> 3;
          for (int q = bl; q < 9 * 45; q += nbl) { XG0(gemm_tile<0>(u, 1024, Bt, 1024, 9 * x + q % 9, q / 9, z, zT, ab, o, smem)); }
        } else {
          for (int t = blockIdx.x; t < 72 * 45; t += G) { XG0(gemm_tile<0>(u, 1024, Bt, 1024, t % 72, t / 72, z, zT, ab, o, smem)); }
        }
      }
      xcd_barrier(xb);
      for (int rep2 = 0; rep2 < REP_M; ++rep2) {
      for (int rep3 = 0; rep3 < REP_A; ++rep3) {
        if (rep3) xcd_barrier(xb);
        const int nb = NCH * 4, nc = NCH * 4, na = NCH * 8;
        for (int t = blockIdx.x; t < nb + nc + na; t += G) {
          if (t < nc) { XCL(c_local2(p, l, t, smem)); }
          else if (t < nb + nc) { XBL(b_local(p, l, t - nc, smem)); }
          else { XA0(a_item(p, l, t - nb - nc, 0, smem)); }
        }
      }
      xcd_barrier(xb);
      {
        for (int t = blockIdx.x; t < 256 + 16; t += G) {
          if (t < 128) { XBS(b_seq2(p, t, smem)); }
          else if (t < 256) { XCS(c_seq2(p, t - 128, smem)); }
          else { XAC(a_carry(p, t - 256)); }
        }
      }
      xcd_barrier(xb);
      }
      {
        const int na = NCH * 8, nm = GR / 4;
        for (int t = blockIdx.x; t < na + nm; t += G) {
          if (t < na) { XA1(a_item(p, l, t, 1, smem)); }
          else { XBC(bc_merge(p, l, t - na)); }
        }
      }
      xcd_barrier(xb);
      for (int rep = 0; rep < REP_G; ++rep) {
        const u16* Bt = (const u16*)(p.ws + O_WTOUT) + (size_t)l * 1024 * 1536;
        for (int t = blockIdx.x; t < 72 * 8; t += G) { XG1(gemm_tile<1>(z + C_GA, NZ, Bt, 1536, t % 72, t / 72, z, zT, ab, o, smem)); }
      }
      xcd_barrier(xb);
      XR(phaseR(p, g, l + 1));
      xcd_barrier(xb);
    }
  }
}

extern "C" void kernel_launch(void* const* d_in, const int* in_sizes, int n_in, void* d_out, int out_size, void* d_ws,
                              size_t ws_size, hipStream_t stream) {
  static int grid_blocks = 0;
  if (!grid_blocks) {
    int dev = 0, cus = 0, per_cu = 0;
    hipGetDevice(&dev);
    hipDeviceGetAttribute(&cus, hipDeviceAttributeMultiprocessorCount, dev);
    hipFuncSetAttribute((const void*)fwd_mega, hipFuncAttributeMaxDynamicSharedMemorySize, LDS_BYTES);
    hipOccupancyMaxActiveBlocksPerMultiprocessor(&per_cu, fwd_mega, 256, LDS_BYTES);
    if (per_cu > 2) per_cu = 2;
    if (per_cu < 1) per_cu = 1;
    grid_blocks = cus * per_cu;
  }
  if (ws_size < WS_TOTAL) {
    fprintf(stderr, "workspace too small: %zu < %zu\n", ws_size, (size_t)WS_TOTAL);
    return;
  }
  P p{};
  const float** f = (const float**)&p;
  for (int i = 0; i < 23; ++i) f[i] = (const float*)d_in[i];
  p.out = (float*)d_out;
  p.ws = (char*)d_ws;
  hipMemsetAsync((char*)d_ws + O_BAR, 0, XCD_BAR_WORDS * 4, stream);
  void* args[] = {&p};
  hipError_t e = hipLaunchCooperativeKernel((void*)fwd_mega, dim3(grid_blocks), dim3(256), args, LDS_BYTES, stream);
  if (e != hipSuccess) fprintf(stderr, "cooperative launch failed: %s (grid %d)\n", hipGetErrorString(e), grid_blocks);
}
```

```cpp
#include <hip/hip_runtime.h>
#include <hip/hip_cooperative_groups.h>
#include <cstdio>
namespace cg = cooperative_groups;

typedef __attribute__((ext_vector_type(8))) short bf16x8;
typedef __attribute__((ext_vector_type(4))) float f32x4;
typedef unsigned short u16;
#define DEV __device__ __forceinline__

constexpr int DM = 1024, TL = 2048, TCX = 256, TS = 2304, GB = 4, GR = GB * TS, NG = 2;
constexpr int NZ = 5760, DEPTH = 4;
constexpr int C_XA = 0, C_Q = 512, C_K = 1024, C_V = 1536, C_QC = 2048, C_F0 = 2560, C_IC = 3584,
              C_GA = 4096, C_GB = 4608, C_GC = 5120, C_AB = 5632;
constexpr int NCH = GR / 64;
constexpr float EPS = 1e-6f;
constexpr int WPB = 2;

constexpr size_t al256(size_t x) { return (x + 255) & ~(size_t)255; }
constexpr size_t O_WTIN = 0;
constexpr size_t O_WTOUT = O_WTIN + al256((size_t)DEPTH * NZ * 1024 * 2);
constexpr size_t O_WGT = O_WTOUT + al256((size_t)DEPTH * 1024 * 1536 * 2);
constexpr size_t O_MOD = O_WGT + al256((size_t)DEPTH * 2 * 2 * 8 * 4096 * 2);
constexpr size_t O_LBS = O_MOD + al256((size_t)DEPTH * 9 * 3072 * 4);
constexpr size_t O_HC = O_LBS + al256((size_t)DEPTH * 1024 * 4);
constexpr size_t O_Z = O_HC + al256((size_t)GB * TCX * 1024 * 4);
constexpr size_t O_ZT = O_Z + al256((size_t)GR * NZ * 2);
constexpr size_t O_AB = O_ZT + al256((size_t)512 * GR * 2);
constexpr size_t O_BSH = O_AB + al256((size_t)GR * 16 * 4);
constexpr size_t BSH_ONE = (size_t)GR * 512 * 2;
constexpr size_t O_BIT = O_BSH + al256(4 * BSH_ONE);
constexpr size_t BIT_SZ = 17408;
constexpr size_t O_CREC = O_BIT + al256((size_t)NCH * 4 * 2 * BIT_SZ);
constexpr size_t CREC_SZ = 33280;
constexpr size_t O_OB = O_CREC + al256((size_t)NCH * 4 * 2 * CREC_SZ);
constexpr size_t O_OC = O_OB + al256((size_t)2 * GR * 512 * 2);
constexpr size_t O_AP = O_OC + al256((size_t)2 * GR * 512 * 2);
constexpr size_t O_AH = O_AP + al256((size_t)NCH * 2 * 512 * 4);
constexpr size_t O_ACAR = O_AH + al256((size_t)NCH * 2 * 512 * 4);
constexpr size_t O_ALA = O_ACAR + al256((size_t)NCH * 2 * 512 * 4);
constexpr size_t O_AU = O_ALA + al256((size_t)2 * GR * 512 * 2);
constexpr size_t O_BAR = O_AU + al256((size_t)2 * GR * 512 * 2);
constexpr size_t WS_TOTAL = O_BAR + al256(3456 * 4);

constexpr int LDS_BYTES = 73728;
#ifndef REP_A
#define REP_A 1
#endif
#ifndef REP_G
#define REP_G 1
#endif
#ifndef REP_M
#define REP_M 1
#endif

struct P {
  const float *x, *c, *ctx, *c_ctx, *w_ada, *b_ada, *norm_pre, *norm_post, *w_in, *conv_a_w, *conv_a_b, *rg_w_r,
      *rg_b_r, *rg_w_i, *rg_b_i, *rg_lam, *conv_b_w, *gdn_a_log, *gdn_dt_bias, *gdn_norm, *hg_lb, *hg_norm, *w_out;
  float* out;
  char* ws;
};

DEV int opq(int x) { asm volatile("" : "+v"(x)); return x; }
DEV int opqs(int x) { asm volatile("" : "+s"(x)); return x; }
typedef __attribute__((ext_vector_type(2))) __bf16 bf16x2_t;
typedef __attribute__((ext_vector_type(2))) float f32x2_t;
DEV u16 f2bf(float f) { __bf16 r = (__bf16)f; return __builtin_bit_cast(u16, r); }
DEV float bf2f(u16 h) { return __uint_as_float(((unsigned)h) << 16); }
DEV unsigned pk2(float a, float b) { f32x2_t v = {a, b}; bf16x2_t r = __builtin_convertvector(v, bf16x2_t); return __builtin_bit_cast(unsigned, r); }
DEV float sigm(float x) { return __builtin_amdgcn_rcpf(1.f + __expf(-x)); }
DEV float silu(float x) { return x * __builtin_amdgcn_rcpf(1.f + __expf(-x)); }
DEV float softplus(float x) { return x > 20.f ? x : log1pf(__expf(x)); }
DEV f32x4 mfma(bf16x8 a, bf16x8 b, f32x4 c) { return __builtin_amdgcn_mfma_f32_16x16x32_bf16(a, b, c, 0, 0, 0); }
DEV bf16x8 ld8(const u16* p) { return *reinterpret_cast<const bf16x8*>(p); }
DEV int lat_map(int l, int t) { return (l & 1) ? ((t & 63) * 32 + (t >> 6)) : t; }
DEV int orig_col(int n) {
  if (n < 512) return n;
  if (n < 2048) return n + 512;
  if (n < 4096) return n + 1040;
  if (n < 4608) return n - 4096 + 512;
  if (n < 5120) return n - 4608 + 2576;
  if (n < 5632) return n + 16;
  if (n < 5648) return n - 5632 + 2560;
  return -1;
}
DEV float zval(const u16* z, int rb, int cp, int n, int col) {
  if (cp < 0 && (n == 0 || n == 4)) return 0.f;
  if (cp > 63 && (n == 3 || n == 35)) return 0.f;
  return bf2f(z[(size_t)(rb + cp) * NZ + col]);
}

DEV void ph0_ada(const P& p, int item, char* smem) {
  float* sc = (float*)smem;
  float* red = (float*)(smem + 36864);
  const int tid = threadIdx.x, lane = tid & 63, wv = tid >> 6;
  for (int i = tid; i < 9 * 1024; i += 256) {
    int v = i >> 10, d = i & 1023;
    float cv = (v < 8) ? p.c[v * 1024 + d] : p.c_ctx[d];
    sc[i] = silu(cv);
  }
  __syncthreads();
  const int col = item * 64 + lane;
  const int l = col / 3072, e = col % 3072;
  const float* w = p.w_ada + (size_t)l * 1024 * 3072 + e + (size_t)(256 * wv) * 3072;
  const float* scw = sc + 256 * wv;
  float acc[9];
#pragma unroll
  for (int i = 0; i < 9; ++i) acc[i] = 0.f;
  for (int d = 0; d < 256; d += 16) {
    float wr[16];
#pragma unroll
    for (int k = 0; k < 16; ++k) wr[k] = w[(size_t)(d + k) * 3072];
#pragma unroll
    for (int k = 0; k < 16; ++k)
#pragma unroll
      for (int i = 0; i < 9; ++i) acc[i] += scw[i * 1024 + d + k] * wr[k];
  }
#pragma unroll
  for (int i = 0; i < 9; ++i) red[(wv * 9 + i) * 64 + lane] = acc[i];
  __syncthreads();
  float* mod = (float*)(p.ws + O_MOD);
  for (int idx = tid; idx < 9 * 64; idx += 256) {
    int i = idx >> 6, ln = idx & 63;
    float sum = red[(0 * 9 + i) * 64 + ln] + red[(1 * 9 + i) * 64 + ln] + red[(2 * 9 + i) * 64 + ln] + red[(3 * 9 + i) * 64 + ln];
    int cc = item * 64 + ln, l2 = cc / 3072, e2 = cc % 3072;
    mod[((size_t)l2 * 9 + i) * 3072 + e2] = sum + p.b_ada[l2 * 3072 + e2];
  }
  __syncthreads();
}
DEV void tconv_tile(const float* src, int lds_, u16* dst, int ldd, int k0, int n0, bool mapcol, char* smem) {
  float* t = (float*)smem;
  const int tid = threadIdx.x, nn = tid & 63, kq = tid >> 6;
  const int n = n0 + nn;
  const int sn0 = mapcol ? orig_col(n) : n;
  const float msk = (sn0 >= 0) ? 1.f : 0.f;
  const int sn = sn0 >= 0 ? sn0 : 0;
  float v[16];
#pragma unroll
  for (int k = 0; k < 16; ++k) v[k] = src[(size_t)(k0 + kq + 4 * k) * lds_ + sn];
#pragma unroll
  for (int k = 0; k < 16; ++k) t[(kq + 4 * k) * 65 + nn] = v[k] * msk;
  __syncthreads();
  {
    const int kk = tid & 63, nq = tid >> 6;
#pragma unroll
    for (int k = 0; k < 16; ++k) {
      int n2 = nq + 4 * k;
      dst[(size_t)(n0 + n2) * ldd + k0 + kk] = f2bf(t[kk * 65 + n2]);
    }
  }
  __syncthreads();
}
DEV void phase0(const P& p, char* smem) {
  const int n_ada = 192, n_in = DEPTH * 16 * 90, n_out = DEPTH * 24 * 16, n_g = 128, n_lb = 4;
  const int total = n_ada + n_in + n_out + n_g + n_lb;
  for (int it = blockIdx.x; it < total; it += gridDim.x) {
    int i = it;
    if (i < n_ada) { ph0_ada(p, i, smem); continue; }
    i -= n_ada;
    if (i < n_in) {
      int l = i / 1440, r = i % 1440, kt = r / 90, nt = r % 90;
      tconv_tile(p.w_in + (size_t)l * 1024 * 5648, 5648, (u16*)(p.ws + O_WTIN) + (size_t)l * NZ * 1024, 1024, kt * 64,
                 nt * 64, true, smem);
      continue;
    }
    i -= n_in;
    if (i < n_out) {
      int l = i / 384, r = i % 384, kt = r / 16, nt = r % 16;
      tconv_tile(p.w_out + (size_t)l * 1536 * 1024, 1024, (u16*)(p.ws + O_WTOUT) + (size_t)l * 1024 * 1536, 1536,
                 kt * 64, nt * 64, false, smem);
      continue;
    }
    i -= n_out;
    if (i < n_g) {
      int h = i & 7, gate = (i >> 3) & 1, dir = (i >> 4) & 1, l = i >> 5;
      const float* src = (gate ? p.rg_w_i : p.rg_w_r) + ((size_t)(l * 2 + dir) * 8 + h) * 4096;
      tconv_tile(src, 64, (u16*)(p.ws + O_WGT) + (size_t)i * 4096, 64, 0, 0, false, smem);
      continue;
    }
    i -= n_g;
    {
      int j = i * 256 + threadIdx.x;
      float v[4], mx = -1e30f;
      for (int l = 0; l < 4; ++l) { v[l] = p.hg_lb[l * 1024 + j]; mx = fmaxf(mx, v[l]); }
      float s = 0.f;
      for (int l = 0; l < 4; ++l) { v[l] = __expf(v[l] - mx); s += v[l]; }
      float* lbs = (float*)(p.ws + O_LBS);
      float cum = 0.f;
      for (int l = 0; l < 4; ++l) {
        if (l > 0) cum += v[l] / s;
        lbs[l * 1024 + j] = cum;
      }
    }
  }
}

DEV void phaseR(const P& p, int g, int l) {
  const int tid_ = opq(threadIdx.x); const int lane = tid_ & 63, w = tid_ >> 6;
  const float* mod = (const float*)(p.ws + O_MOD);
  float* hc = (float*)(p.ws + O_HC);
  const float* o = (const float*)(p.ws + O_BSH);
  u16* u = (u16*)(p.ws + O_BIT);
  for (int it = blockIdx.x; it < GR / 4; it += gridDim.x) {
    int lr = it * 4 + w;
    int lb = lr / TS, s = lr % TS;
    bool isctx = s < TCX;
    if (l == DEPTH && isctx) continue;
    int b = g * GB + lb, t = s - TCX;
    int mi = isctx ? 8 : b;
    float* hp = isctx ? hc + ((size_t)lb * TCX + s) * 1024 : p.out + ((size_t)b * TL + t) * 1024;
    float hv[16];
    if (l == 0) {
      const float* src = isctx ? p.ctx + ((size_t)b * TCX + s) * 1024 : p.x + ((size_t)b * TL + t) * 1024;
#pragma unroll
      for (int k = 0; k < 4; ++k) {
        float4 v = *(const float4*)(src + k * 256 + lane * 4);
        hv[k * 4] = v.x; hv[k * 4 + 1] = v.y; hv[k * 4 + 2] = v.z; hv[k * 4 + 3] = v.w;
      }
    } else {
      int orow = lb * TS + (isctx ? s : TCX + lat_map(l - 1, t));
      const float* op = o + (size_t)orow * 1024;
      float ov[16], ss = 0.f;
#pragma unroll
      for (int k = 0; k < 4; ++k) {
        float4 v = *(const float4*)(op + k * 256 + lane * 4);
        ov[k * 4] = v.x; ov[k * 4 + 1] = v.y; ov[k * 4 + 2] = v.z; ov[k * 4 + 3] = v.w;
        ss += v.x * v.x + v.y * v.y + v.z * v.z + v.w * v.w;
      }
#pragma unroll
      for (int off = 32; off; off >>= 1) ss += __shfl_xor(ss, off);
      float rinv = rsqrtf(ss * (1.f / 1024.f) + EPS);
      const float* gate = mod + ((size_t)(l - 1) * 9 + mi) * 3072 + 2048;
      const float* wp = p.norm_post + (l - 1) * 1024;
#pragma unroll
      for (int k = 0; k < 4; ++k) {
        float4 hh = *(const float4*)(hp + k * 256 + lane * 4);
        float4 gg = *(const float4*)(gate + k * 256 + lane * 4);
        float4 ww = *(const float4*)(wp + k * 256 + lane * 4);
        hv[k * 4] = hh.x + gg.x * (ov[k * 4] * rinv * ww.x);
        hv[k * 4 + 1] = hh.y + gg.y * (ov[k * 4 + 1] * rinv * ww.y);
        hv[k * 4 + 2] = hh.z + gg.z * (ov[k * 4 + 2] * rinv * ww.z);
        hv[k * 4 + 3] = hh.w + gg.w * (ov[k * 4 + 3] * rinv * ww.w);
      }
    }
#pragma unroll
    for (int k = 0; k < 4; ++k)
      *(float4*)(hp + k * 256 + lane * 4) = make_float4(hv[k * 4], hv[k * 4 + 1], hv[k * 4 + 2], hv[k * 4 + 3]);
    if (l < DEPTH) {
      float ss = 0.f;
#pragma unroll
      for (int k = 0; k < 16; ++k) ss += hv[k] * hv[k];
#pragma unroll
      for (int off = 32; off; off >>= 1) ss += __shfl_xor(ss, off);
      float rinv = rsqrtf(ss * (1.f / 1024.f) + EPS);
      const float* sh = mod + ((size_t)l * 9 + mi) * 3072;
      const float* wp = p.norm_pre + l * 1024;
      int urow = lb * TS + (isctx ? s : TCX + lat_map(l, t));
      u16* up = u + (size_t)urow * 1024;
#pragma unroll
      for (int k = 0; k < 4; ++k) {
        float4 ww = *(const float4*)(wp + k * 256 + lane * 4);
        float4 s0 = *(const float4*)(sh + k * 256 + lane * 4);
        float4 s1 = *(const float4*)(sh + 1024 + k * 256 + lane * 4);
        float a0 = hv[k * 4] * rinv * ww.x * (1.f + s1.x) + s0.x;
        float a1 = hv[k * 4 + 1] * rinv * ww.y * (1.f + s1.y) + s0.y;
        float a2 = hv[k * 4 + 2] * rinv * ww.z * (1.f + s1.z) + s0.z;
        float a3 = hv[k * 4 + 3] * rinv * ww.w * (1.f + s1.w) + s0.w;
        uint2 pk; pk.x = pk2(a0, a1); pk.y = pk2(a2, a3);
        *(uint2*)(up + k * 256 + lane * 4) = pk;
      }
    }
  }
}

template <int MODE>
DEV void gemm_tile(const u16* __restrict__ A, int lda, const u16* __restrict__ Bt, int K, int rt, int ct, u16* z,
                   u16* zT, float* ab, float* o, char* smem) {
  u16* As = (u16*)smem;
  u16* Bs = As + 128 * 72;
  const int tid = opq(threadIdx.x), lane = tid & 63, w = tid >> 6, wr = w >> 1, wc = w & 1, fr = lane & 15, fq = lane >> 4;
  const int lrow = tid >> 3, lseg = tid & 7;
  const u16* Ag = A + (size_t)(rt * 128 + lrow) * lda + lseg * 8;
  const u16* Bg = Bt + (size_t)(ct * 128 + lrow) * K + lseg * 8;
  uint4 ra0, ra1, ra2, ra3, rb0, rb1, rb2, rb3;
  f32x4 acc[4][4];
#pragma unroll
  for (int i = 0; i < 4; ++i)
#pragma unroll
    for (int j = 0; j < 4; ++j) acc[i][j] = (f32x4){0.f, 0.f, 0.f, 0.f};
#define GLOAD()                                             \
  ra0 = *(const uint4*)(Ag);                                \
  ra1 = *(const uint4*)(Ag + (size_t)32 * lda);             \
  ra2 = *(const uint4*)(Ag + (size_t)64 * lda);             \
  ra3 = *(const uint4*)(Ag + (size_t)96 * lda);             \
  rb0 = *(const uint4*)(Bg);                                \
  rb1 = *(const uint4*)(Bg + (size_t)32 * K);               \
  rb2 = *(const uint4*)(Bg + (size_t)64 * K);               \
  rb3 = *(const uint4*)(Bg + (size_t)96 * K);
  GLOAD();
  const int nk = K / 64;
#define GSTORE(bufo)                                                      \
  *(uint4*)(As + (bufo) + (lrow)*72 + lseg * 8) = ra0;                    \
  *(uint4*)(As + (bufo) + (lrow + 32) * 72 + lseg * 8) = ra1;             \
  *(uint4*)(As + (bufo) + (lrow + 64) * 72 + lseg * 8) = ra2;             \
  *(uint4*)(As + (bufo) + (lrow + 96) * 72 + lseg * 8) = ra3;             \
  *(uint4*)(Bs + (bufo) + (lrow)*72 + lseg * 8) = rb0;                    \
  *(uint4*)(Bs + (bufo) + (lrow + 32) * 72 + lseg * 8) = rb1;             \
  *(uint4*)(Bs + (bufo) + (lrow + 64) * 72 + lseg * 8) = rb2;             \
  *(uint4*)(Bs + (bufo) + (lrow + 96) * 72 + lseg * 8) = rb3;
  GSTORE(0)
  __syncthreads();
  for (int kt = 0; kt < nk; ++kt) {
    const int cb = (kt & 1) * (2 * 128 * 72);
    if (kt + 1 < nk) {
      Ag += 64; Bg += 64;
      GLOAD();
    }
#pragma unroll
    for (int ks = 0; ks < 2; ++ks) {
      bf16x8 af[4], bfr[4];
#pragma unroll
      for (int mi = 0; mi < 4; ++mi) af[mi] = ld8(As + cb + (wr * 64 + mi * 16 + fr) * 72 + ks * 32 + fq * 8);
#pragma unroll
      for (int ni = 0; ni < 4; ++ni) bfr[ni] = ld8(Bs + cb + (wc * 64 + ni * 16 + fr) * 72 + ks * 32 + fq * 8);
#pragma unroll
      for (int mi = 0; mi < 4; ++mi)
#pragma unroll
        for (int ni = 0; ni < 4; ++ni) acc[mi][ni] = mfma(af[mi], bfr[ni], acc[mi][ni]);
    }
    if (kt + 1 < nk) {
      const int nb_ = ((kt + 1) & 1) * (2 * 128 * 72);
      GSTORE(nb_)
    }
    __syncthreads();
  }
#pragma unroll
  for (int mi = 0; mi < 4; ++mi)
#pragma unroll
    for (int ni = 0; ni < 4; ++ni) {
      int row0 = rt * 128 + wr * 64 + mi * 16 + fq * 4;
      int col = ct * 128 + wc * 64 + ni * 16 + fr;
      f32x4 v = acc[mi][ni];
      if (MODE == 1) {
#pragma unroll
        for (int r = 0; r < 4; ++r) o[(size_t)(row0 + r) * 1024 + col] = v[r];
      } else {
        if (ct >= 28 && ct < 32) {
          uint2 pk; pk.x = pk2(v[0], v[1]); pk.y = pk2(v[2], v[3]);
          *(uint2*)(zT + (size_t)(col - C_IC) * GR + row0) = pk;
        } else if (ct == 44) {
          if (col - C_AB < 16) {
#pragma unroll
            for (int r = 0; r < 4; ++r) ab[(size_t)(row0 + r) * 16 + (col - C_AB)] = v[r];
          }
        } else {
#pragma unroll
          for (int r = 0; r < 4; ++r) z[(size_t)(row0 + r) * NZ + col] = f2bf(v[r]);
        }
      }
    }
}

DEV void a_item(const P& p, int l, int item, int mode, char* smem) {
  float* xc = (float*)smem;
  u16* xcb = (u16*)(smem + 16384);
  float* av = (float*)(smem + 16384 + 9216);
  float* uv = av + 4096;
  float* segP = uv + 4096;
  float* segH = segP + 256;
  const int tid = opq(threadIdx.x), lane = tid & 63, w = tid >> 6, fr = lane & 15, fq = lane >> 4;
  const int cgk = item >> 3, hA = item & 7, n = cgk % 36, rb = cgk * 64;
  u16* z = (u16*)(p.ws + O_Z);
  for (int idx = tid; idx < 4096; idx += 256) {
    int c = idx >> 6, j = idx & 63, ch = hA * 64 + j;
    float val = p.conv_a_b[l * 512 + ch];
#pragma unroll
    for (int tap = 0; tap < 4; ++tap) val += p.conv_a_w[(l * 4 + tap) * 512 + ch] * zval(z, rb, c + tap - 2, n, C_XA + ch);
    xc[idx] = val;
    xcb[c * 72 + j] = f2bf(val);
  }
  __syncthreads();
  float yacc[16];
#pragma unroll
  for (int k = 0; k < 16; ++k) yacc[k] = 0.f;
  const int seg = tid >> 6, sj = tid & 63, sch = hA * 64 + sj;
  for (int dir = 0; dir < 2; ++dir) {
    {
      const u16* wg = (const u16*)(p.ws + O_WGT);
      const u16* wr_ = wg + (size_t)((((l * 2 + dir) * 2 + 0) * 8 + hA)) * 4096;
      const u16* wi_ = wg + (size_t)((((l * 2 + dir) * 2 + 1) * 8 + hA)) * 4096;
      bf16x8 a0 = ld8(xcb + (16 * w + fr) * 72 + fq * 8), a1 = ld8(xcb + (16 * w + fr) * 72 + 32 + fq * 8);
#pragma unroll
      for (int nt = 0; nt < 4; ++nt) {
        f32x4 ar = {0.f, 0.f, 0.f, 0.f}, ai = {0.f, 0.f, 0.f, 0.f};
        const u16* br = wr_ + (nt * 16 + fr) * 64 + fq * 8;
        const u16* bi = wi_ + (nt * 16 + fr) * 64 + fq * 8;
        ar = mfma(a0, ld8(br), ar); ar = mfma(a1, ld8(br + 32), ar);
        ai = mfma(a0, ld8(bi), ai); ai = mfma(a1, ld8(bi + 32), ai);
        int j = nt * 16 + fr, ch = hA * 64 + j;
        float brv = p.rg_b_r[(l * 2 + dir) * 512 + ch], biv = p.rg_b_i[(l * 2 + dir) * 512 + ch];
        float sp = softplus(-p.rg_lam[(l * 2 + dir) * 512 + ch]);
#pragma unroll
        for (int r = 0; r < 4; ++r) {
          int c = 16 * w + 4 * fq + r;
          float rg = sigm(ar[r] + brv), ig = sigm(ai[r] + biv);
          float la = -8.f * rg * sp;
          float a = __expf(la);
          float t2 = 2.f * la;
          float om = (t2 > -0.02f) ? -t2 * (1.f + 0.5f * t2 * (1.f + t2 * (1.f / 3.f) * (1.f + 0.25f * t2))) : 1.f - a * a;
          float uu = sqrtf(fmaxf(om, 0.f)) * (ig * xc[c * 64 + j]);
          av[c * 64 + j] = bf2f(f2bf(la));
          uv[c * 64 + j] = bf2f(f2bf(uu));
        }
      }
    }
    __syncthreads();
    {
      float ls = 0.f, H = 0.f;
      u16* ALA = (u16*)(p.ws + O_ALA);
      u16* AU = (u16*)(p.ws + O_AU);
#pragma unroll
      for (int k = 0; k < 16; ++k) {
        int c = dir ? (16 * seg + 15 - k) : (16 * seg + k);
        float la_ = av[c * 64 + sj], u_ = uv[c * 64 + sj];
        H = __expf(la_) * H + u_;
        ls += la_;
        size_t gi = ((size_t)dir * GR + rb + c) * 512 + sch;
        ALA[gi] = f2bf(la_);
        AU[gi] = f2bf(u_);
      }
      segP[seg * 64 + sj] = __expf(ls);
      segH[seg * 64 + sj] = H;
    }
    __syncthreads();
    if (mode == 0) {
      if (seg == 0) {
        float Pc = 1.f, Hc = 0.f;
        for (int q = 0; q < 4; ++q) {
          int sg = dir ? 3 - q : q;
          Hc = segP[sg * 64 + sj] * Hc + segH[sg * 64 + sj];
          Pc *= segP[sg * 64 + sj];
        }
        size_t idx = ((size_t)cgk * 2 + dir) * 512 + sch;
        ((float*)(p.ws + O_AP))[idx] = Pc;
        ((float*)(p.ws + O_AH))[idx] = Hc;
      }
    } else {
      float st = ((const float*)(p.ws + O_ACAR))[((size_t)cgk * 2 + dir) * 512 + sch];
      int nbefore = dir ? 3 - seg : seg;
      for (int q = 0; q < nbefore; ++q) {
        int sg = dir ? 3 - q : q;
        st = segP[sg * 64 + sj] * st + segH[sg * 64 + sj];
      }
      if (dir == 0) {
#pragma unroll
        for (int k = 0; k < 16; ++k) {
          int c = 16 * seg + k;
          st = av[c * 64 + sj] * st + uv[c * 64 + sj];
          yacc[k] += st;
        }
      } else {
#pragma unroll
        for (int k = 15; k >= 0; --k) {
          int c = 16 * seg + k;
          st = av[c * 64 + sj] * st + uv[c * 64 + sj];
          yacc[k] += st;
        }
      }
    }
    __syncthreads();
  }
  if (mode == 1) {
#pragma unroll
    for (int k = 0; k < 16; ++k) {
      size_t zi = (size_t)(rb + 16 * seg + k) * NZ + C_GA + sch;
      float gate = bf2f(z[zi]);
      z[zi] = f2bf(yacc[k] * silu(gate));
    }
  }
}

DEV void a_fin(const P& p, int l, int item, char* smem) {
  float* segP = (float*)smem;
  float* segH = segP + 512;
  const int tid = opq(threadIdx.x), seg = tid >> 6, sj = tid & 63;
  const int cgk = item >> 3, hA = item & 7, rb = cgk * 64, sch = hA * 64 + sj;
  u16* z = (u16*)(p.ws + O_Z);
  const u16* ALA = (const u16*)(p.ws + O_ALA);
  const u16* AU = (const u16*)(p.ws + O_AU);
  u16 lab[2][16], ub[2][16], gt[16];
#pragma unroll
  for (int dir = 0; dir < 2; ++dir)
#pragma unroll
    for (int k = 0; k < 16; ++k) {
      size_t gi = ((size_t)dir * GR + rb + 16 * seg + k) * 512 + sch;
      lab[dir][k] = ALA[gi];
      ub[dir][k] = AU[gi];
    }
#pragma unroll
  for (int k = 0; k < 16; ++k) gt[k] = z[(size_t)(rb + 16 * seg + k) * NZ + C_GA + sch];
  float car0 = ((const float*)(p.ws + O_ACAR))[((size_t)cgk * 2 + 0) * 512 + sch];
  float car1 = ((const float*)(p.ws + O_ACAR))[((size_t)cgk * 2 + 1) * 512 + sch];
  float af[2][16];
#pragma unroll
  for (int dir = 0; dir < 2; ++dir) {
    float ls = 0.f, H = 0.f;
#pragma unroll
    for (int kk = 0; kk < 16; ++kk) {
      const int k = dir ? 15 - kk : kk;
      float la_ = bf2f(lab[dir][k]);
      float a = __expf(la_);
      af[dir][k] = a;
      H = a * H + bf2f(ub[dir][k]);
      ls += la_;
    }
    segP[(dir * 4 + seg) * 64 + sj] = __expf(ls);
    segH[(dir * 4 + seg) * 64 + sj] = H;
  }
  __syncthreads();
  float yacc[16];
#pragma unroll
  for (int k = 0; k < 16; ++k) yacc[k] = 0.f;
#pragma unroll
  for (int dir = 0; dir < 2; ++dir) {
    float st = dir ? car1 : car0;
    const int nbefore = dir ? 3 - seg : seg;
    for (int q = 0; q < nbefore; ++q) {
      int sg = dir ? 3 - q : q;
      st = segP[(dir * 4 + sg) * 64 + sj] * st + segH[(dir * 4 + sg) * 64 + sj];
    }
#pragma unroll
    for (int kk = 0; kk < 16; ++kk) {
      const int k = dir ? 15 - kk : kk;
      st = af[dir][k] * st + bf2f(ub[dir][k]);
      yacc[k] += st;
    }
  }
#pragma unroll
  for (int k = 0; k < 16; ++k)
    z[(size_t)(rb + 16 * seg + k) * NZ + C_GA + sch] = f2bf(yacc[k] * silu(bf2f(gt[k])));
  __syncthreads();
}

DEV void a_carry(const P& p, int item) {
  int t = item * 256 + threadIdx.x;
  int ch = t & 511, dir = (t >> 9) & 1, lb = t >> 10;
  const float* AP = (const float*)(p.ws + O_AP);
  const float* AH = (const float*)(p.ws + O_AH);
  float* AC = (float*)(p.ws + O_ACAR);
  float st = 0.f;
  for (int j = 0; j < 36; ++j) {
    int n = dir ? (j < 4 ? 3 - j : 39 - j) : j;
    size_t idx = ((size_t)(lb * 36 + n) * 2 + dir) * 512 + ch;
    AC[idx] = st;
    st = AP[idx] * st + AH[idx];
  }
}

DEV void b_local(const P& p, int l, int item, char* smem) {
  u16* qs = (u16*)smem;
  u16* ks = qs + 64 * 136;
  float* Am = (float*)(smem + 34816);
  float* gc = (float*)(smem + 34816 + 32768);
  float* bt = gc + 128;
  const int tid = opq(threadIdx.x), lane = tid & 63, w = tid >> 6, fr = lane & 15, fq = lane >> 4;
  const int cgk = item >> 2, h = item & 3, n = cgk % 36, rb = cgk * 64;
  const u16* z = (const u16*)(p.ws + O_Z);
  u16* qn = (u16*)(p.ws + O_BSH);
  u16* kn = qn + (size_t)GR * 512;
  u16* vb = kn + (size_t)GR * 512;
  u16* knT = vb + (size_t)GR * 512;
  const float* ab = (const float*)(p.ws + O_AB);
  {
    u16* Tt = (u16*)Am;
    uint4 st[5];
#define BL_TLOAD(which)                                                                                  \
  _Pragma("unroll") for (int k = 0; k < 5; ++k) {                                                        \
    int idx = tid + 256 * k, row = idx >> 4, seg = idx & 15, cp = row - 2;                               \
    bool ok = (idx < 1072) && !((cp < 0 && (n == 0 || n == 4)) || (cp > 63 && (n == 3 || n == 35)));    \
    st[k] = make_uint4(0u, 0u, 0u, 0u);                                                                  \
    if (ok) st[k] = *(const uint4*)(z + (size_t)(rb + cp) * NZ + C_Q + (which)*512 + h * 128 + seg * 8); \
  }
    BL_TLOAD(0)
#pragma unroll
    for (int which = 0; which < 3; ++which) {
#pragma unroll
      for (int k = 0; k < 5; ++k) {
        int idx = tid + 256 * k, row = idx >> 4, seg = idx & 15;
        if (idx < 1072) *(uint4*)(Tt + row * 136 + seg * 8) = st[k];
      }
      __syncthreads();
      if (which < 2) { BL_TLOAD(which + 1) }
      float cw[2][4];
#pragma unroll
      for (int hh = 0; hh < 2; ++hh)
#pragma unroll
        for (int tap = 0; tap < 4; ++tap)
          cw[hh][tap] = p.conv_b_w[(size_t)(l * 4 + tap) * 1536 + which * 512 + h * 128 + lane + 64 * hh];
      for (int c = w; c < 64; c += 4) {
        float v[2];
#pragma unroll
        for (int hh = 0; hh < 2; ++hh) {
          int d = lane + 64 * hh;
          float a = 0.f;
#pragma unroll
          for (int tap = 0; tap < 4; ++tap) a += cw[hh][tap] * bf2f(Tt[(c + tap) * 136 + d]);
          v[hh] = silu(a);
        }
        float rs = 1.f;
        if (which < 2) {
          float sq = v[0] * v[0] + v[1] * v[1];
#pragma unroll
          for (int off = 32; off; off >>= 1) sq += __shfl_xor(sq, off);
          rs = rsqrtf(sq + EPS) * (which == 0 ? 0.08838834764831845f : 1.f);
        }
#pragma unroll
        for (int hh = 0; hh < 2; ++hh) {
          int d = lane + 64 * hh;
          u16 ob = f2bf(v[hh] * rs);
          size_t gi = (size_t)(rb + c) * 512 + h * 128 + d;
          if (which == 0) { qs[c * 136 + d] = ob; qn[gi] = ob; }
          else if (which == 1) { ks[c * 136 + d] = ob; kn[gi] = ob; }
          else vb[gi] = ob;
        }
      }
      __syncthreads();
    }
  }
  if (w < 2) {
    int dir = w, i = lane, c = dir ? 63 - i : i;
    float al = ab[(size_t)(rb + c) * 16 + dir * 4 + h], bl = ab[(size_t)(rb + c) * 16 + 8 + dir * 4 + h];
    float g = -__expf(p.gdn_a_log[(l * 2 + dir) * 4 + h]) * softplus(al + p.gdn_dt_bias[(l * 2 + dir) * 4 + h]);
#pragma unroll
    for (int off = 1; off < 64; off <<= 1) {
      float v = __shfl_up(g, off);
      if (lane >= off) g += v;
    }
    gc[dir * 64 + i] = g;
    bt[dir * 64 + i] = sigm(bl);
  }
  __syncthreads();
  for (int idx = tid; idx < 1024; idx += 256) {
    int d = idx >> 3, c8 = idx & 7;
    uint4 pk;
    pk.x = (unsigned)ks[(c8 * 8 + 0) * 136 + d] | ((unsigned)ks[(c8 * 8 + 1) * 136 + d] << 16);
    pk.y = (unsigned)ks[(c8 * 8 + 2) * 136 + d] | ((unsigned)ks[(c8 * 8 + 3) * 136 + d] << 16);
    pk.z = (unsigned)ks[(c8 * 8 + 4) * 136 + d] | ((unsigned)ks[(c8 * 8 + 5) * 136 + d] << 16);
    pk.w = (unsigned)ks[(c8 * 8 + 6) * 136 + d] | ((unsigned)ks[(c8 * 8 + 7) * 136 + d] << 16);
    *(uint4*)(knT + ((size_t)(cgk * 4 + h) * 128 + d) * 64 + c8 * 8) = pk;
  }
  for (int dir = 0; dir < 2; ++dir) {
    char* rec = p.ws + O_BIT + ((size_t)(cgk * 4 + h) * 2 + dir) * BIT_SZ;
    u16* QKm = (u16*)rec + 4096;
    float* scal = (float*)(rec + 16384);
    int irow = 16 * w + fr, ci = dir ? 63 - irow : irow;
    bf16x8 ak[4], aq[4];
#pragma unroll
    for (int s = 0; s < 4; ++s) { ak[s] = ld8(ks + ci * 136 + 32 * s + 8 * fq); aq[s] = ld8(qs + ci * 136 + 32 * s + 8 * fq); }
#pragma unroll
    for (int nt = 0; nt < 4; ++nt) {
      int jcol = 16 * nt + fr, cj = dir ? 63 - jcol : jcol;
      f32x4 kk = {0.f, 0.f, 0.f, 0.f}, qk = {0.f, 0.f, 0.f, 0.f};
#pragma unroll
      for (int s = 0; s < 4; ++s) {
        bf16x8 b = ld8(ks + cj * 136 + 32 * s + 8 * fq);
        kk = mfma(ak[s], b, kk);
        qk = mfma(aq[s], b, qk);
      }
      float gj = gc[dir * 64 + jcol];
#pragma unroll
      for (int r = 0; r < 4; ++r) {
        int i = 16 * w + 4 * fq + r;
        float dec = (jcol <= i) ? __expf(gc[dir * 64 + i] - gj) : 0.f;
        Am[(dir * 64 + i) * 64 + jcol] = (jcol < i) ? bt[dir * 64 + i] * kk[r] * dec : 0.f;
        QKm[i * 64 + jcol] = f2bf(qk[r] * dec);
      }
    }
    if (tid < 64) {
      float gl = gc[dir * 64 + 63], gi = gc[dir * 64 + tid];
      scal[tid] = __expf(gi);
      scal[64 + tid] = bt[dir * 64 + tid];
      scal[128 + tid] = __expf(gl - gi);
      if (tid == 0) scal[192] = __expf(gl);
    }
  }
  __syncthreads();
  if (w < 2) {
    int dir = w, col = lane;
    u16* Tinv = (u16*)(p.ws + O_BIT + ((size_t)(cgk * 4 + h) * 2 + dir) * BIT_SZ);
    const float* Ad = Am + dir * 4096;
    float T[64];
#pragma unroll
    for (int i = 0; i < 64; ++i) {
      float s = (i == col) ? 1.f : 0.f;
#pragma unroll
      for (int j = 0; j < i; ++j) s -= Ad[i * 64 + j] * T[j];
      T[i] = s;
      Tinv[i * 64 + col] = f2bf(s);
      __builtin_amdgcn_sched_barrier(0);
    }
  }
  __syncthreads();
}

DEV void b_seq(const P& p, int bitem, char* smem) {
  const int tid = opq(threadIdx.x), lane = tid & 63, w = tid >> 6, fr = lane & 15, fq = lane >> 4;
  const bool active = w < WPB;
  const int item = bitem * WPB + (active ? w : 0);
  const int slice = item & 7, dir = (item >> 3) & 1, h = (item >> 4) & 3, lb = item >> 6, e0 = slice * 16;
  u16* Ss = (u16*)(smem + w * 11264);
  u16* Rs = Ss + 16 * 136;
  u16* Vsc = Rs + 16 * 72;
  u16* Vor = Vsc + 16 * 72;
  const u16* qn = (const u16*)(p.ws + O_BSH);
  const u16* kn = qn + (size_t)GR * 512;
  const u16* vb = kn + (size_t)GR * 512;
  const u16* knT = vb + (size_t)GR * 512;
  u16* OB = (u16*)(p.ws + O_OB);
  f32x4 S[8];
#pragma unroll
  for (int m = 0; m < 8; ++m) S[m] = (f32x4){0.f, 0.f, 0.f, 0.f};
  for (int j = 0; j < 36; ++j) {
    const int n = dir ? (j < 4 ? 3 - j : 39 - j) : j;
    const int cgk = lb * 36 + n, rb = cgk * 64;
    const char* rec = p.ws + O_BIT + ((size_t)(cgk * 4 + h) * 2 + dir) * BIT_SZ;
    const u16* Tinv = (const u16*)rec;
    const u16* QKm = Tinv + 4096;
    const float* scal = (const float*)(rec + 16384);
    if (active) {
#pragma unroll
      for (int m = 0; m < 8; ++m) {
        uint2 pk; pk.x = pk2(S[m][0], S[m][1]); pk.y = pk2(S[m][2], S[m][3]);
        *(uint2*)(Ss + fr * 136 + 16 * m + 4 * fq) = pk;
      }
    }
    __syncthreads();
    bf16x8 Sf[4];
    if (active) {
#pragma unroll
      for (int s = 0; s < 4; ++s) Sf[s] = ld8(Ss + fr * 136 + 32 * s + 8 * fq);
#pragma unroll
      for (int m = 0; m < 4; ++m) {
        int i = 16 * m + fr, rowi = rb + (dir ? 63 - i : i);
        f32x4 X = {0.f, 0.f, 0.f, 0.f};
#pragma unroll
        for (int s = 0; s < 4; ++s) X = mfma(ld8(kn + (size_t)rowi * 512 + h * 128 + 32 * s + 8 * fq), Sf[s], X);
        float rv[4];
#pragma unroll
        for (int r = 0; r < 4; ++r) {
          int ii = 16 * m + 4 * fq + r, rowr = rb + (dir ? 63 - ii : ii);
          float v = bf2f(vb[(size_t)rowr * 512 + h * 128 + e0 + fr]);
          rv[r] = scal[64 + ii] * (v - scal[ii] * X[r]);
        }
        uint2 pk; pk.x = pk2(rv[0], rv[1]); pk.y = pk2(rv[2], rv[3]);
        *(uint2*)(Rs + fr * 72 + 16 * m + 4 * fq) = pk;
      }
    }
    __syncthreads();
    if (active) {
      bf16x8 Rf0 = ld8(Rs + fr * 72 + 8 * fq), Rf1 = ld8(Rs + fr * 72 + 32 + 8 * fq);
#pragma unroll
      for (int m = 0; m < 4; ++m) {
        f32x4 VN = {0.f, 0.f, 0.f, 0.f};
        VN = mfma(ld8(Tinv + (16 * m + fr) * 64 + 8 * fq), Rf0, VN);
        VN = mfma(ld8(Tinv + (16 * m + fr) * 64 + 32 + 8 * fq), Rf1, VN);
        uint2 pk; pk.x = pk2(VN[0], VN[1]); pk.y = pk2(VN[2], VN[3]);
        *(uint2*)(Vsc + fr * 72 + 16 * m + 4 * fq) = pk;
        int ib = 16 * m + 4 * fq;
        float s0 = VN[0] * scal[128 + ib], s1 = VN[1] * scal[128 + ib + 1], s2 = VN[2] * scal[128 + ib + 2],
              s3 = VN[3] * scal[128 + ib + 3];
        if (dir) {
          pk.x = pk2(s3, s2); pk.y = pk2(s1, s0);
          *(uint2*)(Vor + fr * 72 + (60 - ib)) = pk;
        } else {
          pk.x = pk2(s0, s1); pk.y = pk2(s2, s3);
          *(uint2*)(Vor + fr * 72 + ib) = pk;
        }
      }
    }
    __syncthreads();
    if (active) {
      bf16x8 Vs0 = ld8(Vsc + fr * 72 + 8 * fq), Vs1 = ld8(Vsc + fr * 72 + 32 + 8 * fq);
      bf16x8 Vo0 = ld8(Vor + fr * 72 + 8 * fq), Vo1 = ld8(Vor + fr * 72 + 32 + 8 * fq);
#pragma unroll
      for (int m = 0; m < 4; ++m) {
        int i = 16 * m + fr, rowi = rb + (dir ? 63 - i : i);
        f32x4 O = {0.f, 0.f, 0.f, 0.f};
#pragma unroll
        for (int s = 0; s < 4; ++s) O = mfma(ld8(qn + (size_t)rowi * 512 + h * 128 + 32 * s + 8 * fq), Sf[s], O);
#pragma unroll
        for (int r = 0; r < 4; ++r) O[r] *= scal[16 * m + 4 * fq + r];
        O = mfma(ld8(QKm + (16 * m + fr) * 64 + 8 * fq), Vs0, O);
        O = mfma(ld8(QKm + (16 * m + fr) * 64 + 32 + 8 * fq), Vs1, O);
#pragma unroll
        for (int r = 0; r < 4; ++r) {
          int ii = 16 * m + 4 * fq + r, rowr = rb + (dir ? 63 - ii : ii);
          OB[((size_t)dir * GR + rowr) * 512 + h * 128 + e0 + fr] = f2bf(O[r]);
        }
      }
      float egl = scal[192];
#pragma unroll
      for (int m = 0; m < 8; ++m) {
        const u16* kt = knT + ((size_t)(cgk * 4 + h) * 128 + 16 * m + fr) * 64;
        f32x4 t = S[m];
#pragma unroll
        for (int r = 0; r < 4; ++r) t[r] *= egl;
        t = mfma(ld8(kt + 8 * fq), Vo0, t);
        t = mfma(ld8(kt + 32 + 8 * fq), Vo1, t);
        S[m] = t;
      }
    }
  }
  __syncthreads();
}

DEV void c_local(const P& p, int l, int item, char* smem) {
  float* bsm = (float*)smem;
  u16* Ps = (u16*)(smem + 33024);
  u16* kdt = (u16*)(smem + 33024 + 9216);
  const int tid = opq(threadIdx.x), lane = tid & 63, w = tid >> 6, fr = lane & 15, fq = lane >> 4;
  const int cgk = item >> 2, h = item & 3, rb = cgk * 64;
  const u16* z = (const u16*)(p.ws + O_Z);
  const u16* zT = (const u16*)(p.ws + O_ZT);
  u16* OC = (u16*)(p.ws + O_OC);
  const float* lbs = (const float*)(p.ws + O_LBS);
  for (int dir = 0; dir < 2; ++dir) {
    char* rec = p.ws + O_CREC + ((size_t)(cgk * 4 + h) * 2 + dir) * CREC_SZ;
    u16* QD = (u16*)rec;
    u16* KDT = QD + 8192;
    float* decv = (float*)(rec + 32768);
    const float* lbp = lbs + l * 1024 + dir * 512 + h * 128;
    const int fcol = C_F0 + dir * 512 + h * 128;
    {
      int d = tid & 127, half = tid >> 7;
      float lb_ = lbp[d], run = 0.f;
      for (int k = 0; k < 32; ++k) {
        int i = 32 * half + k, c = dir ? 63 - i : i;
        float f = bf2f(z[(size_t)(rb + c) * NZ + fcol + d]);
        float fg = lb_ + (1.f - lb_) * sigm(f);
        run += __logf(fg);
        bsm[i * 129 + d] = run;
      }
    }
    __syncthreads();
    {
      int d = tid & 127, half = tid >> 7;
      if (half) {
        float add = bsm[31 * 129 + d];
        for (int k = 0; k < 32; ++k) bsm[(32 + k) * 129 + d] += add;
      }
    }
    __syncthreads();
    for (int idx = tid; idx < 8192; idx += 256) {
      int i = idx >> 7, d = idx & 127, c = dir ? 63 - i : i;
      float b = bsm[i * 129 + d];
      float q = silu(bf2f(z[(size_t)(rb + c) * NZ + C_QC + h * 128 + d]));
      QD[i * 128 + d] = f2bf(q * __expf(b));
      float f = bf2f(z[(size_t)(rb + c) * NZ + fcol + d]);
      float k = (1.f - lbp[d]) * sigm(-f);
      kdt[d * 72 + c] = f2bf(k * __expf(bsm[63 * 129 + d] - b));
    }
    if (tid < 128) decv[tid] = __expf(bsm[63 * 129 + tid]);
    __syncthreads();
    for (int idx = tid; idx < 1024; idx += 256) {
      int d = idx >> 3, c8 = idx & 7;
      *(uint4*)(KDT + d * 64 + c8 * 8) = *(const uint4*)(kdt + d * 72 + c8 * 8);
    }
    {
      const int sj = w;
      for (int si = 0; si < 4; ++si) {
        f32x4 acc = {0.f, 0.f, 0.f, 0.f};
        if (si >= sj) {
          int it = 16 * si + fr, jt = 16 * sj + fr;
          int ci = dir ? 63 - it : it, cj = dir ? 63 - jt : jt;
#pragma unroll
          for (int s = 0; s < 4; ++s) {
            int d0 = 32 * s + 8 * fq;
            bf16x8 qv = ld8(z + (size_t)(rb + ci) * NZ + C_QC + h * 128 + d0);
            bf16x8 fv = ld8(z + (size_t)(rb + cj) * NZ + fcol + d0);
            bf16x8 af, bf;
#pragma unroll
            for (int e = 0; e < 8; ++e) {
              int d = d0 + e;
              float Bs_ = si ? bsm[(16 * si - 1) * 129 + d] : 0.f;
              float qq = silu(bf2f((u16)qv[e])) * __expf(bsm[it * 129 + d] - Bs_);
              float kk = (1.f - lbp[d]) * sigm(-bf2f((u16)fv[e])) * __expf(Bs_ - bsm[jt * 129 + d]);
              af[e] = (short)f2bf(qq);
              bf[e] = (short)f2bf(kk);
            }
            acc = mfma(af, bf, acc);
          }
        }
#pragma unroll
        for (int r = 0; r < 4; ++r) {
          int i = 16 * si + 4 * fq + r, jj = 16 * sj + fr;
          float v = (si >= sj && jj <= i) ? acc[r] : 0.f;
          Ps[i * 72 + (dir ? 63 - jj : jj)] = f2bf(v);
        }
        __builtin_amdgcn_sched_barrier(0);
      }
    }
    __syncthreads();
#pragma unroll
    for (int nt2 = 0; nt2 < 2; ++nt2) {
      int e = h * 128 + (2 * w + nt2) * 16 + fr;
      bf16x8 v0 = ld8(zT + (size_t)e * GR + rb + 8 * fq), v1 = ld8(zT + (size_t)e * GR + rb + 32 + 8 * fq);
#pragma unroll
      for (int m = 0; m < 4; ++m) {
        f32x4 O = {0.f, 0.f, 0.f, 0.f};
        O = mfma(ld8(Ps + (16 * m + fr) * 72 + 8 * fq), v0, O);
        O = mfma(ld8(Ps + (16 * m + fr) * 72 + 32 + 8 * fq), v1, O);
#pragma unroll
        for (int r = 0; r < 4; ++r) {
          int ii = 16 * m + 4 * fq + r, rowr = rb + (dir ? 63 - ii : ii);
          OC[((size_t)dir * GR + rowr) * 512 + e] = f2bf(O[r]);
        }
      }
    }
    __syncthreads();
  }
}

DEV void c_seq(const P& p, int bitem, char* smem) {
  const int tid = opq(threadIdx.x), lane = tid & 63, w = tid >> 6, fr = lane & 15, fq = lane >> 4;
  const bool active = w < WPB;
  const int item = bitem * WPB + (active ? w : 0);
  const int slice = item & 7, dir = (item >> 3) & 1, h = (item >> 4) & 3, lb = item >> 6, e0 = slice * 16;
  u16* Ss = (u16*)(smem + w * 4352);
  const u16* zT = (const u16*)(p.ws + O_ZT);
  u16* OC = (u16*)(p.ws + O_OC);
  f32x4 S[8];
#pragma unroll
  for (int m = 0; m < 8; ++m) S[m] = (f32x4){0.f, 0.f, 0.f, 0.f};
  for (int j = 0; j < 36; ++j) {
    const int n = dir ? (j < 4 ? 3 - j : 39 - j) : j;
    const int cgk = lb * 36 + n, rb = cgk * 64;
    const char* rec = p.ws + O_CREC + ((size_t)(cgk * 4 + h) * 2 + dir) * CREC_SZ;
    const u16* QD = (const u16*)rec;
    const u16* KDT = QD + 8192;
    const float* decv = (const float*)(rec + 32768);
    if (active) {
#pragma unroll
      for (int m = 0; m < 8; ++m) {
        uint2 pk; pk.x = pk2(S[m][0], S[m][1]); pk.y = pk2(S[m][2], S[m][3]);
        *(uint2*)(Ss + fr * 136 + 16 * m + 4 * fq) = pk;
      }
    }
    __syncthreads();
    if (active) {
      bf16x8 Sf[4];
#pragma unroll
      for (int s = 0; s < 4; ++s) Sf[s] = ld8(Ss + fr * 136 + 32 * s + 8 * fq);
#pragma unroll
      for (int m = 0; m < 4; ++m) {
        f32x4 O = {0.f, 0.f, 0.f, 0.f};
#pragma unroll
        for (int s = 0; s < 4; ++s) O = mfma(ld8(QD + (16 * m + fr) * 128 + 32 * s + 8 * fq), Sf[s], O);
#pragma unroll
        for (int r = 0; r < 4; ++r) {
          int ii = 16 * m + 4 * fq + r, rowr = rb + (dir ? 63 - ii : ii);
          size_t oi = ((size_t)dir * GR + rowr) * 512 + h * 128 + e0 + fr;
          OC[oi] = f2bf(bf2f(OC[oi]) + O[r]);
        }
      }
      const u16* vp = zT + (size_t)(h * 128 + e0 + fr) * GR + rb;
      bf16x8 V0 = ld8(vp + 8 * fq), V1 = ld8(vp + 32 + 8 * fq);
#pragma unroll
      for (int m = 0; m < 8; ++m) {
        f32x4 t = S[m];
#pragma unroll
        for (int r = 0; r < 4; ++r) t[r] *= decv[16 * m + 4 * fq + r];
        t = mfma(ld8(KDT + (16 * m + fr) * 64 + 8 * fq), V0, t);
        t = mfma(ld8(KDT + (16 * m + fr) * 64 + 32 + 8 * fq), V1, t);
        S[m] = t;
      }
    }
    __syncthreads();
  }
}

#define LBAR()                                              \
  do {                                                      \
    asm volatile("s_waitcnt lgkmcnt(0)" ::: "memory");      \
    __builtin_amdgcn_s_barrier();                           \
    asm volatile("" ::: "memory");                          \
  } while (0)
#define CBAR() asm volatile("" ::: "memory")

DEV void c_local2(const P& p, int l, int item, char* smem) {
  float* bsm = (float*)smem;
  u16* Fq = (u16*)(smem + 33024);
  u16* kdt = (u16*)(smem + 50432);
  u16* Ps = kdt;
  const int tid = opq(threadIdx.x), lane = tid & 63, w = tid >> 6, fr = lane & 15, fq = lane >> 4;
  const int cgk = item >> 2, h = item & 3, rb = cgk * 64;
  const u16* z = (const u16*)(p.ws + O_Z);
  const u16* zT = (const u16*)(p.ws + O_ZT);
  u16* OC = (u16*)(p.ws + O_OC);
  const float* lbs = (const float*)(p.ws + O_LBS);
  u16* zq = (u16*)(p.ws + O_Z) + (size_t)rb * NZ + C_QC + h * 128;
  {
    uint4 t4[4];
#pragma unroll
    for (int k = 0; k < 4; ++k) {
      int idx = tid + 256 * k, c = idx >> 4, seg = idx & 15;
      t4[k] = *(const uint4*)(zq + (size_t)c * NZ + seg * 8);
    }
#pragma unroll
    for (int k = 0; k < 4; ++k) {
      int idx = tid + 256 * k, c = idx >> 4, seg = idx & 15;
      unsigned wv[4] = {t4[k].x, t4[k].y, t4[k].z, t4[k].w};
#pragma unroll
      for (int q = 0; q < 4; ++q)
        wv[q] = pk2(silu(bf2f((u16)(wv[q] & 0xffff))), silu(bf2f((u16)(wv[q] >> 16))));
      *(uint4*)(zq + (size_t)c * NZ + seg * 8) = make_uint4(wv[0], wv[1], wv[2], wv[3]);
    }
  }
  __syncthreads();
  for (int dir = 0; dir < 2; ++dir) {
    char* rec = p.ws + O_CREC + ((size_t)(cgk * 4 + h) * 2 + dir) * CREC_SZ;
    u16* QD = (u16*)rec;
    u16* KDT = QD + 8192;
    float* decv = (float*)(rec + 32768);
    const float* lbp = lbs + l * 1024 + dir * 512 + h * 128;
    const int fcol = C_F0 + dir * 512 + h * 128;
    {
      uint4 t4[4];
#pragma unroll
      for (int k = 0; k < 4; ++k) {
        int idx = tid + 256 * k, c = idx >> 4, seg = idx & 15;
        t4[k] = *(const uint4*)(z + (size_t)(rb + c) * NZ + fcol + seg * 8);
      }
#pragma unroll
      for (int k = 0; k < 4; ++k) {
        int idx = tid + 256 * k, c = idx >> 4, seg = idx & 15;
        *(uint4*)(Fq + c * 136 + seg * 8) = t4[k];
      }
    }
    __syncthreads();
    {
      int d = tid & 127, half = tid >> 7;
      float lb_ = lbp[d], run = 0.f;
#pragma unroll 8
      for (int k = 0; k < 32; ++k) {
        int i = 32 * half + k, c = dir ? 63 - i : i;
        float f = bf2f(Fq[c * 136 + d]);
        float fg = lb_ + (1.f - lb_) * sigm(f);
        run += __logf(fg);
        bsm[i * 129 + d] = run;
      }
    }
    __syncthreads();
    {
      int d = tid & 127, half = tid >> 7;
      if (half) {
        float add = bsm[31 * 129 + d];
#pragma unroll 8
        for (int k = 0; k < 32; ++k) bsm[(32 + k) * 129 + d] += add;
      }
    }
    __syncthreads();
    {
      uint4 qv[4];
#pragma unroll
      for (int k = 0; k < 4; ++k) {
        int idx = tid + 256 * k, c = idx >> 4, seg = idx & 15;
        qv[k] = *(const uint4*)(zq + (size_t)c * NZ + seg * 8);
      }
#pragma unroll
      for (int k = 0; k < 4; ++k) {
        int idx = tid + 256 * k, c = idx >> 4, seg = idx & 15, i = dir ? 63 - c : c, d0 = seg * 8;
        unsigned qw[4] = {qv[k].x, qv[k].y, qv[k].z, qv[k].w};
        uint4 fv4 = *(const uint4*)(Fq + c * 136 + d0);
        unsigned fw[4] = {fv4.x, fv4.y, fv4.z, fv4.w};
        unsigned qo[4], ko[4];
#pragma unroll
        for (int q = 0; q < 4; ++q) {
          int d = d0 + 2 * q;
          float b0 = bsm[i * 129 + d], b1 = bsm[i * 129 + d + 1];
          float bl0 = bsm[63 * 129 + d], bl1 = bsm[63 * 129 + d + 1];
          float q0 = bf2f((u16)(qw[q] & 0xffff)), q1 = bf2f((u16)(qw[q] >> 16));
          qo[q] = pk2(q0 * __expf(b0), q1 * __expf(b1));
          float k0 = (1.f - lbp[d]) * sigm(-bf2f((u16)(fw[q] & 0xffff)));
          float k1 = (1.f - lbp[d + 1]) * sigm(-bf2f((u16)(fw[q] >> 16)));
          ko[q] = pk2(k0, k1);
          kdt[d * 72 + c] = f2bf(k0 * __expf(bl0 - b0));
          kdt[(d + 1) * 72 + c] = f2bf(k1 * __expf(bl1 - b1));
        }
        *(uint4*)(QD + i * 128 + d0) = make_uint4(qo[0], qo[1], qo[2], qo[3]);
        *(uint4*)(Fq + c * 136 + d0) = make_uint4(ko[0], ko[1], ko[2], ko[3]);
      }
      if (tid < 128) decv[tid] = __expf(bsm[63 * 129 + tid]);
    }
    __syncthreads();
    for (int idx = tid; idx < 1024; idx += 256) {
      int d = idx >> 3, c8 = idx & 7;
      *(uint4*)(KDT + d * 64 + c8 * 8) = *(const uint4*)(kdt + d * 72 + c8 * 8);
    }
    bf16x8 qf[3][4];
#pragma unroll
    for (int t = 0; t < 3; ++t) {
      int k = w + 4 * t;
      int si = k < 4 ? 3 : (k < 7 ? 2 : (k < 9 ? 1 : 0));
      int it_ = 16 * si + fr, ci_ = dir ? 63 - it_ : it_;
#pragma unroll
      for (int s = 0; s < 4; ++s) qf[t][s] = ld8(zq + (size_t)ci_ * NZ + 32 * s + 8 * fq);
    }
    __syncthreads();
    for (int idx = tid; idx < 1536; idx += 256) {
      int tl = idx >> 8, e = idx & 255, r16 = e >> 4, c16 = e & 15;
      int si = tl < 3 ? 0 : (tl < 5 ? 1 : 2);
      int sj = tl < 3 ? tl + 1 : (tl < 5 ? tl - 1 : 3);
      int jj = 16 * sj + c16;
      Ps[(16 * si + r16) * 72 + (dir ? 63 - jj : jj)] = 0;
    }
#pragma unroll
    for (int t = 0; t < 3; ++t) {
      const int k = w + 4 * t;
      if (k < 10) {
        const int si = k < 4 ? 3 : (k < 7 ? 2 : (k < 9 ? 1 : 0));
        const int sj = k - (k < 4 ? 0 : (k < 7 ? 4 : (k < 9 ? 7 : 9)));
        const int it = 16 * si + fr, jt = 16 * sj + fr, cj = dir ? 63 - jt : jt;
        const int brow = si ? (16 * si - 1) : 0;
        const float bmul = si ? 1.f : 0.f;
        f32x4 acc = {0.f, 0.f, 0.f, 0.f};
#pragma unroll
        for (int s = 0; s < 4; ++s) {
          int d0 = 32 * s + 8 * fq;
          bf16x8 fv = ld8(Fq + cj * 136 + d0);
          bf16x8 af, bf;
#pragma unroll
          for (int e = 0; e < 8; ++e) {
            int d = d0 + e;
            float Bs_ = bmul * bsm[brow * 129 + d];
            float qq = bf2f((u16)qf[t][s][e]) * __expf(bsm[it * 129 + d] - Bs_);
            float kk = bf2f((u16)fv[e]) * __expf(Bs_ - bsm[jt * 129 + d]);
            af[e] = (short)f2bf(qq);
            bf[e] = (short)f2bf(kk);
          }
          acc = mfma(af, bf, acc);
          __builtin_amdgcn_sched_barrier(0);
        }
#pragma unroll
        for (int r = 0; r < 4; ++r) {
          int i = 16 * si + 4 * fq + r, jj = 16 * sj + fr;
          float v = (jj <= i) ? acc[r] : 0.f;
          Ps[i * 72 + (dir ? 63 - jj : jj)] = f2bf(v);
        }
      }
    }
    __syncthreads();
#pragma unroll
    for (int nt2 = 0; nt2 < 2; ++nt2) {
      int e = h * 128 + (2 * w + nt2) * 16 + fr;
      bf16x8 v0 = ld8(zT + (size_t)e * GR + rb + 8 * fq), v1 = ld8(zT + (size_t)e * GR + rb + 32 + 8 * fq);
#pragma unroll
      for (int m = 0; m < 4; ++m) {
        f32x4 O = {0.f, 0.f, 0.f, 0.f};
        O = mfma(ld8(Ps + (16 * m + fr) * 72 + 8 * fq), v0, O);
        O = mfma(ld8(Ps + (16 * m + fr) * 72 + 32 + 8 * fq), v1, O);
#pragma unroll
        for (int r = 0; r < 4; ++r) {
          int ii = 16 * m + 4 * fq + r, rowr = rb + (dir ? 63 - ii : ii);
          OC[((size_t)dir * GR + rowr) * 512 + e] = f2bf(O[r]);
        }
      }
    }
    __syncthreads();
  }
}

#define LBAR()                                              \
  do {                                                      \
    asm volatile("s_waitcnt lgkmcnt(0)" ::: "memory");      \
    __builtin_amdgcn_s_barrier();                           \
    asm volatile("" ::: "memory");                          \
  } while (0)
#define CBAR() asm volatile("" ::: "memory")
#define BS_CHUNK(jj) (dir ? ((jj) < 4 ? 3 - (jj) : 39 - (jj)) : (jj))
DEV bf16x8 ldo8(const char* base, unsigned off) { return *reinterpret_cast<const bf16x8*>(base + off); }
DEV void b_seq2(const P& p, int bitem, char* smem) {
  const int tid = opq(threadIdx.x), lane = tid & 63, w = tid >> 6, fr = lane & 15, fq = lane >> 4;
  const int es = bitem & 3, dir = (bitem >> 2) & 1, h = (bitem >> 3) & 3, lb = bitem >> 5, e0 = es * 32;
  u16* Ss = (u16*)smem;
  u16* Rs = Ss + 32 * 136;
  u16* Vsc = Rs + 32 * 72;
  u16* Vor = Vsc + 32 * 72;
  const char* qnB = p.ws + O_BSH + (size_t)h * 256;
  const char* knB = qnB + BSH_ONE;
  const char* vbB = knB + BSH_ONE + (size_t)e0 * 2;
  const char* ktB = p.ws + O_BSH + 3 * BSH_ONE + (size_t)h * 16384;
  const char* recB = p.ws + O_BIT + ((size_t)h * 2 + dir) * BIT_SZ;
  char* obB = p.ws + O_OB + ((size_t)dir * GR * 512 + h * 128 + e0) * 2;
  const int mrow = 16 * w + fr, crow0 = 16 * w + 4 * fq;
  const unsigned offA = (unsigned)((dir ? 63 - mrow : mrow) * 1024 + 16 * fq);
  unsigned offR[4];
#pragma unroll
  for (int r = 0; r < 4; ++r) offR[r] = (unsigned)((dir ? 63 - (crow0 + r) : (crow0 + r)) * 1024 + fr * 2);
  const unsigned offT = (unsigned)(mrow * 128 + 16 * fq);
  const unsigned offK = (unsigned)((32 * w + fr) * 128 + 16 * fq);
  const unsigned offS = (unsigned)(16384 + crow0 * 4);
  f32x4 S[2][2];
#pragma unroll
  for (int a = 0; a < 2; ++a)
#pragma unroll
    for (int b = 0; b < 2; ++b) S[a][b] = (f32x4){0.f, 0.f, 0.f, 0.f};
  bf16x8 Akn[4], Aqn[4], At[2], Aqk[2], AkT[2][2];
  u16 vbv[2][4];
  float4 eg4, be4, ek4;
  float egl;
#define BS_LOAD1(cg_)                                                              \
  {                                                                                \
    const size_t ro_ = (size_t)(cg_) * 65536;                                      \
    _Pragma("unroll") for (int s = 0; s < 4; ++s) {                                \
      Akn[s] = ldo8(knB + ro_, offA + 64 * s);                                     \
      Aqn[s] = ldo8(qnB + ro_, offA + 64 * s);                                     \
    }                                                                              \
    _Pragma("unroll") for (int r = 0; r < 4; ++r) {                                \
      vbv[0][r] = *(const u16*)(vbB + ro_ + offR[r]);                              \
      vbv[1][r] = *(const u16*)(vbB + ro_ + (offR[r] + 32));                       \
    }                                                                              \
    const char* rc_ = recB + (size_t)(cg_) * (8 * BIT_SZ);                         \
    eg4 = *(const float4*)(rc_ + offS);                                            \
    be4 = *(const float4*)(rc_ + (offS + 256));                                    \
  }
#define BS_LOAD2(cg_)                                                              \
  {                                                                                \
    const char* rc_ = recB + (size_t)(cg_) * (8 * BIT_SZ);                         \
    At[0] = ldo8(rc_, offT); At[1] = ldo8(rc_, offT + 64);                         \
    ek4 = *(const float4*)(rc_ + (offS + 512));                                    \
  }
#define BS_LOAD3(cg_)                                                              \
  {                                                                                \
    const char* rc_ = recB + (size_t)(cg_) * (8 * BIT_SZ);                         \
    Aqk[0] = ldo8(rc_, offT + 8192); Aqk[1] = ldo8(rc_, offT + 8192 + 64);         \
    egl = *(const float*)(rc_ + 16384 + 768);                                      \
    const char* kt_ = ktB + (size_t)(cg_) * 65536;                                 \
    AkT[0][0] = ldo8(kt_, offK); AkT[0][1] = ldo8(kt_, offK + 64);                 \
    AkT[1][0] = ldo8(kt_, offK + 2048); AkT[1][1] = ldo8(kt_, offK + 2048 + 64);   \
  }
  {
    const int c0 = lb * 36 + BS_CHUNK(0);
    BS_LOAD1(c0) BS_LOAD2(c0) BS_LOAD3(c0)
  }
  for (int j = 0; j < 36; ++j) {
    const int cgk = lb * 36 + BS_CHUNK(j);
    const int jn = (j + 1 < 36) ? j + 1 : j;
    const int cgn = lb * 36 + BS_CHUNK(jn);
#pragma unroll
    for (int mm = 0; mm < 2; ++mm)
#pragma unroll
      for (int nt = 0; nt < 2; ++nt) {
        uint2 pk; pk.x = pk2(S[mm][nt][0], S[mm][nt][1]); pk.y = pk2(S[mm][nt][2], S[mm][nt][3]);
        *(uint2*)(Ss + (16 * nt + fr) * 136 + 32 * w + 16 * mm + 4 * fq) = pk;
      }
    LBAR();
    f32x4 QS[2];
    {
      bf16x8 Sf[2][4];
#pragma unroll
      for (int nt = 0; nt < 2; ++nt)
#pragma unroll
        for (int s = 0; s < 4; ++s) Sf[nt][s] = ld8(Ss + (16 * nt + fr) * 136 + 32 * s + 8 * fq);
#pragma unroll
      for (int nt = 0; nt < 2; ++nt) {
        f32x4 X = {0.f, 0.f, 0.f, 0.f}, Q = {0.f, 0.f, 0.f, 0.f};
#pragma unroll
        for (int s = 0; s < 4; ++s) { X = mfma(Akn[s], Sf[nt][s], X); Q = mfma(Aqn[s], Sf[nt][s], Q); }
        float r0 = be4.x * (bf2f(vbv[nt][0]) - eg4.x * X[0]);
        float r1 = be4.y * (bf2f(vbv[nt][1]) - eg4.y * X[1]);
        float r2 = be4.z * (bf2f(vbv[nt][2]) - eg4.z * X[2]);
        float r3 = be4.w * (bf2f(vbv[nt][3]) - eg4.w * X[3]);
        uint2 pk; pk.x = pk2(r0, r1); pk.y = pk2(r2, r3);
        *(uint2*)(Rs + (16 * nt + fr) * 72 + crow0) = pk;
        Q[0] *= eg4.x; Q[1] *= eg4.y; Q[2] *= eg4.z; Q[3] *= eg4.w;
        QS[nt] = Q;
      }
    }
    CBAR();
    BS_LOAD1(cgn)
    LBAR();
    {
#pragma unroll
      for (int nt = 0; nt < 2; ++nt) {
        bf16x8 Rf0 = ld8(Rs + (16 * nt + fr) * 72 + 8 * fq), Rf1 = ld8(Rs + (16 * nt + fr) * 72 + 32 + 8 * fq);
        f32x4 VN = {0.f, 0.f, 0.f, 0.f};
        VN = mfma(At[0], Rf0, VN);
        VN = mfma(At[1], Rf1, VN);
        uint2 pk; pk.x = pk2(VN[0], VN[1]); pk.y = pk2(VN[2], VN[3]);
        *(uint2*)(Vsc + (16 * nt + fr) * 72 + crow0) = pk;
        float s0 = VN[0] * ek4.x, s1 = VN[1] * ek4.y, s2 = VN[2] * ek4.z, s3 = VN[3] * ek4.w;
        if (dir) {
          pk.x = pk2(s3, s2); pk.y = pk2(s1, s0);
          *(uint2*)(Vor + (16 * nt + fr) * 72 + (60 - crow0)) = pk;
        } else {
          pk.x = pk2(s0, s1); pk.y = pk2(s2, s3);
          *(uint2*)(Vor + (16 * nt + fr) * 72 + crow0) = pk;
        }
      }
    }
    CBAR();
    BS_LOAD2(cgn)
    LBAR();
    {
      char* ob_ = obB + (size_t)cgk * 65536;
#pragma unroll
      for (int nt = 0; nt < 2; ++nt) {
        bf16x8 Vs0 = ld8(Vsc + (16 * nt + fr) * 72 + 8 * fq), Vs1 = ld8(Vsc + (16 * nt + fr) * 72 + 32 + 8 * fq);
        bf16x8 Vo0 = ld8(Vor + (16 * nt + fr) * 72 + 8 * fq), Vo1 = ld8(Vor + (16 * nt + fr) * 72 + 32 + 8 * fq);
        f32x4 O = QS[nt];
        O = mfma(Aqk[0], Vs0, O);
        O = mfma(Aqk[1], Vs1, O);
#pragma unroll
        for (int r = 0; r < 4; ++r) *(u16*)(ob_ + (offR[r] + 32 * nt)) = f2bf(O[r]);
#pragma unroll
        for (int mm = 0; mm < 2; ++mm) {
          f32x4 t = S[mm][nt];
#pragma unroll
          for (int r = 0; r < 4; ++r) t[r] *= egl;
          t = mfma(AkT[mm][0], Vo0, t);
          t = mfma(AkT[mm][1], Vo1, t);
          S[mm][nt] = t;
        }
      }
    }
    CBAR();
    BS_LOAD3(cgn)
  }
  LBAR();
}

DEV void c_seq2(const P& p, int bitem, char* smem) {
  const int tid = opq(threadIdx.x), lane = tid & 63, w = tid >> 6, fr = lane & 15, fq = lane >> 4;
  const int es = bitem & 3, dir = (bitem >> 2) & 1, h = (bitem >> 3) & 3, lb = bitem >> 5, e0 = es * 32;
  u16* Ssb = (u16*)smem;
  const char* recB = p.ws + O_CREC + ((size_t)h * 2 + dir) * CREC_SZ;
  const char* ztB = p.ws + O_ZT + (size_t)(h * 128 + e0) * GR * 2;
  char* ocB = p.ws + O_OC + ((size_t)dir * GR * 512 + h * 128 + e0) * 2;
  const int mrow = 16 * w + fr, crow0 = 16 * w + 4 * fq;
  const unsigned offQ = (unsigned)(mrow * 256 + 16 * fq);
  const unsigned offK = (unsigned)(16384 + (32 * w + fr) * 128 + 16 * fq);
  const unsigned offD = (unsigned)(32768 + (32 * w + 4 * fq) * 4);
  const unsigned offV = (unsigned)(fr * GR * 2 + 16 * fq);
  unsigned offR[4];
#pragma unroll
  for (int r = 0; r < 4; ++r) offR[r] = (unsigned)((dir ? 63 - (crow0 + r) : (crow0 + r)) * 1024 + fr * 2);
  f32x4 S[2][2];
#pragma unroll
  for (int a = 0; a < 2; ++a)
#pragma unroll
    for (int b = 0; b < 2; ++b) S[a][b] = (f32x4){0.f, 0.f, 0.f, 0.f};
  bf16x8 Aqd[4], Akd[2][2], Vf[2][2];
  u16 oi[2][4];
  float4 dec4[2];
#define CS_LOAD(cg_)                                                                    \
  {                                                                                     \
    const char* rc_ = recB + (size_t)(cg_) * (8 * CREC_SZ);                             \
    _Pragma("unroll") for (int s = 0; s < 4; ++s) Aqd[s] = ldo8(rc_, offQ + 64 * s);    \
    Akd[0][0] = ldo8(rc_, offK); Akd[0][1] = ldo8(rc_, offK + 64);                      \
    Akd[1][0] = ldo8(rc_, offK + 2048); Akd[1][1] = ldo8(rc_, offK + 2048 + 64);        \
    dec4[0] = *(const float4*)(rc_ + offD);                                             \
    dec4[1] = *(const float4*)(rc_ + (offD + 64));                                      \
    const char* zt_ = ztB + (size_t)(cg_) * 128;                                        \
    Vf[0][0] = ldo8(zt_, offV); Vf[0][1] = ldo8(zt_, offV + 64);                        \
    Vf[1][0] = ldo8(zt_, offV + 16 * GR * 2); Vf[1][1] = ldo8(zt_, offV + 16 * GR * 2 + 64); \
    const char* oc_ = ocB + (size_t)(cg_) * 65536;                                      \
    _Pragma("unroll") for (int r = 0; r < 4; ++r) {                                     \
      oi[0][r] = *(const u16*)(oc_ + offR[r]);                                          \
      oi[1][r] = *(const u16*)(oc_ + (offR[r] + 32));                                   \
    }                                                                                   \
  }
  {
    const int c0 = lb * 36 + BS_CHUNK(0);
    CS_LOAD(c0)
  }
  for (int j = 0; j < 36; ++j) {
    const int cgk = lb * 36 + BS_CHUNK(j);
    const int jn = (j + 1 < 36) ? j + 1 : j;
    const int cgn = lb * 36 + BS_CHUNK(jn);
    u16* Ss = Ssb + (j & 1) * (32 * 136);
#pragma unroll
    for (int mm = 0; mm < 2; ++mm)
#pragma unroll
      for (int nt = 0; nt < 2; ++nt) {
        uint2 pk; pk.x = pk2(S[mm][nt][0], S[mm][nt][1]); pk.y = pk2(S[mm][nt][2], S[mm][nt][3]);
        *(uint2*)(Ss + (16 * nt + fr) * 136 + 32 * w + 16 * mm + 4 * fq) = pk;
      }
    LBAR();
    char* oc_ = ocB + (size_t)cgk * 65536;
#pragma unroll
    for (int nt = 0; nt < 2; ++nt) {
      f32x4 O = {0.f, 0.f, 0.f, 0.f};
#pragma unroll
      for (int s = 0; s < 4; ++s) O = mfma(Aqd[s], ld8(Ss + (16 * nt + fr) * 136 + 32 * s + 8 * fq), O);
#pragma unroll
      for (int r = 0; r < 4; ++r) *(u16*)(oc_ + (offR[r] + 32 * nt)) = f2bf(bf2f(oi[nt][r]) + O[r]);
#pragma unroll
      for (int mm = 0; mm < 2; ++mm) {
        f32x4 t = S[mm][nt];
        t[0] *= dec4[mm].x; t[1] *= dec4[mm].y; t[2] *= dec4[mm].z; t[3] *= dec4[mm].w;
        t = mfma(Akd[mm][0], Vf[nt][0], t);
        t = mfma(Akd[mm][1], Vf[nt][1], t);
        S[mm][nt] = t;
      }
    }
    CBAR();
    CS_LOAD(cgn)
  }
  LBAR();
}

DEV void bc_merge(const P& p, int l, int it) {
  const int tid_ = opq(threadIdx.x); const int lane = tid_ & 63, w = tid_ >> 6;
  int lr = it * 4 + w;
  int mix = lane >> 5, cm = (lane * 16) & 511;
  const u16* O = (const u16*)(p.ws + (mix ? O_OC : O_OB));
  u16* z = (u16*)(p.ws + O_Z);
  float ov[16], ss = 0.f;
#pragma unroll
  for (int k2 = 0; k2 < 2; ++k2) {
    uint4 a = *(const uint4*)(O + (size_t)lr * 512 + cm + 8 * k2);
    uint4 b = *(const uint4*)(O + ((size_t)GR + lr) * 512 + cm + 8 * k2);
    unsigned aa[4] = {a.x, a.y, a.z, a.w}, bb[4] = {b.x, b.y, b.z, b.w};
#pragma unroll
    for (int q = 0; q < 4; ++q) {
      float v0 = bf2f((u16)(aa[q] & 0xffff)) + bf2f((u16)(bb[q] & 0xffff));
      float v1 = bf2f((u16)(aa[q] >> 16)) + bf2f((u16)(bb[q] >> 16));
      ov[k2 * 8 + q * 2] = v0; ov[k2 * 8 + q * 2 + 1] = v1;
      ss += v0 * v0 + v1 * v1;
    }
  }
  ss += __shfl_xor(ss, 1); ss += __shfl_xor(ss, 2); ss += __shfl_xor(ss, 4);
  float rinv = rsqrtf(ss * (1.f / 128.f) + EPS);
  const float* nw = (mix ? p.hg_norm : p.gdn_norm) + l * 128 + (cm & 127);
  u16* gp = z + (size_t)lr * NZ + (mix ? C_GC : C_GB) + cm;
#pragma unroll
  for (int k2 = 0; k2 < 2; ++k2) {
    uint4 gv = *(const uint4*)(gp + 8 * k2);
    unsigned gg[4] = {gv.x, gv.y, gv.z, gv.w}, oo[4];
#pragma unroll
    for (int q = 0; q < 4; ++q) {
      int e = k2 * 8 + q * 2;
      float y0 = ov[e] * rinv * nw[e] * silu(bf2f((u16)(gg[q] & 0xffff)));
      float y1 = ov[e + 1] * rinv * nw[e + 1] * silu(bf2f((u16)(gg[q] >> 16)));
      oo[q] = pk2(y0, y1);
    }
    *(uint4*)(gp + 8 * k2) = make_uint4(oo[0], oo[1], oo[2], oo[3]);
  }
}

#define XB_TMO      128
#define XB_XCNT(j)  (256  + 64 * (j))
#define XB_XSUB(j)  (1280 + 64 * (j))
#define XB_XGEN(j)  (2304 + 64 * (j))
#define XB_TOP      3328
#define XB_TOPGEN   3392
#define XCD_BAR_WORDS 3456
#define XB_SPIN_CAP (1u << 18)
#define LAS __attribute__((address_space(3)))

__device__ __forceinline__ unsigned xb_ld(unsigned* p)              { return __hip_atomic_load(p, __ATOMIC_RELAXED, __HIP_MEMORY_SCOPE_AGENT); }
__device__ __forceinline__ unsigned xb_add(unsigned* p, unsigned v) { return __hip_atomic_fetch_add(p, v, __ATOMIC_RELAXED, __HIP_MEMORY_SCOPE_AGENT); }
__device__ __forceinline__ unsigned xb_xcc_id() { return (unsigned)__builtin_amdgcn_s_getreg((3 << 11) | 20) & 0xFu; }
#define XB_SPIN(cond, bar) do { unsigned _sp = 0; while (cond) { __builtin_amdgcn_s_sleep(1); \
    if ((++_sp & 255u) == 0u) { if (xb_ld(&(bar)[XB_TMO])) break; if (_sp > XB_SPIN_CAP) { atomicAdd(&(bar)[XB_TMO], 1u); break; } } } } while (0)

struct XcdBarrier {
    unsigned* bar; unsigned x;
    volatile LAS unsigned* st;
};

__device__ __forceinline__ XcdBarrier xcd_barrier_post(unsigned* bar, volatile LAS unsigned* st) {
    XcdBarrier b; b.bar = bar; b.x = xb_xcc_id(); b.st = st;
    if (threadIdx.x == 0) (void)xb_add(&bar[XB_XCNT(b.x)], 1u);
    return b;
}
__device__ __forceinline__ void xcd_barrier_complete(unsigned* bar, unsigned x, unsigned& nloc, unsigned& nx) {
    const unsigned G = gridDim.x * gridDim.y * gridDim.z;
    unsigned sum, cnt, mine, sp = 0u;
    for (;;) {
        sum = 0u; cnt = 0u; mine = 0u;
#pragma unroll
        for (unsigned j = 0; j < 16; ++j) { const unsigned c = xb_ld(&bar[XB_XCNT(j)]); sum += c; cnt += (c > 0u) ? 1u : 0u; mine = (j == x) ? c : mine; }
        if (sum == G) break;
        __builtin_amdgcn_s_sleep(1);
        if ((++sp & 255u) == 0u) { if (xb_ld(&bar[XB_TMO])) break; if (sp > XB_SPIN_CAP) { atomicAdd(&bar[XB_TMO], 1u); break; } }
    }
    nloc = mine > 0u ? mine : 1u; nx = cnt > 0u ? cnt : 1u;
}

__device__ __forceinline__ void xcd_barrier(const XcdBarrier& b) {
    asm volatile("s_waitcnt vmcnt(0)" ::: "memory");
    __syncthreads();
    if (threadIdx.x == 0) {
        unsigned* bar = b.bar;
        __builtin_amdgcn_s_waitcnt(0);
        unsigned nloc = b.st[0], nx = b.st[1];
        if (nloc == 0u) { xcd_barrier_complete(bar, b.x, nloc, nx); b.st[0] = nloc; b.st[1] = nx; }
        const unsigned old = xb_add(&bar[XB_XSUB(b.x)], 1u);
        const unsigned gen = old / nloc;
        if (old + 1u == (gen + 1u) * nloc) {
            __builtin_amdgcn_fence(__ATOMIC_RELEASE, "agent");
            asm volatile("s_waitcnt vmcnt(0)" ::: "memory");
            const unsigned og = xb_add(&bar[XB_TOP], 1u);
            const unsigned tg = og / nx;
            if (og + 1u == (tg + 1u) * nx) xb_add(&bar[XB_TOPGEN], 1u);
            else XB_SPIN(xb_ld(&bar[XB_TOPGEN]) == tg, bar);
            __builtin_amdgcn_fence(__ATOMIC_ACQUIRE, "agent");
            xb_add(&bar[XB_XGEN(b.x)], 1u);
            asm volatile("s_waitcnt vmcnt(0)" ::: "memory");
        } else {
            XB_SPIN(xb_ld(&bar[XB_XGEN(b.x)]) == gen, bar);
            __builtin_amdgcn_fence(__ATOMIC_ACQUIRE, "agent");
            asm volatile("s_waitcnt vmcnt(0)" ::: "memory");
        }
    }
    __syncthreads();
}


#ifdef NO_G0
#define XG0(x)
#else
#define XG0(x) x
#endif
#ifdef NO_G1
#define XG1(x)
#else
#define XG1(x) x
#endif
#ifdef NO_BC
#define XBC(x)
#else
#define XBC(x) x
#endif
#ifdef NO_AC
#define XAC(x)
#else
#define XAC(x) x
#endif
#ifdef NO_P0
#define XP0(x)
#else
#define XP0(x) x
#endif
#ifdef NO_R
#define XR(x)
#else
#define XR(x) x
#endif
#ifdef NO_BL
#define XBL(x)
#else
#define XBL(x) x
#endif
#ifdef NO_CL
#define XCL(x)
#else
#define XCL(x) x
#endif
#ifdef NO_A0
#define XA0(x)
#else
#define XA0(x) x
#endif
#ifdef NO_A1
#define XA1(x)
#else
#define XA1(x) x
#endif
#ifdef NO_BS
#define XBS(x)
#else
#define XBS(x) x
#endif
#ifdef NO_CS
#define XCS(x)
#else
#define XCS(x) x
#endif
__global__ void __launch_bounds__(256, 2) fwd_mega(P p) {
  extern __shared__ __attribute__((aligned(16))) char smem[];
  cg::grid_group grid = cg::this_grid();
  const int G = gridDim.x;
  __shared__ uint4 xb_words;
  if (threadIdx.x == 0) xb_words = make_uint4(0u, 0u, 0u, 0u);
  __syncthreads();
  XcdBarrier xb = xcd_barrier_post((unsigned*)(p.ws + O_BAR), (volatile LAS unsigned*)&xb_words);
  XP0(phase0(p, smem));
  grid.sync();
  u16* z = (u16*)(p.ws + O_Z);
  u16* zT = (u16*)(p.ws + O_ZT);
  float* ab = (float*)(p.ws + O_AB);
  float* o = (float*)(p.ws + O_BSH);
  const u16* u = (const u16*)(p.ws + O_BIT);
  for (int g = 0; g < NG; ++g) {
    XR(phaseR(p, g, 0));
    xcd_barrier(xb);
    for (int l = 0; l < DEPTH; ++l) {
      for (int rep = 0; rep < REP_G; ++rep) {
        const u16* Bt = (const u16*)(p.ws + O_WTIN) + (size_t)l * NZ * 1024;
        if ((G & 7) == 0) {
          const int x = blockIdx.x & 7, bl = blockIdx.x >> 3, nbl = G >> 3;
          for (int q = bl; q < 9 * 45; q += nbl) { XG0(gemm_tile<0>(u, 1024, Bt, 1024, 9 * x + q % 9, q / 9, z, zT, ab, o, smem)); }
        } else {
          for (int t = blockIdx.x; t < 72 * 45; t += G) { XG0(gemm_tile<0>(u, 1024, Bt, 1024, t % 72, t / 72, z, zT, ab, o, smem)); }
        }
      }
      xcd_barrier(xb);
      for (int rep2 = 0; rep2 < REP_M; ++rep2) {
      for (int rep3 = 0; rep3 < REP_A; ++rep3) {
        if (rep3) xcd_barrier(xb);
        const int nb = NCH * 4, nc = NCH * 4, na = NCH * 8;
        for (int t = blockIdx.x; t < nb + nc + na; t += G) {
          if (t < nc) { XCL(c_local2(p, l, t, smem)); }
          else if (t < nb + nc) { XBL(b_local(p, l, t - nc, smem)); }
          else { XA0(a_item(p, l, t - nb - nc, 0, smem)); }
        }
      }
      xcd_barrier(xb);
      {
        for (int t = blockIdx.x; t < 256 + 16; t += G) {
          if (t < 128) { XBS(b_seq2(p, t, smem)); }
          else if (t < 256) { XCS(c_seq2(p, t - 128, smem)); }
          else { XAC(a_carry(p, t - 256)); }
        }
      }
      xcd_barrier(xb);
      }
      {
        const int na = NCH * 8, nm = GR / 4;
        for (int t = blockIdx.x; t < na + nm; t += G) {
          if (t < na) { XA1(a_fin(p, l, t, smem)); }
          else { XBC(bc_merge(p, l, t - na)); }
        }
      }
      xcd_barrier(xb);
      for (int rep = 0; rep < REP_G; ++rep) {
        const u16* Bt = (const u16*)(p.ws + O_WTOUT) + (size_t)l * 1024 * 1536;
        for (int t = blockIdx.x; t < 72 * 8; t += G) { XG1(gemm_tile<1>(z + C_GA, NZ, Bt, 1536, t % 72, t / 72, z, zT, ab, o, smem)); }
      }
      xcd_barrier(xb);
      XR(phaseR(p, g, l + 1));
      xcd_barrier(xb);
    }
  }
}

extern "C" void kernel_launch(void* const* d_in, const int* in_sizes, int n_in, void* d_out, int out_size, void* d_ws,
                              size_t ws_size, hipStream_t stream) {
  static int grid_blocks = 0;
  if (!grid_blocks) {
    int dev = 0, cus = 0, per_cu = 0;
    hipGetDevice(&dev);
    hipDeviceGetAttribute(&cus, hipDeviceAttributeMultiprocessorCount, dev);
    hipFuncSetAttribute((const void*)fwd_mega, hipFuncAttributeMaxDynamicSharedMemorySize, LDS_BYTES);
    hipOccupancyMaxActiveBlocksPerMultiprocessor(&per_cu, fwd_mega, 256, LDS_BYTES);
    if (per_cu > 2) per_cu = 2;
    if (per_cu < 1) per_cu = 1;
    grid_blocks = cus * per_cu;
  }
  if (ws_size < WS_TOTAL) {
    fprintf(stderr, "workspace too small: %zu < %zu\n", ws_size, (size_t)WS_TOTAL);
    return;
  }
  P p{};
  const float** f = (const float**)&p;
  for (int i = 0; i < 23; ++i) f[i] = (const float*)d_in[i];
  p.out = (float*)d_out;
  p.ws = (char*)d_ws;
  hipMemsetAsync((char*)d_ws + O_BAR, 0, XCD_BAR_WORDS * 4, stream);
  void* args[] = {&p};
  hipError_t e = hipLaunchCooperativeKernel((void*)fwd_mega, dim3(grid_blocks), dim3(256), args, LDS_BYTES, stream);
  if (e != hipSuccess) fprintf(stderr, "cooperative launch failed: %s (grid %d)\n", hipGetErrorString(e), grid_blocks);
}
```

```cpp
#include <hip/hip_runtime.h>
#include <hip/hip_cooperative_groups.h>
#include <cstdio>
namespace cg = cooperative_groups;

typedef __attribute__((ext_vector_type(8))) short bf16x8;
typedef __attribute__((ext_vector_type(4))) float f32x4;
typedef unsigned short u16;
#define DEV __device__ __forceinline__

constexpr int DM = 1024, TL = 2048, TCX = 256, TS = 2304, GB = 4, GR = GB * TS, NG = 2;
constexpr int NZ = 5760, DEPTH = 4;
constexpr int C_XA = 0, C_Q = 512, C_K = 1024, C_V = 1536, C_QC = 2048, C_F0 = 2560, C_IC = 3584,
              C_GA = 4096, C_GB = 4608, C_GC = 5120, C_AB = 5632;
constexpr int NCH = GR / 64;
constexpr float EPS = 1e-6f;
constexpr int WPB = 2;

constexpr size_t al256(size_t x) { return (x + 255) & ~(size_t)255; }
constexpr size_t O_WTIN = 0;
constexpr size_t O_WTOUT = O_WTIN + al256((size_t)DEPTH * NZ * 1024 * 2);
constexpr size_t O_WGT = O_WTOUT + al256((size_t)DEPTH * 1024 * 1536 * 2);
constexpr size_t O_MOD = O_WGT + al256((size_t)DEPTH * 2 * 2 * 8 * 4096 * 2);
constexpr size_t O_LBS = O_MOD + al256((size_t)DEPTH * 9 * 3072 * 4);
constexpr size_t O_HC = O_LBS + al256((size_t)DEPTH * 1024 * 4);
constexpr size_t O_Z = O_HC + al256((size_t)GB * TCX * 1024 * 4);
constexpr size_t O_ZT = O_Z + al256((size_t)GR * NZ * 2);
constexpr size_t O_AB = O_ZT + al256((size_t)512 * GR * 2);
constexpr size_t O_BSH = O_AB + al256((size_t)GR * 16 * 4);
constexpr size_t BSH_ONE = (size_t)GR * 512 * 2;
constexpr size_t O_BIT = O_BSH + al256(4 * BSH_ONE);
constexpr size_t BIT_SZ = 17408;
constexpr size_t O_CREC = O_BIT + al256((size_t)NCH * 4 * 2 * BIT_SZ);
constexpr size_t CREC_SZ = 33280;
constexpr size_t O_OB = O_CREC + al256((size_t)NCH * 4 * 2 * CREC_SZ);
constexpr size_t O_OC = O_OB + al256((size_t)2 * GR * 512 * 2);
constexpr size_t O_AP = O_OC + al256((size_t)2 * GR * 512 * 2);
constexpr size_t O_AH = O_AP + al256((size_t)NCH * 2 * 512 * 4);
constexpr size_t O_ACAR = O_AH + al256((size_t)NCH * 2 * 512 * 4);
constexpr size_t O_ALA = O_ACAR + al256((size_t)NCH * 2 * 512 * 4);
constexpr size_t O_AU = O_ALA + al256((size_t)2 * GR * 512 * 2);
constexpr size_t O_BAR = O_AU + al256((size_t)2 * GR * 512 * 2);
constexpr size_t WS_TOTAL = O_BAR + al256(3456 * 4);

constexpr int LDS_BYTES = 73728;
#ifndef REP_A
#define REP_A 1
#endif
#ifndef REP_G
#define REP_G 1
#endif
#ifndef REP_M
#define REP_M 1
#endif

struct P {
  const float *x, *c, *ctx, *c_ctx, *w_ada, *b_ada, *norm_pre, *norm_post, *w_in, *conv_a_w, *conv_a_b, *rg_w_r,
      *rg_b_r, *rg_w_i, *rg_b_i, *rg_lam, *conv_b_w, *gdn_a_log, *gdn_dt_bias, *gdn_norm, *hg_lb, *hg_norm, *w_out;
  float* out;
  char* ws;
};

DEV int opq(int x) { asm volatile("" : "+v"(x)); return x; }
DEV int opqs(int x) { asm volatile("" : "+s"(x)); return x; }
typedef __attribute__((ext_vector_type(2))) __bf16 bf16x2_t;
typedef __attribute__((ext_vector_type(2))) float f32x2_t;
DEV u16 f2bf(float f) { __bf16 r = (__bf16)f; return __builtin_bit_cast(u16, r); }
DEV float bf2f(u16 h) { return __uint_as_float(((unsigned)h) << 16); }
DEV unsigned pk2(float a, float b) { f32x2_t v = {a, b}; bf16x2_t r = __builtin_convertvector(v, bf16x2_t); return __builtin_bit_cast(unsigned, r); }
DEV float sigm(float x) { return __builtin_amdgcn_rcpf(1.f + __expf(-x)); }
DEV float silu(float x) { return x * __builtin_amdgcn_rcpf(1.f + __expf(-x)); }
DEV float softplus(float x) { return x > 20.f ? x : log1pf(__expf(x)); }
DEV f32x4 mfma(bf16x8 a, bf16x8 b, f32x4 c) { return __builtin_amdgcn_mfma_f32_16x16x32_bf16(a, b, c, 0, 0, 0); }
DEV bf16x8 ld8(const u16* p) { return *reinterpret_cast<const bf16x8*>(p); }
DEV int lat_map(int l, int t) { return (l & 1) ? ((t & 63) * 32 + (t >> 6)) : t; }
DEV int orig_col(int n) {
  if (n < 512) return n;
  if (n < 2048) return n + 512;
  if (n < 4096) return n + 1040;
  if (n < 4608) return n - 4096 + 512;
  if (n < 5120) return n - 4608 + 2576;
  if (n < 5632) return n + 16;
  if (n < 5648) return n - 5632 + 2560;
  return -1;
}
DEV float zval(const u16* z, int rb, int cp, int n, int col) {
  if (cp < 0 && (n == 0 || n == 4)) return 0.f;
  if (cp > 63 && (n == 3 || n == 35)) return 0.f;
  return bf2f(z[(size_t)(rb + cp) * NZ + col]);
}

DEV void ph0_ada(const P& p, int item, char* smem) {
  float* sc = (float*)smem;
  float* red = (float*)(smem + 36864);
  const int tid = threadIdx.x, lane = tid & 63, wv = tid >> 6;
  for (int i = tid; i < 9 * 1024; i += 256) {
    int v = i >> 10, d = i & 1023;
    float cv = (v < 8) ? p.c[v * 1024 + d] : p.c_ctx[d];
    sc[i] = silu(cv);
  }
  __syncthreads();
  const int col = item * 64 + lane;
  const int l = col / 3072, e = col % 3072;
  const float* w = p.w_ada + (size_t)l * 1024 * 3072 + e + (size_t)(256 * wv) * 3072;
  const float* scw = sc + 256 * wv;
  float acc[9];
#pragma unroll
  for (int i = 0; i < 9; ++i) acc[i] = 0.f;
  for (int d = 0; d < 256; d += 16) {
    float wr[16];
#pragma unroll
    for (int k = 0; k < 16; ++k) wr[k] = w[(size_t)(d + k) * 3072];
#pragma unroll
    for (int k = 0; k < 16; ++k)
#pragma unroll
      for (int i = 0; i < 9; ++i) acc[i] += scw[i * 1024 + d + k] * wr[k];
  }
#pragma unroll
  for (int i = 0; i < 9; ++i) red[(wv * 9 + i) * 64 + lane] = acc[i];
  __syncthreads();
  float* mod = (float*)(p.ws + O_MOD);
  for (int idx = tid; idx < 9 * 64; idx += 256) {
    int i = idx >> 6, ln = idx & 63;
    float sum = red[(0 * 9 + i) * 64 + ln] + red[(1 * 9 + i) * 64 + ln] + red[(2 * 9 + i) * 64 + ln] + red[(3 * 9 + i) * 64 + ln];
    int cc = item * 64 + ln, l2 = cc / 3072, e2 = cc % 3072;
    mod[((size_t)l2 * 9 + i) * 3072 + e2] = sum + p.b_ada[l2 * 3072 + e2];
  }
  __syncthreads();
}
DEV void tconv_tile(const float* src, int lds_, u16* dst, int ldd, int k0, int n0, bool mapcol, char* smem) {
  float* t = (float*)smem;
  const int tid = threadIdx.x, nn = tid & 63, kq = tid >> 6;
  const int n = n0 + nn;
  const int sn0 = mapcol ? orig_col(n) : n;
  const float msk = (sn0 >= 0) ? 1.f : 0.f;
  const int sn = sn0 >= 0 ? sn0 : 0;
  float v[16];
#pragma unroll
  for (int k = 0; k < 16; ++k) v[k] = src[(size_t)(k0 + kq + 4 * k) * lds_ + sn];
#pragma unroll
  for (int k = 0; k < 16; ++k) t[(kq + 4 * k) * 65 + nn] = v[k] * msk;
  __syncthreads();
  {
    const int kk = tid & 63, nq = tid >> 6;
#pragma unroll
    for (int k = 0; k < 16; ++k) {
      int n2 = nq + 4 * k;
      dst[(size_t)(n0 + n2) * ldd + k0 + kk] = f2bf(t[kk * 65 + n2]);
    }
  }
  __syncthreads();
}
DEV void phase0(const P& p, char* smem) {
  const int n_ada = 192, n_in = DEPTH * 16 * 90, n_out = DEPTH * 24 * 16, n_g = 128, n_lb = 4;
  const int total = n_ada + n_in + n_out + n_g + n_lb;
  for (int it = blockIdx.x; it < total; it += gridDim.x) {
    int i = it;
    if (i < n_ada) { ph0_ada(p, i, smem); continue; }
    i -= n_ada;
    if (i < n_in) {
      int l = i / 1440, r = i % 1440, kt = r / 90, nt = r % 90;
      tconv_tile(p.w_in + (size_t)l * 1024 * 5648, 5648, (u16*)(p.ws + O_WTIN) + (size_t)l * NZ * 1024, 1024, kt * 64,
                 nt * 64, true, smem);
      continue;
    }
    i -= n_in;
    if (i < n_out) {
      int l = i / 384, r = i % 384, kt = r / 16, nt = r % 16;
      tconv_tile(p.w_out + (size_t)l * 1536 * 1024, 1024, (u16*)(p.ws + O_WTOUT) + (size_t)l * 1024 * 1536, 1536,
                 kt * 64, nt * 64, false, smem);
      continue;
    }
    i -= n_out;
    if (i < n_g) {
      int h = i & 7, gate = (i >> 3) & 1, dir = (i >> 4) & 1, l = i >> 5;
      const float* src = (gate ? p.rg_w_i : p.rg_w_r) + ((size_t)(l * 2 + dir) * 8 + h) * 4096;
      tconv_tile(src, 64, (u16*)(p.ws + O_WGT) + (size_t)i * 4096, 64, 0, 0, false, smem);
      continue;
    }
    i -= n_g;
    {
      int j = i * 256 + threadIdx.x;
      float v[4], mx = -1e30f;
      for (int l = 0; l < 4; ++l) { v[l] = p.hg_lb[l * 1024 + j]; mx = fmaxf(mx, v[l]); }
      float s = 0.f;
      for (int l = 0; l < 4; ++l) { v[l] = __expf(v[l] - mx); s += v[l]; }
      float* lbs = (float*)(p.ws + O_LBS);
      float cum = 0.f;
      for (int l = 0; l < 4; ++l) {
        if (l > 0) cum += v[l] / s;
        lbs[l * 1024 + j] = cum;
      }
    }
  }
}

DEV void phaseR(const P& p, int g, int l) {
  const int tid_ = opq(threadIdx.x); const int lane = tid_ & 63, w = tid_ >> 6;
  const float* mod = (const float*)(p.ws + O_MOD);
  float* hc = (float*)(p.ws + O_HC);
  const float* o = (const float*)(p.ws + O_BSH);
  u16* u = (u16*)(p.ws + O_BIT);
  for (int it = blockIdx.x; it < GR / 4; it += gridDim.x) {
    int lr = it * 4 + w;
    int lb = lr / TS, s = lr % TS;
    bool isctx = s < TCX;
    if (l == DEPTH && isctx) continue;
    int b = g * GB + lb, t = s - TCX;
    int mi = isctx ? 8 : b;
    float* hp = isctx ? hc + ((size_t)lb * TCX + s) * 1024 : p.out + ((size_t)b * TL + t) * 1024;
    float hv[16];
    if (l == 0) {
      const float* src = isctx ? p.ctx + ((size_t)b * TCX + s) * 1024 : p.x + ((size_t)b * TL + t) * 1024;
#pragma unroll
      for (int k = 0; k < 4; ++k) {
        float4 v = *(const float4*)(src + k * 256 + lane * 4);
        hv[k * 4] = v.x; hv[k * 4 + 1] = v.y; hv[k * 4 + 2] = v.z; hv[k * 4 + 3] = v.w;
      }
    } else {
      int orow = lb * TS + (isctx ? s : TCX + lat_map(l - 1, t));
      const float* op = o + (size_t)orow * 1024;
      float ov[16], ss = 0.f;
#pragma unroll
      for (int k = 0; k < 4; ++k) {
        float4 v = *(const float4*)(op + k * 256 + lane * 4);
        ov[k * 4] = v.x; ov[k * 4 + 1] = v.y; ov[k * 4 + 2] = v.z; ov[k * 4 + 3] = v.w;
        ss += v.x * v.x + v.y * v.y + v.z * v.z + v.w * v.w;
      }
#pragma unroll
      for (int off = 32; off; off >>= 1) ss += __shfl_xor(ss, off);
      float rinv = rsqrtf(ss * (1.f / 1024.f) + EPS);
      const float* gate = mod + ((size_t)(l - 1) * 9 + mi) * 3072 + 2048;
      const float* wp = p.norm_post + (l - 1) * 1024;
#pragma unroll
      for (int k = 0; k < 4; ++k) {
        float4 hh = *(const float4*)(hp + k * 256 + lane * 4);
        float4 gg = *(const float4*)(gate + k * 256 + lane * 4);
        float4 ww = *(const float4*)(wp + k * 256 + lane * 4);
        hv[k * 4] = hh.x + gg.x * (ov[k * 4] * rinv * ww.x);
        hv[k * 4 + 1] = hh.y + gg.y * (ov[k * 4 + 1] * rinv * ww.y);
        hv[k * 4 + 2] = hh.z + gg.z * (ov[k * 4 + 2] * rinv * ww.z);
        hv[k * 4 + 3] = hh.w + gg.w * (ov[k * 4 + 3] * rinv * ww.w);
      }
    }
#pragma unroll
    for (int k = 0; k < 4; ++k)
      *(float4*)(hp + k * 256 + lane * 4) = make_float4(hv[k * 4], hv[k * 4 + 1], hv[k * 4 + 2], hv[k * 4 + 3]);
    if (l < DEPTH) {
      float ss = 0.f;
#pragma unroll
      for (int k = 0; k < 16; ++k) ss += hv[k] * hv[k];
#pragma unroll
      for (int off = 32; off; off >>= 1) ss += __shfl_xor(ss, off);
      float rinv = rsqrtf(ss * (1.f / 1024.f) + EPS);
      const float* sh = mod + ((size_t)l * 9 + mi) * 3072;
      const float* wp = p.norm_pre + l * 1024;
      int urow = lb * TS + (isctx ? s : TCX + lat_map(l, t));
      u16* up = u + (size_t)urow * 1024;
#pragma unroll
      for (int k = 0; k < 4; ++k) {
        float4 ww = *(const float4*)(wp + k * 256 + lane * 4);
        float4 s0 = *(const float4*)(sh + k * 256 + lane * 4);
        float4 s1 = *(const float4*)(sh + 1024 + k * 256 + lane * 4);
        float a0 = hv[k * 4] * rinv * ww.x * (1.f + s1.x) + s0.x;
        float a1 = hv[k * 4 + 1] * rinv * ww.y * (1.f + s1.y) + s0.y;
        float a2 = hv[k * 4 + 2] * rinv * ww.z * (1.f + s1.z) + s0.z;
        float a3 = hv[k * 4 + 3] * rinv * ww.w * (1.f + s1.w) + s0.w;
        uint2 pk; pk.x = pk2(a0, a1); pk.y = pk2(a2, a3);
        *(uint2*)(up + k * 256 + lane * 4) = pk;
      }
    }
  }
}

template <int MODE>
DEV void gemm_tile(const u16* __restrict__ A, int lda, const u16* __restrict__ Bt, int K, int rt, int ct, u16* z,
                   u16* zT, float* ab, float* o, char* smem) {
  u16* As = (u16*)smem;
  u16* Bs = As + 128 * 72;
  const int tid = opq(threadIdx.x), lane = tid & 63, w = tid >> 6, wr = w >> 1, wc = w & 1, fr = lane & 15, fq = lane >> 4;
  const int lrow = tid >> 3, lseg = tid & 7;
  const u16* Ag = A + (size_t)(rt * 128 + lrow) * lda + lseg * 8;
  const u16* Bg = Bt + (size_t)(ct * 128 + lrow) * K + lseg * 8;
  uint4 pa0, pa1, pa2, pa3, pb0, pb1, pb2, pb3;
  uint4 qa0, qa1, qa2, qa3, qb0, qb1, qb2, qb3;
  f32x4 acc[4][4];
#pragma unroll
  for (int i = 0; i < 4; ++i)
#pragma unroll
    for (int j = 0; j < 4; ++j) acc[i][j] = (f32x4){0.f, 0.f, 0.f, 0.f};
  const int nk = K / 64;
#define GLD(S, kk)                                                            \
  {                                                                           \
    const int kc_ = ((kk) < nk ? (kk) : nk - 1) * 64;                         \
    S##a0 = *(const uint4*)(Ag + kc_);                                        \
    S##a1 = *(const uint4*)(Ag + kc_ + (size_t)32 * lda);                     \
    S##a2 = *(const uint4*)(Ag + kc_ + (size_t)64 * lda);                     \
    S##a3 = *(const uint4*)(Ag + kc_ + (size_t)96 * lda);                     \
    S##b0 = *(const uint4*)(Bg + kc_);                                        \
    S##b1 = *(const uint4*)(Bg + kc_ + (size_t)32 * K);                       \
    S##b2 = *(const uint4*)(Bg + kc_ + (size_t)64 * K);                       \
    S##b3 = *(const uint4*)(Bg + kc_ + (size_t)96 * K);                       \
  }
#define GST(S, bufo)                                                          \
  *(uint4*)(As + (bufo) + (lrow)*72 + lseg * 8) = S##a0;                      \
  *(uint4*)(As + (bufo) + (lrow + 32) * 72 + lseg * 8) = S##a1;               \
  *(uint4*)(As + (bufo) + (lrow + 64) * 72 + lseg * 8) = S##a2;               \
  *(uint4*)(As + (bufo) + (lrow + 96) * 72 + lseg * 8) = S##a3;               \
  *(uint4*)(Bs + (bufo) + (lrow)*72 + lseg * 8) = S##b0;                      \
  *(uint4*)(Bs + (bufo) + (lrow + 32) * 72 + lseg * 8) = S##b1;               \
  *(uint4*)(Bs + (bufo) + (lrow + 64) * 72 + lseg * 8) = S##b2;               \
  *(uint4*)(Bs + (bufo) + (lrow + 96) * 72 + lseg * 8) = S##b3;
#define GCOMP(cb)                                                                                           \
  _Pragma("unroll") for (int ks = 0; ks < 2; ++ks) {                                                        \
    bf16x8 af[4], bfr[4];                                                                                   \
    _Pragma("unroll") for (int mi = 0; mi < 4; ++mi)                                                        \
        af[mi] = ld8(As + (cb) + (wr * 64 + mi * 16 + fr) * 72 + ks * 32 + fq * 8);                         \
    _Pragma("unroll") for (int ni = 0; ni < 4; ++ni)                                                        \
        bfr[ni] = ld8(Bs + (cb) + (wc * 64 + ni * 16 + fr) * 72 + ks * 32 + fq * 8);                        \
    _Pragma("unroll") for (int mi = 0; mi < 4; ++mi)                                                        \
        _Pragma("unroll") for (int ni = 0; ni < 4; ++ni) acc[mi][ni] = mfma(af[mi], bfr[ni], acc[mi][ni]);  \
  }
  constexpr int BUF1 = 2 * 128 * 72;
  GLD(p, 0)
  GLD(q, 1)
  GST(p, 0)
  __syncthreads();
  GLD(p, 2)
  for (int kt = 0; kt < nk; kt += 2) {
    GCOMP(0)
    GST(q, BUF1)
    GLD(q, kt + 3)
    __syncthreads();
    GCOMP(BUF1)
    GST(p, 0)
    GLD(p, kt + 4)
    __syncthreads();
  }
#pragma unroll
  for (int mi = 0; mi < 4; ++mi)
#pragma unroll
    for (int ni = 0; ni < 4; ++ni) {
      int row0 = rt * 128 + wr * 64 + mi * 16 + fq * 4;
      int col = ct * 128 + wc * 64 + ni * 16 + fr;
      f32x4 v = acc[mi][ni];
      if (MODE == 1) {
#pragma unroll
        for (int r = 0; r < 4; ++r) o[(size_t)(row0 + r) * 1024 + col] = v[r];
      } else {
        if (ct >= 28 && ct < 32) {
          uint2 pk; pk.x = pk2(v[0], v[1]); pk.y = pk2(v[2], v[3]);
          *(uint2*)(zT + (size_t)(col - C_IC) * GR + row0) = pk;
        } else if (ct == 44) {
          if (col - C_AB < 16) {
#pragma unroll
            for (int r = 0; r < 4; ++r) ab[(size_t)(row0 + r) * 16 + (col - C_AB)] = v[r];
          }
        } else {
#pragma unroll
          for (int r = 0; r < 4; ++r) z[(size_t)(row0 + r) * NZ + col] = f2bf(v[r]);
        }
      }
    }
}

DEV void a_item(const P& p, int l, int item, int mode, char* smem) {
  float* xc = (float*)smem;
  u16* xcb = (u16*)(smem + 16384);
  float* av = (float*)(smem + 16384 + 9216);
  float* uv = av + 4096;
  float* segP = uv + 4096;
  float* segH = segP + 256;
  const int tid = opq(threadIdx.x), lane = tid & 63, w = tid >> 6, fr = lane & 15, fq = lane >> 4;
  const int cgk = item >> 3, hA = item & 7, n = cgk % 36, rb = cgk * 64;
  u16* z = (u16*)(p.ws + O_Z);
  for (int idx = tid; idx < 4096; idx += 256) {
    int c = idx >> 6, j = idx & 63, ch = hA * 64 + j;
    float val = p.conv_a_b[l * 512 + ch];
#pragma unroll
    for (int tap = 0; tap < 4; ++tap) val += p.conv_a_w[(l * 4 + tap) * 512 + ch] * zval(z, rb, c + tap - 2, n, C_XA + ch);
    xc[idx] = val;
    xcb[c * 72 + j] = f2bf(val);
  }
  __syncthreads();
  float yacc[16];
#pragma unroll
  for (int k = 0; k < 16; ++k) yacc[k] = 0.f;
  const int seg = tid >> 6, sj = tid & 63, sch = hA * 64 + sj;
  for (int dir = 0; dir < 2; ++dir) {
    {
      const u16* wg = (const u16*)(p.ws + O_WGT);
      const u16* wr_ = wg + (size_t)((((l * 2 + dir) * 2 + 0) * 8 + hA)) * 4096;
      const u16* wi_ = wg + (size_t)((((l * 2 + dir) * 2 + 1) * 8 + hA)) * 4096;
      bf16x8 a0 = ld8(xcb + (16 * w + fr) * 72 + fq * 8), a1 = ld8(xcb + (16 * w + fr) * 72 + 32 + fq * 8);
#pragma unroll
      for (int nt = 0; nt < 4; ++nt) {
        f32x4 ar = {0.f, 0.f, 0.f, 0.f}, ai = {0.f, 0.f, 0.f, 0.f};
        const u16* br = wr_ + (nt * 16 + fr) * 64 + fq * 8;
        const u16* bi = wi_ + (nt * 16 + fr) * 64 + fq * 8;
        ar = mfma(a0, ld8(br), ar); ar = mfma(a1, ld8(br + 32), ar);
        ai = mfma(a0, ld8(bi), ai); ai = mfma(a1, ld8(bi + 32), ai);
        int j = nt * 16 + fr, ch = hA * 64 + j;
        float brv = p.rg_b_r[(l * 2 + dir) * 512 + ch], biv = p.rg_b_i[(l * 2 + dir) * 512 + ch];
        float sp = softplus(-p.rg_lam[(l * 2 + dir) * 512 + ch]);
#pragma unroll
        for (int r = 0; r < 4; ++r) {
          int c = 16 * w + 4 * fq + r;
          float rg = sigm(ar[r] + brv), ig = sigm(ai[r] + biv);
          float la = -8.f * rg * sp;
          float a = __expf(la);
          float t2 = 2.f * la;
          float om = (t2 > -0.02f) ? -t2 * (1.f + 0.5f * t2 * (1.f + t2 * (1.f / 3.f) * (1.f + 0.25f * t2))) : 1.f - a * a;
          float uu = sqrtf(fmaxf(om, 0.f)) * (ig * xc[c * 64 + j]);
          av[c * 64 + j] = bf2f(f2bf(la));
          uv[c * 64 + j] = bf2f(f2bf(uu));
        }
      }
    }
    __syncthreads();
    {
      float ls = 0.f, H = 0.f;
      u16* ALA = (u16*)(p.ws + O_ALA);
      u16* AU = (u16*)(p.ws + O_AU);
#pragma unroll
      for (int k = 0; k < 16; ++k) {
        int c = dir ? (16 * seg + 15 - k) : (16 * seg + k);
        float la_ = av[c * 64 + sj], u_ = uv[c * 64 + sj];
        H = __expf(la_) * H + u_;
        ls += la_;
        size_t gi = ((size_t)dir * GR + rb + c) * 512 + sch;
        ALA[gi] = f2bf(la_);
        AU[gi] = f2bf(u_);
      }
      segP[seg * 64 + sj] = __expf(ls);
      segH[seg * 64 + sj] = H;
    }
    __syncthreads();
    if (mode == 0) {
      if (seg == 0) {
        float Pc = 1.f, Hc = 0.f;
        for (int q = 0; q < 4; ++q) {
          int sg = dir ? 3 - q : q;
          Hc = segP[sg * 64 + sj] * Hc + segH[sg * 64 + sj];
          Pc *= segP[sg * 64 + sj];
        }
        size_t idx = ((size_t)cgk * 2 + dir) * 512 + sch;
        ((float*)(p.ws + O_AP))[idx] = Pc;
        ((float*)(p.ws + O_AH))[idx] = Hc;
      }
    } else {
      float st = ((const float*)(p.ws + O_ACAR))[((size_t)cgk * 2 + dir) * 512 + sch];
      int nbefore = dir ? 3 - seg : seg;
      for (int q = 0; q < nbefore; ++q) {
        int sg = dir ? 3 - q : q;
        st = segP[sg * 64 + sj] * st + segH[sg * 64 + sj];
      }
      if (dir == 0) {
#pragma unroll
        for (int k = 0; k < 16; ++k) {
          int c = 16 * seg + k;
          st = av[c * 64 + sj] * st + uv[c * 64 + sj];
          yacc[k] += st;
        }
      } else {
#pragma unroll
        for (int k = 15; k >= 0; --k) {
          int c = 16 * seg + k;
          st = av[c * 64 + sj] * st + uv[c * 64 + sj];
          yacc[k] += st;
        }
      }
    }
    __syncthreads();
  }
  if (mode == 1) {
#pragma unroll
    for (int k = 0; k < 16; ++k) {
      size_t zi = (size_t)(rb + 16 * seg + k) * NZ + C_GA + sch;
      float gate = bf2f(z[zi]);
      z[zi] = f2bf(yacc[k] * silu(gate));
    }
  }
}

DEV void a_fin(const P& p, int l, int item, char* smem) {
  float* segP = (float*)smem;
  float* segH = segP + 512;
  const int tid = opq(threadIdx.x), seg = tid >> 6, sj = tid & 63;
  const int cgk = item >> 3, hA = item & 7, rb = cgk * 64, sch = hA * 64 + sj;
  u16* z = (u16*)(p.ws + O_Z);
  const u16* ALA = (const u16*)(p.ws + O_ALA);
  const u16* AU = (const u16*)(p.ws + O_AU);
  u16 lab[2][16], ub[2][16], gt[16];
#pragma unroll
  for (int dir = 0; dir < 2; ++dir)
#pragma unroll
    for (int k = 0; k < 16; ++k) {
      size_t gi = ((size_t)dir * GR + rb + 16 * seg + k) * 512 + sch;
      lab[dir][k] = ALA[gi];
      ub[dir][k] = AU[gi];
    }
#pragma unroll
  for (int k = 0; k < 16; ++k) gt[k] = z[(size_t)(rb + 16 * seg + k) * NZ + C_GA + sch];
  float car0 = ((const float*)(p.ws + O_ACAR))[((size_t)cgk * 2 + 0) * 512 + sch];
  float car1 = ((const float*)(p.ws + O_ACAR))[((size_t)cgk * 2 + 1) * 512 + sch];
  float af[2][16];
#pragma unroll
  for (int dir = 0; dir < 2; ++dir) {
    float ls = 0.f, H = 0.f;
#pragma unroll
    for (int kk = 0; kk < 16; ++kk) {
      const int k = dir ? 15 - kk : kk;
      float la_ = bf2f(lab[dir][k]);
      float a = __expf(la_);
      af[dir][k] = a;
      H = a * H + bf2f(ub[dir][k]);
      ls += la_;
    }
    segP[(dir * 4 + seg) * 64 + sj] = __expf(ls);
    segH[(dir * 4 + seg) * 64 + sj] = H;
  }
  __syncthreads();
  float yacc[16];
#pragma unroll
  for (int k = 0; k < 16; ++k) yacc[k] = 0.f;
#pragma unroll
  for (int dir = 0; dir < 2; ++dir) {
    float st = dir ? car1 : car0;
    const int nbefore = dir ? 3 - seg : seg;
    for (int q = 0; q < nbefore; ++q) {
      int sg = dir ? 3 - q : q;
      st = segP[(dir * 4 + sg) * 64 + sj] * st + segH[(dir * 4 + sg) * 64 + sj];
    }
#pragma unroll
    for (int kk = 0; kk < 16; ++kk) {
      const int k = dir ? 15 - kk : kk;
      st = af[dir][k] * st + bf2f(ub[dir][k]);
      yacc[k] += st;
    }
  }
#pragma unroll
  for (int k = 0; k < 16; ++k)
    z[(size_t)(rb + 16 * seg + k) * NZ + C_GA + sch] = f2bf(yacc[k] * silu(bf2f(gt[k])));
  __syncthreads();
}

DEV void a_carry(const P& p, int item) {
  int t = item * 256 + threadIdx.x;
  int ch = t & 511, dir = (t >> 9) & 1, lb = t >> 10;
  const float* AP = (const float*)(p.ws + O_AP);
  const float* AH = (const float*)(p.ws + O_AH);
  float* AC = (float*)(p.ws + O_ACAR);
  float st = 0.f;
  for (int j = 0; j < 36; ++j) {
    int n = dir ? (j < 4 ? 3 - j : 39 - j) : j;
    size_t idx = ((size_t)(lb * 36 + n) * 2 + dir) * 512 + ch;
    AC[idx] = st;
    st = AP[idx] * st + AH[idx];
  }
}

DEV void b_local(const P& p, int l, int item, char* smem) {
  u16* qs = (u16*)smem;
  u16* ks = qs + 64 * 136;
  float* Am = (float*)(smem + 34816);
  float* gc = (float*)(smem + 34816 + 32768);
  float* bt = gc + 128;
  const int tid = opq(threadIdx.x), lane = tid & 63, w = tid >> 6, fr = lane & 15, fq = lane >> 4;
  const int cgk = item >> 2, h = item & 3, n = cgk % 36, rb = cgk * 64;
  const u16* z = (const u16*)(p.ws + O_Z);
  u16* qn = (u16*)(p.ws + O_BSH);
  u16* kn = qn + (size_t)GR * 512;
  u16* vb = kn + (size_t)GR * 512;
  u16* knT = vb + (size_t)GR * 512;
  const float* ab = (const float*)(p.ws + O_AB);
  {
    u16* Tt = (u16*)Am;
    uint4 st[5];
#define BL_TLOAD(which)                                                                                  \
  _Pragma("unroll") for (int k = 0; k < 5; ++k) {                                                        \
    int idx = tid + 256 * k, row = idx >> 4, seg = idx & 15, cp = row - 2;                               \
    bool ok = (idx < 1072) && !((cp < 0 && (n == 0 || n == 4)) || (cp > 63 && (n == 3 || n == 35)));    \
    st[k] = make_uint4(0u, 0u, 0u, 0u);                                                                  \
    if (ok) st[k] = *(const uint4*)(z + (size_t)(rb + cp) * NZ + C_Q + (which)*512 + h * 128 + seg * 8); \
  }
    BL_TLOAD(0)
#pragma unroll
    for (int which = 0; which < 3; ++which) {
#pragma unroll
      for (int k = 0; k < 5; ++k) {
        int idx = tid + 256 * k, row = idx >> 4, seg = idx & 15;
        if (idx < 1072) *(uint4*)(Tt + row * 136 + seg * 8) = st[k];
      }
      __syncthreads();
      if (which < 2) { BL_TLOAD(which + 1) }
      float cw[2][4];
#pragma unroll
      for (int hh = 0; hh < 2; ++hh)
#pragma unroll
        for (int tap = 0; tap < 4; ++tap)
          cw[hh][tap] = p.conv_b_w[(size_t)(l * 4 + tap) * 1536 + which * 512 + h * 128 + lane + 64 * hh];
      for (int c = w; c < 64; c += 4) {
        float v[2];
#pragma unroll
        for (int hh = 0; hh < 2; ++hh) {
          int d = lane + 64 * hh;
          float a = 0.f;
#pragma unroll
          for (int tap = 0; tap < 4; ++tap) a += cw[hh][tap] * bf2f(Tt[(c + tap) * 136 + d]);
          v[hh] = silu(a);
        }
        float rs = 1.f;
        if (which < 2) {
          float sq = v[0] * v[0] + v[1] * v[1];
#pragma unroll
          for (int off = 32; off; off >>= 1) sq += __shfl_xor(sq, off);
          rs = rsqrtf(sq + EPS) * (which == 0 ? 0.08838834764831845f : 1.f);
        }
#pragma unroll
        for (int hh = 0; hh < 2; ++hh) {
          int d = lane + 64 * hh;
          u16 ob = f2bf(v[hh] * rs);
          size_t gi = (size_t)(rb + c) * 512 + h * 128 + d;
          if (which == 0) { qs[c * 136 + d] = ob; qn[gi] = ob; }
          else if (which == 1) { ks[c * 136 + d] = ob; kn[gi] = ob; }
          else vb[gi] = ob;
        }
      }
      __syncthreads();
    }
  }
  if (w < 2) {
    int dir = w, i = lane, c = dir ? 63 - i : i;
    float al = ab[(size_t)(rb + c) * 16 + dir * 4 + h], bl = ab[(size_t)(rb + c) * 16 + 8 + dir * 4 + h];
    float g = -__expf(p.gdn_a_log[(l * 2 + dir) * 4 + h]) * softplus(al + p.gdn_dt_bias[(l * 2 + dir) * 4 + h]);
#pragma unroll
    for (int off = 1; off < 64; off <<= 1) {
      float v = __shfl_up(g, off);
      if (lane >= off) g += v;
    }
    gc[dir * 64 + i] = g;
    bt[dir * 64 + i] = sigm(bl);
  }
  __syncthreads();
  for (int idx = tid; idx < 1024; idx += 256) {
    int d = idx >> 3, c8 = idx & 7;
    uint4 pk;
    pk.x = (unsigned)ks[(c8 * 8 + 0) * 136 + d] | ((unsigned)ks[(c8 * 8 + 1) * 136 + d] << 16);
    pk.y = (unsigned)ks[(c8 * 8 + 2) * 136 + d] | ((unsigned)ks[(c8 * 8 + 3) * 136 + d] << 16);
    pk.z = (unsigned)ks[(c8 * 8 + 4) * 136 + d] | ((unsigned)ks[(c8 * 8 + 5) * 136 + d] << 16);
    pk.w = (unsigned)ks[(c8 * 8 + 6) * 136 + d] | ((unsigned)ks[(c8 * 8 + 7) * 136 + d] << 16);
    *(uint4*)(knT + ((size_t)(cgk * 4 + h) * 128 + d) * 64 + c8 * 8) = pk;
  }
  for (int dir = 0; dir < 2; ++dir) {
    char* rec = p.ws + O_BIT + ((size_t)(cgk * 4 + h) * 2 + dir) * BIT_SZ;
    u16* QKm = (u16*)rec + 4096;
    float* scal = (float*)(rec + 16384);
    int irow = 16 * w + fr, ci = dir ? 63 - irow : irow;
    bf16x8 ak[4], aq[4];
#pragma unroll
    for (int s = 0; s < 4; ++s) { ak[s] = ld8(ks + ci * 136 + 32 * s + 8 * fq); aq[s] = ld8(qs + ci * 136 + 32 * s + 8 * fq); }
#pragma unroll
    for (int nt = 0; nt < 4; ++nt) {
      int jcol = 16 * nt + fr, cj = dir ? 63 - jcol : jcol;
      f32x4 kk = {0.f, 0.f, 0.f, 0.f}, qk = {0.f, 0.f, 0.f, 0.f};
#pragma unroll
      for (int s = 0; s < 4; ++s) {
        bf16x8 b = ld8(ks + cj * 136 + 32 * s + 8 * fq);
        kk = mfma(ak[s], b, kk);
        qk = mfma(aq[s], b, qk);
      }
      float gj = gc[dir * 64 + jcol];
#pragma unroll
      for (int r = 0; r < 4; ++r) {
        int i = 16 * w + 4 * fq + r;
        float dec = (jcol <= i) ? __expf(gc[dir * 64 + i] - gj) : 0.f;
        Am[(dir * 64 + i) * 64 + jcol] = (jcol < i) ? bt[dir * 64 + i] * kk[r] * dec : 0.f;
        QKm[i * 64 + jcol] = f2bf(qk[r] * dec);
      }
    }
    if (tid < 64) {
      float gl = gc[dir * 64 + 63], gi = gc[dir * 64 + tid];
      scal[tid] = __expf(gi);
      scal[64 + tid] = bt[dir * 64 + tid];
      scal[128 + tid] = __expf(gl - gi);
      if (tid == 0) scal[192] = __expf(gl);
    }
  }
  __syncthreads();
  if (w < 2) {
    int dir = w, col = lane;
    u16* Tinv = (u16*)(p.ws + O_BIT + ((size_t)(cgk * 4 + h) * 2 + dir) * BIT_SZ);
    const float* Ad = Am + dir * 4096;
    float T[64];
#pragma unroll
    for (int i = 0; i < 64; ++i) {
      float s = (i == col) ? 1.f : 0.f;
#pragma unroll
      for (int j = 0; j < i; ++j) s -= Ad[i * 64 + j] * T[j];
      T[i] = s;
      Tinv[i * 64 + col] = f2bf(s);
      __builtin_amdgcn_sched_barrier(0);
    }
  }
  __syncthreads();
}

DEV void b_seq(const P& p, int bitem, char* smem) {
  const int tid = opq(threadIdx.x), lane = tid & 63, w = tid >> 6, fr = lane & 15, fq = lane >> 4;
  const bool active = w < WPB;
  const int item = bitem * WPB + (active ? w : 0);
  const int slice = item & 7, dir = (item >> 3) & 1, h = (item >> 4) & 3, lb = item >> 6, e0 = slice * 16;
  u16* Ss = (u16*)(smem + w * 11264);
  u16* Rs = Ss + 16 * 136;
  u16* Vsc = Rs + 16 * 72;
  u16* Vor = Vsc + 16 * 72;
  const u16* qn = (const u16*)(p.ws + O_BSH);
  const u16* kn = qn + (size_t)GR * 512;
  const u16* vb = kn + (size_t)GR * 512;
  const u16* knT = vb + (size_t)GR * 512;
  u16* OB = (u16*)(p.ws + O_OB);
  f32x4 S[8];
#pragma unroll
  for (int m = 0; m < 8; ++m) S[m] = (f32x4){0.f, 0.f, 0.f, 0.f};
  for (int j = 0; j < 36; ++j) {
    const int n = dir ? (j < 4 ? 3 - j : 39 - j) : j;
    const int cgk = lb * 36 + n, rb = cgk * 64;
    const char* rec = p.ws + O_BIT + ((size_t)(cgk * 4 + h) * 2 + dir) * BIT_SZ;
    const u16* Tinv = (const u16*)rec;
    const u16* QKm = Tinv + 4096;
    const float* scal = (const float*)(rec + 16384);
    if (active) {
#pragma unroll
      for (int m = 0; m < 8; ++m) {
        uint2 pk; pk.x = pk2(S[m][0], S[m][1]); pk.y = pk2(S[m][2], S[m][3]);
        *(uint2*)(Ss + fr * 136 + 16 * m + 4 * fq) = pk;
      }
    }
    __syncthreads();
    bf16x8 Sf[4];
    if (active) {
#pragma unroll
      for (int s = 0; s < 4; ++s) Sf[s] = ld8(Ss + fr * 136 + 32 * s + 8 * fq);
#pragma unroll
      for (int m = 0; m < 4; ++m) {
        int i = 16 * m + fr, rowi = rb + (dir ? 63 - i : i);
        f32x4 X = {0.f, 0.f, 0.f, 0.f};
#pragma unroll
        for (int s = 0; s < 4; ++s) X = mfma(ld8(kn + (size_t)rowi * 512 + h * 128 + 32 * s + 8 * fq), Sf[s], X);
        float rv[4];
#pragma unroll
        for (int r = 0; r < 4; ++r) {
          int ii = 16 * m + 4 * fq + r, rowr = rb + (dir ? 63 - ii : ii);
          float v = bf2f(vb[(size_t)rowr * 512 + h * 128 + e0 + fr]);
          rv[r] = scal[64 + ii] * (v - scal[ii] * X[r]);
        }
        uint2 pk; pk.x = pk2(rv[0], rv[1]); pk.y = pk2(rv[2], rv[3]);
        *(uint2*)(Rs + fr * 72 + 16 * m + 4 * fq) = pk;
      }
    }
    __syncthreads();
    if (active) {
      bf16x8 Rf0 = ld8(Rs + fr * 72 + 8 * fq), Rf1 = ld8(Rs + fr * 72 + 32 + 8 * fq);
#pragma unroll
      for (int m = 0; m < 4; ++m) {
        f32x4 VN = {0.f, 0.f, 0.f, 0.f};
        VN = mfma(ld8(Tinv + (16 * m + fr) * 64 + 8 * fq), Rf0, VN);
        VN = mfma(ld8(Tinv + (16 * m + fr) * 64 + 32 + 8 * fq), Rf1, VN);
        uint2 pk; pk.x = pk2(VN[0], VN[1]); pk.y = pk2(VN[2], VN[3]);
        *(uint2*)(Vsc + fr * 72 + 16 * m + 4 * fq) = pk;
        int ib = 16 * m + 4 * fq;
        float s0 = VN[0] * scal[128 + ib], s1 = VN[1] * scal[128 + ib + 1], s2 = VN[2] * scal[128 + ib + 2],
              s3 = VN[3] * scal[128 + ib + 3];
        if (dir) {
          pk.x = pk2(s3, s2); pk.y = pk2(s1, s0);
          *(uint2*)(Vor + fr * 72 + (60 - ib)) = pk;
        } else {
          pk.x = pk2(s0, s1); pk.y = pk2(s2, s3);
          *(uint2*)(Vor + fr * 72 + ib) = pk;
        }
      }
    }
    __syncthreads();
    if (active) {
      bf16x8 Vs0 = ld8(Vsc + fr * 72 + 8 * fq), Vs1 = ld8(Vsc + fr * 72 + 32 + 8 * fq);
      bf16x8 Vo0 = ld8(Vor + fr * 72 + 8 * fq), Vo1 = ld8(Vor + fr * 72 + 32 + 8 * fq);
#pragma unroll
      for (int m = 0; m < 4; ++m) {
        int i = 16 * m + fr, rowi = rb + (dir ? 63 - i : i);
        f32x4 O = {0.f, 0.f, 0.f, 0.f};
#pragma unroll
        for (int s = 0; s < 4; ++s) O = mfma(ld8(qn + (size_t)rowi * 512 + h * 128 + 32 * s + 8 * fq), Sf[s], O);
#pragma unroll
        for (int r = 0; r < 4; ++r) O[r] *= scal[16 * m + 4 * fq + r];
        O = mfma(ld8(QKm + (16 * m + fr) * 64 + 8 * fq), Vs0, O);
        O = mfma(ld8(QKm + (16 * m + fr) * 64 + 32 + 8 * fq), Vs1, O);
#pragma unroll
        for (int r = 0; r < 4; ++r) {
          int ii = 16 * m + 4 * fq + r, rowr = rb + (dir ? 63 - ii : ii);
          OB[((size_t)dir * GR + rowr) * 512 + h * 128 + e0 + fr] = f2bf(O[r]);
        }
      }
      float egl = scal[192];
#pragma unroll
      for (int m = 0; m < 8; ++m) {
        const u16* kt = knT + ((size_t)(cgk * 4 + h) * 128 + 16 * m + fr) * 64;
        f32x4 t = S[m];
#pragma unroll
        for (int r = 0; r < 4; ++r) t[r] *= egl;
        t = mfma(ld8(kt + 8 * fq), Vo0, t);
        t = mfma(ld8(kt + 32 + 8 * fq), Vo1, t);
        S[m] = t;
      }
    }
  }
  __syncthreads();
}

DEV void c_local(const P& p, int l, int item, char* smem) {
  float* bsm = (float*)smem;
  u16* Ps = (u16*)(smem + 33024);
  u16* kdt = (u16*)(smem + 33024 + 9216);
  const int tid = opq(threadIdx.x), lane = tid & 63, w = tid >> 6, fr = lane & 15, fq = lane >> 4;
  const int cgk = item >> 2, h = item & 3, rb = cgk * 64;
  const u16* z = (const u16*)(p.ws + O_Z);
  const u16* zT = (const u16*)(p.ws + O_ZT);
  u16* OC = (u16*)(p.ws + O_OC);
  const float* lbs = (const float*)(p.ws + O_LBS);
  for (int dir = 0; dir < 2; ++dir) {
    char* rec = p.ws + O_CREC + ((size_t)(cgk * 4 + h) * 2 + dir) * CREC_SZ;
    u16* QD = (u16*)rec;
    u16* KDT = QD + 8192;
    float* decv = (float*)(rec + 32768);
    const float* lbp = lbs + l * 1024 + dir * 512 + h * 128;
    const int fcol = C_F0 + dir * 512 + h * 128;
    {
      int d = tid & 127, half = tid >> 7;
      float lb_ = lbp[d], run = 0.f;
      for (int k = 0; k < 32; ++k) {
        int i = 32 * half + k, c = dir ? 63 - i : i;
        float f = bf2f(z[(size_t)(rb + c) * NZ + fcol + d]);
        float fg = lb_ + (1.f - lb_) * sigm(f);
        run += __logf(fg);
        bsm[i * 129 + d] = run;
      }
    }
    __syncthreads();
    {
      int d = tid & 127, half = tid >> 7;
      if (half) {
        float add = bsm[31 * 129 + d];
        for (int k = 0; k < 32; ++k) bsm[(32 + k) * 129 + d] += add;
      }
    }
    __syncthreads();
    for (int idx = tid; idx < 8192; idx += 256) {
      int i = idx >> 7, d = idx & 127, c = dir ? 63 - i : i;
      float b = bsm[i * 129 + d];
      float q = silu(bf2f(z[(size_t)(rb + c) * NZ + C_QC + h * 128 + d]));
      QD[i * 128 + d] = f2bf(q * __expf(b));
      float f = bf2f(z[(size_t)(rb + c) * NZ + fcol + d]);
      float k = (1.f - lbp[d]) * sigm(-f);
      kdt[d * 72 + c] = f2bf(k * __expf(bsm[63 * 129 + d] - b));
    }
    if (tid < 128) decv[tid] = __expf(bsm[63 * 129 + tid]);
    __syncthreads();
    for (int idx = tid; idx < 1024; idx += 256) {
      int d = idx >> 3, c8 = idx & 7;
      *(uint4*)(KDT + d * 64 + c8 * 8) = *(const uint4*)(kdt + d * 72 + c8 * 8);
    }
    {
      const int sj = w;
      for (int si = 0; si < 4; ++si) {
        f32x4 acc = {0.f, 0.f, 0.f, 0.f};
        if (si >= sj) {
          int it = 16 * si + fr, jt = 16 * sj + fr;
          int ci = dir ? 63 - it : it, cj = dir ? 63 - jt : jt;
#pragma unroll
          for (int s = 0; s < 4; ++s) {
            int d0 = 32 * s + 8 * fq;
            bf16x8 qv = ld8(z + (size_t)(rb + ci) * NZ + C_QC + h * 128 + d0);
            bf16x8 fv = ld8(z + (size_t)(rb + cj) * NZ + fcol + d0);
            bf16x8 af, bf;
#pragma unroll
            for (int e = 0; e < 8; ++e) {
              int d = d0 + e;
              float Bs_ = si ? bsm[(16 * si - 1) * 129 + d] : 0.f;
              float qq = silu(bf2f((u16)qv[e])) * __expf(bsm[it * 129 + d] - Bs_);
              float kk = (1.f - lbp[d]) * sigm(-bf2f((u16)fv[e])) * __expf(Bs_ - bsm[jt * 129 + d]);
              af[e] = (short)f2bf(qq);
              bf[e] = (short)f2bf(kk);
            }
            acc = mfma(af, bf, acc);
          }
        }
#pragma unroll
        for (int r = 0; r < 4; ++r) {
          int i = 16 * si + 4 * fq + r, jj = 16 * sj + fr;
          float v = (si >= sj && jj <= i) ? acc[r] : 0.f;
          Ps[i * 72 + (dir ? 63 - jj : jj)] = f2bf(v);
        }
        __builtin_amdgcn_sched_barrier(0);
      }
    }
    __syncthreads();
#pragma unroll
    for (int nt2 = 0; nt2 < 2; ++nt2) {
      int e = h * 128 + (2 * w + nt2) * 16 + fr;
      bf16x8 v0 = ld8(zT + (size_t)e * GR + rb + 8 * fq), v1 = ld8(zT + (size_t)e * GR + rb + 32 + 8 * fq);
#pragma unroll
      for (int m = 0; m < 4; ++m) {
        f32x4 O = {0.f, 0.f, 0.f, 0.f};
        O = mfma(ld8(Ps + (16 * m + fr) * 72 + 8 * fq), v0, O);
        O = mfma(ld8(Ps + (16 * m + fr) * 72 + 32 + 8 * fq), v1, O);
#pragma unroll
        for (int r = 0; r < 4; ++r) {
          int ii = 16 * m + 4 * fq + r, rowr = rb + (dir ? 63 - ii : ii);
          OC[((size_t)dir * GR + rowr) * 512 + e] = f2bf(O[r]);
        }
      }
    }
    __syncthreads();
  }
}

DEV void c_seq(const P& p, int bitem, char* smem) {
  const int tid = opq(threadIdx.x), lane = tid & 63, w = tid >> 6, fr = lane & 15, fq = lane >> 4;
  const bool active = w < WPB;
  const int item = bitem * WPB + (active ? w : 0);
  const int slice = item & 7, dir = (item >> 3) & 1, h = (item >> 4) & 3, lb = item >> 6, e0 = slice * 16;
  u16* Ss = (u16*)(smem + w * 4352);
  const u16* zT = (const u16*)(p.ws + O_ZT);
  u16* OC = (u16*)(p.ws + O_OC);
  f32x4 S[8];
#pragma unroll
  for (int m = 0; m < 8; ++m) S[m] = (f32x4){0.f, 0.f, 0.f, 0.f};
  for (int j = 0; j < 36; ++j) {
    const int n = dir ? (j < 4 ? 3 - j : 39 - j) : j;
    const int cgk = lb * 36 + n, rb = cgk * 64;
    const char* rec = p.ws + O_CREC + ((size_t)(cgk * 4 + h) * 2 + dir) * CREC_SZ;
    const u16* QD = (const u16*)rec;
    const u16* KDT = QD + 8192;
    const float* decv = (const float*)(rec + 32768);
    if (active) {
#pragma unroll
      for (int m = 0; m < 8; ++m) {
        uint2 pk; pk.x = pk2(S[m][0], S[m][1]); pk.y = pk2(S[m][2], S[m][3]);
        *(uint2*)(Ss + fr * 136 + 16 * m + 4 * fq) = pk;
      }
    }
    __syncthreads();
    if (active) {
      bf16x8 Sf[4];
#pragma unroll
      for (int s = 0; s < 4; ++s) Sf[s] = ld8(Ss + fr * 136 + 32 * s + 8 * fq);
#pragma unroll
      for (int m = 0; m < 4; ++m) {
        f32x4 O = {0.f, 0.f, 0.f, 0.f};
#pragma unroll
        for (int s = 0; s < 4; ++s) O = mfma(ld8(QD + (16 * m + fr) * 128 + 32 * s + 8 * fq), Sf[s], O);
#pragma unroll
        for (int r = 0; r < 4; ++r) {
          int ii = 16 * m + 4 * fq + r, rowr = rb + (dir ? 63 - ii : ii);
          size_t oi = ((size_t)dir * GR + rowr) * 512 + h * 128 + e0 + fr;
          OC[oi] = f2bf(bf2f(OC[oi]) + O[r]);
        }
      }
      const u16* vp = zT + (size_t)(h * 128 + e0 + fr) * GR + rb;
      bf16x8 V0 = ld8(vp + 8 * fq), V1 = ld8(vp + 32 + 8 * fq);
#pragma unroll
      for (int m = 0; m < 8; ++m) {
        f32x4 t = S[m];
#pragma unroll
        for (int r = 0; r < 4; ++r) t[r] *= decv[16 * m + 4 * fq + r];
        t = mfma(ld8(KDT + (16 * m + fr) * 64 + 8 * fq), V0, t);
        t = mfma(ld8(KDT + (16 * m + fr) * 64 + 32 + 8 * fq), V1, t);
        S[m] = t;
      }
    }
    __syncthreads();
  }
}

#define LBAR()                                              \
  do {                                                      \
    asm volatile("s_waitcnt lgkmcnt(0)" ::: "memory");      \
    __builtin_amdgcn_s_barrier();                           \
    asm volatile("" ::: "memory");                          \
  } while (0)
#define CBAR() asm volatile("" ::: "memory")

DEV void c_local2(const P& p, int l, int item, char* smem) {
  float* bsm = (float*)smem;
  u16* Fq = (u16*)(smem + 33024);
  u16* kdt = (u16*)(smem + 50432);
  u16* Ps = kdt;
  const int tid = opq(threadIdx.x), lane = tid & 63, w = tid >> 6, fr = lane & 15, fq = lane >> 4;
  const int cgk = item >> 2, h = item & 3, rb = cgk * 64;
  const u16* z = (const u16*)(p.ws + O_Z);
  const u16* zT = (const u16*)(p.ws + O_ZT);
  u16* OC = (u16*)(p.ws + O_OC);
  const float* lbs = (const float*)(p.ws + O_LBS);
  u16* zq = (u16*)(p.ws + O_Z) + (size_t)rb * NZ + C_QC + h * 128;
  {
    uint4 t4[4];
#pragma unroll
    for (int k = 0; k < 4; ++k) {
      int idx = tid + 256 * k, c = idx >> 4, seg = idx & 15;
      t4[k] = *(const uint4*)(zq + (size_t)c * NZ + seg * 8);
    }
#pragma unroll
    for (int k = 0; k < 4; ++k) {
      int idx = tid + 256 * k, c = idx >> 4, seg = idx & 15;
      unsigned wv[4] = {t4[k].x, t4[k].y, t4[k].z, t4[k].w};
#pragma unroll
      for (int q = 0; q < 4; ++q)
        wv[q] = pk2(silu(bf2f((u16)(wv[q] & 0xffff))), silu(bf2f((u16)(wv[q] >> 16))));
      *(uint4*)(zq + (size_t)c * NZ + seg * 8) = make_uint4(wv[0], wv[1], wv[2], wv[3]);
    }
  }
  __syncthreads();
  for (int dir = 0; dir < 2; ++dir) {
    char* rec = p.ws + O_CREC + ((size_t)(cgk * 4 + h) * 2 + dir) * CREC_SZ;
    u16* QD = (u16*)rec;
    u16* KDT = QD + 8192;
    float* decv = (float*)(rec + 32768);
    const float* lbp = lbs + l * 1024 + dir * 512 + h * 128;
    const int fcol = C_F0 + dir * 512 + h * 128;
    {
      uint4 t4[4];
#pragma unroll
      for (int k = 0; k < 4; ++k) {
        int idx = tid + 256 * k, c = idx >> 4, seg = idx & 15;
        t4[k] = *(const uint4*)(z + (size_t)(rb + c) * NZ + fcol + seg * 8);
      }
#pragma unroll
      for (int k = 0; k < 4; ++k) {
        int idx = tid + 256 * k, c = idx >> 4, seg = idx & 15;
        *(uint4*)(Fq + c * 136 + seg * 8) = t4[k];
      }
    }
    __syncthreads();
    {
      int d = tid & 127, half = tid >> 7;
      float lb_ = lbp[d], run = 0.f;
#pragma unroll 8
      for (int k = 0; k < 32; ++k) {
        int i = 32 * half + k, c = dir ? 63 - i : i;
        float f = bf2f(Fq[c * 136 + d]);
        float fg = lb_ + (1.f - lb_) * sigm(f);
        run += __logf(fg);
        bsm[i * 129 + d] = run;
      }
    }
    __syncthreads();
    {
      int d = tid & 127, half = tid >> 7;
      if (half) {
        float add = bsm[31 * 129 + d];
#pragma unroll 8
        for (int k = 0; k < 32; ++k) bsm[(32 + k) * 129 + d] += add;
      }
    }
    __syncthreads();
    {
      uint4 qv[4];
#pragma unroll
      for (int k = 0; k < 4; ++k) {
        int idx = tid + 256 * k, c = idx >> 4, seg = idx & 15;
        qv[k] = *(const uint4*)(zq + (size_t)c * NZ + seg * 8);
      }
#pragma unroll
      for (int k = 0; k < 4; ++k) {
        int idx = tid + 256 * k, c = idx >> 4, seg = idx & 15, i = dir ? 63 - c : c, d0 = seg * 8;
        unsigned qw[4] = {qv[k].x, qv[k].y, qv[k].z, qv[k].w};
        uint4 fv4 = *(const uint4*)(Fq + c * 136 + d0);
        unsigned fw[4] = {fv4.x, fv4.y, fv4.z, fv4.w};
        unsigned qo[4], ko[4];
#pragma unroll
        for (int q = 0; q < 4; ++q) {
          int d = d0 + 2 * q;
          float b0 = bsm[i * 129 + d], b1 = bsm[i * 129 + d + 1];
          float bl0 = bsm[63 * 129 + d], bl1 = bsm[63 * 129 + d + 1];
          float q0 = bf2f((u16)(qw[q] & 0xffff)), q1 = bf2f((u16)(qw[q] >> 16));
          qo[q] = pk2(q0 * __expf(b0), q1 * __expf(b1));
          float k0 = (1.f - lbp[d]) * sigm(-bf2f((u16)(fw[q] & 0xffff)));
          float k1 = (1.f - lbp[d + 1]) * sigm(-bf2f((u16)(fw[q] >> 16)));
          ko[q] = pk2(k0, k1);
          kdt[d * 72 + c] = f2bf(k0 * __expf(bl0 - b0));
          kdt[(d + 1) * 72 + c] = f2bf(k1 * __expf(bl1 - b1));
        }
        *(uint4*)(QD + i * 128 + d0) = make_uint4(qo[0], qo[1], qo[2], qo[3]);
        *(uint4*)(Fq + c * 136 + d0) = make_uint4(ko[0], ko[1], ko[2], ko[3]);
      }
      if (tid < 128) decv[tid] = __expf(bsm[63 * 129 + tid]);
    }
    __syncthreads();
    for (int idx = tid; idx < 1024; idx += 256) {
      int d = idx >> 3, c8 = idx & 7;
      *(uint4*)(KDT + d * 64 + c8 * 8) = *(const uint4*)(kdt + d * 72 + c8 * 8);
    }
    bf16x8 qf[3][4];
#pragma unroll
    for (int t = 0; t < 3; ++t) {
      int k = w + 4 * t;
      int si = k < 4 ? 3 : (k < 7 ? 2 : (k < 9 ? 1 : 0));
      int it_ = 16 * si + fr, ci_ = dir ? 63 - it_ : it_;
#pragma unroll
      for (int s = 0; s < 4; ++s) qf[t][s] = ld8(zq + (size_t)ci_ * NZ + 32 * s + 8 * fq);
    }
    __syncthreads();
    for (int idx = tid; idx < 1536; idx += 256) {
      int tl = idx >> 8, e = idx & 255, r16 = e >> 4, c16 = e & 15;
      int si = tl < 3 ? 0 : (tl < 5 ? 1 : 2);
      int sj = tl < 3 ? tl + 1 : (tl < 5 ? tl - 1 : 3);
      int jj = 16 * sj + c16;
      Ps[(16 * si + r16) * 72 + (dir ? 63 - jj : jj)] = 0;
    }
#pragma unroll
    for (int t = 0; t < 3; ++t) {
      const int k = w + 4 * t;
      if (k < 10) {
        const int si = k < 4 ? 3 : (k < 7 ? 2 : (k < 9 ? 1 : 0));
        const int sj = k - (k < 4 ? 0 : (k < 7 ? 4 : (k < 9 ? 7 : 9)));
        const int it = 16 * si + fr, jt = 16 * sj + fr, cj = dir ? 63 - jt : jt;
        const int brow = si ? (16 * si - 1) : 0;
        const float bmul = si ? 1.f : 0.f;
        f32x4 acc = {0.f, 0.f, 0.f, 0.f};
#pragma unroll
        for (int s = 0; s < 4; ++s) {
          int d0 = 32 * s + 8 * fq;
          bf16x8 fv = ld8(Fq + cj * 136 + d0);
          bf16x8 af, bf;
#pragma unroll
          for (int e = 0; e < 8; ++e) {
            int d = d0 + e;
            float Bs_ = bmul * bsm[brow * 129 + d];
            float qq = bf2f((u16)qf[t][s][e]) * __expf(bsm[it * 129 + d] - Bs_);
            float kk = bf2f((u16)fv[e]) * __expf(Bs_ - bsm[jt * 129 + d]);
            af[e] = (short)f2bf(qq);
            bf[e] = (short)f2bf(kk);
          }
          acc = mfma(af, bf, acc);
          __builtin_amdgcn_sched_barrier(0);
        }
#pragma unroll
        for (int r = 0; r < 4; ++r) {
          int i = 16 * si + 4 * fq + r, jj = 16 * sj + fr;
          float v = (jj <= i) ? acc[r] : 0.f;
          Ps[i * 72 + (dir ? 63 - jj : jj)] = f2bf(v);
        }
      }
    }
    __syncthreads();
#pragma unroll
    for (int nt2 = 0; nt2 < 2; ++nt2) {
      int e = h * 128 + (2 * w + nt2) * 16 + fr;
      bf16x8 v0 = ld8(zT + (size_t)e * GR + rb + 8 * fq), v1 = ld8(zT + (size_t)e * GR + rb + 32 + 8 * fq);
#pragma unroll
      for (int m = 0; m < 4; ++m) {
        f32x4 O = {0.f, 0.f, 0.f, 0.f};
        O = mfma(ld8(Ps + (16 * m + fr) * 72 + 8 * fq), v0, O);
        O = mfma(ld8(Ps + (16 * m + fr) * 72 + 32 + 8 * fq), v1, O);
#pragma unroll
        for (int r = 0; r < 4; ++r) {
          int ii = 16 * m + 4 * fq + r, rowr = rb + (dir ? 63 - ii : ii);
          OC[((size_t)dir * GR + rowr) * 512 + e] = f2bf(O[r]);
        }
      }
    }
    __syncthreads();
  }
}

#define LBAR()                                              \
  do {                                                      \
    asm volatile("s_waitcnt lgkmcnt(0)" ::: "memory");      \
    __builtin_amdgcn_s_barrier();                           \
    asm volatile("" ::: "memory");                          \
  } while (0)
#define CBAR() asm volatile("" ::: "memory")
#define BS_CHUNK(jj) (dir ? ((jj) < 4 ? 3 - (jj) : 39 - (jj)) : (jj))
DEV bf16x8 ldo8(const char* base, unsigned off) { return *reinterpret_cast<const bf16x8*>(base + off); }
DEV void b_seq2(const P& p, int bitem, char* smem) {
  const int tid = opq(threadIdx.x), lane = tid & 63, w = tid >> 6, fr = lane & 15, fq = lane >> 4;
  const int es = bitem & 3, dir = (bitem >> 2) & 1, h = (bitem >> 3) & 3, lb = bitem >> 5, e0 = es * 32;
  u16* Ss = (u16*)smem;
  u16* Rs = Ss + 32 * 136;
  u16* Vsc = Rs + 32 * 72;
  u16* Vor = Vsc + 32 * 72;
  const char* qnB = p.ws + O_BSH + (size_t)h * 256;
  const char* knB = qnB + BSH_ONE;
  const char* vbB = knB + BSH_ONE + (size_t)e0 * 2;
  const char* ktB = p.ws + O_BSH + 3 * BSH_ONE + (size_t)h * 16384;
  const char* recB = p.ws + O_BIT + ((size_t)h * 2 + dir) * BIT_SZ;
  char* obB = p.ws + O_OB + ((size_t)dir * GR * 512 + h * 128 + e0) * 2;
  const int mrow = 16 * w + fr, crow0 = 16 * w + 4 * fq;
  const unsigned offA = (unsigned)((dir ? 63 - mrow : mrow) * 1024 + 16 * fq);
  unsigned offR[4];
#pragma unroll
  for (int r = 0; r < 4; ++r) offR[r] = (unsigned)((dir ? 63 - (crow0 + r) : (crow0 + r)) * 1024 + fr * 2);
  const unsigned offT = (unsigned)(mrow * 128 + 16 * fq);
  const unsigned offK = (unsigned)((32 * w + fr) * 128 + 16 * fq);
  const unsigned offS = (unsigned)(16384 + crow0 * 4);
  f32x4 S[2][2];
#pragma unroll
  for (int a = 0; a < 2; ++a)
#pragma unroll
    for (int b = 0; b < 2; ++b) S[a][b] = (f32x4){0.f, 0.f, 0.f, 0.f};
  bf16x8 Akn[4], Aqn[4], At[2], Aqk[2], AkT[2][2];
  u16 vbv[2][4];
  float4 eg4, be4, ek4;
  float egl;
#define BS_LOAD1(cg_)                                                              \
  {                                                                                \
    const size_t ro_ = (size_t)(cg_) * 65536;                                      \
    _Pragma("unroll") for (int s = 0; s < 4; ++s) {                                \
      Akn[s] = ldo8(knB + ro_, offA + 64 * s);                                     \
      Aqn[s] = ldo8(qnB + ro_, offA + 64 * s);                                     \
    }                                                                              \
    _Pragma("unroll") for (int r = 0; r < 4; ++r) {                                \
      vbv[0][r] = *(const u16*)(vbB + ro_ + offR[r]);                              \
      vbv[1][r] = *(const u16*)(vbB + ro_ + (offR[r] + 32));                       \
    }                                                                              \
    const char* rc_ = recB + (size_t)(cg_) * (8 * BIT_SZ);                         \
    eg4 = *(const float4*)(rc_ + offS);                                            \
    be4 = *(const float4*)(rc_ + (offS + 256));                                    \
  }
#define BS_LOAD2(cg_)                                                              \
  {                                                                                \
    const char* rc_ = recB + (size_t)(cg_) * (8 * BIT_SZ);                         \
    At[0] = ldo8(rc_, offT); At[1] = ldo8(rc_, offT + 64);                         \
    ek4 = *(const float4*)(rc_ + (offS + 512));                                    \
  }
#define BS_LOAD3(cg_)                                                              \
  {                                                                                \
    const char* rc_ = recB + (size_t)(cg_) * (8 * BIT_SZ);                         \
    Aqk[0] = ldo8(rc_, offT + 8192); Aqk[1] = ldo8(rc_, offT + 8192 + 64);         \
    egl = *(const float*)(rc_ + 16384 + 768);                                      \
    const char* kt_ = ktB + (size_t)(cg_) * 65536;                                 \
    AkT[0][0] = ldo8(kt_, offK); AkT[0][1] = ldo8(kt_, offK + 64);                 \
    AkT[1][0] = ldo8(kt_, offK + 2048); AkT[1][1] = ldo8(kt_, offK + 2048 + 64);   \
  }
  {
    const int c0 = lb * 36 + BS_CHUNK(0);
    BS_LOAD1(c0) BS_LOAD2(c0) BS_LOAD3(c0)
  }
  for (int j = 0; j < 36; ++j) {
    const int cgk = lb * 36 + BS_CHUNK(j);
    const int jn = (j + 1 < 36) ? j + 1 : j;
    const int cgn = lb * 36 + BS_CHUNK(jn);
#pragma unroll
    for (int mm = 0; mm < 2; ++mm)
#pragma unroll
      for (int nt = 0; nt < 2; ++nt) {
        uint2 pk; pk.x = pk2(S[mm][nt][0], S[mm][nt][1]); pk.y = pk2(S[mm][nt][2], S[mm][nt][3]);
        *(uint2*)(Ss + (16 * nt + fr) * 136 + 32 * w + 16 * mm + 4 * fq) = pk;
      }
    LBAR();
    f32x4 QS[2];
    {
      bf16x8 Sf[2][4];
#pragma unroll
      for (int nt = 0; nt < 2; ++nt)
#pragma unroll
        for (int s = 0; s < 4; ++s) Sf[nt][s] = ld8(Ss + (16 * nt + fr) * 136 + 32 * s + 8 * fq);
#pragma unroll
      for (int nt = 0; nt < 2; ++nt) {
        f32x4 X = {0.f, 0.f, 0.f, 0.f}, Q = {0.f, 0.f, 0.f, 0.f};
#pragma unroll
        for (int s = 0; s < 4; ++s) { X = mfma(Akn[s], Sf[nt][s], X); Q = mfma(Aqn[s], Sf[nt][s], Q); }
        float r0 = be4.x * (bf2f(vbv[nt][0]) - eg4.x * X[0]);
        float r1 = be4.y * (bf2f(vbv[nt][1]) - eg4.y * X[1]);
        float r2 = be4.z * (bf2f(vbv[nt][2]) - eg4.z * X[2]);
        float r3 = be4.w * (bf2f(vbv[nt][3]) - eg4.w * X[3]);
        uint2 pk; pk.x = pk2(r0, r1); pk.y = pk2(r2, r3);
        *(uint2*)(Rs + (16 * nt + fr) * 72 + crow0) = pk;
        Q[0] *= eg4.x; Q[1] *= eg4.y; Q[2] *= eg4.z; Q[3] *= eg4.w;
        QS[nt] = Q;
      }
    }
    CBAR();
    BS_LOAD1(cgn)
    LBAR();
    {
#pragma unroll
      for (int nt = 0; nt < 2; ++nt) {
        bf16x8 Rf0 = ld8(Rs + (16 * nt + fr) * 72 + 8 * fq), Rf1 = ld8(Rs + (16 * nt + fr) * 72 + 32 + 8 * fq);
        f32x4 VN = {0.f, 0.f, 0.f, 0.f};
        VN = mfma(At[0], Rf0, VN);
        VN = mfma(At[1], Rf1, VN);
        uint2 pk; pk.x = pk2(VN[0], VN[1]); pk.y = pk2(VN[2], VN[3]);
        *(uint2*)(Vsc + (16 * nt + fr) * 72 + crow0) = pk;
        float s0 = VN[0] * ek4.x, s1 = VN[1] * ek4.y, s2 = VN[2] * ek4.z, s3 = VN[3] * ek4.w;
        if (dir) {
          pk.x = pk2(s3, s2); pk.y = pk2(s1, s0);
          *(uint2*)(Vor + (16 * nt + fr) * 72 + (60 - crow0)) = pk;
        } else {
          pk.x = pk2(s0, s1); pk.y = pk2(s2, s3);
          *(uint2*)(Vor + (16 * nt + fr) * 72 + crow0) = pk;
        }
      }
    }
    CBAR();
    BS_LOAD2(cgn)
    LBAR();
    {
      char* ob_ = obB + (size_t)cgk * 65536;
#pragma unroll
      for (int nt = 0; nt < 2; ++nt) {
        bf16x8 Vs0 = ld8(Vsc + (16 * nt + fr) * 72 + 8 * fq), Vs1 = ld8(Vsc + (16 * nt + fr) * 72 + 32 + 8 * fq);
        bf16x8 Vo0 = ld8(Vor + (16 * nt + fr) * 72 + 8 * fq), Vo1 = ld8(Vor + (16 * nt + fr) * 72 + 32 + 8 * fq);
        f32x4 O = QS[nt];
        O = mfma(Aqk[0], Vs0, O);
        O = mfma(Aqk[1], Vs1, O);
#pragma unroll
        for (int r = 0; r < 4; ++r) *(u16*)(ob_ + (offR[r] + 32 * nt)) = f2bf(O[r]);
#pragma unroll
        for (int mm = 0; mm < 2; ++mm) {
          f32x4 t = S[mm][nt];
#pragma unroll
          for (int r = 0; r < 4; ++r) t[r] *= egl;
          t = mfma(AkT[mm][0], Vo0, t);
          t = mfma(AkT[mm][1], Vo1, t);
          S[mm][nt] = t;
        }
      }
    }
    CBAR();
    BS_LOAD3(cgn)
  }
  LBAR();
}

DEV void c_seq2(const P& p, int bitem, char* smem) {
  const int tid = opq(threadIdx.x), lane = tid & 63, w = tid >> 6, fr = lane & 15, fq = lane >> 4;
  const int es = bitem & 3, dir = (bitem >> 2) & 1, h = (bitem >> 3) & 3, lb = bitem >> 5, e0 = es * 32;
  u16* Ssb = (u16*)smem;
  const char* recB = p.ws + O_CREC + ((size_t)h * 2 + dir) * CREC_SZ;
  const char* ztB = p.ws + O_ZT + (size_t)(h * 128 + e0) * GR * 2;
  char* ocB = p.ws + O_OC + ((size_t)dir * GR * 512 + h * 128 + e0) * 2;
  const int mrow = 16 * w + fr, crow0 = 16 * w + 4 * fq;
  const unsigned offQ = (unsigned)(mrow * 256 + 16 * fq);
  const unsigned offK = (unsigned)(16384 + (32 * w + fr) * 128 + 16 * fq);
  const unsigned offD = (unsigned)(32768 + (32 * w + 4 * fq) * 4);
  const unsigned offV = (unsigned)(fr * GR * 2 + 16 * fq);
  unsigned offR[4];
#pragma unroll
  for (int r = 0; r < 4; ++r) offR[r] = (unsigned)((dir ? 63 - (crow0 + r) : (crow0 + r)) * 1024 + fr * 2);
  f32x4 S[2][2];
#pragma unroll
  for (int a = 0; a < 2; ++a)
#pragma unroll
    for (int b = 0; b < 2; ++b) S[a][b] = (f32x4){0.f, 0.f, 0.f, 0.f};
  bf16x8 Aqd[4], Akd[2][2], Vf[2][2];
  u16 oi[2][4];
  float4 dec4[2];
#define CS_LOAD(cg_)                                                                    \
  {                                                                                     \
    const char* rc_ = recB + (size_t)(cg_) * (8 * CREC_SZ);                             \
    _Pragma("unroll") for (int s = 0; s < 4; ++s) Aqd[s] = ldo8(rc_, offQ + 64 * s);    \
    Akd[0][0] = ldo8(rc_, offK); Akd[0][1] = ldo8(rc_, offK + 64);                      \
    Akd[1][0] = ldo8(rc_, offK + 2048); Akd[1][1] = ldo8(rc_, offK + 2048 + 64);        \
    dec4[0] = *(const float4*)(rc_ + offD);                                             \
    dec4[1] = *(const float4*)(rc_ + (offD + 64));                                      \
    const char* zt_ = ztB + (size_t)(cg_) * 128;                                        \
    Vf[0][0] = ldo8(zt_, offV); Vf[0][1] = ldo8(zt_, offV + 64);                        \
    Vf[1][0] = ldo8(zt_, offV + 16 * GR * 2); Vf[1][1] = ldo8(zt_, offV + 16 * GR * 2 + 64); \
    const char* oc_ = ocB + (size_t)(cg_) * 65536;                                      \
    _Pragma("unroll") for (int r = 0; r < 4; ++r) {                                     \
      oi[0][r] = *(const u16*)(oc_ + offR[r]);                                          \
      oi[1][r] = *(const u16*)(oc_ + (offR[r] + 32));                                   \
    }                                                                                   \
  }
  {
    const int c0 = lb * 36 + BS_CHUNK(0);
    CS_LOAD(c0)
  }
  for (int j = 0; j < 36; ++j) {
    const int cgk = lb * 36 + BS_CHUNK(j);
    const int jn = (j + 1 < 36) ? j + 1 : j;
    const int cgn = lb * 36 + BS_CHUNK(jn);
    u16* Ss = Ssb + (j & 1) * (32 * 136);
#pragma unroll
    for (int mm = 0; mm < 2; ++mm)
#pragma unroll
      for (int nt = 0; nt < 2; ++nt) {
        uint2 pk; pk.x = pk2(S[mm][nt][0], S[mm][nt][1]); pk.y = pk2(S[mm][nt][2], S[mm][nt][3]);
        *(uint2*)(Ss + (16 * nt + fr) * 136 + 32 * w + 16 * mm + 4 * fq) = pk;
      }
    LBAR();
    char* oc_ = ocB + (size_t)cgk * 65536;
#pragma unroll
    for (int nt = 0; nt < 2; ++nt) {
      f32x4 O = {0.f, 0.f, 0.f, 0.f};
#pragma unroll
      for (int s = 0; s < 4; ++s) O = mfma(Aqd[s], ld8(Ss + (16 * nt + fr) * 136 + 32 * s + 8 * fq), O);
#pragma unroll
      for (int r = 0; r < 4; ++r) *(u16*)(oc_ + (offR[r] + 32 * nt)) = f2bf(bf2f(oi[nt][r]) + O[r]);
#pragma unroll
      for (int mm = 0; mm < 2; ++mm) {
        f32x4 t = S[mm][nt];
        t[0] *= dec4[mm].x; t[1] *= dec4[mm].y; t[2] *= dec4[mm].z; t[3] *= dec4[mm].w;
        t = mfma(Akd[mm][0], Vf[nt][0], t);
        t = mfma(Akd[mm][1], Vf[nt][1], t);
        S[mm][nt] = t;
      }
    }
    CBAR();
    CS_LOAD(cgn)
  }
  LBAR();
}

DEV void bc_merge(const P& p, int l, int it) {
  const int tid_ = opq(threadIdx.x); const int lane = tid_ & 63, w = tid_ >> 6;
  int lr = it * 4 + w;
  int mix = lane >> 5, cm = (lane * 16) & 511;
  const u16* O = (const u16*)(p.ws + (mix ? O_OC : O_OB));
  u16* z = (u16*)(p.ws + O_Z);
  float ov[16], ss = 0.f;
#pragma unroll
  for (int k2 = 0; k2 < 2; ++k2) {
    uint4 a = *(const uint4*)(O + (size_t)lr * 512 + cm + 8 * k2);
    uint4 b = *(const uint4*)(O + ((size_t)GR + lr) * 512 + cm + 8 * k2);
    unsigned aa[4] = {a.x, a.y, a.z, a.w}, bb[4] = {b.x, b.y, b.z, b.w};
#pragma unroll
    for (int q = 0; q < 4; ++q) {
      float v0 = bf2f((u16)(aa[q] & 0xffff)) + bf2f((u16)(bb[q] & 0xffff));
      float v1 = bf2f((u16)(aa[q] >> 16)) + bf2f((u16)(bb[q] >> 16));
      ov[k2 * 8 + q * 2] = v0; ov[k2 * 8 + q * 2 + 1] = v1;
      ss += v0 * v0 + v1 * v1;
    }
  }
  ss += __shfl_xor(ss, 1); ss += __shfl_xor(ss, 2); ss += __shfl_xor(ss, 4);
  float rinv = rsqrtf(ss * (1.f / 128.f) + EPS);
  const float* nw = (mix ? p.hg_norm : p.gdn_norm) + l * 128 + (cm & 127);
  u16* gp = z + (size_t)lr * NZ + (mix ? C_GC : C_GB) + cm;
#pragma unroll
  for (int k2 = 0; k2 < 2; ++k2) {
    uint4 gv = *(const uint4*)(gp + 8 * k2);
    unsigned gg[4] = {gv.x, gv.y, gv.z, gv.w}, oo[4];
#pragma unroll
    for (int q = 0; q < 4; ++q) {
      int e = k2 * 8 + q * 2;
      float y0 = ov[e] * rinv * nw[e] * silu(bf2f((u16)(gg[q] & 0xffff)));
      float y1 = ov[e + 1] * rinv * nw[e + 1] * silu(bf2f((u16)(gg[q] >> 16)));
      oo[q] = pk2(y0, y1);
    }
    *(uint4*)(gp + 8 * k2) = make_uint4(oo[0], oo[1], oo[2], oo[3]);
  }
}

#define XB_TMO      128
#define XB_XCNT(j)  (256  + 64 * (j))
#define XB_XSUB(j)  (1280 + 64 * (j))
#define XB_XGEN(j)  (2304 + 64 * (j))
#define XB_TOP      3328
#define XB_TOPGEN   3392
#define XCD_BAR_WORDS 3456
#define XB_SPIN_CAP (1u << 18)
#define LAS __attribute__((address_space(3)))

__device__ __forceinline__ unsigned xb_ld(unsigned* p)              { return __hip_atomic_load(p, __ATOMIC_RELAXED, __HIP_MEMORY_SCOPE_AGENT); }
__device__ __forceinline__ unsigned xb_add(unsigned* p, unsigned v) { return __hip_atomic_fetch_add(p, v, __ATOMIC_RELAXED, __HIP_MEMORY_SCOPE_AGENT); }
__device__ __forceinline__ unsigned xb_xcc_id() { return (unsigned)__builtin_amdgcn_s_getreg((3 << 11) | 20) & 0xFu; }
#define XB_SPIN(cond, bar) do { unsigned _sp = 0; while (cond) { __builtin_amdgcn_s_sleep(1); \
    if ((++_sp & 255u) == 0u) { if (xb_ld(&(bar)[XB_TMO])) break; if (_sp > XB_SPIN_CAP) { atomicAdd(&(bar)[XB_TMO], 1u); break; } } } } while (0)

struct XcdBarrier {
    unsigned* bar; unsigned x;
    volatile LAS unsigned* st;
};

__device__ __forceinline__ XcdBarrier xcd_barrier_post(unsigned* bar, volatile LAS unsigned* st) {
    XcdBarrier b; b.bar = bar; b.x = xb_xcc_id(); b.st = st;
    if (threadIdx.x == 0) (void)xb_add(&bar[XB_XCNT(b.x)], 1u);
    return b;
}
__device__ __forceinline__ void xcd_barrier_complete(unsigned* bar, unsigned x, unsigned& nloc, unsigned& nx) {
    const unsigned G = gridDim.x * gridDim.y * gridDim.z;
    unsigned sum, cnt, mine, sp = 0u;
    for (;;) {
        sum = 0u; cnt = 0u; mine = 0u;
#pragma unroll
        for (unsigned j = 0; j < 16; ++j) { const unsigned c = xb_ld(&bar[XB_XCNT(j)]); sum += c; cnt += (c > 0u) ? 1u : 0u; mine = (j == x) ? c : mine; }
        if (sum == G) break;
        __builtin_amdgcn_s_sleep(1);
        if ((++sp & 255u) == 0u) { if (xb_ld(&bar[XB_TMO])) break; if (sp > XB_SPIN_CAP) { atomicAdd(&bar[XB_TMO], 1u); break; } }
    }
    nloc = mine > 0u ? mine : 1u; nx = cnt > 0u ? cnt : 1u;
}

__device__ __forceinline__ void xcd_barrier(const XcdBarrier& b) {
    asm volatile("s_waitcnt vmcnt(0)" ::: "memory");
    __syncthreads();
    if (threadIdx.x == 0) {
        unsigned* bar = b.bar;
        __builtin_amdgcn_s_waitcnt(0);
        unsigned nloc = b.st[0], nx = b.st[1];
        if (nloc == 0u) { xcd_barrier_complete(bar, b.x, nloc, nx); b.st[0] = nloc; b.st[1] = nx; }
        const unsigned old = xb_add(&bar[XB_XSUB(b.x)], 1u);
        const unsigned gen = old / nloc;
        if (old + 1u == (gen + 1u) * nloc) {
            __builtin_amdgcn_fence(__ATOMIC_RELEASE, "agent");
            asm volatile("s_waitcnt vmcnt(0)" ::: "memory");
            const unsigned og = xb_add(&bar[XB_TOP], 1u);
            const unsigned tg = og / nx;
            if (og + 1u == (tg + 1u) * nx) xb_add(&bar[XB_TOPGEN], 1u);
            else XB_SPIN(xb_ld(&bar[XB_TOPGEN]) == tg, bar);
            __builtin_amdgcn_fence(__ATOMIC_ACQUIRE, "agent");
            xb_add(&bar[XB_XGEN(b.x)], 1u);
            asm volatile("s_waitcnt vmcnt(0)" ::: "memory");
        } else {
            XB_SPIN(xb_ld(&bar[XB_XGEN(b.x)]) == gen, bar);
            __builtin_amdgcn_fence(__ATOMIC_ACQUIRE, "agent");
            asm volatile("s_waitcnt vmcnt(0)" ::: "memory");
        }
    }
    __syncthreads();
}


#ifdef NO_G0
#define XG0(x)
#else
#define XG0(x) x
#endif
#ifdef NO_G1
#define XG1(x)
#else
#define XG1(x) x
#endif
#ifdef NO_BC
#define XBC(x)
#else
#define XBC(x) x
#endif
#ifdef NO_AC
#define XAC(x)
#else
#define XAC(x) x
#endif
#ifdef NO_P0
#define XP0(x)
#else
#define XP0(x) x
#endif
#ifdef NO_R
#define XR(x)
#else
#define XR(x) x
#endif
#ifdef NO_BL
#define XBL(x)
#else
#define XBL(x) x
#endif
#ifdef NO_CL
#define XCL(x)
#else
#define XCL(x) x
#endif
#ifdef NO_A0
#define XA0(x)
#else
#define XA0(x) x
#endif
#ifdef NO_A1
#define XA1(x)
#else
#define XA1(x) x
#endif
#ifdef NO_BS
#define XBS(x)
#else
#define XBS(x) x
#endif
#ifdef NO_CS
#define XCS(x)
#else
#define XCS(x) x
#endif
__global__ void __launch_bounds__(256, 2) fwd_mega(P p) {
  extern __shared__ __attribute__((aligned(16))) char smem[];
  cg::grid_group grid = cg::this_grid();
  const int G = gridDim.x;
  __shared__ uint4 xb_words;
  if (threadIdx.x == 0) xb_words = make_uint4(0u, 0u, 0u, 0u);
  __syncthreads();
  XcdBarrier xb = xcd_barrier_post((unsigned*)(p.ws + O_BAR), (volatile LAS unsigned*)&xb_words);
  XP0(phase0(p, smem));
  grid.sync();
  u16* z = (u16*)(p.ws + O_Z);
  u16* zT = (u16*)(p.ws + O_ZT);
  float* ab = (float*)(p.ws + O_AB);
  float* o = (float*)(p.ws + O_BSH);
  const u16* u = (const u16*)(p.ws + O_BIT);
  for (int g = 0; g < NG; ++g) {
    XR(phaseR(p, g, 0));
    xcd_barrier(xb);
    for (int l = 0; l < DEPTH; ++l) {
      for (int rep = 0; rep < REP_G; ++rep) {
        const u16* Bt = (const u16*)(p.ws + O_WTIN) + (size_t)l * NZ * 1024;
        if ((G & 7) == 0) {
          const int x = blockIdx.x & 7, bl = blockIdx.x >> 3, nbl = G >> 3;
          for (int q = bl; q < 9 * 45; q += nbl) { XG0(gemm_tile<0>(u, 1024, Bt, 1024, 9 * x + q % 9, q / 9, z, zT, ab, o, smem)); }
        } else {
          for (int t = blockIdx.x; t < 72 * 45; t += G) { XG0(gemm_tile<0>(u, 1024, Bt, 1024, t % 72, t / 72, z, zT, ab, o, smem)); }
        }
      }
      xcd_barrier(xb);
      for (int rep2 = 0; rep2 < REP_M; ++rep2) {
      for (int rep3 = 0; rep3 < REP_A; ++rep3) {
        if (rep3) xcd_barrier(xb);
        const int nb = NCH * 4, nc = NCH * 4, na = NCH * 8;
        for (int t = blockIdx.x; t < nb + nc + na; t += G) {
          if (t < nc) { XCL(c_local2(p, l, t, smem)); }
          else if (t < nb + nc) { XBL(b_local(p, l, t - nc, smem)); }
          else { XA0(a_item(p, l, t - nb - nc, 0, smem)); }
        }
      }
      xcd_barrier(xb);
      {
        for (int t = blockIdx.x; t < 256 + 16; t += G) {
          if (t < 128) { XBS(b_seq2(p, t, smem)); }
          else if (t < 256) { XCS(c_seq2(p, t - 128, smem)); }
          else { XAC(a_carry(p, t - 256)); }
        }
      }
      xcd_barrier(xb);
      }
      {
        const int na = NCH * 8, nm = GR / 4;
        for (int t = blockIdx.x; t < na + nm; t += G) {
          if (t < na) { XA1(a_fin(p, l, t, smem)); }
          else { XBC(bc_merge(p, l, t - na)); }
        }
      }
      xcd_barrier(xb);
      for (int rep = 0; rep < REP_G; ++rep) {
        const u16* Bt = (const u16*)(p.ws + O_WTOUT) + (size_t)l * 1024 * 1536;
        for (int t = blockIdx.x; t < 72 * 8; t += G) { XG1(gemm_tile<1>(z + C_GA, NZ, Bt, 1536, t % 72, t / 72, z, zT, ab, o, smem)); }
      }
      xcd_barrier(xb);
      XR(phaseR(p, g, l + 1));
      xcd_barrier(xb);
    }
  }
}

extern "C" void kernel_launch(void* const* d_in, const int* in_sizes, int n_in, void* d_out, int out_size, void* d_ws,
                              size_t ws_size, hipStream_t stream) {
  static int grid_blocks = 0;
  if (!grid_blocks) {
    int dev = 0, cus = 0, per_cu = 0;
    hipGetDevice(&dev);
    hipDeviceGetAttribute(&cus, hipDeviceAttributeMultiprocessorCount, dev);
    hipFuncSetAttribute((const void*)fwd_mega, hipFuncAttributeMaxDynamicSharedMemorySize, LDS_BYTES);
    hipOccupancyMaxActiveBlocksPerMultiprocessor(&per_cu, fwd_mega, 256, LDS_BYTES);
    if (per_cu > 2) per_cu = 2;
    if (per_cu < 1) per_cu = 1;
    grid_blocks = cus * per_cu;
  }
  if (ws_size < WS_TOTAL) {
    fprintf(stderr, "workspace too small: %zu < %zu\n", ws_size, (size_t)WS_TOTAL);
    return;
  }
  P p{};
  const float** f = (const float**)&p;
  for (int i = 0; i < 23; ++i) f[i] = (const float*)d_in[i];
  p.out = (float*)d_out;
  p.ws = (char*)d_ws;
  hipMemsetAsync((char*)d_ws + O_BAR, 0, XCD_BAR_WORDS * 4, stream);
  void* args[] = {&p};
  hipError_t e = hipLaunchCooperativeKernel((void*)fwd_mega, dim3(grid_blocks), dim3(256), args, LDS_BYTES, stream);
  if (e != hipSuccess) fprintf(stderr, "cooperative launch failed: %s (grid %d)\n", hipGetErrorString(e), grid_blocks);
}
```

```cpp
#include <hip/hip_runtime.h>
#include <hip/hip_cooperative_groups.h>
#include <cstdio>
namespace cg = cooperative_groups;

typedef __attribute__((ext_vector_type(8))) short bf16x8;
typedef __attribute__((ext_vector_type(4))) float f32x4;
typedef unsigned short u16;
#define DEV __device__ __forceinline__

constexpr int DM = 1024, TL = 2048, TCX = 256, TS = 2304, GB = 4, GR = GB * TS, NG = 2;
constexpr int NZ = 5760, DEPTH = 4;
constexpr int C_XA = 0, C_Q = 512, C_K = 1024, C_V = 1536, C_QC = 2048, C_F0 = 2560, C_IC = 3584,
              C_GA = 4096, C_GB = 4608, C_GC = 5120, C_AB = 5632;
constexpr int NCH = GR / 64;
constexpr float EPS = 1e-6f;
constexpr int WPB = 2;

constexpr size_t al256(size_t x) { return (x + 255) & ~(size_t)255; }
constexpr size_t O_WTIN = 0;
constexpr size_t O_WTOUT = O_WTIN + al256((size_t)DEPTH * NZ * 1024 * 2);
constexpr size_t O_WGT = O_WTOUT + al256((size_t)DEPTH * 1024 * 1536 * 2);
constexpr size_t O_MOD = O_WGT + al256((size_t)DEPTH * 2 * 2 * 8 * 4096 * 2);
constexpr size_t O_LBS = O_MOD + al256((size_t)DEPTH * 9 * 3072 * 4);
constexpr size_t O_HC = O_LBS + al256((size_t)DEPTH * 1024 * 4);
constexpr size_t O_Z = O_HC + al256((size_t)GB * TCX * 1024 * 4);
constexpr size_t O_ZT = O_Z + al256((size_t)GR * NZ * 2);
constexpr size_t O_AB = O_ZT + al256((size_t)512 * GR * 2);
constexpr size_t O_BSH = O_AB + al256((size_t)GR * 16 * 4);
constexpr size_t BSH_ONE = (size_t)GR * 512 * 2;
constexpr size_t O_BIT = O_BSH + al256(4 * BSH_ONE);
constexpr size_t BIT_SZ = 17408;
constexpr size_t O_CREC = O_BIT + al256((size_t)NCH * 4 * 2 * BIT_SZ);
constexpr size_t CREC_SZ = 33280;
constexpr size_t O_OB = O_CREC + al256((size_t)NCH * 4 * 2 * CREC_SZ);
constexpr size_t O_OC = O_OB + al256((size_t)2 * GR * 512 * 2);
constexpr size_t O_AP = O_OC + al256((size_t)2 * GR * 512 * 2);
constexpr size_t O_AH = O_AP + al256((size_t)NCH * 2 * 512 * 4);
constexpr size_t O_ACAR = O_AH + al256((size_t)NCH * 2 * 512 * 4);
constexpr size_t O_ALA = O_ACAR + al256((size_t)NCH * 2 * 512 * 4);
constexpr size_t O_AU = O_ALA + al256((size_t)2 * GR * 512 * 2);
constexpr size_t O_BAR = O_AU + al256((size_t)2 * GR * 512 * 2);
constexpr size_t WS_TOTAL = O_BAR + al256(3456 * 4);

constexpr int LDS_BYTES = 73728;
#ifndef REP_A
#define REP_A 1
#endif
#ifndef REP_G
#define REP_G 1
#endif
#ifndef REP_M
#define REP_M 1
#endif

struct P {
  const float *x, *c, *ctx, *c_ctx, *w_ada, *b_ada, *norm_pre, *norm_post, *w_in, *conv_a_w, *conv_a_b, *rg_w_r,
      *rg_b_r, *rg_w_i, *rg_b_i, *rg_lam, *conv_b_w, *gdn_a_log, *gdn_dt_bias, *gdn_norm, *hg_lb, *hg_norm, *w_out;
  float* out;
  char* ws;
};

DEV int opq(int x) { asm volatile("" : "+v"(x)); return x; }
DEV int opqs(int x) { asm volatile("" : "+s"(x)); return x; }
typedef __attribute__((ext_vector_type(2))) __bf16 bf16x2_t;
typedef __attribute__((ext_vector_type(2))) float f32x2_t;
DEV u16 f2bf(float f) { __bf16 r = (__bf16)f; return __builtin_bit_cast(u16, r); }
DEV float bf2f(u16 h) { return __uint_as_float(((unsigned)h) << 16); }
DEV unsigned pk2(float a, float b) { f32x2_t v = {a, b}; bf16x2_t r = __builtin_convertvector(v, bf16x2_t); return __builtin_bit_cast(unsigned, r); }
DEV float sigm(float x) { return __builtin_amdgcn_rcpf(1.f + __expf(-x)); }
DEV float silu(float x) { return x * __builtin_amdgcn_rcpf(1.f + __expf(-x)); }
DEV float softplus(float x) { return x > 20.f ? x : log1pf(__expf(x)); }
DEV f32x4 mfma(bf16x8 a, bf16x8 b, f32x4 c) { return __builtin_amdgcn_mfma_f32_16x16x32_bf16(a, b, c, 0, 0, 0); }
DEV bf16x8 ld8(const u16* p) { return *reinterpret_cast<const bf16x8*>(p); }
DEV int lat_map(int l, int t) { return (l & 1) ? ((t & 63) * 32 + (t >> 6)) : t; }
DEV int orig_col(int n) {
  if (n < 512) return n;
  if (n < 2048) return n + 512;
  if (n < 4096) return n + 1040;
  if (n < 4608) return n - 4096 + 512;
  if (n < 5120) return n - 4608 + 2576;
  if (n < 5632) return n + 16;
  if (n < 5648) return n - 5632 + 2560;
  return -1;
}
DEV float zval(const u16* z, int rb, int cp, int n, int col) {
  if (cp < 0 && (n == 0 || n == 4)) return 0.f;
  if (cp > 63 && (n == 3 || n == 35)) return 0.f;
  return bf2f(z[(size_t)(rb + cp) * NZ + col]);
}

DEV void ph0_ada(const P& p, int item, char* smem) {
  float* sc = (float*)smem;
  float* red = (float*)(smem + 36864);
  const int tid = threadIdx.x, lane = tid & 63, wv = tid >> 6;
  for (int i = tid; i < 9 * 1024; i += 256) {
    int v = i >> 10, d = i & 1023;
    float cv = (v < 8) ? p.c[v * 1024 + d] : p.c_ctx[d];
    sc[i] = silu(cv);
  }
  __syncthreads();
  const int col = item * 64 + lane;
  const int l = col / 3072, e = col % 3072;
  const float* w = p.w_ada + (size_t)l * 1024 * 3072 + e + (size_t)(256 * wv) * 3072;
  const float* scw = sc + 256 * wv;
  float acc[9];
#pragma unroll
  for (int i = 0; i < 9; ++i) acc[i] = 0.f;
  for (int d = 0; d < 256; d += 16) {
    float wr[16];
#pragma unroll
    for (int k = 0; k < 16; ++k) wr[k] = w[(size_t)(d + k) * 3072];
#pragma unroll
    for (int k = 0; k < 16; ++k)
#pragma unroll
      for (int i = 0; i < 9; ++i) acc[i] += scw[i * 1024 + d + k] * wr[k];
  }
#pragma unroll
  for (int i = 0; i < 9; ++i) red[(wv * 9 + i) * 64 + lane] = acc[i];
  __syncthreads();
  float* mod = (float*)(p.ws + O_MOD);
  for (int idx = tid; idx < 9 * 64; idx += 256) {
    int i = idx >> 6, ln = idx & 63;
    float sum = red[(0 * 9 + i) * 64 + ln] + red[(1 * 9 + i) * 64 + ln] + red[(2 * 9 + i) * 64 + ln] + red[(3 * 9 + i) * 64 + ln];
    int cc = item * 64 + ln, l2 = cc / 3072, e2 = cc % 3072;
    mod[((size_t)l2 * 9 + i) * 3072 + e2] = sum + p.b_ada[l2 * 3072 + e2];
  }
  __syncthreads();
}
DEV void tconv_tile(const float* src, int lds_, u16* dst, int ldd, int k0, int n0, bool mapcol, char* smem) {
  float* t = (float*)smem;
  const int tid = threadIdx.x, nn = tid & 63, kq = tid >> 6;
  const int n = n0 + nn;
  const int sn0 = mapcol ? orig_col(n) : n;
  const float msk = (sn0 >= 0) ? 1.f : 0.f;
  const int sn = sn0 >= 0 ? sn0 : 0;
  float v[16];
#pragma unroll
  for (int k = 0; k < 16; ++k) v[k] = src[(size_t)(k0 + kq + 4 * k) * lds_ + sn];
#pragma unroll
  for (int k = 0; k < 16; ++k) t[(kq + 4 * k) * 65 + nn] = v[k] * msk;
  __syncthreads();
  {
    const int kk = tid & 63, nq = tid >> 6;
#pragma unroll
    for (int k = 0; k < 16; ++k) {
      int n2 = nq + 4 * k;
      dst[(size_t)(n0 + n2) * ldd + k0 + kk] = f2bf(t[kk * 65 + n2]);
    }
  }
  __syncthreads();
}
DEV void phase0(const P& p, char* smem) {
  const int n_ada = 192, n_in = DEPTH * 16 * 90, n_out = DEPTH * 24 * 16, n_g = 128, n_lb = 4;
  const int total = n_ada + n_in + n_out + n_g + n_lb;
  for (int it = blockIdx.x; it < total; it += gridDim.x) {
    int i = it;
    if (i < n_ada) { ph0_ada(p, i, smem); continue; }
    i -= n_ada;
    if (i < n_in) {
      int l = i / 1440, r = i % 1440, kt = r / 90, nt = r % 90;
      tconv_tile(p.w_in + (size_t)l * 1024 * 5648, 5648, (u16*)(p.ws + O_WTIN) + (size_t)l * NZ * 1024, 1024, kt * 64,
                 nt * 64, true, smem);
      continue;
    }
    i -= n_in;
    if (i < n_out) {
      int l = i / 384, r = i % 384, kt = r / 16, nt = r % 16;
      tconv_tile(p.w_out + (size_t)l * 1536 * 1024, 1024, (u16*)(p.ws + O_WTOUT) + (size_t)l * 1024 * 1536, 1536,
                 kt * 64, nt * 64, false, smem);
      continue;
    }
    i -= n_out;
    if (i < n_g) {
      int h = i & 7, gate = (i >> 3) & 1, dir = (i >> 4) & 1, l = i >> 5;
      const float* src = (gate ? p.rg_w_i : p.rg_w_r) + ((size_t)(l * 2 + dir) * 8 + h) * 4096;
      tconv_tile(src, 64, (u16*)(p.ws + O_WGT) + (size_t)i * 4096, 64, 0, 0, false, smem);
      continue;
    }
    i -= n_g;
    {
      int j = i * 256 + threadIdx.x;
      float v[4], mx = -1e30f;
      for (int l = 0; l < 4; ++l) { v[l] = p.hg_lb[l * 1024 + j]; mx = fmaxf(mx, v[l]); }
      float s = 0.f;
      for (int l = 0; l < 4; ++l) { v[l] = __expf(v[l] - mx); s += v[l]; }
      float* lbs = (float*)(p.ws + O_LBS);
      float cum = 0.f;
      for (int l = 0; l < 4; ++l) {
        if (l > 0) cum += v[l] / s;
        lbs[l * 1024 + j] = cum;
      }
    }
  }
}

DEV void phaseR(const P& p, int g, int l) {
  const int tid_ = opq(threadIdx.x); const int lane = tid_ & 63, w = tid_ >> 6;
  const float* mod = (const float*)(p.ws + O_MOD);
  float* hc = (float*)(p.ws + O_HC);
  const float* o = (const float*)(p.ws + O_BSH);
  u16* u = (u16*)(p.ws + O_BIT);
  for (int it = blockIdx.x; it < GR / 4; it += gridDim.x) {
    int lr = it * 4 + w;
    int lb = lr / TS, s = lr % TS;
    bool isctx = s < TCX;
    if (l == DEPTH && isctx) continue;
    int b = g * GB + lb, t = s - TCX;
    int mi = isctx ? 8 : b;
    float* hp = isctx ? hc + ((size_t)lb * TCX + s) * 1024 : p.out + ((size_t)b * TL + t) * 1024;
    float hv[16];
    if (l == 0) {
      const float* src = isctx ? p.ctx + ((size_t)b * TCX + s) * 1024 : p.x + ((size_t)b * TL + t) * 1024;
#pragma unroll
      for (int k = 0; k < 4; ++k) {
        float4 v = *(const float4*)(src + k * 256 + lane * 4);
        hv[k * 4] = v.x; hv[k * 4 + 1] = v.y; hv[k * 4 + 2] = v.z; hv[k * 4 + 3] = v.w;
      }
    } else {
      int orow = lb * TS + (isctx ? s : TCX + lat_map(l - 1, t));
      const float* op = o + (size_t)orow * 1024;
      float ov[16], ss = 0.f;
#pragma unroll
      for (int k = 0; k < 4; ++k) {
        float4 v = *(const float4*)(op + k * 256 + lane * 4);
        ov[k * 4] = v.x; ov[k * 4 + 1] = v.y; ov[k * 4 + 2] = v.z; ov[k * 4 + 3] = v.w;
        ss += v.x * v.x + v.y * v.y + v.z * v.z + v.w * v.w;
      }
#pragma unroll
      for (int off = 32; off; off >>= 1) ss += __shfl_xor(ss, off);
      float rinv = rsqrtf(ss * (1.f / 1024.f) + EPS);
      const float* gate = mod + ((size_t)(l - 1) * 9 + mi) * 3072 + 2048;
      const float* wp = p.norm_post + (l - 1) * 1024;
#pragma unroll
      for (int k = 0; k < 4; ++k) {
        float4 hh = *(const float4*)(hp + k * 256 + lane * 4);
        float4 gg = *(const float4*)(gate + k * 256 + lane * 4);
        float4 ww = *(const float4*)(wp + k * 256 + lane * 4);
        hv[k * 4] = hh.x + gg.x * (ov[k * 4] * rinv * ww.x);
        hv[k * 4 + 1] = hh.y + gg.y * (ov[k * 4 + 1] * rinv * ww.y);
        hv[k * 4 + 2] = hh.z + gg.z * (ov[k * 4 + 2] * rinv * ww.z);
        hv[k * 4 + 3] = hh.w + gg.w * (ov[k * 4 + 3] * rinv * ww.w);
      }
    }
#pragma unroll
    for (int k = 0; k < 4; ++k)
      *(float4*)(hp + k * 256 + lane * 4) = make_float4(hv[k * 4], hv[k * 4 + 1], hv[k * 4 + 2], hv[k * 4 + 3]);
    if (l < DEPTH) {
      float ss = 0.f;
#pragma unroll
      for (int k = 0; k < 16; ++k) ss += hv[k] * hv[k];
#pragma unroll
      for (int off = 32; off; off >>= 1) ss += __shfl_xor(ss, off);
      float rinv = rsqrtf(ss * (1.f / 1024.f) + EPS);
      const float* sh = mod + ((size_t)l * 9 + mi) * 3072;
      const float* wp = p.norm_pre + l * 1024;
      int urow = lb * TS + (isctx ? s : TCX + lat_map(l, t));
      u16* up = u + (size_t)urow * 1024;
#pragma unroll
      for (int k = 0; k < 4; ++k) {
        float4 ww = *(const float4*)(wp + k * 256 + lane * 4);
        float4 s0 = *(const float4*)(sh + k * 256 + lane * 4);
        float4 s1 = *(const float4*)(sh + 1024 + k * 256 + lane * 4);
        float a0 = hv[k * 4] * rinv * ww.x * (1.f + s1.x) + s0.x;
        float a1 = hv[k * 4 + 1] * rinv * ww.y * (1.f + s1.y) + s0.y;
        float a2 = hv[k * 4 + 2] * rinv * ww.z * (1.f + s1.z) + s0.z;
        float a3 = hv[k * 4 + 3] * rinv * ww.w * (1.f + s1.w) + s0.w;
        uint2 pk; pk.x = pk2(a0, a1); pk.y = pk2(a2, a3);
        *(uint2*)(up + k * 256 + lane * 4) = pk;
      }
    }
  }
}

template <int MODE>
DEV void gemm_tile(const u16* __restrict__ A, int lda, const u16* __restrict__ Bt, int K, int rt, int ct, u16* z,
                   u16* zT, float* ab, float* o, char* smem) {
  u16* As = (u16*)smem;
  u16* Bs = As + 128 * 72;
  const int tid = opq(threadIdx.x), lane = tid & 63, w = tid >> 6, wr = w >> 1, wc = w & 1, fr = lane & 15, fq = lane >> 4;
  const int lrow = tid >> 3, lseg = tid & 7;
  const u16* Ag = A + (size_t)(rt * 128 + lrow) * lda + lseg * 8;
  const u16* Bg = Bt + (size_t)(ct * 128 + lrow) * K + lseg * 8;
  uint4 pa0, pa1, pa2, pa3, pb0, pb1, pb2, pb3;
  uint4 qa0, qa1, qa2, qa3, qb0, qb1, qb2, qb3;
  f32x4 acc[4][4];
#pragma unroll
  for (int i = 0; i < 4; ++i)
#pragma unroll
    for (int j = 0; j < 4; ++j) acc[i][j] = (f32x4){0.f, 0.f, 0.f, 0.f};
  const int nk = K / 64;
#define GLD(S, kk)                                                            \
  {                                                                           \
    const int kc_ = ((kk) < nk ? (kk) : nk - 1) * 64;                         \
    S##a0 = *(const uint4*)(Ag + kc_);                                        \
    S##a1 = *(const uint4*)(Ag + kc_ + (size_t)32 * lda);                     \
    S##a2 = *(const uint4*)(Ag + kc_ + (size_t)64 * lda);                     \
    S##a3 = *(const uint4*)(Ag + kc_ + (size_t)96 * lda);                     \
    S##b0 = *(const uint4*)(Bg + kc_);                                        \
    S##b1 = *(const uint4*)(Bg + kc_ + (size_t)32 * K);                       \
    S##b2 = *(const uint4*)(Bg + kc_ + (size_t)64 * K);                       \
    S##b3 = *(const uint4*)(Bg + kc_ + (size_t)96 * K);                       \
  }
#define GST(S, bufo)                                                          \
  *(uint4*)(As + (bufo) + (lrow)*72 + lseg * 8) = S##a0;                      \
  *(uint4*)(As + (bufo) + (lrow + 32) * 72 + lseg * 8) = S##a1;               \
  *(uint4*)(As + (bufo) + (lrow + 64) * 72 + lseg * 8) = S##a2;               \
  *(uint4*)(As + (bufo) + (lrow + 96) * 72 + lseg * 8) = S##a3;               \
  *(uint4*)(Bs + (bufo) + (lrow)*72 + lseg * 8) = S##b0;                      \
  *(uint4*)(Bs + (bufo) + (lrow + 32) * 72 + lseg * 8) = S##b1;               \
  *(uint4*)(Bs + (bufo) + (lrow + 64) * 72 + lseg * 8) = S##b2;               \
  *(uint4*)(Bs + (bufo) + (lrow + 96) * 72 + lseg * 8) = S##b3;
#define GCOMP(cb)                                                                                           \
  _Pragma("unroll") for (int ks = 0; ks < 2; ++ks) {                                                        \
    bf16x8 af[4], bfr[4];                                                                                   \
    _Pragma("unroll") for (int mi = 0; mi < 4; ++mi)                                                        \
        af[mi] = ld8(As + (cb) + (wr * 64 + mi * 16 + fr) * 72 + ks * 32 + fq * 8);                         \
    _Pragma("unroll") for (int ni = 0; ni < 4; ++ni)                                                        \
        bfr[ni] = ld8(Bs + (cb) + (wc * 64 + ni * 16 + fr) * 72 + ks * 32 + fq * 8);                        \
    _Pragma("unroll") for (int mi = 0; mi < 4; ++mi)                                                        \
        _Pragma("unroll") for (int ni = 0; ni < 4; ++ni) acc[mi][ni] = mfma(af[mi], bfr[ni], acc[mi][ni]);  \
  }
  constexpr int BUF1 = 2 * 128 * 72;
  GLD(p, 0)
  GLD(q, 1)
  GST(p, 0)
  __syncthreads();
  GLD(p, 2)
  for (int kt = 0; kt < nk; kt += 2) {
    GCOMP(0)
    GST(q, BUF1)
    GLD(q, kt + 3)
    __syncthreads();
    GCOMP(BUF1)
    GST(p, 0)
    GLD(p, kt + 4)
    __syncthreads();
  }
#pragma unroll
  for (int mi = 0; mi < 4; ++mi)
#pragma unroll
    for (int ni = 0; ni < 4; ++ni) {
      int row0 = rt * 128 + wr * 64 + mi * 16 + fq * 4;
      int col = ct * 128 + wc * 64 + ni * 16 + fr;
      f32x4 v = acc[mi][ni];
      if (MODE == 1) {
#pragma unroll
        for (int r = 0; r < 4; ++r) o[(size_t)(row0 + r) * 1024 + col] = v[r];
      } else {
        if (ct >= 28 && ct < 32) {
          uint2 pk; pk.x = pk2(v[0], v[1]); pk.y = pk2(v[2], v[3]);
          *(uint2*)(zT + (size_t)(col - C_IC) * GR + row0) = pk;
        } else if (ct == 44) {
          if (col - C_AB < 16) {
#pragma unroll
            for (int r = 0; r < 4; ++r) ab[(size_t)(row0 + r) * 16 + (col - C_AB)] = v[r];
          }
        } else {
#pragma unroll
          for (int r = 0; r < 4; ++r) z[(size_t)(row0 + r) * NZ + col] = f2bf(v[r]);
        }
      }
    }
}

DEV void a_item(const P& p, int l, int item, int mode, char* smem) {
  float* xc = (float*)smem;
  u16* xcb = (u16*)(smem + 16384);
  float* av = (float*)(smem + 16384 + 9216);
  float* uv = av + 4096;
  float* segP = uv + 4096;
  float* segH = segP + 256;
  const int tid = opq(threadIdx.x), lane = tid & 63, w = tid >> 6, fr = lane & 15, fq = lane >> 4;
  const int cgk = item >> 3, hA = item & 7, n = cgk % 36, rb = cgk * 64;
  u16* z = (u16*)(p.ws + O_Z);
  {
    u16* xin = (u16*)av;
    uint4 st[3];
#pragma unroll
    for (int k = 0; k < 3; ++k) {
      int idx = tid + 256 * k, row = idx >> 3, sg = idx & 7, cp = row - 2;
      bool ok = (idx < 536) && !((cp < 0 && (n == 0 || n == 4)) || (cp > 63 && (n == 3 || n == 35)));
      st[k] = make_uint4(0u, 0u, 0u, 0u);
      if (ok) st[k] = *(const uint4*)(z + (size_t)(rb + cp) * NZ + C_XA + hA * 64 + sg * 8);
    }
    const int j = tid & 63, ch = hA * 64 + j;
    float cw0 = p.conv_a_w[(l * 4 + 0) * 512 + ch], cw1 = p.conv_a_w[(l * 4 + 1) * 512 + ch];
    float cw2 = p.conv_a_w[(l * 4 + 2) * 512 + ch], cw3 = p.conv_a_w[(l * 4 + 3) * 512 + ch];
    float cb = p.conv_a_b[l * 512 + ch];
#pragma unroll
    for (int k = 0; k < 3; ++k) {
      int idx = tid + 256 * k, row = idx >> 3, sg = idx & 7;
      if (idx < 536) *(uint4*)(xin + row * 72 + sg * 8) = st[k];
    }
    __syncthreads();
#pragma unroll
    for (int k = 0; k < 16; ++k) {
      int c = (tid >> 6) + 4 * k;
      float val = cb + cw0 * bf2f(xin[c * 72 + j]) + cw1 * bf2f(xin[(c + 1) * 72 + j]) + cw2 * bf2f(xin[(c + 2) * 72 + j]) +
                  cw3 * bf2f(xin[(c + 3) * 72 + j]);
      xc[c * 64 + j] = val;
      xcb[c * 72 + j] = f2bf(val);
    }
  }
  __syncthreads();
  float yacc[16];
#pragma unroll
  for (int k = 0; k < 16; ++k) yacc[k] = 0.f;
  const int seg = tid >> 6, sj = tid & 63, sch = hA * 64 + sj;
  for (int dir = 0; dir < 2; ++dir) {
    {
      const u16* wg = (const u16*)(p.ws + O_WGT);
      const u16* wr_ = wg + (size_t)((((l * 2 + dir) * 2 + 0) * 8 + hA)) * 4096;
      const u16* wi_ = wg + (size_t)((((l * 2 + dir) * 2 + 1) * 8 + hA)) * 4096;
      bf16x8 a0 = ld8(xcb + (16 * w + fr) * 72 + fq * 8), a1 = ld8(xcb + (16 * w + fr) * 72 + 32 + fq * 8);
#pragma unroll
      for (int nt = 0; nt < 4; ++nt) {
        f32x4 ar = {0.f, 0.f, 0.f, 0.f}, ai = {0.f, 0.f, 0.f, 0.f};
        const u16* br = wr_ + (nt * 16 + fr) * 64 + fq * 8;
        const u16* bi = wi_ + (nt * 16 + fr) * 64 + fq * 8;
        ar = mfma(a0, ld8(br), ar); ar = mfma(a1, ld8(br + 32), ar);
        ai = mfma(a0, ld8(bi), ai); ai = mfma(a1, ld8(bi + 32), ai);
        int j = nt * 16 + fr, ch = hA * 64 + j;
        float brv = p.rg_b_r[(l * 2 + dir) * 512 + ch], biv = p.rg_b_i[(l * 2 + dir) * 512 + ch];
        float sp = softplus(-p.rg_lam[(l * 2 + dir) * 512 + ch]);
#pragma unroll
        for (int r = 0; r < 4; ++r) {
          int c = 16 * w + 4 * fq + r;
          float rg = sigm(ar[r] + brv), ig = sigm(ai[r] + biv);
          float la = -8.f * rg * sp;
          float a = __expf(la);
          float t2 = 2.f * la;
          float om = (t2 > -0.02f) ? -t2 * (1.f + 0.5f * t2 * (1.f + t2 * (1.f / 3.f) * (1.f + 0.25f * t2))) : 1.f - a * a;
          float uu = sqrtf(fmaxf(om, 0.f)) * (ig * xc[c * 64 + j]);
          av[c * 64 + j] = bf2f(f2bf(la));
          uv[c * 64 + j] = bf2f(f2bf(uu));
        }
      }
    }
    __syncthreads();
    {
      float ls = 0.f, H = 0.f;
      u16* ALA = (u16*)(p.ws + O_ALA);
      u16* AU = (u16*)(p.ws + O_AU);
#pragma unroll
      for (int k = 0; k < 16; ++k) {
        int c = dir ? (16 * seg + 15 - k) : (16 * seg + k);
        float la_ = av[c * 64 + sj], u_ = uv[c * 64 + sj];
        H = __expf(la_) * H + u_;
        ls += la_;
        size_t gi = ((size_t)dir * GR + rb + c) * 512 + sch;
        ALA[gi] = f2bf(la_);
        AU[gi] = f2bf(u_);
      }
      segP[seg * 64 + sj] = __expf(ls);
      segH[seg * 64 + sj] = H;
    }
    __syncthreads();
    if (mode == 0) {
      if (seg == 0) {
        float Pc = 1.f, Hc = 0.f;
        for (int q = 0; q < 4; ++q) {
          int sg = dir ? 3 - q : q;
          Hc = segP[sg * 64 + sj] * Hc + segH[sg * 64 + sj];
          Pc *= segP[sg * 64 + sj];
        }
        size_t idx = ((size_t)cgk * 2 + dir) * 512 + sch;
        ((float*)(p.ws + O_AP))[idx] = Pc;
        ((float*)(p.ws + O_AH))[idx] = Hc;
      }
    } else {
      float st = ((const float*)(p.ws + O_ACAR))[((size_t)cgk * 2 + dir) * 512 + sch];
      int nbefore = dir ? 3 - seg : seg;
      for (int q = 0; q < nbefore; ++q) {
        int sg = dir ? 3 - q : q;
        st = segP[sg * 64 + sj] * st + segH[sg * 64 + sj];
      }
      if (dir == 0) {
#pragma unroll
        for (int k = 0; k < 16; ++k) {
          int c = 16 * seg + k;
          st = av[c * 64 + sj] * st + uv[c * 64 + sj];
          yacc[k] += st;
        }
      } else {
#pragma unroll
        for (int k = 15; k >= 0; --k) {
          int c = 16 * seg + k;
          st = av[c * 64 + sj] * st + uv[c * 64 + sj];
          yacc[k] += st;
        }
      }
    }
    __syncthreads();
  }
  if (mode == 1) {
#pragma unroll
    for (int k = 0; k < 16; ++k) {
      size_t zi = (size_t)(rb + 16 * seg + k) * NZ + C_GA + sch;
      float gate = bf2f(z[zi]);
      z[zi] = f2bf(yacc[k] * silu(gate));
    }
  }
}

DEV void a_fin(const P& p, int l, int item, char* smem) {
  float* segP = (float*)smem;
  float* segH = segP + 512;
  const int tid = opq(threadIdx.x), seg = tid >> 6, sj = tid & 63;
  const int cgk = item >> 3, hA = item & 7, rb = cgk * 64, sch = hA * 64 + sj;
  u16* z = (u16*)(p.ws + O_Z);
  const u16* ALA = (const u16*)(p.ws + O_ALA);
  const u16* AU = (const u16*)(p.ws + O_AU);
  u16 lab[2][16], ub[2][16], gt[16];
#pragma unroll
  for (int dir = 0; dir < 2; ++dir)
#pragma unroll
    for (int k = 0; k < 16; ++k) {
      size_t gi = ((size_t)dir * GR + rb + 16 * seg + k) * 512 + sch;
      lab[dir][k] = ALA[gi];
      ub[dir][k] = AU[gi];
    }
#pragma unroll
  for (int k = 0; k < 16; ++k) gt[k] = z[(size_t)(rb + 16 * seg + k) * NZ + C_GA + sch];
  float car0 = ((const float*)(p.ws + O_ACAR))[((size_t)cgk * 2 + 0) * 512 + sch];
  float car1 = ((const float*)(p.ws + O_ACAR))[((size_t)cgk * 2 + 1) * 512 + sch];
  float af[2][16];
#pragma unroll
  for (int dir = 0; dir < 2; ++dir) {
    float ls = 0.f, H = 0.f;
#pragma unroll
    for (int kk = 0; kk < 16; ++kk) {
      const int k = dir ? 15 - kk : kk;
      float la_ = bf2f(lab[dir][k]);
      float a = __expf(la_);
      af[dir][k] = a;
      H = a * H + bf2f(ub[dir][k]);
      ls += la_;
    }
    segP[(dir * 4 + seg) * 64 + sj] = __expf(ls);
    segH[(dir * 4 + seg) * 64 + sj] = H;
  }
  __syncthreads();
  float yacc[16];
#pragma unroll
  for (int k = 0; k < 16; ++k) yacc[k] = 0.f;
#pragma unroll
  for (int dir = 0; dir < 2; ++dir) {
    float st = dir ? car1 : car0;
    const int nbefore = dir ? 3 - seg : seg;
    for (int q = 0; q < nbefore; ++q) {
      int sg = dir ? 3 - q : q;
      st = segP[(dir * 4 + sg) * 64 + sj] * st + segH[(dir * 4 + sg) * 64 + sj];
    }
#pragma unroll
    for (int kk = 0; kk < 16; ++kk) {
      const int k = dir ? 15 - kk : kk;
      st = af[dir][k] * st + bf2f(ub[dir][k]);
      yacc[k] += st;
    }
  }
#pragma unroll
  for (int k = 0; k < 16; ++k)
    z[(size_t)(rb + 16 * seg + k) * NZ + C_GA + sch] = f2bf(yacc[k] * silu(bf2f(gt[k])));
  __syncthreads();
}

DEV void a_carry(const P& p, int item) {
  int t = item * 256 + threadIdx.x;
  int ch = t & 511, dir = (t >> 9) & 1, lb = t >> 10;
  const float* AP = (const float*)(p.ws + O_AP);
  const float* AH = (const float*)(p.ws + O_AH);
  float* AC = (float*)(p.ws + O_ACAR);
  float st = 0.f;
  for (int j = 0; j < 36; ++j) {
    int n = dir ? (j < 4 ? 3 - j : 39 - j) : j;
    size_t idx = ((size_t)(lb * 36 + n) * 2 + dir) * 512 + ch;
    AC[idx] = st;
    st = AP[idx] * st + AH[idx];
  }
}

DEV void b_local(const P& p, int l, int item, char* smem) {
  u16* qs = (u16*)smem;
  u16* ks = qs + 64 * 136;
  float* Am = (float*)(smem + 34816);
  float* gc = (float*)(smem + 34816 + 32768);
  float* bt = gc + 128;
  const int tid = opq(threadIdx.x), lane = tid & 63, w = tid >> 6, fr = lane & 15, fq = lane >> 4;
  const int cgk = item >> 2, h = item & 3, n = cgk % 36, rb = cgk * 64;
  const u16* z = (const u16*)(p.ws + O_Z);
  u16* qn = (u16*)(p.ws + O_BSH);
  u16* kn = qn + (size_t)GR * 512;
  u16* vb = kn + (size_t)GR * 512;
  u16* knT = vb + (size_t)GR * 512;
  const float* ab = (const float*)(p.ws + O_AB);
  {
    u16* Tt = (u16*)Am;
    uint4 st[5];
#define BL_TLOAD(which)                                                                                  \
  _Pragma("unroll") for (int k = 0; k < 5; ++k) {                                                        \
    int idx = tid + 256 * k, row = idx >> 4, seg = idx & 15, cp = row - 2;                               \
    bool ok = (idx < 1072) && !((cp < 0 && (n == 0 || n == 4)) || (cp > 63 && (n == 3 || n == 35)));    \
    st[k] = make_uint4(0u, 0u, 0u, 0u);                                                                  \
    if (ok) st[k] = *(const uint4*)(z + (size_t)(rb + cp) * NZ + C_Q + (which)*512 + h * 128 + seg * 8); \
  }
    BL_TLOAD(0)
#pragma unroll
    for (int which = 0; which < 3; ++which) {
#pragma unroll
      for (int k = 0; k < 5; ++k) {
        int idx = tid + 256 * k, row = idx >> 4, seg = idx & 15;
        if (idx < 1072) *(uint4*)(Tt + row * 136 + seg * 8) = st[k];
      }
      __syncthreads();
      if (which < 2) { BL_TLOAD(which + 1) }
      float cw[2][4];
#pragma unroll
      for (int hh = 0; hh < 2; ++hh)
#pragma unroll
        for (int tap = 0; tap < 4; ++tap)
          cw[hh][tap] = p.conv_b_w[(size_t)(l * 4 + tap) * 1536 + which * 512 + h * 128 + lane + 64 * hh];
      for (int c = w; c < 64; c += 4) {
        float v[2];
#pragma unroll
        for (int hh = 0; hh < 2; ++hh) {
          int d = lane + 64 * hh;
          float a = 0.f;
#pragma unroll
          for (int tap = 0; tap < 4; ++tap) a += cw[hh][tap] * bf2f(Tt[(c + tap) * 136 + d]);
          v[hh] = silu(a);
        }
        float rs = 1.f;
        if (which < 2) {
          float sq = v[0] * v[0] + v[1] * v[1];
#pragma unroll
          for (int off = 32; off; off >>= 1) sq += __shfl_xor(sq, off);
          rs = rsqrtf(sq + EPS) * (which == 0 ? 0.08838834764831845f : 1.f);
        }
#pragma unroll
        for (int hh = 0; hh < 2; ++hh) {
          int d = lane + 64 * hh;
          u16 ob = f2bf(v[hh] * rs);
          size_t gi = (size_t)(rb + c) * 512 + h * 128 + d;
          if (which == 0) { qs[c * 136 + d] = ob; qn[gi] = ob; }
          else if (which == 1) { ks[c * 136 + d] = ob; kn[gi] = ob; }
          else vb[gi] = ob;
        }
      }
      __syncthreads();
    }
  }
  if (w < 2) {
    int dir = w, i = lane, c = dir ? 63 - i : i;
    float al = ab[(size_t)(rb + c) * 16 + dir * 4 + h], bl = ab[(size_t)(rb + c) * 16 + 8 + dir * 4 + h];
    float g = -__expf(p.gdn_a_log[(l * 2 + dir) * 4 + h]) * softplus(al + p.gdn_dt_bias[(l * 2 + dir) * 4 + h]);
#pragma unroll
    for (int off = 1; off < 64; off <<= 1) {
      float v = __shfl_up(g, off);
      if (lane >= off) g += v;
    }
    gc[dir * 64 + i] = g;
    bt[dir * 64 + i] = sigm(bl);
  }
  __syncthreads();
  for (int idx = tid; idx < 1024; idx += 256) {
    int d = idx >> 3, c8 = idx & 7;
    uint4 pk;
    pk.x = (unsigned)ks[(c8 * 8 + 0) * 136 + d] | ((unsigned)ks[(c8 * 8 + 1) * 136 + d] << 16);
    pk.y = (unsigned)ks[(c8 * 8 + 2) * 136 + d] | ((unsigned)ks[(c8 * 8 + 3) * 136 + d] << 16);
    pk.z = (unsigned)ks[(c8 * 8 + 4) * 136 + d] | ((unsigned)ks[(c8 * 8 + 5) * 136 + d] << 16);
    pk.w = (unsigned)ks[(c8 * 8 + 6) * 136 + d] | ((unsigned)ks[(c8 * 8 + 7) * 136 + d] << 16);
    *(uint4*)(knT + ((size_t)(cgk * 4 + h) * 128 + d) * 64 + c8 * 8) = pk;
  }
  for (int dir = 0; dir < 2; ++dir) {
    char* rec = p.ws + O_BIT + ((size_t)(cgk * 4 + h) * 2 + dir) * BIT_SZ;
    u16* QKm = (u16*)rec + 4096;
    float* scal = (float*)(rec + 16384);
    int irow = 16 * w + fr, ci = dir ? 63 - irow : irow;
    bf16x8 ak[4], aq[4];
#pragma unroll
    for (int s = 0; s < 4; ++s) { ak[s] = ld8(ks + ci * 136 + 32 * s + 8 * fq); aq[s] = ld8(qs + ci * 136 + 32 * s + 8 * fq); }
#pragma unroll
    for (int nt = 0; nt < 4; ++nt) {
      int jcol = 16 * nt + fr, cj = dir ? 63 - jcol : jcol;
      f32x4 kk = {0.f, 0.f, 0.f, 0.f}, qk = {0.f, 0.f, 0.f, 0.f};
#pragma unroll
      for (int s = 0; s < 4; ++s) {
        bf16x8 b = ld8(ks + cj * 136 + 32 * s + 8 * fq);
        kk = mfma(ak[s], b, kk);
        qk = mfma(aq[s], b, qk);
      }
      float gj = gc[dir * 64 + jcol];
#pragma unroll
      for (int r = 0; r < 4; ++r) {
        int i = 16 * w + 4 * fq + r;
        float dec = (jcol <= i) ? __expf(gc[dir * 64 + i] - gj) : 0.f;
        Am[(dir * 64 + i) * 64 + jcol] = (jcol < i) ? bt[dir * 64 + i] * kk[r] * dec : 0.f;
        QKm[i * 64 + jcol] = f2bf(qk[r] * dec);
      }
    }
    if (tid < 64) {
      float gl = gc[dir * 64 + 63], gi = gc[dir * 64 + tid];
      scal[tid] = __expf(gi);
      scal[64 + tid] = bt[dir * 64 + tid];
      scal[128 + tid] = __expf(gl - gi);
      if (tid == 0) scal[192] = __expf(gl);
    }
  }
  __syncthreads();
  if (w < 2) {
    int dir = w, col = lane;
    u16* Tinv = (u16*)(p.ws + O_BIT + ((size_t)(cgk * 4 + h) * 2 + dir) * BIT_SZ);
    const float* Ad = Am + dir * 4096;
    float T[64];
#pragma unroll
    for (int i = 0; i < 64; ++i) {
      float s = (i == col) ? 1.f : 0.f;
#pragma unroll
      for (int j = 0; j < i; ++j) s -= Ad[i * 64 + j] * T[j];
      T[i] = s;
      Tinv[i * 64 + col] = f2bf(s);
      __builtin_amdgcn_sched_barrier(0);
    }
  }
  __syncthreads();
}

DEV void b_seq(const P& p, int bitem, char* smem) {
  const int tid = opq(threadIdx.x), lane = tid & 63, w = tid >> 6, fr = lane & 15, fq = lane >> 4;
  const bool active = w < WPB;
  const int item = bitem * WPB + (active ? w : 0);
  const int slice = item & 7, dir = (item >> 3) & 1, h = (item >> 4) & 3, lb = item >> 6, e0 = slice * 16;
  u16* Ss = (u16*)(smem + w * 11264);
  u16* Rs = Ss + 16 * 136;
  u16* Vsc = Rs + 16 * 72;
  u16* Vor = Vsc + 16 * 72;
  const u16* qn = (const u16*)(p.ws + O_BSH);
  const u16* kn = qn + (size_t)GR * 512;
  const u16* vb = kn + (size_t)GR * 512;
  const u16* knT = vb + (size_t)GR * 512;
  u16* OB = (u16*)(p.ws + O_OB);
  f32x4 S[8];
#pragma unroll
  for (int m = 0; m < 8; ++m) S[m] = (f32x4){0.f, 0.f, 0.f, 0.f};
  for (int j = 0; j < 36; ++j) {
    const int n = dir ? (j < 4 ? 3 - j : 39 - j) : j;
    const int cgk = lb * 36 + n, rb = cgk * 64;
    const char* rec = p.ws + O_BIT + ((size_t)(cgk * 4 + h) * 2 + dir) * BIT_SZ;
    const u16* Tinv = (const u16*)rec;
    const u16* QKm = Tinv + 4096;
    const float* scal = (const float*)(rec + 16384);
    if (active) {
#pragma unroll
      for (int m = 0; m < 8; ++m) {
        uint2 pk; pk.x = pk2(S[m][0], S[m][1]); pk.y = pk2(S[m][2], S[m][3]);
        *(uint2*)(Ss + fr * 136 + 16 * m + 4 * fq) = pk;
      }
    }
    __syncthreads();
    bf16x8 Sf[4];
    if (active) {
#pragma unroll
      for (int s = 0; s < 4; ++s) Sf[s] = ld8(Ss + fr * 136 + 32 * s + 8 * fq);
#pragma unroll
      for (int m = 0; m < 4; ++m) {
        int i = 16 * m + fr, rowi = rb + (dir ? 63 - i : i);
        f32x4 X = {0.f, 0.f, 0.f, 0.f};
#pragma unroll
        for (int s = 0; s < 4; ++s) X = mfma(ld8(kn + (size_t)rowi * 512 + h * 128 + 32 * s + 8 * fq), Sf[s], X);
        float rv[4];
#pragma unroll
        for (int r = 0; r < 4; ++r) {
          int ii = 16 * m + 4 * fq + r, rowr = rb + (dir ? 63 - ii : ii);
          float v = bf2f(vb[(size_t)rowr * 512 + h * 128 + e0 + fr]);
          rv[r] = scal[64 + ii] * (v - scal[ii] * X[r]);
        }
        uint2 pk; pk.x = pk2(rv[0], rv[1]); pk.y = pk2(rv[2], rv[3]);
        *(uint2*)(Rs + fr * 72 + 16 * m + 4 * fq) = pk;
      }
    }
    __syncthreads();
    if (active) {
      bf16x8 Rf0 = ld8(Rs + fr * 72 + 8 * fq), Rf1 = ld8(Rs + fr * 72 + 32 + 8 * fq);
#pragma unroll
      for (int m = 0; m < 4; ++m) {
        f32x4 VN = {0.f, 0.f, 0.f, 0.f};
        VN = mfma(ld8(Tinv + (16 * m + fr) * 64 + 8 * fq), Rf0, VN);
        VN = mfma(ld8(Tinv + (16 * m + fr) * 64 + 32 + 8 * fq), Rf1, VN);
        uint2 pk; pk.x = pk2(VN[0], VN[1]); pk.y = pk2(VN[2], VN[3]);
        *(uint2*)(Vsc + fr * 72 + 16 * m + 4 * fq) = pk;
        int ib = 16 * m + 4 * fq;
        float s0 = VN[0] * scal[128 + ib], s1 = VN[1] * scal[128 + ib + 1], s2 = VN[2] * scal[128 + ib + 2],
              s3 = VN[3] * scal[128 + ib + 3];
        if (dir) {
          pk.x = pk2(s3, s2); pk.y = pk2(s1, s0);
          *(uint2*)(Vor + fr * 72 + (60 - ib)) = pk;
        } else {
          pk.x = pk2(s0, s1); pk.y = pk2(s2, s3);
          *(uint2*)(Vor + fr * 72 + ib) = pk;
        }
      }
    }
    __syncthreads();
    if (active) {
      bf16x8 Vs0 = ld8(Vsc + fr * 72 + 8 * fq), Vs1 = ld8(Vsc + fr * 72 + 32 + 8 * fq);
      bf16x8 Vo0 = ld8(Vor + fr * 72 + 8 * fq), Vo1 = ld8(Vor + fr * 72 + 32 + 8 * fq);
#pragma unroll
      for (int m = 0; m < 4; ++m) {
        int i = 16 * m + fr, rowi = rb + (dir ? 63 - i : i);
        f32x4 O = {0.f, 0.f, 0.f, 0.f};
#pragma unroll
        for (int s = 0; s < 4; ++s) O = mfma(ld8(qn + (size_t)rowi * 512 + h * 128 + 32 * s + 8 * fq), Sf[s], O);
#pragma unroll
        for (int r = 0; r < 4; ++r) O[r] *= scal[16 * m + 4 * fq + r];
        O = mfma(ld8(QKm + (16 * m + fr) * 64 + 8 * fq), Vs0, O);
        O = mfma(ld8(QKm + (16 * m + fr) * 64 + 32 + 8 * fq), Vs1, O);
#pragma unroll
        for (int r = 0; r < 4; ++r) {
          int ii = 16 * m + 4 * fq + r, rowr = rb + (dir ? 63 - ii : ii);
          OB[((size_t)dir * GR + rowr) * 512 + h * 128 + e0 + fr] = f2bf(O[r]);
        }
      }
      float egl = scal[192];
#pragma unroll
      for (int m = 0; m < 8; ++m) {
        const u16* kt = knT + ((size_t)(cgk * 4 + h) * 128 + 16 * m + fr) * 64;
        f32x4 t = S[m];
#pragma unroll
        for (int r = 0; r < 4; ++r) t[r] *= egl;
        t = mfma(ld8(kt + 8 * fq), Vo0, t);
        t = mfma(ld8(kt + 32 + 8 * fq), Vo1, t);
        S[m] = t;
      }
    }
  }
  __syncthreads();
}

DEV void c_local(const P& p, int l, int item, char* smem) {
  float* bsm = (float*)smem;
  u16* Ps = (u16*)(smem + 33024);
  u16* kdt = (u16*)(smem + 33024 + 9216);
  const int tid = opq(threadIdx.x), lane = tid & 63, w = tid >> 6, fr = lane & 15, fq = lane >> 4;
  const int cgk = item >> 2, h = item & 3, rb = cgk * 64;
  const u16* z = (const u16*)(p.ws + O_Z);
  const u16* zT = (const u16*)(p.ws + O_ZT);
  u16* OC = (u16*)(p.ws + O_OC);
  const float* lbs = (const float*)(p.ws + O_LBS);
  for (int dir = 0; dir < 2; ++dir) {
    char* rec = p.ws + O_CREC + ((size_t)(cgk * 4 + h) * 2 + dir) * CREC_SZ;
    u16* QD = (u16*)rec;
    u16* KDT = QD + 8192;
    float* decv = (float*)(rec + 32768);
    const float* lbp = lbs + l * 1024 + dir * 512 + h * 128;
    const int fcol = C_F0 + dir * 512 + h * 128;
    {
      int d = tid & 127, half = tid >> 7;
      float lb_ = lbp[d], run = 0.f;
      for (int k = 0; k < 32; ++k) {
        int i = 32 * half + k, c = dir ? 63 - i : i;
        float f = bf2f(z[(size_t)(rb + c) * NZ + fcol + d]);
        float fg = lb_ + (1.f - lb_) * sigm(f);
        run += __logf(fg);
        bsm[i * 129 + d] = run;
      }
    }
    __syncthreads();
    {
      int d = tid & 127, half = tid >> 7;
      if (half) {
        float add = bsm[31 * 129 + d];
        for (int k = 0; k < 32; ++k) bsm[(32 + k) * 129 + d] += add;
      }
    }
    __syncthreads();
    for (int idx = tid; idx < 8192; idx += 256) {
      int i = idx >> 7, d = idx & 127, c = dir ? 63 - i : i;
      float b = bsm[i * 129 + d];
      float q = silu(bf2f(z[(size_t)(rb + c) * NZ + C_QC + h * 128 + d]));
      QD[i * 128 + d] = f2bf(q * __expf(b));
      float f = bf2f(z[(size_t)(rb + c) * NZ + fcol + d]);
      float k = (1.f - lbp[d]) * sigm(-f);
      kdt[d * 72 + c] = f2bf(k * __expf(bsm[63 * 129 + d] - b));
    }
    if (tid < 128) decv[tid] = __expf(bsm[63 * 129 + tid]);
    __syncthreads();
    for (int idx = tid; idx < 1024; idx += 256) {
      int d = idx >> 3, c8 = idx & 7;
      *(uint4*)(KDT + d * 64 + c8 * 8) = *(const uint4*)(kdt + d * 72 + c8 * 8);
    }
    {
      const int sj = w;
      for (int si = 0; si < 4; ++si) {
        f32x4 acc = {0.f, 0.f, 0.f, 0.f};
        if (si >= sj) {
          int it = 16 * si + fr, jt = 16 * sj + fr;
          int ci = dir ? 63 - it : it, cj = dir ? 63 - jt : jt;
#pragma unroll
          for (int s = 0; s < 4; ++s) {
            int d0 = 32 * s + 8 * fq;
            bf16x8 qv = ld8(z + (size_t)(rb + ci) * NZ + C_QC + h * 128 + d0);
            bf16x8 fv = ld8(z + (size_t)(rb + cj) * NZ + fcol + d0);
            bf16x8 af, bf;
#pragma unroll
            for (int e = 0; e < 8; ++e) {
              int d = d0 + e;
              float Bs_ = si ? bsm[(16 * si - 1) * 129 + d] : 0.f;
              float qq = silu(bf2f((u16)qv[e])) * __expf(bsm[it * 129 + d] - Bs_);
              float kk = (1.f - lbp[d]) * sigm(-bf2f((u16)fv[e])) * __expf(Bs_ - bsm[jt * 129 + d]);
              af[e] = (short)f2bf(qq);
              bf[e] = (short)f2bf(kk);
            }
            acc = mfma(af, bf, acc);
          }
        }
#pragma unroll
        for (int r = 0; r < 4; ++r) {
          int i = 16 * si + 4 * fq + r, jj = 16 * sj + fr;
          float v = (si >= sj && jj <= i) ? acc[r] : 0.f;
          Ps[i * 72 + (dir ? 63 - jj : jj)] = f2bf(v);
        }
        __builtin_amdgcn_sched_barrier(0);
      }
    }
    __syncthreads();
#pragma unroll
    for (int nt2 = 0; nt2 < 2; ++nt2) {
      int e = h * 128 + (2 * w + nt2) * 16 + fr;
      bf16x8 v0 = ld8(zT + (size_t)e * GR + rb + 8 * fq), v1 = ld8(zT + (size_t)e * GR + rb + 32 + 8 * fq);
#pragma unroll
      for (int m = 0; m < 4; ++m) {
        f32x4 O = {0.f, 0.f, 0.f, 0.f};
        O = mfma(ld8(Ps + (16 * m + fr) * 72 + 8 * fq), v0, O);
        O = mfma(ld8(Ps + (16 * m + fr) * 72 + 32 + 8 * fq), v1, O);
#pragma unroll
        for (int r = 0; r < 4; ++r) {
          int ii = 16 * m + 4 * fq + r, rowr = rb + (dir ? 63 - ii : ii);
          OC[((size_t)dir * GR + rowr) * 512 + e] = f2bf(O[r]);
        }
      }
    }
    __syncthreads();
  }
}

DEV void c_seq(const P& p, int bitem, char* smem) {
  const int tid = opq(threadIdx.x), lane = tid & 63, w = tid >> 6, fr = lane & 15, fq = lane >> 4;
  const bool active = w < WPB;
  const int item = bitem * WPB + (active ? w : 0);
  const int slice = item & 7, dir = (item >> 3) & 1, h = (item >> 4) & 3, lb = item >> 6, e0 = slice * 16;
  u16* Ss = (u16*)(smem + w * 4352);
  const u16* zT = (const u16*)(p.ws + O_ZT);
  u16* OC = (u16*)(p.ws + O_OC);
  f32x4 S[8];
#pragma unroll
  for (int m = 0; m < 8; ++m) S[m] = (f32x4){0.f, 0.f, 0.f, 0.f};
  for (int j = 0; j < 36; ++j) {
    const int n = dir ? (j < 4 ? 3 - j : 39 - j) : j;
    const int cgk = lb * 36 + n, rb = cgk * 64;
    const char* rec = p.ws + O_CREC + ((size_t)(cgk * 4 + h) * 2 + dir) * CREC_SZ;
    const u16* QD = (const u16*)rec;
    const u16* KDT = QD + 8192;
    const float* decv = (const float*)(rec + 32768);
    if (active) {
#pragma unroll
      for (int m = 0; m < 8; ++m) {
        uint2 pk; pk.x = pk2(S[m][0], S[m][1]); pk.y = pk2(S[m][2], S[m][3]);
        *(uint2*)(Ss + fr * 136 + 16 * m + 4 * fq) = pk;
      }
    }
    __syncthreads();
    if (active) {
      bf16x8 Sf[4];
#pragma unroll
      for (int s = 0; s < 4; ++s) Sf[s] = ld8(Ss + fr * 136 + 32 * s + 8 * fq);
#pragma unroll
      for (int m = 0; m < 4; ++m) {
        f32x4 O = {0.f, 0.f, 0.f, 0.f};
#pragma unroll
        for (int s = 0; s < 4; ++s) O = mfma(ld8(QD + (16 * m + fr) * 128 + 32 * s + 8 * fq), Sf[s], O);
#pragma unroll
        for (int r = 0; r < 4; ++r) {
          int ii = 16 * m + 4 * fq + r, rowr = rb + (dir ? 63 - ii : ii);
          size_t oi = ((size_t)dir * GR + rowr) * 512 + h * 128 + e0 + fr;
          OC[oi] = f2bf(bf2f(OC[oi]) + O[r]);
        }
      }
      const u16* vp = zT + (size_t)(h * 128 + e0 + fr) * GR + rb;
      bf16x8 V0 = ld8(vp + 8 * fq), V1 = ld8(vp + 32 + 8 * fq);
#pragma unroll
      for (int m = 0; m < 8; ++m) {
        f32x4 t = S[m];
#pragma unroll
        for (int r = 0; r < 4; ++r) t[r] *= decv[16 * m + 4 * fq + r];
        t = mfma(ld8(KDT + (16 * m + fr) * 64 + 8 * fq), V0, t);
        t = mfma(ld8(KDT + (16 * m + fr) * 64 + 32 + 8 * fq), V1, t);
        S[m] = t;
      }
    }
    __syncthreads();
  }
}

#define LBAR()                                              \
  do {                                                      \
    asm volatile("s_waitcnt lgkmcnt(0)" ::: "memory");      \
    __builtin_amdgcn_s_barrier();                           \
    asm volatile("" ::: "memory");                          \
  } while (0)
#define CBAR() asm volatile("" ::: "memory")

DEV void c_local2(const P& p, int l, int item, char* smem) {
  float* bsm = (float*)smem;
  u16* Fq = (u16*)(smem + 33024);
  u16* kdt = (u16*)(smem + 50432);
  u16* Ps = kdt;
  const int tid = opq(threadIdx.x), lane = tid & 63, w = tid >> 6, fr = lane & 15, fq = lane >> 4;
  const int cgk = item >> 2, h = item & 3, rb = cgk * 64;
  const u16* z = (const u16*)(p.ws + O_Z);
  const u16* zT = (const u16*)(p.ws + O_ZT);
  u16* OC = (u16*)(p.ws + O_OC);
  const float* lbs = (const float*)(p.ws + O_LBS);
  u16* zq = (u16*)(p.ws + O_Z) + (size_t)rb * NZ + C_QC + h * 128;
  {
    uint4 t4[4];
#pragma unroll
    for (int k = 0; k < 4; ++k) {
      int idx = tid + 256 * k, c = idx >> 4, seg = idx & 15;
      t4[k] = *(const uint4*)(zq + (size_t)c * NZ + seg * 8);
    }
#pragma unroll
    for (int k = 0; k < 4; ++k) {
      int idx = tid + 256 * k, c = idx >> 4, seg = idx & 15;
      unsigned wv[4] = {t4[k].x, t4[k].y, t4[k].z, t4[k].w};
#pragma unroll
      for (int q = 0; q < 4; ++q)
        wv[q] = pk2(silu(bf2f((u16)(wv[q] & 0xffff))), silu(bf2f((u16)(wv[q] >> 16))));
      *(uint4*)(zq + (size_t)c * NZ + seg * 8) = make_uint4(wv[0], wv[1], wv[2], wv[3]);
    }
  }
  __syncthreads();
  for (int dir = 0; dir < 2; ++dir) {
    char* rec = p.ws + O_CREC + ((size_t)(cgk * 4 + h) * 2 + dir) * CREC_SZ;
    u16* QD = (u16*)rec;
    u16* KDT = QD + 8192;
    float* decv = (float*)(rec + 32768);
    const float* lbp = lbs + l * 1024 + dir * 512 + h * 128;
    const int fcol = C_F0 + dir * 512 + h * 128;
    {
      uint4 t4[4];
#pragma unroll
      for (int k = 0; k < 4; ++k) {
        int idx = tid + 256 * k, c = idx >> 4, seg = idx & 15;
        t4[k] = *(const uint4*)(z + (size_t)(rb + c) * NZ + fcol + seg * 8);
      }
#pragma unroll
      for (int k = 0; k < 4; ++k) {
        int idx = tid + 256 * k, c = idx >> 4, seg = idx & 15;
        *(uint4*)(Fq + c * 136 + seg * 8) = t4[k];
      }
    }
    __syncthreads();
    {
      int d = tid & 127, half = tid >> 7;
      float lb_ = lbp[d], run = 0.f;
#pragma unroll 8
      for (int k = 0; k < 32; ++k) {
        int i = 32 * half + k, c = dir ? 63 - i : i;
        float f = bf2f(Fq[c * 136 + d]);
        float fg = lb_ + (1.f - lb_) * sigm(f);
        run += __logf(fg);
        bsm[i * 129 + d] = run;
      }
    }
    __syncthreads();
    {
      int d = tid & 127, half = tid >> 7;
      if (half) {
        float add = bsm[31 * 129 + d];
#pragma unroll 8
        for (int k = 0; k < 32; ++k) bsm[(32 + k) * 129 + d] += add;
      }
    }
    __syncthreads();
    {
      uint4 qv[4];
#pragma unroll
      for (int k = 0; k < 4; ++k) {
        int idx = tid + 256 * k, c = idx >> 4, seg = idx & 15;
        qv[k] = *(const uint4*)(zq + (size_t)c * NZ + seg * 8);
      }
#pragma unroll
      for (int k = 0; k < 4; ++k) {
        int idx = tid + 256 * k, c = idx >> 4, seg = idx & 15, i = dir ? 63 - c : c, d0 = seg * 8;
        unsigned qw[4] = {qv[k].x, qv[k].y, qv[k].z, qv[k].w};
        uint4 fv4 = *(const uint4*)(Fq + c * 136 + d0);
        unsigned fw[4] = {fv4.x, fv4.y, fv4.z, fv4.w};
        unsigned qo[4], ko[4];
#pragma unroll
        for (int q = 0; q < 4; ++q) {
          int d = d0 + 2 * q;
          float b0 = bsm[i * 129 + d], b1 = bsm[i * 129 + d + 1];
          float bl0 = bsm[63 * 129 + d], bl1 = bsm[63 * 129 + d + 1];
          float q0 = bf2f((u16)(qw[q] & 0xffff)), q1 = bf2f((u16)(qw[q] >> 16));
          qo[q] = pk2(q0 * __expf(b0), q1 * __expf(b1));
          float k0 = (1.f - lbp[d]) * sigm(-bf2f((u16)(fw[q] & 0xffff)));
          float k1 = (1.f - lbp[d + 1]) * sigm(-bf2f((u16)(fw[q] >> 16)));
          ko[q] = pk2(k0, k1);
          kdt[d * 72 + c] = f2bf(k0 * __expf(bl0 - b0));
          kdt[(d + 1) * 72 + c] = f2bf(k1 * __expf(bl1 - b1));
        }
        *(uint4*)(QD + i * 128 + d0) = make_uint4(qo[0], qo[1], qo[2], qo[3]);
        *(uint4*)(Fq + c * 136 + d0) = make_uint4(ko[0], ko[1], ko[2], ko[3]);
      }
      if (tid < 128) decv[tid] = __expf(bsm[63 * 129 + tid]);
    }
    __syncthreads();
    for (int idx = tid; idx < 1024; idx += 256) {
      int d = idx >> 3, c8 = idx & 7;
      *(uint4*)(KDT + d * 64 + c8 * 8) = *(const uint4*)(kdt + d * 72 + c8 * 8);
    }
    bf16x8 qf[3][4];
#pragma unroll
    for (int t = 0; t < 3; ++t) {
      int k = w + 4 * t;
      int si = k < 4 ? 3 : (k < 7 ? 2 : (k < 9 ? 1 : 0));
      int it_ = 16 * si + fr, ci_ = dir ? 63 - it_ : it_;
#pragma unroll
      for (int s = 0; s < 4; ++s) qf[t][s] = ld8(zq + (size_t)ci_ * NZ + 32 * s + 8 * fq);
    }
    __syncthreads();
    for (int idx = tid; idx < 1536; idx += 256) {
      int tl = idx >> 8, e = idx & 255, r16 = e >> 4, c16 = e & 15;
      int si = tl < 3 ? 0 : (tl < 5 ? 1 : 2);
      int sj = tl < 3 ? tl + 1 : (tl < 5 ? tl - 1 : 3);
      int jj = 16 * sj + c16;
      Ps[(16 * si + r16) * 72 + (dir ? 63 - jj : jj)] = 0;
    }
#pragma unroll
    for (int t = 0; t < 3; ++t) {
      const int k = w + 4 * t;
      if (k < 10) {
        const int si = k < 4 ? 3 : (k < 7 ? 2 : (k < 9 ? 1 : 0));
        const int sj = k - (k < 4 ? 0 : (k < 7 ? 4 : (k < 9 ? 7 : 9)));
        const int it = 16 * si + fr, jt = 16 * sj + fr, cj = dir ? 63 - jt : jt;
        const int brow = si ? (16 * si - 1) : 0;
        const float bmul = si ? 1.f : 0.f;
        f32x4 acc = {0.f, 0.f, 0.f, 0.f};
#pragma unroll
        for (int s = 0; s < 4; ++s) {
          int d0 = 32 * s + 8 * fq;
          bf16x8 fv = ld8(Fq + cj * 136 + d0);
          bf16x8 af, bf;
#pragma unroll
          for (int e = 0; e < 8; ++e) {
            int d = d0 + e;
            float Bs_ = bmul * bsm[brow * 129 + d];
            float qq = bf2f((u16)qf[t][s][e]) * __expf(bsm[it * 129 + d] - Bs_);
            float kk = bf2f((u16)fv[e]) * __expf(Bs_ - bsm[jt * 129 + d]);
            af[e] = (short)f2bf(qq);
            bf[e] = (short)f2bf(kk);
          }
          acc = mfma(af, bf, acc);
          __builtin_amdgcn_sched_barrier(0);
        }
#pragma unroll
        for (int r = 0; r < 4; ++r) {
          int i = 16 * si + 4 * fq + r, jj = 16 * sj + fr;
          float v = (jj <= i) ? acc[r] : 0.f;
          Ps[i * 72 + (dir ? 63 - jj : jj)] = f2bf(v);
        }
      }
    }
    __syncthreads();
#pragma unroll
    for (int nt2 = 0; nt2 < 2; ++nt2) {
      int e = h * 128 + (2 * w + nt2) * 16 + fr;
      bf16x8 v0 = ld8(zT + (size_t)e * GR + rb + 8 * fq), v1 = ld8(zT + (size_t)e * GR + rb + 32 + 8 * fq);
#pragma unroll
      for (int m = 0; m < 4; ++m) {
        f32x4 O = {0.f, 0.f, 0.f, 0.f};
        O = mfma(ld8(Ps + (16 * m + fr) * 72 + 8 * fq), v0, O);
        O = mfma(ld8(Ps + (16 * m + fr) * 72 + 32 + 8 * fq), v1, O);
#pragma unroll
        for (int r = 0; r < 4; ++r) {
          int ii = 16 * m + 4 * fq + r, rowr = rb + (dir ? 63 - ii : ii);
          OC[((size_t)dir * GR + rowr) * 512 + e] = f2bf(O[r]);
        }
      }
    }
    __syncthreads();
  }
}

#define LBAR()                                              \
  do {                                                      \
    asm volatile("s_waitcnt lgkmcnt(0)" ::: "memory");      \
    __builtin_amdgcn_s_barrier();                           \
    asm volatile("" ::: "memory");                          \
  } while (0)
#define CBAR() asm volatile("" ::: "memory")
#define BS_CHUNK(jj) (dir ? ((jj) < 4 ? 3 - (jj) : 39 - (jj)) : (jj))
DEV bf16x8 ldo8(const char* base, unsigned off) { return *reinterpret_cast<const bf16x8*>(base + off); }
DEV void b_seq2(const P& p, int bitem, char* smem) {
  const int tid = opq(threadIdx.x), lane = tid & 63, w = tid >> 6, fr = lane & 15, fq = lane >> 4;
  const int es = bitem & 3, dir = (bitem >> 2) & 1, h = (bitem >> 3) & 3, lb = bitem >> 5, e0 = es * 32;
  u16* Ss = (u16*)smem;
  u16* Rs = Ss + 32 * 136;
  u16* Vsc = Rs + 32 * 72;
  u16* Vor = Vsc + 32 * 72;
  const char* qnB = p.ws + O_BSH + (size_t)h * 256;
  const char* knB = qnB + BSH_ONE;
  const char* vbB = knB + BSH_ONE + (size_t)e0 * 2;
  const char* ktB = p.ws + O_BSH + 3 * BSH_ONE + (size_t)h * 16384;
  const char* recB = p.ws + O_BIT + ((size_t)h * 2 + dir) * BIT_SZ;
  char* obB = p.ws + O_OB + ((size_t)dir * GR * 512 + h * 128 + e0) * 2;
  const int mrow = 16 * w + fr, crow0 = 16 * w + 4 * fq;
  const unsigned offA = (unsigned)((dir ? 63 - mrow : mrow) * 1024 + 16 * fq);
  unsigned offR[4];
#pragma unroll
  for (int r = 0; r < 4; ++r) offR[r] = (unsigned)((dir ? 63 - (crow0 + r) : (crow0 + r)) * 1024 + fr * 2);
  const unsigned offT = (unsigned)(mrow * 128 + 16 * fq);
  const unsigned offK = (unsigned)((32 * w + fr) * 128 + 16 * fq);
  const unsigned offS = (unsigned)(16384 + crow0 * 4);
  f32x4 S[2][2];
#pragma unroll
  for (int a = 0; a < 2; ++a)
#pragma unroll
    for (int b = 0; b < 2; ++b) S[a][b] = (f32x4){0.f, 0.f, 0.f, 0.f};
  bf16x8 Akn[4], Aqn[4], At[2], Aqk[2], AkT[2][2];
  u16 vbv[2][4];
  float4 eg4, be4, ek4;
  float egl;
#define BS_LOAD1(cg_)                                                              \
  {                                                                                \
    const size_t ro_ = (size_t)(cg_) * 65536;                                      \
    _Pragma("unroll") for (int s = 0; s < 4; ++s) {                                \
      Akn[s] = ldo8(knB + ro_, offA + 64 * s);                                     \
      Aqn[s] = ldo8(qnB + ro_, offA + 64 * s);                                     \
    }                                                                              \
    _Pragma("unroll") for (int r = 0; r < 4; ++r) {                                \
      vbv[0][r] = *(const u16*)(vbB + ro_ + offR[r]);                              \
      vbv[1][r] = *(const u16*)(vbB + ro_ + (offR[r] + 32));                       \
    }                                                                              \
    const char* rc_ = recB + (size_t)(cg_) * (8 * BIT_SZ);                         \
    eg4 = *(const float4*)(rc_ + offS);                                            \
    be4 = *(const float4*)(rc_ + (offS + 256));                                    \
  }
#define BS_LOAD2(cg_)                                                              \
  {                                                                                \
    const char* rc_ = recB + (size_t)(cg_) * (8 * BIT_SZ);                         \
    At[0] = ldo8(rc_, offT); At[1] = ldo8(rc_, offT + 64);                         \
    ek4 = *(const float4*)(rc_ + (offS + 512));                                    \
  }
#define BS_LOAD3(cg_)                                                              \
  {                                                                                \
    const char* rc_ = recB + (size_t)(cg_) * (8 * BIT_SZ);                         \
    Aqk[0] = ldo8(rc_, offT + 8192); Aqk[1] = ldo8(rc_, offT + 8192 + 64);         \
    egl = *(const float*)(rc_ + 16384 + 768);                                      \
    const char* kt_ = ktB + (size_t)(cg_) * 65536;                                 \
    AkT[0][0] = ldo8(kt_, offK); AkT[0][1] = ldo8(kt_, offK + 64);                 \
    AkT[1][0] = ldo8(kt_, offK + 2048); AkT[1][1] = ldo8(kt_, offK + 2048 + 64);   \
  }
  {
    const int c0 = lb * 36 + BS_CHUNK(0);
    BS_LOAD1(c0) BS_LOAD2(c0) BS_LOAD3(c0)
  }
  for (int j = 0; j < 36; ++j) {
    const int cgk = lb * 36 + BS_CHUNK(j);
    const int jn = (j + 1 < 36) ? j + 1 : j;
    const int cgn = lb * 36 + BS_CHUNK(jn);
#pragma unroll
    for (int mm = 0; mm < 2; ++mm)
#pragma unroll
      for (int nt = 0; nt < 2; ++nt) {
        uint2 pk; pk.x = pk2(S[mm][nt][0], S[mm][nt][1]); pk.y = pk2(S[mm][nt][2], S[mm][nt][3]);
        *(uint2*)(Ss + (16 * nt + fr) * 136 + 32 * w + 16 * mm + 4 * fq) = pk;
      }
    LBAR();
    f32x4 QS[2];
    {
      bf16x8 Sf[2][4];
#pragma unroll
      for (int nt = 0; nt < 2; ++nt)
#pragma unroll
        for (int s = 0; s < 4; ++s) Sf[nt][s] = ld8(Ss + (16 * nt + fr) * 136 + 32 * s + 8 * fq);
#pragma unroll
      for (int nt = 0; nt < 2; ++nt) {
        f32x4 X = {0.f, 0.f, 0.f, 0.f}, Q = {0.f, 0.f, 0.f, 0.f};
#pragma unroll
        for (int s = 0; s < 4; ++s) { X = mfma(Akn[s], Sf[nt][s], X); Q = mfma(Aqn[s], Sf[nt][s], Q); }
        float r0 = be4.x * (bf2f(vbv[nt][0]) - eg4.x * X[0]);
        float r1 = be4.y * (bf2f(vbv[nt][1]) - eg4.y * X[1]);
        float r2 = be4.z * (bf2f(vbv[nt][2]) - eg4.z * X[2]);
        float r3 = be4.w * (bf2f(vbv[nt][3]) - eg4.w * X[3]);
        uint2 pk; pk.x = pk2(r0, r1); pk.y = pk2(r2, r3);
        *(uint2*)(Rs + (16 * nt + fr) * 72 + crow0) = pk;
        Q[0] *= eg4.x; Q[1] *= eg4.y; Q[2] *= eg4.z; Q[3] *= eg4.w;
        QS[nt] = Q;
      }
    }
    CBAR();
    BS_LOAD1(cgn)
    LBAR();
    {
#pragma unroll
      for (int nt = 0; nt < 2; ++nt) {
        bf16x8 Rf0 = ld8(Rs + (16 * nt + fr) * 72 + 8 * fq), Rf1 = ld8(Rs + (16 * nt + fr) * 72 + 32 + 8 * fq);
        f32x4 VN = {0.f, 0.f, 0.f, 0.f};
        VN = mfma(At[0], Rf0, VN);
        VN = mfma(At[1], Rf1, VN);
        uint2 pk; pk.x = pk2(VN[0], VN[1]); pk.y = pk2(VN[2], VN[3]);
        *(uint2*)(Vsc + (16 * nt + fr) * 72 + crow0) = pk;
        float s0 = VN[0] * ek4.x, s1 = VN[1] * ek4.y, s2 = VN[2] * ek4.z, s3 = VN[3] * ek4.w;
        if (dir) {
          pk.x = pk2(s3, s2); pk.y = pk2(s1, s0);
          *(uint2*)(Vor + (16 * nt + fr) * 72 + (60 - crow0)) = pk;
        } else {
          pk.x = pk2(s0, s1); pk.y = pk2(s2, s3);
          *(uint2*)(Vor + (16 * nt + fr) * 72 + crow0) = pk;
        }
      }
    }
    CBAR();
    BS_LOAD2(cgn)
    LBAR();
    {
      char* ob_ = obB + (size_t)cgk * 65536;
#pragma unroll
      for (int nt = 0; nt < 2; ++nt) {
        bf16x8 Vs0 = ld8(Vsc + (16 * nt + fr) * 72 + 8 * fq), Vs1 = ld8(Vsc + (16 * nt + fr) * 72 + 32 + 8 * fq);
        bf16x8 Vo0 = ld8(Vor + (16 * nt + fr) * 72 + 8 * fq), Vo1 = ld8(Vor + (16 * nt + fr) * 72 + 32 + 8 * fq);
        f32x4 O = QS[nt];
        O = mfma(Aqk[0], Vs0, O);
        O = mfma(Aqk[1], Vs1, O);
#pragma unroll
        for (int r = 0; r < 4; ++r) *(u16*)(ob_ + (offR[r] + 32 * nt)) = f2bf(O[r]);
#pragma unroll
        for (int mm = 0; mm < 2; ++mm) {
          f32x4 t = S[mm][nt];
#pragma unroll
          for (int r = 0; r < 4; ++r) t[r] *= egl;
          t = mfma(AkT[mm][0], Vo0, t);
          t = mfma(AkT[mm][1], Vo1, t);
          S[mm][nt] = t;
        }
      }
    }
    CBAR();
    BS_LOAD3(cgn)
  }
  LBAR();
}

DEV void c_seq2(const P& p, int bitem, char* smem) {
  const int tid = opq(threadIdx.x), lane = tid & 63, w = tid >> 6, fr = lane & 15, fq = lane >> 4;
  const int es = bitem & 3, dir = (bitem >> 2) & 1, h = (bitem >> 3) & 3, lb = bitem >> 5, e0 = es * 32;
  u16* Ssb = (u16*)smem;
  const char* recB = p.ws + O_CREC + ((size_t)h * 2 + dir) * CREC_SZ;
  const char* ztB = p.ws + O_ZT + (size_t)(h * 128 + e0) * GR * 2;
  char* ocB = p.ws + O_OC + ((size_t)dir * GR * 512 + h * 128 + e0) * 2;
  const int mrow = 16 * w + fr, crow0 = 16 * w + 4 * fq;
  const unsigned offQ = (unsigned)(mrow * 256 + 16 * fq);
  const unsigned offK = (unsigned)(16384 + (32 * w + fr) * 128 + 16 * fq);
  const unsigned offD = (unsigned)(32768 + (32 * w + 4 * fq) * 4);
  const unsigned offV = (unsigned)(fr * GR * 2 + 16 * fq);
  unsigned offR[4];
#pragma unroll
  for (int r = 0; r < 4; ++r) offR[r] = (unsigned)((dir ? 63 - (crow0 + r) : (crow0 + r)) * 1024 + fr * 2);
  f32x4 S[2][2];
#pragma unroll
  for (int a = 0; a < 2; ++a)
#pragma unroll
    for (int b = 0; b < 2; ++b) S[a][b] = (f32x4){0.f, 0.f, 0.f, 0.f};
  bf16x8 Aqd[4], Akd[2][2], Vf[2][2];
  u16 oi[2][4];
  float4 dec4[2];
#define CS_LOAD(cg_)                                                                    \
  {                                                                                     \
    const char* rc_ = recB + (size_t)(cg_) * (8 * CREC_SZ);                             \
    _Pragma("unroll") for (int s = 0; s < 4; ++s) Aqd[s] = ldo8(rc_, offQ + 64 * s);    \
    Akd[0][0] = ldo8(rc_, offK); Akd[0][1] = ldo8(rc_, offK + 64);                      \
    Akd[1][0] = ldo8(rc_, offK + 2048); Akd[1][1] = ldo8(rc_, offK + 2048 + 64);        \
    dec4[0] = *(const float4*)(rc_ + offD);                                             \
    dec4[1] = *(const float4*)(rc_ + (offD + 64));                                      \
    const char* zt_ = ztB + (size_t)(cg_) * 128;                                        \
    Vf[0][0] = ldo8(zt_, offV); Vf[0][1] = ldo8(zt_, offV + 64);                        \
    Vf[1][0] = ldo8(zt_, offV + 16 * GR * 2); Vf[1][1] = ldo8(zt_, offV + 16 * GR * 2 + 64); \
    const char* oc_ = ocB + (size_t)(cg_) * 65536;                                      \
    _Pragma("unroll") for (int r = 0; r < 4; ++r) {                                     \
      oi[0][r] = *(const u16*)(oc_ + offR[r]);                                          \
      oi[1][r] = *(const u16*)(oc_ + (offR[r] + 32));                                   \
    }                                                                                   \
  }
  {
    const int c0 = lb * 36 + BS_CHUNK(0);
    CS_LOAD(c0)
  }
  for (int j = 0; j < 36; ++j) {
    const int cgk = lb * 36 + BS_CHUNK(j);
    const int jn = (j + 1 < 36) ? j + 1 : j;
    const int cgn = lb * 36 + BS_CHUNK(jn);
    u16* Ss = Ssb + (j & 1) * (32 * 136);
#pragma unroll
    for (int mm = 0; mm < 2; ++mm)
#pragma unroll
      for (int nt = 0; nt < 2; ++nt) {
        uint2 pk; pk.x = pk2(S[mm][nt][0], S[mm][nt][1]); pk.y = pk2(S[mm][nt][2], S[mm][nt][3]);
        *(uint2*)(Ss + (16 * nt + fr) * 136 + 32 * w + 16 * mm + 4 * fq) = pk;
      }
    LBAR();
    char* oc_ = ocB + (size_t)cgk * 65536;
#pragma unroll
    for (int nt = 0; nt < 2; ++nt) {
      f32x4 O = {0.f, 0.f, 0.f, 0.f};
#pragma unroll
      for (int s = 0; s < 4; ++s) O = mfma(Aqd[s], ld8(Ss + (16 * nt + fr) * 136 + 32 * s + 8 * fq), O);
#pragma unroll
      for (int r = 0; r < 4; ++r) *(u16*)(oc_ + (offR[r] + 32 * nt)) = f2bf(bf2f(oi[nt][r]) + O[r]);
#pragma unroll
      for (int mm = 0; mm < 2; ++mm) {
        f32x4 t = S[mm][nt];
        t[0] *= dec4[mm].x; t[1] *= dec4[mm].y; t[2] *= dec4[mm].z; t[3] *= dec4[mm].w;
        t = mfma(Akd[mm][0], Vf[nt][0], t);
        t = mfma(Akd[mm][1], Vf[nt][1], t);
        S[mm][nt] = t;
      }
    }
    CBAR();
    CS_LOAD(cgn)
  }
  LBAR();
}

DEV void bc_merge(const P& p, int l, int it) {
  const int tid_ = opq(threadIdx.x); const int lane = tid_ & 63, w = tid_ >> 6;
  int lr = it * 4 + w;
  int mix = lane >> 5, cm = (lane * 16) & 511;
  const u16* O = (const u16*)(p.ws + (mix ? O_OC : O_OB));
  u16* z = (u16*)(p.ws + O_Z);
  float ov[16], ss = 0.f;
#pragma unroll
  for (int k2 = 0; k2 < 2; ++k2) {
    uint4 a = *(const uint4*)(O + (size_t)lr * 512 + cm + 8 * k2);
    uint4 b = *(const uint4*)(O + ((size_t)GR + lr) * 512 + cm + 8 * k2);
    unsigned aa[4] = {a.x, a.y, a.z, a.w}, bb[4] = {b.x, b.y, b.z, b.w};
#pragma unroll
    for (int q = 0; q < 4; ++q) {
      float v0 = bf2f((u16)(aa[q] & 0xffff)) + bf2f((u16)(bb[q] & 0xffff));
      float v1 = bf2f((u16)(aa[q] >> 16)) + bf2f((u16)(bb[q] >> 16));
      ov[k2 * 8 + q * 2] = v0; ov[k2 * 8 + q * 2 + 1] = v1;
      ss += v0 * v0 + v1 * v1;
    }
  }
  ss += __shfl_xor(ss, 1); ss += __shfl_xor(ss, 2); ss += __shfl_xor(ss, 4);
  float rinv = rsqrtf(ss * (1.f / 128.f) + EPS);
  const float* nw = (mix ? p.hg_norm : p.gdn_norm) + l * 128 + (cm & 127);
  u16* gp = z + (size_t)lr * NZ + (mix ? C_GC : C_GB) + cm;
#pragma unroll
  for (int k2 = 0; k2 < 2; ++k2) {
    uint4 gv = *(const uint4*)(gp + 8 * k2);
    unsigned gg[4] = {gv.x, gv.y, gv.z, gv.w}, oo[4];
#pragma unroll
    for (int q = 0; q < 4; ++q) {
      int e = k2 * 8 + q * 2;
      float y0 = ov[e] * rinv * nw[e] * silu(bf2f((u16)(gg[q] & 0xffff)));
      float y1 = ov[e + 1] * rinv * nw[e + 1] * silu(bf2f((u16)(gg[q] >> 16)));
      oo[q] = pk2(y0, y1);
    }
    *(uint4*)(gp + 8 * k2) = make_uint4(oo[0], oo[1], oo[2], oo[3]);
  }
}

#define XB_TMO      128
#define XB_XCNT(j)  (256  + 64 * (j))
#define XB_XSUB(j)  (1280 + 64 * (j))
#define XB_XGEN(j)  (2304 + 64 * (j))
#define XB_TOP      3328
#define XB_TOPGEN   3392
#define XCD_BAR_WORDS 3456
#define XB_SPIN_CAP (1u << 18)
#define LAS __attribute__((address_space(3)))

__device__ __forceinline__ unsigned xb_ld(unsigned* p)              { return __hip_atomic_load(p, __ATOMIC_RELAXED, __HIP_MEMORY_SCOPE_AGENT); }
__device__ __forceinline__ unsigned xb_add(unsigned* p, unsigned v) { return __hip_atomic_fetch_add(p, v, __ATOMIC_RELAXED, __HIP_MEMORY_SCOPE_AGENT); }
__device__ __forceinline__ unsigned xb_xcc_id() { return (unsigned)__builtin_amdgcn_s_getreg((3 << 11) | 20) & 0xFu; }
#define XB_SPIN(cond, bar) do { unsigned _sp = 0; while (cond) { __builtin_amdgcn_s_sleep(1); \
    if ((++_sp & 255u) == 0u) { if (xb_ld(&(bar)[XB_TMO])) break; if (_sp > XB_SPIN_CAP) { atomicAdd(&(bar)[XB_TMO], 1u); break; } } } } while (0)

struct XcdBarrier {
    unsigned* bar; unsigned x;
    volatile LAS unsigned* st;
};

__device__ __forceinline__ XcdBarrier xcd_barrier_post(unsigned* bar, volatile LAS unsigned* st) {
    XcdBarrier b; b.bar = bar; b.x = xb_xcc_id(); b.st = st;
    if (threadIdx.x == 0) (void)xb_add(&bar[XB_XCNT(b.x)], 1u);
    return b;
}
__device__ __forceinline__ void xcd_barrier_complete(unsigned* bar, unsigned x, unsigned& nloc, unsigned& nx) {
    const unsigned G = gridDim.x * gridDim.y * gridDim.z;
    unsigned sum, cnt, mine, sp = 0u;
    for (;;) {
        sum = 0u; cnt = 0u; mine = 0u;
#pragma unroll
        for (unsigned j = 0; j < 16; ++j) { const unsigned c = xb_ld(&bar[XB_XCNT(j)]); sum += c; cnt += (c > 0u) ? 1u : 0u; mine = (j == x) ? c : mine; }
        if (sum == G) break;
        __builtin_amdgcn_s_sleep(1);
        if ((++sp & 255u) == 0u) { if (xb_ld(&bar[XB_TMO])) break; if (sp > XB_SPIN_CAP) { atomicAdd(&bar[XB_TMO], 1u); break; } }
    }
    nloc = mine > 0u ? mine : 1u; nx = cnt > 0u ? cnt : 1u;
}

__device__ __forceinline__ void xcd_barrier(const XcdBarrier& b) {
    asm volatile("s_waitcnt vmcnt(0)" ::: "memory");
    __syncthreads();
    if (threadIdx.x == 0) {
        unsigned* bar = b.bar;
        __builtin_amdgcn_s_waitcnt(0);
        unsigned nloc = b.st[0], nx = b.st[1];
        if (nloc == 0u) { xcd_barrier_complete(bar, b.x, nloc, nx); b.st[0] = nloc; b.st[1] = nx; }
        const unsigned old = xb_add(&bar[XB_XSUB(b.x)], 1u);
        const unsigned gen = old / nloc;
        if (old + 1u == (gen + 1u) * nloc) {
            __builtin_amdgcn_fence(__ATOMIC_RELEASE, "agent");
            asm volatile("s_waitcnt vmcnt(0)" ::: "memory");
            const unsigned og = xb_add(&bar[XB_TOP], 1u);
            const unsigned tg = og / nx;
            if (og + 1u == (tg + 1u) * nx) xb_add(&bar[XB_TOPGEN], 1u);
            else XB_SPIN(xb_ld(&bar[XB_TOPGEN]) == tg, bar);
            __builtin_amdgcn_fence(__ATOMIC_ACQUIRE, "agent");
            xb_add(&bar[XB_XGEN(b.x)], 1u);
            asm volatile("s_waitcnt vmcnt(0)" ::: "memory");
        } else {
            XB_SPIN(xb_ld(&bar[XB_XGEN(b.x)]) == gen, bar);
            __builtin_amdgcn_fence(__ATOMIC_ACQUIRE, "agent");
            asm volatile("s_waitcnt vmcnt(0)" ::: "memory");
        }
    }
    __syncthreads();
}


#ifdef NO_G0
#define XG0(x)
#else
#define XG0(x) x
#endif
#ifdef NO_G1
#define XG1(x)
#else
#define XG1(x) x
#endif
#ifdef NO_BC
#define XBC(x)
#else
#define XBC(x) x
#endif
#ifdef NO_AC
#define XAC(x)
#else
#define XAC(x) x
#endif
#ifdef NO_P0
#define XP0(x)
#else
#define XP0(x) x
#endif
#ifdef NO_R
#define XR(x)
#else
#define XR(x) x
#endif
#ifdef NO_BL
#define XBL(x)
#else
#define XBL(x) x
#endif
#ifdef NO_CL
#define XCL(x)
#else
#define XCL(x) x
#endif
#ifdef NO_A0
#define XA0(x)
#else
#define XA0(x) x
#endif
#ifdef NO_A1
#define XA1(x)
#else
#define XA1(x) x
#endif
#ifdef NO_BS
#define XBS(x)
#else
#define XBS(x) x
#endif
#ifdef NO_CS
#define XCS(x)
#else
#define XCS(x) x
#endif
__global__ void __launch_bounds__(256, 2) fwd_mega(P p) {
  extern __shared__ __attribute__((aligned(16))) char smem[];
  cg::grid_group grid = cg::this_grid();
  const int G = gridDim.x;
  __shared__ uint4 xb_words;
  if (threadIdx.x == 0) xb_words = make_uint4(0u, 0u, 0u, 0u);
  __syncthreads();
  XcdBarrier xb = xcd_barrier_post((unsigned*)(p.ws + O_BAR), (volatile LAS unsigned*)&xb_words);
  XP0(phase0(p, smem));
  grid.sync();
  u16* z = (u16*)(p.ws + O_Z);
  u16* zT = (u16*)(p.ws + O_ZT);
  float* ab = (float*)(p.ws + O_AB);
  float* o = (float*)(p.ws + O_BSH);
  const u16* u = (const u16*)(p.ws + O_BIT);
  for (int g = 0; g < NG; ++g) {
    XR(phaseR(p, g, 0));
    xcd_barrier(xb);
    for (int l = 0; l < DEPTH; ++l) {
      for (int rep = 0; rep < REP_G; ++rep) {
        const u16* Bt = (const u16*)(p.ws + O_WTIN) + (size_t)l * NZ * 1024;
        if ((G & 7) == 0) {
          const int x = blockIdx.x & 7, bl = blockIdx.x >> 3, nbl = G >> 3;
          for (int q = bl; q < 9 * 45; q += nbl) { XG0(gemm_tile<0>(u, 1024, Bt, 1024, 9 * x + q % 9, q / 9, z, zT, ab, o, smem)); }
        } else {
          for (int t = blockIdx.x; t < 72 * 45; t += G) { XG0(gemm_tile<0>(u, 1024, Bt, 1024, t % 72, t / 72, z, zT, ab, o, smem)); }
        }
      }
      xcd_barrier(xb);
      for (int rep2 = 0; rep2 < REP_M; ++rep2) {
      for (int rep3 = 0; rep3 < REP_A; ++rep3) {
        if (rep3) xcd_barrier(xb);
        const int nb = NCH * 4, nc = NCH * 4, na = NCH * 8;
        for (int t = blockIdx.x; t < nb + nc + na; t += G) {
          if (t < nc) { XCL(c_local2(p, l, t, smem)); }
          else if (t < nb + nc) { XBL(b_local(p, l, t - nc, smem)); }
          else { XA0(a_item(p, l, t - nb - nc, 0, smem)); }
        }
      }
      xcd_barrier(xb);
      {
        for (int t = blockIdx.x; t < 256 + 16; t += G) {
          if (t < 128) { XBS(b_seq2(p, t, smem)); }
          else if (t < 256) { XCS(c_seq2(p, t - 128, smem)); }
          else { XAC(a_carry(p, t - 256)); }
        }
      }
      xcd_barrier(xb);
      }
      {
        const int na = NCH * 8, nm = GR / 4;
        for (int t = blockIdx.x; t < na + nm; t += G) {
          if (t < na) { XA1(a_fin(p, l, t, smem)); }
          else { XBC(bc_merge(p, l, t - na)); }
        }
      }
      xcd_barrier(xb);
      for (int rep = 0; rep < REP_G; ++rep) {
        const u16* Bt = (const u16*)(p.ws + O_WTOUT) + (size_t)l * 1024 * 1536;
        for (int t = blockIdx.x; t < 72 * 8; t += G) { XG1(gemm_tile<1>(z + C_GA, NZ, Bt, 1536, t % 72, t / 72, z, zT, ab, o, smem)); }
      }
      xcd_barrier(xb);
      XR(phaseR(p, g, l + 1));
      xcd_barrier(xb);
    }
  }
}

extern "C" void kernel_launch(void* const* d_in, const int* in_sizes, int n_in, void* d_out, int out_size, void* d_ws,
                              size_t ws_size, hipStream_t stream) {
  static int grid_blocks = 0;
  if (!grid_blocks) {
    int dev = 0, cus = 0, per_cu = 0;
    hipGetDevice(&dev);
    hipDeviceGetAttribute(&cus, hipDeviceAttributeMultiprocessorCount, dev);
    hipFuncSetAttribute((const void*)fwd_mega, hipFuncAttributeMaxDynamicSharedMemorySize, LDS_BYTES);
    hipOccupancyMaxActiveBlocksPerMultiprocessor(&per_cu, fwd_mega, 256, LDS_BYTES);
    if (per_cu > 2) per_cu = 2;
    if (per_cu < 1) per_cu = 1;
    grid_blocks = cus * per_cu;
  }
  if (ws_size < WS_TOTAL) {
    fprintf(stderr, "workspace too small: %zu < %zu\n", ws_size, (size_t)WS_TOTAL);
    return;
  }
  P p{};
  const float** f = (const float**)&p;
  for (int i = 0; i < 23; ++i) f[i] = (const float*)d_in[i];
  p.out = (float*)d_out;
  p.ws = (char*)d_ws;
  hipMemsetAsync((char*)d_ws + O_BAR, 0, XCD_BAR_WORDS * 4, stream);
  void* args[] = {&p};
  hipError_t e = hipLaunchCooperativeKernel((void*)fwd_mega, dim3(grid_blocks), dim3(256), args, LDS_BYTES, stream);
  if (e != hipSuccess) fprintf(stderr, "cooperative launch failed: %s (grid %d)\n", hipGetErrorString(e), grid_blocks);
}
```

```cpp
#include <hip/hip_runtime.h>
#include <hip/hip_cooperative_groups.h>
#include <cstdio>
namespace cg = cooperative_groups;

typedef __attribute__((ext_vector_type(8))) short bf16x8;
typedef __attribute__((ext_vector_type(4))) float f32x4;
typedef unsigned short u16;
#define DEV __device__ __forceinline__

constexpr int DM = 1024, TL = 2048, TCX = 256, TS = 2304, GB = 4, GR = GB * TS, NG = 2;
constexpr int NZ = 5760, DEPTH = 4;
constexpr int C_XA = 0, C_Q = 512, C_K = 1024, C_V = 1536, C_QC = 2048, C_F0 = 2560, C_IC = 3584,
              C_GA = 4096, C_GB = 4608, C_GC = 5120, C_AB = 5632;
constexpr int NCH = GR / 64;
constexpr float EPS = 1e-6f;
constexpr int WPB = 2;

constexpr size_t al256(size_t x) { return (x + 255) & ~(size_t)255; }
constexpr size_t O_WTIN = 0;
constexpr size_t O_WTOUT = O_WTIN + al256((size_t)DEPTH * NZ * 1024 * 2);
constexpr size_t O_WGT = O_WTOUT + al256((size_t)DEPTH * 1024 * 1536 * 2);
constexpr size_t O_MOD = O_WGT + al256((size_t)DEPTH * 2 * 2 * 8 * 4096 * 2);
constexpr size_t O_LBS = O_MOD + al256((size_t)DEPTH * 9 * 3072 * 4);
constexpr size_t O_HC = O_LBS + al256((size_t)DEPTH * 1024 * 4);
constexpr size_t O_Z = O_HC + al256((size_t)GB * TCX * 1024 * 4);
constexpr size_t O_ZT = O_Z + al256((size_t)GR * NZ * 2);
constexpr size_t O_AB = O_ZT + al256((size_t)512 * GR * 2);
constexpr size_t O_BSH = O_AB + al256((size_t)GR * 16 * 4);
constexpr size_t BSH_ONE = (size_t)GR * 512 * 2;
constexpr size_t O_BIT = O_BSH + al256(4 * BSH_ONE);
constexpr size_t BIT_SZ = 17408;
constexpr size_t O_CREC = O_BIT + al256((size_t)NCH * 4 * 2 * BIT_SZ);
constexpr size_t CREC_SZ = 33280;
constexpr size_t O_OB = O_CREC + al256((size_t)NCH * 4 * 2 * CREC_SZ);
constexpr size_t O_OC = O_OB + al256((size_t)2 * GR * 512 * 2);
constexpr size_t O_AP = O_OC + al256((size_t)2 * GR * 512 * 2);
constexpr size_t O_AH = O_AP + al256((size_t)NCH * 2 * 512 * 4);
constexpr size_t O_ACAR = O_AH + al256((size_t)NCH * 2 * 512 * 4);
constexpr size_t O_ALA = O_ACAR + al256((size_t)NCH * 2 * 512 * 4);
constexpr size_t O_AU = O_ALA + al256((size_t)2 * GR * 512 * 2);
constexpr size_t O_BAR = O_AU + al256((size_t)2 * GR * 512 * 2);
constexpr size_t WS_TOTAL = O_BAR + al256(3456 * 4);

constexpr int LDS_BYTES = 73728;
#ifndef REP_A
#define REP_A 1
#endif
#ifndef REP_G
#define REP_G 1
#endif
#ifndef REP_M
#define REP_M 1
#endif

struct P {
  const float *x, *c, *ctx, *c_ctx, *w_ada, *b_ada, *norm_pre, *norm_post, *w_in, *conv_a_w, *conv_a_b, *rg_w_r,
      *rg_b_r, *rg_w_i, *rg_b_i, *rg_lam, *conv_b_w, *gdn_a_log, *gdn_dt_bias, *gdn_norm, *hg_lb, *hg_norm, *w_out;
  float* out;
  char* ws;
};

DEV int opq(int x) { asm volatile("" : "+v"(x)); return x; }
DEV int opqs(int x) { asm volatile("" : "+s"(x)); return x; }
typedef __attribute__((ext_vector_type(2))) __bf16 bf16x2_t;
typedef __attribute__((ext_vector_type(2))) float f32x2_t;
DEV u16 f2bf(float f) { __bf16 r = (__bf16)f; return __builtin_bit_cast(u16, r); }
DEV float bf2f(u16 h) { return __uint_as_float(((unsigned)h) << 16); }
DEV unsigned pk2(float a, float b) { f32x2_t v = {a, b}; bf16x2_t r = __builtin_convertvector(v, bf16x2_t); return __builtin_bit_cast(unsigned, r); }
DEV float sigm(float x) { return __builtin_amdgcn_rcpf(1.f + __expf(-x)); }
DEV float silu(float x) { return x * __builtin_amdgcn_rcpf(1.f + __expf(-x)); }
DEV float softplus(float x) { return x > 20.f ? x : log1pf(__expf(x)); }
DEV f32x4 mfma(bf16x8 a, bf16x8 b, f32x4 c) { return __builtin_amdgcn_mfma_f32_16x16x32_bf16(a, b, c, 0, 0, 0); }
DEV bf16x8 ld8(const u16* p) { return *reinterpret_cast<const bf16x8*>(p); }
DEV int lat_map(int l, int t) { return (l & 1) ? ((t & 63) * 32 + (t >> 6)) : t; }
DEV int orig_col(int n) {
  if (n < 512) return n;
  if (n < 2048) return n + 512;
  if (n < 4096) return n + 1040;
  if (n < 4608) return n - 4096 + 512;
  if (n < 5120) return n - 4608 + 2576;
  if (n < 5632) return n + 16;
  if (n < 5648) return n - 5632 + 2560;
  return -1;
}
DEV float zval(const u16* z, int rb, int cp, int n, int col) {
  if (cp < 0 && (n == 0 || n == 4)) return 0.f;
  if (cp > 63 && (n == 3 || n == 35)) return 0.f;
  return bf2f(z[(size_t)(rb + cp) * NZ + col]);
}

DEV void ph0_ada(const P& p, int item, char* smem) {
  float* sc = (float*)smem;
  float* red = (float*)(smem + 36864);
  const int tid = threadIdx.x, lane = tid & 63, wv = tid >> 6;
  for (int i = tid; i < 9 * 1024; i += 256) {
    int v = i >> 10, d = i & 1023;
    float cv = (v < 8) ? p.c[v * 1024 + d] : p.c_ctx[d];
    sc[i] = silu(cv);
  }
  __syncthreads();
  const int col = item * 64 + lane;
  const int l = col / 3072, e = col % 3072;
  const float* w = p.w_ada + (size_t)l * 1024 * 3072 + e + (size_t)(256 * wv) * 3072;
  const float* scw = sc + 256 * wv;
  float acc[9];
#pragma unroll
  for (int i = 0; i < 9; ++i) acc[i] = 0.f;
  for (int d = 0; d < 256; d += 16) {
    float wr[16];
#pragma unroll
    for (int k = 0; k < 16; ++k) wr[k] = w[(size_t)(d + k) * 3072];
#pragma unroll
    for (int k = 0; k < 16; ++k)
#pragma unroll
      for (int i = 0; i < 9; ++i) acc[i] += scw[i * 1024 + d + k] * wr[k];
  }
#pragma unroll
  for (int i = 0; i < 9; ++i) red[(wv * 9 + i) * 64 + lane] = acc[i];
  __syncthreads();
  float* mod = (float*)(p.ws + O_MOD);
  for (int idx = tid; idx < 9 * 64; idx += 256) {
    int i = idx >> 6, ln = idx & 63;
    float sum = red[(0 * 9 + i) * 64 + ln] + red[(1 * 9 + i) * 64 + ln] + red[(2 * 9 + i) * 64 + ln] + red[(3 * 9 + i) * 64 + ln];
    int cc = item * 64 + ln, l2 = cc / 3072, e2 = cc % 3072;
    mod[((size_t)l2 * 9 + i) * 3072 + e2] = sum + p.b_ada[l2 * 3072 + e2];
  }
  __syncthreads();
}
DEV void tconv_tile(const float* src, int lds_, u16* dst, int ldd, int k0, int n0, bool mapcol, char* smem) {
  float* t = (float*)smem;
  const int tid = threadIdx.x, nn = tid & 63, kq = tid >> 6;
  const int n = n0 + nn;
  const int sn0 = mapcol ? orig_col(n) : n;
  const float msk = (sn0 >= 0) ? 1.f : 0.f;
  const int sn = sn0 >= 0 ? sn0 : 0;
  float v[16];
#pragma unroll
  for (int k = 0; k < 16; ++k) v[k] = src[(size_t)(k0 + kq + 4 * k) * lds_ + sn];
#pragma unroll
  for (int k = 0; k < 16; ++k) t[(kq + 4 * k) * 65 + nn] = v[k] * msk;
  __syncthreads();
  {
    const int kk = tid & 63, nq = tid >> 6;
#pragma unroll
    for (int k = 0; k < 16; ++k) {
      int n2 = nq + 4 * k;
      dst[(size_t)(n0 + n2) * ldd + k0 + kk] = f2bf(t[kk * 65 + n2]);
    }
  }
  __syncthreads();
}
DEV void phase0(const P& p, char* smem) {
  const int n_ada = 192, n_in = DEPTH * 16 * 90, n_out = DEPTH * 24 * 16, n_g = 128, n_lb = 4;
  const int total = n_ada + n_in + n_out + n_g + n_lb;
  for (int it = blockIdx.x; it < total; it += gridDim.x) {
    int i = it;
    if (i < n_ada) { ph0_ada(p, i, smem); continue; }
    i -= n_ada;
    if (i < n_in) {
      int l = i / 1440, r = i % 1440, kt = r / 90, nt = r % 90;
      tconv_tile(p.w_in + (size_t)l * 1024 * 5648, 5648, (u16*)(p.ws + O_WTIN) + (size_t)l * NZ * 1024, 1024, kt * 64,
                 nt * 64, true, smem);
      continue;
    }
    i -= n_in;
    if (i < n_out) {
      int l = i / 384, r = i % 384, kt = r / 16, nt = r % 16;
      tconv_tile(p.w_out + (size_t)l * 1536 * 1024, 1024, (u16*)(p.ws + O_WTOUT) + (size_t)l * 1024 * 1536, 1536,
                 kt * 64, nt * 64, false, smem);
      continue;
    }
    i -= n_out;
    if (i < n_g) {
      int h = i & 7, gate = (i >> 3) & 1, dir = (i >> 4) & 1, l = i >> 5;
      const float* src = (gate ? p.rg_w_i : p.rg_w_r) + ((size_t)(l * 2 + dir) * 8 + h) * 4096;
      tconv_tile(src, 64, (u16*)(p.ws + O_WGT) + (size_t)i * 4096, 64, 0, 0, false, smem);
      continue;
    }
    i -= n_g;
    {
      int j = i * 256 + threadIdx.x;
      float v[4], mx = -1e30f;
      for (int l = 0; l < 4; ++l) { v[l] = p.hg_lb[l * 1024 + j]; mx = fmaxf(mx, v[l]); }
      float s = 0.f;
      for (int l = 0; l < 4; ++l) { v[l] = __expf(v[l] - mx); s += v[l]; }
      float* lbs = (float*)(p.ws + O_LBS);
      float cum = 0.f;
      for (int l = 0; l < 4; ++l) {
        if (l > 0) cum += v[l] / s;
        lbs[l * 1024 + j] = cum;
      }
    }
  }
}

DEV void phaseR(const P& p, int g, int l) {
  const int tid_ = opq(threadIdx.x); const int lane = tid_ & 63, w = tid_ >> 6;
  const float* mod = (const float*)(p.ws + O_MOD);
  float* hc = (float*)(p.ws + O_HC);
  const float* o = (const float*)(p.ws + O_BSH);
  u16* u = (u16*)(p.ws + O_BIT);
  for (int it = blockIdx.x; it < GR / 4; it += gridDim.x) {
    int lr = it * 4 + w;
    int lb = lr / TS, s = lr % TS;
    bool isctx = s < TCX;
    if (l == DEPTH && isctx) continue;
    int b = g * GB + lb, t = s - TCX;
    int mi = isctx ? 8 : b;
    float* hp = isctx ? hc + ((size_t)lb * TCX + s) * 1024 : p.out + ((size_t)b * TL + t) * 1024;
    float hv[16];
    if (l == 0) {
      const float* src = isctx ? p.ctx + ((size_t)b * TCX + s) * 1024 : p.x + ((size_t)b * TL + t) * 1024;
#pragma unroll
      for (int k = 0; k < 4; ++k) {
        float4 v = *(const float4*)(src + k * 256 + lane * 4);
        hv[k * 4] = v.x; hv[k * 4 + 1] = v.y; hv[k * 4 + 2] = v.z; hv[k * 4 + 3] = v.w;
      }
    } else {
      int orow = lb * TS + (isctx ? s : TCX + lat_map(l - 1, t));
      const float* op = o + (size_t)orow * 1024;
      float ov[16], ss = 0.f;
#pragma unroll
      for (int k = 0; k < 4; ++k) {
        float4 v = *(const float4*)(op + k * 256 + lane * 4);
        ov[k * 4] = v.x; ov[k * 4 + 1] = v.y; ov[k * 4 + 2] = v.z; ov[k * 4 + 3] = v.w;
        ss += v.x * v.x + v.y * v.y + v.z * v.z + v.w * v.w;
      }
#pragma unroll
      for (int off = 32; off; off >>= 1) ss += __shfl_xor(ss, off);
      float rinv = rsqrtf(ss * (1.f / 1024.f) + EPS);
      const float* gate = mod + ((size_t)(l - 1) * 9 + mi) * 3072 + 2048;
      const float* wp = p.norm_post + (l - 1) * 1024;
#pragma unroll
      for (int k = 0; k < 4; ++k) {
        float4 hh = *(const float4*)(hp + k * 256 + lane * 4);
        float4 gg = *(const float4*)(gate + k * 256 + lane * 4);
        float4 ww = *(const float4*)(wp + k * 256 + lane * 4);
        hv[k * 4] = hh.x + gg.x * (ov[k * 4] * rinv * ww.x);
        hv[k * 4 + 1] = hh.y + gg.y * (ov[k * 4 + 1] * rinv * ww.y);
        hv[k * 4 + 2] = hh.z + gg.z * (ov[k * 4 + 2] * rinv * ww.z);
        hv[k * 4 + 3] = hh.w + gg.w * (ov[k * 4 + 3] * rinv * ww.w);
      }
    }
#pragma unroll
    for (int k = 0; k < 4; ++k)
      *(float4*)(hp + k * 256 + lane * 4) = make_float4(hv[k * 4], hv[k * 4 + 1], hv[k * 4 + 2], hv[k * 4 + 3]);
    if (l < DEPTH) {
      float ss = 0.f;
#pragma unroll
      for (int k = 0; k < 16; ++k) ss += hv[k] * hv[k];
#pragma unroll
      for (int off = 32; off; off >>= 1) ss += __shfl_xor(ss, off);
      float rinv = rsqrtf(ss * (1.f / 1024.f) + EPS);
      const float* sh = mod + ((size_t)l * 9 + mi) * 3072;
      const float* wp = p.norm_pre + l * 1024;
      int urow = lb * TS + (isctx ? s : TCX + lat_map(l, t));
      u16* up = u + (size_t)urow * 1024;
#pragma unroll
      for (int k = 0; k < 4; ++k) {
        float4 ww = *(const float4*)(wp + k * 256 + lane * 4);
        float4 s0 = *(const float4*)(sh + k * 256 + lane * 4);
        float4 s1 = *(const float4*)(sh + 1024 + k * 256 + lane * 4);
        float a0 = hv[k * 4] * rinv * ww.x * (1.f + s1.x) + s0.x;
        float a1 = hv[k * 4 + 1] * rinv * ww.y * (1.f + s1.y) + s0.y;
        float a2 = hv[k * 4 + 2] * rinv * ww.z * (1.f + s1.z) + s0.z;
        float a3 = hv[k * 4 + 3] * rinv * ww.w * (1.f + s1.w) + s0.w;
        uint2 pk; pk.x = pk2(a0, a1); pk.y = pk2(a2, a3);
        *(uint2*)(up + k * 256 + lane * 4) = pk;
      }
    }
  }
}

template <int MODE>
DEV void gemm_tile(const u16* __restrict__ A, int lda, const u16* __restrict__ Bt, int K, int rt, int ct, u16* z,
                   u16* zT, float* ab, float* o, char* smem) {
  u16* As = (u16*)smem;
  u16* Bs = As + 128 * 72;
  const int tid = opq(threadIdx.x), lane = tid & 63, w = tid >> 6, wr = w >> 1, wc = w & 1, fr = lane & 15, fq = lane >> 4;
  const int lrow = tid >> 3, lseg = tid & 7;
  const u16* Ag = A + (size_t)(rt * 128 + lrow) * lda + lseg * 8;
  const u16* Bg = Bt + (size_t)(ct * 128 + lrow) * K + lseg * 8;
  uint4 pa0, pa1, pa2, pa3, pb0, pb1, pb2, pb3;
  uint4 qa0, qa1, qa2, qa3, qb0, qb1, qb2, qb3;
  f32x4 acc[4][4];
#pragma unroll
  for (int i = 0; i < 4; ++i)
#pragma unroll
    for (int j = 0; j < 4; ++j) acc[i][j] = (f32x4){0.f, 0.f, 0.f, 0.f};
  const int nk = K / 64;
#define GLD(S, kk)                                                            \
  {                                                                           \
    const int kc_ = ((kk) < nk ? (kk) : nk - 1) * 64;                         \
    S##a0 = *(const uint4*)(Ag + kc_);                                        \
    S##a1 = *(const uint4*)(Ag + kc_ + (size_t)32 * lda);                     \
    S##a2 = *(const uint4*)(Ag + kc_ + (size_t)64 * lda);                     \
    S##a3 = *(const uint4*)(Ag + kc_ + (size_t)96 * lda);                     \
    S##b0 = *(const uint4*)(Bg + kc_);                                        \
    S##b1 = *(const uint4*)(Bg + kc_ + (size_t)32 * K);                       \
    S##b2 = *(const uint4*)(Bg + kc_ + (size_t)64 * K);                       \
    S##b3 = *(const uint4*)(Bg + kc_ + (size_t)96 * K);                       \
  }
#define GST(S, bufo)                                                          \
  *(uint4*)(As + (bufo) + (lrow)*72 + lseg * 8) = S##a0;                      \
  *(uint4*)(As + (bufo) + (lrow + 32) * 72 + lseg * 8) = S##a1;               \
  *(uint4*)(As + (bufo) + (lrow + 64) * 72 + lseg * 8) = S##a2;               \
  *(uint4*)(As + (bufo) + (lrow + 96) * 72 + lseg * 8) = S##a3;               \
  *(uint4*)(Bs + (bufo) + (lrow)*72 + lseg * 8) = S##b0;                      \
  *(uint4*)(Bs + (bufo) + (lrow + 32) * 72 + lseg * 8) = S##b1;               \
  *(uint4*)(Bs + (bufo) + (lrow + 64) * 72 + lseg * 8) = S##b2;               \
  *(uint4*)(Bs + (bufo) + (lrow + 96) * 72 + lseg * 8) = S##b3;
#define GCOMP(cb)                                                                                           \
  _Pragma("unroll") for (int ks = 0; ks < 2; ++ks) {                                                        \
    bf16x8 af[4], bfr[4];                                                                                   \
    _Pragma("unroll") for (int mi = 0; mi < 4; ++mi)                                                        \
        af[mi] = ld8(As + (cb) + (wr * 64 + mi * 16 + fr) * 72 + ks * 32 + fq * 8);                         \
    _Pragma("unroll") for (int ni = 0; ni < 4; ++ni)                                                        \
        bfr[ni] = ld8(Bs + (cb) + (wc * 64 + ni * 16 + fr) * 72 + ks * 32 + fq * 8);                        \
    _Pragma("unroll") for (int mi = 0; mi < 4; ++mi)                                                        \
        _Pragma("unroll") for (int ni = 0; ni < 4; ++ni) acc[mi][ni] = mfma(af[mi], bfr[ni], acc[mi][ni]);  \
  }
  constexpr int BUF1 = 2 * 128 * 72;
  GLD(p, 0)
  GLD(q, 1)
  GST(p, 0)
  __syncthreads();
  GLD(p, 2)
  for (int kt = 0; kt < nk; kt += 2) {
    GCOMP(0)
    GST(q, BUF1)
    GLD(q, kt + 3)
    __syncthreads();
    GCOMP(BUF1)
    GST(p, 0)
    GLD(p, kt + 4)
    __syncthreads();
  }
#pragma unroll
  for (int mi = 0; mi < 4; ++mi)
#pragma unroll
    for (int ni = 0; ni < 4; ++ni) {
      int row0 = rt * 128 + wr * 64 + mi * 16 + fq * 4;
      int col = ct * 128 + wc * 64 + ni * 16 + fr;
      f32x4 v = acc[mi][ni];
      if (MODE == 1) {
#pragma unroll
        for (int r = 0; r < 4; ++r) o[(size_t)(row0 + r) * 1024 + col] = v[r];
      } else {
        if (ct >= 28 && ct < 32) {
          uint2 pk; pk.x = pk2(v[0], v[1]); pk.y = pk2(v[2], v[3]);
          *(uint2*)(zT + (size_t)(col - C_IC) * GR + row0) = pk;
        } else if (ct == 44) {
          if (col - C_AB < 16) {
#pragma unroll
            for (int r = 0; r < 4; ++r) ab[(size_t)(row0 + r) * 16 + (col - C_AB)] = v[r];
          }
        } else {
#pragma unroll
          for (int r = 0; r < 4; ++r) z[(size_t)(row0 + r) * NZ + col] = f2bf(v[r]);
        }
      }
    }
}

DEV void a_item(const P& p, int l, int item, int mode, char* smem) {
  float* xc = (float*)smem;
  u16* xcb = (u16*)(smem + 16384);
  float* av = (float*)(smem + 16384 + 9216);
  float* uv = av + 4096;
  float* segP = uv + 4096;
  float* segH = segP + 256;
  const int tid = opq(threadIdx.x), lane = tid & 63, w = tid >> 6, fr = lane & 15, fq = lane >> 4;
  const int cgk = item >> 3, hA = item & 7, n = cgk % 36, rb = cgk * 64;
  u16* z = (u16*)(p.ws + O_Z);
  {
    u16* xin = (u16*)av;
    uint4 st[3];
#pragma unroll
    for (int k = 0; k < 3; ++k) {
      int idx = tid + 256 * k, row = idx >> 3, sg = idx & 7, cp = row - 2;
      bool ok = (idx < 536) && !((cp < 0 && (n == 0 || n == 4)) || (cp > 63 && (n == 3 || n == 35)));
      st[k] = make_uint4(0u, 0u, 0u, 0u);
      if (ok) st[k] = *(const uint4*)(z + (size_t)(rb + cp) * NZ + C_XA + hA * 64 + sg * 8);
    }
    const int j = tid & 63, ch = hA * 64 + j;
    float cw0 = p.conv_a_w[(l * 4 + 0) * 512 + ch], cw1 = p.conv_a_w[(l * 4 + 1) * 512 + ch];
    float cw2 = p.conv_a_w[(l * 4 + 2) * 512 + ch], cw3 = p.conv_a_w[(l * 4 + 3) * 512 + ch];
    float cb = p.conv_a_b[l * 512 + ch];
#pragma unroll
    for (int k = 0; k < 3; ++k) {
      int idx = tid + 256 * k, row = idx >> 3, sg = idx & 7;
      if (idx < 536) *(uint4*)(xin + row * 72 + sg * 8) = st[k];
    }
    __syncthreads();
#pragma unroll
    for (int k = 0; k < 16; ++k) {
      int c = (tid >> 6) + 4 * k;
      float val = cb + cw0 * bf2f(xin[c * 72 + j]) + cw1 * bf2f(xin[(c + 1) * 72 + j]) + cw2 * bf2f(xin[(c + 2) * 72 + j]) +
                  cw3 * bf2f(xin[(c + 3) * 72 + j]);
      xc[c * 64 + j] = val;
      xcb[c * 72 + j] = f2bf(val);
    }
  }
  __syncthreads();
  float yacc[16];
#pragma unroll
  for (int k = 0; k < 16; ++k) yacc[k] = 0.f;
  const int seg = tid >> 6, sj = tid & 63, sch = hA * 64 + sj;
  for (int dir = 0; dir < 2; ++dir) {
    {
      const u16* wg = (const u16*)(p.ws + O_WGT);
      const u16* wr_ = wg + (size_t)((((l * 2 + dir) * 2 + 0) * 8 + hA)) * 4096;
      const u16* wi_ = wg + (size_t)((((l * 2 + dir) * 2 + 1) * 8 + hA)) * 4096;
      bf16x8 a0 = ld8(xcb + (16 * w + fr) * 72 + fq * 8), a1 = ld8(xcb + (16 * w + fr) * 72 + 32 + fq * 8);
#pragma unroll
      for (int nt = 0; nt < 4; ++nt) {
        f32x4 ar = {0.f, 0.f, 0.f, 0.f}, ai = {0.f, 0.f, 0.f, 0.f};
        const u16* br = wr_ + (nt * 16 + fr) * 64 + fq * 8;
        const u16* bi = wi_ + (nt * 16 + fr) * 64 + fq * 8;
        ar = mfma(a0, ld8(br), ar); ar = mfma(a1, ld8(br + 32), ar);
        ai = mfma(a0, ld8(bi), ai); ai = mfma(a1, ld8(bi + 32), ai);
        int j = nt * 16 + fr, ch = hA * 64 + j;
        float brv = p.rg_b_r[(l * 2 + dir) * 512 + ch], biv = p.rg_b_i[(l * 2 + dir) * 512 + ch];
        float sp = softplus(-p.rg_lam[(l * 2 + dir) * 512 + ch]);
#pragma unroll
        for (int r = 0; r < 4; ++r) {
          int c = 16 * w + 4 * fq + r;
          float rg = sigm(ar[r] + brv), ig = sigm(ai[r] + biv);
          float la = -8.f * rg * sp;
          float a = __expf(la);
          float t2 = 2.f * la;
          float om = (t2 > -0.02f) ? -t2 * (1.f + 0.5f * t2 * (1.f + t2 * (1.f / 3.f) * (1.f + 0.25f * t2))) : 1.f - a * a;
          float uu = sqrtf(fmaxf(om, 0.f)) * (ig * xc[c * 64 + j]);
          av[c * 64 + j] = bf2f(f2bf(la));
          uv[c * 64 + j] = bf2f(f2bf(uu));
        }
      }
    }
    __syncthreads();
    {
      float ls = 0.f, H = 0.f;
      u16* ALA = (u16*)(p.ws + O_ALA);
      u16* AU = (u16*)(p.ws + O_AU);
#pragma unroll
      for (int k = 0; k < 16; ++k) {
        int c = dir ? (16 * seg + 15 - k) : (16 * seg + k);
        float la_ = av[c * 64 + sj], u_ = uv[c * 64 + sj];
        H = __expf(la_) * H + u_;
        ls += la_;
        size_t gi = ((size_t)dir * GR + rb + c) * 512 + sch;
        ALA[gi] = f2bf(la_);
        AU[gi] = f2bf(u_);
      }
      segP[seg * 64 + sj] = __expf(ls);
      segH[seg * 64 + sj] = H;
    }
    __syncthreads();
    if (mode == 0) {
      if (seg == 0) {
        float Pc = 1.f, Hc = 0.f;
        for (int q = 0; q < 4; ++q) {
          int sg = dir ? 3 - q : q;
          Hc = segP[sg * 64 + sj] * Hc + segH[sg * 64 + sj];
          Pc *= segP[sg * 64 + sj];
        }
        size_t idx = ((size_t)cgk * 2 + dir) * 512 + sch;
        ((float*)(p.ws + O_AP))[idx] = Pc;
        ((float*)(p.ws + O_AH))[idx] = Hc;
      }
    } else {
      float st = ((const float*)(p.ws + O_ACAR))[((size_t)cgk * 2 + dir) * 512 + sch];
      int nbefore = dir ? 3 - seg : seg;
      for (int q = 0; q < nbefore; ++q) {
        int sg = dir ? 3 - q : q;
        st = segP[sg * 64 + sj] * st + segH[sg * 64 + sj];
      }
      if (dir == 0) {
#pragma unroll
        for (int k = 0; k < 16; ++k) {
          int c = 16 * seg + k;
          st = av[c * 64 + sj] * st + uv[c * 64 + sj];
          yacc[k] += st;
        }
      } else {
#pragma unroll
        for (int k = 15; k >= 0; --k) {
          int c = 16 * seg + k;
          st = av[c * 64 + sj] * st + uv[c * 64 + sj];
          yacc[k] += st;
        }
      }
    }
    __syncthreads();
  }
  if (mode == 1) {
#pragma unroll
    for (int k = 0; k < 16; ++k) {
      size_t zi = (size_t)(rb + 16 * seg + k) * NZ + C_GA + sch;
      float gate = bf2f(z[zi]);
      z[zi] = f2bf(yacc[k] * silu(gate));
    }
  }
}

DEV void a_fin(const P& p, int l, int item, char* smem) {
  float* segP = (float*)smem;
  float* segH = segP + 512;
  const int tid = opq(threadIdx.x), seg = tid >> 6, sj = tid & 63;
  const int cgk = item >> 3, hA = item & 7, rb = cgk * 64, sch = hA * 64 + sj;
  u16* z = (u16*)(p.ws + O_Z);
  const u16* ALA = (const u16*)(p.ws + O_ALA);
  const u16* AU = (const u16*)(p.ws + O_AU);
  u16 lab[2][16], ub[2][16], gt[16];
#pragma unroll
  for (int dir = 0; dir < 2; ++dir)
#pragma unroll
    for (int k = 0; k < 16; ++k) {
      size_t gi = ((size_t)dir * GR + rb + 16 * seg + k) * 512 + sch;
      lab[dir][k] = ALA[gi];
      ub[dir][k] = AU[gi];
    }
#pragma unroll
  for (int k = 0; k < 16; ++k) gt[k] = z[(size_t)(rb + 16 * seg + k) * NZ + C_GA + sch];
  float car0 = ((const float*)(p.ws + O_ACAR))[((size_t)cgk * 2 + 0) * 512 + sch];
  float car1 = ((const float*)(p.ws + O_ACAR))[((size_t)cgk * 2 + 1) * 512 + sch];
  float af[2][16];
#pragma unroll
  for (int dir = 0; dir < 2; ++dir) {
    float ls = 0.f, H = 0.f;
#pragma unroll
    for (int kk = 0; kk < 16; ++kk) {
      const int k = dir ? 15 - kk : kk;
      float la_ = bf2f(lab[dir][k]);
      float a = __expf(la_);
      af[dir][k] = a;
      H = a * H + bf2f(ub[dir][k]);
      ls += la_;
    }
    segP[(dir * 4 + seg) * 64 + sj] = __expf(ls);
    segH[(dir * 4 + seg) * 64 + sj] = H;
  }
  __syncthreads();
  float yacc[16];
#pragma unroll
  for (int k = 0; k < 16; ++k) yacc[k] = 0.f;
#pragma unroll
  for (int dir = 0; dir < 2; ++dir) {
    float st = dir ? car1 : car0;
    const int nbefore = dir ? 3 - seg : seg;
    for (int q = 0; q < nbefore; ++q) {
      int sg = dir ? 3 - q : q;
      st = segP[(dir * 4 + sg) * 64 + sj] * st + segH[(dir * 4 + sg) * 64 + sj];
    }
#pragma unroll
    for (int kk = 0; kk < 16; ++kk) {
      const int k = dir ? 15 - kk : kk;
      st = af[dir][k] * st + bf2f(ub[dir][k]);
      yacc[k] += st;
    }
  }
#pragma unroll
  for (int k = 0; k < 16; ++k)
    z[(size_t)(rb + 16 * seg + k) * NZ + C_GA + sch] = f2bf(yacc[k] * silu(bf2f(gt[k])));
  __syncthreads();
}

DEV void a_carry(const P& p, int item) {
  int t = item * 256 + threadIdx.x;
  int ch = t & 511, dir = (t >> 9) & 1, lb = t >> 10;
  const float* AP = (const float*)(p.ws + O_AP);
  const float* AH = (const float*)(p.ws + O_AH);
  float* AC = (float*)(p.ws + O_ACAR);
  float st = 0.f;
  float pv[36], hv[36];
#pragma unroll
  for (int j = 0; j < 36; ++j) {
    int n = dir ? (j < 4 ? 3 - j : 39 - j) : j;
    size_t idx = ((size_t)(lb * 36 + n) * 2 + dir) * 512 + ch;
    pv[j] = AP[idx];
    hv[j] = AH[idx];
  }
#pragma unroll
  for (int j = 0; j < 36; ++j) {
    int n = dir ? (j < 4 ? 3 - j : 39 - j) : j;
    size_t idx = ((size_t)(lb * 36 + n) * 2 + dir) * 512 + ch;
    AC[idx] = st;
    st = pv[j] * st + hv[j];
  }
}

DEV void b_local(const P& p, int l, int item, char* smem) {
  u16* qs = (u16*)smem;
  u16* ks = qs + 64 * 136;
  float* Am = (float*)(smem + 34816);
  float* gc = (float*)(smem + 34816 + 32768);
  float* bt = gc + 128;
  const int tid = opq(threadIdx.x), lane = tid & 63, w = tid >> 6, fr = lane & 15, fq = lane >> 4;
  const int cgk = item >> 2, h = item & 3, n = cgk % 36, rb = cgk * 64;
  const u16* z = (const u16*)(p.ws + O_Z);
  u16* qn = (u16*)(p.ws + O_BSH);
  u16* kn = qn + (size_t)GR * 512;
  u16* vb = kn + (size_t)GR * 512;
  u16* knT = vb + (size_t)GR * 512;
  const float* ab = (const float*)(p.ws + O_AB);
  {
    u16* Tt = (u16*)Am;
    uint4 st[5];
#define BL_TLOAD(which)                                                                                  \
  _Pragma("unroll") for (int k = 0; k < 5; ++k) {                                                        \
    int idx = tid + 256 * k, row = idx >> 4, seg = idx & 15, cp = row - 2;                               \
    bool ok = (idx < 1072) && !((cp < 0 && (n == 0 || n == 4)) || (cp > 63 && (n == 3 || n == 35)));    \
    st[k] = make_uint4(0u, 0u, 0u, 0u);                                                                  \
    if (ok) st[k] = *(const uint4*)(z + (size_t)(rb + cp) * NZ + C_Q + (which)*512 + h * 128 + seg * 8); \
  }
    BL_TLOAD(0)
#pragma unroll
    for (int which = 0; which < 3; ++which) {
#pragma unroll
      for (int k = 0; k < 5; ++k) {
        int idx = tid + 256 * k, row = idx >> 4, seg = idx & 15;
        if (idx < 1072) *(uint4*)(Tt + row * 136 + seg * 8) = st[k];
      }
      __syncthreads();
      if (which < 2) { BL_TLOAD(which + 1) }
      float cw[2][4];
#pragma unroll
      for (int hh = 0; hh < 2; ++hh)
#pragma unroll
        for (int tap = 0; tap < 4; ++tap)
          cw[hh][tap] = p.conv_b_w[(size_t)(l * 4 + tap) * 1536 + which * 512 + h * 128 + lane + 64 * hh];
#pragma unroll 4
      for (int c = w; c < 64; c += 4) {
        float v[2];
#pragma unroll
        for (int hh = 0; hh < 2; ++hh) {
          int d = lane + 64 * hh;
          float a = 0.f;
#pragma unroll
          for (int tap = 0; tap < 4; ++tap) a += cw[hh][tap] * bf2f(Tt[(c + tap) * 136 + d]);
          v[hh] = silu(a);
        }
        float rs = 1.f;
        if (which < 2) {
          float sq = v[0] * v[0] + v[1] * v[1];
#pragma unroll
          for (int off = 32; off; off >>= 1) sq += __shfl_xor(sq, off);
          rs = rsqrtf(sq + EPS) * (which == 0 ? 0.08838834764831845f : 1.f);
        }
#pragma unroll
        for (int hh = 0; hh < 2; ++hh) {
          int d = lane + 64 * hh;
          u16 ob = f2bf(v[hh] * rs);
          size_t gi = (size_t)(rb + c) * 512 + h * 128 + d;
          if (which == 0) { qs[c * 136 + d] = ob; qn[gi] = ob; }
          else if (which == 1) { ks[c * 136 + d] = ob; kn[gi] = ob; }
          else vb[gi] = ob;
        }
      }
      __syncthreads();
    }
  }
  if (w < 2) {
    int dir = w, i = lane, c = dir ? 63 - i : i;
    float al = ab[(size_t)(rb + c) * 16 + dir * 4 + h], bl = ab[(size_t)(rb + c) * 16 + 8 + dir * 4 + h];
    float g = -__expf(p.gdn_a_log[(l * 2 + dir) * 4 + h]) * softplus(al + p.gdn_dt_bias[(l * 2 + dir) * 4 + h]);
#pragma unroll
    for (int off = 1; off < 64; off <<= 1) {
      float v = __shfl_up(g, off);
      if (lane >= off) g += v;
    }
    gc[dir * 64 + i] = g;
    bt[dir * 64 + i] = sigm(bl);
  }
  __syncthreads();
  for (int idx = tid; idx < 1024; idx += 256) {
    int d = idx >> 3, c8 = idx & 7;
    uint4 pk;
    pk.x = (unsigned)ks[(c8 * 8 + 0) * 136 + d] | ((unsigned)ks[(c8 * 8 + 1) * 136 + d] << 16);
    pk.y = (unsigned)ks[(c8 * 8 + 2) * 136 + d] | ((unsigned)ks[(c8 * 8 + 3) * 136 + d] << 16);
    pk.z = (unsigned)ks[(c8 * 8 + 4) * 136 + d] | ((unsigned)ks[(c8 * 8 + 5) * 136 + d] << 16);
    pk.w = (unsigned)ks[(c8 * 8 + 6) * 136 + d] | ((unsigned)ks[(c8 * 8 + 7) * 136 + d] << 16);
    *(uint4*)(knT + ((size_t)(cgk * 4 + h) * 128 + d) * 64 + c8 * 8) = pk;
  }
  for (int dir = 0; dir < 2; ++dir) {
    char* rec = p.ws + O_BIT + ((size_t)(cgk * 4 + h) * 2 + dir) * BIT_SZ;
    u16* QKm = (u16*)rec + 4096;
    float* scal = (float*)(rec + 16384);
    int irow = 16 * w + fr, ci = dir ? 63 - irow : irow;
    bf16x8 ak[4], aq[4];
#pragma unroll
    for (int s = 0; s < 4; ++s) { ak[s] = ld8(ks + ci * 136 + 32 * s + 8 * fq); aq[s] = ld8(qs + ci * 136 + 32 * s + 8 * fq); }
#pragma unroll
    for (int nt = 0; nt < 4; ++nt) {
      int jcol = 16 * nt + fr, cj = dir ? 63 - jcol : jcol;
      f32x4 kk = {0.f, 0.f, 0.f, 0.f}, qk = {0.f, 0.f, 0.f, 0.f};
#pragma unroll
      for (int s = 0; s < 4; ++s) {
        bf16x8 b = ld8(ks + cj * 136 + 32 * s + 8 * fq);
        kk = mfma(ak[s], b, kk);
        qk = mfma(aq[s], b, qk);
      }
      float gj = gc[dir * 64 + jcol];
#pragma unroll
      for (int r = 0; r < 4; ++r) {
        int i = 16 * w + 4 * fq + r;
        float dec = (jcol <= i) ? __expf(gc[dir * 64 + i] - gj) : 0.f;
        Am[(dir * 64 + i) * 64 + jcol] = (jcol < i) ? bt[dir * 64 + i] * kk[r] * dec : 0.f;
        QKm[i * 64 + jcol] = f2bf(qk[r] * dec);
      }
    }
    if (tid < 64) {
      float gl = gc[dir * 64 + 63], gi = gc[dir * 64 + tid];
      scal[tid] = __expf(gi);
      scal[64 + tid] = bt[dir * 64 + tid];
      scal[128 + tid] = __expf(gl - gi);
      if (tid == 0) scal[192] = __expf(gl);
    }
  }
  __syncthreads();
  if (w < 2) {
    int dir = w, col = lane;
    u16* Tinv = (u16*)(p.ws + O_BIT + ((size_t)(cgk * 4 + h) * 2 + dir) * BIT_SZ);
    const float* Ad = Am + dir * 4096;
    float T[64];
#pragma unroll
    for (int i = 0; i < 64; ++i) {
      float s = (i == col) ? 1.f : 0.f;
#pragma unroll
      for (int j = 0; j < i; ++j) s -= Ad[i * 64 + j] * T[j];
      T[i] = s;
      Tinv[i * 64 + col] = f2bf(s);
      __builtin_amdgcn_sched_barrier(0);
    }
  }
  __syncthreads();
}

DEV void b_seq(const P& p, int bitem, char* smem) {
  const int tid = opq(threadIdx.x), lane = tid & 63, w = tid >> 6, fr = lane & 15, fq = lane >> 4;
  const bool active = w < WPB;
  const int item = bitem * WPB + (active ? w : 0);
  const int slice = item & 7, dir = (item >> 3) & 1, h = (item >> 4) & 3, lb = item >> 6, e0 = slice * 16;
  u16* Ss = (u16*)(smem + w * 11264);
  u16* Rs = Ss + 16 * 136;
  u16* Vsc = Rs + 16 * 72;
  u16* Vor = Vsc + 16 * 72;
  const u16* qn = (const u16*)(p.ws + O_BSH);
  const u16* kn = qn + (size_t)GR * 512;
  const u16* vb = kn + (size_t)GR * 512;
  const u16* knT = vb + (size_t)GR * 512;
  u16* OB = (u16*)(p.ws + O_OB);
  f32x4 S[8];
#pragma unroll
  for (int m = 0; m < 8; ++m) S[m] = (f32x4){0.f, 0.f, 0.f, 0.f};
  for (int j = 0; j < 36; ++j) {
    const int n = dir ? (j < 4 ? 3 - j : 39 - j) : j;
    const int cgk = lb * 36 + n, rb = cgk * 64;
    const char* rec = p.ws + O_BIT + ((size_t)(cgk * 4 + h) * 2 + dir) * BIT_SZ;
    const u16* Tinv = (const u16*)rec;
    const u16* QKm = Tinv + 4096;
    const float* scal = (const float*)(rec + 16384);
    if (active) {
#pragma unroll
      for (int m = 0; m < 8; ++m) {
        uint2 pk; pk.x = pk2(S[m][0], S[m][1]); pk.y = pk2(S[m][2], S[m][3]);
        *(uint2*)(Ss + fr * 136 + 16 * m + 4 * fq) = pk;
      }
    }
    __syncthreads();
    bf16x8 Sf[4];
    if (active) {
#pragma unroll
      for (int s = 0; s < 4; ++s) Sf[s] = ld8(Ss + fr * 136 + 32 * s + 8 * fq);
#pragma unroll
      for (int m = 0; m < 4; ++m) {
        int i = 16 * m + fr, rowi = rb + (dir ? 63 - i : i);
        f32x4 X = {0.f, 0.f, 0.f, 0.f};
#pragma unroll
        for (int s = 0; s < 4; ++s) X = mfma(ld8(kn + (size_t)rowi * 512 + h * 128 + 32 * s + 8 * fq), Sf[s], X);
        float rv[4];
#pragma unroll
        for (int r = 0; r < 4; ++r) {
          int ii = 16 * m + 4 * fq + r, rowr = rb + (dir ? 63 - ii : ii);
          float v = bf2f(vb[(size_t)rowr * 512 + h * 128 + e0 + fr]);
          rv[r] = scal[64 + ii] * (v - scal[ii] * X[r]);
        }
        uint2 pk; pk.x = pk2(rv[0], rv[1]); pk.y = pk2(rv[2], rv[3]);
        *(uint2*)(Rs + fr * 72 + 16 * m + 4 * fq) = pk;
      }
    }
    __syncthreads();
    if (active) {
      bf16x8 Rf0 = ld8(Rs + fr * 72 + 8 * fq), Rf1 = ld8(Rs + fr * 72 + 32 + 8 * fq);
#pragma unroll
      for (int m = 0; m < 4; ++m) {
        f32x4 VN = {0.f, 0.f, 0.f, 0.f};
        VN = mfma(ld8(Tinv + (16 * m + fr) * 64 + 8 * fq), Rf0, VN);
        VN = mfma(ld8(Tinv + (16 * m + fr) * 64 + 32 + 8 * fq), Rf1, VN);
        uint2 pk; pk.x = pk2(VN[0], VN[1]); pk.y = pk2(VN[2], VN[3]);
        *(uint2*)(Vsc + fr * 72 + 16 * m + 4 * fq) = pk;
        int ib = 16 * m + 4 * fq;
        float s0 = VN[0] * scal[128 + ib], s1 = VN[1] * scal[128 + ib + 1], s2 = VN[2] * scal[128 + ib + 2],
              s3 = VN[3] * scal[128 + ib + 3];
        if (dir) {
          pk.x = pk2(s3, s2); pk.y = pk2(s1, s0);
          *(uint2*)(Vor + fr * 72 + (60 - ib)) = pk;
        } else {
          pk.x = pk2(s0, s1); pk.y = pk2(s2, s3);
          *(uint2*)(Vor + fr * 72 + ib) = pk;
        }
      }
    }
    __syncthreads();
    if (active) {
      bf16x8 Vs0 = ld8(Vsc + fr * 72 + 8 * fq), Vs1 = ld8(Vsc + fr * 72 + 32 + 8 * fq);
      bf16x8 Vo0 = ld8(Vor + fr * 72 + 8 * fq), Vo1 = ld8(Vor + fr * 72 + 32 + 8 * fq);
#pragma unroll
      for (int m = 0; m < 4; ++m) {
        int i = 16 * m + fr, rowi = rb + (dir ? 63 - i : i);
        f32x4 O = {0.f, 0.f, 0.f, 0.f};
#pragma unroll
        for (int s = 0; s < 4; ++s) O = mfma(ld8(qn + (size_t)rowi * 512 + h * 128 + 32 * s + 8 * fq), Sf[s], O);
#pragma unroll
        for (int r = 0; r < 4; ++r) O[r] *= scal[16 * m + 4 * fq + r];
        O = mfma(ld8(QKm + (16 * m + fr) * 64 + 8 * fq), Vs0, O);
        O = mfma(ld8(QKm + (16 * m + fr) * 64 + 32 + 8 * fq), Vs1, O);
#pragma unroll
        for (int r = 0; r < 4; ++r) {
          int ii = 16 * m + 4 * fq + r, rowr = rb + (dir ? 63 - ii : ii);
          OB[((size_t)dir * GR + rowr) * 512 + h * 128 + e0 + fr] = f2bf(O[r]);
        }
      }
      float egl = scal[192];
#pragma unroll
      for (int m = 0; m < 8; ++m) {
        const u16* kt = knT + ((size_t)(cgk * 4 + h) * 128 + 16 * m + fr) * 64;
        f32x4 t = S[m];
#pragma unroll
        for (int r = 0; r < 4; ++r) t[r] *= egl;
        t = mfma(ld8(kt + 8 * fq), Vo0, t);
        t = mfma(ld8(kt + 32 + 8 * fq), Vo1, t);
        S[m] = t;
      }
    }
  }
  __syncthreads();
}

DEV void c_local(const P& p, int l, int item, char* smem) {
  float* bsm = (float*)smem;
  u16* Ps = (u16*)(smem + 33024);
  u16* kdt = (u16*)(smem + 33024 + 9216);
  const int tid = opq(threadIdx.x), lane = tid & 63, w = tid >> 6, fr = lane & 15, fq = lane >> 4;
  const int cgk = item >> 2, h = item & 3, rb = cgk * 64;
  const u16* z = (const u16*)(p.ws + O_Z);
  const u16* zT = (const u16*)(p.ws + O_ZT);
  u16* OC = (u16*)(p.ws + O_OC);
  const float* lbs = (const float*)(p.ws + O_LBS);
  for (int dir = 0; dir < 2; ++dir) {
    char* rec = p.ws + O_CREC + ((size_t)(cgk * 4 + h) * 2 + dir) * CREC_SZ;
    u16* QD = (u16*)rec;
    u16* KDT = QD + 8192;
    float* decv = (float*)(rec + 32768);
    const float* lbp = lbs + l * 1024 + dir * 512 + h * 128;
    const int fcol = C_F0 + dir * 512 + h * 128;
    {
      int d = tid & 127, half = tid >> 7;
      float lb_ = lbp[d], run = 0.f;
      for (int k = 0; k < 32; ++k) {
        int i = 32 * half + k, c = dir ? 63 - i : i;
        float f = bf2f(z[(size_t)(rb + c) * NZ + fcol + d]);
        float fg = lb_ + (1.f - lb_) * sigm(f);
        run += __logf(fg);
        bsm[i * 129 + d] = run;
      }
    }
    __syncthreads();
    {
      int d = tid & 127, half = tid >> 7;
      if (half) {
        float add = bsm[31 * 129 + d];
        for (int k = 0; k < 32; ++k) bsm[(32 + k) * 129 + d] += add;
      }
    }
    __syncthreads();
    for (int idx = tid; idx < 8192; idx += 256) {
      int i = idx >> 7, d = idx & 127, c = dir ? 63 - i : i;
      float b = bsm[i * 129 + d];
      float q = silu(bf2f(z[(size_t)(rb + c) * NZ + C_QC + h * 128 + d]));
      QD[i * 128 + d] = f2bf(q * __expf(b));
      float f = bf2f(z[(size_t)(rb + c) * NZ + fcol + d]);
      float k = (1.f - lbp[d]) * sigm(-f);
      kdt[d * 72 + c] = f2bf(k * __expf(bsm[63 * 129 + d] - b));
    }
    if (tid < 128) decv[tid] = __expf(bsm[63 * 129 + tid]);
    __syncthreads();
    for (int idx = tid; idx < 1024; idx += 256) {
      int d = idx >> 3, c8 = idx & 7;
      *(uint4*)(KDT + d * 64 + c8 * 8) = *(const uint4*)(kdt + d * 72 + c8 * 8);
    }
    {
      const int sj = w;
      for (int si = 0; si < 4; ++si) {
        f32x4 acc = {0.f, 0.f, 0.f, 0.f};
        if (si >= sj) {
          int it = 16 * si + fr, jt = 16 * sj + fr;
          int ci = dir ? 63 - it : it, cj = dir ? 63 - jt : jt;
#pragma unroll
          for (int s = 0; s < 4; ++s) {
            int d0 = 32 * s + 8 * fq;
            bf16x8 qv = ld8(z + (size_t)(rb + ci) * NZ + C_QC + h * 128 + d0);
            bf16x8 fv = ld8(z + (size_t)(rb + cj) * NZ + fcol + d0);
            bf16x8 af, bf;
#pragma unroll
            for (int e = 0; e < 8; ++e) {
              int d = d0 + e;
              float Bs_ = si ? bsm[(16 * si - 1) * 129 + d] : 0.f;
              float qq = silu(bf2f((u16)qv[e])) * __expf(bsm[it * 129 + d] - Bs_);
              float kk = (1.f - lbp[d]) * sigm(-bf2f((u16)fv[e])) * __expf(Bs_ - bsm[jt * 129 + d]);
              af[e] = (short)f2bf(qq);
              bf[e] = (short)f2bf(kk);
            }
            acc = mfma(af, bf, acc);
          }
        }
#pragma unroll
        for (int r = 0; r < 4; ++r) {
          int i = 16 * si + 4 * fq + r, jj = 16 * sj + fr;
          float v = (si >= sj && jj <= i) ? acc[r] : 0.f;
          Ps[i * 72 + (dir ? 63 - jj : jj)] = f2bf(v);
        }
        __builtin_amdgcn_sched_barrier(0);
      }
    }
    __syncthreads();
#pragma unroll
    for (int nt2 = 0; nt2 < 2; ++nt2) {
      int e = h * 128 + (2 * w + nt2) * 16 + fr;
      bf16x8 v0 = ld8(zT + (size_t)e * GR + rb + 8 * fq), v1 = ld8(zT + (size_t)e * GR + rb + 32 + 8 * fq);
#pragma unroll
      for (int m = 0; m < 4; ++m) {
        f32x4 O = {0.f, 0.f, 0.f, 0.f};
        O = mfma(ld8(Ps + (16 * m + fr) * 72 + 8 * fq), v0, O);
        O = mfma(ld8(Ps + (16 * m + fr) * 72 + 32 + 8 * fq), v1, O);
#pragma unroll
        for (int r = 0; r < 4; ++r) {
          int ii = 16 * m + 4 * fq + r, rowr = rb + (dir ? 63 - ii : ii);
          OC[((size_t)dir * GR + rowr) * 512 + e] = f2bf(O[r]);
        }
      }
    }
    __syncthreads();
  }
}

DEV void c_seq(const P& p, int bitem, char* smem) {
  const int tid = opq(threadIdx.x), lane = tid & 63, w = tid >> 6, fr = lane & 15, fq = lane >> 4;
  const bool active = w < WPB;
  const int item = bitem * WPB + (active ? w : 0);
  const int slice = item & 7, dir = (item >> 3) & 1, h = (item >> 4) & 3, lb = item >> 6, e0 = slice * 16;
  u16* Ss = (u16*)(smem + w * 4352);
  const u16* zT = (const u16*)(p.ws + O_ZT);
  u16* OC = (u16*)(p.ws + O_OC);
  f32x4 S[8];
#pragma unroll
  for (int m = 0; m < 8; ++m) S[m] = (f32x4){0.f, 0.f, 0.f, 0.f};
  for (int j = 0; j < 36; ++j) {
    const int n = dir ? (j < 4 ? 3 - j : 39 - j) : j;
    const int cgk = lb * 36 + n, rb = cgk * 64;
    const char* rec = p.ws + O_CREC + ((size_t)(cgk * 4 + h) * 2 + dir) * CREC_SZ;
    const u16* QD = (const u16*)rec;
    const u16* KDT = QD + 8192;
    const float* decv = (const float*)(rec + 32768);
    if (active) {
#pragma unroll
      for (int m = 0; m < 8; ++m) {
        uint2 pk; pk.x = pk2(S[m][0], S[m][1]); pk.y = pk2(S[m][2], S[m][3]);
        *(uint2*)(Ss + fr * 136 + 16 * m + 4 * fq) = pk;
      }
    }
    __syncthreads();
    if (active) {
      bf16x8 Sf[4];
#pragma unroll
      for (int s = 0; s < 4; ++s) Sf[s] = ld8(Ss + fr * 136 + 32 * s + 8 * fq);
#pragma unroll
      for (int m = 0; m < 4; ++m) {
        f32x4 O = {0.f, 0.f, 0.f, 0.f};
#pragma unroll
        for (int s = 0; s < 4; ++s) O = mfma(ld8(QD + (16 * m + fr) * 128 + 32 * s + 8 * fq), Sf[s], O);
#pragma unroll
        for (int r = 0; r < 4; ++r) {
          int ii = 16 * m + 4 * fq + r, rowr = rb + (dir ? 63 - ii : ii);
          size_t oi = ((size_t)dir * GR + rowr) * 512 + h * 128 + e0 + fr;
          OC[oi] = f2bf(bf2f(OC[oi]) + O[r]);
        }
      }
      const u16* vp = zT + (size_t)(h * 128 + e0 + fr) * GR + rb;
      bf16x8 V0 = ld8(vp + 8 * fq), V1 = ld8(vp + 32 + 8 * fq);
#pragma unroll
      for (int m = 0; m < 8; ++m) {
        f32x4 t = S[m];
#pragma unroll
        for (int r = 0; r < 4; ++r) t[r] *= decv[16 * m + 4 * fq + r];
        t = mfma(ld8(KDT + (16 * m + fr) * 64 + 8 * fq), V0, t);
        t = mfma(ld8(KDT + (16 * m + fr) * 64 + 32 + 8 * fq), V1, t);
        S[m] = t;
      }
    }
    __syncthreads();
  }
}

#define LBAR()                                              \
  do {                                                      \
    asm volatile("s_waitcnt lgkmcnt(0)" ::: "memory");      \
    __builtin_amdgcn_s_barrier();                           \
    asm volatile("" ::: "memory");                          \
  } while (0)
#define CBAR() asm volatile("" ::: "memory")

DEV void c_local2(const P& p, int l, int item, char* smem) {
  float* bsm = (float*)smem;
  u16* Fq = (u16*)(smem + 33024);
  u16* kdt = (u16*)(smem + 50432);
  u16* Ps = kdt;
  const int tid = opq(threadIdx.x), lane = tid & 63, w = tid >> 6, fr = lane & 15, fq = lane >> 4;
  const int cgk = item >> 2, h = item & 3, rb = cgk * 64;
  const u16* z = (const u16*)(p.ws + O_Z);
  const u16* zT = (const u16*)(p.ws + O_ZT);
  u16* OC = (u16*)(p.ws + O_OC);
  const float* lbs = (const float*)(p.ws + O_LBS);
  u16* zq = (u16*)(p.ws + O_Z) + (size_t)rb * NZ + C_QC + h * 128;
  {
    uint4 t4[4];
#pragma unroll
    for (int k = 0; k < 4; ++k) {
      int idx = tid + 256 * k, c = idx >> 4, seg = idx & 15;
      t4[k] = *(const uint4*)(zq + (size_t)c * NZ + seg * 8);
    }
#pragma unroll
    for (int k = 0; k < 4; ++k) {
      int idx = tid + 256 * k, c = idx >> 4, seg = idx & 15;
      unsigned wv[4] = {t4[k].x, t4[k].y, t4[k].z, t4[k].w};
#pragma unroll
      for (int q = 0; q < 4; ++q)
        wv[q] = pk2(silu(bf2f((u16)(wv[q] & 0xffff))), silu(bf2f((u16)(wv[q] >> 16))));
      *(uint4*)(zq + (size_t)c * NZ + seg * 8) = make_uint4(wv[0], wv[1], wv[2], wv[3]);
    }
  }
  __syncthreads();
  for (int dir = 0; dir < 2; ++dir) {
    char* rec = p.ws + O_CREC + ((size_t)(cgk * 4 + h) * 2 + dir) * CREC_SZ;
    u16* QD = (u16*)rec;
    u16* KDT = QD + 8192;
    float* decv = (float*)(rec + 32768);
    const float* lbp = lbs + l * 1024 + dir * 512 + h * 128;
    const int fcol = C_F0 + dir * 512 + h * 128;
    {
      uint4 t4[4];
#pragma unroll
      for (int k = 0; k < 4; ++k) {
        int idx = tid + 256 * k, c = idx >> 4, seg = idx & 15;
        t4[k] = *(const uint4*)(z + (size_t)(rb + c) * NZ + fcol + seg * 8);
      }
#pragma unroll
      for (int k = 0; k < 4; ++k) {
        int idx = tid + 256 * k, c = idx >> 4, seg = idx & 15;
        *(uint4*)(Fq + c * 136 + seg * 8) = t4[k];
      }
    }
    __syncthreads();
    {
      int d = tid & 127, half = tid >> 7;
      float lb_ = lbp[d], run = 0.f;
#pragma unroll 8
      for (int k = 0; k < 32; ++k) {
        int i = 32 * half + k, c = dir ? 63 - i : i;
        float f = bf2f(Fq[c * 136 + d]);
        float fg = lb_ + (1.f - lb_) * sigm(f);
        run += __logf(fg);
        bsm[i * 129 + d] = run;
      }
    }
    __syncthreads();
    {
      int d = tid & 127, half = tid >> 7;
      if (half) {
        float add = bsm[31 * 129 + d];
#pragma unroll 8
        for (int k = 0; k < 32; ++k) bsm[(32 + k) * 129 + d] += add;
      }
    }
    __syncthreads();
    {
      uint4 qv[4];
#pragma unroll
      for (int k = 0; k < 4; ++k) {
        int idx = tid + 256 * k, c = idx >> 4, seg = idx & 15;
        qv[k] = *(const uint4*)(zq + (size_t)c * NZ + seg * 8);
      }
#pragma unroll
      for (int k = 0; k < 4; ++k) {
        int idx = tid + 256 * k, c = idx >> 4, seg = idx & 15, i = dir ? 63 - c : c, d0 = seg * 8;
        unsigned qw[4] = {qv[k].x, qv[k].y, qv[k].z, qv[k].w};
        uint4 fv4 = *(const uint4*)(Fq + c * 136 + d0);
        unsigned fw[4] = {fv4.x, fv4.y, fv4.z, fv4.w};
        unsigned qo[4], ko[4];
#pragma unroll
        for (int q = 0; q < 4; ++q) {
          int d = d0 + 2 * q;
          float b0 = bsm[i * 129 + d], b1 = bsm[i * 129 + d + 1];
          float bl0 = bsm[63 * 129 + d], bl1 = bsm[63 * 129 + d + 1];
          float q0 = bf2f((u16)(qw[q] & 0xffff)), q1 = bf2f((u16)(qw[q] >> 16));
          qo[q] = pk2(q0 * __expf(b0), q1 * __expf(b1));
          float k0 = (1.f - lbp[d]) * sigm(-bf2f((u16)(fw[q] & 0xffff)));
          float k1 = (1.f - lbp[d + 1]) * sigm(-bf2f((u16)(fw[q] >> 16)));
          ko[q] = pk2(k0, k1);
          kdt[d * 72 + c] = f2bf(k0 * __expf(bl0 - b0));
          kdt[(d + 1) * 72 + c] = f2bf(k1 * __expf(bl1 - b1));
        }
        *(uint4*)(QD + i * 128 + d0) = make_uint4(qo[0], qo[1], qo[2], qo[3]);
        *(uint4*)(Fq + c * 136 + d0) = make_uint4(ko[0], ko[1], ko[2], ko[3]);
      }
      if (tid < 128) decv[tid] = __expf(bsm[63 * 129 + tid]);
    }
    __syncthreads();
    for (int idx = tid; idx < 1024; idx += 256) {
      int d = idx >> 3, c8 = idx & 7;
      *(uint4*)(KDT + d * 64 + c8 * 8) = *(const uint4*)(kdt + d * 72 + c8 * 8);
    }
    bf16x8 qf[3][4];
#pragma unroll
    for (int t = 0; t < 3; ++t) {
      int k = w + 4 * t;
      int si = k < 4 ? 3 : (k < 7 ? 2 : (k < 9 ? 1 : 0));
      int it_ = 16 * si + fr, ci_ = dir ? 63 - it_ : it_;
#pragma unroll
      for (int s = 0; s < 4; ++s) qf[t][s] = ld8(zq + (size_t)ci_ * NZ + 32 * s + 8 * fq);
    }
    __syncthreads();
    for (int idx = tid; idx < 1536; idx += 256) {
      int tl = idx >> 8, e = idx & 255, r16 = e >> 4, c16 = e & 15;
      int si = tl < 3 ? 0 : (tl < 5 ? 1 : 2);
      int sj = tl < 3 ? tl + 1 : (tl < 5 ? tl - 1 : 3);
      int jj = 16 * sj + c16;
      Ps[(16 * si + r16) * 72 + (dir ? 63 - jj : jj)] = 0;
    }
#pragma unroll
    for (int t = 0; t < 3; ++t) {
      const int k = w + 4 * t;
      if (k < 10) {
        const int si = k < 4 ? 3 : (k < 7 ? 2 : (k < 9 ? 1 : 0));
        const int sj = k - (k < 4 ? 0 : (k < 7 ? 4 : (k < 9 ? 7 : 9)));
        const int it = 16 * si + fr, jt = 16 * sj + fr, cj = dir ? 63 - jt : jt;
        const int brow = si ? (16 * si - 1) : 0;
        const float bmul = si ? 1.f : 0.f;
        f32x4 acc = {0.f, 0.f, 0.f, 0.f};
#pragma unroll
        for (int s = 0; s < 4; ++s) {
          int d0 = 32 * s + 8 * fq;
          bf16x8 fv = ld8(Fq + cj * 136 + d0);
          bf16x8 af, bf;
#pragma unroll
          for (int e = 0; e < 8; ++e) {
            int d = d0 + e;
            float Bs_ = bmul * bsm[brow * 129 + d];
            float qq = bf2f((u16)qf[t][s][e]) * __expf(bsm[it * 129 + d] - Bs_);
            float kk = bf2f((u16)fv[e]) * __expf(Bs_ - bsm[jt * 129 + d]);
            af[e] = (short)f2bf(qq);
            bf[e] = (short)f2bf(kk);
          }
          acc = mfma(af, bf, acc);
          __builtin_amdgcn_sched_barrier(0);
        }
#pragma unroll
        for (int r = 0; r < 4; ++r) {
          int i = 16 * si + 4 * fq + r, jj = 16 * sj + fr;
          float v = (jj <= i) ? acc[r] : 0.f;
          Ps[i * 72 + (dir ? 63 - jj : jj)] = f2bf(v);
        }
      }
    }
    __syncthreads();
#pragma unroll
    for (int nt2 = 0; nt2 < 2; ++nt2) {
      int e = h * 128 + (2 * w + nt2) * 16 + fr;
      bf16x8 v0 = ld8(zT + (size_t)e * GR + rb + 8 * fq), v1 = ld8(zT + (size_t)e * GR + rb + 32 + 8 * fq);
#pragma unroll
      for (int m = 0; m < 4; ++m) {
        f32x4 O = {0.f, 0.f, 0.f, 0.f};
        O = mfma(ld8(Ps + (16 * m + fr) * 72 + 8 * fq), v0, O);
        O = mfma(ld8(Ps + (16 * m + fr) * 72 + 32 + 8 * fq), v1, O);
#pragma unroll
        for (int r = 0; r < 4; ++r) {
          int ii = 16 * m + 4 * fq + r, rowr = rb + (dir ? 63 - ii : ii);
          OC[((size_t)dir * GR + rowr) * 512 + e] = f2bf(O[r]);
        }
      }
    }
    __syncthreads();
  }
}

#define LBAR()                                              \
  do {                                                      \
    asm volatile("s_waitcnt lgkmcnt(0)" ::: "memory");      \
    __builtin_amdgcn_s_barrier();                           \
    asm volatile("" ::: "memory");                          \
  } while (0)
#define CBAR() asm volatile("" ::: "memory")
#define BS_CHUNK(jj) (dir ? ((jj) < 4 ? 3 - (jj) : 39 - (jj)) : (jj))
DEV bf16x8 ldo8(const char* base, unsigned off) { return *reinterpret_cast<const bf16x8*>(base + off); }
DEV void b_seq2(const P& p, int bitem, char* smem) {
  const int tid = opq(threadIdx.x), lane = tid & 63, w = tid >> 6, fr = lane & 15, fq = lane >> 4;
  const int es = bitem & 3, dir = (bitem >> 2) & 1, h = (bitem >> 3) & 3, lb = bitem >> 5, e0 = es * 32;
  u16* Ss = (u16*)smem;
  u16* Rs = Ss + 32 * 136;
  u16* Vsc = Rs + 32 * 72;
  u16* Vor = Vsc + 32 * 72;
  const char* qnB = p.ws + O_BSH + (size_t)h * 256;
  const char* knB = qnB + BSH_ONE;
  const char* vbB = knB + BSH_ONE + (size_t)e0 * 2;
  const char* ktB = p.ws + O_BSH + 3 * BSH_ONE + (size_t)h * 16384;
  const char* recB = p.ws + O_BIT + ((size_t)h * 2 + dir) * BIT_SZ;
  char* obB = p.ws + O_OB + ((size_t)dir * GR * 512 + h * 128 + e0) * 2;
  const int mrow = 16 * w + fr, crow0 = 16 * w + 4 * fq;
  const unsigned offA = (unsigned)((dir ? 63 - mrow : mrow) * 1024 + 16 * fq);
  unsigned offR[4];
#pragma unroll
  for (int r = 0; r < 4; ++r) offR[r] = (unsigned)((dir ? 63 - (crow0 + r) : (crow0 + r)) * 1024 + fr * 2);
  const unsigned offT = (unsigned)(mrow * 128 + 16 * fq);
  const unsigned offK = (unsigned)((32 * w + fr) * 128 + 16 * fq);
  const unsigned offS = (unsigned)(16384 + crow0 * 4);
  f32x4 S[2][2];
#pragma unroll
  for (int a = 0; a < 2; ++a)
#pragma unroll
    for (int b = 0; b < 2; ++b) S[a][b] = (f32x4){0.f, 0.f, 0.f, 0.f};
  bf16x8 Akn[4], Aqn[4], At[2], Aqk[2], AkT[2][2];
  u16 vbv[2][4];
  float4 eg4, be4, ek4;
  float egl;
#define BS_LOAD1(cg_)                                                              \
  {                                                                                \
    const size_t ro_ = (size_t)(cg_) * 65536;                                      \
    _Pragma("unroll") for (int s = 0; s < 4; ++s) {                                \
      Akn[s] = ldo8(knB + ro_, offA + 64 * s);                                     \
      Aqn[s] = ldo8(qnB + ro_, offA + 64 * s);                                     \
    }                                                                              \
    _Pragma("unroll") for (int r = 0; r < 4; ++r) {                                \
      vbv[0][r] = *(const u16*)(vbB + ro_ + offR[r]);                              \
      vbv[1][r] = *(const u16*)(vbB + ro_ + (offR[r] + 32));                       \
    }                                                                              \
    const char* rc_ = recB + (size_t)(cg_) * (8 * BIT_SZ);                         \
    eg4 = *(const float4*)(rc_ + offS);                                            \
    be4 = *(const float4*)(rc_ + (offS + 256));                                    \
  }
#define BS_LOAD2(cg_)                                                              \
  {                                                                                \
    const char* rc_ = recB + (size_t)(cg_) * (8 * BIT_SZ);                         \
    At[0] = ldo8(rc_, offT); At[1] = ldo8(rc_, offT + 64);                         \
    ek4 = *(const float4*)(rc_ + (offS + 512));                                    \
  }
#define BS_LOAD3(cg_)                                                              \
  {                                                                                \
    const char* rc_ = recB + (size_t)(cg_) * (8 * BIT_SZ);                         \
    Aqk[0] = ldo8(rc_, offT + 8192); Aqk[1] = ldo8(rc_, offT + 8192 + 64);         \
    egl = *(const float*)(rc_ + 16384 + 768);                                      \
    const char* kt_ = ktB + (size_t)(cg_) * 65536;                                 \
    AkT[0][0] = ldo8(kt_, offK); AkT[0][1] = ldo8(kt_, offK + 64);                 \
    AkT[1][0] = ldo8(kt_, offK + 2048); AkT[1][1] = ldo8(kt_, offK + 2048 + 64);   \
  }
  {
    const int c0 = lb * 36 + BS_CHUNK(0);
    BS_LOAD1(c0) BS_LOAD2(c0) BS_LOAD3(c0)
  }
  for (int j = 0; j < 36; ++j) {
    const int cgk = lb * 36 + BS_CHUNK(j);
    const int jn = (j + 1 < 36) ? j + 1 : j;
    const int cgn = lb * 36 + BS_CHUNK(jn);
#pragma unroll
    for (int mm = 0; mm < 2; ++mm)
#pragma unroll
      for (int nt = 0; nt < 2; ++nt) {
        uint2 pk; pk.x = pk2(S[mm][nt][0], S[mm][nt][1]); pk.y = pk2(S[mm][nt][2], S[mm][nt][3]);
        *(uint2*)(Ss + (16 * nt + fr) * 136 + 32 * w + 16 * mm + 4 * fq) = pk;
      }
    LBAR();
    f32x4 QS[2];
    {
      bf16x8 Sf[2][4];
#pragma unroll
      for (int nt = 0; nt < 2; ++nt)
#pragma unroll
        for (int s = 0; s < 4; ++s) Sf[nt][s] = ld8(Ss + (16 * nt + fr) * 136 + 32 * s + 8 * fq);
#pragma unroll
      for (int nt = 0; nt < 2; ++nt) {
        f32x4 X = {0.f, 0.f, 0.f, 0.f}, Q = {0.f, 0.f, 0.f, 0.f};
#pragma unroll
        for (int s = 0; s < 4; ++s) { X = mfma(Akn[s], Sf[nt][s], X); Q = mfma(Aqn[s], Sf[nt][s], Q); }
        float r0 = be4.x * (bf2f(vbv[nt][0]) - eg4.x * X[0]);
        float r1 = be4.y * (bf2f(vbv[nt][1]) - eg4.y * X[1]);
        float r2 = be4.z * (bf2f(vbv[nt][2]) - eg4.z * X[2]);
        float r3 = be4.w * (bf2f(vbv[nt][3]) - eg4.w * X[3]);
        uint2 pk; pk.x = pk2(r0, r1); pk.y = pk2(r2, r3);
        *(uint2*)(Rs + (16 * nt + fr) * 72 + crow0) = pk;
        Q[0] *= eg4.x; Q[1] *= eg4.y; Q[2] *= eg4.z; Q[3] *= eg4.w;
        QS[nt] = Q;
      }
    }
    CBAR();
    BS_LOAD1(cgn)
    LBAR();
    {
#pragma unroll
      for (int nt = 0; nt < 2; ++nt) {
        bf16x8 Rf0 = ld8(Rs + (16 * nt + fr) * 72 + 8 * fq), Rf1 = ld8(Rs + (16 * nt + fr) * 72 + 32 + 8 * fq);
        f32x4 VN = {0.f, 0.f, 0.f, 0.f};
        VN = mfma(At[0], Rf0, VN);
        VN = mfma(At[1], Rf1, VN);
        uint2 pk; pk.x = pk2(VN[0], VN[1]); pk.y = pk2(VN[2], VN[3]);
        *(uint2*)(Vsc + (16 * nt + fr) * 72 + crow0) = pk;
        float s0 = VN[0] * ek4.x, s1 = VN[1] * ek4.y, s2 = VN[2] * ek4.z, s3 = VN[3] * ek4.w;
        if (dir) {
          pk.x = pk2(s3, s2); pk.y = pk2(s1, s0);
          *(uint2*)(Vor + (16 * nt + fr) * 72 + (60 - crow0)) = pk;
        } else {
          pk.x = pk2(s0, s1); pk.y = pk2(s2, s3);
          *(uint2*)(Vor + (16 * nt + fr) * 72 + crow0) = pk;
        }
      }
    }
    CBAR();
    BS_LOAD2(cgn)
    LBAR();
    {
      char* ob_ = obB + (size_t)cgk * 65536;
#pragma unroll
      for (int nt = 0; nt < 2; ++nt) {
        bf16x8 Vs0 = ld8(Vsc + (16 * nt + fr) * 72 + 8 * fq), Vs1 = ld8(Vsc + (16 * nt + fr) * 72 + 32 + 8 * fq);
        bf16x8 Vo0 = ld8(Vor + (16 * nt + fr) * 72 + 8 * fq), Vo1 = ld8(Vor + (16 * nt + fr) * 72 + 32 + 8 * fq);
        f32x4 O = QS[nt];
        O = mfma(Aqk[0], Vs0, O);
        O = mfma(Aqk[1], Vs1, O);
#pragma unroll
        for (int r = 0; r < 4; ++r) *(u16*)(ob_ + (offR[r] + 32 * nt)) = f2bf(O[r]);
#pragma unroll
        for (int mm = 0; mm < 2; ++mm) {
          f32x4 t = S[mm][nt];
#pragma unroll
          for (int r = 0; r < 4; ++r) t[r] *= egl;
          t = mfma(AkT[mm][0], Vo0, t);
          t = mfma(AkT[mm][1], Vo1, t);
          S[mm][nt] = t;
        }
      }
    }
    CBAR();
    BS_LOAD3(cgn)
  }
  LBAR();
}

DEV void c_seq2(const P& p, int bitem, char* smem) {
  const int tid = opq(threadIdx.x), lane = tid & 63, w = tid >> 6, fr = lane & 15, fq = lane >> 4;
  const int es = bitem & 3, dir = (bitem >> 2) & 1, h = (bitem >> 3) & 3, lb = bitem >> 5, e0 = es * 32;
  u16* Ssb = (u16*)smem;
  const char* recB = p.ws + O_CREC + ((size_t)h * 2 + dir) * CREC_SZ;
  const char* ztB = p.ws + O_ZT + (size_t)(h * 128 + e0) * GR * 2;
  char* ocB = p.ws + O_OC + ((size_t)dir * GR * 512 + h * 128 + e0) * 2;
  const int mrow = 16 * w + fr, crow0 = 16 * w + 4 * fq;
  const unsigned offQ = (unsigned)(mrow * 256 + 16 * fq);
  const unsigned offK = (unsigned)(16384 + (32 * w + fr) * 128 + 16 * fq);
  const unsigned offD = (unsigned)(32768 + (32 * w + 4 * fq) * 4);
  const unsigned offV = (unsigned)(fr * GR * 2 + 16 * fq);
  unsigned offR[4];
#pragma unroll
  for (int r = 0; r < 4; ++r) offR[r] = (unsigned)((dir ? 63 - (crow0 + r) : (crow0 + r)) * 1024 + fr * 2);
  f32x4 S[2][2];
#pragma unroll
  for (int a = 0; a < 2; ++a)
#pragma unroll
    for (int b = 0; b < 2; ++b) S[a][b] = (f32x4){0.f, 0.f, 0.f, 0.f};
  bf16x8 Aqd[4], Akd[2][2], Vf[2][2];
  u16 oi[2][4];
  float4 dec4[2];
#define CS_LOAD(cg_)                                                                    \
  {                                                                                     \
    const char* rc_ = recB + (size_t)(cg_) * (8 * CREC_SZ);                             \
    _Pragma("unroll") for (int s = 0; s < 4; ++s) Aqd[s] = ldo8(rc_, offQ + 64 * s);    \
    Akd[0][0] = ldo8(rc_, offK); Akd[0][1] = ldo8(rc_, offK + 64);                      \
    Akd[1][0] = ldo8(rc_, offK + 2048); Akd[1][1] = ldo8(rc_, offK + 2048 + 64);        \
    dec4[0] = *(const float4*)(rc_ + offD);                                             \
    dec4[1] = *(const float4*)(rc_ + (offD + 64));                                      \
    const char* zt_ = ztB + (size_t)(cg_) * 128;                                        \
    Vf[0][0] = ldo8(zt_, offV); Vf[0][1] = ldo8(zt_, offV + 64);                        \
    Vf[1][0] = ldo8(zt_, offV + 16 * GR * 2); Vf[1][1] = ldo8(zt_, offV + 16 * GR * 2 + 64); \
    const char* oc_ = ocB + (size_t)(cg_) * 65536;                                      \
    _Pragma("unroll") for (int r = 0; r < 4; ++r) {                                     \
      oi[0][r] = *(const u16*)(oc_ + offR[r]);                                          \
      oi[1][r] = *(const u16*)(oc_ + (offR[r] + 32));                                   \
    }                                                                                   \
  }
  {
    const int c0 = lb * 36 + BS_CHUNK(0);
    CS_LOAD(c0)
  }
  for (int j = 0; j < 36; ++j) {
    const int cgk = lb * 36 + BS_CHUNK(j);
    const int jn = (j + 1 < 36) ? j + 1 : j;
    const int cgn = lb * 36 + BS_CHUNK(jn);
    u16* Ss = Ssb + (j & 1) * (32 * 136);
#pragma unroll
    for (int mm = 0; mm < 2; ++mm)
#pragma unroll
      for (int nt = 0; nt < 2; ++nt) {
        uint2 pk; pk.x = pk2(S[mm][nt][0], S[mm][nt][1]); pk.y = pk2(S[mm][nt][2], S[mm][nt][3]);
        *(uint2*)(Ss + (16 * nt + fr) * 136 + 32 * w + 16 * mm + 4 * fq) = pk;
      }
    LBAR();
    char* oc_ = ocB + (size_t)cgk * 65536;
#pragma unroll
    for (int nt = 0; nt < 2; ++nt) {
      f32x4 O = {0.f, 0.f, 0.f, 0.f};
#pragma unroll
      for (int s = 0; s < 4; ++s) O = mfma(Aqd[s], ld8(Ss + (16 * nt + fr) * 136 + 32 * s + 8 * fq), O);
#pragma unroll
      for (int r = 0; r < 4; ++r) *(u16*)(oc_ + (offR[r] + 32 * nt)) = f2bf(bf2f(oi[nt][r]) + O[r]);
#pragma unroll
      for (int mm = 0; mm < 2; ++mm) {
        f32x4 t = S[mm][nt];
        t[0] *= dec4[mm].x; t[1] *= dec4[mm].y; t[2] *= dec4[mm].z; t[3] *= dec4[mm].w;
        t = mfma(Akd[mm][0], Vf[nt][0], t);
        t = mfma(Akd[mm][1], Vf[nt][1], t);
        S[mm][nt] = t;
      }
    }
    CBAR();
    CS_LOAD(cgn)
  }
  LBAR();
}

DEV void bc_merge(const P& p, int l, int it) {
  const int tid_ = opq(threadIdx.x); const int lane = tid_ & 63, w = tid_ >> 6;
  int lr = it * 4 + w;
  int mix = lane >> 5, cm = (lane * 16) & 511;
  const u16* O = (const u16*)(p.ws + (mix ? O_OC : O_OB));
  u16* z = (u16*)(p.ws + O_Z);
  float ov[16], ss = 0.f;
#pragma unroll
  for (int k2 = 0; k2 < 2; ++k2) {
    uint4 a = *(const uint4*)(O + (size_t)lr * 512 + cm + 8 * k2);
    uint4 b = *(const uint4*)(O + ((size_t)GR + lr) * 512 + cm + 8 * k2);
    unsigned aa[4] = {a.x, a.y, a.z, a.w}, bb[4] = {b.x, b.y, b.z, b.w};
#pragma unroll
    for (int q = 0; q < 4; ++q) {
      float v0 = bf2f((u16)(aa[q] & 0xffff)) + bf2f((u16)(bb[q] & 0xffff));
      float v1 = bf2f((u16)(aa[q] >> 16)) + bf2f((u16)(bb[q] >> 16));
      ov[k2 * 8 + q * 2] = v0; ov[k2 * 8 + q * 2 + 1] = v1;
      ss += v0 * v0 + v1 * v1;
    }
  }
  ss += __shfl_xor(ss, 1); ss += __shfl_xor(ss, 2); ss += __shfl_xor(ss, 4);
  float rinv = rsqrtf(ss * (1.f / 128.f) + EPS);
  const float* nw = (mix ? p.hg_norm : p.gdn_norm) + l * 128 + (cm & 127);
  u16* gp = z + (size_t)lr * NZ + (mix ? C_GC : C_GB) + cm;
#pragma unroll
  for (int k2 = 0; k2 < 2; ++k2) {
    uint4 gv = *(const uint4*)(gp + 8 * k2);
    unsigned gg[4] = {gv.x, gv.y, gv.z, gv.w}, oo[4];
#pragma unroll
    for (int q = 0; q < 4; ++q) {
      int e = k2 * 8 + q * 2;
      float y0 = ov[e] * rinv * nw[e] * silu(bf2f((u16)(gg[q] & 0xffff)));
      float y1 = ov[e + 1] * rinv * nw[e + 1] * silu(bf2f((u16)(gg[q] >> 16)));
      oo[q] = pk2(y0, y1);
    }
    *(uint4*)(gp + 8 * k2) = make_uint4(oo[0], oo[1], oo[2], oo[3]);
  }
}

#define XB_TMO      128
#define XB_XCNT(j)  (256  + 64 * (j))
#define XB_XSUB(j)  (1280 + 64 * (j))
#define XB_XGEN(j)  (2304 + 64 * (j))
#define XB_TOP      3328
#define XB_TOPGEN   3392
#define XCD_BAR_WORDS 3456
#define XB_SPIN_CAP (1u << 18)
#define LAS __attribute__((address_space(3)))

__device__ __forceinline__ unsigned xb_ld(unsigned* p)              { return __hip_atomic_load(p, __ATOMIC_RELAXED, __HIP_MEMORY_SCOPE_AGENT); }
__device__ __forceinline__ unsigned xb_add(unsigned* p, unsigned v) { return __hip_atomic_fetch_add(p, v, __ATOMIC_RELAXED, __HIP_MEMORY_SCOPE_AGENT); }
__device__ __forceinline__ unsigned xb_xcc_id() { return (unsigned)__builtin_amdgcn_s_getreg((3 << 11) | 20) & 0xFu; }
#define XB_SPIN(cond, bar) do { unsigned _sp = 0; while (cond) { __builtin_amdgcn_s_sleep(1); \
    if ((++_sp & 255u) == 0u) { if (xb_ld(&(bar)[XB_TMO])) break; if (_sp > XB_SPIN_CAP) { atomicAdd(&(bar)[XB_TMO], 1u); break; } } } } while (0)

struct XcdBarrier {
    unsigned* bar; unsigned x;
    volatile LAS unsigned* st;
};

__device__ __forceinline__ XcdBarrier xcd_barrier_post(unsigned* bar, volatile LAS unsigned* st) {
    XcdBarrier b; b.bar = bar; b.x = xb_xcc_id(); b.st = st;
    if (threadIdx.x == 0) (void)xb_add(&bar[XB_XCNT(b.x)], 1u);
    return b;
}
__device__ __forceinline__ void xcd_barrier_complete(unsigned* bar, unsigned x, unsigned& nloc, unsigned& nx) {
    const unsigned G = gridDim.x * gridDim.y * gridDim.z;
    unsigned sum, cnt, mine, sp = 0u;
    for (;;) {
        sum = 0u; cnt = 0u; mine = 0u;
#pragma unroll
        for (unsigned j = 0; j < 16; ++j) { const unsigned c = xb_ld(&bar[XB_XCNT(j)]); sum += c; cnt += (c > 0u) ? 1u : 0u; mine = (j == x) ? c : mine; }
        if (sum == G) break;
        __builtin_amdgcn_s_sleep(1);
        if ((++sp & 255u) == 0u) { if (xb_ld(&bar[XB_TMO])) break; if (sp > XB_SPIN_CAP) { atomicAdd(&bar[XB_TMO], 1u); break; } }
    }
    nloc = mine > 0u ? mine : 1u; nx = cnt > 0u ? cnt : 1u;
}

__device__ __forceinline__ void xcd_barrier(const XcdBarrier& b) {
    asm volatile("s_waitcnt vmcnt(0)" ::: "memory");
    __syncthreads();
    if (threadIdx.x == 0) {
        unsigned* bar = b.bar;
        __builtin_amdgcn_s_waitcnt(0);
        unsigned nloc = b.st[0], nx = b.st[1];
        if (nloc == 0u) { xcd_barrier_complete(bar, b.x, nloc, nx); b.st[0] = nloc; b.st[1] = nx; }
        const unsigned old = xb_add(&bar[XB_XSUB(b.x)], 1u);
        const unsigned gen = old / nloc;
        if (old + 1u == (gen + 1u) * nloc) {
            __builtin_amdgcn_fence(__ATOMIC_RELEASE, "agent");
            asm volatile("s_waitcnt vmcnt(0)" ::: "memory");
            const unsigned og = xb_add(&bar[XB_TOP], 1u);
            const unsigned tg = og / nx;
            if (og + 1u == (tg + 1u) * nx) xb_add(&bar[XB_TOPGEN], 1u);
            else XB_SPIN(xb_ld(&bar[XB_TOPGEN]) == tg, bar);
            __builtin_amdgcn_fence(__ATOMIC_ACQUIRE, "agent");
            xb_add(&bar[XB_XGEN(b.x)], 1u);
            asm volatile("s_waitcnt vmcnt(0)" ::: "memory");
        } else {
            XB_SPIN(xb_ld(&bar[XB_XGEN(b.x)]) == gen, bar);
            __builtin_amdgcn_fence(__ATOMIC_ACQUIRE, "agent");
            asm volatile("s_waitcnt vmcnt(0)" ::: "memory");
        }
    }
    __syncthreads();
}


#ifdef NO_G0
#define XG0(x)
#else
#define XG0(x) x
#endif
#ifdef NO_G1
#define XG1(x)
#else
#define XG1(x) x
#endif
#ifdef NO_BC
#define XBC(x)
#else
#define XBC(x) x
#endif
#ifdef NO_AC
#define XAC(x)
#else
#define XAC(x) x
#endif
#ifdef NO_P0
#define XP0(x)
#else
#define XP0(x) x
#endif
#ifdef NO_R
#define XR(x)
#else
#define XR(x) x
#endif
#ifdef NO_BL
#define XBL(x)
#else
#define XBL(x) x
#endif
#ifdef NO_CL
#define XCL(x)
#else
#define XCL(x) x
#endif
#ifdef NO_A0
#define XA0(x)
#else
#define XA0(x) x
#endif
#ifdef NO_A1
#define XA1(x)
#else
#define XA1(x) x
#endif
#ifdef NO_BS
#define XBS(x)
#else
#define XBS(x) x
#endif
#ifdef NO_CS
#define XCS(x)
#else
#define XCS(x) x
#endif
__global__ void __launch_bounds__(256, 2) fwd_mega(P p) {
  extern __shared__ __attribute__((aligned(16))) char smem[];
  cg::grid_group grid = cg::this_grid();
  const int G = gridDim.x;
  __shared__ uint4 xb_words;
  if (threadIdx.x == 0) xb_words = make_uint4(0u, 0u, 0u, 0u);
  __syncthreads();
  XcdBarrier xb = xcd_barrier_post((unsigned*)(p.ws + O_BAR), (volatile LAS unsigned*)&xb_words);
  XP0(phase0(p, smem));
  grid.sync();
  u16* z = (u16*)(p.ws + O_Z);
  u16* zT = (u16*)(p.ws + O_ZT);
  float* ab = (float*)(p.ws + O_AB);
  float* o = (float*)(p.ws + O_BSH);
  const u16* u = (const u16*)(p.ws + O_BIT);
  for (int g = 0; g < NG; ++g) {
    XR(phaseR(p, g, 0));
    xcd_barrier(xb);
    for (int l = 0; l < DEPTH; ++l) {
      for (int rep = 0; rep < REP_G; ++rep) {
        const u16* Bt = (const u16*)(p.ws + O_WTIN) + (size_t)l * NZ * 1024;
        if ((G & 7) == 0) {
          const int x = blockIdx.x & 7, bl = blockIdx.x >> 3, nbl = G >> 3;
          for (int q = bl; q < 9 * 45; q += nbl) { XG0(gemm_tile<0>(u, 1024, Bt, 1024, 9 * x + q % 9, q / 9, z, zT, ab, o, smem)); }
        } else {
          for (int t = blockIdx.x; t < 72 * 45; t += G) { XG0(gemm_tile<0>(u, 1024, Bt, 1024, t % 72, t / 72, z, zT, ab, o, smem)); }
        }
      }
      xcd_barrier(xb);
      for (int rep2 = 0; rep2 < REP_M; ++rep2) {
      for (int rep3 = 0; rep3 < REP_A; ++rep3) {
        if (rep3) xcd_barrier(xb);
        const int nb = NCH * 4, nc = NCH * 4, na = NCH * 8;
        for (int t = blockIdx.x; t < nb + nc + na; t += G) {
          if (t < nc) { XCL(c_local2(p, l, t, smem)); }
          else if (t < nb + nc) { XBL(b_local(p, l, t - nc, smem)); }
          else { XA0(a_item(p, l, t - nb - nc, 0, smem)); }
        }
      }
      xcd_barrier(xb);
      {
        for (int t = blockIdx.x; t < 256 + 16; t += G) {
          if (t < 128) { XBS(b_seq2(p, t, smem)); }
          else if (t < 256) { XCS(c_seq2(p, t - 128, smem)); }
          else { XAC(a_carry(p, t - 256)); }
        }
      }
      xcd_barrier(xb);
      }
      {
        const int na = NCH * 8, nm = GR / 4;
        for (int t = blockIdx.x; t < na + nm; t += G) {
          if (t < na) { XA1(a_fin(p, l, t, smem)); }
          else { XBC(bc_merge(p, l, t - na)); }
        }
      }
      xcd_barrier(xb);
      for (int rep = 0; rep < REP_G; ++rep) {
        const u16* Bt = (const u16*)(p.ws + O_WTOUT) + (size_t)l * 1024 * 1536;
        for (int t = blockIdx.x; t < 72 * 8; t += G) { XG1(gemm_tile<1>(z + C_GA, NZ, Bt, 1536, t % 72, t / 72, z, zT, ab, o, smem)); }
      }
      xcd_barrier(xb);
      XR(phaseR(p, g, l + 1));
      xcd_barrier(xb);
    }
  }
}

extern "C" void kernel_launch(void* const* d_in, const int* in_sizes, int n_in, void* d_out, int out_size, void* d_ws,
                              size_t ws_size, hipStream_t stream) {
  static int grid_blocks = 0;
  if (!grid_blocks) {
    int dev = 0, cus = 0, per_cu = 0;
    hipGetDevice(&dev);
    hipDeviceGetAttribute(&cus, hipDeviceAttributeMultiprocessorCount, dev);
    hipFuncSetAttribute((const void*)fwd_mega, hipFuncAttributeMaxDynamicSharedMemorySize, LDS_BYTES);
    hipOccupancyMaxActiveBlocksPerMultiprocessor(&per_cu, fwd_mega, 256, LDS_BYTES);
    if (per_cu > 2) per_cu = 2;
    if (per_cu < 1) per_cu = 1;
    grid_blocks = cus * per_cu;
  }
  if (ws_size < WS_TOTAL) {
    fprintf(stderr, "workspace too small: %zu < %zu\n", ws_size, (size_t)WS_TOTAL);
    return;
  }
  P p{};
  const float** f = (const float**)&p;
  for (int i = 0; i < 23; ++i) f[i] = (const float*)d_in[i];
  p.out = (float*)d_out;
  p.ws = (char*)d_ws;
  hipMemsetAsync((char*)d_ws + O_BAR, 0, XCD_BAR_WORDS * 4, stream);
  void* args[] = {&p};
  hipError_t e = hipLaunchCooperativeKernel((void*)fwd_mega, dim3(grid_blocks), dim3(256), args, LDS_BYTES, stream);
  if (e != hipSuccess) fprintf(stderr, "cooperative launch failed: %s (grid %d)\n", hipGetErrorString(e), grid_blocks);
}
```

```cpp
#include <hip/hip_runtime.h>
#include <hip/hip_cooperative_groups.h>
#include <cstdio>
namespace cg = cooperative_groups;

typedef __attribute__((ext_vector_type(8))) short bf16x8;
typedef __attribute__((ext_vector_type(4))) float f32x4;
typedef unsigned short u16;
#define DEV __device__ __forceinline__

constexpr int DM = 1024, TL = 2048, TCX = 256, TS = 2304, GB = 4, GR = GB * TS, NG = 2;
constexpr int NZ = 5760, DEPTH = 4;
constexpr int C_XA = 0, C_Q = 512, C_K = 1024, C_V = 1536, C_QC = 2048, C_F0 = 2560, C_IC = 3584,
              C_GA = 4096, C_GB = 4608, C_GC = 5120, C_AB = 5632;
constexpr int NCH = GR / 64;
constexpr float EPS = 1e-6f;
constexpr int WPB = 2;

constexpr size_t al256(size_t x) { return (x + 255) & ~(size_t)255; }
constexpr size_t O_WTIN = 0;
constexpr size_t O_WTOUT = O_WTIN + al256((size_t)DEPTH * NZ * 1024 * 2);
constexpr size_t O_WGT = O_WTOUT + al256((size_t)DEPTH * 1024 * 1536 * 2);
constexpr size_t O_MOD = O_WGT + al256((size_t)DEPTH * 2 * 2 * 8 * 4096 * 2);
constexpr size_t O_LBS = O_MOD + al256((size_t)DEPTH * 9 * 3072 * 4);
constexpr size_t O_HC = O_LBS + al256((size_t)DEPTH * 1024 * 4);
constexpr size_t O_Z = O_HC + al256((size_t)GB * TCX * 1024 * 4);
constexpr size_t O_ZT = O_Z + al256((size_t)GR * NZ * 2);
constexpr size_t O_AB = O_ZT + al256((size_t)512 * GR * 2);
constexpr size_t O_BSH = O_AB + al256((size_t)GR * 16 * 4);
constexpr size_t BSH_ONE = (size_t)GR * 512 * 2;
constexpr size_t O_BIT = O_BSH + al256(4 * BSH_ONE);
constexpr size_t BIT_SZ = 17408;
constexpr size_t O_CREC = O_BIT + al256((size_t)NCH * 4 * 2 * BIT_SZ);
constexpr size_t CREC_SZ = 33280;
constexpr size_t O_OB = O_CREC + al256((size_t)NCH * 4 * 2 * CREC_SZ);
constexpr size_t O_OC = O_OB + al256((size_t)2 * GR * 512 * 2);
constexpr size_t O_AP = O_OC + al256((size_t)2 * GR * 512 * 2);
constexpr size_t O_AH = O_AP + al256((size_t)NCH * 2 * 512 * 4);
constexpr size_t O_ACAR = O_AH + al256((size_t)NCH * 2 * 512 * 4);
constexpr size_t O_ALA = O_ACAR + al256((size_t)NCH * 2 * 512 * 4);
constexpr size_t O_AU = O_ALA + al256((size_t)2 * GR * 512 * 2);
constexpr size_t O_BAR = O_AU + al256((size_t)2 * GR * 512 * 2);
constexpr size_t WS_TOTAL = O_BAR + al256(3456 * 4);

constexpr int LDS_BYTES = 73728;
#ifndef REP_A
#define REP_A 1
#endif
#ifndef REP_G
#define REP_G 1
#endif
#ifndef REP_M
#define REP_M 1
#endif

struct P {
  const float *x, *c, *ctx, *c_ctx, *w_ada, *b_ada, *norm_pre, *norm_post, *w_in, *conv_a_w, *conv_a_b, *rg_w_r,
      *rg_b_r, *rg_w_i, *rg_b_i, *rg_lam, *conv_b_w, *gdn_a_log, *gdn_dt_bias, *gdn_norm, *hg_lb, *hg_norm, *w_out;
  float* out;
  char* ws;
};

DEV int opq(int x) { asm volatile("" : "+v"(x)); return x; }
DEV int opqs(int x) { asm volatile("" : "+s"(x)); return x; }
typedef __attribute__((ext_vector_type(2))) __bf16 bf16x2_t;
typedef __attribute__((ext_vector_type(2))) float f32x2_t;
DEV u16 f2bf(float f) { __bf16 r = (__bf16)f; return __builtin_bit_cast(u16, r); }
DEV float bf2f(u16 h) { return __uint_as_float(((unsigned)h) << 16); }
DEV unsigned pk2(float a, float b) { f32x2_t v = {a, b}; bf16x2_t r = __builtin_convertvector(v, bf16x2_t); return __builtin_bit_cast(unsigned, r); }
DEV float sigm(float x) { return __builtin_amdgcn_rcpf(1.f + __expf(-x)); }
DEV float silu(float x) { return x * __builtin_amdgcn_rcpf(1.f + __expf(-x)); }
DEV float softplus(float x) { return x > 20.f ? x : log1pf(__expf(x)); }
DEV f32x4 mfma(bf16x8 a, bf16x8 b, f32x4 c) { return __builtin_amdgcn_mfma_f32_16x16x32_bf16(a, b, c, 0, 0, 0); }
DEV bf16x8 ld8(const u16* p) { return *reinterpret_cast<const bf16x8*>(p); }
DEV int lat_map(int l, int t) { return (l & 1) ? ((t & 63) * 32 + (t >> 6)) : t; }
DEV int orig_col(int n) {
  if (n < 512) return n;
  if (n < 2048) return n + 512;
  if (n < 4096) return n + 1040;
  if (n < 4608) return n - 4096 + 512;
  if (n < 5120) return n - 4608 + 2576;
  if (n < 5632) return n + 16;
  if (n < 5648) return n - 5632 + 2560;
  return -1;
}
DEV float zval(const u16* z, int rb, int cp, int n, int col) {
  if (cp < 0 && (n == 0 || n == 4)) return 0.f;
  if (cp > 63 && (n == 3 || n == 35)) return 0.f;
  return bf2f(z[(size_t)(rb + cp) * NZ + col]);
}

DEV void ph0_ada(const P& p, int item, char* smem) {
  float* sc = (float*)smem;
  float* red = (float*)(smem + 36864);
  const int tid = threadIdx.x, lane = tid & 63, wv = tid >> 6;
  for (int i = tid; i < 9 * 1024; i += 256) {
    int v = i >> 10, d = i & 1023;
    float cv = (v < 8) ? p.c[v * 1024 + d] : p.c_ctx[d];
    sc[i] = silu(cv);
  }
  __syncthreads();
  const int col = item * 64 + lane;
  const int l = col / 3072, e = col % 3072;
  const float* w = p.w_ada + (size_t)l * 1024 * 3072 + e + (size_t)(256 * wv) * 3072;
  const float* scw = sc + 256 * wv;
  float acc[9];
#pragma unroll
  for (int i = 0; i < 9; ++i) acc[i] = 0.f;
  for (int d = 0; d < 256; d += 16) {
    float wr[16];
#pragma unroll
    for (int k = 0; k < 16; ++k) wr[k] = w[(size_t)(d + k) * 3072];
#pragma unroll
    for (int k = 0; k < 16; ++k)
#pragma unroll
      for (int i = 0; i < 9; ++i) acc[i] += scw[i * 1024 + d + k] * wr[k];
  }
#pragma unroll
  for (int i = 0; i < 9; ++i) red[(wv * 9 + i) * 64 + lane] = acc[i];
  __syncthreads();
  float* mod = (float*)(p.ws + O_MOD);
  for (int idx = tid; idx < 9 * 64; idx += 256) {
    int i = idx >> 6, ln = idx & 63;
    float sum = red[(0 * 9 + i) * 64 + ln] + red[(1 * 9 + i) * 64 + ln] + red[(2 * 9 + i) * 64 + ln] + red[(3 * 9 + i) * 64 + ln];
    int cc = item * 64 + ln, l2 = cc / 3072, e2 = cc % 3072;
    mod[((size_t)l2 * 9 + i) * 3072 + e2] = sum + p.b_ada[l2 * 3072 + e2];
  }
  __syncthreads();
}
DEV void tconv_tile(const float* src, int lds_, u16* dst, int ldd, int k0, int n0, bool mapcol, char* smem) {
  float* t = (float*)smem;
  const int tid = threadIdx.x, nn = tid & 63, kq = tid >> 6;
  const int n = n0 + nn;
  const int sn0 = mapcol ? orig_col(n) : n;
  const float msk = (sn0 >= 0) ? 1.f : 0.f;
  const int sn = sn0 >= 0 ? sn0 : 0;
  float v[16];
#pragma unroll
  for (int k = 0; k < 16; ++k) v[k] = src[(size_t)(k0 + kq + 4 * k) * lds_ + sn];
#pragma unroll
  for (int k = 0; k < 16; ++k) t[(kq + 4 * k) * 65 + nn] = v[k] * msk;
  __syncthreads();
  {
    const int kk = tid & 63, nq = tid >> 6;
#pragma unroll
    for (int k = 0; k < 16; ++k) {
      int n2 = nq + 4 * k;
      dst[(size_t)(n0 + n2) * ldd + k0 + kk] = f2bf(t[kk * 65 + n2]);
    }
  }
  __syncthreads();
}
DEV void phase0(const P& p, char* smem) {
  const int n_ada = 192, n_in = DEPTH * 16 * 90, n_out = DEPTH * 24 * 16, n_g = 128, n_lb = 4;
  const int total = n_ada + n_in + n_out + n_g + n_lb;
  for (int it = blockIdx.x; it < total; it += gridDim.x) {
    int i = it;
    if (i < n_ada) { ph0_ada(p, i, smem); continue; }
    i -= n_ada;
    if (i < n_in) {
      int l = i / 1440, r = i % 1440, kt = r / 90, nt = r % 90;
      tconv_tile(p.w_in + (size_t)l * 1024 * 5648, 5648, (u16*)(p.ws + O_WTIN) + (size_t)l * NZ * 1024, 1024, kt * 64,
                 nt * 64, true, smem);
      continue;
    }
    i -= n_in;
    if (i < n_out) {
      int l = i / 384, r = i % 384, kt = r / 16, nt = r % 16;
      tconv_tile(p.w_out + (size_t)l * 1536 * 1024, 1024, (u16*)(p.ws + O_WTOUT) + (size_t)l * 1024 * 1536, 1536,
                 kt * 64, nt * 64, false, smem);
      continue;
    }
    i -= n_out;
    if (i < n_g) {
      int h = i & 7, gate = (i >> 3) & 1, dir = (i >> 4) & 1, l = i >> 5;
      const float* src = (gate ? p.rg_w_i : p.rg_w_r) + ((size_t)(l * 2 + dir) * 8 + h) * 4096;
      tconv_tile(src, 64, (u16*)(p.ws + O_WGT) + (size_t)i * 4096, 64, 0, 0, false, smem);
      continue;
    }
    i -= n_g;
    {
      int j = i * 256 + threadIdx.x;
      float v[4], mx = -1e30f;
      for (int l = 0; l < 4; ++l) { v[l] = p.hg_lb[l * 1024 + j]; mx = fmaxf(mx, v[l]); }
      float s = 0.f;
      for (int l = 0; l < 4; ++l) { v[l] = __expf(v[l] - mx); s += v[l]; }
      float* lbs = (float*)(p.ws + O_LBS);
      float cum = 0.f;
      for (int l = 0; l < 4; ++l) {
        if (l > 0) cum += v[l] / s;
        lbs[l * 1024 + j] = cum;
      }
    }
  }
}

DEV void phaseR(const P& p, int g, int l) {
  const int tid_ = opq(threadIdx.x); const int lane = tid_ & 63, w = tid_ >> 6;
  const float* mod = (const float*)(p.ws + O_MOD);
  float* hc = (float*)(p.ws + O_HC);
  const float* o = (const float*)(p.ws + O_BSH);
  u16* u = (u16*)(p.ws + O_BIT);
  for (int it = blockIdx.x; it < GR / 4; it += gridDim.x) {
    int lr = it * 4 + w;
    int lb = lr / TS, s = lr % TS;
    bool isctx = s < TCX;
    if (l == DEPTH && isctx) continue;
    int b = g * GB + lb, t = s - TCX;
    int mi = isctx ? 8 : b;
    float* hp = isctx ? hc + ((size_t)lb * TCX + s) * 1024 : p.out + ((size_t)b * TL + t) * 1024;
    float hv[16];
    if (l == 0) {
      const float* src = isctx ? p.ctx + ((size_t)b * TCX + s) * 1024 : p.x + ((size_t)b * TL + t) * 1024;
#pragma unroll
      for (int k = 0; k < 4; ++k) {
        float4 v = *(const float4*)(src + k * 256 + lane * 4);
        hv[k * 4] = v.x; hv[k * 4 + 1] = v.y; hv[k * 4 + 2] = v.z; hv[k * 4 + 3] = v.w;
      }
    } else {
      int orow = lb * TS + (isctx ? s : TCX + lat_map(l - 1, t));
      const float* op = o + (size_t)orow * 1024;
      float ov[16], ss = 0.f;
#pragma unroll
      for (int k = 0; k < 4; ++k) {
        float4 v = *(const float4*)(op + k * 256 + lane * 4);
        ov[k * 4] = v.x; ov[k * 4 + 1] = v.y; ov[k * 4 + 2] = v.z; ov[k * 4 + 3] = v.w;
        ss += v.x * v.x + v.y * v.y + v.z * v.z + v.w * v.w;
      }
#pragma unroll
      for (int off = 32; off; off >>= 1) ss += __shfl_xor(ss, off);
      float rinv = rsqrtf(ss * (1.f / 1024.f) + EPS);
      const float* gate = mod + ((size_t)(l - 1) * 9 + mi) * 3072 + 2048;
      const float* wp = p.norm_post + (l - 1) * 1024;
#pragma unroll
      for (int k = 0; k < 4; ++k) {
        float4 hh = *(const float4*)(hp + k * 256 + lane * 4);
        float4 gg = *(const float4*)(gate + k * 256 + lane * 4);
        float4 ww = *(const float4*)(wp + k * 256 + lane * 4);
        hv[k * 4] = hh.x + gg.x * (ov[k * 4] * rinv * ww.x);
        hv[k * 4 + 1] = hh.y + gg.y * (ov[k * 4 + 1] * rinv * ww.y);
        hv[k * 4 + 2] = hh.z + gg.z * (ov[k * 4 + 2] * rinv * ww.z);
        hv[k * 4 + 3] = hh.w + gg.w * (ov[k * 4 + 3] * rinv * ww.w);
      }
    }
#pragma unroll
    for (int k = 0; k < 4; ++k)
      *(float4*)(hp + k * 256 + lane * 4) = make_float4(hv[k * 4], hv[k * 4 + 1], hv[k * 4 + 2], hv[k * 4 + 3]);
    if (l < DEPTH) {
      float ss = 0.f;
#pragma unroll
      for (int k = 0; k < 16; ++k) ss += hv[k] * hv[k];
#pragma unroll
      for (int off = 32; off; off >>= 1) ss += __shfl_xor(ss, off);
      float rinv = rsqrtf(ss * (1.f / 1024.f) + EPS);
      const float* sh = mod + ((size_t)l * 9 + mi) * 3072;
      const float* wp = p.norm_pre + l * 1024;
      int urow = lb * TS + (isctx ? s : TCX + lat_map(l, t));
      u16* up = u + (size_t)urow * 1024;
#pragma unroll
      for (int k = 0; k < 4; ++k) {
        float4 ww = *(const float4*)(wp + k * 256 + lane * 4);
        float4 s0 = *(const float4*)(sh + k * 256 + lane * 4);
        float4 s1 = *(const float4*)(sh + 1024 + k * 256 + lane * 4);
        float a0 = hv[k * 4] * rinv * ww.x * (1.f + s1.x) + s0.x;
        float a1 = hv[k * 4 + 1] * rinv * ww.y * (1.f + s1.y) + s0.y;
        float a2 = hv[k * 4 + 2] * rinv * ww.z * (1.f + s1.z) + s0.z;
        float a3 = hv[k * 4 + 3] * rinv * ww.w * (1.f + s1.w) + s0.w;
        uint2 pk; pk.x = pk2(a0, a1); pk.y = pk2(a2, a3);
        *(uint2*)(up + k * 256 + lane * 4) = pk;
      }
    }
  }
}

template <int MODE>
DEV void gemm_tile(const u16* __restrict__ A, int lda, const u16* __restrict__ Bt, int K, int rt, int ct, u16* z,
                   u16* zT, float* ab, float* o, char* smem) {
  u16* As = (u16*)smem;
  u16* Bs = As + 128 * 72;
  const int tid = opq(threadIdx.x), lane = tid & 63, w = tid >> 6, wr = w >> 1, wc = w & 1, fr = lane & 15, fq = lane >> 4;
  const int lrow = tid >> 3, lseg = tid & 7;
  const u16* Ag = A + (size_t)(rt * 128 + lrow) * lda + lseg * 8;
  const u16* Bg = Bt + (size_t)(ct * 128 + lrow) * K + lseg * 8;
  uint4 pa0, pa1, pa2, pa3, pb0, pb1, pb2, pb3;
  uint4 qa0, qa1, qa2, qa3, qb0, qb1, qb2, qb3;
  f32x4 acc[4][4];
#pragma unroll
  for (int i = 0; i < 4; ++i)
#pragma unroll
    for (int j = 0; j < 4; ++j) acc[i][j] = (f32x4){0.f, 0.f, 0.f, 0.f};
  const int nk = K / 64;
#define GLD(S, kk)                                                            \
  {                                                                           \
    const int kc_ = ((kk) < nk ? (kk) : nk - 1) * 64;                         \
    S##a0 = *(const uint4*)(Ag + kc_);                                        \
    S##a1 = *(const uint4*)(Ag + kc_ + (size_t)32 * lda);                     \
    S##a2 = *(const uint4*)(Ag + kc_ + (size_t)64 * lda);                     \
    S##a3 = *(const uint4*)(Ag + kc_ + (size_t)96 * lda);                     \
    S##b0 = *(const uint4*)(Bg + kc_);                                        \
    S##b1 = *(const uint4*)(Bg + kc_ + (size_t)32 * K);                       \
    S##b2 = *(const uint4*)(Bg + kc_ + (size_t)64 * K);                       \
    S##b3 = *(const uint4*)(Bg + kc_ + (size_t)96 * K);                       \
  }
#define GST(S, bufo)                                                          \
  *(uint4*)(As + (bufo) + (lrow)*72 + lseg * 8) = S##a0;                      \
  *(uint4*)(As + (bufo) + (lrow + 32) * 72 + lseg * 8) = S##a1;               \
  *(uint4*)(As + (bufo) + (lrow + 64) * 72 + lseg * 8) = S##a2;               \
  *(uint4*)(As + (bufo) + (lrow + 96) * 72 + lseg * 8) = S##a3;               \
  *(uint4*)(Bs + (bufo) + (lrow)*72 + lseg * 8) = S##b0;                      \
  *(uint4*)(Bs + (bufo) + (lrow + 32) * 72 + lseg * 8) = S##b1;               \
  *(uint4*)(Bs + (bufo) + (lrow + 64) * 72 + lseg * 8) = S##b2;               \
  *(uint4*)(Bs + (bufo) + (lrow + 96) * 72 + lseg * 8) = S##b3;
#define GCOMP(cb)                                                                                           \
  _Pragma("unroll") for (int ks = 0; ks < 2; ++ks) {                                                        \
    bf16x8 af[4], bfr[4];                                                                                   \
    _Pragma("unroll") for (int mi = 0; mi < 4; ++mi)                                                        \
        af[mi] = ld8(As + (cb) + (wr * 64 + mi * 16 + fr) * 72 + ks * 32 + fq * 8);                         \
    _Pragma("unroll") for (int ni = 0; ni < 4; ++ni)                                                        \
        bfr[ni] = ld8(Bs + (cb) + (wc * 64 + ni * 16 + fr) * 72 + ks * 32 + fq * 8);                        \
    _Pragma("unroll") for (int mi = 0; mi < 4; ++mi)                                                        \
        _Pragma("unroll") for (int ni = 0; ni < 4; ++ni) acc[mi][ni] = mfma(af[mi], bfr[ni], acc[mi][ni]);  \
  }
  constexpr int BUF1 = 2 * 128 * 72;
  GLD(p, 0)
  GLD(q, 1)
  GST(p, 0)
  __syncthreads();
  GLD(p, 2)
  for (int kt = 0; kt < nk; kt += 2) {
    GCOMP(0)
    GST(q, BUF1)
    GLD(q, kt + 3)
    __syncthreads();
    GCOMP(BUF1)
    GST(p, 0)
    GLD(p, kt + 4)
    __syncthreads();
  }
#pragma unroll
  for (int mi = 0; mi < 4; ++mi)
#pragma unroll
    for (int ni = 0; ni < 4; ++ni) {
      int row0 = rt * 128 + wr * 64 + mi * 16 + fq * 4;
      int col = ct * 128 + wc * 64 + ni * 16 + fr;
      f32x4 v = acc[mi][ni];
      if (MODE == 1) {
#pragma unroll
        for (int r = 0; r < 4; ++r) o[(size_t)(row0 + r) * 1024 + col] = v[r];
      } else {
        if (ct >= 28 && ct < 32) {
          uint2 pk; pk.x = pk2(v[0], v[1]); pk.y = pk2(v[2], v[3]);
          *(uint2*)(zT + (size_t)(col - C_IC) * GR + row0) = pk;
        } else if (ct == 44) {
          if (col - C_AB < 16) {
#pragma unroll
            for (int r = 0; r < 4; ++r) ab[(size_t)(row0 + r) * 16 + (col - C_AB)] = v[r];
          }
        } else {
#pragma unroll
          for (int r = 0; r < 4; ++r) z[(size_t)(row0 + r) * NZ + col] = f2bf(v[r]);
        }
      }
    }
}

DEV void a_item(const P& p, int l, int item, int mode, char* smem) {
  float* xc = (float*)smem;
  u16* xcb = (u16*)(smem + 16384);
  float* av = (float*)(smem + 16384 + 9216);
  float* uv = av + 4096;
  float* segP = uv + 4096;
  float* segH = segP + 256;
  const int tid = opq(threadIdx.x), lane = tid & 63, w = tid >> 6, fr = lane & 15, fq = lane >> 4;
  const int cgk = item >> 3, hA = item & 7, n = cgk % 36, rb = cgk * 64;
  u16* z = (u16*)(p.ws + O_Z);
  {
    u16* xin = (u16*)av;
    uint4 st[3];
#pragma unroll
    for (int k = 0; k < 3; ++k) {
      int idx = tid + 256 * k, row = idx >> 3, sg = idx & 7, cp = row - 2;
      bool ok = (idx < 536) && !((cp < 0 && (n == 0 || n == 4)) || (cp > 63 && (n == 3 || n == 35)));
      st[k] = make_uint4(0u, 0u, 0u, 0u);
      if (ok) st[k] = *(const uint4*)(z + (size_t)(rb + cp) * NZ + C_XA + hA * 64 + sg * 8);
    }
    const int j = tid & 63, ch = hA * 64 + j;
    float cw0 = p.conv_a_w[(l * 4 + 0) * 512 + ch], cw1 = p.conv_a_w[(l * 4 + 1) * 512 + ch];
    float cw2 = p.conv_a_w[(l * 4 + 2) * 512 + ch], cw3 = p.conv_a_w[(l * 4 + 3) * 512 + ch];
    float cb = p.conv_a_b[l * 512 + ch];
#pragma unroll
    for (int k = 0; k < 3; ++k) {
      int idx = tid + 256 * k, row = idx >> 3, sg = idx & 7;
      if (idx < 536) *(uint4*)(xin + row * 72 + sg * 8) = st[k];
    }
    __syncthreads();
#pragma unroll
    for (int k = 0; k < 16; ++k) {
      int c = (tid >> 6) + 4 * k;
      float val = cb + cw0 * bf2f(xin[c * 72 + j]) + cw1 * bf2f(xin[(c + 1) * 72 + j]) + cw2 * bf2f(xin[(c + 2) * 72 + j]) +
                  cw3 * bf2f(xin[(c + 3) * 72 + j]);
      xc[c * 64 + j] = val;
      xcb[c * 72 + j] = f2bf(val);
    }
  }
  __syncthreads();
  float yacc[16];
#pragma unroll
  for (int k = 0; k < 16; ++k) yacc[k] = 0.f;
  const int seg = tid >> 6, sj = tid & 63, sch = hA * 64 + sj;
  for (int dir = 0; dir < 2; ++dir) {
    {
      const u16* wg = (const u16*)(p.ws + O_WGT);
      const u16* wr_ = wg + (size_t)((((l * 2 + dir) * 2 + 0) * 8 + hA)) * 4096;
      const u16* wi_ = wg + (size_t)((((l * 2 + dir) * 2 + 1) * 8 + hA)) * 4096;
      bf16x8 a0 = ld8(xcb + (16 * w + fr) * 72 + fq * 8), a1 = ld8(xcb + (16 * w + fr) * 72 + 32 + fq * 8);
#pragma unroll
      for (int nt = 0; nt < 4; ++nt) {
        f32x4 ar = {0.f, 0.f, 0.f, 0.f}, ai = {0.f, 0.f, 0.f, 0.f};
        const u16* br = wr_ + (nt * 16 + fr) * 64 + fq * 8;
        const u16* bi = wi_ + (nt * 16 + fr) * 64 + fq * 8;
        ar = mfma(a0, ld8(br), ar); ar = mfma(a1, ld8(br + 32), ar);
        ai = mfma(a0, ld8(bi), ai); ai = mfma(a1, ld8(bi + 32), ai);
        int j = nt * 16 + fr, ch = hA * 64 + j;
        float brv = p.rg_b_r[(l * 2 + dir) * 512 + ch], biv = p.rg_b_i[(l * 2 + dir) * 512 + ch];
        float sp = softplus(-p.rg_lam[(l * 2 + dir) * 512 + ch]);
#pragma unroll
        for (int r = 0; r < 4; ++r) {
          int c = 16 * w + 4 * fq + r;
          float rg = sigm(ar[r] + brv), ig = sigm(ai[r] + biv);
          float la = -8.f * rg * sp;
          float a = __expf(la);
          float t2 = 2.f * la;
          float om = (t2 > -0.02f) ? -t2 * (1.f + 0.5f * t2 * (1.f + t2 * (1.f / 3.f) * (1.f + 0.25f * t2))) : 1.f - a * a;
          float uu = sqrtf(fmaxf(om, 0.f)) * (ig * xc[c * 64 + j]);
          av[c * 64 + j] = bf2f(f2bf(la));
          uv[c * 64 + j] = bf2f(f2bf(uu));
        }
      }
    }
    __syncthreads();
    {
      float ls = 0.f, H = 0.f;
      u16* ALA = (u16*)(p.ws + O_ALA);
      u16* AU = (u16*)(p.ws + O_AU);
#pragma unroll
      for (int k = 0; k < 16; ++k) {
        int c = dir ? (16 * seg + 15 - k) : (16 * seg + k);
        float la_ = av[c * 64 + sj], u_ = uv[c * 64 + sj];
        H = __expf(la_) * H + u_;
        ls += la_;
        size_t gi = ((size_t)dir * GR + rb + c) * 512 + sch;
        ALA[gi] = f2bf(la_);
        AU[gi] = f2bf(u_);
      }
      segP[seg * 64 + sj] = __expf(ls);
      segH[seg * 64 + sj] = H;
    }
    __syncthreads();
    if (mode == 0) {
      if (seg == 0) {
        float Pc = 1.f, Hc = 0.f;
        for (int q = 0; q < 4; ++q) {
          int sg = dir ? 3 - q : q;
          Hc = segP[sg * 64 + sj] * Hc + segH[sg * 64 + sj];
          Pc *= segP[sg * 64 + sj];
        }
        size_t idx = ((size_t)cgk * 2 + dir) * 512 + sch;
        ((float*)(p.ws + O_AP))[idx] = Pc;
        ((float*)(p.ws + O_AH))[idx] = Hc;
      }
    } else {
      float st = ((const float*)(p.ws + O_ACAR))[((size_t)cgk * 2 + dir) * 512 + sch];
      int nbefore = dir ? 3 - seg : seg;
      for (int q = 0; q < nbefore; ++q) {
        int sg = dir ? 3 - q : q;
        st = segP[sg * 64 + sj] * st + segH[sg * 64 + sj];
      }
      if (dir == 0) {
#pragma unroll
        for (int k = 0; k < 16; ++k) {
          int c = 16 * seg + k;
          st = av[c * 64 + sj] * st + uv[c * 64 + sj];
          yacc[k] += st;
        }
      } else {
#pragma unroll
        for (int k = 15; k >= 0; --k) {
          int c = 16 * seg + k;
          st = av[c * 64 + sj] * st + uv[c * 64 + sj];
          yacc[k] += st;
        }
      }
    }
    __syncthreads();
  }
  if (mode == 1) {
#pragma unroll
    for (int k = 0; k < 16; ++k) {
      size_t zi = (size_t)(rb + 16 * seg + k) * NZ + C_GA + sch;
      float gate = bf2f(z[zi]);
      z[zi] = f2bf(yacc[k] * silu(gate));
    }
  }
}

DEV void a_fin(const P& p, int l, int item, char* smem) {
  float* segP = (float*)smem;
  float* segH = segP + 512;
  const int tid = opq(threadIdx.x), seg = tid >> 6, sj = tid & 63;
  const int cgk = item >> 3, hA = item & 7, rb = cgk * 64, sch = hA * 64 + sj;
  u16* z = (u16*)(p.ws + O_Z);
  const u16* ALA = (const u16*)(p.ws + O_ALA);
  const u16* AU = (const u16*)(p.ws + O_AU);
  u16 lab[2][16], ub[2][16], gt[16];
#pragma unroll
  for (int dir = 0; dir < 2; ++dir)
#pragma unroll
    for (int k = 0; k < 16; ++k) {
      size_t gi = ((size_t)dir * GR + rb + 16 * seg + k) * 512 + sch;
      lab[dir][k] = ALA[gi];
      ub[dir][k] = AU[gi];
    }
#pragma unroll
  for (int k = 0; k < 16; ++k) gt[k] = z[(size_t)(rb + 16 * seg + k) * NZ + C_GA + sch];
  float car0 = ((const float*)(p.ws + O_ACAR))[((size_t)cgk * 2 + 0) * 512 + sch];
  float car1 = ((const float*)(p.ws + O_ACAR))[((size_t)cgk * 2 + 1) * 512 + sch];
  float af[2][16];
#pragma unroll
  for (int dir = 0; dir < 2; ++dir) {
    float ls = 0.f, H = 0.f;
#pragma unroll
    for (int kk = 0; kk < 16; ++kk) {
      const int k = dir ? 15 - kk : kk;
      float la_ = bf2f(lab[dir][k]);
      float a = __expf(la_);
      af[dir][k] = a;
      H = a * H + bf2f(ub[dir][k]);
      ls += la_;
    }
    segP[(dir * 4 + seg) * 64 + sj] = __expf(ls);
    segH[(dir * 4 + seg) * 64 + sj] = H;
  }
  __syncthreads();
  float yacc[16];
#pragma unroll
  for (int k = 0; k < 16; ++k) yacc[k] = 0.f;
#pragma unroll
  for (int dir = 0; dir < 2; ++dir) {
    float st = dir ? car1 : car0;
    const int nbefore = dir ? 3 - seg : seg;
    for (int q = 0; q < nbefore; ++q) {
      int sg = dir ? 3 - q : q;
      st = segP[(dir * 4 + sg) * 64 + sj] * st + segH[(dir * 4 + sg) * 64 + sj];
    }
#pragma unroll
    for (int kk = 0; kk < 16; ++kk) {
      const int k = dir ? 15 - kk : kk;
      st = af[dir][k] * st + bf2f(ub[dir][k]);
      yacc[k] += st;
    }
  }
#pragma unroll
  for (int k = 0; k < 16; ++k)
    z[(size_t)(rb + 16 * seg + k) * NZ + C_GA + sch] = f2bf(yacc[k] * silu(bf2f(gt[k])));
  __syncthreads();
}

DEV void a_carry(const P& p, int item) {
  int t = item * 256 + threadIdx.x;
  int ch = t & 511, dir = (t >> 9) & 1, lb = t >> 10;
  const float* AP = (const float*)(p.ws + O_AP);
  const float* AH = (const float*)(p.ws + O_AH);
  float* AC = (float*)(p.ws + O_ACAR);
  float st = 0.f;
  float pv[36], hv[36];
#pragma unroll
  for (int j = 0; j < 36; ++j) {
    int n = dir ? (j < 4 ? 3 - j : 39 - j) : j;
    size_t idx = ((size_t)(lb * 36 + n) * 2 + dir) * 512 + ch;
    pv[j] = AP[idx];
    hv[j] = AH[idx];
  }
#pragma unroll
  for (int j = 0; j < 36; ++j) {
    int n = dir ? (j < 4 ? 3 - j : 39 - j) : j;
    size_t idx = ((size_t)(lb * 36 + n) * 2 + dir) * 512 + ch;
    AC[idx] = st;
    st = pv[j] * st + hv[j];
  }
}

DEV void b_local(const P& p, int l, int item, char* smem) {
  u16* qs = (u16*)smem;
  u16* ks = qs + 64 * 136;
  float* Am = (float*)(smem + 34816);
  float* gc = (float*)(smem + 34816 + 32768);
  float* bt = gc + 128;
  const int tid = opq(threadIdx.x), lane = tid & 63, w = tid >> 6, fr = lane & 15, fq = lane >> 4;
  const int cgk = item >> 2, h = item & 3, n = cgk % 36, rb = cgk * 64;
  const u16* z = (const u16*)(p.ws + O_Z);
  u16* qn = (u16*)(p.ws + O_BSH);
  u16* kn = qn + (size_t)GR * 512;
  u16* vb = kn + (size_t)GR * 512;
  u16* knT = vb + (size_t)GR * 512;
  const float* ab = (const float*)(p.ws + O_AB);
  {
    u16* Tt = (u16*)Am;
    uint4 st[5];
#define BL_TLOAD(which)                                                                                  \
  _Pragma("unroll") for (int k = 0; k < 5; ++k) {                                                        \
    int idx = tid + 256 * k, row = idx >> 4, seg = idx & 15, cp = row - 2;                               \
    bool ok = (idx < 1072) && !((cp < 0 && (n == 0 || n == 4)) || (cp > 63 && (n == 3 || n == 35)));    \
    st[k] = make_uint4(0u, 0u, 0u, 0u);                                                                  \
    if (ok) st[k] = *(const uint4*)(z + (size_t)(rb + cp) * NZ + C_Q + (which)*512 + h * 128 + seg * 8); \
  }
    BL_TLOAD(0)
#pragma unroll
    for (int which = 0; which < 3; ++which) {
#pragma unroll
      for (int k = 0; k < 5; ++k) {
        int idx = tid + 256 * k, row = idx >> 4, seg = idx & 15;
        if (idx < 1072) *(uint4*)(Tt + row * 136 + seg * 8) = st[k];
      }
      __syncthreads();
      if (which < 2) { BL_TLOAD(which + 1) }
      float cw[2][4];
#pragma unroll
      for (int hh = 0; hh < 2; ++hh)
#pragma unroll
        for (int tap = 0; tap < 4; ++tap)
          cw[hh][tap] = p.conv_b_w[(size_t)(l * 4 + tap) * 1536 + which * 512 + h * 128 + lane + 64 * hh];
#pragma unroll 4
      for (int c = w; c < 64; c += 4) {
        float v[2];
#pragma unroll
        for (int hh = 0; hh < 2; ++hh) {
          int d = lane + 64 * hh;
          float a = 0.f;
#pragma unroll
          for (int tap = 0; tap < 4; ++tap) a += cw[hh][tap] * bf2f(Tt[(c + tap) * 136 + d]);
          v[hh] = silu(a);
        }
        float rs = 1.f;
        if (which < 2) {
          float sq = v[0] * v[0] + v[1] * v[1];
#pragma unroll
          for (int off = 32; off; off >>= 1) sq += __shfl_xor(sq, off);
          rs = rsqrtf(sq + EPS) * (which == 0 ? 0.08838834764831845f : 1.f);
        }
#pragma unroll
        for (int hh = 0; hh < 2; ++hh) {
          int d = lane + 64 * hh;
          u16 ob = f2bf(v[hh] * rs);
          size_t gi = (size_t)(rb + c) * 512 + h * 128 + d;
          if (which == 0) { qs[c * 136 + d] = ob; qn[gi] = ob; }
          else if (which == 1) { ks[c * 136 + d] = ob; kn[gi] = ob; }
          else vb[gi] = ob;
        }
      }
      __syncthreads();
    }
  }
  if (w < 2) {
    int dir = w, i = lane, c = dir ? 63 - i : i;
    float al = ab[(size_t)(rb + c) * 16 + dir * 4 + h], bl = ab[(size_t)(rb + c) * 16 + 8 + dir * 4 + h];
    float g = -__expf(p.gdn_a_log[(l * 2 + dir) * 4 + h]) * softplus(al + p.gdn_dt_bias[(l * 2 + dir) * 4 + h]);
#pragma unroll
    for (int off = 1; off < 64; off <<= 1) {
      float v = __shfl_up(g, off);
      if (lane >= off) g += v;
    }
    gc[dir * 64 + i] = g;
    bt[dir * 64 + i] = sigm(bl);
  }
  __syncthreads();
  for (int idx = tid; idx < 1024; idx += 256) {
    int d = idx >> 3, c8 = idx & 7;
    uint4 pk;
    pk.x = (unsigned)ks[(c8 * 8 + 0) * 136 + d] | ((unsigned)ks[(c8 * 8 + 1) * 136 + d] << 16);
    pk.y = (unsigned)ks[(c8 * 8 + 2) * 136 + d] | ((unsigned)ks[(c8 * 8 + 3) * 136 + d] << 16);
    pk.z = (unsigned)ks[(c8 * 8 + 4) * 136 + d] | ((unsigned)ks[(c8 * 8 + 5) * 136 + d] << 16);
    pk.w = (unsigned)ks[(c8 * 8 + 6) * 136 + d] | ((unsigned)ks[(c8 * 8 + 7) * 136 + d] << 16);
    *(uint4*)(knT + ((size_t)(cgk * 4 + h) * 128 + d) * 64 + c8 * 8) = pk;
  }
  for (int dir = 0; dir < 2; ++dir) {
    char* rec = p.ws + O_BIT + ((size_t)(cgk * 4 + h) * 2 + dir) * BIT_SZ;
    u16* QKm = (u16*)rec + 4096;
    float* scal = (float*)(rec + 16384);
    int irow = 16 * w + fr, ci = dir ? 63 - irow : irow;
    bf16x8 ak[4], aq[4];
#pragma unroll
    for (int s = 0; s < 4; ++s) { ak[s] = ld8(ks + ci * 136 + 32 * s + 8 * fq); aq[s] = ld8(qs + ci * 136 + 32 * s + 8 * fq); }
#pragma unroll
    for (int nt = 0; nt < 4; ++nt) {
      int jcol = 16 * nt + fr, cj = dir ? 63 - jcol : jcol;
      f32x4 kk = {0.f, 0.f, 0.f, 0.f}, qk = {0.f, 0.f, 0.f, 0.f};
#pragma unroll
      for (int s = 0; s < 4; ++s) {
        bf16x8 b = ld8(ks + cj * 136 + 32 * s + 8 * fq);
        kk = mfma(ak[s], b, kk);
        qk = mfma(aq[s], b, qk);
      }
      float gj = gc[dir * 64 + jcol];
#pragma unroll
      for (int r = 0; r < 4; ++r) {
        int i = 16 * w + 4 * fq + r;
        float dec = (jcol <= i) ? __expf(gc[dir * 64 + i] - gj) : 0.f;
        Am[(dir * 64 + i) * 64 + jcol] = (jcol < i) ? bt[dir * 64 + i] * kk[r] * dec : 0.f;
        QKm[i * 64 + jcol] = f2bf(qk[r] * dec);
      }
    }
    if (tid < 64) {
      float gl = gc[dir * 64 + 63], gi = gc[dir * 64 + tid];
      scal[tid] = __expf(gi);
      scal[64 + tid] = bt[dir * 64 + tid];
      scal[128 + tid] = __expf(gl - gi);
      if (tid == 0) scal[192] = __expf(gl);
    }
  }
  __syncthreads();
  if (w < 2) {
    int dir = w, col = lane;
    u16* Tinv = (u16*)(p.ws + O_BIT + ((size_t)(cgk * 4 + h) * 2 + dir) * BIT_SZ);
    const float* Ad = Am + dir * 4096;
    float T[64];
#pragma unroll
    for (int i = 0; i < 64; ++i) {
      float s = (i == col) ? 1.f : 0.f;
#pragma unroll
      for (int j = 0; j < i; ++j) s -= Ad[i * 64 + j] * T[j];
      T[i] = s;
      Tinv[i * 64 + col] = f2bf(s);
      __builtin_amdgcn_sched_barrier(0);
    }
  }
  __syncthreads();
}

DEV void b_seq(const P& p, int bitem, char* smem) {
  const int tid = opq(threadIdx.x), lane = tid & 63, w = tid >> 6, fr = lane & 15, fq = lane >> 4;
  const bool active = w < WPB;
  const int item = bitem * WPB + (active ? w : 0);
  const int slice = item & 7, dir = (item >> 3) & 1, h = (item >> 4) & 3, lb = item >> 6, e0 = slice * 16;
  u16* Ss = (u16*)(smem + w * 11264);
  u16* Rs = Ss + 16 * 136;
  u16* Vsc = Rs + 16 * 72;
  u16* Vor = Vsc + 16 * 72;
  const u16* qn = (const u16*)(p.ws + O_BSH);
  const u16* kn = qn + (size_t)GR * 512;
  const u16* vb = kn + (size_t)GR * 512;
  const u16* knT = vb + (size_t)GR * 512;
  u16* OB = (u16*)(p.ws + O_OB);
  f32x4 S[8];
#pragma unroll
  for (int m = 0; m < 8; ++m) S[m] = (f32x4){0.f, 0.f, 0.f, 0.f};
  for (int j = 0; j < 36; ++j) {
    const int n = dir ? (j < 4 ? 3 - j : 39 - j) : j;
    const int cgk = lb * 36 + n, rb = cgk * 64;
    const char* rec = p.ws + O_BIT + ((size_t)(cgk * 4 + h) * 2 + dir) * BIT_SZ;
    const u16* Tinv = (const u16*)rec;
    const u16* QKm = Tinv + 4096;
    const float* scal = (const float*)(rec + 16384);
    if (active) {
#pragma unroll
      for (int m = 0; m < 8; ++m) {
        uint2 pk; pk.x = pk2(S[m][0], S[m][1]); pk.y = pk2(S[m][2], S[m][3]);
        *(uint2*)(Ss + fr * 136 + 16 * m + 4 * fq) = pk;
      }
    }
    __syncthreads();
    bf16x8 Sf[4];
    if (active) {
#pragma unroll
      for (int s = 0; s < 4; ++s) Sf[s] = ld8(Ss + fr * 136 + 32 * s + 8 * fq);
#pragma unroll
      for (int m = 0; m < 4; ++m) {
        int i = 16 * m + fr, rowi = rb + (dir ? 63 - i : i);
        f32x4 X = {0.f, 0.f, 0.f, 0.f};
#pragma unroll
        for (int s = 0; s < 4; ++s) X = mfma(ld8(kn + (size_t)rowi * 512 + h * 128 + 32 * s + 8 * fq), Sf[s], X);
        float rv[4];
#pragma unroll
        for (int r = 0; r < 4; ++r) {
          int ii = 16 * m + 4 * fq + r, rowr = rb + (dir ? 63 - ii : ii);
          float v = bf2f(vb[(size_t)rowr * 512 + h * 128 + e0 + fr]);
          rv[r] = scal[64 + ii] * (v - scal[ii] * X[r]);
        }
        uint2 pk; pk.x = pk2(rv[0], rv[1]); pk.y = pk2(rv[2], rv[3]);
        *(uint2*)(Rs + fr * 72 + 16 * m + 4 * fq) = pk;
      }
    }
    __syncthreads();
    if (active) {
      bf16x8 Rf0 = ld8(Rs + fr * 72 + 8 * fq), Rf1 = ld8(Rs + fr * 72 + 32 + 8 * fq);
#pragma unroll
      for (int m = 0; m < 4; ++m) {
        f32x4 VN = {0.f, 0.f, 0.f, 0.f};
        VN = mfma(ld8(Tinv + (16 * m + fr) * 64 + 8 * fq), Rf0, VN);
        VN = mfma(ld8(Tinv + (16 * m + fr) * 64 + 32 + 8 * fq), Rf1, VN);
        uint2 pk; pk.x = pk2(VN[0], VN[1]); pk.y = pk2(VN[2], VN[3]);
        *(uint2*)(Vsc + fr * 72 + 16 * m + 4 * fq) = pk;
        int ib = 16 * m + 4 * fq;
        float s0 = VN[0] * scal[128 + ib], s1 = VN[1] * scal[128 + ib + 1], s2 = VN[2] * scal[128 + ib + 2],
              s3 = VN[3] * scal[128 + ib + 3];
        if (dir) {
          pk.x = pk2(s3, s2); pk.y = pk2(s1, s0);
          *(uint2*)(Vor + fr * 72 + (60 - ib)) = pk;
        } else {
          pk.x = pk2(s0, s1); pk.y = pk2(s2, s3);
          *(uint2*)(Vor + fr * 72 + ib) = pk;
        }
      }
    }
    __syncthreads();
    if (active) {
      bf16x8 Vs0 = ld8(Vsc + fr * 72 + 8 * fq), Vs1 = ld8(Vsc + fr * 72 + 32 + 8 * fq);
      bf16x8 Vo0 = ld8(Vor + fr * 72 + 8 * fq), Vo1 = ld8(Vor + fr * 72 + 32 + 8 * fq);
#pragma unroll
      for (int m = 0; m < 4; ++m) {
        int i = 16 * m + fr, rowi = rb + (dir ? 63 - i : i);
        f32x4 O = {0.f, 0.f, 0.f, 0.f};
#pragma unroll
        for (int s = 0; s < 4; ++s) O = mfma(ld8(qn + (size_t)rowi * 512 + h * 128 + 32 * s + 8 * fq), Sf[s], O);
#pragma unroll
        for (int r = 0; r < 4; ++r) O[r] *= scal[16 * m + 4 * fq + r];
        O = mfma(ld8(QKm + (16 * m + fr) * 64 + 8 * fq), Vs0, O);
        O = mfma(ld8(QKm + (16 * m + fr) * 64 + 32 + 8 * fq), Vs1, O);
#pragma unroll
        for (int r = 0; r < 4; ++r) {
          int ii = 16 * m + 4 * fq + r, rowr = rb + (dir ? 63 - ii : ii);
          OB[((size_t)dir * GR + rowr) * 512 + h * 128 + e0 + fr] = f2bf(O[r]);
        }
      }
      float egl = scal[192];
#pragma unroll
      for (int m = 0; m < 8; ++m) {
        const u16* kt = knT + ((size_t)(cgk * 4 + h) * 128 + 16 * m + fr) * 64;
        f32x4 t = S[m];
#pragma unroll
        for (int r = 0; r < 4; ++r) t[r] *= egl;
        t = mfma(ld8(kt + 8 * fq), Vo0, t);
        t = mfma(ld8(kt + 32 + 8 * fq), Vo1, t);
        S[m] = t;
      }
    }
  }
  __syncthreads();
}

DEV void c_local(const P& p, int l, int item, char* smem) {
  float* bsm = (float*)smem;
  u16* Ps = (u16*)(smem + 33024);
  u16* kdt = (u16*)(smem + 33024 + 9216);
  const int tid = opq(threadIdx.x), lane = tid & 63, w = tid >> 6, fr = lane & 15, fq = lane >> 4;
  const int cgk = item >> 2, h = item & 3, rb = cgk * 64;
  const u16* z = (const u16*)(p.ws + O_Z);
  const u16* zT = (const u16*)(p.ws + O_ZT);
  u16* OC = (u16*)(p.ws + O_OC);
  const float* lbs = (const float*)(p.ws + O_LBS);
  for (int dir = 0; dir < 2; ++dir) {
    char* rec = p.ws + O_CREC + ((size_t)(cgk * 4 + h) * 2 + dir) * CREC_SZ;
    u16* QD = (u16*)rec;
    u16* KDT = QD + 8192;
    float* decv = (float*)(rec + 32768);
    const float* lbp = lbs + l * 1024 + dir * 512 + h * 128;
    const int fcol = C_F0 + dir * 512 + h * 128;
    {
      int d = tid & 127, half = tid >> 7;
      float lb_ = lbp[d], run = 0.f;
      for (int k = 0; k < 32; ++k) {
        int i = 32 * half + k, c = dir ? 63 - i : i;
        float f = bf2f(z[(size_t)(rb + c) * NZ + fcol + d]);
        float fg = lb_ + (1.f - lb_) * sigm(f);
        run += __logf(fg);
        bsm[i * 129 + d] = run;
      }
    }
    __syncthreads();
    {
      int d = tid & 127, half = tid >> 7;
      if (half) {
        float add = bsm[31 * 129 + d];
        for (int k = 0; k < 32; ++k) bsm[(32 + k) * 129 + d] += add;
      }
    }
    __syncthreads();
    for (int idx = tid; idx < 8192; idx += 256) {
      int i = idx >> 7, d = idx & 127, c = dir ? 63 - i : i;
      float b = bsm[i * 129 + d];
      float q = silu(bf2f(z[(size_t)(rb + c) * NZ + C_QC + h * 128 + d]));
      QD[i * 128 + d] = f2bf(q * __expf(b));
      float f = bf2f(z[(size_t)(rb + c) * NZ + fcol + d]);
      float k = (1.f - lbp[d]) * sigm(-f);
      kdt[d * 72 + c] = f2bf(k * __expf(bsm[63 * 129 + d] - b));
    }
    if (tid < 128) decv[tid] = __expf(bsm[63 * 129 + tid]);
    __syncthreads();
    for (int idx = tid; idx < 1024; idx += 256) {
      int d = idx >> 3, c8 = idx & 7;
      *(uint4*)(KDT + d * 64 + c8 * 8) = *(const uint4*)(kdt + d * 72 + c8 * 8);
    }
    {
      const int sj = w;
      for (int si = 0; si < 4; ++si) {
        f32x4 acc = {0.f, 0.f, 0.f, 0.f};
        if (si >= sj) {
          int it = 16 * si + fr, jt = 16 * sj + fr;
          int ci = dir ? 63 - it : it, cj = dir ? 63 - jt : jt;
#pragma unroll
          for (int s = 0; s < 4; ++s) {
            int d0 = 32 * s + 8 * fq;
            bf16x8 qv = ld8(z + (size_t)(rb + ci) * NZ + C_QC + h * 128 + d0);
            bf16x8 fv = ld8(z + (size_t)(rb + cj) * NZ + fcol + d0);
            bf16x8 af, bf;
#pragma unroll
            for (int e = 0; e < 8; ++e) {
              int d = d0 + e;
              float Bs_ = si ? bsm[(16 * si - 1) * 129 + d] : 0.f;
              float qq = silu(bf2f((u16)qv[e])) * __expf(bsm[it * 129 + d] - Bs_);
              float kk = (1.f - lbp[d]) * sigm(-bf2f((u16)fv[e])) * __expf(Bs_ - bsm[jt * 129 + d]);
              af[e] = (short)f2bf(qq);
              bf[e] = (short)f2bf(kk);
            }
            acc = mfma(af, bf, acc);
          }
        }
#pragma unroll
        for (int r = 0; r < 4; ++r) {
          int i = 16 * si + 4 * fq + r, jj = 16 * sj + fr;
          float v = (si >= sj && jj <= i) ? acc[r] : 0.f;
          Ps[i * 72 + (dir ? 63 - jj : jj)] = f2bf(v);
        }
        __builtin_amdgcn_sched_barrier(0);
      }
    }
    __syncthreads();
#pragma unroll
    for (int nt2 = 0; nt2 < 2; ++nt2) {
      int e = h * 128 + (2 * w + nt2) * 16 + fr;
      bf16x8 v0 = ld8(zT + (size_t)e * GR + rb + 8 * fq), v1 = ld8(zT + (size_t)e * GR + rb + 32 + 8 * fq);
#pragma unroll
      for (int m = 0; m < 4; ++m) {
        f32x4 O = {0.f, 0.f, 0.f, 0.f};
        O = mfma(ld8(Ps + (16 * m + fr) * 72 + 8 * fq), v0, O);
        O = mfma(ld8(Ps + (16 * m + fr) * 72 + 32 + 8 * fq), v1, O);
#pragma unroll
        for (int r = 0; r < 4; ++r) {
          int ii = 16 * m + 4 * fq + r, rowr = rb + (dir ? 63 - ii : ii);
          OC[((size_t)dir * GR + rowr) * 512 + e] = f2bf(O[r]);
        }
      }
    }
    __syncthreads();
  }
}

DEV void c_seq(const P& p, int bitem, char* smem) {
  const int tid = opq(threadIdx.x), lane = tid & 63, w = tid >> 6, fr = lane & 15, fq = lane >> 4;
  const bool active = w < WPB;
  const int item = bitem * WPB + (active ? w : 0);
  const int slice = item & 7, dir = (item >> 3) & 1, h = (item >> 4) & 3, lb = item >> 6, e0 = slice * 16;
  u16* Ss = (u16*)(smem + w * 4352);
  const u16* zT = (const u16*)(p.ws + O_ZT);
  u16* OC = (u16*)(p.ws + O_OC);
  f32x4 S[8];
#pragma unroll
  for (int m = 0; m < 8; ++m) S[m] = (f32x4){0.f, 0.f, 0.f, 0.f};
  for (int j = 0; j < 36; ++j) {
    const int n = dir ? (j < 4 ? 3 - j : 39 - j) : j;
    const int cgk = lb * 36 + n, rb = cgk * 64;
    const char* rec = p.ws + O_CREC + ((size_t)(cgk * 4 + h) * 2 + dir) * CREC_SZ;
    const u16* QD = (const u16*)rec;
    const u16* KDT = QD + 8192;
    const float* decv = (const float*)(rec + 32768);
    if (active) {
#pragma unroll
      for (int m = 0; m < 8; ++m) {
        uint2 pk; pk.x = pk2(S[m][0], S[m][1]); pk.y = pk2(S[m][2], S[m][3]);
        *(uint2*)(Ss + fr * 136 + 16 * m + 4 * fq) = pk;
      }
    }
    __syncthreads();
    if (active) {
      bf16x8 Sf[4];
#pragma unroll
      for (int s = 0; s < 4; ++s) Sf[s] = ld8(Ss + fr * 136 + 32 * s + 8 * fq);
#pragma unroll
      for (int m = 0; m < 4; ++m) {
        f32x4 O = {0.f, 0.f, 0.f, 0.f};
#pragma unroll
        for (int s = 0; s < 4; ++s) O = mfma(ld8(QD + (16 * m + fr) * 128 + 32 * s + 8 * fq), Sf[s], O);
#pragma unroll
        for (int r = 0; r < 4; ++r) {
          int ii = 16 * m + 4 * fq + r, rowr = rb + (dir ? 63 - ii : ii);
          size_t oi = ((size_t)dir * GR + rowr) * 512 + h * 128 + e0 + fr;
          OC[oi] = f2bf(bf2f(OC[oi]) + O[r]);
        }
      }
      const u16* vp = zT + (size_t)(h * 128 + e0 + fr) * GR + rb;
      bf16x8 V0 = ld8(vp + 8 * fq), V1 = ld8(vp + 32 + 8 * fq);
#pragma unroll
      for (int m = 0; m < 8; ++m) {
        f32x4 t = S[m];
#pragma unroll
        for (int r = 0; r < 4; ++r) t[r] *= decv[16 * m + 4 * fq + r];
        t = mfma(ld8(KDT + (16 * m + fr) * 64 + 8 * fq), V0, t);
        t = mfma(ld8(KDT + (16 * m + fr) * 64 + 32 + 8 * fq), V1, t);
        S[m] = t;
      }
    }
    __syncthreads();
  }
}

#define LBAR()                                              \
  do {                                                      \
    asm volatile("s_waitcnt lgkmcnt(0)" ::: "memory");      \
    __builtin_amdgcn_s_barrier();                           \
    asm volatile("" ::: "memory");                          \
  } while (0)
#define CBAR() asm volatile("" ::: "memory")

DEV void c_local2(const P& p, int l, int item, char* smem) {
  float* bsm = (float*)smem;
  u16* Fq = (u16*)(smem + 33024);
  u16* kdt = (u16*)(smem + 50432);
  u16* Ps = kdt;
  const int tid = opq(threadIdx.x), lane = tid & 63, w = tid >> 6, fr = lane & 15, fq = lane >> 4;
  const int cgk = item >> 2, h = item & 3, rb = cgk * 64;
  const u16* z = (const u16*)(p.ws + O_Z);
  const u16* zT = (const u16*)(p.ws + O_ZT);
  u16* OC = (u16*)(p.ws + O_OC);
  const float* lbs = (const float*)(p.ws + O_LBS);
  u16* zq = (u16*)(p.ws + O_Z) + (size_t)rb * NZ + C_QC + h * 128;
  {
    uint4 t4[4];
#pragma unroll
    for (int k = 0; k < 4; ++k) {
      int idx = tid + 256 * k, c = idx >> 4, seg = idx & 15;
      t4[k] = *(const uint4*)(zq + (size_t)c * NZ + seg * 8);
    }
#pragma unroll
    for (int k = 0; k < 4; ++k) {
      int idx = tid + 256 * k, c = idx >> 4, seg = idx & 15;
      unsigned wv[4] = {t4[k].x, t4[k].y, t4[k].z, t4[k].w};
#pragma unroll
      for (int q = 0; q < 4; ++q)
        wv[q] = pk2(silu(bf2f((u16)(wv[q] & 0xffff))), silu(bf2f((u16)(wv[q] >> 16))));
      *(uint4*)(zq + (size_t)c * NZ + seg * 8) = make_uint4(wv[0], wv[1], wv[2], wv[3]);
    }
  }
  __syncthreads();
  for (int dir = 0; dir < 2; ++dir) {
    char* rec = p.ws + O_CREC + ((size_t)(cgk * 4 + h) * 2 + dir) * CREC_SZ;
    u16* QD = (u16*)rec;
    u16* KDT = QD + 8192;
    float* decv = (float*)(rec + 32768);
    const float* lbp = lbs + l * 1024 + dir * 512 + h * 128;
    const int fcol = C_F0 + dir * 512 + h * 128;
    {
      uint4 t4[4];
#pragma unroll
      for (int k = 0; k < 4; ++k) {
        int idx = tid + 256 * k, c = idx >> 4, seg = idx & 15;
        t4[k] = *(const uint4*)(z + (size_t)(rb + c) * NZ + fcol + seg * 8);
      }
#pragma unroll
      for (int k = 0; k < 4; ++k) {
        int idx = tid + 256 * k, c = idx >> 4, seg = idx & 15;
        *(uint4*)(Fq + c * 136 + seg * 8) = t4[k];
      }
    }
    __syncthreads();
    {
      int d = tid & 127, half = tid >> 7;
      float lb_ = lbp[d], run = 0.f;
#pragma unroll 8
      for (int k = 0; k < 32; ++k) {
        int i = 32 * half + k, c = dir ? 63 - i : i;
        float f = bf2f(Fq[c * 136 + d]);
        float fg = lb_ + (1.f - lb_) * sigm(f);
        run += __logf(fg);
        bsm[i * 129 + d] = run;
      }
    }
    __syncthreads();
    {
      int d = tid & 127, half = tid >> 7;
      if (half) {
        float add = bsm[31 * 129 + d];
#pragma unroll 8
        for (int k = 0; k < 32; ++k) bsm[(32 + k) * 129 + d] += add;
      }
    }
    __syncthreads();
    {
      uint4 qv[4];
#pragma unroll
      for (int k = 0; k < 4; ++k) {
        int idx = tid + 256 * k, c = idx >> 4, seg = idx & 15;
        qv[k] = *(const uint4*)(zq + (size_t)c * NZ + seg * 8);
      }
#pragma unroll
      for (int k = 0; k < 4; ++k) {
        int idx = tid + 256 * k, c = idx >> 4, seg = idx & 15, i = dir ? 63 - c : c, d0 = seg * 8;
        unsigned qw[4] = {qv[k].x, qv[k].y, qv[k].z, qv[k].w};
        uint4 fv4 = *(const uint4*)(Fq + c * 136 + d0);
        unsigned fw[4] = {fv4.x, fv4.y, fv4.z, fv4.w};
        unsigned qo[4], ko[4];
#pragma unroll
        for (int q = 0; q < 4; ++q) {
          int d = d0 + 2 * q;
          float b0 = bsm[i * 129 + d], b1 = bsm[i * 129 + d + 1];
          float bl0 = bsm[63 * 129 + d], bl1 = bsm[63 * 129 + d + 1];
          float q0 = bf2f((u16)(qw[q] & 0xffff)), q1 = bf2f((u16)(qw[q] >> 16));
          qo[q] = pk2(q0 * __expf(b0), q1 * __expf(b1));
          float k0 = (1.f - lbp[d]) * sigm(-bf2f((u16)(fw[q] & 0xffff)));
          float k1 = (1.f - lbp[d + 1]) * sigm(-bf2f((u16)(fw[q] >> 16)));
          ko[q] = pk2(k0, k1);
          kdt[d * 72 + c] = f2bf(k0 * __expf(bl0 - b0));
          kdt[(d + 1) * 72 + c] = f2bf(k1 * __expf(bl1 - b1));
        }
        *(uint4*)(QD + i * 128 + d0) = make_uint4(qo[0], qo[1], qo[2], qo[3]);
        *(uint4*)(Fq + c * 136 + d0) = make_uint4(ko[0], ko[1], ko[2], ko[3]);
      }
      if (tid < 128) decv[tid] = __expf(bsm[63 * 129 + tid]);
    }
    __syncthreads();
    for (int idx = tid; idx < 1024; idx += 256) {
      int d = idx >> 3, c8 = idx & 7;
      *(uint4*)(KDT + d * 64 + c8 * 8) = *(const uint4*)(kdt + d * 72 + c8 * 8);
    }
    bf16x8 qf[3][4];
#pragma unroll
    for (int t = 0; t < 3; ++t) {
      int k = w + 4 * t;
      int si = k < 4 ? 3 : (k < 7 ? 2 : (k < 9 ? 1 : 0));
      int it_ = 16 * si + fr, ci_ = dir ? 63 - it_ : it_;
#pragma unroll
      for (int s = 0; s < 4; ++s) qf[t][s] = ld8(zq + (size_t)ci_ * NZ + 32 * s + 8 * fq);
    }
    __syncthreads();
    for (int idx = tid; idx < 1536; idx += 256) {
      int tl = idx >> 8, e = idx & 255, r16 = e >> 4, c16 = e & 15;
      int si = tl < 3 ? 0 : (tl < 5 ? 1 : 2);
      int sj = tl < 3 ? tl + 1 : (tl < 5 ? tl - 1 : 3);
      int jj = 16 * sj + c16;
      Ps[(16 * si + r16) * 72 + (dir ? 63 - jj : jj)] = 0;
    }
#pragma unroll
    for (int t = 0; t < 3; ++t) {
      const int k = w + 4 * t;
      if (k < 10) {
        const int si = k < 4 ? 3 : (k < 7 ? 2 : (k < 9 ? 1 : 0));
        const int sj = k - (k < 4 ? 0 : (k < 7 ? 4 : (k < 9 ? 7 : 9)));
        const int it = 16 * si + fr, jt = 16 * sj + fr, cj = dir ? 63 - jt : jt;
        const int brow = si ? (16 * si - 1) : 0;
        const float bmul = si ? 1.f : 0.f;
        f32x4 acc = {0.f, 0.f, 0.f, 0.f};
#pragma unroll
        for (int s = 0; s < 4; ++s) {
          int d0 = 32 * s + 8 * fq;
          bf16x8 fv = ld8(Fq + cj * 136 + d0);
          bf16x8 af, bf;
#pragma unroll
          for (int e = 0; e < 8; ++e) {
            int d = d0 + e;
            float Bs_ = bmul * bsm[brow * 129 + d];
            float qq = bf2f((u16)qf[t][s][e]) * __expf(bsm[it * 129 + d] - Bs_);
            float kk = bf2f((u16)fv[e]) * __expf(Bs_ - bsm[jt * 129 + d]);
            af[e] = (short)f2bf(qq);
            bf[e] = (short)f2bf(kk);
          }
          acc = mfma(af, bf, acc);
          __builtin_amdgcn_sched_barrier(0);
        }
#pragma unroll
        for (int r = 0; r < 4; ++r) {
          int i = 16 * si + 4 * fq + r, jj = 16 * sj + fr;
          float v = (jj <= i) ? acc[r] : 0.f;
          Ps[i * 72 + (dir ? 63 - jj : jj)] = f2bf(v);
        }
      }
    }
    __syncthreads();
#pragma unroll
    for (int nt2 = 0; nt2 < 2; ++nt2) {
      int e = h * 128 + (2 * w + nt2) * 16 + fr;
      bf16x8 v0 = ld8(zT + (size_t)e * GR + rb + 8 * fq), v1 = ld8(zT + (size_t)e * GR + rb + 32 + 8 * fq);
#pragma unroll
      for (int m = 0; m < 4; ++m) {
        f32x4 O = {0.f, 0.f, 0.f, 0.f};
        O = mfma(ld8(Ps + (16 * m + fr) * 72 + 8 * fq), v0, O);
        O = mfma(ld8(Ps + (16 * m + fr) * 72 + 32 + 8 * fq), v1, O);
#pragma unroll
        for (int r = 0; r < 4; ++r) {
          int ii = 16 * m + 4 * fq + r, rowr = rb + (dir ? 63 - ii : ii);
          OC[((size_t)dir * GR + rowr) * 512 + e] = f2bf(O[r]);
        }
      }
    }
    __syncthreads();
  }
}

#define LBAR()                                              \
  do {                                                      \
    asm volatile("s_waitcnt lgkmcnt(0)" ::: "memory");      \
    __builtin_amdgcn_s_barrier();                           \
    asm volatile("" ::: "memory");                          \
  } while (0)
#define CBAR() asm volatile("" ::: "memory")
#define BS_CHUNK(jj) (dir ? ((jj) < 4 ? 3 - (jj) : 39 - (jj)) : (jj))
DEV bf16x8 ldo8(const char* base, unsigned off) { return *reinterpret_cast<const bf16x8*>(base + off); }
DEV void b_seq2(const P& p, int bitem, char* smem) {
  const int tid = opq(threadIdx.x), lane = tid & 63, w = tid >> 6, fr = lane & 15, fq = lane >> 4;
  const int es = bitem & 3, dir = (bitem >> 2) & 1, h = (bitem >> 3) & 3, lb = bitem >> 5, e0 = es * 32;
  u16* Ss = (u16*)smem;
  u16* Rs = Ss + 32 * 136;
  u16* Vsc = Rs + 32 * 72;
  u16* Vor = Vsc + 32 * 72;
  const char* qnB = p.ws + O_BSH + (size_t)h * 256;
  const char* knB = qnB + BSH_ONE;
  const char* vbB = knB + BSH_ONE + (size_t)e0 * 2;
  const char* ktB = p.ws + O_BSH + 3 * BSH_ONE + (size_t)h * 16384;
  const char* recB = p.ws + O_BIT + ((size_t)h * 2 + dir) * BIT_SZ;
  char* obB = p.ws + O_OB + ((size_t)dir * GR * 512 + h * 128 + e0) * 2;
  const int mrow = 16 * w + fr, crow0 = 16 * w + 4 * fq;
  const unsigned offA = (unsigned)((dir ? 63 - mrow : mrow) * 1024 + 16 * fq);
  unsigned offR[4];
#pragma unroll
  for (int r = 0; r < 4; ++r) offR[r] = (unsigned)((dir ? 63 - (crow0 + r) : (crow0 + r)) * 1024 + fr * 2);
  const unsigned offT = (unsigned)(mrow * 128 + 16 * fq);
  const unsigned offK = (unsigned)((32 * w + fr) * 128 + 16 * fq);
  const unsigned offS = (unsigned)(16384 + crow0 * 4);
  f32x4 S[2][2];
#pragma unroll
  for (int a = 0; a < 2; ++a)
#pragma unroll
    for (int b = 0; b < 2; ++b) S[a][b] = (f32x4){0.f, 0.f, 0.f, 0.f};
  bf16x8 Akn[4], Aqn[4], At[2][2], Aqk[2][2], AkT[2][2][2];
  u16 vbv[2][4];
  float4 eg4, be4, ek4[2];
  float egl[2];
#define BS_LOAD1(cg_)                                                              \
  {                                                                                \
    const size_t ro_ = (size_t)(cg_) * 65536;                                      \
    _Pragma("unroll") for (int s = 0; s < 4; ++s) {                                \
      Akn[s] = ldo8(knB + ro_, offA + 64 * s);                                     \
      Aqn[s] = ldo8(qnB + ro_, offA + 64 * s);                                     \
    }                                                                              \
    _Pragma("unroll") for (int r = 0; r < 4; ++r) {                                \
      vbv[0][r] = *(const u16*)(vbB + ro_ + offR[r]);                              \
      vbv[1][r] = *(const u16*)(vbB + ro_ + (offR[r] + 32));                       \
    }                                                                              \
    const char* rc_ = recB + (size_t)(cg_) * (8 * BIT_SZ);                         \
    eg4 = *(const float4*)(rc_ + offS);                                            \
    be4 = *(const float4*)(rc_ + (offS + 256));                                    \
  }
#define BS_LOAD2(cg_, SS)                                                          \
  {                                                                                \
    const char* rc_ = recB + (size_t)(cg_) * (8 * BIT_SZ);                         \
    At[SS][0] = ldo8(rc_, offT); At[SS][1] = ldo8(rc_, offT + 64);                 \
    ek4[SS] = *(const float4*)(rc_ + (offS + 512));                                \
  }
#define BS_LOAD3(cg_, SS)                                                          \
  {                                                                                \
    const char* rc_ = recB + (size_t)(cg_) * (8 * BIT_SZ);                         \
    Aqk[SS][0] = ldo8(rc_, offT + 8192); Aqk[SS][1] = ldo8(rc_, offT + 8192 + 64); \
    egl[SS] = *(const float*)(rc_ + 16384 + 768);                                  \
    const char* kt_ = ktB + (size_t)(cg_) * 65536;                                 \
    AkT[SS][0][0] = ldo8(kt_, offK); AkT[SS][0][1] = ldo8(kt_, offK + 64);         \
    AkT[SS][1][0] = ldo8(kt_, offK + 2048); AkT[SS][1][1] = ldo8(kt_, offK + 2048 + 64); \
  }
  {
    const int c0 = lb * 36 + BS_CHUNK(0);
    BS_LOAD1(c0) BS_LOAD2(c0, 0) BS_LOAD3(c0, 0)
  }
  for (int j2 = 0; j2 < 36; j2 += 2)
#pragma unroll
  for (int u = 0; u < 2; ++u) {
    const int j = j2 + u;
    const int cgk = lb * 36 + BS_CHUNK(j);
    const int jn = (j + 1 < 36) ? j + 1 : j;
    const int cgn = lb * 36 + BS_CHUNK(jn);
    BS_LOAD2(cgn, u ^ 1)
    BS_LOAD3(cgn, u ^ 1)
#pragma unroll
    for (int mm = 0; mm < 2; ++mm)
#pragma unroll
      for (int nt = 0; nt < 2; ++nt) {
        uint2 pk; pk.x = pk2(S[mm][nt][0], S[mm][nt][1]); pk.y = pk2(S[mm][nt][2], S[mm][nt][3]);
        *(uint2*)(Ss + (16 * nt + fr) * 136 + 32 * w + 16 * mm + 4 * fq) = pk;
      }
    LBAR();
    f32x4 QS[2];
    {
      bf16x8 Sf[2][4];
#pragma unroll
      for (int nt = 0; nt < 2; ++nt)
#pragma unroll
        for (int s = 0; s < 4; ++s) Sf[nt][s] = ld8(Ss + (16 * nt + fr) * 136 + 32 * s + 8 * fq);
#pragma unroll
      for (int nt = 0; nt < 2; ++nt) {
        f32x4 X = {0.f, 0.f, 0.f, 0.f}, Q = {0.f, 0.f, 0.f, 0.f};
#pragma unroll
        for (int s = 0; s < 4; ++s) { X = mfma(Akn[s], Sf[nt][s], X); Q = mfma(Aqn[s], Sf[nt][s], Q); }
        float r0 = be4.x * (bf2f(vbv[nt][0]) - eg4.x * X[0]);
        float r1 = be4.y * (bf2f(vbv[nt][1]) - eg4.y * X[1]);
        float r2 = be4.z * (bf2f(vbv[nt][2]) - eg4.z * X[2]);
        float r3 = be4.w * (bf2f(vbv[nt][3]) - eg4.w * X[3]);
        uint2 pk; pk.x = pk2(r0, r1); pk.y = pk2(r2, r3);
        *(uint2*)(Rs + (16 * nt + fr) * 72 + crow0) = pk;
        Q[0] *= eg4.x; Q[1] *= eg4.y; Q[2] *= eg4.z; Q[3] *= eg4.w;
        QS[nt] = Q;
      }
    }
    CBAR();
    BS_LOAD1(cgn)
    LBAR();
    {
#pragma unroll
      for (int nt = 0; nt < 2; ++nt) {
        bf16x8 Rf0 = ld8(Rs + (16 * nt + fr) * 72 + 8 * fq), Rf1 = ld8(Rs + (16 * nt + fr) * 72 + 32 + 8 * fq);
        f32x4 VN = {0.f, 0.f, 0.f, 0.f};
        VN = mfma(At[u][0], Rf0, VN);
        VN = mfma(At[u][1], Rf1, VN);
        uint2 pk; pk.x = pk2(VN[0], VN[1]); pk.y = pk2(VN[2], VN[3]);
        *(uint2*)(Vsc + (16 * nt + fr) * 72 + crow0) = pk;
        float s0 = VN[0] * ek4[u].x, s1 = VN[1] * ek4[u].y, s2 = VN[2] * ek4[u].z, s3 = VN[3] * ek4[u].w;
        if (dir) {
          pk.x = pk2(s3, s2); pk.y = pk2(s1, s0);
          *(uint2*)(Vor + (16 * nt + fr) * 72 + (60 - crow0)) = pk;
        } else {
          pk.x = pk2(s0, s1); pk.y = pk2(s2, s3);
          *(uint2*)(Vor + (16 * nt + fr) * 72 + crow0) = pk;
        }
      }
    }
    LBAR();
    {
      char* ob_ = obB + (size_t)cgk * 65536;
#pragma unroll
      for (int nt = 0; nt < 2; ++nt) {
        bf16x8 Vs0 = ld8(Vsc + (16 * nt + fr) * 72 + 8 * fq), Vs1 = ld8(Vsc + (16 * nt + fr) * 72 + 32 + 8 * fq);
        bf16x8 Vo0 = ld8(Vor + (16 * nt + fr) * 72 + 8 * fq), Vo1 = ld8(Vor + (16 * nt + fr) * 72 + 32 + 8 * fq);
        f32x4 O = QS[nt];
        O = mfma(Aqk[u][0], Vs0, O);
        O = mfma(Aqk[u][1], Vs1, O);
#pragma unroll
        for (int r = 0; r < 4; ++r) *(u16*)(ob_ + (offR[r] + 32 * nt)) = f2bf(O[r]);
#pragma unroll
        for (int mm = 0; mm < 2; ++mm) {
          f32x4 t = S[mm][nt];
#pragma unroll
          for (int r = 0; r < 4; ++r) t[r] *= egl[u];
          t = mfma(AkT[u][mm][0], Vo0, t);
          t = mfma(AkT[u][mm][1], Vo1, t);
          S[mm][nt] = t;
        }
      }
    }
  }
  LBAR();
}

DEV void c_seq2(const P& p, int bitem, char* smem) {
  const int tid = opq(threadIdx.x), lane = tid & 63, w = tid >> 6, fr = lane & 15, fq = lane >> 4;
  const int es = bitem & 3, dir = (bitem >> 2) & 1, h = (bitem >> 3) & 3, lb = bitem >> 5, e0 = es * 32;
  u16* Ssb = (u16*)smem;
  const char* recB = p.ws + O_CREC + ((size_t)h * 2 + dir) * CREC_SZ;
  const char* ztB = p.ws + O_ZT + (size_t)(h * 128 + e0) * GR * 2;
  char* ocB = p.ws + O_OC + ((size_t)dir * GR * 512 + h * 128 + e0) * 2;
  const int mrow = 16 * w + fr, crow0 = 16 * w + 4 * fq;
  const unsigned offQ = (unsigned)(mrow * 256 + 16 * fq);
  const unsigned offK = (unsigned)(16384 + (32 * w + fr) * 128 + 16 * fq);
  const unsigned offD = (unsigned)(32768 + (32 * w + 4 * fq) * 4);
  const unsigned offV = (unsigned)(fr * GR * 2 + 16 * fq);
  unsigned offR[4];
#pragma unroll
  for (int r = 0; r < 4; ++r) offR[r] = (unsigned)((dir ? 63 - (crow0 + r) : (crow0 + r)) * 1024 + fr * 2);
  f32x4 S[2][2];
#pragma unroll
  for (int a = 0; a < 2; ++a)
#pragma unroll
    for (int b = 0; b < 2; ++b) S[a][b] = (f32x4){0.f, 0.f, 0.f, 0.f};
  bf16x8 Aqd[4], Akd[2][2], Vf[2][2];
  u16 oi[2][4];
  float4 dec4[2];
#define CS_LOAD(cg_)                                                                    \
  {                                                                                     \
    const char* rc_ = recB + (size_t)(cg_) * (8 * CREC_SZ);                             \
    _Pragma("unroll") for (int s = 0; s < 4; ++s) Aqd[s] = ldo8(rc_, offQ + 64 * s);    \
    Akd[0][0] = ldo8(rc_, offK); Akd[0][1] = ldo8(rc_, offK + 64);                      \
    Akd[1][0] = ldo8(rc_, offK + 2048); Akd[1][1] = ldo8(rc_, offK + 2048 + 64);        \
    dec4[0] = *(const float4*)(rc_ + offD);                                             \
    dec4[1] = *(const float4*)(rc_ + (offD + 64));                                      \
    const char* zt_ = ztB + (size_t)(cg_) * 128;                                        \
    Vf[0][0] = ldo8(zt_, offV); Vf[0][1] = ldo8(zt_, offV + 64);                        \
    Vf[1][0] = ldo8(zt_, offV + 16 * GR * 2); Vf[1][1] = ldo8(zt_, offV + 16 * GR * 2 + 64); \
    const char* oc_ = ocB + (size_t)(cg_) * 65536;                                      \
    _Pragma("unroll") for (int r = 0; r < 4; ++r) {                                     \
      oi[0][r] = *(const u16*)(oc_ + offR[r]);                                          \
      oi[1][r] = *(const u16*)(oc_ + (offR[r] + 32));                                   \
    }                                                                                   \
  }
  {
    const int c0 = lb * 36 + BS_CHUNK(0);
    CS_LOAD(c0)
  }
  for (int j = 0; j < 36; ++j) {
    const int cgk = lb * 36 + BS_CHUNK(j);
    const int jn = (j + 1 < 36) ? j + 1 : j;
    const int cgn = lb * 36 + BS_CHUNK(jn);
    u16* Ss = Ssb + (j & 1) * (32 * 136);
#pragma unroll
    for (int mm = 0; mm < 2; ++mm)
#pragma unroll
      for (int nt = 0; nt < 2; ++nt) {
        uint2 pk; pk.x = pk2(S[mm][nt][0], S[mm][nt][1]); pk.y = pk2(S[mm][nt][2], S[mm][nt][3]);
        *(uint2*)(Ss + (16 * nt + fr) * 136 + 32 * w + 16 * mm + 4 * fq) = pk;
      }
    LBAR();
    char* oc_ = ocB + (size_t)cgk * 65536;
#pragma unroll
    for (int nt = 0; nt < 2; ++nt) {
      f32x4 O = {0.f, 0.f, 0.f, 0.f};
#pragma unroll
      for (int s = 0; s < 4; ++s) O = mfma(Aqd[s], ld8(Ss + (16 * nt + fr) * 136 + 32 * s + 8 * fq), O);
#pragma unroll
      for (int r = 0; r < 4; ++r) *(u16*)(oc_ + (offR[r] + 32 * nt)) = f2bf(bf2f(oi[nt][r]) + O[r]);
#pragma unroll
      for (int mm = 0; mm < 2; ++mm) {
        f32x4 t = S[mm][nt];
        t[0] *= dec4[mm].x; t[1] *= dec4[mm].y; t[2] *= dec4[mm].z; t[3] *= dec4[mm].w;
        t = mfma(Akd[mm][0], Vf[nt][0], t);
        t = mfma(Akd[mm][1], Vf[nt][1], t);
        S[mm][nt] = t;
      }
    }
    CBAR();
    CS_LOAD(cgn)
  }
  LBAR();
}

DEV void bc_merge(const P& p, int l, int it) {
  const int tid_ = opq(threadIdx.x); const int lane = tid_ & 63, w = tid_ >> 6;
  int lr = it * 4 + w;
  int mix = lane >> 5, cm = (lane * 16) & 511;
  const u16* O = (const u16*)(p.ws + (mix ? O_OC : O_OB));
  u16* z = (u16*)(p.ws + O_Z);
  float ov[16], ss = 0.f;
#pragma unroll
  for (int k2 = 0; k2 < 2; ++k2) {
    uint4 a = *(const uint4*)(O + (size_t)lr * 512 + cm + 8 * k2);
    uint4 b = *(const uint4*)(O + ((size_t)GR + lr) * 512 + cm + 8 * k2);
    unsigned aa[4] = {a.x, a.y, a.z, a.w}, bb[4] = {b.x, b.y, b.z, b.w};
#pragma unroll
    for (int q = 0; q < 4; ++q) {
      float v0 = bf2f((u16)(aa[q] & 0xffff)) + bf2f((u16)(bb[q] & 0xffff));
      float v1 = bf2f((u16)(aa[q] >> 16)) + bf2f((u16)(bb[q] >> 16));
      ov[k2 * 8 + q * 2] = v0; ov[k2 * 8 + q * 2 + 1] = v1;
      ss += v0 * v0 + v1 * v1;
    }
  }
  ss += __shfl_xor(ss, 1); ss += __shfl_xor(ss, 2); ss += __shfl_xor(ss, 4);
  float rinv = rsqrtf(ss * (1.f / 128.f) + EPS);
  const float* nw = (mix ? p.hg_norm : p.gdn_norm) + l * 128 + (cm & 127);
  u16* gp = z + (size_t)lr * NZ + (mix ? C_GC : C_GB) + cm;
#pragma unroll
  for (int k2 = 0; k2 < 2; ++k2) {
    uint4 gv = *(const uint4*)(gp + 8 * k2);
    unsigned gg[4] = {gv.x, gv.y, gv.z, gv.w}, oo[4];
#pragma unroll
    for (int q = 0; q < 4; ++q) {
      int e = k2 * 8 + q * 2;
      float y0 = ov[e] * rinv * nw[e] * silu(bf2f((u16)(gg[q] & 0xffff)));
      float y1 = ov[e + 1] * rinv * nw[e + 1] * silu(bf2f((u16)(gg[q] >> 16)));
      oo[q] = pk2(y0, y1);
    }
    *(uint4*)(gp + 8 * k2) = make_uint4(oo[0], oo[1], oo[2], oo[3]);
  }
}

#define XB_TMO      128
#define XB_XCNT(j)  (256  + 64 * (j))
#define XB_XSUB(j)  (1280 + 64 * (j))
#define XB_XGEN(j)  (2304 + 64 * (j))
#define XB_TOP      3328
#define XB_TOPGEN   3392
#define XCD_BAR_WORDS 3456
#define XB_SPIN_CAP (1u << 18)
#define LAS __attribute__((address_space(3)))

__device__ __forceinline__ unsigned xb_ld(unsigned* p)              { return __hip_atomic_load(p, __ATOMIC_RELAXED, __HIP_MEMORY_SCOPE_AGENT); }
__device__ __forceinline__ unsigned xb_add(unsigned* p, unsigned v) { return __hip_atomic_fetch_add(p, v, __ATOMIC_RELAXED, __HIP_MEMORY_SCOPE_AGENT); }
__device__ __forceinline__ unsigned xb_xcc_id() { return (unsigned)__builtin_amdgcn_s_getreg((3 << 11) | 20) & 0xFu; }
#define XB_SPIN(cond, bar) do { unsigned _sp = 0; while (cond) { __builtin_amdgcn_s_sleep(1); \
    if ((++_sp & 255u) == 0u) { if (xb_ld(&(bar)[XB_TMO])) break; if (_sp > XB_SPIN_CAP) { atomicAdd(&(bar)[XB_TMO], 1u); break; } } } } while (0)

struct XcdBarrier {
    unsigned* bar; unsigned x;
    volatile LAS unsigned* st;
};

__device__ __forceinline__ XcdBarrier xcd_barrier_post(unsigned* bar, volatile LAS unsigned* st) {
    XcdBarrier b; b.bar = bar; b.x = xb_xcc_id(); b.st = st;
    if (threadIdx.x == 0) (void)xb_add(&bar[XB_XCNT(b.x)], 1u);
    return b;
}
__device__ __forceinline__ void xcd_barrier_complete(unsigned* bar, unsigned x, unsigned& nloc, unsigned& nx) {
    const unsigned G = gridDim.x * gridDim.y * gridDim.z;
    unsigned sum, cnt, mine, sp = 0u;
    for (;;) {
        sum = 0u; cnt = 0u; mine = 0u;
#pragma unroll
        for (unsigned j = 0; j < 16; ++j) { const unsigned c = xb_ld(&bar[XB_XCNT(j)]); sum += c; cnt += (c > 0u) ? 1u : 0u; mine = (j == x) ? c : mine; }
        if (sum == G) break;
        __builtin_amdgcn_s_sleep(1);
        if ((++sp & 255u) == 0u) { if (xb_ld(&bar[XB_TMO])) break; if (sp > XB_SPIN_CAP) { atomicAdd(&bar[XB_TMO], 1u); break; } }
    }
    nloc = mine > 0u ? mine : 1u; nx = cnt > 0u ? cnt : 1u;
}

__device__ __forceinline__ void xcd_barrier(const XcdBarrier& b) {
    asm volatile("s_waitcnt vmcnt(0)" ::: "memory");
    __syncthreads();
    if (threadIdx.x == 0) {
        unsigned* bar = b.bar;
        __builtin_amdgcn_s_waitcnt(0);
        unsigned nloc = b.st[0], nx = b.st[1];
        if (nloc == 0u) { xcd_barrier_complete(bar, b.x, nloc, nx); b.st[0] = nloc; b.st[1] = nx; }
        const unsigned old = xb_add(&bar[XB_XSUB(b.x)], 1u);
        const unsigned gen = old / nloc;
        if (old + 1u == (gen + 1u) * nloc) {
            __builtin_amdgcn_fence(__ATOMIC_RELEASE, "agent");
            asm volatile("s_waitcnt vmcnt(0)" ::: "memory");
            const unsigned og = xb_add(&bar[XB_TOP], 1u);
            const unsigned tg = og / nx;
            if (og + 1u == (tg + 1u) * nx) xb_add(&bar[XB_TOPGEN], 1u);
            else XB_SPIN(xb_ld(&bar[XB_TOPGEN]) == tg, bar);
            __builtin_amdgcn_fence(__ATOMIC_ACQUIRE, "agent");
            xb_add(&bar[XB_XGEN(b.x)], 1u);
            asm volatile("s_waitcnt vmcnt(0)" ::: "memory");
        } else {
            XB_SPIN(xb_ld(&bar[XB_XGEN(b.x)]) == gen, bar);
            __builtin_amdgcn_fence(__ATOMIC_ACQUIRE, "agent");
            asm volatile("s_waitcnt vmcnt(0)" ::: "memory");
        }
    }
    __syncthreads();
}


#ifdef NO_G0
#define XG0(x)
#else
#define XG0(x) x
#endif
#ifdef NO_G1
#define XG1(x)
#else
#define XG1(x) x
#endif
#ifdef NO_BC
#define XBC(x)
#else
#define XBC(x) x
#endif
#ifdef NO_AC
#define XAC(x)
#else
#define XAC(x) x
#endif
#ifdef NO_P0
#define XP0(x)
#else
#define XP0(x) x
#endif
#ifdef NO_R
#define XR(x)
#else
#define XR(x) x
#endif
#ifdef NO_BL
#define XBL(x)
#else
#define XBL(x) x
#endif
#ifdef NO_CL
#define XCL(x)
#else
#define XCL(x) x
#endif
#ifdef NO_A0
#define XA0(x)
#else
#define XA0(x) x
#endif
#ifdef NO_A1
#define XA1(x)
#else
#define XA1(x) x
#endif
#ifdef NO_BS
#define XBS(x)
#else
#define XBS(x) x
#endif
#ifdef NO_CS
#define XCS(x)
#else
#define XCS(x) x
#endif
__global__ void __launch_bounds__(256, 2) fwd_mega(P p) {
  extern __shared__ __attribute__((aligned(16))) char smem[];
  cg::grid_group grid = cg::this_grid();
  const int G = gridDim.x;
  __shared__ uint4 xb_words;
  if (threadIdx.x == 0) xb_words = make_uint4(0u, 0u, 0u, 0u);
  __syncthreads();
  XcdBarrier xb = xcd_barrier_post((unsigned*)(p.ws + O_BAR), (volatile LAS unsigned*)&xb_words);
  XP0(phase0(p, smem));
  grid.sync();
  u16* z = (u16*)(p.ws + O_Z);
  u16* zT = (u16*)(p.ws + O_ZT);
  float* ab = (float*)(p.ws + O_AB);
  float* o = (float*)(p.ws + O_BSH);
  const u16* u = (const u16*)(p.ws + O_BIT);
  for (int g = 0; g < NG; ++g) {
    XR(phaseR(p, g, 0));
    xcd_barrier(xb);
    for (int l = 0; l < DEPTH; ++l) {
      for (int rep = 0; rep < REP_G; ++rep) {
        const u16* Bt = (const u16*)(p.ws + O_WTIN) + (size_t)l * NZ * 1024;
        if ((G & 7) == 0) {
          const int x = blockIdx.x & 7, bl = blockIdx.x >> 3, nbl = G >> 3;
          for (int q = bl; q < 9 * 45; q += nbl) { XG0(gemm_tile<0>(u, 1024, Bt, 1024, 9 * x + q % 9, q / 9, z, zT, ab, o, smem)); }
        } else {
          for (int t = blockIdx.x; t < 72 * 45; t += G) { XG0(gemm_tile<0>(u, 1024, Bt, 1024, t % 72, t / 72, z, zT, ab, o, smem)); }
        }
      }
      xcd_barrier(xb);
      for (int rep2 = 0; rep2 < REP_M; ++rep2) {
      for (int rep3 = 0; rep3 < REP_A; ++rep3) {
        if (rep3) xcd_barrier(xb);
        const int nb = NCH * 4, nc = NCH * 4, na = NCH * 8;
        for (int t = blockIdx.x; t < nb + nc + na; t += G) {
          if (t < nc) { XCL(c_local2(p, l, t, smem)); }
          else if (t < nb + nc) { XBL(b_local(p, l, t - nc, smem)); }
          else { XA0(a_item(p, l, t - nb - nc, 0, smem)); }
        }
      }
      xcd_barrier(xb);
      {
        for (int t = blockIdx.x; t < 256 + 16; t += G) {
          if (t < 128) { XBS(b_seq2(p, t, smem)); }
          else if (t < 256) { XCS(c_seq2(p, t - 128, smem)); }
          else { XAC(a_carry(p, t - 256)); }
        }
      }
      xcd_barrier(xb);
      }
      {
        const int na = NCH * 8, nm = GR / 4;
        for (int t = blockIdx.x; t < na + nm; t += G) {
          if (t < na) { XA1(a_fin(p, l, t, smem)); }
          else { XBC(bc_merge(p, l, t - na)); }
        }
      }
      xcd_barrier(xb);
      for (int rep = 0; rep < REP_G; ++rep) {
        const u16* Bt = (const u16*)(p.ws + O_WTOUT) + (size_t)l * 1024 * 1536;
        for (int t = blockIdx.x; t < 72 * 8; t += G) { XG1(gemm_tile<1>(z + C_GA, NZ, Bt, 1536, t % 72, t / 72, z, zT, ab, o, smem)); }
      }
      xcd_barrier(xb);
      XR(phaseR(p, g, l + 1));
      xcd_barrier(xb);
    }
  }
}

extern "C" void kernel_launch(void* const* d_in, const int* in_sizes, int n_in, void* d_out, int out_size, void* d_ws,
                              size_t ws_size, hipStream_t stream) {
  static int grid_blocks = 0;
  if (!grid_blocks) {
    int dev = 0, cus = 0, per_cu = 0;
    hipGetDevice(&dev);
    hipDeviceGetAttribute(&cus, hipDeviceAttributeMultiprocessorCount, dev);
    hipFuncSetAttribute((const void*)fwd_mega, hipFuncAttributeMaxDynamicSharedMemorySize, LDS_BYTES);
    hipOccupancyMaxActiveBlocksPerMultiprocessor(&per_cu, fwd_mega, 256, LDS_BYTES);
    if (per_cu > 2) per_cu = 2;
    if (per_cu < 1) per_cu = 1;
    grid_blocks = cus * per_cu;
  }
  if (ws_size < WS_TOTAL) {
    fprintf(stderr, "workspace too small: %zu < %zu\n", ws_size, (size_t)WS_TOTAL);
    return;
  }
  P p{};
  const float** f = (const float**)&p;
  for (int i = 0; i < 23; ++i) f[i] = (const float*)d_in[i];
  p.out = (float*)d_out;
  p.ws = (char*)d_ws;
  hipMemsetAsync((char*)d_ws + O_BAR, 0, XCD_BAR_WORDS * 4, stream);
  void* args[] = {&p};
  hipError_t e = hipLaunchCooperativeKernel((void*)fwd_mega, dim3(grid_blocks), dim3(256), args, LDS_BYTES, stream);
  if (e != hipSuccess) fprintf(stderr, "cooperative launch failed: %s (grid %d)\n", hipGetErrorString(e), grid_blocks);
}
```

```cpp
#include <hip/hip_runtime.h>
#include <hip/hip_cooperative_groups.h>
#include <cstdio>
namespace cg = cooperative_groups;

typedef __attribute__((ext_vector_type(8))) short bf16x8;
typedef __attribute__((ext_vector_type(4))) float f32x4;
typedef unsigned short u16;
#define DEV __device__ __forceinline__

constexpr int DM = 1024, TL = 2048, TCX = 256, TS = 2304, GB = 4, GR = GB * TS, NG = 2;
constexpr int NZ = 5760, DEPTH = 4;
constexpr int C_XA = 0, C_Q = 512, C_K = 1024, C_V = 1536, C_QC = 2048, C_F0 = 2560, C_IC = 3584,
              C_GA = 4096, C_GB = 4608, C_GC = 5120, C_AB = 5632;
constexpr int NCH = GR / 64;
constexpr float EPS = 1e-6f;
constexpr int WPB = 2;

constexpr size_t al256(size_t x) { return (x + 255) & ~(size_t)255; }
constexpr size_t O_WTIN = 0;
constexpr size_t O_WTOUT = O_WTIN + al256((size_t)DEPTH * NZ * 1024 * 2);
constexpr size_t O_WGT = O_WTOUT + al256((size_t)DEPTH * 1024 * 1536 * 2);
constexpr size_t O_MOD = O_WGT + al256((size_t)DEPTH * 2 * 2 * 8 * 4096 * 2);
constexpr size_t O_LBS = O_MOD + al256((size_t)DEPTH * 9 * 3072 * 4);
constexpr size_t O_HC = O_LBS + al256((size_t)DEPTH * 1024 * 4);
constexpr size_t O_Z = O_HC + al256((size_t)GB * TCX * 1024 * 4);
constexpr size_t O_ZT = O_Z + al256((size_t)GR * NZ * 2);
constexpr size_t O_AB = O_ZT + al256((size_t)512 * GR * 2);
constexpr size_t O_BSH = O_AB + al256((size_t)GR * 16 * 4);
constexpr size_t BSH_ONE = (size_t)GR * 512 * 2;
constexpr size_t O_BIT = O_BSH + al256(4 * BSH_ONE);
constexpr size_t BIT_SZ = 17408;
constexpr size_t O_CREC = O_BIT + al256((size_t)NCH * 4 * 2 * BIT_SZ);
constexpr size_t CREC_SZ = 33280;
constexpr size_t O_OB = O_CREC + al256((size_t)NCH * 4 * 2 * CREC_SZ);
constexpr size_t O_OC = O_OB + al256((size_t)2 * GR * 512 * 2);
constexpr size_t O_AP = O_OC + al256((size_t)2 * GR * 512 * 2);
constexpr size_t O_AH = O_AP + al256((size_t)NCH * 2 * 512 * 4);
constexpr size_t O_ACAR = O_AH + al256((size_t)NCH * 2 * 512 * 4);
constexpr size_t O_ALA = O_ACAR + al256((size_t)NCH * 2 * 512 * 4);
constexpr size_t O_AU = O_ALA + al256((size_t)2 * GR * 512 * 2);
constexpr size_t O_BAR = O_AU + al256((size_t)2 * GR * 512 * 2);
constexpr size_t WS_TOTAL = O_BAR + al256(3456 * 4);

constexpr int LDS_BYTES = 73728;
#ifndef REP_A
#define REP_A 1
#endif
#ifndef REP_G
#define REP_G 1
#endif
#ifndef REP_M
#define REP_M 1
#endif

struct P {
  const float *x, *c, *ctx, *c_ctx, *w_ada, *b_ada, *norm_pre, *norm_post, *w_in, *conv_a_w, *conv_a_b, *rg_w_r,
      *rg_b_r, *rg_w_i, *rg_b_i, *rg_lam, *conv_b_w, *gdn_a_log, *gdn_dt_bias, *gdn_norm, *hg_lb, *hg_norm, *w_out;
  float* out;
  char* ws;
};

DEV int opq(int x) { asm volatile("" : "+v"(x)); return x; }
DEV int opqs(int x) { asm volatile("" : "+s"(x)); return x; }
typedef __attribute__((ext_vector_type(2))) __bf16 bf16x2_t;
typedef __attribute__((ext_vector_type(2))) float f32x2_t;
DEV u16 f2bf(float f) { __bf16 r = (__bf16)f; return __builtin_bit_cast(u16, r); }
DEV float bf2f(u16 h) { return __uint_as_float(((unsigned)h) << 16); }
DEV unsigned pk2(float a, float b) { f32x2_t v = {a, b}; bf16x2_t r = __builtin_convertvector(v, bf16x2_t); return __builtin_bit_cast(unsigned, r); }
DEV float sigm(float x) { return __builtin_amdgcn_rcpf(1.f + __expf(-x)); }
DEV float silu(float x) { return x * __builtin_amdgcn_rcpf(1.f + __expf(-x)); }
DEV float softplus(float x) { return x > 20.f ? x : log1pf(__expf(x)); }
DEV f32x4 mfma(bf16x8 a, bf16x8 b, f32x4 c) { return __builtin_amdgcn_mfma_f32_16x16x32_bf16(a, b, c, 0, 0, 0); }
DEV bf16x8 ld8(const u16* p) { return *reinterpret_cast<const bf16x8*>(p); }
DEV int lat_map(int l, int t) { return (l & 1) ? ((t & 63) * 32 + (t >> 6)) : t; }
DEV int orig_col(int n) {
  if (n < 512) return n;
  if (n < 2048) return n + 512;
  if (n < 4096) return n + 1040;
  if (n < 4608) return n - 4096 + 512;
  if (n < 5120) return n - 4608 + 2576;
  if (n < 5632) return n + 16;
  if (n < 5648) return n - 5632 + 2560;
  return -1;
}
DEV float zval(const u16* z, int rb, int cp, int n, int col) {
  if (cp < 0 && (n == 0 || n == 4)) return 0.f;
  if (cp > 63 && (n == 3 || n == 35)) return 0.f;
  return bf2f(z[(size_t)(rb + cp) * NZ + col]);
}

DEV void ph0_ada(const P& p, int item, char* smem) {
  float* sc = (float*)smem;
  float* red = (float*)(smem + 36864);
  const int tid = threadIdx.x, lane = tid & 63, wv = tid >> 6;
  for (int i = tid; i < 9 * 1024; i += 256) {
    int v = i >> 10, d = i & 1023;
    float cv = (v < 8) ? p.c[v * 1024 + d] : p.c_ctx[d];
    sc[i] = silu(cv);
  }
  __syncthreads();
  const int col = item * 64 + lane;
  const int l = col / 3072, e = col % 3072;
  const float* w = p.w_ada + (size_t)l * 1024 * 3072 + e + (size_t)(256 * wv) * 3072;
  const float* scw = sc + 256 * wv;
  float acc[9];
#pragma unroll
  for (int i = 0; i < 9; ++i) acc[i] = 0.f;
  for (int d = 0; d < 256; d += 16) {
    float wr[16];
#pragma unroll
    for (int k = 0; k < 16; ++k) wr[k] = w[(size_t)(d + k) * 3072];
#pragma unroll
    for (int k = 0; k < 16; ++k)
#pragma unroll
      for (int i = 0; i < 9; ++i) acc[i] += scw[i * 1024 + d + k] * wr[k];
  }
#pragma unroll
  for (int i = 0; i < 9; ++i) red[(wv * 9 + i) * 64 + lane] = acc[i];
  __syncthreads();
  float* mod = (float*)(p.ws + O_MOD);
  for (int idx = tid; idx < 9 * 64; idx += 256) {
    int i = idx >> 6, ln = idx & 63;
    float sum = red[(0 * 9 + i) * 64 + ln] + red[(1 * 9 + i) * 64 + ln] + red[(2 * 9 + i) * 64 + ln] + red[(3 * 9 + i) * 64 + ln];
    int cc = item * 64 + ln, l2 = cc / 3072, e2 = cc % 3072;
    mod[((size_t)l2 * 9 + i) * 3072 + e2] = sum + p.b_ada[l2 * 3072 + e2];
  }
  __syncthreads();
}
DEV void tconv_tile(const float* src, int lds_, u16* dst, int ldd, int k0, int n0, bool mapcol, char* smem) {
  float* t = (float*)smem;
  const int tid = threadIdx.x, nn = tid & 63, kq = tid >> 6;
  const int n = n0 + nn;
  const int sn0 = mapcol ? orig_col(n) : n;
  const float msk = (sn0 >= 0) ? 1.f : 0.f;
  const int sn = sn0 >= 0 ? sn0 : 0;
  float v[16];
#pragma unroll
  for (int k = 0; k < 16; ++k) v[k] = src[(size_t)(k0 + kq + 4 * k) * lds_ + sn];
#pragma unroll
  for (int k = 0; k < 16; ++k) t[(kq + 4 * k) * 65 + nn] = v[k] * msk;
  __syncthreads();
  {
    const int kk = tid & 63, nq = tid >> 6;
#pragma unroll
    for (int k = 0; k < 16; ++k) {
      int n2 = nq + 4 * k;
      dst[(size_t)(n0 + n2) * ldd + k0 + kk] = f2bf(t[kk * 65 + n2]);
    }
  }
  __syncthreads();
}
DEV void phase0(const P& p, char* smem) {
  const int n_ada = 192, n_in = DEPTH * 16 * 90, n_out = DEPTH * 24 * 16, n_g = 128, n_lb = 4;
  const int total = n_ada + n_in + n_out + n_g + n_lb;
  for (int it = blockIdx.x; it < total; it += gridDim.x) {
    int i = it;
    if (i < n_ada) { ph0_ada(p, i, smem); continue; }
    i -= n_ada;
    if (i < n_in) {
      int l = i / 1440, r = i % 1440, kt = r / 90, nt = r % 90;
      tconv_tile(p.w_in + (size_t)l * 1024 * 5648, 5648, (u16*)(p.ws + O_WTIN) + (size_t)l * NZ * 1024, 1024, kt * 64,
                 nt * 64, true, smem);
      continue;
    }
    i -= n_in;
    if (i < n_out) {
      int l = i / 384, r = i % 384, kt = r / 16, nt = r % 16;
      tconv_tile(p.w_out + (size_t)l * 1536 * 1024, 1024, (u16*)(p.ws + O_WTOUT) + (size_t)l * 1024 * 1536, 1536,
                 kt * 64, nt * 64, false, smem);
      continue;
    }
    i -= n_out;
    if (i < n_g) {
      int h = i & 7, gate = (i >> 3) & 1, dir = (i >> 4) & 1, l = i >> 5;
      const float* src = (gate ? p.rg_w_i : p.rg_w_r) + ((size_t)(l * 2 + dir) * 8 + h) * 4096;
      tconv_tile(src, 64, (u16*)(p.ws + O_WGT) + (size_t)i * 4096, 64, 0, 0, false, smem);
      continue;
    }
    i -= n_g;
    {
      int j = i * 256 + threadIdx.x;
      float v[4], mx = -1e30f;
      for (int l = 0; l < 4; ++l) { v[l] = p.hg_lb[l * 1024 + j]; mx = fmaxf(mx, v[l]); }
      float s = 0.f;
      for (int l = 0; l < 4; ++l) { v[l] = __expf(v[l] - mx); s += v[l]; }
      float* lbs = (float*)(p.ws + O_LBS);
      float cum = 0.f;
      for (int l = 0; l < 4; ++l) {
        if (l > 0) cum += v[l] / s;
        lbs[l * 1024 + j] = cum;
      }
    }
  }
}

DEV void phaseR(const P& p, int g, int l) {
  const int tid_ = opq(threadIdx.x); const int lane = tid_ & 63, w = tid_ >> 6;
  const float* mod = (const float*)(p.ws + O_MOD);
  float* hc = (float*)(p.ws + O_HC);
  const float* o = (const float*)(p.ws + O_BSH);
  u16* u = (u16*)(p.ws + O_BIT);
  for (int it = blockIdx.x; it < GR / 4; it += gridDim.x) {
    int lr = it * 4 + w;
    int lb = lr / TS, s = lr % TS;
    bool isctx = s < TCX;
    if (l == DEPTH && isctx) continue;
    int b = g * GB + lb, t = s - TCX;
    int mi = isctx ? 8 : b;
    float* hp = isctx ? hc + ((size_t)lb * TCX + s) * 1024 : p.out + ((size_t)b * TL + t) * 1024;
    float hv[16];
    if (l == 0) {
      const float* src = isctx ? p.ctx + ((size_t)b * TCX + s) * 1024 : p.x + ((size_t)b * TL + t) * 1024;
#pragma unroll
      for (int k = 0; k < 4; ++k) {
        float4 v = *(const float4*)(src + k * 256 + lane * 4);
        hv[k * 4] = v.x; hv[k * 4 + 1] = v.y; hv[k * 4 + 2] = v.z; hv[k * 4 + 3] = v.w;
      }
    } else {
      int orow = lb * TS + (isctx ? s : TCX + lat_map(l - 1, t));
      const float* op = o + (size_t)orow * 1024;
      float ov[16], ss = 0.f;
#pragma unroll
      for (int k = 0; k < 4; ++k) {
        float4 v = *(const float4*)(op + k * 256 + lane * 4);
        ov[k * 4] = v.x; ov[k * 4 + 1] = v.y; ov[k * 4 + 2] = v.z; ov[k * 4 + 3] = v.w;
        ss += v.x * v.x + v.y * v.y + v.z * v.z + v.w * v.w;
      }
#pragma unroll
      for (int off = 32; off; off >>= 1) ss += __shfl_xor(ss, off);
      float rinv = rsqrtf(ss * (1.f / 1024.f) + EPS);
      const float* gate = mod + ((size_t)(l - 1) * 9 + mi) * 3072 + 2048;
      const float* wp = p.norm_post + (l - 1) * 1024;
#pragma unroll
      for (int k = 0; k < 4; ++k) {
        float4 hh = *(const float4*)(hp + k * 256 + lane * 4);
        float4 gg = *(const float4*)(gate + k * 256 + lane * 4);
        float4 ww = *(const float4*)(wp + k * 256 + lane * 4);
        hv[k * 4] = hh.x + gg.x * (ov[k * 4] * rinv * ww.x);
        hv[k * 4 + 1] = hh.y + gg.y * (ov[k * 4 + 1] * rinv * ww.y);
        hv[k * 4 + 2] = hh.z + gg.z * (ov[k * 4 + 2] * rinv * ww.z);
        hv[k * 4 + 3] = hh.w + gg.w * (ov[k * 4 + 3] * rinv * ww.w);
      }
    }
#pragma unroll
    for (int k = 0; k < 4; ++k)
      *(float4*)(hp + k * 256 + lane * 4) = make_float4(hv[k * 4], hv[k * 4 + 1], hv[k * 4 + 2], hv[k * 4 + 3]);
    if (l < DEPTH) {
      float ss = 0.f;
#pragma unroll
      for (int k = 0; k < 16; ++k) ss += hv[k] * hv[k];
#pragma unroll
      for (int off = 32; off; off >>= 1) ss += __shfl_xor(ss, off);
      float rinv = rsqrtf(ss * (1.f / 1024.f) + EPS);
      const float* sh = mod + ((size_t)l * 9 + mi) * 3072;
      const float* wp = p.norm_pre + l * 1024;
      int urow = lb * TS + (isctx ? s : TCX + lat_map(l, t));
      u16* up = u + (size_t)urow * 1024;
#pragma unroll
      for (int k = 0; k < 4; ++k) {
        float4 ww = *(const float4*)(wp + k * 256 + lane * 4);
        float4 s0 = *(const float4*)(sh + k * 256 + lane * 4);
        float4 s1 = *(const float4*)(sh + 1024 + k * 256 + lane * 4);
        float a0 = hv[k * 4] * rinv * ww.x * (1.f + s1.x) + s0.x;
        float a1 = hv[k * 4 + 1] * rinv * ww.y * (1.f + s1.y) + s0.y;
        float a2 = hv[k * 4 + 2] * rinv * ww.z * (1.f + s1.z) + s0.z;
        float a3 = hv[k * 4 + 3] * rinv * ww.w * (1.f + s1.w) + s0.w;
        uint2 pk; pk.x = pk2(a0, a1); pk.y = pk2(a2, a3);
        *(uint2*)(up + k * 256 + lane * 4) = pk;
      }
    }
  }
}

template <int MODE>
DEV void gemm_tile(const u16* __restrict__ A, int lda, const u16* __restrict__ Bt, int K, int rt, int ct, u16* z,
                   u16* zT, float* ab, float* o, char* smem) {
  u16* As = (u16*)smem;
  u16* Bs = As + 128 * 72;
  const int tid = opq(threadIdx.x), lane = tid & 63, w = tid >> 6, wr = w >> 1, wc = w & 1, fr = lane & 15, fq = lane >> 4;
  const int lrow = tid >> 3, lseg = tid & 7;
  const u16* Ag = A + (size_t)(rt * 128 + lrow) * lda + lseg * 8;
  const u16* Bg = Bt + (size_t)(ct * 128 + lrow) * K + lseg * 8;
  uint4 pa0, pa1, pa2, pa3, pb0, pb1, pb2, pb3;
  uint4 qa0, qa1, qa2, qa3, qb0, qb1, qb2, qb3;
  f32x4 acc[4][4];
#pragma unroll
  for (int i = 0; i < 4; ++i)
#pragma unroll
    for (int j = 0; j < 4; ++j) acc[i][j] = (f32x4){0.f, 0.f, 0.f, 0.f};
  const int nk = K / 64;
#define GLD(S, kk)                                                            \
  {                                                                           \
    const int kc_ = ((kk) < nk ? (kk) : nk - 1) * 64;                         \
    S##a0 = *(const uint4*)(Ag + kc_);                                        \
    S##a1 = *(const uint4*)(Ag + kc_ + (size_t)32 * lda);                     \
    S##a2 = *(const uint4*)(Ag + kc_ + (size_t)64 * lda);                     \
    S##a3 = *(const uint4*)(Ag + kc_ + (size_t)96 * lda);                     \
    S##b0 = *(const uint4*)(Bg + kc_);                                        \
    S##b1 = *(const uint4*)(Bg + kc_ + (size_t)32 * K);                       \
    S##b2 = *(const uint4*)(Bg + kc_ + (size_t)64 * K);                       \
    S##b3 = *(const uint4*)(Bg + kc_ + (size_t)96 * K);                       \
  }
#define GST(S, bufo)                                                          \
  *(uint4*)(As + (bufo) + (lrow)*72 + lseg * 8) = S##a0;                      \
  *(uint4*)(As + (bufo) + (lrow + 32) * 72 + lseg * 8) = S##a1;               \
  *(uint4*)(As + (bufo) + (lrow + 64) * 72 + lseg * 8) = S##a2;               \
  *(uint4*)(As + (bufo) + (lrow + 96) * 72 + lseg * 8) = S##a3;               \
  *(uint4*)(Bs + (bufo) + (lrow)*72 + lseg * 8) = S##b0;                      \
  *(uint4*)(Bs + (bufo) + (lrow + 32) * 72 + lseg * 8) = S##b1;               \
  *(uint4*)(Bs + (bufo) + (lrow + 64) * 72 + lseg * 8) = S##b2;               \
  *(uint4*)(Bs + (bufo) + (lrow + 96) * 72 + lseg * 8) = S##b3;
#define GCOMP(cb)                                                                                           \
  _Pragma("unroll") for (int ks = 0; ks < 2; ++ks) {                                                        \
    bf16x8 af[4], bfr[4];                                                                                   \
    _Pragma("unroll") for (int mi = 0; mi < 4; ++mi)                                                        \
        af[mi] = ld8(As + (cb) + (wr * 64 + mi * 16 + fr) * 72 + ks * 32 + fq * 8);                         \
    _Pragma("unroll") for (int ni = 0; ni < 4; ++ni)                                                        \
        bfr[ni] = ld8(Bs + (cb) + (wc * 64 + ni * 16 + fr) * 72 + ks * 32 + fq * 8);                        \
    _Pragma("unroll") for (int mi = 0; mi < 4; ++mi)                                                        \
        _Pragma("unroll") for (int ni = 0; ni < 4; ++ni) acc[mi][ni] = mfma(af[mi], bfr[ni], acc[mi][ni]);  \
  }
  constexpr int BUF1 = 2 * 128 * 72;
  GLD(p, 0)
  GLD(q, 1)
  GST(p, 0)
  __syncthreads();
  GLD(p, 2)
  for (int kt = 0; kt < nk; kt += 2) {
    GCOMP(0)
    GST(q, BUF1)
    GLD(q, kt + 3)
    __syncthreads();
    GCOMP(BUF1)
    GST(p, 0)
    GLD(p, kt + 4)
    __syncthreads();
  }
#pragma unroll
  for (int mi = 0; mi < 4; ++mi)
#pragma unroll
    for (int ni = 0; ni < 4; ++ni) {
      int row0 = rt * 128 + wr * 64 + mi * 16 + fq * 4;
      int col = ct * 128 + wc * 64 + ni * 16 + fr;
      f32x4 v = acc[mi][ni];
      if (MODE == 1) {
#pragma unroll
        for (int r = 0; r < 4; ++r) o[(size_t)(row0 + r) * 1024 + col] = v[r];
      } else {
        if (ct >= 28 && ct < 32) {
          uint2 pk; pk.x = pk2(v[0], v[1]); pk.y = pk2(v[2], v[3]);
          *(uint2*)(zT + (size_t)(col - C_IC) * GR + row0) = pk;
        } else if (ct == 44) {
          if (col - C_AB < 16) {
#pragma unroll
            for (int r = 0; r < 4; ++r) ab[(size_t)(row0 + r) * 16 + (col - C_AB)] = v[r];
          }
        } else {
#pragma unroll
          for (int r = 0; r < 4; ++r) z[(size_t)(row0 + r) * NZ + col] = f2bf(v[r]);
        }
      }
    }
}

DEV void a_item(const P& p, int l, int item, int mode, char* smem) {
  float* xc = (float*)smem;
  u16* xcb = (u16*)(smem + 16384);
  float* av = (float*)(smem + 16384 + 9216);
  float* uv = av + 4096;
  float* segP = uv + 4096;
  float* segH = segP + 256;
  const int tid = opq(threadIdx.x), lane = tid & 63, w = tid >> 6, fr = lane & 15, fq = lane >> 4;
  const int cgk = item >> 3, hA = item & 7, n = cgk % 36, rb = cgk * 64;
  u16* z = (u16*)(p.ws + O_Z);
  {
    u16* xin = (u16*)av;
    uint4 st[3];
#pragma unroll
    for (int k = 0; k < 3; ++k) {
      int idx = tid + 256 * k, row = idx >> 3, sg = idx & 7, cp = row - 2;
      bool ok = (idx < 536) && !((cp < 0 && (n == 0 || n == 4)) || (cp > 63 && (n == 3 || n == 35)));
      st[k] = make_uint4(0u, 0u, 0u, 0u);
      if (ok) st[k] = *(const uint4*)(z + (size_t)(rb + cp) * NZ + C_XA + hA * 64 + sg * 8);
    }
    const int j = tid & 63, ch = hA * 64 + j;
    float cw0 = p.conv_a_w[(l * 4 + 0) * 512 + ch], cw1 = p.conv_a_w[(l * 4 + 1) * 512 + ch];
    float cw2 = p.conv_a_w[(l * 4 + 2) * 512 + ch], cw3 = p.conv_a_w[(l * 4 + 3) * 512 + ch];
    float cb = p.conv_a_b[l * 512 + ch];
#pragma unroll
    for (int k = 0; k < 3; ++k) {
      int idx = tid + 256 * k, row = idx >> 3, sg = idx & 7;
      if (idx < 536) *(uint4*)(xin + row * 72 + sg * 8) = st[k];
    }
    __syncthreads();
#pragma unroll
    for (int k = 0; k < 16; ++k) {
      int c = (tid >> 6) + 4 * k;
      float val = cb + cw0 * bf2f(xin[c * 72 + j]) + cw1 * bf2f(xin[(c + 1) * 72 + j]) + cw2 * bf2f(xin[(c + 2) * 72 + j]) +
                  cw3 * bf2f(xin[(c + 3) * 72 + j]);
      xc[c * 64 + j] = val;
      xcb[c * 72 + j] = f2bf(val);
    }
  }
  __syncthreads();
  float yacc[16];
#pragma unroll
  for (int k = 0; k < 16; ++k) yacc[k] = 0.f;
  const int seg = tid >> 6, sj = tid & 63, sch = hA * 64 + sj;
  for (int dir = 0; dir < 2; ++dir) {
    {
      const u16* wg = (const u16*)(p.ws + O_WGT);
      const u16* wr_ = wg + (size_t)((((l * 2 + dir) * 2 + 0) * 8 + hA)) * 4096;
      const u16* wi_ = wg + (size_t)((((l * 2 + dir) * 2 + 1) * 8 + hA)) * 4096;
      bf16x8 a0 = ld8(xcb + (16 * w + fr) * 72 + fq * 8), a1 = ld8(xcb + (16 * w + fr) * 72 + 32 + fq * 8);
#pragma unroll
      for (int nt = 0; nt < 4; ++nt) {
        f32x4 ar = {0.f, 0.f, 0.f, 0.f}, ai = {0.f, 0.f, 0.f, 0.f};
        const u16* br = wr_ + (nt * 16 + fr) * 64 + fq * 8;
        const u16* bi = wi_ + (nt * 16 + fr) * 64 + fq * 8;
        ar = mfma(a0, ld8(br), ar); ar = mfma(a1, ld8(br + 32), ar);
        ai = mfma(a0, ld8(bi), ai); ai = mfma(a1, ld8(bi + 32), ai);
        int j = nt * 16 + fr, ch = hA * 64 + j;
        float brv = p.rg_b_r[(l * 2 + dir) * 512 + ch], biv = p.rg_b_i[(l * 2 + dir) * 512 + ch];
        float sp = softplus(-p.rg_lam[(l * 2 + dir) * 512 + ch]);
#pragma unroll
        for (int r = 0; r < 4; ++r) {
          int c = 16 * w + 4 * fq + r;
          float rg = sigm(ar[r] + brv), ig = sigm(ai[r] + biv);
          float la = -8.f * rg * sp;
          float a = __expf(la);
          float t2 = 2.f * la;
          float om = (t2 > -0.02f) ? -t2 * (1.f + 0.5f * t2 * (1.f + t2 * (1.f / 3.f) * (1.f + 0.25f * t2))) : 1.f - a * a;
          float uu = sqrtf(fmaxf(om, 0.f)) * (ig * xc[c * 64 + j]);
          av[c * 64 + j] = bf2f(f2bf(la));
          uv[c * 64 + j] = bf2f(f2bf(uu));
        }
      }
    }
    __syncthreads();
    {
      float ls = 0.f, H = 0.f;
      u16* ALA = (u16*)(p.ws + O_ALA);
      u16* AU = (u16*)(p.ws + O_AU);
#pragma unroll
      for (int k = 0; k < 16; ++k) {
        int c = dir ? (16 * seg + 15 - k) : (16 * seg + k);
        float la_ = av[c * 64 + sj], u_ = uv[c * 64 + sj];
        H = __expf(la_) * H + u_;
        ls += la_;
        size_t gi = ((size_t)dir * GR + rb + c) * 512 + sch;
        ALA[gi] = f2bf(la_);
        AU[gi] = f2bf(u_);
      }
      segP[seg * 64 + sj] = __expf(ls);
      segH[seg * 64 + sj] = H;
    }
    __syncthreads();
    if (mode == 0) {
      if (seg == 0) {
        float Pc = 1.f, Hc = 0.f;
        for (int q = 0; q < 4; ++q) {
          int sg = dir ? 3 - q : q;
          Hc = segP[sg * 64 + sj] * Hc + segH[sg * 64 + sj];
          Pc *= segP[sg * 64 + sj];
        }
        size_t idx = ((size_t)cgk * 2 + dir) * 512 + sch;
        ((float*)(p.ws + O_AP))[idx] = Pc;
        ((float*)(p.ws + O_AH))[idx] = Hc;
      }
    } else {
      float st = ((const float*)(p.ws + O_ACAR))[((size_t)cgk * 2 + dir) * 512 + sch];
      int nbefore = dir ? 3 - seg : seg;
      for (int q = 0; q < nbefore; ++q) {
        int sg = dir ? 3 - q : q;
        st = segP[sg * 64 + sj] * st + segH[sg * 64 + sj];
      }
      if (dir == 0) {
#pragma unroll
        for (int k = 0; k < 16; ++k) {
          int c = 16 * seg + k;
          st = av[c * 64 + sj] * st + uv[c * 64 + sj];
          yacc[k] += st;
        }
      } else {
#pragma unroll
        for (int k = 15; k >= 0; --k) {
          int c = 16 * seg + k;
          st = av[c * 64 + sj] * st + uv[c * 64 + sj];
          yacc[k] += st;
        }
      }
    }
    __syncthreads();
  }
  if (mode == 1) {
#pragma unroll
    for (int k = 0; k < 16; ++k) {
      size_t zi = (size_t)(rb + 16 * seg + k) * NZ + C_GA + sch;
      float gate = bf2f(z[zi]);
      z[zi] = f2bf(yacc[k] * silu(gate));
    }
  }
}

DEV void a_fin(const P& p, int l, int item, char* smem) {
  float* segP = (float*)smem;
  float* segH = segP + 512;
  const int tid = opq(threadIdx.x), seg = tid >> 6, sj = tid & 63;
  const int cgk = item >> 3, hA = item & 7, rb = cgk * 64, sch = hA * 64 + sj;
  u16* z = (u16*)(p.ws + O_Z);
  const u16* ALA = (const u16*)(p.ws + O_ALA);
  const u16* AU = (const u16*)(p.ws + O_AU);
  u16 lab[2][16], ub[2][16], gt[16];
#pragma unroll
  for (int dir = 0; dir < 2; ++dir)
#pragma unroll
    for (int k = 0; k < 16; ++k) {
      size_t gi = ((size_t)dir * GR + rb + 16 * seg + k) * 512 + sch;
      lab[dir][k] = ALA[gi];
      ub[dir][k] = AU[gi];
    }
#pragma unroll
  for (int k = 0; k < 16; ++k) gt[k] = z[(size_t)(rb + 16 * seg + k) * NZ + C_GA + sch];
  float car0 = ((const float*)(p.ws + O_ACAR))[((size_t)cgk * 2 + 0) * 512 + sch];
  float car1 = ((const float*)(p.ws + O_ACAR))[((size_t)cgk * 2 + 1) * 512 + sch];
  float af[2][16];
#pragma unroll
  for (int dir = 0; dir < 2; ++dir) {
    float ls = 0.f, H = 0.f;
#pragma unroll
    for (int kk = 0; kk < 16; ++kk) {
      const int k = dir ? 15 - kk : kk;
      float la_ = bf2f(lab[dir][k]);
      float a = __expf(la_);
      af[dir][k] = a;
      H = a * H + bf2f(ub[dir][k]);
      ls += la_;
    }
    segP[(dir * 4 + seg) * 64 + sj] = __expf(ls);
    segH[(dir * 4 + seg) * 64 + sj] = H;
  }
  __syncthreads();
  float yacc[16];
#pragma unroll
  for (int k = 0; k < 16; ++k) yacc[k] = 0.f;
#pragma unroll
  for (int dir = 0; dir < 2; ++dir) {
    float st = dir ? car1 : car0;
    const int nbefore = dir ? 3 - seg : seg;
    for (int q = 0; q < nbefore; ++q) {
      int sg = dir ? 3 - q : q;
      st = segP[(dir * 4 + sg) * 64 + sj] * st + segH[(dir * 4 + sg) * 64 + sj];
    }
#pragma unroll
    for (int kk = 0; kk < 16; ++kk) {
      const int k = dir ? 15 - kk : kk;
      st = af[dir][k] * st + bf2f(ub[dir][k]);
      yacc[k] += st;
    }
  }
#pragma unroll
  for (int k = 0; k < 16; ++k)
    z[(size_t)(rb + 16 * seg + k) * NZ + C_GA + sch] = f2bf(yacc[k] * silu(bf2f(gt[k])));
  __syncthreads();
}

DEV void a_carry(const P& p, int item) {
  int t = item * 256 + threadIdx.x;
  int ch = t & 511, dir = (t >> 9) & 1, lb = t >> 10;
  const float* AP = (const float*)(p.ws + O_AP);
  const float* AH = (const float*)(p.ws + O_AH);
  float* AC = (float*)(p.ws + O_ACAR);
  float st = 0.f;
  float pv[36], hv[36];
#pragma unroll
  for (int j = 0; j < 36; ++j) {
    int n = dir ? (j < 4 ? 3 - j : 39 - j) : j;
    size_t idx = ((size_t)(lb * 36 + n) * 2 + dir) * 512 + ch;
    pv[j] = AP[idx];
    hv[j] = AH[idx];
  }
#pragma unroll
  for (int j = 0; j < 36; ++j) {
    int n = dir ? (j < 4 ? 3 - j : 39 - j) : j;
    size_t idx = ((size_t)(lb * 36 + n) * 2 + dir) * 512 + ch;
    AC[idx] = st;
    st = pv[j] * st + hv[j];
  }
}

DEV void b_local(const P& p, int l, int item, char* smem) {
  u16* qs = (u16*)smem;
  u16* ks = qs + 64 * 136;
  float* Am = (float*)(smem + 34816);
  float* gc = (float*)(smem + 34816 + 32768);
  float* bt = gc + 128;
  const int tid = opq(threadIdx.x), lane = tid & 63, w = tid >> 6, fr = lane & 15, fq = lane >> 4;
  const int cgk = item >> 2, h = item & 3, n = cgk % 36, rb = cgk * 64;
  const u16* z = (const u16*)(p.ws + O_Z);
  u16* qn = (u16*)(p.ws + O_BSH);
  u16* kn = qn + (size_t)GR * 512;
  u16* vb = kn + (size_t)GR * 512;
  u16* knT = vb + (size_t)GR * 512;
  const float* ab = (const float*)(p.ws + O_AB);
  {
    u16* Tt = (u16*)Am;
    uint4 st[5];
#define BL_TLOAD(which)                                                                                  \
  _Pragma("unroll") for (int k = 0; k < 5; ++k) {                                                        \
    int idx = tid + 256 * k, row = idx >> 4, seg = idx & 15, cp = row - 2;                               \
    bool ok = (idx < 1072) && !((cp < 0 && (n == 0 || n == 4)) || (cp > 63 && (n == 3 || n == 35)));    \
    st[k] = make_uint4(0u, 0u, 0u, 0u);                                                                  \
    if (ok) st[k] = *(const uint4*)(z + (size_t)(rb + cp) * NZ + C_Q + (which)*512 + h * 128 + seg * 8); \
  }
    BL_TLOAD(0)
#pragma unroll
    for (int which = 0; which < 3; ++which) {
#pragma unroll
      for (int k = 0; k < 5; ++k) {
        int idx = tid + 256 * k, row = idx >> 4, seg = idx & 15;
        if (idx < 1072) *(uint4*)(Tt + row * 136 + seg * 8) = st[k];
      }
      __syncthreads();
      if (which < 2) { BL_TLOAD(which + 1) }
      float cw[2][4];
#pragma unroll
      for (int hh = 0; hh < 2; ++hh)
#pragma unroll
        for (int tap = 0; tap < 4; ++tap)
          cw[hh][tap] = p.conv_b_w[(size_t)(l * 4 + tap) * 1536 + which * 512 + h * 128 + lane + 64 * hh];
#pragma unroll 4
      for (int c = w; c < 64; c += 4) {
        float v[2];
#pragma unroll
        for (int hh = 0; hh < 2; ++hh) {
          int d = lane + 64 * hh;
          float a = 0.f;
#pragma unroll
          for (int tap = 0; tap < 4; ++tap) a += cw[hh][tap] * bf2f(Tt[(c + tap) * 136 + d]);
          v[hh] = silu(a);
        }
        float rs = 1.f;
        if (which < 2) {
          float sq = v[0] * v[0] + v[1] * v[1];
#pragma unroll
          for (int off = 32; off; off >>= 1) sq += __shfl_xor(sq, off);
          rs = rsqrtf(sq + EPS) * (which == 0 ? 0.08838834764831845f : 1.f);
        }
#pragma unroll
        for (int hh = 0; hh < 2; ++hh) {
          int d = lane + 64 * hh;
          u16 ob = f2bf(v[hh] * rs);
          size_t gi = (size_t)(rb + c) * 512 + h * 128 + d;
          if (which == 0) { qs[c * 136 + d] = ob; qn[gi] = ob; }
          else if (which == 1) { ks[c * 136 + d] = ob; kn[gi] = ob; }
          else vb[gi] = ob;
        }
      }
      __syncthreads();
    }
  }
  if (w < 2) {
    int dir = w, i = lane, c = dir ? 63 - i : i;
    float al = ab[(size_t)(rb + c) * 16 + dir * 4 + h], bl = ab[(size_t)(rb + c) * 16 + 8 + dir * 4 + h];
    float g = -__expf(p.gdn_a_log[(l * 2 + dir) * 4 + h]) * softplus(al + p.gdn_dt_bias[(l * 2 + dir) * 4 + h]);
#pragma unroll
    for (int off = 1; off < 64; off <<= 1) {
      float v = __shfl_up(g, off);
      if (lane >= off) g += v;
    }
    gc[dir * 64 + i] = g;
    bt[dir * 64 + i] = sigm(bl);
  }
  __syncthreads();
  for (int idx = tid; idx < 1024; idx += 256) {
    int d = idx >> 3, c8 = idx & 7;
    uint4 pk;
    pk.x = (unsigned)ks[(c8 * 8 + 0) * 136 + d] | ((unsigned)ks[(c8 * 8 + 1) * 136 + d] << 16);
    pk.y = (unsigned)ks[(c8 * 8 + 2) * 136 + d] | ((unsigned)ks[(c8 * 8 + 3) * 136 + d] << 16);
    pk.z = (unsigned)ks[(c8 * 8 + 4) * 136 + d] | ((unsigned)ks[(c8 * 8 + 5) * 136 + d] << 16);
    pk.w = (unsigned)ks[(c8 * 8 + 6) * 136 + d] | ((unsigned)ks[(c8 * 8 + 7) * 136 + d] << 16);
    *(uint4*)(knT + ((size_t)(cgk * 4 + h) * 128 + d) * 64 + c8 * 8) = pk;
  }
  for (int dir = 0; dir < 2; ++dir) {
    char* rec = p.ws + O_BIT + ((size_t)(cgk * 4 + h) * 2 + dir) * BIT_SZ;
    u16* QKm = (u16*)rec + 4096;
    float* scal = (float*)(rec + 16384);
    int irow = 16 * w + fr, ci = dir ? 63 - irow : irow;
    bf16x8 ak[4], aq[4];
#pragma unroll
    for (int s = 0; s < 4; ++s) { ak[s] = ld8(ks + ci * 136 + 32 * s + 8 * fq); aq[s] = ld8(qs + ci * 136 + 32 * s + 8 * fq); }
#pragma unroll
    for (int nt = 0; nt < 4; ++nt) {
      int jcol = 16 * nt + fr, cj = dir ? 63 - jcol : jcol;
      f32x4 kk = {0.f, 0.f, 0.f, 0.f}, qk = {0.f, 0.f, 0.f, 0.f};
#pragma unroll
      for (int s = 0; s < 4; ++s) {
        bf16x8 b = ld8(ks + cj * 136 + 32 * s + 8 * fq);
        kk = mfma(ak[s], b, kk);
        qk = mfma(aq[s], b, qk);
      }
      float gj = gc[dir * 64 + jcol];
#pragma unroll
      for (int r = 0; r < 4; ++r) {
        int i = 16 * w + 4 * fq + r;
        float dec = (jcol <= i) ? __expf(gc[dir * 64 + i] - gj) : 0.f;
        Am[(dir * 64 + i) * 64 + jcol] = (jcol < i) ? bt[dir * 64 + i] * kk[r] * dec : 0.f;
        QKm[i * 64 + jcol] = f2bf(qk[r] * dec);
      }
    }
    if (tid < 64) {
      float gl = gc[dir * 64 + 63], gi = gc[dir * 64 + tid];
      scal[tid] = __expf(gi);
      scal[64 + tid] = bt[dir * 64 + tid];
      scal[128 + tid] = __expf(gl - gi);
      if (tid == 0) scal[192] = __expf(gl);
    }
  }
  __syncthreads();
  if (w < 2) {
    int dir = w, col = lane;
    u16* Tinv = (u16*)(p.ws + O_BIT + ((size_t)(cgk * 4 + h) * 2 + dir) * BIT_SZ);
    const float* Ad = Am + dir * 4096;
    float T[64];
#pragma unroll
    for (int i = 0; i < 64; ++i) {
      float s = (i == col) ? 1.f : 0.f;
#pragma unroll
      for (int j = 0; j < i; ++j) s -= Ad[i * 64 + j] * T[j];
      T[i] = s;
      Tinv[i * 64 + col] = f2bf(s);
      __builtin_amdgcn_sched_barrier(0);
    }
  }
  __syncthreads();
}

DEV void b_seq(const P& p, int bitem, char* smem) {
  const int tid = opq(threadIdx.x), lane = tid & 63, w = tid >> 6, fr = lane & 15, fq = lane >> 4;
  const bool active = w < WPB;
  const int item = bitem * WPB + (active ? w : 0);
  const int slice = item & 7, dir = (item >> 3) & 1, h = (item >> 4) & 3, lb = item >> 6, e0 = slice * 16;
  u16* Ss = (u16*)(smem + w * 11264);
  u16* Rs = Ss + 16 * 136;
  u16* Vsc = Rs + 16 * 72;
  u16* Vor = Vsc + 16 * 72;
  const u16* qn = (const u16*)(p.ws + O_BSH);
  const u16* kn = qn + (size_t)GR * 512;
  const u16* vb = kn + (size_t)GR * 512;
  const u16* knT = vb + (size_t)GR * 512;
  u16* OB = (u16*)(p.ws + O_OB);
  f32x4 S[8];
#pragma unroll
  for (int m = 0; m < 8; ++m) S[m] = (f32x4){0.f, 0.f, 0.f, 0.f};
  for (int j = 0; j < 36; ++j) {
    const int n = dir ? (j < 4 ? 3 - j : 39 - j) : j;
    const int cgk = lb * 36 + n, rb = cgk * 64;
    const char* rec = p.ws + O_BIT + ((size_t)(cgk * 4 + h) * 2 + dir) * BIT_SZ;
    const u16* Tinv = (const u16*)rec;
    const u16* QKm = Tinv + 4096;
    const float* scal = (const float*)(rec + 16384);
    if (active) {
#pragma unroll
      for (int m = 0; m < 8; ++m) {
        uint2 pk; pk.x = pk2(S[m][0], S[m][1]); pk.y = pk2(S[m][2], S[m][3]);
        *(uint2*)(Ss + fr * 136 + 16 * m + 4 * fq) = pk;
      }
    }
    __syncthreads();
    bf16x8 Sf[4];
    if (active) {
#pragma unroll
      for (int s = 0; s < 4; ++s) Sf[s] = ld8(Ss + fr * 136 + 32 * s + 8 * fq);
#pragma unroll
      for (int m = 0; m < 4; ++m) {
        int i = 16 * m + fr, rowi = rb + (dir ? 63 - i : i);
        f32x4 X = {0.f, 0.f, 0.f, 0.f};
#pragma unroll
        for (int s = 0; s < 4; ++s) X = mfma(ld8(kn + (size_t)rowi * 512 + h * 128 + 32 * s + 8 * fq), Sf[s], X);
        float rv[4];
#pragma unroll
        for (int r = 0; r < 4; ++r) {
          int ii = 16 * m + 4 * fq + r, rowr = rb + (dir ? 63 - ii : ii);
          float v = bf2f(vb[(size_t)rowr * 512 + h * 128 + e0 + fr]);
          rv[r] = scal[64 + ii] * (v - scal[ii] * X[r]);
        }
        uint2 pk; pk.x = pk2(rv[0], rv[1]); pk.y = pk2(rv[2], rv[3]);
        *(uint2*)(Rs + fr * 72 + 16 * m + 4 * fq) = pk;
      }
    }
    __syncthreads();
    if (active) {
      bf16x8 Rf0 = ld8(Rs + fr * 72 + 8 * fq), Rf1 = ld8(Rs + fr * 72 + 32 + 8 * fq);
#pragma unroll
      for (int m = 0; m < 4; ++m) {
        f32x4 VN = {0.f, 0.f, 0.f, 0.f};
        VN = mfma(ld8(Tinv + (16 * m + fr) * 64 + 8 * fq), Rf0, VN);
        VN = mfma(ld8(Tinv + (16 * m + fr) * 64 + 32 + 8 * fq), Rf1, VN);
        uint2 pk; pk.x = pk2(VN[0], VN[1]); pk.y = pk2(VN[2], VN[3]);
        *(uint2*)(Vsc + fr * 72 + 16 * m + 4 * fq) = pk;
        int ib = 16 * m + 4 * fq;
        float s0 = VN[0] * scal[128 + ib], s1 = VN[1] * scal[128 + ib + 1], s2 = VN[2] * scal[128 + ib + 2],
              s3 = VN[3] * scal[128 + ib + 3];
        if (dir) {
          pk.x = pk2(s3, s2); pk.y = pk2(s1, s0);
          *(uint2*)(Vor + fr * 72 + (60 - ib)) = pk;
        } else {
          pk.x = pk2(s0, s1); pk.y = pk2(s2, s3);
          *(uint2*)(Vor + fr * 72 + ib) = pk;
        }
      }
    }
    __syncthreads();
    if (active) {
      bf16x8 Vs0 = ld8(Vsc + fr * 72 + 8 * fq), Vs1 = ld8(Vsc + fr * 72 + 32 + 8 * fq);
      bf16x8 Vo0 = ld8(Vor + fr * 72 + 8 * fq), Vo1 = ld8(Vor + fr * 72 + 32 + 8 * fq);
#pragma unroll
      for (int m = 0; m < 4; ++m) {
        int i = 16 * m + fr, rowi = rb + (dir ? 63 - i : i);
        f32x4 O = {0.f, 0.f, 0.f, 0.f};
#pragma unroll
        for (int s = 0; s < 4; ++s) O = mfma(ld8(qn + (size_t)rowi * 512 + h * 128 + 32 * s + 8 * fq), Sf[s], O);
#pragma unroll
        for (int r = 0; r < 4; ++r) O[r] *= scal[16 * m + 4 * fq + r];
        O = mfma(ld8(QKm + (16 * m + fr) * 64 + 8 * fq), Vs0, O);
        O = mfma(ld8(QKm + (16 * m + fr) * 64 + 32 + 8 * fq), Vs1, O);
#pragma unroll
        for (int r = 0; r < 4; ++r) {
          int ii = 16 * m + 4 * fq + r, rowr = rb + (dir ? 63 - ii : ii);
          OB[((size_t)dir * GR + rowr) * 512 + h * 128 + e0 + fr] = f2bf(O[r]);
        }
      }
      float egl = scal[192];
#pragma unroll
      for (int m = 0; m < 8; ++m) {
        const u16* kt = knT + ((size_t)(cgk * 4 + h) * 128 + 16 * m + fr) * 64;
        f32x4 t = S[m];
#pragma unroll
        for (int r = 0; r < 4; ++r) t[r] *= egl;
        t = mfma(ld8(kt + 8 * fq), Vo0, t);
        t = mfma(ld8(kt + 32 + 8 * fq), Vo1, t);
        S[m] = t;
      }
    }
  }
  __syncthreads();
}

DEV void c_local(const P& p, int l, int item, char* smem) {
  float* bsm = (float*)smem;
  u16* Ps = (u16*)(smem + 33024);
  u16* kdt = (u16*)(smem + 33024 + 9216);
  const int tid = opq(threadIdx.x), lane = tid & 63, w = tid >> 6, fr = lane & 15, fq = lane >> 4;
  const int cgk = item >> 2, h = item & 3, rb = cgk * 64;
  const u16* z = (const u16*)(p.ws + O_Z);
  const u16* zT = (const u16*)(p.ws + O_ZT);
  u16* OC = (u16*)(p.ws + O_OC);
  const float* lbs = (const float*)(p.ws + O_LBS);
  for (int dir = 0; dir < 2; ++dir) {
    char* rec = p.ws + O_CREC + ((size_t)(cgk * 4 + h) * 2 + dir) * CREC_SZ;
    u16* QD = (u16*)rec;
    u16* KDT = QD + 8192;
    float* decv = (float*)(rec + 32768);
    const float* lbp = lbs + l * 1024 + dir * 512 + h * 128;
    const int fcol = C_F0 + dir * 512 + h * 128;
    {
      int d = tid & 127, half = tid >> 7;
      float lb_ = lbp[d], run = 0.f;
      for (int k = 0; k < 32; ++k) {
        int i = 32 * half + k, c = dir ? 63 - i : i;
        float f = bf2f(z[(size_t)(rb + c) * NZ + fcol + d]);
        float fg = lb_ + (1.f - lb_) * sigm(f);
        run += __logf(fg);
        bsm[i * 129 + d] = run;
      }
    }
    __syncthreads();
    {
      int d = tid & 127, half = tid >> 7;
      if (half) {
        float add = bsm[31 * 129 + d];
        for (int k = 0; k < 32; ++k) bsm[(32 + k) * 129 + d] += add;
      }
    }
    __syncthreads();
    for (int idx = tid; idx < 8192; idx += 256) {
      int i = idx >> 7, d = idx & 127, c = dir ? 63 - i : i;
      float b = bsm[i * 129 + d];
      float q = silu(bf2f(z[(size_t)(rb + c) * NZ + C_QC + h * 128 + d]));
      QD[i * 128 + d] = f2bf(q * __expf(b));
      float f = bf2f(z[(size_t)(rb + c) * NZ + fcol + d]);
      float k = (1.f - lbp[d]) * sigm(-f);
      kdt[d * 72 + c] = f2bf(k * __expf(bsm[63 * 129 + d] - b));
    }
    if (tid < 128) decv[tid] = __expf(bsm[63 * 129 + tid]);
    __syncthreads();
    for (int idx = tid; idx < 1024; idx += 256) {
      int d = idx >> 3, c8 = idx & 7;
      *(uint4*)(KDT + d * 64 + c8 * 8) = *(const uint4*)(kdt + d * 72 + c8 * 8);
    }
    {
      const int sj = w;
      for (int si = 0; si < 4; ++si) {
        f32x4 acc = {0.f, 0.f, 0.f, 0.f};
        if (si >= sj) {
          int it = 16 * si + fr, jt = 16 * sj + fr;
          int ci = dir ? 63 - it : it, cj = dir ? 63 - jt : jt;
#pragma unroll
          for (int s = 0; s < 4; ++s) {
            int d0 = 32 * s + 8 * fq;
            bf16x8 qv = ld8(z + (size_t)(rb + ci) * NZ + C_QC + h * 128 + d0);
            bf16x8 fv = ld8(z + (size_t)(rb + cj) * NZ + fcol + d0);
            bf16x8 af, bf;
#pragma unroll
            for (int e = 0; e < 8; ++e) {
              int d = d0 + e;
              float Bs_ = si ? bsm[(16 * si - 1) * 129 + d] : 0.f;
              float qq = silu(bf2f((u16)qv[e])) * __expf(bsm[it * 129 + d] - Bs_);
              float kk = (1.f - lbp[d]) * sigm(-bf2f((u16)fv[e])) * __expf(Bs_ - bsm[jt * 129 + d]);
              af[e] = (short)f2bf(qq);
              bf[e] = (short)f2bf(kk);
            }
            acc = mfma(af, bf, acc);
          }
        }
#pragma unroll
        for (int r = 0; r < 4; ++r) {
          int i = 16 * si + 4 * fq + r, jj = 16 * sj + fr;
          float v = (si >= sj && jj <= i) ? acc[r] : 0.f;
          Ps[i * 72 + (dir ? 63 - jj : jj)] = f2bf(v);
        }
        __builtin_amdgcn_sched_barrier(0);
      }
    }
    __syncthreads();
#pragma unroll
    for (int nt2 = 0; nt2 < 2; ++nt2) {
      int e = h * 128 + (2 * w + nt2) * 16 + fr;
      bf16x8 v0 = ld8(zT + (size_t)e * GR + rb + 8 * fq), v1 = ld8(zT + (size_t)e * GR + rb + 32 + 8 * fq);
#pragma unroll
      for (int m = 0; m < 4; ++m) {
        f32x4 O = {0.f, 0.f, 0.f, 0.f};
        O = mfma(ld8(Ps + (16 * m + fr) * 72 + 8 * fq), v0, O);
        O = mfma(ld8(Ps + (16 * m + fr) * 72 + 32 + 8 * fq), v1, O);
#pragma unroll
        for (int r = 0; r < 4; ++r) {
          int ii = 16 * m + 4 * fq + r, rowr = rb + (dir ? 63 - ii : ii);
          OC[((size_t)dir * GR + rowr) * 512 + e] = f2bf(O[r]);
        }
      }
    }
    __syncthreads();
  }
}

DEV void c_seq(const P& p, int bitem, char* smem) {
  const int tid = opq(threadIdx.x), lane = tid & 63, w = tid >> 6, fr = lane & 15, fq = lane >> 4;
  const bool active = w < WPB;
  const int item = bitem * WPB + (active ? w : 0);
  const int slice = item & 7, dir = (item >> 3) & 1, h = (item >> 4) & 3, lb = item >> 6, e0 = slice * 16;
  u16* Ss = (u16*)(smem + w * 4352);
  const u16* zT = (const u16*)(p.ws + O_ZT);
  u16* OC = (u16*)(p.ws + O_OC);
  f32x4 S[8];
#pragma unroll
  for (int m = 0; m < 8; ++m) S[m] = (f32x4){0.f, 0.f, 0.f, 0.f};
  for (int j = 0; j < 36; ++j) {
    const int n = dir ? (j < 4 ? 3 - j : 39 - j) : j;
    const int cgk = lb * 36 + n, rb = cgk * 64;
    const char* rec = p.ws + O_CREC + ((size_t)(cgk * 4 + h) * 2 + dir) * CREC_SZ;
    const u16* QD = (const u16*)rec;
    const u16* KDT = QD + 8192;
    const float* decv = (const float*)(rec + 32768);
    if (active) {
#pragma unroll
      for (int m = 0; m < 8; ++m) {
        uint2 pk; pk.x = pk2(S[m][0], S[m][1]); pk.y = pk2(S[m][2], S[m][3]);
        *(uint2*)(Ss + fr * 136 + 16 * m + 4 * fq) = pk;
      }
    }
    __syncthreads();
    if (active) {
      bf16x8 Sf[4];
#pragma unroll
      for (int s = 0; s < 4; ++s) Sf[s] = ld8(Ss + fr * 136 + 32 * s + 8 * fq);
#pragma unroll
      for (int m = 0; m < 4; ++m) {
        f32x4 O = {0.f, 0.f, 0.f, 0.f};
#pragma unroll
        for (int s = 0; s < 4; ++s) O = mfma(ld8(QD + (16 * m + fr) * 128 + 32 * s + 8 * fq), Sf[s], O);
#pragma unroll
        for (int r = 0; r < 4; ++r) {
          int ii = 16 * m + 4 * fq + r, rowr = rb + (dir ? 63 - ii : ii);
          size_t oi = ((size_t)dir * GR + rowr) * 512 + h * 128 + e0 + fr;
          OC[oi] = f2bf(bf2f(OC[oi]) + O[r]);
        }
      }
      const u16* vp = zT + (size_t)(h * 128 + e0 + fr) * GR + rb;
      bf16x8 V0 = ld8(vp + 8 * fq), V1 = ld8(vp + 32 + 8 * fq);
#pragma unroll
      for (int m = 0; m < 8; ++m) {
        f32x4 t = S[m];
#pragma unroll
        for (int r = 0; r < 4; ++r) t[r] *= decv[16 * m + 4 * fq + r];
        t = mfma(ld8(KDT + (16 * m + fr) * 64 + 8 * fq), V0, t);
        t = mfma(ld8(KDT + (16 * m + fr) * 64 + 32 + 8 * fq), V1, t);
        S[m] = t;
      }
    }
    __syncthreads();
  }
}

#define LBAR()                                              \
  do {                                                      \
    asm volatile("s_waitcnt lgkmcnt(0)" ::: "memory");      \
    __builtin_amdgcn_s_barrier();                           \
    asm volatile("" ::: "memory");                          \
  } while (0)
#define CBAR() asm volatile("" ::: "memory")

DEV void c_local2(const P& p, int l, int item, char* smem) {
  float* bsm = (float*)smem;
  u16* Fq = (u16*)(smem + 33024);
  u16* kdt = (u16*)(smem + 50432);
  u16* Ps = kdt;
  const int tid = opq(threadIdx.x), lane = tid & 63, w = tid >> 6, fr = lane & 15, fq = lane >> 4;
  const int cgk = item >> 2, h = item & 3, rb = cgk * 64;
  const u16* z = (const u16*)(p.ws + O_Z);
  const u16* zT = (const u16*)(p.ws + O_ZT);
  u16* OC = (u16*)(p.ws + O_OC);
  const float* lbs = (const float*)(p.ws + O_LBS);
  u16* zq = (u16*)(p.ws + O_Z) + (size_t)rb * NZ + C_QC + h * 128;
  {
    uint4 t4[4];
#pragma unroll
    for (int k = 0; k < 4; ++k) {
      int idx = tid + 256 * k, c = idx >> 4, seg = idx & 15;
      t4[k] = *(const uint4*)(zq + (size_t)c * NZ + seg * 8);
    }
#pragma unroll
    for (int k = 0; k < 4; ++k) {
      int idx = tid + 256 * k, c = idx >> 4, seg = idx & 15;
      unsigned wv[4] = {t4[k].x, t4[k].y, t4[k].z, t4[k].w};
#pragma unroll
      for (int q = 0; q < 4; ++q)
        wv[q] = pk2(silu(bf2f((u16)(wv[q] & 0xffff))), silu(bf2f((u16)(wv[q] >> 16))));
      *(uint4*)(zq + (size_t)c * NZ + seg * 8) = make_uint4(wv[0], wv[1], wv[2], wv[3]);
    }
  }
  __syncthreads();
  for (int dir = 0; dir < 2; ++dir) {
    char* rec = p.ws + O_CREC + ((size_t)(cgk * 4 + h) * 2 + dir) * CREC_SZ;
    u16* QD = (u16*)rec;
    u16* KDT = QD + 8192;
    float* decv = (float*)(rec + 32768);
    const float* lbp = lbs + l * 1024 + dir * 512 + h * 128;
    const int fcol = C_F0 + dir * 512 + h * 128;
    {
      uint4 t4[4];
#pragma unroll
      for (int k = 0; k < 4; ++k) {
        int idx = tid + 256 * k, c = idx >> 4, seg = idx & 15;
        t4[k] = *(const uint4*)(z + (size_t)(rb + c) * NZ + fcol + seg * 8);
      }
#pragma unroll
      for (int k = 0; k < 4; ++k) {
        int idx = tid + 256 * k, c = idx >> 4, seg = idx & 15;
        *(uint4*)(Fq + c * 136 + seg * 8) = t4[k];
      }
    }
    __syncthreads();
    {
      int d = tid & 127, half = tid >> 7;
      float lb_ = lbp[d], run = 0.f;
#pragma unroll 8
      for (int k = 0; k < 32; ++k) {
        int i = 32 * half + k, c = dir ? 63 - i : i;
        float f = bf2f(Fq[c * 136 + d]);
        float fg = lb_ + (1.f - lb_) * sigm(f);
        run += __logf(fg);
        bsm[i * 129 + d] = run;
      }
    }
    __syncthreads();
    {
      int d = tid & 127, half = tid >> 7;
      if (half) {
        float add = bsm[31 * 129 + d];
#pragma unroll 8
        for (int k = 0; k < 32; ++k) bsm[(32 + k) * 129 + d] += add;
      }
    }
    __syncthreads();
    {
      uint4 qv[4];
#pragma unroll
      for (int k = 0; k < 4; ++k) {
        int idx = tid + 256 * k, c = idx >> 4, seg = idx & 15;
        qv[k] = *(const uint4*)(zq + (size_t)c * NZ + seg * 8);
      }
#pragma unroll
      for (int k = 0; k < 4; ++k) {
        int idx = tid + 256 * k, c = idx >> 4, seg = idx & 15, i = dir ? 63 - c : c, d0 = seg * 8;
        unsigned qw[4] = {qv[k].x, qv[k].y, qv[k].z, qv[k].w};
        uint4 fv4 = *(const uint4*)(Fq + c * 136 + d0);
        unsigned fw[4] = {fv4.x, fv4.y, fv4.z, fv4.w};
        unsigned qo[4], ko[4];
#pragma unroll
        for (int q = 0; q < 4; ++q) {
          int d = d0 + 2 * q;
          float b0 = bsm[i * 129 + d], b1 = bsm[i * 129 + d + 1];
          float bl0 = bsm[63 * 129 + d], bl1 = bsm[63 * 129 + d + 1];
          float q0 = bf2f((u16)(qw[q] & 0xffff)), q1 = bf2f((u16)(qw[q] >> 16));
          qo[q] = pk2(q0 * __expf(b0), q1 * __expf(b1));
          float k0 = (1.f - lbp[d]) * sigm(-bf2f((u16)(fw[q] & 0xffff)));
          float k1 = (1.f - lbp[d + 1]) * sigm(-bf2f((u16)(fw[q] >> 16)));
          ko[q] = pk2(k0, k1);
          kdt[d * 72 + c] = f2bf(k0 * __expf(bl0 - b0));
          kdt[(d + 1) * 72 + c] = f2bf(k1 * __expf(bl1 - b1));
        }
        *(uint4*)(QD + i * 128 + d0) = make_uint4(qo[0], qo[1], qo[2], qo[3]);
        *(uint4*)(Fq + c * 136 + d0) = make_uint4(ko[0], ko[1], ko[2], ko[3]);
      }
      if (tid < 128) decv[tid] = __expf(bsm[63 * 129 + tid]);
    }
    __syncthreads();
    for (int idx = tid; idx < 1024; idx += 256) {
      int d = idx >> 3, c8 = idx & 7;
      *(uint4*)(KDT + d * 64 + c8 * 8) = *(const uint4*)(kdt + d * 72 + c8 * 8);
    }
    bf16x8 qf[3][4];
#pragma unroll
    for (int t = 0; t < 3; ++t) {
      int k = w + 4 * t;
      int si = k < 4 ? 3 : (k < 7 ? 2 : (k < 9 ? 1 : 0));
      int it_ = 16 * si + fr, ci_ = dir ? 63 - it_ : it_;
#pragma unroll
      for (int s = 0; s < 4; ++s) qf[t][s] = ld8(zq + (size_t)ci_ * NZ + 32 * s + 8 * fq);
    }
    __syncthreads();
    for (int idx = tid; idx < 1536; idx += 256) {
      int tl = idx >> 8, e = idx & 255, r16 = e >> 4, c16 = e & 15;
      int si = tl < 3 ? 0 : (tl < 5 ? 1 : 2);
      int sj = tl < 3 ? tl + 1 : (tl < 5 ? tl - 1 : 3);
      int jj = 16 * sj + c16;
      Ps[(16 * si + r16) * 72 + (dir ? 63 - jj : jj)] = 0;
    }
#pragma unroll
    for (int t = 0; t < 3; ++t) {
      const int k = w + 4 * t;
      if (k < 10) {
        const int si = k < 4 ? 3 : (k < 7 ? 2 : (k < 9 ? 1 : 0));
        const int sj = k - (k < 4 ? 0 : (k < 7 ? 4 : (k < 9 ? 7 : 9)));
        const int it = 16 * si + fr, jt = 16 * sj + fr, cj = dir ? 63 - jt : jt;
        const int brow = si ? (16 * si - 1) : 0;
        const float bmul = si ? 1.f : 0.f;
        f32x4 acc = {0.f, 0.f, 0.f, 0.f};
#pragma unroll
        for (int s = 0; s < 4; ++s) {
          int d0 = 32 * s + 8 * fq;
          bf16x8 fv = ld8(Fq + cj * 136 + d0);
          bf16x8 af, bf;
#pragma unroll
          for (int e = 0; e < 8; ++e) {
            int d = d0 + e;
            float Bs_ = bmul * bsm[brow * 129 + d];
            float qq = bf2f((u16)qf[t][s][e]) * __expf(bsm[it * 129 + d] - Bs_);
            float kk = bf2f((u16)fv[e]) * __expf(Bs_ - bsm[jt * 129 + d]);
            af[e] = (short)f2bf(qq);
            bf[e] = (short)f2bf(kk);
          }
          acc = mfma(af, bf, acc);
          __builtin_amdgcn_sched_barrier(0);
        }
#pragma unroll
        for (int r = 0; r < 4; ++r) {
          int i = 16 * si + 4 * fq + r, jj = 16 * sj + fr;
          float v = (jj <= i) ? acc[r] : 0.f;
          Ps[i * 72 + (dir ? 63 - jj : jj)] = f2bf(v);
        }
      }
    }
    __syncthreads();
#pragma unroll
    for (int nt2 = 0; nt2 < 2; ++nt2) {
      int e = h * 128 + (2 * w + nt2) * 16 + fr;
      bf16x8 v0 = ld8(zT + (size_t)e * GR + rb + 8 * fq), v1 = ld8(zT + (size_t)e * GR + rb + 32 + 8 * fq);
#pragma unroll
      for (int m = 0; m < 4; ++m) {
        f32x4 O = {0.f, 0.f, 0.f, 0.f};
        O = mfma(ld8(Ps + (16 * m + fr) * 72 + 8 * fq), v0, O);
        O = mfma(ld8(Ps + (16 * m + fr) * 72 + 32 + 8 * fq), v1, O);
#pragma unroll
        for (int r = 0; r < 4; ++r) {
          int ii = 16 * m + 4 * fq + r, rowr = rb + (dir ? 63 - ii : ii);
          OC[((size_t)dir * GR + rowr) * 512 + e] = f2bf(O[r]);
        }
      }
    }
    __syncthreads();
  }
}

#define LBAR()                                              \
  do {                                                      \
    asm volatile("s_waitcnt lgkmcnt(0)" ::: "memory");      \
    __builtin_amdgcn_s_barrier();                           \
    asm volatile("" ::: "memory");                          \
  } while (0)
#define CBAR() asm volatile("" ::: "memory")
#define BS_CHUNK(jj) (dir ? ((jj) < 4 ? 3 - (jj) : 39 - (jj)) : (jj))
DEV bf16x8 ldo8(const char* base, unsigned off) { return *reinterpret_cast<const bf16x8*>(base + off); }
DEV void b_seq2(const P& p, int bitem, char* smem) {
  const int tid = opq(threadIdx.x), lane = tid & 63, w = tid >> 6, fr = lane & 15, fq = lane >> 4;
  const int es = bitem & 3, dir = (bitem >> 2) & 1, h = (bitem >> 3) & 3, lb = bitem >> 5, e0 = es * 32;
  u16* Ss = (u16*)smem;
  u16* Rs = Ss + 32 * 136;
  u16* Vsc = Rs + 32 * 72;
  u16* Vor = Vsc + 32 * 72;
  const char* qnB = p.ws + O_BSH + (size_t)h * 256;
  const char* knB = qnB + BSH_ONE;
  const char* vbB = knB + BSH_ONE + (size_t)e0 * 2;
  const char* ktB = p.ws + O_BSH + 3 * BSH_ONE + (size_t)h * 16384;
  const char* recB = p.ws + O_BIT + ((size_t)h * 2 + dir) * BIT_SZ;
  char* obB = p.ws + O_OB + ((size_t)dir * GR * 512 + h * 128 + e0) * 2;
  const int mrow = 16 * w + fr, crow0 = 16 * w + 4 * fq;
  const unsigned offA = (unsigned)((dir ? 63 - mrow : mrow) * 1024 + 16 * fq);
  unsigned offR[4];
#pragma unroll
  for (int r = 0; r < 4; ++r) offR[r] = (unsigned)((dir ? 63 - (crow0 + r) : (crow0 + r)) * 1024 + fr * 2);
  const unsigned offT = (unsigned)(mrow * 128 + 16 * fq);
  const unsigned offK = (unsigned)((32 * w + fr) * 128 + 16 * fq);
  const unsigned offS = (unsigned)(16384 + crow0 * 4);
  f32x4 S[2][2];
#pragma unroll
  for (int a = 0; a < 2; ++a)
#pragma unroll
    for (int b = 0; b < 2; ++b) S[a][b] = (f32x4){0.f, 0.f, 0.f, 0.f};
  bf16x8 Akn[4], Aqn[4], At[2][2], Aqk[2][2], AkT[2][2][2];
  u16 vbv[2][4];
  float4 eg4, be4, ek4[2];
  float egl[2];
#define BS_LOAD1(cg_)                                                              \
  {                                                                                \
    const size_t ro_ = (size_t)(cg_) * 65536;                                      \
    _Pragma("unroll") for (int s = 0; s < 4; ++s) {                                \
      Akn[s] = ldo8(knB + ro_, offA + 64 * s);                                     \
      Aqn[s] = ldo8(qnB + ro_, offA + 64 * s);                                     \
    }                                                                              \
    _Pragma("unroll") for (int r = 0; r < 4; ++r) {                                \
      vbv[0][r] = *(const u16*)(vbB + ro_ + offR[r]);                              \
      vbv[1][r] = *(const u16*)(vbB + ro_ + (offR[r] + 32));                       \
    }                                                                              \
    const char* rc_ = recB + (size_t)(cg_) * (8 * BIT_SZ);                         \
    eg4 = *(const float4*)(rc_ + offS);                                            \
    be4 = *(const float4*)(rc_ + (offS + 256));                                    \
  }
#define BS_LOAD2(cg_, SS)                                                          \
  {                                                                                \
    const char* rc_ = recB + (size_t)(cg_) * (8 * BIT_SZ);                         \
    At[SS][0] = ldo8(rc_, offT); At[SS][1] = ldo8(rc_, offT + 64);                 \
    ek4[SS] = *(const float4*)(rc_ + (offS + 512));                                \
  }
#define BS_LOAD3(cg_, SS)                                                          \
  {                                                                                \
    const char* rc_ = recB + (size_t)(cg_) * (8 * BIT_SZ);                         \
    Aqk[SS][0] = ldo8(rc_, offT + 8192); Aqk[SS][1] = ldo8(rc_, offT + 8192 + 64); \
    egl[SS] = *(const float*)(rc_ + 16384 + 768);                                  \
    const char* kt_ = ktB + (size_t)(cg_) * 65536;                                 \
    AkT[SS][0][0] = ldo8(kt_, offK); AkT[SS][0][1] = ldo8(kt_, offK + 64);         \
    AkT[SS][1][0] = ldo8(kt_, offK + 2048); AkT[SS][1][1] = ldo8(kt_, offK + 2048 + 64); \
  }
  {
    const int c0 = lb * 36 + BS_CHUNK(0);
    BS_LOAD1(c0) BS_LOAD2(c0, 0) BS_LOAD3(c0, 0)
  }
  for (int j2 = 0; j2 < 36; j2 += 2)
#pragma unroll
  for (int u = 0; u < 2; ++u) {
    const int j = j2 + u;
    const int cgk = lb * 36 + BS_CHUNK(j);
    const int jn = (j + 1 < 36) ? j + 1 : j;
    const int cgn = lb * 36 + BS_CHUNK(jn);
    BS_LOAD2(cgn, u ^ 1)
    BS_LOAD3(cgn, u ^ 1)
#pragma unroll
    for (int mm = 0; mm < 2; ++mm)
#pragma unroll
      for (int nt = 0; nt < 2; ++nt) {
        uint2 pk; pk.x = pk2(S[mm][nt][0], S[mm][nt][1]); pk.y = pk2(S[mm][nt][2], S[mm][nt][3]);
        *(uint2*)(Ss + (16 * nt + fr) * 136 + 32 * w + 16 * mm + 4 * fq) = pk;
      }
    LBAR();
    f32x4 QS[2];
    {
      bf16x8 Sf[2][4];
#pragma unroll
      for (int nt = 0; nt < 2; ++nt)
#pragma unroll
        for (int s = 0; s < 4; ++s) Sf[nt][s] = ld8(Ss + (16 * nt + fr) * 136 + 32 * s + 8 * fq);
#pragma unroll
      for (int nt = 0; nt < 2; ++nt) {
        f32x4 X = {0.f, 0.f, 0.f, 0.f}, Q = {0.f, 0.f, 0.f, 0.f};
#pragma unroll
        for (int s = 0; s < 4; ++s) { X = mfma(Akn[s], Sf[nt][s], X); Q = mfma(Aqn[s], Sf[nt][s], Q); }
        float r0 = be4.x * (bf2f(vbv[nt][0]) - eg4.x * X[0]);
        float r1 = be4.y * (bf2f(vbv[nt][1]) - eg4.y * X[1]);
        float r2 = be4.z * (bf2f(vbv[nt][2]) - eg4.z * X[2]);
        float r3 = be4.w * (bf2f(vbv[nt][3]) - eg4.w * X[3]);
        uint2 pk; pk.x = pk2(r0, r1); pk.y = pk2(r2, r3);
        *(uint2*)(Rs + (16 * nt + fr) * 72 + crow0) = pk;
        Q[0] *= eg4.x; Q[1] *= eg4.y; Q[2] *= eg4.z; Q[3] *= eg4.w;
        QS[nt] = Q;
      }
    }
    CBAR();
    BS_LOAD1(cgn)
    LBAR();
    {
#pragma unroll
      for (int nt = 0; nt < 2; ++nt) {
        bf16x8 Rf0 = ld8(Rs + (16 * nt + fr) * 72 + 8 * fq), Rf1 = ld8(Rs + (16 * nt + fr) * 72 + 32 + 8 * fq);
        f32x4 VN = {0.f, 0.f, 0.f, 0.f};
        VN = mfma(At[u][0], Rf0, VN);
        VN = mfma(At[u][1], Rf1, VN);
        uint2 pk; pk.x = pk2(VN[0], VN[1]); pk.y = pk2(VN[2], VN[3]);
        *(uint2*)(Vsc + (16 * nt + fr) * 72 + crow0) = pk;
        float s0 = VN[0] * ek4[u].x, s1 = VN[1] * ek4[u].y, s2 = VN[2] * ek4[u].z, s3 = VN[3] * ek4[u].w;
        if (dir) {
          pk.x = pk2(s3, s2); pk.y = pk2(s1, s0);
          *(uint2*)(Vor + (16 * nt + fr) * 72 + (60 - crow0)) = pk;
        } else {
          pk.x = pk2(s0, s1); pk.y = pk2(s2, s3);
          *(uint2*)(Vor + (16 * nt + fr) * 72 + crow0) = pk;
        }
      }
    }
    LBAR();
    {
      char* ob_ = obB + (size_t)cgk * 65536;
#pragma unroll
      for (int nt = 0; nt < 2; ++nt) {
        bf16x8 Vs0 = ld8(Vsc + (16 * nt + fr) * 72 + 8 * fq), Vs1 = ld8(Vsc + (16 * nt + fr) * 72 + 32 + 8 * fq);
        bf16x8 Vo0 = ld8(Vor + (16 * nt + fr) * 72 + 8 * fq), Vo1 = ld8(Vor + (16 * nt + fr) * 72 + 32 + 8 * fq);
        f32x4 O = QS[nt];
        O = mfma(Aqk[u][0], Vs0, O);
        O = mfma(Aqk[u][1], Vs1, O);
#pragma unroll
        for (int r = 0; r < 4; ++r) *(u16*)(ob_ + (offR[r] + 32 * nt)) = f2bf(O[r]);
#pragma unroll
        for (int mm = 0; mm < 2; ++mm) {
          f32x4 t = S[mm][nt];
#pragma unroll
          for (int r = 0; r < 4; ++r) t[r] *= egl[u];
          t = mfma(AkT[u][mm][0], Vo0, t);
          t = mfma(AkT[u][mm][1], Vo1, t);
          S[mm][nt] = t;
        }
      }
    }
  }
  LBAR();
}

DEV void c_seq2(const P& p, int bitem, char* smem) {
  const int tid = opq(threadIdx.x), lane = tid & 63, w = tid >> 6, fr = lane & 15, fq = lane >> 4;
  const int es = bitem & 3, dir = (bitem >> 2) & 1, h = (bitem >> 3) & 3, lb = bitem >> 5, e0 = es * 32;
  u16* Ssb = (u16*)smem;
  const char* recB = p.ws + O_CREC + ((size_t)h * 2 + dir) * CREC_SZ;
  const char* ztB = p.ws + O_ZT + (size_t)(h * 128 + e0) * GR * 2;
  char* ocB = p.ws + O_OC + ((size_t)dir * GR * 512 + h * 128 + e0) * 2;
  const int mrow = 16 * w + fr, crow0 = 16 * w + 4 * fq;
  const unsigned offQ = (unsigned)(mrow * 256 + 16 * fq);
  const unsigned offK = (unsigned)(16384 + (32 * w + fr) * 128 + 16 * fq);
  const unsigned offD = (unsigned)(32768 + (32 * w + 4 * fq) * 4);
  const unsigned offV = (unsigned)(fr * GR * 2 + 16 * fq);
  unsigned offR[4];
#pragma unroll
  for (int r = 0; r < 4; ++r) offR[r] = (unsigned)((dir ? 63 - (crow0 + r) : (crow0 + r)) * 1024 + fr * 2);
  f32x4 S[2][2];
#pragma unroll
  for (int a = 0; a < 2; ++a)
#pragma unroll
    for (int b = 0; b < 2; ++b) S[a][b] = (f32x4){0.f, 0.f, 0.f, 0.f};
  bf16x8 Aqd[4], Akd[2][2], Vf[2][2];
  u16 oi[2][4];
  float4 dec4[2];
#define CS_LOAD(cg_)                                                                    \
  {                                                                                     \
    const char* rc_ = recB + (size_t)(cg_) * (8 * CREC_SZ);                             \
    _Pragma("unroll") for (int s = 0; s < 4; ++s) Aqd[s] = ldo8(rc_, offQ + 64 * s);    \
    Akd[0][0] = ldo8(rc_, offK); Akd[0][1] = ldo8(rc_, offK + 64);                      \
    Akd[1][0] = ldo8(rc_, offK + 2048); Akd[1][1] = ldo8(rc_, offK + 2048 + 64);        \
    dec4[0] = *(const float4*)(rc_ + offD);                                             \
    dec4[1] = *(const float4*)(rc_ + (offD + 64));                                      \
    const char* zt_ = ztB + (size_t)(cg_) * 128;                                        \
    Vf[0][0] = ldo8(zt_, offV); Vf[0][1] = ldo8(zt_, offV + 64);                        \
    Vf[1][0] = ldo8(zt_, offV + 16 * GR * 2); Vf[1][1] = ldo8(zt_, offV + 16 * GR * 2 + 64); \
    const char* oc_ = ocB + (size_t)(cg_) * 65536;                                      \
    _Pragma("unroll") for (int r = 0; r < 4; ++r) {                                     \
      oi[0][r] = *(const u16*)(oc_ + offR[r]);                                          \
      oi[1][r] = *(const u16*)(oc_ + (offR[r] + 32));                                   \
    }                                                                                   \
  }
  {
    const int c0 = lb * 36 + BS_CHUNK(0);
    CS_LOAD(c0)
  }
  for (int j = 0; j < 36; ++j) {
    const int cgk = lb * 36 + BS_CHUNK(j);
    const int jn = (j + 1 < 36) ? j + 1 : j;
    const int cgn = lb * 36 + BS_CHUNK(jn);
    u16* Ss = Ssb + (j & 1) * (32 * 136);
#pragma unroll
    for (int mm = 0; mm < 2; ++mm)
#pragma unroll
      for (int nt = 0; nt < 2; ++nt) {
        uint2 pk; pk.x = pk2(S[mm][nt][0], S[mm][nt][1]); pk.y = pk2(S[mm][nt][2], S[mm][nt][3]);
        *(uint2*)(Ss + (16 * nt + fr) * 136 + 32 * w + 16 * mm + 4 * fq) = pk;
      }
    LBAR();
    char* oc_ = ocB + (size_t)cgk * 65536;
#pragma unroll
    for (int nt = 0; nt < 2; ++nt) {
      f32x4 O = {0.f, 0.f, 0.f, 0.f};
#pragma unroll
      for (int s = 0; s < 4; ++s) O = mfma(Aqd[s], ld8(Ss + (16 * nt + fr) * 136 + 32 * s + 8 * fq), O);
#pragma unroll
      for (int r = 0; r < 4; ++r) *(u16*)(oc_ + (offR[r] + 32 * nt)) = f2bf(bf2f(oi[nt][r]) + O[r]);
#pragma unroll
      for (int mm = 0; mm < 2; ++mm) {
        f32x4 t = S[mm][nt];
        t[0] *= dec4[mm].x; t[1] *= dec4[mm].y; t[2] *= dec4[mm].z; t[3] *= dec4[mm].w;
        t = mfma(Akd[mm][0], Vf[nt][0], t);
        t = mfma(Akd[mm][1], Vf[nt][1], t);
        S[mm][nt] = t;
      }
    }
    CBAR();
    CS_LOAD(cgn)
  }
  LBAR();
}

DEV void bc_merge(const P& p, int l, int it) {
  const int tid_ = opq(threadIdx.x); const int lane = tid_ & 63, w = tid_ >> 6;
  int lr = it * 4 + w;
  int mix = lane >> 5, cm = (lane * 16) & 511;
  const u16* O = (const u16*)(p.ws + (mix ? O_OC : O_OB));
  u16* z = (u16*)(p.ws + O_Z);
  float ov[16], ss = 0.f;
#pragma unroll
  for (int k2 = 0; k2 < 2; ++k2) {
    uint4 a = *(const uint4*)(O + (size_t)lr * 512 + cm + 8 * k2);
    uint4 b = *(const uint4*)(O + ((size_t)GR + lr) * 512 + cm + 8 * k2);
    unsigned aa[4] = {a.x, a.y, a.z, a.w}, bb[4] = {b.x, b.y, b.z, b.w};
#pragma unroll
    for (int q = 0; q < 4; ++q) {
      float v0 = bf2f((u16)(aa[q] & 0xffff)) + bf2f((u16)(bb[q] & 0xffff));
      float v1 = bf2f((u16)(aa[q] >> 16)) + bf2f((u16)(bb[q] >> 16));
      ov[k2 * 8 + q * 2] = v0; ov[k2 * 8 + q * 2 + 1] = v1;
      ss += v0 * v0 + v1 * v1;
    }
  }
  ss += __shfl_xor(ss, 1); ss += __shfl_xor(ss, 2); ss += __shfl_xor(ss, 4);
  float rinv = rsqrtf(ss * (1.f / 128.f) + EPS);
  const float* nw = (mix ? p.hg_norm : p.gdn_norm) + l * 128 + (cm & 127);
  u16* gp = z + (size_t)lr * NZ + (mix ? C_GC : C_GB) + cm;
#pragma unroll
  for (int k2 = 0; k2 < 2; ++k2) {
    uint4 gv = *(const uint4*)(gp + 8 * k2);
    unsigned gg[4] = {gv.x, gv.y, gv.z, gv.w}, oo[4];
#pragma unroll
    for (int q = 0; q < 4; ++q) {
      int e = k2 * 8 + q * 2;
      float y0 = ov[e] * rinv * nw[e] * silu(bf2f((u16)(gg[q] & 0xffff)));
      float y1 = ov[e + 1] * rinv * nw[e + 1] * silu(bf2f((u16)(gg[q] >> 16)));
      oo[q] = pk2(y0, y1);
    }
    *(uint4*)(gp + 8 * k2) = make_uint4(oo[0], oo[1], oo[2], oo[3]);
  }
}

#define XB_TMO      128
#define XB_XCNT(j)  (256  + 64 * (j))
#define XB_XSUB(j)  (1280 + 64 * (j))
#define XB_XGEN(j)  (2304 + 64 * (j))
#define XB_TOP      3328
#define XB_TOPGEN   3392
#define XCD_BAR_WORDS 3456
#define XB_SPIN_CAP (1u << 18)
#define LAS __attribute__((address_space(3)))

__device__ __forceinline__ unsigned xb_ld(unsigned* p)              { return __hip_atomic_load(p, __ATOMIC_RELAXED, __HIP_MEMORY_SCOPE_AGENT); }
__device__ __forceinline__ unsigned xb_add(unsigned* p, unsigned v) { return __hip_atomic_fetch_add(p, v, __ATOMIC_RELAXED, __HIP_MEMORY_SCOPE_AGENT); }
__device__ __forceinline__ unsigned xb_xcc_id() { return (unsigned)__builtin_amdgcn_s_getreg((3 << 11) | 20) & 0xFu; }
#define XB_SPIN(cond, bar) do { unsigned _sp = 0; while (cond) { __builtin_amdgcn_s_sleep(1); \
    if ((++_sp & 255u) == 0u) { if (xb_ld(&(bar)[XB_TMO])) break; if (_sp > XB_SPIN_CAP) { atomicAdd(&(bar)[XB_TMO], 1u); break; } } } } while (0)

struct XcdBarrier {
    unsigned* bar; unsigned x;
    volatile LAS unsigned* st;
};

__device__ __forceinline__ XcdBarrier xcd_barrier_post(unsigned* bar, volatile LAS unsigned* st) {
    XcdBarrier b; b.bar = bar; b.x = xb_xcc_id(); b.st = st;
    if (threadIdx.x == 0) (void)xb_add(&bar[XB_XCNT(b.x)], 1u);
    return b;
}
__device__ __forceinline__ void xcd_barrier_complete(unsigned* bar, unsigned x, unsigned& nloc, unsigned& nx) {
    const unsigned G = gridDim.x * gridDim.y * gridDim.z;
    unsigned sum, cnt, mine, sp = 0u;
    for (;;) {
        sum = 0u; cnt = 0u; mine = 0u;
#pragma unroll
        for (unsigned j = 0; j < 16; ++j) { const unsigned c = xb_ld(&bar[XB_XCNT(j)]); sum += c; cnt += (c > 0u) ? 1u : 0u; mine = (j == x) ? c : mine; }
        if (sum == G) break;
        __builtin_amdgcn_s_sleep(1);
        if ((++sp & 255u) == 0u) { if (xb_ld(&bar[XB_TMO])) break; if (sp > XB_SPIN_CAP) { atomicAdd(&bar[XB_TMO], 1u); break; } }
    }
    nloc = mine > 0u ? mine : 1u; nx = cnt > 0u ? cnt : 1u;
}

__device__ __forceinline__ void xcd_barrier(const XcdBarrier& b) {
    asm volatile("s_waitcnt vmcnt(0)" ::: "memory");
    __syncthreads();
    if (threadIdx.x == 0) {
        unsigned* bar = b.bar;
        __builtin_amdgcn_s_waitcnt(0);
        unsigned nloc = b.st[0], nx = b.st[1];
        if (nloc == 0u) { xcd_barrier_complete(bar, b.x, nloc, nx); b.st[0] = nloc; b.st[1] = nx; }
        const unsigned old = xb_add(&bar[XB_XSUB(b.x)], 1u);
        const unsigned gen = old / nloc;
        if (old + 1u == (gen + 1u) * nloc) {
            __builtin_amdgcn_fence(__ATOMIC_RELEASE, "agent");
            asm volatile("s_waitcnt vmcnt(0)" ::: "memory");
            const unsigned og = xb_add(&bar[XB_TOP], 1u);
            const unsigned tg = og / nx;
            if (og + 1u == (tg + 1u) * nx) xb_add(&bar[XB_TOPGEN], 1u);
            else XB_SPIN(xb_ld(&bar[XB_TOPGEN]) == tg, bar);
            __builtin_amdgcn_fence(__ATOMIC_ACQUIRE, "agent");
            xb_add(&bar[XB_XGEN(b.x)], 1u);
            asm volatile("s_waitcnt vmcnt(0)" ::: "memory");
        } else {
            XB_SPIN(xb_ld(&bar[XB_XGEN(b.x)]) == gen, bar);
            __builtin_amdgcn_fence(__ATOMIC_ACQUIRE, "agent");
            asm volatile("s_waitcnt vmcnt(0)" ::: "memory");
        }
    }
    __syncthreads();
}


#ifdef NO_G0
#define XG0(x)
#else
#define XG0(x) x
#endif
#ifdef NO_G1
#define XG1(x)
#else
#define XG1(x) x
#endif
#ifdef NO_BC
#define XBC(x)
#else
#define XBC(x) x
#endif
#ifdef NO_AC
#define XAC(x)
#else
#define XAC(x) x
#endif
#ifdef NO_P0
#define XP0(x)
#else
#define XP0(x) x
#endif
#ifdef NO_R
#define XR(x)
#else
#define XR(x) x
#endif
#ifdef NO_BL
#define XBL(x)
#else
#define XBL(x) x
#endif
#ifdef NO_CL
#define XCL(x)
#else
#define XCL(x) x
#endif
#ifdef NO_A0
#define XA0(x)
#else
#define XA0(x) x
#endif
#ifdef NO_A1
#define XA1(x)
#else
#define XA1(x) x
#endif
#ifdef NO_BS
#define XBS(x)
#else
#define XBS(x) x
#endif
#ifdef NO_CS
#define XCS(x)
#else
#define XCS(x) x
#endif
__global__ void __launch_bounds__(256, 2) fwd_mega(P p) {
  extern __shared__ __attribute__((aligned(16))) char smem[];
  cg::grid_group grid = cg::this_grid();
  const int G = gridDim.x;
  __shared__ uint4 xb_words;
  if (threadIdx.x == 0) xb_words = make_uint4(0u, 0u, 0u, 0u);
  __syncthreads();
  XcdBarrier xb = xcd_barrier_post((unsigned*)(p.ws + O_BAR), (volatile LAS unsigned*)&xb_words);
  XP0(phase0(p, smem));
  grid.sync();
  u16* z = (u16*)(p.ws + O_Z);
  u16* zT = (u16*)(p.ws + O_ZT);
  float* ab = (float*)(p.ws + O_AB);
  float* o = (float*)(p.ws + O_BSH);
  const u16* u = (const u16*)(p.ws + O_BIT);
  for (int g = 0; g < NG; ++g) {
    XR(phaseR(p, g, 0));
    xcd_barrier(xb);
    for (int l = 0; l < DEPTH; ++l) {
      for (int rep = 0; rep < REP_G; ++rep) {
        const u16* Bt = (const u16*)(p.ws + O_WTIN) + (size_t)l * NZ * 1024;
        if ((G & 7) == 0) {
          const int x = blockIdx.x & 7, bl = blockIdx.x >> 3, nbl = G >> 3;
          for (int q = bl; q < 9 * 45; q += nbl) { XG0(gemm_tile<0>(u, 1024, Bt, 1024, 9 * x + q % 9, q / 9, z, zT, ab, o, smem)); }
        } else {
          for (int t = blockIdx.x; t < 72 * 45; t += G) { XG0(gemm_tile<0>(u, 1024, Bt, 1024, t % 72, t / 72, z, zT, ab, o, smem)); }
        }
      }
      xcd_barrier(xb);
      for (int rep2 = 0; rep2 < REP_M; ++rep2) {
      for (int rep3 = 0; rep3 < REP_A; ++rep3) {
        if (rep3) xcd_barrier(xb);
        const int nb = NCH * 4, nc = NCH * 4, na = NCH * 8;
        if (G == 512) {
          const int bx = blockIdx.x;
          XCL(c_local2(p, l, bx, smem));
          if (bx < 64) { XCL(c_local2(p, l, 512 + bx, smem)); }
          XBL(b_local(p, l, bx, smem));
          if (bx >= 64 && bx < 128) { XBL(b_local(p, l, 448 + bx, smem)); }
          if (bx < 128) { XA0(a_item(p, l, bx, 0, smem)); }
          else {
            for (int t = 128 + (bx - 128); t < na; t += 384) { XA0(a_item(p, l, t, 0, smem)); }
          }
        } else {
          for (int t = blockIdx.x; t < nb + nc + na; t += G) {
            if (t < nc) { XCL(c_local2(p, l, t, smem)); }
            else if (t < nb + nc) { XBL(b_local(p, l, t - nc, smem)); }
            else { XA0(a_item(p, l, t - nb - nc, 0, smem)); }
          }
        }
      }
      xcd_barrier(xb);
      {
        for (int t = blockIdx.x; t < 256 + 16; t += G) {
          if (t < 128) { XBS(b_seq2(p, t, smem)); }
          else if (t < 256) { XCS(c_seq2(p, t - 128, smem)); }
          else { XAC(a_carry(p, t - 256)); }
        }
      }
      xcd_barrier(xb);
      }
      {
        const int na = NCH * 8, nm = GR / 4;
        for (int t = blockIdx.x; t < na + nm; t += G) {
          if (t < na) { XA1(a_fin(p, l, t, smem)); }
          else { XBC(bc_merge(p, l, t - na)); }
        }
      }
      xcd_barrier(xb);
      for (int rep = 0; rep < REP_G; ++rep) {
        const u16* Bt = (const u16*)(p.ws + O_WTOUT) + (size_t)l * 1024 * 1536;
        for (int t = blockIdx.x; t < 72 * 8; t += G) { XG1(gemm_tile<1>(z + C_GA, NZ, Bt, 1536, t % 72, t / 72, z, zT, ab, o, smem)); }
      }
      xcd_barrier(xb);
      XR(phaseR(p, g, l + 1));
      xcd_barrier(xb);
    }
  }
}

extern "C" void kernel_launch(void* const* d_in, const int* in_sizes, int n_in, void* d_out, int out_size, void* d_ws,
                              size_t ws_size, hipStream_t stream) {
  static int grid_blocks = 0;
  if (!grid_blocks) {
    int dev = 0, cus = 0, per_cu = 0;
    hipGetDevice(&dev);
    hipDeviceGetAttribute(&cus, hipDeviceAttributeMultiprocessorCount, dev);
    hipFuncSetAttribute((const void*)fwd_mega, hipFuncAttributeMaxDynamicSharedMemorySize, LDS_BYTES);
    hipOccupancyMaxActiveBlocksPerMultiprocessor(&per_cu, fwd_mega, 256, LDS_BYTES);
    if (per_cu > 2) per_cu = 2;
    if (per_cu < 1) per_cu = 1;
    grid_blocks = cus * per_cu;
  }
  if (ws_size < WS_TOTAL) {
    fprintf(stderr, "workspace too small: %zu < %zu\n", ws_size, (size_t)WS_TOTAL);
    return;
  }
  P p{};
  const float** f = (const float**)&p;
  for (int i = 0; i < 23; ++i) f[i] = (const float*)d_in[i];
  p.out = (float*)d_out;
  p.ws = (char*)d_ws;
  hipMemsetAsync((char*)d_ws + O_BAR, 0, XCD_BAR_WORDS * 4, stream);
  void* args[] = {&p};
  hipError_t e = hipLaunchCooperativeKernel((void*)fwd_mega, dim3(grid_blocks), dim3(256), args, LDS_BYTES, stream);
  if (e != hipSuccess) fprintf(stderr, "cooperative launch failed: %s (grid %d)\n", hipGetErrorString(e), grid_blocks);
}
```

```cpp
#include <hip/hip_runtime.h>
#include <hip/hip_cooperative_groups.h>
#include <cstdio>
namespace cg = cooperative_groups;

typedef __attribute__((ext_vector_type(8))) short bf16x8;
typedef __attribute__((ext_vector_type(4))) float f32x4;
typedef unsigned short u16;
#define DEV __device__ __forceinline__

constexpr int DM = 1024, TL = 2048, TCX = 256, TS = 2304, GB = 4, GR = GB * TS, NG = 2;
constexpr int NZ = 5760, DEPTH = 4;
constexpr int C_XA = 0, C_Q = 512, C_K = 1024, C_V = 1536, C_QC = 2048, C_F0 = 2560, C_IC = 3584,
              C_GA = 4096, C_GB = 4608, C_GC = 5120, C_AB = 5632;
constexpr int NCH = GR / 64;
constexpr float EPS = 1e-6f;
constexpr int WPB = 2;

constexpr size_t al256(size_t x) { return (x + 255) & ~(size_t)255; }
constexpr size_t O_WTIN = 0;
constexpr size_t O_WTOUT = O_WTIN + al256((size_t)DEPTH * NZ * 1024 * 2);
constexpr size_t O_WGT = O_WTOUT + al256((size_t)DEPTH * 1024 * 1536 * 2);
constexpr size_t O_MOD = O_WGT + al256((size_t)DEPTH * 2 * 2 * 8 * 4096 * 2);
constexpr size_t O_LBS = O_MOD + al256((size_t)DEPTH * 9 * 3072 * 4);
constexpr size_t O_HC = O_LBS + al256((size_t)DEPTH * 1024 * 4);
constexpr size_t O_Z = O_HC + al256((size_t)GB * TCX * 1024 * 4);
constexpr size_t O_ZT = O_Z + al256((size_t)GR * NZ * 2);
constexpr size_t O_AB = O_ZT + al256((size_t)512 * GR * 2);
constexpr size_t O_BSH = O_AB + al256((size_t)GR * 16 * 4);
constexpr size_t BSH_ONE = (size_t)GR * 512 * 2;
constexpr size_t O_BIT = O_BSH + al256(4 * BSH_ONE);
constexpr size_t BIT_SZ = 17408;
constexpr size_t O_CREC = O_BIT + al256((size_t)NCH * 4 * 2 * BIT_SZ);
constexpr size_t CREC_SZ = 33280;
constexpr size_t O_OB = O_CREC + al256((size_t)NCH * 4 * 2 * CREC_SZ);
constexpr size_t O_OC = O_OB + al256((size_t)2 * GR * 512 * 2);
constexpr size_t O_AP = O_OC + al256((size_t)2 * GR * 512 * 2);
constexpr size_t O_AH = O_AP + al256((size_t)NCH * 2 * 512 * 4);
constexpr size_t O_ACAR = O_AH + al256((size_t)NCH * 2 * 512 * 4);
constexpr size_t O_ALA = O_ACAR + al256((size_t)NCH * 2 * 512 * 4);
constexpr size_t O_AU = O_ALA + al256((size_t)2 * GR * 512 * 2);
constexpr size_t O_BAR = O_AU + al256((size_t)2 * GR * 512 * 2);
constexpr size_t WS_TOTAL = O_BAR + al256(3456 * 4);

constexpr int LDS_BYTES = 73728;
#ifndef REP_A
#define REP_A 1
#endif
#ifndef REP_G
#define REP_G 1
#endif
#ifndef REP_M
#define REP_M 1
#endif

struct P {
  const float *x, *c, *ctx, *c_ctx, *w_ada, *b_ada, *norm_pre, *norm_post, *w_in, *conv_a_w, *conv_a_b, *rg_w_r,
      *rg_b_r, *rg_w_i, *rg_b_i, *rg_lam, *conv_b_w, *gdn_a_log, *gdn_dt_bias, *gdn_norm, *hg_lb, *hg_norm, *w_out;
  float* out;
  char* ws;
};

DEV int opq(int x) { asm volatile("" : "+v"(x)); return x; }
DEV int opqs(int x) { asm volatile("" : "+s"(x)); return x; }
typedef __attribute__((ext_vector_type(2))) __bf16 bf16x2_t;
typedef __attribute__((ext_vector_type(2))) float f32x2_t;
DEV u16 f2bf(float f) { __bf16 r = (__bf16)f; return __builtin_bit_cast(u16, r); }
DEV float bf2f(u16 h) { return __uint_as_float(((unsigned)h) << 16); }
DEV unsigned pk2(float a, float b) { f32x2_t v = {a, b}; bf16x2_t r = __builtin_convertvector(v, bf16x2_t); return __builtin_bit_cast(unsigned, r); }
DEV float sigm(float x) { return __builtin_amdgcn_rcpf(1.f + __expf(-x)); }
DEV float silu(float x) { return x * __builtin_amdgcn_rcpf(1.f + __expf(-x)); }
DEV float softplus(float x) { return x > 20.f ? x : log1pf(__expf(x)); }
DEV f32x4 mfma(bf16x8 a, bf16x8 b, f32x4 c) { return __builtin_amdgcn_mfma_f32_16x16x32_bf16(a, b, c, 0, 0, 0); }
DEV bf16x8 ld8(const u16* p) { return *reinterpret_cast<const bf16x8*>(p); }
DEV int lat_map(int l, int t) { return (l & 1) ? ((t & 63) * 32 + (t >> 6)) : t; }
DEV int orig_col(int n) {
  if (n < 512) return n;
  if (n < 2048) return n + 512;
  if (n < 4096) return n + 1040;
  if (n < 4608) return n - 4096 + 512;
  if (n < 5120) return n - 4608 + 2576;
  if (n < 5632) return n + 16;
  if (n < 5648) return n - 5632 + 2560;
  return -1;
}
DEV float zval(const u16* z, int rb, int cp, int n, int col) {
  if (cp < 0 && (n == 0 || n == 4)) return 0.f;
  if (cp > 63 && (n == 3 || n == 35)) return 0.f;
  return bf2f(z[(size_t)(rb + cp) * NZ + col]);
}

DEV void ph0_ada(const P& p, int item, char* smem) {
  float* sc = (float*)smem;
  float* red = (float*)(smem + 36864);
  const int tid = threadIdx.x, lane = tid & 63, wv = tid >> 6;
  for (int i = tid; i < 9 * 1024; i += 256) {
    int v = i >> 10, d = i & 1023;
    float cv = (v < 8) ? p.c[v * 1024 + d] : p.c_ctx[d];
    sc[i] = silu(cv);
  }
  __syncthreads();
  const int col = item * 64 + lane;
  const int l = col / 3072, e = col % 3072;
  const float* w = p.w_ada + (size_t)l * 1024 * 3072 + e + (size_t)(256 * wv) * 3072;
  const float* scw = sc + 256 * wv;
  float acc[9];
#pragma unroll
  for (int i = 0; i < 9; ++i) acc[i] = 0.f;
  for (int d = 0; d < 256; d += 16) {
    float wr[16];
#pragma unroll
    for (int k = 0; k < 16; ++k) wr[k] = w[(size_t)(d + k) * 3072];
#pragma unroll
    for (int k = 0; k < 16; ++k)
#pragma unroll
      for (int i = 0; i < 9; ++i) acc[i] += scw[i * 1024 + d + k] * wr[k];
  }
#pragma unroll
  for (int i = 0; i < 9; ++i) red[(wv * 9 + i) * 64 + lane] = acc[i];
  __syncthreads();
  float* mod = (float*)(p.ws + O_MOD);
  for (int idx = tid; idx < 9 * 64; idx += 256) {
    int i = idx >> 6, ln = idx & 63;
    float sum = red[(0 * 9 + i) * 64 + ln] + red[(1 * 9 + i) * 64 + ln] + red[(2 * 9 + i) * 64 + ln] + red[(3 * 9 + i) * 64 + ln];
    int cc = item * 64 + ln, l2 = cc / 3072, e2 = cc % 3072;
    mod[((size_t)l2 * 9 + i) * 3072 + e2] = sum + p.b_ada[l2 * 3072 + e2];
  }
  __syncthreads();
}
DEV void tconv_tile(const float* src, int lds_, u16* dst, int ldd, int k0, int n0, bool mapcol, char* smem) {
  float* t = (float*)smem;
  const int tid = threadIdx.x, nn = tid & 63, kq = tid >> 6;
  const int n = n0 + nn;
  const int sn0 = mapcol ? orig_col(n) : n;
  const float msk = (sn0 >= 0) ? 1.f : 0.f;
  const int sn = sn0 >= 0 ? sn0 : 0;
  float v[16];
#pragma unroll
  for (int k = 0; k < 16; ++k) v[k] = src[(size_t)(k0 + kq + 4 * k) * lds_ + sn];
#pragma unroll
  for (int k = 0; k < 16; ++k) t[(kq + 4 * k) * 65 + nn] = v[k] * msk;
  __syncthreads();
  {
    const int kk = tid & 63, nq = tid >> 6;
#pragma unroll
    for (int k = 0; k < 16; ++k) {
      int n2 = nq + 4 * k;
      dst[(size_t)(n0 + n2) * ldd + k0 + kk] = f2bf(t[kk * 65 + n2]);
    }
  }
  __syncthreads();
}
DEV void phase0(const P& p, char* smem) {
  const int n_ada = 192, n_in = DEPTH * 16 * 90, n_out = DEPTH * 24 * 16, n_g = 128, n_lb = 4;
  const int total = n_ada + n_in + n_out + n_g + n_lb;
  for (int it = blockIdx.x; it < total; it += gridDim.x) {
    int i = it;
    if (i < n_ada) { ph0_ada(p, i, smem); continue; }
    i -= n_ada;
    if (i < n_in) {
      int l = i / 1440, r = i % 1440, kt = r / 90, nt = r % 90;
      tconv_tile(p.w_in + (size_t)l * 1024 * 5648, 5648, (u16*)(p.ws + O_WTIN) + (size_t)l * NZ * 1024, 1024, kt * 64,
                 nt * 64, true, smem);
      continue;
    }
    i -= n_in;
    if (i < n_out) {
      int l = i / 384, r = i % 384, kt = r / 16, nt = r % 16;
      tconv_tile(p.w_out + (size_t)l * 1536 * 1024, 1024, (u16*)(p.ws + O_WTOUT) + (size_t)l * 1024 * 1536, 1536,
                 kt * 64, nt * 64, false, smem);
      continue;
    }
    i -= n_out;
    if (i < n_g) {
      int h = i & 7, gate = (i >> 3) & 1, dir = (i >> 4) & 1, l = i >> 5;
      const float* src = (gate ? p.rg_w_i : p.rg_w_r) + ((size_t)(l * 2 + dir) * 8 + h) * 4096;
      tconv_tile(src, 64, (u16*)(p.ws + O_WGT) + (size_t)i * 4096, 64, 0, 0, false, smem);
      continue;
    }
    i -= n_g;
    {
      int j = i * 256 + threadIdx.x;
      float v[4], mx = -1e30f;
      for (int l = 0; l < 4; ++l) { v[l] = p.hg_lb[l * 1024 + j]; mx = fmaxf(mx, v[l]); }
      float s = 0.f;
      for (int l = 0; l < 4; ++l) { v[l] = __expf(v[l] - mx); s += v[l]; }
      float* lbs = (float*)(p.ws + O_LBS);
      float cum = 0.f;
      for (int l = 0; l < 4; ++l) {
        if (l > 0) cum += v[l] / s;
        lbs[l * 1024 + j] = cum;
      }
    }
  }
}

DEV void phaseR(const P& p, int g, int l) {
  const int tid_ = opq(threadIdx.x); const int lane = tid_ & 63, w = tid_ >> 6;
  const float* mod = (const float*)(p.ws + O_MOD);
  float* hc = (float*)(p.ws + O_HC);
  const float* o = (const float*)(p.ws + O_BSH);
  u16* u = (u16*)(p.ws + O_BIT);
  for (int it = blockIdx.x; it < GR / 4; it += gridDim.x) {
    int lr = it * 4 + w;
    int lb = lr / TS, s = lr % TS;
    bool isctx = s < TCX;
    if (l == DEPTH && isctx) continue;
    int b = g * GB + lb, t = s - TCX;
    int mi = isctx ? 8 : b;
    float* hp = isctx ? hc + ((size_t)lb * TCX + s) * 1024 : p.out + ((size_t)b * TL + t) * 1024;
    float hv[16];
    if (l == 0) {
      const float* src = isctx ? p.ctx + ((size_t)b * TCX + s) * 1024 : p.x + ((size_t)b * TL + t) * 1024;
#pragma unroll
      for (int k = 0; k < 4; ++k) {
        float4 v = *(const float4*)(src + k * 256 + lane * 4);
        hv[k * 4] = v.x; hv[k * 4 + 1] = v.y; hv[k * 4 + 2] = v.z; hv[k * 4 + 3] = v.w;
      }
    } else {
      int orow = lb * TS + (isctx ? s : TCX + lat_map(l - 1, t));
      const float* op = o + (size_t)orow * 1024;
      float ov[16], ss = 0.f;
#pragma unroll
      for (int k = 0; k < 4; ++k) {
        float4 v = *(const float4*)(op + k * 256 + lane * 4);
        ov[k * 4] = v.x; ov[k * 4 + 1] = v.y; ov[k * 4 + 2] = v.z; ov[k * 4 + 3] = v.w;
        ss += v.x * v.x + v.y * v.y + v.z * v.z + v.w * v.w;
      }
#pragma unroll
      for (int off = 32; off; off >>= 1) ss += __shfl_xor(ss, off);
      float rinv = rsqrtf(ss * (1.f / 1024.f) + EPS);
      const float* gate = mod + ((size_t)(l - 1) * 9 + mi) * 3072 + 2048;
      const float* wp = p.norm_post + (l - 1) * 1024;
#pragma unroll
      for (int k = 0; k < 4; ++k) {
        float4 hh = *(const float4*)(hp + k * 256 + lane * 4);
        float4 gg = *(const float4*)(gate + k * 256 + lane * 4);
        float4 ww = *(const float4*)(wp + k * 256 + lane * 4);
        hv[k * 4] = hh.x + gg.x * (ov[k * 4] * rinv * ww.x);
        hv[k * 4 + 1] = hh.y + gg.y * (ov[k * 4 + 1] * rinv * ww.y);
        hv[k * 4 + 2] = hh.z + gg.z * (ov[k * 4 + 2] * rinv * ww.z);
        hv[k * 4 + 3] = hh.w + gg.w * (ov[k * 4 + 3] * rinv * ww.w);
      }
    }
#pragma unroll
    for (int k = 0; k < 4; ++k)
      *(float4*)(hp + k * 256 + lane * 4) = make_float4(hv[k * 4], hv[k * 4 + 1], hv[k * 4 + 2], hv[k * 4 + 3]);
    if (l < DEPTH) {
      float ss = 0.f;
#pragma unroll
      for (int k = 0; k < 16; ++k) ss += hv[k] * hv[k];
#pragma unroll
      for (int off = 32; off; off >>= 1) ss += __shfl_xor(ss, off);
      float rinv = rsqrtf(ss * (1.f / 1024.f) + EPS);
      const float* sh = mod + ((size_t)l * 9 + mi) * 3072;
      const float* wp = p.norm_pre + l * 1024;
      int urow = lb * TS + (isctx ? s : TCX + lat_map(l, t));
      u16* up = u + (size_t)urow * 1024;
#pragma unroll
      for (int k = 0; k < 4; ++k) {
        float4 ww = *(const float4*)(wp + k * 256 + lane * 4);
        float4 s0 = *(const float4*)(sh + k * 256 + lane * 4);
        float4 s1 = *(const float4*)(sh + 1024 + k * 256 + lane * 4);
        float a0 = hv[k * 4] * rinv * ww.x * (1.f + s1.x) + s0.x;
        float a1 = hv[k * 4 + 1] * rinv * ww.y * (1.f + s1.y) + s0.y;
        float a2 = hv[k * 4 + 2] * rinv * ww.z * (1.f + s1.z) + s0.z;
        float a3 = hv[k * 4 + 3] * rinv * ww.w * (1.f + s1.w) + s0.w;
        uint2 pk; pk.x = pk2(a0, a1); pk.y = pk2(a2, a3);
        *(uint2*)(up + k * 256 + lane * 4) = pk;
      }
    }
  }
}

template <int MODE>
DEV void gemm_tile(const u16* __restrict__ A, int lda, const u16* __restrict__ Bt, int K, int rt, int ct, u16* z,
                   u16* zT, float* ab, float* o, char* smem) {
  u16* As = (u16*)smem;
  u16* Bs = As + 128 * 72;
  const int tid = opq(threadIdx.x), lane = tid & 63, w = tid >> 6, wr = w >> 1, wc = w & 1, fr = lane & 15, fq = lane >> 4;
  const int lrow = tid >> 3, lseg = tid & 7;
  const u16* Ag = A + (size_t)(rt * 128 + lrow) * lda + lseg * 8;
  const u16* Bg = Bt + (size_t)(ct * 128 + lrow) * K + lseg * 8;
  uint4 pa0, pa1, pa2, pa3, pb0, pb1, pb2, pb3;
  uint4 qa0, qa1, qa2, qa3, qb0, qb1, qb2, qb3;
  f32x4 acc[4][4];
#pragma unroll
  for (int i = 0; i < 4; ++i)
#pragma unroll
    for (int j = 0; j < 4; ++j) acc[i][j] = (f32x4){0.f, 0.f, 0.f, 0.f};
  const int nk = K / 64;
#define GLD(S, kk)                                                            \
  {                                                                           \
    const int kc_ = ((kk) < nk ? (kk) : nk - 1) * 64;                         \
    S##a0 = *(const uint4*)(Ag + kc_);                                        \
    S##a1 = *(const uint4*)(Ag + kc_ + (size_t)32 * lda);                     \
    S##a2 = *(const uint4*)(Ag + kc_ + (size_t)64 * lda);                     \
    S##a3 = *(const uint4*)(Ag + kc_ + (size_t)96 * lda);                     \
    S##b0 = *(const uint4*)(Bg + kc_);                                        \
    S##b1 = *(const uint4*)(Bg + kc_ + (size_t)32 * K);                       \
    S##b2 = *(const uint4*)(Bg + kc_ + (size_t)64 * K);                       \
    S##b3 = *(const uint4*)(Bg + kc_ + (size_t)96 * K);                       \
  }
#define GST(S, bufo)                                                          \
  *(uint4*)(As + (bufo) + (lrow)*72 + lseg * 8) = S##a0;                      \
  *(uint4*)(As + (bufo) + (lrow + 32) * 72 + lseg * 8) = S##a1;               \
  *(uint4*)(As + (bufo) + (lrow + 64) * 72 + lseg * 8) = S##a2;               \
  *(uint4*)(As + (bufo) + (lrow + 96) * 72 + lseg * 8) = S##a3;               \
  *(uint4*)(Bs + (bufo) + (lrow)*72 + lseg * 8) = S##b0;                      \
  *(uint4*)(Bs + (bufo) + (lrow + 32) * 72 + lseg * 8) = S##b1;               \
  *(uint4*)(Bs + (bufo) + (lrow + 64) * 72 + lseg * 8) = S##b2;               \
  *(uint4*)(Bs + (bufo) + (lrow + 96) * 72 + lseg * 8) = S##b3;
#define GCOMP(cb)                                                                                           \
  _Pragma("unroll") for (int ks = 0; ks < 2; ++ks) {                                                        \
    bf16x8 af[4], bfr[4];                                                                                   \
    _Pragma("unroll") for (int mi = 0; mi < 4; ++mi)                                                        \
        af[mi] = ld8(As + (cb) + (wr * 64 + mi * 16 + fr) * 72 + ks * 32 + fq * 8);                         \
    _Pragma("unroll") for (int ni = 0; ni < 4; ++ni)                                                        \
        bfr[ni] = ld8(Bs + (cb) + (wc * 64 + ni * 16 + fr) * 72 + ks * 32 + fq * 8);                        \
    _Pragma("unroll") for (int mi = 0; mi < 4; ++mi)                                                        \
        _Pragma("unroll") for (int ni = 0; ni < 4; ++ni) acc[mi][ni] = mfma(af[mi], bfr[ni], acc[mi][ni]);  \
  }
  constexpr int BUF1 = 2 * 128 * 72;
  GLD(p, 0)
  GLD(q, 1)
  GST(p, 0)
  __syncthreads();
  GLD(p, 2)
  for (int kt = 0; kt < nk; kt += 2) {
    GCOMP(0)
    GST(q, BUF1)
    GLD(q, kt + 3)
    __syncthreads();
    GCOMP(BUF1)
    GST(p, 0)
    GLD(p, kt + 4)
    __syncthreads();
  }
#pragma unroll
  for (int mi = 0; mi < 4; ++mi)
#pragma unroll
    for (int ni = 0; ni < 4; ++ni) {
      int row0 = rt * 128 + wr * 64 + mi * 16 + fq * 4;
      int col = ct * 128 + wc * 64 + ni * 16 + fr;
      f32x4 v = acc[mi][ni];
      if (MODE == 1) {
#pragma unroll
        for (int r = 0; r < 4; ++r) o[(size_t)(row0 + r) * 1024 + col] = v[r];
      } else {
        if (ct >= 28 && ct < 32) {
          uint2 pk; pk.x = pk2(v[0], v[1]); pk.y = pk2(v[2], v[3]);
          *(uint2*)(zT + (size_t)(col - C_IC) * GR + row0) = pk;
        } else if (ct == 44) {
          if (col - C_AB < 16) {
#pragma unroll
            for (int r = 0; r < 4; ++r) ab[(size_t)(row0 + r) * 16 + (col - C_AB)] = v[r];
          }
        } else {
#pragma unroll
          for (int r = 0; r < 4; ++r) z[(size_t)(row0 + r) * NZ + col] = f2bf(v[r]);
        }
      }
    }
}

DEV void a_item(const P& p, int l, int item, int mode, char* smem) {
  float* xc = (float*)smem;
  u16* xcb = (u16*)(smem + 16384);
  float* av = (float*)(smem + 16384 + 9216);
  float* uv = av + 4096;
  float* segP = uv + 4096;
  float* segH = segP + 256;
  const int tid = opq(threadIdx.x), lane = tid & 63, w = tid >> 6, fr = lane & 15, fq = lane >> 4;
  const int cgk = item >> 3, hA = item & 7, n = cgk % 36, rb = cgk * 64;
  u16* z = (u16*)(p.ws + O_Z);
  {
    u16* xin = (u16*)av;
    uint4 st[3];
#pragma unroll
    for (int k = 0; k < 3; ++k) {
      int idx = tid + 256 * k, row = idx >> 3, sg = idx & 7, cp = row - 2;
      bool ok = (idx < 536) && !((cp < 0 && (n == 0 || n == 4)) || (cp > 63 && (n == 3 || n == 35)));
      st[k] = make_uint4(0u, 0u, 0u, 0u);
      if (ok) st[k] = *(const uint4*)(z + (size_t)(rb + cp) * NZ + C_XA + hA * 64 + sg * 8);
    }
    const int j = tid & 63, ch = hA * 64 + j;
    float cw0 = p.conv_a_w[(l * 4 + 0) * 512 + ch], cw1 = p.conv_a_w[(l * 4 + 1) * 512 + ch];
    float cw2 = p.conv_a_w[(l * 4 + 2) * 512 + ch], cw3 = p.conv_a_w[(l * 4 + 3) * 512 + ch];
    float cb = p.conv_a_b[l * 512 + ch];
#pragma unroll
    for (int k = 0; k < 3; ++k) {
      int idx = tid + 256 * k, row = idx >> 3, sg = idx & 7;
      if (idx < 536) *(uint4*)(xin + row * 72 + sg * 8) = st[k];
    }
    __syncthreads();
#pragma unroll
    for (int k = 0; k < 16; ++k) {
      int c = (tid >> 6) + 4 * k;
      float val = cb + cw0 * bf2f(xin[c * 72 + j]) + cw1 * bf2f(xin[(c + 1) * 72 + j]) + cw2 * bf2f(xin[(c + 2) * 72 + j]) +
                  cw3 * bf2f(xin[(c + 3) * 72 + j]);
      xc[c * 64 + j] = val;
      xcb[c * 72 + j] = f2bf(val);
    }
  }
  __syncthreads();
  float yacc[16];
#pragma unroll
  for (int k = 0; k < 16; ++k) yacc[k] = 0.f;
  const int seg = tid >> 6, sj = tid & 63, sch = hA * 64 + sj;
  for (int dir = 0; dir < 2; ++dir) {
    {
      const u16* wg = (const u16*)(p.ws + O_WGT);
      const u16* wr_ = wg + (size_t)((((l * 2 + dir) * 2 + 0) * 8 + hA)) * 4096;
      const u16* wi_ = wg + (size_t)((((l * 2 + dir) * 2 + 1) * 8 + hA)) * 4096;
      bf16x8 a0 = ld8(xcb + (16 * w + fr) * 72 + fq * 8), a1 = ld8(xcb + (16 * w + fr) * 72 + 32 + fq * 8);
#pragma unroll
      for (int nt = 0; nt < 4; ++nt) {
        f32x4 ar = {0.f, 0.f, 0.f, 0.f}, ai = {0.f, 0.f, 0.f, 0.f};
        const u16* br = wr_ + (nt * 16 + fr) * 64 + fq * 8;
        const u16* bi = wi_ + (nt * 16 + fr) * 64 + fq * 8;
        ar = mfma(a0, ld8(br), ar); ar = mfma(a1, ld8(br + 32), ar);
        ai = mfma(a0, ld8(bi), ai); ai = mfma(a1, ld8(bi + 32), ai);
        int j = nt * 16 + fr, ch = hA * 64 + j;
        float brv = p.rg_b_r[(l * 2 + dir) * 512 + ch], biv = p.rg_b_i[(l * 2 + dir) * 512 + ch];
        float sp = softplus(-p.rg_lam[(l * 2 + dir) * 512 + ch]);
#pragma unroll
        for (int r = 0; r < 4; ++r) {
          int c = 16 * w + 4 * fq + r;
          float rg = sigm(ar[r] + brv), ig = sigm(ai[r] + biv);
          float la = -8.f * rg * sp;
          float a = __expf(la);
          float t2 = 2.f * la;
          float om = (t2 > -0.02f) ? -t2 * (1.f + 0.5f * t2 * (1.f + t2 * (1.f / 3.f) * (1.f + 0.25f * t2))) : 1.f - a * a;
          float uu = sqrtf(fmaxf(om, 0.f)) * (ig * xc[c * 64 + j]);
          av[c * 64 + j] = bf2f(f2bf(la));
          uv[c * 64 + j] = bf2f(f2bf(uu));
        }
      }
    }
    __syncthreads();
    {
      float ls = 0.f, H = 0.f;
      u16* ALA = (u16*)(p.ws + O_ALA);
      u16* AU = (u16*)(p.ws + O_AU);
#pragma unroll
      for (int k = 0; k < 16; ++k) {
        int c = dir ? (16 * seg + 15 - k) : (16 * seg + k);
        float la_ = av[c * 64 + sj], u_ = uv[c * 64 + sj];
        H = __expf(la_) * H + u_;
        ls += la_;
        size_t gi = ((size_t)dir * GR + rb + c) * 512 + sch;
        ALA[gi] = f2bf(la_);
        AU[gi] = f2bf(u_);
      }
      segP[seg * 64 + sj] = __expf(ls);
      segH[seg * 64 + sj] = H;
    }
    __syncthreads();
    if (mode == 0) {
      if (seg == 0) {
        float Pc = 1.f, Hc = 0.f;
        for (int q = 0; q < 4; ++q) {
          int sg = dir ? 3 - q : q;
          Hc = segP[sg * 64 + sj] * Hc + segH[sg * 64 + sj];
          Pc *= segP[sg * 64 + sj];
        }
        size_t idx = ((size_t)cgk * 2 + dir) * 512 + sch;
        ((float*)(p.ws + O_AP))[idx] = Pc;
        ((float*)(p.ws + O_AH))[idx] = Hc;
      }
    } else {
      float st = ((const float*)(p.ws + O_ACAR))[((size_t)cgk * 2 + dir) * 512 + sch];
      int nbefore = dir ? 3 - seg : seg;
      for (int q = 0; q < nbefore; ++q) {
        int sg = dir ? 3 - q : q;
        st = segP[sg * 64 + sj] * st + segH[sg * 64 + sj];
      }
      if (dir == 0) {
#pragma unroll
        for (int k = 0; k < 16; ++k) {
          int c = 16 * seg + k;
          st = av[c * 64 + sj] * st + uv[c * 64 + sj];
          yacc[k] += st;
        }
      } else {
#pragma unroll
        for (int k = 15; k >= 0; --k) {
          int c = 16 * seg + k;
          st = av[c * 64 + sj] * st + uv[c * 64 + sj];
          yacc[k] += st;
        }
      }
    }
    __syncthreads();
  }
  if (mode == 1) {
#pragma unroll
    for (int k = 0; k < 16; ++k) {
      size_t zi = (size_t)(rb + 16 * seg + k) * NZ + C_GA + sch;
      float gate = bf2f(z[zi]);
      z[zi] = f2bf(yacc[k] * silu(gate));
    }
  }
}

DEV void a_fin(const P& p, int l, int item, char* smem) {
  float* segP = (float*)smem;
  float* segH = segP + 512;
  const int tid = opq(threadIdx.x), seg = tid >> 6, sj = tid & 63;
  const int cgk = item >> 3, hA = item & 7, rb = cgk * 64, sch = hA * 64 + sj;
  u16* z = (u16*)(p.ws + O_Z);
  const u16* ALA = (const u16*)(p.ws + O_ALA);
  const u16* AU = (const u16*)(p.ws + O_AU);
  u16 lab[2][16], ub[2][16], gt[16];
#pragma unroll
  for (int dir = 0; dir < 2; ++dir)
#pragma unroll
    for (int k = 0; k < 16; ++k) {
      size_t gi = ((size_t)dir * GR + rb + 16 * seg + k) * 512 + sch;
      lab[dir][k] = ALA[gi];
      ub[dir][k] = AU[gi];
    }
#pragma unroll
  for (int k = 0; k < 16; ++k) gt[k] = z[(size_t)(rb + 16 * seg + k) * NZ + C_GA + sch];
  float car0 = ((const float*)(p.ws + O_ACAR))[((size_t)cgk * 2 + 0) * 512 + sch];
  float car1 = ((const float*)(p.ws + O_ACAR))[((size_t)cgk * 2 + 1) * 512 + sch];
  float af[2][16];
#pragma unroll
  for (int dir = 0; dir < 2; ++dir) {
    float ls = 0.f, H = 0.f;
#pragma unroll
    for (int kk = 0; kk < 16; ++kk) {
      const int k = dir ? 15 - kk : kk;
      float la_ = bf2f(lab[dir][k]);
      float a = __expf(la_);
      af[dir][k] = a;
      H = a * H + bf2f(ub[dir][k]);
      ls += la_;
    }
    segP[(dir * 4 + seg) * 64 + sj] = __expf(ls);
    segH[(dir * 4 + seg) * 64 + sj] = H;
  }
  __syncthreads();
  float yacc[16];
#pragma unroll
  for (int k = 0; k < 16; ++k) yacc[k] = 0.f;
#pragma unroll
  for (int dir = 0; dir < 2; ++dir) {
    float st = dir ? car1 : car0;
    const int nbefore = dir ? 3 - seg : seg;
    for (int q = 0; q < nbefore; ++q) {
      int sg = dir ? 3 - q : q;
      st = segP[(dir * 4 + sg) * 64 + sj] * st + segH[(dir * 4 + sg) * 64 + sj];
    }
#pragma unroll
    for (int kk = 0; kk < 16; ++kk) {
      const int k = dir ? 15 - kk : kk;
      st = af[dir][k] * st + bf2f(ub[dir][k]);
      yacc[k] += st;
    }
  }
#pragma unroll
  for (int k = 0; k < 16; ++k)
    z[(size_t)(rb + 16 * seg + k) * NZ + C_GA + sch] = f2bf(yacc[k] * silu(bf2f(gt[k])));
  __syncthreads();
}

DEV void a_fin2(const P& p, int l, int item, char* smem) {
  float* segP = (float*)smem;
  float* segH = segP + 1024;
  const int tid = opq(threadIdx.x), sg = tid >> 5, cp = tid & 31;
  const int cgk = item >> 3, hA = item & 7, rb = cgk * 64, sch = hA * 64 + 2 * cp;
  u16* z = (u16*)(p.ws + O_Z);
  const u16* ALA = (const u16*)(p.ws + O_ALA);
  const u16* AU = (const u16*)(p.ws + O_AU);
  unsigned lab[2][8], ub[2][8], gt[8];
#pragma unroll
  for (int dir = 0; dir < 2; ++dir)
#pragma unroll
    for (int k = 0; k < 8; ++k) {
      size_t gi = ((size_t)dir * GR + rb + 8 * sg + k) * 512 + sch;
      lab[dir][k] = *(const unsigned*)(ALA + gi);
      ub[dir][k] = *(const unsigned*)(AU + gi);
    }
#pragma unroll
  for (int k = 0; k < 8; ++k) gt[k] = *(const unsigned*)(z + (size_t)(rb + 8 * sg + k) * NZ + C_GA + sch);
  const float2 car0 = *(const float2*)((const float*)(p.ws + O_ACAR) + ((size_t)cgk * 2 + 0) * 512 + sch);
  const float2 car1 = *(const float2*)((const float*)(p.ws + O_ACAR) + ((size_t)cgk * 2 + 1) * 512 + sch);
  float af[2][8][2];
#pragma unroll
  for (int dir = 0; dir < 2; ++dir) {
    float ls0 = 0.f, ls1 = 0.f, H0 = 0.f, H1 = 0.f;
#pragma unroll
    for (int kk = 0; kk < 8; ++kk) {
      const int k = dir ? 7 - kk : kk;
      float l0 = bf2f((u16)(lab[dir][k] & 0xffff)), l1 = bf2f((u16)(lab[dir][k] >> 16));
      float a0 = __expf(l0), a1 = __expf(l1);
      af[dir][k][0] = a0; af[dir][k][1] = a1;
      H0 = a0 * H0 + bf2f((u16)(ub[dir][k] & 0xffff));
      H1 = a1 * H1 + bf2f((u16)(ub[dir][k] >> 16));
      ls0 += l0; ls1 += l1;
    }
    *(float2*)(segP + (dir * 8 + sg) * 64 + 2 * cp) = make_float2(__expf(ls0), __expf(ls1));
    *(float2*)(segH + (dir * 8 + sg) * 64 + 2 * cp) = make_float2(H0, H1);
  }
  __syncthreads();
  float y0[8], y1[8];
#pragma unroll
  for (int k = 0; k < 8; ++k) { y0[k] = 0.f; y1[k] = 0.f; }
#pragma unroll
  for (int dir = 0; dir < 2; ++dir) {
    float s0 = dir ? car1.x : car0.x, s1 = dir ? car1.y : car0.y;
    const int nbefore = dir ? 7 - sg : sg;
    for (int q = 0; q < nbefore; ++q) {
      int sq = dir ? 7 - q : q;
      float2 pp = *(const float2*)(segP + (dir * 8 + sq) * 64 + 2 * cp);
      float2 hh = *(const float2*)(segH + (dir * 8 + sq) * 64 + 2 * cp);
      s0 = pp.x * s0 + hh.x;
      s1 = pp.y * s1 + hh.y;
    }
#pragma unroll
    for (int kk = 0; kk < 8; ++kk) {
      const int k = dir ? 7 - kk : kk;
      s0 = af[dir][k][0] * s0 + bf2f((u16)(ub[dir][k] & 0xffff));
      s1 = af[dir][k][1] * s1 + bf2f((u16)(ub[dir][k] >> 16));
      y0[k] += s0; y1[k] += s1;
    }
  }
#pragma unroll
  for (int k = 0; k < 8; ++k) {
    float g0 = bf2f((u16)(gt[k] & 0xffff)), g1 = bf2f((u16)(gt[k] >> 16));
    *(unsigned*)(z + (size_t)(rb + 8 * sg + k) * NZ + C_GA + sch) = pk2(y0[k] * silu(g0), y1[k] * silu(g1));
  }
  __syncthreads();
}

DEV void a_carry(const P& p, int item) {
  int t = item * 256 + threadIdx.x;
  int ch = t & 511, dir = (t >> 9) & 1, lb = t >> 10;
  const float* AP = (const float*)(p.ws + O_AP);
  const float* AH = (const float*)(p.ws + O_AH);
  float* AC = (float*)(p.ws + O_ACAR);
  float st = 0.f;
  float pv[36], hv[36];
#pragma unroll
  for (int j = 0; j < 36; ++j) {
    int n = dir ? (j < 4 ? 3 - j : 39 - j) : j;
    size_t idx = ((size_t)(lb * 36 + n) * 2 + dir) * 512 + ch;
    pv[j] = AP[idx];
    hv[j] = AH[idx];
  }
#pragma unroll
  for (int j = 0; j < 36; ++j) {
    int n = dir ? (j < 4 ? 3 - j : 39 - j) : j;
    size_t idx = ((size_t)(lb * 36 + n) * 2 + dir) * 512 + ch;
    AC[idx] = st;
    st = pv[j] * st + hv[j];
  }
}

DEV void b_local(const P& p, int l, int item, char* smem) {
  u16* qs = (u16*)smem;
  u16* ks = qs + 64 * 136;
  float* Am = (float*)(smem + 34816);
  float* gc = (float*)(smem + 34816 + 32768);
  float* bt = gc + 128;
  const int tid = opq(threadIdx.x), lane = tid & 63, w = tid >> 6, fr = lane & 15, fq = lane >> 4;
  const int cgk = item >> 2, h = item & 3, n = cgk % 36, rb = cgk * 64;
  const u16* z = (const u16*)(p.ws + O_Z);
  u16* qn = (u16*)(p.ws + O_BSH);
  u16* kn = qn + (size_t)GR * 512;
  u16* vb = kn + (size_t)GR * 512;
  u16* knT = vb + (size_t)GR * 512;
  const float* ab = (const float*)(p.ws + O_AB);
  {
    u16* Tt = (u16*)Am;
    uint4 st[5];
#define BL_TLOAD(which)                                                                                  \
  _Pragma("unroll") for (int k = 0; k < 5; ++k) {                                                        \
    int idx = tid + 256 * k, row = idx >> 4, seg = idx & 15, cp = row - 2;                               \
    bool ok = (idx < 1072) && !((cp < 0 && (n == 0 || n == 4)) || (cp > 63 && (n == 3 || n == 35)));    \
    st[k] = make_uint4(0u, 0u, 0u, 0u);                                                                  \
    if (ok) st[k] = *(const uint4*)(z + (size_t)(rb + cp) * NZ + C_Q + (which)*512 + h * 128 + seg * 8); \
  }
    BL_TLOAD(0)
#pragma unroll
    for (int which = 0; which < 3; ++which) {
#pragma unroll
      for (int k = 0; k < 5; ++k) {
        int idx = tid + 256 * k, row = idx >> 4, seg = idx & 15;
        if (idx < 1072) *(uint4*)(Tt + row * 136 + seg * 8) = st[k];
      }
      __syncthreads();
      if (which < 2) { BL_TLOAD(which + 1) }
      float cw[2][4];
#pragma unroll
      for (int hh = 0; hh < 2; ++hh)
#pragma unroll
        for (int tap = 0; tap < 4; ++tap)
          cw[hh][tap] = p.conv_b_w[(size_t)(l * 4 + tap) * 1536 + which * 512 + h * 128 + lane + 64 * hh];
#pragma unroll 4
      for (int c = w; c < 64; c += 4) {
        float v[2];
#pragma unroll
        for (int hh = 0; hh < 2; ++hh) {
          int d = lane + 64 * hh;
          float a = 0.f;
#pragma unroll
          for (int tap = 0; tap < 4; ++tap) a += cw[hh][tap] * bf2f(Tt[(c + tap) * 136 + d]);
          v[hh] = silu(a);
        }
        float rs = 1.f;
        if (which < 2) {
          float sq = v[0] * v[0] + v[1] * v[1];
#pragma unroll
          for (int off = 32; off; off >>= 1) sq += __shfl_xor(sq, off);
          rs = rsqrtf(sq + EPS) * (which == 0 ? 0.08838834764831845f : 1.f);
        }
#pragma unroll
        for (int hh = 0; hh < 2; ++hh) {
          int d = lane + 64 * hh;
          u16 ob = f2bf(v[hh] * rs);
          size_t gi = (size_t)(rb + c) * 512 + h * 128 + d;
          if (which == 0) { qs[c * 136 + d] = ob; qn[gi] = ob; }
          else if (which == 1) { ks[c * 136 + d] = ob; kn[gi] = ob; }
          else vb[gi] = ob;
        }
      }
      __syncthreads();
    }
  }
  if (w < 2) {
    int dir = w, i = lane, c = dir ? 63 - i : i;
    float al = ab[(size_t)(rb + c) * 16 + dir * 4 + h], bl = ab[(size_t)(rb + c) * 16 + 8 + dir * 4 + h];
    float g = -__expf(p.gdn_a_log[(l * 2 + dir) * 4 + h]) * softplus(al + p.gdn_dt_bias[(l * 2 + dir) * 4 + h]);
#pragma unroll
    for (int off = 1; off < 64; off <<= 1) {
      float v = __shfl_up(g, off);
      if (lane >= off) g += v;
    }
    gc[dir * 64 + i] = g;
    bt[dir * 64 + i] = sigm(bl);
  }
  __syncthreads();
  for (int idx = tid; idx < 1024; idx += 256) {
    int d = idx >> 3, c8 = idx & 7;
    uint4 pk;
    pk.x = (unsigned)ks[(c8 * 8 + 0) * 136 + d] | ((unsigned)ks[(c8 * 8 + 1) * 136 + d] << 16);
    pk.y = (unsigned)ks[(c8 * 8 + 2) * 136 + d] | ((unsigned)ks[(c8 * 8 + 3) * 136 + d] << 16);
    pk.z = (unsigned)ks[(c8 * 8 + 4) * 136 + d] | ((unsigned)ks[(c8 * 8 + 5) * 136 + d] << 16);
    pk.w = (unsigned)ks[(c8 * 8 + 6) * 136 + d] | ((unsigned)ks[(c8 * 8 + 7) * 136 + d] << 16);
    *(uint4*)(knT + ((size_t)(cgk * 4 + h) * 128 + d) * 64 + c8 * 8) = pk;
  }
  for (int dir = 0; dir < 2; ++dir) {
    char* rec = p.ws + O_BIT + ((size_t)(cgk * 4 + h) * 2 + dir) * BIT_SZ;
    u16* QKm = (u16*)rec + 4096;
    float* scal = (float*)(rec + 16384);
    int irow = 16 * w + fr, ci = dir ? 63 - irow : irow;
    bf16x8 ak[4], aq[4];
#pragma unroll
    for (int s = 0; s < 4; ++s) { ak[s] = ld8(ks + ci * 136 + 32 * s + 8 * fq); aq[s] = ld8(qs + ci * 136 + 32 * s + 8 * fq); }
#pragma unroll
    for (int nt = 0; nt < 4; ++nt) {
      int jcol = 16 * nt + fr, cj = dir ? 63 - jcol : jcol;
      f32x4 kk = {0.f, 0.f, 0.f, 0.f}, qk = {0.f, 0.f, 0.f, 0.f};
#pragma unroll
      for (int s = 0; s < 4; ++s) {
        bf16x8 b = ld8(ks + cj * 136 + 32 * s + 8 * fq);
        kk = mfma(ak[s], b, kk);
        qk = mfma(aq[s], b, qk);
      }
      float gj = gc[dir * 64 + jcol];
#pragma unroll
      for (int r = 0; r < 4; ++r) {
        int i = 16 * w + 4 * fq + r;
        float dec = (jcol <= i) ? __expf(gc[dir * 64 + i] - gj) : 0.f;
        Am[(dir * 64 + i) * 64 + jcol] = (jcol < i) ? bt[dir * 64 + i] * kk[r] * dec : 0.f;
        QKm[i * 64 + jcol] = f2bf(qk[r] * dec);
      }
    }
    if (tid < 64) {
      float gl = gc[dir * 64 + 63], gi = gc[dir * 64 + tid];
      scal[tid] = __expf(gi);
      scal[64 + tid] = bt[dir * 64 + tid];
      scal[128 + tid] = __expf(gl - gi);
      if (tid == 0) scal[192] = __expf(gl);
    }
  }
  __syncthreads();
  if (w < 2) {
    int dir = w, col = lane;
    u16* Tinv = (u16*)(p.ws + O_BIT + ((size_t)(cgk * 4 + h) * 2 + dir) * BIT_SZ);
    const float* Ad = Am + dir * 4096;
    float T[64];
#pragma unroll
    for (int i = 0; i < 64; ++i) {
      float s = (i == col) ? 1.f : 0.f;
#pragma unroll
      for (int j = 0; j < i; ++j) s -= Ad[i * 64 + j] * T[j];
      T[i] = s;
      Tinv[i * 64 + col] = f2bf(s);
      __builtin_amdgcn_sched_barrier(0);
    }
  }
  __syncthreads();
}

DEV void b_seq(const P& p, int bitem, char* smem) {
  const int tid = opq(threadIdx.x), lane = tid & 63, w = tid >> 6, fr = lane & 15, fq = lane >> 4;
  const bool active = w < WPB;
  const int item = bitem * WPB + (active ? w : 0);
  const int slice = item & 7, dir = (item >> 3) & 1, h = (item >> 4) & 3, lb = item >> 6, e0 = slice * 16;
  u16* Ss = (u16*)(smem + w * 11264);
  u16* Rs = Ss + 16 * 136;
  u16* Vsc = Rs + 16 * 72;
  u16* Vor = Vsc + 16 * 72;
  const u16* qn = (const u16*)(p.ws + O_BSH);
  const u16* kn = qn + (size_t)GR * 512;
  const u16* vb = kn + (size_t)GR * 512;
  const u16* knT = vb + (size_t)GR * 512;
  u16* OB = (u16*)(p.ws + O_OB);
  f32x4 S[8];
#pragma unroll
  for (int m = 0; m < 8; ++m) S[m] = (f32x4){0.f, 0.f, 0.f, 0.f};
  for (int j = 0; j < 36; ++j) {
    const int n = dir ? (j < 4 ? 3 - j : 39 - j) : j;
    const int cgk = lb * 36 + n, rb = cgk * 64;
    const char* rec = p.ws + O_BIT + ((size_t)(cgk * 4 + h) * 2 + dir) * BIT_SZ;
    const u16* Tinv = (const u16*)rec;
    const u16* QKm = Tinv + 4096;
    const float* scal = (const float*)(rec + 16384);
    if (active) {
#pragma unroll
      for (int m = 0; m < 8; ++m) {
        uint2 pk; pk.x = pk2(S[m][0], S[m][1]); pk.y = pk2(S[m][2], S[m][3]);
        *(uint2*)(Ss + fr * 136 + 16 * m + 4 * fq) = pk;
      }
    }
    __syncthreads();
    bf16x8 Sf[4];
    if (active) {
#pragma unroll
      for (int s = 0; s < 4; ++s) Sf[s] = ld8(Ss + fr * 136 + 32 * s + 8 * fq);
#pragma unroll
      for (int m = 0; m < 4; ++m) {
        int i = 16 * m + fr, rowi = rb + (dir ? 63 - i : i);
        f32x4 X = {0.f, 0.f, 0.f, 0.f};
#pragma unroll
        for (int s = 0; s < 4; ++s) X = mfma(ld8(kn + (size_t)rowi * 512 + h * 128 + 32 * s + 8 * fq), Sf[s], X);
        float rv[4];
#pragma unroll
        for (int r = 0; r < 4; ++r) {
          int ii = 16 * m + 4 * fq + r, rowr = rb + (dir ? 63 - ii : ii);
          float v = bf2f(vb[(size_t)rowr * 512 + h * 128 + e0 + fr]);
          rv[r] = scal[64 + ii] * (v - scal[ii] * X[r]);
        }
        uint2 pk; pk.x = pk2(rv[0], rv[1]); pk.y = pk2(rv[2], rv[3]);
        *(uint2*)(Rs + fr * 72 + 16 * m + 4 * fq) = pk;
      }
    }
    __syncthreads();
    if (active) {
      bf16x8 Rf0 = ld8(Rs + fr * 72 + 8 * fq), Rf1 = ld8(Rs + fr * 72 + 32 + 8 * fq);
#pragma unroll
      for (int m = 0; m < 4; ++m) {
        f32x4 VN = {0.f, 0.f, 0.f, 0.f};
        VN = mfma(ld8(Tinv + (16 * m + fr) * 64 + 8 * fq), Rf0, VN);
        VN = mfma(ld8(Tinv + (16 * m + fr) * 64 + 32 + 8 * fq), Rf1, VN);
        uint2 pk; pk.x = pk2(VN[0], VN[1]); pk.y = pk2(VN[2], VN[3]);
        *(uint2*)(Vsc + fr * 72 + 16 * m + 4 * fq) = pk;
        int ib = 16 * m + 4 * fq;
        float s0 = VN[0] * scal[128 + ib], s1 = VN[1] * scal[128 + ib + 1], s2 = VN[2] * scal[128 + ib + 2],
              s3 = VN[3] * scal[128 + ib + 3];
        if (dir) {
          pk.x = pk2(s3, s2); pk.y = pk2(s1, s0);
          *(uint2*)(Vor + fr * 72 + (60 - ib)) = pk;
        } else {
          pk.x = pk2(s0, s1); pk.y = pk2(s2, s3);
          *(uint2*)(Vor + fr * 72 + ib) = pk;
        }
      }
    }
    __syncthreads();
    if (active) {
      bf16x8 Vs0 = ld8(Vsc + fr * 72 + 8 * fq), Vs1 = ld8(Vsc + fr * 72 + 32 + 8 * fq);
      bf16x8 Vo0 = ld8(Vor + fr * 72 + 8 * fq), Vo1 = ld8(Vor + fr * 72 + 32 + 8 * fq);
#pragma unroll
      for (int m = 0; m < 4; ++m) {
        int i = 16 * m + fr, rowi = rb + (dir ? 63 - i : i);
        f32x4 O = {0.f, 0.f, 0.f, 0.f};
#pragma unroll
        for (int s = 0; s < 4; ++s) O = mfma(ld8(qn + (size_t)rowi * 512 + h * 128 + 32 * s + 8 * fq), Sf[s], O);
#pragma unroll
        for (int r = 0; r < 4; ++r) O[r] *= scal[16 * m + 4 * fq + r];
        O = mfma(ld8(QKm + (16 * m + fr) * 64 + 8 * fq), Vs0, O);
        O = mfma(ld8(QKm + (16 * m + fr) * 64 + 32 + 8 * fq), Vs1, O);
#pragma unroll
        for (int r = 0; r < 4; ++r) {
          int ii = 16 * m + 4 * fq + r, rowr = rb + (dir ? 63 - ii : ii);
          OB[((size_t)dir * GR + rowr) * 512 + h * 128 + e0 + fr] = f2bf(O[r]);
        }
      }
      float egl = scal[192];
#pragma unroll
      for (int m = 0; m < 8; ++m) {
        const u16* kt = knT + ((size_t)(cgk * 4 + h) * 128 + 16 * m + fr) * 64;
        f32x4 t = S[m];
#pragma unroll
        for (int r = 0; r < 4; ++r) t[r] *= egl;
        t = mfma(ld8(kt + 8 * fq), Vo0, t);
        t = mfma(ld8(kt + 32 + 8 * fq), Vo1, t);
        S[m] = t;
      }
    }
  }
  __syncthreads();
}

DEV void c_local(const P& p, int l, int item, char* smem) {
  float* bsm = (float*)smem;
  u16* Ps = (u16*)(smem + 33024);
  u16* kdt = (u16*)(smem + 33024 + 9216);
  const int tid = opq(threadIdx.x), lane = tid & 63, w = tid >> 6, fr = lane & 15, fq = lane >> 4;
  const int cgk = item >> 2, h = item & 3, rb = cgk * 64;
  const u16* z = (const u16*)(p.ws + O_Z);
  const u16* zT = (const u16*)(p.ws + O_ZT);
  u16* OC = (u16*)(p.ws + O_OC);
  const float* lbs = (const float*)(p.ws + O_LBS);
  for (int dir = 0; dir < 2; ++dir) {
    char* rec = p.ws + O_CREC + ((size_t)(cgk * 4 + h) * 2 + dir) * CREC_SZ;
    u16* QD = (u16*)rec;
    u16* KDT = QD + 8192;
    float* decv = (float*)(rec + 32768);
    const float* lbp = lbs + l * 1024 + dir * 512 + h * 128;
    const int fcol = C_F0 + dir * 512 + h * 128;
    {
      int d = tid & 127, half = tid >> 7;
      float lb_ = lbp[d], run = 0.f;
      for (int k = 0; k < 32; ++k) {
        int i = 32 * half + k, c = dir ? 63 - i : i;
        float f = bf2f(z[(size_t)(rb + c) * NZ + fcol + d]);
        float fg = lb_ + (1.f - lb_) * sigm(f);
        run += __logf(fg);
        bsm[i * 129 + d] = run;
      }
    }
    __syncthreads();
    {
      int d = tid & 127, half = tid >> 7;
      if (half) {
        float add = bsm[31 * 129 + d];
        for (int k = 0; k < 32; ++k) bsm[(32 + k) * 129 + d] += add;
      }
    }
    __syncthreads();
    for (int idx = tid; idx < 8192; idx += 256) {
      int i = idx >> 7, d = idx & 127, c = dir ? 63 - i : i;
      float b = bsm[i * 129 + d];
      float q = silu(bf2f(z[(size_t)(rb + c) * NZ + C_QC + h * 128 + d]));
      QD[i * 128 + d] = f2bf(q * __expf(b));
      float f = bf2f(z[(size_t)(rb + c) * NZ + fcol + d]);
      float k = (1.f - lbp[d]) * sigm(-f);
      kdt[d * 72 + c] = f2bf(k * __expf(bsm[63 * 129 + d] - b));
    }
    if (tid < 128) decv[tid] = __expf(bsm[63 * 129 + tid]);
    __syncthreads();
    for (int idx = tid; idx < 1024; idx += 256) {
      int d = idx >> 3, c8 = idx & 7;
      *(uint4*)(KDT + d * 64 + c8 * 8) = *(const uint4*)(kdt + d * 72 + c8 * 8);
    }
    {
      const int sj = w;
      for (int si = 0; si < 4; ++si) {
        f32x4 acc = {0.f, 0.f, 0.f, 0.f};
        if (si >= sj) {
          int it = 16 * si + fr, jt = 16 * sj + fr;
          int ci = dir ? 63 - it : it, cj = dir ? 63 - jt : jt;
#pragma unroll
          for (int s = 0; s < 4; ++s) {
            int d0 = 32 * s + 8 * fq;
            bf16x8 qv = ld8(z + (size_t)(rb + ci) * NZ + C_QC + h * 128 + d0);
            bf16x8 fv = ld8(z + (size_t)(rb + cj) * NZ + fcol + d0);
            bf16x8 af, bf;
#pragma unroll
            for (int e = 0; e < 8; ++e) {
              int d = d0 + e;
              float Bs_ = si ? bsm[(16 * si - 1) * 129 + d] : 0.f;
              float qq = silu(bf2f((u16)qv[e])) * __expf(bsm[it * 129 + d] - Bs_);
              float kk = (1.f - lbp[d]) * sigm(-bf2f((u16)fv[e])) * __expf(Bs_ - bsm[jt * 129 + d]);
              af[e] = (short)f2bf(qq);
              bf[e] = (short)f2bf(kk);
            }
            acc = mfma(af, bf, acc);
          }
        }
#pragma unroll
        for (int r = 0; r < 4; ++r) {
          int i = 16 * si + 4 * fq + r, jj = 16 * sj + fr;
          float v = (si >= sj && jj <= i) ? acc[r] : 0.f;
          Ps[i * 72 + (dir ? 63 - jj : jj)] = f2bf(v);
        }
        __builtin_amdgcn_sched_barrier(0);
      }
    }
    __syncthreads();
#pragma unroll
    for (int nt2 = 0; nt2 < 2; ++nt2) {
      int e = h * 128 + (2 * w + nt2) * 16 + fr;
      bf16x8 v0 = ld8(zT + (size_t)e * GR + rb + 8 * fq), v1 = ld8(zT + (size_t)e * GR + rb + 32 + 8 * fq);
#pragma unroll
      for (int m = 0; m < 4; ++m) {
        f32x4 O = {0.f, 0.f, 0.f, 0.f};
        O = mfma(ld8(Ps + (16 * m + fr) * 72 + 8 * fq), v0, O);
        O = mfma(ld8(Ps + (16 * m + fr) * 72 + 32 + 8 * fq), v1, O);
#pragma unroll
        for (int r = 0; r < 4; ++r) {
          int ii = 16 * m + 4 * fq + r, rowr = rb + (dir ? 63 - ii : ii);
          OC[((size_t)dir * GR + rowr) * 512 + e] = f2bf(O[r]);
        }
      }
    }
    __syncthreads();
  }
}

DEV void c_seq(const P& p, int bitem, char* smem) {
  const int tid = opq(threadIdx.x), lane = tid & 63, w = tid >> 6, fr = lane & 15, fq = lane >> 4;
  const bool active = w < WPB;
  const int item = bitem * WPB + (active ? w : 0);
  const int slice = item & 7, dir = (item >> 3) & 1, h = (item >> 4) & 3, lb = item >> 6, e0 = slice * 16;
  u16* Ss = (u16*)(smem + w * 4352);
  const u16* zT = (const u16*)(p.ws + O_ZT);
  u16* OC = (u16*)(p.ws + O_OC);
  f32x4 S[8];
#pragma unroll
  for (int m = 0; m < 8; ++m) S[m] = (f32x4){0.f, 0.f, 0.f, 0.f};
  for (int j = 0; j < 36; ++j) {
    const int n = dir ? (j < 4 ? 3 - j : 39 - j) : j;
    const int cgk = lb * 36 + n, rb = cgk * 64;
    const char* rec = p.ws + O_CREC + ((size_t)(cgk * 4 + h) * 2 + dir) * CREC_SZ;
    const u16* QD = (const u16*)rec;
    const u16* KDT = QD + 8192;
    const float* decv = (const float*)(rec + 32768);
    if (active) {
#pragma unroll
      for (int m = 0; m < 8; ++m) {
        uint2 pk; pk.x = pk2(S[m][0], S[m][1]); pk.y = pk2(S[m][2], S[m][3]);
        *(uint2*)(Ss + fr * 136 + 16 * m + 4 * fq) = pk;
      }
    }
    __syncthreads();
    if (active) {
      bf16x8 Sf[4];
#pragma unroll
      for (int s = 0; s < 4; ++s) Sf[s] = ld8(Ss + fr * 136 + 32 * s + 8 * fq);
#pragma unroll
      for (int m = 0; m < 4; ++m) {
        f32x4 O = {0.f, 0.f, 0.f, 0.f};
#pragma unroll
        for (int s = 0; s < 4; ++s) O = mfma(ld8(QD + (16 * m + fr) * 128 + 32 * s + 8 * fq), Sf[s], O);
#pragma unroll
        for (int r = 0; r < 4; ++r) {
          int ii = 16 * m + 4 * fq + r, rowr = rb + (dir ? 63 - ii : ii);
          size_t oi = ((size_t)dir * GR + rowr) * 512 + h * 128 + e0 + fr;
          OC[oi] = f2bf(bf2f(OC[oi]) + O[r]);
        }
      }
      const u16* vp = zT + (size_t)(h * 128 + e0 + fr) * GR + rb;
      bf16x8 V0 = ld8(vp + 8 * fq), V1 = ld8(vp + 32 + 8 * fq);
#pragma unroll
      for (int m = 0; m < 8; ++m) {
        f32x4 t = S[m];
#pragma unroll
        for (int r = 0; r < 4; ++r) t[r] *= decv[16 * m + 4 * fq + r];
        t = mfma(ld8(KDT + (16 * m + fr) * 64 + 8 * fq), V0, t);
        t = mfma(ld8(KDT + (16 * m + fr) * 64 + 32 + 8 * fq), V1, t);
        S[m] = t;
      }
    }
    __syncthreads();
  }
}

#define LBAR()                                              \
  do {                                                      \
    asm volatile("s_waitcnt lgkmcnt(0)" ::: "memory");      \
    __builtin_amdgcn_s_barrier();                           \
    asm volatile("" ::: "memory");                          \
  } while (0)
#define CBAR() asm volatile("" ::: "memory")

DEV void c_local2(const P& p, int l, int item, char* smem) {
  float* bsm = (float*)smem;
  u16* Fq = (u16*)(smem + 33024);
  u16* kdt = (u16*)(smem + 50432);
  u16* Ps = kdt;
  const int tid = opq(threadIdx.x), lane = tid & 63, w = tid >> 6, fr = lane & 15, fq = lane >> 4;
  const int cgk = item >> 2, h = item & 3, rb = cgk * 64;
  const u16* z = (const u16*)(p.ws + O_Z);
  const u16* zT = (const u16*)(p.ws + O_ZT);
  u16* OC = (u16*)(p.ws + O_OC);
  const float* lbs = (const float*)(p.ws + O_LBS);
  u16* zq = (u16*)(p.ws + O_Z) + (size_t)rb * NZ + C_QC + h * 128;
  {
    uint4 t4[4];
#pragma unroll
    for (int k = 0; k < 4; ++k) {
      int idx = tid + 256 * k, c = idx >> 4, seg = idx & 15;
      t4[k] = *(const uint4*)(zq + (size_t)c * NZ + seg * 8);
    }
#pragma unroll
    for (int k = 0; k < 4; ++k) {
      int idx = tid + 256 * k, c = idx >> 4, seg = idx & 15;
      unsigned wv[4] = {t4[k].x, t4[k].y, t4[k].z, t4[k].w};
#pragma unroll
      for (int q = 0; q < 4; ++q)
        wv[q] = pk2(silu(bf2f((u16)(wv[q] & 0xffff))), silu(bf2f((u16)(wv[q] >> 16))));
      *(uint4*)(zq + (size_t)c * NZ + seg * 8) = make_uint4(wv[0], wv[1], wv[2], wv[3]);
    }
  }
  __syncthreads();
  for (int dir = 0; dir < 2; ++dir) {
    char* rec = p.ws + O_CREC + ((size_t)(cgk * 4 + h) * 2 + dir) * CREC_SZ;
    u16* QD = (u16*)rec;
    u16* KDT = QD + 8192;
    float* decv = (float*)(rec + 32768);
    const float* lbp = lbs + l * 1024 + dir * 512 + h * 128;
    const int fcol = C_F0 + dir * 512 + h * 128;
    {
      uint4 t4[4];
#pragma unroll
      for (int k = 0; k < 4; ++k) {
        int idx = tid + 256 * k, c = idx >> 4, seg = idx & 15;
        t4[k] = *(const uint4*)(z + (size_t)(rb + c) * NZ + fcol + seg * 8);
      }
#pragma unroll
      for (int k = 0; k < 4; ++k) {
        int idx = tid + 256 * k, c = idx >> 4, seg = idx & 15;
        *(uint4*)(Fq + c * 136 + seg * 8) = t4[k];
      }
    }
    __syncthreads();
    {
      int d = tid & 127, half = tid >> 7;
      float lb_ = lbp[d], run = 0.f;
#pragma unroll 8
      for (int k = 0; k < 32; ++k) {
        int i = 32 * half + k, c = dir ? 63 - i : i;
        float f = bf2f(Fq[c * 136 + d]);
        float fg = lb_ + (1.f - lb_) * sigm(f);
        run += __logf(fg);
        bsm[i * 129 + d] = run;
      }
    }
    __syncthreads();
    {
      int d = tid & 127, half = tid >> 7;
      if (half) {
        float add = bsm[31 * 129 + d];
#pragma unroll 8
        for (int k = 0; k < 32; ++k) bsm[(32 + k) * 129 + d] += add;
      }
    }
    __syncthreads();
    {
      uint4 qv[4];
#pragma unroll
      for (int k = 0; k < 4; ++k) {
        int idx = tid + 256 * k, c = idx >> 4, seg = idx & 15;
        qv[k] = *(const uint4*)(zq + (size_t)c * NZ + seg * 8);
      }
#pragma unroll
      for (int k = 0; k < 4; ++k) {
        int idx = tid + 256 * k, c = idx >> 4, seg = idx & 15, i = dir ? 63 - c : c, d0 = seg * 8;
        unsigned qw[4] = {qv[k].x, qv[k].y, qv[k].z, qv[k].w};
        uint4 fv4 = *(const uint4*)(Fq + c * 136 + d0);
        unsigned fw[4] = {fv4.x, fv4.y, fv4.z, fv4.w};
        unsigned qo[4], ko[4];
#pragma unroll
        for (int q = 0; q < 4; ++q) {
          int d = d0 + 2 * q;
          float b0 = bsm[i * 129 + d], b1 = bsm[i * 129 + d + 1];
          float bl0 = bsm[63 * 129 + d], bl1 = bsm[63 * 129 + d + 1];
          float q0 = bf2f((u16)(qw[q] & 0xffff)), q1 = bf2f((u16)(qw[q] >> 16));
          qo[q] = pk2(q0 * __expf(b0), q1 * __expf(b1));
          float k0 = (1.f - lbp[d]) * sigm(-bf2f((u16)(fw[q] & 0xffff)));
          float k1 = (1.f - lbp[d + 1]) * sigm(-bf2f((u16)(fw[q] >> 16)));
          ko[q] = pk2(k0, k1);
          kdt[d * 72 + c] = f2bf(k0 * __expf(bl0 - b0));
          kdt[(d + 1) * 72 + c] = f2bf(k1 * __expf(bl1 - b1));
        }
        *(uint4*)(QD + i * 128 + d0) = make_uint4(qo[0], qo[1], qo[2], qo[3]);
        *(uint4*)(Fq + c * 136 + d0) = make_uint4(ko[0], ko[1], ko[2], ko[3]);
      }
      if (tid < 128) decv[tid] = __expf(bsm[63 * 129 + tid]);
    }
    __syncthreads();
    for (int idx = tid; idx < 1024; idx += 256) {
      int d = idx >> 3, c8 = idx & 7;
      *(uint4*)(KDT + d * 64 + c8 * 8) = *(const uint4*)(kdt + d * 72 + c8 * 8);
    }
    bf16x8 qf[3][4];
#pragma unroll
    for (int t = 0; t < 3; ++t) {
      int k = w + 4 * t;
      int si = k < 4 ? 3 : (k < 7 ? 2 : (k < 9 ? 1 : 0));
      int it_ = 16 * si + fr, ci_ = dir ? 63 - it_ : it_;
#pragma unroll
      for (int s = 0; s < 4; ++s) qf[t][s] = ld8(zq + (size_t)ci_ * NZ + 32 * s + 8 * fq);
    }
    __syncthreads();
    for (int idx = tid; idx < 1536; idx += 256) {
      int tl = idx >> 8, e = idx & 255, r16 = e >> 4, c16 = e & 15;
      int si = tl < 3 ? 0 : (tl < 5 ? 1 : 2);
      int sj = tl < 3 ? tl + 1 : (tl < 5 ? tl - 1 : 3);
      int jj = 16 * sj + c16;
      Ps[(16 * si + r16) * 72 + (dir ? 63 - jj : jj)] = 0;
    }
#pragma unroll
    for (int t = 0; t < 3; ++t) {
      const int k = w + 4 * t;
      if (k < 10) {
        const int si = k < 4 ? 3 : (k < 7 ? 2 : (k < 9 ? 1 : 0));
        const int sj = k - (k < 4 ? 0 : (k < 7 ? 4 : (k < 9 ? 7 : 9)));
        const int it = 16 * si + fr, jt = 16 * sj + fr, cj = dir ? 63 - jt : jt;
        const int brow = si ? (16 * si - 1) : 0;
        const float bmul = si ? 1.f : 0.f;
        f32x4 acc = {0.f, 0.f, 0.f, 0.f};
#pragma unroll
        for (int s = 0; s < 4; ++s) {
          int d0 = 32 * s + 8 * fq;
          bf16x8 fv = ld8(Fq + cj * 136 + d0);
          bf16x8 af, bf;
#pragma unroll
          for (int e = 0; e < 8; ++e) {
            int d = d0 + e;
            float Bs_ = bmul * bsm[brow * 129 + d];
            float qq = bf2f((u16)qf[t][s][e]) * __expf(bsm[it * 129 + d] - Bs_);
            float kk = bf2f((u16)fv[e]) * __expf(Bs_ - bsm[jt * 129 + d]);
            af[e] = (short)f2bf(qq);
            bf[e] = (short)f2bf(kk);
          }
          acc = mfma(af, bf, acc);
          __builtin_amdgcn_sched_barrier(0);
        }
#pragma unroll
        for (int r = 0; r < 4; ++r) {
          int i = 16 * si + 4 * fq + r, jj = 16 * sj + fr;
          float v = (jj <= i) ? acc[r] : 0.f;
          Ps[i * 72 + (dir ? 63 - jj : jj)] = f2bf(v);
        }
      }
    }
    __syncthreads();
#pragma unroll
    for (int nt2 = 0; nt2 < 2; ++nt2) {
      int e = h * 128 + (2 * w + nt2) * 16 + fr;
      bf16x8 v0 = ld8(zT + (size_t)e * GR + rb + 8 * fq), v1 = ld8(zT + (size_t)e * GR + rb + 32 + 8 * fq);
#pragma unroll
      for (int m = 0; m < 4; ++m) {
        f32x4 O = {0.f, 0.f, 0.f, 0.f};
        O = mfma(ld8(Ps + (16 * m + fr) * 72 + 8 * fq), v0, O);
        O = mfma(ld8(Ps + (16 * m + fr) * 72 + 32 + 8 * fq), v1, O);
#pragma unroll
        for (int r = 0; r < 4; ++r) {
          int ii = 16 * m + 4 * fq + r, rowr = rb + (dir ? 63 - ii : ii);
          OC[((size_t)dir * GR + rowr) * 512 + e] = f2bf(O[r]);
        }
      }
    }
    __syncthreads();
  }
}

#define LBAR()                                              \
  do {                                                      \
    asm volatile("s_waitcnt lgkmcnt(0)" ::: "memory");      \
    __builtin_amdgcn_s_barrier();                           \
    asm volatile("" ::: "memory");                          \
  } while (0)
#define CBAR() asm volatile("" ::: "memory")
#define BS_CHUNK(jj) (dir ? ((jj) < 4 ? 3 - (jj) : 39 - (jj)) : (jj))
DEV bf16x8 ldo8(const char* base, unsigned off) { return *reinterpret_cast<const bf16x8*>(base + off); }
DEV void b_seq2(const P& p, int bitem, char* smem) {
  const int tid = opq(threadIdx.x), lane = tid & 63, w = tid >> 6, fr = lane & 15, fq = lane >> 4;
  const int es = bitem & 3, dir = (bitem >> 2) & 1, h = (bitem >> 3) & 3, lb = bitem >> 5, e0 = es * 32;
  u16* Ss = (u16*)smem;
  u16* Rs = Ss + 32 * 136;
  u16* Vsc = Rs + 32 * 72;
  u16* Vor = Vsc + 32 * 72;
  const char* qnB = p.ws + O_BSH + (size_t)h * 256;
  const char* knB = qnB + BSH_ONE;
  const char* vbB = knB + BSH_ONE + (size_t)e0 * 2;
  const char* ktB = p.ws + O_BSH + 3 * BSH_ONE + (size_t)h * 16384;
  const char* recB = p.ws + O_BIT + ((size_t)h * 2 + dir) * BIT_SZ;
  char* obB = p.ws + O_OB + ((size_t)dir * GR * 512 + h * 128 + e0) * 2;
  const int mrow = 16 * w + fr, crow0 = 16 * w + 4 * fq;
  const unsigned offA = (unsigned)((dir ? 63 - mrow : mrow) * 1024 + 16 * fq);
  unsigned offR[4];
#pragma unroll
  for (int r = 0; r < 4; ++r) offR[r] = (unsigned)((dir ? 63 - (crow0 + r) : (crow0 + r)) * 1024 + fr * 2);
  const unsigned offT = (unsigned)(mrow * 128 + 16 * fq);
  const unsigned offK = (unsigned)((32 * w + fr) * 128 + 16 * fq);
  const unsigned offS = (unsigned)(16384 + crow0 * 4);
  f32x4 S[2][2];
#pragma unroll
  for (int a = 0; a < 2; ++a)
#pragma unroll
    for (int b = 0; b < 2; ++b) S[a][b] = (f32x4){0.f, 0.f, 0.f, 0.f};
  bf16x8 Akn[4], Aqn[4], At[2][2], Aqk[2][2], AkT[2][2][2];
  u16 vbv[2][4];
  float4 eg4, be4, ek4[2];
  float egl[2];
#define BS_LOAD1(cg_)                                                              \
  {                                                                                \
    const size_t ro_ = (size_t)(cg_) * 65536;                                      \
    _Pragma("unroll") for (int s = 0; s < 4; ++s) {                                \
      Akn[s] = ldo8(knB + ro_, offA + 64 * s);                                     \
      Aqn[s] = ldo8(qnB + ro_, offA + 64 * s);                                     \
    }                                                                              \
    _Pragma("unroll") for (int r = 0; r < 4; ++r) {                                \
      vbv[0][r] = *(const u16*)(vbB + ro_ + offR[r]);                              \
      vbv[1][r] = *(const u16*)(vbB + ro_ + (offR[r] + 32));                       \
    }                                                                              \
    const char* rc_ = recB + (size_t)(cg_) * (8 * BIT_SZ);                         \
    eg4 = *(const float4*)(rc_ + offS);                                            \
    be4 = *(const float4*)(rc_ + (offS + 256));                                    \
  }
#define BS_LOAD2(cg_, SS)                                                          \
  {                                                                                \
    const char* rc_ = recB + (size_t)(cg_) * (8 * BIT_SZ);                         \
    At[SS][0] = ldo8(rc_, offT); At[SS][1] = ldo8(rc_, offT + 64);                 \
    ek4[SS] = *(const float4*)(rc_ + (offS + 512));                                \
  }
#define BS_LOAD3(cg_, SS)                                                          \
  {                                                                                \
    const char* rc_ = recB + (size_t)(cg_) * (8 * BIT_SZ);                         \
    Aqk[SS][0] = ldo8(rc_, offT + 8192); Aqk[SS][1] = ldo8(rc_, offT + 8192 + 64); \
    egl[SS] = *(const float*)(rc_ + 16384 + 768);                                  \
    const char* kt_ = ktB + (size_t)(cg_) * 65536;                                 \
    AkT[SS][0][0] = ldo8(kt_, offK); AkT[SS][0][1] = ldo8(kt_, offK + 64);         \
    AkT[SS][1][0] = ldo8(kt_, offK + 2048); AkT[SS][1][1] = ldo8(kt_, offK + 2048 + 64); \
  }
  {
    const int c0 = lb * 36 + BS_CHUNK(0);
    BS_LOAD1(c0) BS_LOAD2(c0, 0) BS_LOAD3(c0, 0)
  }
  for (int j2 = 0; j2 < 36; j2 += 2)
#pragma unroll
  for (int u = 0; u < 2; ++u) {
    const int j = j2 + u;
    const int cgk = lb * 36 + BS_CHUNK(j);
    const int jn = (j + 1 < 36) ? j + 1 : j;
    const int cgn = lb * 36 + BS_CHUNK(jn);
    BS_LOAD2(cgn, u ^ 1)
    BS_LOAD3(cgn, u ^ 1)
#pragma unroll
    for (int mm = 0; mm < 2; ++mm)
#pragma unroll
      for (int nt = 0; nt < 2; ++nt) {
        uint2 pk; pk.x = pk2(S[mm][nt][0], S[mm][nt][1]); pk.y = pk2(S[mm][nt][2], S[mm][nt][3]);
        *(uint2*)(Ss + (16 * nt + fr) * 136 + 32 * w + 16 * mm + 4 * fq) = pk;
      }
    LBAR();
    f32x4 QS[2];
    {
      bf16x8 Sf[2][4];
#pragma unroll
      for (int nt = 0; nt < 2; ++nt)
#pragma unroll
        for (int s = 0; s < 4; ++s) Sf[nt][s] = ld8(Ss + (16 * nt + fr) * 136 + 32 * s + 8 * fq);
#pragma unroll
      for (int nt = 0; nt < 2; ++nt) {
        f32x4 X = {0.f, 0.f, 0.f, 0.f}, Q = {0.f, 0.f, 0.f, 0.f};
#pragma unroll
        for (int s = 0; s < 4; ++s) { X = mfma(Akn[s], Sf[nt][s], X); Q = mfma(Aqn[s], Sf[nt][s], Q); }
        float r0 = be4.x * (bf2f(vbv[nt][0]) - eg4.x * X[0]);
        float r1 = be4.y * (bf2f(vbv[nt][1]) - eg4.y * X[1]);
        float r2 = be4.z * (bf2f(vbv[nt][2]) - eg4.z * X[2]);
        float r3 = be4.w * (bf2f(vbv[nt][3]) - eg4.w * X[3]);
        uint2 pk; pk.x = pk2(r0, r1); pk.y = pk2(r2, r3);
        *(uint2*)(Rs + (16 * nt + fr) * 72 + crow0) = pk;
        Q[0] *= eg4.x; Q[1] *= eg4.y; Q[2] *= eg4.z; Q[3] *= eg4.w;
        QS[nt] = Q;
      }
    }
    CBAR();
    BS_LOAD1(cgn)
    LBAR();
    {
#pragma unroll
      for (int nt = 0; nt < 2; ++nt) {
        bf16x8 Rf0 = ld8(Rs + (16 * nt + fr) * 72 + 8 * fq), Rf1 = ld8(Rs + (16 * nt + fr) * 72 + 32 + 8 * fq);
        f32x4 VN = {0.f, 0.f, 0.f, 0.f};
        VN = mfma(At[u][0], Rf0, VN);
        VN = mfma(At[u][1], Rf1, VN);
        uint2 pk; pk.x = pk2(VN[0], VN[1]); pk.y = pk2(VN[2], VN[3]);
        *(uint2*)(Vsc + (16 * nt + fr) * 72 + crow0) = pk;
        float s0 = VN[0] * ek4[u].x, s1 = VN[1] * ek4[u].y, s2 = VN[2] * ek4[u].z, s3 = VN[3] * ek4[u].w;
        if (dir) {
          pk.x = pk2(s3, s2); pk.y = pk2(s1, s0);
          *(uint2*)(Vor + (16 * nt + fr) * 72 + (60 - crow0)) = pk;
        } else {
          pk.x = pk2(s0, s1); pk.y = pk2(s2, s3);
          *(uint2*)(Vor + (16 * nt + fr) * 72 + crow0) = pk;
        }
      }
    }
    LBAR();
    {
      char* ob_ = obB + (size_t)cgk * 65536;
#pragma unroll
      for (int nt = 0; nt < 2; ++nt) {
        bf16x8 Vs0 = ld8(Vsc + (16 * nt + fr) * 72 + 8 * fq), Vs1 = ld8(Vsc + (16 * nt + fr) * 72 + 32 + 8 * fq);
        bf16x8 Vo0 = ld8(Vor + (16 * nt + fr) * 72 + 8 * fq), Vo1 = ld8(Vor + (16 * nt + fr) * 72 + 32 + 8 * fq);
        f32x4 O = QS[nt];
        O = mfma(Aqk[u][0], Vs0, O);
        O = mfma(Aqk[u][1], Vs1, O);
#pragma unroll
        for (int r = 0; r < 4; ++r) *(u16*)(ob_ + (offR[r] + 32 * nt)) = f2bf(O[r]);
#pragma unroll
        for (int mm = 0; mm < 2; ++mm) {
          f32x4 t = S[mm][nt];
#pragma unroll
          for (int r = 0; r < 4; ++r) t[r] *= egl[u];
          t = mfma(AkT[u][mm][0], Vo0, t);
          t = mfma(AkT[u][mm][1], Vo1, t);
          S[mm][nt] = t;
        }
      }
    }
  }
  LBAR();
}

DEV void c_seq2(const P& p, int bitem, char* smem) {
  const int tid = opq(threadIdx.x), lane = tid & 63, w = tid >> 6, fr = lane & 15, fq = lane >> 4;
  const int es = bitem & 3, dir = (bitem >> 2) & 1, h = (bitem >> 3) & 3, lb = bitem >> 5, e0 = es * 32;
  u16* Ssb = (u16*)smem;
  const char* recB = p.ws + O_CREC + ((size_t)h * 2 + dir) * CREC_SZ;
  const char* ztB = p.ws + O_ZT + (size_t)(h * 128 + e0) * GR * 2;
  char* ocB = p.ws + O_OC + ((size_t)dir * GR * 512 + h * 128 + e0) * 2;
  const int mrow = 16 * w + fr, crow0 = 16 * w + 4 * fq;
  const unsigned offQ = (unsigned)(mrow * 256 + 16 * fq);
  const unsigned offK = (unsigned)(16384 + (32 * w + fr) * 128 + 16 * fq);
  const unsigned offD = (unsigned)(32768 + (32 * w + 4 * fq) * 4);
  const unsigned offV = (unsigned)(fr * GR * 2 + 16 * fq);
  unsigned offR[4];
#pragma unroll
  for (int r = 0; r < 4; ++r) offR[r] = (unsigned)((dir ? 63 - (crow0 + r) : (crow0 + r)) * 1024 + fr * 2);
  f32x4 S[2][2];
#pragma unroll
  for (int a = 0; a < 2; ++a)
#pragma unroll
    for (int b = 0; b < 2; ++b) S[a][b] = (f32x4){0.f, 0.f, 0.f, 0.f};
  bf16x8 Aqd[4], Akd[2][2], Vf[2][2];
  u16 oi[2][4];
  float4 dec4[2];
#define CS_LOAD(cg_)                                                                    \
  {                                                                                     \
    const char* rc_ = recB + (size_t)(cg_) * (8 * CREC_SZ);                             \
    _Pragma("unroll") for (int s = 0; s < 4; ++s) Aqd[s] = ldo8(rc_, offQ + 64 * s);    \
    Akd[0][0] = ldo8(rc_, offK); Akd[0][1] = ldo8(rc_, offK + 64);                      \
    Akd[1][0] = ldo8(rc_, offK + 2048); Akd[1][1] = ldo8(rc_, offK + 2048 + 64);        \
    dec4[0] = *(const float4*)(rc_ + offD);                                             \
    dec4[1] = *(const float4*)(rc_ + (offD + 64));                                      \
    const char* zt_ = ztB + (size_t)(cg_) * 128;                                        \
    Vf[0][0] = ldo8(zt_, offV); Vf[0][1] = ldo8(zt_, offV + 64);                        \
    Vf[1][0] = ldo8(zt_, offV + 16 * GR * 2); Vf[1][1] = ldo8(zt_, offV + 16 * GR * 2 + 64); \
    const char* oc_ = ocB + (size_t)(cg_) * 65536;                                      \
    _Pragma("unroll") for (int r = 0; r < 4; ++r) {                                     \
      oi[0][r] = *(const u16*)(oc_ + offR[r]);                                          \
      oi[1][r] = *(const u16*)(oc_ + (offR[r] + 32));                                   \
    }                                                                                   \
  }
  {
    const int c0 = lb * 36 + BS_CHUNK(0);
    CS_LOAD(c0)
  }
  for (int j = 0; j < 36; ++j) {
    const int cgk = lb * 36 + BS_CHUNK(j);
    const int jn = (j + 1 < 36) ? j + 1 : j;
    const int cgn = lb * 36 + BS_CHUNK(jn);
    u16* Ss = Ssb + (j & 1) * (32 * 136);
#pragma unroll
    for (int mm = 0; mm < 2; ++mm)
#pragma unroll
      for (int nt = 0; nt < 2; ++nt) {
        uint2 pk; pk.x = pk2(S[mm][nt][0], S[mm][nt][1]); pk.y = pk2(S[mm][nt][2], S[mm][nt][3]);
        *(uint2*)(Ss + (16 * nt + fr) * 136 + 32 * w + 16 * mm + 4 * fq) = pk;
      }
    LBAR();
    char* oc_ = ocB + (size_t)cgk * 65536;
#pragma unroll
    for (int nt = 0; nt < 2; ++nt) {
      f32x4 O = {0.f, 0.f, 0.f, 0.f};
#pragma unroll
      for (int s = 0; s < 4; ++s) O = mfma(Aqd[s], ld8(Ss + (16 * nt + fr) * 136 + 32 * s + 8 * fq), O);
#pragma unroll
      for (int r = 0; r < 4; ++r) *(u16*)(oc_ + (offR[r] + 32 * nt)) = f2bf(bf2f(oi[nt][r]) + O[r]);
#pragma unroll
      for (int mm = 0; mm < 2; ++mm) {
        f32x4 t = S[mm][nt];
        t[0] *= dec4[mm].x; t[1] *= dec4[mm].y; t[2] *= dec4[mm].z; t[3] *= dec4[mm].w;
        t = mfma(Akd[mm][0], Vf[nt][0], t);
        t = mfma(Akd[mm][1], Vf[nt][1], t);
        S[mm][nt] = t;
      }
    }
    CBAR();
    CS_LOAD(cgn)
  }
  LBAR();
}

DEV void bc_merge_row(const P& p, int l, int lr, int lane);
DEV void bc_merge(const P& p, int l, int it) {
  const int tid_ = opq(threadIdx.x); const int lane = tid_ & 63, w = tid_ >> 6;
#pragma unroll
  for (int rr = 0; rr < 2; ++rr) bc_merge_row(p, l, it * 8 + w * 2 + rr, lane);
}
DEV void bc_merge_row(const P& p, int l, int lr, int lane) {
  int mix = lane >> 5, cm = (lane * 16) & 511;
  const u16* O = (const u16*)(p.ws + (mix ? O_OC : O_OB));
  u16* z = (u16*)(p.ws + O_Z);
  float ov[16], ss = 0.f;
#pragma unroll
  for (int k2 = 0; k2 < 2; ++k2) {
    uint4 a = *(const uint4*)(O + (size_t)lr * 512 + cm + 8 * k2);
    uint4 b = *(const uint4*)(O + ((size_t)GR + lr) * 512 + cm + 8 * k2);
    unsigned aa[4] = {a.x, a.y, a.z, a.w}, bb[4] = {b.x, b.y, b.z, b.w};
#pragma unroll
    for (int q = 0; q < 4; ++q) {
      float v0 = bf2f((u16)(aa[q] & 0xffff)) + bf2f((u16)(bb[q] & 0xffff));
      float v1 = bf2f((u16)(aa[q] >> 16)) + bf2f((u16)(bb[q] >> 16));
      ov[k2 * 8 + q * 2] = v0; ov[k2 * 8 + q * 2 + 1] = v1;
      ss += v0 * v0 + v1 * v1;
    }
  }
  ss += __shfl_xor(ss, 1); ss += __shfl_xor(ss, 2); ss += __shfl_xor(ss, 4);
  float rinv = rsqrtf(ss * (1.f / 128.f) + EPS);
  const float* nw = (mix ? p.hg_norm : p.gdn_norm) + l * 128 + (cm & 127);
  u16* gp = z + (size_t)lr * NZ + (mix ? C_GC : C_GB) + cm;
#pragma unroll
  for (int k2 = 0; k2 < 2; ++k2) {
    uint4 gv = *(const uint4*)(gp + 8 * k2);
    unsigned gg[4] = {gv.x, gv.y, gv.z, gv.w}, oo[4];
#pragma unroll
    for (int q = 0; q < 4; ++q) {
      int e = k2 * 8 + q * 2;
      float y0 = ov[e] * rinv * nw[e] * silu(bf2f((u16)(gg[q] & 0xffff)));
      float y1 = ov[e + 1] * rinv * nw[e + 1] * silu(bf2f((u16)(gg[q] >> 16)));
      oo[q] = pk2(y0, y1);
    }
    *(uint4*)(gp + 8 * k2) = make_uint4(oo[0], oo[1], oo[2], oo[3]);
  }
}

#define XB_TMO      128
#define XB_XCNT(j)  (256  + 64 * (j))
#define XB_XSUB(j)  (1280 + 64 * (j))
#define XB_XGEN(j)  (2304 + 64 * (j))
#define XB_TOP      3328
#define XB_TOPGEN   3392
#define XCD_BAR_WORDS 3456
#define XB_SPIN_CAP (1u << 18)
#define LAS __attribute__((address_space(3)))

__device__ __forceinline__ unsigned xb_ld(unsigned* p)              { return __hip_atomic_load(p, __ATOMIC_RELAXED, __HIP_MEMORY_SCOPE_AGENT); }
__device__ __forceinline__ unsigned xb_add(unsigned* p, unsigned v) { return __hip_atomic_fetch_add(p, v, __ATOMIC_RELAXED, __HIP_MEMORY_SCOPE_AGENT); }
__device__ __forceinline__ unsigned xb_xcc_id() { return (unsigned)__builtin_amdgcn_s_getreg((3 << 11) | 20) & 0xFu; }
#define XB_SPIN(cond, bar) do { unsigned _sp = 0; while (cond) { __builtin_amdgcn_s_sleep(1); \
    if ((++_sp & 255u) == 0u) { if (xb_ld(&(bar)[XB_TMO])) break; if (_sp > XB_SPIN_CAP) { atomicAdd(&(bar)[XB_TMO], 1u); break; } } } } while (0)

struct XcdBarrier {
    unsigned* bar; unsigned x;
    volatile LAS unsigned* st;
};

__device__ __forceinline__ XcdBarrier xcd_barrier_post(unsigned* bar, volatile LAS unsigned* st) {
    XcdBarrier b; b.bar = bar; b.x = xb_xcc_id(); b.st = st;
    if (threadIdx.x == 0) (void)xb_add(&bar[XB_XCNT(b.x)], 1u);
    return b;
}
__device__ __forceinline__ void xcd_barrier_complete(unsigned* bar, unsigned x, unsigned& nloc, unsigned& nx) {
    const unsigned G = gridDim.x * gridDim.y * gridDim.z;
    unsigned sum, cnt, mine, sp = 0u;
    for (;;) {
        sum = 0u; cnt = 0u; mine = 0u;
#pragma unroll
        for (unsigned j = 0; j < 16; ++j) { const unsigned c = xb_ld(&bar[XB_XCNT(j)]); sum += c; cnt += (c > 0u) ? 1u : 0u; mine = (j == x) ? c : mine; }
        if (sum == G) break;
        __builtin_amdgcn_s_sleep(1);
        if ((++sp & 255u) == 0u) { if (xb_ld(&bar[XB_TMO])) break; if (sp > XB_SPIN_CAP) { atomicAdd(&bar[XB_TMO], 1u); break; } }
    }
    nloc = mine > 0u ? mine : 1u; nx = cnt > 0u ? cnt : 1u;
}

__device__ __forceinline__ void xcd_barrier(const XcdBarrier& b) {
    asm volatile("s_waitcnt vmcnt(0)" ::: "memory");
    __syncthreads();
    if (threadIdx.x == 0) {
        unsigned* bar = b.bar;
        __builtin_amdgcn_s_waitcnt(0);
        unsigned nloc = b.st[0], nx = b.st[1];
        if (nloc == 0u) { xcd_barrier_complete(bar, b.x, nloc, nx); b.st[0] = nloc; b.st[1] = nx; }
        const unsigned old = xb_add(&bar[XB_XSUB(b.x)], 1u);
        const unsigned gen = old / nloc;
        if (old + 1u == (gen + 1u) * nloc) {
            __builtin_amdgcn_fence(__ATOMIC_RELEASE, "agent");
            asm volatile("s_waitcnt vmcnt(0)" ::: "memory");
            const unsigned og = xb_add(&bar[XB_TOP], 1u);
            const unsigned tg = og / nx;
            if (og + 1u == (tg + 1u) * nx) xb_add(&bar[XB_TOPGEN], 1u);
            else XB_SPIN(xb_ld(&bar[XB_TOPGEN]) == tg, bar);
            __builtin_amdgcn_fence(__ATOMIC_ACQUIRE, "agent");
            xb_add(&bar[XB_XGEN(b.x)], 1u);
            asm volatile("s_waitcnt vmcnt(0)" ::: "memory");
        } else {
            XB_SPIN(xb_ld(&bar[XB_XGEN(b.x)]) == gen, bar);
            __builtin_amdgcn_fence(__ATOMIC_ACQUIRE, "agent");
            asm volatile("s_waitcnt vmcnt(0)" ::: "memory");
        }
    }
    __syncthreads();
}


#ifdef NO_G0
#define XG0(x)
#else
#define XG0(x) x
#endif
#ifdef NO_G1
#define XG1(x)
#else
#define XG1(x) x
#endif
#ifdef NO_BC
#define XBC(x)
#else
#define XBC(x) x
#endif
#ifdef NO_AC
#define XAC(x)
#else
#define XAC(x) x
#endif
#ifdef NO_P0
#define XP0(x)
#else
#define XP0(x) x
#endif
#ifdef NO_R
#define XR(x)
#else
#define XR(x) x
#endif
#ifdef NO_BL
#define XBL(x)
#else
#define XBL(x) x
#endif
#ifdef NO_CL
#define XCL(x)
#else
#define XCL(x) x
#endif
#ifdef NO_A0
#define XA0(x)
#else
#define XA0(x) x
#endif
#ifdef NO_A1
#define XA1(x)
#else
#define XA1(x) x
#endif
#ifdef NO_BS
#define XBS(x)
#else
#define XBS(x) x
#endif
#ifdef NO_CS
#define XCS(x)
#else
#define XCS(x) x
#endif
__global__ void __launch_bounds__(256, 2) fwd_mega(P p) {
  extern __shared__ __attribute__((aligned(16))) char smem[];
  cg::grid_group grid = cg::this_grid();
  const int G = gridDim.x;
  __shared__ uint4 xb_words;
  if (threadIdx.x == 0) xb_words = make_uint4(0u, 0u, 0u, 0u);
  __syncthreads();
  XcdBarrier xb = xcd_barrier_post((unsigned*)(p.ws + O_BAR), (volatile LAS unsigned*)&xb_words);
  XP0(phase0(p, smem));
  grid.sync();
  u16* z = (u16*)(p.ws + O_Z);
  u16* zT = (u16*)(p.ws + O_ZT);
  float* ab = (float*)(p.ws + O_AB);
  float* o = (float*)(p.ws + O_BSH);
  const u16* u = (const u16*)(p.ws + O_BIT);
  for (int g = 0; g < NG; ++g) {
    XR(phaseR(p, g, 0));
    xcd_barrier(xb);
    for (int l = 0; l < DEPTH; ++l) {
      for (int rep = 0; rep < REP_G; ++rep) {
        const u16* Bt = (const u16*)(p.ws + O_WTIN) + (size_t)l * NZ * 1024;
        if ((G & 7) == 0) {
          const int x = blockIdx.x & 7, bl = blockIdx.x >> 3, nbl = G >> 3;
          for (int q = bl; q < 9 * 45; q += nbl) { XG0(gemm_tile<0>(u, 1024, Bt, 1024, 9 * x + q % 9, q / 9, z, zT, ab, o, smem)); }
        } else {
          for (int t = blockIdx.x; t < 72 * 45; t += G) { XG0(gemm_tile<0>(u, 1024, Bt, 1024, t % 72, t / 72, z, zT, ab, o, smem)); }
        }
      }
      xcd_barrier(xb);
      for (int rep2 = 0; rep2 < REP_M; ++rep2) {
      for (int rep3 = 0; rep3 < REP_A; ++rep3) {
        if (rep3) xcd_barrier(xb);
        const int nb = NCH * 4, nc = NCH * 4, na = NCH * 8;
        if (G == 512) {
          const int bx = blockIdx.x;
          XCL(c_local2(p, l, bx, smem));
          if (bx < 64) { XCL(c_local2(p, l, 512 + bx, smem)); }
          XBL(b_local(p, l, bx, smem));
          if (bx >= 64 && bx < 128) { XBL(b_local(p, l, 448 + bx, smem)); }
          if (bx < 128) { XA0(a_item(p, l, bx, 0, smem)); }
          else {
            for (int t = 128 + (bx - 128); t < na; t += 384) { XA0(a_item(p, l, t, 0, smem)); }
          }
        } else {
          for (int t = blockIdx.x; t < nb + nc + na; t += G) {
            if (t < nc) { XCL(c_local2(p, l, t, smem)); }
            else if (t < nb + nc) { XBL(b_local(p, l, t - nc, smem)); }
            else { XA0(a_item(p, l, t - nb - nc, 0, smem)); }
          }
        }
      }
      xcd_barrier(xb);
      {
        for (int t = blockIdx.x; t < 256 + 16; t += G) {
          if (t < 128) { XBS(b_seq2(p, t, smem)); }
          else if (t < 256) { XCS(c_seq2(p, t - 128, smem)); }
          else { XAC(a_carry(p, t - 256)); }
        }
      }
      xcd_barrier(xb);
      }
      {
        const int na = NCH * 8, nm = GR / 8;
        for (int t = blockIdx.x; t < na + nm; t += G) {
          if (t < na) { XA1(a_fin2(p, l, t, smem)); }
          else { XBC(bc_merge(p, l, t - na)); }
        }
      }
      xcd_barrier(xb);
      for (int rep = 0; rep < REP_G; ++rep) {
        const u16* Bt = (const u16*)(p.ws + O_WTOUT) + (size_t)l * 1024 * 1536;
        for (int t = blockIdx.x; t < 72 * 8; t += G) { XG1(gemm_tile<1>(z + C_GA, NZ, Bt, 1536, t % 72, t / 72, z, zT, ab, o, smem)); }
      }
      xcd_barrier(xb);
      XR(phaseR(p, g, l + 1));
      xcd_barrier(xb);
    }
  }
}

extern "C" void kernel_launch(void* const* d_in, const int* in_sizes, int n_in, void* d_out, int out_size, void* d_ws,
                              size_t ws_size, hipStream_t stream) {
  static int grid_blocks = 0;
  if (!grid_blocks) {
    int dev = 0, cus = 0, per_cu = 0;
    hipGetDevice(&dev);
    hipDeviceGetAttribute(&cus, hipDeviceAttributeMultiprocessorCount, dev);
    hipFuncSetAttribute((const void*)fwd_mega, hipFuncAttributeMaxDynamicSharedMemorySize, LDS_BYTES);
    hipOccupancyMaxActiveBlocksPerMultiprocessor(&per_cu, fwd_mega, 256, LDS_BYTES);
    if (per_cu > 2) per_cu = 2;
    if (per_cu < 1) per_cu = 1;
    grid_blocks = cus * per_cu;
  }
  if (ws_size < WS_TOTAL) {
    fprintf(stderr, "workspace too small: %zu < %zu\n", ws_size, (size_t)WS_TOTAL);
    return;
  }
  P p{};
  const float** f = (const float**)&p;
  for (int i = 0; i < 23; ++i) f[i] = (const float*)d_in[i];
  p.out = (float*)d_out;
  p.ws = (char*)d_ws;
  hipMemsetAsync((char*)d_ws + O_BAR, 0, XCD_BAR_WORDS * 4, stream);
  void* args[] = {&p};
  hipError_t e = hipLaunchCooperativeKernel((void*)fwd_mega, dim3(grid_blocks), dim3(256), args, LDS_BYTES, stream);
  if (e != hipSuccess) fprintf(stderr, "cooperative launch failed: %s (grid %d)\n", hipGetErrorString(e), grid_blocks);
}
```

```cpp
#include <hip/hip_runtime.h>
#include <hip/hip_cooperative_groups.h>
#include <cstdio>
namespace cg = cooperative_groups;

typedef __attribute__((ext_vector_type(8))) short bf16x8;
typedef __attribute__((ext_vector_type(4))) float f32x4;
typedef unsigned short u16;
#define DEV __device__ __forceinline__

constexpr int DM = 1024, TL = 2048, TCX = 256, TS = 2304, GB = 4, GR = GB * TS, NG = 2;
constexpr int NZ = 5760, DEPTH = 4;
constexpr int C_XA = 0, C_Q = 512, C_K = 1024, C_V = 1536, C_QC = 2048, C_F0 = 2560, C_IC = 3584,
              C_GA = 4096, C_GB = 4608, C_GC = 5120, C_AB = 5632;
constexpr int NCH = GR / 64;
constexpr float EPS = 1e-6f;
constexpr int WPB = 2;

constexpr size_t al256(size_t x) { return (x + 255) & ~(size_t)255; }
constexpr size_t O_WTIN = 0;
constexpr size_t O_WTOUT = O_WTIN + al256((size_t)DEPTH * NZ * 1024 * 2);
constexpr size_t O_WGT = O_WTOUT + al256((size_t)DEPTH * 1024 * 1536 * 2);
constexpr size_t O_MOD = O_WGT + al256((size_t)DEPTH * 2 * 2 * 8 * 4096 * 2);
constexpr size_t O_LBS = O_MOD + al256((size_t)DEPTH * 9 * 3072 * 4);
constexpr size_t O_HC = O_LBS + al256((size_t)DEPTH * 1024 * 4);
constexpr size_t O_Z = O_HC + al256((size_t)GB * TCX * 1024 * 4);
constexpr size_t O_ZT = O_Z + al256((size_t)GR * NZ * 2);
constexpr size_t O_AB = O_ZT + al256((size_t)512 * GR * 2);
constexpr size_t O_BSH = O_AB + al256((size_t)GR * 16 * 4);
constexpr size_t BSH_ONE = (size_t)GR * 512 * 2;
constexpr size_t O_BIT = O_BSH + al256(4 * BSH_ONE);
constexpr size_t BIT_SZ = 17408;
constexpr size_t O_CREC = O_BIT + al256((size_t)NCH * 4 * 2 * BIT_SZ);
constexpr size_t CREC_SZ = 33280;
constexpr size_t O_OB = O_CREC + al256((size_t)NCH * 4 * 2 * CREC_SZ);
constexpr size_t O_OC = O_OB + al256((size_t)2 * GR * 512 * 2);
constexpr size_t O_AP = O_OC + al256((size_t)2 * GR * 512 * 2);
constexpr size_t O_AH = O_AP + al256((size_t)NCH * 2 * 512 * 4);
constexpr size_t O_ACAR = O_AH + al256((size_t)NCH * 2 * 512 * 4);
constexpr size_t O_ALA = O_ACAR + al256((size_t)NCH * 2 * 512 * 4);
constexpr size_t O_AU = O_ALA + al256((size_t)2 * GR * 512 * 2);
constexpr size_t O_BAR = O_AU + al256((size_t)2 * GR * 512 * 2);
constexpr size_t WS_TOTAL = O_BAR + al256(3456 * 4);

constexpr int LDS_BYTES = 73728;
#ifndef REP_A
#define REP_A 1
#endif
#ifndef REP_G
#define REP_G 1
#endif
#ifndef REP_M
#define REP_M 1
#endif

struct P {
  const float *x, *c, *ctx, *c_ctx, *w_ada, *b_ada, *norm_pre, *norm_post, *w_in, *conv_a_w, *conv_a_b, *rg_w_r,
      *rg_b_r, *rg_w_i, *rg_b_i, *rg_lam, *conv_b_w, *gdn_a_log, *gdn_dt_bias, *gdn_norm, *hg_lb, *hg_norm, *w_out;
  float* out;
  char* ws;
};

DEV int opq(int x) { asm volatile("" : "+v"(x)); return x; }
DEV int opqs(int x) { asm volatile("" : "+s"(x)); return x; }
typedef __attribute__((ext_vector_type(2))) __bf16 bf16x2_t;
typedef __attribute__((ext_vector_type(2))) float f32x2_t;
DEV u16 f2bf(float f) { __bf16 r = (__bf16)f; return __builtin_bit_cast(u16, r); }
DEV float bf2f(u16 h) { return __uint_as_float(((unsigned)h) << 16); }
DEV unsigned pk2(float a, float b) { f32x2_t v = {a, b}; bf16x2_t r = __builtin_convertvector(v, bf16x2_t); return __builtin_bit_cast(unsigned, r); }
DEV float sigm(float x) { return __builtin_amdgcn_rcpf(1.f + __expf(-x)); }
DEV float silu(float x) { return x * __builtin_amdgcn_rcpf(1.f + __expf(-x)); }
DEV float softplus(float x) { return x > 20.f ? x : log1pf(__expf(x)); }
DEV f32x4 mfma(bf16x8 a, bf16x8 b, f32x4 c) { return __builtin_amdgcn_mfma_f32_16x16x32_bf16(a, b, c, 0, 0, 0); }
DEV bf16x8 ld8(const u16* p) { return *reinterpret_cast<const bf16x8*>(p); }
DEV int lat_map(int l, int t) { return (l & 1) ? ((t & 63) * 32 + (t >> 6)) : t; }
DEV int orig_col(int n) {
  if (n < 512) return n;
  if (n < 2048) return n + 512;
  if (n < 4096) return n + 1040;
  if (n < 4608) return n - 4096 + 512;
  if (n < 5120) return n - 4608 + 2576;
  if (n < 5632) return n + 16;
  if (n < 5648) return n - 5632 + 2560;
  return -1;
}
DEV float zval(const u16* z, int rb, int cp, int n, int col) {
  if (cp < 0 && (n == 0 || n == 4)) return 0.f;
  if (cp > 63 && (n == 3 || n == 35)) return 0.f;
  return bf2f(z[(size_t)(rb + cp) * NZ + col]);
}

DEV void ph0_ada(const P& p, int item, char* smem) {
  float* sc = (float*)smem;
  float* red = (float*)(smem + 36864);
  const int tid = threadIdx.x, lane = tid & 63, wv = tid >> 6;
  for (int i = tid; i < 9 * 1024; i += 256) {
    int v = i >> 10, d = i & 1023;
    float cv = (v < 8) ? p.c[v * 1024 + d] : p.c_ctx[d];
    sc[i] = silu(cv);
  }
  __syncthreads();
  const int col = item * 64 + lane;
  const int l = col / 3072, e = col % 3072;
  const float* w = p.w_ada + (size_t)l * 1024 * 3072 + e + (size_t)(256 * wv) * 3072;
  const float* scw = sc + 256 * wv;
  float acc[9];
#pragma unroll
  for (int i = 0; i < 9; ++i) acc[i] = 0.f;
  for (int d = 0; d < 256; d += 16) {
    float wr[16];
#pragma unroll
    for (int k = 0; k < 16; ++k) wr[k] = w[(size_t)(d + k) * 3072];
#pragma unroll
    for (int k = 0; k < 16; ++k)
#pragma unroll
      for (int i = 0; i < 9; ++i) acc[i] += scw[i * 1024 + d + k] * wr[k];
  }
#pragma unroll
  for (int i = 0; i < 9; ++i) red[(wv * 9 + i) * 64 + lane] = acc[i];
  __syncthreads();
  float* mod = (float*)(p.ws + O_MOD);
  for (int idx = tid; idx < 9 * 64; idx += 256) {
    int i = idx >> 6, ln = idx & 63;
    float sum = red[(0 * 9 + i) * 64 + ln] + red[(1 * 9 + i) * 64 + ln] + red[(2 * 9 + i) * 64 + ln] + red[(3 * 9 + i) * 64 + ln];
    int cc = item * 64 + ln, l2 = cc / 3072, e2 = cc % 3072;
    mod[((size_t)l2 * 9 + i) * 3072 + e2] = sum + p.b_ada[l2 * 3072 + e2];
  }
  __syncthreads();
}
DEV void tconv_tile(const float* src, int lds_, u16* dst, int ldd, int k0, int n0, bool mapcol, char* smem) {
  float* t = (float*)smem;
  const int tid = threadIdx.x, nn = tid & 63, kq = tid >> 6;
  const int n = n0 + nn;
  const int sn0 = mapcol ? orig_col(n) : n;
  const float msk = (sn0 >= 0) ? 1.f : 0.f;
  const int sn = sn0 >= 0 ? sn0 : 0;
  float v[16];
#pragma unroll
  for (int k = 0; k < 16; ++k) v[k] = src[(size_t)(k0 + kq + 4 * k) * lds_ + sn];
#pragma unroll
  for (int k = 0; k < 16; ++k) t[(kq + 4 * k) * 65 + nn] = v[k] * msk;
  __syncthreads();
  {
    const int kk = tid & 63, nq = tid >> 6;
#pragma unroll
    for (int k = 0; k < 16; ++k) {
      int n2 = nq + 4 * k;
      dst[(size_t)(n0 + n2) * ldd + k0 + kk] = f2bf(t[kk * 65 + n2]);
    }
  }
  __syncthreads();
}
DEV void phase0(const P& p, char* smem) {
  const int n_ada = 192, n_in = DEPTH * 16 * 90, n_out = DEPTH * 24 * 16, n_g = 128, n_lb = 4;
  const int total = n_ada + n_in + n_out + n_g + n_lb;
  for (int it = blockIdx.x; it < total; it += gridDim.x) {
    int i = it;
    if (i < n_ada) { ph0_ada(p, i, smem); continue; }
    i -= n_ada;
    if (i < n_in) {
      int l = i / 1440, r = i % 1440, kt = r / 90, nt = r % 90;
      tconv_tile(p.w_in + (size_t)l * 1024 * 5648, 5648, (u16*)(p.ws + O_WTIN) + (size_t)l * NZ * 1024, 1024, kt * 64,
                 nt * 64, true, smem);
      continue;
    }
    i -= n_in;
    if (i < n_out) {
      int l = i / 384, r = i % 384, kt = r / 16, nt = r % 16;
      tconv_tile(p.w_out + (size_t)l * 1536 * 1024, 1024, (u16*)(p.ws + O_WTOUT) + (size_t)l * 1024 * 1536, 1536,
                 kt * 64, nt * 64, false, smem);
      continue;
    }
    i -= n_out;
    if (i < n_g) {
      int h = i & 7, gate = (i >> 3) & 1, dir = (i >> 4) & 1, l = i >> 5;
      const float* src = (gate ? p.rg_w_i : p.rg_w_r) + ((size_t)(l * 2 + dir) * 8 + h) * 4096;
      tconv_tile(src, 64, (u16*)(p.ws + O_WGT) + (size_t)i * 4096, 64, 0, 0, false, smem);
      continue;
    }
    i -= n_g;
    {
      int j = i * 256 + threadIdx.x;
      float v[4], mx = -1e30f;
      for (int l = 0; l < 4; ++l) { v[l] = p.hg_lb[l * 1024 + j]; mx = fmaxf(mx, v[l]); }
      float s = 0.f;
      for (int l = 0; l < 4; ++l) { v[l] = __expf(v[l] - mx); s += v[l]; }
      float* lbs = (float*)(p.ws + O_LBS);
      float cum = 0.f;
      for (int l = 0; l < 4; ++l) {
        if (l > 0) cum += v[l] / s;
        lbs[l * 1024 + j] = cum;
      }
    }
  }
}

DEV void phaseR(const P& p, int g, int l) {
  const int tid_ = opq(threadIdx.x); const int lane = tid_ & 63, w = tid_ >> 6;
  const float* mod = (const float*)(p.ws + O_MOD);
  float* hc = (float*)(p.ws + O_HC);
  const float* o = (const float*)(p.ws + O_BSH);
  u16* u = (u16*)(p.ws + O_BIT);
  for (int it = blockIdx.x; it < GR / 4; it += gridDim.x) {
    int lr = it * 4 + w;
    int lb = lr / TS, s = lr % TS;
    bool isctx = s < TCX;
    if (l == DEPTH && isctx) continue;
    int b = g * GB + lb, t = s - TCX;
    int mi = isctx ? 8 : b;
    float* hp = isctx ? hc + ((size_t)lb * TCX + s) * 1024 : p.out + ((size_t)b * TL + t) * 1024;
    float hv[16];
    if (l == 0) {
      const float* src = isctx ? p.ctx + ((size_t)b * TCX + s) * 1024 : p.x + ((size_t)b * TL + t) * 1024;
#pragma unroll
      for (int k = 0; k < 4; ++k) {
        float4 v = *(const float4*)(src + k * 256 + lane * 4);
        hv[k * 4] = v.x; hv[k * 4 + 1] = v.y; hv[k * 4 + 2] = v.z; hv[k * 4 + 3] = v.w;
      }
    } else {
      int orow = lb * TS + (isctx ? s : TCX + lat_map(l - 1, t));
      const float* op = o + (size_t)orow * 1024;
      float ov[16], ss = 0.f;
#pragma unroll
      for (int k = 0; k < 4; ++k) {
        float4 v = *(const float4*)(op + k * 256 + lane * 4);
        ov[k * 4] = v.x; ov[k * 4 + 1] = v.y; ov[k * 4 + 2] = v.z; ov[k * 4 + 3] = v.w;
        ss += v.x * v.x + v.y * v.y + v.z * v.z + v.w * v.w;
      }
#pragma unroll
      for (int off = 32; off; off >>= 1) ss += __shfl_xor(ss, off);
      float rinv = rsqrtf(ss * (1.f / 1024.f) + EPS);
      const float* gate = mod + ((size_t)(l - 1) * 9 + mi) * 3072 + 2048;
      const float* wp = p.norm_post + (l - 1) * 1024;
#pragma unroll
      for (int k = 0; k < 4; ++k) {
        float4 hh = *(const float4*)(hp + k * 256 + lane * 4);
        float4 gg = *(const float4*)(gate + k * 256 + lane * 4);
        float4 ww = *(const float4*)(wp + k * 256 + lane * 4);
        hv[k * 4] = hh.x + gg.x * (ov[k * 4] * rinv * ww.x);
        hv[k * 4 + 1] = hh.y + gg.y * (ov[k * 4 + 1] * rinv * ww.y);
        hv[k * 4 + 2] = hh.z + gg.z * (ov[k * 4 + 2] * rinv * ww.z);
        hv[k * 4 + 3] = hh.w + gg.w * (ov[k * 4 + 3] * rinv * ww.w);
      }
    }
#pragma unroll
    for (int k = 0; k < 4; ++k)
      *(float4*)(hp + k * 256 + lane * 4) = make_float4(hv[k * 4], hv[k * 4 + 1], hv[k * 4 + 2], hv[k * 4 + 3]);
    if (l < DEPTH) {
      float ss = 0.f;
#pragma unroll
      for (int k = 0; k < 16; ++k) ss += hv[k] * hv[k];
#pragma unroll
      for (int off = 32; off; off >>= 1) ss += __shfl_xor(ss, off);
      float rinv = rsqrtf(ss * (1.f / 1024.f) + EPS);
      const float* sh = mod + ((size_t)l * 9 + mi) * 3072;
      const float* wp = p.norm_pre + l * 1024;
      int urow = lb * TS + (isctx ? s : TCX + lat_map(l, t));
      u16* up = u + (size_t)urow * 1024;
#pragma unroll
      for (int k = 0; k < 4; ++k) {
        float4 ww = *(const float4*)(wp + k * 256 + lane * 4);
        float4 s0 = *(const float4*)(sh + k * 256 + lane * 4);
        float4 s1 = *(const float4*)(sh + 1024 + k * 256 + lane * 4);
        float a0 = hv[k * 4] * rinv * ww.x * (1.f + s1.x) + s0.x;
        float a1 = hv[k * 4 + 1] * rinv * ww.y * (1.f + s1.y) + s0.y;
        float a2 = hv[k * 4 + 2] * rinv * ww.z * (1.f + s1.z) + s0.z;
        float a3 = hv[k * 4 + 3] * rinv * ww.w * (1.f + s1.w) + s0.w;
        uint2 pk; pk.x = pk2(a0, a1); pk.y = pk2(a2, a3);
        *(uint2*)(up + k * 256 + lane * 4) = pk;
      }
    }
  }
}

template <int MODE>
DEV void gemm_tile(const u16* __restrict__ A, int lda, const u16* __restrict__ Bt, int K, int rt, int ct, u16* z,
                   u16* zT, float* ab, float* o, char* smem) {
  u16* As = (u16*)smem;
  u16* Bs = As + 128 * 72;
  const int tid = opq(threadIdx.x), lane = tid & 63, w = tid >> 6, wr = w >> 1, wc = w & 1, fr = lane & 15, fq = lane >> 4;
  const int lrow = tid >> 3, lseg = tid & 7;
  const u16* Ag = A + (size_t)(rt * 128 + lrow) * lda + lseg * 8;
  const u16* Bg = Bt + (size_t)(ct * 128 + lrow) * K + lseg * 8;
  uint4 pa0, pa1, pa2, pa3, pb0, pb1, pb2, pb3;
  uint4 qa0, qa1, qa2, qa3, qb0, qb1, qb2, qb3;
  f32x4 acc[4][4];
#pragma unroll
  for (int i = 0; i < 4; ++i)
#pragma unroll
    for (int j = 0; j < 4; ++j) acc[i][j] = (f32x4){0.f, 0.f, 0.f, 0.f};
  const int nk = K / 64;
#define GLD(S, kk)                                                            \
  {                                                                           \
    const int kc_ = ((kk) < nk ? (kk) : nk - 1) * 64;                         \
    S##a0 = *(const uint4*)(Ag + kc_);                                        \
    S##a1 = *(const uint4*)(Ag + kc_ + (size_t)32 * lda);                     \
    S##a2 = *(const uint4*)(Ag + kc_ + (size_t)64 * lda);                     \
    S##a3 = *(const uint4*)(Ag + kc_ + (size_t)96 * lda);                     \
    S##b0 = *(const uint4*)(Bg + kc_);                                        \
    S##b1 = *(const uint4*)(Bg + kc_ + (size_t)32 * K);                       \
    S##b2 = *(const uint4*)(Bg + kc_ + (size_t)64 * K);                       \
    S##b3 = *(const uint4*)(Bg + kc_ + (size_t)96 * K);                       \
  }
#define GST(S, bufo)                                                          \
  *(uint4*)(As + (bufo) + (lrow)*72 + lseg * 8) = S##a0;                      \
  *(uint4*)(As + (bufo) + (lrow + 32) * 72 + lseg * 8) = S##a1;               \
  *(uint4*)(As + (bufo) + (lrow + 64) * 72 + lseg * 8) = S##a2;               \
  *(uint4*)(As + (bufo) + (lrow + 96) * 72 + lseg * 8) = S##a3;               \
  *(uint4*)(Bs + (bufo) + (lrow)*72 + lseg * 8) = S##b0;                      \
  *(uint4*)(Bs + (bufo) + (lrow + 32) * 72 + lseg * 8) = S##b1;               \
  *(uint4*)(Bs + (bufo) + (lrow + 64) * 72 + lseg * 8) = S##b2;               \
  *(uint4*)(Bs + (bufo) + (lrow + 96) * 72 + lseg * 8) = S##b3;
#define GCOMP(cb)                                                                                           \
  _Pragma("unroll") for (int ks = 0; ks < 2; ++ks) {                                                        \
    bf16x8 af[4], bfr[4];                                                                                   \
    _Pragma("unroll") for (int mi = 0; mi < 4; ++mi)                                                        \
        af[mi] = ld8(As + (cb) + (wr * 64 + mi * 16 + fr) * 72 + ks * 32 + fq * 8);                         \
    _Pragma("unroll") for (int ni = 0; ni < 4; ++ni)                                                        \
        bfr[ni] = ld8(Bs + (cb) + (wc * 64 + ni * 16 + fr) * 72 + ks * 32 + fq * 8);                        \
    _Pragma("unroll") for (int mi = 0; mi < 4; ++mi)                                                        \
        _Pragma("unroll") for (int ni = 0; ni < 4; ++ni) acc[mi][ni] = mfma(af[mi], bfr[ni], acc[mi][ni]);  \
  }
  constexpr int BUF1 = 2 * 128 * 72;
  GLD(p, 0)
  GLD(q, 1)
  GST(p, 0)
  __syncthreads();
  GLD(p, 2)
  for (int kt = 0; kt < nk; kt += 2) {
    GCOMP(0)
    GST(q, BUF1)
    GLD(q, kt + 3)
    __syncthreads();
    GCOMP(BUF1)
    GST(p, 0)
    GLD(p, kt + 4)
    __syncthreads();
  }
#pragma unroll
  for (int mi = 0; mi < 4; ++mi)
#pragma unroll
    for (int ni = 0; ni < 4; ++ni) {
      int row0 = rt * 128 + wr * 64 + mi * 16 + fq * 4;
      int col = ct * 128 + wc * 64 + ni * 16 + fr;
      f32x4 v = acc[mi][ni];
      if (MODE == 1) {
#pragma unroll
        for (int r = 0; r < 4; ++r) o[(size_t)(row0 + r) * 1024 + col] = v[r];
      } else {
        if (ct >= 28 && ct < 32) {
          uint2 pk; pk.x = pk2(v[0], v[1]); pk.y = pk2(v[2], v[3]);
          *(uint2*)(zT + (size_t)(col - C_IC) * GR + row0) = pk;
        } else if (ct == 44) {
          if (col - C_AB < 16) {
#pragma unroll
            for (int r = 0; r < 4; ++r) ab[(size_t)(row0 + r) * 16 + (col - C_AB)] = v[r];
          }
        } else {
#pragma unroll
          for (int r = 0; r < 4; ++r) z[(size_t)(row0 + r) * NZ + col] = f2bf(v[r]);
        }
      }
    }
}

DEV void a_item(const P& p, int l, int item, int mode, char* smem) {
  float* xc = (float*)smem;
  u16* xcb = (u16*)(smem + 16384);
  float* av = (float*)(smem + 16384 + 9216);
  float* uv = av + 4096;
  float* segP = uv + 4096;
  float* segH = segP + 256;
  const int tid = opq(threadIdx.x), lane = tid & 63, w = tid >> 6, fr = lane & 15, fq = lane >> 4;
  const int cgk = item >> 3, hA = item & 7, n = cgk % 36, rb = cgk * 64;
  u16* z = (u16*)(p.ws + O_Z);
  {
    u16* xin = (u16*)av;
    uint4 st[3];
#pragma unroll
    for (int k = 0; k < 3; ++k) {
      int idx = tid + 256 * k, row = idx >> 3, sg = idx & 7, cp = row - 2;
      bool ok = (idx < 536) && !((cp < 0 && (n == 0 || n == 4)) || (cp > 63 && (n == 3 || n == 35)));
      st[k] = make_uint4(0u, 0u, 0u, 0u);
      if (ok) st[k] = *(const uint4*)(z + (size_t)(rb + cp) * NZ + C_XA + hA * 64 + sg * 8);
    }
    const int j = tid & 63, ch = hA * 64 + j;
    float cw0 = p.conv_a_w[(l * 4 + 0) * 512 + ch], cw1 = p.conv_a_w[(l * 4 + 1) * 512 + ch];
    float cw2 = p.conv_a_w[(l * 4 + 2) * 512 + ch], cw3 = p.conv_a_w[(l * 4 + 3) * 512 + ch];
    float cb = p.conv_a_b[l * 512 + ch];
#pragma unroll
    for (int k = 0; k < 3; ++k) {
      int idx = tid + 256 * k, row = idx >> 3, sg = idx & 7;
      if (idx < 536) *(uint4*)(xin + row * 72 + sg * 8) = st[k];
    }
    __syncthreads();
#pragma unroll
    for (int k = 0; k < 16; ++k) {
      int c = (tid >> 6) + 4 * k;
      float val = cb + cw0 * bf2f(xin[c * 72 + j]) + cw1 * bf2f(xin[(c + 1) * 72 + j]) + cw2 * bf2f(xin[(c + 2) * 72 + j]) +
                  cw3 * bf2f(xin[(c + 3) * 72 + j]);
      xc[c * 64 + j] = val;
      xcb[c * 72 + j] = f2bf(val);
    }
  }
  __syncthreads();
  float yacc[16];
#pragma unroll
  for (int k = 0; k < 16; ++k) yacc[k] = 0.f;
  const int seg = tid >> 6, sj = tid & 63, sch = hA * 64 + sj;
  for (int dir = 0; dir < 2; ++dir) {
    {
      const u16* wg = (const u16*)(p.ws + O_WGT);
      const u16* wr_ = wg + (size_t)((((l * 2 + dir) * 2 + 0) * 8 + hA)) * 4096;
      const u16* wi_ = wg + (size_t)((((l * 2 + dir) * 2 + 1) * 8 + hA)) * 4096;
      bf16x8 a0 = ld8(xcb + (16 * w + fr) * 72 + fq * 8), a1 = ld8(xcb + (16 * w + fr) * 72 + 32 + fq * 8);
#pragma unroll
      for (int nt = 0; nt < 4; ++nt) {
        f32x4 ar = {0.f, 0.f, 0.f, 0.f}, ai = {0.f, 0.f, 0.f, 0.f};
        const u16* br = wr_ + (nt * 16 + fr) * 64 + fq * 8;
        const u16* bi = wi_ + (nt * 16 + fr) * 64 + fq * 8;
        ar = mfma(a0, ld8(br), ar); ar = mfma(a1, ld8(br + 32), ar);
        ai = mfma(a0, ld8(bi), ai); ai = mfma(a1, ld8(bi + 32), ai);
        int j = nt * 16 + fr, ch = hA * 64 + j;
        float brv = p.rg_b_r[(l * 2 + dir) * 512 + ch], biv = p.rg_b_i[(l * 2 + dir) * 512 + ch];
        float sp = softplus(-p.rg_lam[(l * 2 + dir) * 512 + ch]);
#pragma unroll
        for (int r = 0; r < 4; ++r) {
          int c = 16 * w + 4 * fq + r;
          float rg = sigm(ar[r] + brv), ig = sigm(ai[r] + biv);
          float la = -8.f * rg * sp;
          float a = __expf(la);
          float t2 = 2.f * la;
          float om = (t2 > -0.02f) ? -t2 * (1.f + 0.5f * t2 * (1.f + t2 * (1.f / 3.f) * (1.f + 0.25f * t2))) : 1.f - a * a;
          float uu = sqrtf(fmaxf(om, 0.f)) * (ig * xc[c * 64 + j]);
          av[c * 64 + j] = bf2f(f2bf(la));
          uv[c * 64 + j] = bf2f(f2bf(uu));
        }
      }
    }
    __syncthreads();
    {
      float ls = 0.f, H = 0.f;
      u16* ALA = (u16*)(p.ws + O_ALA);
      u16* AU = (u16*)(p.ws + O_AU);
#pragma unroll
      for (int k = 0; k < 16; ++k) {
        int c = dir ? (16 * seg + 15 - k) : (16 * seg + k);
        float la_ = av[c * 64 + sj], u_ = uv[c * 64 + sj];
        H = __expf(la_) * H + u_;
        ls += la_;
        size_t gi = ((size_t)dir * GR + rb + c) * 512 + sch;
        ALA[gi] = f2bf(la_);
        AU[gi] = f2bf(u_);
      }
      segP[seg * 64 + sj] = __expf(ls);
      segH[seg * 64 + sj] = H;
    }
    __syncthreads();
    if (mode == 0) {
      if (seg == 0) {
        float Pc = 1.f, Hc = 0.f;
        for (int q = 0; q < 4; ++q) {
          int sg = dir ? 3 - q : q;
          Hc = segP[sg * 64 + sj] * Hc + segH[sg * 64 + sj];
          Pc *= segP[sg * 64 + sj];
        }
        size_t idx = ((size_t)cgk * 2 + dir) * 512 + sch;
        ((float*)(p.ws + O_AP))[idx] = Pc;
        ((float*)(p.ws + O_AH))[idx] = Hc;
      }
    } else {
      float st = ((const float*)(p.ws + O_ACAR))[((size_t)cgk * 2 + dir) * 512 + sch];
      int nbefore = dir ? 3 - seg : seg;
      for (int q = 0; q < nbefore; ++q) {
        int sg = dir ? 3 - q : q;
        st = segP[sg * 64 + sj] * st + segH[sg * 64 + sj];
      }
      if (dir == 0) {
#pragma unroll
        for (int k = 0; k < 16; ++k) {
          int c = 16 * seg + k;
          st = av[c * 64 + sj] * st + uv[c * 64 + sj];
          yacc[k] += st;
        }
      } else {
#pragma unroll
        for (int k = 15; k >= 0; --k) {
          int c = 16 * seg + k;
          st = av[c * 64 + sj] * st + uv[c * 64 + sj];
          yacc[k] += st;
        }
      }
    }
    __syncthreads();
  }
  if (mode == 1) {
#pragma unroll
    for (int k = 0; k < 16; ++k) {
      size_t zi = (size_t)(rb + 16 * seg + k) * NZ + C_GA + sch;
      float gate = bf2f(z[zi]);
      z[zi] = f2bf(yacc[k] * silu(gate));
    }
  }
}

DEV void a_fin(const P& p, int l, int item, char* smem) {
  float* segP = (float*)smem;
  float* segH = segP + 512;
  const int tid = opq(threadIdx.x), seg = tid >> 6, sj = tid & 63;
  const int cgk = item >> 3, hA = item & 7, rb = cgk * 64, sch = hA * 64 + sj;
  u16* z = (u16*)(p.ws + O_Z);
  const u16* ALA = (const u16*)(p.ws + O_ALA);
  const u16* AU = (const u16*)(p.ws + O_AU);
  u16 lab[2][16], ub[2][16], gt[16];
#pragma unroll
  for (int dir = 0; dir < 2; ++dir)
#pragma unroll
    for (int k = 0; k < 16; ++k) {
      size_t gi = ((size_t)dir * GR + rb + 16 * seg + k) * 512 + sch;
      lab[dir][k] = ALA[gi];
      ub[dir][k] = AU[gi];
    }
#pragma unroll
  for (int k = 0; k < 16; ++k) gt[k] = z[(size_t)(rb + 16 * seg + k) * NZ + C_GA + sch];
  float car0 = ((const float*)(p.ws + O_ACAR))[((size_t)cgk * 2 + 0) * 512 + sch];
  float car1 = ((const float*)(p.ws + O_ACAR))[((size_t)cgk * 2 + 1) * 512 + sch];
  float af[2][16];
#pragma unroll
  for (int dir = 0; dir < 2; ++dir) {
    float ls = 0.f, H = 0.f;
#pragma unroll
    for (int kk = 0; kk < 16; ++kk) {
      const int k = dir ? 15 - kk : kk;
      float la_ = bf2f(lab[dir][k]);
      float a = __expf(la_);
      af[dir][k] = a;
      H = a * H + bf2f(ub[dir][k]);
      ls += la_;
    }
    segP[(dir * 4 + seg) * 64 + sj] = __expf(ls);
    segH[(dir * 4 + seg) * 64 + sj] = H;
  }
  __syncthreads();
  float yacc[16];
#pragma unroll
  for (int k = 0; k < 16; ++k) yacc[k] = 0.f;
#pragma unroll
  for (int dir = 0; dir < 2; ++dir) {
    float st = dir ? car1 : car0;
    const int nbefore = dir ? 3 - seg : seg;
    for (int q = 0; q < nbefore; ++q) {
      int sg = dir ? 3 - q : q;
      st = segP[(dir * 4 + sg) * 64 + sj] * st + segH[(dir * 4 + sg) * 64 + sj];
    }
#pragma unroll
    for (int kk = 0; kk < 16; ++kk) {
      const int k = dir ? 15 - kk : kk;
      st = af[dir][k] * st + bf2f(ub[dir][k]);
      yacc[k] += st;
    }
  }
#pragma unroll
  for (int k = 0; k < 16; ++k)
    z[(size_t)(rb + 16 * seg + k) * NZ + C_GA + sch] = f2bf(yacc[k] * silu(bf2f(gt[k])));
  __syncthreads();
}

DEV void a_fin2(const P& p, int l, int item, char* smem) {
  float* segP = (float*)smem;
  float* segH = segP + 1024;
  const int tid = opq(threadIdx.x), sg = tid >> 5, cp = tid & 31;
  const int cgk = item >> 3, hA = item & 7, rb = cgk * 64, sch = hA * 64 + 2 * cp;
  u16* z = (u16*)(p.ws + O_Z);
  const u16* ALA = (const u16*)(p.ws + O_ALA);
  const u16* AU = (const u16*)(p.ws + O_AU);
  unsigned lab[2][8], ub[2][8], gt[8];
#pragma unroll
  for (int dir = 0; dir < 2; ++dir)
#pragma unroll
    for (int k = 0; k < 8; ++k) {
      size_t gi = ((size_t)dir * GR + rb + 8 * sg + k) * 512 + sch;
      lab[dir][k] = *(const unsigned*)(ALA + gi);
      ub[dir][k] = *(const unsigned*)(AU + gi);
    }
#pragma unroll
  for (int k = 0; k < 8; ++k) gt[k] = *(const unsigned*)(z + (size_t)(rb + 8 * sg + k) * NZ + C_GA + sch);
  const float2 car0 = *(const float2*)((const float*)(p.ws + O_ACAR) + ((size_t)cgk * 2 + 0) * 512 + sch);
  const float2 car1 = *(const float2*)((const float*)(p.ws + O_ACAR) + ((size_t)cgk * 2 + 1) * 512 + sch);
  float af[2][8][2];
#pragma unroll
  for (int dir = 0; dir < 2; ++dir) {
    float ls0 = 0.f, ls1 = 0.f, H0 = 0.f, H1 = 0.f;
#pragma unroll
    for (int kk = 0; kk < 8; ++kk) {
      const int k = dir ? 7 - kk : kk;
      float l0 = bf2f((u16)(lab[dir][k] & 0xffff)), l1 = bf2f((u16)(lab[dir][k] >> 16));
      float a0 = __expf(l0), a1 = __expf(l1);
      af[dir][k][0] = a0; af[dir][k][1] = a1;
      H0 = a0 * H0 + bf2f((u16)(ub[dir][k] & 0xffff));
      H1 = a1 * H1 + bf2f((u16)(ub[dir][k] >> 16));
      ls0 += l0; ls1 += l1;
    }
    *(float2*)(segP + (dir * 8 + sg) * 64 + 2 * cp) = make_float2(__expf(ls0), __expf(ls1));
    *(float2*)(segH + (dir * 8 + sg) * 64 + 2 * cp) = make_float2(H0, H1);
  }
  __syncthreads();
  float y0[8], y1[8];
#pragma unroll
  for (int k = 0; k < 8; ++k) { y0[k] = 0.f; y1[k] = 0.f; }
#pragma unroll
  for (int dir = 0; dir < 2; ++dir) {
    float s0 = dir ? car1.x : car0.x, s1 = dir ? car1.y : car0.y;
    const int nbefore = dir ? 7 - sg : sg;
    for (int q = 0; q < nbefore; ++q) {
      int sq = dir ? 7 - q : q;
      float2 pp = *(const float2*)(segP + (dir * 8 + sq) * 64 + 2 * cp);
      float2 hh = *(const float2*)(segH + (dir * 8 + sq) * 64 + 2 * cp);
      s0 = pp.x * s0 + hh.x;
      s1 = pp.y * s1 + hh.y;
    }
#pragma unroll
    for (int kk = 0; kk < 8; ++kk) {
      const int k = dir ? 7 - kk : kk;
      s0 = af[dir][k][0] * s0 + bf2f((u16)(ub[dir][k] & 0xffff));
      s1 = af[dir][k][1] * s1 + bf2f((u16)(ub[dir][k] >> 16));
      y0[k] += s0; y1[k] += s1;
    }
  }
#pragma unroll
  for (int k = 0; k < 8; ++k) {
    float g0 = bf2f((u16)(gt[k] & 0xffff)), g1 = bf2f((u16)(gt[k] >> 16));
    *(unsigned*)(z + (size_t)(rb + 8 * sg + k) * NZ + C_GA + sch) = pk2(y0[k] * silu(g0), y1[k] * silu(g1));
  }
  __syncthreads();
}

DEV void a_carry(const P& p, int item) {
  int t = item * 256 + threadIdx.x;
  int ch = t & 511, dir = (t >> 9) & 1, lb = t >> 10;
  const float* AP = (const float*)(p.ws + O_AP);
  const float* AH = (const float*)(p.ws + O_AH);
  float* AC = (float*)(p.ws + O_ACAR);
  float st = 0.f;
  float pv[36], hv[36];
#pragma unroll
  for (int j = 0; j < 36; ++j) {
    int n = dir ? (j < 4 ? 3 - j : 39 - j) : j;
    size_t idx = ((size_t)(lb * 36 + n) * 2 + dir) * 512 + ch;
    pv[j] = AP[idx];
    hv[j] = AH[idx];
  }
#pragma unroll
  for (int j = 0; j < 36; ++j) {
    int n = dir ? (j < 4 ? 3 - j : 39 - j) : j;
    size_t idx = ((size_t)(lb * 36 + n) * 2 + dir) * 512 + ch;
    AC[idx] = st;
    st = pv[j] * st + hv[j];
  }
}

DEV void b_local(const P& p, int l, int item, char* smem) {
  u16* qs = (u16*)smem;
  u16* ks = qs + 64 * 136;
  float* Am = (float*)(smem + 34816);
  float* gc = (float*)(smem + 34816 + 32768);
  float* bt = gc + 128;
  const int tid = opq(threadIdx.x), lane = tid & 63, w = tid >> 6, fr = lane & 15, fq = lane >> 4;
  const int cgk = item >> 2, h = item & 3, n = cgk % 36, rb = cgk * 64;
  const u16* z = (const u16*)(p.ws + O_Z);
  u16* qn = (u16*)(p.ws + O_BSH);
  u16* kn = qn + (size_t)GR * 512;
  u16* vb = kn + (size_t)GR * 512;
  u16* knT = vb + (size_t)GR * 512;
  const float* ab = (const float*)(p.ws + O_AB);
  {
    u16* Tt = (u16*)Am;
    uint4 st[5];
#define BL_TLOAD(which)                                                                                  \
  _Pragma("unroll") for (int k = 0; k < 5; ++k) {                                                        \
    int idx = tid + 256 * k, row = idx >> 4, seg = idx & 15, cp = row - 2;                               \
    bool ok = (idx < 1072) && !((cp < 0 && (n == 0 || n == 4)) || (cp > 63 && (n == 3 || n == 35)));    \
    st[k] = make_uint4(0u, 0u, 0u, 0u);                                                                  \
    if (ok) st[k] = *(const uint4*)(z + (size_t)(rb + cp) * NZ + C_Q + (which)*512 + h * 128 + seg * 8); \
  }
    BL_TLOAD(0)
#pragma unroll
    for (int which = 0; which < 3; ++which) {
#pragma unroll
      for (int k = 0; k < 5; ++k) {
        int idx = tid + 256 * k, row = idx >> 4, seg = idx & 15;
        if (idx < 1072) *(uint4*)(Tt + row * 136 + seg * 8) = st[k];
      }
      __syncthreads();
      if (which < 2) { BL_TLOAD(which + 1) }
      float cw[2][4];
#pragma unroll
      for (int hh = 0; hh < 2; ++hh)
#pragma unroll
        for (int tap = 0; tap < 4; ++tap)
          cw[hh][tap] = p.conv_b_w[(size_t)(l * 4 + tap) * 1536 + which * 512 + h * 128 + lane + 64 * hh];
#pragma unroll 4
      for (int c = w; c < 64; c += 4) {
        float v[2];
#pragma unroll
        for (int hh = 0; hh < 2; ++hh) {
          int d = lane + 64 * hh;
          float a = 0.f;
#pragma unroll
          for (int tap = 0; tap < 4; ++tap) a += cw[hh][tap] * bf2f(Tt[(c + tap) * 136 + d]);
          v[hh] = silu(a);
        }
        float rs = 1.f;
        if (which < 2) {
          float sq = v[0] * v[0] + v[1] * v[1];
#pragma unroll
          for (int off = 32; off; off >>= 1) sq += __shfl_xor(sq, off);
          rs = rsqrtf(sq + EPS) * (which == 0 ? 0.08838834764831845f : 1.f);
        }
#pragma unroll
        for (int hh = 0; hh < 2; ++hh) {
          int d = lane + 64 * hh;
          u16 ob = f2bf(v[hh] * rs);
          size_t gi = (size_t)(rb + c) * 512 + h * 128 + d;
          if (which == 0) { qs[c * 136 + d] = ob; qn[gi] = ob; }
          else if (which == 1) { ks[c * 136 + d] = ob; kn[gi] = ob; }
          else vb[gi] = ob;
        }
      }
      __syncthreads();
    }
  }
  if (w < 2) {
    int dir = w, i = lane, c = dir ? 63 - i : i;
    float al = ab[(size_t)(rb + c) * 16 + dir * 4 + h], bl = ab[(size_t)(rb + c) * 16 + 8 + dir * 4 + h];
    float g = -__expf(p.gdn_a_log[(l * 2 + dir) * 4 + h]) * softplus(al + p.gdn_dt_bias[(l * 2 + dir) * 4 + h]);
#pragma unroll
    for (int off = 1; off < 64; off <<= 1) {
      float v = __shfl_up(g, off);
      if (lane >= off) g += v;
    }
    gc[dir * 64 + i] = g;
    bt[dir * 64 + i] = sigm(bl);
  }
  __syncthreads();
  for (int idx = tid; idx < 1024; idx += 256) {
    int d = idx >> 3, c8 = idx & 7;
    uint4 pk;
    pk.x = (unsigned)ks[(c8 * 8 + 0) * 136 + d] | ((unsigned)ks[(c8 * 8 + 1) * 136 + d] << 16);
    pk.y = (unsigned)ks[(c8 * 8 + 2) * 136 + d] | ((unsigned)ks[(c8 * 8 + 3) * 136 + d] << 16);
    pk.z = (unsigned)ks[(c8 * 8 + 4) * 136 + d] | ((unsigned)ks[(c8 * 8 + 5) * 136 + d] << 16);
    pk.w = (unsigned)ks[(c8 * 8 + 6) * 136 + d] | ((unsigned)ks[(c8 * 8 + 7) * 136 + d] << 16);
    *(uint4*)(knT + ((size_t)(cgk * 4 + h) * 128 + d) * 64 + c8 * 8) = pk;
  }
  for (int dir = 0; dir < 2; ++dir) {
    char* rec = p.ws + O_BIT + ((size_t)(cgk * 4 + h) * 2 + dir) * BIT_SZ;
    u16* QKm = (u16*)rec + 4096;
    float* scal = (float*)(rec + 16384);
    int irow = 16 * w + fr, ci = dir ? 63 - irow : irow;
    bf16x8 ak[4], aq[4];
#pragma unroll
    for (int s = 0; s < 4; ++s) { ak[s] = ld8(ks + ci * 136 + 32 * s + 8 * fq); aq[s] = ld8(qs + ci * 136 + 32 * s + 8 * fq); }
#pragma unroll
    for (int nt = 0; nt < 4; ++nt) {
      int jcol = 16 * nt + fr, cj = dir ? 63 - jcol : jcol;
      f32x4 kk = {0.f, 0.f, 0.f, 0.f}, qk = {0.f, 0.f, 0.f, 0.f};
#pragma unroll
      for (int s = 0; s < 4; ++s) {
        bf16x8 b = ld8(ks + cj * 136 + 32 * s + 8 * fq);
        kk = mfma(ak[s], b, kk);
        qk = mfma(aq[s], b, qk);
      }
      float gj = gc[dir * 64 + jcol];
#pragma unroll
      for (int r = 0; r < 4; ++r) {
        int i = 16 * w + 4 * fq + r;
        float dec = (jcol <= i) ? __expf(gc[dir * 64 + i] - gj) : 0.f;
        Am[(dir * 64 + i) * 64 + jcol] = (jcol < i) ? bt[dir * 64 + i] * kk[r] * dec : 0.f;
        QKm[i * 64 + jcol] = f2bf(qk[r] * dec);
      }
    }
    if (tid < 64) {
      float gl = gc[dir * 64 + 63], gi = gc[dir * 64 + tid];
      scal[tid] = __expf(gi);
      scal[64 + tid] = bt[dir * 64 + tid];
      scal[128 + tid] = __expf(gl - gi);
      if (tid == 0) scal[192] = __expf(gl);
    }
  }
  __syncthreads();
  if (w < 2) {
    int dir = w, col = lane;
    u16* Tinv = (u16*)(p.ws + O_BIT + ((size_t)(cgk * 4 + h) * 2 + dir) * BIT_SZ);
    const float* Ad = Am + dir * 4096;
    float T[64];
#pragma unroll
    for (int i = 0; i < 64; ++i) {
      float s = (i == col) ? 1.f : 0.f;
#pragma unroll
      for (int j = 0; j < i; ++j) s -= Ad[i * 64 + j] * T[j];
      T[i] = s;
      Tinv[i * 64 + col] = f2bf(s);
      __builtin_amdgcn_sched_barrier(0);
    }
  }
  __syncthreads();
}

DEV void b_seq(const P& p, int bitem, char* smem) {
  const int tid = opq(threadIdx.x), lane = tid & 63, w = tid >> 6, fr = lane & 15, fq = lane >> 4;
  const bool active = w < WPB;
  const int item = bitem * WPB + (active ? w : 0);
  const int slice = item & 7, dir = (item >> 3) & 1, h = (item >> 4) & 3, lb = item >> 6, e0 = slice * 16;
  u16* Ss = (u16*)(smem + w * 11264);
  u16* Rs = Ss + 16 * 136;
  u16* Vsc = Rs + 16 * 72;
  u16* Vor = Vsc + 16 * 72;
  const u16* qn = (const u16*)(p.ws + O_BSH);
  const u16* kn = qn + (size_t)GR * 512;
  const u16* vb = kn + (size_t)GR * 512;
  const u16* knT = vb + (size_t)GR * 512;
  u16* OB = (u16*)(p.ws + O_OB);
  f32x4 S[8];
#pragma unroll
  for (int m = 0; m < 8; ++m) S[m] = (f32x4){0.f, 0.f, 0.f, 0.f};
  for (int j = 0; j < 36; ++j) {
    const int n = dir ? (j < 4 ? 3 - j : 39 - j) : j;
    const int cgk = lb * 36 + n, rb = cgk * 64;
    const char* rec = p.ws + O_BIT + ((size_t)(cgk * 4 + h) * 2 + dir) * BIT_SZ;
    const u16* Tinv = (const u16*)rec;
    const u16* QKm = Tinv + 4096;
    const float* scal = (const float*)(rec + 16384);
    if (active) {
#pragma unroll
      for (int m = 0; m < 8; ++m) {
        uint2 pk; pk.x = pk2(S[m][0], S[m][1]); pk.y = pk2(S[m][2], S[m][3]);
        *(uint2*)(Ss + fr * 136 + 16 * m + 4 * fq) = pk;
      }
    }
    __syncthreads();
    bf16x8 Sf[4];
    if (active) {
#pragma unroll
      for (int s = 0; s < 4; ++s) Sf[s] = ld8(Ss + fr * 136 + 32 * s + 8 * fq);
#pragma unroll
      for (int m = 0; m < 4; ++m) {
        int i = 16 * m + fr, rowi = rb + (dir ? 63 - i : i);
        f32x4 X = {0.f, 0.f, 0.f, 0.f};
#pragma unroll
        for (int s = 0; s < 4; ++s) X = mfma(ld8(kn + (size_t)rowi * 512 + h * 128 + 32 * s + 8 * fq), Sf[s], X);
        float rv[4];
#pragma unroll
        for (int r = 0; r < 4; ++r) {
          int ii = 16 * m + 4 * fq + r, rowr = rb + (dir ? 63 - ii : ii);
          float v = bf2f(vb[(size_t)rowr * 512 + h * 128 + e0 + fr]);
          rv[r] = scal[64 + ii] * (v - scal[ii] * X[r]);
        }
        uint2 pk; pk.x = pk2(rv[0], rv[1]); pk.y = pk2(rv[2], rv[3]);
        *(uint2*)(Rs + fr * 72 + 16 * m + 4 * fq) = pk;
      }
    }
    __syncthreads();
    if (active) {
      bf16x8 Rf0 = ld8(Rs + fr * 72 + 8 * fq), Rf1 = ld8(Rs + fr * 72 + 32 + 8 * fq);
#pragma unroll
      for (int m = 0; m < 4; ++m) {
        f32x4 VN = {0.f, 0.f, 0.f, 0.f};
        VN = mfma(ld8(Tinv + (16 * m + fr) * 64 + 8 * fq), Rf0, VN);
        VN = mfma(ld8(Tinv + (16 * m + fr) * 64 + 32 + 8 * fq), Rf1, VN);
        uint2 pk; pk.x = pk2(VN[0], VN[1]); pk.y = pk2(VN[2], VN[3]);
        *(uint2*)(Vsc + fr * 72 + 16 * m + 4 * fq) = pk;
        int ib = 16 * m + 4 * fq;
        float s0 = VN[0] * scal[128 + ib], s1 = VN[1] * scal[128 + ib + 1], s2 = VN[2] * scal[128 + ib + 2],
              s3 = VN[3] * scal[128 + ib + 3];
        if (dir) {
          pk.x = pk2(s3, s2); pk.y = pk2(s1, s0);
          *(uint2*)(Vor + fr * 72 + (60 - ib)) = pk;
        } else {
          pk.x = pk2(s0, s1); pk.y = pk2(s2, s3);
          *(uint2*)(Vor + fr * 72 + ib) = pk;
        }
      }
    }
    __syncthreads();
    if (active) {
      bf16x8 Vs0 = ld8(Vsc + fr * 72 + 8 * fq), Vs1 = ld8(Vsc + fr * 72 + 32 + 8 * fq);
      bf16x8 Vo0 = ld8(Vor + fr * 72 + 8 * fq), Vo1 = ld8(Vor + fr * 72 + 32 + 8 * fq);
#pragma unroll
      for (int m = 0; m < 4; ++m) {
        int i = 16 * m + fr, rowi = rb + (dir ? 63 - i : i);
        f32x4 O = {0.f, 0.f, 0.f, 0.f};
#pragma unroll
        for (int s = 0; s < 4; ++s) O = mfma(ld8(qn + (size_t)rowi * 512 + h * 128 + 32 * s + 8 * fq), Sf[s], O);
#pragma unroll
        for (int r = 0; r < 4; ++r) O[r] *= scal[16 * m + 4 * fq + r];
        O = mfma(ld8(QKm + (16 * m + fr) * 64 + 8 * fq), Vs0, O);
        O = mfma(ld8(QKm + (16 * m + fr) * 64 + 32 + 8 * fq), Vs1, O);
#pragma unroll
        for (int r = 0; r < 4; ++r) {
          int ii = 16 * m + 4 * fq + r, rowr = rb + (dir ? 63 - ii : ii);
          OB[((size_t)dir * GR + rowr) * 512 + h * 128 + e0 + fr] = f2bf(O[r]);
        }
      }
      float egl = scal[192];
#pragma unroll
      for (int m = 0; m < 8; ++m) {
        const u16* kt = knT + ((size_t)(cgk * 4 + h) * 128 + 16 * m + fr) * 64;
        f32x4 t = S[m];
#pragma unroll
        for (int r = 0; r < 4; ++r) t[r] *= egl;
        t = mfma(ld8(kt + 8 * fq), Vo0, t);
        t = mfma(ld8(kt + 32 + 8 * fq), Vo1, t);
        S[m] = t;
      }
    }
  }
  __syncthreads();
}

DEV void c_local(const P& p, int l, int item, char* smem) {
  float* bsm = (float*)smem;
  u16* Ps = (u16*)(smem + 33024);
  u16* kdt = (u16*)(smem + 33024 + 9216);
  const int tid = opq(threadIdx.x), lane = tid & 63, w = tid >> 6, fr = lane & 15, fq = lane >> 4;
  const int cgk = item >> 2, h = item & 3, rb = cgk * 64;
  const u16* z = (const u16*)(p.ws + O_Z);
  const u16* zT = (const u16*)(p.ws + O_ZT);
  u16* OC = (u16*)(p.ws + O_OC);
  const float* lbs = (const float*)(p.ws + O_LBS);
  for (int dir = 0; dir < 2; ++dir) {
    char* rec = p.ws + O_CREC + ((size_t)(cgk * 4 + h) * 2 + dir) * CREC_SZ;
    u16* QD = (u16*)rec;
    u16* KDT = QD + 8192;
    float* decv = (float*)(rec + 32768);
    const float* lbp = lbs + l * 1024 + dir * 512 + h * 128;
    const int fcol = C_F0 + dir * 512 + h * 128;
    {
      int d = tid & 127, half = tid >> 7;
      float lb_ = lbp[d], run = 0.f;
      for (int k = 0; k < 32; ++k) {
        int i = 32 * half + k, c = dir ? 63 - i : i;
        float f = bf2f(z[(size_t)(rb + c) * NZ + fcol + d]);
        float fg = lb_ + (1.f - lb_) * sigm(f);
        run += __logf(fg);
        bsm[i * 129 + d] = run;
      }
    }
    __syncthreads();
    {
      int d = tid & 127, half = tid >> 7;
      if (half) {
        float add = bsm[31 * 129 + d];
        for (int k = 0; k < 32; ++k) bsm[(32 + k) * 129 + d] += add;
      }
    }
    __syncthreads();
    for (int idx = tid; idx < 8192; idx += 256) {
      int i = idx >> 7, d = idx & 127, c = dir ? 63 - i : i;
      float b = bsm[i * 129 + d];
      float q = silu(bf2f(z[(size_t)(rb + c) * NZ + C_QC + h * 128 + d]));
      QD[i * 128 + d] = f2bf(q * __expf(b));
      float f = bf2f(z[(size_t)(rb + c) * NZ + fcol + d]);
      float k = (1.f - lbp[d]) * sigm(-f);
      kdt[d * 72 + c] = f2bf(k * __expf(bsm[63 * 129 + d] - b));
    }
    if (tid < 128) decv[tid] = __expf(bsm[63 * 129 + tid]);
    __syncthreads();
    for (int idx = tid; idx < 1024; idx += 256) {
      int d = idx >> 3, c8 = idx & 7;
      *(uint4*)(KDT + d * 64 + c8 * 8) = *(const uint4*)(kdt + d * 72 + c8 * 8);
    }
    {
      const int sj = w;
      for (int si = 0; si < 4; ++si) {
        f32x4 acc = {0.f, 0.f, 0.f, 0.f};
        if (si >= sj) {
          int it = 16 * si + fr, jt = 16 * sj + fr;
          int ci = dir ? 63 - it : it, cj = dir ? 63 - jt : jt;
#pragma unroll
          for (int s = 0; s < 4; ++s) {
            int d0 = 32 * s + 8 * fq;
            bf16x8 qv = ld8(z + (size_t)(rb + ci) * NZ + C_QC + h * 128 + d0);
            bf16x8 fv = ld8(z + (size_t)(rb + cj) * NZ + fcol + d0);
            bf16x8 af, bf;
#pragma unroll
            for (int e = 0; e < 8; ++e) {
              int d = d0 + e;
              float Bs_ = si ? bsm[(16 * si - 1) * 129 + d] : 0.f;
              float qq = silu(bf2f((u16)qv[e])) * __expf(bsm[it * 129 + d] - Bs_);
              float kk = (1.f - lbp[d]) * sigm(-bf2f((u16)fv[e])) * __expf(Bs_ - bsm[jt * 129 + d]);
              af[e] = (short)f2bf(qq);
              bf[e] = (short)f2bf(kk);
            }
            acc = mfma(af, bf, acc);
          }
        }
#pragma unroll
        for (int r = 0; r < 4; ++r) {
          int i = 16 * si + 4 * fq + r, jj = 16 * sj + fr;
          float v = (si >= sj && jj <= i) ? acc[r] : 0.f;
          Ps[i * 72 + (dir ? 63 - jj : jj)] = f2bf(v);
        }
        __builtin_amdgcn_sched_barrier(0);
      }
    }
    __syncthreads();
#pragma unroll
    for (int nt2 = 0; nt2 < 2; ++nt2) {
      int e = h * 128 + (2 * w + nt2) * 16 + fr;
      bf16x8 v0 = ld8(zT + (size_t)e * GR + rb + 8 * fq), v1 = ld8(zT + (size_t)e * GR + rb + 32 + 8 * fq);
#pragma unroll
      for (int m = 0; m < 4; ++m) {
        f32x4 O = {0.f, 0.f, 0.f, 0.f};
        O = mfma(ld8(Ps + (16 * m + fr) * 72 + 8 * fq), v0, O);
        O = mfma(ld8(Ps + (16 * m + fr) * 72 + 32 + 8 * fq), v1, O);
#pragma unroll
        for (int r = 0; r < 4; ++r) {
          int ii = 16 * m + 4 * fq + r, rowr = rb + (dir ? 63 - ii : ii);
          OC[((size_t)dir * GR + rowr) * 512 + e] = f2bf(O[r]);
        }
      }
    }
    __syncthreads();
  }
}

DEV void c_seq(const P& p, int bitem, char* smem) {
  const int tid = opq(threadIdx.x), lane = tid & 63, w = tid >> 6, fr = lane & 15, fq = lane >> 4;
  const bool active = w < WPB;
  const int item = bitem * WPB + (active ? w : 0);
  const int slice = item & 7, dir = (item >> 3) & 1, h = (item >> 4) & 3, lb = item >> 6, e0 = slice * 16;
  u16* Ss = (u16*)(smem + w * 4352);
  const u16* zT = (const u16*)(p.ws + O_ZT);
  u16* OC = (u16*)(p.ws + O_OC);
  f32x4 S[8];
#pragma unroll
  for (int m = 0; m < 8; ++m) S[m] = (f32x4){0.f, 0.f, 0.f, 0.f};
  for (int j = 0; j < 36; ++j) {
    const int n = dir ? (j < 4 ? 3 - j : 39 - j) : j;
    const int cgk = lb * 36 + n, rb = cgk * 64;
    const char* rec = p.ws + O_CREC + ((size_t)(cgk * 4 + h) * 2 + dir) * CREC_SZ;
    const u16* QD = (const u16*)rec;
    const u16* KDT = QD + 8192;
    const float* decv = (const float*)(rec + 32768);
    if (active) {
#pragma unroll
      for (int m = 0; m < 8; ++m) {
        uint2 pk; pk.x = pk2(S[m][0], S[m][1]); pk.y = pk2(S[m][2], S[m][3]);
        *(uint2*)(Ss + fr * 136 + 16 * m + 4 * fq) = pk;
      }
    }
    __syncthreads();
    if (active) {
      bf16x8 Sf[4];
#pragma unroll
      for (int s = 0; s < 4; ++s) Sf[s] = ld8(Ss + fr * 136 + 32 * s + 8 * fq);
#pragma unroll
      for (int m = 0; m < 4; ++m) {
        f32x4 O = {0.f, 0.f, 0.f, 0.f};
#pragma unroll
        for (int s = 0; s < 4; ++s) O = mfma(ld8(QD + (16 * m + fr) * 128 + 32 * s + 8 * fq), Sf[s], O);
#pragma unroll
        for (int r = 0; r < 4; ++r) {
          int ii = 16 * m + 4 * fq + r, rowr = rb + (dir ? 63 - ii : ii);
          size_t oi = ((size_t)dir * GR + rowr) * 512 + h * 128 + e0 + fr;
          OC[oi] = f2bf(bf2f(OC[oi]) + O[r]);
        }
      }
      const u16* vp = zT + (size_t)(h * 128 + e0 + fr) * GR + rb;
      bf16x8 V0 = ld8(vp + 8 * fq), V1 = ld8(vp + 32 + 8 * fq);
#pragma unroll
      for (int m = 0; m < 8; ++m) {
        f32x4 t = S[m];
#pragma unroll
        for (int r = 0; r < 4; ++r) t[r] *= decv[16 * m + 4 * fq + r];
        t = mfma(ld8(KDT + (16 * m + fr) * 64 + 8 * fq), V0, t);
        t = mfma(ld8(KDT + (16 * m + fr) * 64 + 32 + 8 * fq), V1, t);
        S[m] = t;
      }
    }
    __syncthreads();
  }
}

#define LBAR()                                              \
  do {                                                      \
    asm volatile("s_waitcnt lgkmcnt(0)" ::: "memory");      \
    __builtin_amdgcn_s_barrier();                           \
    asm volatile("" ::: "memory");                          \
  } while (0)
#define CBAR() asm volatile("" ::: "memory")

DEV void c_local2(const P& p, int l, int item, char* smem) {
  float* bsm = (float*)smem;
  u16* Fq = (u16*)(smem + 33024);
  u16* kdt = (u16*)(smem + 50432);
  u16* Ps = kdt;
  const int tid = opq(threadIdx.x), lane = tid & 63, w = tid >> 6, fr = lane & 15, fq = lane >> 4;
  const int cgk = item >> 2, h = item & 3, rb = cgk * 64;
  const u16* z = (const u16*)(p.ws + O_Z);
  const u16* zT = (const u16*)(p.ws + O_ZT);
  u16* OC = (u16*)(p.ws + O_OC);
  const float* lbs = (const float*)(p.ws + O_LBS);
  u16* zq = (u16*)(p.ws + O_Z) + (size_t)rb * NZ + C_QC + h * 128;
  {
    uint4 t4[4];
#pragma unroll
    for (int k = 0; k < 4; ++k) {
      int idx = tid + 256 * k, c = idx >> 4, seg = idx & 15;
      t4[k] = *(const uint4*)(zq + (size_t)c * NZ + seg * 8);
    }
#pragma unroll
    for (int k = 0; k < 4; ++k) {
      int idx = tid + 256 * k, c = idx >> 4, seg = idx & 15;
      unsigned wv[4] = {t4[k].x, t4[k].y, t4[k].z, t4[k].w};
#pragma unroll
      for (int q = 0; q < 4; ++q)
        wv[q] = pk2(silu(bf2f((u16)(wv[q] & 0xffff))), silu(bf2f((u16)(wv[q] >> 16))));
      *(uint4*)(zq + (size_t)c * NZ + seg * 8) = make_uint4(wv[0], wv[1], wv[2], wv[3]);
    }
  }
  __syncthreads();
  for (int dir = 0; dir < 2; ++dir) {
    char* rec = p.ws + O_CREC + ((size_t)(cgk * 4 + h) * 2 + dir) * CREC_SZ;
    u16* QD = (u16*)rec;
    u16* KDT = QD + 8192;
    float* decv = (float*)(rec + 32768);
    const float* lbp = lbs + l * 1024 + dir * 512 + h * 128;
    const int fcol = C_F0 + dir * 512 + h * 128;
    {
      uint4 t4[4];
#pragma unroll
      for (int k = 0; k < 4; ++k) {
        int idx = tid + 256 * k, c = idx >> 4, seg = idx & 15;
        t4[k] = *(const uint4*)(z + (size_t)(rb + c) * NZ + fcol + seg * 8);
      }
#pragma unroll
      for (int k = 0; k < 4; ++k) {
        int idx = tid + 256 * k, c = idx >> 4, seg = idx & 15;
        *(uint4*)(Fq + c * 136 + seg * 8) = t4[k];
      }
    }
    __syncthreads();
    {
      int d = tid & 127, half = tid >> 7;
      float lb_ = lbp[d], run = 0.f;
#pragma unroll 8
      for (int k = 0; k < 32; ++k) {
        int i = 32 * half + k, c = dir ? 63 - i : i;
        float f = bf2f(Fq[c * 136 + d]);
        float fg = lb_ + (1.f - lb_) * sigm(f);
        run += __logf(fg);
        bsm[i * 129 + d] = run;
      }
    }
    __syncthreads();
    {
      int d = tid & 127, half = tid >> 7;
      if (half) {
        float add = bsm[31 * 129 + d];
#pragma unroll 8
        for (int k = 0; k < 32; ++k) bsm[(32 + k) * 129 + d] += add;
      }
    }
    __syncthreads();
    {
      uint4 qv[4];
#pragma unroll
      for (int k = 0; k < 4; ++k) {
        int idx = tid + 256 * k, c = idx >> 4, seg = idx & 15;
        qv[k] = *(const uint4*)(zq + (size_t)c * NZ + seg * 8);
      }
#pragma unroll
      for (int k = 0; k < 4; ++k) {
        int idx = tid + 256 * k, c = idx >> 4, seg = idx & 15, i = dir ? 63 - c : c, d0 = seg * 8;
        unsigned qw[4] = {qv[k].x, qv[k].y, qv[k].z, qv[k].w};
        uint4 fv4 = *(const uint4*)(Fq + c * 136 + d0);
        unsigned fw[4] = {fv4.x, fv4.y, fv4.z, fv4.w};
        unsigned qo[4], ko[4];
#pragma unroll
        for (int q = 0; q < 4; ++q) {
          int d = d0 + 2 * q;
          float b0 = bsm[i * 129 + d], b1 = bsm[i * 129 + d + 1];
          float bl0 = bsm[63 * 129 + d], bl1 = bsm[63 * 129 + d + 1];
          float q0 = bf2f((u16)(qw[q] & 0xffff)), q1 = bf2f((u16)(qw[q] >> 16));
          qo[q] = pk2(q0 * __expf(b0), q1 * __expf(b1));
          float k0 = (1.f - lbp[d]) * sigm(-bf2f((u16)(fw[q] & 0xffff)));
          float k1 = (1.f - lbp[d + 1]) * sigm(-bf2f((u16)(fw[q] >> 16)));
          ko[q] = pk2(k0, k1);
          kdt[d * 72 + c] = f2bf(k0 * __expf(bl0 - b0));
          kdt[(d + 1) * 72 + c] = f2bf(k1 * __expf(bl1 - b1));
        }
        *(uint4*)(QD + i * 128 + d0) = make_uint4(qo[0], qo[1], qo[2], qo[3]);
        *(uint4*)(Fq + c * 136 + d0) = make_uint4(ko[0], ko[1], ko[2], ko[3]);
      }
      if (tid < 128) decv[tid] = __expf(bsm[63 * 129 + tid]);
    }
    __syncthreads();
    for (int idx = tid; idx < 1024; idx += 256) {
      int d = idx >> 3, c8 = idx & 7;
      *(uint4*)(KDT + d * 64 + c8 * 8) = *(const uint4*)(kdt + d * 72 + c8 * 8);
    }
    bf16x8 qf[3][4];
#pragma unroll
    for (int t = 0; t < 3; ++t) {
      int k = w + 4 * t;
      int si = k < 4 ? 3 : (k < 7 ? 2 : (k < 9 ? 1 : 0));
      int it_ = 16 * si + fr, ci_ = dir ? 63 - it_ : it_;
#pragma unroll
      for (int s = 0; s < 4; ++s) qf[t][s] = ld8(zq + (size_t)ci_ * NZ + 32 * s + 8 * fq);
    }
    __syncthreads();
    for (int idx = tid; idx < 1536; idx += 256) {
      int tl = idx >> 8, e = idx & 255, r16 = e >> 4, c16 = e & 15;
      int si = tl < 3 ? 0 : (tl < 5 ? 1 : 2);
      int sj = tl < 3 ? tl + 1 : (tl < 5 ? tl - 1 : 3);
      int jj = 16 * sj + c16;
      Ps[(16 * si + r16) * 72 + (dir ? 63 - jj : jj)] = 0;
    }
#pragma unroll
    for (int t = 0; t < 3; ++t) {
      const int k = w + 4 * t;
      if (k < 10) {
        const int si = k < 4 ? 3 : (k < 7 ? 2 : (k < 9 ? 1 : 0));
        const int sj = k - (k < 4 ? 0 : (k < 7 ? 4 : (k < 9 ? 7 : 9)));
        const int it = 16 * si + fr, jt = 16 * sj + fr, cj = dir ? 63 - jt : jt;
        const int brow = si ? (16 * si - 1) : 0;
        const float bmul = si ? 1.f : 0.f;
        f32x4 acc = {0.f, 0.f, 0.f, 0.f};
#pragma unroll
        for (int s = 0; s < 4; ++s) {
          int d0 = 32 * s + 8 * fq;
          bf16x8 fv = ld8(Fq + cj * 136 + d0);
          bf16x8 af, bf;
#pragma unroll
          for (int e = 0; e < 8; ++e) {
            int d = d0 + e;
            float Bs_ = bmul * bsm[brow * 129 + d];
            float qq = bf2f((u16)qf[t][s][e]) * __expf(bsm[it * 129 + d] - Bs_);
            float kk = bf2f((u16)fv[e]) * __expf(Bs_ - bsm[jt * 129 + d]);
            af[e] = (short)f2bf(qq);
            bf[e] = (short)f2bf(kk);
          }
          acc = mfma(af, bf, acc);
          __builtin_amdgcn_sched_barrier(0);
        }
#pragma unroll
        for (int r = 0; r < 4; ++r) {
          int i = 16 * si + 4 * fq + r, jj = 16 * sj + fr;
          float v = (jj <= i) ? acc[r] : 0.f;
          Ps[i * 72 + (dir ? 63 - jj : jj)] = f2bf(v);
        }
      }
    }
    __syncthreads();
#pragma unroll
    for (int nt2 = 0; nt2 < 2; ++nt2) {
      int e = h * 128 + (2 * w + nt2) * 16 + fr;
      bf16x8 v0 = ld8(zT + (size_t)e * GR + rb + 8 * fq), v1 = ld8(zT + (size_t)e * GR + rb + 32 + 8 * fq);
#pragma unroll
      for (int m = 0; m < 4; ++m) {
        f32x4 O = {0.f, 0.f, 0.f, 0.f};
        O = mfma(ld8(Ps + (16 * m + fr) * 72 + 8 * fq), v0, O);
        O = mfma(ld8(Ps + (16 * m + fr) * 72 + 32 + 8 * fq), v1, O);
#pragma unroll
        for (int r = 0; r < 4; ++r) {
          int ii = 16 * m + 4 * fq + r, rowr = rb + (dir ? 63 - ii : ii);
          OC[((size_t)dir * GR + rowr) * 512 + e] = f2bf(O[r]);
        }
      }
    }
    __syncthreads();
  }
}

#define LBAR()                                              \
  do {                                                      \
    asm volatile("s_waitcnt lgkmcnt(0)" ::: "memory");      \
    __builtin_amdgcn_s_barrier();                           \
    asm volatile("" ::: "memory");                          \
  } while (0)
#define CBAR() asm volatile("" ::: "memory")
#define BS_CHUNK(jj) (dir ? ((jj) < 4 ? 3 - (jj) : 39 - (jj)) : (jj))
DEV bf16x8 ldo8(const char* base, unsigned off) { return *reinterpret_cast<const bf16x8*>(base + off); }
DEV void b_seq2(const P& p, int bitem, char* smem) {
  const int tid = opq(threadIdx.x), lane = tid & 63, w = tid >> 6, fr = lane & 15, fq = lane >> 4;
  const int es = bitem & 3, dir = (bitem >> 2) & 1, h = (bitem >> 3) & 3, lb = bitem >> 5, e0 = es * 32;
  u16* Ss = (u16*)smem;
  u16* Rs = Ss + 32 * 136;
  u16* Vsc = Rs + 32 * 72;
  u16* Vor = Vsc + 32 * 72;
  const char* qnB = p.ws + O_BSH + (size_t)h * 256;
  const char* knB = qnB + BSH_ONE;
  const char* vbB = knB + BSH_ONE + (size_t)e0 * 2;
  const char* ktB = p.ws + O_BSH + 3 * BSH_ONE + (size_t)h * 16384;
  const char* recB = p.ws + O_BIT + ((size_t)h * 2 + dir) * BIT_SZ;
  char* obB = p.ws + O_OB + ((size_t)dir * GR * 512 + h * 128 + e0) * 2;
  const int mrow = 16 * w + fr, crow0 = 16 * w + 4 * fq;
  const unsigned offA = (unsigned)((dir ? 63 - mrow : mrow) * 1024 + 16 * fq);
  unsigned offR[4];
#pragma unroll
  for (int r = 0; r < 4; ++r) offR[r] = (unsigned)((dir ? 63 - (crow0 + r) : (crow0 + r)) * 1024 + fr * 2);
  const unsigned offT = (unsigned)(mrow * 128 + 16 * fq);
  const unsigned offK = (unsigned)((32 * w + fr) * 128 + 16 * fq);
  const unsigned offS = (unsigned)(16384 + crow0 * 4);
  f32x4 S[2][2];
#pragma unroll
  for (int a = 0; a < 2; ++a)
#pragma unroll
    for (int b = 0; b < 2; ++b) S[a][b] = (f32x4){0.f, 0.f, 0.f, 0.f};
  bf16x8 Akn[4], Aqn[4], At[2][2], Aqk[2][2], AkT[2][2][2];
  u16 vbv[2][4];
  float4 eg4, be4, ek4[2];
  float egl[2];
#define BS_LOAD1(cg_)                                                              \
  {                                                                                \
    const size_t ro_ = (size_t)(cg_) * 65536;                                      \
    _Pragma("unroll") for (int s = 0; s < 4; ++s) {                                \
      Akn[s] = ldo8(knB + ro_, offA + 64 * s);                                     \
      Aqn[s] = ldo8(qnB + ro_, offA + 64 * s);                                     \
    }                                                                              \
    _Pragma("unroll") for (int r = 0; r < 4; ++r) {                                \
      vbv[0][r] = *(const u16*)(vbB + ro_ + offR[r]);                              \
      vbv[1][r] = *(const u16*)(vbB + ro_ + (offR[r] + 32));                       \
    }                                                                              \
    const char* rc_ = recB + (size_t)(cg_) * (8 * BIT_SZ);                         \
    eg4 = *(const float4*)(rc_ + offS);                                            \
    be4 = *(const float4*)(rc_ + (offS + 256));                                    \
  }
#define BS_LOAD2(cg_, SS)                                                          \
  {                                                                                \
    const char* rc_ = recB + (size_t)(cg_) * (8 * BIT_SZ);                         \
    At[SS][0] = ldo8(rc_, offT); At[SS][1] = ldo8(rc_, offT + 64);                 \
    ek4[SS] = *(const float4*)(rc_ + (offS + 512));                                \
  }
#define BS_LOAD3(cg_, SS)                                                          \
  {                                                                                \
    const char* rc_ = recB + (size_t)(cg_) * (8 * BIT_SZ);                         \
    Aqk[SS][0] = ldo8(rc_, offT + 8192); Aqk[SS][1] = ldo8(rc_, offT + 8192 + 64); \
    egl[SS] = *(const float*)(rc_ + 16384 + 768);                                  \
    const char* kt_ = ktB + (size_t)(cg_) * 65536;                                 \
    AkT[SS][0][0] = ldo8(kt_, offK); AkT[SS][0][1] = ldo8(kt_, offK + 64);         \
    AkT[SS][1][0] = ldo8(kt_, offK + 2048); AkT[SS][1][1] = ldo8(kt_, offK + 2048 + 64); \
  }
  {
    const int c0 = lb * 36 + BS_CHUNK(0);
    BS_LOAD1(c0) BS_LOAD2(c0, 0) BS_LOAD3(c0, 0)
  }
  for (int j2 = 0; j2 < 36; j2 += 2)
#pragma unroll
  for (int u = 0; u < 2; ++u) {
    const int j = j2 + u;
    const int cgk = lb * 36 + BS_CHUNK(j);
    const int jn = (j + 1 < 36) ? j + 1 : j;
    const int cgn = lb * 36 + BS_CHUNK(jn);
    BS_LOAD2(cgn, u ^ 1)
    BS_LOAD3(cgn, u ^ 1)
#pragma unroll
    for (int mm = 0; mm < 2; ++mm)
#pragma unroll
      for (int nt = 0; nt < 2; ++nt) {
        uint2 pk; pk.x = pk2(S[mm][nt][0], S[mm][nt][1]); pk.y = pk2(S[mm][nt][2], S[mm][nt][3]);
        *(uint2*)(Ss + (16 * nt + fr) * 136 + 32 * w + 16 * mm + 4 * fq) = pk;
      }
    LBAR();
    f32x4 QS[2];
    {
      bf16x8 Sf[2][4];
#pragma unroll
      for (int nt = 0; nt < 2; ++nt)
#pragma unroll
        for (int s = 0; s < 4; ++s) Sf[nt][s] = ld8(Ss + (16 * nt + fr) * 136 + 32 * s + 8 * fq);
#pragma unroll
      for (int nt = 0; nt < 2; ++nt) {
        f32x4 X = {0.f, 0.f, 0.f, 0.f}, Q = {0.f, 0.f, 0.f, 0.f};
#pragma unroll
        for (int s = 0; s < 4; ++s) { X = mfma(Akn[s], Sf[nt][s], X); Q = mfma(Aqn[s], Sf[nt][s], Q); }
        float r0 = be4.x * (bf2f(vbv[nt][0]) - eg4.x * X[0]);
        float r1 = be4.y * (bf2f(vbv[nt][1]) - eg4.y * X[1]);
        float r2 = be4.z * (bf2f(vbv[nt][2]) - eg4.z * X[2]);
        float r3 = be4.w * (bf2f(vbv[nt][3]) - eg4.w * X[3]);
        uint2 pk; pk.x = pk2(r0, r1); pk.y = pk2(r2, r3);
        *(uint2*)(Rs + (16 * nt + fr) * 72 + crow0) = pk;
        Q[0] *= eg4.x; Q[1] *= eg4.y; Q[2] *= eg4.z; Q[3] *= eg4.w;
        QS[nt] = Q;
      }
    }
    CBAR();
    BS_LOAD1(cgn)
    LBAR();
    {
#pragma unroll
      for (int nt = 0; nt < 2; ++nt) {
        bf16x8 Rf0 = ld8(Rs + (16 * nt + fr) * 72 + 8 * fq), Rf1 = ld8(Rs + (16 * nt + fr) * 72 + 32 + 8 * fq);
        f32x4 VN = {0.f, 0.f, 0.f, 0.f};
        VN = mfma(At[u][0], Rf0, VN);
        VN = mfma(At[u][1], Rf1, VN);
        uint2 pk; pk.x = pk2(VN[0], VN[1]); pk.y = pk2(VN[2], VN[3]);
        *(uint2*)(Vsc + (16 * nt + fr) * 72 + crow0) = pk;
        float s0 = VN[0] * ek4[u].x, s1 = VN[1] * ek4[u].y, s2 = VN[2] * ek4[u].z, s3 = VN[3] * ek4[u].w;
        if (dir) {
          pk.x = pk2(s3, s2); pk.y = pk2(s1, s0);
          *(uint2*)(Vor + (16 * nt + fr) * 72 + (60 - crow0)) = pk;
        } else {
          pk.x = pk2(s0, s1); pk.y = pk2(s2, s3);
          *(uint2*)(Vor + (16 * nt + fr) * 72 + crow0) = pk;
        }
      }
    }
    LBAR();
    {
      char* ob_ = obB + (size_t)cgk * 65536;
#pragma unroll
      for (int nt = 0; nt < 2; ++nt) {
        bf16x8 Vs0 = ld8(Vsc + (16 * nt + fr) * 72 + 8 * fq), Vs1 = ld8(Vsc + (16 * nt + fr) * 72 + 32 + 8 * fq);
        bf16x8 Vo0 = ld8(Vor + (16 * nt + fr) * 72 + 8 * fq), Vo1 = ld8(Vor + (16 * nt + fr) * 72 + 32 + 8 * fq);
        f32x4 O = QS[nt];
        O = mfma(Aqk[u][0], Vs0, O);
        O = mfma(Aqk[u][1], Vs1, O);
#pragma unroll
        for (int r = 0; r < 4; ++r) *(u16*)(ob_ + (offR[r] + 32 * nt)) = f2bf(O[r]);
#pragma unroll
        for (int mm = 0; mm < 2; ++mm) {
          f32x4 t = S[mm][nt];
#pragma unroll
          for (int r = 0; r < 4; ++r) t[r] *= egl[u];
          t = mfma(AkT[u][mm][0], Vo0, t);
          t = mfma(AkT[u][mm][1], Vo1, t);
          S[mm][nt] = t;
        }
      }
    }
  }
  LBAR();
}

DEV void c_seq2(const P& p, int bitem, char* smem) {
  const int tid = opq(threadIdx.x), lane = tid & 63, w = tid >> 6, fr = lane & 15, fq = lane >> 4;
  const int es = bitem & 3, dir = (bitem >> 2) & 1, h = (bitem >> 3) & 3, lb = bitem >> 5, e0 = es * 32;
  u16* Ssb = (u16*)smem;
  const char* recB = p.ws + O_CREC + ((size_t)h * 2 + dir) * CREC_SZ;
  const char* ztB = p.ws + O_ZT + (size_t)(h * 128 + e0) * GR * 2;
  char* ocB = p.ws + O_OC + ((size_t)dir * GR * 512 + h * 128 + e0) * 2;
  const int mrow = 16 * w + fr, crow0 = 16 * w + 4 * fq;
  const unsigned offQ = (unsigned)(mrow * 256 + 16 * fq);
  const unsigned offK = (unsigned)(16384 + (32 * w + fr) * 128 + 16 * fq);
  const unsigned offD = (unsigned)(32768 + (32 * w + 4 * fq) * 4);
  const unsigned offV = (unsigned)(fr * GR * 2 + 16 * fq);
  unsigned offR[4];
#pragma unroll
  for (int r = 0; r < 4; ++r) offR[r] = (unsigned)((dir ? 63 - (crow0 + r) : (crow0 + r)) * 1024 + fr * 2);
  f32x4 S[2][2];
#pragma unroll
  for (int a = 0; a < 2; ++a)
#pragma unroll
    for (int b = 0; b < 2; ++b) S[a][b] = (f32x4){0.f, 0.f, 0.f, 0.f};
  bf16x8 Aqd[4], Akd[2][2], Vf[2][2];
  u16 oi[2][4];
  float4 dec4[2];
#define CS_LOAD(cg_)                                                                    \
  {                                                                                     \
    const char* rc_ = recB + (size_t)(cg_) * (8 * CREC_SZ);                             \
    _Pragma("unroll") for (int s = 0; s < 4; ++s) Aqd[s] = ldo8(rc_, offQ + 64 * s);    \
    Akd[0][0] = ldo8(rc_, offK); Akd[0][1] = ldo8(rc_, offK + 64);                      \
    Akd[1][0] = ldo8(rc_, offK + 2048); Akd[1][1] = ldo8(rc_, offK + 2048 + 64);        \
    dec4[0] = *(const float4*)(rc_ + offD);                                             \
    dec4[1] = *(const float4*)(rc_ + (offD + 64));                                      \
    const char* zt_ = ztB + (size_t)(cg_) * 128;                                        \
    Vf[0][0] = ldo8(zt_, offV); Vf[0][1] = ldo8(zt_, offV + 64);                        \
    Vf[1][0] = ldo8(zt_, offV + 16 * GR * 2); Vf[1][1] = ldo8(zt_, offV + 16 * GR * 2 + 64); \
    const char* oc_ = ocB + (size_t)(cg_) * 65536;                                      \
    _Pragma("unroll") for (int r = 0; r < 4; ++r) {                                     \
      oi[0][r] = *(const u16*)(oc_ + offR[r]);                                          \
      oi[1][r] = *(const u16*)(oc_ + (offR[r] + 32));                                   \
    }                                                                                   \
  }
  {
    const int c0 = lb * 36 + BS_CHUNK(0);
    CS_LOAD(c0)
  }
  for (int j = 0; j < 36; ++j) {
    const int cgk = lb * 36 + BS_CHUNK(j);
    const int jn = (j + 1 < 36) ? j + 1 : j;
    const int cgn = lb * 36 + BS_CHUNK(jn);
    u16* Ss = Ssb + (j & 1) * (32 * 136);
#pragma unroll
    for (int mm = 0; mm < 2; ++mm)
#pragma unroll
      for (int nt = 0; nt < 2; ++nt) {
        uint2 pk; pk.x = pk2(S[mm][nt][0], S[mm][nt][1]); pk.y = pk2(S[mm][nt][2], S[mm][nt][3]);
        *(uint2*)(Ss + (16 * nt + fr) * 136 + 32 * w + 16 * mm + 4 * fq) = pk;
      }
    LBAR();
    char* oc_ = ocB + (size_t)cgk * 65536;
#pragma unroll
    for (int nt = 0; nt < 2; ++nt) {
      f32x4 O = {0.f, 0.f, 0.f, 0.f};
#pragma unroll
      for (int s = 0; s < 4; ++s) O = mfma(Aqd[s], ld8(Ss + (16 * nt + fr) * 136 + 32 * s + 8 * fq), O);
#pragma unroll
      for (int r = 0; r < 4; ++r) *(u16*)(oc_ + (offR[r] + 32 * nt)) = f2bf(bf2f(oi[nt][r]) + O[r]);
#pragma unroll
      for (int mm = 0; mm < 2; ++mm) {
        f32x4 t = S[mm][nt];
        t[0] *= dec4[mm].x; t[1] *= dec4[mm].y; t[2] *= dec4[mm].z; t[3] *= dec4[mm].w;
        t = mfma(Akd[mm][0], Vf[nt][0], t);
        t = mfma(Akd[mm][1], Vf[nt][1], t);
        S[mm][nt] = t;
      }
    }
    CBAR();
    CS_LOAD(cgn)
  }
  LBAR();
}

DEV void bc_merge_row(const P& p, int l, int lr, int lane);
DEV void bc_merge(const P& p, int l, int it) {
  const int tid_ = opq(threadIdx.x); const int lane = tid_ & 63, w = tid_ >> 6;
#pragma unroll
  for (int rr = 0; rr < 2; ++rr) bc_merge_row(p, l, it * 8 + w * 2 + rr, lane);
}
DEV void bc_merge_row(const P& p, int l, int lr, int lane) {
  int mix = lane >> 5, cm = (lane * 16) & 511;
  const u16* O = (const u16*)(p.ws + (mix ? O_OC : O_OB));
  u16* z = (u16*)(p.ws + O_Z);
  float ov[16], ss = 0.f;
#pragma unroll
  for (int k2 = 0; k2 < 2; ++k2) {
    uint4 a = *(const uint4*)(O + (size_t)lr * 512 + cm + 8 * k2);
    uint4 b = *(const uint4*)(O + ((size_t)GR + lr) * 512 + cm + 8 * k2);
    unsigned aa[4] = {a.x, a.y, a.z, a.w}, bb[4] = {b.x, b.y, b.z, b.w};
#pragma unroll
    for (int q = 0; q < 4; ++q) {
      float v0 = bf2f((u16)(aa[q] & 0xffff)) + bf2f((u16)(bb[q] & 0xffff));
      float v1 = bf2f((u16)(aa[q] >> 16)) + bf2f((u16)(bb[q] >> 16));
      ov[k2 * 8 + q * 2] = v0; ov[k2 * 8 + q * 2 + 1] = v1;
      ss += v0 * v0 + v1 * v1;
    }
  }
  ss += __shfl_xor(ss, 1); ss += __shfl_xor(ss, 2); ss += __shfl_xor(ss, 4);
  float rinv = rsqrtf(ss * (1.f / 128.f) + EPS);
  const float* nw = (mix ? p.hg_norm : p.gdn_norm) + l * 128 + (cm & 127);
  u16* gp = z + (size_t)lr * NZ + (mix ? C_GC : C_GB) + cm;
#pragma unroll
  for (int k2 = 0; k2 < 2; ++k2) {
    uint4 gv = *(const uint4*)(gp + 8 * k2);
    unsigned gg[4] = {gv.x, gv.y, gv.z, gv.w}, oo[4];
#pragma unroll
    for (int q = 0; q < 4; ++q) {
      int e = k2 * 8 + q * 2;
      float y0 = ov[e] * rinv * nw[e] * silu(bf2f((u16)(gg[q] & 0xffff)));
      float y1 = ov[e + 1] * rinv * nw[e + 1] * silu(bf2f((u16)(gg[q] >> 16)));
      oo[q] = pk2(y0, y1);
    }
    *(uint4*)(gp + 8 * k2) = make_uint4(oo[0], oo[1], oo[2], oo[3]);
  }
}

#define XB_TMO      128
#define XB_XCNT(j)  (256  + 64 * (j))
#define XB_XSUB(j)  (1280 + 64 * (j))
#define XB_XGEN(j)  (2304 + 64 * (j))
#define XB_TOP      3328
#define XB_TOPGEN   3392
#define XCD_BAR_WORDS 3456
#define XB_SPIN_CAP (1u << 18)
#define LAS __attribute__((address_space(3)))

__device__ __forceinline__ unsigned xb_ld(unsigned* p)              { return __hip_atomic_load(p, __ATOMIC_RELAXED, __HIP_MEMORY_SCOPE_AGENT); }
__device__ __forceinline__ unsigned xb_add(unsigned* p, unsigned v) { return __hip_atomic_fetch_add(p, v, __ATOMIC_RELAXED, __HIP_MEMORY_SCOPE_AGENT); }
__device__ __forceinline__ unsigned xb_xcc_id() { return (unsigned)__builtin_amdgcn_s_getreg((3 << 11) | 20) & 0xFu; }
#define XB_SPIN(cond, bar) do { unsigned _sp = 0; while (cond) { __builtin_amdgcn_s_sleep(1); \
    if ((++_sp & 255u) == 0u) { if (xb_ld(&(bar)[XB_TMO])) break; if (_sp > XB_SPIN_CAP) { atomicAdd(&(bar)[XB_TMO], 1u); break; } } } } while (0)

struct XcdBarrier {
    unsigned* bar; unsigned x;
    volatile LAS unsigned* st;
};

__device__ __forceinline__ XcdBarrier xcd_barrier_post(unsigned* bar, volatile LAS unsigned* st) {
    XcdBarrier b; b.bar = bar; b.x = xb_xcc_id(); b.st = st;
    if (threadIdx.x == 0) (void)xb_add(&bar[XB_XCNT(b.x)], 1u);
    return b;
}
__device__ __forceinline__ void xcd_barrier_complete(unsigned* bar, unsigned x, unsigned& nloc, unsigned& nx) {
    const unsigned G = gridDim.x * gridDim.y * gridDim.z;
    unsigned sum, cnt, mine, sp = 0u;
    for (;;) {
        sum = 0u; cnt = 0u; mine = 0u;
#pragma unroll
        for (unsigned j = 0; j < 16; ++j) { const unsigned c = xb_ld(&bar[XB_XCNT(j)]); sum += c; cnt += (c > 0u) ? 1u : 0u; mine = (j == x) ? c : mine; }
        if (sum == G) break;
        __builtin_amdgcn_s_sleep(1);
        if ((++sp & 255u) == 0u) { if (xb_ld(&bar[XB_TMO])) break; if (sp > XB_SPIN_CAP) { atomicAdd(&bar[XB_TMO], 1u); break; } }
    }
    nloc = mine > 0u ? mine : 1u; nx = cnt > 0u ? cnt : 1u;
}

__device__ __forceinline__ void xcd_barrier(const XcdBarrier& b) {
    asm volatile("s_waitcnt vmcnt(0)" ::: "memory");
    __syncthreads();
    if (threadIdx.x == 0) {
        unsigned* bar = b.bar;
        __builtin_amdgcn_s_waitcnt(0);
        unsigned nloc = b.st[0], nx = b.st[1];
        if (nloc == 0u) { xcd_barrier_complete(bar, b.x, nloc, nx); b.st[0] = nloc; b.st[1] = nx; }
        const unsigned old = xb_add(&bar[XB_XSUB(b.x)], 1u);
        const unsigned gen = old / nloc;
        if (old + 1u == (gen + 1u) * nloc) {
            __builtin_amdgcn_fence(__ATOMIC_RELEASE, "agent");
            asm volatile("s_waitcnt vmcnt(0)" ::: "memory");
            const unsigned og = xb_add(&bar[XB_TOP], 1u);
            const unsigned tg = og / nx;
            if (og + 1u == (tg + 1u) * nx) xb_add(&bar[XB_TOPGEN], 1u);
            else XB_SPIN(xb_ld(&bar[XB_TOPGEN]) == tg, bar);
            __builtin_amdgcn_fence(__ATOMIC_ACQUIRE, "agent");
            xb_add(&bar[XB_XGEN(b.x)], 1u);
            asm volatile("s_waitcnt vmcnt(0)" ::: "memory");
        } else {
            XB_SPIN(xb_ld(&bar[XB_XGEN(b.x)]) == gen, bar);
            __builtin_amdgcn_fence(__ATOMIC_ACQUIRE, "agent");
            asm volatile("s_waitcnt vmcnt(0)" ::: "memory");
        }
    }
    __syncthreads();
}


#ifdef NO_G0
#define XG0(x)
#else
#define XG0(x) x
#endif
#ifdef NO_G1
#define XG1(x)
#else
#define XG1(x) x
#endif
#ifdef NO_BC
#define XBC(x)
#else
#define XBC(x) x
#endif
#ifdef NO_AC
#define XAC(x)
#else
#define XAC(x) x
#endif
#ifdef NO_P0
#define XP0(x)
#else
#define XP0(x) x
#endif
#ifdef NO_R
#define XR(x)
#else
#define XR(x) x
#endif
#ifdef NO_BL
#define XBL(x)
#else
#define XBL(x) x
#endif
#ifdef NO_CL
#define XCL(x)
#else
#define XCL(x) x
#endif
#ifdef NO_A0
#define XA0(x)
#else
#define XA0(x) x
#endif
#ifdef NO_A1
#define XA1(x)
#else
#define XA1(x) x
#endif
#ifdef NO_BS
#define XBS(x)
#else
#define XBS(x) x
#endif
#ifdef NO_CS
#define XCS(x)
#else
#define XCS(x) x
#endif
__global__ void __launch_bounds__(256, 2) fwd_mega(P p) {
  extern __shared__ __attribute__((aligned(16))) char smem[];
  cg::grid_group grid = cg::this_grid();
  const int G = gridDim.x;
  __shared__ uint4 xb_words;
  if (threadIdx.x == 0) xb_words = make_uint4(0u, 0u, 0u, 0u);
  __syncthreads();
  XcdBarrier xb = xcd_barrier_post((unsigned*)(p.ws + O_BAR), (volatile LAS unsigned*)&xb_words);
  XP0(phase0(p, smem));
  if (p.ws == nullptr) grid.sync();
  xcd_barrier(xb);
  u16* z = (u16*)(p.ws + O_Z);
  u16* zT = (u16*)(p.ws + O_ZT);
  float* ab = (float*)(p.ws + O_AB);
  float* o = (float*)(p.ws + O_BSH);
  const u16* u = (const u16*)(p.ws + O_BIT);
  for (int g = 0; g < NG; ++g) {
    XR(phaseR(p, g, 0));
    xcd_barrier(xb);
    for (int l = 0; l < DEPTH; ++l) {
      for (int rep = 0; rep < REP_G; ++rep) {
        const u16* Bt = (const u16*)(p.ws + O_WTIN) + (size_t)l * NZ * 1024;
        if ((G & 7) == 0) {
          const int x = blockIdx.x & 7, bl = blockIdx.x >> 3, nbl = G >> 3;
          for (int q = bl; q < 9 * 45; q += nbl) { XG0(gemm_tile<0>(u, 1024, Bt, 1024, 9 * x + q % 9, q / 9, z, zT, ab, o, smem)); }
        } else {
          for (int t = blockIdx.x; t < 72 * 45; t += G) { XG0(gemm_tile<0>(u, 1024, Bt, 1024, t % 72, t / 72, z, zT, ab, o, smem)); }
        }
      }
      xcd_barrier(xb);
      for (int rep2 = 0; rep2 < REP_M; ++rep2) {
      for (int rep3 = 0; rep3 < REP_A; ++rep3) {
        if (rep3) xcd_barrier(xb);
        const int nb = NCH * 4, nc = NCH * 4, na = NCH * 8;
        if (G == 512) {
          const int bx = blockIdx.x;
          XCL(c_local2(p, l, bx, smem));
          if (bx < 64) { XCL(c_local2(p, l, 512 + bx, smem)); }
          XBL(b_local(p, l, bx, smem));
          if (bx >= 64 && bx < 128) { XBL(b_local(p, l, 448 + bx, smem)); }
          if (bx < 128) { XA0(a_item(p, l, bx, 0, smem)); }
          else {
            for (int t = 128 + (bx - 128); t < na; t += 384) { XA0(a_item(p, l, t, 0, smem)); }
          }
        } else {
          for (int t = blockIdx.x; t < nb + nc + na; t += G) {
            if (t < nc) { XCL(c_local2(p, l, t, smem)); }
            else if (t < nb + nc) { XBL(b_local(p, l, t - nc, smem)); }
            else { XA0(a_item(p, l, t - nb - nc, 0, smem)); }
          }
        }
      }
      xcd_barrier(xb);
      {
        for (int t = blockIdx.x; t < 256 + 16; t += G) {
          if (t < 128) { XBS(b_seq2(p, t, smem)); }
          else if (t < 256) { XCS(c_seq2(p, t - 128, smem)); }
          else { XAC(a_carry(p, t - 256)); }
        }
      }
      xcd_barrier(xb);
      }
      {
        const int na = NCH * 8, nm = GR / 8;
        for (int t = blockIdx.x; t < na + nm; t += G) {
          if (t < na) { XA1(a_fin2(p, l, t, smem)); }
          else { XBC(bc_merge(p, l, t - na)); }
        }
      }
      xcd_barrier(xb);
      for (int rep = 0; rep < REP_G; ++rep) {
        const u16* Bt = (const u16*)(p.ws + O_WTOUT) + (size_t)l * 1024 * 1536;
        for (int t = blockIdx.x; t < 72 * 8; t += G) { XG1(gemm_tile<1>(z + C_GA, NZ, Bt, 1536, t % 72, t / 72, z, zT, ab, o, smem)); }
      }
      xcd_barrier(xb);
      XR(phaseR(p, g, l + 1));
      xcd_barrier(xb);
    }
  }
}

extern "C" void kernel_launch(void* const* d_in, const int* in_sizes, int n_in, void* d_out, int out_size, void* d_ws,
                              size_t ws_size, hipStream_t stream) {
  static int grid_blocks = 0;
  if (!grid_blocks) {
    int dev = 0, cus = 0, per_cu = 0;
    hipGetDevice(&dev);
    hipDeviceGetAttribute(&cus, hipDeviceAttributeMultiprocessorCount, dev);
    hipFuncSetAttribute((const void*)fwd_mega, hipFuncAttributeMaxDynamicSharedMemorySize, LDS_BYTES);
    hipOccupancyMaxActiveBlocksPerMultiprocessor(&per_cu, fwd_mega, 256, LDS_BYTES);
    if (per_cu > 2) per_cu = 2;
    if (per_cu < 1) per_cu = 1;
    grid_blocks = cus * per_cu;
  }
  if (ws_size < WS_TOTAL) {
    fprintf(stderr, "workspace too small: %zu < %zu\n", ws_size, (size_t)WS_TOTAL);
    return;
  }
  P p{};
  const float** f = (const float**)&p;
  for (int i = 0; i < 23; ++i) f[i] = (const float*)d_in[i];
  p.out = (float*)d_out;
  p.ws = (char*)d_ws;
  hipMemsetAsync((char*)d_ws + O_BAR, 0, XCD_BAR_WORDS * 4, stream);
  void* args[] = {&p};
  hipError_t e = hipLaunchCooperativeKernel((void*)fwd_mega, dim3(grid_blocks), dim3(256), args, LDS_BYTES, stream);
  if (e != hipSuccess) fprintf(stderr, "cooperative launch failed: %s (grid %d)\n", hipGetErrorString(e), grid_blocks);
}
```

```cpp
#include <hip/hip_runtime.h>
#include <hip/hip_cooperative_groups.h>
#include <cstdio>
namespace cg = cooperative_groups;

typedef __attribute__((ext_vector_type(8))) short bf16x8;
typedef __attribute__((ext_vector_type(4))) float f32x4;
typedef unsigned short u16;
#define DEV __device__ __forceinline__

constexpr int DM = 1024, TL = 2048, TCX = 256, TS = 2304, GB = 4, GR = GB * TS, NG = 2;
constexpr int NZ = 5760, DEPTH = 4;
constexpr int C_XA = 0, C_Q = 512, C_K = 1024, C_V = 1536, C_QC = 2048, C_F0 = 2560, C_IC = 3584,
              C_GA = 4096, C_GB = 4608, C_GC = 5120, C_AB = 5632;
constexpr int NCH = GR / 64;
constexpr float EPS = 1e-6f;
constexpr int WPB = 2;

constexpr size_t al256(size_t x) { return (x + 255) & ~(size_t)255; }
constexpr size_t O_WTIN = 0;
constexpr size_t O_WTOUT = O_WTIN + al256((size_t)DEPTH * NZ * 1024 * 2);
constexpr size_t O_WGT = O_WTOUT + al256((size_t)DEPTH * 1024 * 1536 * 2);
constexpr size_t O_MOD = O_WGT + al256((size_t)DEPTH * 2 * 2 * 8 * 4096 * 2);
constexpr size_t O_LBS = O_MOD + al256((size_t)DEPTH * 9 * 3072 * 4);
constexpr size_t O_HC = O_LBS + al256((size_t)DEPTH * 1024 * 4);
constexpr size_t O_Z = O_HC + al256((size_t)GB * TCX * 1024 * 4);
constexpr size_t O_ZT = O_Z + al256((size_t)GR * NZ * 2);
constexpr size_t O_AB = O_ZT + al256((size_t)512 * GR * 2);
constexpr size_t O_BSH = O_AB + al256((size_t)GR * 16 * 4);
constexpr size_t BSH_ONE = (size_t)GR * 512 * 2;
constexpr size_t O_BIT = O_BSH + al256(4 * BSH_ONE);
constexpr size_t BIT_SZ = 17408;
constexpr size_t O_CREC = O_BIT + al256((size_t)NCH * 4 * 2 * BIT_SZ);
constexpr size_t CREC_SZ = 33280;
constexpr size_t O_OB = O_CREC + al256((size_t)NCH * 4 * 2 * CREC_SZ);
constexpr size_t O_OC = O_OB + al256((size_t)2 * GR * 512 * 2);
constexpr size_t O_AP = O_OC + al256((size_t)2 * GR * 512 * 2);
constexpr size_t O_AH = O_AP + al256((size_t)NCH * 2 * 512 * 4);
constexpr size_t O_ACAR = O_AH + al256((size_t)NCH * 2 * 512 * 4);
constexpr size_t O_ALA = O_ACAR + al256((size_t)NCH * 2 * 512 * 4);
constexpr size_t O_AU = O_ALA + al256((size_t)2 * GR * 512 * 2);
constexpr size_t O_BAR = O_AU + al256((size_t)2 * GR * 512 * 2);
constexpr size_t WS_TOTAL = O_BAR + al256(3456 * 4);

constexpr int LDS_BYTES = 73728;
#ifndef REP_A
#define REP_A 1
#endif
#ifndef REP_G
#define REP_G 1
#endif
#ifndef REP_M
#define REP_M 1
#endif

struct P {
  const float *x, *c, *ctx, *c_ctx, *w_ada, *b_ada, *norm_pre, *norm_post, *w_in, *conv_a_w, *conv_a_b, *rg_w_r,
      *rg_b_r, *rg_w_i, *rg_b_i, *rg_lam, *conv_b_w, *gdn_a_log, *gdn_dt_bias, *gdn_norm, *hg_lb, *hg_norm, *w_out;
  float* out;
  char* ws;
};

DEV int opq(int x) { asm volatile("" : "+v"(x)); return x; }
DEV int opqs(int x) { asm volatile("" : "+s"(x)); return x; }
typedef __attribute__((ext_vector_type(2))) __bf16 bf16x2_t;
typedef __attribute__((ext_vector_type(2))) float f32x2_t;
DEV u16 f2bf(float f) { __bf16 r = (__bf16)f; return __builtin_bit_cast(u16, r); }
DEV float bf2f(u16 h) { return __uint_as_float(((unsigned)h) << 16); }
DEV unsigned pk2(float a, float b) { f32x2_t v = {a, b}; bf16x2_t r = __builtin_convertvector(v, bf16x2_t); return __builtin_bit_cast(unsigned, r); }
DEV float sigm(float x) { return __builtin_amdgcn_rcpf(1.f + __expf(-x)); }
DEV float silu(float x) { return x * __builtin_amdgcn_rcpf(1.f + __expf(-x)); }
DEV float softplus(float x) { return x > 20.f ? x : log1pf(__expf(x)); }
DEV f32x4 mfma(bf16x8 a, bf16x8 b, f32x4 c) { return __builtin_amdgcn_mfma_f32_16x16x32_bf16(a, b, c, 0, 0, 0); }
DEV bf16x8 ld8(const u16* p) { return *reinterpret_cast<const bf16x8*>(p); }
DEV int lat_map(int l, int t) { return (l & 1) ? ((t & 63) * 32 + (t >> 6)) : t; }
DEV int orig_col(int n) {
  if (n < 512) return n;
  if (n < 2048) return n + 512;
  if (n < 4096) return n + 1040;
  if (n < 4608) return n - 4096 + 512;
  if (n < 5120) return n - 4608 + 2576;
  if (n < 5632) return n + 16;
  if (n < 5648) return n - 5632 + 2560;
  return -1;
}
DEV float zval(const u16* z, int rb, int cp, int n, int col) {
  if (cp < 0 && (n == 0 || n == 4)) return 0.f;
  if (cp > 63 && (n == 3 || n == 35)) return 0.f;
  return bf2f(z[(size_t)(rb + cp) * NZ + col]);
}

DEV void ph0_ada(const P& p, int item, char* smem) {
  float* sc = (float*)smem;
  float* red = (float*)(smem + 36864);
  const int tid = threadIdx.x, lane = tid & 63, wv = tid >> 6;
  for (int i = tid; i < 9 * 1024; i += 256) {
    int v = i >> 10, d = i & 1023;
    float cv = (v < 8) ? p.c[v * 1024 + d] : p.c_ctx[d];
    sc[i] = silu(cv);
  }
  __syncthreads();
  const int col = item * 64 + lane;
  const int l = col / 3072, e = col % 3072;
  const float* w = p.w_ada + (size_t)l * 1024 * 3072 + e + (size_t)(256 * wv) * 3072;
  const float* scw = sc + 256 * wv;
  float acc[9];
#pragma unroll
  for (int i = 0; i < 9; ++i) acc[i] = 0.f;
  for (int d = 0; d < 256; d += 16) {
    float wr[16];
#pragma unroll
    for (int k = 0; k < 16; ++k) wr[k] = w[(size_t)(d + k) * 3072];
#pragma unroll
    for (int k = 0; k < 16; ++k)
#pragma unroll
      for (int i = 0; i < 9; ++i) acc[i] += scw[i * 1024 + d + k] * wr[k];
  }
#pragma unroll
  for (int i = 0; i < 9; ++i) red[(wv * 9 + i) * 64 + lane] = acc[i];
  __syncthreads();
  float* mod = (float*)(p.ws + O_MOD);
  for (int idx = tid; idx < 9 * 64; idx += 256) {
    int i = idx >> 6, ln = idx & 63;
    float sum = red[(0 * 9 + i) * 64 + ln] + red[(1 * 9 + i) * 64 + ln] + red[(2 * 9 + i) * 64 + ln] + red[(3 * 9 + i) * 64 + ln];
    int cc = item * 64 + ln, l2 = cc / 3072, e2 = cc % 3072;
    mod[((size_t)l2 * 9 + i) * 3072 + e2] = sum + p.b_ada[l2 * 3072 + e2];
  }
  __syncthreads();
}
DEV void tconv_tile(const float* src, int lds_, u16* dst, int ldd, int k0, int n0, bool mapcol, char* smem) {
  float* t = (float*)smem;
  const int tid = threadIdx.x, nn = tid & 63, kq = tid >> 6;
  const int n = n0 + nn;
  const int sn0 = mapcol ? orig_col(n) : n;
  const float msk = (sn0 >= 0) ? 1.f : 0.f;
  const int sn = sn0 >= 0 ? sn0 : 0;
  float v[16];
#pragma unroll
  for (int k = 0; k < 16; ++k) v[k] = src[(size_t)(k0 + kq + 4 * k) * lds_ + sn];
#pragma unroll
  for (int k = 0; k < 16; ++k) t[(kq + 4 * k) * 65 + nn] = v[k] * msk;
  __syncthreads();
  {
    const int kk = tid & 63, nq = tid >> 6;
#pragma unroll
    for (int k = 0; k < 16; ++k) {
      int n2 = nq + 4 * k;
      dst[(size_t)(n0 + n2) * ldd + k0 + kk] = f2bf(t[kk * 65 + n2]);
    }
  }
  __syncthreads();
}
DEV void phase0(const P& p, char* smem) {
  const int n_ada = 192, n_in = DEPTH * 16 * 90, n_out = DEPTH * 24 * 16, n_g = 128, n_lb = 4;
  const int total = n_ada + n_in + n_out + n_g + n_lb;
  for (int it = blockIdx.x; it < total; it += gridDim.x) {
    int i = it;
    if (i < n_ada) { ph0_ada(p, i, smem); continue; }
    i -= n_ada;
    if (i < n_in) {
      int l = i / 1440, r = i % 1440, kt = r / 90, nt = r % 90;
      tconv_tile(p.w_in + (size_t)l * 1024 * 5648, 5648, (u16*)(p.ws + O_WTIN) + (size_t)l * NZ * 1024, 1024, kt * 64,
                 nt * 64, true, smem);
      continue;
    }
    i -= n_in;
    if (i < n_out) {
      int l = i / 384, r = i % 384, kt = r / 16, nt = r % 16;
      tconv_tile(p.w_out + (size_t)l * 1536 * 1024, 1024, (u16*)(p.ws + O_WTOUT) + (size_t)l * 1024 * 1536, 1536,
                 kt * 64, nt * 64, false, smem);
      continue;
    }
    i -= n_out;
    if (i < n_g) {
      int h = i & 7, gate = (i >> 3) & 1, dir = (i >> 4) & 1, l = i >> 5;
      const float* src = (gate ? p.rg_w_i : p.rg_w_r) + ((size_t)(l * 2 + dir) * 8 + h) * 4096;
      tconv_tile(src, 64, (u16*)(p.ws + O_WGT) + (size_t)i * 4096, 64, 0, 0, false, smem);
      continue;
    }
    i -= n_g;
    {
      int j = i * 256 + threadIdx.x;
      float v[4], mx = -1e30f;
      for (int l = 0; l < 4; ++l) { v[l] = p.hg_lb[l * 1024 + j]; mx = fmaxf(mx, v[l]); }
      float s = 0.f;
      for (int l = 0; l < 4; ++l) { v[l] = __expf(v[l] - mx); s += v[l]; }
      float* lbs = (float*)(p.ws + O_LBS);
      float cum = 0.f;
      for (int l = 0; l < 4; ++l) {
        if (l > 0) cum += v[l] / s;
        lbs[l * 1024 + j] = cum;
      }
    }
  }
}

DEV void phaseR(const P& p, int g, int l) {
  const int tid_ = opq(threadIdx.x); const int lane = tid_ & 63, w = tid_ >> 6;
  const float* mod = (const float*)(p.ws + O_MOD);
  float* hc = (float*)(p.ws + O_HC);
  const float* o = (const float*)(p.ws + O_BSH);
  u16* u = (u16*)(p.ws + O_BIT);
  for (int it = blockIdx.x; it < GR / 4; it += gridDim.x) {
    int lr = it * 4 + w;
    int lb = lr / TS, s = lr % TS;
    bool isctx = s < TCX;
    if (l == DEPTH && isctx) continue;
    int b = g * GB + lb, t = s - TCX;
    int mi = isctx ? 8 : b;
    float* hp = isctx ? hc + ((size_t)lb * TCX + s) * 1024 : p.out + ((size_t)b * TL + t) * 1024;
    float hv[16];
    if (l == 0) {
      const float* src = isctx ? p.ctx + ((size_t)b * TCX + s) * 1024 : p.x + ((size_t)b * TL + t) * 1024;
#pragma unroll
      for (int k = 0; k < 4; ++k) {
        float4 v = *(const float4*)(src + k * 256 + lane * 4);
        hv[k * 4] = v.x; hv[k * 4 + 1] = v.y; hv[k * 4 + 2] = v.z; hv[k * 4 + 3] = v.w;
      }
    } else {
      int orow = lb * TS + (isctx ? s : TCX + lat_map(l - 1, t));
      const float* op = o + (size_t)orow * 1024;
      float ov[16], ss = 0.f;
#pragma unroll
      for (int k = 0; k < 4; ++k) {
        float4 v = *(const float4*)(op + k * 256 + lane * 4);
        ov[k * 4] = v.x; ov[k * 4 + 1] = v.y; ov[k * 4 + 2] = v.z; ov[k * 4 + 3] = v.w;
        ss += v.x * v.x + v.y * v.y + v.z * v.z + v.w * v.w;
      }
#pragma unroll
      for (int off = 32; off; off >>= 1) ss += __shfl_xor(ss, off);
      float rinv = rsqrtf(ss * (1.f / 1024.f) + EPS);
      const float* gate = mod + ((size_t)(l - 1) * 9 + mi) * 3072 + 2048;
      const float* wp = p.norm_post + (l - 1) * 1024;
#pragma unroll
      for (int k = 0; k < 4; ++k) {
        float4 hh = *(const float4*)(hp + k * 256 + lane * 4);
        float4 gg = *(const float4*)(gate + k * 256 + lane * 4);
        float4 ww = *(const float4*)(wp + k * 256 + lane * 4);
        hv[k * 4] = hh.x + gg.x * (ov[k * 4] * rinv * ww.x);
        hv[k * 4 + 1] = hh.y + gg.y * (ov[k * 4 + 1] * rinv * ww.y);
        hv[k * 4 + 2] = hh.z + gg.z * (ov[k * 4 + 2] * rinv * ww.z);
        hv[k * 4 + 3] = hh.w + gg.w * (ov[k * 4 + 3] * rinv * ww.w);
      }
    }
#pragma unroll
    for (int k = 0; k < 4; ++k)
      *(float4*)(hp + k * 256 + lane * 4) = make_float4(hv[k * 4], hv[k * 4 + 1], hv[k * 4 + 2], hv[k * 4 + 3]);
    if (l < DEPTH) {
      float ss = 0.f;
#pragma unroll
      for (int k = 0; k < 16; ++k) ss += hv[k] * hv[k];
#pragma unroll
      for (int off = 32; off; off >>= 1) ss += __shfl_xor(ss, off);
      float rinv = rsqrtf(ss * (1.f / 1024.f) + EPS);
      const float* sh = mod + ((size_t)l * 9 + mi) * 3072;
      const float* wp = p.norm_pre + l * 1024;
      int urow = lb * TS + (isctx ? s : TCX + lat_map(l, t));
      u16* up = u + (size_t)urow * 1024;
#pragma unroll
      for (int k = 0; k < 4; ++k) {
        float4 ww = *(const float4*)(wp + k * 256 + lane * 4);
        float4 s0 = *(const float4*)(sh + k * 256 + lane * 4);
        float4 s1 = *(const float4*)(sh + 1024 + k * 256 + lane * 4);
        float a0 = hv[k * 4] * rinv * ww.x * (1.f + s1.x) + s0.x;
        float a1 = hv[k * 4 + 1] * rinv * ww.y * (1.f + s1.y) + s0.y;
        float a2 = hv[k * 4 + 2] * rinv * ww.z * (1.f + s1.z) + s0.z;
        float a3 = hv[k * 4 + 3] * rinv * ww.w * (1.f + s1.w) + s0.w;
        uint2 pk; pk.x = pk2(a0, a1); pk.y = pk2(a2, a3);
        *(uint2*)(up + k * 256 + lane * 4) = pk;
      }
    }
  }
}

template <int MODE>
DEV void gemm_tile(const u16* __restrict__ A, int lda, const u16* __restrict__ Bt, int K, int rt, int ct, u16* z,
                   u16* zT, float* ab, float* o, char* smem) {
  u16* As = (u16*)smem;
  u16* Bs = As + 128 * 72;
  const int tid = opq(threadIdx.x), lane = tid & 63, w = tid >> 6, wr = w >> 1, wc = w & 1, fr = lane & 15, fq = lane >> 4;
  const int lrow = tid >> 3, lseg = tid & 7;
  const u16* Ag = A + (size_t)(rt * 128 + lrow) * lda + lseg * 8;
  const u16* Bg = Bt + (size_t)(ct * 128 + lrow) * K + lseg * 8;
  uint4 pa0, pa1, pa2, pa3, pb0, pb1, pb2, pb3;
  uint4 qa0, qa1, qa2, qa3, qb0, qb1, qb2, qb3;
  f32x4 acc[4][4];
#pragma unroll
  for (int i = 0; i < 4; ++i)
#pragma unroll
    for (int j = 0; j < 4; ++j) acc[i][j] = (f32x4){0.f, 0.f, 0.f, 0.f};
  const int nk = K / 64;
#define GLD(S, kk)                                                            \
  {                                                                           \
    const int kc_ = ((kk) < nk ? (kk) : nk - 1) * 64;                         \
    S##a0 = *(const uint4*)(Ag + kc_);                                        \
    S##a1 = *(const uint4*)(Ag + kc_ + (size_t)32 * lda);                     \
    S##a2 = *(const uint4*)(Ag + kc_ + (size_t)64 * lda);                     \
    S##a3 = *(const uint4*)(Ag + kc_ + (size_t)96 * lda);                     \
    S##b0 = *(const uint4*)(Bg + kc_);                                        \
    S##b1 = *(const uint4*)(Bg + kc_ + (size_t)32 * K);                       \
    S##b2 = *(const uint4*)(Bg + kc_ + (size_t)64 * K);                       \
    S##b3 = *(const uint4*)(Bg + kc_ + (size_t)96 * K);                       \
  }
#define GST(S, bufo)                                                          \
  *(uint4*)(As + (bufo) + (lrow)*72 + lseg * 8) = S##a0;                      \
  *(uint4*)(As + (bufo) + (lrow + 32) * 72 + lseg * 8) = S##a1;               \
  *(uint4*)(As + (bufo) + (lrow + 64) * 72 + lseg * 8) = S##a2;               \
  *(uint4*)(As + (bufo) + (lrow + 96) * 72 + lseg * 8) = S##a3;               \
  *(uint4*)(Bs + (bufo) + (lrow)*72 + lseg * 8) = S##b0;                      \
  *(uint4*)(Bs + (bufo) + (lrow + 32) * 72 + lseg * 8) = S##b1;               \
  *(uint4*)(Bs + (bufo) + (lrow + 64) * 72 + lseg * 8) = S##b2;               \
  *(uint4*)(Bs + (bufo) + (lrow + 96) * 72 + lseg * 8) = S##b3;
#define GCOMP(cb)                                                                                           \
  _Pragma("unroll") for (int ks = 0; ks < 2; ++ks) {                                                        \
    bf16x8 af[4], bfr[4];                                                                                   \
    _Pragma("unroll") for (int mi = 0; mi < 4; ++mi)                                                        \
        af[mi] = ld8(As + (cb) + (wr * 64 + mi * 16 + fr) * 72 + ks * 32 + fq * 8);                         \
    _Pragma("unroll") for (int ni = 0; ni < 4; ++ni)                                                        \
        bfr[ni] = ld8(Bs + (cb) + (wc * 64 + ni * 16 + fr) * 72 + ks * 32 + fq * 8);                        \
    _Pragma("unroll") for (int mi = 0; mi < 4; ++mi)                                                        \
        _Pragma("unroll") for (int ni = 0; ni < 4; ++ni) acc[mi][ni] = mfma(af[mi], bfr[ni], acc[mi][ni]);  \
  }
  constexpr int BUF1 = 2 * 128 * 72;
  GLD(p, 0)
  GLD(q, 1)
  GST(p, 0)
  __syncthreads();
  GLD(p, 2)
  for (int kt = 0; kt < nk; kt += 2) {
    GCOMP(0)
    GST(q, BUF1)
    GLD(q, kt + 3)
    __syncthreads();
    GCOMP(BUF1)
    GST(p, 0)
    GLD(p, kt + 4)
    __syncthreads();
  }
#pragma unroll
  for (int mi = 0; mi < 4; ++mi)
#pragma unroll
    for (int ni = 0; ni < 4; ++ni) {
      int row0 = rt * 128 + wr * 64 + mi * 16 + fq * 4;
      int col = ct * 128 + wc * 64 + ni * 16 + fr;
      f32x4 v = acc[mi][ni];
      if (MODE == 1) {
#pragma unroll
        for (int r = 0; r < 4; ++r) o[(size_t)(row0 + r) * 1024 + col] = v[r];
      } else {
        if (ct >= 28 && ct < 32) {
          uint2 pk; pk.x = pk2(v[0], v[1]); pk.y = pk2(v[2], v[3]);
          *(uint2*)(zT + (size_t)(col - C_IC) * GR + row0) = pk;
        } else if (ct == 44) {
          if (col - C_AB < 16) {
#pragma unroll
            for (int r = 0; r < 4; ++r) ab[(size_t)(row0 + r) * 16 + (col - C_AB)] = v[r];
          }
        } else {
#pragma unroll
          for (int r = 0; r < 4; ++r) z[(size_t)(row0 + r) * NZ + col] = f2bf(v[r]);
        }
      }
    }
}

DEV void a_item(const P& p, int l, int item, int mode, char* smem) {
  float* xc = (float*)smem;
  u16* xcb = (u16*)(smem + 16384);
  float* av = (float*)(smem + 16384 + 9216);
  float* uv = av + 4096;
  float* segP = uv + 4096;
  float* segH = segP + 256;
  const int tid = opq(threadIdx.x), lane = tid & 63, w = tid >> 6, fr = lane & 15, fq = lane >> 4;
  const int cgk = item >> 3, hA = item & 7, n = cgk % 36, rb = cgk * 64;
  u16* z = (u16*)(p.ws + O_Z);
  {
    u16* xin = (u16*)av;
    uint4 st[3];
#pragma unroll
    for (int k = 0; k < 3; ++k) {
      int idx = tid + 256 * k, row = idx >> 3, sg = idx & 7, cp = row - 2;
      bool ok = (idx < 536) && !((cp < 0 && (n == 0 || n == 4)) || (cp > 63 && (n == 3 || n == 35)));
      st[k] = make_uint4(0u, 0u, 0u, 0u);
      if (ok) st[k] = *(const uint4*)(z + (size_t)(rb + cp) * NZ + C_XA + hA * 64 + sg * 8);
    }
    const int j = tid & 63, ch = hA * 64 + j;
    float cw0 = p.conv_a_w[(l * 4 + 0) * 512 + ch], cw1 = p.conv_a_w[(l * 4 + 1) * 512 + ch];
    float cw2 = p.conv_a_w[(l * 4 + 2) * 512 + ch], cw3 = p.conv_a_w[(l * 4 + 3) * 512 + ch];
    float cb = p.conv_a_b[l * 512 + ch];
#pragma unroll
    for (int k = 0; k < 3; ++k) {
      int idx = tid + 256 * k, row = idx >> 3, sg = idx & 7;
      if (idx < 536) *(uint4*)(xin + row * 72 + sg * 8) = st[k];
    }
    __syncthreads();
#pragma unroll
    for (int k = 0; k < 16; ++k) {
      int c = (tid >> 6) + 4 * k;
      float val = cb + cw0 * bf2f(xin[c * 72 + j]) + cw1 * bf2f(xin[(c + 1) * 72 + j]) + cw2 * bf2f(xin[(c + 2) * 72 + j]) +
                  cw3 * bf2f(xin[(c + 3) * 72 + j]);
      xc[c * 64 + j] = val;
      xcb[c * 72 + j] = f2bf(val);
    }
  }
  __syncthreads();
  float yacc[16];
#pragma unroll
  for (int k = 0; k < 16; ++k) yacc[k] = 0.f;
  const int seg = tid >> 6, sj = tid & 63, sch = hA * 64 + sj;
  for (int dir = 0; dir < 2; ++dir) {
    {
      const u16* wg = (const u16*)(p.ws + O_WGT);
      const u16* wr_ = wg + (size_t)((((l * 2 + dir) * 2 + 0) * 8 + hA)) * 4096;
      const u16* wi_ = wg + (size_t)((((l * 2 + dir) * 2 + 1) * 8 + hA)) * 4096;
      bf16x8 a0 = ld8(xcb + (16 * w + fr) * 72 + fq * 8), a1 = ld8(xcb + (16 * w + fr) * 72 + 32 + fq * 8);
#pragma unroll
      for (int nt = 0; nt < 4; ++nt) {
        f32x4 ar = {0.f, 0.f, 0.f, 0.f}, ai = {0.f, 0.f, 0.f, 0.f};
        const u16* br = wr_ + (nt * 16 + fr) * 64 + fq * 8;
        const u16* bi = wi_ + (nt * 16 + fr) * 64 + fq * 8;
        ar = mfma(a0, ld8(br), ar); ar = mfma(a1, ld8(br + 32), ar);
        ai = mfma(a0, ld8(bi), ai); ai = mfma(a1, ld8(bi + 32), ai);
        int j = nt * 16 + fr, ch = hA * 64 + j;
        float brv = p.rg_b_r[(l * 2 + dir) * 512 + ch], biv = p.rg_b_i[(l * 2 + dir) * 512 + ch];
        float sp = softplus(-p.rg_lam[(l * 2 + dir) * 512 + ch]);
#pragma unroll
        for (int r = 0; r < 4; ++r) {
          int c = 16 * w + 4 * fq + r;
          float rg = sigm(ar[r] + brv), ig = sigm(ai[r] + biv);
          float la = -8.f * rg * sp;
          float a = __expf(la);
          float t2 = 2.f * la;
          float om = (t2 > -0.02f) ? -t2 * (1.f + 0.5f * t2 * (1.f + t2 * (1.f / 3.f) * (1.f + 0.25f * t2))) : 1.f - a * a;
          float uu = sqrtf(fmaxf(om, 0.f)) * (ig * xc[c * 64 + j]);
          av[c * 64 + j] = bf2f(f2bf(la));
          uv[c * 64 + j] = bf2f(f2bf(uu));
        }
      }
    }
    __syncthreads();
    {
      float ls = 0.f, H = 0.f;
      u16* ALA = (u16*)(p.ws + O_ALA);
      u16* AU = (u16*)(p.ws + O_AU);
#pragma unroll
      for (int k = 0; k < 16; ++k) {
        int c = dir ? (16 * seg + 15 - k) : (16 * seg + k);
        float la_ = av[c * 64 + sj], u_ = uv[c * 64 + sj];
        H = __expf(la_) * H + u_;
        ls += la_;
        size_t gi = ((size_t)dir * GR + rb + c) * 512 + sch;
        ALA[gi] = f2bf(la_);
        AU[gi] = f2bf(u_);
      }
      segP[seg * 64 + sj] = __expf(ls);
      segH[seg * 64 + sj] = H;
    }
    __syncthreads();
    if (mode == 0) {
      if (seg == 0) {
        float Pc = 1.f, Hc = 0.f;
        for (int q = 0; q < 4; ++q) {
          int sg = dir ? 3 - q : q;
          Hc = segP[sg * 64 + sj] * Hc + segH[sg * 64 + sj];
          Pc *= segP[sg * 64 + sj];
        }
        size_t idx = ((size_t)cgk * 2 + dir) * 512 + sch;
        ((float*)(p.ws + O_AP))[idx] = Pc;
        ((float*)(p.ws + O_AH))[idx] = Hc;
      }
    } else {
      float st = ((const float*)(p.ws + O_ACAR))[((size_t)cgk * 2 + dir) * 512 + sch];
      int nbefore = dir ? 3 - seg : seg;
      for (int q = 0; q < nbefore; ++q) {
        int sg = dir ? 3 - q : q;
        st = segP[sg * 64 + sj] * st + segH[sg * 64 + sj];
      }
      if (dir == 0) {
#pragma unroll
        for (int k = 0; k < 16; ++k) {
          int c = 16 * seg + k;
          st = av[c * 64 + sj] * st + uv[c * 64 + sj];
          yacc[k] += st;
        }
      } else {
#pragma unroll
        for (int k = 15; k >= 0; --k) {
          int c = 16 * seg + k;
          st = av[c * 64 + sj] * st + uv[c * 64 + sj];
          yacc[k] += st;
        }
      }
    }
    __syncthreads();
  }
  if (mode == 1) {
#pragma unroll
    for (int k = 0; k < 16; ++k) {
      size_t zi = (size_t)(rb + 16 * seg + k) * NZ + C_GA + sch;
      float gate = bf2f(z[zi]);
      z[zi] = f2bf(yacc[k] * silu(gate));
    }
  }
}

DEV void a_fin(const P& p, int l, int item, char* smem) {
  float* segP = (float*)smem;
  float* segH = segP + 512;
  const int tid = opq(threadIdx.x), seg = tid >> 6, sj = tid & 63;
  const int cgk = item >> 3, hA = item & 7, rb = cgk * 64, sch = hA * 64 + sj;
  u16* z = (u16*)(p.ws + O_Z);
  const u16* ALA = (const u16*)(p.ws + O_ALA);
  const u16* AU = (const u16*)(p.ws + O_AU);
  u16 lab[2][16], ub[2][16], gt[16];
#pragma unroll
  for (int dir = 0; dir < 2; ++dir)
#pragma unroll
    for (int k = 0; k < 16; ++k) {
      size_t gi = ((size_t)dir * GR + rb + 16 * seg + k) * 512 + sch;
      lab[dir][k] = ALA[gi];
      ub[dir][k] = AU[gi];
    }
#pragma unroll
  for (int k = 0; k < 16; ++k) gt[k] = z[(size_t)(rb + 16 * seg + k) * NZ + C_GA + sch];
  float car0 = ((const float*)(p.ws + O_ACAR))[((size_t)cgk * 2 + 0) * 512 + sch];
  float car1 = ((const float*)(p.ws + O_ACAR))[((size_t)cgk * 2 + 1) * 512 + sch];
  float af[2][16];
#pragma unroll
  for (int dir = 0; dir < 2; ++dir) {
    float ls = 0.f, H = 0.f;
#pragma unroll
    for (int kk = 0; kk < 16; ++kk) {
      const int k = dir ? 15 - kk : kk;
      float la_ = bf2f(lab[dir][k]);
      float a = __expf(la_);
      af[dir][k] = a;
      H = a * H + bf2f(ub[dir][k]);
      ls += la_;
    }
    segP[(dir * 4 + seg) * 64 + sj] = __expf(ls);
    segH[(dir * 4 + seg) * 64 + sj] = H;
  }
  __syncthreads();
  float yacc[16];
#pragma unroll
  for (int k = 0; k < 16; ++k) yacc[k] = 0.f;
#pragma unroll
  for (int dir = 0; dir < 2; ++dir) {
    float st = dir ? car1 : car0;
    const int nbefore = dir ? 3 - seg : seg;
    for (int q = 0; q < nbefore; ++q) {
      int sg = dir ? 3 - q : q;
      st = segP[(dir * 4 + sg) * 64 + sj] * st + segH[(dir * 4 + sg) * 64 + sj];
    }
#pragma unroll
    for (int kk = 0; kk < 16; ++kk) {
      const int k = dir ? 15 - kk : kk;
      st = af[dir][k] * st + bf2f(ub[dir][k]);
      yacc[k] += st;
    }
  }
#pragma unroll
  for (int k = 0; k < 16; ++k)
    z[(size_t)(rb + 16 * seg + k) * NZ + C_GA + sch] = f2bf(yacc[k] * silu(bf2f(gt[k])));
  __syncthreads();
}

DEV void a_fin2(const P& p, int l, int item, char* smem) {
  float* segP = (float*)smem;
  float* segH = segP + 1024;
  const int tid = opq(threadIdx.x), sg = tid >> 5, cp = tid & 31;
  const int cgk = item >> 3, hA = item & 7, rb = cgk * 64, sch = hA * 64 + 2 * cp;
  u16* z = (u16*)(p.ws + O_Z);
  const u16* ALA = (const u16*)(p.ws + O_ALA);
  const u16* AU = (const u16*)(p.ws + O_AU);
  unsigned lab[2][8], ub[2][8], gt[8];
#pragma unroll
  for (int dir = 0; dir < 2; ++dir)
#pragma unroll
    for (int k = 0; k < 8; ++k) {
      size_t gi = ((size_t)dir * GR + rb + 8 * sg + k) * 512 + sch;
      lab[dir][k] = *(const unsigned*)(ALA + gi);
      ub[dir][k] = *(const unsigned*)(AU + gi);
    }
#pragma unroll
  for (int k = 0; k < 8; ++k) gt[k] = *(const unsigned*)(z + (size_t)(rb + 8 * sg + k) * NZ + C_GA + sch);
  const float2 car0 = *(const float2*)((const float*)(p.ws + O_ACAR) + ((size_t)cgk * 2 + 0) * 512 + sch);
  const float2 car1 = *(const float2*)((const float*)(p.ws + O_ACAR) + ((size_t)cgk * 2 + 1) * 512 + sch);
  float af[2][8][2];
#pragma unroll
  for (int dir = 0; dir < 2; ++dir) {
    float ls0 = 0.f, ls1 = 0.f, H0 = 0.f, H1 = 0.f;
#pragma unroll
    for (int kk = 0; kk < 8; ++kk) {
      const int k = dir ? 7 - kk : kk;
      float l0 = bf2f((u16)(lab[dir][k] & 0xffff)), l1 = bf2f((u16)(lab[dir][k] >> 16));
      float a0 = __expf(l0), a1 = __expf(l1);
      af[dir][k][0] = a0; af[dir][k][1] = a1;
      H0 = a0 * H0 + bf2f((u16)(ub[dir][k] & 0xffff));
      H1 = a1 * H1 + bf2f((u16)(ub[dir][k] >> 16));
      ls0 += l0; ls1 += l1;
    }
    *(float2*)(segP + (dir * 8 + sg) * 64 + 2 * cp) = make_float2(__expf(ls0), __expf(ls1));
    *(float2*)(segH + (dir * 8 + sg) * 64 + 2 * cp) = make_float2(H0, H1);
  }
  __syncthreads();
  float y0[8], y1[8];
#pragma unroll
  for (int k = 0; k < 8; ++k) { y0[k] = 0.f; y1[k] = 0.f; }
#pragma unroll
  for (int dir = 0; dir < 2; ++dir) {
    float s0 = dir ? car1.x : car0.x, s1 = dir ? car1.y : car0.y;
    const int nbefore = dir ? 7 - sg : sg;
    for (int q = 0; q < nbefore; ++q) {
      int sq = dir ? 7 - q : q;
      float2 pp = *(const float2*)(segP + (dir * 8 + sq) * 64 + 2 * cp);
      float2 hh = *(const float2*)(segH + (dir * 8 + sq) * 64 + 2 * cp);
      s0 = pp.x * s0 + hh.x;
      s1 = pp.y * s1 + hh.y;
    }
#pragma unroll
    for (int kk = 0; kk < 8; ++kk) {
      const int k = dir ? 7 - kk : kk;
      s0 = af[dir][k][0] * s0 + bf2f((u16)(ub[dir][k] & 0xffff));
      s1 = af[dir][k][1] * s1 + bf2f((u16)(ub[dir][k] >> 16));
      y0[k] += s0; y1[k] += s1;
    }
  }
#pragma unroll
  for (int k = 0; k < 8; ++k) {
    float g0 = bf2f((u16)(gt[k] & 0xffff)), g1 = bf2f((u16)(gt[k] >> 16));
    *(unsigned*)(z + (size_t)(rb + 8 * sg + k) * NZ + C_GA + sch) = pk2(y0[k] * silu(g0), y1[k] * silu(g1));
  }
  __syncthreads();
}

DEV void a_carry(const P& p, int item) {
  int t = item * 256 + threadIdx.x;
  int ch = t & 511, dir = (t >> 9) & 1, lb = t >> 10;
  const float* AP = (const float*)(p.ws + O_AP);
  const float* AH = (const float*)(p.ws + O_AH);
  float* AC = (float*)(p.ws + O_ACAR);
  float st = 0.f;
  float pv[36], hv[36];
#pragma unroll
  for (int j = 0; j < 36; ++j) {
    int n = dir ? (j < 4 ? 3 - j : 39 - j) : j;
    size_t idx = ((size_t)(lb * 36 + n) * 2 + dir) * 512 + ch;
    pv[j] = AP[idx];
    hv[j] = AH[idx];
  }
#pragma unroll
  for (int j = 0; j < 36; ++j) {
    int n = dir ? (j < 4 ? 3 - j : 39 - j) : j;
    size_t idx = ((size_t)(lb * 36 + n) * 2 + dir) * 512 + ch;
    AC[idx] = st;
    st = pv[j] * st + hv[j];
  }
}

DEV void b_local(const P& p, int l, int item, char* smem) {
  u16* qs = (u16*)smem;
  u16* ks = qs + 64 * 136;
  float* Am = (float*)(smem + 34816);
  float* gc = (float*)(smem + 34816 + 32768);
  float* bt = gc + 128;
  const int tid = opq(threadIdx.x), lane = tid & 63, w = tid >> 6, fr = lane & 15, fq = lane >> 4;
  const int cgk = item >> 2, h = item & 3, n = cgk % 36, rb = cgk * 64;
  const u16* z = (const u16*)(p.ws + O_Z);
  u16* qn = (u16*)(p.ws + O_BSH);
  u16* kn = qn + (size_t)GR * 512;
  u16* vb = kn + (size_t)GR * 512;
  u16* knT = vb + (size_t)GR * 512;
  const float* ab = (const float*)(p.ws + O_AB);
  {
    u16* Tt = (u16*)Am;
    uint4 st[5];
#define BL_TLOAD(which)                                                                                  \
  _Pragma("unroll") for (int k = 0; k < 5; ++k) {                                                        \
    int idx = tid + 256 * k, row = idx >> 4, seg = idx & 15, cp = row - 2;                               \
    bool ok = (idx < 1072) && !((cp < 0 && (n == 0 || n == 4)) || (cp > 63 && (n == 3 || n == 35)));    \
    st[k] = make_uint4(0u, 0u, 0u, 0u);                                                                  \
    if (ok) st[k] = *(const uint4*)(z + (size_t)(rb + cp) * NZ + C_Q + (which)*512 + h * 128 + seg * 8); \
  }
    BL_TLOAD(0)
#pragma unroll
    for (int which = 0; which < 3; ++which) {
#pragma unroll
      for (int k = 0; k < 5; ++k) {
        int idx = tid + 256 * k, row = idx >> 4, seg = idx & 15;
        if (idx < 1072) *(uint4*)(Tt + row * 136 + seg * 8) = st[k];
      }
      __syncthreads();
      if (which < 2) { BL_TLOAD(which + 1) }
      float cw[2][4];
#pragma unroll
      for (int hh = 0; hh < 2; ++hh)
#pragma unroll
        for (int tap = 0; tap < 4; ++tap)
          cw[hh][tap] = p.conv_b_w[(size_t)(l * 4 + tap) * 1536 + which * 512 + h * 128 + lane + 64 * hh];
#pragma unroll 4
      for (int c = w; c < 64; c += 4) {
        float v[2];
#pragma unroll
        for (int hh = 0; hh < 2; ++hh) {
          int d = lane + 64 * hh;
          float a = 0.f;
#pragma unroll
          for (int tap = 0; tap < 4; ++tap) a += cw[hh][tap] * bf2f(Tt[(c + tap) * 136 + d]);
          v[hh] = silu(a);
        }
        float rs = 1.f;
        if (which < 2) {
          float sq = v[0] * v[0] + v[1] * v[1];
#pragma unroll
          for (int off = 32; off; off >>= 1) sq += __shfl_xor(sq, off);
          rs = rsqrtf(sq + EPS) * (which == 0 ? 0.08838834764831845f : 1.f);
        }
#pragma unroll
        for (int hh = 0; hh < 2; ++hh) {
          int d = lane + 64 * hh;
          u16 ob = f2bf(v[hh] * rs);
          size_t gi = (size_t)(rb + c) * 512 + h * 128 + d;
          if (which == 0) { qs[c * 136 + d] = ob; qn[gi] = ob; }
          else if (which == 1) { ks[c * 136 + d] = ob; kn[gi] = ob; }
          else vb[gi] = ob;
        }
      }
      __syncthreads();
    }
  }
  if (w < 2) {
    int dir = w, i = lane, c = dir ? 63 - i : i;
    float al = ab[(size_t)(rb + c) * 16 + dir * 4 + h], bl = ab[(size_t)(rb + c) * 16 + 8 + dir * 4 + h];
    float g = -__expf(p.gdn_a_log[(l * 2 + dir) * 4 + h]) * softplus(al + p.gdn_dt_bias[(l * 2 + dir) * 4 + h]);
#pragma unroll
    for (int off = 1; off < 64; off <<= 1) {
      float v = __shfl_up(g, off);
      if (lane >= off) g += v;
    }
    gc[dir * 64 + i] = g;
    bt[dir * 64 + i] = sigm(bl);
  }
  __syncthreads();
  for (int idx = tid; idx < 1024; idx += 256) {
    int d = idx >> 3, c8 = idx & 7;
    uint4 pk;
    pk.x = (unsigned)ks[(c8 * 8 + 0) * 136 + d] | ((unsigned)ks[(c8 * 8 + 1) * 136 + d] << 16);
    pk.y = (unsigned)ks[(c8 * 8 + 2) * 136 + d] | ((unsigned)ks[(c8 * 8 + 3) * 136 + d] << 16);
    pk.z = (unsigned)ks[(c8 * 8 + 4) * 136 + d] | ((unsigned)ks[(c8 * 8 + 5) * 136 + d] << 16);
    pk.w = (unsigned)ks[(c8 * 8 + 6) * 136 + d] | ((unsigned)ks[(c8 * 8 + 7) * 136 + d] << 16);
    *(uint4*)(knT + ((size_t)(cgk * 4 + h) * 128 + d) * 64 + c8 * 8) = pk;
  }
  for (int dir = 0; dir < 2; ++dir) {
    char* rec = p.ws + O_BIT + ((size_t)(cgk * 4 + h) * 2 + dir) * BIT_SZ;
    u16* QKm = (u16*)rec + 4096;
    float* scal = (float*)(rec + 16384);
    int irow = 16 * w + fr, ci = dir ? 63 - irow : irow;
    bf16x8 ak[4], aq[4];
#pragma unroll
    for (int s = 0; s < 4; ++s) { ak[s] = ld8(ks + ci * 136 + 32 * s + 8 * fq); aq[s] = ld8(qs + ci * 136 + 32 * s + 8 * fq); }
#pragma unroll
    for (int nt = 0; nt < 4; ++nt) {
      int jcol = 16 * nt + fr, cj = dir ? 63 - jcol : jcol;
      f32x4 kk = {0.f, 0.f, 0.f, 0.f}, qk = {0.f, 0.f, 0.f, 0.f};
#pragma unroll
      for (int s = 0; s < 4; ++s) {
        bf16x8 b = ld8(ks + cj * 136 + 32 * s + 8 * fq);
        kk = mfma(ak[s], b, kk);
        qk = mfma(aq[s], b, qk);
      }
      float gj = gc[dir * 64 + jcol];
#pragma unroll
      for (int r = 0; r < 4; ++r) {
        int i = 16 * w + 4 * fq + r;
        float dec = (jcol <= i) ? __expf(gc[dir * 64 + i] - gj) : 0.f;
        Am[(dir * 64 + i) * 64 + jcol] = (jcol < i) ? bt[dir * 64 + i] * kk[r] * dec : 0.f;
        QKm[i * 64 + jcol] = f2bf(qk[r] * dec);
      }
    }
    if (tid < 64) {
      float gl = gc[dir * 64 + 63], gi = gc[dir * 64 + tid];
      scal[tid] = __expf(gi);
      scal[64 + tid] = bt[dir * 64 + tid];
      scal[128 + tid] = __expf(gl - gi);
      if (tid == 0) scal[192] = __expf(gl);
    }
  }
  __syncthreads();
  if (w < 2) {
    int dir = w, col = lane;
    u16* Tinv = (u16*)(p.ws + O_BIT + ((size_t)(cgk * 4 + h) * 2 + dir) * BIT_SZ);
    const float* Ad = Am + dir * 4096;
    float T[64];
#pragma unroll
    for (int i = 0; i < 64; ++i) {
      float s = (i == col) ? 1.f : 0.f;
#pragma unroll
      for (int j = 0; j < i; ++j) s -= Ad[i * 64 + j] * T[j];
      T[i] = s;
      Tinv[i * 64 + col] = f2bf(s);
      __builtin_amdgcn_sched_barrier(0);
    }
  }
  __syncthreads();
}

DEV void b_seq(const P& p, int bitem, char* smem) {
  const int tid = opq(threadIdx.x), lane = tid & 63, w = tid >> 6, fr = lane & 15, fq = lane >> 4;
  const bool active = w < WPB;
  const int item = bitem * WPB + (active ? w : 0);
  const int slice = item & 7, dir = (item >> 3) & 1, h = (item >> 4) & 3, lb = item >> 6, e0 = slice * 16;
  u16* Ss = (u16*)(smem + w * 11264);
  u16* Rs = Ss + 16 * 136;
  u16* Vsc = Rs + 16 * 72;
  u16* Vor = Vsc + 16 * 72;
  const u16* qn = (const u16*)(p.ws + O_BSH);
  const u16* kn = qn + (size_t)GR * 512;
  const u16* vb = kn + (size_t)GR * 512;
  const u16* knT = vb + (size_t)GR * 512;
  u16* OB = (u16*)(p.ws + O_OB);
  f32x4 S[8];
#pragma unroll
  for (int m = 0; m < 8; ++m) S[m] = (f32x4){0.f, 0.f, 0.f, 0.f};
  for (int j = 0; j < 36; ++j) {
    const int n = dir ? (j < 4 ? 3 - j : 39 - j) : j;
    const int cgk = lb * 36 + n, rb = cgk * 64;
    const char* rec = p.ws + O_BIT + ((size_t)(cgk * 4 + h) * 2 + dir) * BIT_SZ;
    const u16* Tinv = (const u16*)rec;
    const u16* QKm = Tinv + 4096;
    const float* scal = (const float*)(rec + 16384);
    if (active) {
#pragma unroll
      for (int m = 0; m < 8; ++m) {
        uint2 pk; pk.x = pk2(S[m][0], S[m][1]); pk.y = pk2(S[m][2], S[m][3]);
        *(uint2*)(Ss + fr * 136 + 16 * m + 4 * fq) = pk;
      }
    }
    __syncthreads();
    bf16x8 Sf[4];
    if (active) {
#pragma unroll
      for (int s = 0; s < 4; ++s) Sf[s] = ld8(Ss + fr * 136 + 32 * s + 8 * fq);
#pragma unroll
      for (int m = 0; m < 4; ++m) {
        int i = 16 * m + fr, rowi = rb + (dir ? 63 - i : i);
        f32x4 X = {0.f, 0.f, 0.f, 0.f};
#pragma unroll
        for (int s = 0; s < 4; ++s) X = mfma(ld8(kn + (size_t)rowi * 512 + h * 128 + 32 * s + 8 * fq), Sf[s], X);
        float rv[4];
#pragma unroll
        for (int r = 0; r < 4; ++r) {
          int ii = 16 * m + 4 * fq + r, rowr = rb + (dir ? 63 - ii : ii);
          float v = bf2f(vb[(size_t)rowr * 512 + h * 128 + e0 + fr]);
          rv[r] = scal[64 + ii] * (v - scal[ii] * X[r]);
        }
        uint2 pk; pk.x = pk2(rv[0], rv[1]); pk.y = pk2(rv[2], rv[3]);
        *(uint2*)(Rs + fr * 72 + 16 * m + 4 * fq) = pk;
      }
    }
    __syncthreads();
    if (active) {
      bf16x8 Rf0 = ld8(Rs + fr * 72 + 8 * fq), Rf1 = ld8(Rs + fr * 72 + 32 + 8 * fq);
#pragma unroll
      for (int m = 0; m < 4; ++m) {
        f32x4 VN = {0.f, 0.f, 0.f, 0.f};
        VN = mfma(ld8(Tinv + (16 * m + fr) * 64 + 8 * fq), Rf0, VN);
        VN = mfma(ld8(Tinv + (16 * m + fr) * 64 + 32 + 8 * fq), Rf1, VN);
        uint2 pk; pk.x = pk2(VN[0], VN[1]); pk.y = pk2(VN[2], VN[3]);
        *(uint2*)(Vsc + fr * 72 + 16 * m + 4 * fq) = pk;
        int ib = 16 * m + 4 * fq;
        float s0 = VN[0] * scal[128 + ib], s1 = VN[1] * scal[128 + ib + 1], s2 = VN[2] * scal[128 + ib + 2],
              s3 = VN[3] * scal[128 + ib + 3];
        if (dir) {
          pk.x = pk2(s3, s2); pk.y = pk2(s1, s0);
          *(uint2*)(Vor + fr * 72 + (60 - ib)) = pk;
        } else {
          pk.x = pk2(s0, s1); pk.y = pk2(s2, s3);
          *(uint2*)(Vor + fr * 72 + ib) = pk;
        }
      }
    }
    __syncthreads();
    if (active) {
      bf16x8 Vs0 = ld8(Vsc + fr * 72 + 8 * fq), Vs1 = ld8(Vsc + fr * 72 + 32 + 8 * fq);
      bf16x8 Vo0 = ld8(Vor + fr * 72 + 8 * fq), Vo1 = ld8(Vor + fr * 72 + 32 + 8 * fq);
#pragma unroll
      for (int m = 0; m < 4; ++m) {
        int i = 16 * m + fr, rowi = rb + (dir ? 63 - i : i);
        f32x4 O = {0.f, 0.f, 0.f, 0.f};
#pragma unroll
        for (int s = 0; s < 4; ++s) O = mfma(ld8(qn + (size_t)rowi * 512 + h * 128 + 32 * s + 8 * fq), Sf[s], O);
#pragma unroll
        for (int r = 0; r < 4; ++r) O[r] *= scal[16 * m + 4 * fq + r];
        O = mfma(ld8(QKm + (16 * m + fr) * 64 + 8 * fq), Vs0, O);
        O = mfma(ld8(QKm + (16 * m + fr) * 64 + 32 + 8 * fq), Vs1, O);
#pragma unroll
        for (int r = 0; r < 4; ++r) {
          int ii = 16 * m + 4 * fq + r, rowr = rb + (dir ? 63 - ii : ii);
          OB[((size_t)dir * GR + rowr) * 512 + h * 128 + e0 + fr] = f2bf(O[r]);
        }
      }
      float egl = scal[192];
#pragma unroll
      for (int m = 0; m < 8; ++m) {
        const u16* kt = knT + ((size_t)(cgk * 4 + h) * 128 + 16 * m + fr) * 64;
        f32x4 t = S[m];
#pragma unroll
        for (int r = 0; r < 4; ++r) t[r] *= egl;
        t = mfma(ld8(kt + 8 * fq), Vo0, t);
        t = mfma(ld8(kt + 32 + 8 * fq), Vo1, t);
        S[m] = t;
      }
    }
  }
  __syncthreads();
}

DEV void c_local(const P& p, int l, int item, char* smem) {
  float* bsm = (float*)smem;
  u16* Ps = (u16*)(smem + 33024);
  u16* kdt = (u16*)(smem + 33024 + 9216);
  const int tid = opq(threadIdx.x), lane = tid & 63, w = tid >> 6, fr = lane & 15, fq = lane >> 4;
  const int cgk = item >> 2, h = item & 3, rb = cgk * 64;
  const u16* z = (const u16*)(p.ws + O_Z);
  const u16* zT = (const u16*)(p.ws + O_ZT);
  u16* OC = (u16*)(p.ws + O_OC);
  const float* lbs = (const float*)(p.ws + O_LBS);
  for (int dir = 0; dir < 2; ++dir) {
    char* rec = p.ws + O_CREC + ((size_t)(cgk * 4 + h) * 2 + dir) * CREC_SZ;
    u16* QD = (u16*)rec;
    u16* KDT = QD + 8192;
    float* decv = (float*)(rec + 32768);
    const float* lbp = lbs + l * 1024 + dir * 512 + h * 128;
    const int fcol = C_F0 + dir * 512 + h * 128;
    {
      int d = tid & 127, half = tid >> 7;
      float lb_ = lbp[d], run = 0.f;
      for (int k = 0; k < 32; ++k) {
        int i = 32 * half + k, c = dir ? 63 - i : i;
        float f = bf2f(z[(size_t)(rb + c) * NZ + fcol + d]);
        float fg = lb_ + (1.f - lb_) * sigm(f);
        run += __logf(fg);
        bsm[i * 129 + d] = run;
      }
    }
    __syncthreads();
    {
      int d = tid & 127, half = tid >> 7;
      if (half) {
        float add = bsm[31 * 129 + d];
        for (int k = 0; k < 32; ++k) bsm[(32 + k) * 129 + d] += add;
      }
    }
    __syncthreads();
    for (int idx = tid; idx < 8192; idx += 256) {
      int i = idx >> 7, d = idx & 127, c = dir ? 63 - i : i;
      float b = bsm[i * 129 + d];
      float q = silu(bf2f(z[(size_t)(rb + c) * NZ + C_QC + h * 128 + d]));
      QD[i * 128 + d] = f2bf(q * __expf(b));
      float f = bf2f(z[(size_t)(rb + c) * NZ + fcol + d]);
      float k = (1.f - lbp[d]) * sigm(-f);
      kdt[d * 72 + c] = f2bf(k * __expf(bsm[63 * 129 + d] - b));
    }
    if (tid < 128) decv[tid] = __expf(bsm[63 * 129 + tid]);
    __syncthreads();
    for (int idx = tid; idx < 1024; idx += 256) {
      int d = idx >> 3, c8 = idx & 7;
      *(uint4*)(KDT + d * 64 + c8 * 8) = *(const uint4*)(kdt + d * 72 + c8 * 8);
    }
    {
      const int sj = w;
      for (int si = 0; si < 4; ++si) {
        f32x4 acc = {0.f, 0.f, 0.f, 0.f};
        if (si >= sj) {
          int it = 16 * si + fr, jt = 16 * sj + fr;
          int ci = dir ? 63 - it : it, cj = dir ? 63 - jt : jt;
#pragma unroll
          for (int s = 0; s < 4; ++s) {
            int d0 = 32 * s + 8 * fq;
            bf16x8 qv = ld8(z + (size_t)(rb + ci) * NZ + C_QC + h * 128 + d0);
            bf16x8 fv = ld8(z + (size_t)(rb + cj) * NZ + fcol + d0);
            bf16x8 af, bf;
#pragma unroll
            for (int e = 0; e < 8; ++e) {
              int d = d0 + e;
              float Bs_ = si ? bsm[(16 * si - 1) * 129 + d] : 0.f;
              float qq = silu(bf2f((u16)qv[e])) * __expf(bsm[it * 129 + d] - Bs_);
              float kk = (1.f - lbp[d]) * sigm(-bf2f((u16)fv[e])) * __expf(Bs_ - bsm[jt * 129 + d]);
              af[e] = (short)f2bf(qq);
              bf[e] = (short)f2bf(kk);
            }
            acc = mfma(af, bf, acc);
          }
        }
#pragma unroll
        for (int r = 0; r < 4; ++r) {
          int i = 16 * si + 4 * fq + r, jj = 16 * sj + fr;
          float v = (si >= sj && jj <= i) ? acc[r] : 0.f;
          Ps[i * 72 + (dir ? 63 - jj : jj)] = f2bf(v);
        }
        __builtin_amdgcn_sched_barrier(0);
      }
    }
    __syncthreads();
#pragma unroll
    for (int nt2 = 0; nt2 < 2; ++nt2) {
      int e = h * 128 + (2 * w + nt2) * 16 + fr;
      bf16x8 v0 = ld8(zT + (size_t)e * GR + rb + 8 * fq), v1 = ld8(zT + (size_t)e * GR + rb + 32 + 8 * fq);
#pragma unroll
      for (int m = 0; m < 4; ++m) {
        f32x4 O = {0.f, 0.f, 0.f, 0.f};
        O = mfma(ld8(Ps + (16 * m + fr) * 72 + 8 * fq), v0, O);
        O = mfma(ld8(Ps + (16 * m + fr) * 72 + 32 + 8 * fq), v1, O);
#pragma unroll
        for (int r = 0; r < 4; ++r) {
          int ii = 16 * m + 4 * fq + r, rowr = rb + (dir ? 63 - ii : ii);
          OC[((size_t)dir * GR + rowr) * 512 + e] = f2bf(O[r]);
        }
      }
    }
    __syncthreads();
  }
}

DEV void c_seq(const P& p, int bitem, char* smem) {
  const int tid = opq(threadIdx.x), lane = tid & 63, w = tid >> 6, fr = lane & 15, fq = lane >> 4;
  const bool active = w < WPB;
  const int item = bitem * WPB + (active ? w : 0);
  const int slice = item & 7, dir = (item >> 3) & 1, h = (item >> 4) & 3, lb = item >> 6, e0 = slice * 16;
  u16* Ss = (u16*)(smem + w * 4352);
  const u16* zT = (const u16*)(p.ws + O_ZT);
  u16* OC = (u16*)(p.ws + O_OC);
  f32x4 S[8];
#pragma unroll
  for (int m = 0; m < 8; ++m) S[m] = (f32x4){0.f, 0.f, 0.f, 0.f};
  for (int j = 0; j < 36; ++j) {
    const int n = dir ? (j < 4 ? 3 - j : 39 - j) : j;
    const int cgk = lb * 36 + n, rb = cgk * 64;
    const char* rec = p.ws + O_CREC + ((size_t)(cgk * 4 + h) * 2 + dir) * CREC_SZ;
    const u16* QD = (const u16*)rec;
    const u16* KDT = QD + 8192;
    const float* decv = (const float*)(rec + 32768);
    if (active) {
#pragma unroll
      for (int m = 0; m < 8; ++m) {
        uint2 pk; pk.x = pk2(S[m][0], S[m][1]); pk.y = pk2(S[m][2], S[m][3]);
        *(uint2*)(Ss + fr * 136 + 16 * m + 4 * fq) = pk;
      }
    }
    __syncthreads();
    if (active) {
      bf16x8 Sf[4];
#pragma unroll
      for (int s = 0; s < 4; ++s) Sf[s] = ld8(Ss + fr * 136 + 32 * s + 8 * fq);
#pragma unroll
      for (int m = 0; m < 4; ++m) {
        f32x4 O = {0.f, 0.f, 0.f, 0.f};
#pragma unroll
        for (int s = 0; s < 4; ++s) O = mfma(ld8(QD + (16 * m + fr) * 128 + 32 * s + 8 * fq), Sf[s], O);
#pragma unroll
        for (int r = 0; r < 4; ++r) {
          int ii = 16 * m + 4 * fq + r, rowr = rb + (dir ? 63 - ii : ii);
          size_t oi = ((size_t)dir * GR + rowr) * 512 + h * 128 + e0 + fr;
          OC[oi] = f2bf(bf2f(OC[oi]) + O[r]);
        }
      }
      const u16* vp = zT + (size_t)(h * 128 + e0 + fr) * GR + rb;
      bf16x8 V0 = ld8(vp + 8 * fq), V1 = ld8(vp + 32 + 8 * fq);
#pragma unroll
      for (int m = 0; m < 8; ++m) {
        f32x4 t = S[m];
#pragma unroll
        for (int r = 0; r < 4; ++r) t[r] *= decv[16 * m + 4 * fq + r];
        t = mfma(ld8(KDT + (16 * m + fr) * 64 + 8 * fq), V0, t);
        t = mfma(ld8(KDT + (16 * m + fr) * 64 + 32 + 8 * fq), V1, t);
        S[m] = t;
      }
    }
    __syncthreads();
  }
}

#define LBAR()                                              \
  do {                                                      \
    asm volatile("s_waitcnt lgkmcnt(0)" ::: "memory");      \
    __builtin_amdgcn_s_barrier();                           \
    asm volatile("" ::: "memory");                          \
  } while (0)
#define CBAR() asm volatile("" ::: "memory")

DEV void c_local2(const P& p, int l, int item, char* smem) {
  float* bsm = (float*)smem;
  u16* Fq = (u16*)(smem + 33024);
  u16* kdt = (u16*)(smem + 50432);
  u16* Ps = kdt;
  const int tid = opq(threadIdx.x), lane = tid & 63, w = tid >> 6, fr = lane & 15, fq = lane >> 4;
  const int cgk = item >> 2, h = item & 3, rb = cgk * 64;
  const u16* z = (const u16*)(p.ws + O_Z);
  const u16* zT = (const u16*)(p.ws + O_ZT);
  u16* OC = (u16*)(p.ws + O_OC);
  const float* lbs = (const float*)(p.ws + O_LBS);
  u16* zq = (u16*)(p.ws + O_Z) + (size_t)rb * NZ + C_QC + h * 128;
  {
    uint4 t4[4];
#pragma unroll
    for (int k = 0; k < 4; ++k) {
      int idx = tid + 256 * k, c = idx >> 4, seg = idx & 15;
      t4[k] = *(const uint4*)(zq + (size_t)c * NZ + seg * 8);
    }
#pragma unroll
    for (int k = 0; k < 4; ++k) {
      int idx = tid + 256 * k, c = idx >> 4, seg = idx & 15;
      unsigned wv[4] = {t4[k].x, t4[k].y, t4[k].z, t4[k].w};
#pragma unroll
      for (int q = 0; q < 4; ++q)
        wv[q] = pk2(silu(bf2f((u16)(wv[q] & 0xffff))), silu(bf2f((u16)(wv[q] >> 16))));
      *(uint4*)(zq + (size_t)c * NZ + seg * 8) = make_uint4(wv[0], wv[1], wv[2], wv[3]);
    }
  }
  __syncthreads();
  for (int dir = 0; dir < 2; ++dir) {
    char* rec = p.ws + O_CREC + ((size_t)(cgk * 4 + h) * 2 + dir) * CREC_SZ;
    u16* QD = (u16*)rec;
    u16* KDT = QD + 8192;
    float* decv = (float*)(rec + 32768);
    const float* lbp = lbs + l * 1024 + dir * 512 + h * 128;
    const int fcol = C_F0 + dir * 512 + h * 128;
    {
      uint4 t4[4];
#pragma unroll
      for (int k = 0; k < 4; ++k) {
        int idx = tid + 256 * k, c = idx >> 4, seg = idx & 15;
        t4[k] = *(const uint4*)(z + (size_t)(rb + c) * NZ + fcol + seg * 8);
      }
#pragma unroll
      for (int k = 0; k < 4; ++k) {
        int idx = tid + 256 * k, c = idx >> 4, seg = idx & 15;
        *(uint4*)(Fq + c * 136 + seg * 8) = t4[k];
      }
    }
    __syncthreads();
    {
      int d = tid & 127, half = tid >> 7;
      float lb_ = lbp[d], run = 0.f;
#pragma unroll 8
      for (int k = 0; k < 32; ++k) {
        int i = 32 * half + k, c = dir ? 63 - i : i;
        float f = bf2f(Fq[c * 136 + d]);
        float fg = lb_ + (1.f - lb_) * sigm(f);
        run += __logf(fg);
        bsm[i * 129 + d] = run;
      }
    }
    __syncthreads();
    {
      int d = tid & 127, half = tid >> 7;
      if (half) {
        float add = bsm[31 * 129 + d];
#pragma unroll 8
        for (int k = 0; k < 32; ++k) bsm[(32 + k) * 129 + d] += add;
      }
    }
    __syncthreads();
    {
      uint4 qv[4];
#pragma unroll
      for (int k = 0; k < 4; ++k) {
        int idx = tid + 256 * k, c = idx >> 4, seg = idx & 15;
        qv[k] = *(const uint4*)(zq + (size_t)c * NZ + seg * 8);
      }
#pragma unroll
      for (int k = 0; k < 4; ++k) {
        int idx = tid + 256 * k, c = idx >> 4, seg = idx & 15, i = dir ? 63 - c : c, d0 = seg * 8;
        unsigned qw[4] = {qv[k].x, qv[k].y, qv[k].z, qv[k].w};
        uint4 fv4 = *(const uint4*)(Fq + c * 136 + d0);
        unsigned fw[4] = {fv4.x, fv4.y, fv4.z, fv4.w};
        unsigned qo[4], ko[4];
#pragma unroll
        for (int q = 0; q < 4; ++q) {
          int d = d0 + 2 * q;
          float b0 = bsm[i * 129 + d], b1 = bsm[i * 129 + d + 1];
          float bl0 = bsm[63 * 129 + d], bl1 = bsm[63 * 129 + d + 1];
          float q0 = bf2f((u16)(qw[q] & 0xffff)), q1 = bf2f((u16)(qw[q] >> 16));
          qo[q] = pk2(q0 * __expf(b0), q1 * __expf(b1));
          float k0 = (1.f - lbp[d]) * sigm(-bf2f((u16)(fw[q] & 0xffff)));
          float k1 = (1.f - lbp[d + 1]) * sigm(-bf2f((u16)(fw[q] >> 16)));
          ko[q] = pk2(k0, k1);
          kdt[d * 72 + c] = f2bf(k0 * __expf(bl0 - b0));
          kdt[(d + 1) * 72 + c] = f2bf(k1 * __expf(bl1 - b1));
        }
        *(uint4*)(QD + i * 128 + d0) = make_uint4(qo[0], qo[1], qo[2], qo[3]);
        *(uint4*)(Fq + c * 136 + d0) = make_uint4(ko[0], ko[1], ko[2], ko[3]);
      }
      if (tid < 128) decv[tid] = __expf(bsm[63 * 129 + tid]);
    }
    __syncthreads();
    for (int idx = tid; idx < 1024; idx += 256) {
      int d = idx >> 3, c8 = idx & 7;
      *(uint4*)(KDT + d * 64 + c8 * 8) = *(const uint4*)(kdt + d * 72 + c8 * 8);
    }
    bf16x8 qf[3][4];
#pragma unroll
    for (int t = 0; t < 3; ++t) {
      int k = w + 4 * t;
      int si = k < 4 ? 3 : (k < 7 ? 2 : (k < 9 ? 1 : 0));
      int it_ = 16 * si + fr, ci_ = dir ? 63 - it_ : it_;
#pragma unroll
      for (int s = 0; s < 4; ++s) qf[t][s] = ld8(zq + (size_t)ci_ * NZ + 32 * s + 8 * fq);
    }
    __syncthreads();
    for (int idx = tid; idx < 1536; idx += 256) {
      int tl = idx >> 8, e = idx & 255, r16 = e >> 4, c16 = e & 15;
      int si = tl < 3 ? 0 : (tl < 5 ? 1 : 2);
      int sj = tl < 3 ? tl + 1 : (tl < 5 ? tl - 1 : 3);
      int jj = 16 * sj + c16;
      Ps[(16 * si + r16) * 72 + (dir ? 63 - jj : jj)] = 0;
    }
#pragma unroll
    for (int t = 0; t < 3; ++t) {
      const int k = w + 4 * t;
      if (k < 10) {
        const int si = k < 4 ? 3 : (k < 7 ? 2 : (k < 9 ? 1 : 0));
        const int sj = k - (k < 4 ? 0 : (k < 7 ? 4 : (k < 9 ? 7 : 9)));
        const int it = 16 * si + fr, jt = 16 * sj + fr, cj = dir ? 63 - jt : jt;
        const int brow = si ? (16 * si - 1) : 0;
        const float bmul = si ? 1.f : 0.f;
        f32x4 acc = {0.f, 0.f, 0.f, 0.f};
#pragma unroll
        for (int s = 0; s < 4; ++s) {
          int d0 = 32 * s + 8 * fq;
          bf16x8 fv = ld8(Fq + cj * 136 + d0);
          bf16x8 af, bf;
#pragma unroll
          for (int e = 0; e < 8; ++e) {
            int d = d0 + e;
            float Bs_ = bmul * bsm[brow * 129 + d];
            float qq = bf2f((u16)qf[t][s][e]) * __expf(bsm[it * 129 + d] - Bs_);
            float kk = bf2f((u16)fv[e]) * __expf(Bs_ - bsm[jt * 129 + d]);
            af[e] = (short)f2bf(qq);
            bf[e] = (short)f2bf(kk);
          }
          acc = mfma(af, bf, acc);
          __builtin_amdgcn_sched_barrier(0);
        }
#pragma unroll
        for (int r = 0; r < 4; ++r) {
          int i = 16 * si + 4 * fq + r, jj = 16 * sj + fr;
          float v = (jj <= i) ? acc[r] : 0.f;
          Ps[i * 72 + (dir ? 63 - jj : jj)] = f2bf(v);
        }
      }
    }
    __syncthreads();
#pragma unroll
    for (int nt2 = 0; nt2 < 2; ++nt2) {
      int e = h * 128 + (2 * w + nt2) * 16 + fr;
      bf16x8 v0 = ld8(zT + (size_t)e * GR + rb + 8 * fq), v1 = ld8(zT + (size_t)e * GR + rb + 32 + 8 * fq);
#pragma unroll
      for (int m = 0; m < 4; ++m) {
        f32x4 O = {0.f, 0.f, 0.f, 0.f};
        O = mfma(ld8(Ps + (16 * m + fr) * 72 + 8 * fq), v0, O);
        O = mfma(ld8(Ps + (16 * m + fr) * 72 + 32 + 8 * fq), v1, O);
#pragma unroll
        for (int r = 0; r < 4; ++r) {
          int ii = 16 * m + 4 * fq + r, rowr = rb + (dir ? 63 - ii : ii);
          OC[((size_t)dir * GR + rowr) * 512 + e] = f2bf(O[r]);
        }
      }
    }
    __syncthreads();
  }
}

#define LBAR()                                              \
  do {                                                      \
    asm volatile("s_waitcnt lgkmcnt(0)" ::: "memory");      \
    __builtin_amdgcn_s_barrier();                           \
    asm volatile("" ::: "memory");                          \
  } while (0)
#define CBAR() asm volatile("" ::: "memory")
#define BS_CHUNK(jj) (dir ? ((jj) < 4 ? 3 - (jj) : 39 - (jj)) : (jj))
DEV bf16x8 ldo8(const char* base, unsigned off) { return *reinterpret_cast<const bf16x8*>(base + off); }
DEV void b_seq2(const P& p, int bitem, char* smem) {
  const int tid = opq(threadIdx.x), lane = tid & 63, w = tid >> 6, fr = lane & 15, fq = lane >> 4;
  const int es = bitem & 3, dir = (bitem >> 2) & 1, h = (bitem >> 3) & 3, lb = bitem >> 5, e0 = es * 32;
  u16* Ss = (u16*)smem;
  u16* Rs = Ss + 32 * 136;
  u16* Vsc = Rs + 32 * 72;
  u16* Vor = Vsc + 32 * 72;
  const char* qnB = p.ws + O_BSH + (size_t)h * 256;
  const char* knB = qnB + BSH_ONE;
  const char* vbB = knB + BSH_ONE + (size_t)e0 * 2;
  const char* ktB = p.ws + O_BSH + 3 * BSH_ONE + (size_t)h * 16384;
  const char* recB = p.ws + O_BIT + ((size_t)h * 2 + dir) * BIT_SZ;
  char* obB = p.ws + O_OB + ((size_t)dir * GR * 512 + h * 128 + e0) * 2;
  const int mrow = 16 * w + fr, crow0 = 16 * w + 4 * fq;
  const unsigned offA = (unsigned)((dir ? 63 - mrow : mrow) * 1024 + 16 * fq);
  unsigned offR[4];
#pragma unroll
  for (int r = 0; r < 4; ++r) offR[r] = (unsigned)((dir ? 63 - (crow0 + r) : (crow0 + r)) * 1024 + fr * 2);
  const unsigned offT = (unsigned)(mrow * 128 + 16 * fq);
  const unsigned offK = (unsigned)((32 * w + fr) * 128 + 16 * fq);
  const unsigned offS = (unsigned)(16384 + crow0 * 4);
  f32x4 S[2][2];
#pragma unroll
  for (int a = 0; a < 2; ++a)
#pragma unroll
    for (int b = 0; b < 2; ++b) S[a][b] = (f32x4){0.f, 0.f, 0.f, 0.f};
  bf16x8 Akn[4], Aqn[4], At[2][2], Aqk[2][2], AkT[2][2][2];
  u16 vbv[2][4];
  float4 eg4, be4, ek4[2];
  float egl[2];
#define BS_LOAD1(cg_)                                                              \
  {                                                                                \
    const size_t ro_ = (size_t)(cg_) * 65536;                                      \
    _Pragma("unroll") for (int s = 0; s < 4; ++s) {                                \
      Akn[s] = ldo8(knB + ro_, offA + 64 * s);                                     \
      Aqn[s] = ldo8(qnB + ro_, offA + 64 * s);                                     \
    }                                                                              \
    _Pragma("unroll") for (int r = 0; r < 4; ++r) {                                \
      vbv[0][r] = *(const u16*)(vbB + ro_ + offR[r]);                              \
      vbv[1][r] = *(const u16*)(vbB + ro_ + (offR[r] + 32));                       \
    }                                                                              \
    const char* rc_ = recB + (size_t)(cg_) * (8 * BIT_SZ);                         \
    eg4 = *(const float4*)(rc_ + offS);                                            \
    be4 = *(const float4*)(rc_ + (offS + 256));                                    \
  }
#define BS_LOAD2(cg_, SS)                                                          \
  {                                                                                \
    const char* rc_ = recB + (size_t)(cg_) * (8 * BIT_SZ);                         \
    At[SS][0] = ldo8(rc_, offT); At[SS][1] = ldo8(rc_, offT + 64);                 \
    ek4[SS] = *(const float4*)(rc_ + (offS + 512));                                \
  }
#define BS_LOAD3(cg_, SS)                                                          \
  {                                                                                \
    const char* rc_ = recB + (size_t)(cg_) * (8 * BIT_SZ);                         \
    Aqk[SS][0] = ldo8(rc_, offT + 8192); Aqk[SS][1] = ldo8(rc_, offT + 8192 + 64); \
    egl[SS] = *(const float*)(rc_ + 16384 + 768);                                  \
    const char* kt_ = ktB + (size_t)(cg_) * 65536;                                 \
    AkT[SS][0][0] = ldo8(kt_, offK); AkT[SS][0][1] = ldo8(kt_, offK + 64);         \
    AkT[SS][1][0] = ldo8(kt_, offK + 2048); AkT[SS][1][1] = ldo8(kt_, offK + 2048 + 64); \
  }
  {
    const int c0 = lb * 36 + BS_CHUNK(0);
    BS_LOAD1(c0) BS_LOAD2(c0, 0) BS_LOAD3(c0, 0)
  }
  for (int j2 = 0; j2 < 36; j2 += 2)
#pragma unroll
  for (int u = 0; u < 2; ++u) {
    const int j = j2 + u;
    const int cgk = lb * 36 + BS_CHUNK(j);
    const int jn = (j + 1 < 36) ? j + 1 : j;
    const int cgn = lb * 36 + BS_CHUNK(jn);
    BS_LOAD2(cgn, u ^ 1)
    BS_LOAD3(cgn, u ^ 1)
#pragma unroll
    for (int mm = 0; mm < 2; ++mm)
#pragma unroll
      for (int nt = 0; nt < 2; ++nt) {
        uint2 pk; pk.x = pk2(S[mm][nt][0], S[mm][nt][1]); pk.y = pk2(S[mm][nt][2], S[mm][nt][3]);
        *(uint2*)(Ss + (16 * nt + fr) * 136 + 32 * w + 16 * mm + 4 * fq) = pk;
      }
    LBAR();
    f32x4 QS[2];
    {
      bf16x8 Sf[2][4];
#pragma unroll
      for (int nt = 0; nt < 2; ++nt)
#pragma unroll
        for (int s = 0; s < 4; ++s) Sf[nt][s] = ld8(Ss + (16 * nt + fr) * 136 + 32 * s + 8 * fq);
#pragma unroll
      for (int nt = 0; nt < 2; ++nt) {
        f32x4 X = {0.f, 0.f, 0.f, 0.f}, Q = {0.f, 0.f, 0.f, 0.f};
#pragma unroll
        for (int s = 0; s < 4; ++s) { X = mfma(Akn[s], Sf[nt][s], X); Q = mfma(Aqn[s], Sf[nt][s], Q); }
        float r0 = be4.x * (bf2f(vbv[nt][0]) - eg4.x * X[0]);
        float r1 = be4.y * (bf2f(vbv[nt][1]) - eg4.y * X[1]);
        float r2 = be4.z * (bf2f(vbv[nt][2]) - eg4.z * X[2]);
        float r3 = be4.w * (bf2f(vbv[nt][3]) - eg4.w * X[3]);
        uint2 pk; pk.x = pk2(r0, r1); pk.y = pk2(r2, r3);
        *(uint2*)(Rs + (16 * nt + fr) * 72 + crow0) = pk;
        Q[0] *= eg4.x; Q[1] *= eg4.y; Q[2] *= eg4.z; Q[3] *= eg4.w;
        QS[nt] = Q;
      }
    }
    CBAR();
    BS_LOAD1(cgn)
    LBAR();
    {
#pragma unroll
      for (int nt = 0; nt < 2; ++nt) {
        bf16x8 Rf0 = ld8(Rs + (16 * nt + fr) * 72 + 8 * fq), Rf1 = ld8(Rs + (16 * nt + fr) * 72 + 32 + 8 * fq);
        f32x4 VN = {0.f, 0.f, 0.f, 0.f};
        VN = mfma(At[u][0], Rf0, VN);
        VN = mfma(At[u][1], Rf1, VN);
        uint2 pk; pk.x = pk2(VN[0], VN[1]); pk.y = pk2(VN[2], VN[3]);
        *(uint2*)(Vsc + (16 * nt + fr) * 72 + crow0) = pk;
        float s0 = VN[0] * ek4[u].x, s1 = VN[1] * ek4[u].y, s2 = VN[2] * ek4[u].z, s3 = VN[3] * ek4[u].w;
        if (dir) {
          pk.x = pk2(s3, s2); pk.y = pk2(s1, s0);
          *(uint2*)(Vor + (16 * nt + fr) * 72 + (60 - crow0)) = pk;
        } else {
          pk.x = pk2(s0, s1); pk.y = pk2(s2, s3);
          *(uint2*)(Vor + (16 * nt + fr) * 72 + crow0) = pk;
        }
      }
    }
    LBAR();
    {
      char* ob_ = obB + (size_t)cgk * 65536;
#pragma unroll
      for (int nt = 0; nt < 2; ++nt) {
        bf16x8 Vs0 = ld8(Vsc + (16 * nt + fr) * 72 + 8 * fq), Vs1 = ld8(Vsc + (16 * nt + fr) * 72 + 32 + 8 * fq);
        bf16x8 Vo0 = ld8(Vor + (16 * nt + fr) * 72 + 8 * fq), Vo1 = ld8(Vor + (16 * nt + fr) * 72 + 32 + 8 * fq);
        f32x4 O = QS[nt];
        O = mfma(Aqk[u][0], Vs0, O);
        O = mfma(Aqk[u][1], Vs1, O);
#pragma unroll
        for (int r = 0; r < 4; ++r) *(u16*)(ob_ + (offR[r] + 32 * nt)) = f2bf(O[r]);
#pragma unroll
        for (int mm = 0; mm < 2; ++mm) {
          f32x4 t = S[mm][nt];
#pragma unroll
          for (int r = 0; r < 4; ++r) t[r] *= egl[u];
          t = mfma(AkT[u][mm][0], Vo0, t);
          t = mfma(AkT[u][mm][1], Vo1, t);
          S[mm][nt] = t;
        }
      }
    }
  }
  LBAR();
}

DEV void c_seq2(const P& p, int bitem, char* smem) {
  const int tid = opq(threadIdx.x), lane = tid & 63, w = tid >> 6, fr = lane & 15, fq = lane >> 4;
  const int es = bitem & 3, dir = (bitem >> 2) & 1, h = (bitem >> 3) & 3, lb = bitem >> 5, e0 = es * 32;
  u16* Ssb = (u16*)smem;
  const char* recB = p.ws + O_CREC + ((size_t)h * 2 + dir) * CREC_SZ;
  const char* ztB = p.ws + O_ZT + (size_t)(h * 128 + e0) * GR * 2;
  char* ocB = p.ws + O_OC + ((size_t)dir * GR * 512 + h * 128 + e0) * 2;
  const int mrow = 16 * w + fr, crow0 = 16 * w + 4 * fq;
  const unsigned offQ = (unsigned)(mrow * 256 + 16 * fq);
  const unsigned offK = (unsigned)(16384 + (32 * w + fr) * 128 + 16 * fq);
  const unsigned offD = (unsigned)(32768 + (32 * w + 4 * fq) * 4);
  const unsigned offV = (unsigned)(fr * GR * 2 + 16 * fq);
  unsigned offR[4];
#pragma unroll
  for (int r = 0; r < 4; ++r) offR[r] = (unsigned)((dir ? 63 - (crow0 + r) : (crow0 + r)) * 1024 + fr * 2);
  f32x4 S[2][2];
#pragma unroll
  for (int a = 0; a < 2; ++a)
#pragma unroll
    for (int b = 0; b < 2; ++b) S[a][b] = (f32x4){0.f, 0.f, 0.f, 0.f};
  bf16x8 Aqd[4], Akd[2][2], Vf[2][2];
  u16 oi[2][4];
  float4 dec4[2];
#define CS_LOAD(cg_)                                                                    \
  {                                                                                     \
    const char* rc_ = recB + (size_t)(cg_) * (8 * CREC_SZ);                             \
    _Pragma("unroll") for (int s = 0; s < 4; ++s) Aqd[s] = ldo8(rc_, offQ + 64 * s);    \
    Akd[0][0] = ldo8(rc_, offK); Akd[0][1] = ldo8(rc_, offK + 64);                      \
    Akd[1][0] = ldo8(rc_, offK + 2048); Akd[1][1] = ldo8(rc_, offK + 2048 + 64);        \
    dec4[0] = *(const float4*)(rc_ + offD);                                             \
    dec4[1] = *(const float4*)(rc_ + (offD + 64));                                      \
    const char* zt_ = ztB + (size_t)(cg_) * 128;                                        \
    Vf[0][0] = ldo8(zt_, offV); Vf[0][1] = ldo8(zt_, offV + 64);                        \
    Vf[1][0] = ldo8(zt_, offV + 16 * GR * 2); Vf[1][1] = ldo8(zt_, offV + 16 * GR * 2 + 64); \
    const char* oc_ = ocB + (size_t)(cg_) * 65536;                                      \
    _Pragma("unroll") for (int r = 0; r < 4; ++r) {                                     \
      oi[0][r] = *(const u16*)(oc_ + offR[r]);                                          \
      oi[1][r] = *(const u16*)(oc_ + (offR[r] + 32));                                   \
    }                                                                                   \
  }
  {
    const int c0 = lb * 36 + BS_CHUNK(0);
    CS_LOAD(c0)
  }
  for (int j = 0; j < 36; ++j) {
    const int cgk = lb * 36 + BS_CHUNK(j);
    const int jn = (j + 1 < 36) ? j + 1 : j;
    const int cgn = lb * 36 + BS_CHUNK(jn);
    u16* Ss = Ssb + (j & 1) * (32 * 136);
#pragma unroll
    for (int mm = 0; mm < 2; ++mm)
#pragma unroll
      for (int nt = 0; nt < 2; ++nt) {
        uint2 pk; pk.x = pk2(S[mm][nt][0], S[mm][nt][1]); pk.y = pk2(S[mm][nt][2], S[mm][nt][3]);
        *(uint2*)(Ss + (16 * nt + fr) * 136 + 32 * w + 16 * mm + 4 * fq) = pk;
      }
    LBAR();
    char* oc_ = ocB + (size_t)cgk * 65536;
#pragma unroll
    for (int nt = 0; nt < 2; ++nt) {
      f32x4 O = {0.f, 0.f, 0.f, 0.f};
#pragma unroll
      for (int s = 0; s < 4; ++s) O = mfma(Aqd[s], ld8(Ss + (16 * nt + fr) * 136 + 32 * s + 8 * fq), O);
#pragma unroll
      for (int r = 0; r < 4; ++r) *(u16*)(oc_ + (offR[r] + 32 * nt)) = f2bf(bf2f(oi[nt][r]) + O[r]);
#pragma unroll
      for (int mm = 0; mm < 2; ++mm) {
        f32x4 t = S[mm][nt];
        t[0] *= dec4[mm].x; t[1] *= dec4[mm].y; t[2] *= dec4[mm].z; t[3] *= dec4[mm].w;
        t = mfma(Akd[mm][0], Vf[nt][0], t);
        t = mfma(Akd[mm][1], Vf[nt][1], t);
        S[mm][nt] = t;
      }
    }
    CBAR();
    CS_LOAD(cgn)
  }
  LBAR();
}

DEV void bc_merge_row(const P& p, int l, int lr, int lane);
DEV void bc_merge(const P& p, int l, int it) {
  const int tid_ = opq(threadIdx.x); const int lane = tid_ & 63, w = tid_ >> 6;
#pragma unroll
  for (int rr = 0; rr < 2; ++rr) bc_merge_row(p, l, it * 8 + w * 2 + rr, lane);
}
DEV void bc_merge_row(const P& p, int l, int lr, int lane) {
  int mix = lane >> 5, cm = (lane * 16) & 511;
  const u16* O = (const u16*)(p.ws + (mix ? O_OC : O_OB));
  u16* z = (u16*)(p.ws + O_Z);
  float ov[16], ss = 0.f;
#pragma unroll
  for (int k2 = 0; k2 < 2; ++k2) {
    uint4 a = *(const uint4*)(O + (size_t)lr * 512 + cm + 8 * k2);
    uint4 b = *(const uint4*)(O + ((size_t)GR + lr) * 512 + cm + 8 * k2);
    unsigned aa[4] = {a.x, a.y, a.z, a.w}, bb[4] = {b.x, b.y, b.z, b.w};
#pragma unroll
    for (int q = 0; q < 4; ++q) {
      float v0 = bf2f((u16)(aa[q] & 0xffff)) + bf2f((u16)(bb[q] & 0xffff));
      float v1 = bf2f((u16)(aa[q] >> 16)) + bf2f((u16)(bb[q] >> 16));
      ov[k2 * 8 + q * 2] = v0; ov[k2 * 8 + q * 2 + 1] = v1;
      ss += v0 * v0 + v1 * v1;
    }
  }
  ss += __shfl_xor(ss, 1); ss += __shfl_xor(ss, 2); ss += __shfl_xor(ss, 4);
  float rinv = rsqrtf(ss * (1.f / 128.f) + EPS);
  const float* nw = (mix ? p.hg_norm : p.gdn_norm) + l * 128 + (cm & 127);
  u16* gp = z + (size_t)lr * NZ + (mix ? C_GC : C_GB) + cm;
#pragma unroll
  for (int k2 = 0; k2 < 2; ++k2) {
    uint4 gv = *(const uint4*)(gp + 8 * k2);
    unsigned gg[4] = {gv.x, gv.y, gv.z, gv.w}, oo[4];
#pragma unroll
    for (int q = 0; q < 4; ++q) {
      int e = k2 * 8 + q * 2;
      float y0 = ov[e] * rinv * nw[e] * silu(bf2f((u16)(gg[q] & 0xffff)));
      float y1 = ov[e + 1] * rinv * nw[e + 1] * silu(bf2f((u16)(gg[q] >> 16)));
      oo[q] = pk2(y0, y1);
    }
    *(uint4*)(gp + 8 * k2) = make_uint4(oo[0], oo[1], oo[2], oo[3]);
  }
}

#define XB_TMO      128
#define XB_XCNT(j)  (256  + 64 * (j))
#define XB_XSUB(j)  (1280 + 64 * (j))
#define XB_XGEN(j)  (2304 + 64 * (j))
#define XB_TOP      3328
#define XB_TOPGEN   3392
#define XCD_BAR_WORDS 3456
#define XB_SPIN_CAP (1u << 18)
#define LAS __attribute__((address_space(3)))

__device__ __forceinline__ unsigned xb_ld(unsigned* p)              { return __hip_atomic_load(p, __ATOMIC_RELAXED, __HIP_MEMORY_SCOPE_AGENT); }
__device__ __forceinline__ unsigned xb_add(unsigned* p, unsigned v) { return __hip_atomic_fetch_add(p, v, __ATOMIC_RELAXED, __HIP_MEMORY_SCOPE_AGENT); }
__device__ __forceinline__ unsigned xb_xcc_id() { return (unsigned)__builtin_amdgcn_s_getreg((3 << 11) | 20) & 0xFu; }
#define XB_SPIN(cond, bar) do { unsigned _sp = 0; while (cond) { __builtin_amdgcn_s_sleep(1); \
    if ((++_sp & 255u) == 0u) { if (xb_ld(&(bar)[XB_TMO])) break; if (_sp > XB_SPIN_CAP) { atomicAdd(&(bar)[XB_TMO], 1u); break; } } } } while (0)

struct XcdBarrier {
    unsigned* bar; unsigned x;
    volatile LAS unsigned* st;
};

__device__ __forceinline__ XcdBarrier xcd_barrier_post(unsigned* bar, volatile LAS unsigned* st) {
    XcdBarrier b; b.bar = bar; b.x = xb_xcc_id(); b.st = st;
    if (threadIdx.x == 0) (void)xb_add(&bar[XB_XCNT(b.x)], 1u);
    return b;
}
__device__ __forceinline__ void xcd_barrier_complete(unsigned* bar, unsigned x, unsigned& nloc, unsigned& nx) {
    const unsigned G = gridDim.x * gridDim.y * gridDim.z;
    unsigned sum, cnt, mine, sp = 0u;
    for (;;) {
        sum = 0u; cnt = 0u; mine = 0u;
#pragma unroll
        for (unsigned j = 0; j < 16; ++j) { const unsigned c = xb_ld(&bar[XB_XCNT(j)]); sum += c; cnt += (c > 0u) ? 1u : 0u; mine = (j == x) ? c : mine; }
        if (sum == G) break;
        __builtin_amdgcn_s_sleep(1);
        if ((++sp & 255u) == 0u) { if (xb_ld(&bar[XB_TMO])) break; if (sp > XB_SPIN_CAP) { atomicAdd(&bar[XB_TMO], 1u); break; } }
    }
    nloc = mine > 0u ? mine : 1u; nx = cnt > 0u ? cnt : 1u;
}

__device__ __forceinline__ void xcd_barrier(const XcdBarrier& b) {
    asm volatile("s_waitcnt vmcnt(0)" ::: "memory");
    __syncthreads();
    if (threadIdx.x == 0) {
        unsigned* bar = b.bar;
        __builtin_amdgcn_s_waitcnt(0);
        unsigned nloc = b.st[0], nx = b.st[1];
        if (nloc == 0u) { xcd_barrier_complete(bar, b.x, nloc, nx); b.st[0] = nloc; b.st[1] = nx; }
        const unsigned old = xb_add(&bar[XB_XSUB(b.x)], 1u);
        const unsigned gen = old / nloc;
        if (old + 1u == (gen + 1u) * nloc) {
            __builtin_amdgcn_fence(__ATOMIC_RELEASE, "agent");
            asm volatile("s_waitcnt vmcnt(0)" ::: "memory");
            const unsigned og = xb_add(&bar[XB_TOP], 1u);
            const unsigned tg = og / nx;
            if (og + 1u == (tg + 1u) * nx) xb_add(&bar[XB_TOPGEN], 1u);
            else XB_SPIN(xb_ld(&bar[XB_TOPGEN]) == tg, bar);
            __builtin_amdgcn_fence(__ATOMIC_ACQUIRE, "agent");
            xb_add(&bar[XB_XGEN(b.x)], 1u);
            asm volatile("s_waitcnt vmcnt(0)" ::: "memory");
        } else {
            XB_SPIN(xb_ld(&bar[XB_XGEN(b.x)]) == gen, bar);
            __builtin_amdgcn_fence(__ATOMIC_ACQUIRE, "agent");
            asm volatile("s_waitcnt vmcnt(0)" ::: "memory");
        }
    }
    __syncthreads();
}


#ifdef NO_G0
#define XG0(x)
#else
#define XG0(x) x
#endif
#ifdef NO_G1
#define XG1(x)
#else
#define XG1(x) x
#endif
#ifdef NO_BC
#define XBC(x)
#else
#define XBC(x) x
#endif
#ifdef NO_AC
#define XAC(x)
#else
#define XAC(x) x
#endif
#ifdef NO_P0
#define XP0(x)
#else
#define XP0(x) x
#endif
#ifdef NO_R
#define XR(x)
#else
#define XR(x) x
#endif
#ifdef NO_BL
#define XBL(x)
#else
#define XBL(x) x
#endif
#ifdef NO_CL
#define XCL(x)
#else
#define XCL(x) x
#endif
#ifdef NO_A0
#define XA0(x)
#else
#define XA0(x) x
#endif
#ifdef NO_A1
#define XA1(x)
#else
#define XA1(x) x
#endif
#ifdef NO_BS
#define XBS(x)
#else
#define XBS(x) x
#endif
#ifdef NO_CS
#define XCS(x)
#else
#define XCS(x) x
#endif
__global__ void __launch_bounds__(256, 2) fwd_mega(P p) {
  extern __shared__ __attribute__((aligned(16))) char smem[];
  cg::grid_group grid = cg::this_grid();
  const int G = gridDim.x;
  __shared__ uint4 xb_words;
  if (threadIdx.x == 0) xb_words = make_uint4(0u, 0u, 0u, 0u);
  __syncthreads();
  XcdBarrier xb = xcd_barrier_post((unsigned*)(p.ws + O_BAR), (volatile LAS unsigned*)&xb_words);
  XP0(phase0(p, smem));
  if (p.ws == nullptr) grid.sync();
  xcd_barrier(xb);
  u16* z = (u16*)(p.ws + O_Z);
  u16* zT = (u16*)(p.ws + O_ZT);
  float* ab = (float*)(p.ws + O_AB);
  float* o = (float*)(p.ws + O_BSH);
  const u16* u = (const u16*)(p.ws + O_BIT);
  for (int g = 0; g < NG; ++g) {
    XR(phaseR(p, g, 0));
    xcd_barrier(xb);
    for (int l = 0; l < DEPTH; ++l) {
      for (int rep = 0; rep < REP_G; ++rep) {
        const u16* Bt = (const u16*)(p.ws + O_WTIN) + (size_t)l * NZ * 1024;
        if ((G & 7) == 0) {
          const int x = blockIdx.x & 7, bl = blockIdx.x >> 3, nbl = G >> 3;
          for (int q = bl; q < 9 * 45; q += nbl) { XG0(gemm_tile<0>(u, 1024, Bt, 1024, 9 * x + q % 9, q / 9, z, zT, ab, o, smem)); }
        } else {
          for (int t = blockIdx.x; t < 72 * 45; t += G) { XG0(gemm_tile<0>(u, 1024, Bt, 1024, t % 72, t / 72, z, zT, ab, o, smem)); }
        }
      }
      xcd_barrier(xb);
      for (int rep2 = 0; rep2 < REP_M; ++rep2) {
      for (int rep3 = 0; rep3 < REP_A; ++rep3) {
        if (rep3) xcd_barrier(xb);
        const int nb = NCH * 4, nc = NCH * 4, na = NCH * 8;
        if (G == 512) {
          const int bx = blockIdx.x;
          XCL(c_local2(p, l, bx, smem));
          if (bx < 64) { XCL(c_local2(p, l, 512 + bx, smem)); }
          XBL(b_local(p, l, bx, smem));
          if (bx >= 64 && bx < 128) { XBL(b_local(p, l, 448 + bx, smem)); }
          if (bx < 128) { XA0(a_item(p, l, bx, 0, smem)); }
          else {
            for (int t = 128 + (bx - 128); t < na; t += 384) { XA0(a_item(p, l, t, 0, smem)); }
          }
        } else {
          for (int t = blockIdx.x; t < nb + nc + na; t += G) {
            if (t < nc) { XCL(c_local2(p, l, t, smem)); }
            else if (t < nb + nc) { XBL(b_local(p, l, t - nc, smem)); }
            else { XA0(a_item(p, l, t - nb - nc, 0, smem)); }
          }
        }
      }
      xcd_barrier(xb);
      {
        for (int t = blockIdx.x; t < 256 + 16; t += G) {
          if (t < 128) { XBS(b_seq2(p, t, smem)); }
          else if (t < 256) { XCS(c_seq2(p, t - 128, smem)); }
          else { XAC(a_carry(p, t - 256)); }
        }
      }
      xcd_barrier(xb);
      }
      {
        const int na = NCH * 8, nm = GR / 8;
        for (int t = blockIdx.x; t < na + nm; t += G) {
          if (t < na) { XA1(a_fin2(p, l, t, smem)); }
          else { XBC(bc_merge(p, l, t - na)); }
        }
      }
      xcd_barrier(xb);
      for (int rep = 0; rep < REP_G; ++rep) {
        const u16* Bt = (const u16*)(p.ws + O_WTOUT) + (size_t)l * 1024 * 1536;
        if (l == DEPTH - 1) {
          for (int t = blockIdx.x; t < 64 * 8; t += G) {
            const int q = t % 64, rt = (q >> 4) * 18 + 2 + (q & 15);
            XG1(gemm_tile<1>(z + C_GA, NZ, Bt, 1536, rt, t / 64, z, zT, ab, o, smem));
          }
        } else {
          for (int t = blockIdx.x; t < 72 * 8; t += G) { XG1(gemm_tile<1>(z + C_GA, NZ, Bt, 1536, t % 72, t / 72, z, zT, ab, o, smem)); }
        }
      }
      xcd_barrier(xb);
      XR(phaseR(p, g, l + 1));
      if (l + 1 < DEPTH) xcd_barrier(xb);
    }
  }
}

extern "C" void kernel_launch(void* const* d_in, const int* in_sizes, int n_in, void* d_out, int out_size, void* d_ws,
                              size_t ws_size, hipStream_t stream) {
  static int grid_blocks = 0;
  if (!grid_blocks) {
    int dev = 0, cus = 0, per_cu = 0;
    hipGetDevice(&dev);
    hipDeviceGetAttribute(&cus, hipDeviceAttributeMultiprocessorCount, dev);
    hipFuncSetAttribute((const void*)fwd_mega, hipFuncAttributeMaxDynamicSharedMemorySize, LDS_BYTES);
    hipOccupancyMaxActiveBlocksPerMultiprocessor(&per_cu, fwd_mega, 256, LDS_BYTES);
    if (per_cu > 2) per_cu = 2;
    if (per_cu < 1) per_cu = 1;
    grid_blocks = cus * per_cu;
  }
  if (ws_size < WS_TOTAL) {
    fprintf(stderr, "workspace too small: %zu < %zu\n", ws_size, (size_t)WS_TOTAL);
    return;
  }
  P p{};
  const float** f = (const float**)&p;
  for (int i = 0; i < 23; ++i) f[i] = (const float*)d_in[i];
  p.out = (float*)d_out;
  p.ws = (char*)d_ws;
  hipMemsetAsync((char*)d_ws + O_BAR, 0, XCD_BAR_WORDS * 4, stream);
  void* args[] = {&p};
  hipError_t e = hipLaunchCooperativeKernel((void*)fwd_mega, dim3(grid_blocks), dim3(256), args, LDS_BYTES, stream);
  if (e != hipSuccess) fprintf(stderr, "cooperative launch failed: %s (grid %d)\n", hipGetErrorString(e), grid_blocks);
}
```

```cpp
#include <hip/hip_runtime.h>
#include <hip/hip_cooperative_groups.h>
#include <cstdio>
namespace cg = cooperative_groups;

typedef __attribute__((ext_vector_type(8))) short bf16x8;
typedef __attribute__((ext_vector_type(4))) float f32x4;
typedef unsigned short u16;
#define DEV __device__ __forceinline__

constexpr int DM = 1024, TL = 2048, TCX = 256, TS = 2304, GB = 4, GR = GB * TS, NG = 2;
constexpr int NZ = 5760, DEPTH = 4;
constexpr int C_XA = 0, C_Q = 512, C_K = 1024, C_V = 1536, C_QC = 2048, C_F0 = 2560, C_IC = 3584,
              C_GA = 4096, C_GB = 4608, C_GC = 5120, C_AB = 5632;
constexpr int NCH = GR / 64;
constexpr float EPS = 1e-6f;
constexpr int WPB = 2;

constexpr size_t al256(size_t x) { return (x + 255) & ~(size_t)255; }
constexpr size_t O_WTIN = 0;
constexpr size_t O_WTOUT = O_WTIN + al256((size_t)DEPTH * NZ * 1024 * 2);
constexpr size_t O_WGT = O_WTOUT + al256((size_t)DEPTH * 1024 * 1536 * 2);
constexpr size_t O_MOD = O_WGT + al256((size_t)DEPTH * 2 * 2 * 8 * 4096 * 2);
constexpr size_t O_LBS = O_MOD + al256((size_t)DEPTH * 9 * 3072 * 4);
constexpr size_t O_HC = O_LBS + al256((size_t)DEPTH * 1024 * 4);
constexpr size_t O_Z = O_HC + al256((size_t)GB * TCX * 1024 * 4);
constexpr size_t O_ZT = O_Z + al256((size_t)GR * NZ * 2);
constexpr size_t O_AB = O_ZT + al256((size_t)512 * GR * 2);
constexpr size_t O_BSH = O_AB + al256((size_t)GR * 16 * 4);
constexpr size_t BSH_ONE = (size_t)GR * 512 * 2;
constexpr size_t O_BIT = O_BSH + al256(4 * BSH_ONE);
constexpr size_t BIT_SZ = 17408;
constexpr size_t O_CREC = O_BIT + al256((size_t)NCH * 4 * 2 * BIT_SZ);
constexpr size_t CREC_SZ = 33280;
constexpr size_t O_OB = O_CREC + al256((size_t)NCH * 4 * 2 * CREC_SZ);
constexpr size_t O_OC = O_OB + al256((size_t)2 * GR * 512 * 2);
constexpr size_t O_AP = O_OC + al256((size_t)2 * GR * 512 * 2);
constexpr size_t O_AH = O_AP + al256((size_t)NCH * 2 * 512 * 4);
constexpr size_t O_ACAR = O_AH + al256((size_t)NCH * 2 * 512 * 4);
constexpr size_t O_ALA = O_ACAR + al256((size_t)NCH * 2 * 512 * 4);
constexpr size_t O_AU = O_ALA + al256((size_t)2 * GR * 512 * 2);
constexpr size_t O_BAR = O_AU + al256((size_t)2 * GR * 512 * 2);
constexpr size_t WS_TOTAL = O_BAR + al256(3456 * 4);

constexpr int LDS_BYTES = 73728;
#ifndef REP_A
#define REP_A 1
#endif
#ifndef REP_G
#define REP_G 1
#endif
#ifndef REP_M
#define REP_M 1
#endif

struct P {
  const float *x, *c, *ctx, *c_ctx, *w_ada, *b_ada, *norm_pre, *norm_post, *w_in, *conv_a_w, *conv_a_b, *rg_w_r,
      *rg_b_r, *rg_w_i, *rg_b_i, *rg_lam, *conv_b_w, *gdn_a_log, *gdn_dt_bias, *gdn_norm, *hg_lb, *hg_norm, *w_out;
  float* out;
  char* ws;
};

DEV int opq(int x) { asm volatile("" : "+v"(x)); return x; }
DEV int opqs(int x) { asm volatile("" : "+s"(x)); return x; }
typedef __attribute__((ext_vector_type(2))) __bf16 bf16x2_t;
typedef __attribute__((ext_vector_type(2))) float f32x2_t;
DEV u16 f2bf(float f) { __bf16 r = (__bf16)f; return __builtin_bit_cast(u16, r); }
DEV float bf2f(u16 h) { return __uint_as_float(((unsigned)h) << 16); }
DEV unsigned pk2(float a, float b) { f32x2_t v = {a, b}; bf16x2_t r = __builtin_convertvector(v, bf16x2_t); return __builtin_bit_cast(unsigned, r); }
DEV float sigm(float x) { return __builtin_amdgcn_rcpf(1.f + __expf(-x)); }
DEV float silu(float x) { return x * __builtin_amdgcn_rcpf(1.f + __expf(-x)); }
DEV float softplus(float x) { return x > 20.f ? x : log1pf(__expf(x)); }
DEV f32x4 mfma(bf16x8 a, bf16x8 b, f32x4 c) { return __builtin_amdgcn_mfma_f32_16x16x32_bf16(a, b, c, 0, 0, 0); }
DEV bf16x8 ld8(const u16* p) { return *reinterpret_cast<const bf16x8*>(p); }
DEV int lat_map(int l, int t) { return (l & 1) ? ((t & 63) * 32 + (t >> 6)) : t; }
DEV int orig_col(int n) {
  if (n < 512) return n;
  if (n < 2048) return n + 512;
  if (n < 4096) return n + 1040;
  if (n < 4608) return n - 4096 + 512;
  if (n < 5120) return n - 4608 + 2576;
  if (n < 5632) return n + 16;
  if (n < 5648) return n - 5632 + 2560;
  return -1;
}
DEV float zval(const u16* z, int rb, int cp, int n, int col) {
  if (cp < 0 && (n == 0 || n == 4)) return 0.f;
  if (cp > 63 && (n == 3 || n == 35)) return 0.f;
  return bf2f(z[(size_t)(rb + cp) * NZ + col]);
}

DEV void ph0_ada(const P& p, int item, char* smem) {
  float* sc = (float*)smem;
  float* red = (float*)(smem + 36864);
  const int tid = threadIdx.x, lane = tid & 63, wv = tid >> 6;
  for (int i = tid; i < 9 * 1024; i += 256) {
    int v = i >> 10, d = i & 1023;
    float cv = (v < 8) ? p.c[v * 1024 + d] : p.c_ctx[d];
    sc[i] = silu(cv);
  }
  __syncthreads();
  const int col = item * 64 + lane;
  const int l = col / 3072, e = col % 3072;
  const float* w = p.w_ada + (size_t)l * 1024 * 3072 + e + (size_t)(256 * wv) * 3072;
  const float* scw = sc + 256 * wv;
  float acc[9];
#pragma unroll
  for (int i = 0; i < 9; ++i) acc[i] = 0.f;
  for (int d = 0; d < 256; d += 16) {
    float wr[16];
#pragma unroll
    for (int k = 0; k < 16; ++k) wr[k] = w[(size_t)(d + k) * 3072];
#pragma unroll
    for (int k = 0; k < 16; ++k)
#pragma unroll
      for (int i = 0; i < 9; ++i) acc[i] += scw[i * 1024 + d + k] * wr[k];
  }
#pragma unroll
  for (int i = 0; i < 9; ++i) red[(wv * 9 + i) * 64 + lane] = acc[i];
  __syncthreads();
  float* mod = (float*)(p.ws + O_MOD);
  for (int idx = tid; idx < 9 * 64; idx += 256) {
    int i = idx >> 6, ln = idx & 63;
    float sum = red[(0 * 9 + i) * 64 + ln] + red[(1 * 9 + i) * 64 + ln] + red[(2 * 9 + i) * 64 + ln] + red[(3 * 9 + i) * 64 + ln];
    int cc = item * 64 + ln, l2 = cc / 3072, e2 = cc % 3072;
    mod[((size_t)l2 * 9 + i) * 3072 + e2] = sum + p.b_ada[l2 * 3072 + e2];
  }
  __syncthreads();
}
DEV void tconv_tile(const float* src, int lds_, u16* dst, int ldd, int k0, int n0, bool mapcol, char* smem) {
  float* t = (float*)smem;
  const int tid = threadIdx.x, nn = tid & 63, kq = tid >> 6;
  const int n = n0 + nn;
  const int sn0 = mapcol ? orig_col(n) : n;
  const float msk = (sn0 >= 0) ? 1.f : 0.f;
  const int sn = sn0 >= 0 ? sn0 : 0;
  float v[16];
#pragma unroll
  for (int k = 0; k < 16; ++k) v[k] = src[(size_t)(k0 + kq + 4 * k) * lds_ + sn];
#pragma unroll
  for (int k = 0; k < 16; ++k) t[(kq + 4 * k) * 65 + nn] = v[k] * msk;
  __syncthreads();
  {
    const int kk = tid & 63, nq = tid >> 6;
#pragma unroll
    for (int k = 0; k < 16; ++k) {
      int n2 = nq + 4 * k;
      dst[(size_t)(n0 + n2) * ldd + k0 + kk] = f2bf(t[kk * 65 + n2]);
    }
  }
  __syncthreads();
}
DEV void phase0(const P& p, char* smem) {
  const int n_ada = 192, n_in = DEPTH * 16 * 90, n_out = DEPTH * 24 * 16, n_g = 128, n_lb = 4;
  const int total = n_ada + n_in + n_out + n_g + n_lb;
  for (int it = blockIdx.x; it < total; it += gridDim.x) {
    int i = it;
    if (i < n_ada) { ph0_ada(p, i, smem); continue; }
    i -= n_ada;
    if (i < n_in) {
      int l = i / 1440, r = i % 1440, kt = r / 90, nt = r % 90;
      tconv_tile(p.w_in + (size_t)l * 1024 * 5648, 5648, (u16*)(p.ws + O_WTIN) + (size_t)l * NZ * 1024, 1024, kt * 64,
                 nt * 64, true, smem);
      continue;
    }
    i -= n_in;
    if (i < n_out) {
      int l = i / 384, r = i % 384, kt = r / 16, nt = r % 16;
      tconv_tile(p.w_out + (size_t)l * 1536 * 1024, 1024, (u16*)(p.ws + O_WTOUT) + (size_t)l * 1024 * 1536, 1536,
                 kt * 64, nt * 64, false, smem);
      continue;
    }
    i -= n_out;
    if (i < n_g) {
      int h = i & 7, gate = (i >> 3) & 1, dir = (i >> 4) & 1, l = i >> 5;
      const float* src = (gate ? p.rg_w_i : p.rg_w_r) + ((size_t)(l * 2 + dir) * 8 + h) * 4096;
      tconv_tile(src, 64, (u16*)(p.ws + O_WGT) + (size_t)i * 4096, 64, 0, 0, false, smem);
      continue;
    }
    i -= n_g;
    {
      int j = i * 256 + threadIdx.x;
      float v[4], mx = -1e30f;
      for (int l = 0; l < 4; ++l) { v[l] = p.hg_lb[l * 1024 + j]; mx = fmaxf(mx, v[l]); }
      float s = 0.f;
      for (int l = 0; l < 4; ++l) { v[l] = __expf(v[l] - mx); s += v[l]; }
      float* lbs = (float*)(p.ws + O_LBS);
      float cum = 0.f;
      for (int l = 0; l < 4; ++l) {
        if (l > 0) cum += v[l] / s;
        lbs[l * 1024 + j] = cum;
      }
    }
  }
}

DEV void phaseR(const P& p, int g, int l) {
  const int tid_ = opq(threadIdx.x); const int lane = tid_ & 63, w = tid_ >> 6;
  const float* mod = (const float*)(p.ws + O_MOD);
  float* hc = (float*)(p.ws + O_HC);
  const float* o = (const float*)(p.ws + O_BSH);
  u16* u = (u16*)(p.ws + O_BIT);
  for (int it = blockIdx.x; it < GR / 4; it += gridDim.x) {
    int lr = it * 4 + w;
    int lb = lr / TS, s = lr % TS;
    bool isctx = s < TCX;
    if (l == DEPTH && isctx) continue;
    int b = g * GB + lb, t = s - TCX;
    int mi = isctx ? 8 : b;
    float* hp = isctx ? hc + ((size_t)lb * TCX + s) * 1024 : p.out + ((size_t)b * TL + t) * 1024;
    float hv[16];
    if (l == 0) {
      const float* src = isctx ? p.ctx + ((size_t)b * TCX + s) * 1024 : p.x + ((size_t)b * TL + t) * 1024;
#pragma unroll
      for (int k = 0; k < 4; ++k) {
        float4 v = *(const float4*)(src + k * 256 + lane * 4);
        hv[k * 4] = v.x; hv[k * 4 + 1] = v.y; hv[k * 4 + 2] = v.z; hv[k * 4 + 3] = v.w;
      }
    } else {
      int orow = lb * TS + (isctx ? s : TCX + lat_map(l - 1, t));
      const float* op = o + (size_t)orow * 1024;
      float ov[16], ss = 0.f;
#pragma unroll
      for (int k = 0; k < 4; ++k) {
        float4 v = *(const float4*)(op + k * 256 + lane * 4);
        ov[k * 4] = v.x; ov[k * 4 + 1] = v.y; ov[k * 4 + 2] = v.z; ov[k * 4 + 3] = v.w;
        ss += v.x * v.x + v.y * v.y + v.z * v.z + v.w * v.w;
      }
#pragma unroll
      for (int off = 32; off; off >>= 1) ss += __shfl_xor(ss, off);
      float rinv = rsqrtf(ss * (1.f / 1024.f) + EPS);
      const float* gate = mod + ((size_t)(l - 1) * 9 + mi) * 3072 + 2048;
      const float* wp = p.norm_post + (l - 1) * 1024;
#pragma unroll
      for (int k = 0; k < 4; ++k) {
        float4 hh = *(const float4*)(hp + k * 256 + lane * 4);
        float4 gg = *(const float4*)(gate + k * 256 + lane * 4);
        float4 ww = *(const float4*)(wp + k * 256 + lane * 4);
        hv[k * 4] = hh.x + gg.x * (ov[k * 4] * rinv * ww.x);
        hv[k * 4 + 1] = hh.y + gg.y * (ov[k * 4 + 1] * rinv * ww.y);
        hv[k * 4 + 2] = hh.z + gg.z * (ov[k * 4 + 2] * rinv * ww.z);
        hv[k * 4 + 3] = hh.w + gg.w * (ov[k * 4 + 3] * rinv * ww.w);
      }
    }
#pragma unroll
    for (int k = 0; k < 4; ++k)
      *(float4*)(hp + k * 256 + lane * 4) = make_float4(hv[k * 4], hv[k * 4 + 1], hv[k * 4 + 2], hv[k * 4 + 3]);
    if (l < DEPTH) {
      float ss = 0.f;
#pragma unroll
      for (int k = 0; k < 16; ++k) ss += hv[k] * hv[k];
#pragma unroll
      for (int off = 32; off; off >>= 1) ss += __shfl_xor(ss, off);
      float rinv = rsqrtf(ss * (1.f / 1024.f) + EPS);
      const float* sh = mod + ((size_t)l * 9 + mi) * 3072;
      const float* wp = p.norm_pre + l * 1024;
      int urow = lb * TS + (isctx ? s : TCX + lat_map(l, t));
      u16* up = u + (size_t)urow * 1024;
#pragma unroll
      for (int k = 0; k < 4; ++k) {
        float4 ww = *(const float4*)(wp + k * 256 + lane * 4);
        float4 s0 = *(const float4*)(sh + k * 256 + lane * 4);
        float4 s1 = *(const float4*)(sh + 1024 + k * 256 + lane * 4);
        float a0 = hv[k * 4] * rinv * ww.x * (1.f + s1.x) + s0.x;
        float a1 = hv[k * 4 + 1] * rinv * ww.y * (1.f + s1.y) + s0.y;
        float a2 = hv[k * 4 + 2] * rinv * ww.z * (1.f + s1.z) + s0.z;
        float a3 = hv[k * 4 + 3] * rinv * ww.w * (1.f + s1.w) + s0.w;
        uint2 pk; pk.x = pk2(a0, a1); pk.y = pk2(a2, a3);
        *(uint2*)(up + k * 256 + lane * 4) = pk;
      }
    }
  }
}

template <int MODE>
DEV void gemm_tile(const u16* __restrict__ A, int lda, const u16* __restrict__ Bt, int K, int rt, int ct, u16* z,
                   u16* zT, float* ab, float* o, char* smem) {
  u16* As = (u16*)smem;
  u16* Bs = As + 128 * 64;
  const int tid = opq(threadIdx.x), lane = tid & 63, w = tid >> 6, wr = w >> 1, wc = w & 1, fr = lane & 15, fq = lane >> 4;
  const int lrow = tid >> 3, lseg = tid & 7;
  const int wsw = (lseg ^ ((lrow >> 1) & 7)) * 8;
  const int rsw = (fr >> 1) & 7;
  const u16* Ag = A + (size_t)(rt * 128 + lrow) * lda + lseg * 8;
  const u16* Bg = Bt + (size_t)(ct * 128 + lrow) * K + lseg * 8;
  uint4 pa0, pa1, pa2, pa3, pb0, pb1, pb2, pb3;
  uint4 qa0, qa1, qa2, qa3, qb0, qb1, qb2, qb3;
  f32x4 acc[4][4];
#pragma unroll
  for (int i = 0; i < 4; ++i)
#pragma unroll
    for (int j = 0; j < 4; ++j) acc[i][j] = (f32x4){0.f, 0.f, 0.f, 0.f};
  const int nk = K / 64;
#define GLD(S, kk)                                                            \
  {                                                                           \
    const int kc_ = ((kk) < nk ? (kk) : nk - 1) * 64;                         \
    S##a0 = *(const uint4*)(Ag + kc_);                                        \
    S##a1 = *(const uint4*)(Ag + kc_ + (size_t)32 * lda);                     \
    S##a2 = *(const uint4*)(Ag + kc_ + (size_t)64 * lda);                     \
    S##a3 = *(const uint4*)(Ag + kc_ + (size_t)96 * lda);                     \
    S##b0 = *(const uint4*)(Bg + kc_);                                        \
    S##b1 = *(const uint4*)(Bg + kc_ + (size_t)32 * K);                       \
    S##b2 = *(const uint4*)(Bg + kc_ + (size_t)64 * K);                       \
    S##b3 = *(const uint4*)(Bg + kc_ + (size_t)96 * K);                       \
  }
#define GST(S, bufo)                                                          \
  *(uint4*)(As + (bufo) + (lrow)*64 + wsw) = S##a0;                      \
  *(uint4*)(As + (bufo) + (lrow + 32) * 64 + wsw) = S##a1;               \
  *(uint4*)(As + (bufo) + (lrow + 64) * 64 + wsw) = S##a2;               \
  *(uint4*)(As + (bufo) + (lrow + 96) * 64 + wsw) = S##a3;               \
  *(uint4*)(Bs + (bufo) + (lrow)*64 + wsw) = S##b0;                      \
  *(uint4*)(Bs + (bufo) + (lrow + 32) * 64 + wsw) = S##b1;               \
  *(uint4*)(Bs + (bufo) + (lrow + 64) * 64 + wsw) = S##b2;               \
  *(uint4*)(Bs + (bufo) + (lrow + 96) * 64 + wsw) = S##b3;
#define GCOMP(cb)                                                                                           \
  _Pragma("unroll") for (int ks = 0; ks < 2; ++ks) {                                                        \
    bf16x8 af[4], bfr[4];                                                                                   \
    _Pragma("unroll") for (int mi = 0; mi < 4; ++mi)                                                        \
        af[mi] = ld8(As + (cb) + (wr * 64 + mi * 16 + fr) * 64 + (((ks * 4 + fq) ^ rsw) * 8));                         \
    _Pragma("unroll") for (int ni = 0; ni < 4; ++ni)                                                        \
        bfr[ni] = ld8(Bs + (cb) + (wc * 64 + ni * 16 + fr) * 64 + (((ks * 4 + fq) ^ rsw) * 8));                        \
    _Pragma("unroll") for (int mi = 0; mi < 4; ++mi)                                                        \
        _Pragma("unroll") for (int ni = 0; ni < 4; ++ni) acc[mi][ni] = mfma(af[mi], bfr[ni], acc[mi][ni]);  \
  }
  constexpr int BUF1 = 2 * 128 * 64;
  GLD(p, 0)
  GLD(q, 1)
  GST(p, 0)
  __syncthreads();
  GLD(p, 2)
  for (int kt = 0; kt < nk; kt += 2) {
    GCOMP(0)
    GST(q, BUF1)
    GLD(q, kt + 3)
    __syncthreads();
    GCOMP(BUF1)
    GST(p, 0)
    GLD(p, kt + 4)
    __syncthreads();
  }
#pragma unroll
  for (int mi = 0; mi < 4; ++mi)
#pragma unroll
    for (int ni = 0; ni < 4; ++ni) {
      int row0 = rt * 128 + wr * 64 + mi * 16 + fq * 4;
      int col = ct * 128 + wc * 64 + ni * 16 + fr;
      f32x4 v = acc[mi][ni];
      if (MODE == 1) {
#pragma unroll
        for (int r = 0; r < 4; ++r) o[(size_t)(row0 + r) * 1024 + col] = v[r];
      } else {
        if (ct >= 28 && ct < 32) {
          uint2 pk; pk.x = pk2(v[0], v[1]); pk.y = pk2(v[2], v[3]);
          *(uint2*)(zT + (size_t)(col - C_IC) * GR + row0) = pk;
        } else if (ct == 44) {
          if (col - C_AB < 16) {
#pragma unroll
            for (int r = 0; r < 4; ++r) ab[(size_t)(row0 + r) * 16 + (col - C_AB)] = v[r];
          }
        } else {
#pragma unroll
          for (int r = 0; r < 4; ++r) z[(size_t)(row0 + r) * NZ + col] = f2bf(v[r]);
        }
      }
    }
}

DEV void a_item(const P& p, int l, int item, int mode, char* smem) {
  float* xc = (float*)smem;
  u16* xcb = (u16*)(smem + 16384);
  float* av = (float*)(smem + 16384 + 9216);
  float* uv = av + 4096;
  float* segP = uv + 4096;
  float* segH = segP + 256;
  const int tid = opq(threadIdx.x), lane = tid & 63, w = tid >> 6, fr = lane & 15, fq = lane >> 4;
  const int cgk = item >> 3, hA = item & 7, n = cgk % 36, rb = cgk * 64;
  u16* z = (u16*)(p.ws + O_Z);
  {
    u16* xin = (u16*)av;
    uint4 st[3];
#pragma unroll
    for (int k = 0; k < 3; ++k) {
      int idx = tid + 256 * k, row = idx >> 3, sg = idx & 7, cp = row - 2;
      bool ok = (idx < 536) && !((cp < 0 && (n == 0 || n == 4)) || (cp > 63 && (n == 3 || n == 35)));
      st[k] = make_uint4(0u, 0u, 0u, 0u);
      if (ok) st[k] = *(const uint4*)(z + (size_t)(rb + cp) * NZ + C_XA + hA * 64 + sg * 8);
    }
    const int j = tid & 63, ch = hA * 64 + j;
    float cw0 = p.conv_a_w[(l * 4 + 0) * 512 + ch], cw1 = p.conv_a_w[(l * 4 + 1) * 512 + ch];
    float cw2 = p.conv_a_w[(l * 4 + 2) * 512 + ch], cw3 = p.conv_a_w[(l * 4 + 3) * 512 + ch];
    float cb = p.conv_a_b[l * 512 + ch];
#pragma unroll
    for (int k = 0; k < 3; ++k) {
      int idx = tid + 256 * k, row = idx >> 3, sg = idx & 7;
      if (idx < 536) *(uint4*)(xin + row * 72 + sg * 8) = st[k];
    }
    __syncthreads();
#pragma unroll
    for (int k = 0; k < 16; ++k) {
      int c = (tid >> 6) + 4 * k;
      float val = cb + cw0 * bf2f(xin[c * 72 + j]) + cw1 * bf2f(xin[(c + 1) * 72 + j]) + cw2 * bf2f(xin[(c + 2) * 72 + j]) +
                  cw3 * bf2f(xin[(c + 3) * 72 + j]);
      xc[c * 64 + j] = val;
      xcb[c * 72 + j] = f2bf(val);
    }
  }
  __syncthreads();
  float yacc[16];
#pragma unroll
  for (int k = 0; k < 16; ++k) yacc[k] = 0.f;
  const int seg = tid >> 6, sj = tid & 63, sch = hA * 64 + sj;
  for (int dir = 0; dir < 2; ++dir) {
    {
      const u16* wg = (const u16*)(p.ws + O_WGT);
      const u16* wr_ = wg + (size_t)((((l * 2 + dir) * 2 + 0) * 8 + hA)) * 4096;
      const u16* wi_ = wg + (size_t)((((l * 2 + dir) * 2 + 1) * 8 + hA)) * 4096;
      bf16x8 a0 = ld8(xcb + (16 * w + fr) * 72 + fq * 8), a1 = ld8(xcb + (16 * w + fr) * 72 + 32 + fq * 8);
#pragma unroll
      for (int nt = 0; nt < 4; ++nt) {
        f32x4 ar = {0.f, 0.f, 0.f, 0.f}, ai = {0.f, 0.f, 0.f, 0.f};
        const u16* br = wr_ + (nt * 16 + fr) * 64 + fq * 8;
        const u16* bi = wi_ + (nt * 16 + fr) * 64 + fq * 8;
        ar = mfma(a0, ld8(br), ar); ar = mfma(a1, ld8(br + 32), ar);
        ai = mfma(a0, ld8(bi), ai); ai = mfma(a1, ld8(bi + 32), ai);
        int j = nt * 16 + fr, ch = hA * 64 + j;
        float brv = p.rg_b_r[(l * 2 + dir) * 512 + ch], biv = p.rg_b_i[(l * 2 + dir) * 512 + ch];
        float sp = softplus(-p.rg_lam[(l * 2 + dir) * 512 + ch]);
#pragma unroll
        for (int r = 0; r < 4; ++r) {
          int c = 16 * w + 4 * fq + r;
          float rg = sigm(ar[r] + brv), ig = sigm(ai[r] + biv);
          float la = -8.f * rg * sp;
          float a = __expf(la);
          float t2 = 2.f * la;
          float om = (t2 > -0.02f) ? -t2 * (1.f + 0.5f * t2 * (1.f + t2 * (1.f / 3.f) * (1.f + 0.25f * t2))) : 1.f - a * a;
          float uu = sqrtf(fmaxf(om, 0.f)) * (ig * xc[c * 64 + j]);
          av[c * 64 + j] = bf2f(f2bf(la));
          uv[c * 64 + j] = bf2f(f2bf(uu));
        }
      }
    }
    __syncthreads();
    {
      float ls = 0.f, H = 0.f;
      u16* ALA = (u16*)(p.ws + O_ALA);
      u16* AU = (u16*)(p.ws + O_AU);
#pragma unroll
      for (int k = 0; k < 16; ++k) {
        int c = dir ? (16 * seg + 15 - k) : (16 * seg + k);
        float la_ = av[c * 64 + sj], u_ = uv[c * 64 + sj];
        H = __expf(la_) * H + u_;
        ls += la_;
        size_t gi = ((size_t)dir * GR + rb + c) * 512 + sch;
        ALA[gi] = f2bf(la_);
        AU[gi] = f2bf(u_);
      }
      segP[seg * 64 + sj] = __expf(ls);
      segH[seg * 64 + sj] = H;
    }
    __syncthreads();
    if (mode == 0) {
      if (seg == 0) {
        float Pc = 1.f, Hc = 0.f;
        for (int q = 0; q < 4; ++q) {
          int sg = dir ? 3 - q : q;
          Hc = segP[sg * 64 + sj] * Hc + segH[sg * 64 + sj];
          Pc *= segP[sg * 64 + sj];
        }
        size_t idx = ((size_t)cgk * 2 + dir) * 512 + sch;
        ((float*)(p.ws + O_AP))[idx] = Pc;
        ((float*)(p.ws + O_AH))[idx] = Hc;
      }
    } else {
      float st = ((const float*)(p.ws + O_ACAR))[((size_t)cgk * 2 + dir) * 512 + sch];
      int nbefore = dir ? 3 - seg : seg;
      for (int q = 0; q < nbefore; ++q) {
        int sg = dir ? 3 - q : q;
        st = segP[sg * 64 + sj] * st + segH[sg * 64 + sj];
      }
      if (dir == 0) {
#pragma unroll
        for (int k = 0; k < 16; ++k) {
          int c = 16 * seg + k;
          st = av[c * 64 + sj] * st + uv[c * 64 + sj];
          yacc[k] += st;
        }
      } else {
#pragma unroll
        for (int k = 15; k >= 0; --k) {
          int c = 16 * seg + k;
          st = av[c * 64 + sj] * st + uv[c * 64 + sj];
          yacc[k] += st;
        }
      }
    }
    __syncthreads();
  }
  if (mode == 1) {
#pragma unroll
    for (int k = 0; k < 16; ++k) {
      size_t zi = (size_t)(rb + 16 * seg + k) * NZ + C_GA + sch;
      float gate = bf2f(z[zi]);
      z[zi] = f2bf(yacc[k] * silu(gate));
    }
  }
}

DEV void a_fin(const P& p, int l, int item, char* smem) {
  float* segP = (float*)smem;
  float* segH = segP + 512;
  const int tid = opq(threadIdx.x), seg = tid >> 6, sj = tid & 63;
  const int cgk = item >> 3, hA = item & 7, rb = cgk * 64, sch = hA * 64 + sj;
  u16* z = (u16*)(p.ws + O_Z);
  const u16* ALA = (const u16*)(p.ws + O_ALA);
  const u16* AU = (const u16*)(p.ws + O_AU);
  u16 lab[2][16], ub[2][16], gt[16];
#pragma unroll
  for (int dir = 0; dir < 2; ++dir)
#pragma unroll
    for (int k = 0; k < 16; ++k) {
      size_t gi = ((size_t)dir * GR + rb + 16 * seg + k) * 512 + sch;
      lab[dir][k] = ALA[gi];
      ub[dir][k] = AU[gi];
    }
#pragma unroll
  for (int k = 0; k < 16; ++k) gt[k] = z[(size_t)(rb + 16 * seg + k) * NZ + C_GA + sch];
  float car0 = ((const float*)(p.ws + O_ACAR))[((size_t)cgk * 2 + 0) * 512 + sch];
  float car1 = ((const float*)(p.ws + O_ACAR))[((size_t)cgk * 2 + 1) * 512 + sch];
  float af[2][16];
#pragma unroll
  for (int dir = 0; dir < 2; ++dir) {
    float ls = 0.f, H = 0.f;
#pragma unroll
    for (int kk = 0; kk < 16; ++kk) {
      const int k = dir ? 15 - kk : kk;
      float la_ = bf2f(lab[dir][k]);
      float a = __expf(la_);
      af[dir][k] = a;
      H = a * H + bf2f(ub[dir][k]);
      ls += la_;
    }
    segP[(dir * 4 + seg) * 64 + sj] = __expf(ls);
    segH[(dir * 4 + seg) * 64 + sj] = H;
  }
  __syncthreads();
  float yacc[16];
#pragma unroll
  for (int k = 0; k < 16; ++k) yacc[k] = 0.f;
#pragma unroll
  for (int dir = 0; dir < 2; ++dir) {
    float st = dir ? car1 : car0;
    const int nbefore = dir ? 3 - seg : seg;
    for (int q = 0; q < nbefore; ++q) {
      int sg = dir ? 3 - q : q;
      st = segP[(dir * 4 + sg) * 64 + sj] * st + segH[(dir * 4 + sg) * 64 + sj];
    }
#pragma unroll
    for (int kk = 0; kk < 16; ++kk) {
      const int k = dir ? 15 - kk : kk;
      st = af[dir][k] * st + bf2f(ub[dir][k]);
      yacc[k] += st;
    }
  }
#pragma unroll
  for (int k = 0; k < 16; ++k)
    z[(size_t)(rb + 16 * seg + k) * NZ + C_GA + sch] = f2bf(yacc[k] * silu(bf2f(gt[k])));
  __syncthreads();
}

DEV void a_fin2(const P& p, int l, int item, char* smem) {
  float* segP = (float*)smem;
  float* segH = segP + 1024;
  const int tid = opq(threadIdx.x), sg = tid >> 5, cp = tid & 31;
  const int cgk = item >> 3, hA = item & 7, rb = cgk * 64, sch = hA * 64 + 2 * cp;
  u16* z = (u16*)(p.ws + O_Z);
  const u16* ALA = (const u16*)(p.ws + O_ALA);
  const u16* AU = (const u16*)(p.ws + O_AU);
  unsigned lab[2][8], ub[2][8], gt[8];
#pragma unroll
  for (int dir = 0; dir < 2; ++dir)
#pragma unroll
    for (int k = 0; k < 8; ++k) {
      size_t gi = ((size_t)dir * GR + rb + 8 * sg + k) * 512 + sch;
      lab[dir][k] = *(const unsigned*)(ALA + gi);
      ub[dir][k] = *(const unsigned*)(AU + gi);
    }
#pragma unroll
  for (int k = 0; k < 8; ++k) gt[k] = *(const unsigned*)(z + (size_t)(rb + 8 * sg + k) * NZ + C_GA + sch);
  const float2 car0 = *(const float2*)((const float*)(p.ws + O_ACAR) + ((size_t)cgk * 2 + 0) * 512 + sch);
  const float2 car1 = *(const float2*)((const float*)(p.ws + O_ACAR) + ((size_t)cgk * 2 + 1) * 512 + sch);
  float af[2][8][2];
#pragma unroll
  for (int dir = 0; dir < 2; ++dir) {
    float ls0 = 0.f, ls1 = 0.f, H0 = 0.f, H1 = 0.f;
#pragma unroll
    for (int kk = 0; kk < 8; ++kk) {
      const int k = dir ? 7 - kk : kk;
      float l0 = bf2f((u16)(lab[dir][k] & 0xffff)), l1 = bf2f((u16)(lab[dir][k] >> 16));
      float a0 = __expf(l0), a1 = __expf(l1);
      af[dir][k][0] = a0; af[dir][k][1] = a1;
      H0 = a0 * H0 + bf2f((u16)(ub[dir][k] & 0xffff));
      H1 = a1 * H1 + bf2f((u16)(ub[dir][k] >> 16));
      ls0 += l0; ls1 += l1;
    }
    *(float2*)(segP + (dir * 8 + sg) * 64 + 2 * cp) = make_float2(__expf(ls0), __expf(ls1));
    *(float2*)(segH + (dir * 8 + sg) * 64 + 2 * cp) = make_float2(H0, H1);
  }
  __syncthreads();
  float y0[8], y1[8];
#pragma unroll
  for (int k = 0; k < 8; ++k) { y0[k] = 0.f; y1[k] = 0.f; }
#pragma unroll
  for (int dir = 0; dir < 2; ++dir) {
    float s0 = dir ? car1.x : car0.x, s1 = dir ? car1.y : car0.y;
    const int nbefore = dir ? 7 - sg : sg;
    for (int q = 0; q < nbefore; ++q) {
      int sq = dir ? 7 - q : q;
      float2 pp = *(const float2*)(segP + (dir * 8 + sq) * 64 + 2 * cp);
      float2 hh = *(const float2*)(segH + (dir * 8 + sq) * 64 + 2 * cp);
      s0 = pp.x * s0 + hh.x;
      s1 = pp.y * s1 + hh.y;
    }
#pragma unroll
    for (int kk = 0; kk < 8; ++kk) {
      const int k = dir ? 7 - kk : kk;
      s0 = af[dir][k][0] * s0 + bf2f((u16)(ub[dir][k] & 0xffff));
      s1 = af[dir][k][1] * s1 + bf2f((u16)(ub[dir][k] >> 16));
      y0[k] += s0; y1[k] += s1;
    }
  }
#pragma unroll
  for (int k = 0; k < 8; ++k) {
    float g0 = bf2f((u16)(gt[k] & 0xffff)), g1 = bf2f((u16)(gt[k] >> 16));
    *(unsigned*)(z + (size_t)(rb + 8 * sg + k) * NZ + C_GA + sch) = pk2(y0[k] * silu(g0), y1[k] * silu(g1));
  }
  __syncthreads();
}

DEV void a_carry(const P& p, int item) {
  int t = item * 256 + threadIdx.x;
  int ch = t & 511, dir = (t >> 9) & 1, lb = t >> 10;
  const float* AP = (const float*)(p.ws + O_AP);
  const float* AH = (const float*)(p.ws + O_AH);
  float* AC = (float*)(p.ws + O_ACAR);
  float st = 0.f;
  float pv[36], hv[36];
#pragma unroll
  for (int j = 0; j < 36; ++j) {
    int n = dir ? (j < 4 ? 3 - j : 39 - j) : j;
    size_t idx = ((size_t)(lb * 36 + n) * 2 + dir) * 512 + ch;
    pv[j] = AP[idx];
    hv[j] = AH[idx];
  }
#pragma unroll
  for (int j = 0; j < 36; ++j) {
    int n = dir ? (j < 4 ? 3 - j : 39 - j) : j;
    size_t idx = ((size_t)(lb * 36 + n) * 2 + dir) * 512 + ch;
    AC[idx] = st;
    st = pv[j] * st + hv[j];
  }
}

DEV void b_local(const P& p, int l, int item, char* smem) {
  u16* qs = (u16*)smem;
  u16* ks = qs + 64 * 136;
  float* Am = (float*)(smem + 34816);
  float* gc = (float*)(smem + 34816 + 32768);
  float* bt = gc + 128;
  const int tid = opq(threadIdx.x), lane = tid & 63, w = tid >> 6, fr = lane & 15, fq = lane >> 4;
  const int cgk = item >> 2, h = item & 3, n = cgk % 36, rb = cgk * 64;
  const u16* z = (const u16*)(p.ws + O_Z);
  u16* qn = (u16*)(p.ws + O_BSH);
  u16* kn = qn + (size_t)GR * 512;
  u16* vb = kn + (size_t)GR * 512;
  u16* knT = vb + (size_t)GR * 512;
  const float* ab = (const float*)(p.ws + O_AB);
  {
    u16* Tt = (u16*)Am;
    uint4 st[5];
#define BL_TLOAD(which)                                                                                  \
  _Pragma("unroll") for (int k = 0; k < 5; ++k) {                                                        \
    int idx = tid + 256 * k, row = idx >> 4, seg = idx & 15, cp = row - 2;                               \
    bool ok = (idx < 1072) && !((cp < 0 && (n == 0 || n == 4)) || (cp > 63 && (n == 3 || n == 35)));    \
    st[k] = make_uint4(0u, 0u, 0u, 0u);                                                                  \
    if (ok) st[k] = *(const uint4*)(z + (size_t)(rb + cp) * NZ + C_Q + (which)*512 + h * 128 + seg * 8); \
  }
    BL_TLOAD(0)
#pragma unroll
    for (int which = 0; which < 3; ++which) {
#pragma unroll
      for (int k = 0; k < 5; ++k) {
        int idx = tid + 256 * k, row = idx >> 4, seg = idx & 15;
        if (idx < 1072) *(uint4*)(Tt + row * 136 + seg * 8) = st[k];
      }
      __syncthreads();
      if (which < 2) { BL_TLOAD(which + 1) }
      float cw[2][4];
#pragma unroll
      for (int hh = 0; hh < 2; ++hh)
#pragma unroll
        for (int tap = 0; tap < 4; ++tap)
          cw[hh][tap] = p.conv_b_w[(size_t)(l * 4 + tap) * 1536 + which * 512 + h * 128 + lane + 64 * hh];
#pragma unroll 4
      for (int c = w; c < 64; c += 4) {
        float v[2];
#pragma unroll
        for (int hh = 0; hh < 2; ++hh) {
          int d = lane + 64 * hh;
          float a = 0.f;
#pragma unroll
          for (int tap = 0; tap < 4; ++tap) a += cw[hh][tap] * bf2f(Tt[(c + tap) * 136 + d]);
          v[hh] = silu(a);
        }
        float rs = 1.f;
        if (which < 2) {
          float sq = v[0] * v[0] + v[1] * v[1];
#pragma unroll
          for (int off = 32; off; off >>= 1) sq += __shfl_xor(sq, off);
          rs = rsqrtf(sq + EPS) * (which == 0 ? 0.08838834764831845f : 1.f);
        }
#pragma unroll
        for (int hh = 0; hh < 2; ++hh) {
          int d = lane + 64 * hh;
          u16 ob = f2bf(v[hh] * rs);
          size_t gi = (size_t)(rb + c) * 512 + h * 128 + d;
          if (which == 0) { qs[c * 136 + d] = ob; qn[gi] = ob; }
          else if (which == 1) { ks[c * 136 + d] = ob; kn[gi] = ob; }
          else vb[gi] = ob;
        }
      }
      __syncthreads();
    }
  }
  if (w < 2) {
    int dir = w, i = lane, c = dir ? 63 - i : i;
    float al = ab[(size_t)(rb + c) * 16 + dir * 4 + h], bl = ab[(size_t)(rb + c) * 16 + 8 + dir * 4 + h];
    float g = -__expf(p.gdn_a_log[(l * 2 + dir) * 4 + h]) * softplus(al + p.gdn_dt_bias[(l * 2 + dir) * 4 + h]);
#pragma unroll
    for (int off = 1; off < 64; off <<= 1) {
      float v = __shfl_up(g, off);
      if (lane >= off) g += v;
    }
    gc[dir * 64 + i] = g;
    bt[dir * 64 + i] = sigm(bl);
  }
  __syncthreads();
  for (int idx = tid; idx < 1024; idx += 256) {
    int d = idx >> 3, c8 = idx & 7;
    uint4 pk;
    pk.x = (unsigned)ks[(c8 * 8 + 0) * 136 + d] | ((unsigned)ks[(c8 * 8 + 1) * 136 + d] << 16);
    pk.y = (unsigned)ks[(c8 * 8 + 2) * 136 + d] | ((unsigned)ks[(c8 * 8 + 3) * 136 + d] << 16);
    pk.z = (unsigned)ks[(c8 * 8 + 4) * 136 + d] | ((unsigned)ks[(c8 * 8 + 5) * 136 + d] << 16);
    pk.w = (unsigned)ks[(c8 * 8 + 6) * 136 + d] | ((unsigned)ks[(c8 * 8 + 7) * 136 + d] << 16);
    *(uint4*)(knT + ((size_t)(cgk * 4 + h) * 128 + d) * 64 + c8 * 8) = pk;
  }
  for (int dir = 0; dir < 2; ++dir) {
    char* rec = p.ws + O_BIT + ((size_t)(cgk * 4 + h) * 2 + dir) * BIT_SZ;
    u16* QKm = (u16*)rec + 4096;
    float* scal = (float*)(rec + 16384);
    int irow = 16 * w + fr, ci = dir ? 63 - irow : irow;
    bf16x8 ak[4], aq[4];
#pragma unroll
    for (int s = 0; s < 4; ++s) { ak[s] = ld8(ks + ci * 136 + 32 * s + 8 * fq); aq[s] = ld8(qs + ci * 136 + 32 * s + 8 * fq); }
#pragma unroll
    for (int nt = 0; nt < 4; ++nt) {
      int jcol = 16 * nt + fr, cj = dir ? 63 - jcol : jcol;
      f32x4 kk = {0.f, 0.f, 0.f, 0.f}, qk = {0.f, 0.f, 0.f, 0.f};
#pragma unroll
      for (int s = 0; s < 4; ++s) {
        bf16x8 b = ld8(ks + cj * 136 + 32 * s + 8 * fq);
        kk = mfma(ak[s], b, kk);
        qk = mfma(aq[s], b, qk);
      }
      float gj = gc[dir * 64 + jcol];
#pragma unroll
      for (int r = 0; r < 4; ++r) {
        int i = 16 * w + 4 * fq + r;
        float dec = (jcol <= i) ? __expf(gc[dir * 64 + i] - gj) : 0.f;
        Am[(dir * 64 + i) * 64 + jcol] = (jcol < i) ? bt[dir * 64 + i] * kk[r] * dec : 0.f;
        QKm[i * 64 + jcol] = f2bf(qk[r] * dec);
      }
    }
    if (tid < 64) {
      float gl = gc[dir * 64 + 63], gi = gc[dir * 64 + tid];
      scal[tid] = __expf(gi);
      scal[64 + tid] = bt[dir * 64 + tid];
      scal[128 + tid] = __expf(gl - gi);
      if (tid == 0) scal[192] = __expf(gl);
    }
  }
  __syncthreads();
  if (w < 2) {
    int dir = w, col = lane;
    u16* Tinv = (u16*)(p.ws + O_BIT + ((size_t)(cgk * 4 + h) * 2 + dir) * BIT_SZ);
    const float* Ad = Am + dir * 4096;
    float T[64];
#pragma unroll
    for (int i = 0; i < 64; ++i) {
      float s = (i == col) ? 1.f : 0.f;
#pragma unroll
      for (int j = 0; j < i; ++j) s -= Ad[i * 64 + j] * T[j];
      T[i] = s;
      Tinv[i * 64 + col] = f2bf(s);
      __builtin_amdgcn_sched_barrier(0);
    }
  }
  __syncthreads();
}

DEV void b_seq(const P& p, int bitem, char* smem) {
  const int tid = opq(threadIdx.x), lane = tid & 63, w = tid >> 6, fr = lane & 15, fq = lane >> 4;
  const bool active = w < WPB;
  const int item = bitem * WPB + (active ? w : 0);
  const int slice = item & 7, dir = (item >> 3) & 1, h = (item >> 4) & 3, lb = item >> 6, e0 = slice * 16;
  u16* Ss = (u16*)(smem + w * 11264);
  u16* Rs = Ss + 16 * 136;
  u16* Vsc = Rs + 16 * 72;
  u16* Vor = Vsc + 16 * 72;
  const u16* qn = (const u16*)(p.ws + O_BSH);
  const u16* kn = qn + (size_t)GR * 512;
  const u16* vb = kn + (size_t)GR * 512;
  const u16* knT = vb + (size_t)GR * 512;
  u16* OB = (u16*)(p.ws + O_OB);
  f32x4 S[8];
#pragma unroll
  for (int m = 0; m < 8; ++m) S[m] = (f32x4){0.f, 0.f, 0.f, 0.f};
  for (int j = 0; j < 36; ++j) {
    const int n = dir ? (j < 4 ? 3 - j : 39 - j) : j;
    const int cgk = lb * 36 + n, rb = cgk * 64;
    const char* rec = p.ws + O_BIT + ((size_t)(cgk * 4 + h) * 2 + dir) * BIT_SZ;
    const u16* Tinv = (const u16*)rec;
    const u16* QKm = Tinv + 4096;
    const float* scal = (const float*)(rec + 16384);
    if (active) {
#pragma unroll
      for (int m = 0; m < 8; ++m) {
        uint2 pk; pk.x = pk2(S[m][0], S[m][1]); pk.y = pk2(S[m][2], S[m][3]);
        *(uint2*)(Ss + fr * 136 + 16 * m + 4 * fq) = pk;
      }
    }
    __syncthreads();
    bf16x8 Sf[4];
    if (active) {
#pragma unroll
      for (int s = 0; s < 4; ++s) Sf[s] = ld8(Ss + fr * 136 + 32 * s + 8 * fq);
#pragma unroll
      for (int m = 0; m < 4; ++m) {
        int i = 16 * m + fr, rowi = rb + (dir ? 63 - i : i);
        f32x4 X = {0.f, 0.f, 0.f, 0.f};
#pragma unroll
        for (int s = 0; s < 4; ++s) X = mfma(ld8(kn + (size_t)rowi * 512 + h * 128 + 32 * s + 8 * fq), Sf[s], X);
        float rv[4];
#pragma unroll
        for (int r = 0; r < 4; ++r) {
          int ii = 16 * m + 4 * fq + r, rowr = rb + (dir ? 63 - ii : ii);
          float v = bf2f(vb[(size_t)rowr * 512 + h * 128 + e0 + fr]);
          rv[r] = scal[64 + ii] * (v - scal[ii] * X[r]);
        }
        uint2 pk; pk.x = pk2(rv[0], rv[1]); pk.y = pk2(rv[2], rv[3]);
        *(uint2*)(Rs + fr * 72 + 16 * m + 4 * fq) = pk;
      }
    }
    __syncthreads();
    if (active) {
      bf16x8 Rf0 = ld8(Rs + fr * 72 + 8 * fq), Rf1 = ld8(Rs + fr * 72 + 32 + 8 * fq);
#pragma unroll
      for (int m = 0; m < 4; ++m) {
        f32x4 VN = {0.f, 0.f, 0.f, 0.f};
        VN = mfma(ld8(Tinv + (16 * m + fr) * 64 + 8 * fq), Rf0, VN);
        VN = mfma(ld8(Tinv + (16 * m + fr) * 64 + 32 + 8 * fq), Rf1, VN);
        uint2 pk; pk.x = pk2(VN[0], VN[1]); pk.y = pk2(VN[2], VN[3]);
        *(uint2*)(Vsc + fr * 72 + 16 * m + 4 * fq) = pk;
        int ib = 16 * m + 4 * fq;
        float s0 = VN[0] * scal[128 + ib], s1 = VN[1] * scal[128 + ib + 1], s2 = VN[2] * scal[128 + ib + 2],
              s3 = VN[3] * scal[128 + ib + 3];
        if (dir) {
          pk.x = pk2(s3, s2); pk.y = pk2(s1, s0);
          *(uint2*)(Vor + fr * 72 + (60 - ib)) = pk;
        } else {
          pk.x = pk2(s0, s1); pk.y = pk2(s2, s3);
          *(uint2*)(Vor + fr * 72 + ib) = pk;
        }
      }
    }
    __syncthreads();
    if (active) {
      bf16x8 Vs0 = ld8(Vsc + fr * 72 + 8 * fq), Vs1 = ld8(Vsc + fr * 72 + 32 + 8 * fq);
      bf16x8 Vo0 = ld8(Vor + fr * 72 + 8 * fq), Vo1 = ld8(Vor + fr * 72 + 32 + 8 * fq);
#pragma unroll
      for (int m = 0; m < 4; ++m) {
        int i = 16 * m + fr, rowi = rb + (dir ? 63 - i : i);
        f32x4 O = {0.f, 0.f, 0.f, 0.f};
#pragma unroll
        for (int s = 0; s < 4; ++s) O = mfma(ld8(qn + (size_t)rowi * 512 + h * 128 + 32 * s + 8 * fq), Sf[s], O);
#pragma unroll
        for (int r = 0; r < 4; ++r) O[r] *= scal[16 * m + 4 * fq + r];
        O = mfma(ld8(QKm + (16 * m + fr) * 64 + 8 * fq), Vs0, O);
        O = mfma(ld8(QKm + (16 * m + fr) * 64 + 32 + 8 * fq), Vs1, O);
#pragma unroll
        for (int r = 0; r < 4; ++r) {
          int ii = 16 * m + 4 * fq + r, rowr = rb + (dir ? 63 - ii : ii);
          OB[((size_t)dir * GR + rowr) * 512 + h * 128 + e0 + fr] = f2bf(O[r]);
        }
      }
      float egl = scal[192];
#pragma unroll
      for (int m = 0; m < 8; ++m) {
        const u16* kt = knT + ((size_t)(cgk * 4 + h) * 128 + 16 * m + fr) * 64;
        f32x4 t = S[m];
#pragma unroll
        for (int r = 0; r < 4; ++r) t[r] *= egl;
        t = mfma(ld8(kt + 8 * fq), Vo0, t);
        t = mfma(ld8(kt + 32 + 8 * fq), Vo1, t);
        S[m] = t;
      }
    }
  }
  __syncthreads();
}

DEV void c_local(const P& p, int l, int item, char* smem) {
  float* bsm = (float*)smem;
  u16* Ps = (u16*)(smem + 33024);
  u16* kdt = (u16*)(smem + 33024 + 9216);
  const int tid = opq(threadIdx.x), lane = tid & 63, w = tid >> 6, fr = lane & 15, fq = lane >> 4;
  const int cgk = item >> 2, h = item & 3, rb = cgk * 64;
  const u16* z = (const u16*)(p.ws + O_Z);
  const u16* zT = (const u16*)(p.ws + O_ZT);
  u16* OC = (u16*)(p.ws + O_OC);
  const float* lbs = (const float*)(p.ws + O_LBS);
  for (int dir = 0; dir < 2; ++dir) {
    char* rec = p.ws + O_CREC + ((size_t)(cgk * 4 + h) * 2 + dir) * CREC_SZ;
    u16* QD = (u16*)rec;
    u16* KDT = QD + 8192;
    float* decv = (float*)(rec + 32768);
    const float* lbp = lbs + l * 1024 + dir * 512 + h * 128;
    const int fcol = C_F0 + dir * 512 + h * 128;
    {
      int d = tid & 127, half = tid >> 7;
      float lb_ = lbp[d], run = 0.f;
      for (int k = 0; k < 32; ++k) {
        int i = 32 * half + k, c = dir ? 63 - i : i;
        float f = bf2f(z[(size_t)(rb + c) * NZ + fcol + d]);
        float fg = lb_ + (1.f - lb_) * sigm(f);
        run += __logf(fg);
        bsm[i * 129 + d] = run;
      }
    }
    __syncthreads();
    {
      int d = tid & 127, half = tid >> 7;
      if (half) {
        float add = bsm[31 * 129 + d];
        for (int k = 0; k < 32; ++k) bsm[(32 + k) * 129 + d] += add;
      }
    }
    __syncthreads();
    for (int idx = tid; idx < 8192; idx += 256) {
      int i = idx >> 7, d = idx & 127, c = dir ? 63 - i : i;
      float b = bsm[i * 129 + d];
      float q = silu(bf2f(z[(size_t)(rb + c) * NZ + C_QC + h * 128 + d]));
      QD[i * 128 + d] = f2bf(q * __expf(b));
      float f = bf2f(z[(size_t)(rb + c) * NZ + fcol + d]);
      float k = (1.f - lbp[d]) * sigm(-f);
      kdt[d * 72 + c] = f2bf(k * __expf(bsm[63 * 129 + d] - b));
    }
    if (tid < 128) decv[tid] = __expf(bsm[63 * 129 + tid]);
    __syncthreads();
    for (int idx = tid; idx < 1024; idx += 256) {
      int d = idx >> 3, c8 = idx & 7;
      *(uint4*)(KDT + d * 64 + c8 * 8) = *(const uint4*)(kdt + d * 72 + c8 * 8);
    }
    {
      const int sj = w;
      for (int si = 0; si < 4; ++si) {
        f32x4 acc = {0.f, 0.f, 0.f, 0.f};
        if (si >= sj) {
          int it = 16 * si + fr, jt = 16 * sj + fr;
          int ci = dir ? 63 - it : it, cj = dir ? 63 - jt : jt;
#pragma unroll
          for (int s = 0; s < 4; ++s) {
            int d0 = 32 * s + 8 * fq;
            bf16x8 qv = ld8(z + (size_t)(rb + ci) * NZ + C_QC + h * 128 + d0);
            bf16x8 fv = ld8(z + (size_t)(rb + cj) * NZ + fcol + d0);
            bf16x8 af, bf;
#pragma unroll
            for (int e = 0; e < 8; ++e) {
              int d = d0 + e;
              float Bs_ = si ? bsm[(16 * si - 1) * 129 + d] : 0.f;
              float qq = silu(bf2f((u16)qv[e])) * __expf(bsm[it * 129 + d] - Bs_);
              float kk = (1.f - lbp[d]) * sigm(-bf2f((u16)fv[e])) * __expf(Bs_ - bsm[jt * 129 + d]);
              af[e] = (short)f2bf(qq);
              bf[e] = (short)f2bf(kk);
            }
            acc = mfma(af, bf, acc);
          }
        }
#pragma unroll
        for (int r = 0; r < 4; ++r) {
          int i = 16 * si + 4 * fq + r, jj = 16 * sj + fr;
          float v = (si >= sj && jj <= i) ? acc[r] : 0.f;
          Ps[i * 72 + (dir ? 63 - jj : jj)] = f2bf(v);
        }
        __builtin_amdgcn_sched_barrier(0);
      }
    }
    __syncthreads();
#pragma unroll
    for (int nt2 = 0; nt2 < 2; ++nt2) {
      int e = h * 128 + (2 * w + nt2) * 16 + fr;
      bf16x8 v0 = ld8(zT + (size_t)e * GR + rb + 8 * fq), v1 = ld8(zT + (size_t)e * GR + rb + 32 + 8 * fq);
#pragma unroll
      for (int m = 0; m < 4; ++m) {
        f32x4 O = {0.f, 0.f, 0.f, 0.f};
        O = mfma(ld8(Ps + (16 * m + fr) * 72 + 8 * fq), v0, O);
        O = mfma(ld8(Ps + (16 * m + fr) * 72 + 32 + 8 * fq), v1, O);
#pragma unroll
        for (int r = 0; r < 4; ++r) {
          int ii = 16 * m + 4 * fq + r, rowr = rb + (dir ? 63 - ii : ii);
          OC[((size_t)dir * GR + rowr) * 512 + e] = f2bf(O[r]);
        }
      }
    }
    __syncthreads();
  }
}

DEV void c_seq(const P& p, int bitem, char* smem) {
  const int tid = opq(threadIdx.x), lane = tid & 63, w = tid >> 6, fr = lane & 15, fq = lane >> 4;
  const bool active = w < WPB;
  const int item = bitem * WPB + (active ? w : 0);
  const int slice = item & 7, dir = (item >> 3) & 1, h = (item >> 4) & 3, lb = item >> 6, e0 = slice * 16;
  u16* Ss = (u16*)(smem + w * 4352);
  const u16* zT = (const u16*)(p.ws + O_ZT);
  u16* OC = (u16*)(p.ws + O_OC);
  f32x4 S[8];
#pragma unroll
  for (int m = 0; m < 8; ++m) S[m] = (f32x4){0.f, 0.f, 0.f, 0.f};
  for (int j = 0; j < 36; ++j) {
    const int n = dir ? (j < 4 ? 3 - j : 39 - j) : j;
    const int cgk = lb * 36 + n, rb = cgk * 64;
    const char* rec = p.ws + O_CREC + ((size_t)(cgk * 4 + h) * 2 + dir) * CREC_SZ;
    const u16* QD = (const u16*)rec;
    const u16* KDT = QD + 8192;
    const float* decv = (const float*)(rec + 32768);
    if (active) {
#pragma unroll
      for (int m = 0; m < 8; ++m) {
        uint2 pk; pk.x = pk2(S[m][0], S[m][1]); pk.y = pk2(S[m][2], S[m][3]);
        *(uint2*)(Ss + fr * 136 + 16 * m + 4 * fq) = pk;
      }
    }
    __syncthreads();
    if (active) {
      bf16x8 Sf[4];
#pragma unroll
      for (int s = 0; s < 4; ++s) Sf[s] = ld8(Ss + fr * 136 + 32 * s + 8 * fq);
#pragma unroll
      for (int m = 0; m < 4; ++m) {
        f32x4 O = {0.f, 0.f, 0.f, 0.f};
#pragma unroll
        for (int s = 0; s < 4; ++s) O = mfma(ld8(QD + (16 * m + fr) * 128 + 32 * s + 8 * fq), Sf[s], O);
#pragma unroll
        for (int r = 0; r < 4; ++r) {
          int ii = 16 * m + 4 * fq + r, rowr = rb + (dir ? 63 - ii : ii);
          size_t oi = ((size_t)dir * GR + rowr) * 512 + h * 128 + e0 + fr;
          OC[oi] = f2bf(bf2f(OC[oi]) + O[r]);
        }
      }
      const u16* vp = zT + (size_t)(h * 128 + e0 + fr) * GR + rb;
      bf16x8 V0 = ld8(vp + 8 * fq), V1 = ld8(vp + 32 + 8 * fq);
#pragma unroll
      for (int m = 0; m < 8; ++m) {
        f32x4 t = S[m];
#pragma unroll
        for (int r = 0; r < 4; ++r) t[r] *= decv[16 * m + 4 * fq + r];
        t = mfma(ld8(KDT + (16 * m + fr) * 64 + 8 * fq), V0, t);
        t = mfma(ld8(KDT + (16 * m + fr) * 64 + 32 + 8 * fq), V1, t);
        S[m] = t;
      }
    }
    __syncthreads();
  }
}

#define LBAR()                                              \
  do {                                                      \
    asm volatile("s_waitcnt lgkmcnt(0)" ::: "memory");      \
    __builtin_amdgcn_s_barrier();                           \
    asm volatile("" ::: "memory");                          \
  } while (0)
#define CBAR() asm volatile("" ::: "memory")

DEV void c_local2(const P& p, int l, int item, char* smem) {
  float* bsm = (float*)smem;
  u16* Fq = (u16*)(smem + 33024);
  u16* kdt = (u16*)(smem + 50432);
  u16* Ps = kdt;
  const int tid = opq(threadIdx.x), lane = tid & 63, w = tid >> 6, fr = lane & 15, fq = lane >> 4;
  const int cgk = item >> 2, h = item & 3, rb = cgk * 64;
  const u16* z = (const u16*)(p.ws + O_Z);
  const u16* zT = (const u16*)(p.ws + O_ZT);
  u16* OC = (u16*)(p.ws + O_OC);
  const float* lbs = (const float*)(p.ws + O_LBS);
  u16* zq = (u16*)(p.ws + O_Z) + (size_t)rb * NZ + C_QC + h * 128;
  {
    uint4 t4[4];
#pragma unroll
    for (int k = 0; k < 4; ++k) {
      int idx = tid + 256 * k, c = idx >> 4, seg = idx & 15;
      t4[k] = *(const uint4*)(zq + (size_t)c * NZ + seg * 8);
    }
#pragma unroll
    for (int k = 0; k < 4; ++k) {
      int idx = tid + 256 * k, c = idx >> 4, seg = idx & 15;
      unsigned wv[4] = {t4[k].x, t4[k].y, t4[k].z, t4[k].w};
#pragma unroll
      for (int q = 0; q < 4; ++q)
        wv[q] = pk2(silu(bf2f((u16)(wv[q] & 0xffff))), silu(bf2f((u16)(wv[q] >> 16))));
      *(uint4*)(zq + (size_t)c * NZ + seg * 8) = make_uint4(wv[0], wv[1], wv[2], wv[3]);
    }
  }
  __syncthreads();
  for (int dir = 0; dir < 2; ++dir) {
    char* rec = p.ws + O_CREC + ((size_t)(cgk * 4 + h) * 2 + dir) * CREC_SZ;
    u16* QD = (u16*)rec;
    u16* KDT = QD + 8192;
    float* decv = (float*)(rec + 32768);
    const float* lbp = lbs + l * 1024 + dir * 512 + h * 128;
    const int fcol = C_F0 + dir * 512 + h * 128;
    {
      uint4 t4[4];
#pragma unroll
      for (int k = 0; k < 4; ++k) {
        int idx = tid + 256 * k, c = idx >> 4, seg = idx & 15;
        t4[k] = *(const uint4*)(z + (size_t)(rb + c) * NZ + fcol + seg * 8);
      }
#pragma unroll
      for (int k = 0; k < 4; ++k) {
        int idx = tid + 256 * k, c = idx >> 4, seg = idx & 15;
        *(uint4*)(Fq + c * 136 + seg * 8) = t4[k];
      }
    }
    __syncthreads();
    {
      int d = tid & 127, half = tid >> 7;
      float lb_ = lbp[d], run = 0.f;
#pragma unroll 8
      for (int k = 0; k < 32; ++k) {
        int i = 32 * half + k, c = dir ? 63 - i : i;
        float f = bf2f(Fq[c * 136 + d]);
        float fg = lb_ + (1.f - lb_) * sigm(f);
        run += __logf(fg);
        bsm[i * 129 + d] = run;
      }
    }
    __syncthreads();
    {
      int d = tid & 127, half = tid >> 7;
      if (half) {
        float add = bsm[31 * 129 + d];
#pragma unroll 8
        for (int k = 0; k < 32; ++k) bsm[(32 + k) * 129 + d] += add;
      }
    }
    __syncthreads();
    {
      uint4 qv[4];
#pragma unroll
      for (int k = 0; k < 4; ++k) {
        int idx = tid + 256 * k, c = idx >> 4, seg = idx & 15;
        qv[k] = *(const uint4*)(zq + (size_t)c * NZ + seg * 8);
      }
#pragma unroll
      for (int k = 0; k < 4; ++k) {
        int idx = tid + 256 * k, c = idx >> 4, seg = idx & 15, i = dir ? 63 - c : c, d0 = seg * 8;
        unsigned qw[4] = {qv[k].x, qv[k].y, qv[k].z, qv[k].w};
        uint4 fv4 = *(const uint4*)(Fq + c * 136 + d0);
        unsigned fw[4] = {fv4.x, fv4.y, fv4.z, fv4.w};
        unsigned qo[4], ko[4];
#pragma unroll
        for (int q = 0; q < 4; ++q) {
          int d = d0 + 2 * q;
          float b0 = bsm[i * 129 + d], b1 = bsm[i * 129 + d + 1];
          float bl0 = bsm[63 * 129 + d], bl1 = bsm[63 * 129 + d + 1];
          float q0 = bf2f((u16)(qw[q] & 0xffff)), q1 = bf2f((u16)(qw[q] >> 16));
          qo[q] = pk2(q0 * __expf(b0), q1 * __expf(b1));
          float k0 = (1.f - lbp[d]) * sigm(-bf2f((u16)(fw[q] & 0xffff)));
          float k1 = (1.f - lbp[d + 1]) * sigm(-bf2f((u16)(fw[q] >> 16)));
          ko[q] = pk2(k0, k1);
          kdt[d * 72 + c] = f2bf(k0 * __expf(bl0 - b0));
          kdt[(d + 1) * 72 + c] = f2bf(k1 * __expf(bl1 - b1));
        }
        *(uint4*)(QD + i * 128 + d0) = make_uint4(qo[0], qo[1], qo[2], qo[3]);
        *(uint4*)(Fq + c * 136 + d0) = make_uint4(ko[0], ko[1], ko[2], ko[3]);
      }
      if (tid < 128) decv[tid] = __expf(bsm[63 * 129 + tid]);
    }
    __syncthreads();
    for (int idx = tid; idx < 1024; idx += 256) {
      int d = idx >> 3, c8 = idx & 7;
      *(uint4*)(KDT + d * 64 + c8 * 8) = *(const uint4*)(kdt + d * 72 + c8 * 8);
    }
    bf16x8 qf[3][4];
#pragma unroll
    for (int t = 0; t < 3; ++t) {
      int k = w + 4 * t;
      int si = k < 4 ? 3 : (k < 7 ? 2 : (k < 9 ? 1 : 0));
      int it_ = 16 * si + fr, ci_ = dir ? 63 - it_ : it_;
#pragma unroll
      for (int s = 0; s < 4; ++s) qf[t][s] = ld8(zq + (size_t)ci_ * NZ + 32 * s + 8 * fq);
    }
    __syncthreads();
    for (int idx = tid; idx < 1536; idx += 256) {
      int tl = idx >> 8, e = idx & 255, r16 = e >> 4, c16 = e & 15;
      int si = tl < 3 ? 0 : (tl < 5 ? 1 : 2);
      int sj = tl < 3 ? tl + 1 : (tl < 5 ? tl - 1 : 3);
      int jj = 16 * sj + c16;
      Ps[(16 * si + r16) * 72 + (dir ? 63 - jj : jj)] = 0;
    }
#pragma unroll
    for (int t = 0; t < 3; ++t) {
      const int k = w + 4 * t;
      if (k < 10) {
        const int si = k < 4 ? 3 : (k < 7 ? 2 : (k < 9 ? 1 : 0));
        const int sj = k - (k < 4 ? 0 : (k < 7 ? 4 : (k < 9 ? 7 : 9)));
        const int it = 16 * si + fr, jt = 16 * sj + fr, cj = dir ? 63 - jt : jt;
        const int brow = si ? (16 * si - 1) : 0;
        const float bmul = si ? 1.f : 0.f;
        f32x4 acc = {0.f, 0.f, 0.f, 0.f};
#pragma unroll
        for (int s = 0; s < 4; ++s) {
          int d0 = 32 * s + 8 * fq;
          bf16x8 fv = ld8(Fq + cj * 136 + d0);
          bf16x8 af, bf;
#pragma unroll
          for (int e = 0; e < 8; ++e) {
            int d = d0 + e;
            float Bs_ = bmul * bsm[brow * 129 + d];
            float qq = bf2f((u16)qf[t][s][e]) * __expf(bsm[it * 129 + d] - Bs_);
            float kk = bf2f((u16)fv[e]) * __expf(Bs_ - bsm[jt * 129 + d]);
            af[e] = (short)f2bf(qq);
            bf[e] = (short)f2bf(kk);
          }
          acc = mfma(af, bf, acc);
          __builtin_amdgcn_sched_barrier(0);
        }
#pragma unroll
        for (int r = 0; r < 4; ++r) {
          int i = 16 * si + 4 * fq + r, jj = 16 * sj + fr;
          float v = (jj <= i) ? acc[r] : 0.f;
          Ps[i * 72 + (dir ? 63 - jj : jj)] = f2bf(v);
        }
      }
    }
    __syncthreads();
#pragma unroll
    for (int nt2 = 0; nt2 < 2; ++nt2) {
      int e = h * 128 + (2 * w + nt2) * 16 + fr;
      bf16x8 v0 = ld8(zT + (size_t)e * GR + rb + 8 * fq), v1 = ld8(zT + (size_t)e * GR + rb + 32 + 8 * fq);
#pragma unroll
      for (int m = 0; m < 4; ++m) {
        f32x4 O = {0.f, 0.f, 0.f, 0.f};
        O = mfma(ld8(Ps + (16 * m + fr) * 72 + 8 * fq), v0, O);
        O = mfma(ld8(Ps + (16 * m + fr) * 72 + 32 + 8 * fq), v1, O);
#pragma unroll
        for (int r = 0; r < 4; ++r) {
          int ii = 16 * m + 4 * fq + r, rowr = rb + (dir ? 63 - ii : ii);
          OC[((size_t)dir * GR + rowr) * 512 + e] = f2bf(O[r]);
        }
      }
    }
    __syncthreads();
  }
}

#define LBAR()                                              \
  do {                                                      \
    asm volatile("s_waitcnt lgkmcnt(0)" ::: "memory");      \
    __builtin_amdgcn_s_barrier();                           \
    asm volatile("" ::: "memory");                          \
  } while (0)
#define CBAR() asm volatile("" ::: "memory")
#define BS_CHUNK(jj) (dir ? ((jj) < 4 ? 3 - (jj) : 39 - (jj)) : (jj))
DEV bf16x8 ldo8(const char* base, unsigned off) { return *reinterpret_cast<const bf16x8*>(base + off); }
DEV void b_seq2(const P& p, int bitem, char* smem) {
  const int tid = opq(threadIdx.x), lane = tid & 63, w = tid >> 6, fr = lane & 15, fq = lane >> 4;
  const int es = bitem & 3, dir = (bitem >> 2) & 1, h = (bitem >> 3) & 3, lb = bitem >> 5, e0 = es * 32;
  u16* Ss = (u16*)smem;
  u16* Rs = Ss + 32 * 136;
  u16* Vsc = Rs + 32 * 72;
  u16* Vor = Vsc + 32 * 72;
  const char* qnB = p.ws + O_BSH + (size_t)h * 256;
  const char* knB = qnB + BSH_ONE;
  const char* vbB = knB + BSH_ONE + (size_t)e0 * 2;
  const char* ktB = p.ws + O_BSH + 3 * BSH_ONE + (size_t)h * 16384;
  const char* recB = p.ws + O_BIT + ((size_t)h * 2 + dir) * BIT_SZ;
  char* obB = p.ws + O_OB + ((size_t)dir * GR * 512 + h * 128 + e0) * 2;
  const int mrow = 16 * w + fr, crow0 = 16 * w + 4 * fq;
  const unsigned offA = (unsigned)((dir ? 63 - mrow : mrow) * 1024 + 16 * fq);
  unsigned offR[4];
#pragma unroll
  for (int r = 0; r < 4; ++r) offR[r] = (unsigned)((dir ? 63 - (crow0 + r) : (crow0 + r)) * 1024 + fr * 2);
  const unsigned offT = (unsigned)(mrow * 128 + 16 * fq);
  const unsigned offK = (unsigned)((32 * w + fr) * 128 + 16 * fq);
  const unsigned offS = (unsigned)(16384 + crow0 * 4);
  f32x4 S[2][2];
#pragma unroll
  for (int a = 0; a < 2; ++a)
#pragma unroll
    for (int b = 0; b < 2; ++b) S[a][b] = (f32x4){0.f, 0.f, 0.f, 0.f};
  bf16x8 Akn[4], Aqn[4], At[2][2], Aqk[2][2], AkT[2][2][2];
  u16 vbv[2][4];
  float4 eg4, be4, ek4[2];
  float egl[2];
#define BS_LOAD1(cg_)                                                              \
  {                                                                                \
    const size_t ro_ = (size_t)(cg_) * 65536;                                      \
    _Pragma("unroll") for (int s = 0; s < 4; ++s) {                                \
      Akn[s] = ldo8(knB + ro_, offA + 64 * s);                                     \
      Aqn[s] = ldo8(qnB + ro_, offA + 64 * s);                                     \
    }                                                                              \
    _Pragma("unroll") for (int r = 0; r < 4; ++r) {                                \
      vbv[0][r] = *(const u16*)(vbB + ro_ + offR[r]);                              \
      vbv[1][r] = *(const u16*)(vbB + ro_ + (offR[r] + 32));                       \
    }                                                                              \
    const char* rc_ = recB + (size_t)(cg_) * (8 * BIT_SZ);                         \
    eg4 = *(const float4*)(rc_ + offS);                                            \
    be4 = *(const float4*)(rc_ + (offS + 256));                                    \
  }
#define BS_LOAD2(cg_, SS)                                                          \
  {                                                                                \
    const char* rc_ = recB + (size_t)(cg_) * (8 * BIT_SZ);                         \
    At[SS][0] = ldo8(rc_, offT); At[SS][1] = ldo8(rc_, offT + 64);                 \
    ek4[SS] = *(const float4*)(rc_ + (offS + 512));                                \
  }
#define BS_LOAD3(cg_, SS)                                                          \
  {                                                                                \
    const char* rc_ = recB + (size_t)(cg_) * (8 * BIT_SZ);                         \
    Aqk[SS][0] = ldo8(rc_, offT + 8192); Aqk[SS][1] = ldo8(rc_, offT + 8192 + 64); \
    egl[SS] = *(const float*)(rc_ + 16384 + 768);                                  \
    const char* kt_ = ktB + (size_t)(cg_) * 65536;                                 \
    AkT[SS][0][0] = ldo8(kt_, offK); AkT[SS][0][1] = ldo8(kt_, offK + 64);         \
    AkT[SS][1][0] = ldo8(kt_, offK + 2048); AkT[SS][1][1] = ldo8(kt_, offK + 2048 + 64); \
  }
  {
    const int c0 = lb * 36 + BS_CHUNK(0);
    BS_LOAD1(c0) BS_LOAD2(c0, 0) BS_LOAD3(c0, 0)
  }
  for (int j2 = 0; j2 < 36; j2 += 2)
#pragma unroll
  for (int u = 0; u < 2; ++u) {
    const int j = j2 + u;
    const int cgk = lb * 36 + BS_CHUNK(j);
    const int jn = (j + 1 < 36) ? j + 1 : j;
    const int cgn = lb * 36 + BS_CHUNK(jn);
    BS_LOAD2(cgn, u ^ 1)
    BS_LOAD3(cgn, u ^ 1)
#pragma unroll
    for (int mm = 0; mm < 2; ++mm)
#pragma unroll
      for (int nt = 0; nt < 2; ++nt) {
        uint2 pk; pk.x = pk2(S[mm][nt][0], S[mm][nt][1]); pk.y = pk2(S[mm][nt][2], S[mm][nt][3]);
        *(uint2*)(Ss + (16 * nt + fr) * 136 + 32 * w + 16 * mm + 4 * fq) = pk;
      }
    LBAR();
    f32x4 QS[2];
    {
      bf16x8 Sf[2][4];
#pragma unroll
      for (int nt = 0; nt < 2; ++nt)
#pragma unroll
        for (int s = 0; s < 4; ++s) Sf[nt][s] = ld8(Ss + (16 * nt + fr) * 136 + 32 * s + 8 * fq);
#pragma unroll
      for (int nt = 0; nt < 2; ++nt) {
        f32x4 X = {0.f, 0.f, 0.f, 0.f}, Q = {0.f, 0.f, 0.f, 0.f};
#pragma unroll
        for (int s = 0; s < 4; ++s) { X = mfma(Akn[s], Sf[nt][s], X); Q = mfma(Aqn[s], Sf[nt][s], Q); }
        float r0 = be4.x * (bf2f(vbv[nt][0]) - eg4.x * X[0]);
        float r1 = be4.y * (bf2f(vbv[nt][1]) - eg4.y * X[1]);
        float r2 = be4.z * (bf2f(vbv[nt][2]) - eg4.z * X[2]);
        float r3 = be4.w * (bf2f(vbv[nt][3]) - eg4.w * X[3]);
        uint2 pk; pk.x = pk2(r0, r1); pk.y = pk2(r2, r3);
        *(uint2*)(Rs + (16 * nt + fr) * 72 + crow0) = pk;
        Q[0] *= eg4.x; Q[1] *= eg4.y; Q[2] *= eg4.z; Q[3] *= eg4.w;
        QS[nt] = Q;
      }
    }
    CBAR();
    BS_LOAD1(cgn)
    LBAR();
    {
#pragma unroll
      for (int nt = 0; nt < 2; ++nt) {
        bf16x8 Rf0 = ld8(Rs + (16 * nt + fr) * 72 + 8 * fq), Rf1 = ld8(Rs + (16 * nt + fr) * 72 + 32 + 8 * fq);
        f32x4 VN = {0.f, 0.f, 0.f, 0.f};
        VN = mfma(At[u][0], Rf0, VN);
        VN = mfma(At[u][1], Rf1, VN);
        uint2 pk; pk.x = pk2(VN[0], VN[1]); pk.y = pk2(VN[2], VN[3]);
        *(uint2*)(Vsc + (16 * nt + fr) * 72 + crow0) = pk;
        float s0 = VN[0] * ek4[u].x, s1 = VN[1] * ek4[u].y, s2 = VN[2] * ek4[u].z, s3 = VN[3] * ek4[u].w;
        if (dir) {
          pk.x = pk2(s3, s2); pk.y = pk2(s1, s0);
          *(uint2*)(Vor + (16 * nt + fr) * 72 + (60 - crow0)) = pk;
        } else {
          pk.x = pk2(s0, s1); pk.y = pk2(s2, s3);
          *(uint2*)(Vor + (16 * nt + fr) * 72 + crow0) = pk;
        }
      }
    }
    LBAR();
    {
      char* ob_ = obB + (size_t)cgk * 65536;
#pragma unroll
      for (int nt = 0; nt < 2; ++nt) {
        bf16x8 Vs0 = ld8(Vsc + (16 * nt + fr) * 72 + 8 * fq), Vs1 = ld8(Vsc + (16 * nt + fr) * 72 + 32 + 8 * fq);
        bf16x8 Vo0 = ld8(Vor + (16 * nt + fr) * 72 + 8 * fq), Vo1 = ld8(Vor + (16 * nt + fr) * 72 + 32 + 8 * fq);
        f32x4 O = QS[nt];
        O = mfma(Aqk[u][0], Vs0, O);
        O = mfma(Aqk[u][1], Vs1, O);
#pragma unroll
        for (int r = 0; r < 4; ++r) *(u16*)(ob_ + (offR[r] + 32 * nt)) = f2bf(O[r]);
#pragma unroll
        for (int mm = 0; mm < 2; ++mm) {
          f32x4 t = S[mm][nt];
#pragma unroll
          for (int r = 0; r < 4; ++r) t[r] *= egl[u];
          t = mfma(AkT[u][mm][0], Vo0, t);
          t = mfma(AkT[u][mm][1], Vo1, t);
          S[mm][nt] = t;
        }
      }
    }
  }
  LBAR();
}

DEV void c_seq2(const P& p, int bitem, char* smem) {
  const int tid = opq(threadIdx.x), lane = tid & 63, w = tid >> 6, fr = lane & 15, fq = lane >> 4;
  const int es = bitem & 3, dir = (bitem >> 2) & 1, h = (bitem >> 3) & 3, lb = bitem >> 5, e0 = es * 32;
  u16* Ssb = (u16*)smem;
  const char* recB = p.ws + O_CREC + ((size_t)h * 2 + dir) * CREC_SZ;
  const char* ztB = p.ws + O_ZT + (size_t)(h * 128 + e0) * GR * 2;
  char* ocB = p.ws + O_OC + ((size_t)dir * GR * 512 + h * 128 + e0) * 2;
  const int mrow = 16 * w + fr, crow0 = 16 * w + 4 * fq;
  const unsigned offQ = (unsigned)(mrow * 256 + 16 * fq);
  const unsigned offK = (unsigned)(16384 + (32 * w + fr) * 128 + 16 * fq);
  const unsigned offD = (unsigned)(32768 + (32 * w + 4 * fq) * 4);
  const unsigned offV = (unsigned)(fr * GR * 2 + 16 * fq);
  unsigned offR[4];
#pragma unroll
  for (int r = 0; r < 4; ++r) offR[r] = (unsigned)((dir ? 63 - (crow0 + r) : (crow0 + r)) * 1024 + fr * 2);
  f32x4 S[2][2];
#pragma unroll
  for (int a = 0; a < 2; ++a)
#pragma unroll
    for (int b = 0; b < 2; ++b) S[a][b] = (f32x4){0.f, 0.f, 0.f, 0.f};
  bf16x8 Aqd[4], Akd[2][2], Vf[2][2];
  u16 oi[2][4];
  float4 dec4[2];
#define CS_LOAD(cg_)                                                                    \
  {                                                                                     \
    const char* rc_ = recB + (size_t)(cg_) * (8 * CREC_SZ);                             \
    _Pragma("unroll") for (int s = 0; s < 4; ++s) Aqd[s] = ldo8(rc_, offQ + 64 * s);    \
    Akd[0][0] = ldo8(rc_, offK); Akd[0][1] = ldo8(rc_, offK + 64);                      \
    Akd[1][0] = ldo8(rc_, offK + 2048); Akd[1][1] = ldo8(rc_, offK + 2048 + 64);        \
    dec4[0] = *(const float4*)(rc_ + offD);                                             \
    dec4[1] = *(const float4*)(rc_ + (offD + 64));                                      \
    const char* zt_ = ztB + (size_t)(cg_) * 128;                                        \
    Vf[0][0] = ldo8(zt_, offV); Vf[0][1] = ldo8(zt_, offV + 64);                        \
    Vf[1][0] = ldo8(zt_, offV + 16 * GR * 2); Vf[1][1] = ldo8(zt_, offV + 16 * GR * 2 + 64); \
    const char* oc_ = ocB + (size_t)(cg_) * 65536;                                      \
    _Pragma("unroll") for (int r = 0; r < 4; ++r) {                                     \
      oi[0][r] = *(const u16*)(oc_ + offR[r]);                                          \
      oi[1][r] = *(const u16*)(oc_ + (offR[r] + 32));                                   \
    }                                                                                   \
  }
  {
    const int c0 = lb * 36 + BS_CHUNK(0);
    CS_LOAD(c0)
  }
  for (int j = 0; j < 36; ++j) {
    const int cgk = lb * 36 + BS_CHUNK(j);
    const int jn = (j + 1 < 36) ? j + 1 : j;
    const int cgn = lb * 36 + BS_CHUNK(jn);
    u16* Ss = Ssb + (j & 1) * (32 * 136);
#pragma unroll
    for (int mm = 0; mm < 2; ++mm)
#pragma unroll
      for (int nt = 0; nt < 2; ++nt) {
        uint2 pk; pk.x = pk2(S[mm][nt][0], S[mm][nt][1]); pk.y = pk2(S[mm][nt][2], S[mm][nt][3]);
        *(uint2*)(Ss + (16 * nt + fr) * 136 + 32 * w + 16 * mm + 4 * fq) = pk;
      }
    LBAR();
    char* oc_ = ocB + (size_t)cgk * 65536;
#pragma unroll
    for (int nt = 0; nt < 2; ++nt) {
      f32x4 O = {0.f, 0.f, 0.f, 0.f};
#pragma unroll
      for (int s = 0; s < 4; ++s) O = mfma(Aqd[s], ld8(Ss + (16 * nt + fr) * 136 + 32 * s + 8 * fq), O);
#pragma unroll
      for (int r = 0; r < 4; ++r) *(u16*)(oc_ + (offR[r] + 32 * nt)) = f2bf(bf2f(oi[nt][r]) + O[r]);
#pragma unroll
      for (int mm = 0; mm < 2; ++mm) {
        f32x4 t = S[mm][nt];
        t[0] *= dec4[mm].x; t[1] *= dec4[mm].y; t[2] *= dec4[mm].z; t[3] *= dec4[mm].w;
        t = mfma(Akd[mm][0], Vf[nt][0], t);
        t = mfma(Akd[mm][1], Vf[nt][1], t);
        S[mm][nt] = t;
      }
    }
    CBAR();
    CS_LOAD(cgn)
  }
  LBAR();
}

DEV void bc_merge_row(const P& p, int l, int lr, int lane);
DEV void bc_merge(const P& p, int l, int it) {
  const int tid_ = opq(threadIdx.x); const int lane = tid_ & 63, w = tid_ >> 6;
#pragma unroll
  for (int rr = 0; rr < 2; ++rr) bc_merge_row(p, l, it * 8 + w * 2 + rr, lane);
}
DEV void bc_merge_row(const P& p, int l, int lr, int lane) {
  int mix = lane >> 5, cm = (lane * 16) & 511;
  const u16* O = (const u16*)(p.ws + (mix ? O_OC : O_OB));
  u16* z = (u16*)(p.ws + O_Z);
  float ov[16], ss = 0.f;
#pragma unroll
  for (int k2 = 0; k2 < 2; ++k2) {
    uint4 a = *(const uint4*)(O + (size_t)lr * 512 + cm + 8 * k2);
    uint4 b = *(const uint4*)(O + ((size_t)GR + lr) * 512 + cm + 8 * k2);
    unsigned aa[4] = {a.x, a.y, a.z, a.w}, bb[4] = {b.x, b.y, b.z, b.w};
#pragma unroll
    for (int q = 0; q < 4; ++q) {
      float v0 = bf2f((u16)(aa[q] & 0xffff)) + bf2f((u16)(bb[q] & 0xffff));
      float v1 = bf2f((u16)(aa[q] >> 16)) + bf2f((u16)(bb[q] >> 16));
      ov[k2 * 8 + q * 2] = v0; ov[k2 * 8 + q * 2 + 1] = v1;
      ss += v0 * v0 + v1 * v1;
    }
  }
  ss += __shfl_xor(ss, 1); ss += __shfl_xor(ss, 2); ss += __shfl_xor(ss, 4);
  float rinv = rsqrtf(ss * (1.f / 128.f) + EPS);
  const float* nw = (mix ? p.hg_norm : p.gdn_norm) + l * 128 + (cm & 127);
  u16* gp = z + (size_t)lr * NZ + (mix ? C_GC : C_GB) + cm;
#pragma unroll
  for (int k2 = 0; k2 < 2; ++k2) {
    uint4 gv = *(const uint4*)(gp + 8 * k2);
    unsigned gg[4] = {gv.x, gv.y, gv.z, gv.w}, oo[4];
#pragma unroll
    for (int q = 0; q < 4; ++q) {
      int e = k2 * 8 + q * 2;
      float y0 = ov[e] * rinv * nw[e] * silu(bf2f((u16)(gg[q] & 0xffff)));
      float y1 = ov[e + 1] * rinv * nw[e + 1] * silu(bf2f((u16)(gg[q] >> 16)));
      oo[q] = pk2(y0, y1);
    }
    *(uint4*)(gp + 8 * k2) = make_uint4(oo[0], oo[1], oo[2], oo[3]);
  }
}

#define XB_TMO      128
#define XB_XCNT(j)  (256  + 64 * (j))
#define XB_XSUB(j)  (1280 + 64 * (j))
#define XB_XGEN(j)  (2304 + 64 * (j))
#define XB_TOP      3328
#define XB_TOPGEN   3392
#define XCD_BAR_WORDS 3456
#define XB_SPIN_CAP (1u << 18)
#define LAS __attribute__((address_space(3)))

__device__ __forceinline__ unsigned xb_ld(unsigned* p)              { return __hip_atomic_load(p, __ATOMIC_RELAXED, __HIP_MEMORY_SCOPE_AGENT); }
__device__ __forceinline__ unsigned xb_add(unsigned* p, unsigned v) { return __hip_atomic_fetch_add(p, v, __ATOMIC_RELAXED, __HIP_MEMORY_SCOPE_AGENT); }
__device__ __forceinline__ unsigned xb_xcc_id() { return (unsigned)__builtin_amdgcn_s_getreg((3 << 11) | 20) & 0xFu; }
#define XB_SPIN(cond, bar) do { unsigned _sp = 0; while (cond) { __builtin_amdgcn_s_sleep(1); \
    if ((++_sp & 255u) == 0u) { if (xb_ld(&(bar)[XB_TMO])) break; if (_sp > XB_SPIN_CAP) { atomicAdd(&(bar)[XB_TMO], 1u); break; } } } } while (0)

struct XcdBarrier {
    unsigned* bar; unsigned x;
    volatile LAS unsigned* st;
};

__device__ __forceinline__ XcdBarrier xcd_barrier_post(unsigned* bar, volatile LAS unsigned* st) {
    XcdBarrier b; b.bar = bar; b.x = xb_xcc_id(); b.st = st;
    if (threadIdx.x == 0) (void)xb_add(&bar[XB_XCNT(b.x)], 1u);
    return b;
}
__device__ __forceinline__ void xcd_barrier_complete(unsigned* bar, unsigned x, unsigned& nloc, unsigned& nx) {
    const unsigned G = gridDim.x * gridDim.y * gridDim.z;
    unsigned sum, cnt, mine, sp = 0u;
    for (;;) {
        sum = 0u; cnt = 0u; mine = 0u;
#pragma unroll
        for (unsigned j = 0; j < 16; ++j) { const unsigned c = xb_ld(&bar[XB_XCNT(j)]); sum += c; cnt += (c > 0u) ? 1u : 0u; mine = (j == x) ? c : mine; }
        if (sum == G) break;
        __builtin_amdgcn_s_sleep(1);
        if ((++sp & 255u) == 0u) { if (xb_ld(&bar[XB_TMO])) break; if (sp > XB_SPIN_CAP) { atomicAdd(&bar[XB_TMO], 1u); break; } }
    }
    nloc = mine > 0u ? mine : 1u; nx = cnt > 0u ? cnt : 1u;
}

__device__ __forceinline__ void xcd_barrier(const XcdBarrier& b) {
    asm volatile("s_waitcnt vmcnt(0)" ::: "memory");
    __syncthreads();
    if (threadIdx.x == 0) {
        unsigned* bar = b.bar;
        __builtin_amdgcn_s_waitcnt(0);
        unsigned nloc = b.st[0], nx = b.st[1];
        if (nloc == 0u) { xcd_barrier_complete(bar, b.x, nloc, nx); b.st[0] = nloc; b.st[1] = nx; }
        const unsigned old = xb_add(&bar[XB_XSUB(b.x)], 1u);
        const unsigned gen = old / nloc;
        if (old + 1u == (gen + 1u) * nloc) {
            __builtin_amdgcn_fence(__ATOMIC_RELEASE, "agent");
            asm volatile("s_waitcnt vmcnt(0)" ::: "memory");
            const unsigned og = xb_add(&bar[XB_TOP], 1u);
            const unsigned tg = og / nx;
            if (og + 1u == (tg + 1u) * nx) xb_add(&bar[XB_TOPGEN], 1u);
            else XB_SPIN(xb_ld(&bar[XB_TOPGEN]) == tg, bar);
            __builtin_amdgcn_fence(__ATOMIC_ACQUIRE, "agent");
            xb_add(&bar[XB_XGEN(b.x)], 1u);
            asm volatile("s_waitcnt vmcnt(0)" ::: "memory");
        } else {
            XB_SPIN(xb_ld(&bar[XB_XGEN(b.x)]) == gen, bar);
            __builtin_amdgcn_fence(__ATOMIC_ACQUIRE, "agent");
            asm volatile("s_waitcnt vmcnt(0)" ::: "memory");
        }
    }
    __syncthreads();
}


#ifdef NO_G0
#define XG0(x)
#else
#define XG0(x) x
#endif
#ifdef NO_G1
#define XG1(x)
#else
#define XG1(x) x
#endif
#ifdef NO_BC
#define XBC(x)
#else
#define XBC(x) x
#endif
#ifdef NO_AC
#define XAC(x)
#else
#define XAC(x) x
#endif
#ifdef NO_P0
#define XP0(x)
#else
#define XP0(x) x
#endif
#ifdef NO_R
#define XR(x)
#else
#define XR(x) x
#endif
#ifdef NO_BL
#define XBL(x)
#else
#define XBL(x) x
#endif
#ifdef NO_CL
#define XCL(x)
#else
#define XCL(x) x
#endif
#ifdef NO_A0
#define XA0(x)
#else
#define XA0(x) x
#endif
#ifdef NO_A1
#define XA1(x)
#else
#define XA1(x) x
#endif
#ifdef NO_BS
#define XBS(x)
#else
#define XBS(x) x
#endif
#ifdef NO_CS
#define XCS(x)
#else
#define XCS(x) x
#endif
__global__ void __launch_bounds__(256, 2) fwd_mega(P p) {
  extern __shared__ __attribute__((aligned(16))) char smem[];
  cg::grid_group grid = cg::this_grid();
  const int G = gridDim.x;
  __shared__ uint4 xb_words;
  if (threadIdx.x == 0) xb_words = make_uint4(0u, 0u, 0u, 0u);
  __syncthreads();
  XcdBarrier xb = xcd_barrier_post((unsigned*)(p.ws + O_BAR), (volatile LAS unsigned*)&xb_words);
  XP0(phase0(p, smem));
  if (p.ws == nullptr) grid.sync();
  xcd_barrier(xb);
  u16* z = (u16*)(p.ws + O_Z);
  u16* zT = (u16*)(p.ws + O_ZT);
  float* ab = (float*)(p.ws + O_AB);
  float* o = (float*)(p.ws + O_BSH);
  const u16* u = (const u16*)(p.ws + O_BIT);
  for (int g = 0; g < NG; ++g) {
    XR(phaseR(p, g, 0));
    xcd_barrier(xb);
    for (int l = 0; l < DEPTH; ++l) {
      for (int rep = 0; rep < REP_G; ++rep) {
        const u16* Bt = (const u16*)(p.ws + O_WTIN) + (size_t)l * NZ * 1024;
        if ((G & 7) == 0) {
          const int x = blockIdx.x & 7, bl = blockIdx.x >> 3, nbl = G >> 3;
          for (int q = bl; q < 9 * 45; q += nbl) { XG0(gemm_tile<0>(u, 1024, Bt, 1024, 9 * x + q % 9, q / 9, z, zT, ab, o, smem)); }
        } else {
          for (int t = blockIdx.x; t < 72 * 45; t += G) { XG0(gemm_tile<0>(u, 1024, Bt, 1024, t % 72, t / 72, z, zT, ab, o, smem)); }
        }
      }
      xcd_barrier(xb);
      for (int rep2 = 0; rep2 < REP_M; ++rep2) {
      for (int rep3 = 0; rep3 < REP_A; ++rep3) {
        if (rep3) xcd_barrier(xb);
        const int nb = NCH * 4, nc = NCH * 4, na = NCH * 8;
        if (G == 512) {
          const int bx = blockIdx.x;
          XCL(c_local2(p, l, bx, smem));
          if (bx < 64) { XCL(c_local2(p, l, 512 + bx, smem)); }
          XBL(b_local(p, l, bx, smem));
          if (bx >= 64 && bx < 128) { XBL(b_local(p, l, 448 + bx, smem)); }
          if (bx < 128) { XA0(a_item(p, l, bx, 0, smem)); }
          else {
            for (int t = 128 + (bx - 128); t < na; t += 384) { XA0(a_item(p, l, t, 0, smem)); }
          }
        } else {
          for (int t = blockIdx.x; t < nb + nc + na; t += G) {
            if (t < nc) { XCL(c_local2(p, l, t, smem)); }
            else if (t < nb + nc) { XBL(b_local(p, l, t - nc, smem)); }
            else { XA0(a_item(p, l, t - nb - nc, 0, smem)); }
          }
        }
      }
      xcd_barrier(xb);
      {
        for (int t = blockIdx.x; t < 256 + 16; t += G) {
          if (t < 128) { XBS(b_seq2(p, t, smem)); }
          else if (t < 256) { XCS(c_seq2(p, t - 128, smem)); }
          else { XAC(a_carry(p, t - 256)); }
        }
      }
      xcd_barrier(xb);
      }
      {
        const int na = NCH * 8, nm = GR / 8;
        for (int t = blockIdx.x; t < na + nm; t += G) {
          if (t < na) { XA1(a_fin2(p, l, t, smem)); }
          else { XBC(bc_merge(p, l, t - na)); }
        }
      }
      xcd_barrier(xb);
      for (int rep = 0; rep < REP_G; ++rep) {
        const u16* Bt = (const u16*)(p.ws + O_WTOUT) + (size_t)l * 1024 * 1536;
        if (l == DEPTH - 1) {
          for (int t = blockIdx.x; t < 64 * 8; t += G) {
            const int q = t % 64, rt = (q >> 4) * 18 + 2 + (q & 15);
            XG1(gemm_tile<1>(z + C_GA, NZ, Bt, 1536, rt, t / 64, z, zT, ab, o, smem));
          }
        } else {
          for (int t = blockIdx.x; t < 72 * 8; t += G) { XG1(gemm_tile<1>(z + C_GA, NZ, Bt, 1536, t % 72, t / 72, z, zT, ab, o, smem)); }
        }
      }
      xcd_barrier(xb);
      XR(phaseR(p, g, l + 1));
      if (l + 1 < DEPTH) xcd_barrier(xb);
    }
  }
}

extern "C" void kernel_launch(void* const* d_in, const int* in_sizes, int n_in, void* d_out, int out_size, void* d_ws,
                              size_t ws_size, hipStream_t stream) {
  static int grid_blocks = 0;
  if (!grid_blocks) {
    int dev = 0, cus = 0, per_cu = 0;
    hipGetDevice(&dev);
    hipDeviceGetAttribute(&cus, hipDeviceAttributeMultiprocessorCount, dev);
    hipFuncSetAttribute((const void*)fwd_mega, hipFuncAttributeMaxDynamicSharedMemorySize, LDS_BYTES);
    hipOccupancyMaxActiveBlocksPerMultiprocessor(&per_cu, fwd_mega, 256, LDS_BYTES);
    if (per_cu > 2) per_cu = 2;
    if (per_cu < 1) per_cu = 1;
    grid_blocks = cus * per_cu;
  }
  if (ws_size < WS_TOTAL) {
    fprintf(stderr, "workspace too small: %zu < %zu\n", ws_size, (size_t)WS_TOTAL);
    return;
  }
  P p{};
  const float** f = (const float**)&p;
  for (int i = 0; i < 23; ++i) f[i] = (const float*)d_in[i];
  p.out = (float*)d_out;
  p.ws = (char*)d_ws;
  hipMemsetAsync((char*)d_ws + O_BAR, 0, XCD_BAR_WORDS * 4, stream);
  void* args[] = {&p};
  hipError_t e = hipLaunchCooperativeKernel((void*)fwd_mega, dim3(grid_blocks), dim3(256), args, LDS_BYTES, stream);
  if (e != hipSuccess) fprintf(stderr, "cooperative launch failed: %s (grid %d)\n", hipGetErrorString(e), grid_blocks);
}
```

```cpp
#include <hip/hip_runtime.h>
#include <hip/hip_cooperative_groups.h>
#include <cstdio>
namespace cg = cooperative_groups;

typedef __attribute__((ext_vector_type(8))) short bf16x8;
typedef __attribute__((ext_vector_type(4))) float f32x4;
typedef unsigned short u16;
#define DEV __device__ __forceinline__

constexpr int DM = 1024, TL = 2048, TCX = 256, TS = 2304, GB = 4, GR = GB * TS, NG = 2;
constexpr int NZ = 5760, DEPTH = 4;
constexpr int C_XA = 0, C_Q = 512, C_K = 1024, C_V = 1536, C_QC = 2048, C_F0 = 2560, C_IC = 3584,
              C_GA = 4096, C_GB = 4608, C_GC = 5120, C_AB = 5632;
constexpr int NCH = GR / 64;
constexpr float EPS = 1e-6f;
constexpr int WPB = 2;

constexpr size_t al256(size_t x) { return (x + 255) & ~(size_t)255; }
constexpr size_t O_WTIN = 0;
constexpr size_t O_WTOUT = O_WTIN + al256((size_t)DEPTH * NZ * 1024 * 2);
constexpr size_t O_WGT = O_WTOUT + al256((size_t)DEPTH * 1024 * 1536 * 2);
constexpr size_t O_MOD = O_WGT + al256((size_t)DEPTH * 2 * 2 * 8 * 4096 * 2);
constexpr size_t O_LBS = O_MOD + al256((size_t)DEPTH * 9 * 3072 * 4);
constexpr size_t O_HC = O_LBS + al256((size_t)DEPTH * 1024 * 4);
constexpr size_t O_Z = O_HC + al256((size_t)GB * TCX * 1024 * 4);
constexpr size_t O_ZT = O_Z + al256((size_t)GR * NZ * 2);
constexpr size_t O_AB = O_ZT + al256((size_t)512 * GR * 2);
constexpr size_t O_BSH = O_AB + al256((size_t)GR * 16 * 4);
constexpr size_t BSH_ONE = (size_t)GR * 512 * 2;
constexpr size_t O_BIT = O_BSH + al256(4 * BSH_ONE);
constexpr size_t BIT_SZ = 17408;
constexpr size_t O_CREC = O_BIT + al256((size_t)NCH * 4 * 2 * BIT_SZ);
constexpr size_t CREC_SZ = 33280;
constexpr size_t O_OB = O_CREC + al256((size_t)NCH * 4 * 2 * CREC_SZ);
constexpr size_t O_OC = O_OB + al256((size_t)2 * GR * 512 * 2);
constexpr size_t O_AP = O_OC + al256((size_t)2 * GR * 512 * 2);
constexpr size_t O_AH = O_AP + al256((size_t)NCH * 2 * 512 * 4);
constexpr size_t O_ACAR = O_AH + al256((size_t)NCH * 2 * 512 * 4);
constexpr size_t O_ALA = O_ACAR + al256((size_t)NCH * 2 * 512 * 4);
constexpr size_t O_AU = O_ALA + al256((size_t)2 * GR * 512 * 2);
constexpr size_t O_BAR = O_AU + al256((size_t)2 * GR * 512 * 2);
constexpr size_t WS_TOTAL = O_BAR + al256(3456 * 4);

constexpr int LDS_BYTES = 73728;
#ifndef REP_A
#define REP_A 1
#endif
#ifndef REP_G
#define REP_G 1
#endif
#ifndef REP_M
#define REP_M 1
#endif

struct P {
  const float *x, *c, *ctx, *c_ctx, *w_ada, *b_ada, *norm_pre, *norm_post, *w_in, *conv_a_w, *conv_a_b, *rg_w_r,
      *rg_b_r, *rg_w_i, *rg_b_i, *rg_lam, *conv_b_w, *gdn_a_log, *gdn_dt_bias, *gdn_norm, *hg_lb, *hg_norm, *w_out;
  float* out;
  char* ws;
};

DEV int opq(int x) { asm volatile("" : "+v"(x)); return x; }
DEV int opqs(int x) { asm volatile("" : "+s"(x)); return x; }
typedef __attribute__((ext_vector_type(2))) __bf16 bf16x2_t;
typedef __attribute__((ext_vector_type(2))) float f32x2_t;
DEV u16 f2bf(float f) { __bf16 r = (__bf16)f; return __builtin_bit_cast(u16, r); }
DEV float bf2f(u16 h) { return __uint_as_float(((unsigned)h) << 16); }
DEV unsigned pk2(float a, float b) { f32x2_t v = {a, b}; bf16x2_t r = __builtin_convertvector(v, bf16x2_t); return __builtin_bit_cast(unsigned, r); }
DEV float sigm(float x) { return __builtin_amdgcn_rcpf(1.f + __expf(-x)); }
DEV float silu(float x) { return x * __builtin_amdgcn_rcpf(1.f + __expf(-x)); }
DEV float softplus(float x) { return x > 20.f ? x : log1pf(__expf(x)); }
DEV f32x4 mfma(bf16x8 a, bf16x8 b, f32x4 c) { return __builtin_amdgcn_mfma_f32_16x16x32_bf16(a, b, c, 0, 0, 0); }
DEV bf16x8 ld8(const u16* p) { return *reinterpret_cast<const bf16x8*>(p); }
DEV int lat_map(int l, int t) { return (l & 1) ? ((t & 63) * 32 + (t >> 6)) : t; }
DEV int orig_col(int n) {
  if (n < 512) return n;
  if (n < 2048) return n + 512;
  if (n < 4096) return n + 1040;
  if (n < 4608) return n - 4096 + 512;
  if (n < 5120) return n - 4608 + 2576;
  if (n < 5632) return n + 16;
  if (n < 5648) return n - 5632 + 2560;
  return -1;
}
DEV float zval(const u16* z, int rb, int cp, int n, int col) {
  if (cp < 0 && (n == 0 || n == 4)) return 0.f;
  if (cp > 63 && (n == 3 || n == 35)) return 0.f;
  return bf2f(z[(size_t)(rb + cp) * NZ + col]);
}

DEV void ph0_ada(const P& p, int item, char* smem) {
  float* sc = (float*)smem;
  float* red = (float*)(smem + 36864);
  const int tid = threadIdx.x, lane = tid & 63, wv = tid >> 6;
  for (int i = tid; i < 9 * 1024; i += 256) {
    int v = i >> 10, d = i & 1023;
    float cv = (v < 8) ? p.c[v * 1024 + d] : p.c_ctx[d];
    sc[i] = silu(cv);
  }
  __syncthreads();
  const int col = item * 64 + lane;
  const int l = col / 3072, e = col % 3072;
  const float* w = p.w_ada + (size_t)l * 1024 * 3072 + e + (size_t)(256 * wv) * 3072;
  const float* scw = sc + 256 * wv;
  float acc[9];
#pragma unroll
  for (int i = 0; i < 9; ++i) acc[i] = 0.f;
  for (int d = 0; d < 256; d += 16) {
    float wr[16];
#pragma unroll
    for (int k = 0; k < 16; ++k) wr[k] = w[(size_t)(d + k) * 3072];
#pragma unroll
    for (int k = 0; k < 16; ++k)
#pragma unroll
      for (int i = 0; i < 9; ++i) acc[i] += scw[i * 1024 + d + k] * wr[k];
  }
#pragma unroll
  for (int i = 0; i < 9; ++i) red[(wv * 9 + i) * 64 + lane] = acc[i];
  __syncthreads();
  float* mod = (float*)(p.ws + O_MOD);
  for (int idx = tid; idx < 9 * 64; idx += 256) {
    int i = idx >> 6, ln = idx & 63;
    float sum = red[(0 * 9 + i) * 64 + ln] + red[(1 * 9 + i) * 64 + ln] + red[(2 * 9 + i) * 64 + ln] + red[(3 * 9 + i) * 64 + ln];
    int cc = item * 64 + ln, l2 = cc / 3072, e2 = cc % 3072;
    mod[((size_t)l2 * 9 + i) * 3072 + e2] = sum + p.b_ada[l2 * 3072 + e2];
  }
  __syncthreads();
}
DEV void tconv_tile(const float* src, int lds_, u16* dst, int ldd, int k0, int n0, bool mapcol, char* smem) {
  float* t = (float*)smem;
  const int tid = threadIdx.x, nn = tid & 63, kq = tid >> 6;
  const int n = n0 + nn;
  const int sn0 = mapcol ? orig_col(n) : n;
  const float msk = (sn0 >= 0) ? 1.f : 0.f;
  const int sn = sn0 >= 0 ? sn0 : 0;
  float v[16];
#pragma unroll
  for (int k = 0; k < 16; ++k) v[k] = src[(size_t)(k0 + kq + 4 * k) * lds_ + sn];
#pragma unroll
  for (int k = 0; k < 16; ++k) t[(kq + 4 * k) * 65 + nn] = v[k] * msk;
  __syncthreads();
  {
    const int kk = tid & 63, nq = tid >> 6;
#pragma unroll
    for (int k = 0; k < 16; ++k) {
      int n2 = nq + 4 * k;
      dst[(size_t)(n0 + n2) * ldd + k0 + kk] = f2bf(t[kk * 65 + n2]);
    }
  }
  __syncthreads();
}
DEV void phase0(const P& p, char* smem) {
  const int n_ada = 192, n_in = DEPTH * 16 * 90, n_out = DEPTH * 24 * 16, n_g = 128, n_lb = 4;
  const int total = n_ada + n_in + n_out + n_g + n_lb;
  for (int it = blockIdx.x; it < total; it += gridDim.x) {
    int i = it;
    if (i < n_ada) { ph0_ada(p, i, smem); continue; }
    i -= n_ada;
    if (i < n_in) {
      int l = i / 1440, r = i % 1440, kt = r / 90, nt = r % 90;
      tconv_tile(p.w_in + (size_t)l * 1024 * 5648, 5648, (u16*)(p.ws + O_WTIN) + (size_t)l * NZ * 1024, 1024, kt * 64,
                 nt * 64, true, smem);
      continue;
    }
    i -= n_in;
    if (i < n_out) {
      int l = i / 384, r = i % 384, kt = r / 16, nt = r % 16;
      tconv_tile(p.w_out + (size_t)l * 1536 * 1024, 1024, (u16*)(p.ws + O_WTOUT) + (size_t)l * 1024 * 1536, 1536,
                 kt * 64, nt * 64, false, smem);
      continue;
    }
    i -= n_out;
    if (i < n_g) {
      int h = i & 7, gate = (i >> 3) & 1, dir = (i >> 4) & 1, l = i >> 5;
      const float* src = (gate ? p.rg_w_i : p.rg_w_r) + ((size_t)(l * 2 + dir) * 8 + h) * 4096;
      tconv_tile(src, 64, (u16*)(p.ws + O_WGT) + (size_t)i * 4096, 64, 0, 0, false, smem);
      continue;
    }
    i -= n_g;
    {
      int j = i * 256 + threadIdx.x;
      float v[4], mx = -1e30f;
      for (int l = 0; l < 4; ++l) { v[l] = p.hg_lb[l * 1024 + j]; mx = fmaxf(mx, v[l]); }
      float s = 0.f;
      for (int l = 0; l < 4; ++l) { v[l] = __expf(v[l] - mx); s += v[l]; }
      float* lbs = (float*)(p.ws + O_LBS);
      float cum = 0.f;
      for (int l = 0; l < 4; ++l) {
        if (l > 0) cum += v[l] / s;
        lbs[l * 1024 + j] = cum;
      }
    }
  }
}

DEV void phaseR(const P& p, int g, int l) {
  const int tid_ = opq(threadIdx.x); const int lane = tid_ & 63, w = tid_ >> 6;
  const float* mod = (const float*)(p.ws + O_MOD);
  float* hc = (float*)(p.ws + O_HC);
  const float* o = (const float*)(p.ws + O_BSH);
  u16* u = (u16*)(p.ws + O_BIT);
  for (int it = blockIdx.x; it < GR / 4; it += gridDim.x) {
    int lr = it * 4 + w;
    int lb = lr / TS, s = lr % TS;
    bool isctx = s < TCX;
    if (l == DEPTH && isctx) continue;
    int b = g * GB + lb, t = s - TCX;
    int mi = isctx ? 8 : b;
    float* hp = isctx ? hc + ((size_t)lb * TCX + s) * 1024 : p.out + ((size_t)b * TL + t) * 1024;
    float hv[16];
    if (l == 0) {
      const float* src = isctx ? p.ctx + ((size_t)b * TCX + s) * 1024 : p.x + ((size_t)b * TL + t) * 1024;
#pragma unroll
      for (int k = 0; k < 4; ++k) {
        float4 v = *(const float4*)(src + k * 256 + lane * 4);
        hv[k * 4] = v.x; hv[k * 4 + 1] = v.y; hv[k * 4 + 2] = v.z; hv[k * 4 + 3] = v.w;
      }
    } else {
      int orow = lb * TS + (isctx ? s : TCX + lat_map(l - 1, t));
      const float* op = o + (size_t)orow * 1024;
      float ov[16], ss = 0.f;
#pragma unroll
      for (int k = 0; k < 4; ++k) {
        float4 v = *(const float4*)(op + k * 256 + lane * 4);
        ov[k * 4] = v.x; ov[k * 4 + 1] = v.y; ov[k * 4 + 2] = v.z; ov[k * 4 + 3] = v.w;
        ss += v.x * v.x + v.y * v.y + v.z * v.z + v.w * v.w;
      }
#pragma unroll
      for (int off = 32; off; off >>= 1) ss += __shfl_xor(ss, off);
      float rinv = rsqrtf(ss * (1.f / 1024.f) + EPS);
      const float* gate = mod + ((size_t)(l - 1) * 9 + mi) * 3072 + 2048;
      const float* wp = p.norm_post + (l - 1) * 1024;
#pragma unroll
      for (int k = 0; k < 4; ++k) {
        float4 hh = *(const float4*)(hp + k * 256 + lane * 4);
        float4 gg = *(const float4*)(gate + k * 256 + lane * 4);
        float4 ww = *(const float4*)(wp + k * 256 + lane * 4);
        hv[k * 4] = hh.x + gg.x * (ov[k * 4] * rinv * ww.x);
        hv[k * 4 + 1] = hh.y + gg.y * (ov[k * 4 + 1] * rinv * ww.y);
        hv[k * 4 + 2] = hh.z + gg.z * (ov[k * 4 + 2] * rinv * ww.z);
        hv[k * 4 + 3] = hh.w + gg.w * (ov[k * 4 + 3] * rinv * ww.w);
      }
    }
#pragma unroll
    for (int k = 0; k < 4; ++k)
      *(float4*)(hp + k * 256 + lane * 4) = make_float4(hv[k * 4], hv[k * 4 + 1], hv[k * 4 + 2], hv[k * 4 + 3]);
    if (l < DEPTH) {
      float ss = 0.f;
#pragma unroll
      for (int k = 0; k < 16; ++k) ss += hv[k] * hv[k];
#pragma unroll
      for (int off = 32; off; off >>= 1) ss += __shfl_xor(ss, off);
      float rinv = rsqrtf(ss * (1.f / 1024.f) + EPS);
      const float* sh = mod + ((size_t)l * 9 + mi) * 3072;
      const float* wp = p.norm_pre + l * 1024;
      int urow = lb * TS + (isctx ? s : TCX + lat_map(l, t));
      u16* up = u + (size_t)urow * 1024;
#pragma unroll
      for (int k = 0; k < 4; ++k) {
        float4 ww = *(const float4*)(wp + k * 256 + lane * 4);
        float4 s0 = *(const float4*)(sh + k * 256 + lane * 4);
        float4 s1 = *(const float4*)(sh + 1024 + k * 256 + lane * 4);
        float a0 = hv[k * 4] * rinv * ww.x * (1.f + s1.x) + s0.x;
        float a1 = hv[k * 4 + 1] * rinv * ww.y * (1.f + s1.y) + s0.y;
        float a2 = hv[k * 4 + 2] * rinv * ww.z * (1.f + s1.z) + s0.z;
        float a3 = hv[k * 4 + 3] * rinv * ww.w * (1.f + s1.w) + s0.w;
        uint2 pk; pk.x = pk2(a0, a1); pk.y = pk2(a2, a3);
        *(uint2*)(up + k * 256 + lane * 4) = pk;
      }
    }
  }
}

template <int MODE>
DEV void gemm_tile(const u16* __restrict__ A, int lda, const u16* __restrict__ Bt, int K, int rt, int ct, u16* z,
                   u16* zT, float* ab, float* o, char* smem) {
  u16* As = (u16*)smem;
  u16* Bs = As + 128 * 64;
  const int tid = opq(threadIdx.x), lane = tid & 63, w = tid >> 6, wr = w >> 1, wc = w & 1, fr = lane & 15, fq = lane >> 4;
  const int lrow = tid >> 3, lseg = tid & 7;
  const int wsw = (lseg ^ ((lrow >> 1) & 7)) * 8;
  const int rsw = (fr >> 1) & 7;
  const u16* Ag = A + (size_t)(rt * 128 + lrow) * lda + lseg * 8;
  const u16* Bg = Bt + (size_t)(ct * 128 + lrow) * K + lseg * 8;
  uint4 pa0, pa1, pa2, pa3, pb0, pb1, pb2, pb3;
  uint4 qa0, qa1, qa2, qa3, qb0, qb1, qb2, qb3;
  f32x4 acc[4][4];
#pragma unroll
  for (int i = 0; i < 4; ++i)
#pragma unroll
    for (int j = 0; j < 4; ++j) acc[i][j] = (f32x4){0.f, 0.f, 0.f, 0.f};
  const int nk = K / 64;
#define GLD(S, kk)                                                            \
  {                                                                           \
    const int kc_ = ((kk) < nk ? (kk) : nk - 1) * 64;                         \
    S##a0 = *(const uint4*)(Ag + kc_);                                        \
    S##a1 = *(const uint4*)(Ag + kc_ + (size_t)32 * lda);                     \
    S##a2 = *(const uint4*)(Ag + kc_ + (size_t)64 * lda);                     \
    S##a3 = *(const uint4*)(Ag + kc_ + (size_t)96 * lda);                     \
    S##b0 = *(const uint4*)(Bg + kc_);                                        \
    S##b1 = *(const uint4*)(Bg + kc_ + (size_t)32 * K);                       \
    S##b2 = *(const uint4*)(Bg + kc_ + (size_t)64 * K);                       \
    S##b3 = *(const uint4*)(Bg + kc_ + (size_t)96 * K);                       \
  }
#define GST(S, bufo)                                                          \
  *(uint4*)(As + (bufo) + (lrow)*64 + wsw) = S##a0;                      \
  *(uint4*)(As + (bufo) + (lrow + 32) * 64 + wsw) = S##a1;               \
  *(uint4*)(As + (bufo) + (lrow + 64) * 64 + wsw) = S##a2;               \
  *(uint4*)(As + (bufo) + (lrow + 96) * 64 + wsw) = S##a3;               \
  *(uint4*)(Bs + (bufo) + (lrow)*64 + wsw) = S##b0;                      \
  *(uint4*)(Bs + (bufo) + (lrow + 32) * 64 + wsw) = S##b1;               \
  *(uint4*)(Bs + (bufo) + (lrow + 64) * 64 + wsw) = S##b2;               \
  *(uint4*)(Bs + (bufo) + (lrow + 96) * 64 + wsw) = S##b3;
#define GCOMP(cb)                                                                                           \
  _Pragma("unroll") for (int ks = 0; ks < 2; ++ks) {                                                        \
    bf16x8 af[4], bfr[4];                                                                                   \
    _Pragma("unroll") for (int mi = 0; mi < 4; ++mi)                                                        \
        af[mi] = ld8(As + (cb) + (wr * 64 + mi * 16 + fr) * 64 + (((ks * 4 + fq) ^ rsw) * 8));                         \
    _Pragma("unroll") for (int ni = 0; ni < 4; ++ni)                                                        \
        bfr[ni] = ld8(Bs + (cb) + (wc * 64 + ni * 16 + fr) * 64 + (((ks * 4 + fq) ^ rsw) * 8));                        \
    _Pragma("unroll") for (int mi = 0; mi < 4; ++mi)                                                        \
        _Pragma("unroll") for (int ni = 0; ni < 4; ++ni) acc[mi][ni] = mfma(af[mi], bfr[ni], acc[mi][ni]);  \
  }
  constexpr int BUF1 = 2 * 128 * 64;
  GLD(p, 0)
  GLD(q, 1)
  GST(p, 0)
  __syncthreads();
  GLD(p, 2)
  for (int kt = 0; kt < nk; kt += 2) {
    GCOMP(0)
    GST(q, BUF1)
    GLD(q, kt + 3)
    __syncthreads();
    GCOMP(BUF1)
    GST(p, 0)
    GLD(p, kt + 4)
    __syncthreads();
  }
#pragma unroll
  for (int mi = 0; mi < 4; ++mi)
#pragma unroll
    for (int ni = 0; ni < 4; ++ni) {
      int row0 = rt * 128 + wr * 64 + mi * 16 + fq * 4;
      int col = ct * 128 + wc * 64 + ni * 16 + fr;
      f32x4 v = acc[mi][ni];
      if (MODE == 1) {
#pragma unroll
        for (int r = 0; r < 4; ++r) o[(size_t)(row0 + r) * 1024 + col] = v[r];
      } else {
        if (ct >= 28 && ct < 32) {
          uint2 pk; pk.x = pk2(v[0], v[1]); pk.y = pk2(v[2], v[3]);
          *(uint2*)(zT + (size_t)(col - C_IC) * GR + row0) = pk;
        } else if (ct == 44) {
          if (col - C_AB < 16) {
#pragma unroll
            for (int r = 0; r < 4; ++r) ab[(size_t)(row0 + r) * 16 + (col - C_AB)] = v[r];
          }
        } else {
#pragma unroll
          for (int r = 0; r < 4; ++r) z[(size_t)(row0 + r) * NZ + col] = f2bf(v[r]);
        }
      }
    }
}

DEV void a_item(const P& p, int l, int item, int mode, char* smem) {
  float* xc = (float*)smem;
  u16* xcb = (u16*)(smem + 16384);
  float* av = (float*)(smem + 16384 + 9216);
  float* uv = av + 4096;
  float* segP = uv + 4096;
  float* segH = segP + 256;
  const int tid = opq(threadIdx.x), lane = tid & 63, w = tid >> 6, fr = lane & 15, fq = lane >> 4;
  const int cgk = item >> 3, hA = item & 7, n = cgk % 36, rb = cgk * 64;
  u16* z = (u16*)(p.ws + O_Z);
  {
    u16* xin = (u16*)av;
    uint4 st[3];
#pragma unroll
    for (int k = 0; k < 3; ++k) {
      int idx = tid + 256 * k, row = idx >> 3, sg = idx & 7, cp = row - 2;
      bool ok = (idx < 536) && !((cp < 0 && (n == 0 || n == 4)) || (cp > 63 && (n == 3 || n == 35)));
      st[k] = make_uint4(0u, 0u, 0u, 0u);
      if (ok) st[k] = *(const uint4*)(z + (size_t)(rb + cp) * NZ + C_XA + hA * 64 + sg * 8);
    }
    const int j = tid & 63, ch = hA * 64 + j;
    float cw0 = p.conv_a_w[(l * 4 + 0) * 512 + ch], cw1 = p.conv_a_w[(l * 4 + 1) * 512 + ch];
    float cw2 = p.conv_a_w[(l * 4 + 2) * 512 + ch], cw3 = p.conv_a_w[(l * 4 + 3) * 512 + ch];
    float cb = p.conv_a_b[l * 512 + ch];
#pragma unroll
    for (int k = 0; k < 3; ++k) {
      int idx = tid + 256 * k, row = idx >> 3, sg = idx & 7;
      if (idx < 536) *(uint4*)(xin + row * 72 + sg * 8) = st[k];
    }
    __syncthreads();
#pragma unroll
    for (int k = 0; k < 16; ++k) {
      int c = (tid >> 6) + 4 * k;
      float val = cb + cw0 * bf2f(xin[c * 72 + j]) + cw1 * bf2f(xin[(c + 1) * 72 + j]) + cw2 * bf2f(xin[(c + 2) * 72 + j]) +
                  cw3 * bf2f(xin[(c + 3) * 72 + j]);
      xc[c * 64 + j] = val;
      xcb[c * 72 + j] = f2bf(val);
    }
  }
  __syncthreads();
  float yacc[16];
#pragma unroll
  for (int k = 0; k < 16; ++k) yacc[k] = 0.f;
  const int seg = tid >> 6, sj = tid & 63, sch = hA * 64 + sj;
  for (int dir = 0; dir < 2; ++dir) {
    {
      const u16* wg = (const u16*)(p.ws + O_WGT);
      const u16* wr_ = wg + (size_t)((((l * 2 + dir) * 2 + 0) * 8 + hA)) * 4096;
      const u16* wi_ = wg + (size_t)((((l * 2 + dir) * 2 + 1) * 8 + hA)) * 4096;
      bf16x8 a0 = ld8(xcb + (16 * w + fr) * 72 + fq * 8), a1 = ld8(xcb + (16 * w + fr) * 72 + 32 + fq * 8);
#pragma unroll
      for (int nt = 0; nt < 4; ++nt) {
        f32x4 ar = {0.f, 0.f, 0.f, 0.f}, ai = {0.f, 0.f, 0.f, 0.f};
        const u16* br = wr_ + (nt * 16 + fr) * 64 + fq * 8;
        const u16* bi = wi_ + (nt * 16 + fr) * 64 + fq * 8;
        ar = mfma(a0, ld8(br), ar); ar = mfma(a1, ld8(br + 32), ar);
        ai = mfma(a0, ld8(bi), ai); ai = mfma(a1, ld8(bi + 32), ai);
        int j = nt * 16 + fr, ch = hA * 64 + j;
        float brv = p.rg_b_r[(l * 2 + dir) * 512 + ch], biv = p.rg_b_i[(l * 2 + dir) * 512 + ch];
        float sp = softplus(-p.rg_lam[(l * 2 + dir) * 512 + ch]);
#pragma unroll
        for (int r = 0; r < 4; ++r) {
          int c = 16 * w + 4 * fq + r;
          float rg = sigm(ar[r] + brv), ig = sigm(ai[r] + biv);
          float la = -8.f * rg * sp;
          float a = __expf(la);
          float t2 = 2.f * la;
          float om = (t2 > -0.02f) ? -t2 * (1.f + 0.5f * t2 * (1.f + t2 * (1.f / 3.f) * (1.f + 0.25f * t2))) : 1.f - a * a;
          float uu = sqrtf(fmaxf(om, 0.f)) * (ig * xc[c * 64 + j]);
          av[c * 64 + j] = bf2f(f2bf(la));
          uv[c * 64 + j] = bf2f(f2bf(uu));
        }
      }
    }
    __syncthreads();
    {
      float ls = 0.f, H = 0.f;
      u16* ALA = (u16*)(p.ws + O_ALA);
      u16* AU = (u16*)(p.ws + O_AU);
#pragma unroll
      for (int k = 0; k < 16; ++k) {
        int c = dir ? (16 * seg + 15 - k) : (16 * seg + k);
        float la_ = av[c * 64 + sj], u_ = uv[c * 64 + sj];
        H = __expf(la_) * H + u_;
        ls += la_;
        size_t gi = ((size_t)dir * GR + rb + c) * 512 + sch;
        ALA[gi] = f2bf(la_);
        AU[gi] = f2bf(u_);
      }
      segP[seg * 64 + sj] = __expf(ls);
      segH[seg * 64 + sj] = H;
    }
    __syncthreads();
    if (mode == 0) {
      if (seg == 0) {
        float Pc = 1.f, Hc = 0.f;
        for (int q = 0; q < 4; ++q) {
          int sg = dir ? 3 - q : q;
          Hc = segP[sg * 64 + sj] * Hc + segH[sg * 64 + sj];
          Pc *= segP[sg * 64 + sj];
        }
        size_t idx = ((size_t)cgk * 2 + dir) * 512 + sch;
        ((float*)(p.ws + O_AP))[idx] = Pc;
        ((float*)(p.ws + O_AH))[idx] = Hc;
      }
    } else {
      float st = ((const float*)(p.ws + O_ACAR))[((size_t)cgk * 2 + dir) * 512 + sch];
      int nbefore = dir ? 3 - seg : seg;
      for (int q = 0; q < nbefore; ++q) {
        int sg = dir ? 3 - q : q;
        st = segP[sg * 64 + sj] * st + segH[sg * 64 + sj];
      }
      if (dir == 0) {
#pragma unroll
        for (int k = 0; k < 16; ++k) {
          int c = 16 * seg + k;
          st = av[c * 64 + sj] * st + uv[c * 64 + sj];
          yacc[k] += st;
        }
      } else {
#pragma unroll
        for (int k = 15; k >= 0; --k) {
          int c = 16 * seg + k;
          st = av[c * 64 + sj] * st + uv[c * 64 + sj];
          yacc[k] += st;
        }
      }
    }
    __syncthreads();
  }
  if (mode == 1) {
#pragma unroll
    for (int k = 0; k < 16; ++k) {
      size_t zi = (size_t)(rb + 16 * seg + k) * NZ + C_GA + sch;
      float gate = bf2f(z[zi]);
      z[zi] = f2bf(yacc[k] * silu(gate));
    }
  }
}

DEV void a_fin(const P& p, int l, int item, char* smem) {
  float* segP = (float*)smem;
  float* segH = segP + 512;
  const int tid = opq(threadIdx.x), seg = tid >> 6, sj = tid & 63;
  const int cgk = item >> 3, hA = item & 7, rb = cgk * 64, sch = hA * 64 + sj;
  u16* z = (u16*)(p.ws + O_Z);
  const u16* ALA = (const u16*)(p.ws + O_ALA);
  const u16* AU = (const u16*)(p.ws + O_AU);
  u16 lab[2][16], ub[2][16], gt[16];
#pragma unroll
  for (int dir = 0; dir < 2; ++dir)
#pragma unroll
    for (int k = 0; k < 16; ++k) {
      size_t gi = ((size_t)dir * GR + rb + 16 * seg + k) * 512 + sch;
      lab[dir][k] = ALA[gi];
      ub[dir][k] = AU[gi];
    }
#pragma unroll
  for (int k = 0; k < 16; ++k) gt[k] = z[(size_t)(rb + 16 * seg + k) * NZ + C_GA + sch];
  float car0 = ((const float*)(p.ws + O_ACAR))[((size_t)cgk * 2 + 0) * 512 + sch];
  float car1 = ((const float*)(p.ws + O_ACAR))[((size_t)cgk * 2 + 1) * 512 + sch];
  float af[2][16];
#pragma unroll
  for (int dir = 0; dir < 2; ++dir) {
    float ls = 0.f, H = 0.f;
#pragma unroll
    for (int kk = 0; kk < 16; ++kk) {
      const int k = dir ? 15 - kk : kk;
      float la_ = bf2f(lab[dir][k]);
      float a = __expf(la_);
      af[dir][k] = a;
      H = a * H + bf2f(ub[dir][k]);
      ls += la_;
    }
    segP[(dir * 4 + seg) * 64 + sj] = __expf(ls);
    segH[(dir * 4 + seg) * 64 + sj] = H;
  }
  __syncthreads();
  float yacc[16];
#pragma unroll
  for (int k = 0; k < 16; ++k) yacc[k] = 0.f;
#pragma unroll
  for (int dir = 0; dir < 2; ++dir) {
    float st = dir ? car1 : car0;
    const int nbefore = dir ? 3 - seg : seg;
    for (int q = 0; q < nbefore; ++q) {
      int sg = dir ? 3 - q : q;
      st = segP[(dir * 4 + sg) * 64 + sj] * st + segH[(dir * 4 + sg) * 64 + sj];
    }
#pragma unroll
    for (int kk = 0; kk < 16; ++kk) {
      const int k = dir ? 15 - kk : kk;
      st = af[dir][k] * st + bf2f(ub[dir][k]);
      yacc[k] += st;
    }
  }
#pragma unroll
  for (int k = 0; k < 16; ++k)
    z[(size_t)(rb + 16 * seg + k) * NZ + C_GA + sch] = f2bf(yacc[k] * silu(bf2f(gt[k])));
  __syncthreads();
}

DEV void a_fin2(const P& p, int l, int item, char* smem) {
  float* segP = (float*)smem;
  float* segH = segP + 1024;
  const int tid = opq(threadIdx.x), sg = tid >> 5, cp = tid & 31;
  const int cgk = item >> 3, hA = item & 7, rb = cgk * 64, sch = hA * 64 + 2 * cp;
  u16* z = (u16*)(p.ws + O_Z);
  const u16* ALA = (const u16*)(p.ws + O_ALA);
  const u16* AU = (const u16*)(p.ws + O_AU);
  unsigned lab[2][8], ub[2][8], gt[8];
#pragma unroll
  for (int dir = 0; dir < 2; ++dir)
#pragma unroll
    for (int k = 0; k < 8; ++k) {
      size_t gi = ((size_t)dir * GR + rb + 8 * sg + k) * 512 + sch;
      lab[dir][k] = *(const unsigned*)(ALA + gi);
      ub[dir][k] = *(const unsigned*)(AU + gi);
    }
#pragma unroll
  for (int k = 0; k < 8; ++k) gt[k] = *(const unsigned*)(z + (size_t)(rb + 8 * sg + k) * NZ + C_GA + sch);
  const float2 car0 = *(const float2*)((const float*)(p.ws + O_ACAR) + ((size_t)cgk * 2 + 0) * 512 + sch);
  const float2 car1 = *(const float2*)((const float*)(p.ws + O_ACAR) + ((size_t)cgk * 2 + 1) * 512 + sch);
  float af[2][8][2];
#pragma unroll
  for (int dir = 0; dir < 2; ++dir) {
    float ls0 = 0.f, ls1 = 0.f, H0 = 0.f, H1 = 0.f;
#pragma unroll
    for (int kk = 0; kk < 8; ++kk) {
      const int k = dir ? 7 - kk : kk;
      float l0 = bf2f((u16)(lab[dir][k] & 0xffff)), l1 = bf2f((u16)(lab[dir][k] >> 16));
      float a0 = __expf(l0), a1 = __expf(l1);
      af[dir][k][0] = a0; af[dir][k][1] = a1;
      H0 = a0 * H0 + bf2f((u16)(ub[dir][k] & 0xffff));
      H1 = a1 * H1 + bf2f((u16)(ub[dir][k] >> 16));
      ls0 += l0; ls1 += l1;
    }
    *(float2*)(segP + (dir * 8 + sg) * 64 + 2 * cp) = make_float2(__expf(ls0), __expf(ls1));
    *(float2*)(segH + (dir * 8 + sg) * 64 + 2 * cp) = make_float2(H0, H1);
  }
  __syncthreads();
  float y0[8], y1[8];
#pragma unroll
  for (int k = 0; k < 8; ++k) { y0[k] = 0.f; y1[k] = 0.f; }
#pragma unroll
  for (int dir = 0; dir < 2; ++dir) {
    float s0 = dir ? car1.x : car0.x, s1 = dir ? car1.y : car0.y;
    const int nbefore = dir ? 7 - sg : sg;
    for (int q = 0; q < nbefore; ++q) {
      int sq = dir ? 7 - q : q;
      float2 pp = *(const float2*)(segP + (dir * 8 + sq) * 64 + 2 * cp);
      float2 hh = *(const float2*)(segH + (dir * 8 + sq) * 64 + 2 * cp);
      s0 = pp.x * s0 + hh.x;
      s1 = pp.y * s1 + hh.y;
    }
#pragma unroll
    for (int kk = 0; kk < 8; ++kk) {
      const int k = dir ? 7 - kk : kk;
      s0 = af[dir][k][0] * s0 + bf2f((u16)(ub[dir][k] & 0xffff));
      s1 = af[dir][k][1] * s1 + bf2f((u16)(ub[dir][k] >> 16));
      y0[k] += s0; y1[k] += s1;
    }
  }
#pragma unroll
  for (int k = 0; k < 8; ++k) {
    float g0 = bf2f((u16)(gt[k] & 0xffff)), g1 = bf2f((u16)(gt[k] >> 16));
    *(unsigned*)(z + (size_t)(rb + 8 * sg + k) * NZ + C_GA + sch) = pk2(y0[k] * silu(g0), y1[k] * silu(g1));
  }
  __syncthreads();
}

DEV void a_carry(const P& p, int item) {
  int t = item * 256 + threadIdx.x;
  int ch = t & 511, dir = (t >> 9) & 1, lb = t >> 10;
  const float* AP = (const float*)(p.ws + O_AP);
  const float* AH = (const float*)(p.ws + O_AH);
  float* AC = (float*)(p.ws + O_ACAR);
  float st = 0.f;
  float pv[36], hv[36];
#pragma unroll
  for (int j = 0; j < 36; ++j) {
    int n = dir ? (j < 4 ? 3 - j : 39 - j) : j;
    size_t idx = ((size_t)(lb * 36 + n) * 2 + dir) * 512 + ch;
    pv[j] = AP[idx];
    hv[j] = AH[idx];
  }
#pragma unroll
  for (int j = 0; j < 36; ++j) {
    int n = dir ? (j < 4 ? 3 - j : 39 - j) : j;
    size_t idx = ((size_t)(lb * 36 + n) * 2 + dir) * 512 + ch;
    AC[idx] = st;
    st = pv[j] * st + hv[j];
  }
}

DEV void b_local(const P& p, int l, int item, char* smem) {
  u16* qs = (u16*)smem;
  u16* ks = qs + 64 * 136;
  float* Am = (float*)(smem + 34816);
  float* gc = (float*)(smem + 34816 + 32768);
  float* bt = gc + 128;
  const int tid = opq(threadIdx.x), lane = tid & 63, w = tid >> 6, fr = lane & 15, fq = lane >> 4;
  const int cgk = item >> 2, h = item & 3, n = cgk % 36, rb = cgk * 64;
  const u16* z = (const u16*)(p.ws + O_Z);
  u16* qn = (u16*)(p.ws + O_BSH);
  u16* kn = qn + (size_t)GR * 512;
  u16* vb = kn + (size_t)GR * 512;
  u16* knT = vb + (size_t)GR * 512;
  const float* ab = (const float*)(p.ws + O_AB);
  {
    u16* Tt = (u16*)Am;
    uint4 st[5];
#define BL_TLOAD(which)                                                                                  \
  _Pragma("unroll") for (int k = 0; k < 5; ++k) {                                                        \
    int idx = tid + 256 * k, row = idx >> 4, seg = idx & 15, cp = row - 2;                               \
    bool ok = (idx < 1072) && !((cp < 0 && (n == 0 || n == 4)) || (cp > 63 && (n == 3 || n == 35)));    \
    st[k] = make_uint4(0u, 0u, 0u, 0u);                                                                  \
    if (ok) st[k] = *(const uint4*)(z + (size_t)(rb + cp) * NZ + C_Q + (which)*512 + h * 128 + seg * 8); \
  }
    BL_TLOAD(0)
#pragma unroll
    for (int which = 0; which < 3; ++which) {
#pragma unroll
      for (int k = 0; k < 5; ++k) {
        int idx = tid + 256 * k, row = idx >> 4, seg = idx & 15;
        if (idx < 1072) *(uint4*)(Tt + row * 136 + seg * 8) = st[k];
      }
      __syncthreads();
      if (which < 2) { BL_TLOAD(which + 1) }
      float cw[2][4];
#pragma unroll
      for (int hh = 0; hh < 2; ++hh)
#pragma unroll
        for (int tap = 0; tap < 4; ++tap)
          cw[hh][tap] = p.conv_b_w[(size_t)(l * 4 + tap) * 1536 + which * 512 + h * 128 + lane + 64 * hh];
#pragma unroll 4
      for (int c = w; c < 64; c += 4) {
        float v[2];
#pragma unroll
        for (int hh = 0; hh < 2; ++hh) {
          int d = lane + 64 * hh;
          float a = 0.f;
#pragma unroll
          for (int tap = 0; tap < 4; ++tap) a += cw[hh][tap] * bf2f(Tt[(c + tap) * 136 + d]);
          v[hh] = silu(a);
        }
        float rs = 1.f;
        if (which < 2) {
          float sq = v[0] * v[0] + v[1] * v[1];
#pragma unroll
          for (int off = 32; off; off >>= 1) sq += __shfl_xor(sq, off);
          rs = rsqrtf(sq + EPS) * (which == 0 ? 0.08838834764831845f : 1.f);
        }
#pragma unroll
        for (int hh = 0; hh < 2; ++hh) {
          int d = lane + 64 * hh;
          u16 ob = f2bf(v[hh] * rs);
          size_t gi = (size_t)(rb + c) * 512 + h * 128 + d;
          if (which == 0) { qs[c * 136 + d] = ob; qn[gi] = ob; }
          else if (which == 1) { ks[c * 136 + d] = ob; kn[gi] = ob; }
          else vb[gi] = ob;
        }
      }
      __syncthreads();
    }
  }
  if (w < 2) {
    int dir = w, i = lane, c = dir ? 63 - i : i;
    float al = ab[(size_t)(rb + c) * 16 + dir * 4 + h], bl = ab[(size_t)(rb + c) * 16 + 8 + dir * 4 + h];
    float g = -__expf(p.gdn_a_log[(l * 2 + dir) * 4 + h]) * softplus(al + p.gdn_dt_bias[(l * 2 + dir) * 4 + h]);
#pragma unroll
    for (int off = 1; off < 64; off <<= 1) {
      float v = __shfl_up(g, off);
      if (lane >= off) g += v;
    }
    gc[dir * 64 + i] = g;
    bt[dir * 64 + i] = sigm(bl);
  }
  __syncthreads();
  for (int idx = tid; idx < 1024; idx += 256) {
    int d = idx >> 3, c8 = idx & 7;
    uint4 pk;
    pk.x = (unsigned)ks[(c8 * 8 + 0) * 136 + d] | ((unsigned)ks[(c8 * 8 + 1) * 136 + d] << 16);
    pk.y = (unsigned)ks[(c8 * 8 + 2) * 136 + d] | ((unsigned)ks[(c8 * 8 + 3) * 136 + d] << 16);
    pk.z = (unsigned)ks[(c8 * 8 + 4) * 136 + d] | ((unsigned)ks[(c8 * 8 + 5) * 136 + d] << 16);
    pk.w = (unsigned)ks[(c8 * 8 + 6) * 136 + d] | ((unsigned)ks[(c8 * 8 + 7) * 136 + d] << 16);
    *(uint4*)(knT + ((size_t)(cgk * 4 + h) * 128 + d) * 64 + c8 * 8) = pk;
  }
  for (int dir = 0; dir < 2; ++dir) {
    char* rec = p.ws + O_BIT + ((size_t)(cgk * 4 + h) * 2 + dir) * BIT_SZ;
    u16* QKm = (u16*)rec + 4096;
    float* scal = (float*)(rec + 16384);
    int irow = 16 * w + fr, ci = dir ? 63 - irow : irow;
    bf16x8 ak[4], aq[4];
#pragma unroll
    for (int s = 0; s < 4; ++s) { ak[s] = ld8(ks + ci * 136 + 32 * s + 8 * fq); aq[s] = ld8(qs + ci * 136 + 32 * s + 8 * fq); }
#pragma unroll
    for (int nt = 0; nt < 4; ++nt) {
      int jcol = 16 * nt + fr, cj = dir ? 63 - jcol : jcol;
      f32x4 kk = {0.f, 0.f, 0.f, 0.f}, qk = {0.f, 0.f, 0.f, 0.f};
#pragma unroll
      for (int s = 0; s < 4; ++s) {
        bf16x8 b = ld8(ks + cj * 136 + 32 * s + 8 * fq);
        kk = mfma(ak[s], b, kk);
        qk = mfma(aq[s], b, qk);
      }
      float gj = gc[dir * 64 + jcol];
#pragma unroll
      for (int r = 0; r < 4; ++r) {
        int i = 16 * w + 4 * fq + r;
        float dec = (jcol <= i) ? __expf(gc[dir * 64 + i] - gj) : 0.f;
        Am[(dir * 64 + i) * 64 + jcol] = (jcol < i) ? bt[dir * 64 + i] * kk[r] * dec : 0.f;
        QKm[i * 64 + jcol] = f2bf(qk[r] * dec);
      }
    }
    if (tid < 64) {
      float gl = gc[dir * 64 + 63], gi = gc[dir * 64 + tid];
      scal[tid] = __expf(gi);
      scal[64 + tid] = bt[dir * 64 + tid];
      scal[128 + tid] = __expf(gl - gi);
      if (tid == 0) scal[192] = __expf(gl);
    }
  }
  __syncthreads();
  if (w < 2) {
    int dir = w, col = lane;
    u16* Tinv = (u16*)(p.ws + O_BIT + ((size_t)(cgk * 4 + h) * 2 + dir) * BIT_SZ);
    const float* Ad = Am + dir * 4096;
    float T[64];
#pragma unroll
    for (int i = 0; i < 64; ++i) {
      float s = (i == col) ? 1.f : 0.f;
#pragma unroll
      for (int j = 0; j < i; ++j) s -= Ad[i * 64 + j] * T[j];
      T[i] = s;
      Tinv[i * 64 + col] = f2bf(s);
      __builtin_amdgcn_sched_barrier(0);
    }
  }
  __syncthreads();
}

DEV void b_seq(const P& p, int bitem, char* smem) {
  const int tid = opq(threadIdx.x), lane = tid & 63, w = tid >> 6, fr = lane & 15, fq = lane >> 4;
  const bool active = w < WPB;
  const int item = bitem * WPB + (active ? w : 0);
  const int slice = item & 7, dir = (item >> 3) & 1, h = (item >> 4) & 3, lb = item >> 6, e0 = slice * 16;
  u16* Ss = (u16*)(smem + w * 11264);
  u16* Rs = Ss + 16 * 136;
  u16* Vsc = Rs + 16 * 72;
  u16* Vor = Vsc + 16 * 72;
  const u16* qn = (const u16*)(p.ws + O_BSH);
  const u16* kn = qn + (size_t)GR * 512;
  const u16* vb = kn + (size_t)GR * 512;
  const u16* knT = vb + (size_t)GR * 512;
  u16* OB = (u16*)(p.ws + O_OB);
  f32x4 S[8];
#pragma unroll
  for (int m = 0; m < 8; ++m) S[m] = (f32x4){0.f, 0.f, 0.f, 0.f};
  for (int j = 0; j < 36; ++j) {
    const int n = dir ? (j < 4 ? 3 - j : 39 - j) : j;
    const int cgk = lb * 36 + n, rb = cgk * 64;
    const char* rec = p.ws + O_BIT + ((size_t)(cgk * 4 + h) * 2 + dir) * BIT_SZ;
    const u16* Tinv = (const u16*)rec;
    const u16* QKm = Tinv + 4096;
    const float* scal = (const float*)(rec + 16384);
    if (active) {
#pragma unroll
      for (int m = 0; m < 8; ++m) {
        uint2 pk; pk.x = pk2(S[m][0], S[m][1]); pk.y = pk2(S[m][2], S[m][3]);
        *(uint2*)(Ss + fr * 136 + 16 * m + 4 * fq) = pk;
      }
    }
    __syncthreads();
    bf16x8 Sf[4];
    if (active) {
#pragma unroll
      for (int s = 0; s < 4; ++s) Sf[s] = ld8(Ss + fr * 136 + 32 * s + 8 * fq);
#pragma unroll
      for (int m = 0; m < 4; ++m) {
        int i = 16 * m + fr, rowi = rb + (dir ? 63 - i : i);
        f32x4 X = {0.f, 0.f, 0.f, 0.f};
#pragma unroll
        for (int s = 0; s < 4; ++s) X = mfma(ld8(kn + (size_t)rowi * 512 + h * 128 + 32 * s + 8 * fq), Sf[s], X);
        float rv[4];
#pragma unroll
        for (int r = 0; r < 4; ++r) {
          int ii = 16 * m + 4 * fq + r, rowr = rb + (dir ? 63 - ii : ii);
          float v = bf2f(vb[(size_t)rowr * 512 + h * 128 + e0 + fr]);
          rv[r] = scal[64 + ii] * (v - scal[ii] * X[r]);
        }
        uint2 pk; pk.x = pk2(rv[0], rv[1]); pk.y = pk2(rv[2], rv[3]);
        *(uint2*)(Rs + fr * 72 + 16 * m + 4 * fq) = pk;
      }
    }
    __syncthreads();
    if (active) {
      bf16x8 Rf0 = ld8(Rs + fr * 72 + 8 * fq), Rf1 = ld8(Rs + fr * 72 + 32 + 8 * fq);
#pragma unroll
      for (int m = 0; m < 4; ++m) {
        f32x4 VN = {0.f, 0.f, 0.f, 0.f};
        VN = mfma(ld8(Tinv + (16 * m + fr) * 64 + 8 * fq), Rf0, VN);
        VN = mfma(ld8(Tinv + (16 * m + fr) * 64 + 32 + 8 * fq), Rf1, VN);
        uint2 pk; pk.x = pk2(VN[0], VN[1]); pk.y = pk2(VN[2], VN[3]);
        *(uint2*)(Vsc + fr * 72 + 16 * m + 4 * fq) = pk;
        int ib = 16 * m + 4 * fq;
        float s0 = VN[0] * scal[128 + ib], s1 = VN[1] * scal[128 + ib + 1], s2 = VN[2] * scal[128 + ib + 2],
              s3 = VN[3] * scal[128 + ib + 3];
        if (dir) {
          pk.x = pk2(s3, s2); pk.y = pk2(s1, s0);
          *(uint2*)(Vor + fr * 72 + (60 - ib)) = pk;
        } else {
          pk.x = pk2(s0, s1); pk.y = pk2(s2, s3);
          *(uint2*)(Vor + fr * 72 + ib) = pk;
        }
      }
    }
    __syncthreads();
    if (active) {
      bf16x8 Vs0 = ld8(Vsc + fr * 72 + 8 * fq), Vs1 = ld8(Vsc + fr * 72 + 32 + 8 * fq);
      bf16x8 Vo0 = ld8(Vor + fr * 72 + 8 * fq), Vo1 = ld8(Vor + fr * 72 + 32 + 8 * fq);
#pragma unroll
      for (int m = 0; m < 4; ++m) {
        int i = 16 * m + fr, rowi = rb + (dir ? 63 - i : i);
        f32x4 O = {0.f, 0.f, 0.f, 0.f};
#pragma unroll
        for (int s = 0; s < 4; ++s) O = mfma(ld8(qn + (size_t)rowi * 512 + h * 128 + 32 * s + 8 * fq), Sf[s], O);
#pragma unroll
        for (int r = 0; r < 4; ++r) O[r] *= scal[16 * m + 4 * fq + r];
        O = mfma(ld8(QKm + (16 * m + fr) * 64 + 8 * fq), Vs0, O);
        O = mfma(ld8(QKm + (16 * m + fr) * 64 + 32 + 8 * fq), Vs1, O);
#pragma unroll
        for (int r = 0; r < 4; ++r) {
          int ii = 16 * m + 4 * fq + r, rowr = rb + (dir ? 63 - ii : ii);
          OB[((size_t)dir * GR + rowr) * 512 + h * 128 + e0 + fr] = f2bf(O[r]);
        }
      }
      float egl = scal[192];
#pragma unroll
      for (int m = 0; m < 8; ++m) {
        const u16* kt = knT + ((size_t)(cgk * 4 + h) * 128 + 16 * m + fr) * 64;
        f32x4 t = S[m];
#pragma unroll
        for (int r = 0; r < 4; ++r) t[r] *= egl;
        t = mfma(ld8(kt + 8 * fq), Vo0, t);
        t = mfma(ld8(kt + 32 + 8 * fq), Vo1, t);
        S[m] = t;
      }
    }
  }
  __syncthreads();
}

DEV void c_local(const P& p, int l, int item, char* smem) {
  float* bsm = (float*)smem;
  u16* Ps = (u16*)(smem + 33024);
  u16* kdt = (u16*)(smem + 33024 + 9216);
  const int tid = opq(threadIdx.x), lane = tid & 63, w = tid >> 6, fr = lane & 15, fq = lane >> 4;
  const int cgk = item >> 2, h = item & 3, rb = cgk * 64;
  const u16* z = (const u16*)(p.ws + O_Z);
  const u16* zT = (const u16*)(p.ws + O_ZT);
  u16* OC = (u16*)(p.ws + O_OC);
  const float* lbs = (const float*)(p.ws + O_LBS);
  for (int dir = 0; dir < 2; ++dir) {
    char* rec = p.ws + O_CREC + ((size_t)(cgk * 4 + h) * 2 + dir) * CREC_SZ;
    u16* QD = (u16*)rec;
    u16* KDT = QD + 8192;
    float* decv = (float*)(rec + 32768);
    const float* lbp = lbs + l * 1024 + dir * 512 + h * 128;
    const int fcol = C_F0 + dir * 512 + h * 128;
    {
      int d = tid & 127, half = tid >> 7;
      float lb_ = lbp[d], run = 0.f;
      for (int k = 0; k < 32; ++k) {
        int i = 32 * half + k, c = dir ? 63 - i : i;
        float f = bf2f(z[(size_t)(rb + c) * NZ + fcol + d]);
        float fg = lb_ + (1.f - lb_) * sigm(f);
        run += __logf(fg);
        bsm[i * 129 + d] = run;
      }
    }
    __syncthreads();
    {
      int d = tid & 127, half = tid >> 7;
      if (half) {
        float add = bsm[31 * 129 + d];
        for (int k = 0; k < 32; ++k) bsm[(32 + k) * 129 + d] += add;
      }
    }
    __syncthreads();
    for (int idx = tid; idx < 8192; idx += 256) {
      int i = idx >> 7, d = idx & 127, c = dir ? 63 - i : i;
      float b = bsm[i * 129 + d];
      float q = silu(bf2f(z[(size_t)(rb + c) * NZ + C_QC + h * 128 + d]));
      QD[i * 128 + d] = f2bf(q * __expf(b));
      float f = bf2f(z[(size_t)(rb + c) * NZ + fcol + d]);
      float k = (1.f - lbp[d]) * sigm(-f);
      kdt[d * 72 + c] = f2bf(k * __expf(bsm[63 * 129 + d] - b));
    }
    if (tid < 128) decv[tid] = __expf(bsm[63 * 129 + tid]);
    __syncthreads();
    for (int idx = tid; idx < 1024; idx += 256) {
      int d = idx >> 3, c8 = idx & 7;
      *(uint4*)(KDT + d * 64 + c8 * 8) = *(const uint4*)(kdt + d * 72 + c8 * 8);
    }
    {
      const int sj = w;
      for (int si = 0; si < 4; ++si) {
        f32x4 acc = {0.f, 0.f, 0.f, 0.f};
        if (si >= sj) {
          int it = 16 * si + fr, jt = 16 * sj + fr;
          int ci = dir ? 63 - it : it, cj = dir ? 63 - jt : jt;
#pragma unroll
          for (int s = 0; s < 4; ++s) {
            int d0 = 32 * s + 8 * fq;
            bf16x8 qv = ld8(z + (size_t)(rb + ci) * NZ + C_QC + h * 128 + d0);
            bf16x8 fv = ld8(z + (size_t)(rb + cj) * NZ + fcol + d0);
            bf16x8 af, bf;
#pragma unroll
            for (int e = 0; e < 8; ++e) {
              int d = d0 + e;
              float Bs_ = si ? bsm[(16 * si - 1) * 129 + d] : 0.f;
              float qq = silu(bf2f((u16)qv[e])) * __expf(bsm[it * 129 + d] - Bs_);
              float kk = (1.f - lbp[d]) * sigm(-bf2f((u16)fv[e])) * __expf(Bs_ - bsm[jt * 129 + d]);
              af[e] = (short)f2bf(qq);
              bf[e] = (short)f2bf(kk);
            }
            acc = mfma(af, bf, acc);
          }
        }
#pragma unroll
        for (int r = 0; r < 4; ++r) {
          int i = 16 * si + 4 * fq + r, jj = 16 * sj + fr;
          float v = (si >= sj && jj <= i) ? acc[r] : 0.f;
          Ps[i * 72 + (dir ? 63 - jj : jj)] = f2bf(v);
        }
        __builtin_amdgcn_sched_barrier(0);
      }
    }
    __syncthreads();
#pragma unroll
    for (int nt2 = 0; nt2 < 2; ++nt2) {
      int e = h * 128 + (2 * w + nt2) * 16 + fr;
      bf16x8 v0 = ld8(zT + (size_t)e * GR + rb + 8 * fq), v1 = ld8(zT + (size_t)e * GR + rb + 32 + 8 * fq);
#pragma unroll
      for (int m = 0; m < 4; ++m) {
        f32x4 O = {0.f, 0.f, 0.f, 0.f};
        O = mfma(ld8(Ps + (16 * m + fr) * 72 + 8 * fq), v0, O);
        O = mfma(ld8(Ps + (16 * m + fr) * 72 + 32 + 8 * fq), v1, O);
#pragma unroll
        for (int r = 0; r < 4; ++r) {
          int ii = 16 * m + 4 * fq + r, rowr = rb + (dir ? 63 - ii : ii);
          OC[((size_t)dir * GR + rowr) * 512 + e] = f2bf(O[r]);
        }
      }
    }
    __syncthreads();
  }
}

DEV void c_seq(const P& p, int bitem, char* smem) {
  const int tid = opq(threadIdx.x), lane = tid & 63, w = tid >> 6, fr = lane & 15, fq = lane >> 4;
  const bool active = w < WPB;
  const int item = bitem * WPB + (active ? w : 0);
  const int slice = item & 7, dir = (item >> 3) & 1, h = (item >> 4) & 3, lb = item >> 6, e0 = slice * 16;
  u16* Ss = (u16*)(smem + w * 4352);
  const u16* zT = (const u16*)(p.ws + O_ZT);
  u16* OC = (u16*)(p.ws + O_OC);
  f32x4 S[8];
#pragma unroll
  for (int m = 0; m < 8; ++m) S[m] = (f32x4){0.f, 0.f, 0.f, 0.f};
  for (int j = 0; j < 36; ++j) {
    const int n = dir ? (j < 4 ? 3 - j : 39 - j) : j;
    const int cgk = lb * 36 + n, rb = cgk * 64;
    const char* rec = p.ws + O_CREC + ((size_t)(cgk * 4 + h) * 2 + dir) * CREC_SZ;
    const u16* QD = (const u16*)rec;
    const u16* KDT = QD + 8192;
    const float* decv = (const float*)(rec + 32768);
    if (active) {
#pragma unroll
      for (int m = 0; m < 8; ++m) {
        uint2 pk; pk.x = pk2(S[m][0], S[m][1]); pk.y = pk2(S[m][2], S[m][3]);
        *(uint2*)(Ss + fr * 136 + 16 * m + 4 * fq) = pk;
      }
    }
    __syncthreads();
    if (active) {
      bf16x8 Sf[4];
#pragma unroll
      for (int s = 0; s < 4; ++s) Sf[s] = ld8(Ss + fr * 136 + 32 * s + 8 * fq);
#pragma unroll
      for (int m = 0; m < 4; ++m) {
        f32x4 O = {0.f, 0.f, 0.f, 0.f};
#pragma unroll
        for (int s = 0; s < 4; ++s) O = mfma(ld8(QD + (16 * m + fr) * 128 + 32 * s + 8 * fq), Sf[s], O);
#pragma unroll
        for (int r = 0; r < 4; ++r) {
          int ii = 16 * m + 4 * fq + r, rowr = rb + (dir ? 63 - ii : ii);
          size_t oi = ((size_t)dir * GR + rowr) * 512 + h * 128 + e0 + fr;
          OC[oi] = f2bf(bf2f(OC[oi]) + O[r]);
        }
      }
      const u16* vp = zT + (size_t)(h * 128 + e0 + fr) * GR + rb;
      bf16x8 V0 = ld8(vp + 8 * fq), V1 = ld8(vp + 32 + 8 * fq);
#pragma unroll
      for (int m = 0; m < 8; ++m) {
        f32x4 t = S[m];
#pragma unroll
        for (int r = 0; r < 4; ++r) t[r] *= decv[16 * m + 4 * fq + r];
        t = mfma(ld8(KDT + (16 * m + fr) * 64 + 8 * fq), V0, t);
        t = mfma(ld8(KDT + (16 * m + fr) * 64 + 32 + 8 * fq), V1, t);
        S[m] = t;
      }
    }
    __syncthreads();
  }
}

#define LBAR()                                              \
  do {                                                      \
    asm volatile("s_waitcnt lgkmcnt(0)" ::: "memory");      \
    __builtin_amdgcn_s_barrier();                           \
    asm volatile("" ::: "memory");                          \
  } while (0)
#define CBAR() asm volatile("" ::: "memory")

DEV void c_local2(const P& p, int l, int item, char* smem) {
  float* bsm = (float*)smem;
  u16* Fq = (u16*)(smem + 33024);
  u16* kdt = (u16*)(smem + 50432);
  u16* Ps = kdt;
  const int tid = opq(threadIdx.x), lane = tid & 63, w = tid >> 6, fr = lane & 15, fq = lane >> 4;
  const int cgk = item >> 2, h = item & 3, rb = cgk * 64;
  const u16* z = (const u16*)(p.ws + O_Z);
  const u16* zT = (const u16*)(p.ws + O_ZT);
  u16* OC = (u16*)(p.ws + O_OC);
  const float* lbs = (const float*)(p.ws + O_LBS);
  u16* zq = (u16*)(p.ws + O_Z) + (size_t)rb * NZ + C_QC + h * 128;
  {
    uint4 t4[4];
#pragma unroll
    for (int k = 0; k < 4; ++k) {
      int idx = tid + 256 * k, c = idx >> 4, seg = idx & 15;
      t4[k] = *(const uint4*)(zq + (size_t)c * NZ + seg * 8);
    }
#pragma unroll
    for (int k = 0; k < 4; ++k) {
      int idx = tid + 256 * k, c = idx >> 4, seg = idx & 15;
      unsigned wv[4] = {t4[k].x, t4[k].y, t4[k].z, t4[k].w};
#pragma unroll
      for (int q = 0; q < 4; ++q)
        wv[q] = pk2(silu(bf2f((u16)(wv[q] & 0xffff))), silu(bf2f((u16)(wv[q] >> 16))));
      *(uint4*)(zq + (size_t)c * NZ + seg * 8) = make_uint4(wv[0], wv[1], wv[2], wv[3]);
    }
  }
  __syncthreads();
  for (int dir = 0; dir < 2; ++dir) {
    char* rec = p.ws + O_CREC + ((size_t)(cgk * 4 + h) * 2 + dir) * CREC_SZ;
    u16* QD = (u16*)rec;
    u16* KDT = QD + 8192;
    float* decv = (float*)(rec + 32768);
    const float* lbp = lbs + l * 1024 + dir * 512 + h * 128;
    const int fcol = C_F0 + dir * 512 + h * 128;
    {
      uint4 t4[4];
#pragma unroll
      for (int k = 0; k < 4; ++k) {
        int idx = tid + 256 * k, c = idx >> 4, seg = idx & 15;
        t4[k] = *(const uint4*)(z + (size_t)(rb + c) * NZ + fcol + seg * 8);
      }
#pragma unroll
      for (int k = 0; k < 4; ++k) {
        int idx = tid + 256 * k, c = idx >> 4, seg = idx & 15;
        *(uint4*)(Fq + c * 136 + seg * 8) = t4[k];
      }
    }
    __syncthreads();
    {
      int d = tid & 127, half = tid >> 7;
      float lb_ = lbp[d], run = 0.f;
#pragma unroll 8
      for (int k = 0; k < 32; ++k) {
        int i = 32 * half + k, c = dir ? 63 - i : i;
        float f = bf2f(Fq[c * 136 + d]);
        float fg = lb_ + (1.f - lb_) * sigm(f);
        run += __logf(fg);
        bsm[i * 129 + d] = run;
      }
    }
    __syncthreads();
    {
      int d = tid & 127, half = tid >> 7;
      if (half) {
        float add = bsm[31 * 129 + d];
#pragma unroll 8
        for (int k = 0; k < 32; ++k) bsm[(32 + k) * 129 + d] += add;
      }
    }
    __syncthreads();
    {
      uint4 qv[4];
#pragma unroll
      for (int k = 0; k < 4; ++k) {
        int idx = tid + 256 * k, c = idx >> 4, seg = idx & 15;
        qv[k] = *(const uint4*)(zq + (size_t)c * NZ + seg * 8);
      }
#pragma unroll
      for (int k = 0; k < 4; ++k) {
        int idx = tid + 256 * k, c = idx >> 4, seg = idx & 15, i = dir ? 63 - c : c, d0 = seg * 8;
        unsigned qw[4] = {qv[k].x, qv[k].y, qv[k].z, qv[k].w};
        uint4 fv4 = *(const uint4*)(Fq + c * 136 + d0);
        unsigned fw[4] = {fv4.x, fv4.y, fv4.z, fv4.w};
        unsigned qo[4], ko[4];
#pragma unroll
        for (int q = 0; q < 4; ++q) {
          int d = d0 + 2 * q;
          float b0 = bsm[i * 129 + d], b1 = bsm[i * 129 + d + 1];
          float bl0 = bsm[63 * 129 + d], bl1 = bsm[63 * 129 + d + 1];
          float q0 = bf2f((u16)(qw[q] & 0xffff)), q1 = bf2f((u16)(qw[q] >> 16));
          qo[q] = pk2(q0 * __expf(b0), q1 * __expf(b1));
          float k0 = (1.f - lbp[d]) * sigm(-bf2f((u16)(fw[q] & 0xffff)));
          float k1 = (1.f - lbp[d + 1]) * sigm(-bf2f((u16)(fw[q] >> 16)));
          ko[q] = pk2(k0, k1);
          kdt[d * 72 + c] = f2bf(k0 * __expf(bl0 - b0));
          kdt[(d + 1) * 72 + c] = f2bf(k1 * __expf(bl1 - b1));
        }
        *(uint4*)(QD + i * 128 + d0) = make_uint4(qo[0], qo[1], qo[2], qo[3]);
        *(uint4*)(Fq + c * 136 + d0) = make_uint4(ko[0], ko[1], ko[2], ko[3]);
      }
      if (tid < 128) decv[tid] = __expf(bsm[63 * 129 + tid]);
    }
    __syncthreads();
    for (int idx = tid; idx < 1024; idx += 256) {
      int d = idx >> 3, c8 = idx & 7;
      *(uint4*)(KDT + d * 64 + c8 * 8) = *(const uint4*)(kdt + d * 72 + c8 * 8);
    }
    bf16x8 qf[3][4];
#pragma unroll
    for (int t = 0; t < 3; ++t) {
      int k = w + 4 * t;
      int si = k < 4 ? 3 : (k < 7 ? 2 : (k < 9 ? 1 : 0));
      int it_ = 16 * si + fr, ci_ = dir ? 63 - it_ : it_;
#pragma unroll
      for (int s = 0; s < 4; ++s) qf[t][s] = ld8(zq + (size_t)ci_ * NZ + 32 * s + 8 * fq);
    }
    __syncthreads();
    for (int idx = tid; idx < 1536; idx += 256) {
      int tl = idx >> 8, e = idx & 255, r16 = e >> 4, c16 = e & 15;
      int si = tl < 3 ? 0 : (tl < 5 ? 1 : 2);
      int sj = tl < 3 ? tl + 1 : (tl < 5 ? tl - 1 : 3);
      int jj = 16 * sj + c16;
      Ps[(16 * si + r16) * 72 + (dir ? 63 - jj : jj)] = 0;
    }
#pragma unroll
    for (int t = 0; t < 3; ++t) {
      const int k = w + 4 * t;
      if (k < 10) {
        const int si = k < 4 ? 3 : (k < 7 ? 2 : (k < 9 ? 1 : 0));
        const int sj = k - (k < 4 ? 0 : (k < 7 ? 4 : (k < 9 ? 7 : 9)));
        const int it = 16 * si + fr, jt = 16 * sj + fr, cj = dir ? 63 - jt : jt;
        const int brow = si ? (16 * si - 1) : 0;
        const float bmul = si ? 1.f : 0.f;
        f32x4 acc = {0.f, 0.f, 0.f, 0.f};
#pragma unroll
        for (int s = 0; s < 4; ++s) {
          int d0 = 32 * s + 8 * fq;
          bf16x8 fv = ld8(Fq + cj * 136 + d0);
          bf16x8 af, bf;
#pragma unroll
          for (int e = 0; e < 8; ++e) {
            int d = d0 + e;
            float Bs_ = bmul * bsm[brow * 129 + d];
            float qq = bf2f((u16)qf[t][s][e]) * __expf(bsm[it * 129 + d] - Bs_);
            float kk = bf2f((u16)fv[e]) * __expf(Bs_ - bsm[jt * 129 + d]);
            af[e] = (short)f2bf(qq);
            bf[e] = (short)f2bf(kk);
          }
          acc = mfma(af, bf, acc);
          __builtin_amdgcn_sched_barrier(0);
        }
#pragma unroll
        for (int r = 0; r < 4; ++r) {
          int i = 16 * si + 4 * fq + r, jj = 16 * sj + fr;
          float v = (jj <= i) ? acc[r] : 0.f;
          Ps[i * 72 + (dir ? 63 - jj : jj)] = f2bf(v);
        }
      }
    }
    __syncthreads();
#pragma unroll
    for (int nt2 = 0; nt2 < 2; ++nt2) {
      int e = h * 128 + (2 * w + nt2) * 16 + fr;
      bf16x8 v0 = ld8(zT + (size_t)e * GR + rb + 8 * fq), v1 = ld8(zT + (size_t)e * GR + rb + 32 + 8 * fq);
#pragma unroll
      for (int m = 0; m < 4; ++m) {
        f32x4 O = {0.f, 0.f, 0.f, 0.f};
        O = mfma(ld8(Ps + (16 * m + fr) * 72 + 8 * fq), v0, O);
        O = mfma(ld8(Ps + (16 * m + fr) * 72 + 32 + 8 * fq), v1, O);
#pragma unroll
        for (int r = 0; r < 4; ++r) {
          int ii = 16 * m + 4 * fq + r, rowr = rb + (dir ? 63 - ii : ii);
          OC[((size_t)dir * GR + rowr) * 512 + e] = f2bf(O[r]);
        }
      }
    }
    __syncthreads();
  }
}

#define LBAR()                                              \
  do {                                                      \
    asm volatile("s_waitcnt lgkmcnt(0)" ::: "memory");      \
    __builtin_amdgcn_s_barrier();                           \
    asm volatile("" ::: "memory");                          \
  } while (0)
#define CBAR() asm volatile("" ::: "memory")
#define BS_CHUNK(jj) (dir ? ((jj) < 4 ? 3 - (jj) : 39 - (jj)) : (jj))
DEV bf16x8 ldo8(const char* base, unsigned off) { return *reinterpret_cast<const bf16x8*>(base + off); }
DEV void b_seq2(const P& p, int bitem, char* smem) {
  const int tid = opq(threadIdx.x), lane = tid & 63, w = tid >> 6, fr = lane & 15, fq = lane >> 4;
  const int es = bitem >> 5, dir = bitem & 1, h = (bitem >> 1) & 3, lb = (bitem >> 3) & 3, e0 = es * 32;
  u16* Ss = (u16*)smem;
  u16* Rs = Ss + 32 * 136;
  u16* Vsc = Rs + 32 * 72;
  u16* Vor = Vsc + 32 * 72;
  const char* qnB = p.ws + O_BSH + (size_t)h * 256;
  const char* knB = qnB + BSH_ONE;
  const char* vbB = knB + BSH_ONE + (size_t)e0 * 2;
  const char* ktB = p.ws + O_BSH + 3 * BSH_ONE + (size_t)h * 16384;
  const char* recB = p.ws + O_BIT + ((size_t)h * 2 + dir) * BIT_SZ;
  char* obB = p.ws + O_OB + ((size_t)dir * GR * 512 + h * 128 + e0) * 2;
  const int mrow = 16 * w + fr, crow0 = 16 * w + 4 * fq;
  const unsigned offA = (unsigned)((dir ? 63 - mrow : mrow) * 1024 + 16 * fq);
  unsigned offR[4];
#pragma unroll
  for (int r = 0; r < 4; ++r) offR[r] = (unsigned)((dir ? 63 - (crow0 + r) : (crow0 + r)) * 1024 + fr * 2);
  const unsigned offT = (unsigned)(mrow * 128 + 16 * fq);
  const unsigned offK = (unsigned)((32 * w + fr) * 128 + 16 * fq);
  const unsigned offS = (unsigned)(16384 + crow0 * 4);
  f32x4 S[2][2];
#pragma unroll
  for (int a = 0; a < 2; ++a)
#pragma unroll
    for (int b = 0; b < 2; ++b) S[a][b] = (f32x4){0.f, 0.f, 0.f, 0.f};
  bf16x8 Akn[4], Aqn[4], At[2][2], Aqk[2][2], AkT[2][2][2];
  u16 vbv[2][4];
  float4 eg4, be4, ek4[2];
  float egl[2];
#define BS_LOAD1(cg_)                                                              \
  {                                                                                \
    const size_t ro_ = (size_t)(cg_) * 65536;                                      \
    _Pragma("unroll") for (int s = 0; s < 4; ++s) {                                \
      Akn[s] = ldo8(knB + ro_, offA + 64 * s);                                     \
      Aqn[s] = ldo8(qnB + ro_, offA + 64 * s);                                     \
    }                                                                              \
    _Pragma("unroll") for (int r = 0; r < 4; ++r) {                                \
      vbv[0][r] = *(const u16*)(vbB + ro_ + offR[r]);                              \
      vbv[1][r] = *(const u16*)(vbB + ro_ + (offR[r] + 32));                       \
    }                                                                              \
    const char* rc_ = recB + (size_t)(cg_) * (8 * BIT_SZ);                         \
    eg4 = *(const float4*)(rc_ + offS);                                            \
    be4 = *(const float4*)(rc_ + (offS + 256));                                    \
  }
#define BS_LOAD2(cg_, SS)                                                          \
  {                                                                                \
    const char* rc_ = recB + (size_t)(cg_) * (8 * BIT_SZ);                         \
    At[SS][0] = ldo8(rc_, offT); At[SS][1] = ldo8(rc_, offT + 64);                 \
    ek4[SS] = *(const float4*)(rc_ + (offS + 512));                                \
  }
#define BS_LOAD3(cg_, SS)                                                          \
  {                                                                                \
    const char* rc_ = recB + (size_t)(cg_) * (8 * BIT_SZ);                         \
    Aqk[SS][0] = ldo8(rc_, offT + 8192); Aqk[SS][1] = ldo8(rc_, offT + 8192 + 64); \
    egl[SS] = *(const float*)(rc_ + 16384 + 768);                                  \
    const char* kt_ = ktB + (size_t)(cg_) * 65536;                                 \
    AkT[SS][0][0] = ldo8(kt_, offK); AkT[SS][0][1] = ldo8(kt_, offK + 64);         \
    AkT[SS][1][0] = ldo8(kt_, offK + 2048); AkT[SS][1][1] = ldo8(kt_, offK + 2048 + 64); \
  }
  {
    const int c0 = lb * 36 + BS_CHUNK(0);
    BS_LOAD1(c0) BS_LOAD2(c0, 0) BS_LOAD3(c0, 0)
  }
  for (int j2 = 0; j2 < 36; j2 += 2)
#pragma unroll
  for (int u = 0; u < 2; ++u) {
    const int j = j2 + u;
    const int cgk = lb * 36 + BS_CHUNK(j);
    const int jn = (j + 1 < 36) ? j + 1 : j;
    const int cgn = lb * 36 + BS_CHUNK(jn);
    BS_LOAD2(cgn, u ^ 1)
    BS_LOAD3(cgn, u ^ 1)
#pragma unroll
    for (int mm = 0; mm < 2; ++mm)
#pragma unroll
      for (int nt = 0; nt < 2; ++nt) {
        uint2 pk; pk.x = pk2(S[mm][nt][0], S[mm][nt][1]); pk.y = pk2(S[mm][nt][2], S[mm][nt][3]);
        *(uint2*)(Ss + (16 * nt + fr) * 136 + 32 * w + 16 * mm + 4 * fq) = pk;
      }
    LBAR();
    f32x4 QS[2];
    {
      bf16x8 Sf[2][4];
#pragma unroll
      for (int nt = 0; nt < 2; ++nt)
#pragma unroll
        for (int s = 0; s < 4; ++s) Sf[nt][s] = ld8(Ss + (16 * nt + fr) * 136 + 32 * s + 8 * fq);
#pragma unroll
      for (int nt = 0; nt < 2; ++nt) {
        f32x4 X = {0.f, 0.f, 0.f, 0.f}, Q = {0.f, 0.f, 0.f, 0.f};
#pragma unroll
        for (int s = 0; s < 4; ++s) { X = mfma(Akn[s], Sf[nt][s], X); Q = mfma(Aqn[s], Sf[nt][s], Q); }
        float r0 = be4.x * (bf2f(vbv[nt][0]) - eg4.x * X[0]);
        float r1 = be4.y * (bf2f(vbv[nt][1]) - eg4.y * X[1]);
        float r2 = be4.z * (bf2f(vbv[nt][2]) - eg4.z * X[2]);
        float r3 = be4.w * (bf2f(vbv[nt][3]) - eg4.w * X[3]);
        uint2 pk; pk.x = pk2(r0, r1); pk.y = pk2(r2, r3);
        *(uint2*)(Rs + (16 * nt + fr) * 72 + crow0) = pk;
        Q[0] *= eg4.x; Q[1] *= eg4.y; Q[2] *= eg4.z; Q[3] *= eg4.w;
        QS[nt] = Q;
      }
    }
    CBAR();
    BS_LOAD1(cgn)
    LBAR();
    {
#pragma unroll
      for (int nt = 0; nt < 2; ++nt) {
        bf16x8 Rf0 = ld8(Rs + (16 * nt + fr) * 72 + 8 * fq), Rf1 = ld8(Rs + (16 * nt + fr) * 72 + 32 + 8 * fq);
        f32x4 VN = {0.f, 0.f, 0.f, 0.f};
        VN = mfma(At[u][0], Rf0, VN);
        VN = mfma(At[u][1], Rf1, VN);
        uint2 pk; pk.x = pk2(VN[0], VN[1]); pk.y = pk2(VN[2], VN[3]);
        *(uint2*)(Vsc + (16 * nt + fr) * 72 + crow0) = pk;
        float s0 = VN[0] * ek4[u].x, s1 = VN[1] * ek4[u].y, s2 = VN[2] * ek4[u].z, s3 = VN[3] * ek4[u].w;
        if (dir) {
          pk.x = pk2(s3, s2); pk.y = pk2(s1, s0);
          *(uint2*)(Vor + (16 * nt + fr) * 72 + (60 - crow0)) = pk;
        } else {
          pk.x = pk2(s0, s1); pk.y = pk2(s2, s3);
          *(uint2*)(Vor + (16 * nt + fr) * 72 + crow0) = pk;
        }
      }
    }
    LBAR();
    {
      char* ob_ = obB + (size_t)cgk * 65536;
#pragma unroll
      for (int nt = 0; nt < 2; ++nt) {
        bf16x8 Vs0 = ld8(Vsc + (16 * nt + fr) * 72 + 8 * fq), Vs1 = ld8(Vsc + (16 * nt + fr) * 72 + 32 + 8 * fq);
        bf16x8 Vo0 = ld8(Vor + (16 * nt + fr) * 72 + 8 * fq), Vo1 = ld8(Vor + (16 * nt + fr) * 72 + 32 + 8 * fq);
        f32x4 O = QS[nt];
        O = mfma(Aqk[u][0], Vs0, O);
        O = mfma(Aqk[u][1], Vs1, O);
#pragma unroll
        for (int r = 0; r < 4; ++r) *(u16*)(ob_ + (offR[r] + 32 * nt)) = f2bf(O[r]);
#pragma unroll
        for (int mm = 0; mm < 2; ++mm) {
          f32x4 t = S[mm][nt];
#pragma unroll
          for (int r = 0; r < 4; ++r) t[r] *= egl[u];
          t = mfma(AkT[u][mm][0], Vo0, t);
          t = mfma(AkT[u][mm][1], Vo1, t);
          S[mm][nt] = t;
        }
      }
    }
  }
  LBAR();
}

DEV void c_seq2(const P& p, int bitem, char* smem) {
  const int tid = opq(threadIdx.x), lane = tid & 63, w = tid >> 6, fr = lane & 15, fq = lane >> 4;
  const int es = bitem >> 5, dir = bitem & 1, h = (bitem >> 1) & 3, lb = (bitem >> 3) & 3, e0 = es * 32;
  u16* Ssb = (u16*)smem;
  const char* recB = p.ws + O_CREC + ((size_t)h * 2 + dir) * CREC_SZ;
  const char* ztB = p.ws + O_ZT + (size_t)(h * 128 + e0) * GR * 2;
  char* ocB = p.ws + O_OC + ((size_t)dir * GR * 512 + h * 128 + e0) * 2;
  const int mrow = 16 * w + fr, crow0 = 16 * w + 4 * fq;
  const unsigned offQ = (unsigned)(mrow * 256 + 16 * fq);
  const unsigned offK = (unsigned)(16384 + (32 * w + fr) * 128 + 16 * fq);
  const unsigned offD = (unsigned)(32768 + (32 * w + 4 * fq) * 4);
  const unsigned offV = (unsigned)(fr * GR * 2 + 16 * fq);
  unsigned offR[4];
#pragma unroll
  for (int r = 0; r < 4; ++r) offR[r] = (unsigned)((dir ? 63 - (crow0 + r) : (crow0 + r)) * 1024 + fr * 2);
  f32x4 S[2][2];
#pragma unroll
  for (int a = 0; a < 2; ++a)
#pragma unroll
    for (int b = 0; b < 2; ++b) S[a][b] = (f32x4){0.f, 0.f, 0.f, 0.f};
  bf16x8 Aqd[4], Akd[2][2], Vf[2][2];
  u16 oi[2][4];
  float4 dec4[2];
#define CS_LOAD(cg_)                                                                    \
  {                                                                                     \
    const char* rc_ = recB + (size_t)(cg_) * (8 * CREC_SZ);                             \
    _Pragma("unroll") for (int s = 0; s < 4; ++s) Aqd[s] = ldo8(rc_, offQ + 64 * s);    \
    Akd[0][0] = ldo8(rc_, offK); Akd[0][1] = ldo8(rc_, offK + 64);                      \
    Akd[1][0] = ldo8(rc_, offK + 2048); Akd[1][1] = ldo8(rc_, offK + 2048 + 64);        \
    dec4[0] = *(const float4*)(rc_ + offD);                                             \
    dec4[1] = *(const float4*)(rc_ + (offD + 64));                                      \
    const char* zt_ = ztB + (size_t)(cg_) * 128;                                        \
    Vf[0][0] = ldo8(zt_, offV); Vf[0][1] = ldo8(zt_, offV + 64);                        \
    Vf[1][0] = ldo8(zt_, offV + 16 * GR * 2); Vf[1][1] = ldo8(zt_, offV + 16 * GR * 2 + 64); \
    const char* oc_ = ocB + (size_t)(cg_) * 65536;                                      \
    _Pragma("unroll") for (int r = 0; r < 4; ++r) {                                     \
      oi[0][r] = *(const u16*)(oc_ + offR[r]);                                          \
      oi[1][r] = *(const u16*)(oc_ + (offR[r] + 32));                                   \
    }                                                                                   \
  }
  {
    const int c0 = lb * 36 + BS_CHUNK(0);
    CS_LOAD(c0)
  }
  for (int j = 0; j < 36; ++j) {
    const int cgk = lb * 36 + BS_CHUNK(j);
    const int jn = (j + 1 < 36) ? j + 1 : j;
    const int cgn = lb * 36 + BS_CHUNK(jn);
    u16* Ss = Ssb + (j & 1) * (32 * 136);
#pragma unroll
    for (int mm = 0; mm < 2; ++mm)
#pragma unroll
      for (int nt = 0; nt < 2; ++nt) {
        uint2 pk; pk.x = pk2(S[mm][nt][0], S[mm][nt][1]); pk.y = pk2(S[mm][nt][2], S[mm][nt][3]);
        *(uint2*)(Ss + (16 * nt + fr) * 136 + 32 * w + 16 * mm + 4 * fq) = pk;
      }
    LBAR();
    char* oc_ = ocB + (size_t)cgk * 65536;
#pragma unroll
    for (int nt = 0; nt < 2; ++nt) {
      f32x4 O = {0.f, 0.f, 0.f, 0.f};
#pragma unroll
      for (int s = 0; s < 4; ++s) O = mfma(Aqd[s], ld8(Ss + (16 * nt + fr) * 136 + 32 * s + 8 * fq), O);
#pragma unroll
      for (int r = 0; r < 4; ++r) *(u16*)(oc_ + (offR[r] + 32 * nt)) = f2bf(bf2f(oi[nt][r]) + O[r]);
#pragma unroll
      for (int mm = 0; mm < 2; ++mm) {
        f32x4 t = S[mm][nt];
        t[0] *= dec4[mm].x; t[1] *= dec4[mm].y; t[2] *= dec4[mm].z; t[3] *= dec4[mm].w;
        t = mfma(Akd[mm][0], Vf[nt][0], t);
        t = mfma(Akd[mm][1], Vf[nt][1], t);
        S[mm][nt] = t;
      }
    }
    CBAR();
    CS_LOAD(cgn)
  }
  LBAR();
}

DEV void bc_merge_row(const P& p, int l, int lr, int lane);
DEV void bc_merge(const P& p, int l, int it) {
  const int tid_ = opq(threadIdx.x); const int lane = tid_ & 63, w = tid_ >> 6;
#pragma unroll
  for (int rr = 0; rr < 2; ++rr) bc_merge_row(p, l, it * 8 + w * 2 + rr, lane);
}
DEV void bc_merge_row(const P& p, int l, int lr, int lane) {
  int mix = lane >> 5, cm = (lane * 16) & 511;
  const u16* O = (const u16*)(p.ws + (mix ? O_OC : O_OB));
  u16* z = (u16*)(p.ws + O_Z);
  float ov[16], ss = 0.f;
#pragma unroll
  for (int k2 = 0; k2 < 2; ++k2) {
    uint4 a = *(const uint4*)(O + (size_t)lr * 512 + cm + 8 * k2);
    uint4 b = *(const uint4*)(O + ((size_t)GR + lr) * 512 + cm + 8 * k2);
    unsigned aa[4] = {a.x, a.y, a.z, a.w}, bb[4] = {b.x, b.y, b.z, b.w};
#pragma unroll
    for (int q = 0; q < 4; ++q) {
      float v0 = bf2f((u16)(aa[q] & 0xffff)) + bf2f((u16)(bb[q] & 0xffff));
      float v1 = bf2f((u16)(aa[q] >> 16)) + bf2f((u16)(bb[q] >> 16));
      ov[k2 * 8 + q * 2] = v0; ov[k2 * 8 + q * 2 + 1] = v1;
      ss += v0 * v0 + v1 * v1;
    }
  }
  ss += __shfl_xor(ss, 1); ss += __shfl_xor(ss, 2); ss += __shfl_xor(ss, 4);
  float rinv = rsqrtf(ss * (1.f / 128.f) + EPS);
  const float* nw = (mix ? p.hg_norm : p.gdn_norm) + l * 128 + (cm & 127);
  u16* gp = z + (size_t)lr * NZ + (mix ? C_GC : C_GB) + cm;
#pragma unroll
  for (int k2 = 0; k2 < 2; ++k2) {
    uint4 gv = *(const uint4*)(gp + 8 * k2);
    unsigned gg[4] = {gv.x, gv.y, gv.z, gv.w}, oo[4];
#pragma unroll
    for (int q = 0; q < 4; ++q) {
      int e = k2 * 8 + q * 2;
      float y0 = ov[e] * rinv * nw[e] * silu(bf2f((u16)(gg[q] & 0xffff)));
      float y1 = ov[e + 1] * rinv * nw[e + 1] * silu(bf2f((u16)(gg[q] >> 16)));
      oo[q] = pk2(y0, y1);
    }
    *(uint4*)(gp + 8 * k2) = make_uint4(oo[0], oo[1], oo[2], oo[3]);
  }
}

#define XB_TMO      128
#define XB_XCNT(j)  (256  + 64 * (j))
#define XB_XSUB(j)  (1280 + 64 * (j))
#define XB_XGEN(j)  (2304 + 64 * (j))
#define XB_TOP      3328
#define XB_TOPGEN   3392
#define XCD_BAR_WORDS 3456
#define XB_SPIN_CAP (1u << 18)
#define LAS __attribute__((address_space(3)))

__device__ __forceinline__ unsigned xb_ld(unsigned* p)              { return __hip_atomic_load(p, __ATOMIC_RELAXED, __HIP_MEMORY_SCOPE_AGENT); }
__device__ __forceinline__ unsigned xb_add(unsigned* p, unsigned v) { return __hip_atomic_fetch_add(p, v, __ATOMIC_RELAXED, __HIP_MEMORY_SCOPE_AGENT); }
__device__ __forceinline__ unsigned xb_xcc_id() { return (unsigned)__builtin_amdgcn_s_getreg((3 << 11) | 20) & 0xFu; }
#define XB_SPIN(cond, bar) do { unsigned _sp = 0; while (cond) { __builtin_amdgcn_s_sleep(1); \
    if ((++_sp & 255u) == 0u) { if (xb_ld(&(bar)[XB_TMO])) break; if (_sp > XB_SPIN_CAP) { atomicAdd(&(bar)[XB_TMO], 1u); break; } } } } while (0)

struct XcdBarrier {
    unsigned* bar; unsigned x;
    volatile LAS unsigned* st;
};

__device__ __forceinline__ XcdBarrier xcd_barrier_post(unsigned* bar, volatile LAS unsigned* st) {
    XcdBarrier b; b.bar = bar; b.x = xb_xcc_id(); b.st = st;
    if (threadIdx.x == 0) (void)xb_add(&bar[XB_XCNT(b.x)], 1u);
    return b;
}
__device__ __forceinline__ void xcd_barrier_complete(unsigned* bar, unsigned x, unsigned& nloc, unsigned& nx) {
    const unsigned G = gridDim.x * gridDim.y * gridDim.z;
    unsigned sum, cnt, mine, sp = 0u;
    for (;;) {
        sum = 0u; cnt = 0u; mine = 0u;
#pragma unroll
        for (unsigned j = 0; j < 16; ++j) { const unsigned c = xb_ld(&bar[XB_XCNT(j)]); sum += c; cnt += (c > 0u) ? 1u : 0u; mine = (j == x) ? c : mine; }
        if (sum == G) break;
        __builtin_amdgcn_s_sleep(1);
        if ((++sp & 255u) == 0u) { if (xb_ld(&bar[XB_TMO])) break; if (sp > XB_SPIN_CAP) { atomicAdd(&bar[XB_TMO], 1u); break; } }
    }
    nloc = mine > 0u ? mine : 1u; nx = cnt > 0u ? cnt : 1u;
}

__device__ __forceinline__ void xcd_barrier(const XcdBarrier& b) {
    asm volatile("s_waitcnt vmcnt(0)" ::: "memory");
    __syncthreads();
    if (threadIdx.x == 0) {
        unsigned* bar = b.bar;
        __builtin_amdgcn_s_waitcnt(0);
        unsigned nloc = b.st[0], nx = b.st[1];
        if (nloc == 0u) { xcd_barrier_complete(bar, b.x, nloc, nx); b.st[0] = nloc; b.st[1] = nx; }
        const unsigned old = xb_add(&bar[XB_XSUB(b.x)], 1u);
        const unsigned gen = old / nloc;
        if (old + 1u == (gen + 1u) * nloc) {
            __builtin_amdgcn_fence(__ATOMIC_RELEASE, "agent");
            asm volatile("s_waitcnt vmcnt(0)" ::: "memory");
            const unsigned og = xb_add(&bar[XB_TOP], 1u);
            const unsigned tg = og / nx;
            if (og + 1u == (tg + 1u) * nx) xb_add(&bar[XB_TOPGEN], 1u);
            else XB_SPIN(xb_ld(&bar[XB_TOPGEN]) == tg, bar);
            __builtin_amdgcn_fence(__ATOMIC_ACQUIRE, "agent");
            xb_add(&bar[XB_XGEN(b.x)], 1u);
            asm volatile("s_waitcnt vmcnt(0)" ::: "memory");
        } else {
            XB_SPIN(xb_ld(&bar[XB_XGEN(b.x)]) == gen, bar);
            __builtin_amdgcn_fence(__ATOMIC_ACQUIRE, "agent");
            asm volatile("s_waitcnt vmcnt(0)" ::: "memory");
        }
    }
    __syncthreads();
}


#ifdef NO_G0
#define XG0(x)
#else
#define XG0(x) x
#endif
#ifdef NO_G1
#define XG1(x)
#else
#define XG1(x) x
#endif
#ifdef NO_BC
#define XBC(x)
#else
#define XBC(x) x
#endif
#ifdef NO_AC
#define XAC(x)
#else
#define XAC(x) x
#endif
#ifdef NO_P0
#define XP0(x)
#else
#define XP0(x) x
#endif
#ifdef NO_R
#define XR(x)
#else
#define XR(x) x
#endif
#ifdef NO_BL
#define XBL(x)
#else
#define XBL(x) x
#endif
#ifdef NO_CL
#define XCL(x)
#else
#define XCL(x) x
#endif
#ifdef NO_A0
#define XA0(x)
#else
#define XA0(x) x
#endif
#ifdef NO_A1
#define XA1(x)
#else
#define XA1(x) x
#endif
#ifdef NO_BS
#define XBS(x)
#else
#define XBS(x) x
#endif
#ifdef NO_CS
#define XCS(x)
#else
#define XCS(x) x
#endif
__global__ void __launch_bounds__(256, 2) fwd_mega(P p) {
  extern __shared__ __attribute__((aligned(16))) char smem[];
  cg::grid_group grid = cg::this_grid();
  const int G = gridDim.x;
  __shared__ uint4 xb_words;
  if (threadIdx.x == 0) xb_words = make_uint4(0u, 0u, 0u, 0u);
  __syncthreads();
  XcdBarrier xb = xcd_barrier_post((unsigned*)(p.ws + O_BAR), (volatile LAS unsigned*)&xb_words);
  XP0(phase0(p, smem));
  if (p.ws == nullptr) grid.sync();
  xcd_barrier(xb);
  u16* z = (u16*)(p.ws + O_Z);
  u16* zT = (u16*)(p.ws + O_ZT);
  float* ab = (float*)(p.ws + O_AB);
  float* o = (float*)(p.ws + O_BSH);
  const u16* u = (const u16*)(p.ws + O_BIT);
  for (int g = 0; g < NG; ++g) {
    XR(phaseR(p, g, 0));
    xcd_barrier(xb);
    for (int l = 0; l < DEPTH; ++l) {
      for (int rep = 0; rep < REP_G; ++rep) {
        const u16* Bt = (const u16*)(p.ws + O_WTIN) + (size_t)l * NZ * 1024;
        if ((G & 7) == 0) {
          const int x = blockIdx.x & 7, bl = blockIdx.x >> 3, nbl = G >> 3;
          for (int q = bl; q < 9 * 45; q += nbl) { XG0(gemm_tile<0>(u, 1024, Bt, 1024, 9 * x + q % 9, q / 9, z, zT, ab, o, smem)); }
        } else {
          for (int t = blockIdx.x; t < 72 * 45; t += G) { XG0(gemm_tile<0>(u, 1024, Bt, 1024, t % 72, t / 72, z, zT, ab, o, smem)); }
        }
      }
      xcd_barrier(xb);
      for (int rep2 = 0; rep2 < REP_M; ++rep2) {
      for (int rep3 = 0; rep3 < REP_A; ++rep3) {
        if (rep3) xcd_barrier(xb);
        const int nb = NCH * 4, nc = NCH * 4, na = NCH * 8;
        if (G == 512) {
          const int bx = blockIdx.x;
          XCL(c_local2(p, l, bx, smem));
          if (bx < 64) { XCL(c_local2(p, l, 512 + bx, smem)); }
          XBL(b_local(p, l, bx, smem));
          if (bx >= 64 && bx < 128) { XBL(b_local(p, l, 448 + bx, smem)); }
          if (bx < 128) { XA0(a_item(p, l, bx, 0, smem)); }
          else {
            for (int t = 128 + (bx - 128); t < na; t += 384) { XA0(a_item(p, l, t, 0, smem)); }
          }
        } else {
          for (int t = blockIdx.x; t < nb + nc + na; t += G) {
            if (t < nc) { XCL(c_local2(p, l, t, smem)); }
            else if (t < nb + nc) { XBL(b_local(p, l, t - nc, smem)); }
            else { XA0(a_item(p, l, t - nb - nc, 0, smem)); }
          }
        }
      }
      xcd_barrier(xb);
      {
        for (int t = blockIdx.x; t < 256 + 16; t += G) {
          if (t < 128) { XBS(b_seq2(p, t, smem)); }
          else if (t < 256) { XCS(c_seq2(p, t - 128, smem)); }
          else { XAC(a_carry(p, t - 256)); }
        }
      }
      xcd_barrier(xb);
      }
      {
        const int na = NCH * 8, nm = GR / 8;
        for (int t = blockIdx.x; t < na + nm; t += G) {
          if (t < na) { XA1(a_fin2(p, l, t, smem)); }
          else { XBC(bc_merge(p, l, t - na)); }
        }
      }
      xcd_barrier(xb);
      for (int rep = 0; rep < REP_G; ++rep) {
        const u16* Bt = (const u16*)(p.ws + O_WTOUT) + (size_t)l * 1024 * 1536;
        if (l == DEPTH - 1) {
          for (int t = blockIdx.x; t < 64 * 8; t += G) {
            const int q = t % 64, rt = (q >> 4) * 18 + 2 + (q & 15);
            XG1(gemm_tile<1>(z + C_GA, NZ, Bt, 1536, rt, t / 64, z, zT, ab, o, smem));
          }
        } else {
          for (int t = blockIdx.x; t < 72 * 8; t += G) { XG1(gemm_tile<1>(z + C_GA, NZ, Bt, 1536, t % 72, t / 72, z, zT, ab, o, smem)); }
        }
      }
      xcd_barrier(xb);
      XR(phaseR(p, g, l + 1));
      if (l + 1 < DEPTH) xcd_barrier(xb);
    }
  }
}

extern "C" void kernel_launch(void* const* d_in, const int* in_sizes, int n_in, void* d_out, int out_size, void* d_ws,
                              size_t ws_size, hipStream_t stream) {
  static int grid_blocks = 0;
  if (!grid_blocks) {
    int dev = 0, cus = 0, per_cu = 0;
    hipGetDevice(&dev);
    hipDeviceGetAttribute(&cus, hipDeviceAttributeMultiprocessorCount, dev);
    hipFuncSetAttribute((const void*)fwd_mega, hipFuncAttributeMaxDynamicSharedMemorySize, LDS_BYTES);
    hipOccupancyMaxActiveBlocksPerMultiprocessor(&per_cu, fwd_mega, 256, LDS_BYTES);
    if (per_cu > 2) per_cu = 2;
    if (per_cu < 1) per_cu = 1;
    grid_blocks = cus * per_cu;
  }
  if (ws_size < WS_TOTAL) {
    fprintf(stderr, "workspace too small: %zu < %zu\n", ws_size, (size_t)WS_TOTAL);
    return;
  }
  P p{};
  const float** f = (const float**)&p;
  for (int i = 0; i < 23; ++i) f[i] = (const float*)d_in[i];
  p.out = (float*)d_out;
  p.ws = (char*)d_ws;
  hipMemsetAsync((char*)d_ws + O_BAR, 0, XCD_BAR_WORDS * 4, stream);
  void* args[] = {&p};
  hipError_t e = hipLaunchCooperativeKernel((void*)fwd_mega, dim3(grid_blocks), dim3(256), args, LDS_BYTES, stream);
  if (e != hipSuccess) fprintf(stderr, "cooperative launch failed: %s (grid %d)\n", hipGetErrorString(e), grid_blocks);
}
```

```cpp
#include <hip/hip_runtime.h>
#include <hip/hip_cooperative_groups.h>
#include <cstdio>
namespace cg = cooperative_groups;

typedef __attribute__((ext_vector_type(8))) short bf16x8;
typedef __attribute__((ext_vector_type(4))) float f32x4;
typedef unsigned short u16;
#define DEV __device__ __forceinline__

constexpr int DM = 1024, TL = 2048, TCX = 256, TS = 2304, GB = 4, GR = GB * TS, NG = 2;
constexpr int NZ = 5760, DEPTH = 4;
constexpr int C_XA = 0, C_Q = 512, C_K = 1024, C_V = 1536, C_QC = 2048, C_F0 = 2560, C_IC = 3584,
              C_GA = 4096, C_GB = 4608, C_GC = 5120, C_AB = 5632;
constexpr int NCH = GR / 64;
constexpr float EPS = 1e-6f;
constexpr int WPB = 2;

constexpr size_t al256(size_t x) { return (x + 255) & ~(size_t)255; }
constexpr size_t O_WTIN = 0;
constexpr size_t O_WTOUT = O_WTIN + al256((size_t)DEPTH * NZ * 1024 * 2);
constexpr size_t O_WGT = O_WTOUT + al256((size_t)DEPTH * 1024 * 1536 * 2);
constexpr size_t O_MOD = O_WGT + al256((size_t)DEPTH * 2 * 2 * 8 * 4096 * 2);
constexpr size_t O_LBS = O_MOD + al256((size_t)DEPTH * 9 * 3072 * 4);
constexpr size_t O_HC = O_LBS + al256((size_t)DEPTH * 1024 * 4);
constexpr size_t O_Z = O_HC + al256((size_t)GB * TCX * 1024 * 4);
constexpr size_t O_ZT = O_Z + al256((size_t)GR * NZ * 2);
constexpr size_t O_AB = O_ZT + al256((size_t)512 * GR * 2);
constexpr size_t O_BSH = O_AB + al256((size_t)GR * 16 * 4);
constexpr size_t BSH_ONE = (size_t)GR * 512 * 2;
constexpr size_t O_BIT = O_BSH + al256(4 * BSH_ONE);
constexpr size_t BIT_SZ = 17408;
constexpr size_t O_CREC = O_BIT + al256((size_t)NCH * 4 * 2 * BIT_SZ);
constexpr size_t CREC_SZ = 33280;
constexpr size_t O_OB = O_CREC + al256((size_t)NCH * 4 * 2 * CREC_SZ);
constexpr size_t O_OC = O_OB + al256((size_t)2 * GR * 512 * 2);
constexpr size_t O_AP = O_OC + al256((size_t)2 * GR * 512 * 2);
constexpr size_t O_AH = O_AP + al256((size_t)NCH * 2 * 512 * 4);
constexpr size_t O_ACAR = O_AH + al256((size_t)NCH * 2 * 512 * 4);
constexpr size_t O_ALA = O_ACAR + al256((size_t)NCH * 2 * 512 * 4);
constexpr size_t O_AU = O_ALA + al256((size_t)2 * GR * 512 * 2);
constexpr size_t O_BAR = O_AU + al256((size_t)2 * GR * 512 * 2);
constexpr size_t WS_TOTAL = O_BAR + al256(3456 * 4);

constexpr int LDS_BYTES = 73728;
#ifndef REP_A
#define REP_A 1
#endif
#ifndef REP_G
#define REP_G 1
#endif
#ifndef REP_M
#define REP_M 1
#endif

struct P {
  const float *x, *c, *ctx, *c_ctx, *w_ada, *b_ada, *norm_pre, *norm_post, *w_in, *conv_a_w, *conv_a_b, *rg_w_r,
      *rg_b_r, *rg_w_i, *rg_b_i, *rg_lam, *conv_b_w, *gdn_a_log, *gdn_dt_bias, *gdn_norm, *hg_lb, *hg_norm, *w_out;
  float* out;
  char* ws;
};

DEV int opq(int x) { asm volatile("" : "+v"(x)); return x; }
DEV int opqs(int x) { asm volatile("" : "+s"(x)); return x; }
typedef __attribute__((ext_vector_type(2))) __bf16 bf16x2_t;
typedef __attribute__((ext_vector_type(2))) float f32x2_t;
DEV u16 f2bf(float f) { __bf16 r = (__bf16)f; return __builtin_bit_cast(u16, r); }
DEV float bf2f(u16 h) { return __uint_as_float(((unsigned)h) << 16); }
DEV unsigned pk2(float a, float b) { f32x2_t v = {a, b}; bf16x2_t r = __builtin_convertvector(v, bf16x2_t); return __builtin_bit_cast(unsigned, r); }
DEV float sigm(float x) { return __builtin_amdgcn_rcpf(1.f + __expf(-x)); }
DEV float silu(float x) { return x * __builtin_amdgcn_rcpf(1.f + __expf(-x)); }
DEV float softplus(float x) { return x > 20.f ? x : log1pf(__expf(x)); }
DEV f32x4 mfma(bf16x8 a, bf16x8 b, f32x4 c) { return __builtin_amdgcn_mfma_f32_16x16x32_bf16(a, b, c, 0, 0, 0); }
DEV bf16x8 ld8(const u16* p) { return *reinterpret_cast<const bf16x8*>(p); }
DEV int lat_map(int l, int t) { return (l & 1) ? ((t & 63) * 32 + (t >> 6)) : t; }
DEV int orig_col(int n) {
  if (n < 512) return n;
  if (n < 2048) return n + 512;
  if (n < 4096) return n + 1040;
  if (n < 4608) return n - 4096 + 512;
  if (n < 5120) return n - 4608 + 2576;
  if (n < 5632) return n + 16;
  if (n < 5648) return n - 5632 + 2560;
  return -1;
}
DEV float zval(const u16* z, int rb, int cp, int n, int col) {
  if (cp < 0 && (n == 0 || n == 4)) return 0.f;
  if (cp > 63 && (n == 3 || n == 35)) return 0.f;
  return bf2f(z[(size_t)(rb + cp) * NZ + col]);
}

DEV void ph0_ada(const P& p, int item, char* smem) {
  float* sc = (float*)smem;
  float* red = (float*)(smem + 36864);
  const int tid = threadIdx.x, lane = tid & 63, wv = tid >> 6;
  for (int i = tid; i < 9 * 1024; i += 256) {
    int v = i >> 10, d = i & 1023;
    float cv = (v < 8) ? p.c[v * 1024 + d] : p.c_ctx[d];
    sc[i] = silu(cv);
  }
  __syncthreads();
  const int col = item * 64 + lane;
  const int l = col / 3072, e = col % 3072;
  const float* w = p.w_ada + (size_t)l * 1024 * 3072 + e + (size_t)(256 * wv) * 3072;
  const float* scw = sc + 256 * wv;
  float acc[9];
#pragma unroll
  for (int i = 0; i < 9; ++i) acc[i] = 0.f;
  for (int d = 0; d < 256; d += 16) {
    float wr[16];
#pragma unroll
    for (int k = 0; k < 16; ++k) wr[k] = w[(size_t)(d + k) * 3072];
#pragma unroll
    for (int k = 0; k < 16; ++k)
#pragma unroll
      for (int i = 0; i < 9; ++i) acc[i] += scw[i * 1024 + d + k] * wr[k];
  }
#pragma unroll
  for (int i = 0; i < 9; ++i) red[(wv * 9 + i) * 64 + lane] = acc[i];
  __syncthreads();
  float* mod = (float*)(p.ws + O_MOD);
  for (int idx = tid; idx < 9 * 64; idx += 256) {
    int i = idx >> 6, ln = idx & 63;
    float sum = red[(0 * 9 + i) * 64 + ln] + red[(1 * 9 + i) * 64 + ln] + red[(2 * 9 + i) * 64 + ln] + red[(3 * 9 + i) * 64 + ln];
    int cc = item * 64 + ln, l2 = cc / 3072, e2 = cc % 3072;
    mod[((size_t)l2 * 9 + i) * 3072 + e2] = sum + p.b_ada[l2 * 3072 + e2];
  }
  __syncthreads();
}
DEV void tconv_tile(const float* src, int lds_, u16* dst, int ldd, int k0, int n0, bool mapcol, char* smem) {
  float* t = (float*)smem;
  const int tid = threadIdx.x, nn = tid & 63, kq = tid >> 6;
  const int n = n0 + nn;
  const int sn0 = mapcol ? orig_col(n) : n;
  const float msk = (sn0 >= 0) ? 1.f : 0.f;
  const int sn = sn0 >= 0 ? sn0 : 0;
  float v[16];
#pragma unroll
  for (int k = 0; k < 16; ++k) v[k] = src[(size_t)(k0 + kq + 4 * k) * lds_ + sn];
#pragma unroll
  for (int k = 0; k < 16; ++k) t[(kq + 4 * k) * 65 + nn] = v[k] * msk;
  __syncthreads();
  {
    const int kk = tid & 63, nq = tid >> 6;
#pragma unroll
    for (int k = 0; k < 16; ++k) {
      int n2 = nq + 4 * k;
      dst[(size_t)(n0 + n2) * ldd + k0 + kk] = f2bf(t[kk * 65 + n2]);
    }
  }
  __syncthreads();
}
DEV void phase0(const P& p, char* smem) {
  const int n_ada = 192, n_in = DEPTH * 16 * 90, n_out = DEPTH * 24 * 16, n_g = 128, n_lb = 4;
  const int total = n_ada + n_in + n_out + n_g + n_lb;
  for (int it = blockIdx.x; it < total; it += gridDim.x) {
    int i = it;
    if (i < n_ada) { ph0_ada(p, i, smem); continue; }
    i -= n_ada;
    if (i < n_in) {
      int l = i / 1440, r = i % 1440, kt = r / 90, nt = r % 90;
      tconv_tile(p.w_in + (size_t)l * 1024 * 5648, 5648, (u16*)(p.ws + O_WTIN) + (size_t)l * NZ * 1024, 1024, kt * 64,
                 nt * 64, true, smem);
      continue;
    }
    i -= n_in;
    if (i < n_out) {
      int l = i / 384, r = i % 384, kt = r / 16, nt = r % 16;
      tconv_tile(p.w_out + (size_t)l * 1536 * 1024, 1024, (u16*)(p.ws + O_WTOUT) + (size_t)l * 1024 * 1536, 1536,
                 kt * 64, nt * 64, false, smem);
      continue;
    }
    i -= n_out;
    if (i < n_g) {
      int h = i & 7, gate = (i >> 3) & 1, dir = (i >> 4) & 1, l = i >> 5;
      const float* src = (gate ? p.rg_w_i : p.rg_w_r) + ((size_t)(l * 2 + dir) * 8 + h) * 4096;
      tconv_tile(src, 64, (u16*)(p.ws + O_WGT) + (size_t)i * 4096, 64, 0, 0, false, smem);
      continue;
    }
    i -= n_g;
    {
      int j = i * 256 + threadIdx.x;
      float v[4], mx = -1e30f;
      for (int l = 0; l < 4; ++l) { v[l] = p.hg_lb[l * 1024 + j]; mx = fmaxf(mx, v[l]); }
      float s = 0.f;
      for (int l = 0; l < 4; ++l) { v[l] = __expf(v[l] - mx); s += v[l]; }
      float* lbs = (float*)(p.ws + O_LBS);
      float cum = 0.f;
      for (int l = 0; l < 4; ++l) {
        if (l > 0) cum += v[l] / s;
        lbs[l * 1024 + j] = cum;
      }
    }
  }
}

DEV void phaseR(const P& p, int g, int l) {
  const int tid_ = opq(threadIdx.x); const int lane = tid_ & 63, w = tid_ >> 6;
  const float* mod = (const float*)(p.ws + O_MOD);
  float* hc = (float*)(p.ws + O_HC);
  const float* o = (const float*)(p.ws + O_BSH);
  u16* u = (u16*)(p.ws + O_BIT);
  for (int it = blockIdx.x; it < GR / 4; it += gridDim.x) {
    int lr = it * 4 + w;
    int lb = lr / TS, s = lr % TS;
    bool isctx = s < TCX;
    if (l == DEPTH && isctx) continue;
    int b = g * GB + lb, t = s - TCX;
    int mi = isctx ? 8 : b;
    float* hp = isctx ? hc + ((size_t)lb * TCX + s) * 1024 : p.out + ((size_t)b * TL + t) * 1024;
    float hv[16];
    if (l == 0) {
      const float* src = isctx ? p.ctx + ((size_t)b * TCX + s) * 1024 : p.x + ((size_t)b * TL + t) * 1024;
#pragma unroll
      for (int k = 0; k < 4; ++k) {
        float4 v = *(const float4*)(src + k * 256 + lane * 4);
        hv[k * 4] = v.x; hv[k * 4 + 1] = v.y; hv[k * 4 + 2] = v.z; hv[k * 4 + 3] = v.w;
      }
    } else {
      int orow = lb * TS + (isctx ? s : TCX + lat_map(l - 1, t));
      const u16* op = (const u16*)o + (size_t)orow * 1024;
      float ov[16], ss = 0.f;
#pragma unroll
      for (int k = 0; k < 4; ++k) {
        uint2 pv = *(const uint2*)(op + k * 256 + lane * 4);
        float4 v = make_float4(bf2f((u16)(pv.x & 0xffff)), bf2f((u16)(pv.x >> 16)), bf2f((u16)(pv.y & 0xffff)), bf2f((u16)(pv.y >> 16)));
        ov[k * 4] = v.x; ov[k * 4 + 1] = v.y; ov[k * 4 + 2] = v.z; ov[k * 4 + 3] = v.w;
        ss += v.x * v.x + v.y * v.y + v.z * v.z + v.w * v.w;
      }
#pragma unroll
      for (int off = 32; off; off >>= 1) ss += __shfl_xor(ss, off);
      float rinv = rsqrtf(ss * (1.f / 1024.f) + EPS);
      const float* gate = mod + ((size_t)(l - 1) * 9 + mi) * 3072 + 2048;
      const float* wp = p.norm_post + (l - 1) * 1024;
#pragma unroll
      for (int k = 0; k < 4; ++k) {
        float4 hh = *(const float4*)(hp + k * 256 + lane * 4);
        float4 gg = *(const float4*)(gate + k * 256 + lane * 4);
        float4 ww = *(const float4*)(wp + k * 256 + lane * 4);
        hv[k * 4] = hh.x + gg.x * (ov[k * 4] * rinv * ww.x);
        hv[k * 4 + 1] = hh.y + gg.y * (ov[k * 4 + 1] * rinv * ww.y);
        hv[k * 4 + 2] = hh.z + gg.z * (ov[k * 4 + 2] * rinv * ww.z);
        hv[k * 4 + 3] = hh.w + gg.w * (ov[k * 4 + 3] * rinv * ww.w);
      }
    }
#pragma unroll
    for (int k = 0; k < 4; ++k)
      *(float4*)(hp + k * 256 + lane * 4) = make_float4(hv[k * 4], hv[k * 4 + 1], hv[k * 4 + 2], hv[k * 4 + 3]);
    if (l < DEPTH) {
      float ss = 0.f;
#pragma unroll
      for (int k = 0; k < 16; ++k) ss += hv[k] * hv[k];
#pragma unroll
      for (int off = 32; off; off >>= 1) ss += __shfl_xor(ss, off);
      float rinv = rsqrtf(ss * (1.f / 1024.f) + EPS);
      const float* sh = mod + ((size_t)l * 9 + mi) * 3072;
      const float* wp = p.norm_pre + l * 1024;
      int urow = lb * TS + (isctx ? s : TCX + lat_map(l, t));
      u16* up = u + (size_t)urow * 1024;
#pragma unroll
      for (int k = 0; k < 4; ++k) {
        float4 ww = *(const float4*)(wp + k * 256 + lane * 4);
        float4 s0 = *(const float4*)(sh + k * 256 + lane * 4);
        float4 s1 = *(const float4*)(sh + 1024 + k * 256 + lane * 4);
        float a0 = hv[k * 4] * rinv * ww.x * (1.f + s1.x) + s0.x;
        float a1 = hv[k * 4 + 1] * rinv * ww.y * (1.f + s1.y) + s0.y;
        float a2 = hv[k * 4 + 2] * rinv * ww.z * (1.f + s1.z) + s0.z;
        float a3 = hv[k * 4 + 3] * rinv * ww.w * (1.f + s1.w) + s0.w;
        uint2 pk; pk.x = pk2(a0, a1); pk.y = pk2(a2, a3);
        *(uint2*)(up + k * 256 + lane * 4) = pk;
      }
    }
  }
}

template <int MODE>
DEV void gemm_tile(const u16* __restrict__ A, int lda, const u16* __restrict__ Bt, int K, int rt, int ct, u16* z,
                   u16* zT, float* ab, float* o, char* smem) {
  u16* As = (u16*)smem;
  u16* Bs = As + 128 * 64;
  const int tid = opq(threadIdx.x), lane = tid & 63, w = tid >> 6, wr = w >> 1, wc = w & 1, fr = lane & 15, fq = lane >> 4;
  const int lrow = tid >> 3, lseg = tid & 7;
  const int wsw = (lseg ^ ((lrow >> 1) & 7)) * 8;
  const int rsw = (fr >> 1) & 7;
  const u16* Ag = A + (size_t)(rt * 128 + lrow) * lda + lseg * 8;
  const u16* Bg = Bt + (size_t)(ct * 128 + lrow) * K + lseg * 8;
  uint4 pa0, pa1, pa2, pa3, pb0, pb1, pb2, pb3;
  uint4 qa0, qa1, qa2, qa3, qb0, qb1, qb2, qb3;
  f32x4 acc[4][4];
#pragma unroll
  for (int i = 0; i < 4; ++i)
#pragma unroll
    for (int j = 0; j < 4; ++j) acc[i][j] = (f32x4){0.f, 0.f, 0.f, 0.f};
  const int nk = K / 64;
#define GLD(S, kk)                                                            \
  {                                                                           \
    const int kc_ = ((kk) < nk ? (kk) : nk - 1) * 64;                         \
    S##a0 = *(const uint4*)(Ag + kc_);                                        \
    S##a1 = *(const uint4*)(Ag + kc_ + (size_t)32 * lda);                     \
    S##a2 = *(const uint4*)(Ag + kc_ + (size_t)64 * lda);                     \
    S##a3 = *(const uint4*)(Ag + kc_ + (size_t)96 * lda);                     \
    S##b0 = *(const uint4*)(Bg + kc_);                                        \
    S##b1 = *(const uint4*)(Bg + kc_ + (size_t)32 * K);                       \
    S##b2 = *(const uint4*)(Bg + kc_ + (size_t)64 * K);                       \
    S##b3 = *(const uint4*)(Bg + kc_ + (size_t)96 * K);                       \
  }
#define GST(S, bufo)                                                          \
  *(uint4*)(As + (bufo) + (lrow)*64 + wsw) = S##a0;                      \
  *(uint4*)(As + (bufo) + (lrow + 32) * 64 + wsw) = S##a1;               \
  *(uint4*)(As + (bufo) + (lrow + 64) * 64 + wsw) = S##a2;               \
  *(uint4*)(As + (bufo) + (lrow + 96) * 64 + wsw) = S##a3;               \
  *(uint4*)(Bs + (bufo) + (lrow)*64 + wsw) = S##b0;                      \
  *(uint4*)(Bs + (bufo) + (lrow + 32) * 64 + wsw) = S##b1;               \
  *(uint4*)(Bs + (bufo) + (lrow + 64) * 64 + wsw) = S##b2;               \
  *(uint4*)(Bs + (bufo) + (lrow + 96) * 64 + wsw) = S##b3;
#define GCOMP(cb)                                                                                           \
  _Pragma("unroll") for (int ks = 0; ks < 2; ++ks) {                                                        \
    bf16x8 af[4], bfr[4];                                                                                   \
    _Pragma("unroll") for (int mi = 0; mi < 4; ++mi)                                                        \
        af[mi] = ld8(As + (cb) + (wr * 64 + mi * 16 + fr) * 64 + (((ks * 4 + fq) ^ rsw) * 8));                         \
    _Pragma("unroll") for (int ni = 0; ni < 4; ++ni)                                                        \
        bfr[ni] = ld8(Bs + (cb) + (wc * 64 + ni * 16 + fr) * 64 + (((ks * 4 + fq) ^ rsw) * 8));                        \
    _Pragma("unroll") for (int mi = 0; mi < 4; ++mi)                                                        \
        _Pragma("unroll") for (int ni = 0; ni < 4; ++ni) acc[mi][ni] = mfma(af[mi], bfr[ni], acc[mi][ni]);  \
  }
  constexpr int BUF1 = 2 * 128 * 64;
  GLD(p, 0)
  GLD(q, 1)
  GST(p, 0)
  __syncthreads();
  GLD(p, 2)
  for (int kt = 0; kt < nk; kt += 2) {
    GCOMP(0)
    GST(q, BUF1)
    GLD(q, kt + 3)
    __syncthreads();
    GCOMP(BUF1)
    GST(p, 0)
    GLD(p, kt + 4)
    __syncthreads();
  }
#pragma unroll
  for (int mi = 0; mi < 4; ++mi)
#pragma unroll
    for (int ni = 0; ni < 4; ++ni) {
      int row0 = rt * 128 + wr * 64 + mi * 16 + fq * 4;
      int col = ct * 128 + wc * 64 + ni * 16 + fr;
      f32x4 v = acc[mi][ni];
      if (MODE == 1) {
#pragma unroll
        for (int r = 0; r < 4; ++r) ((u16*)o)[(size_t)(row0 + r) * 1024 + col] = f2bf(v[r]);
      } else {
        if (ct >= 28 && ct < 32) {
          uint2 pk; pk.x = pk2(v[0], v[1]); pk.y = pk2(v[2], v[3]);
          *(uint2*)(zT + (size_t)(col - C_IC) * GR + row0) = pk;
        } else if (ct == 44) {
          if (col - C_AB < 16) {
#pragma unroll
            for (int r = 0; r < 4; ++r) ab[(size_t)(row0 + r) * 16 + (col - C_AB)] = v[r];
          }
        } else {
#pragma unroll
          for (int r = 0; r < 4; ++r) z[(size_t)(row0 + r) * NZ + col] = f2bf(v[r]);
        }
      }
    }
}

DEV void a_item(const P& p, int l, int item, int mode, char* smem) {
  float* xc = (float*)smem;
  u16* xcb = (u16*)(smem + 16384);
  float* av = (float*)(smem + 16384 + 9216);
  float* uv = av + 4096;
  float* segP = uv + 4096;
  float* segH = segP + 256;
  const int tid = opq(threadIdx.x), lane = tid & 63, w = tid >> 6, fr = lane & 15, fq = lane >> 4;
  const int cgk = item >> 3, hA = item & 7, n = cgk % 36, rb = cgk * 64;
  u16* z = (u16*)(p.ws + O_Z);
  {
    u16* xin = (u16*)av;
    uint4 st[3];
#pragma unroll
    for (int k = 0; k < 3; ++k) {
      int idx = tid + 256 * k, row = idx >> 3, sg = idx & 7, cp = row - 2;
      bool ok = (idx < 536) && !((cp < 0 && (n == 0 || n == 4)) || (cp > 63 && (n == 3 || n == 35)));
      st[k] = make_uint4(0u, 0u, 0u, 0u);
      if (ok) st[k] = *(const uint4*)(z + (size_t)(rb + cp) * NZ + C_XA + hA * 64 + sg * 8);
    }
    const int j = tid & 63, ch = hA * 64 + j;
    float cw0 = p.conv_a_w[(l * 4 + 0) * 512 + ch], cw1 = p.conv_a_w[(l * 4 + 1) * 512 + ch];
    float cw2 = p.conv_a_w[(l * 4 + 2) * 512 + ch], cw3 = p.conv_a_w[(l * 4 + 3) * 512 + ch];
    float cb = p.conv_a_b[l * 512 + ch];
#pragma unroll
    for (int k = 0; k < 3; ++k) {
      int idx = tid + 256 * k, row = idx >> 3, sg = idx & 7;
      if (idx < 536) *(uint4*)(xin + row * 72 + sg * 8) = st[k];
    }
    __syncthreads();
#pragma unroll
    for (int k = 0; k < 16; ++k) {
      int c = (tid >> 6) + 4 * k;
      float val = cb + cw0 * bf2f(xin[c * 72 + j]) + cw1 * bf2f(xin[(c + 1) * 72 + j]) + cw2 * bf2f(xin[(c + 2) * 72 + j]) +
                  cw3 * bf2f(xin[(c + 3) * 72 + j]);
      xc[c * 64 + j] = val;
      xcb[c * 72 + j] = f2bf(val);
    }
  }
  __syncthreads();
  float yacc[16];
#pragma unroll
  for (int k = 0; k < 16; ++k) yacc[k] = 0.f;
  const int seg = tid >> 6, sj = tid & 63, sch = hA * 64 + sj;
  for (int dir = 0; dir < 2; ++dir) {
    {
      const u16* wg = (const u16*)(p.ws + O_WGT);
      const u16* wr_ = wg + (size_t)((((l * 2 + dir) * 2 + 0) * 8 + hA)) * 4096;
      const u16* wi_ = wg + (size_t)((((l * 2 + dir) * 2 + 1) * 8 + hA)) * 4096;
      bf16x8 a0 = ld8(xcb + (16 * w + fr) * 72 + fq * 8), a1 = ld8(xcb + (16 * w + fr) * 72 + 32 + fq * 8);
#pragma unroll
      for (int nt = 0; nt < 4; ++nt) {
        f32x4 ar = {0.f, 0.f, 0.f, 0.f}, ai = {0.f, 0.f, 0.f, 0.f};
        const u16* br = wr_ + (nt * 16 + fr) * 64 + fq * 8;
        const u16* bi = wi_ + (nt * 16 + fr) * 64 + fq * 8;
        ar = mfma(a0, ld8(br), ar); ar = mfma(a1, ld8(br + 32), ar);
        ai = mfma(a0, ld8(bi), ai); ai = mfma(a1, ld8(bi + 32), ai);
        int j = nt * 16 + fr, ch = hA * 64 + j;
        float brv = p.rg_b_r[(l * 2 + dir) * 512 + ch], biv = p.rg_b_i[(l * 2 + dir) * 512 + ch];
        float sp = softplus(-p.rg_lam[(l * 2 + dir) * 512 + ch]);
#pragma unroll
        for (int r = 0; r < 4; ++r) {
          int c = 16 * w + 4 * fq + r;
          float rg = sigm(ar[r] + brv), ig = sigm(ai[r] + biv);
          float la = -8.f * rg * sp;
          float a = __expf(la);
          float t2 = 2.f * la;
          float om = (t2 > -0.02f) ? -t2 * (1.f + 0.5f * t2 * (1.f + t2 * (1.f / 3.f) * (1.f + 0.25f * t2))) : 1.f - a * a;
          float uu = sqrtf(fmaxf(om, 0.f)) * (ig * xc[c * 64 + j]);
          av[c * 64 + j] = bf2f(f2bf(la));
          uv[c * 64 + j] = bf2f(f2bf(uu));
        }
      }
    }
    __syncthreads();
    {
      float ls = 0.f, H = 0.f;
      u16* ALA = (u16*)(p.ws + O_ALA);
      u16* AU = (u16*)(p.ws + O_AU);
#pragma unroll
      for (int k = 0; k < 16; ++k) {
        int c = dir ? (16 * seg + 15 - k) : (16 * seg + k);
        float la_ = av[c * 64 + sj], u_ = uv[c * 64 + sj];
        H = __expf(la_) * H + u_;
        ls += la_;
        size_t gi = ((size_t)dir * GR + rb + c) * 512 + sch;
        ALA[gi] = f2bf(la_);
        AU[gi] = f2bf(u_);
      }
      segP[seg * 64 + sj] = __expf(ls);
      segH[seg * 64 + sj] = H;
    }
    __syncthreads();
    if (mode == 0) {
      if (seg == 0) {
        float Pc = 1.f, Hc = 0.f;
        for (int q = 0; q < 4; ++q) {
          int sg = dir ? 3 - q : q;
          Hc = segP[sg * 64 + sj] * Hc + segH[sg * 64 + sj];
          Pc *= segP[sg * 64 + sj];
        }
        size_t idx = ((size_t)cgk * 2 + dir) * 512 + sch;
        ((float*)(p.ws + O_AP))[idx] = Pc;
        ((float*)(p.ws + O_AH))[idx] = Hc;
      }
    } else {
      float st = ((const float*)(p.ws + O_ACAR))[((size_t)cgk * 2 + dir) * 512 + sch];
      int nbefore = dir ? 3 - seg : seg;
      for (int q = 0; q < nbefore; ++q) {
        int sg = dir ? 3 - q : q;
        st = segP[sg * 64 + sj] * st + segH[sg * 64 + sj];
      }
      if (dir == 0) {
#pragma unroll
        for (int k = 0; k < 16; ++k) {
          int c = 16 * seg + k;
          st = av[c * 64 + sj] * st + uv[c * 64 + sj];
          yacc[k] += st;
        }
      } else {
#pragma unroll
        for (int k = 15; k >= 0; --k) {
          int c = 16 * seg + k;
          st = av[c * 64 + sj] * st + uv[c * 64 + sj];
          yacc[k] += st;
        }
      }
    }
    __syncthreads();
  }
  if (mode == 1) {
#pragma unroll
    for (int k = 0; k < 16; ++k) {
      size_t zi = (size_t)(rb + 16 * seg + k) * NZ + C_GA + sch;
      float gate = bf2f(z[zi]);
      z[zi] = f2bf(yacc[k] * silu(gate));
    }
  }
}

DEV void a_fin(const P& p, int l, int item, char* smem) {
  float* segP = (float*)smem;
  float* segH = segP + 512;
  const int tid = opq(threadIdx.x), seg = tid >> 6, sj = tid & 63;
  const int cgk = item >> 3, hA = item & 7, rb = cgk * 64, sch = hA * 64 + sj;
  u16* z = (u16*)(p.ws + O_Z);
  const u16* ALA = (const u16*)(p.ws + O_ALA);
  const u16* AU = (const u16*)(p.ws + O_AU);
  u16 lab[2][16], ub[2][16], gt[16];
#pragma unroll
  for (int dir = 0; dir < 2; ++dir)
#pragma unroll
    for (int k = 0; k < 16; ++k) {
      size_t gi = ((size_t)dir * GR + rb + 16 * seg + k) * 512 + sch;
      lab[dir][k] = ALA[gi];
      ub[dir][k] = AU[gi];
    }
#pragma unroll
  for (int k = 0; k < 16; ++k) gt[k] = z[(size_t)(rb + 16 * seg + k) * NZ + C_GA + sch];
  float car0 = ((const float*)(p.ws + O_ACAR))[((size_t)cgk * 2 + 0) * 512 + sch];
  float car1 = ((const float*)(p.ws + O_ACAR))[((size_t)cgk * 2 + 1) * 512 + sch];
  float af[2][16];
#pragma unroll
  for (int dir = 0; dir < 2; ++dir) {
    float ls = 0.f, H = 0.f;
#pragma unroll
    for (int kk = 0; kk < 16; ++kk) {
      const int k = dir ? 15 - kk : kk;
      float la_ = bf2f(lab[dir][k]);
      float a = __expf(la_);
      af[dir][k] = a;
      H = a * H + bf2f(ub[dir][k]);
      ls += la_;
    }
    segP[(dir * 4 + seg) * 64 + sj] = __expf(ls);
    segH[(dir * 4 + seg) * 64 + sj] = H;
  }
  __syncthreads();
  float yacc[16];
#pragma unroll
  for (int k = 0; k < 16; ++k) yacc[k] = 0.f;
#pragma unroll
  for (int dir = 0; dir < 2; ++dir) {
    float st = dir ? car1 : car0;
    const int nbefore = dir ? 3 - seg : seg;
    for (int q = 0; q < nbefore; ++q) {
      int sg = dir ? 3 - q : q;
      st = segP[(dir * 4 + sg) * 64 + sj] * st + segH[(dir * 4 + sg) * 64 + sj];
    }
#pragma unroll
    for (int kk = 0; kk < 16; ++kk) {
      const int k = dir ? 15 - kk : kk;
      st = af[dir][k] * st + bf2f(ub[dir][k]);
      yacc[k] += st;
    }
  }
#pragma unroll
  for (int k = 0; k < 16; ++k)
    z[(size_t)(rb + 16 * seg + k) * NZ + C_GA + sch] = f2bf(yacc[k] * silu(bf2f(gt[k])));
  __syncthreads();
}

DEV void a_fin2(const P& p, int l, int item, char* smem) {
  float* segP = (float*)smem;
  float* segH = segP + 1024;
  const int tid = opq(threadIdx.x), sg = tid >> 5, cp = tid & 31;
  const int cgk = item >> 3, hA = item & 7, rb = cgk * 64, sch = hA * 64 + 2 * cp;
  u16* z = (u16*)(p.ws + O_Z);
  const u16* ALA = (const u16*)(p.ws + O_ALA);
  const u16* AU = (const u16*)(p.ws + O_AU);
  unsigned lab[2][8], ub[2][8], gt[8];
#pragma unroll
  for (int dir = 0; dir < 2; ++dir)
#pragma unroll
    for (int k = 0; k < 8; ++k) {
      size_t gi = ((size_t)dir * GR + rb + 8 * sg + k) * 512 + sch;
      lab[dir][k] = *(const unsigned*)(ALA + gi);
      ub[dir][k] = *(const unsigned*)(AU + gi);
    }
#pragma unroll
  for (int k = 0; k < 8; ++k) gt[k] = *(const unsigned*)(z + (size_t)(rb + 8 * sg + k) * NZ + C_GA + sch);
  const float2 car0 = *(const float2*)((const float*)(p.ws + O_ACAR) + ((size_t)cgk * 2 + 0) * 512 + sch);
  const float2 car1 = *(const float2*)((const float*)(p.ws + O_ACAR) + ((size_t)cgk * 2 + 1) * 512 + sch);
  float af[2][8][2];
#pragma unroll
  for (int dir = 0; dir < 2; ++dir) {
    float ls0 = 0.f, ls1 = 0.f, H0 = 0.f, H1 = 0.f;
#pragma unroll
    for (int kk = 0; kk < 8; ++kk) {
      const int k = dir ? 7 - kk : kk;
      float l0 = bf2f((u16)(lab[dir][k] & 0xffff)), l1 = bf2f((u16)(lab[dir][k] >> 16));
      float a0 = __expf(l0), a1 = __expf(l1);
      af[dir][k][0] = a0; af[dir][k][1] = a1;
      H0 = a0 * H0 + bf2f((u16)(ub[dir][k] & 0xffff));
      H1 = a1 * H1 + bf2f((u16)(ub[dir][k] >> 16));
      ls0 += l0; ls1 += l1;
    }
    *(float2*)(segP + (dir * 8 + sg) * 64 + 2 * cp) = make_float2(__expf(ls0), __expf(ls1));
    *(float2*)(segH + (dir * 8 + sg) * 64 + 2 * cp) = make_float2(H0, H1);
  }
  __syncthreads();
  float y0[8], y1[8];
#pragma unroll
  for (int k = 0; k < 8; ++k) { y0[k] = 0.f; y1[k] = 0.f; }
#pragma unroll
  for (int dir = 0; dir < 2; ++dir) {
    float s0 = dir ? car1.x : car0.x, s1 = dir ? car1.y : car0.y;
    const int nbefore = dir ? 7 - sg : sg;
    for (int q = 0; q < nbefore; ++q) {
      int sq = dir ? 7 - q : q;
      float2 pp = *(const float2*)(segP + (dir * 8 + sq) * 64 + 2 * cp);
      float2 hh = *(const float2*)(segH + (dir * 8 + sq) * 64 + 2 * cp);
      s0 = pp.x * s0 + hh.x;
      s1 = pp.y * s1 + hh.y;
    }
#pragma unroll
    for (int kk = 0; kk < 8; ++kk) {
      const int k = dir ? 7 - kk : kk;
      s0 = af[dir][k][0] * s0 + bf2f((u16)(ub[dir][k] & 0xffff));
      s1 = af[dir][k][1] * s1 + bf2f((u16)(ub[dir][k] >> 16));
      y0[k] += s0; y1[k] += s1;
    }
  }
#pragma unroll
  for (int k = 0; k < 8; ++k) {
    float g0 = bf2f((u16)(gt[k] & 0xffff)), g1 = bf2f((u16)(gt[k] >> 16));
    *(unsigned*)(z + (size_t)(rb + 8 * sg + k) * NZ + C_GA + sch) = pk2(y0[k] * silu(g0), y1[k] * silu(g1));
  }
  __syncthreads();
}

DEV void a_carry(const P& p, int item) {
  int t = item * 256 + threadIdx.x;
  int ch = t & 511, dir = (t >> 9) & 1, lb = t >> 10;
  const float* AP = (const float*)(p.ws + O_AP);
  const float* AH = (const float*)(p.ws + O_AH);
  float* AC = (float*)(p.ws + O_ACAR);
  float st = 0.f;
  float pv[36], hv[36];
#pragma unroll
  for (int j = 0; j < 36; ++j) {
    int n = dir ? (j < 4 ? 3 - j : 39 - j) : j;
    size_t idx = ((size_t)(lb * 36 + n) * 2 + dir) * 512 + ch;
    pv[j] = AP[idx];
    hv[j] = AH[idx];
  }
#pragma unroll
  for (int j = 0; j < 36; ++j) {
    int n = dir ? (j < 4 ? 3 - j : 39 - j) : j;
    size_t idx = ((size_t)(lb * 36 + n) * 2 + dir) * 512 + ch;
    AC[idx] = st;
    st = pv[j] * st + hv[j];
  }
}

DEV void b_local(const P& p, int l, int item, char* smem) {
  u16* qs = (u16*)smem;
  u16* ks = qs + 64 * 136;
  float* Am = (float*)(smem + 34816);
  float* gc = (float*)(smem + 34816 + 32768);
  float* bt = gc + 128;
  const int tid = opq(threadIdx.x), lane = tid & 63, w = tid >> 6, fr = lane & 15, fq = lane >> 4;
  const int cgk = item >> 2, h = item & 3, n = cgk % 36, rb = cgk * 64;
  const u16* z = (const u16*)(p.ws + O_Z);
  u16* qn = (u16*)(p.ws + O_BSH);
  u16* kn = qn + (size_t)GR * 512;
  u16* vb = kn + (size_t)GR * 512;
  u16* knT = vb + (size_t)GR * 512;
  const float* ab = (const float*)(p.ws + O_AB);
  {
    u16* Tt = (u16*)Am;
    uint4 st[5];
#define BL_TLOAD(which)                                                                                  \
  _Pragma("unroll") for (int k = 0; k < 5; ++k) {                                                        \
    int idx = tid + 256 * k, row = idx >> 4, seg = idx & 15, cp = row - 2;                               \
    bool ok = (idx < 1072) && !((cp < 0 && (n == 0 || n == 4)) || (cp > 63 && (n == 3 || n == 35)));    \
    st[k] = make_uint4(0u, 0u, 0u, 0u);                                                                  \
    if (ok) st[k] = *(const uint4*)(z + (size_t)(rb + cp) * NZ + C_Q + (which)*512 + h * 128 + seg * 8); \
  }
    BL_TLOAD(0)
#pragma unroll
    for (int which = 0; which < 3; ++which) {
#pragma unroll
      for (int k = 0; k < 5; ++k) {
        int idx = tid + 256 * k, row = idx >> 4, seg = idx & 15;
        if (idx < 1072) *(uint4*)(Tt + row * 136 + seg * 8) = st[k];
      }
      __syncthreads();
      if (which < 2) { BL_TLOAD(which + 1) }
      float cw[2][4];
#pragma unroll
      for (int hh = 0; hh < 2; ++hh)
#pragma unroll
        for (int tap = 0; tap < 4; ++tap)
          cw[hh][tap] = p.conv_b_w[(size_t)(l * 4 + tap) * 1536 + which * 512 + h * 128 + lane + 64 * hh];
#pragma unroll 4
      for (int c = w; c < 64; c += 4) {
        float v[2];
#pragma unroll
        for (int hh = 0; hh < 2; ++hh) {
          int d = lane + 64 * hh;
          float a = 0.f;
#pragma unroll
          for (int tap = 0; tap < 4; ++tap) a += cw[hh][tap] * bf2f(Tt[(c + tap) * 136 + d]);
          v[hh] = silu(a);
        }
        float rs = 1.f;
        if (which < 2) {
          float sq = v[0] * v[0] + v[1] * v[1];
#pragma unroll
          for (int off = 32; off; off >>= 1) sq += __shfl_xor(sq, off);
          rs = rsqrtf(sq + EPS) * (which == 0 ? 0.08838834764831845f : 1.f);
        }
#pragma unroll
        for (int hh = 0; hh < 2; ++hh) {
          int d = lane + 64 * hh;
          u16 ob = f2bf(v[hh] * rs);
          size_t gi = (size_t)(rb + c) * 512 + h * 128 + d;
          if (which == 0) { qs[c * 136 + d] = ob; qn[gi] = ob; }
          else if (which == 1) { ks[c * 136 + d] = ob; kn[gi] = ob; }
          else vb[gi] = ob;
        }
      }
      __syncthreads();
    }
  }
  if (w < 2) {
    int dir = w, i = lane, c = dir ? 63 - i : i;
    float al = ab[(size_t)(rb + c) * 16 + dir * 4 + h], bl = ab[(size_t)(rb + c) * 16 + 8 + dir * 4 + h];
    float g = -__expf(p.gdn_a_log[(l * 2 + dir) * 4 + h]) * softplus(al + p.gdn_dt_bias[(l * 2 + dir) * 4 + h]);
#pragma unroll
    for (int off = 1; off < 64; off <<= 1) {
      float v = __shfl_up(g, off);
      if (lane >= off) g += v;
    }
    gc[dir * 64 + i] = g;
    bt[dir * 64 + i] = sigm(bl);
  }
  __syncthreads();
  for (int idx = tid; idx < 1024; idx += 256) {
    int d = idx >> 3, c8 = idx & 7;
    uint4 pk;
    pk.x = (unsigned)ks[(c8 * 8 + 0) * 136 + d] | ((unsigned)ks[(c8 * 8 + 1) * 136 + d] << 16);
    pk.y = (unsigned)ks[(c8 * 8 + 2) * 136 + d] | ((unsigned)ks[(c8 * 8 + 3) * 136 + d] << 16);
    pk.z = (unsigned)ks[(c8 * 8 + 4) * 136 + d] | ((unsigned)ks[(c8 * 8 + 5) * 136 + d] << 16);
    pk.w = (unsigned)ks[(c8 * 8 + 6) * 136 + d] | ((unsigned)ks[(c8 * 8 + 7) * 136 + d] << 16);
    *(uint4*)(knT + ((size_t)(cgk * 4 + h) * 128 + d) * 64 + c8 * 8) = pk;
  }
  for (int dir = 0; dir < 2; ++dir) {
    char* rec = p.ws + O_BIT + ((size_t)(cgk * 4 + h) * 2 + dir) * BIT_SZ;
    u16* QKm = (u16*)rec + 4096;
    float* scal = (float*)(rec + 16384);
    int irow = 16 * w + fr, ci = dir ? 63 - irow : irow;
    bf16x8 ak[4], aq[4];
#pragma unroll
    for (int s = 0; s < 4; ++s) { ak[s] = ld8(ks + ci * 136 + 32 * s + 8 * fq); aq[s] = ld8(qs + ci * 136 + 32 * s + 8 * fq); }
#pragma unroll
    for (int nt = 0; nt < 4; ++nt) {
      int jcol = 16 * nt + fr, cj = dir ? 63 - jcol : jcol;
      f32x4 kk = {0.f, 0.f, 0.f, 0.f}, qk = {0.f, 0.f, 0.f, 0.f};
#pragma unroll
      for (int s = 0; s < 4; ++s) {
        bf16x8 b = ld8(ks + cj * 136 + 32 * s + 8 * fq);
        kk = mfma(ak[s], b, kk);
        qk = mfma(aq[s], b, qk);
      }
      float gj = gc[dir * 64 + jcol];
#pragma unroll
      for (int r = 0; r < 4; ++r) {
        int i = 16 * w + 4 * fq + r;
        float dec = (jcol <= i) ? __expf(gc[dir * 64 + i] - gj) : 0.f;
        Am[(dir * 64 + i) * 64 + jcol] = (jcol < i) ? bt[dir * 64 + i] * kk[r] * dec : 0.f;
        QKm[i * 64 + jcol] = f2bf(qk[r] * dec);
      }
    }
    if (tid < 64) {
      float gl = gc[dir * 64 + 63], gi = gc[dir * 64 + tid];
      scal[tid] = __expf(gi);
      scal[64 + tid] = bt[dir * 64 + tid];
      scal[128 + tid] = __expf(gl - gi);
      if (tid == 0) scal[192] = __expf(gl);
    }
  }
  __syncthreads();
  if (w < 2) {
    int dir = w, col = lane;
    u16* Tinv = (u16*)(p.ws + O_BIT + ((size_t)(cgk * 4 + h) * 2 + dir) * BIT_SZ);
    const float* Ad = Am + dir * 4096;
    float T[64];
#pragma unroll
    for (int i = 0; i < 64; ++i) {
      float s = (i == col) ? 1.f : 0.f;
#pragma unroll
      for (int j = 0; j < i; ++j) s -= Ad[i * 64 + j] * T[j];
      T[i] = s;
      Tinv[i * 64 + col] = f2bf(s);
      __builtin_amdgcn_sched_barrier(0);
    }
  }
  __syncthreads();
}

DEV void b_seq(const P& p, int bitem, char* smem) {
  const int tid = opq(threadIdx.x), lane = tid & 63, w = tid >> 6, fr = lane & 15, fq = lane >> 4;
  const bool active = w < WPB;
  const int item = bitem * WPB + (active ? w : 0);
  const int slice = item & 7, dir = (item >> 3) & 1, h = (item >> 4) & 3, lb = item >> 6, e0 = slice * 16;
  u16* Ss = (u16*)(smem + w * 11264);
  u16* Rs = Ss + 16 * 136;
  u16* Vsc = Rs + 16 * 72;
  u16* Vor = Vsc + 16 * 72;
  const u16* qn = (const u16*)(p.ws + O_BSH);
  const u16* kn = qn + (size_t)GR * 512;
  const u16* vb = kn + (size_t)GR * 512;
  const u16* knT = vb + (size_t)GR * 512;
  u16* OB = (u16*)(p.ws + O_OB);
  f32x4 S[8];
#pragma unroll
  for (int m = 0; m < 8; ++m) S[m] = (f32x4){0.f, 0.f, 0.f, 0.f};
  for (int j = 0; j < 36; ++j) {
    const int n = dir ? (j < 4 ? 3 - j : 39 - j) : j;
    const int cgk = lb * 36 + n, rb = cgk * 64;
    const char* rec = p.ws + O_BIT + ((size_t)(cgk * 4 + h) * 2 + dir) * BIT_SZ;
    const u16* Tinv = (const u16*)rec;
    const u16* QKm = Tinv + 4096;
    const float* scal = (const float*)(rec + 16384);
    if (active) {
#pragma unroll
      for (int m = 0; m < 8; ++m) {
        uint2 pk; pk.x = pk2(S[m][0], S[m][1]); pk.y = pk2(S[m][2], S[m][3]);
        *(uint2*)(Ss + fr * 136 + 16 * m + 4 * fq) = pk;
      }
    }
    __syncthreads();
    bf16x8 Sf[4];
    if (active) {
#pragma unroll
      for (int s = 0; s < 4; ++s) Sf[s] = ld8(Ss + fr * 136 + 32 * s + 8 * fq);
#pragma unroll
      for (int m = 0; m < 4; ++m) {
        int i = 16 * m + fr, rowi = rb + (dir ? 63 - i : i);
        f32x4 X = {0.f, 0.f, 0.f, 0.f};
#pragma unroll
        for (int s = 0; s < 4; ++s) X = mfma(ld8(kn + (size_t)rowi * 512 + h * 128 + 32 * s + 8 * fq), Sf[s], X);
        float rv[4];
#pragma unroll
        for (int r = 0; r < 4; ++r) {
          int ii = 16 * m + 4 * fq + r, rowr = rb + (dir ? 63 - ii : ii);
          float v = bf2f(vb[(size_t)rowr * 512 + h * 128 + e0 + fr]);
          rv[r] = scal[64 + ii] * (v - scal[ii] * X[r]);
        }
        uint2 pk; pk.x = pk2(rv[0], rv[1]); pk.y = pk2(rv[2], rv[3]);
        *(uint2*)(Rs + fr * 72 + 16 * m + 4 * fq) = pk;
      }
    }
    __syncthreads();
    if (active) {
      bf16x8 Rf0 = ld8(Rs + fr * 72 + 8 * fq), Rf1 = ld8(Rs + fr * 72 + 32 + 8 * fq);
#pragma unroll
      for (int m = 0; m < 4; ++m) {
        f32x4 VN = {0.f, 0.f, 0.f, 0.f};
        VN = mfma(ld8(Tinv + (16 * m + fr) * 64 + 8 * fq), Rf0, VN);
        VN = mfma(ld8(Tinv + (16 * m + fr) * 64 + 32 + 8 * fq), Rf1, VN);
        uint2 pk; pk.x = pk2(VN[0], VN[1]); pk.y = pk2(VN[2], VN[3]);
        *(uint2*)(Vsc + fr * 72 + 16 * m + 4 * fq) = pk;
        int ib = 16 * m + 4 * fq;
        float s0 = VN[0] * scal[128 + ib], s1 = VN[1] * scal[128 + ib + 1], s2 = VN[2] * scal[128 + ib + 2],
              s3 = VN[3] * scal[128 + ib + 3];
        if (dir) {
          pk.x = pk2(s3, s2); pk.y = pk2(s1, s0);
          *(uint2*)(Vor + fr * 72 + (60 - ib)) = pk;
        } else {
          pk.x = pk2(s0, s1); pk.y = pk2(s2, s3);
          *(uint2*)(Vor + fr * 72 + ib) = pk;
        }
      }
    }
    __syncthreads();
    if (active) {
      bf16x8 Vs0 = ld8(Vsc + fr * 72 + 8 * fq), Vs1 = ld8(Vsc + fr * 72 + 32 + 8 * fq);
      bf16x8 Vo0 = ld8(Vor + fr * 72 + 8 * fq), Vo1 = ld8(Vor + fr * 72 + 32 + 8 * fq);
#pragma unroll
      for (int m = 0; m < 4; ++m) {
        int i = 16 * m + fr, rowi = rb + (dir ? 63 - i : i);
        f32x4 O = {0.f, 0.f, 0.f, 0.f};
#pragma unroll
        for (int s = 0; s < 4; ++s) O = mfma(ld8(qn + (size_t)rowi * 512 + h * 128 + 32 * s + 8 * fq), Sf[s], O);
#pragma unroll
        for (int r = 0; r < 4; ++r) O[r] *= scal[16 * m + 4 * fq + r];
        O = mfma(ld8(QKm + (16 * m + fr) * 64 + 8 * fq), Vs0, O);
        O = mfma(ld8(QKm + (16 * m + fr) * 64 + 32 + 8 * fq), Vs1, O);
#pragma unroll
        for (int r = 0; r < 4; ++r) {
          int ii = 16 * m + 4 * fq + r, rowr = rb + (dir ? 63 - ii : ii);
          OB[((size_t)dir * GR + rowr) * 512 + h * 128 + e0 + fr] = f2bf(O[r]);
        }
      }
      float egl = scal[192];
#pragma unroll
      for (int m = 0; m < 8; ++m) {
        const u16* kt = knT + ((size_t)(cgk * 4 + h) * 128 + 16 * m + fr) * 64;
        f32x4 t = S[m];
#pragma unroll
        for (int r = 0; r < 4; ++r) t[r] *= egl;
        t = mfma(ld8(kt + 8 * fq), Vo0, t);
        t = mfma(ld8(kt + 32 + 8 * fq), Vo1, t);
        S[m] = t;
      }
    }
  }
  __syncthreads();
}

DEV void c_local(const P& p, int l, int item, char* smem) {
  float* bsm = (float*)smem;
  u16* Ps = (u16*)(smem + 33024);
  u16* kdt = (u16*)(smem + 33024 + 9216);
  const int tid = opq(threadIdx.x), lane = tid & 63, w = tid >> 6, fr = lane & 15, fq = lane >> 4;
  const int cgk = item >> 2, h = item & 3, rb = cgk * 64;
  const u16* z = (const u16*)(p.ws + O_Z);
  const u16* zT = (const u16*)(p.ws + O_ZT);
  u16* OC = (u16*)(p.ws + O_OC);
  const float* lbs = (const float*)(p.ws + O_LBS);
  for (int dir = 0; dir < 2; ++dir) {
    char* rec = p.ws + O_CREC + ((size_t)(cgk * 4 + h) * 2 + dir) * CREC_SZ;
    u16* QD = (u16*)rec;
    u16* KDT = QD + 8192;
    float* decv = (float*)(rec + 32768);
    const float* lbp = lbs + l * 1024 + dir * 512 + h * 128;
    const int fcol = C_F0 + dir * 512 + h * 128;
    {
      int d = tid & 127, half = tid >> 7;
      float lb_ = lbp[d], run = 0.f;
      for (int k = 0; k < 32; ++k) {
        int i = 32 * half + k, c = dir ? 63 - i : i;
        float f = bf2f(z[(size_t)(rb + c) * NZ + fcol + d]);
        float fg = lb_ + (1.f - lb_) * sigm(f);
        run += __logf(fg);
        bsm[i * 129 + d] = run;
      }
    }
    __syncthreads();
    {
      int d = tid & 127, half = tid >> 7;
      if (half) {
        float add = bsm[31 * 129 + d];
        for (int k = 0; k < 32; ++k) bsm[(32 + k) * 129 + d] += add;
      }
    }
    __syncthreads();
    for (int idx = tid; idx < 8192; idx += 256) {
      int i = idx >> 7, d = idx & 127, c = dir ? 63 - i : i;
      float b = bsm[i * 129 + d];
      float q = silu(bf2f(z[(size_t)(rb + c) * NZ + C_QC + h * 128 + d]));
      QD[i * 128 + d] = f2bf(q * __expf(b));
      float f = bf2f(z[(size_t)(rb + c) * NZ + fcol + d]);
      float k = (1.f - lbp[d]) * sigm(-f);
      kdt[d * 72 + c] = f2bf(k * __expf(bsm[63 * 129 + d] - b));
    }
    if (tid < 128) decv[tid] = __expf(bsm[63 * 129 + tid]);
    __syncthreads();
    for (int idx = tid; idx < 1024; idx += 256) {
      int d = idx >> 3, c8 = idx & 7;
      *(uint4*)(KDT + d * 64 + c8 * 8) = *(const uint4*)(kdt + d * 72 + c8 * 8);
    }
    {
      const int sj = w;
      for (int si = 0; si < 4; ++si) {
        f32x4 acc = {0.f, 0.f, 0.f, 0.f};
        if (si >= sj) {
          int it = 16 * si + fr, jt = 16 * sj + fr;
          int ci = dir ? 63 - it : it, cj = dir ? 63 - jt : jt;
#pragma unroll
          for (int s = 0; s < 4; ++s) {
            int d0 = 32 * s + 8 * fq;
            bf16x8 qv = ld8(z + (size_t)(rb + ci) * NZ + C_QC + h * 128 + d0);
            bf16x8 fv = ld8(z + (size_t)(rb + cj) * NZ + fcol + d0);
            bf16x8 af, bf;
#pragma unroll
            for (int e = 0; e < 8; ++e) {
              int d = d0 + e;
              float Bs_ = si ? bsm[(16 * si - 1) * 129 + d] : 0.f;
              float qq = silu(bf2f((u16)qv[e])) * __expf(bsm[it * 129 + d] - Bs_);
              float kk = (1.f - lbp[d]) * sigm(-bf2f((u16)fv[e])) * __expf(Bs_ - bsm[jt * 129 + d]);
              af[e] = (short)f2bf(qq);
              bf[e] = (short)f2bf(kk);
            }
            acc = mfma(af, bf, acc);
          }
        }
#pragma unroll
        for (int r = 0; r < 4; ++r) {
          int i = 16 * si + 4 * fq + r, jj = 16 * sj + fr;
          float v = (si >= sj && jj <= i) ? acc[r] : 0.f;
          Ps[i * 72 + (dir ? 63 - jj : jj)] = f2bf(v);
        }
        __builtin_amdgcn_sched_barrier(0);
      }
    }
    __syncthreads();
#pragma unroll
    for (int nt2 = 0; nt2 < 2; ++nt2) {
      int e = h * 128 + (2 * w + nt2) * 16 + fr;
      bf16x8 v0 = ld8(zT + (size_t)e * GR + rb + 8 * fq), v1 = ld8(zT + (size_t)e * GR + rb + 32 + 8 * fq);
#pragma unroll
      for (int m = 0; m < 4; ++m) {
        f32x4 O = {0.f, 0.f, 0.f, 0.f};
        O = mfma(ld8(Ps + (16 * m + fr) * 72 + 8 * fq), v0, O);
        O = mfma(ld8(Ps + (16 * m + fr) * 72 + 32 + 8 * fq), v1, O);
#pragma unroll
        for (int r = 0; r < 4; ++r) {
          int ii = 16 * m + 4 * fq + r, rowr = rb + (dir ? 63 - ii : ii);
          OC[((size_t)dir * GR + rowr) * 512 + e] = f2bf(O[r]);
        }
      }
    }
    __syncthreads();
  }
}

DEV void c_seq(const P& p, int bitem, char* smem) {
  const int tid = opq(threadIdx.x), lane = tid & 63, w = tid >> 6, fr = lane & 15, fq = lane >> 4;
  const bool active = w < WPB;
  const int item = bitem * WPB + (active ? w : 0);
  const int slice = item & 7, dir = (item >> 3) & 1, h = (item >> 4) & 3, lb = item >> 6, e0 = slice * 16;
  u16* Ss = (u16*)(smem + w * 4352);
  const u16* zT = (const u16*)(p.ws + O_ZT);
  u16* OC = (u16*)(p.ws + O_OC);
  f32x4 S[8];
#pragma unroll
  for (int m = 0; m < 8; ++m) S[m] = (f32x4){0.f, 0.f, 0.f, 0.f};
  for (int j = 0; j < 36; ++j) {
    const int n = dir ? (j < 4 ? 3 - j : 39 - j) : j;
    const int cgk = lb * 36 + n, rb = cgk * 64;
    const char* rec = p.ws + O_CREC + ((size_t)(cgk * 4 + h) * 2 + dir) * CREC_SZ;
    const u16* QD = (const u16*)rec;
    const u16* KDT = QD + 8192;
    const float* decv = (const float*)(rec + 32768);
    if (active) {
#pragma unroll
      for (int m = 0; m < 8; ++m) {
        uint2 pk; pk.x = pk2(S[m][0], S[m][1]); pk.y = pk2(S[m][2], S[m][3]);
        *(uint2*)(Ss + fr * 136 + 16 * m + 4 * fq) = pk;
      }
    }
    __syncthreads();
    if (active) {
      bf16x8 Sf[4];
#pragma unroll
      for (int s = 0; s < 4; ++s) Sf[s] = ld8(Ss + fr * 136 + 32 * s + 8 * fq);
#pragma unroll
      for (int m = 0; m < 4; ++m) {
        f32x4 O = {0.f, 0.f, 0.f, 0.f};
#pragma unroll
        for (int s = 0; s < 4; ++s) O = mfma(ld8(QD + (16 * m + fr) * 128 + 32 * s + 8 * fq), Sf[s], O);
#pragma unroll
        for (int r = 0; r < 4; ++r) {
          int ii = 16 * m + 4 * fq + r, rowr = rb + (dir ? 63 - ii : ii);
          size_t oi = ((size_t)dir * GR + rowr) * 512 + h * 128 + e0 + fr;
          OC[oi] = f2bf(bf2f(OC[oi]) + O[r]);
        }
      }
      const u16* vp = zT + (size_t)(h * 128 + e0 + fr) * GR + rb;
      bf16x8 V0 = ld8(vp + 8 * fq), V1 = ld8(vp + 32 + 8 * fq);
#pragma unroll
      for (int m = 0; m < 8; ++m) {
        f32x4 t = S[m];
#pragma unroll
        for (int r = 0; r < 4; ++r) t[r] *= decv[16 * m + 4 * fq + r];
        t = mfma(ld8(KDT + (16 * m + fr) * 64 + 8 * fq), V0, t);
        t = mfma(ld8(KDT + (16 * m + fr) * 64 + 32 + 8 * fq), V1, t);
        S[m] = t;
      }
    }
    __syncthreads();
  }
}

#define LBAR()                                              \
  do {                                                      \
    asm volatile("s_waitcnt lgkmcnt(0)" ::: "memory");      \
    __builtin_amdgcn_s_barrier();                           \
    asm volatile("" ::: "memory");                          \
  } while (0)
#define CBAR() asm volatile("" ::: "memory")

DEV void c_local2(const P& p, int l, int item, char* smem) {
  float* bsm = (float*)smem;
  u16* Fq = (u16*)(smem + 33024);
  u16* kdt = (u16*)(smem + 50432);
  u16* Ps = kdt;
  const int tid = opq(threadIdx.x), lane = tid & 63, w = tid >> 6, fr = lane & 15, fq = lane >> 4;
  const int cgk = item >> 2, h = item & 3, rb = cgk * 64;
  const u16* z = (const u16*)(p.ws + O_Z);
  const u16* zT = (const u16*)(p.ws + O_ZT);
  u16* OC = (u16*)(p.ws + O_OC);
  const float* lbs = (const float*)(p.ws + O_LBS);
  u16* zq = (u16*)(p.ws + O_Z) + (size_t)rb * NZ + C_QC + h * 128;
  {
    uint4 t4[4];
#pragma unroll
    for (int k = 0; k < 4; ++k) {
      int idx = tid + 256 * k, c = idx >> 4, seg = idx & 15;
      t4[k] = *(const uint4*)(zq + (size_t)c * NZ + seg * 8);
    }
#pragma unroll
    for (int k = 0; k < 4; ++k) {
      int idx = tid + 256 * k, c = idx >> 4, seg = idx & 15;
      unsigned wv[4] = {t4[k].x, t4[k].y, t4[k].z, t4[k].w};
#pragma unroll
      for (int q = 0; q < 4; ++q)
        wv[q] = pk2(silu(bf2f((u16)(wv[q] & 0xffff))), silu(bf2f((u16)(wv[q] >> 16))));
      *(uint4*)(zq + (size_t)c * NZ + seg * 8) = make_uint4(wv[0], wv[1], wv[2], wv[3]);
    }
  }
  __syncthreads();
  for (int dir = 0; dir < 2; ++dir) {
    char* rec = p.ws + O_CREC + ((size_t)(cgk * 4 + h) * 2 + dir) * CREC_SZ;
    u16* QD = (u16*)rec;
    u16* KDT = QD + 8192;
    float* decv = (float*)(rec + 32768);
    const float* lbp = lbs + l * 1024 + dir * 512 + h * 128;
    const int fcol = C_F0 + dir * 512 + h * 128;
    {
      uint4 t4[4];
#pragma unroll
      for (int k = 0; k < 4; ++k) {
        int idx = tid + 256 * k, c = idx >> 4, seg = idx & 15;
        t4[k] = *(const uint4*)(z + (size_t)(rb + c) * NZ + fcol + seg * 8);
      }
#pragma unroll
      for (int k = 0; k < 4; ++k) {
        int idx = tid + 256 * k, c = idx >> 4, seg = idx & 15;
        *(uint4*)(Fq + c * 136 + seg * 8) = t4[k];
      }
    }
    __syncthreads();
    {
      int d = tid & 127, half = tid >> 7;
      float lb_ = lbp[d], run = 0.f;
#pragma unroll 8
      for (int k = 0; k < 32; ++k) {
        int i = 32 * half + k, c = dir ? 63 - i : i;
        float f = bf2f(Fq[c * 136 + d]);
        float fg = lb_ + (1.f - lb_) * sigm(f);
        run += __logf(fg);
        bsm[i * 129 + d] = run;
      }
    }
    __syncthreads();
    {
      int d = tid & 127, half = tid >> 7;
      if (half) {
        float add = bsm[31 * 129 + d];
#pragma unroll 8
        for (int k = 0; k < 32; ++k) bsm[(32 + k) * 129 + d] += add;
      }
    }
    __syncthreads();
    {
      uint4 qv[4];
#pragma unroll
      for (int k = 0; k < 4; ++k) {
        int idx = tid + 256 * k, c = idx >> 4, seg = idx & 15;
        qv[k] = *(const uint4*)(zq + (size_t)c * NZ + seg * 8);
      }
#pragma unroll
      for (int k = 0; k < 4; ++k) {
        int idx = tid + 256 * k, c = idx >> 4, seg = idx & 15, i = dir ? 63 - c : c, d0 = seg * 8;
        unsigned qw[4] = {qv[k].x, qv[k].y, qv[k].z, qv[k].w};
        uint4 fv4 = *(const uint4*)(Fq + c * 136 + d0);
        unsigned fw[4] = {fv4.x, fv4.y, fv4.z, fv4.w};
        unsigned qo[4], ko[4];
#pragma unroll
        for (int q = 0; q < 4; ++q) {
          int d = d0 + 2 * q;
          float b0 = bsm[i * 129 + d], b1 = bsm[i * 129 + d + 1];
          float bl0 = bsm[63 * 129 + d], bl1 = bsm[63 * 129 + d + 1];
          float q0 = bf2f((u16)(qw[q] & 0xffff)), q1 = bf2f((u16)(qw[q] >> 16));
          qo[q] = pk2(q0 * __expf(b0), q1 * __expf(b1));
          float k0 = (1.f - lbp[d]) * sigm(-bf2f((u16)(fw[q] & 0xffff)));
          float k1 = (1.f - lbp[d + 1]) * sigm(-bf2f((u16)(fw[q] >> 16)));
          ko[q] = pk2(k0, k1);
          kdt[d * 72 + c] = f2bf(k0 * __expf(bl0 - b0));
          kdt[(d + 1) * 72 + c] = f2bf(k1 * __expf(bl1 - b1));
        }
        *(uint4*)(QD + i * 128 + d0) = make_uint4(qo[0], qo[1], qo[2], qo[3]);
        *(uint4*)(Fq + c * 136 + d0) = make_uint4(ko[0], ko[1], ko[2], ko[3]);
      }
      if (tid < 128) decv[tid] = __expf(bsm[63 * 129 + tid]);
    }
    __syncthreads();
    for (int idx = tid; idx < 1024; idx += 256) {
      int d = idx >> 3, c8 = idx & 7;
      *(uint4*)(KDT + d * 64 + c8 * 8) = *(const uint4*)(kdt + d * 72 + c8 * 8);
    }
    bf16x8 qf[3][4];
#pragma unroll
    for (int t = 0; t < 3; ++t) {
      int k = w + 4 * t;
      int si = k < 4 ? 3 : (k < 7 ? 2 : (k < 9 ? 1 : 0));
      int it_ = 16 * si + fr, ci_ = dir ? 63 - it_ : it_;
#pragma unroll
      for (int s = 0; s < 4; ++s) qf[t][s] = ld8(zq + (size_t)ci_ * NZ + 32 * s + 8 * fq);
    }
    __syncthreads();
    for (int idx = tid; idx < 1536; idx += 256) {
      int tl = idx >> 8, e = idx & 255, r16 = e >> 4, c16 = e & 15;
      int si = tl < 3 ? 0 : (tl < 5 ? 1 : 2);
      int sj = tl < 3 ? tl + 1 : (tl < 5 ? tl - 1 : 3);
      int jj = 16 * sj + c16;
      Ps[(16 * si + r16) * 72 + (dir ? 63 - jj : jj)] = 0;
    }
#pragma unroll
    for (int t = 0; t < 3; ++t) {
      const int k = w + 4 * t;
      if (k < 10) {
        const int si = k < 4 ? 3 : (k < 7 ? 2 : (k < 9 ? 1 : 0));
        const int sj = k - (k < 4 ? 0 : (k < 7 ? 4 : (k < 9 ? 7 : 9)));
        const int it = 16 * si + fr, jt = 16 * sj + fr, cj = dir ? 63 - jt : jt;
        const int brow = si ? (16 * si - 1) : 0;
        const float bmul = si ? 1.f : 0.f;
        f32x4 acc = {0.f, 0.f, 0.f, 0.f};
#pragma unroll
        for (int s = 0; s < 4; ++s) {
          int d0 = 32 * s + 8 * fq;
          bf16x8 fv = ld8(Fq + cj * 136 + d0);
          bf16x8 af, bf;
#pragma unroll
          for (int e = 0; e < 8; ++e) {
            int d = d0 + e;
            float Bs_ = bmul * bsm[brow * 129 + d];
            float qq = bf2f((u16)qf[t][s][e]) * __expf(bsm[it * 129 + d] - Bs_);
            float kk = bf2f((u16)fv[e]) * __expf(Bs_ - bsm[jt * 129 + d]);
            af[e] = (short)f2bf(qq);
            bf[e] = (short)f2bf(kk);
          }
          acc = mfma(af, bf, acc);
          __builtin_amdgcn_sched_barrier(0);
        }
#pragma unroll
        for (int r = 0; r < 4; ++r) {
          int i = 16 * si + 4 * fq + r, jj = 16 * sj + fr;
          float v = (jj <= i) ? acc[r] : 0.f;
          Ps[i * 72 + (dir ? 63 - jj : jj)] = f2bf(v);
        }
      }
    }
    __syncthreads();
#pragma unroll
    for (int nt2 = 0; nt2 < 2; ++nt2) {
      int e = h * 128 + (2 * w + nt2) * 16 + fr;
      bf16x8 v0 = ld8(zT + (size_t)e * GR + rb + 8 * fq), v1 = ld8(zT + (size_t)e * GR + rb + 32 + 8 * fq);
#pragma unroll
      for (int m = 0; m < 4; ++m) {
        f32x4 O = {0.f, 0.f, 0.f, 0.f};
        O = mfma(ld8(Ps + (16 * m + fr) * 72 + 8 * fq), v0, O);
        O = mfma(ld8(Ps + (16 * m + fr) * 72 + 32 + 8 * fq), v1, O);
#pragma unroll
        for (int r = 0; r < 4; ++r) {
          int ii = 16 * m + 4 * fq + r, rowr = rb + (dir ? 63 - ii : ii);
          OC[((size_t)dir * GR + rowr) * 512 + e] = f2bf(O[r]);
        }
      }
    }
    __syncthreads();
  }
}

#define LBAR()                                              \
  do {                                                      \
    asm volatile("s_waitcnt lgkmcnt(0)" ::: "memory");      \
    __builtin_amdgcn_s_barrier();                           \
    asm volatile("" ::: "memory");                          \
  } while (0)
#define CBAR() asm volatile("" ::: "memory")
#define BS_CHUNK(jj) (dir ? ((jj) < 4 ? 3 - (jj) : 39 - (jj)) : (jj))
DEV bf16x8 ldo8(const char* base, unsigned off) { return *reinterpret_cast<const bf16x8*>(base + off); }
DEV void b_seq2(const P& p, int bitem, char* smem) {
  const int tid = opq(threadIdx.x), lane = tid & 63, w = tid >> 6, fr = lane & 15, fq = lane >> 4;
  const int es = bitem >> 5, dir = bitem & 1, h = (bitem >> 1) & 3, lb = (bitem >> 3) & 3, e0 = es * 32;
  u16* Ss = (u16*)smem;
  u16* Rs = Ss + 32 * 136;
  u16* Vsc = Rs + 32 * 72;
  u16* Vor = Vsc + 32 * 72;
  const char* qnB = p.ws + O_BSH + (size_t)h * 256;
  const char* knB = qnB + BSH_ONE;
  const char* vbB = knB + BSH_ONE + (size_t)e0 * 2;
  const char* ktB = p.ws + O_BSH + 3 * BSH_ONE + (size_t)h * 16384;
  const char* recB = p.ws + O_BIT + ((size_t)h * 2 + dir) * BIT_SZ;
  char* obB = p.ws + O_OB + ((size_t)dir * GR * 512 + h * 128 + e0) * 2;
  const int mrow = 16 * w + fr, crow0 = 16 * w + 4 * fq;
  const unsigned offA = (unsigned)((dir ? 63 - mrow : mrow) * 1024 + 16 * fq);
  unsigned offR[4];
#pragma unroll
  for (int r = 0; r < 4; ++r) offR[r] = (unsigned)((dir ? 63 - (crow0 + r) : (crow0 + r)) * 1024 + fr * 2);
  const unsigned offT = (unsigned)(mrow * 128 + 16 * fq);
  const unsigned offK = (unsigned)((32 * w + fr) * 128 + 16 * fq);
  const unsigned offS = (unsigned)(16384 + crow0 * 4);
  f32x4 S[2][2];
#pragma unroll
  for (int a = 0; a < 2; ++a)
#pragma unroll
    for (int b = 0; b < 2; ++b) S[a][b] = (f32x4){0.f, 0.f, 0.f, 0.f};
  bf16x8 Akn[4], Aqn[4], At[2][2], Aqk[2][2], AkT[2][2][2];
  u16 vbv[2][4];
  float4 eg4, be4, ek4[2];
  float egl[2];
#define BS_LOAD1(cg_)                                                              \
  {                                                                                \
    const size_t ro_ = (size_t)(cg_) * 65536;                                      \
    _Pragma("unroll") for (int s = 0; s < 4; ++s) {                                \
      Akn[s] = ldo8(knB + ro_, offA + 64 * s);                                     \
      Aqn[s] = ldo8(qnB + ro_, offA + 64 * s);                                     \
    }                                                                              \
    _Pragma("unroll") for (int r = 0; r < 4; ++r) {                                \
      vbv[0][r] = *(const u16*)(vbB + ro_ + offR[r]);                              \
      vbv[1][r] = *(const u16*)(vbB + ro_ + (offR[r] + 32));                       \
    }                                                                              \
    const char* rc_ = recB + (size_t)(cg_) * (8 * BIT_SZ);                         \
    eg4 = *(const float4*)(rc_ + offS);                                            \
    be4 = *(const float4*)(rc_ + (offS + 256));                                    \
  }
#define BS_LOAD2(cg_, SS)                                                          \
  {                                                                                \
    const char* rc_ = recB + (size_t)(cg_) * (8 * BIT_SZ);                         \
    At[SS][0] = ldo8(rc_, offT); At[SS][1] = ldo8(rc_, offT + 64);                 \
    ek4[SS] = *(const float4*)(rc_ + (offS + 512));                                \
  }
#define BS_LOAD3(cg_, SS)                                                          \
  {                                                                                \
    const char* rc_ = recB + (size_t)(cg_) * (8 * BIT_SZ);                         \
    Aqk[SS][0] = ldo8(rc_, offT + 8192); Aqk[SS][1] = ldo8(rc_, offT + 8192 + 64); \
    egl[SS] = *(const float*)(rc_ + 16384 + 768);                                  \
    const char* kt_ = ktB + (size_t)(cg_) * 65536;                                 \
    AkT[SS][0][0] = ldo8(kt_, offK); AkT[SS][0][1] = ldo8(kt_, offK + 64);         \
    AkT[SS][1][0] = ldo8(kt_, offK + 2048); AkT[SS][1][1] = ldo8(kt_, offK + 2048 + 64); \
  }
  {
    const int c0 = lb * 36 + BS_CHUNK(0);
    BS_LOAD1(c0) BS_LOAD2(c0, 0) BS_LOAD3(c0, 0)
  }
  for (int j2 = 0; j2 < 36; j2 += 2)
#pragma unroll
  for (int u = 0; u < 2; ++u) {
    const int j = j2 + u;
    const int cgk = lb * 36 + BS_CHUNK(j);
    const int jn = (j + 1 < 36) ? j + 1 : j;
    const int cgn = lb * 36 + BS_CHUNK(jn);
    BS_LOAD2(cgn, u ^ 1)
    BS_LOAD3(cgn, u ^ 1)
#pragma unroll
    for (int mm = 0; mm < 2; ++mm)
#pragma unroll
      for (int nt = 0; nt < 2; ++nt) {
        uint2 pk; pk.x = pk2(S[mm][nt][0], S[mm][nt][1]); pk.y = pk2(S[mm][nt][2], S[mm][nt][3]);
        *(uint2*)(Ss + (16 * nt + fr) * 136 + 32 * w + 16 * mm + 4 * fq) = pk;
      }
    LBAR();
    f32x4 QS[2];
    {
      bf16x8 Sf[2][4];
#pragma unroll
      for (int nt = 0; nt < 2; ++nt)
#pragma unroll
        for (int s = 0; s < 4; ++s) Sf[nt][s] = ld8(Ss + (16 * nt + fr) * 136 + 32 * s + 8 * fq);
#pragma unroll
      for (int nt = 0; nt < 2; ++nt) {
        f32x4 X = {0.f, 0.f, 0.f, 0.f}, Q = {0.f, 0.f, 0.f, 0.f};
#pragma unroll
        for (int s = 0; s < 4; ++s) { X = mfma(Akn[s], Sf[nt][s], X); Q = mfma(Aqn[s], Sf[nt][s], Q); }
        float r0 = be4.x * (bf2f(vbv[nt][0]) - eg4.x * X[0]);
        float r1 = be4.y * (bf2f(vbv[nt][1]) - eg4.y * X[1]);
        float r2 = be4.z * (bf2f(vbv[nt][2]) - eg4.z * X[2]);
        float r3 = be4.w * (bf2f(vbv[nt][3]) - eg4.w * X[3]);
        uint2 pk; pk.x = pk2(r0, r1); pk.y = pk2(r2, r3);
        *(uint2*)(Rs + (16 * nt + fr) * 72 + crow0) = pk;
        Q[0] *= eg4.x; Q[1] *= eg4.y; Q[2] *= eg4.z; Q[3] *= eg4.w;
        QS[nt] = Q;
      }
    }
    CBAR();
    BS_LOAD1(cgn)
    LBAR();
    {
#pragma unroll
      for (int nt = 0; nt < 2; ++nt) {
        bf16x8 Rf0 = ld8(Rs + (16 * nt + fr) * 72 + 8 * fq), Rf1 = ld8(Rs + (16 * nt + fr) * 72 + 32 + 8 * fq);
        f32x4 VN = {0.f, 0.f, 0.f, 0.f};
        VN = mfma(At[u][0], Rf0, VN);
        VN = mfma(At[u][1], Rf1, VN);
        uint2 pk; pk.x = pk2(VN[0], VN[1]); pk.y = pk2(VN[2], VN[3]);
        *(uint2*)(Vsc + (16 * nt + fr) * 72 + crow0) = pk;
        float s0 = VN[0] * ek4[u].x, s1 = VN[1] * ek4[u].y, s2 = VN[2] * ek4[u].z, s3 = VN[3] * ek4[u].w;
        if (dir) {
          pk.x = pk2(s3, s2); pk.y = pk2(s1, s0);
          *(uint2*)(Vor + (16 * nt + fr) * 72 + (60 - crow0)) = pk;
        } else {
          pk.x = pk2(s0, s1); pk.y = pk2(s2, s3);
          *(uint2*)(Vor + (16 * nt + fr) * 72 + crow0) = pk;
        }
      }
    }
    LBAR();
    {
      char* ob_ = obB + (size_t)cgk * 65536;
#pragma unroll
      for (int nt = 0; nt < 2; ++nt) {
        bf16x8 Vs0 = ld8(Vsc + (16 * nt + fr) * 72 + 8 * fq), Vs1 = ld8(Vsc + (16 * nt + fr) * 72 + 32 + 8 * fq);
        bf16x8 Vo0 = ld8(Vor + (16 * nt + fr) * 72 + 8 * fq), Vo1 = ld8(Vor + (16 * nt + fr) * 72 + 32 + 8 * fq);
        f32x4 O = QS[nt];
        O = mfma(Aqk[u][0], Vs0, O);
        O = mfma(Aqk[u][1], Vs1, O);
#pragma unroll
        for (int r = 0; r < 4; ++r) *(u16*)(ob_ + (offR[r] + 32 * nt)) = f2bf(O[r]);
#pragma unroll
        for (int mm = 0; mm < 2; ++mm) {
          f32x4 t = S[mm][nt];
#pragma unroll
          for (int r = 0; r < 4; ++r) t[r] *= egl[u];
          t = mfma(AkT[u][mm][0], Vo0, t);
          t = mfma(AkT[u][mm][1], Vo1, t);
          S[mm][nt] = t;
        }
      }
    }
  }
  LBAR();
}

DEV void c_seq2(const P& p, int bitem, char* smem) {
  const int tid = opq(threadIdx.x), lane = tid & 63, w = tid >> 6, fr = lane & 15, fq = lane >> 4;
  const int es = bitem >> 5, dir = bitem & 1, h = (bitem >> 1) & 3, lb = (bitem >> 3) & 3, e0 = es * 32;
  u16* Ssb = (u16*)smem;
  const char* recB = p.ws + O_CREC + ((size_t)h * 2 + dir) * CREC_SZ;
  const char* ztB = p.ws + O_ZT + (size_t)(h * 128 + e0) * GR * 2;
  char* ocB = p.ws + O_OC + ((size_t)dir * GR * 512 + h * 128 + e0) * 2;
  const int mrow = 16 * w + fr, crow0 = 16 * w + 4 * fq;
  const unsigned offQ = (unsigned)(mrow * 256 + 16 * fq);
  const unsigned offK = (unsigned)(16384 + (32 * w + fr) * 128 + 16 * fq);
  const unsigned offD = (unsigned)(32768 + (32 * w + 4 * fq) * 4);
  const unsigned offV = (unsigned)(fr * GR * 2 + 16 * fq);
  unsigned offR[4];
#pragma unroll
  for (int r = 0; r < 4; ++r) offR[r] = (unsigned)((dir ? 63 - (crow0 + r) : (crow0 + r)) * 1024 + fr * 2);
  f32x4 S[2][2];
#pragma unroll
  for (int a = 0; a < 2; ++a)
#pragma unroll
    for (int b = 0; b < 2; ++b) S[a][b] = (f32x4){0.f, 0.f, 0.f, 0.f};
  bf16x8 Aqd[4], Akd[2][2], Vf[2][2];
  u16 oi[2][4];
  float4 dec4[2];
#define CS_LOAD(cg_)                                                                    \
  {                                                                                     \
    const char* rc_ = recB + (size_t)(cg_) * (8 * CREC_SZ);                             \
    _Pragma("unroll") for (int s = 0; s < 4; ++s) Aqd[s] = ldo8(rc_, offQ + 64 * s);    \
    Akd[0][0] = ldo8(rc_, offK); Akd[0][1] = ldo8(rc_, offK + 64);                      \
    Akd[1][0] = ldo8(rc_, offK + 2048); Akd[1][1] = ldo8(rc_, offK + 2048 + 64);        \
    dec4[0] = *(const float4*)(rc_ + offD);                                             \
    dec4[1] = *(const float4*)(rc_ + (offD + 64));                                      \
    const char* zt_ = ztB + (size_t)(cg_) * 128;                                        \
    Vf[0][0] = ldo8(zt_, offV); Vf[0][1] = ldo8(zt_, offV + 64);                        \
    Vf[1][0] = ldo8(zt_, offV + 16 * GR * 2); Vf[1][1] = ldo8(zt_, offV + 16 * GR * 2 + 64); \
    const char* oc_ = ocB + (size_t)(cg_) * 65536;                                      \
    _Pragma("unroll") for (int r = 0; r < 4; ++r) {                                     \
      oi[0][r] = *(const u16*)(oc_ + offR[r]);                                          \
      oi[1][r] = *(const u16*)(oc_ + (offR[r] + 32));                                   \
    }                                                                                   \
  }
  {
    const int c0 = lb * 36 + BS_CHUNK(0);
    CS_LOAD(c0)
  }
  for (int j = 0; j < 36; ++j) {
    const int cgk = lb * 36 + BS_CHUNK(j);
    const int jn = (j + 1 < 36) ? j + 1 : j;
    const int cgn = lb * 36 + BS_CHUNK(jn);
    u16* Ss = Ssb + (j & 1) * (32 * 136);
#pragma unroll
    for (int mm = 0; mm < 2; ++mm)
#pragma unroll
      for (int nt = 0; nt < 2; ++nt) {
        uint2 pk; pk.x = pk2(S[mm][nt][0], S[mm][nt][1]); pk.y = pk2(S[mm][nt][2], S[mm][nt][3]);
        *(uint2*)(Ss + (16 * nt + fr) * 136 + 32 * w + 16 * mm + 4 * fq) = pk;
      }
    LBAR();
    char* oc_ = ocB + (size_t)cgk * 65536;
#pragma unroll
    for (int nt = 0; nt < 2; ++nt) {
      f32x4 O = {0.f, 0.f, 0.f, 0.f};
#pragma unroll
      for (int s = 0; s < 4; ++s) O = mfma(Aqd[s], ld8(Ss + (16 * nt + fr) * 136 + 32 * s + 8 * fq), O);
#pragma unroll
      for (int r = 0; r < 4; ++r) *(u16*)(oc_ + (offR[r] + 32 * nt)) = f2bf(bf2f(oi[nt][r]) + O[r]);
#pragma unroll
      for (int mm = 0; mm < 2; ++mm) {
        f32x4 t = S[mm][nt];
        t[0] *= dec4[mm].x; t[1] *= dec4[mm].y; t[2] *= dec4[mm].z; t[3] *= dec4[mm].w;
        t = mfma(Akd[mm][0], Vf[nt][0], t);
        t = mfma(Akd[mm][1], Vf[nt][1], t);
        S[mm][nt] = t;
      }
    }
    CBAR();
    CS_LOAD(cgn)
  }
  LBAR();
}

DEV void bc_merge_row(const P& p, int l, int lr, int lane);
DEV void bc_merge(const P& p, int l, int it) {
  const int tid_ = opq(threadIdx.x); const int lane = tid_ & 63, w = tid_ >> 6;
#pragma unroll
  for (int rr = 0; rr < 2; ++rr) bc_merge_row(p, l, it * 8 + w * 2 + rr, lane);
}
DEV void bc_merge_row(const P& p, int l, int lr, int lane) {
  int mix = lane >> 5, cm = (lane * 16) & 511;
  const u16* O = (const u16*)(p.ws + (mix ? O_OC : O_OB));
  u16* z = (u16*)(p.ws + O_Z);
  float ov[16], ss = 0.f;
#pragma unroll
  for (int k2 = 0; k2 < 2; ++k2) {
    uint4 a = *(const uint4*)(O + (size_t)lr * 512 + cm + 8 * k2);
    uint4 b = *(const uint4*)(O + ((size_t)GR + lr) * 512 + cm + 8 * k2);
    unsigned aa[4] = {a.x, a.y, a.z, a.w}, bb[4] = {b.x, b.y, b.z, b.w};
#pragma unroll
    for (int q = 0; q < 4; ++q) {
      float v0 = bf2f((u16)(aa[q] & 0xffff)) + bf2f((u16)(bb[q] & 0xffff));
      float v1 = bf2f((u16)(aa[q] >> 16)) + bf2f((u16)(bb[q] >> 16));
      ov[k2 * 8 + q * 2] = v0; ov[k2 * 8 + q * 2 + 1] = v1;
      ss += v0 * v0 + v1 * v1;
    }
  }
  ss += __shfl_xor(ss, 1); ss += __shfl_xor(ss, 2); ss += __shfl_xor(ss, 4);
  float rinv = rsqrtf(ss * (1.f / 128.f) + EPS);
  const float* nw = (mix ? p.hg_norm : p.gdn_norm) + l * 128 + (cm & 127);
  u16* gp = z + (size_t)lr * NZ + (mix ? C_GC : C_GB) + cm;
#pragma unroll
  for (int k2 = 0; k2 < 2; ++k2) {
    uint4 gv = *(const uint4*)(gp + 8 * k2);
    unsigned gg[4] = {gv.x, gv.y, gv.z, gv.w}, oo[4];
#pragma unroll
    for (int q = 0; q < 4; ++q) {
      int e = k2 * 8 + q * 2;
      float y0 = ov[e] * rinv * nw[e] * silu(bf2f((u16)(gg[q] & 0xffff)));
      float y1 = ov[e + 1] * rinv * nw[e + 1] * silu(bf2f((u16)(gg[q] >> 16)));
      oo[q] = pk2(y0, y1);
    }
    *(uint4*)(gp + 8 * k2) = make_uint4(oo[0], oo[1], oo[2], oo[3]);
  }
}

#define XB_TMO      128
#define XB_XCNT(j)  (256  + 64 * (j))
#define XB_XSUB(j)  (1280 + 64 * (j))
#define XB_XGEN(j)  (2304 + 64 * (j))
#define XB_TOP      3328
#define XB_TOPGEN   3392
#define XCD_BAR_WORDS 3456
#define XB_SPIN_CAP (1u << 18)
#define LAS __attribute__((address_space(3)))

__device__ __forceinline__ unsigned xb_ld(unsigned* p)              { return __hip_atomic_load(p, __ATOMIC_RELAXED, __HIP_MEMORY_SCOPE_AGENT); }
__device__ __forceinline__ unsigned xb_add(unsigned* p, unsigned v) { return __hip_atomic_fetch_add(p, v, __ATOMIC_RELAXED, __HIP_MEMORY_SCOPE_AGENT); }
__device__ __forceinline__ unsigned xb_xcc_id() { return (unsigned)__builtin_amdgcn_s_getreg((3 << 11) | 20) & 0xFu; }
#define XB_SPIN(cond, bar) do { unsigned _sp = 0; while (cond) { __builtin_amdgcn_s_sleep(1); \
    if ((++_sp & 255u) == 0u) { if (xb_ld(&(bar)[XB_TMO])) break; if (_sp > XB_SPIN_CAP) { atomicAdd(&(bar)[XB_TMO], 1u); break; } } } } while (0)

struct XcdBarrier {
    unsigned* bar; unsigned x;
    volatile LAS unsigned* st;
};

__device__ __forceinline__ XcdBarrier xcd_barrier_post(unsigned* bar, volatile LAS unsigned* st) {
    XcdBarrier b; b.bar = bar; b.x = xb_xcc_id(); b.st = st;
    if (threadIdx.x == 0) (void)xb_add(&bar[XB_XCNT(b.x)], 1u);
    return b;
}
__device__ __forceinline__ void xcd_barrier_complete(unsigned* bar, unsigned x, unsigned& nloc, unsigned& nx) {
    const unsigned G = gridDim.x * gridDim.y * gridDim.z;
    unsigned sum, cnt, mine, sp = 0u;
    for (;;) {
        sum = 0u; cnt = 0u; mine = 0u;
#pragma unroll
        for (unsigned j = 0; j < 16; ++j) { const unsigned c = xb_ld(&bar[XB_XCNT(j)]); sum += c; cnt += (c > 0u) ? 1u : 0u; mine = (j == x) ? c : mine; }
        if (sum == G) break;
        __builtin_amdgcn_s_sleep(1);
        if ((++sp & 255u) == 0u) { if (xb_ld(&bar[XB_TMO])) break; if (sp > XB_SPIN_CAP) { atomicAdd(&bar[XB_TMO], 1u); break; } }
    }
    nloc = mine > 0u ? mine : 1u; nx = cnt > 0u ? cnt : 1u;
}

__device__ __forceinline__ void xcd_barrier(const XcdBarrier& b) {
    asm volatile("s_waitcnt vmcnt(0)" ::: "memory");
    __syncthreads();
    if (threadIdx.x == 0) {
        unsigned* bar = b.bar;
        __builtin_amdgcn_s_waitcnt(0);
        unsigned nloc = b.st[0], nx = b.st[1];
        if (nloc == 0u) { xcd_barrier_complete(bar, b.x, nloc, nx); b.st[0] = nloc; b.st[1] = nx; }
        const unsigned old = xb_add(&bar[XB_XSUB(b.x)], 1u);
        const unsigned gen = old / nloc;
        if (old + 1u == (gen + 1u) * nloc) {
            __builtin_amdgcn_fence(__ATOMIC_RELEASE, "agent");
            asm volatile("s_waitcnt vmcnt(0)" ::: "memory");
            const unsigned og = xb_add(&bar[XB_TOP], 1u);
            const unsigned tg = og / nx;
            if (og + 1u == (tg + 1u) * nx) xb_add(&bar[XB_TOPGEN], 1u);
            else XB_SPIN(xb_ld(&bar[XB_TOPGEN]) == tg, bar);
            __builtin_amdgcn_fence(__ATOMIC_ACQUIRE, "agent");
            xb_add(&bar[XB_XGEN(b.x)], 1u);
            asm volatile("s_waitcnt vmcnt(0)" ::: "memory");
        } else {
            XB_SPIN(xb_ld(&bar[XB_XGEN(b.x)]) == gen, bar);
            __builtin_amdgcn_fence(__ATOMIC_ACQUIRE, "agent");
            asm volatile("s_waitcnt vmcnt(0)" ::: "memory");
        }
    }
    __syncthreads();
}


#ifdef NO_G0
#define XG0(x)
#else
#define XG0(x) x
#endif
#ifdef NO_G1
#define XG1(x)
#else
#define XG1(x) x
#endif
#ifdef NO_BC
#define XBC(x)
#else
#define XBC(x) x
#endif
#ifdef NO_AC
#define XAC(x)
#else
#define XAC(x) x
#endif
#ifdef NO_P0
#define XP0(x)
#else
#define XP0(x) x
#endif
#ifdef NO_R
#define XR(x)
#else
#define XR(x) x
#endif
#ifdef NO_BL
#define XBL(x)
#else
#define XBL(x) x
#endif
#ifdef NO_CL
#define XCL(x)
#else
#define XCL(x) x
#endif
#ifdef NO_A0
#define XA0(x)
#else
#define XA0(x) x
#endif
#ifdef NO_A1
#define XA1(x)
#else
#define XA1(x) x
#endif
#ifdef NO_BS
#define XBS(x)
#else
#define XBS(x) x
#endif
#ifdef NO_CS
#define XCS(x)
#else
#define XCS(x) x
#endif
__global__ void __launch_bounds__(256, 2) fwd_mega(P p) {
  extern __shared__ __attribute__((aligned(16))) char smem[];
  cg::grid_group grid = cg::this_grid();
  const int G = gridDim.x;
  __shared__ uint4 xb_words;
  if (threadIdx.x == 0) xb_words = make_uint4(0u, 0u, 0u, 0u);
  __syncthreads();
  XcdBarrier xb = xcd_barrier_post((unsigned*)(p.ws + O_BAR), (volatile LAS unsigned*)&xb_words);
  XP0(phase0(p, smem));
  if (p.ws == nullptr) grid.sync();
  xcd_barrier(xb);
  u16* z = (u16*)(p.ws + O_Z);
  u16* zT = (u16*)(p.ws + O_ZT);
  float* ab = (float*)(p.ws + O_AB);
  float* o = (float*)(p.ws + O_BSH);
  const u16* u = (const u16*)(p.ws + O_BIT);
  for (int g = 0; g < NG; ++g) {
    XR(phaseR(p, g, 0));
    xcd_barrier(xb);
    for (int l = 0; l < DEPTH; ++l) {
      for (int rep = 0; rep < REP_G; ++rep) {
        const u16* Bt = (const u16*)(p.ws + O_WTIN) + (size_t)l * NZ * 1024;
        if ((G & 7) == 0) {
          const int x = blockIdx.x & 7, bl = blockIdx.x >> 3, nbl = G >> 3;
          for (int q = bl; q < 9 * 45; q += nbl) { XG0(gemm_tile<0>(u, 1024, Bt, 1024, 9 * x + q % 9, q / 9, z, zT, ab, o, smem)); }
        } else {
          for (int t = blockIdx.x; t < 72 * 45; t += G) { XG0(gemm_tile<0>(u, 1024, Bt, 1024, t % 72, t / 72, z, zT, ab, o, smem)); }
        }
      }
      xcd_barrier(xb);
      for (int rep2 = 0; rep2 < REP_M; ++rep2) {
      for (int rep3 = 0; rep3 < REP_A; ++rep3) {
        if (rep3) xcd_barrier(xb);
        const int nb = NCH * 4, nc = NCH * 4, na = NCH * 8;
        if (G == 512) {
          const int bx = blockIdx.x;
          XCL(c_local2(p, l, bx, smem));
          if (bx < 64) { XCL(c_local2(p, l, 512 + bx, smem)); }
          XBL(b_local(p, l, bx, smem));
          if (bx >= 64 && bx < 128) { XBL(b_local(p, l, 448 + bx, smem)); }
          if (bx < 128) { XA0(a_item(p, l, bx, 0, smem)); }
          else {
            for (int t = 128 + (bx - 128); t < na; t += 384) { XA0(a_item(p, l, t, 0, smem)); }
          }
        } else {
          for (int t = blockIdx.x; t < nb + nc + na; t += G) {
            if (t < nc) { XCL(c_local2(p, l, t, smem)); }
            else if (t < nb + nc) { XBL(b_local(p, l, t - nc, smem)); }
            else { XA0(a_item(p, l, t - nb - nc, 0, smem)); }
          }
        }
      }
      xcd_barrier(xb);
      {
        for (int t = blockIdx.x; t < 256 + 16; t += G) {
          if (t < 128) { XBS(b_seq2(p, t, smem)); }
          else if (t < 256) { XCS(c_seq2(p, t - 128, smem)); }
          else { XAC(a_carry(p, t - 256)); }
        }
      }
      xcd_barrier(xb);
      }
      {
        const int na = NCH * 8, nm = GR / 8;
        for (int t = blockIdx.x; t < na + nm; t += G) {
          if (t < na) { XA1(a_fin2(p, l, t, smem)); }
          else { XBC(bc_merge(p, l, t - na)); }
        }
      }
      xcd_barrier(xb);
      for (int rep = 0; rep < REP_G; ++rep) {
        const u16* Bt = (const u16*)(p.ws + O_WTOUT) + (size_t)l * 1024 * 1536;
        if (l == DEPTH - 1) {
          for (int t = blockIdx.x; t < 64 * 8; t += G) {
            const int q = t % 64, rt = (q >> 4) * 18 + 2 + (q & 15);
            XG1(gemm_tile<1>(z + C_GA, NZ, Bt, 1536, rt, t / 64, z, zT, ab, o, smem));
          }
        } else {
          for (int t = blockIdx.x; t < 72 * 8; t += G) { XG1(gemm_tile<1>(z + C_GA, NZ, Bt, 1536, t % 72, t / 72, z, zT, ab, o, smem)); }
        }
      }
      xcd_barrier(xb);
      XR(phaseR(p, g, l + 1));
      if (l + 1 < DEPTH) xcd_barrier(xb);
    }
  }
}

extern "C" void kernel_launch(void* const* d_in, const int* in_sizes, int n_in, void* d_out, int out_size, void* d_ws,
                              size_t ws_size, hipStream_t stream) {
  static int grid_blocks = 0;
  if (!grid_blocks) {
    int dev = 0, cus = 0, per_cu = 0;
    hipGetDevice(&dev);
    hipDeviceGetAttribute(&cus, hipDeviceAttributeMultiprocessorCount, dev);
    hipFuncSetAttribute((const void*)fwd_mega, hipFuncAttributeMaxDynamicSharedMemorySize, LDS_BYTES);
    hipOccupancyMaxActiveBlocksPerMultiprocessor(&per_cu, fwd_mega, 256, LDS_BYTES);
    if (per_cu > 2) per_cu = 2;
    if (per_cu < 1) per_cu = 1;
    grid_blocks = cus * per_cu;
  }
  if (ws_size < WS_TOTAL) {
    fprintf(stderr, "workspace too small: %zu < %zu\n", ws_size, (size_t)WS_TOTAL);
    return;
  }
  P p{};
  const float** f = (const float**)&p;
  for (int i = 0; i < 23; ++i) f[i] = (const float*)d_in[i];
  p.out = (float*)d_out;
  p.ws = (char*)d_ws;
  hipMemsetAsync((char*)d_ws + O_BAR, 0, XCD_BAR_WORDS * 4, stream);
  void* args[] = {&p};
  hipError_t e = hipLaunchCooperativeKernel((void*)fwd_mega, dim3(grid_blocks), dim3(256), args, LDS_BYTES, stream);
  if (e != hipSuccess) fprintf(stderr, "cooperative launch failed: %s (grid %d)\n", hipGetErrorString(e), grid_blocks);
}
```

```cpp
#include <hip/hip_runtime.h>
#include <hip/hip_cooperative_groups.h>
#include <cstdio>
namespace cg = cooperative_groups;

typedef __attribute__((ext_vector_type(8))) short bf16x8;
typedef __attribute__((ext_vector_type(4))) float f32x4;
typedef unsigned short u16;
#define DEV __device__ __forceinline__

constexpr int DM = 1024, TL = 2048, TCX = 256, TS = 2304, GB = 4, GR = GB * TS, NG = 2;
constexpr int NZ = 5760, DEPTH = 4;
constexpr int C_XA = 0, C_Q = 512, C_K = 1024, C_V = 1536, C_QC = 2048, C_F0 = 2560, C_IC = 3584,
              C_GA = 4096, C_GB = 4608, C_GC = 5120, C_AB = 5632;
constexpr int NCH = GR / 64;
constexpr float EPS = 1e-6f;
constexpr int WPB = 2;

constexpr size_t al256(size_t x) { return (x + 255) & ~(size_t)255; }
constexpr size_t O_WTIN = 0;
constexpr size_t O_WTOUT = O_WTIN + al256((size_t)DEPTH * NZ * 1024 * 2);
constexpr size_t O_WGT = O_WTOUT + al256((size_t)DEPTH * 1024 * 1536 * 2);
constexpr size_t O_MOD = O_WGT + al256((size_t)DEPTH * 2 * 2 * 8 * 4096 * 2);
constexpr size_t O_LBS = O_MOD + al256((size_t)DEPTH * 9 * 3072 * 4);
constexpr size_t O_HC = O_LBS + al256((size_t)DEPTH * 1024 * 4);
constexpr size_t O_Z = O_HC + al256((size_t)GB * TCX * 1024 * 4);
constexpr size_t O_ZT = O_Z + al256((size_t)GR * NZ * 2);
constexpr size_t O_AB = O_ZT + al256((size_t)512 * GR * 2);
constexpr size_t O_BSH = O_AB + al256((size_t)GR * 16 * 4);
constexpr size_t BSH_ONE = (size_t)GR * 512 * 2;
constexpr size_t O_BIT = O_BSH + al256(4 * BSH_ONE);
constexpr size_t BIT_SZ = 17408;
constexpr size_t O_CREC = O_BIT + al256((size_t)NCH * 4 * 2 * BIT_SZ);
constexpr size_t CREC_SZ = 33280;
constexpr size_t O_OB = O_CREC + al256((size_t)NCH * 4 * 2 * CREC_SZ);
constexpr size_t O_OC = O_OB + al256((size_t)2 * GR * 512 * 2);
constexpr size_t O_AP = O_OC + al256((size_t)2 * GR * 512 * 2);
constexpr size_t O_AH = O_AP + al256((size_t)NCH * 2 * 512 * 4);
constexpr size_t O_ACAR = O_AH + al256((size_t)NCH * 2 * 512 * 4);
constexpr size_t O_ALA = O_ACAR + al256((size_t)NCH * 2 * 512 * 4);
constexpr size_t O_AU = O_ALA + al256((size_t)2 * GR * 512 * 2);
constexpr size_t O_BAR = O_AU + al256((size_t)2 * GR * 512 * 2);
constexpr size_t WS_TOTAL = O_BAR + al256(3456 * 4 + 256);

constexpr int LDS_BYTES = 73728;
#ifndef REP_A
#define REP_A 1
#endif
#ifndef REP_G
#define REP_G 1
#endif
#ifndef REP_M
#define REP_M 1
#endif

struct P {
  const float *x, *c, *ctx, *c_ctx, *w_ada, *b_ada, *norm_pre, *norm_post, *w_in, *conv_a_w, *conv_a_b, *rg_w_r,
      *rg_b_r, *rg_w_i, *rg_b_i, *rg_lam, *conv_b_w, *gdn_a_log, *gdn_dt_bias, *gdn_norm, *hg_lb, *hg_norm, *w_out;
  float* out;
  char* ws;
};

DEV int opq(int x) { asm volatile("" : "+v"(x)); return x; }
DEV int opqs(int x) { asm volatile("" : "+s"(x)); return x; }
typedef __attribute__((ext_vector_type(2))) __bf16 bf16x2_t;
typedef __attribute__((ext_vector_type(2))) float f32x2_t;
DEV u16 f2bf(float f) { __bf16 r = (__bf16)f; return __builtin_bit_cast(u16, r); }
DEV float bf2f(u16 h) { return __uint_as_float(((unsigned)h) << 16); }
DEV unsigned pk2(float a, float b) { f32x2_t v = {a, b}; bf16x2_t r = __builtin_convertvector(v, bf16x2_t); return __builtin_bit_cast(unsigned, r); }
DEV float sigm(float x) { return __builtin_amdgcn_rcpf(1.f + __expf(-x)); }
DEV float silu(float x) { return x * __builtin_amdgcn_rcpf(1.f + __expf(-x)); }
DEV float softplus(float x) { return x > 20.f ? x : log1pf(__expf(x)); }
DEV f32x4 mfma(bf16x8 a, bf16x8 b, f32x4 c) { return __builtin_amdgcn_mfma_f32_16x16x32_bf16(a, b, c, 0, 0, 0); }
DEV bf16x8 ld8(const u16* p) { return *reinterpret_cast<const bf16x8*>(p); }
DEV int lat_map(int l, int t) { return (l & 1) ? ((t & 63) * 32 + (t >> 6)) : t; }
DEV int orig_col(int n) {
  if (n < 512) return n;
  if (n < 2048) return n + 512;
  if (n < 4096) return n + 1040;
  if (n < 4608) return n - 4096 + 512;
  if (n < 5120) return n - 4608 + 2576;
  if (n < 5632) return n + 16;
  if (n < 5648) return n - 5632 + 2560;
  return -1;
}
DEV float zval(const u16* z, int rb, int cp, int n, int col) {
  if (cp < 0 && (n == 0 || n == 4)) return 0.f;
  if (cp > 63 && (n == 3 || n == 35)) return 0.f;
  return bf2f(z[(size_t)(rb + cp) * NZ + col]);
}

DEV void ph0_ada(const P& p, int item, char* smem) {
  float* sc = (float*)smem;
  float* red = (float*)(smem + 36864);
  const int tid = threadIdx.x, lane = tid & 63, wv = tid >> 6;
  for (int i = tid; i < 9 * 1024; i += 256) {
    int v = i >> 10, d = i & 1023;
    float cv = (v < 8) ? p.c[v * 1024 + d] : p.c_ctx[d];
    sc[i] = silu(cv);
  }
  __syncthreads();
  const int col = item * 64 + lane;
  const int l = col / 3072, e = col % 3072;
  const float* w = p.w_ada + (size_t)l * 1024 * 3072 + e + (size_t)(256 * wv) * 3072;
  const float* scw = sc + 256 * wv;
  float acc[9];
#pragma unroll
  for (int i = 0; i < 9; ++i) acc[i] = 0.f;
  for (int d = 0; d < 256; d += 16) {
    float wr[16];
#pragma unroll
    for (int k = 0; k < 16; ++k) wr[k] = w[(size_t)(d + k) * 3072];
#pragma unroll
    for (int k = 0; k < 16; ++k)
#pragma unroll
      for (int i = 0; i < 9; ++i) acc[i] += scw[i * 1024 + d + k] * wr[k];
  }
#pragma unroll
  for (int i = 0; i < 9; ++i) red[(wv * 9 + i) * 64 + lane] = acc[i];
  __syncthreads();
  float* mod = (float*)(p.ws + O_MOD);
  for (int idx = tid; idx < 9 * 64; idx += 256) {
    int i = idx >> 6, ln = idx & 63;
    float sum = red[(0 * 9 + i) * 64 + ln] + red[(1 * 9 + i) * 64 + ln] + red[(2 * 9 + i) * 64 + ln] + red[(3 * 9 + i) * 64 + ln];
    int cc = item * 64 + ln, l2 = cc / 3072, e2 = cc % 3072;
    mod[((size_t)l2 * 9 + i) * 3072 + e2] = sum + p.b_ada[l2 * 3072 + e2];
  }
  __syncthreads();
}
DEV void tconv_tile(const float* src, int lds_, u16* dst, int ldd, int k0, int n0, bool mapcol, char* smem) {
  float* t = (float*)smem;
  const int tid = threadIdx.x, nn = tid & 63, kq = tid >> 6;
  const int n = n0 + nn;
  const int sn0 = mapcol ? orig_col(n) : n;
  const float msk = (sn0 >= 0) ? 1.f : 0.f;
  const int sn = sn0 >= 0 ? sn0 : 0;
  float v[16];
#pragma unroll
  for (int k = 0; k < 16; ++k) v[k] = src[(size_t)(k0 + kq + 4 * k) * lds_ + sn];
#pragma unroll
  for (int k = 0; k < 16; ++k) t[(kq + 4 * k) * 65 + nn] = v[k] * msk;
  __syncthreads();
  {
    const int kk = tid & 63, nq = tid >> 6;
#pragma unroll
    for (int k = 0; k < 16; ++k) {
      int n2 = nq + 4 * k;
      dst[(size_t)(n0 + n2) * ldd + k0 + kk] = f2bf(t[kk * 65 + n2]);
    }
  }
  __syncthreads();
}
DEV void phase0(const P& p, char* smem) {
  const int n_ada = 192, n_in = DEPTH * 16 * 90, n_out = DEPTH * 24 * 16, n_g = 128, n_lb = 4;
  const int total = n_ada + n_in + n_out + n_g + n_lb;
  for (int it = blockIdx.x; it < total; it += gridDim.x) {
    int i = it;
    if (i < n_ada) { ph0_ada(p, i, smem); continue; }
    i -= n_ada;
    if (i < n_in) {
      int l = i / 1440, r = i % 1440, kt = r / 90, nt = r % 90;
      tconv_tile(p.w_in + (size_t)l * 1024 * 5648, 5648, (u16*)(p.ws + O_WTIN) + (size_t)l * NZ * 1024, 1024, kt * 64,
                 nt * 64, true, smem);
      continue;
    }
    i -= n_in;
    if (i < n_out) {
      int l = i / 384, r = i % 384, kt = r / 16, nt = r % 16;
      tconv_tile(p.w_out + (size_t)l * 1536 * 1024, 1024, (u16*)(p.ws + O_WTOUT) + (size_t)l * 1024 * 1536, 1536,
                 kt * 64, nt * 64, false, smem);
      continue;
    }
    i -= n_out;
    if (i < n_g) {
      int h = i & 7, gate = (i >> 3) & 1, dir = (i >> 4) & 1, l = i >> 5;
      const float* src = (gate ? p.rg_w_i : p.rg_w_r) + ((size_t)(l * 2 + dir) * 8 + h) * 4096;
      tconv_tile(src, 64, (u16*)(p.ws + O_WGT) + (size_t)i * 4096, 64, 0, 0, false, smem);
      continue;
    }
    i -= n_g;
    {
      int j = i * 256 + threadIdx.x;
      float v[4], mx = -1e30f;
      for (int l = 0; l < 4; ++l) { v[l] = p.hg_lb[l * 1024 + j]; mx = fmaxf(mx, v[l]); }
      float s = 0.f;
      for (int l = 0; l < 4; ++l) { v[l] = __expf(v[l] - mx); s += v[l]; }
      float* lbs = (float*)(p.ws + O_LBS);
      float cum = 0.f;
      for (int l = 0; l < 4; ++l) {
        if (l > 0) cum += v[l] / s;
        lbs[l * 1024 + j] = cum;
      }
    }
  }
}

DEV void phaseR(const P& p, int g, int l) {
  const int tid_ = opq(threadIdx.x); const int lane = tid_ & 63, w = tid_ >> 6;
  const float* mod = (const float*)(p.ws + O_MOD);
  float* hc = (float*)(p.ws + O_HC);
  const float* o = (const float*)(p.ws + O_BSH);
  u16* u = (u16*)(p.ws + O_BIT);
  for (int it = blockIdx.x; it < GR / 4; it += gridDim.x) {
    int lr = it * 4 + w;
    int lb = lr / TS, s = lr % TS;
    bool isctx = s < TCX;
    if (l == DEPTH && isctx) continue;
    int b = g * GB + lb, t = s - TCX;
    int mi = isctx ? 8 : b;
    float* hp = isctx ? hc + ((size_t)lb * TCX + s) * 1024 : p.out + ((size_t)b * TL + t) * 1024;
    float hv[16];
    if (l == 0) {
      const float* src = isctx ? p.ctx + ((size_t)b * TCX + s) * 1024 : p.x + ((size_t)b * TL + t) * 1024;
#pragma unroll
      for (int k = 0; k < 4; ++k) {
        float4 v = *(const float4*)(src + k * 256 + lane * 4);
        hv[k * 4] = v.x; hv[k * 4 + 1] = v.y; hv[k * 4 + 2] = v.z; hv[k * 4 + 3] = v.w;
      }
    } else {
      int orow = lb * TS + (isctx ? s : TCX + lat_map(l - 1, t));
      const u16* op = (const u16*)o + (size_t)orow * 1024;
      float ov[16], ss = 0.f;
#pragma unroll
      for (int k = 0; k < 4; ++k) {
        uint2 pv = *(const uint2*)(op + k * 256 + lane * 4);
        float4 v = make_float4(bf2f((u16)(pv.x & 0xffff)), bf2f((u16)(pv.x >> 16)), bf2f((u16)(pv.y & 0xffff)), bf2f((u16)(pv.y >> 16)));
        ov[k * 4] = v.x; ov[k * 4 + 1] = v.y; ov[k * 4 + 2] = v.z; ov[k * 4 + 3] = v.w;
        ss += v.x * v.x + v.y * v.y + v.z * v.z + v.w * v.w;
      }
#pragma unroll
      for (int off = 32; off; off >>= 1) ss += __shfl_xor(ss, off);
      float rinv = rsqrtf(ss * (1.f / 1024.f) + EPS);
      const float* gate = mod + ((size_t)(l - 1) * 9 + mi) * 3072 + 2048;
      const float* wp = p.norm_post + (l - 1) * 1024;
#pragma unroll
      for (int k = 0; k < 4; ++k) {
        float4 hh = *(const float4*)(hp + k * 256 + lane * 4);
        float4 gg = *(const float4*)(gate + k * 256 + lane * 4);
        float4 ww = *(const float4*)(wp + k * 256 + lane * 4);
        hv[k * 4] = hh.x + gg.x * (ov[k * 4] * rinv * ww.x);
        hv[k * 4 + 1] = hh.y + gg.y * (ov[k * 4 + 1] * rinv * ww.y);
        hv[k * 4 + 2] = hh.z + gg.z * (ov[k * 4 + 2] * rinv * ww.z);
        hv[k * 4 + 3] = hh.w + gg.w * (ov[k * 4 + 3] * rinv * ww.w);
      }
    }
#pragma unroll
    for (int k = 0; k < 4; ++k)
      *(float4*)(hp + k * 256 + lane * 4) = make_float4(hv[k * 4], hv[k * 4 + 1], hv[k * 4 + 2], hv[k * 4 + 3]);
    if (l < DEPTH) {
      float ss = 0.f;
#pragma unroll
      for (int k = 0; k < 16; ++k) ss += hv[k] * hv[k];
#pragma unroll
      for (int off = 32; off; off >>= 1) ss += __shfl_xor(ss, off);
      float rinv = rsqrtf(ss * (1.f / 1024.f) + EPS);
      const float* sh = mod + ((size_t)l * 9 + mi) * 3072;
      const float* wp = p.norm_pre + l * 1024;
      int urow = lb * TS + (isctx ? s : TCX + lat_map(l, t));
      u16* up = u + (size_t)urow * 1024;
#pragma unroll
      for (int k = 0; k < 4; ++k) {
        float4 ww = *(const float4*)(wp + k * 256 + lane * 4);
        float4 s0 = *(const float4*)(sh + k * 256 + lane * 4);
        float4 s1 = *(const float4*)(sh + 1024 + k * 256 + lane * 4);
        float a0 = hv[k * 4] * rinv * ww.x * (1.f + s1.x) + s0.x;
        float a1 = hv[k * 4 + 1] * rinv * ww.y * (1.f + s1.y) + s0.y;
        float a2 = hv[k * 4 + 2] * rinv * ww.z * (1.f + s1.z) + s0.z;
        float a3 = hv[k * 4 + 3] * rinv * ww.w * (1.f + s1.w) + s0.w;
        uint2 pk; pk.x = pk2(a0, a1); pk.y = pk2(a2, a3);
        *(uint2*)(up + k * 256 + lane * 4) = pk;
      }
    }
  }
}

template <int MODE>
DEV void gemm_tile(const u16* __restrict__ A, int lda, const u16* __restrict__ Bt, int K, int rt, int ct, u16* z,
                   u16* zT, float* ab, float* o, char* smem) {
  u16* As = (u16*)smem;
  u16* Bs = As + 128 * 64;
  const int tid = opq(threadIdx.x), lane = tid & 63, w = tid >> 6, wr = w >> 1, wc = w & 1, fr = lane & 15, fq = lane >> 4;
  const int lrow = tid >> 3, lseg = tid & 7;
  const int wsw = (lseg ^ ((lrow >> 1) & 7)) * 8;
  const int rsw = (fr >> 1) & 7;
  const u16* Ag = A + (size_t)(rt * 128 + lrow) * lda + lseg * 8;
  const u16* Bg = Bt + (size_t)(ct * 128 + lrow) * K + lseg * 8;
  uint4 pa0, pa1, pa2, pa3, pb0, pb1, pb2, pb3;
  uint4 qa0, qa1, qa2, qa3, qb0, qb1, qb2, qb3;
  f32x4 acc[4][4];
#pragma unroll
  for (int i = 0; i < 4; ++i)
#pragma unroll
    for (int j = 0; j < 4; ++j) acc[i][j] = (f32x4){0.f, 0.f, 0.f, 0.f};
  const int nk = K / 64;
#define GLD(S, kk)                                                            \
  {                                                                           \
    const int kc_ = ((kk) < nk ? (kk) : nk - 1) * 64;                         \
    S##a0 = *(const uint4*)(Ag + kc_);                                        \
    S##a1 = *(const uint4*)(Ag + kc_ + (size_t)32 * lda);                     \
    S##a2 = *(const uint4*)(Ag + kc_ + (size_t)64 * lda);                     \
    S##a3 = *(const uint4*)(Ag + kc_ + (size_t)96 * lda);                     \
    S##b0 = *(const uint4*)(Bg + kc_);                                        \
    S##b1 = *(const uint4*)(Bg + kc_ + (size_t)32 * K);                       \
    S##b2 = *(const uint4*)(Bg + kc_ + (size_t)64 * K);                       \
    S##b3 = *(const uint4*)(Bg + kc_ + (size_t)96 * K);                       \
  }
#define GST(S, bufo)                                                          \
  *(uint4*)(As + (bufo) + (lrow)*64 + wsw) = S##a0;                      \
  *(uint4*)(As + (bufo) + (lrow + 32) * 64 + wsw) = S##a1;               \
  *(uint4*)(As + (bufo) + (lrow + 64) * 64 + wsw) = S##a2;               \
  *(uint4*)(As + (bufo) + (lrow + 96) * 64 + wsw) = S##a3;               \
  *(uint4*)(Bs + (bufo) + (lrow)*64 + wsw) = S##b0;                      \
  *(uint4*)(Bs + (bufo) + (lrow + 32) * 64 + wsw) = S##b1;               \
  *(uint4*)(Bs + (bufo) + (lrow + 64) * 64 + wsw) = S##b2;               \
  *(uint4*)(Bs + (bufo) + (lrow + 96) * 64 + wsw) = S##b3;
#define GCOMP(cb)                                                                                           \
  _Pragma("unroll") for (int ks = 0; ks < 2; ++ks) {                                                        \
    bf16x8 af[4], bfr[4];                                                                                   \
    _Pragma("unroll") for (int mi = 0; mi < 4; ++mi)                                                        \
        af[mi] = ld8(As + (cb) + (wr * 64 + mi * 16 + fr) * 64 + (((ks * 4 + fq) ^ rsw) * 8));                         \
    _Pragma("unroll") for (int ni = 0; ni < 4; ++ni)                                                        \
        bfr[ni] = ld8(Bs + (cb) + (wc * 64 + ni * 16 + fr) * 64 + (((ks * 4 + fq) ^ rsw) * 8));                        \
    _Pragma("unroll") for (int mi = 0; mi < 4; ++mi)                                                        \
        _Pragma("unroll") for (int ni = 0; ni < 4; ++ni) acc[mi][ni] = mfma(af[mi], bfr[ni], acc[mi][ni]);  \
  }
  constexpr int BUF1 = 2 * 128 * 64;
  GLD(p, 0)
  GLD(q, 1)
  GST(p, 0)
  __syncthreads();
  GLD(p, 2)
  for (int kt = 0; kt < nk; kt += 2) {
    GCOMP(0)
    GST(q, BUF1)
    GLD(q, kt + 3)
    __syncthreads();
    GCOMP(BUF1)
    GST(p, 0)
    GLD(p, kt + 4)
    __syncthreads();
  }
#pragma unroll
  for (int mi = 0; mi < 4; ++mi)
#pragma unroll
    for (int ni = 0; ni < 4; ++ni) {
      int row0 = rt * 128 + wr * 64 + mi * 16 + fq * 4;
      int col = ct * 128 + wc * 64 + ni * 16 + fr;
      f32x4 v = acc[mi][ni];
      if (MODE == 1) {
#pragma unroll
        for (int r = 0; r < 4; ++r) ((u16*)o)[(size_t)(row0 + r) * 1024 + col] = f2bf(v[r]);
      } else {
        if (ct >= 28 && ct < 32) {
          uint2 pk; pk.x = pk2(v[0], v[1]); pk.y = pk2(v[2], v[3]);
          *(uint2*)(zT + (size_t)(col - C_IC) * GR + row0) = pk;
        } else if (ct == 44) {
          if (col - C_AB < 16) {
#pragma unroll
            for (int r = 0; r < 4; ++r) ab[(size_t)(row0 + r) * 16 + (col - C_AB)] = v[r];
          }
        } else {
#pragma unroll
          for (int r = 0; r < 4; ++r) z[(size_t)(row0 + r) * NZ + col] = f2bf(v[r]);
        }
      }
    }
}

DEV void a_item(const P& p, int l, int item, int mode, char* smem) {
  float* xc = (float*)smem;
  u16* xcb = (u16*)(smem + 16384);
  float* av = (float*)(smem + 16384 + 9216);
  float* uv = av + 4096;
  float* segP = uv + 4096;
  float* segH = segP + 256;
  const int tid = opq(threadIdx.x), lane = tid & 63, w = tid >> 6, fr = lane & 15, fq = lane >> 4;
  const int cgk = item >> 3, hA = item & 7, n = cgk % 36, rb = cgk * 64;
  u16* z = (u16*)(p.ws + O_Z);
  {
    u16* xin = (u16*)av;
    uint4 st[3];
#pragma unroll
    for (int k = 0; k < 3; ++k) {
      int idx = tid + 256 * k, row = idx >> 3, sg = idx & 7, cp = row - 2;
      bool ok = (idx < 536) && !((cp < 0 && (n == 0 || n == 4)) || (cp > 63 && (n == 3 || n == 35)));
      st[k] = make_uint4(0u, 0u, 0u, 0u);
      if (ok) st[k] = *(const uint4*)(z + (size_t)(rb + cp) * NZ + C_XA + hA * 64 + sg * 8);
    }
    const int j = tid & 63, ch = hA * 64 + j;
    float cw0 = p.conv_a_w[(l * 4 + 0) * 512 + ch], cw1 = p.conv_a_w[(l * 4 + 1) * 512 + ch];
    float cw2 = p.conv_a_w[(l * 4 + 2) * 512 + ch], cw3 = p.conv_a_w[(l * 4 + 3) * 512 + ch];
    float cb = p.conv_a_b[l * 512 + ch];
#pragma unroll
    for (int k = 0; k < 3; ++k) {
      int idx = tid + 256 * k, row = idx >> 3, sg = idx & 7;
      if (idx < 536) *(uint4*)(xin + row * 72 + sg * 8) = st[k];
    }
    __syncthreads();
#pragma unroll
    for (int k = 0; k < 16; ++k) {
      int c = (tid >> 6) + 4 * k;
      float val = cb + cw0 * bf2f(xin[c * 72 + j]) + cw1 * bf2f(xin[(c + 1) * 72 + j]) + cw2 * bf2f(xin[(c + 2) * 72 + j]) +
                  cw3 * bf2f(xin[(c + 3) * 72 + j]);
      xc[c * 64 + j] = val;
      xcb[c * 72 + j] = f2bf(val);
    }
  }
  __syncthreads();
  float yacc[16];
#pragma unroll
  for (int k = 0; k < 16; ++k) yacc[k] = 0.f;
  const int seg = tid >> 6, sj = tid & 63, sch = hA * 64 + sj;
  for (int dir = 0; dir < 2; ++dir) {
    {
      const u16* wg = (const u16*)(p.ws + O_WGT);
      const u16* wr_ = wg + (size_t)((((l * 2 + dir) * 2 + 0) * 8 + hA)) * 4096;
      const u16* wi_ = wg + (size_t)((((l * 2 + dir) * 2 + 1) * 8 + hA)) * 4096;
      bf16x8 a0 = ld8(xcb + (16 * w + fr) * 72 + fq * 8), a1 = ld8(xcb + (16 * w + fr) * 72 + 32 + fq * 8);
#pragma unroll
      for (int nt = 0; nt < 4; ++nt) {
        f32x4 ar = {0.f, 0.f, 0.f, 0.f}, ai = {0.f, 0.f, 0.f, 0.f};
        const u16* br = wr_ + (nt * 16 + fr) * 64 + fq * 8;
        const u16* bi = wi_ + (nt * 16 + fr) * 64 + fq * 8;
        ar = mfma(a0, ld8(br), ar); ar = mfma(a1, ld8(br + 32), ar);
        ai = mfma(a0, ld8(bi), ai); ai = mfma(a1, ld8(bi + 32), ai);
        int j = nt * 16 + fr, ch = hA * 64 + j;
        float brv = p.rg_b_r[(l * 2 + dir) * 512 + ch], biv = p.rg_b_i[(l * 2 + dir) * 512 + ch];
        float sp = softplus(-p.rg_lam[(l * 2 + dir) * 512 + ch]);
#pragma unroll
        for (int r = 0; r < 4; ++r) {
          int c = 16 * w + 4 * fq + r;
          float rg = sigm(ar[r] + brv), ig = sigm(ai[r] + biv);
          float la = -8.f * rg * sp;
          float a = __expf(la);
          float t2 = 2.f * la;
          float om = (t2 > -0.02f) ? -t2 * (1.f + 0.5f * t2 * (1.f + t2 * (1.f / 3.f) * (1.f + 0.25f * t2))) : 1.f - a * a;
          float uu = sqrtf(fmaxf(om, 0.f)) * (ig * xc[c * 64 + j]);
          av[c * 64 + j] = bf2f(f2bf(la));
          uv[c * 64 + j] = bf2f(f2bf(uu));
        }
      }
    }
    __syncthreads();
    {
      float ls = 0.f, H = 0.f;
      u16* ALA = (u16*)(p.ws + O_ALA);
      u16* AU = (u16*)(p.ws + O_AU);
#pragma unroll
      for (int k = 0; k < 16; ++k) {
        int c = dir ? (16 * seg + 15 - k) : (16 * seg + k);
        float la_ = av[c * 64 + sj], u_ = uv[c * 64 + sj];
        H = __expf(la_) * H + u_;
        ls += la_;
        size_t gi = ((size_t)dir * GR + rb + c) * 512 + sch;
        ALA[gi] = f2bf(la_);
        AU[gi] = f2bf(u_);
      }
      segP[seg * 64 + sj] = __expf(ls);
      segH[seg * 64 + sj] = H;
    }
    __syncthreads();
    if (mode == 0) {
      if (seg == 0) {
        float Pc = 1.f, Hc = 0.f;
        for (int q = 0; q < 4; ++q) {
          int sg = dir ? 3 - q : q;
          Hc = segP[sg * 64 + sj] * Hc + segH[sg * 64 + sj];
          Pc *= segP[sg * 64 + sj];
        }
        size_t idx = ((size_t)cgk * 2 + dir) * 512 + sch;
        ((float*)(p.ws + O_AP))[idx] = Pc;
        ((float*)(p.ws + O_AH))[idx] = Hc;
      }
    } else {
      float st = ((const float*)(p.ws + O_ACAR))[((size_t)cgk * 2 + dir) * 512 + sch];
      int nbefore = dir ? 3 - seg : seg;
      for (int q = 0; q < nbefore; ++q) {
        int sg = dir ? 3 - q : q;
        st = segP[sg * 64 + sj] * st + segH[sg * 64 + sj];
      }
      if (dir == 0) {
#pragma unroll
        for (int k = 0; k < 16; ++k) {
          int c = 16 * seg + k;
          st = av[c * 64 + sj] * st + uv[c * 64 + sj];
          yacc[k] += st;
        }
      } else {
#pragma unroll
        for (int k = 15; k >= 0; --k) {
          int c = 16 * seg + k;
          st = av[c * 64 + sj] * st + uv[c * 64 + sj];
          yacc[k] += st;
        }
      }
    }
    __syncthreads();
  }
  if (mode == 1) {
#pragma unroll
    for (int k = 0; k < 16; ++k) {
      size_t zi = (size_t)(rb + 16 * seg + k) * NZ + C_GA + sch;
      float gate = bf2f(z[zi]);
      z[zi] = f2bf(yacc[k] * silu(gate));
    }
  }
}

DEV void a_fin(const P& p, int l, int item, char* smem) {
  float* segP = (float*)smem;
  float* segH = segP + 512;
  const int tid = opq(threadIdx.x), seg = tid >> 6, sj = tid & 63;
  const int cgk = item >> 3, hA = item & 7, rb = cgk * 64, sch = hA * 64 + sj;
  u16* z = (u16*)(p.ws + O_Z);
  const u16* ALA = (const u16*)(p.ws + O_ALA);
  const u16* AU = (const u16*)(p.ws + O_AU);
  u16 lab[2][16], ub[2][16], gt[16];
#pragma unroll
  for (int dir = 0; dir < 2; ++dir)
#pragma unroll
    for (int k = 0; k < 16; ++k) {
      size_t gi = ((size_t)dir * GR + rb + 16 * seg + k) * 512 + sch;
      lab[dir][k] = ALA[gi];
      ub[dir][k] = AU[gi];
    }
#pragma unroll
  for (int k = 0; k < 16; ++k) gt[k] = z[(size_t)(rb + 16 * seg + k) * NZ + C_GA + sch];
  float car0 = ((const float*)(p.ws + O_ACAR))[((size_t)cgk * 2 + 0) * 512 + sch];
  float car1 = ((const float*)(p.ws + O_ACAR))[((size_t)cgk * 2 + 1) * 512 + sch];
  float af[2][16];
#pragma unroll
  for (int dir = 0; dir < 2; ++dir) {
    float ls = 0.f, H = 0.f;
#pragma unroll
    for (int kk = 0; kk < 16; ++kk) {
      const int k = dir ? 15 - kk : kk;
      float la_ = bf2f(lab[dir][k]);
      float a = __expf(la_);
      af[dir][k] = a;
      H = a * H + bf2f(ub[dir][k]);
      ls += la_;
    }
    segP[(dir * 4 + seg) * 64 + sj] = __expf(ls);
    segH[(dir * 4 + seg) * 64 + sj] = H;
  }
  __syncthreads();
  float yacc[16];
#pragma unroll
  for (int k = 0; k < 16; ++k) yacc[k] = 0.f;
#pragma unroll
  for (int dir = 0; dir < 2; ++dir) {
    float st = dir ? car1 : car0;
    const int nbefore = dir ? 3 - seg : seg;
    for (int q = 0; q < nbefore; ++q) {
      int sg = dir ? 3 - q : q;
      st = segP[(dir * 4 + sg) * 64 + sj] * st + segH[(dir * 4 + sg) * 64 + sj];
    }
#pragma unroll
    for (int kk = 0; kk < 16; ++kk) {
      const int k = dir ? 15 - kk : kk;
      st = af[dir][k] * st + bf2f(ub[dir][k]);
      yacc[k] += st;
    }
  }
#pragma unroll
  for (int k = 0; k < 16; ++k)
    z[(size_t)(rb + 16 * seg + k) * NZ + C_GA + sch] = f2bf(yacc[k] * silu(bf2f(gt[k])));
  __syncthreads();
}

DEV void a_fin2(const P& p, int l, int item, char* smem) {
  float* segP = (float*)smem;
  float* segH = segP + 1024;
  const int tid = opq(threadIdx.x), sg = tid >> 5, cp = tid & 31;
  const int cgk = item >> 3, hA = item & 7, rb = cgk * 64, sch = hA * 64 + 2 * cp;
  u16* z = (u16*)(p.ws + O_Z);
  const u16* ALA = (const u16*)(p.ws + O_ALA);
  const u16* AU = (const u16*)(p.ws + O_AU);
  unsigned lab[2][8], ub[2][8], gt[8];
#pragma unroll
  for (int dir = 0; dir < 2; ++dir)
#pragma unroll
    for (int k = 0; k < 8; ++k) {
      size_t gi = ((size_t)dir * GR + rb + 8 * sg + k) * 512 + sch;
      lab[dir][k] = *(const unsigned*)(ALA + gi);
      ub[dir][k] = *(const unsigned*)(AU + gi);
    }
#pragma unroll
  for (int k = 0; k < 8; ++k) gt[k] = *(const unsigned*)(z + (size_t)(rb + 8 * sg + k) * NZ + C_GA + sch);
  const float2 car0 = *(const float2*)((const float*)(p.ws + O_ACAR) + ((size_t)cgk * 2 + 0) * 512 + sch);
  const float2 car1 = *(const float2*)((const float*)(p.ws + O_ACAR) + ((size_t)cgk * 2 + 1) * 512 + sch);
  float af[2][8][2];
#pragma unroll
  for (int dir = 0; dir < 2; ++dir) {
    float ls0 = 0.f, ls1 = 0.f, H0 = 0.f, H1 = 0.f;
#pragma unroll
    for (int kk = 0; kk < 8; ++kk) {
      const int k = dir ? 7 - kk : kk;
      float l0 = bf2f((u16)(lab[dir][k] & 0xffff)), l1 = bf2f((u16)(lab[dir][k] >> 16));
      float a0 = __expf(l0), a1 = __expf(l1);
      af[dir][k][0] = a0; af[dir][k][1] = a1;
      H0 = a0 * H0 + bf2f((u16)(ub[dir][k] & 0xffff));
      H1 = a1 * H1 + bf2f((u16)(ub[dir][k] >> 16));
      ls0 += l0; ls1 += l1;
    }
    *(float2*)(segP + (dir * 8 + sg) * 64 + 2 * cp) = make_float2(__expf(ls0), __expf(ls1));
    *(float2*)(segH + (dir * 8 + sg) * 64 + 2 * cp) = make_float2(H0, H1);
  }
  __syncthreads();
  float y0[8], y1[8];
#pragma unroll
  for (int k = 0; k < 8; ++k) { y0[k] = 0.f; y1[k] = 0.f; }
#pragma unroll
  for (int dir = 0; dir < 2; ++dir) {
    float s0 = dir ? car1.x : car0.x, s1 = dir ? car1.y : car0.y;
    const int nbefore = dir ? 7 - sg : sg;
    for (int q = 0; q < nbefore; ++q) {
      int sq = dir ? 7 - q : q;
      float2 pp = *(const float2*)(segP + (dir * 8 + sq) * 64 + 2 * cp);
      float2 hh = *(const float2*)(segH + (dir * 8 + sq) * 64 + 2 * cp);
      s0 = pp.x * s0 + hh.x;
      s1 = pp.y * s1 + hh.y;
    }
#pragma unroll
    for (int kk = 0; kk < 8; ++kk) {
      const int k = dir ? 7 - kk : kk;
      s0 = af[dir][k][0] * s0 + bf2f((u16)(ub[dir][k] & 0xffff));
      s1 = af[dir][k][1] * s1 + bf2f((u16)(ub[dir][k] >> 16));
      y0[k] += s0; y1[k] += s1;
    }
  }
#pragma unroll
  for (int k = 0; k < 8; ++k) {
    float g0 = bf2f((u16)(gt[k] & 0xffff)), g1 = bf2f((u16)(gt[k] >> 16));
    *(unsigned*)(z + (size_t)(rb + 8 * sg + k) * NZ + C_GA + sch) = pk2(y0[k] * silu(g0), y1[k] * silu(g1));
  }
  __syncthreads();
}

DEV void a_carry(const P& p, int item, unsigned* flag) {
  int t = item * 256 + threadIdx.x;
  int ch = t & 511, dir = (t >> 9) & 1, lb = t >> 10;
  const float* AP = (const float*)(p.ws + O_AP);
  const float* AH = (const float*)(p.ws + O_AH);
  float* AC = (float*)(p.ws + O_ACAR);
  float st = 0.f;
  float pv[36], hv[36];
#pragma unroll
  for (int j = 0; j < 36; ++j) {
    int n = dir ? (j < 4 ? 3 - j : 39 - j) : j;
    size_t idx = ((size_t)(lb * 36 + n) * 2 + dir) * 512 + ch;
    pv[j] = AP[idx];
    hv[j] = AH[idx];
  }
#pragma unroll
  for (int j = 0; j < 36; ++j) {
    int n = dir ? (j < 4 ? 3 - j : 39 - j) : j;
    size_t idx = ((size_t)(lb * 36 + n) * 2 + dir) * 512 + ch;
    AC[idx] = st;
    st = pv[j] * st + hv[j];
  }
  asm volatile("s_waitcnt vmcnt(0)" ::: "memory");
  __syncthreads();
  if (threadIdx.x == 0) {
    __builtin_amdgcn_fence(__ATOMIC_RELEASE, "agent");
    asm volatile("s_waitcnt vmcnt(0)" ::: "memory");
    __hip_atomic_fetch_add(flag, 1u, __ATOMIC_RELAXED, __HIP_MEMORY_SCOPE_AGENT);
  }
}

DEV void b_local(const P& p, int l, int item, char* smem) {
  u16* qs = (u16*)smem;
  u16* ks = qs + 64 * 136;
  float* Am = (float*)(smem + 34816);
  float* gc = (float*)(smem + 34816 + 32768);
  float* bt = gc + 128;
  const int tid = opq(threadIdx.x), lane = tid & 63, w = tid >> 6, fr = lane & 15, fq = lane >> 4;
  const int cgk = item >> 2, h = item & 3, n = cgk % 36, rb = cgk * 64;
  const u16* z = (const u16*)(p.ws + O_Z);
  u16* qn = (u16*)(p.ws + O_BSH);
  u16* kn = qn + (size_t)GR * 512;
  u16* vb = kn + (size_t)GR * 512;
  u16* knT = vb + (size_t)GR * 512;
  const float* ab = (const float*)(p.ws + O_AB);
  {
    u16* Tt = (u16*)Am;
    uint4 st[5];
#define BL_TLOAD(which)                                                                                  \
  _Pragma("unroll") for (int k = 0; k < 5; ++k) {                                                        \
    int idx = tid + 256 * k, row = idx >> 4, seg = idx & 15, cp = row - 2;                               \
    bool ok = (idx < 1072) && !((cp < 0 && (n == 0 || n == 4)) || (cp > 63 && (n == 3 || n == 35)));    \
    st[k] = make_uint4(0u, 0u, 0u, 0u);                                                                  \
    if (ok) st[k] = *(const uint4*)(z + (size_t)(rb + cp) * NZ + C_Q + (which)*512 + h * 128 + seg * 8); \
  }
    BL_TLOAD(0)
#pragma unroll
    for (int which = 0; which < 3; ++which) {
#pragma unroll
      for (int k = 0; k < 5; ++k) {
        int idx = tid + 256 * k, row = idx >> 4, seg = idx & 15;
        if (idx < 1072) *(uint4*)(Tt + row * 136 + seg * 8) = st[k];
      }
      __syncthreads();
      if (which < 2) { BL_TLOAD(which + 1) }
      float cw[2][4];
#pragma unroll
      for (int hh = 0; hh < 2; ++hh)
#pragma unroll
        for (int tap = 0; tap < 4; ++tap)
          cw[hh][tap] = p.conv_b_w[(size_t)(l * 4 + tap) * 1536 + which * 512 + h * 128 + lane + 64 * hh];
#pragma unroll 4
      for (int c = w; c < 64; c += 4) {
        float v[2];
#pragma unroll
        for (int hh = 0; hh < 2; ++hh) {
          int d = lane + 64 * hh;
          float a = 0.f;
#pragma unroll
          for (int tap = 0; tap < 4; ++tap) a += cw[hh][tap] * bf2f(Tt[(c + tap) * 136 + d]);
          v[hh] = silu(a);
        }
        float rs = 1.f;
        if (which < 2) {
          float sq = v[0] * v[0] + v[1] * v[1];
#pragma unroll
          for (int off = 32; off; off >>= 1) sq += __shfl_xor(sq, off);
          rs = rsqrtf(sq + EPS) * (which == 0 ? 0.08838834764831845f : 1.f);
        }
#pragma unroll
        for (int hh = 0; hh < 2; ++hh) {
          int d = lane + 64 * hh;
          u16 ob = f2bf(v[hh] * rs);
          size_t gi = (size_t)(rb + c) * 512 + h * 128 + d;
          if (which == 0) { qs[c * 136 + d] = ob; qn[gi] = ob; }
          else if (which == 1) { ks[c * 136 + d] = ob; kn[gi] = ob; }
          else vb[gi] = ob;
        }
      }
      __syncthreads();
    }
  }
  if (w < 2) {
    int dir = w, i = lane, c = dir ? 63 - i : i;
    float al = ab[(size_t)(rb + c) * 16 + dir * 4 + h], bl = ab[(size_t)(rb + c) * 16 + 8 + dir * 4 + h];
    float g = -__expf(p.gdn_a_log[(l * 2 + dir) * 4 + h]) * softplus(al + p.gdn_dt_bias[(l * 2 + dir) * 4 + h]);
#pragma unroll
    for (int off = 1; off < 64; off <<= 1) {
      float v = __shfl_up(g, off);
      if (lane >= off) g += v;
    }
    gc[dir * 64 + i] = g;
    bt[dir * 64 + i] = sigm(bl);
  }
  __syncthreads();
  for (int idx = tid; idx < 1024; idx += 256) {
    int d = idx >> 3, c8 = idx & 7;
    uint4 pk;
    pk.x = (unsigned)ks[(c8 * 8 + 0) * 136 + d] | ((unsigned)ks[(c8 * 8 + 1) * 136 + d] << 16);
    pk.y = (unsigned)ks[(c8 * 8 + 2) * 136 + d] | ((unsigned)ks[(c8 * 8 + 3) * 136 + d] << 16);
    pk.z = (unsigned)ks[(c8 * 8 + 4) * 136 + d] | ((unsigned)ks[(c8 * 8 + 5) * 136 + d] << 16);
    pk.w = (unsigned)ks[(c8 * 8 + 6) * 136 + d] | ((unsigned)ks[(c8 * 8 + 7) * 136 + d] << 16);
    *(uint4*)(knT + ((size_t)(cgk * 4 + h) * 128 + d) * 64 + c8 * 8) = pk;
  }
  for (int dir = 0; dir < 2; ++dir) {
    char* rec = p.ws + O_BIT + ((size_t)(cgk * 4 + h) * 2 + dir) * BIT_SZ;
    u16* QKm = (u16*)rec + 4096;
    float* scal = (float*)(rec + 16384);
    int irow = 16 * w + fr, ci = dir ? 63 - irow : irow;
    bf16x8 ak[4], aq[4];
#pragma unroll
    for (int s = 0; s < 4; ++s) { ak[s] = ld8(ks + ci * 136 + 32 * s + 8 * fq); aq[s] = ld8(qs + ci * 136 + 32 * s + 8 * fq); }
#pragma unroll
    for (int nt = 0; nt < 4; ++nt) {
      int jcol = 16 * nt + fr, cj = dir ? 63 - jcol : jcol;
      f32x4 kk = {0.f, 0.f, 0.f, 0.f}, qk = {0.f, 0.f, 0.f, 0.f};
#pragma unroll
      for (int s = 0; s < 4; ++s) {
        bf16x8 b = ld8(ks + cj * 136 + 32 * s + 8 * fq);
        kk = mfma(ak[s], b, kk);
        qk = mfma(aq[s], b, qk);
      }
      float gj = gc[dir * 64 + jcol];
#pragma unroll
      for (int r = 0; r < 4; ++r) {
        int i = 16 * w + 4 * fq + r;
        float dec = (jcol <= i) ? __expf(gc[dir * 64 + i] - gj) : 0.f;
        Am[(dir * 64 + i) * 64 + jcol] = (jcol < i) ? bt[dir * 64 + i] * kk[r] * dec : 0.f;
        QKm[i * 64 + jcol] = f2bf(qk[r] * dec);
      }
    }
    if (tid < 64) {
      float gl = gc[dir * 64 + 63], gi = gc[dir * 64 + tid];
      scal[tid] = __expf(gi);
      scal[64 + tid] = bt[dir * 64 + tid];
      scal[128 + tid] = __expf(gl - gi);
      if (tid == 0) scal[192] = __expf(gl);
    }
  }
  __syncthreads();
  if (w < 2) {
    int dir = w, col = lane;
    u16* Tinv = (u16*)(p.ws + O_BIT + ((size_t)(cgk * 4 + h) * 2 + dir) * BIT_SZ);
    const float* Ad = Am + dir * 4096;
    float T[64];
#pragma unroll
    for (int i = 0; i < 64; ++i) {
      float s = (i == col) ? 1.f : 0.f;
#pragma unroll
      for (int j = 0; j < i; ++j) s -= Ad[i * 64 + j] * T[j];
      T[i] = s;
      Tinv[i * 64 + col] = f2bf(s);
      __builtin_amdgcn_sched_barrier(0);
    }
  }
  __syncthreads();
}

DEV void b_seq(const P& p, int bitem, char* smem) {
  const int tid = opq(threadIdx.x), lane = tid & 63, w = tid >> 6, fr = lane & 15, fq = lane >> 4;
  const bool active = w < WPB;
  const int item = bitem * WPB + (active ? w : 0);
  const int slice = item & 7, dir = (item >> 3) & 1, h = (item >> 4) & 3, lb = item >> 6, e0 = slice * 16;
  u16* Ss = (u16*)(smem + w * 11264);
  u16* Rs = Ss + 16 * 136;
  u16* Vsc = Rs + 16 * 72;
  u16* Vor = Vsc + 16 * 72;
  const u16* qn = (const u16*)(p.ws + O_BSH);
  const u16* kn = qn + (size_t)GR * 512;
  const u16* vb = kn + (size_t)GR * 512;
  const u16* knT = vb + (size_t)GR * 512;
  u16* OB = (u16*)(p.ws + O_OB);
  f32x4 S[8];
#pragma unroll
  for (int m = 0; m < 8; ++m) S[m] = (f32x4){0.f, 0.f, 0.f, 0.f};
  for (int j = 0; j < 36; ++j) {
    const int n = dir ? (j < 4 ? 3 - j : 39 - j) : j;
    const int cgk = lb * 36 + n, rb = cgk * 64;
    const char* rec = p.ws + O_BIT + ((size_t)(cgk * 4 + h) * 2 + dir) * BIT_SZ;
    const u16* Tinv = (const u16*)rec;
    const u16* QKm = Tinv + 4096;
    const float* scal = (const float*)(rec + 16384);
    if (active) {
#pragma unroll
      for (int m = 0; m < 8; ++m) {
        uint2 pk; pk.x = pk2(S[m][0], S[m][1]); pk.y = pk2(S[m][2], S[m][3]);
        *(uint2*)(Ss + fr * 136 + 16 * m + 4 * fq) = pk;
      }
    }
    __syncthreads();
    bf16x8 Sf[4];
    if (active) {
#pragma unroll
      for (int s = 0; s < 4; ++s) Sf[s] = ld8(Ss + fr * 136 + 32 * s + 8 * fq);
#pragma unroll
      for (int m = 0; m < 4; ++m) {
        int i = 16 * m + fr, rowi = rb + (dir ? 63 - i : i);
        f32x4 X = {0.f, 0.f, 0.f, 0.f};
#pragma unroll
        for (int s = 0; s < 4; ++s) X = mfma(ld8(kn + (size_t)rowi * 512 + h * 128 + 32 * s + 8 * fq), Sf[s], X);
        float rv[4];
#pragma unroll
        for (int r = 0; r < 4; ++r) {
          int ii = 16 * m + 4 * fq + r, rowr = rb + (dir ? 63 - ii : ii);
          float v = bf2f(vb[(size_t)rowr * 512 + h * 128 + e0 + fr]);
          rv[r] = scal[64 + ii] * (v - scal[ii] * X[r]);
        }
        uint2 pk; pk.x = pk2(rv[0], rv[1]); pk.y = pk2(rv[2], rv[3]);
        *(uint2*)(Rs + fr * 72 + 16 * m + 4 * fq) = pk;
      }
    }
    __syncthreads();
    if (active) {
      bf16x8 Rf0 = ld8(Rs + fr * 72 + 8 * fq), Rf1 = ld8(Rs + fr * 72 + 32 + 8 * fq);
#pragma unroll
      for (int m = 0; m < 4; ++m) {
        f32x4 VN = {0.f, 0.f, 0.f, 0.f};
        VN = mfma(ld8(Tinv + (16 * m + fr) * 64 + 8 * fq), Rf0, VN);
        VN = mfma(ld8(Tinv + (16 * m + fr) * 64 + 32 + 8 * fq), Rf1, VN);
        uint2 pk; pk.x = pk2(VN[0], VN[1]); pk.y = pk2(VN[2], VN[3]);
        *(uint2*)(Vsc + fr * 72 + 16 * m + 4 * fq) = pk;
        int ib = 16 * m + 4 * fq;
        float s0 = VN[0] * scal[128 + ib], s1 = VN[1] * scal[128 + ib + 1], s2 = VN[2] * scal[128 + ib + 2],
              s3 = VN[3] * scal[128 + ib + 3];
        if (dir) {
          pk.x = pk2(s3, s2); pk.y = pk2(s1, s0);
          *(uint2*)(Vor + fr * 72 + (60 - ib)) = pk;
        } else {
          pk.x = pk2(s0, s1); pk.y = pk2(s2, s3);
          *(uint2*)(Vor + fr * 72 + ib) = pk;
        }
      }
    }
    __syncthreads();
    if (active) {
      bf16x8 Vs0 = ld8(Vsc + fr * 72 + 8 * fq), Vs1 = ld8(Vsc + fr * 72 + 32 + 8 * fq);
      bf16x8 Vo0 = ld8(Vor + fr * 72 + 8 * fq), Vo1 = ld8(Vor + fr * 72 + 32 + 8 * fq);
#pragma unroll
      for (int m = 0; m < 4; ++m) {
        int i = 16 * m + fr, rowi = rb + (dir ? 63 - i : i);
        f32x4 O = {0.f, 0.f, 0.f, 0.f};
#pragma unroll
        for (int s = 0; s < 4; ++s) O = mfma(ld8(qn + (size_t)rowi * 512 + h * 128 + 32 * s + 8 * fq), Sf[s], O);
#pragma unroll
        for (int r = 0; r < 4; ++r) O[r] *= scal[16 * m + 4 * fq + r];
        O = mfma(ld8(QKm + (16 * m + fr) * 64 + 8 * fq), Vs0, O);
        O = mfma(ld8(QKm + (16 * m + fr) * 64 + 32 + 8 * fq), Vs1, O);
#pragma unroll
        for (int r = 0; r < 4; ++r) {
          int ii = 16 * m + 4 * fq + r, rowr = rb + (dir ? 63 - ii : ii);
          OB[((size_t)dir * GR + rowr) * 512 + h * 128 + e0 + fr] = f2bf(O[r]);
        }
      }
      float egl = scal[192];
#pragma unroll
      for (int m = 0; m < 8; ++m) {
        const u16* kt = knT + ((size_t)(cgk * 4 + h) * 128 + 16 * m + fr) * 64;
        f32x4 t = S[m];
#pragma unroll
        for (int r = 0; r < 4; ++r) t[r] *= egl;
        t = mfma(ld8(kt + 8 * fq), Vo0, t);
        t = mfma(ld8(kt + 32 + 8 * fq), Vo1, t);
        S[m] = t;
      }
    }
  }
  __syncthreads();
}

DEV void c_local(const P& p, int l, int item, char* smem) {
  float* bsm = (float*)smem;
  u16* Ps = (u16*)(smem + 33024);
  u16* kdt = (u16*)(smem + 33024 + 9216);
  const int tid = opq(threadIdx.x), lane = tid & 63, w = tid >> 6, fr = lane & 15, fq = lane >> 4;
  const int cgk = item >> 2, h = item & 3, rb = cgk * 64;
  const u16* z = (const u16*)(p.ws + O_Z);
  const u16* zT = (const u16*)(p.ws + O_ZT);
  u16* OC = (u16*)(p.ws + O_OC);
  const float* lbs = (const float*)(p.ws + O_LBS);
  for (int dir = 0; dir < 2; ++dir) {
    char* rec = p.ws + O_CREC + ((size_t)(cgk * 4 + h) * 2 + dir) * CREC_SZ;
    u16* QD = (u16*)rec;
    u16* KDT = QD + 8192;
    float* decv = (float*)(rec + 32768);
    const float* lbp = lbs + l * 1024 + dir * 512 + h * 128;
    const int fcol = C_F0 + dir * 512 + h * 128;
    {
      int d = tid & 127, half = tid >> 7;
      float lb_ = lbp[d], run = 0.f;
      for (int k = 0; k < 32; ++k) {
        int i = 32 * half + k, c = dir ? 63 - i : i;
        float f = bf2f(z[(size_t)(rb + c) * NZ + fcol + d]);
        float fg = lb_ + (1.f - lb_) * sigm(f);
        run += __logf(fg);
        bsm[i * 129 + d] = run;
      }
    }
    __syncthreads();
    {
      int d = tid & 127, half = tid >> 7;
      if (half) {
        float add = bsm[31 * 129 + d];
        for (int k = 0; k < 32; ++k) bsm[(32 + k) * 129 + d] += add;
      }
    }
    __syncthreads();
    for (int idx = tid; idx < 8192; idx += 256) {
      int i = idx >> 7, d = idx & 127, c = dir ? 63 - i : i;
      float b = bsm[i * 129 + d];
      float q = silu(bf2f(z[(size_t)(rb + c) * NZ + C_QC + h * 128 + d]));
      QD[i * 128 + d] = f2bf(q * __expf(b));
      float f = bf2f(z[(size_t)(rb + c) * NZ + fcol + d]);
      float k = (1.f - lbp[d]) * sigm(-f);
      kdt[d * 72 + c] = f2bf(k * __expf(bsm[63 * 129 + d] - b));
    }
    if (tid < 128) decv[tid] = __expf(bsm[63 * 129 + tid]);
    __syncthreads();
    for (int idx = tid; idx < 1024; idx += 256) {
      int d = idx >> 3, c8 = idx & 7;
      *(uint4*)(KDT + d * 64 + c8 * 8) = *(const uint4*)(kdt + d * 72 + c8 * 8);
    }
    {
      const int sj = w;
      for (int si = 0; si < 4; ++si) {
        f32x4 acc = {0.f, 0.f, 0.f, 0.f};
        if (si >= sj) {
          int it = 16 * si + fr, jt = 16 * sj + fr;
          int ci = dir ? 63 - it : it, cj = dir ? 63 - jt : jt;
#pragma unroll
          for (int s = 0; s < 4; ++s) {
            int d0 = 32 * s + 8 * fq;
            bf16x8 qv = ld8(z + (size_t)(rb + ci) * NZ + C_QC + h * 128 + d0);
            bf16x8 fv = ld8(z + (size_t)(rb + cj) * NZ + fcol + d0);
            bf16x8 af, bf;
#pragma unroll
            for (int e = 0; e < 8; ++e) {
              int d = d0 + e;
              float Bs_ = si ? bsm[(16 * si - 1) * 129 + d] : 0.f;
              float qq = silu(bf2f((u16)qv[e])) * __expf(bsm[it * 129 + d] - Bs_);
              float kk = (1.f - lbp[d]) * sigm(-bf2f((u16)fv[e])) * __expf(Bs_ - bsm[jt * 129 + d]);
              af[e] = (short)f2bf(qq);
              bf[e] = (short)f2bf(kk);
            }
            acc = mfma(af, bf, acc);
          }
        }
#pragma unroll
        for (int r = 0; r < 4; ++r) {
          int i = 16 * si + 4 * fq + r, jj = 16 * sj + fr;
          float v = (si >= sj && jj <= i) ? acc[r] : 0.f;
          Ps[i * 72 + (dir ? 63 - jj : jj)] = f2bf(v);
        }
        __builtin_amdgcn_sched_barrier(0);
      }
    }
    __syncthreads();
#pragma unroll
    for (int nt2 = 0; nt2 < 2; ++nt2) {
      int e = h * 128 + (2 * w + nt2) * 16 + fr;
      bf16x8 v0 = ld8(zT + (size_t)e * GR + rb + 8 * fq), v1 = ld8(zT + (size_t)e * GR + rb + 32 + 8 * fq);
#pragma unroll
      for (int m = 0; m < 4; ++m) {
        f32x4 O = {0.f, 0.f, 0.f, 0.f};
        O = mfma(ld8(Ps + (16 * m + fr) * 72 + 8 * fq), v0, O);
        O = mfma(ld8(Ps + (16 * m + fr) * 72 + 32 + 8 * fq), v1, O);
#pragma unroll
        for (int r = 0; r < 4; ++r) {
          int ii = 16 * m + 4 * fq + r, rowr = rb + (dir ? 63 - ii : ii);
          OC[((size_t)dir * GR + rowr) * 512 + e] = f2bf(O[r]);
        }
      }
    }
    __syncthreads();
  }
}

DEV void c_seq(const P& p, int bitem, char* smem) {
  const int tid = opq(threadIdx.x), lane = tid & 63, w = tid >> 6, fr = lane & 15, fq = lane >> 4;
  const bool active = w < WPB;
  const int item = bitem * WPB + (active ? w : 0);
  const int slice = item & 7, dir = (item >> 3) & 1, h = (item >> 4) & 3, lb = item >> 6, e0 = slice * 16;
  u16* Ss = (u16*)(smem + w * 4352);
  const u16* zT = (const u16*)(p.ws + O_ZT);
  u16* OC = (u16*)(p.ws + O_OC);
  f32x4 S[8];
#pragma unroll
  for (int m = 0; m < 8; ++m) S[m] = (f32x4){0.f, 0.f, 0.f, 0.f};
  for (int j = 0; j < 36; ++j) {
    const int n = dir ? (j < 4 ? 3 - j : 39 - j) : j;
    const int cgk = lb * 36 + n, rb = cgk * 64;
    const char* rec = p.ws + O_CREC + ((size_t)(cgk * 4 + h) * 2 + dir) * CREC_SZ;
    const u16* QD = (const u16*)rec;
    const u16* KDT = QD + 8192;
    const float* decv = (const float*)(rec + 32768);
    if (active) {
#pragma unroll
      for (int m = 0; m < 8; ++m) {
        uint2 pk; pk.x = pk2(S[m][0], S[m][1]); pk.y = pk2(S[m][2], S[m][3]);
        *(uint2*)(Ss + fr * 136 + 16 * m + 4 * fq) = pk;
      }
    }
    __syncthreads();
    if (active) {
      bf16x8 Sf[4];
#pragma unroll
      for (int s = 0; s < 4; ++s) Sf[s] = ld8(Ss + fr * 136 + 32 * s + 8 * fq);
#pragma unroll
      for (int m = 0; m < 4; ++m) {
        f32x4 O = {0.f, 0.f, 0.f, 0.f};
#pragma unroll
        for (int s = 0; s < 4; ++s) O = mfma(ld8(QD + (16 * m + fr) * 128 + 32 * s + 8 * fq), Sf[s], O);
#pragma unroll
        for (int r = 0; r < 4; ++r) {
          int ii = 16 * m + 4 * fq + r, rowr = rb + (dir ? 63 - ii : ii);
          size_t oi = ((size_t)dir * GR + rowr) * 512 + h * 128 + e0 + fr;
          OC[oi] = f2bf(bf2f(OC[oi]) + O[r]);
        }
      }
      const u16* vp = zT + (size_t)(h * 128 + e0 + fr) * GR + rb;
      bf16x8 V0 = ld8(vp + 8 * fq), V1 = ld8(vp + 32 + 8 * fq);
#pragma unroll
      for (int m = 0; m < 8; ++m) {
        f32x4 t = S[m];
#pragma unroll
        for (int r = 0; r < 4; ++r) t[r] *= decv[16 * m + 4 * fq + r];
        t = mfma(ld8(KDT + (16 * m + fr) * 64 + 8 * fq), V0, t);
        t = mfma(ld8(KDT + (16 * m + fr) * 64 + 32 + 8 * fq), V1, t);
        S[m] = t;
      }
    }
    __syncthreads();
  }
}

#define LBAR()                                              \
  do {                                                      \
    asm volatile("s_waitcnt lgkmcnt(0)" ::: "memory");      \
    __builtin_amdgcn_s_barrier();                           \
    asm volatile("" ::: "memory");                          \
  } while (0)
#define CBAR() asm volatile("" ::: "memory")

DEV void c_local2(const P& p, int l, int item, char* smem) {
  float* bsm = (float*)smem;
  u16* Fq = (u16*)(smem + 33024);
  u16* kdt = (u16*)(smem + 50432);
  u16* Ps = kdt;
  const int tid = opq(threadIdx.x), lane = tid & 63, w = tid >> 6, fr = lane & 15, fq = lane >> 4;
  const int cgk = item >> 2, h = item & 3, rb = cgk * 64;
  const u16* z = (const u16*)(p.ws + O_Z);
  const u16* zT = (const u16*)(p.ws + O_ZT);
  u16* OC = (u16*)(p.ws + O_OC);
  const float* lbs = (const float*)(p.ws + O_LBS);
  u16* zq = (u16*)(p.ws + O_Z) + (size_t)rb * NZ + C_QC + h * 128;
  {
    uint4 t4[4];
#pragma unroll
    for (int k = 0; k < 4; ++k) {
      int idx = tid + 256 * k, c = idx >> 4, seg = idx & 15;
      t4[k] = *(const uint4*)(zq + (size_t)c * NZ + seg * 8);
    }
#pragma unroll
    for (int k = 0; k < 4; ++k) {
      int idx = tid + 256 * k, c = idx >> 4, seg = idx & 15;
      unsigned wv[4] = {t4[k].x, t4[k].y, t4[k].z, t4[k].w};
#pragma unroll
      for (int q = 0; q < 4; ++q)
        wv[q] = pk2(silu(bf2f((u16)(wv[q] & 0xffff))), silu(bf2f((u16)(wv[q] >> 16))));
      *(uint4*)(zq + (size_t)c * NZ + seg * 8) = make_uint4(wv[0], wv[1], wv[2], wv[3]);
    }
  }
  __syncthreads();
  for (int dir = 0; dir < 2; ++dir) {
    char* rec = p.ws + O_CREC + ((size_t)(cgk * 4 + h) * 2 + dir) * CREC_SZ;
    u16* QD = (u16*)rec;
    u16* KDT = QD + 8192;
    float* decv = (float*)(rec + 32768);
    const float* lbp = lbs + l * 1024 + dir * 512 + h * 128;
    const int fcol = C_F0 + dir * 512 + h * 128;
    {
      uint4 t4[4];
#pragma unroll
      for (int k = 0; k < 4; ++k) {
        int idx = tid + 256 * k, c = idx >> 4, seg = idx & 15;
        t4[k] = *(const uint4*)(z + (size_t)(rb + c) * NZ + fcol + seg * 8);
      }
#pragma unroll
      for (int k = 0; k < 4; ++k) {
        int idx = tid + 256 * k, c = idx >> 4, seg = idx & 15;
        *(uint4*)(Fq + c * 136 + seg * 8) = t4[k];
      }
    }
    __syncthreads();
    {
      int d = tid & 127, half = tid >> 7;
      float lb_ = lbp[d], run = 0.f;
#pragma unroll 8
      for (int k = 0; k < 32; ++k) {
        int i = 32 * half + k, c = dir ? 63 - i : i;
        float f = bf2f(Fq[c * 136 + d]);
        float fg = lb_ + (1.f - lb_) * sigm(f);
        run += __logf(fg);
        bsm[i * 129 + d] = run;
      }
    }
    __syncthreads();
    {
      int d = tid & 127, half = tid >> 7;
      if (half) {
        float add = bsm[31 * 129 + d];
#pragma unroll 8
        for (int k = 0; k < 32; ++k) bsm[(32 + k) * 129 + d] += add;
      }
    }
    __syncthreads();
    {
      uint4 qv[4];
#pragma unroll
      for (int k = 0; k < 4; ++k) {
        int idx = tid + 256 * k, c = idx >> 4, seg = idx & 15;
        qv[k] = *(const uint4*)(zq + (size_t)c * NZ + seg * 8);
      }
#pragma unroll
      for (int k = 0; k < 4; ++k) {
        int idx = tid + 256 * k, c = idx >> 4, seg = idx & 15, i = dir ? 63 - c : c, d0 = seg * 8;
        unsigned qw[4] = {qv[k].x, qv[k].y, qv[k].z, qv[k].w};
        uint4 fv4 = *(const uint4*)(Fq + c * 136 + d0);
        unsigned fw[4] = {fv4.x, fv4.y, fv4.z, fv4.w};
        unsigned qo[4], ko[4];
#pragma unroll
        for (int q = 0; q < 4; ++q) {
          int d = d0 + 2 * q;
          float b0 = bsm[i * 129 + d], b1 = bsm[i * 129 + d + 1];
          float bl0 = bsm[63 * 129 + d], bl1 = bsm[63 * 129 + d + 1];
          float q0 = bf2f((u16)(qw[q] & 0xffff)), q1 = bf2f((u16)(qw[q] >> 16));
          qo[q] = pk2(q0 * __expf(b0), q1 * __expf(b1));
          float k0 = (1.f - lbp[d]) * sigm(-bf2f((u16)(fw[q] & 0xffff)));
          float k1 = (1.f - lbp[d + 1]) * sigm(-bf2f((u16)(fw[q] >> 16)));
          ko[q] = pk2(k0, k1);
          kdt[d * 72 + c] = f2bf(k0 * __expf(bl0 - b0));
          kdt[(d + 1) * 72 + c] = f2bf(k1 * __expf(bl1 - b1));
        }
        *(uint4*)(QD + i * 128 + d0) = make_uint4(qo[0], qo[1], qo[2], qo[3]);
        *(uint4*)(Fq + c * 136 + d0) = make_uint4(ko[0], ko[1], ko[2], ko[3]);
      }
      if (tid < 128) decv[tid] = __expf(bsm[63 * 129 + tid]);
    }
    __syncthreads();
    for (int idx = tid; idx < 1024; idx += 256) {
      int d = idx >> 3, c8 = idx & 7;
      *(uint4*)(KDT + d * 64 + c8 * 8) = *(const uint4*)(kdt + d * 72 + c8 * 8);
    }
    bf16x8 qf[3][4];
#pragma unroll
    for (int t = 0; t < 3; ++t) {
      int k = w + 4 * t;
      int si = k < 4 ? 3 : (k < 7 ? 2 : (k < 9 ? 1 : 0));
      int it_ = 16 * si + fr, ci_ = dir ? 63 - it_ : it_;
#pragma unroll
      for (int s = 0; s < 4; ++s) qf[t][s] = ld8(zq + (size_t)ci_ * NZ + 32 * s + 8 * fq);
    }
    __syncthreads();
    for (int idx = tid; idx < 1536; idx += 256) {
      int tl = idx >> 8, e = idx & 255, r16 = e >> 4, c16 = e & 15;
      int si = tl < 3 ? 0 : (tl < 5 ? 1 : 2);
      int sj = tl < 3 ? tl + 1 : (tl < 5 ? tl - 1 : 3);
      int jj = 16 * sj + c16;
      Ps[(16 * si + r16) * 72 + (dir ? 63 - jj : jj)] = 0;
    }
#pragma unroll
    for (int t = 0; t < 3; ++t) {
      const int k = w + 4 * t;
      if (k < 10) {
        const int si = k < 4 ? 3 : (k < 7 ? 2 : (k < 9 ? 1 : 0));
        const int sj = k - (k < 4 ? 0 : (k < 7 ? 4 : (k < 9 ? 7 : 9)));
        const int it = 16 * si + fr, jt = 16 * sj + fr, cj = dir ? 63 - jt : jt;
        const int brow = si ? (16 * si - 1) : 0;
        const float bmul = si ? 1.f : 0.f;
        f32x4 acc = {0.f, 0.f, 0.f, 0.f};
#pragma unroll
        for (int s = 0; s < 4; ++s) {
          int d0 = 32 * s + 8 * fq;
          bf16x8 fv = ld8(Fq + cj * 136 + d0);
          bf16x8 af, bf;
#pragma unroll
          for (int e = 0; e < 8; ++e) {
            int d = d0 + e;
            float Bs_ = bmul * bsm[brow * 129 + d];
            float qq = bf2f((u16)qf[t][s][e]) * __expf(bsm[it * 129 + d] - Bs_);
            float kk = bf2f((u16)fv[e]) * __expf(Bs_ - bsm[jt * 129 + d]);
            af[e] = (short)f2bf(qq);
            bf[e] = (short)f2bf(kk);
          }
          acc = mfma(af, bf, acc);
          __builtin_amdgcn_sched_barrier(0);
        }
#pragma unroll
        for (int r = 0; r < 4; ++r) {
          int i = 16 * si + 4 * fq + r, jj = 16 * sj + fr;
          float v = (jj <= i) ? acc[r] : 0.f;
          Ps[i * 72 + (dir ? 63 - jj : jj)] = f2bf(v);
        }
      }
    }
    __syncthreads();
#pragma unroll
    for (int nt2 = 0; nt2 < 2; ++nt2) {
      int e = h * 128 + (2 * w + nt2) * 16 + fr;
      bf16x8 v0 = ld8(zT + (size_t)e * GR + rb + 8 * fq), v1 = ld8(zT + (size_t)e * GR + rb + 32 + 8 * fq);
#pragma unroll
      for (int m = 0; m < 4; ++m) {
        f32x4 O = {0.f, 0.f, 0.f, 0.f};
        O = mfma(ld8(Ps + (16 * m + fr) * 72 + 8 * fq), v0, O);
        O = mfma(ld8(Ps + (16 * m + fr) * 72 + 32 + 8 * fq), v1, O);
#pragma unroll
        for (int r = 0; r < 4; ++r) {
          int ii = 16 * m + 4 * fq + r, rowr = rb + (dir ? 63 - ii : ii);
          OC[((size_t)dir * GR + rowr) * 512 + e] = f2bf(O[r]);
        }
      }
    }
    __syncthreads();
  }
}

#define LBAR()                                              \
  do {                                                      \
    asm volatile("s_waitcnt lgkmcnt(0)" ::: "memory");      \
    __builtin_amdgcn_s_barrier();                           \
    asm volatile("" ::: "memory");                          \
  } while (0)
#define CBAR() asm volatile("" ::: "memory")
#define BS_CHUNK(jj) (dir ? ((jj) < 4 ? 3 - (jj) : 39 - (jj)) : (jj))
DEV bf16x8 ldo8(const char* base, unsigned off) { return *reinterpret_cast<const bf16x8*>(base + off); }
DEV void b_seq2(const P& p, int bitem, char* smem) {
  const int tid = opq(threadIdx.x), lane = tid & 63, w = tid >> 6, fr = lane & 15, fq = lane >> 4;
  const int es = bitem >> 5, dir = bitem & 1, h = (bitem >> 1) & 3, lb = (bitem >> 3) & 3, e0 = es * 32;
  u16* Ss = (u16*)smem;
  u16* Rs = Ss + 32 * 136;
  u16* Vsc = Rs + 32 * 72;
  u16* Vor = Vsc + 32 * 72;
  const char* qnB = p.ws + O_BSH + (size_t)h * 256;
  const char* knB = qnB + BSH_ONE;
  const char* vbB = knB + BSH_ONE + (size_t)e0 * 2;
  const char* ktB = p.ws + O_BSH + 3 * BSH_ONE + (size_t)h * 16384;
  const char* recB = p.ws + O_BIT + ((size_t)h * 2 + dir) * BIT_SZ;
  char* obB = p.ws + O_OB + ((size_t)dir * GR * 512 + h * 128 + e0) * 2;
  const int mrow = 16 * w + fr, crow0 = 16 * w + 4 * fq;
  const unsigned offA = (unsigned)((dir ? 63 - mrow : mrow) * 1024 + 16 * fq);
  unsigned offR[4];
#pragma unroll
  for (int r = 0; r < 4; ++r) offR[r] = (unsigned)((dir ? 63 - (crow0 + r) : (crow0 + r)) * 1024 + fr * 2);
  const unsigned offT = (unsigned)(mrow * 128 + 16 * fq);
  const unsigned offK = (unsigned)((32 * w + fr) * 128 + 16 * fq);
  const unsigned offS = (unsigned)(16384 + crow0 * 4);
  f32x4 S[2][2];
#pragma unroll
  for (int a = 0; a < 2; ++a)
#pragma unroll
    for (int b = 0; b < 2; ++b) S[a][b] = (f32x4){0.f, 0.f, 0.f, 0.f};
  bf16x8 Akn[4], Aqn[4], At[2][2], Aqk[2][2], AkT[2][2][2];
  u16 vbv[2][4];
  float4 eg4, be4, ek4[2];
  float egl[2];
#define BS_LOAD1(cg_)                                                              \
  {                                                                                \
    const size_t ro_ = (size_t)(cg_) * 65536;                                      \
    _Pragma("unroll") for (int s = 0; s < 4; ++s) {                                \
      Akn[s] = ldo8(knB + ro_, offA + 64 * s);                                     \
      Aqn[s] = ldo8(qnB + ro_, offA + 64 * s);                                     \
    }                                                                              \
    _Pragma("unroll") for (int r = 0; r < 4; ++r) {                                \
      vbv[0][r] = *(const u16*)(vbB + ro_ + offR[r]);                              \
      vbv[1][r] = *(const u16*)(vbB + ro_ + (offR[r] + 32));                       \
    }                                                                              \
    const char* rc_ = recB + (size_t)(cg_) * (8 * BIT_SZ);                         \
    eg4 = *(const float4*)(rc_ + offS);                                            \
    be4 = *(const float4*)(rc_ + (offS + 256));                                    \
  }
#define BS_LOAD2(cg_, SS)                                                          \
  {                                                                                \
    const char* rc_ = recB + (size_t)(cg_) * (8 * BIT_SZ);                         \
    At[SS][0] = ldo8(rc_, offT); At[SS][1] = ldo8(rc_, offT + 64);                 \
    ek4[SS] = *(const float4*)(rc_ + (offS + 512));                                \
  }
#define BS_LOAD3(cg_, SS)                                                          \
  {                                                                                \
    const char* rc_ = recB + (size_t)(cg_) * (8 * BIT_SZ);                         \
    Aqk[SS][0] = ldo8(rc_, offT + 8192); Aqk[SS][1] = ldo8(rc_, offT + 8192 + 64); \
    egl[SS] = *(const float*)(rc_ + 16384 + 768);                                  \
    const char* kt_ = ktB + (size_t)(cg_) * 65536;                                 \
    AkT[SS][0][0] = ldo8(kt_, offK); AkT[SS][0][1] = ldo8(kt_, offK + 64);         \
    AkT[SS][1][0] = ldo8(kt_, offK + 2048); AkT[SS][1][1] = ldo8(kt_, offK + 2048 + 64); \
  }
  {
    const int c0 = lb * 36 + BS_CHUNK(0);
    BS_LOAD1(c0) BS_LOAD2(c0, 0) BS_LOAD3(c0, 0)
  }
  for (int j2 = 0; j2 < 36; j2 += 2)
#pragma unroll
  for (int u = 0; u < 2; ++u) {
    const int j = j2 + u;
    const int cgk = lb * 36 + BS_CHUNK(j);
    const int jn = (j + 1 < 36) ? j + 1 : j;
    const int cgn = lb * 36 + BS_CHUNK(jn);
    BS_LOAD2(cgn, u ^ 1)
    BS_LOAD3(cgn, u ^ 1)
#pragma unroll
    for (int mm = 0; mm < 2; ++mm)
#pragma unroll
      for (int nt = 0; nt < 2; ++nt) {
        uint2 pk; pk.x = pk2(S[mm][nt][0], S[mm][nt][1]); pk.y = pk2(S[mm][nt][2], S[mm][nt][3]);
        *(uint2*)(Ss + (16 * nt + fr) * 136 + 32 * w + 16 * mm + 4 * fq) = pk;
      }
    LBAR();
    f32x4 QS[2];
    {
      bf16x8 Sf[2][4];
#pragma unroll
      for (int nt = 0; nt < 2; ++nt)
#pragma unroll
        for (int s = 0; s < 4; ++s) Sf[nt][s] = ld8(Ss + (16 * nt + fr) * 136 + 32 * s + 8 * fq);
#pragma unroll
      for (int nt = 0; nt < 2; ++nt) {
        f32x4 X = {0.f, 0.f, 0.f, 0.f}, Q = {0.f, 0.f, 0.f, 0.f};
#pragma unroll
        for (int s = 0; s < 4; ++s) { X = mfma(Akn[s], Sf[nt][s], X); Q = mfma(Aqn[s], Sf[nt][s], Q); }
        float r0 = be4.x * (bf2f(vbv[nt][0]) - eg4.x * X[0]);
        float r1 = be4.y * (bf2f(vbv[nt][1]) - eg4.y * X[1]);
        float r2 = be4.z * (bf2f(vbv[nt][2]) - eg4.z * X[2]);
        float r3 = be4.w * (bf2f(vbv[nt][3]) - eg4.w * X[3]);
        uint2 pk; pk.x = pk2(r0, r1); pk.y = pk2(r2, r3);
        *(uint2*)(Rs + (16 * nt + fr) * 72 + crow0) = pk;
        Q[0] *= eg4.x; Q[1] *= eg4.y; Q[2] *= eg4.z; Q[3] *= eg4.w;
        QS[nt] = Q;
      }
    }
    CBAR();
    BS_LOAD1(cgn)
    LBAR();
    {
#pragma unroll
      for (int nt = 0; nt < 2; ++nt) {
        bf16x8 Rf0 = ld8(Rs + (16 * nt + fr) * 72 + 8 * fq), Rf1 = ld8(Rs + (16 * nt + fr) * 72 + 32 + 8 * fq);
        f32x4 VN = {0.f, 0.f, 0.f, 0.f};
        VN = mfma(At[u][0], Rf0, VN);
        VN = mfma(At[u][1], Rf1, VN);
        uint2 pk; pk.x = pk2(VN[0], VN[1]); pk.y = pk2(VN[2], VN[3]);
        *(uint2*)(Vsc + (16 * nt + fr) * 72 + crow0) = pk;
        float s0 = VN[0] * ek4[u].x, s1 = VN[1] * ek4[u].y, s2 = VN[2] * ek4[u].z, s3 = VN[3] * ek4[u].w;
        if (dir) {
          pk.x = pk2(s3, s2); pk.y = pk2(s1, s0);
          *(uint2*)(Vor + (16 * nt + fr) * 72 + (60 - crow0)) = pk;
        } else {
          pk.x = pk2(s0, s1); pk.y = pk2(s2, s3);
          *(uint2*)(Vor + (16 * nt + fr) * 72 + crow0) = pk;
        }
      }
    }
    LBAR();
    {
      char* ob_ = obB + (size_t)cgk * 65536;
#pragma unroll
      for (int nt = 0; nt < 2; ++nt) {
        bf16x8 Vs0 = ld8(Vsc + (16 * nt + fr) * 72 + 8 * fq), Vs1 = ld8(Vsc + (16 * nt + fr) * 72 + 32 + 8 * fq);
        bf16x8 Vo0 = ld8(Vor + (16 * nt + fr) * 72 + 8 * fq), Vo1 = ld8(Vor + (16 * nt + fr) * 72 + 32 + 8 * fq);
        f32x4 O = QS[nt];
        O = mfma(Aqk[u][0], Vs0, O);
        O = mfma(Aqk[u][1], Vs1, O);
#pragma unroll
        for (int r = 0; r < 4; ++r) *(u16*)(ob_ + (offR[r] + 32 * nt)) = f2bf(O[r]);
#pragma unroll
        for (int mm = 0; mm < 2; ++mm) {
          f32x4 t = S[mm][nt];
#pragma unroll
          for (int r = 0; r < 4; ++r) t[r] *= egl[u];
          t = mfma(AkT[u][mm][0], Vo0, t);
          t = mfma(AkT[u][mm][1], Vo1, t);
          S[mm][nt] = t;
        }
      }
    }
  }
  LBAR();
}

DEV void c_seq2(const P& p, int bitem, char* smem) {
  const int tid = opq(threadIdx.x), lane = tid & 63, w = tid >> 6, fr = lane & 15, fq = lane >> 4;
  const int es = bitem >> 5, dir = bitem & 1, h = (bitem >> 1) & 3, lb = (bitem >> 3) & 3, e0 = es * 32;
  u16* Ssb = (u16*)smem;
  const char* recB = p.ws + O_CREC + ((size_t)h * 2 + dir) * CREC_SZ;
  const char* ztB = p.ws + O_ZT + (size_t)(h * 128 + e0) * GR * 2;
  char* ocB = p.ws + O_OC + ((size_t)dir * GR * 512 + h * 128 + e0) * 2;
  const int mrow = 16 * w + fr, crow0 = 16 * w + 4 * fq;
  const unsigned offQ = (unsigned)(mrow * 256 + 16 * fq);
  const unsigned offK = (unsigned)(16384 + (32 * w + fr) * 128 + 16 * fq);
  const unsigned offD = (unsigned)(32768 + (32 * w + 4 * fq) * 4);
  const unsigned offV = (unsigned)(fr * GR * 2 + 16 * fq);
  unsigned offR[4];
#pragma unroll
  for (int r = 0; r < 4; ++r) offR[r] = (unsigned)((dir ? 63 - (crow0 + r) : (crow0 + r)) * 1024 + fr * 2);
  f32x4 S[2][2];
#pragma unroll
  for (int a = 0; a < 2; ++a)
#pragma unroll
    for (int b = 0; b < 2; ++b) S[a][b] = (f32x4){0.f, 0.f, 0.f, 0.f};
  bf16x8 Aqd[4], Akd[2][2], Vf[2][2];
  u16 oi[2][4];
  float4 dec4[2];
#define CS_LOAD(cg_)                                                                    \
  {                                                                                     \
    const char* rc_ = recB + (size_t)(cg_) * (8 * CREC_SZ);                             \
    _Pragma("unroll") for (int s = 0; s < 4; ++s) Aqd[s] = ldo8(rc_, offQ + 64 * s);    \
    Akd[0][0] = ldo8(rc_, offK); Akd[0][1] = ldo8(rc_, offK + 64);                      \
    Akd[1][0] = ldo8(rc_, offK + 2048); Akd[1][1] = ldo8(rc_, offK + 2048 + 64);        \
    dec4[0] = *(const float4*)(rc_ + offD);                                             \
    dec4[1] = *(const float4*)(rc_ + (offD + 64));                                      \
    const char* zt_ = ztB + (size_t)(cg_) * 128;                                        \
    Vf[0][0] = ldo8(zt_, offV); Vf[0][1] = ldo8(zt_, offV + 64);                        \
    Vf[1][0] = ldo8(zt_, offV + 16 * GR * 2); Vf[1][1] = ldo8(zt_, offV + 16 * GR * 2 + 64); \
    const char* oc_ = ocB + (size_t)(cg_) * 65536;                                      \
    _Pragma("unroll") for (int r = 0; r < 4; ++r) {                                     \
      oi[0][r] = *(const u16*)(oc_ + offR[r]);                                          \
      oi[1][r] = *(const u16*)(oc_ + (offR[r] + 32));                                   \
    }                                                                                   \
  }
  {
    const int c0 = lb * 36 + BS_CHUNK(0);
    CS_LOAD(c0)
  }
  for (int j = 0; j < 36; ++j) {
    const int cgk = lb * 36 + BS_CHUNK(j);
    const int jn = (j + 1 < 36) ? j + 1 : j;
    const int cgn = lb * 36 + BS_CHUNK(jn);
    u16* Ss = Ssb + (j & 1) * (32 * 136);
#pragma unroll
    for (int mm = 0; mm < 2; ++mm)
#pragma unroll
      for (int nt = 0; nt < 2; ++nt) {
        uint2 pk; pk.x = pk2(S[mm][nt][0], S[mm][nt][1]); pk.y = pk2(S[mm][nt][2], S[mm][nt][3]);
        *(uint2*)(Ss + (16 * nt + fr) * 136 + 32 * w + 16 * mm + 4 * fq) = pk;
      }
    LBAR();
    char* oc_ = ocB + (size_t)cgk * 65536;
#pragma unroll
    for (int nt = 0; nt < 2; ++nt) {
      f32x4 O = {0.f, 0.f, 0.f, 0.f};
#pragma unroll
      for (int s = 0; s < 4; ++s) O = mfma(Aqd[s], ld8(Ss + (16 * nt + fr) * 136 + 32 * s + 8 * fq), O);
#pragma unroll
      for (int r = 0; r < 4; ++r) *(u16*)(oc_ + (offR[r] + 32 * nt)) = f2bf(bf2f(oi[nt][r]) + O[r]);
#pragma unroll
      for (int mm = 0; mm < 2; ++mm) {
        f32x4 t = S[mm][nt];
        t[0] *= dec4[mm].x; t[1] *= dec4[mm].y; t[2] *= dec4[mm].z; t[3] *= dec4[mm].w;
        t = mfma(Akd[mm][0], Vf[nt][0], t);
        t = mfma(Akd[mm][1], Vf[nt][1], t);
        S[mm][nt] = t;
      }
    }
    CBAR();
    CS_LOAD(cgn)
  }
  LBAR();
}

DEV void bc_merge_row(const P& p, int l, int lr, int lane);
DEV void bc_merge(const P& p, int l, int it) {
  const int tid_ = opq(threadIdx.x); const int lane = tid_ & 63, w = tid_ >> 6;
#pragma unroll
  for (int rr = 0; rr < 2; ++rr) bc_merge_row(p, l, it * 8 + w * 2 + rr, lane);
}
DEV void bc_merge_row(const P& p, int l, int lr, int lane) {
  int mix = lane >> 5, cm = (lane * 16) & 511;
  const u16* O = (const u16*)(p.ws + (mix ? O_OC : O_OB));
  u16* z = (u16*)(p.ws + O_Z);
  float ov[16], ss = 0.f;
#pragma unroll
  for (int k2 = 0; k2 < 2; ++k2) {
    uint4 a = *(const uint4*)(O + (size_t)lr * 512 + cm + 8 * k2);
    uint4 b = *(const uint4*)(O + ((size_t)GR + lr) * 512 + cm + 8 * k2);
    unsigned aa[4] = {a.x, a.y, a.z, a.w}, bb[4] = {b.x, b.y, b.z, b.w};
#pragma unroll
    for (int q = 0; q < 4; ++q) {
      float v0 = bf2f((u16)(aa[q] & 0xffff)) + bf2f((u16)(bb[q] & 0xffff));
      float v1 = bf2f((u16)(aa[q] >> 16)) + bf2f((u16)(bb[q] >> 16));
      ov[k2 * 8 + q * 2] = v0; ov[k2 * 8 + q * 2 + 1] = v1;
      ss += v0 * v0 + v1 * v1;
    }
  }
  ss += __shfl_xor(ss, 1); ss += __shfl_xor(ss, 2); ss += __shfl_xor(ss, 4);
  float rinv = rsqrtf(ss * (1.f / 128.f) + EPS);
  const float* nw = (mix ? p.hg_norm : p.gdn_norm) + l * 128 + (cm & 127);
  u16* gp = z + (size_t)lr * NZ + (mix ? C_GC : C_GB) + cm;
#pragma unroll
  for (int k2 = 0; k2 < 2; ++k2) {
    uint4 gv = *(const uint4*)(gp + 8 * k2);
    unsigned gg[4] = {gv.x, gv.y, gv.z, gv.w}, oo[4];
#pragma unroll
    for (int q = 0; q < 4; ++q) {
      int e = k2 * 8 + q * 2;
      float y0 = ov[e] * rinv * nw[e] * silu(bf2f((u16)(gg[q] & 0xffff)));
      float y1 = ov[e + 1] * rinv * nw[e + 1] * silu(bf2f((u16)(gg[q] >> 16)));
      oo[q] = pk2(y0, y1);
    }
    *(uint4*)(gp + 8 * k2) = make_uint4(oo[0], oo[1], oo[2], oo[3]);
  }
}

#define XB_TMO      128
#define XB_XCNT(j)  (256  + 64 * (j))
#define XB_XSUB(j)  (1280 + 64 * (j))
#define XB_XGEN(j)  (2304 + 64 * (j))
#define XB_TOP      3328
#define XB_TOPGEN   3392
#define XCD_BAR_WORDS 3456
#define XB_SPIN_CAP (1u << 18)
#define LAS __attribute__((address_space(3)))

__device__ __forceinline__ unsigned xb_ld(unsigned* p)              { return __hip_atomic_load(p, __ATOMIC_RELAXED, __HIP_MEMORY_SCOPE_AGENT); }
__device__ __forceinline__ unsigned xb_add(unsigned* p, unsigned v) { return __hip_atomic_fetch_add(p, v, __ATOMIC_RELAXED, __HIP_MEMORY_SCOPE_AGENT); }
__device__ __forceinline__ unsigned xb_xcc_id() { return (unsigned)__builtin_amdgcn_s_getreg((3 << 11) | 20) & 0xFu; }
#define XB_SPIN(cond, bar) do { unsigned _sp = 0; while (cond) { __builtin_amdgcn_s_sleep(1); \
    if ((++_sp & 255u) == 0u) { if (xb_ld(&(bar)[XB_TMO])) break; if (_sp > XB_SPIN_CAP) { atomicAdd(&(bar)[XB_TMO], 1u); break; } } } } while (0)

struct XcdBarrier {
    unsigned* bar; unsigned x;
    volatile LAS unsigned* st;
};

__device__ __forceinline__ XcdBarrier xcd_barrier_post(unsigned* bar, volatile LAS unsigned* st) {
    XcdBarrier b; b.bar = bar; b.x = xb_xcc_id(); b.st = st;
    if (threadIdx.x == 0) (void)xb_add(&bar[XB_XCNT(b.x)], 1u);
    return b;
}
__device__ __forceinline__ void xcd_barrier_complete(unsigned* bar, unsigned x, unsigned& nloc, unsigned& nx) {
    const unsigned G = gridDim.x * gridDim.y * gridDim.z;
    unsigned sum, cnt, mine, sp = 0u;
    for (;;) {
        sum = 0u; cnt = 0u; mine = 0u;
#pragma unroll
        for (unsigned j = 0; j < 16; ++j) { const unsigned c = xb_ld(&bar[XB_XCNT(j)]); sum += c; cnt += (c > 0u) ? 1u : 0u; mine = (j == x) ? c : mine; }
        if (sum == G) break;
        __builtin_amdgcn_s_sleep(1);
        if ((++sp & 255u) == 0u) { if (xb_ld(&bar[XB_TMO])) break; if (sp > XB_SPIN_CAP) { atomicAdd(&bar[XB_TMO], 1u); break; } }
    }
    nloc = mine > 0u ? mine : 1u; nx = cnt > 0u ? cnt : 1u;
}

__device__ __forceinline__ void xcd_barrier(const XcdBarrier& b) {
    asm volatile("s_waitcnt vmcnt(0)" ::: "memory");
    __syncthreads();
    if (threadIdx.x == 0) {
        unsigned* bar = b.bar;
        __builtin_amdgcn_s_waitcnt(0);
        unsigned nloc = b.st[0], nx = b.st[1];
        if (nloc == 0u) { xcd_barrier_complete(bar, b.x, nloc, nx); b.st[0] = nloc; b.st[1] = nx; }
        const unsigned old = xb_add(&bar[XB_XSUB(b.x)], 1u);
        const unsigned gen = old / nloc;
        if (old + 1u == (gen + 1u) * nloc) {
            __builtin_amdgcn_fence(__ATOMIC_RELEASE, "agent");
            asm volatile("s_waitcnt vmcnt(0)" ::: "memory");
            const unsigned og = xb_add(&bar[XB_TOP], 1u);
            const unsigned tg = og / nx;
            if (og + 1u == (tg + 1u) * nx) xb_add(&bar[XB_TOPGEN], 1u);
            else XB_SPIN(xb_ld(&bar[XB_TOPGEN]) == tg, bar);
            __builtin_amdgcn_fence(__ATOMIC_ACQUIRE, "agent");
            xb_add(&bar[XB_XGEN(b.x)], 1u);
            asm volatile("s_waitcnt vmcnt(0)" ::: "memory");
        } else {
            XB_SPIN(xb_ld(&bar[XB_XGEN(b.x)]) == gen, bar);
            __builtin_amdgcn_fence(__ATOMIC_ACQUIRE, "agent");
            asm volatile("s_waitcnt vmcnt(0)" ::: "memory");
        }
    }
    __syncthreads();
}


#ifdef NO_G0
#define XG0(x)
#else
#define XG0(x) x
#endif
#ifdef NO_G1
#define XG1(x)
#else
#define XG1(x) x
#endif
#ifdef NO_BC
#define XBC(x)
#else
#define XBC(x) x
#endif
#ifdef NO_AC
#define XAC(x)
#else
#define XAC(x) x
#endif
#ifdef NO_P0
#define XP0(x)
#else
#define XP0(x) x
#endif
#ifdef NO_R
#define XR(x)
#else
#define XR(x) x
#endif
#ifdef NO_BL
#define XBL(x)
#else
#define XBL(x) x
#endif
#ifdef NO_CL
#define XCL(x)
#else
#define XCL(x) x
#endif
#ifdef NO_A0
#define XA0(x)
#else
#define XA0(x) x
#endif
#ifdef NO_A1
#define XA1(x)
#else
#define XA1(x) x
#endif
#ifdef NO_BS
#define XBS(x)
#else
#define XBS(x) x
#endif
#ifdef NO_CS
#define XCS(x)
#else
#define XCS(x) x
#endif
__global__ void __launch_bounds__(256, 2) fwd_mega(P p) {
  extern __shared__ __attribute__((aligned(16))) char smem[];
  cg::grid_group grid = cg::this_grid();
  const int G = gridDim.x;
  __shared__ uint4 xb_words;
  if (threadIdx.x == 0) xb_words = make_uint4(0u, 0u, 0u, 0u);
  __syncthreads();
  XcdBarrier xb = xcd_barrier_post((unsigned*)(p.ws + O_BAR), (volatile LAS unsigned*)&xb_words);
  XP0(phase0(p, smem));
  if (p.ws == nullptr) grid.sync();
  xcd_barrier(xb);
  u16* z = (u16*)(p.ws + O_Z);
  u16* zT = (u16*)(p.ws + O_ZT);
  float* ab = (float*)(p.ws + O_AB);
  float* o = (float*)(p.ws + O_BSH);
  const u16* u = (const u16*)(p.ws + O_BIT);
  for (int g = 0; g < NG; ++g) {
    XR(phaseR(p, g, 0));
    xcd_barrier(xb);
    for (int l = 0; l < DEPTH; ++l) {
      for (int rep = 0; rep < REP_G; ++rep) {
        const u16* Bt = (const u16*)(p.ws + O_WTIN) + (size_t)l * NZ * 1024;
        if ((G & 7) == 0) {
          const int x = blockIdx.x & 7, bl = blockIdx.x >> 3, nbl = G >> 3;
          for (int q = bl; q < 9 * 45; q += nbl) { XG0(gemm_tile<0>(u, 1024, Bt, 1024, 9 * x + q % 9, q / 9, z, zT, ab, o, smem)); }
        } else {
          for (int t = blockIdx.x; t < 72 * 45; t += G) { XG0(gemm_tile<0>(u, 1024, Bt, 1024, t % 72, t / 72, z, zT, ab, o, smem)); }
        }
      }
      xcd_barrier(xb);
      for (int rep2 = 0; rep2 < REP_M; ++rep2) {
      for (int rep3 = 0; rep3 < REP_A; ++rep3) {
        if (rep3) xcd_barrier(xb);
        const int nb = NCH * 4, nc = NCH * 4, na = NCH * 8;
        if (G == 512) {
          const int bx = blockIdx.x;
          XCL(c_local2(p, l, bx, smem));
          if (bx < 64) { XCL(c_local2(p, l, 512 + bx, smem)); }
          XBL(b_local(p, l, bx, smem));
          if (bx >= 64 && bx < 128) { XBL(b_local(p, l, 448 + bx, smem)); }
          if (bx < 128) { XA0(a_item(p, l, bx, 0, smem)); }
          else {
            for (int t = 128 + (bx - 128); t < na; t += 384) { XA0(a_item(p, l, t, 0, smem)); }
          }
        } else {
          for (int t = blockIdx.x; t < nb + nc + na; t += G) {
            if (t < nc) { XCL(c_local2(p, l, t, smem)); }
            else if (t < nb + nc) { XBL(b_local(p, l, t - nc, smem)); }
            else { XA0(a_item(p, l, t - nb - nc, 0, smem)); }
          }
        }
      }
      xcd_barrier(xb);
      {
        unsigned* cflag = (unsigned*)(p.ws + O_BAR) + XCD_BAR_WORDS + (g * DEPTH + l);
        const int na = NCH * 8;
        for (int part = 0; part < 2; ++part) {
          int a0 = na, astep = 1;
          if (part == 0) {
            for (int t = blockIdx.x; t < 256 + 16; t += G) {
              if (t < 128) { XBS(b_seq2(p, t, smem)); }
              else if (t < 256) { XCS(c_seq2(p, t - 128, smem)); }
              else { XAC(a_carry(p, t - 256, cflag)); }
            }
            if (G == 512 && blockIdx.x >= 384) {
              if (threadIdx.x == 0) {
                unsigned sp = 0;
                while (__hip_atomic_load(cflag, __ATOMIC_RELAXED, __HIP_MEMORY_SCOPE_AGENT) < 16u && ++sp < (1u << 24)) __builtin_amdgcn_s_sleep(2);
                __builtin_amdgcn_fence(__ATOMIC_ACQUIRE, "agent");
                asm volatile("s_waitcnt vmcnt(0)" ::: "memory");
              }
              __syncthreads();
              a0 = blockIdx.x - 384; astep = 128;
            }
          } else if (G != 512) {
            a0 = blockIdx.x; astep = G;
          }
          for (int t = a0; t < na; t += astep) { XA1(a_fin2(p, l, t, smem)); }
          if (part == 0) xcd_barrier(xb);
        }
      }
      }
      {
        const int nm = GR / 8;
        for (int t = blockIdx.x; t < nm; t += G) { XBC(bc_merge(p, l, t)); }
      }
      xcd_barrier(xb);
      for (int rep = 0; rep < REP_G; ++rep) {
        const u16* Bt = (const u16*)(p.ws + O_WTOUT) + (size_t)l * 1024 * 1536;
        if (l == DEPTH - 1) {
          for (int t = blockIdx.x; t < 64 * 8; t += G) {
            const int q = t % 64, rt = (q >> 4) * 18 + 2 + (q & 15);
            XG1(gemm_tile<1>(z + C_GA, NZ, Bt, 1536, rt, t / 64, z, zT, ab, o, smem));
          }
        } else {
          for (int t = blockIdx.x; t < 72 * 8; t += G) { XG1(gemm_tile<1>(z + C_GA, NZ, Bt, 1536, t % 72, t / 72, z, zT, ab, o, smem)); }
        }
      }
      xcd_barrier(xb);
      XR(phaseR(p, g, l + 1));
      if (l + 1 < DEPTH) xcd_barrier(xb);
    }
  }
}

extern "C" void kernel_launch(void* const* d_in, const int* in_sizes, int n_in, void* d_out, int out_size, void* d_ws,
                              size_t ws_size, hipStream_t stream) {
  static int grid_blocks = 0;
  if (!grid_blocks) {
    int dev = 0, cus = 0, per_cu = 0;
    hipGetDevice(&dev);
    hipDeviceGetAttribute(&cus, hipDeviceAttributeMultiprocessorCount, dev);
    hipFuncSetAttribute((const void*)fwd_mega, hipFuncAttributeMaxDynamicSharedMemorySize, LDS_BYTES);
    hipOccupancyMaxActiveBlocksPerMultiprocessor(&per_cu, fwd_mega, 256, LDS_BYTES);
    if (per_cu > 2) per_cu = 2;
    if (per_cu < 1) per_cu = 1;
    grid_blocks = cus * per_cu;
  }
  if (ws_size < WS_TOTAL) {
    fprintf(stderr, "workspace too small: %zu < %zu\n", ws_size, (size_t)WS_TOTAL);
    return;
  }
  P p{};
  const float** f = (const float**)&p;
  for (int i = 0; i < 23; ++i) f[i] = (const float*)d_in[i];
  p.out = (float*)d_out;
  p.ws = (char*)d_ws;
  hipMemsetAsync((char*)d_ws + O_BAR, 0, XCD_BAR_WORDS * 4 + 256, stream);
  void* args[] = {&p};
  hipError_t e = hipLaunchCooperativeKernel((void*)fwd_mega, dim3(grid_blocks), dim3(256), args, LDS_BYTES, stream);
  if (e != hipSuccess) fprintf(stderr, "cooperative launch failed: %s (grid %d)\n", hipGetErrorString(e), grid_blocks);
}
```
